# Optimizing an MI355X kernel written in HIP

```python
import math
import jax, jax.numpy as jnp
from jax import lax
import numpy as np

D_MODEL = 1024
BATCH = 4
SEQ = 8192
DEPTH = 2

CHUNK = 64
Q_BLOCK = 128
D_MIX = D_MODEL
D_SSM = D_MIX // 2
SSM_GROUP = 16
N_SSM_GROUPS = D_SSM // SSM_GROUP
SSM_STATE = 64
D_ATTN = D_MIX - D_SSM
N_HEADS = 4
HEAD_DIM_V = D_ATTN // N_HEADS
HEAD_DIM_QK = HEAD_DIM_V // 2
D_IN = D_SSM + 3 * D_ATTN
ROPE_THETA = 10000.0
N_EXPERTS = 32
TOP_K = 4
D_FF = D_MODEL
SWIGLU_LIMIT = 7.0
SWIGLU_ALPHA = 1.702
MOE_BLOCK = 128
EPS = 1e-6

kernel_name = "hymba_s5_diffattn_gptoss_moe"


def rms_norm(x, g):
    xf = x.astype(jnp.float32)
    y = xf * lax.rsqrt(jnp.mean(xf * xf, axis=-1, keepdims=True) + EPS)
    return (y * g.astype(jnp.float32)).astype(x.dtype)


def rope_tables(seq_len):
    inv = 1.0 / (ROPE_THETA ** (jnp.arange(0, HEAD_DIM_QK, 2, dtype=jnp.float32) / HEAD_DIM_QK))
    ang = jnp.arange(seq_len, dtype=jnp.float32)[:, None] * inv[None, :]
    return jnp.cos(ang), jnp.sin(ang)


def apply_rope(x, cos, sin):
    c = cos[None, :, None, None, :].astype(x.dtype)
    s = sin[None, :, None, None, :].astype(x.dtype)
    x1, x2 = jnp.split(x, 2, axis=-1)
    return jnp.concatenate([x1 * c - x2 * s, x2 * c + x1 * s], axis=-1)


def _ssm_combine(e1, e2):
    a1, b1 = e1
    a2, b2 = e2
    return a2 * a1, a2 * b1 + b2


def s5_mixer(u, lam_re, lam_im, log_step, b_re, b_im, c_re, c_im, d_skip, w_glu, g_norm):
    bsz, seq, _ = u.shape
    uf = u.astype(jnp.float32).reshape(bsz, seq, N_SSM_GROUPS, SSM_GROUP)
    lam = lax.complex(lam_re.astype(jnp.float32), lam_im.astype(jnp.float32))
    step = jnp.exp(log_step.astype(jnp.float32))[:, None]
    lam_bar = jnp.exp(lam * step)
    b_mat = lax.complex(b_re.astype(jnp.float32), b_im.astype(jnp.float32))
    c_mat = lax.complex(c_re.astype(jnp.float32), c_im.astype(jnp.float32))
    b_bar = ((lam_bar - 1.0) / lam)[..., None] * b_mat
    bu = jnp.einsum('bsgh,gph->bsgp', uf.astype(jnp.complex64), b_bar)
    a = jnp.broadcast_to(lam_bar[None, None], (1, seq, N_SSM_GROUPS, SSM_STATE))
    _, states = lax.associative_scan(_ssm_combine, (a, bu), axis=1)
    y = jnp.einsum('bsgp,ghp->bsgh', states, c_mat).real \
        + d_skip.astype(jnp.float32).reshape(N_SSM_GROUPS, SSM_GROUP) * uf
    y = jax.nn.gelu(y.reshape(bsz, seq, D_SSM))
    y = y * jax.nn.sigmoid(y @ w_glu.astype(jnp.float32))
    return rms_norm(y.astype(u.dtype), g_norm)


def diff_attention(q, k, v, cos, sin, q_norm_g, k_norm_g, lam_q1, lam_k1, lam_q2, lam_k2,
                   subln_g, lambda_init):
    bsz, seq, _ = q.shape
    q = q.reshape(bsz, seq, N_HEADS, 2, HEAD_DIM_QK)
    k = k.reshape(bsz, seq, N_HEADS, 2, HEAD_DIM_QK)
    v = v.reshape(bsz, seq, N_HEADS, HEAD_DIM_V)
    q = apply_rope(rms_norm(q, q_norm_g), cos, sin)
    k = apply_rope(rms_norm(k, k_norm_g), cos, sin)
    lam = (jnp.exp(jnp.sum(lam_q1.astype(jnp.float32) * lam_k1.astype(jnp.float32)))
           - jnp.exp(jnp.sum(lam_q2.astype(jnp.float32) * lam_k2.astype(jnp.float32)))
           + lambda_init)
    scale = 1.0 / math.sqrt(HEAD_DIM_QK)
    n_blk = seq // Q_BLOCK
    k_chunk = jnp.arange(seq) // CHUNK
    q_blocks = jnp.moveaxis(q.reshape(bsz, n_blk, Q_BLOCK, N_HEADS, 2, HEAD_DIM_QK), 1, 0)

    def attend(args):
        qb, bi = args
        s = jnp.einsum('bqhmd,bkhmd->bhmqk', qb, k).astype(jnp.float32) * scale
        q_chunk = (bi * Q_BLOCK + jnp.arange(Q_BLOCK)) // CHUNK
        mask = k_chunk[None, :] <= q_chunk[:, None]
        p = jax.nn.softmax(jnp.where(mask, s, -jnp.inf), axis=-1)
        pd = p[:, :, 0] - lam * p[:, :, 1]
        return jnp.einsum('bhqk,bkhd->bqhd', pd.astype(v.dtype), v)

    o = lax.map(attend, (q_blocks, jnp.arange(n_blk)))
    o = jnp.moveaxis(o, 0, 1).reshape(bsz, seq, N_HEADS, HEAD_DIM_V)
    o = rms_norm(o, subln_g) * (1.0 - lambda_init)
    return o.reshape(bsz, seq, D_ATTN)


def moe_ffn(xn, w_router, b_router, w_up, b_up, w_down, b_down):
    bsz, seq, dm = xn.shape
    n_tok = bsz * seq
    xt = xn.reshape(n_tok, dm)
    logits = (xt @ w_router + b_router).astype(jnp.float32)
    top_val, top_idx = lax.top_k(logits, TOP_K)
    gates = jax.nn.softmax(top_val, axis=-1)
    n_assign = n_tok * TOP_K
    expert = top_idx.reshape(-1)
    token = jnp.arange(n_assign) // TOP_K
    order = jnp.argsort(expert, stable=True)
    e_s, t_s, g_s = expert[order], token[order], gates.reshape(-1)[order]
    counts = jnp.bincount(expert, length=N_EXPERTS)
    padded = (counts + MOE_BLOCK - 1) // MOE_BLOCK * MOE_BLOCK
    pad_end = jnp.cumsum(padded)
    pad_start = pad_end - padded
    start = jnp.cumsum(counts) - counts
    dest = pad_start[e_s] + jnp.arange(n_assign) - start[e_s]
    n_blocks = -(-n_assign // MOE_BLOCK) + N_EXPERTS
    buf = jnp.zeros((n_blocks * MOE_BLOCK, dm), xt.dtype).at[dest].set(xt[t_s])
    block_expert = jnp.minimum(
        jnp.searchsorted(pad_end, jnp.arange(n_blocks) * MOE_BLOCK, side='right'), N_EXPERTS - 1)

    def expert_block(args):
        xb, e = args
        h = xb @ w_up[e] + b_up[e]
        glu, lin = jnp.split(h, 2, axis=-1)
        glu = jnp.minimum(glu, SWIGLU_LIMIT)
        lin = jnp.clip(lin, -SWIGLU_LIMIT, SWIGLU_LIMIT)
        act = glu * jax.nn.sigmoid(SWIGLU_ALPHA * glu) * (lin + 1.0)
        return act @ w_down[e] + b_down[e]

    y_buf = lax.map(expert_block, (buf.reshape(n_blocks, MOE_BLOCK, dm), block_expert))
    y = y_buf.reshape(-1, dm)[dest] * g_s[:, None].astype(y_buf.dtype)
    out = jax.ops.segment_sum(y, t_s, num_segments=n_tok)
    return out.reshape(bsz, seq, dm).astype(xn.dtype)


def setup_inputs(seed: int = 0) -> dict:
    key = jax.random.key(seed)
    ks = jax.random.split(key, 32)

    def nrm(k, shape, scale):
        return jax.random.normal(k, shape, jnp.float32) * scale

    G, P, H = N_SSM_GROUPS, SSM_STATE, SSM_GROUP
    lam_re = -0.5 + 0.01 * jax.random.uniform(ks[3], (DEPTH, G, P), jnp.float32, -1.0, 1.0)
    lam_im = jnp.pi * jnp.arange(P, dtype=jnp.float32)[None, None, :] + nrm(ks[4], (DEPTH, G, P), 0.01)
    log_step = jax.random.uniform(ks[5], (DEPTH, G), jnp.float32, math.log(1e-3), math.log(1e-1))
    return {
        "x": nrm(ks[0], (BATCH, SEQ, D_MODEL), 1.0),
        "g_mix": 1.0 + nrm(ks[1], (DEPTH, D_MODEL), 0.02),
        "w_in": nrm(ks[2], (DEPTH, D_MODEL, D_IN), D_MODEL ** -0.5),
        "ssm_lam_re": lam_re,
        "ssm_lam_im": lam_im,
        "ssm_log_step": log_step,
        "ssm_b_re": nrm(ks[6], (DEPTH, G, P, H), (2.0 * H) ** -0.5),
        "ssm_b_im": nrm(ks[7], (DEPTH, G, P, H), (2.0 * H) ** -0.5),
        "ssm_c_re": nrm(ks[8], (DEPTH, G, H, P), (2.0 * P) ** -0.5),
        "ssm_c_im": nrm(ks[9], (DEPTH, G, H, P), (2.0 * P) ** -0.5),
        "ssm_d": nrm(ks[10], (DEPTH, D_SSM), 1.0),
        "ssm_w_glu": nrm(ks[11], (DEPTH, D_SSM, D_SSM), D_SSM ** -0.5),
        "ssm_norm_g": 1.0 + nrm(ks[12], (DEPTH, D_SSM), 0.02),
        "q_norm_g": 1.0 + nrm(ks[13], (DEPTH, HEAD_DIM_QK), 0.02),
        "k_norm_g": 1.0 + nrm(ks[14], (DEPTH, HEAD_DIM_QK), 0.02),
        "lam_q1": nrm(ks[15], (DEPTH, HEAD_DIM_QK), 0.1),
        "lam_k1": nrm(ks[16], (DEPTH, HEAD_DIM_QK), 0.1),
        "lam_q2": nrm(ks[17], (DEPTH, HEAD_DIM_QK), 0.1),
        "lam_k2": nrm(ks[18], (DEPTH, HEAD_DIM_QK), 0.1),
        "subln_g": 1.0 + nrm(ks[19], (DEPTH, HEAD_DIM_V), 0.02),
        "w_out": nrm(ks[20], (DEPTH, D_MIX, D_MODEL), D_MIX ** -0.5),
        "g_ffn": 1.0 + nrm(ks[21], (DEPTH, D_MODEL), 0.02),
        "w_router": nrm(ks[22], (DEPTH, D_MODEL, N_EXPERTS), D_MODEL ** -0.5),
        "b_router": nrm(ks[23], (DEPTH, N_EXPERTS), 0.01),
        "w_up": nrm(ks[24], (DEPTH, N_EXPERTS, D_MODEL, 2 * D_FF), D_MODEL ** -0.5),
        "b_up": nrm(ks[25], (DEPTH, N_EXPERTS, 2 * D_FF), 0.01),
        "w_down": nrm(ks[26], (DEPTH, N_EXPERTS, D_FF, D_MODEL), D_FF ** -0.5),
        "b_down": nrm(ks[27], (DEPTH, N_EXPERTS, D_MODEL), 0.01),
    }


def reference(x, g_mix, w_in, ssm_lam_re, ssm_lam_im, ssm_log_step, ssm_b_re, ssm_b_im,
              ssm_c_re, ssm_c_im, ssm_d, ssm_w_glu, ssm_norm_g, q_norm_g, k_norm_g,
              lam_q1, lam_k1, lam_q2, lam_k2, subln_g, w_out, g_ffn, w_router, b_router,
              w_up, b_up, w_down, b_down):
    seq = x.shape[1]
    cos, sin = rope_tables(seq)
    h = x
    for l in range(DEPTH):
        lambda_init = 0.8 - 0.6 * math.exp(-0.3 * l)
        xn = rms_norm(h, g_mix[l])
        proj = xn @ w_in[l]
        u = proj[..., :D_SSM]
        q = proj[..., D_SSM:D_SSM + D_ATTN]
        k = proj[..., D_SSM + D_ATTN:D_SSM + 2 * D_ATTN]
        v = proj[..., D_SSM + 2 * D_ATTN:]
        y_ssm = s5_mixer(u, ssm_lam_re[l], ssm_lam_im[l], ssm_log_step[l], ssm_b_re[l], ssm_b_im[l],
                         ssm_c_re[l], ssm_c_im[l], ssm_d[l], ssm_w_glu[l], ssm_norm_g[l])
        y_att = diff_attention(q, k, v, cos, sin, q_norm_g[l], k_norm_g[l], lam_q1[l], lam_k1[l],
                               lam_q2[l], lam_k2[l], subln_g[l], lambda_init)
        h = h + jnp.concatenate([y_ssm, y_att], axis=-1) @ w_out[l]
        h = h + moe_ffn(rms_norm(h, g_ffn[l]), w_router[l], b_router[l], w_up[l], b_up[l],
                        w_down[l], b_down[l])
    return h
```

```cpp
#include <hip/hip_runtime.h>
#include <math.h>
#include <stdint.h>

namespace nv {
constexpr int D_MODEL = 1024, BATCH = 4, SEQ = 8192, DEPTH = 2, T = BATCH * SEQ;
constexpr int D_SSM = 512, G = 32, HS = 16, P = 64, D_ATTN = 512, NH = 4, DV = 128, DQK = 64, D_IN = 2048;
constexpr int NE = 32, TOPK = 4, D_FF = 1024, NASSIGN = T * TOPK;
constexpr float EPS = 1e-6f;

__device__ __forceinline__ float wave_sum(float v) {
#pragma unroll
    for (int o = 1; o < 64; o <<= 1) v += __shfl_xor(v, o);
    return v;
}

__global__ __launch_bounds__(256) void k_rmsnorm(const float* __restrict__ x, const float* __restrict__ g, float* __restrict__ y, int rows, int dim, int ldy) {
    const int row = blockIdx.x * 4 + (threadIdx.x >> 6), lane = threadIdx.x & 63;
    if (row >= rows) return;
    const float* xr = x + (size_t)row * dim;
    float s = 0.f;
    for (int i = lane; i < dim; i += 64) { const float v = xr[i]; s += v * v; }
    s = wave_sum(s);
    const float r = rsqrtf(s / (float)dim + EPS);
    for (int i = lane; i < dim; i += 64) y[(size_t)row * ldy + i] = xr[i] * r * g[i];
}

struct GemmP {
    const float* A; int lda; const int* rowidx; const float* B; int ldb; float* C; int ldc; int M, N, K;
    const float* bias; const float* R; int ldr; int epi; const int* cnt; const int* off; long strideB; int strideBias; const float* gate; int pad;
};
__global__ __launch_bounds__(256) void k_gemm(GemmP p) {
    __shared__ float As[16][68];
    __shared__ float Bs[16][68];
    __shared__ float Bs2[16][68];
    const int e = blockIdx.z; int M = p.M; int rowoff = 0; const float* B = p.B; const float* bias = p.bias;
    if (p.cnt) { M = p.cnt[e]; rowoff = p.off[e]; B += (size_t)e * p.strideB; if (bias) bias += (size_t)e * p.strideBias; }
    const int m0 = blockIdx.y * 64, n0 = blockIdx.x * 64;
    if (m0 >= M) return;
    const int tid = threadIdx.x, tx = tid & 15, ty = tid >> 4;
    float acc[4][4], acc2[4][4];
#pragma unroll
    for (int i = 0; i < 4; ++i)
#pragma unroll
        for (int j = 0; j < 4; ++j) { acc[i][j] = 0.f; acc2[i][j] = 0.f; }
    const int ar = tid >> 2, ak = (tid & 3) * 4;
    const bool avalid = (m0 + ar) < M; size_t asrc = 0;
    if (avalid) { int gr = rowoff + m0 + ar; if (p.rowidx) gr = p.rowidx[gr]; asrc = (size_t)gr * p.lda; }
    const int bk = tid >> 4, bn = (tid & 15) * 4;
    for (int k0 = 0; k0 < p.K; k0 += 16) {
        float4 av = make_float4(0.f, 0.f, 0.f, 0.f);
        if (avalid) av = *(const float4*)(p.A + asrc + k0 + ak);
        As[ak + 0][ar] = av.x; As[ak + 1][ar] = av.y; As[ak + 2][ar] = av.z; As[ak + 3][ar] = av.w;
        const float4 bv = *(const float4*)(B + (size_t)(k0 + bk) * p.ldb + n0 + bn);
        Bs[bk][bn + 0] = bv.x; Bs[bk][bn + 1] = bv.y; Bs[bk][bn + 2] = bv.z; Bs[bk][bn + 3] = bv.w;
        if (p.epi == 3) {
            const float4 bv2 = *(const float4*)(B + (size_t)(k0 + bk) * p.ldb + n0 + bn + 1024);
            Bs2[bk][bn + 0] = bv2.x; Bs2[bk][bn + 1] = bv2.y; Bs2[bk][bn + 2] = bv2.z; Bs2[bk][bn + 3] = bv2.w;
        }
        __syncthreads();
#pragma unroll
        for (int kk = 0; kk < 16; ++kk) {
            float a[4], b[4];
#pragma unroll
            for (int i = 0; i < 4; ++i) { a[i] = As[kk][ty * 4 + i]; b[i] = Bs[kk][tx * 4 + i]; }
#pragma unroll
            for (int i = 0; i < 4; ++i)
#pragma unroll
                for (int j = 0; j < 4; ++j) acc[i][j] += a[i] * b[j];
            if (p.epi == 3) {
                float b2[4];
#pragma unroll
                for (int i = 0; i < 4; ++i) b2[i] = Bs2[kk][tx * 4 + i];
#pragma unroll
                for (int i = 0; i < 4; ++i)
#pragma unroll
                    for (int j = 0; j < 4; ++j) acc2[i][j] += a[i] * b2[j];
            }
        }
        __syncthreads();
    }
#pragma unroll
    for (int i = 0; i < 4; ++i) {
        const int row = m0 + ty * 4 + i; if (row >= M) continue;
        const int grow = rowoff + row;
#pragma unroll
        for (int j = 0; j < 4; ++j) {
            const int col = n0 + tx * 4 + j; float v = acc[i][j]; float o;
            if (p.epi == 0) { o = v + (bias ? bias[col] : 0.f); }
            else if (p.epi == 1) { const float yv = p.A[(size_t)grow * p.lda + col]; o = yv * (1.f / (1.f + expf(-v))); }
            else if (p.epi == 2) { o = p.R[(size_t)grow * p.ldr + col] + v; }
            else if (p.epi == 3) {
                float glu = v + bias[col], lin = acc2[i][j] + bias[col + 1024];
                glu = fminf(glu, 7.0f); lin = fminf(fmaxf(lin, -7.0f), 7.0f);
                o = glu * (1.f / (1.f + expf(-1.702f * glu))) * (lin + 1.0f);
            } else { o = p.gate[grow] * (v + bias[col]); }
            p.C[(size_t)grow * p.ldc + col] = o;
        }
    }
}

__global__ __launch_bounds__(256) void k_qknorm_rope(const float* __restrict__ proj, const float* __restrict__ gq, const float* __restrict__ gk, float* __restrict__ QN, float* __restrict__ KN) {
    const size_t idx = (size_t)blockIdx.x * 256 + threadIdx.x;
    if (idx >= (size_t)T * 16) return;
    const int t = (int)(idx >> 4), w = (int)(idx & 15), which = w >> 3, hm = w & 7;
    const int s = t % SEQ;
    const float* src = proj + (size_t)t * D_IN + D_SSM + which * D_ATTN + hm * 64;
    const float* g = which ? gk : gq;
    float* dst = (which ? KN : QN) + (size_t)t * D_ATTN + hm * 64;
    float ss = 0.f;
    for (int i = 0; i < 64; ++i) { const float v = src[i]; ss += v * v; }
    const float r = rsqrtf(ss / 64.f + EPS);
    for (int j = 0; j < 32; ++j) {
        const float inv = 1.0f / powf(10000.0f, (float)(2 * j) / 64.0f);
        const float ang = (float)s * inv;
        const float c = cosf(ang), sn = sinf(ang);
        const float x1 = src[j] * r * g[j], x2 = src[j + 32] * r * g[j + 32];
        dst[j] = x1 * c - x2 * sn; dst[j + 32] = x2 * c + x1 * sn;
    }
}

__device__ __forceinline__ float gelu_tanh(float x) { return 0.5f * x * (1.f + tanhf(0.7978845608028654f * (x + 0.044715f * x * x * x))); }

__global__ __launch_bounds__(64) void k_s5(const float* __restrict__ proj, const float* __restrict__ lam_re, const float* __restrict__ lam_im, const float* __restrict__ log_step,
                                           const float* __restrict__ b_re, const float* __restrict__ b_im, const float* __restrict__ c_re, const float* __restrict__ c_im,
                                           const float* __restrict__ dskip, float* __restrict__ ys) {
    const int b = blockIdx.x / G, g = blockIdx.x % G, p = threadIdx.x;
    const float step = expf(log_step[g]);
    const float lr = lam_re[g * P + p], li = lam_im[g * P + p];
    const float mag = expf(lr * step), ang = li * step;
    const float lbr = mag * cosf(ang), lbi = mag * sinf(ang);
    const float nr = lbr - 1.f, ni = lbi, den = lr * lr + li * li;
    const float fr = (nr * lr + ni * li) / den, fi = (ni * lr - nr * li) / den;
    float bbr[16], bbi[16], cr[16], ci[16];
#pragma unroll
    for (int h = 0; h < 16; ++h) {
        const float br = b_re[(size_t)(g * P + p) * HS + h], bi = b_im[(size_t)(g * P + p) * HS + h];
        bbr[h] = fr * br - fi * bi; bbi[h] = fr * bi + fi * br;
        cr[h] = c_re[(size_t)(g * HS + h) * P + p]; ci[h] = c_im[(size_t)(g * HS + h) * P + p];
    }
    const float dk = (p < 16) ? dskip[g * 16 + p] : 0.f;
    float xr = 0.f, xi = 0.f;
    for (int s = 0; s < SEQ; ++s) {
        const float* up = proj + (size_t)(b * SEQ + s) * D_IN + g * 16;
        float u[16];
#pragma unroll
        for (int q = 0; q < 4; ++q) { const float4 v = *(const float4*)(up + 4 * q); u[4 * q] = v.x; u[4 * q + 1] = v.y; u[4 * q + 2] = v.z; u[4 * q + 3] = v.w; }
        float bur = 0.f, bui = 0.f;
#pragma unroll
        for (int h = 0; h < 16; ++h) { bur += u[h] * bbr[h]; bui += u[h] * bbi[h]; }
        const float nxr = lbr * xr - lbi * xi + bur, nxi = lbr * xi + lbi * xr + bui;
        xr = nxr; xi = nxi;
        float my = 0.f;
#pragma unroll
        for (int h = 0; h < 16; ++h) { float v = xr * cr[h] - xi * ci[h]; v = wave_sum(v); if (p == h) my = v; }
        if (p < 16) { const float y = my + dk * up[p]; ys[(size_t)(b * SEQ + s) * D_SSM + g * 16 + p] = gelu_tanh(y); }
    }
}

__global__ void k_lam(const float* q1, const float* k1, const float* q2, const float* k2, float* lamv) {
    const int l = blockIdx.x, i = threadIdx.x;
    float a = q1[l * 64 + i] * k1[l * 64 + i], b = q2[l * 64 + i] * k2[l * 64 + i];
    a = wave_sum(a); b = wave_sum(b);
    const float lambda_init = 0.8f - 0.6f * expf(-0.3f * (float)l);
    if (i == 0) lamv[l] = expf(a) - expf(b) + lambda_init;
}

__global__ __launch_bounds__(256) void k_attn(const float* __restrict__ QN, const float* __restrict__ KN, const float* __restrict__ proj, float* __restrict__ MIX,
                                              const float* __restrict__ lamv, const float* __restrict__ subln_g, float one_minus_li) {
    const int chunk = blockIdx.x, h = blockIdx.y, b = blockIdx.z;
    const int tid = threadIdx.x, qi = tid >> 2, qt = tid & 3;
    __shared__ float K0s[32][64];
    __shared__ float K1s[32][64];
    __shared__ float Vs[32][128];
    const size_t trow = (size_t)b * SEQ + chunk * 64 + qi;
    float q0[64], q1[64];
#pragma unroll
    for (int d = 0; d < 64; ++d) { q0[d] = QN[trow * D_ATTN + h * 128 + d]; q1[d] = QN[trow * D_ATTN + h * 128 + 64 + d]; }
    float o0[32], o1[32];
#pragma unroll
    for (int i = 0; i < 32; ++i) { o0[i] = 0.f; o1[i] = 0.f; }
    float m0 = -INFINITY, l0 = 0.f, m1 = -INFINITY, l1 = 0.f;
    const int nkeys = (chunk + 1) * 64;
    for (int k0 = 0; k0 < nkeys; k0 += 32) {
        __syncthreads();
        for (int i = tid; i < 2048; i += 256) { const int r = i >> 6, c = i & 63; const size_t kr = (size_t)b * SEQ + k0 + r;
            K0s[r][c] = KN[kr * D_ATTN + h * 128 + c]; K1s[r][c] = KN[kr * D_ATTN + h * 128 + 64 + c]; }
        for (int i = tid; i < 4096; i += 256) { const int r = i >> 7, c = i & 127; Vs[r][c] = proj[((size_t)b * SEQ + k0 + r) * D_IN + D_SSM + 2 * D_ATTN + h * 128 + c]; }
        __syncthreads();
        for (int j = 0; j < 32; ++j) {
            float s0 = 0.f, s1 = 0.f;
#pragma unroll
            for (int d = 0; d < 64; ++d) { s0 += q0[d] * K0s[j][d]; s1 += q1[d] * K1s[j][d]; }
            s0 *= 0.125f; s1 *= 0.125f;
            if (s0 > m0) { const float a = expf(m0 - s0); l0 *= a;
#pragma unroll
                for (int i = 0; i < 32; ++i) o0[i] *= a;
                m0 = s0; }
            if (s1 > m1) { const float a = expf(m1 - s1); l1 *= a;
#pragma unroll
                for (int i = 0; i < 32; ++i) o1[i] *= a;
                m1 = s1; }
            const float p0 = expf(s0 - m0), p1 = expf(s1 - m1);
            l0 += p0; l1 += p1;
#pragma unroll
            for (int i = 0; i < 32; ++i) { const float v = Vs[j][qt * 32 + i]; o0[i] += p0 * v; o1[i] += p1 * v; }
        }
    }
    const float lam = lamv[0];
    const float r0 = 1.f / l0, r1 = lam / l1;
    float ss = 0.f;
#pragma unroll
    for (int i = 0; i < 32; ++i) { o0[i] = o0[i] * r0 - o1[i] * r1; ss += o0[i] * o0[i]; }
    ss += __shfl_xor(ss, 1); ss += __shfl_xor(ss, 2);
    const float rn = rsqrtf(ss / 128.f + EPS) * one_minus_li;
#pragma unroll
    for (int i = 0; i < 32; ++i) MIX[trow * D_MODEL + D_SSM + h * 128 + qt * 32 + i] = o0[i] * rn * subln_g[qt * 32 + i];
}

__global__ __launch_bounds__(256) void k_router(const float* __restrict__ xn, const float* __restrict__ wr, const float* __restrict__ br, float* __restrict__ logits) {
    const size_t idx = (size_t)blockIdx.x * 256 + threadIdx.x;
    const int t = (int)(idx >> 5), e = (int)(idx & 31);
    const float* x = xn + (size_t)t * D_MODEL;
    float s = 0.f;
    for (int k = 0; k < D_MODEL; ++k) s += x[k] * wr[k * NE + e];
    logits[idx] = s + br[e];
}
__global__ __launch_bounds__(256) void k_topk(const float* __restrict__ logits, int* __restrict__ cnt, int* __restrict__ topi, int* __restrict__ topp, float* __restrict__ topg) {
    const int t = blockIdx.x * 256 + threadIdx.x;
    if (t >= T) return;
    float lg[32];
#pragma unroll
    for (int e = 0; e < 32; ++e) lg[e] = logits[(size_t)t * 32 + e];
    unsigned mask = 0u; float val[4]; int sel[4];
#pragma unroll
    for (int k = 0; k < 4; ++k) {
        float best = -INFINITY; int bi = 0;
#pragma unroll
        for (int e = 0; e < 32; ++e) { const bool ok = !((mask >> e) & 1u) && (lg[e] > best); if (ok) { best = lg[e]; bi = e; } }
        mask |= 1u << bi; val[k] = best; sel[k] = bi;
    }
    float ex[4], sum = 0.f;
#pragma unroll
    for (int k = 0; k < 4; ++k) { ex[k] = expf(val[k] - val[0]); sum += ex[k]; }
#pragma unroll
    for (int k = 0; k < 4; ++k) {
        const int pos = atomicAdd(&cnt[sel[k]], 1);
        topi[t * 4 + k] = sel[k]; topp[t * 4 + k] = pos; topg[t * 4 + k] = ex[k] / sum;
    }
}
__global__ void k_offsets(const int* cnt, int* off) { if (threadIdx.x == 0) { int a = 0; for (int e = 0; e < NE; ++e) { off[e] = a; a += cnt[e]; } } }
__global__ __launch_bounds__(256) void k_scatter(const int* __restrict__ topi, const int* __restrict__ topp, const float* __restrict__ topg, const int* __restrict__ off,
                                                  int* __restrict__ rowtok, float* __restrict__ rowgate, int* __restrict__ tokrow) {
    const int i = blockIdx.x * 256 + threadIdx.x;
    if (i >= NASSIGN) return;
    const int row = off[topi[i]] + topp[i];
    rowtok[row] = i >> 2; rowgate[row] = topg[i]; tokrow[i] = row;
}
__global__ __launch_bounds__(256) void k_combine(float* __restrict__ h, const float* __restrict__ yb, const int* __restrict__ tokrow) {
    const size_t idx = (size_t)blockIdx.x * 256 + threadIdx.x;
    const int t = (int)(idx >> 10), c = (int)(idx & 1023);
    float s = h[idx];
#pragma unroll
    for (int k = 0; k < 4; ++k) s += yb[(size_t)tokrow[t * 4 + k] * D_MODEL + c];
    h[idx] = s;
}
}

extern "C" void kernel_launch(void* const* d_in, const int* in_sizes, int n_in, void* d_out, int out_size, void* d_ws, size_t ws_size, hipStream_t stream) {
    using namespace nv;
    const float* x = (const float*)d_in[0];
    const float* g_mix = (const float*)d_in[1];     const float* w_in = (const float*)d_in[2];
    const float* lam_re = (const float*)d_in[3];    const float* lam_im = (const float*)d_in[4];   const float* log_step = (const float*)d_in[5];
    const float* b_re = (const float*)d_in[6];      const float* b_im = (const float*)d_in[7];
    const float* c_re = (const float*)d_in[8];      const float* c_im = (const float*)d_in[9];
    const float* ssm_d = (const float*)d_in[10];    const float* w_glu = (const float*)d_in[11];   const float* ssm_norm_g = (const float*)d_in[12];
    const float* q_norm_g = (const float*)d_in[13]; const float* k_norm_g = (const float*)d_in[14];
    const float* lq1 = (const float*)d_in[15];      const float* lk1 = (const float*)d_in[16];
    const float* lq2 = (const float*)d_in[17];      const float* lk2 = (const float*)d_in[18];
    const float* subln_g = (const float*)d_in[19];  const float* w_out = (const float*)d_in[20];
    const float* g_ffn = (const float*)d_in[21];    const float* w_router = (const float*)d_in[22]; const float* b_router = (const float*)d_in[23];
    const float* w_up = (const float*)d_in[24];     const float* b_up = (const float*)d_in[25];
    const float* w_down = (const float*)d_in[26];   const float* b_down = (const float*)d_in[27];
    float* out = (float*)d_out;

    float* ws = (float*)d_ws; size_t o = 0;
    auto take = [&](size_t n) { float* p = ws + o; o += (n + 63) & ~(size_t)63; return p; };
    float* XN = take((size_t)T * D_MODEL);
    float* PROJ = take((size_t)T * D_IN);
    float* QN = take((size_t)T * D_ATTN);
    float* KN = take((size_t)T * D_ATTN);
    float* YS = take((size_t)T * D_SSM);
    float* ZS = take((size_t)T * D_SSM);
    float* MIX = take((size_t)T * D_MODEL);
    float* LOGITS = take((size_t)T * NE);
    float* TOPG = take((size_t)NASSIGN);
    float* ROWGATE = take((size_t)NASSIGN);
    float* LAMV = take(64);
    int* TOPI = (int*)take((size_t)NASSIGN);
    int* TOPP = (int*)take((size_t)NASSIGN);
    int* ROWTOK = (int*)take((size_t)NASSIGN);
    int* TOKROW = (int*)take((size_t)NASSIGN);
    int* CNT = (int*)take(64);
    int* OFF = (int*)take(64);
    float* ACT = take((size_t)NASSIGN * D_FF);
    float* YB = take((size_t)NASSIGN * D_MODEL);
    if (o * 4 > ws_size) return;

    hipLaunchKernelGGL(k_lam, dim3(DEPTH), dim3(64), 0, stream, lq1, lk1, lq2, lk2, LAMV);
    for (int l = 0; l < DEPTH; ++l) {
        const float* hin = (l == 0) ? x : out;
        const float lambda_init = 0.8f - 0.6f * expf(-0.3f * (float)l);
        hipLaunchKernelGGL(k_rmsnorm, dim3(T / 4), dim3(256), 0, stream, hin, g_mix + (size_t)l * D_MODEL, XN, T, D_MODEL, D_MODEL);
        { GemmP p{}; p.A = XN; p.lda = D_MODEL; p.B = w_in + (size_t)l * D_MODEL * D_IN; p.ldb = D_IN; p.C = PROJ; p.ldc = D_IN; p.M = T; p.N = D_IN; p.K = D_MODEL; p.epi = 0;
          hipLaunchKernelGGL(k_gemm, dim3(D_IN / 64, T / 64, 1), dim3(256), 0, stream, p); }
        hipLaunchKernelGGL(k_qknorm_rope, dim3(T * 16 / 256), dim3(256), 0, stream, PROJ, q_norm_g + l * 64, k_norm_g + l * 64, QN, KN);
        hipLaunchKernelGGL(k_s5, dim3(BATCH * G), dim3(64), 0, stream, PROJ, lam_re + l * G * P, lam_im + l * G * P, log_step + l * G,
                           b_re + (size_t)l * G * P * HS, b_im + (size_t)l * G * P * HS, c_re + (size_t)l * G * HS * P, c_im + (size_t)l * G * HS * P, ssm_d + l * D_SSM, YS);
        { GemmP p{}; p.A = YS; p.lda = D_SSM; p.B = w_glu + (size_t)l * D_SSM * D_SSM; p.ldb = D_SSM; p.C = ZS; p.ldc = D_SSM; p.M = T; p.N = D_SSM; p.K = D_SSM; p.epi = 1;
          hipLaunchKernelGGL(k_gemm, dim3(D_SSM / 64, T / 64, 1), dim3(256), 0, stream, p); }
        hipLaunchKernelGGL(k_rmsnorm, dim3(T / 4), dim3(256), 0, stream, ZS, ssm_norm_g + l * D_SSM, MIX, T, D_SSM, D_MODEL);
        hipLaunchKernelGGL(k_attn, dim3(SEQ / 64, NH, BATCH), dim3(256), 0, stream, QN, KN, PROJ, MIX, LAMV + l, subln_g + l * DV, 1.0f - lambda_init);
        { GemmP p{}; p.A = MIX; p.lda = D_MODEL; p.B = w_out + (size_t)l * D_MODEL * D_MODEL; p.ldb = D_MODEL; p.C = out; p.ldc = D_MODEL; p.M = T; p.N = D_MODEL; p.K = D_MODEL; p.epi = 2; p.R = hin; p.ldr = D_MODEL;
          hipLaunchKernelGGL(k_gemm, dim3(D_MODEL / 64, T / 64, 1), dim3(256), 0, stream, p); }
        hipLaunchKernelGGL(k_rmsnorm, dim3(T / 4), dim3(256), 0, stream, out, g_ffn + (size_t)l * D_MODEL, XN, T, D_MODEL, D_MODEL);
        hipLaunchKernelGGL(k_router, dim3(T * NE / 256), dim3(256), 0, stream, XN, w_router + (size_t)l * D_MODEL * NE, b_router + l * NE, LOGITS);
        hipMemsetAsync(CNT, 0, 64 * 4, stream);
        hipLaunchKernelGGL(k_topk, dim3(T / 256), dim3(256), 0, stream, LOGITS, CNT, TOPI, TOPP, TOPG);
        hipLaunchKernelGGL(k_offsets, dim3(1), dim3(64), 0, stream, CNT, OFF);
        hipLaunchKernelGGL(k_scatter, dim3(NASSIGN / 256), dim3(256), 0, stream, TOPI, TOPP, TOPG, OFF, ROWTOK, ROWGATE, TOKROW);
        { GemmP p{}; p.A = XN; p.lda = D_MODEL; p.rowidx = ROWTOK; p.B = w_up + (size_t)l * NE * D_MODEL * 2 * D_FF; p.ldb = 2 * D_FF; p.C = ACT; p.ldc = D_FF; p.M = 0; p.N = D_FF; p.K = D_MODEL; p.epi = 3;
          p.bias = b_up + (size_t)l * NE * 2 * D_FF; p.cnt = CNT; p.off = OFF; p.strideB = (long)D_MODEL * 2 * D_FF; p.strideBias = 2 * D_FF;
          hipLaunchKernelGGL(k_gemm, dim3(D_FF / 64, T / 64, NE), dim3(256), 0, stream, p); }
        { GemmP p{}; p.A = ACT; p.lda = D_FF; p.B = w_down + (size_t)l * NE * D_FF * D_MODEL; p.ldb = D_MODEL; p.C = YB; p.ldc = D_MODEL; p.M = 0; p.N = D_MODEL; p.K = D_FF; p.epi = 4;
          p.bias = b_down + (size_t)l * NE * D_MODEL; p.cnt = CNT; p.off = OFF; p.strideB = (long)D_FF * D_MODEL; p.strideBias = D_MODEL; p.gate = ROWGATE;
          hipLaunchKernelGGL(k_gemm, dim3(D_MODEL / 64, T / 64, NE), dim3(256), 0, stream, p); }
        hipLaunchKernelGGL(k_combine, dim3((size_t)T * D_MODEL / 256), dim3(256), 0, stream, out, YB, TOKROW);
    }
}
```

```cpp
#include <hip/hip_runtime.h>
#include <cstdio>
#include <cstdint>
#include <math.h>

#define LAS __attribute__((address_space(3)))
#define GAS __attribute__((address_space(1)))
typedef unsigned short bf16_t;
typedef short bf16x8 __attribute__((ext_vector_type(8)));
typedef short s16x4 __attribute__((ext_vector_type(4)));
typedef float f32x4 __attribute__((ext_vector_type(4)));
typedef float f32x2 __attribute__((ext_vector_type(2)));
typedef float f32x16 __attribute__((ext_vector_type(16)));
typedef unsigned u32x4 __attribute__((ext_vector_type(4)));
typedef unsigned u32x2 __attribute__((ext_vector_type(2)));

constexpr int D = 1024, BATCH = 4, SEQ = 8192, DEPTH = 2, T = BATCH * SEQ;
constexpr int DS = 512, NG = 32, HS = 16, NP = 64, DA = 512, NH = 4, DV = 128, DIN = 2048;
constexpr int NE = 32, DFF = 1024, NASSIGN = T * 4;
constexpr int MPAD_MAX = NASSIGN + NE * 256, NTILE_MAX = MPAD_MAX / 256;
constexpr int NCHUNK = T / 64, CPB = SEQ / 64;
constexpr float EPS = 1e-6f;
constexpr float C2 = 0.125f * 1.4426950408889634f;
constexpr int NWAVES = 8, NTHREADS = 512;

constexpr size_t MiB = 1u << 20;
constexpr size_t WS_CTL = 0, CTL_ZERO_BYTES = 1 * MiB;
constexpr size_t WS_COS = 1 * MiB, WS_SIN = 2 * MiB;
constexpr size_t WS_SCAL = 3 * MiB;
constexpr size_t WS_KT = 4 * MiB, KT_STRIDE = 2 * MiB;
constexpr size_t WS_LAML = 8 * MiB, LAML_STRIDE = 32768;
constexpr size_t WS_GT = 16 * MiB, GT_STRIDE = 8 * MiB;
constexpr size_t WS_HT = 32 * MiB, HT_STRIDE = 8 * MiB;
constexpr size_t WS_WIN = 48 * MiB, WIN_STRIDE = 4 * MiB;
constexpr size_t WS_WGLU = 56 * MiB, WGLU_STRIDE = MiB / 2;
constexpr size_t WS_WOUT = 58 * MiB, WOUT_STRIDE = 2 * MiB;
constexpr size_t WS_WUP = 64 * MiB, WUP_STRIDE = 128 * MiB;
constexpr size_t WS_WDN = 320 * MiB, WDN_STRIDE = 64 * MiB;
constexpr size_t WS_XN = 448 * MiB;
constexpr size_t WS_U = 512 * MiB, WS_Q = 544 * MiB, WS_K = 576 * MiB, WS_V = 608 * MiB;
constexpr size_t WS_YG = 640 * MiB;
constexpr size_t WS_MIX = 672 * MiB;
constexpr size_t WS_S = 736 * MiB;
constexpr size_t WS_RSP = 744 * MiB;
constexpr size_t WS_TOPI = 746 * MiB, WS_TOPG = 747 * MiB, WS_TOKROW = 748 * MiB, WS_WGCNT = 749 * MiB;
constexpr size_t WS_ROWTOK = 750 * MiB, WS_ROWGATE = 751 * MiB, WS_TILEEXP = 752 * MiB;
constexpr size_t WS_ACT = 768 * MiB, WS_YB = 1040 * MiB, WS_END = 1312 * MiB;
constexpr int CW_BAR = 4096;

constexpr int LDS_CTL = 0;
constexpr int LDS_RING = 4096;
constexpr int LDS_BYTES = 147456;

__device__ __forceinline__ unsigned f2bf(float f) { unsigned u = __builtin_bit_cast(unsigned, f); return (u + 0x7fffu + ((u >> 16) & 1u)) >> 16; }
__device__ __forceinline__ unsigned pk2(float lo, float hi) { return f2bf(lo) | (f2bf(hi) << 16); }
__device__ __forceinline__ unsigned cvt_pk_bf16(float lo, float hi) { unsigned r; asm volatile("v_cvt_pk_bf16_f32 %0, %1, %2" : "=v"(r) : "v"(lo), "v"(hi)); return r; }
__device__ __forceinline__ float bf_lo(unsigned w) { return __builtin_bit_cast(float, w << 16); }
__device__ __forceinline__ float bf_hi(unsigned w) { return __builtin_bit_cast(float, w & 0xffff0000u); }
__device__ __forceinline__ float wave_sum(float v) {
#pragma unroll
    for (int o = 1; o < 64; o <<= 1) v += __shfl_xor(v, o);
    return v;
}
__device__ __forceinline__ float gelu_tanh(float x) {
    const float z = 0.7978845608028654f * (x + 0.044715f * x * x * x);
    return x / (1.f + __expf(-2.f * z));
}
__device__ __forceinline__ float sigmoidf(float v) { return 1.f / (1.f + __expf(-v)); }

#define XB_TMO      128
#define XB_XCNT(j)  (256  + 64 * (j))
#define XB_XSUB(j)  (1280 + 64 * (j))
#define XB_XGEN(j)  (2304 + 64 * (j))
#define XB_TOP      3328
#define XB_TOPGEN   3392
#define XCD_BAR_WORDS 3456
#define XB_SPIN_CAP (1u << 18)
__device__ __forceinline__ unsigned xb_ld(unsigned* p)              { return __hip_atomic_load(p, __ATOMIC_RELAXED, __HIP_MEMORY_SCOPE_AGENT); }
__device__ __forceinline__ unsigned xb_add(unsigned* p, unsigned v) { return __hip_atomic_fetch_add(p, v, __ATOMIC_RELAXED, __HIP_MEMORY_SCOPE_AGENT); }
__device__ __forceinline__ unsigned xb_xcc_id() { return (unsigned)__builtin_amdgcn_s_getreg((3 << 11) | 20) & 0xFu; }
#define XB_SPIN(cond, bar) do { unsigned _sp = 0; while (cond) { __builtin_amdgcn_s_sleep(1); \
    if ((++_sp & 255u) == 0u) { if (xb_ld(&(bar)[XB_TMO])) break; if (_sp > XB_SPIN_CAP) { atomicAdd(&(bar)[XB_TMO], 1u); break; } } } } while (0)
struct XcdBarrier { unsigned* bar; unsigned x; volatile LAS unsigned* st; };
__device__ __forceinline__ XcdBarrier xcd_barrier_post(unsigned* bar, volatile LAS unsigned* st) {
    XcdBarrier b; b.bar = bar; b.x = xb_xcc_id(); b.st = st;
    if (threadIdx.x == 0) (void)xb_add(&bar[XB_XCNT(b.x)], 1u);
    return b;
}
__device__ __forceinline__ void xcd_barrier_complete(unsigned* bar, unsigned x, unsigned& nloc, unsigned& nx) {
    const unsigned G = gridDim.x * gridDim.y * gridDim.z;
    unsigned sum, cnt, mine, sp = 0u;
    for (;;) {
        sum = 0u; cnt = 0u; mine = 0u;
#pragma unroll
        for (unsigned j = 0; j < 16; ++j) { const unsigned c = xb_ld(&bar[XB_XCNT(j)]); sum += c; cnt += (c > 0u) ? 1u : 0u; mine = (j == x) ? c : mine; }
        if (sum == G) break;
        __builtin_amdgcn_s_sleep(1);
        if ((++sp & 255u) == 0u) { if (xb_ld(&bar[XB_TMO])) break; if (sp > XB_SPIN_CAP) { atomicAdd(&bar[XB_TMO], 1u); break; } }
    }
    nloc = mine > 0u ? mine : 1u; nx = cnt > 0u ? cnt : 1u;
}
__device__ __forceinline__ void xcd_barrier(const XcdBarrier& b) {
    asm volatile("s_waitcnt vmcnt(0)" ::: "memory");
    __syncthreads();
    if (threadIdx.x == 0) {
        unsigned* bar = b.bar;
        __builtin_amdgcn_s_waitcnt(0);
        unsigned nloc = b.st[0], nx = b.st[1];
        if (nloc == 0u) { xcd_barrier_complete(bar, b.x, nloc, nx); b.st[0] = nloc; b.st[1] = nx; }
        const unsigned old = xb_add(&bar[XB_XSUB(b.x)], 1u);
        const unsigned gen = old / nloc;
        if (old + 1u == (gen + 1u) * nloc) {
            __builtin_amdgcn_fence(__ATOMIC_RELEASE, "agent");
            asm volatile("s_waitcnt vmcnt(0)" ::: "memory");
            const unsigned og = xb_add(&bar[XB_TOP], 1u);
            const unsigned tg = og / nx;
            if (og + 1u == (tg + 1u) * nx) xb_add(&bar[XB_TOPGEN], 1u);
            else XB_SPIN(xb_ld(&bar[XB_TOPGEN]) == tg, bar);
            __builtin_amdgcn_fence(__ATOMIC_ACQUIRE, "agent");
            xb_add(&bar[XB_XGEN(b.x)], 1u);
            asm volatile("s_waitcnt vmcnt(0)" ::: "memory");
        } else {
            XB_SPIN(xb_ld(&bar[XB_XGEN(b.x)]) == gen, bar);
            __builtin_amdgcn_fence(__ATOMIC_ACQUIRE, "agent");
            asm volatile("s_waitcnt vmcnt(0)" ::: "memory");
        }
    }
    __syncthreads();
}

namespace pg8 {
constexpr int BM = 256, BK = 64, HALF = 128, HTB = HALF * BK * 2, STAGE_BYTES = 8 * HTB;
__host__ __device__ __forceinline__ int lds_byte(int r, int c) { const int st = (r >> 4) * 2 + (c >> 5), rr = r & 15, cc = c & 31, ob = rr * 64 + cc * 2; return st * 1024 + (ob ^ (((ob >> 9) & 1) << 5)); }
__host__ __device__ __forceinline__ void stage_rc(int b, int& R, int& C) { const int st = b / 1024, sb = b % 1024, swz = sb ^ (((sb >> 9) & 1) << 5); R = (st >> 1) * 16 + swz / 64; C = (st & 1) * 32 + (swz % 64) / 2; }
__host__ __device__ __forceinline__ int perm32(int rho) { const int n = rho >> 4, i = rho & 15; return 8 * (i >> 2) + 4 * n + (i & 3); }

struct Unit { int pm, pn; };
template <class P>
__device__ __forceinline__ void gemm_phase(LAS unsigned char* lds, LAS unsigned char* ldsctl, P& S, const int tid) {
    const int wid = __builtin_amdgcn_readfirstlane(tid >> 6), lane = tid & 63, wr = wid >> 2, wc = wid & 3, fr = lane & 15, fq = lane >> 4;
    constexpr int K = P::K, nt = K / BK;
    int R0, C0, R1, C1; stage_rc(tid * 16, R0, C0); stage_rc(tid * 16 + 8192, R1, C1);
    unsigned voffB[2];
    {
        const int Rb0 = P::BROW64 ? (64 * (R0 >> 5) + perm32(R0 & 31)) : ((R0 & ~31) + perm32(R0 & 31));
        const int Rb1 = P::BROW64 ? (64 * (R1 >> 5) + perm32(R1 & 31)) : ((R1 & ~31) + perm32(R1 & 31));
        voffB[0] = (unsigned)(Rb0 * K + C0) * 2u; voffB[1] = (unsigned)(Rb1 * K + C1) * 2u;
    }
    const unsigned ldsw = (unsigned)wid * 1024u;
    const int aoff = lds_byte(wr * 64 + fr, fq * 8), boff = lds_byte(wc * 32 + fr, fq * 8);
#define PG8_SA(b, h) (((b) * 2 + (h)) * HTB)
#define PG8_SB(b, h) ((4 + (b) * 2 + (h)) * HTB)
#define PG8_STAGE_A(bufoff, vo, h, kofs) do { _Pragma("unroll") for (int _i = 0; _i < 2; ++_i) \
        __builtin_amdgcn_global_load_lds((const unsigned*)(Abase + (vo)[P::GATHER ? (h) : 0][_i] + ((kofs) + (P::GATHER ? 0u : (unsigned)(h) * HSTEPA))), (LAS unsigned*)(lds + (bufoff) + ldsw + _i * 8192), 16, 0, 0); } while (0)
#define PG8_STAGE_B(bufoff, gbase) do { _Pragma("unroll") for (int _i = 0; _i < 2; ++_i) \
        __builtin_amdgcn_global_load_lds((const unsigned*)((const char*)(gbase) + voffB[_i]), (LAS unsigned*)(lds + (bufoff) + ldsw + _i * 8192), 16, 0, 0); } while (0)
#define PG8_LDA(dst, b, h) do { _Pragma("unroll") for (int m = 0; m < 4; ++m) _Pragma("unroll") for (int k = 0; k < 2; ++k) dst[m][k] = *(const LAS bf16x8*)(lds + PG8_SA(b, h) + aoff + m * 2048 + k * 1024); } while (0)
#define PG8_LDB(dst, b, h) do { _Pragma("unroll") for (int n = 0; n < 2; ++n) _Pragma("unroll") for (int k = 0; k < 2; ++k) dst[n][k] = *(const LAS bf16x8*)(lds + PG8_SB(b, h) + boff + n * 2048 + k * 1024); } while (0)
#define PG8_MMA(ai, bj, At, Bt) do { __builtin_amdgcn_s_setprio(1); _Pragma("unroll") for (int m = 0; m < 4; ++m) _Pragma("unroll") for (int n = 0; n < 2; ++n) _Pragma("unroll") for (int k = 0; k < 2; ++k) \
        acc[ai][bj][m][n] = __builtin_amdgcn_mfma_f32_16x16x32_bf16(Bt[n][k], At[m][k], acc[ai][bj][m][n], 0, 0, 0); __builtin_amdgcn_s_setprio(0); } while (0)
#define PG8_WAIT_V(n) asm volatile("s_waitcnt vmcnt(" #n ")" ::: "memory")
#define PG8_WAIT_L(n) asm volatile("s_waitcnt lgkmcnt(" #n ")" ::: "memory")
#define PG8_BAR __builtin_amdgcn_s_barrier()
#define PG8_SCHED __builtin_amdgcn_sched_barrier(0)
    Unit cur, nxt; int ui = 0;
    if (!S.next(0, cur)) return;
    f32x4 acc[2][2][4][2];
#pragma unroll
    for (int a = 0; a < 2; ++a)
#pragma unroll
        for (int b = 0; b < 2; ++b)
#pragma unroll
            for (int m = 0; m < 4; ++m)
#pragma unroll
                for (int n = 0; n < 2; ++n) acc[a][b][m][n] = (f32x4){0.f, 0.f, 0.f, 0.f};
    bf16x8 At[4][2], B0[2][2], B1[2][2];
    const char* const Abase = S.a_base();
    unsigned voffA[2][2], voffAn[2][2];
    const char *cB0, *cB1;
    S.unit_begin(cur, ldsctl, tid, 0);
    S.a_offs(cur, R0, C0, R1, C1, voffA, true);
    S.b_ptrs(cur, cB0, cB1);
    constexpr unsigned kstep = BK * 2, HSTEPA = (unsigned)HALF * K * 2u;
    PG8_STAGE_B(PG8_SB(0, 0), cB0); PG8_STAGE_B(PG8_SB(0, 1), cB1); PG8_STAGE_A(PG8_SA(0, 0), voffA, 0, 0u); PG8_STAGE_A(PG8_SA(0, 1), voffA, 1, 0u);
    if (wr == 1) PG8_BAR;
    PG8_WAIT_V(2); PG8_BAR;
    PG8_STAGE_B(PG8_SB(1, 0), cB0 + kstep); PG8_STAGE_A(PG8_SA(1, 0), voffA, 0, kstep); PG8_STAGE_B(PG8_SB(1, 1), cB1 + kstep);
    PG8_WAIT_V(6); PG8_BAR;
    for (;;) {
        const bool has_next = S.next(ui + 1, nxt);
        const char *nB0 = cB0, *nB1 = cB1;
#pragma unroll
        for (int h = 0; h < 2; ++h)
#pragma unroll
            for (int i = 0; i < 2; ++i) voffAn[h][i] = voffA[h][i];
        if (has_next) { S.unit_begin(nxt, ldsctl, tid, (ui + 1) & 1); S.a_offs(nxt, R0, C0, R1, C1, voffAn, false); S.b_ptrs(nxt, nB0, nB1); }
        for (int t = 0; t < nt; t += 2) {
            const bool last = (t == nt - 2);
            S.midk(acc, cur, t, wr, fr, ldsctl, ui & 1);
            if (last) S.a_fix(voffAn);
            unsigned a2o[2][2];
#pragma unroll
            for (int h = 0; h < 2; ++h)
#pragma unroll
                for (int i = 0; i < 2; ++i) a2o[h][i] = last ? voffAn[h][i] : voffA[h][i] + (unsigned)(t + 2) * kstep;
            const char* b2h0 = last ? nB0 : cB0 + (size_t)(t + 2) * kstep; const char* b2h1 = last ? nB1 : cB1 + (size_t)(t + 2) * kstep;
            const unsigned a1k = (unsigned)(t + 1) * kstep;
            PG8_LDB(B0, 0, 0); PG8_LDB(B1, 0, 1); PG8_SCHED; PG8_LDA(At, 0, 0); PG8_STAGE_A(PG8_SA(1, 1), voffA, 1, a1k);
            PG8_WAIT_V(8); PG8_WAIT_L(0); PG8_BAR; PG8_MMA(0, 0, At, B0); PG8_MMA(0, 1, At, B1); PG8_BAR; PG8_SCHED;
            PG8_LDA(At, 0, 1); PG8_STAGE_B(PG8_SB(0, 0), b2h0); PG8_STAGE_B(PG8_SB(0, 1), b2h1); PG8_STAGE_A(PG8_SA(0, 0), a2o, 0, 0u);
            PG8_WAIT_V(8); PG8_WAIT_L(0); PG8_BAR; PG8_MMA(1, 0, At, B0); PG8_MMA(1, 1, At, B1); PG8_BAR; PG8_SCHED;
            PG8_LDB(B0, 1, 0); PG8_LDB(B1, 1, 1); PG8_SCHED; PG8_LDA(At, 1, 0); PG8_STAGE_A(PG8_SA(0, 1), a2o, 1, 0u);
            PG8_WAIT_V(8); PG8_WAIT_L(0); PG8_BAR; PG8_MMA(0, 0, At, B0); PG8_MMA(0, 1, At, B1); PG8_BAR; PG8_SCHED;
            PG8_LDA(At, 1, 1); PG8_STAGE_B(PG8_SB(1, 0), b2h0 + kstep); PG8_STAGE_B(PG8_SB(1, 1), b2h1 + kstep); PG8_STAGE_A(PG8_SA(1, 0), a2o, 0, kstep);
            PG8_WAIT_V(8); PG8_WAIT_L(0); PG8_BAR; PG8_MMA(1, 0, At, B0); PG8_MMA(1, 1, At, B1); PG8_BAR; PG8_SCHED;
        }
        if (wr == 0) PG8_BAR;
        S.epi(acc, cur, wr, wc, fr, fq);
        if (!has_next) break;
#pragma unroll
        for (int a = 0; a < 2; ++a)
#pragma unroll
            for (int b = 0; b < 2; ++b)
#pragma unroll
                for (int m = 0; m < 4; ++m)
#pragma unroll
                    for (int n = 0; n < 2; ++n) acc[a][b][m][n] = (f32x4){0.f, 0.f, 0.f, 0.f};
        cur = nxt; cB0 = nB0; cB1 = nB1; ++ui;
#pragma unroll
        for (int h = 0; h < 2; ++h)
#pragma unroll
            for (int i = 0; i < 2; ++i) voffA[h][i] = voffAn[h][i];
        if (wr == 1) PG8_BAR;
    }
    PG8_WAIT_V(0);
    PG8_BAR;
#undef PG8_SA
#undef PG8_SB
#undef PG8_STAGE_A
#undef PG8_STAGE_B
#undef PG8_LDA
#undef PG8_LDB
#undef PG8_MMA
#undef PG8_WAIT_V
#undef PG8_WAIT_L
#undef PG8_BAR
#undef PG8_SCHED
}
struct StaticOrder {
    int nM, nN, nwg, G, c;
    __device__ void init(int M, int N, int G_, int c_) { nM = M / BM; nN = N / BM; nwg = nM * nN; G = G_; c = c_; }
    __device__ bool next(int i, Unit& u) const {
        const long L = (long)i * G + c; if (L >= nwg) return false;
        int wgid = (int)L; { const int q = nwg / 8, r = nwg % 8, xcd = wgid % 8, off = wgid / 8; wgid = (xcd < r ? xcd * (q + 1) : r * (q + 1) + (xcd - r) * q) + off; }
        const int nig = 8 * nN, gid = wgid / nig, fm = gid * 8, gsz = (nM - fm) < 8 ? (nM - fm) : 8;
        u.pm = fm + ((wgid % nig) % gsz); u.pn = (wgid % nig) / gsz; return true;
    }
};
}

struct Frame {
    LAS unsigned char* lds; LAS unsigned char* ctl;
    unsigned char* ws;
    int tid, lane, wave, G, bx;
    float* out; const struct Args* ap; unsigned char* ws0; float* out0; size_t z;
};

struct Args { const float* in[28]; float* out; unsigned char* ws; int ph_lo, ph_hi; };
#define arg_in(i) (F.ap->in[i] + F.z)
__device__ __forceinline__ void phase_begin(Frame& F) {
    int t = F.tid; asm volatile("" : "+v"(t)); F.tid = t; F.lane = t & 63; F.wave = __builtin_amdgcn_readfirstlane(t >> 6);
    size_t z = 0; asm volatile("" : "+s"(z)); F.z = z; F.ws = F.ws0 + z; F.out = F.out0 + z;
    int bx = F.bx; asm volatile("" : "+s"(bx)); F.bx = bx;
}
struct PBase {
    static constexpr bool GATHER = false;
    __device__ __forceinline__ void unit_begin(const pg8::Unit&, LAS unsigned char*, int, int) {}
    __device__ __forceinline__ void midk(f32x4 (&)[2][2][4][2], const pg8::Unit&, int, int, int, LAS unsigned char*, int) {}
    __device__ __forceinline__ void a_fix(unsigned (&)[2][2]) {}
};
struct PInProj : PBase {
    static constexpr int K = 1024, BROW64 = 1;
    pg8::StaticOrder so; const char* A; const char* B; bf16_t* UQKV; const float *GQK, *COS, *SIN;
    __device__ __forceinline__ bool next(int i, pg8::Unit& u) const { return so.next(i, u); }
    __device__ __forceinline__ const char* a_base() const { return A; }
    __device__ __forceinline__ void a_offs(const pg8::Unit& u, int R0, int C0, int R1, int C1, unsigned (&vo)[2][2], bool) const {
#pragma unroll
        for (int h = 0; h < 2; ++h) { vo[h][0] = (unsigned)((u.pm * 256 + 128 * h + R0) * K + C0) * 2u; vo[h][1] = (unsigned)((u.pm * 256 + 128 * h + R1) * K + C1) * 2u; }
    }
    __device__ __forceinline__ void b_ptrs(const pg8::Unit& u, const char*& b0, const char*& b1) const { b0 = B + (size_t)u.pn * 256 * K * 2; b1 = b0 + (size_t)32 * K * 2; }
    __device__ __forceinline__ void epi(f32x4 (&acc)[2][2][4][2], const pg8::Unit& u, int wr, int wc, int fr, int fq) const {
        const int kind = u.pn >> 1;
        const int colg = (u.pn & 1) * 256 + 64 * wc;
        bf16_t* dst = UQKV + (size_t)kind * (size_t)(16u << 20);
        const int row0 = u.pm * 256 + wr * 64 + fr;
        if (kind == 0 || kind == 3) {
#pragma unroll
            for (int ai = 0; ai < 2; ++ai)
#pragma unroll
                for (int m = 0; m < 4; ++m) { bf16_t* rowp = dst + (size_t)(row0 + ai * 128 + m * 16) * 512 + colg + 8 * fq;
#pragma unroll
                    for (int bj = 0; bj < 2; ++bj) { const f32x4 v0 = acc[ai][bj][m][0], v1 = acc[ai][bj][m][1];
                        u32x4 w; w.x = cvt_pk_bf16(v0[0], v0[1]); w.y = cvt_pk_bf16(v0[2], v0[3]); w.z = cvt_pk_bf16(v1[0], v1[1]); w.w = cvt_pk_bf16(v1[2], v1[3]);
                        *(u32x4*)(rowp + 32 * bj) = w; } }
        } else {
            const float* g = GQK + (kind - 1) * 64; const float sc = kind == 1 ? C2 : 1.0f;
            f32x4 g0[2], g1[2];
#pragma unroll
            for (int n = 0; n < 2; ++n) { g0[n] = *(const f32x4*)(g + 8 * fq + 4 * n); g1[n] = *(const f32x4*)(g + 32 + 8 * fq + 4 * n); }
#pragma unroll
            for (int ai = 0; ai < 2; ++ai)
#pragma unroll
                for (int m = 0; m < 4; ++m) {
                    const int row = row0 + ai * 128 + m * 16; const int pos = row & (SEQ - 1);
                    float ss = 0.f;
#pragma unroll
                    for (int bj = 0; bj < 2; ++bj)
#pragma unroll
                        for (int n = 0; n < 2; ++n) { const f32x4 x = acc[ai][bj][m][n]; ss += (x[0] * x[0] + x[1] * x[1]) + (x[2] * x[2] + x[3] * x[3]); }
                    ss += __shfl_xor(ss, 16); ss += __shfl_xor(ss, 32);
                    const float r = rsqrtf(ss * (1.f / 64.f) + EPS) * sc;
                    f32x4 o1[2], o2[2];
#pragma unroll
                    for (int n = 0; n < 2; ++n) {
                        const f32x4 c = *(const f32x4*)(COS + (size_t)pos * 32 + 8 * fq + 4 * n), s = *(const f32x4*)(SIN + (size_t)pos * 32 + 8 * fq + 4 * n);
                        const f32x4 x1 = acc[ai][0][m][n] * g0[n] * r, x2 = acc[ai][1][m][n] * g1[n] * r;
                        o1[n] = x1 * c - x2 * s; o2[n] = x2 * c + x1 * s;
                    }
                    bf16_t* rowp = dst + (size_t)row * 512 + colg + 8 * fq;
                    u32x4 w; w.x = cvt_pk_bf16(o1[0][0], o1[0][1]); w.y = cvt_pk_bf16(o1[0][2], o1[0][3]); w.z = cvt_pk_bf16(o1[1][0], o1[1][1]); w.w = cvt_pk_bf16(o1[1][2], o1[1][3]);
                    *(u32x4*)(rowp) = w;
                    w.x = cvt_pk_bf16(o2[0][0], o2[0][1]); w.y = cvt_pk_bf16(o2[0][2], o2[0][3]); w.z = cvt_pk_bf16(o2[1][0], o2[1][1]); w.w = cvt_pk_bf16(o2[1][2], o2[1][3]);
                    *(u32x4*)(rowp + 32) = w;
                    asm volatile("" ::: "memory");
                }
        }
    }
};
struct PGlu : PBase {
    static constexpr int K = 512, BROW64 = 0;
    pg8::StaticOrder so; const char* A; const char* B; const bf16_t* YG; bf16_t* MIX; float* RSP;
    __device__ __forceinline__ bool next(int i, pg8::Unit& u) const { return so.next(i, u); }
    __device__ __forceinline__ const char* a_base() const { return A; }
    __device__ __forceinline__ void a_offs(const pg8::Unit& u, int R0, int C0, int R1, int C1, unsigned (&vo)[2][2], bool) const {
#pragma unroll
        for (int h = 0; h < 2; ++h) { vo[h][0] = (unsigned)((u.pm * 256 + 128 * h + R0) * K + C0) * 2u; vo[h][1] = (unsigned)((u.pm * 256 + 128 * h + R1) * K + C1) * 2u; }
    }
    __device__ __forceinline__ void b_ptrs(const pg8::Unit& u, const char*& b0, const char*& b1) const { b0 = B + (size_t)u.pn * 256 * K * 2; b1 = b0 + (size_t)128 * K * 2; }
    __device__ __forceinline__ void epi(f32x4 (&acc)[2][2][4][2], const pg8::Unit& u, int wr, int wc, int fr, int fq) const {
        const int row0 = u.pm * 256 + wr * 64 + fr, col0 = u.pn * 256 + wc * 32 + 8 * fq;
#pragma unroll
        for (int ai = 0; ai < 2; ++ai)
#pragma unroll
            for (int m = 0; m < 4; ++m) {
                const int row = row0 + ai * 128 + m * 16; float ss = 0.f;
#pragma unroll
                for (int bj = 0; bj < 2; ++bj) {
                    const u32x4 yw = *(const u32x4*)(YG + (size_t)row * 512 + col0 + 128 * bj);
                    const f32x4 a0 = acc[ai][bj][m][0], a1 = acc[ai][bj][m][1];
                    float z[8];
                    z[0] = bf_lo(yw.x) * sigmoidf(a0[0]); z[1] = bf_hi(yw.x) * sigmoidf(a0[1]); z[2] = bf_lo(yw.y) * sigmoidf(a0[2]); z[3] = bf_hi(yw.y) * sigmoidf(a0[3]);
                    z[4] = bf_lo(yw.z) * sigmoidf(a1[0]); z[5] = bf_hi(yw.z) * sigmoidf(a1[1]); z[6] = bf_lo(yw.w) * sigmoidf(a1[2]); z[7] = bf_hi(yw.w) * sigmoidf(a1[3]);
#pragma unroll
                    for (int i = 0; i < 8; ++i) ss += z[i] * z[i];
                    u32x4 w; w.x = cvt_pk_bf16(z[0], z[1]); w.y = cvt_pk_bf16(z[2], z[3]); w.z = cvt_pk_bf16(z[4], z[5]); w.w = cvt_pk_bf16(z[6], z[7]);
                    *(u32x4*)(MIX + (size_t)row * 1024 + col0 + 128 * bj) = w;
                }
                ss += __shfl_xor(ss, 16); ss += __shfl_xor(ss, 32);
                if (fq == 0) RSP[(size_t)row * 8 + u.pn * 4 + wc] = ss;
            }
    }
};
struct POut : PBase {
    static constexpr int K = 1024, BROW64 = 0;
    pg8::StaticOrder so; const char* A; const char* B; const float* RSP; const float* base; float* out;
    __device__ __forceinline__ bool next(int i, pg8::Unit& u) const { return so.next(i, u); }
    __device__ __forceinline__ const char* a_base() const { return A; }
    __device__ __forceinline__ void a_offs(const pg8::Unit& u, int R0, int C0, int R1, int C1, unsigned (&vo)[2][2], bool) const {
#pragma unroll
        for (int h = 0; h < 2; ++h) { vo[h][0] = (unsigned)((u.pm * 256 + 128 * h + R0) * K + C0) * 2u; vo[h][1] = (unsigned)((u.pm * 256 + 128 * h + R1) * K + C1) * 2u; }
    }
    __device__ __forceinline__ void b_ptrs(const pg8::Unit& u, const char*& b0, const char*& b1) const { b0 = B + (size_t)u.pn * 256 * K * 2; b1 = b0 + (size_t)128 * K * 2; }
    __device__ __forceinline__ void unit_begin(const pg8::Unit& u, LAS unsigned char* ldsctl, int tid, int slot) const {
        if (tid < 256) {
            const f32x4 p0 = *(const f32x4*)(RSP + (size_t)(u.pm * 256 + tid) * 8), p1 = *(const f32x4*)(RSP + (size_t)(u.pm * 256 + tid) * 8 + 4);
            const float ss = ((p0[0] + p0[1]) + (p0[2] + p0[3])) + ((p1[0] + p1[1]) + (p1[2] + p1[3]));
            ((LAS float*)(ldsctl + 1024 + slot * 1024))[tid] = rsqrtf(ss * (1.f / 512.f) + EPS);
        }
    }
    __device__ __forceinline__ void midk(f32x4 (&acc)[2][2][4][2], const pg8::Unit& u, int t, int wr, int fr, LAS unsigned char* ldsctl, int slot) const {
        if (t == 8) {
            const LAS float* rs = (const LAS float*)(ldsctl + 1024 + slot * 1024);
#pragma unroll
            for (int ai = 0; ai < 2; ++ai)
#pragma unroll
                for (int m = 0; m < 4; ++m) { const float r = rs[ai * 128 + wr * 64 + m * 16 + fr];
#pragma unroll
                    for (int bj = 0; bj < 2; ++bj)
#pragma unroll
                        for (int n = 0; n < 2; ++n) acc[ai][bj][m][n] *= r; }
        }
    }
    __device__ __forceinline__ void epi(f32x4 (&acc)[2][2][4][2], const pg8::Unit& u, int wr, int wc, int fr, int fq) const {
        const int row0 = u.pm * 256 + wr * 64 + fr, col0 = u.pn * 256 + wc * 32 + 8 * fq;
#pragma unroll
        for (int ai = 0; ai < 2; ++ai)
#pragma unroll
            for (int m = 0; m < 4; ++m) { const size_t off = (size_t)(row0 + ai * 128 + m * 16) * 1024 + col0;
#pragma unroll
                for (int bj = 0; bj < 2; ++bj)
#pragma unroll
                    for (int n = 0; n < 2; ++n) { const f32x4 bs = *(const f32x4*)(base + off + bj * 128 + 4 * n); *(f32x4*)(out + off + bj * 128 + 4 * n) = bs + acc[ai][bj][m][n]; }
                if (m & 1) asm volatile("" ::: "memory"); }
    }
};
template <int NN> struct MoeOrder {
    int G, c, ntiles;
    __device__ __forceinline__ bool next(int i, pg8::Unit& u) const { const int L = i * G + c; u.pm = L / NN; u.pn = L % NN; return u.pm < ntiles; }
};
struct PUp : PBase {
    static constexpr int K = 1024, BROW64 = 0; static constexpr bool GATHER = true;
    MoeOrder<8> mo; const char* A; const char* B; const int* ROWTOK; const int* TILEEXP; const float* bup; bf16_t* ACT;
    int idx[2][2]; int c0, c1;
    __device__ __forceinline__ bool next(int i, pg8::Unit& u) const { return mo.next(i, u); }
    __device__ __forceinline__ const char* a_base() const { return A; }
    __device__ __forceinline__ void a_offs(const pg8::Unit& u, int R0, int C0, int R1, int C1, unsigned (&vo)[2][2], bool first) {
        c0 = C0; c1 = C1;
        const int* rp = ROWTOK + u.pm * 256;
#pragma unroll
        for (int h = 0; h < 2; ++h) {
            asm volatile("global_load_dword %0, %1, off" : "=v"(idx[h][0]) : "v"(rp + 128 * h + R0) : "memory");
            asm volatile("global_load_dword %0, %1, off" : "=v"(idx[h][1]) : "v"(rp + 128 * h + R1) : "memory");
        }
        asm volatile("s_waitcnt vmcnt(0)" : "+v"(idx[0][0]), "+v"(idx[0][1]), "+v"(idx[1][0]), "+v"(idx[1][1]) :: "memory");
#pragma unroll
        for (int h = 0; h < 2; ++h) { vo[h][0] = (unsigned)(idx[h][0] * K + c0) * 2u; vo[h][1] = (unsigned)(idx[h][1] * K + c1) * 2u; }
    }
    __device__ __forceinline__ void b_ptrs(const pg8::Unit& u, const char*& b0, const char*& b1) const {
        const int e = TILEEXP[u.pm]; b0 = B + ((size_t)e * 2048 + (size_t)u.pn * 128) * K * 2; b1 = b0 + (size_t)1024 * K * 2; }
    __device__ __forceinline__ void epi(f32x4 (&acc)[2][2][4][2], const pg8::Unit& u, int wr, int wc, int fr, int fq) const {
        const int e = TILEEXP[u.pm];
        const int row0 = u.pm * 256 + wr * 64 + fr, col0 = u.pn * 128 + wc * 32 + 8 * fq;
        const float* bg = bup + (size_t)e * 2048 + col0; const float* bl = bg + 1024;
        f32x4 bgv[2], blv[2];
#pragma unroll
        for (int n = 0; n < 2; ++n) { bgv[n] = *(const f32x4*)(bg + 4 * n); blv[n] = *(const f32x4*)(bl + 4 * n); }
#pragma unroll
        for (int ai = 0; ai < 2; ++ai)
#pragma unroll
            for (int m = 0; m < 4; ++m) {
                float a[8];
#pragma unroll
                for (int n = 0; n < 2; ++n)
#pragma unroll
                    for (int j = 0; j < 4; ++j) {
                        float glu = acc[ai][0][m][n][j] + bgv[n][j], lin = acc[ai][1][m][n][j] + blv[n][j];
                        glu = fminf(glu, 7.0f); lin = fminf(fmaxf(lin, -7.0f), 7.0f);
                        a[4 * n + j] = glu * sigmoidf(1.702f * glu) * (lin + 1.0f);
                    }
                u32x4 w; w.x = cvt_pk_bf16(a[0], a[1]); w.y = cvt_pk_bf16(a[2], a[3]); w.z = cvt_pk_bf16(a[4], a[5]); w.w = cvt_pk_bf16(a[6], a[7]);
                *(u32x4*)(ACT + (size_t)(row0 + ai * 128 + m * 16) * 1024 + col0) = w;
            }
    }
};
struct PDown : PBase {
    static constexpr int K = 1024, BROW64 = 0;
    MoeOrder<4> mo; const char* A; const char* B; const int* TILEEXP; const float* bdn; const float* ROWGATE; bf16_t* YB;
    __device__ __forceinline__ bool next(int i, pg8::Unit& u) const { return mo.next(i, u); }
    __device__ __forceinline__ const char* a_base() const { return A; }
    __device__ __forceinline__ void a_offs(const pg8::Unit& u, int R0, int C0, int R1, int C1, unsigned (&vo)[2][2], bool) const {
#pragma unroll
        for (int h = 0; h < 2; ++h) { vo[h][0] = (unsigned)((u.pm * 256 + 128 * h + R0) * K + C0) * 2u; vo[h][1] = (unsigned)((u.pm * 256 + 128 * h + R1) * K + C1) * 2u; }
    }
    __device__ __forceinline__ void b_ptrs(const pg8::Unit& u, const char*& b0, const char*& b1) const {
        const int e = TILEEXP[u.pm]; b0 = B + ((size_t)e * 1024 + (size_t)u.pn * 256) * K * 2; b1 = b0 + (size_t)128 * K * 2; }
    __device__ __forceinline__ void epi(f32x4 (&acc)[2][2][4][2], const pg8::Unit& u, int wr, int wc, int fr, int fq) const {
        const int e = TILEEXP[u.pm];
        const int row0 = u.pm * 256 + wr * 64 + fr, col0 = u.pn * 256 + wc * 32 + 8 * fq;
        f32x4 bv[2][2];
#pragma unroll
        for (int bj = 0; bj < 2; ++bj)
#pragma unroll
            for (int n = 0; n < 2; ++n) bv[bj][n] = *(const f32x4*)(bdn + (size_t)e * 1024 + col0 + 128 * bj + 4 * n);
#pragma unroll
        for (int ai = 0; ai < 2; ++ai)
#pragma unroll
            for (int m = 0; m < 4; ++m) { const int row = row0 + ai * 128 + m * 16; const float gt = ROWGATE[row];
#pragma unroll
                for (int bj = 0; bj < 2; ++bj) { const f32x4 v0 = (acc[ai][bj][m][0] + bv[bj][0]) * gt, v1 = (acc[ai][bj][m][1] + bv[bj][1]) * gt;
                    u32x4 w; w.x = cvt_pk_bf16(v0[0], v0[1]); w.y = cvt_pk_bf16(v0[2], v0[3]); w.z = cvt_pk_bf16(v1[0], v1[1]); w.w = cvt_pk_bf16(v1[2], v1[3]);
                    *(u32x4*)(YB + (size_t)row * 1024 + col0 + 128 * bj) = w; } }
    }
};

__device__ __forceinline__ void transpose_item(const float* W, int K, int N, bf16_t* WT, const float* kscale, int nscale, LAS float* scr, int item, int lane) {
    const int nblk = N / 64, kb = item / nblk, nb = item % nblk, k0 = 64 * kb, n0 = 64 * nb;
#pragma unroll 8
    for (int kk = 0; kk < 64; ++kk) { float v = W[(size_t)(k0 + kk) * N + n0 + lane]; if (kscale && (k0 + kk) < nscale) v *= kscale[k0 + kk]; scr[kk * 65 + lane] = v; }
    asm volatile("s_waitcnt lgkmcnt(0)" ::: "memory");
    const int c = lane & 7;
#pragma unroll
    for (int j = 0; j < 8; ++j) { const int n = (lane >> 3) + 8 * j; const LAS float* s = scr + (8 * c) * 65 + n;
        u32x4 o; o.x = pk2(s[0 * 65], s[1 * 65]); o.y = pk2(s[2 * 65], s[3 * 65]); o.z = pk2(s[4 * 65], s[5 * 65]); o.w = pk2(s[6 * 65], s[7 * 65]);
        *(u32x4*)(WT + (size_t)(n0 + n) * K + k0 + 8 * c) = o; }
    asm volatile("s_waitcnt lgkmcnt(0)" ::: "memory");
}
__device__ __forceinline__ void rms_row_to_bf16(const f32x4 (&v)[4], const float* g, bf16_t* orow, int lane) {
    float s = 0.f;
#pragma unroll
    for (int j = 0; j < 4; ++j) s += (v[j][0] * v[j][0] + v[j][1] * v[j][1]) + (v[j][2] * v[j][2] + v[j][3] * v[j][3]);
    const float r = rsqrtf(wave_sum(s) * (1.f / D) + EPS);
#pragma unroll
    for (int j = 0; j < 4; ++j) { const f32x4 gg = *(const f32x4*)(g + 4 * lane + 256 * j); const f32x4 o = v[j] * gg * r;
        u32x2 w; w.x = cvt_pk_bf16(o[0], o[1]); w.y = cvt_pk_bf16(o[2], o[3]); *(u32x2*)(orow + 4 * lane + 256 * j) = w; }
}
struct Cplx { float re, im; };
__device__ __forceinline__ Cplx cmul(Cplx a, Cplx b) { return Cplx{a.re * b.re - a.im * b.im, a.re * b.im + a.im * b.re}; }
__device__ __forceinline__ Cplx lam_pow(float lr, float li, float step, int n) {
    const float mag = expf((float)n * lr * step); const double ang = (double)n * (double)li * (double)step;
    return Cplx{mag * (float)cos(ang), mag * (float)sin(ang)};
}
__device__ __forceinline__ Cplx bbar_factor(float lr, float li, float step) {
    const Cplx lb = lam_pow(lr, li, step, 1); const float nr = lb.re - 1.f, ni = lb.im, den = lr * lr + li * li;
    return Cplx{(nr * lr + ni * li) / den, (ni * lr - nr * li) / den};
}
__device__ __forceinline__ void p0_prologue(Frame& F) {
    const int gw = F.bx * NWAVES + F.wave, NGW = F.G * NWAVES, lane = F.lane;
    const int gt = F.bx * NTHREADS + F.tid, NGT = F.G * NTHREADS;
    unsigned char* ws = F.ws;
    {
        LAS float* scr = (LAS float*)(F.lds + LDS_RING) + F.wave * (64 * 65);
        constexpr int I_UP = 32 * 16 * 32, I_DN = 32 * 16 * 16, I_IN = 16 * 32, I_OUT = 16 * 16, I_GLU = 8 * 8;
        constexpr int PER_L = I_UP + I_DN + I_IN + I_OUT + I_GLU;
        for (int it = gw; it < DEPTH * PER_L; it += NGW) {
            const int l = it / PER_L; int r = it % PER_L;
            if (r < I_UP) { const int e = r / 512, q = r % 512;
                transpose_item(arg_in(24) + ((size_t)l * NE + e) * 1024 * 2048, 1024, 2048, (bf16_t*)(ws + WS_WUP + l * WUP_STRIDE) + (size_t)e * 2048 * 1024, nullptr, 0, scr, q, lane); continue; }
            r -= I_UP;
            if (r < I_DN) { const int e = r / 256, q = r % 256;
                transpose_item(arg_in(26) + ((size_t)l * NE + e) * 1024 * 1024, 1024, 1024, (bf16_t*)(ws + WS_WDN + l * WDN_STRIDE) + (size_t)e * 1024 * 1024, nullptr, 0, scr, q, lane); continue; }
            r -= I_DN;
            if (r < I_IN) { transpose_item(arg_in(2) + (size_t)l * 1024 * 2048, 1024, 2048, (bf16_t*)(ws + WS_WIN + l * WIN_STRIDE), nullptr, 0, scr, r, lane); continue; }
            r -= I_IN;
            if (r < I_OUT) { transpose_item(arg_in(20) + (size_t)l * 1024 * 1024, 1024, 1024, (bf16_t*)(ws + WS_WOUT + l * WOUT_STRIDE), arg_in(12) + l * DS, DS, scr, r, lane); continue; }
            r -= I_OUT;
            transpose_item(arg_in(11) + (size_t)l * 512 * 512, 512, 512, (bf16_t*)(ws + WS_WGLU + l * WGLU_STRIDE), nullptr, 0, scr, r, lane);
        }
    }
    for (int i = gt; i < SEQ * 32; i += NGT) {
        const int s = i >> 5, j = i & 31;
        const float inv = 1.0f / powf(10000.0f, (float)(2 * j) / 64.0f);
        const float ang = (float)s * inv;
        ((float*)(ws + WS_COS))[i] = (float)cos((double)ang); ((float*)(ws + WS_SIN))[i] = (float)sin((double)ang);
    }
    if (F.bx == 0 && F.wave < DEPTH) {
        const int l = F.wave;
        float a = arg_in(15)[l * 64 + lane] * arg_in(16)[l * 64 + lane], b = arg_in(17)[l * 64 + lane] * arg_in(18)[l * 64 + lane];
        a = wave_sum(a); b = wave_sum(b);
        float mq = fabsf(arg_in(13)[l * 64 + lane]), mk = fabsf(arg_in(14)[l * 64 + lane]);
#pragma unroll
        for (int o = 1; o < 64; o <<= 1) { mq = fmaxf(mq, __shfl_xor(mq, o)); mk = fmaxf(mk, __shfl_xor(mk, o)); }
        const float lambda_init = 0.8f - 0.6f * expf(-0.3f * (float)l);
        { float* gqk = (float*)(ws + WS_SCAL) + 64 + l * 128; gqk[lane] = arg_in(13)[l * 64 + lane]; gqk[64 + lane] = arg_in(14)[l * 64 + lane]; }
        if (lane == 0) { float* sc = (float*)(ws + WS_SCAL) + l * 4; sc[0] = expf(a) - expf(b) + lambda_init; sc[1] = C2 * 64.f * mq * mk * 1.02f + 0.5f; sc[2] = 1.0f - lambda_init; }
    }
    for (int l = 0; l < DEPTH; ++l) {
        const float* lam_re = arg_in(3) + l * NG * NP; const float* lam_im = arg_in(4) + l * NG * NP; const float* log_step = arg_in(5) + l * NG;
        const float* b_re = arg_in(6) + (size_t)l * NG * NP * HS; const float* b_im = arg_in(7) + (size_t)l * NG * NP * HS;
        const float* c_re = arg_in(8) + (size_t)l * NG * HS * NP; const float* c_im = arg_in(9) + (size_t)l * NG * HS * NP;
        bf16_t* KT = (bf16_t*)(ws + WS_KT + l * KT_STRIDE); bf16_t* GT = (bf16_t*)(ws + WS_GT + l * GT_STRIDE); bf16_t* HT = (bf16_t*)(ws + WS_HT + l * HT_STRIDE);
        float* LAML = (float*)(ws + WS_LAML + l * LAML_STRIDE);
        for (int i = gt; i < NG * 65 * HS * 4; i += NGT) {
            const int pq = i & 3, h = (i >> 2) % HS, slot = (i / (4 * HS)) % 65, g = i / (4 * HS * 65);
            float accv[16];
#pragma unroll
            for (int q = 0; q < 16; ++q) accv[q] = 0.f;
            if (slot > 0) {
                const float step = expf(log_step[g]);
                for (int pp = 0; pp < 16; ++pp) {
                    const int p = pq * 16 + pp;
                    const float lr = lam_re[g * NP + p], li = lam_im[g * NP + p];
                    const Cplx pw = lam_pow(lr, li, step, slot - 1), f = bbar_factor(lr, li, step);
                    const Cplx w = cmul(cmul(Cplx{c_re[(size_t)(g * HS + h) * NP + p], c_im[(size_t)(g * HS + h) * NP + p]}, pw), f);
#pragma unroll
                    for (int q = 0; q < 16; ++q) { const float br = b_re[(size_t)(g * NP + p) * HS + q], bi = b_im[(size_t)(g * NP + p) * HS + q]; accv[q] += w.re * br - w.im * bi; }
                }
            }
#pragma unroll
            for (int q = 0; q < 16; ++q) { accv[q] += __shfl_xor(accv[q], 1); accv[q] += __shfl_xor(accv[q], 2); }
            if (pq == 0) {
                u32x4 o0, o1; o0.x = pk2(accv[0], accv[1]); o0.y = pk2(accv[2], accv[3]); o0.z = pk2(accv[4], accv[5]); o0.w = pk2(accv[6], accv[7]);
                o1.x = pk2(accv[8], accv[9]); o1.y = pk2(accv[10], accv[11]); o1.z = pk2(accv[12], accv[13]); o1.w = pk2(accv[14], accv[15]);
                u32x4* dst = (u32x4*)(KT + ((size_t)(g * 65 + slot) * HS + h) * 16); dst[0] = o0; dst[1] = o1;
            }
        }
        for (int i = gt; i < NG * NP * 64; i += NGT) {
            const int s = i % 64, p = (i / 64) % NP, g = i / (64 * NP);
            const float step = expf(log_step[g]); const float lr = lam_re[g * NP + p], li = lam_im[g * NP + p];
            const Cplx w = cmul(lam_pow(lr, li, step, 63 - s), bbar_factor(lr, li, step));
            float vr[16], vi[16];
#pragma unroll
            for (int q = 0; q < 16; ++q) { const float br = b_re[(size_t)(g * NP + p) * HS + q], bi = b_im[(size_t)(g * NP + p) * HS + q]; vr[q] = w.re * br - w.im * bi; vi[q] = w.re * bi + w.im * br; }
            u32x4* dr = (u32x4*)(GT + ((size_t)(g * 128 + 2 * p) * 1024 + s * 16)); u32x4* di = (u32x4*)(GT + ((size_t)(g * 128 + 2 * p + 1) * 1024 + s * 16));
            u32x4 o; o.x = pk2(vr[0], vr[1]); o.y = pk2(vr[2], vr[3]); o.z = pk2(vr[4], vr[5]); o.w = pk2(vr[6], vr[7]); dr[0] = o;
            o.x = pk2(vr[8], vr[9]); o.y = pk2(vr[10], vr[11]); o.z = pk2(vr[12], vr[13]); o.w = pk2(vr[14], vr[15]); dr[1] = o;
            o.x = pk2(vi[0], vi[1]); o.y = pk2(vi[2], vi[3]); o.z = pk2(vi[4], vi[5]); o.w = pk2(vi[6], vi[7]); di[0] = o;
            o.x = pk2(vi[8], vi[9]); o.y = pk2(vi[10], vi[11]); o.z = pk2(vi[12], vi[13]); o.w = pk2(vi[14], vi[15]); di[1] = o;
        }
        for (int i = gt; i < NG * 64 * HS * 4; i += NGT) {
            const int pq = i & 3, h = (i >> 2) % HS, t = (i / (4 * HS)) % 64, g = i / (4 * HS * 64);
            const float step = expf(log_step[g]);
            bf16_t* dst = HT + ((size_t)(g * 1024 + t * 16 + h) * 128 + pq * 32);
            for (int pp = 0; pp < 16; pp += 4) {
                float v[8];
#pragma unroll
                for (int q = 0; q < 4; ++q) { const int p = pq * 16 + pp + q;
                    const Cplx w = cmul(Cplx{c_re[(size_t)(g * HS + h) * NP + p], c_im[(size_t)(g * HS + h) * NP + p]}, lam_pow(lam_re[g * NP + p], lam_im[g * NP + p], step, t + 1));
                    v[2 * q] = w.re; v[2 * q + 1] = -w.im; }
                u32x4 o; o.x = pk2(v[0], v[1]); o.y = pk2(v[2], v[3]); o.z = pk2(v[4], v[5]); o.w = pk2(v[6], v[7]);
                *(u32x4*)(dst + 2 * pp) = o;
            }
        }
        for (int i = gt; i < NG * NP; i += NGT) { const int g = i / NP; const Cplx w = lam_pow(lam_re[i], lam_im[i], expf(log_step[g]), 64); LAML[2 * i] = w.re; LAML[2 * i + 1] = w.im; }
    }
    for (int m = gw; m < T; m += NGW) {
        const f32x4* xr = (const f32x4*)(arg_in(0) + (size_t)m * D) + lane; f32x4 v[4];
#pragma unroll
        for (int j = 0; j < 4; ++j) v[j] = xr[64 * j];
        rms_row_to_bf16(v, arg_in(1), (bf16_t*)(ws + WS_XN) + (size_t)m * D, lane);
    }
}

__device__ __forceinline__ void s5a_phase(Frame& F, int l) {
    const bf16_t* GT = (const bf16_t*)(F.ws + WS_GT + l * GT_STRIDE); const bf16_t* U = (const bf16_t*)(F.ws + WS_U); float* S = (float*)(F.ws + WS_S);
    const int lane = F.lane, n = lane & 15, kq = lane >> 4;
    for (int uu = F.bx * NWAVES + F.wave; uu < NG * 32 * 2; uu += F.G * NWAVES) {
        const int g = uu >> 6, ntile = (uu >> 1) & 31, mh = uu & 1;
        const int chunk = ntile * 16 + n;
        const bf16_t* up = U + ((size_t)chunk * 64 + (kq >> 1)) * DS + g * 16 + 8 * (kq & 1);
        const bf16_t* gp = GT + ((size_t)(g * 128 + mh * 64 + n) * 1024 + 8 * kq);
        f32x4 acc[4];
#pragma unroll
        for (int mt = 0; mt < 4; ++mt) acc[mt] = (f32x4){0.f, 0.f, 0.f, 0.f};
#pragma unroll 4
        for (int ks = 0; ks < 32; ++ks) {
            const bf16x8 b = *(const bf16x8*)(up + (size_t)(2 * ks) * DS);
#pragma unroll
            for (int mt = 0; mt < 4; ++mt) { const bf16x8 a = *(const bf16x8*)(gp + (size_t)(mt * 16) * 1024 + 32 * ks); acc[mt] = __builtin_amdgcn_mfma_f32_16x16x32_bf16(a, b, acc[mt], 0, 0, 0); }
        }
#pragma unroll
        for (int mt = 0; mt < 4; ++mt) *(f32x4*)(S + ((size_t)chunk * NG + g) * 128 + mh * 64 + mt * 16 + 4 * kq) = acc[mt];
    }
}
__device__ __forceinline__ void s5c_phase(Frame& F, int l) {
    const bf16_t* KT = (const bf16_t*)(F.ws + WS_KT + l * KT_STRIDE); const bf16_t* HT = (const bf16_t*)(F.ws + WS_HT + l * HT_STRIDE);
    const float* LAML = (const float*)(F.ws + WS_LAML + l * LAML_STRIDE); const float* S = (const float*)(F.ws + WS_S);
    const bf16_t* U = (const bf16_t*)(F.ws + WS_U); bf16_t* YG = (bf16_t*)(F.ws + WS_YG); const float* dsk = arg_in(10) + l * DS;
    const int lane = F.lane, n = lane & 15, kq = lane >> 4, wave = F.wave;
    LAS unsigned char* ktl = F.lds + LDS_RING;
    LAS unsigned char* xs = F.lds + LDS_RING + 33792 + wave * 4096;
    for (int wu = F.bx; wu < NG * 8; wu += F.G) {
        const int g = wu >> 3, sc = (wu & 7) * 4 + (wave >> 1), par = wave & 1;
        __syncthreads();
        for (int i = F.tid; i < 65 * 32; i += NTHREADS) *(LAS u32x4*)(ktl + i * 16) = *(const u32x4*)(KT + (size_t)g * 65 * 256 + i * 8);
        const int b = sc >> 3, c0 = (sc & 7) * 16;
        {
            const Cplx L = Cplx{LAML[(g * NP + lane) * 2], LAML[(g * NP + lane) * 2 + 1]};
            Cplx X{0.f, 0.f};
            const float* sp = S + ((size_t)(b * CPB) * NG + g) * 128 + 2 * lane;
            for (int c = 0; c < c0; ++c) { const f32x2 s = *(const f32x2*)(sp + (size_t)c * NG * 128); const Cplx nx = cmul(L, X); X.re = nx.re + s[0]; X.im = nx.im + s[1]; }
#pragma unroll 4
            for (int j = 0; j < 16; ++j) {
                *(LAS unsigned*)(xs + j * 256 + 4 * lane) = pk2(X.re, X.im);
                const f32x2 s = *(const f32x2*)(sp + (size_t)(c0 + j) * NG * 128); const Cplx nx = cmul(L, X); X.re = nx.re + s[0]; X.im = nx.im + s[1];
            }
        }
        __syncthreads();
        const int chunk = b * CPB + c0 + n;
        bf16x8 ub[32];
        {
            const bf16_t* up = U + ((size_t)chunk * 64 + (kq >> 1)) * DS + g * 16 + 8 * (kq & 1);
#pragma unroll
            for (int kp = 0; kp < 32; ++kp) ub[kp] = *(const bf16x8*)(up + (size_t)(2 * kp) * DS);
        }
        bf16x8 xb[4];
#pragma unroll
        for (int ks = 0; ks < 4; ++ks) xb[ks] = *(const LAS bf16x8*)(xs + n * 256 + (32 * ks + 8 * kq) * 2);
        const f32x4 dv = *(const f32x4*)(dsk + g * 16 + 4 * kq);
        const bf16_t* hp = HT + ((size_t)(g * 1024 + n) * 128 + 8 * kq);
        const LAS unsigned char* kbase = ktl + (n * 16 + 8 * (kq & 1)) * 2;
        for (int ti = 0; ti < 32; ++ti) {
            const int t = 2 * ti + par;
            f32x4 acc = (f32x4){0.f, 0.f, 0.f, 0.f};
            const int slot0 = t + 1 - (kq >> 1);
#pragma unroll
            for (int kp = 0; kp < 32; ++kp) {
                if (kp <= ti) { const bf16x8 a = *(const LAS bf16x8*)(kbase + (slot0 - 2 * kp) * 512); acc = __builtin_amdgcn_mfma_f32_16x16x32_bf16(a, ub[kp], acc, 0, 0, 0); }
            }
#pragma unroll
            for (int ks = 0; ks < 4; ++ks) { const bf16x8 a = *(const bf16x8*)(hp + (size_t)(t * 16) * 128 + 32 * ks); acc = __builtin_amdgcn_mfma_f32_16x16x32_bf16(a, xb[ks], acc, 0, 0, 0); }
            const size_t tok = (size_t)chunk * 64 + t;
            const u32x2 uw = *(const u32x2*)(U + tok * DS + g * 16 + 4 * kq);
            const float y0 = acc[0] + dv[0] * bf_lo(uw.x), y1 = acc[1] + dv[1] * bf_hi(uw.x), y2 = acc[2] + dv[2] * bf_lo(uw.y), y3 = acc[3] + dv[3] * bf_hi(uw.y);
            u32x2 w; w.x = cvt_pk_bf16(gelu_tanh(y0), gelu_tanh(y1)); w.y = cvt_pk_bf16(gelu_tanh(y2), gelu_tanh(y3));
            *(u32x2*)(YG + tok * DS + g * 16 + 4 * kq) = w;
        }
    }
    __syncthreads();
}

namespace att {
constexpr int KSLOT = 16384, VSLOT = 16384, LDS_K = 0, LDS_V = 3 * KSLOT, LDS_WS = 6 * 16384, LDS_END = LDS_WS + 8 * 256;
constexpr int STG_ROW = 136;
__device__ __forceinline__ int crow(int r, int hi) { return (r & 3) + 8 * (r >> 2) + 4 * hi; }
__device__ __forceinline__ void glds16(const void* gsrc, unsigned lds_dst) { unsigned keep;
    asm volatile("s_mov_b32 %0, m0\n\ts_mov_b32 m0, %2\n\ts_nop 0\n\tglobal_load_lds_dwordx4 %1, off\n\ts_mov_b32 m0, %0" : "=&s"(keep) : "v"(gsrc), "s"(lds_dst) : "memory"); }
typedef __attribute__((address_space(3))) const char* lds_cptr;
typedef short v4i16_t __attribute__((ext_vector_type(4)));
__device__ __forceinline__ s16x4 vtr(lds_cptr p) { return __builtin_bit_cast(s16x4, __builtin_amdgcn_ds_read_tr16_b64_v4i16((__attribute__((address_space(3))) v4i16_t*)p)); }
#define ATT_WAIT_BAR(N) asm volatile("s_waitcnt vmcnt(" #N ") lgkmcnt(0)\n\ts_barrier" ::: "memory")

__device__ __forceinline__ void attn_unit(int bh, int qb, const bf16_t* Q, const bf16_t* K, const bf16_t* V, bf16_t* MIX, const float* subg, float lam, float mshift, float oml,
                                          LAS unsigned char* shm, int tid) {
    const int lane = tid & 63, r32 = lane & 31, hi = lane >> 5; const int wid = __builtin_amdgcn_readfirstlane(tid >> 6);
    const int b = bh >> 2, h = bh & 3, m = wid & 1, qg = wid >> 1;
    const size_t rowbase = (size_t)b * SEQ; const int q0 = qb * 128;
    const int NT = 2 * qb + 2, cw = 2 * qb + (qg >> 1);
    const unsigned lds0 = (unsigned)(uintptr_t)shm;
    const bf16_t* k0src = K + (rowbase + lane) * DA + h * 128 + wid * 8;
    const bf16_t* k1src = k0src + 64;
    const bf16_t* v0src = V + (rowbase + 16 * (wid & 3) + (lane >> 2)) * DA + h * 128 + (wid >> 2) * 32 + (lane & 3) * 8;
    const bf16_t* v1src = v0src + 64;
    const unsigned kdst = lds0 + LDS_K + wid * 1024, vdst = lds0 + LDS_V + wid * 1024;
#define ATT_DMA(t, slot) do { const size_t _o = (size_t)(t) * 64 * DA; \
        glds16(k0src + _o, (unsigned)__builtin_amdgcn_readfirstlane(kdst + (slot) * KSLOT)); glds16(k1src + _o, (unsigned)__builtin_amdgcn_readfirstlane(kdst + (slot) * KSLOT + 8192)); \
        glds16(v0src + _o, (unsigned)__builtin_amdgcn_readfirstlane(vdst + (slot) * VSLOT)); glds16(v1src + _o, (unsigned)__builtin_amdgcn_readfirstlane(vdst + (slot) * VSLOT + 8192)); } while (0)
    bf16x8 qr[4];
    { const bf16_t* Qw = Q + (rowbase + q0 + qg * 32 + r32) * DA + h * 128 + m * 64 + hi * 8;
#pragma unroll
      for (int d0 = 0; d0 < 4; ++d0) qr[d0] = *(const bf16x8*)(Qw + d0 * 16); }
    ATT_DMA(0, 0); ATT_DMA(1, 1);
    f32x16 o[4];
#pragma unroll
    for (int d = 0; d < 4; ++d)
#pragma unroll
        for (int r = 0; r < 16; ++r) o[d][r] = 0.f;
    float l_reg = 0.f;
    f32x16 negm;
#pragma unroll
    for (int r = 0; r < 16; ++r) negm[r] = -mshift;
    const lds_cptr shm3 = (lds_cptr)shm;
    const lds_cptr kp0 = shm3 + LDS_K + m * 8192 + hi * 1024 + r32 * 16;
    const lds_cptr vp0 = shm3 + LDS_V + ((lane >> 4) & 1) * 32 + (lane & 3) * 8 + (4 * hi + ((lane & 15) >> 2)) * 64;
    int slot = 0;
    for (int t = 0; t < NT; ++t) {
        if (t + 1 < NT) { ATT_WAIT_BAR(4); } else { ATT_WAIT_BAR(0); }
        if (t + 2 < NT) { const int s2 = (slot == 0) ? 2 : slot - 1; ATT_DMA(t + 2, s2); }
        if (t <= cw) {
            const lds_cptr kp = kp0 + slot * KSLOT; const lds_cptr vp = vp0 + slot * VSLOT;
            bf16x8 kf[8];
#pragma unroll
            for (int j = 0; j < 4; ++j) { kf[2 * j] = *(const __attribute__((address_space(3))) bf16x8*)(kp + j * 2048); kf[2 * j + 1] = *(const __attribute__((address_space(3))) bf16x8*)(kp + j * 2048 + 512); }
            f32x16 p0 = __builtin_amdgcn_mfma_f32_32x32x16_bf16(kf[0], qr[0], negm, 0, 0, 0);
            f32x16 p1 = __builtin_amdgcn_mfma_f32_32x32x16_bf16(kf[1], qr[0], negm, 0, 0, 0);
#pragma unroll
            for (int d0 = 1; d0 < 4; ++d0) { p0 = __builtin_amdgcn_mfma_f32_32x32x16_bf16(kf[2 * d0], qr[d0], p0, 0, 0, 0); p1 = __builtin_amdgcn_mfma_f32_32x32x16_bf16(kf[2 * d0 + 1], qr[d0], p1, 0, 0, 0); }
            float sacc = 0.f;
#pragma unroll
            for (int r = 0; r < 16; ++r) { p0[r] = __builtin_amdgcn_exp2f(p0[r]); p1[r] = __builtin_amdgcn_exp2f(p1[r]); sacc += p0[r] + p1[r]; }
            l_reg += sacc;
            u32x4 pw[4];
#pragma unroll
            for (int q = 0; q < 4; ++q) { pw[0][q] = cvt_pk_bf16(p0[2 * q], p0[2 * q + 1]); pw[1][q] = cvt_pk_bf16(p0[8 + 2 * q], p0[8 + 2 * q + 1]);
                                          pw[2][q] = cvt_pk_bf16(p1[2 * q], p1[2 * q + 1]); pw[3][q] = cvt_pk_bf16(p1[8 + 2 * q], p1[8 + 2 * q + 1]); }
#pragma unroll
            for (int d = 0; d < 4; ++d) {
#pragma unroll
                for (int ks = 0; ks < 4; ++ks) {
                    const s16x4 lo = vtr(vp + d * 4096 + ks * 1024), hh = vtr(vp + d * 4096 + ks * 1024 + 512);
                    const bf16x8 vf = (bf16x8){lo[0], lo[1], lo[2], lo[3], hh[0], hh[1], hh[2], hh[3]};
                    o[d] = __builtin_amdgcn_mfma_f32_32x32x16_bf16(__builtin_bit_cast(bf16x8, pw[ks]), vf, o[d], 0, 0, 0);
                }
            }
        }
        slot = (slot == 2) ? 0 : slot + 1;
    }
    { auto rr = __builtin_amdgcn_permlane32_swap(__float_as_uint(l_reg), __float_as_uint(l_reg), false, false); l_reg = __uint_as_float(rr[0]) + __uint_as_float(rr[1]); }
    LAS float* wsf = (LAS float*)(shm + LDS_WS) + wid * 64;
    if (hi == 0) wsf[r32] = l_reg;
    ATT_WAIT_BAR(0);
    float rli[16];
    const float scl = m ? lam : 1.0f;
#pragma unroll
    for (int r = 0; r < 16; ++r) rli[r] = scl * __builtin_amdgcn_rcpf(wsf[crow(r, hi)]);
    LAS float* stg = (LAS float*)shm + qg * (32 * STG_ROW);
    if (m == 1) {
#pragma unroll
        for (int r = 0; r < 16; ++r)
#pragma unroll
            for (int d = 0; d < 4; ++d) stg[crow(r, hi) * STG_ROW + d * 32 + r32] = o[d][r] * rli[r];
    }
    ATT_WAIT_BAR(0);
    if (m == 0) {
#pragma unroll
        for (int r = 0; r < 16; ++r)
#pragma unroll
            for (int d = 0; d < 4; ++d) { LAS float* p = stg + crow(r, hi) * STG_ROW + d * 32 + r32; *p = o[d][r] * rli[r] - *p; }
    }
    ATT_WAIT_BAR(0);
    {
        const int row = 16 * m + (lane >> 2), qt = lane & 3;
        const LAS float* p = stg + row * STG_ROW + qt * 32;
        f32x4 v[8]; float ss = 0.f;
#pragma unroll
        for (int i = 0; i < 8; ++i) { v[i] = *(const LAS f32x4*)(p + 4 * i); ss += (v[i][0] * v[i][0] + v[i][1] * v[i][1]) + (v[i][2] * v[i][2] + v[i][3] * v[i][3]); }
        ss += __shfl_xor(ss, 1); ss += __shfl_xor(ss, 2);
        const float rn = rsqrtf(ss * (1.f / 128.f) + EPS) * oml;
        bf16_t* dst = MIX + (rowbase + q0 + qg * 32 + row) * D + DS + h * 128 + qt * 32;
#pragma unroll
        for (int i = 0; i < 4; ++i) {
            const f32x4 g0 = *(const f32x4*)(subg + qt * 32 + 8 * i), g1 = *(const f32x4*)(subg + qt * 32 + 8 * i + 4);
            const f32x4 a = v[2 * i] * g0 * rn, c = v[2 * i + 1] * g1 * rn;
            u32x4 w; w.x = cvt_pk_bf16(a[0], a[1]); w.y = cvt_pk_bf16(a[2], a[3]); w.z = cvt_pk_bf16(c[0], c[1]); w.w = cvt_pk_bf16(c[2], c[3]);
            *(u32x4*)(dst + 8 * i) = w;
        }
    }
    ATT_WAIT_BAR(0);
#undef ATT_DMA
}
}
__device__ __forceinline__ void attn_phase(Frame& F, int l) {
    const bf16_t* Q = (const bf16_t*)(F.ws + WS_Q); const bf16_t* K = (const bf16_t*)(F.ws + WS_K); const bf16_t* V = (const bf16_t*)(F.ws + WS_V);
    bf16_t* MIX = (bf16_t*)(F.ws + WS_MIX);
    const float* sc = (const float*)(F.ws + WS_SCAL) + l * 4;
    const float lam = sc[0], mshift = sc[1], oml = sc[2];
    const float* subg = arg_in(19) + l * DV;
    const int G = F.G;
    for (int v = F.bx; v < 256; v += G) {
        const int bh = v >> 4, s = v & 15;
#pragma unroll 1
        for (int i = 0; i < 4; ++i) { const int qb = (i == 0) ? s : (i == 1) ? 31 - s : (i == 2) ? 32 + s : 63 - s;
            att::attn_unit(bh, qb, Q, K, V, MIX, subg, lam, mshift, oml, F.lds + LDS_RING, F.tid); }
    }
}

__device__ __forceinline__ void router_phase(Frame& F, int l) {
    const float* h1 = F.out; const float* g = arg_in(21) + (size_t)l * D; const float* wr = arg_in(22) + (size_t)l * D * NE; const float* br = arg_in(23) + l * NE;
    bf16_t* XN = (bf16_t*)(F.ws + WS_XN); int* TOPI = (int*)(F.ws + WS_TOPI); float* TOPG = (float*)(F.ws + WS_TOPG); int* WGCNT = (int*)(F.ws + WS_WGCNT);
    const int lane = F.lane, tid = F.tid;
    LAS unsigned char* wl = F.lds + LDS_RING;
    LAS int* cnt = (LAS int*)(F.ctl + 256);
    __syncthreads();
    for (int i = tid; i < D * 8; i += NTHREADS) { const int k = i >> 3, c = i & 7; const f32x4 w = *(const f32x4*)(wr + (size_t)k * NE + 4 * c);
        *(LAS f32x4*)(wl + (k ^ ((k >> 5) & 1)) * 128 + (((c + (k >> 2)) & 7) * 16)) = w; }
    if (tid < 32) cnt[tid] = 0;
    __syncthreads();
    const float bias = br[lane >> 1];
    for (int wgu = F.bx; wgu < 256; wgu += F.G) {
        if (wgu != F.bx) { __syncthreads(); if (tid < 32) cnt[tid] = 0; __syncthreads(); }
        for (int ri = 0; ri < 16; ++ri) {
            const int row = wgu * 128 + F.wave * 16 + ri;
            const f32x4* xr = (const f32x4*)(h1 + (size_t)row * D) + lane; f32x4 v[4]; float s = 0.f;
#pragma unroll
            for (int j = 0; j < 4; ++j) { v[j] = xr[64 * j]; s += (v[j][0] * v[j][0] + v[j][1] * v[j][1]) + (v[j][2] * v[j][2] + v[j][3] * v[j][3]); }
            const float r = rsqrtf(wave_sum(s) * (1.f / D) + EPS);
            float acc[32];
#pragma unroll
            for (int e = 0; e < 32; ++e) acc[e] = 0.f;
#pragma unroll
            for (int j = 0; j < 4; ++j) {
                const f32x4 gg = *(const f32x4*)(g + 4 * lane + 256 * j); const f32x4 xn = v[j] * gg * r;
                u32x2 w; w.x = cvt_pk_bf16(xn[0], xn[1]); w.y = cvt_pk_bf16(xn[2], xn[3]); *(u32x2*)(XN + (size_t)row * D + 4 * lane + 256 * j) = w;
#pragma unroll
                for (int i = 0; i < 4; ++i) {
                    const int k = 4 * lane + 256 * j + i; const LAS unsigned char* rowp = wl + (k ^ ((k >> 5) & 1)) * 128;
#pragma unroll
                    for (int c = 0; c < 8; ++c) { const f32x4 w4 = *(const LAS f32x4*)(rowp + (((c + (k >> 2)) & 7) * 16));
                        acc[4 * c] += xn[i] * w4[0]; acc[4 * c + 1] += xn[i] * w4[1]; acc[4 * c + 2] += xn[i] * w4[2]; acc[4 * c + 3] += xn[i] * w4[3]; }
                }
            }
            float v16[16], v8[8], v4[4], v2[2], v1;
#pragma unroll
            for (int i = 0; i < 16; ++i) { const bool up = lane & 32; const float keep = up ? acc[16 + i] : acc[i], send = up ? acc[i] : acc[16 + i]; v16[i] = keep + __shfl_xor(send, 32); }
#pragma unroll
            for (int i = 0; i < 8; ++i) { const bool up = lane & 16; const float keep = up ? v16[8 + i] : v16[i], send = up ? v16[i] : v16[8 + i]; v8[i] = keep + __shfl_xor(send, 16); }
#pragma unroll
            for (int i = 0; i < 4; ++i) { const bool up = lane & 8; const float keep = up ? v8[4 + i] : v8[i], send = up ? v8[i] : v8[4 + i]; v4[i] = keep + __shfl_xor(send, 8); }
#pragma unroll
            for (int i = 0; i < 2; ++i) { const bool up = lane & 4; const float keep = up ? v4[2 + i] : v4[i], send = up ? v4[i] : v4[2 + i]; v2[i] = keep + __shfl_xor(send, 4); }
            { const bool up = lane & 2; const float keep = up ? v2[1] : v2[0], send = up ? v2[0] : v2[1]; v1 = keep + __shfl_xor(send, 2); }
            v1 += __shfl_xor(v1, 1);
            float mylogit = v1 + bias; const int mye = lane >> 1;
            float val[4]; int sel[4];
#pragma unroll
            for (int k = 0; k < 4; ++k) {
                float bv = mylogit; int be = mye;
#pragma unroll
                for (int o = 2; o < 64; o <<= 1) { const float ov = __shfl_xor(bv, o); const int oe = __shfl_xor(be, o); if (ov > bv || (ov == bv && oe < be)) { bv = ov; be = oe; } }
                val[k] = bv; sel[k] = be; if (mye == be) mylogit = -INFINITY;
            }
            float ex[4], sum = 0.f;
#pragma unroll
            for (int k = 0; k < 4; ++k) { ex[k] = __expf(val[k] - val[0]); sum += ex[k]; }
            if (lane < 4) {
                const int e = lane == 0 ? sel[0] : lane == 1 ? sel[1] : lane == 2 ? sel[2] : sel[3];
                const float gte = (lane == 0 ? ex[0] : lane == 1 ? ex[1] : lane == 2 ? ex[2] : ex[3]) / sum;
                const int pos = __hip_atomic_fetch_add(cnt + e, 1, __ATOMIC_RELAXED, __HIP_MEMORY_SCOPE_WORKGROUP);
                TOPI[row * 4 + lane] = e | (pos << 8); TOPG[row * 4 + lane] = gte;
            }
        }
        __syncthreads();
        if (tid < 32) WGCNT[wgu * 32 + tid] = cnt[tid];
    }
    __syncthreads();
}
__device__ __forceinline__ void routing_phase(Frame& F) {
    const int* TOPI = (const int*)(F.ws + WS_TOPI); const float* TOPG = (const float*)(F.ws + WS_TOPG); const int* WGCNT = (const int*)(F.ws + WS_WGCNT);
    int* TOKROW = (int*)(F.ws + WS_TOKROW); int* ROWTOK = (int*)(F.ws + WS_ROWTOK); float* ROWGATE = (float*)(F.ws + WS_ROWGATE); int* TILEEXP = (int*)(F.ws + WS_TILEEXP);
    const int tid = F.tid;
    LAS int* tot = (LAS int*)(F.lds + LDS_RING);
    LAS int* pst = tot + 32;
    LAS int* mypre = pst + 40;
    LAS int* part = mypre + 32;
    for (int wgu = F.bx; wgu < 256; wgu += F.G) {
        __syncthreads();
        {
            const int e = tid & 31, wq = tid >> 5; int a = 0, mine = 0;
#pragma unroll
            for (int j = 0; j < 16; ++j) { const int w = wq * 16 + j; const int c = WGCNT[w * 32 + e]; a += c; if (w < wgu) mine += c; }
            part[wq * 32 + e] = a; part[512 + wq * 32 + e] = mine;
        }
        __syncthreads();
        if (tid < 32) { int a = 0, mine = 0;
#pragma unroll
            for (int q = 0; q < 16; ++q) { a += part[q * 32 + tid]; mine += part[512 + q * 32 + tid]; }
            tot[tid] = a; mypre[tid] = mine; }
        __syncthreads();
        if (tid == 0) { int a = 0; for (int e = 0; e < 32; ++e) { pst[e] = a; a += (tot[e] + 255) & ~255; } pst[32] = a; }
        __syncthreads();
        {
            const int t = wgu * 128 + (tid >> 2), k = tid & 3;
            const int w = TOPI[t * 4 + k]; const int e = w & 255, pos = w >> 8;
            const int dest = pst[e] + mypre[e] + pos;
            ROWTOK[dest] = t; ROWGATE[dest] = TOPG[t * 4 + k]; TOKROW[t * 4 + k] = dest;
        }
        if (wgu < 32) {
            const int e = wgu; const int beg = pst[e] + tot[e], end = pst[e + 1];
            for (int r = beg + tid; r < end; r += NTHREADS) { ROWTOK[r] = 0; ROWGATE[r] = 0.f; }
        }
        if (wgu == 0) {
            const int ntiles = pst[32] >> 8;
            for (int pm = tid; pm < ntiles; pm += NTHREADS) { int e = 0; for (int q = 1; q < 32; ++q) if ((pm << 8) >= pst[q]) e = q; TILEEXP[pm] = e; }
            if (tid == 0) TILEEXP[1023] = ntiles;
        }
    }
    __syncthreads();
}
__device__ __forceinline__ void combine_phase(Frame& F, const float* gnext) {
    const bf16_t* YB = (const bf16_t*)(F.ws + WS_YB); const int* TOKROW = (const int*)(F.ws + WS_TOKROW); bf16_t* XN = (bf16_t*)(F.ws + WS_XN);
    const int lane = F.lane;
    for (int m = F.bx * NWAVES + F.wave; m < T; m += F.G * NWAVES) {
        const f32x4* xr = (const f32x4*)(F.out + (size_t)m * D) + lane; f32x4 v[4];
#pragma unroll
        for (int j = 0; j < 4; ++j) v[j] = xr[64 * j];
        const int4 tr = *(const int4*)(TOKROW + m * 4);
        const int rows[4] = {tr.x, tr.y, tr.z, tr.w};
#pragma unroll
        for (int k = 0; k < 4; ++k) {
            const u32x2* yr = (const u32x2*)(YB + (size_t)rows[k] * D) + lane;
#pragma unroll
            for (int j = 0; j < 4; ++j) { const u32x2 w = yr[64 * j]; v[j][0] += bf_lo(w.x); v[j][1] += bf_hi(w.x); v[j][2] += bf_lo(w.y); v[j][3] += bf_hi(w.y); }
        }
        f32x4* orow = (f32x4*)(F.out + (size_t)m * D) + lane;
#pragma unroll
        for (int j = 0; j < 4; ++j) orow[64 * j] = v[j];
        if (gnext) rms_row_to_bf16(v, gnext, XN + (size_t)m * D, lane);
    }
}

constexpr int NPH_LAYER = 10, NPH = 1 + DEPTH * NPH_LAYER;
__global__ void __launch_bounds__(NTHREADS, 2) mk_fwd(Args args) {
    extern __shared__ __attribute__((aligned(16))) unsigned char lds_raw[];
    Frame F;
    F.lds = (LAS unsigned char*)lds_raw; F.ctl = F.lds + LDS_CTL; F.ws = args.ws; F.ws0 = args.ws; F.out0 = args.out; F.ap = &args; F.z = 0;
    F.tid = threadIdx.x; F.lane = F.tid & 63; F.wave = __builtin_amdgcn_readfirstlane(F.tid >> 6); F.G = gridDim.x; F.bx = blockIdx.x;
    F.out = args.out;
    for (int u = F.tid; u < 1024; u += NTHREADS) ((LAS unsigned*)F.ctl)[u] = 0u;
    __syncthreads();
    XcdBarrier bar = xcd_barrier_post((unsigned*)(F.ws + WS_CTL) + CW_BAR, (volatile LAS unsigned*)F.ctl);
    const int lo = args.ph_lo, hi = args.ph_hi;
#ifndef PHMASK
#define PHMASK 0x7ff
#endif
#define RUN(k) (lo <= (k) && (k) < hi)
#define EN(b) ((PHMASK >> (b)) & 1)
#define SEAM(k) do { if (RUN((k) + 1)) xcd_barrier(bar); } while (0)
    if (EN(10) && RUN(0)) { phase_begin(F); p0_prologue(F); SEAM(0); }
    for (int l = 0; l < DEPTH; ++l) {
        const int pb = 1 + l * NPH_LAYER;
        if (EN(0) && RUN(pb + 0)) { phase_begin(F); unsigned char* ws = F.ws;
            PInProj P; P.so.init(T, DIN, F.G, F.bx); P.A = (const char*)(ws + WS_XN); P.B = (const char*)(ws + WS_WIN + l * WIN_STRIDE);
            P.UQKV = (bf16_t*)(ws + WS_U); P.GQK = (const float*)(ws + WS_SCAL) + 64 + l * 128; P.COS = (const float*)(ws + WS_COS); P.SIN = (const float*)(ws + WS_SIN);
            pg8::gemm_phase(F.lds + LDS_RING, F.ctl, P, F.tid); SEAM(pb + 0);
        }
        if (EN(1) && RUN(pb + 1)) { phase_begin(F); unsigned char* ws = F.ws; s5a_phase(F, l); SEAM(pb + 1); }
        if (EN(2) && RUN(pb + 2)) { phase_begin(F); unsigned char* ws = F.ws; s5c_phase(F, l); attn_phase(F, l); SEAM(pb + 2); }
        if (EN(3) && RUN(pb + 3)) { phase_begin(F); unsigned char* ws = F.ws;
            PGlu P; P.so.init(T, DS, F.G, F.bx); P.A = (const char*)(ws + WS_YG); P.B = (const char*)(ws + WS_WGLU + l * WGLU_STRIDE);
            P.YG = (const bf16_t*)(ws + WS_YG); P.MIX = (bf16_t*)(ws + WS_MIX); P.RSP = (float*)(ws + WS_RSP);
            pg8::gemm_phase(F.lds + LDS_RING, F.ctl, P, F.tid); SEAM(pb + 3);
        }
        if (EN(4) && RUN(pb + 4)) { phase_begin(F); unsigned char* ws = F.ws;
            POut P; P.so.init(T, D, F.G, F.bx); P.A = (const char*)(ws + WS_MIX); P.B = (const char*)(ws + WS_WOUT + l * WOUT_STRIDE);
            P.RSP = (const float*)(ws + WS_RSP); P.base = (l == 0) ? arg_in(0) : F.out; P.out = F.out;
            pg8::gemm_phase(F.lds + LDS_RING, F.ctl, P, F.tid); SEAM(pb + 4);
        }
        if (EN(5) && RUN(pb + 5)) { phase_begin(F); unsigned char* ws = F.ws; router_phase(F, l); SEAM(pb + 5); }
        if (EN(6) && RUN(pb + 6)) { phase_begin(F); unsigned char* ws = F.ws; routing_phase(F); SEAM(pb + 6); }
        if (EN(7) && RUN(pb + 7)) { phase_begin(F); unsigned char* ws = F.ws;
            PUp P; P.mo.G = F.G; P.mo.c = F.bx; P.mo.ntiles = ((const int*)(ws + WS_TILEEXP))[1023];
            P.A = (const char*)(ws + WS_XN); P.B = (const char*)(ws + WS_WUP + l * WUP_STRIDE); P.ROWTOK = (const int*)(ws + WS_ROWTOK); P.TILEEXP = (const int*)(ws + WS_TILEEXP);
            P.bup = arg_in(25) + (size_t)l * NE * 2048; P.ACT = (bf16_t*)(ws + WS_ACT);
            pg8::gemm_phase(F.lds + LDS_RING, F.ctl, P, F.tid); SEAM(pb + 7);
        }
        if (EN(8) && RUN(pb + 8)) { phase_begin(F); unsigned char* ws = F.ws;
            PDown P; P.mo.G = F.G; P.mo.c = F.bx; P.mo.ntiles = ((const int*)(ws + WS_TILEEXP))[1023];
            P.A = (const char*)(ws + WS_ACT); P.B = (const char*)(ws + WS_WDN + l * WDN_STRIDE); P.TILEEXP = (const int*)(ws + WS_TILEEXP);
            P.bdn = arg_in(27) + (size_t)l * NE * 1024; P.ROWGATE = (const float*)(ws + WS_ROWGATE); P.YB = (bf16_t*)(ws + WS_YB);
            pg8::gemm_phase(F.lds + LDS_RING, F.ctl, P, F.tid); SEAM(pb + 8);
        }
        if (EN(9) && RUN(pb + 9)) { phase_begin(F); unsigned char* ws = F.ws; combine_phase(F, (l + 1 < DEPTH) ? arg_in(1) + (size_t)(l + 1) * D : nullptr); SEAM(pb + 9); }
    }
#undef RUN
#undef SEAM
}

extern "C" void kernel_launch(void* const* d_in, const int* in_sizes, int n_in, void* d_out, int out_size, void* d_ws, size_t ws_size, hipStream_t stream) {
    static int grid = 0;
    if (grid == 0) {
        if (n_in != 28 || out_size != T * D || ws_size < WS_END) { fprintf(stderr, "kernel_launch: unexpected shapes (n_in %d out %d ws %zu)\n", n_in, out_size, ws_size); grid = -1; return; }
        int dev = 0, cus = 0;
        if (hipGetDevice(&dev) != hipSuccess || hipDeviceGetAttribute(&cus, hipDeviceAttributeMultiprocessorCount, dev) != hipSuccess) { grid = -1; return; }
        if (hipFuncSetAttribute((const void*)mk_fwd, hipFuncAttributeMaxDynamicSharedMemorySize, LDS_BYTES) != hipSuccess) { fprintf(stderr, "kernel_launch: hipFuncSetAttribute failed\n"); grid = -1; return; }
        int per_cu = 0;
        if (hipOccupancyMaxActiveBlocksPerMultiprocessor(&per_cu, (const void*)mk_fwd, NTHREADS, LDS_BYTES) != hipSuccess || per_cu < 1) { fprintf(stderr, "kernel_launch: occupancy query says %d\n", per_cu); }
        (void)hipGetLastError();
        grid = cus;
    }
    if (grid < 0) return;
    if (hipMemsetAsync((char*)d_ws + WS_CTL, 0, CTL_ZERO_BYTES, stream) != hipSuccess) return;
    Args a{};
    for (int i = 0; i < 28; ++i) a.in[i] = (const float*)d_in[i];
    a.out = (float*)d_out; a.ws = (unsigned char*)d_ws; a.ph_lo = 0; a.ph_hi = NPH;
    hipLaunchKernelGGL(mk_fwd, dim3(grid), dim3(NTHREADS), LDS_BYTES, stream, a);
}
```

```cpp
#include <hip/hip_runtime.h>
#include <cstdio>
#include <cstdint>
#include <math.h>

#define LAS __attribute__((address_space(3)))
#define GAS __attribute__((address_space(1)))
typedef unsigned short bf16_t;
typedef short bf16x8 __attribute__((ext_vector_type(8)));
typedef short s16x4 __attribute__((ext_vector_type(4)));
typedef float f32x4 __attribute__((ext_vector_type(4)));
typedef float f32x2 __attribute__((ext_vector_type(2)));
typedef float f32x16 __attribute__((ext_vector_type(16)));
typedef unsigned u32x4 __attribute__((ext_vector_type(4)));
typedef unsigned u32x2 __attribute__((ext_vector_type(2)));

constexpr int D = 1024, BATCH = 4, SEQ = 8192, DEPTH = 2, T = BATCH * SEQ;
constexpr int DS = 512, NG = 32, HS = 16, NP = 64, DA = 512, NH = 4, DV = 128, DIN = 2048;
constexpr int NE = 32, DFF = 1024, NASSIGN = T * 4;
constexpr int MPAD_MAX = NASSIGN + NE * 256, NTILE_MAX = MPAD_MAX / 256;
constexpr int NCHUNK = T / 64, CPB = SEQ / 64;
constexpr float EPS = 1e-6f;
constexpr float C2 = 0.125f * 1.4426950408889634f;
constexpr int NWAVES = 8, NTHREADS = 512;

constexpr size_t MiB = 1u << 20;
constexpr size_t WS_CTL = 0, CTL_ZERO_BYTES = 1 * MiB;
constexpr size_t WS_COS = 1 * MiB, WS_SIN = 2 * MiB;
constexpr size_t WS_SCAL = 3 * MiB;
constexpr size_t WS_KT = 4 * MiB, KT_STRIDE = 2 * MiB;
constexpr size_t WS_LAML = 8 * MiB, LAML_STRIDE = 32768;
constexpr size_t WS_GT = 16 * MiB, GT_STRIDE = 8 * MiB;
constexpr size_t WS_HT = 32 * MiB, HT_STRIDE = 8 * MiB;
constexpr size_t WS_WIN = 48 * MiB, WIN_STRIDE = 4 * MiB;
constexpr size_t WS_WGLU = 56 * MiB, WGLU_STRIDE = MiB / 2;
constexpr size_t WS_WOUT = 58 * MiB, WOUT_STRIDE = 2 * MiB;
constexpr size_t WS_WUP = 64 * MiB, WUP_STRIDE = 128 * MiB;
constexpr size_t WS_WDN = 320 * MiB, WDN_STRIDE = 64 * MiB;
constexpr size_t WS_XN = 448 * MiB;
constexpr size_t WS_U = 512 * MiB, WS_Q = 544 * MiB, WS_K = 576 * MiB, WS_V = 608 * MiB;
constexpr size_t WS_YG = 640 * MiB;
constexpr size_t WS_MIX = 672 * MiB;
constexpr size_t WS_S = 736 * MiB;
constexpr size_t WS_RSP = 744 * MiB;
constexpr size_t WS_TOPI = 746 * MiB, WS_TOPG = 747 * MiB, WS_TOKROW = 748 * MiB, WS_WGCNT = 749 * MiB;
constexpr size_t WS_ROWTOK = 750 * MiB, WS_ROWGATE = 751 * MiB, WS_TILEEXP = 752 * MiB;
constexpr size_t WS_ACT = 768 * MiB, WS_YB = 1040 * MiB, WS_END = 1312 * MiB;
constexpr int CW_BAR = 4096;

constexpr int LDS_CTL = 0;
constexpr int LDS_RING = 4096;
constexpr int LDS_BYTES = 147456;

__device__ __forceinline__ unsigned f2bf(float f) { unsigned u = __builtin_bit_cast(unsigned, f); return (u + 0x7fffu + ((u >> 16) & 1u)) >> 16; }
__device__ __forceinline__ unsigned pk2(float lo, float hi) { return f2bf(lo) | (f2bf(hi) << 16); }
__device__ __forceinline__ unsigned cvt_pk_bf16(float lo, float hi) { unsigned r; asm volatile("v_cvt_pk_bf16_f32 %0, %1, %2" : "=v"(r) : "v"(lo), "v"(hi)); return r; }
__device__ __forceinline__ float bf_lo(unsigned w) { return __builtin_bit_cast(float, w << 16); }
__device__ __forceinline__ float bf_hi(unsigned w) { return __builtin_bit_cast(float, w & 0xffff0000u); }
__device__ __forceinline__ float wave_sum(float v) {
#pragma unroll
    for (int o = 1; o < 64; o <<= 1) v += __shfl_xor(v, o);
    return v;
}
__device__ __forceinline__ float gelu_tanh(float x) {
    const float z = 0.7978845608028654f * (x + 0.044715f * x * x * x);
    return x / (1.f + __expf(-2.f * z));
}
__device__ __forceinline__ float sigmoidf(float v) { return 1.f / (1.f + __expf(-v)); }

#define XB_TMO      128
#define XB_XCNT(j)  (256  + 64 * (j))
#define XB_XSUB(j)  (1280 + 64 * (j))
#define XB_XGEN(j)  (2304 + 64 * (j))
#define XB_TOP      3328
#define XB_TOPGEN   3392
#define XCD_BAR_WORDS 3456
#define XB_SPIN_CAP (1u << 18)
__device__ __forceinline__ unsigned xb_ld(unsigned* p)              { return __hip_atomic_load(p, __ATOMIC_RELAXED, __HIP_MEMORY_SCOPE_AGENT); }
__device__ __forceinline__ unsigned xb_add(unsigned* p, unsigned v) { return __hip_atomic_fetch_add(p, v, __ATOMIC_RELAXED, __HIP_MEMORY_SCOPE_AGENT); }
__device__ __forceinline__ unsigned xb_xcc_id() { return (unsigned)__builtin_amdgcn_s_getreg((3 << 11) | 20) & 0xFu; }
#define XB_SPIN(cond, bar) do { unsigned _sp = 0; while (cond) { __builtin_amdgcn_s_sleep(1); \
    if ((++_sp & 255u) == 0u) { if (xb_ld(&(bar)[XB_TMO])) break; if (_sp > XB_SPIN_CAP) { atomicAdd(&(bar)[XB_TMO], 1u); break; } } } } while (0)
struct XcdBarrier { unsigned* bar; unsigned x; volatile LAS unsigned* st; };
__device__ __forceinline__ XcdBarrier xcd_barrier_post(unsigned* bar, volatile LAS unsigned* st) {
    XcdBarrier b; b.bar = bar; b.x = xb_xcc_id(); b.st = st;
    if (threadIdx.x == 0) (void)xb_add(&bar[XB_XCNT(b.x)], 1u);
    return b;
}
__device__ __forceinline__ void xcd_barrier_complete(unsigned* bar, unsigned x, unsigned& nloc, unsigned& nx) {
    const unsigned G = gridDim.x * gridDim.y * gridDim.z;
    unsigned sum, cnt, mine, sp = 0u;
    for (;;) {
        sum = 0u; cnt = 0u; mine = 0u;
#pragma unroll
        for (unsigned j = 0; j < 16; ++j) { const unsigned c = xb_ld(&bar[XB_XCNT(j)]); sum += c; cnt += (c > 0u) ? 1u : 0u; mine = (j == x) ? c : mine; }
        if (sum == G) break;
        __builtin_amdgcn_s_sleep(1);
        if ((++sp & 255u) == 0u) { if (xb_ld(&bar[XB_TMO])) break; if (sp > XB_SPIN_CAP) { atomicAdd(&bar[XB_TMO], 1u); break; } }
    }
    nloc = mine > 0u ? mine : 1u; nx = cnt > 0u ? cnt : 1u;
}
__device__ __forceinline__ void xcd_barrier(const XcdBarrier& b) {
    asm volatile("s_waitcnt vmcnt(0)" ::: "memory");
    __syncthreads();
    if (threadIdx.x == 0) {
        unsigned* bar = b.bar;
        __builtin_amdgcn_s_waitcnt(0);
        unsigned nloc = b.st[0], nx = b.st[1];
        if (nloc == 0u) { xcd_barrier_complete(bar, b.x, nloc, nx); b.st[0] = nloc; b.st[1] = nx; }
        const unsigned old = xb_add(&bar[XB_XSUB(b.x)], 1u);
        const unsigned gen = old / nloc;
        if (old + 1u == (gen + 1u) * nloc) {
            __builtin_amdgcn_fence(__ATOMIC_RELEASE, "agent");
            asm volatile("s_waitcnt vmcnt(0)" ::: "memory");
            const unsigned og = xb_add(&bar[XB_TOP], 1u);
            const unsigned tg = og / nx;
            if (og + 1u == (tg + 1u) * nx) xb_add(&bar[XB_TOPGEN], 1u);
            else XB_SPIN(xb_ld(&bar[XB_TOPGEN]) == tg, bar);
            __builtin_amdgcn_fence(__ATOMIC_ACQUIRE, "agent");
            xb_add(&bar[XB_XGEN(b.x)], 1u);
            asm volatile("s_waitcnt vmcnt(0)" ::: "memory");
        } else {
            XB_SPIN(xb_ld(&bar[XB_XGEN(b.x)]) == gen, bar);
            __builtin_amdgcn_fence(__ATOMIC_ACQUIRE, "agent");
            asm volatile("s_waitcnt vmcnt(0)" ::: "memory");
        }
    }
    __syncthreads();
}

namespace pg8 {
constexpr int BM = 256, BK = 64, HALF = 128, HTB = HALF * BK * 2, STAGE_BYTES = 8 * HTB;
__host__ __device__ __forceinline__ int lds_byte(int r, int c) { const int st = (r >> 4) * 2 + (c >> 5), rr = r & 15, cc = c & 31, ob = rr * 64 + cc * 2; return st * 1024 + (ob ^ (((ob >> 9) & 1) << 5)); }
__host__ __device__ __forceinline__ void stage_rc(int b, int& R, int& C) { const int st = b / 1024, sb = b % 1024, swz = sb ^ (((sb >> 9) & 1) << 5); R = (st >> 1) * 16 + swz / 64; C = (st & 1) * 32 + (swz % 64) / 2; }
__host__ __device__ __forceinline__ int perm32(int rho) { const int n = rho >> 4, i = rho & 15; return 8 * (i >> 2) + 4 * n + (i & 3); }

struct Unit { int pm, pn; };
template <class P>
__device__ __forceinline__ void gemm_phase(LAS unsigned char* lds, LAS unsigned char* ldsctl, P& S, const int tid) {
    const int wid = __builtin_amdgcn_readfirstlane(tid >> 6), lane = tid & 63, wr = wid >> 2, wc = wid & 3, fr = lane & 15, fq = lane >> 4;
    constexpr int K = P::K, nt = K / BK;
    int R0, C0, R1, C1; stage_rc(tid * 16, R0, C0); stage_rc(tid * 16 + 8192, R1, C1);
    unsigned voffB[2];
    {
        const int Rb0 = P::BROW64 ? (64 * (R0 >> 5) + perm32(R0 & 31)) : ((R0 & ~31) + perm32(R0 & 31));
        const int Rb1 = P::BROW64 ? (64 * (R1 >> 5) + perm32(R1 & 31)) : ((R1 & ~31) + perm32(R1 & 31));
        voffB[0] = (unsigned)(Rb0 * K + C0) * 2u; voffB[1] = (unsigned)(Rb1 * K + C1) * 2u;
    }
    const unsigned ldsw = (unsigned)wid * 1024u;
    const int aoff = lds_byte(wr * 64 + fr, fq * 8), boff = lds_byte(wc * 32 + fr, fq * 8);
#define PG8_SA(b, h) (((b) * 2 + (h)) * HTB)
#define PG8_SB(b, h) ((4 + (b) * 2 + (h)) * HTB)
#define PG8_STAGE_A(bufoff, vo, h, kofs) do { _Pragma("unroll") for (int _i = 0; _i < 2; ++_i) \
        __builtin_amdgcn_global_load_lds((const unsigned*)(Abase + (vo)[P::GATHER ? (h) : 0][_i] + ((kofs) + (P::GATHER ? 0u : (unsigned)(h) * HSTEPA))), (LAS unsigned*)(lds + (bufoff) + ldsw + _i * 8192), 16, 0, 0); } while (0)
#define PG8_STAGE_B(bufoff, gbase) do { _Pragma("unroll") for (int _i = 0; _i < 2; ++_i) \
        __builtin_amdgcn_global_load_lds((const unsigned*)((const char*)(gbase) + voffB[_i]), (LAS unsigned*)(lds + (bufoff) + ldsw + _i * 8192), 16, 0, 0); } while (0)
#define PG8_LDA(dst, b, h) do { _Pragma("unroll") for (int m = 0; m < 4; ++m) _Pragma("unroll") for (int k = 0; k < 2; ++k) dst[m][k] = *(const LAS bf16x8*)(lds + PG8_SA(b, h) + aoff + m * 2048 + k * 1024); } while (0)
#define PG8_LDB(dst, b, h) do { _Pragma("unroll") for (int n = 0; n < 2; ++n) _Pragma("unroll") for (int k = 0; k < 2; ++k) dst[n][k] = *(const LAS bf16x8*)(lds + PG8_SB(b, h) + boff + n * 2048 + k * 1024); } while (0)
#define PG8_MMA(ai, bj, At, Bt) do { __builtin_amdgcn_s_setprio(1); _Pragma("unroll") for (int m = 0; m < 4; ++m) _Pragma("unroll") for (int n = 0; n < 2; ++n) _Pragma("unroll") for (int k = 0; k < 2; ++k) \
        acc[ai][bj][m][n] = __builtin_amdgcn_mfma_f32_16x16x32_bf16(Bt[n][k], At[m][k], acc[ai][bj][m][n], 0, 0, 0); __builtin_amdgcn_s_setprio(0); } while (0)
#define PG8_WAIT_V(n) asm volatile("s_waitcnt vmcnt(" #n ")" ::: "memory")
#define PG8_WAIT_L(n) asm volatile("s_waitcnt lgkmcnt(" #n ")" ::: "memory")
#define PG8_BAR __builtin_amdgcn_s_barrier()
#define PG8_SCHED __builtin_amdgcn_sched_barrier(0)
    Unit cur, nxt; int ui = 0;
    if (!S.next(0, cur)) return;
    f32x4 acc[2][2][4][2];
#pragma unroll
    for (int a = 0; a < 2; ++a)
#pragma unroll
        for (int b = 0; b < 2; ++b)
#pragma unroll
            for (int m = 0; m < 4; ++m)
#pragma unroll
                for (int n = 0; n < 2; ++n) acc[a][b][m][n] = (f32x4){0.f, 0.f, 0.f, 0.f};
    bf16x8 At[4][2], B0[2][2], B1[2][2];
    const char* const Abase = S.a_base();
    unsigned voffA[2][2], voffAn[2][2];
    const char *cB0, *cB1;
    S.unit_begin(cur, ldsctl, tid, 0);
    S.a_offs(cur, R0, C0, R1, C1, voffA, true);
    S.b_ptrs(cur, cB0, cB1);
    constexpr unsigned kstep = BK * 2, HSTEPA = (unsigned)HALF * K * 2u;
    PG8_STAGE_B(PG8_SB(0, 0), cB0); PG8_STAGE_B(PG8_SB(0, 1), cB1); PG8_STAGE_A(PG8_SA(0, 0), voffA, 0, 0u); PG8_STAGE_A(PG8_SA(0, 1), voffA, 1, 0u);
    if (wr == 1) PG8_BAR;
    PG8_WAIT_V(2); PG8_BAR;
    PG8_STAGE_B(PG8_SB(1, 0), cB0 + kstep); PG8_STAGE_A(PG8_SA(1, 0), voffA, 0, kstep); PG8_STAGE_B(PG8_SB(1, 1), cB1 + kstep);
    PG8_WAIT_V(6); PG8_BAR;
    for (;;) {
        const bool has_next = S.next(ui + 1, nxt);
        const char *nB0 = cB0, *nB1 = cB1;
#pragma unroll
        for (int h = 0; h < 2; ++h)
#pragma unroll
            for (int i = 0; i < 2; ++i) voffAn[h][i] = voffA[h][i];
        if (has_next) { S.unit_begin(nxt, ldsctl, tid, (ui + 1) & 1); S.a_offs(nxt, R0, C0, R1, C1, voffAn, false); S.b_ptrs(nxt, nB0, nB1); }
        for (int t = 0; t < nt; t += 2) {
            const bool last = (t == nt - 2);
            S.midk(acc, cur, t, wr, fr, ldsctl, ui & 1);
            if (last) S.a_fix(voffAn);
            unsigned a2o[2][2];
#pragma unroll
            for (int h = 0; h < 2; ++h)
#pragma unroll
                for (int i = 0; i < 2; ++i) a2o[h][i] = last ? voffAn[h][i] : voffA[h][i] + (unsigned)(t + 2) * kstep;
            const char* b2h0 = last ? nB0 : cB0 + (size_t)(t + 2) * kstep; const char* b2h1 = last ? nB1 : cB1 + (size_t)(t + 2) * kstep;
            const unsigned a1k = (unsigned)(t + 1) * kstep;
            PG8_LDB(B0, 0, 0); PG8_LDB(B1, 0, 1); PG8_SCHED; PG8_LDA(At, 0, 0); PG8_STAGE_A(PG8_SA(1, 1), voffA, 1, a1k);
            PG8_WAIT_V(8); PG8_WAIT_L(0); PG8_BAR; PG8_MMA(0, 0, At, B0); PG8_MMA(0, 1, At, B1); PG8_BAR; PG8_SCHED;
            PG8_LDA(At, 0, 1); PG8_STAGE_B(PG8_SB(0, 0), b2h0); PG8_STAGE_B(PG8_SB(0, 1), b2h1); PG8_STAGE_A(PG8_SA(0, 0), a2o, 0, 0u);
            PG8_WAIT_V(8); PG8_WAIT_L(0); PG8_BAR; PG8_MMA(1, 0, At, B0); PG8_MMA(1, 1, At, B1); PG8_BAR; PG8_SCHED;
            PG8_LDB(B0, 1, 0); PG8_LDB(B1, 1, 1); PG8_SCHED; PG8_LDA(At, 1, 0); PG8_STAGE_A(PG8_SA(0, 1), a2o, 1, 0u);
            PG8_WAIT_V(8); PG8_WAIT_L(0); PG8_BAR; PG8_MMA(0, 0, At, B0); PG8_MMA(0, 1, At, B1); PG8_BAR; PG8_SCHED;
            PG8_LDA(At, 1, 1); PG8_STAGE_B(PG8_SB(1, 0), b2h0 + kstep); PG8_STAGE_B(PG8_SB(1, 1), b2h1 + kstep); PG8_STAGE_A(PG8_SA(1, 0), a2o, 0, kstep);
            PG8_WAIT_V(8); PG8_WAIT_L(0); PG8_BAR; PG8_MMA(1, 0, At, B0); PG8_MMA(1, 1, At, B1); PG8_BAR; PG8_SCHED;
        }
        if (wr == 0) PG8_BAR;
        S.epi(acc, cur, wr, wc, fr, fq);
        if (!has_next) break;
#pragma unroll
        for (int a = 0; a < 2; ++a)
#pragma unroll
            for (int b = 0; b < 2; ++b)
#pragma unroll
                for (int m = 0; m < 4; ++m)
#pragma unroll
                    for (int n = 0; n < 2; ++n) acc[a][b][m][n] = (f32x4){0.f, 0.f, 0.f, 0.f};
        cur = nxt; cB0 = nB0; cB1 = nB1; ++ui;
#pragma unroll
        for (int h = 0; h < 2; ++h)
#pragma unroll
            for (int i = 0; i < 2; ++i) voffA[h][i] = voffAn[h][i];
        if (wr == 1) PG8_BAR;
    }
    PG8_WAIT_V(0);
    PG8_BAR;
#undef PG8_SA
#undef PG8_SB
#undef PG8_STAGE_A
#undef PG8_STAGE_B
#undef PG8_LDA
#undef PG8_LDB
#undef PG8_MMA
#undef PG8_WAIT_V
#undef PG8_WAIT_L
#undef PG8_BAR
#undef PG8_SCHED
}
struct StaticOrder {
    int nM, nN, nwg, G, c;
    __device__ void init(int M, int N, int G_, int c_) { nM = M / BM; nN = N / BM; nwg = nM * nN; G = G_; c = c_; }
    __device__ bool next(int i, Unit& u) const {
        const long L = (long)i * G + c; if (L >= nwg) return false;
        int wgid = (int)L; { const int q = nwg / 8, r = nwg % 8, xcd = wgid % 8, off = wgid / 8; wgid = (xcd < r ? xcd * (q + 1) : r * (q + 1) + (xcd - r) * q) + off; }
        const int nig = 8 * nN, gid = wgid / nig, fm = gid * 8, gsz = (nM - fm) < 8 ? (nM - fm) : 8;
        u.pm = fm + ((wgid % nig) % gsz); u.pn = (wgid % nig) / gsz; return true;
    }
};
}

struct Frame {
    LAS unsigned char* lds; LAS unsigned char* ctl;
    unsigned char* ws;
    int tid, lane, wave, G, bx;
    float* out; const struct Args* ap; unsigned char* ws0; float* out0; size_t z;
};

struct Args { const float* in[28]; float* out; unsigned char* ws; int ph_lo, ph_hi; };
#define arg_in(i) (F.ap->in[i] + F.z)
__device__ __forceinline__ void phase_begin(Frame& F) {
    int t = F.tid; asm volatile("" : "+v"(t)); F.tid = t; F.lane = t & 63; F.wave = __builtin_amdgcn_readfirstlane(t >> 6);
    size_t z = 0; asm volatile("" : "+s"(z)); F.z = z; F.ws = F.ws0 + z; F.out = F.out0 + z;
    int bx = F.bx; asm volatile("" : "+s"(bx)); F.bx = bx;
}
struct PBase {
    static constexpr bool GATHER = false;
    __device__ __forceinline__ void unit_begin(const pg8::Unit&, LAS unsigned char*, int, int) {}
    __device__ __forceinline__ void midk(f32x4 (&)[2][2][4][2], const pg8::Unit&, int, int, int, LAS unsigned char*, int) {}
    __device__ __forceinline__ void a_fix(unsigned (&)[2][2]) {}
};
struct PInProj : PBase {
    static constexpr int K = 1024, BROW64 = 1;
    pg8::StaticOrder so; const char* A; const char* B; bf16_t* UQKV; const float *GQK, *COS, *SIN;
    __device__ __forceinline__ bool next(int i, pg8::Unit& u) const { return so.next(i, u); }
    __device__ __forceinline__ const char* a_base() const { return A; }
    __device__ __forceinline__ void a_offs(const pg8::Unit& u, int R0, int C0, int R1, int C1, unsigned (&vo)[2][2], bool) const {
#pragma unroll
        for (int h = 0; h < 2; ++h) { vo[h][0] = (unsigned)((u.pm * 256 + 128 * h + R0) * K + C0) * 2u; vo[h][1] = (unsigned)((u.pm * 256 + 128 * h + R1) * K + C1) * 2u; }
    }
    __device__ __forceinline__ void b_ptrs(const pg8::Unit& u, const char*& b0, const char*& b1) const { b0 = B + (size_t)u.pn * 256 * K * 2; b1 = b0 + (size_t)32 * K * 2; }
    __device__ __forceinline__ void epi(f32x4 (&acc)[2][2][4][2], const pg8::Unit& u, int wr, int wc, int fr, int fq) const {
        const int kind = u.pn >> 1;
        const int colg = (u.pn & 1) * 256 + 64 * wc;
        bf16_t* dst = UQKV + (size_t)kind * (size_t)(16u << 20);
        const int row0 = u.pm * 256 + wr * 64 + fr;
        if (kind == 0 || kind == 3) {
#pragma unroll
            for (int ai = 0; ai < 2; ++ai)
#pragma unroll
                for (int m = 0; m < 4; ++m) { bf16_t* rowp = dst + (size_t)(row0 + ai * 128 + m * 16) * 512 + colg + 8 * fq;
#pragma unroll
                    for (int bj = 0; bj < 2; ++bj) { const f32x4 v0 = acc[ai][bj][m][0], v1 = acc[ai][bj][m][1];
                        u32x4 w; w.x = cvt_pk_bf16(v0[0], v0[1]); w.y = cvt_pk_bf16(v0[2], v0[3]); w.z = cvt_pk_bf16(v1[0], v1[1]); w.w = cvt_pk_bf16(v1[2], v1[3]);
                        *(u32x4*)(rowp + 32 * bj) = w; } }
        } else {
            const float* g = GQK + (kind - 1) * 64; const float sc = kind == 1 ? C2 : 1.0f;
            f32x4 g0[2], g1[2];
#pragma unroll
            for (int n = 0; n < 2; ++n) { g0[n] = *(const f32x4*)(g + 8 * fq + 4 * n); g1[n] = *(const f32x4*)(g + 32 + 8 * fq + 4 * n); }
#pragma unroll
            for (int ai = 0; ai < 2; ++ai)
#pragma unroll
                for (int m = 0; m < 4; ++m) {
                    const int row = row0 + ai * 128 + m * 16; const int pos = row & (SEQ - 1);
                    float ss = 0.f;
#pragma unroll
                    for (int bj = 0; bj < 2; ++bj)
#pragma unroll
                        for (int n = 0; n < 2; ++n) { const f32x4 x = acc[ai][bj][m][n]; ss += (x[0] * x[0] + x[1] * x[1]) + (x[2] * x[2] + x[3] * x[3]); }
                    ss += __shfl_xor(ss, 16); ss += __shfl_xor(ss, 32);
                    const float r = rsqrtf(ss * (1.f / 64.f) + EPS) * sc;
                    f32x4 o1[2], o2[2];
#pragma unroll
                    for (int n = 0; n < 2; ++n) {
                        const f32x4 c = *(const f32x4*)(COS + (size_t)pos * 32 + 8 * fq + 4 * n), s = *(const f32x4*)(SIN + (size_t)pos * 32 + 8 * fq + 4 * n);
                        const f32x4 x1 = acc[ai][0][m][n] * g0[n] * r, x2 = acc[ai][1][m][n] * g1[n] * r;
                        o1[n] = x1 * c - x2 * s; o2[n] = x2 * c + x1 * s;
                    }
                    bf16_t* rowp = dst + (size_t)row * 512 + colg + 8 * fq;
                    u32x4 w; w.x = cvt_pk_bf16(o1[0][0], o1[0][1]); w.y = cvt_pk_bf16(o1[0][2], o1[0][3]); w.z = cvt_pk_bf16(o1[1][0], o1[1][1]); w.w = cvt_pk_bf16(o1[1][2], o1[1][3]);
                    *(u32x4*)(rowp) = w;
                    w.x = cvt_pk_bf16(o2[0][0], o2[0][1]); w.y = cvt_pk_bf16(o2[0][2], o2[0][3]); w.z = cvt_pk_bf16(o2[1][0], o2[1][1]); w.w = cvt_pk_bf16(o2[1][2], o2[1][3]);
                    *(u32x4*)(rowp + 32) = w;
                    asm volatile("" ::: "memory");
                }
        }
    }
};
struct PGlu : PBase {
    static constexpr int K = 512, BROW64 = 0;
    pg8::StaticOrder so; const char* A; const char* B; const bf16_t* YG; bf16_t* MIX; float* RSP;
    __device__ __forceinline__ bool next(int i, pg8::Unit& u) const { return so.next(i, u); }
    __device__ __forceinline__ const char* a_base() const { return A; }
    __device__ __forceinline__ void a_offs(const pg8::Unit& u, int R0, int C0, int R1, int C1, unsigned (&vo)[2][2], bool) const {
#pragma unroll
        for (int h = 0; h < 2; ++h) { vo[h][0] = (unsigned)((u.pm * 256 + 128 * h + R0) * K + C0) * 2u; vo[h][1] = (unsigned)((u.pm * 256 + 128 * h + R1) * K + C1) * 2u; }
    }
    __device__ __forceinline__ void b_ptrs(const pg8::Unit& u, const char*& b0, const char*& b1) const { b0 = B + (size_t)u.pn * 256 * K * 2; b1 = b0 + (size_t)128 * K * 2; }
    __device__ __forceinline__ void epi(f32x4 (&acc)[2][2][4][2], const pg8::Unit& u, int wr, int wc, int fr, int fq) const {
        const int row0 = u.pm * 256 + wr * 64 + fr, col0 = u.pn * 256 + wc * 32 + 8 * fq;
#pragma unroll
        for (int ai = 0; ai < 2; ++ai)
#pragma unroll
            for (int m = 0; m < 4; ++m) {
                const int row = row0 + ai * 128 + m * 16; float ss = 0.f;
#pragma unroll
                for (int bj = 0; bj < 2; ++bj) {
                    const u32x4 yw = *(const u32x4*)(YG + (size_t)row * 512 + col0 + 128 * bj);
                    const f32x4 a0 = acc[ai][bj][m][0], a1 = acc[ai][bj][m][1];
                    float z[8];
                    z[0] = bf_lo(yw.x) * sigmoidf(a0[0]); z[1] = bf_hi(yw.x) * sigmoidf(a0[1]); z[2] = bf_lo(yw.y) * sigmoidf(a0[2]); z[3] = bf_hi(yw.y) * sigmoidf(a0[3]);
                    z[4] = bf_lo(yw.z) * sigmoidf(a1[0]); z[5] = bf_hi(yw.z) * sigmoidf(a1[1]); z[6] = bf_lo(yw.w) * sigmoidf(a1[2]); z[7] = bf_hi(yw.w) * sigmoidf(a1[3]);
#pragma unroll
                    for (int i = 0; i < 8; ++i) ss += z[i] * z[i];
                    u32x4 w; w.x = cvt_pk_bf16(z[0], z[1]); w.y = cvt_pk_bf16(z[2], z[3]); w.z = cvt_pk_bf16(z[4], z[5]); w.w = cvt_pk_bf16(z[6], z[7]);
                    *(u32x4*)(MIX + (size_t)row * 1024 + col0 + 128 * bj) = w;
                }
                ss += __shfl_xor(ss, 16); ss += __shfl_xor(ss, 32);
                if (fq == 0) RSP[(size_t)row * 8 + u.pn * 4 + wc] = ss;
            }
    }
};
struct POut : PBase {
    static constexpr int K = 1024, BROW64 = 0;
    pg8::StaticOrder so; const char* A; const char* B; const float* RSP; const float* base; float* out;
    __device__ __forceinline__ bool next(int i, pg8::Unit& u) const { return so.next(i, u); }
    __device__ __forceinline__ const char* a_base() const { return A; }
    __device__ __forceinline__ void a_offs(const pg8::Unit& u, int R0, int C0, int R1, int C1, unsigned (&vo)[2][2], bool) const {
#pragma unroll
        for (int h = 0; h < 2; ++h) { vo[h][0] = (unsigned)((u.pm * 256 + 128 * h + R0) * K + C0) * 2u; vo[h][1] = (unsigned)((u.pm * 256 + 128 * h + R1) * K + C1) * 2u; }
    }
    __device__ __forceinline__ void b_ptrs(const pg8::Unit& u, const char*& b0, const char*& b1) const { b0 = B + (size_t)u.pn * 256 * K * 2; b1 = b0 + (size_t)128 * K * 2; }
    __device__ __forceinline__ void unit_begin(const pg8::Unit& u, LAS unsigned char* ldsctl, int tid, int slot) const {
        if (tid < 256) {
            const f32x4 p0 = *(const f32x4*)(RSP + (size_t)(u.pm * 256 + tid) * 8), p1 = *(const f32x4*)(RSP + (size_t)(u.pm * 256 + tid) * 8 + 4);
            const float ss = ((p0[0] + p0[1]) + (p0[2] + p0[3])) + ((p1[0] + p1[1]) + (p1[2] + p1[3]));
            ((LAS float*)(ldsctl + 1024 + slot * 1024))[tid] = rsqrtf(ss * (1.f / 512.f) + EPS);
        }
    }
    __device__ __forceinline__ void midk(f32x4 (&acc)[2][2][4][2], const pg8::Unit& u, int t, int wr, int fr, LAS unsigned char* ldsctl, int slot) const {
        if (t == 8) {
            const LAS float* rs = (const LAS float*)(ldsctl + 1024 + slot * 1024);
#pragma unroll
            for (int ai = 0; ai < 2; ++ai)
#pragma unroll
                for (int m = 0; m < 4; ++m) { const float r = rs[ai * 128 + wr * 64 + m * 16 + fr];
#pragma unroll
                    for (int bj = 0; bj < 2; ++bj)
#pragma unroll
                        for (int n = 0; n < 2; ++n) acc[ai][bj][m][n] *= r; }
        }
    }
    __device__ __forceinline__ void epi(f32x4 (&acc)[2][2][4][2], const pg8::Unit& u, int wr, int wc, int fr, int fq) const {
        const int row0 = u.pm * 256 + wr * 64 + fr, col0 = u.pn * 256 + wc * 32 + 8 * fq;
#pragma unroll
        for (int ai = 0; ai < 2; ++ai)
#pragma unroll
            for (int m = 0; m < 4; ++m) { const size_t off = (size_t)(row0 + ai * 128 + m * 16) * 1024 + col0;
#pragma unroll
                for (int bj = 0; bj < 2; ++bj)
#pragma unroll
                    for (int n = 0; n < 2; ++n) { const f32x4 bs = *(const f32x4*)(base + off + bj * 128 + 4 * n); *(f32x4*)(out + off + bj * 128 + 4 * n) = bs + acc[ai][bj][m][n]; }
                if (m & 1) asm volatile("" ::: "memory"); }
    }
};
template <int NN> struct MoeOrder {
    int G, c, ntiles;
    __device__ __forceinline__ bool next(int i, pg8::Unit& u) const { const int L = i * G + c; u.pm = L / NN; u.pn = L % NN; return u.pm < ntiles; }
};
struct PUp : PBase {
    static constexpr int K = 1024, BROW64 = 0; static constexpr bool GATHER = true;
    MoeOrder<8> mo; const char* A; const char* B; const int* ROWTOK; const int* TILEEXP; const float* bup; bf16_t* ACT;
    int idx[2][2]; int c0, c1;
    __device__ __forceinline__ bool next(int i, pg8::Unit& u) const { return mo.next(i, u); }
    __device__ __forceinline__ const char* a_base() const { return A; }
    __device__ __forceinline__ void a_offs(const pg8::Unit& u, int R0, int C0, int R1, int C1, unsigned (&vo)[2][2], bool first) {
        c0 = C0; c1 = C1;
        const int* rp = ROWTOK + u.pm * 256;
#pragma unroll
        for (int h = 0; h < 2; ++h) {
            asm volatile("global_load_dword %0, %1, off" : "=v"(idx[h][0]) : "v"(rp + 128 * h + R0) : "memory");
            asm volatile("global_load_dword %0, %1, off" : "=v"(idx[h][1]) : "v"(rp + 128 * h + R1) : "memory");
        }
        asm volatile("s_waitcnt vmcnt(0)" : "+v"(idx[0][0]), "+v"(idx[0][1]), "+v"(idx[1][0]), "+v"(idx[1][1]) :: "memory");
#pragma unroll
        for (int h = 0; h < 2; ++h) { vo[h][0] = (unsigned)(idx[h][0] * K + c0) * 2u; vo[h][1] = (unsigned)(idx[h][1] * K + c1) * 2u; }
    }
    __device__ __forceinline__ void b_ptrs(const pg8::Unit& u, const char*& b0, const char*& b1) const {
        const int e = TILEEXP[u.pm]; b0 = B + ((size_t)e * 2048 + (size_t)u.pn * 128) * K * 2; b1 = b0 + (size_t)1024 * K * 2; }
    __device__ __forceinline__ void epi(f32x4 (&acc)[2][2][4][2], const pg8::Unit& u, int wr, int wc, int fr, int fq) const {
        const int e = TILEEXP[u.pm];
        const int row0 = u.pm * 256 + wr * 64 + fr, col0 = u.pn * 128 + wc * 32 + 8 * fq;
        const float* bg = bup + (size_t)e * 2048 + col0; const float* bl = bg + 1024;
        f32x4 bgv[2], blv[2];
#pragma unroll
        for (int n = 0; n < 2; ++n) { bgv[n] = *(const f32x4*)(bg + 4 * n); blv[n] = *(const f32x4*)(bl + 4 * n); }
#pragma unroll
        for (int ai = 0; ai < 2; ++ai)
#pragma unroll
            for (int m = 0; m < 4; ++m) {
                float a[8];
#pragma unroll
                for (int n = 0; n < 2; ++n)
#pragma unroll
                    for (int j = 0; j < 4; ++j) {
                        float glu = acc[ai][0][m][n][j] + bgv[n][j], lin = acc[ai][1][m][n][j] + blv[n][j];
                        glu = fminf(glu, 7.0f); lin = fminf(fmaxf(lin, -7.0f), 7.0f);
                        a[4 * n + j] = glu * sigmoidf(1.702f * glu) * (lin + 1.0f);
                    }
                u32x4 w; w.x = cvt_pk_bf16(a[0], a[1]); w.y = cvt_pk_bf16(a[2], a[3]); w.z = cvt_pk_bf16(a[4], a[5]); w.w = cvt_pk_bf16(a[6], a[7]);
                *(u32x4*)(ACT + (size_t)(row0 + ai * 128 + m * 16) * 1024 + col0) = w;
            }
    }
};
struct PDown : PBase {
    static constexpr int K = 1024, BROW64 = 0;
    MoeOrder<4> mo; const char* A; const char* B; const int* TILEEXP; const float* bdn; const float* ROWGATE; bf16_t* YB;
    __device__ __forceinline__ bool next(int i, pg8::Unit& u) const { return mo.next(i, u); }
    __device__ __forceinline__ const char* a_base() const { return A; }
    __device__ __forceinline__ void a_offs(const pg8::Unit& u, int R0, int C0, int R1, int C1, unsigned (&vo)[2][2], bool) const {
#pragma unroll
        for (int h = 0; h < 2; ++h) { vo[h][0] = (unsigned)((u.pm * 256 + 128 * h + R0) * K + C0) * 2u; vo[h][1] = (unsigned)((u.pm * 256 + 128 * h + R1) * K + C1) * 2u; }
    }
    __device__ __forceinline__ void b_ptrs(const pg8::Unit& u, const char*& b0, const char*& b1) const {
        const int e = TILEEXP[u.pm]; b0 = B + ((size_t)e * 1024 + (size_t)u.pn * 256) * K * 2; b1 = b0 + (size_t)128 * K * 2; }
    __device__ __forceinline__ void epi(f32x4 (&acc)[2][2][4][2], const pg8::Unit& u, int wr, int wc, int fr, int fq) const {
        const int e = TILEEXP[u.pm];
        const int row0 = u.pm * 256 + wr * 64 + fr, col0 = u.pn * 256 + wc * 32 + 8 * fq;
        f32x4 bv[2][2];
#pragma unroll
        for (int bj = 0; bj < 2; ++bj)
#pragma unroll
            for (int n = 0; n < 2; ++n) bv[bj][n] = *(const f32x4*)(bdn + (size_t)e * 1024 + col0 + 128 * bj + 4 * n);
#pragma unroll
        for (int ai = 0; ai < 2; ++ai)
#pragma unroll
            for (int m = 0; m < 4; ++m) { const int row = row0 + ai * 128 + m * 16; const float gt = ROWGATE[row];
#pragma unroll
                for (int bj = 0; bj < 2; ++bj) { const f32x4 v0 = (acc[ai][bj][m][0] + bv[bj][0]) * gt, v1 = (acc[ai][bj][m][1] + bv[bj][1]) * gt;
                    u32x4 w; w.x = cvt_pk_bf16(v0[0], v0[1]); w.y = cvt_pk_bf16(v0[2], v0[3]); w.z = cvt_pk_bf16(v1[0], v1[1]); w.w = cvt_pk_bf16(v1[2], v1[3]);
                    *(u32x4*)(YB + (size_t)row * 1024 + col0 + 128 * bj) = w; } }
    }
};

struct TItem { const float* src; bf16_t* dst; const float* ksc; int N, K; };
__device__ __forceinline__ void titem_load(const TItem& it, f32x4 (&v)[16], int lane) {
    const float* p = it.src + (size_t)(lane >> 4) * it.N + 4 * (lane & 15);
#pragma unroll
    for (int i = 0; i < 16; ++i) v[i] = *(const f32x4*)(p + (size_t)(4 * i) * it.N);
}
__device__ __forceinline__ void titem_store(const TItem& it, f32x4 (&v)[16], LAS float* scr, int lane) {
    if (it.ksc) {
#pragma unroll
        for (int i = 0; i < 16; ++i) v[i] *= it.ksc[4 * i + (lane >> 4)];
    }
#pragma unroll
    for (int i = 0; i < 16; ++i) { LAS float* d = scr + (4 * i + (lane >> 4)) * 65 + 4 * (lane & 15); d[0] = v[i][0]; d[1] = v[i][1]; d[2] = v[i][2]; d[3] = v[i][3]; }
    asm volatile("s_waitcnt lgkmcnt(0)" ::: "memory");
    const int c = lane & 7;
#pragma unroll
    for (int j = 0; j < 8; ++j) { const int n = (lane >> 3) + 8 * j; const LAS float* s = scr + (8 * c) * 65 + n;
        u32x4 o; o.x = pk2(s[0 * 65], s[1 * 65]); o.y = pk2(s[2 * 65], s[3 * 65]); o.z = pk2(s[4 * 65], s[5 * 65]); o.w = pk2(s[6 * 65], s[7 * 65]);
        *(u32x4*)(it.dst + (size_t)n * it.K + 8 * c) = o; }
    asm volatile("s_waitcnt lgkmcnt(0)" ::: "memory");
}
__device__ __forceinline__ void rms_row_to_bf16(const f32x4 (&v)[4], const float* g, bf16_t* orow, int lane) {
    float s = 0.f;
#pragma unroll
    for (int j = 0; j < 4; ++j) s += (v[j][0] * v[j][0] + v[j][1] * v[j][1]) + (v[j][2] * v[j][2] + v[j][3] * v[j][3]);
    const float r = rsqrtf(wave_sum(s) * (1.f / D) + EPS);
#pragma unroll
    for (int j = 0; j < 4; ++j) { const f32x4 gg = *(const f32x4*)(g + 4 * lane + 256 * j); const f32x4 o = v[j] * gg * r;
        u32x2 w; w.x = cvt_pk_bf16(o[0], o[1]); w.y = cvt_pk_bf16(o[2], o[3]); *(u32x2*)(orow + 4 * lane + 256 * j) = w; }
}
struct Cplx { float re, im; };
__device__ __forceinline__ Cplx cmul(Cplx a, Cplx b) { return Cplx{a.re * b.re - a.im * b.im, a.re * b.im + a.im * b.re}; }
__device__ __forceinline__ Cplx lam_pow(float lr, float li, float step, int n) {
    const float mag = expf((float)n * lr * step); const double ang = (double)n * (double)li * (double)step;
    return Cplx{mag * (float)cos(ang), mag * (float)sin(ang)};
}
__device__ __forceinline__ Cplx bbar_factor(float lr, float li, float step) {
    const Cplx lb = lam_pow(lr, li, step, 1); const float nr = lb.re - 1.f, ni = lb.im, den = lr * lr + li * li;
    return Cplx{(nr * lr + ni * li) / den, (ni * lr - nr * li) / den};
}
__device__ __forceinline__ void p0_prologue(Frame& F) {
    const int gw = F.bx * NWAVES + F.wave, NGW = F.G * NWAVES, lane = F.lane;
    const int gt = F.bx * NTHREADS + F.tid, NGT = F.G * NTHREADS;
    unsigned char* ws = F.ws;
    {
        LAS float* scr = (LAS float*)(F.lds + LDS_RING) + F.wave * (64 * 65);
        constexpr int I_UP = 32 * 16 * 32, I_DN = 32 * 16 * 16, I_IN = 16 * 32, I_OUT = 16 * 16, I_GLU = 8 * 8;
        constexpr int PER_L = I_UP + I_DN + I_IN + I_OUT + I_GLU, TOTAL = DEPTH * PER_L;
        auto decode = [&](int it) -> TItem {
            TItem ti; const int l = it / PER_L; int r = it % PER_L; const float* W; bf16_t* WT; int K, N; ti.ksc = nullptr;
            if (r < I_UP) { const int e = r / 512; r %= 512; K = 1024; N = 2048; W = arg_in(24) + ((size_t)l * NE + e) * 1024 * 2048; WT = (bf16_t*)(ws + WS_WUP + l * WUP_STRIDE) + (size_t)e * 2048 * 1024; }
            else if ((r -= I_UP) < I_DN) { const int e = r / 256; r %= 256; K = 1024; N = 1024; W = arg_in(26) + ((size_t)l * NE + e) * 1024 * 1024; WT = (bf16_t*)(ws + WS_WDN + l * WDN_STRIDE) + (size_t)e * 1024 * 1024; }
            else if ((r -= I_DN) < I_IN) { K = 1024; N = 2048; W = arg_in(2) + (size_t)l * 1024 * 2048; WT = (bf16_t*)(ws + WS_WIN + l * WIN_STRIDE); }
            else if ((r -= I_IN) < I_OUT) { K = 1024; N = 1024; W = arg_in(20) + (size_t)l * 1024 * 1024; WT = (bf16_t*)(ws + WS_WOUT + l * WOUT_STRIDE); if ((r / 16) * 64 < DS) ti.ksc = arg_in(12) + l * DS + (r / 16) * 64; }
            else { r -= I_OUT; K = 512; N = 512; W = arg_in(11) + (size_t)l * 512 * 512; WT = (bf16_t*)(ws + WS_WGLU + l * WGLU_STRIDE); }
            const int nblk = N / 64, k0 = 64 * (r / nblk), n0 = 64 * (r % nblk);
            ti.src = W + (size_t)k0 * N + n0; ti.dst = WT + (size_t)n0 * K + k0; ti.N = N; ti.K = K; return ti;
        };
        f32x4 va[16], vb[16]; TItem ia, ib;
        int it = gw;
        if (it < TOTAL) { ia = decode(it); titem_load(ia, va, lane); }
        while (it < TOTAL) {
            const int itb = it + NGW;
            if (itb < TOTAL) { ib = decode(itb); titem_load(ib, vb, lane); }
            titem_store(ia, va, scr, lane);
            if (itb >= TOTAL) break;
            const int itc = itb + NGW;
            if (itc < TOTAL) { ia = decode(itc); titem_load(ia, va, lane); }
            titem_store(ib, vb, scr, lane);
            it = itc;
        }
    }
    for (int i = gt; i < SEQ * 32; i += NGT) {
        const int s = i >> 5, j = i & 31;
        const float inv = 1.0f / powf(10000.0f, (float)(2 * j) / 64.0f);
        const float ang = (float)s * inv;
        ((float*)(ws + WS_COS))[i] = (float)cos((double)ang); ((float*)(ws + WS_SIN))[i] = (float)sin((double)ang);
    }
    if (F.bx == 0 && F.wave < DEPTH) {
        const int l = F.wave;
        float a = arg_in(15)[l * 64 + lane] * arg_in(16)[l * 64 + lane], b = arg_in(17)[l * 64 + lane] * arg_in(18)[l * 64 + lane];
        a = wave_sum(a); b = wave_sum(b);
        float mq = fabsf(arg_in(13)[l * 64 + lane]), mk = fabsf(arg_in(14)[l * 64 + lane]);
#pragma unroll
        for (int o = 1; o < 64; o <<= 1) { mq = fmaxf(mq, __shfl_xor(mq, o)); mk = fmaxf(mk, __shfl_xor(mk, o)); }
        const float lambda_init = 0.8f - 0.6f * expf(-0.3f * (float)l);
        { float* gqk = (float*)(ws + WS_SCAL) + 64 + l * 128; gqk[lane] = arg_in(13)[l * 64 + lane]; gqk[64 + lane] = arg_in(14)[l * 64 + lane]; }
        if (lane == 0) { float* sc = (float*)(ws + WS_SCAL) + l * 4; sc[0] = expf(a) - expf(b) + lambda_init; sc[1] = C2 * 64.f * mq * mk * 1.02f + 0.5f; sc[2] = 1.0f - lambda_init; }
    }
    for (int l = 0; l < DEPTH; ++l) {
        const float* lam_re = arg_in(3) + l * NG * NP; const float* lam_im = arg_in(4) + l * NG * NP; const float* log_step = arg_in(5) + l * NG;
        const float* b_re = arg_in(6) + (size_t)l * NG * NP * HS; const float* b_im = arg_in(7) + (size_t)l * NG * NP * HS;
        const float* c_re = arg_in(8) + (size_t)l * NG * HS * NP; const float* c_im = arg_in(9) + (size_t)l * NG * HS * NP;
        bf16_t* KT = (bf16_t*)(ws + WS_KT + l * KT_STRIDE); bf16_t* GT = (bf16_t*)(ws + WS_GT + l * GT_STRIDE); bf16_t* HT = (bf16_t*)(ws + WS_HT + l * HT_STRIDE);
        float* LAML = (float*)(ws + WS_LAML + l * LAML_STRIDE);
        for (int i = gt; i < NG * 65 * HS * 4; i += NGT) {
            const int pq = i & 3, h = (i >> 2) % HS, slot = (i / (4 * HS)) % 65, g = i / (4 * HS * 65);
            float accv[16];
#pragma unroll
            for (int q = 0; q < 16; ++q) accv[q] = 0.f;
            if (slot > 0) {
                const float step = expf(log_step[g]);
                for (int pp = 0; pp < 16; ++pp) {
                    const int p = pq * 16 + pp;
                    const float lr = lam_re[g * NP + p], li = lam_im[g * NP + p];
                    const Cplx pw = lam_pow(lr, li, step, slot - 1), f = bbar_factor(lr, li, step);
                    const Cplx w = cmul(cmul(Cplx{c_re[(size_t)(g * HS + h) * NP + p], c_im[(size_t)(g * HS + h) * NP + p]}, pw), f);
#pragma unroll
                    for (int q = 0; q < 16; ++q) { const float br = b_re[(size_t)(g * NP + p) * HS + q], bi = b_im[(size_t)(g * NP + p) * HS + q]; accv[q] += w.re * br - w.im * bi; }
                }
            }
#pragma unroll
            for (int q = 0; q < 16; ++q) { accv[q] += __shfl_xor(accv[q], 1); accv[q] += __shfl_xor(accv[q], 2); }
            if (pq == 0) {
                u32x4 o0, o1; o0.x = pk2(accv[0], accv[1]); o0.y = pk2(accv[2], accv[3]); o0.z = pk2(accv[4], accv[5]); o0.w = pk2(accv[6], accv[7]);
                o1.x = pk2(accv[8], accv[9]); o1.y = pk2(accv[10], accv[11]); o1.z = pk2(accv[12], accv[13]); o1.w = pk2(accv[14], accv[15]);
                u32x4* dst = (u32x4*)(KT + ((size_t)(g * 65 + slot) * HS + h) * 16); dst[0] = o0; dst[1] = o1;
            }
        }
        for (int i = gt; i < NG * NP * 64; i += NGT) {
            const int s = i % 64, p = (i / 64) % NP, g = i / (64 * NP);
            const float step = expf(log_step[g]); const float lr = lam_re[g * NP + p], li = lam_im[g * NP + p];
            const Cplx w = cmul(lam_pow(lr, li, step, 63 - s), bbar_factor(lr, li, step));
            float vr[16], vi[16];
#pragma unroll
            for (int q = 0; q < 16; ++q) { const float br = b_re[(size_t)(g * NP + p) * HS + q], bi = b_im[(size_t)(g * NP + p) * HS + q]; vr[q] = w.re * br - w.im * bi; vi[q] = w.re * bi + w.im * br; }
            u32x4* dr = (u32x4*)(GT + ((size_t)(g * 128 + 2 * p) * 1024 + s * 16)); u32x4* di = (u32x4*)(GT + ((size_t)(g * 128 + 2 * p + 1) * 1024 + s * 16));
            u32x4 o; o.x = pk2(vr[0], vr[1]); o.y = pk2(vr[2], vr[3]); o.z = pk2(vr[4], vr[5]); o.w = pk2(vr[6], vr[7]); dr[0] = o;
            o.x = pk2(vr[8], vr[9]); o.y = pk2(vr[10], vr[11]); o.z = pk2(vr[12], vr[13]); o.w = pk2(vr[14], vr[15]); dr[1] = o;
            o.x = pk2(vi[0], vi[1]); o.y = pk2(vi[2], vi[3]); o.z = pk2(vi[4], vi[5]); o.w = pk2(vi[6], vi[7]); di[0] = o;
            o.x = pk2(vi[8], vi[9]); o.y = pk2(vi[10], vi[11]); o.z = pk2(vi[12], vi[13]); o.w = pk2(vi[14], vi[15]); di[1] = o;
        }
        for (int i = gt; i < NG * 64 * HS * 4; i += NGT) {
            const int pq = i & 3, h = (i >> 2) % HS, t = (i / (4 * HS)) % 64, g = i / (4 * HS * 64);
            const float step = expf(log_step[g]);
            bf16_t* dst = HT + ((size_t)(g * 1024 + t * 16 + h) * 128 + pq * 32);
            for (int pp = 0; pp < 16; pp += 4) {
                float v[8];
#pragma unroll
                for (int q = 0; q < 4; ++q) { const int p = pq * 16 + pp + q;
                    const Cplx w = cmul(Cplx{c_re[(size_t)(g * HS + h) * NP + p], c_im[(size_t)(g * HS + h) * NP + p]}, lam_pow(lam_re[g * NP + p], lam_im[g * NP + p], step, t + 1));
                    v[2 * q] = w.re; v[2 * q + 1] = -w.im; }
                u32x4 o; o.x = pk2(v[0], v[1]); o.y = pk2(v[2], v[3]); o.z = pk2(v[4], v[5]); o.w = pk2(v[6], v[7]);
                *(u32x4*)(dst + 2 * pp) = o;
            }
        }
        for (int i = gt; i < NG * NP; i += NGT) { const int g = i / NP; const Cplx w = lam_pow(lam_re[i], lam_im[i], expf(log_step[g]), 64); LAML[2 * i] = w.re; LAML[2 * i + 1] = w.im; }
    }
    for (int m = gw; m < T; m += NGW) {
        const f32x4* xr = (const f32x4*)(arg_in(0) + (size_t)m * D) + lane; f32x4 v[4];
#pragma unroll
        for (int j = 0; j < 4; ++j) v[j] = xr[64 * j];
        rms_row_to_bf16(v, arg_in(1), (bf16_t*)(ws + WS_XN) + (size_t)m * D, lane);
    }
}

__device__ __forceinline__ void s5a_phase(Frame& F, int l) {
    const bf16_t* GT = (const bf16_t*)(F.ws + WS_GT + l * GT_STRIDE); const bf16_t* U = (const bf16_t*)(F.ws + WS_U); float* S = (float*)(F.ws + WS_S);
    const int lane = F.lane, n = lane & 15, kq = lane >> 4;
    for (int uu = F.bx * NWAVES + F.wave; uu < NG * 32 * 2; uu += F.G * NWAVES) {
        const int g = uu >> 6, ntile = (uu >> 1) & 31, mh = uu & 1;
        const int chunk = ntile * 16 + n;
        const bf16_t* up = U + ((size_t)chunk * 64 + (kq >> 1)) * DS + g * 16 + 8 * (kq & 1);
        const bf16_t* gp = GT + ((size_t)(g * 128 + mh * 64 + n) * 1024 + 8 * kq);
        f32x4 acc[4];
#pragma unroll
        for (int mt = 0; mt < 4; ++mt) acc[mt] = (f32x4){0.f, 0.f, 0.f, 0.f};
#pragma unroll 4
        for (int ks = 0; ks < 32; ++ks) {
            const bf16x8 b = *(const bf16x8*)(up + (size_t)(2 * ks) * DS);
#pragma unroll
            for (int mt = 0; mt < 4; ++mt) { const bf16x8 a = *(const bf16x8*)(gp + (size_t)(mt * 16) * 1024 + 32 * ks); acc[mt] = __builtin_amdgcn_mfma_f32_16x16x32_bf16(a, b, acc[mt], 0, 0, 0); }
        }
#pragma unroll
        for (int mt = 0; mt < 4; ++mt) *(f32x4*)(S + ((size_t)chunk * NG + g) * 128 + mh * 64 + mt * 16 + 4 * kq) = acc[mt];
    }
}
__device__ __forceinline__ void s5c_phase(Frame& F, int l) {
    const bf16_t* KT = (const bf16_t*)(F.ws + WS_KT + l * KT_STRIDE); const bf16_t* HT = (const bf16_t*)(F.ws + WS_HT + l * HT_STRIDE);
    const float* LAML = (const float*)(F.ws + WS_LAML + l * LAML_STRIDE); const float* S = (const float*)(F.ws + WS_S);
    const bf16_t* U = (const bf16_t*)(F.ws + WS_U); bf16_t* YG = (bf16_t*)(F.ws + WS_YG); const float* dsk = arg_in(10) + l * DS;
    const int lane = F.lane, n = lane & 15, kq = lane >> 4, wave = F.wave;
    LAS unsigned char* ktl = F.lds + LDS_RING;
    LAS unsigned char* xs = F.lds + LDS_RING + 33792 + wave * 4096;
    LAS f32x2* EB = (LAS f32x2*)(F.lds + LDS_RING + 33792 + 8 * 4096);
    LAS f32x2* EH = EB + 512;
    for (int wu = F.bx; wu < NG * 8; wu += F.G) {
        const int g = wu >> 3, scq = wu & 7, b = scq >> 1, cbase = (scq & 1) * 64, scl = wave >> 1, par = wave & 1;
        __syncthreads();
        for (int i = F.tid; i < 65 * 32; i += NTHREADS) *(LAS u32x4*)(ktl + i * 16) = *(const u32x4*)(KT + (size_t)g * 65 * 256 + i * 8);
        const Cplx L = Cplx{LAML[(g * NP + lane) * 2], LAML[(g * NP + lane) * 2 + 1]};
        const float* sp = S + ((size_t)(b * CPB) * NG + g) * 128 + 2 * lane;
        {
            f32x2 sv[8];
#pragma unroll
            for (int j = 0; j < 8; ++j) sv[j] = *(const f32x2*)(sp + (size_t)(cbase + 8 * wave + j) * NG * 128);
            Cplx E{0.f, 0.f};
#pragma unroll
            for (int j = 0; j < 8; ++j) { const Cplx nx = cmul(L, E); E.re = nx.re + sv[j][0]; E.im = nx.im + sv[j][1]; }
            EB[wave * 64 + lane] = (f32x2){E.re, E.im};
            if (cbase) {
#pragma unroll
                for (int j = 0; j < 8; ++j) sv[j] = *(const f32x2*)(sp + (size_t)(8 * wave + j) * NG * 128);
                Cplx H{0.f, 0.f};
#pragma unroll
                for (int j = 0; j < 8; ++j) { const Cplx nx = cmul(L, H); H.re = nx.re + sv[j][0]; H.im = nx.im + sv[j][1]; }
                EH[wave * 64 + lane] = (f32x2){H.re, H.im};
            }
        }
        __syncthreads();
        const int c0 = cbase + 16 * scl;
        {
            const Cplx L2 = cmul(L, L), L4 = cmul(L2, L2), L8 = cmul(L4, L4);
            Cplx X{0.f, 0.f};
            if (cbase) {
#pragma unroll
                for (int w = 0; w < 8; ++w) { const f32x2 e = EH[w * 64 + lane]; const Cplx nx = cmul(L8, X); X.re = nx.re + e[0]; X.im = nx.im + e[1]; }
            }
            for (int w = 0; w < 2 * scl; ++w) { const f32x2 e = EB[w * 64 + lane]; const Cplx nx = cmul(L8, X); X.re = nx.re + e[0]; X.im = nx.im + e[1]; }
            f32x2 sv[16];
#pragma unroll
            for (int j = 0; j < 16; ++j) sv[j] = *(const f32x2*)(sp + (size_t)(c0 + j) * NG * 128);
#pragma unroll
            for (int j = 0; j < 16; ++j) {
                *(LAS unsigned*)(xs + j * 256 + 4 * lane) = pk2(X.re, X.im);
                const Cplx nx = cmul(L, X); X.re = nx.re + sv[j][0]; X.im = nx.im + sv[j][1];
            }
        }
        const int chunk = b * CPB + c0 + n;
        bf16x8 ub[32];
        {
            const bf16_t* up = U + ((size_t)chunk * 64 + (kq >> 1)) * DS + g * 16 + 8 * (kq & 1);
#pragma unroll
            for (int kp = 0; kp < 32; ++kp) ub[kp] = *(const bf16x8*)(up + (size_t)(2 * kp) * DS);
        }
        const LAS unsigned char* xbp = xs + n * 256 + 16 * kq;
        const f32x4 dv = *(const f32x4*)(dsk + g * 16 + 4 * kq);
        const bf16_t* hp = HT + ((size_t)(g * 1024 + n) * 128 + 8 * kq);
        const bf16_t* uq = U + (size_t)chunk * 64 * DS + g * 16 + 4 * kq;
        const LAS unsigned char* kbase = ktl + (n * 16 + 8 * (kq & 1)) * 2;
        bf16x8 ha[4]; u32x2 uw;
#pragma unroll
        for (int ks = 0; ks < 4; ++ks) ha[ks] = *(const bf16x8*)(hp + (size_t)(par * 16) * 128 + 32 * ks);
        uw = *(const u32x2*)(uq + (size_t)par * DS);
        for (int ti = 0; ti < 32; ++ti) {
            const int t = 2 * ti + par, tn = (ti < 31) ? t + 2 : t;
            bf16x8 hn[4]; u32x2 un;
#pragma unroll
            for (int ks = 0; ks < 4; ++ks) hn[ks] = *(const bf16x8*)(hp + (size_t)(tn * 16) * 128 + 32 * ks);
            un = *(const u32x2*)(uq + (size_t)tn * DS);
            f32x4 acc = (f32x4){0.f, 0.f, 0.f, 0.f};
            const int slot0 = t + 1 - (kq >> 1);
#pragma unroll
            for (int kp = 0; kp < 32; ++kp) {
                if (kp <= ti) { const bf16x8 a = *(const LAS bf16x8*)(kbase + (slot0 - 2 * kp) * 512); acc = __builtin_amdgcn_mfma_f32_16x16x32_bf16(a, ub[kp], acc, 0, 0, 0); }
            }
#pragma unroll
            for (int ks = 0; ks < 4; ++ks) acc = __builtin_amdgcn_mfma_f32_16x16x32_bf16(ha[ks], *(const LAS bf16x8*)(xbp + 64 * ks), acc, 0, 0, 0);
            const float y0 = acc[0] + dv[0] * bf_lo(uw.x), y1 = acc[1] + dv[1] * bf_hi(uw.x), y2 = acc[2] + dv[2] * bf_lo(uw.y), y3 = acc[3] + dv[3] * bf_hi(uw.y);
            u32x2 w; w.x = cvt_pk_bf16(gelu_tanh(y0), gelu_tanh(y1)); w.y = cvt_pk_bf16(gelu_tanh(y2), gelu_tanh(y3));
            *(u32x2*)(YG + ((size_t)chunk * 64 + t) * DS + g * 16 + 4 * kq) = w;
#pragma unroll
            for (int ks = 0; ks < 4; ++ks) ha[ks] = hn[ks];
            uw = un;
        }
    }
    __syncthreads();
}

namespace att {
constexpr int KSLOT = 16384, VSLOT = 16384, LDS_K = 0, LDS_V = 3 * KSLOT, LDS_WS = 6 * 16384, LDS_END = LDS_WS + 8 * 256;
constexpr int STG_ROW = 136;
__device__ __forceinline__ int crow(int r, int hi) { return (r & 3) + 8 * (r >> 2) + 4 * hi; }
__device__ __forceinline__ void glds16(const void* gsrc, unsigned lds_dst) { unsigned keep;
    asm volatile("s_mov_b32 %0, m0\n\ts_mov_b32 m0, %2\n\ts_nop 0\n\tglobal_load_lds_dwordx4 %1, off\n\ts_mov_b32 m0, %0" : "=&s"(keep) : "v"(gsrc), "s"(lds_dst) : "memory"); }
typedef __attribute__((address_space(3))) const char* lds_cptr;
typedef short v4i16_t __attribute__((ext_vector_type(4)));
__device__ __forceinline__ s16x4 vtr(lds_cptr p) { return __builtin_bit_cast(s16x4, __builtin_amdgcn_ds_read_tr16_b64_v4i16((__attribute__((address_space(3))) v4i16_t*)p)); }
#define ATT_WAIT_BAR(N) asm volatile("s_waitcnt vmcnt(" #N ") lgkmcnt(0)\n\ts_barrier" ::: "memory")

__device__ __forceinline__ void attn_unit(int bh, int qb, const bf16_t* Q, const bf16_t* K, const bf16_t* V, bf16_t* MIX, const float* subg, float lam, float mshift, float oml,
                                          LAS unsigned char* shm, int tid) {
    const int lane = tid & 63, r32 = lane & 31, hi = lane >> 5; const int wid = __builtin_amdgcn_readfirstlane(tid >> 6);
    const int b = bh >> 2, h = bh & 3, m = wid & 1, qg = wid >> 1;
    const size_t rowbase = (size_t)b * SEQ; const int q0 = qb * 128;
    const int NT = 2 * qb + 2, cw = 2 * qb + (qg >> 1);
    const unsigned lds0 = (unsigned)(uintptr_t)shm;
    const bf16_t* k0src = K + (rowbase + lane) * DA + h * 128 + wid * 8;
    const bf16_t* k1src = k0src + 64;
    const bf16_t* v0src = V + (rowbase + 16 * (wid & 3) + (lane >> 2)) * DA + h * 128 + (wid >> 2) * 32 + (lane & 3) * 8;
    const bf16_t* v1src = v0src + 64;
    const unsigned kdst = lds0 + LDS_K + wid * 1024, vdst = lds0 + LDS_V + wid * 1024;
#define ATT_DMA(t, slot) do { const size_t _o = (size_t)(t) * 64 * DA; \
        glds16(k0src + _o, (unsigned)__builtin_amdgcn_readfirstlane(kdst + (slot) * KSLOT)); glds16(k1src + _o, (unsigned)__builtin_amdgcn_readfirstlane(kdst + (slot) * KSLOT + 8192)); \
        glds16(v0src + _o, (unsigned)__builtin_amdgcn_readfirstlane(vdst + (slot) * VSLOT)); glds16(v1src + _o, (unsigned)__builtin_amdgcn_readfirstlane(vdst + (slot) * VSLOT + 8192)); } while (0)
    bf16x8 qr[4];
    { const bf16_t* Qw = Q + (rowbase + q0 + qg * 32 + r32) * DA + h * 128 + m * 64 + hi * 8;
#pragma unroll
      for (int d0 = 0; d0 < 4; ++d0) qr[d0] = *(const bf16x8*)(Qw + d0 * 16); }
    ATT_DMA(0, 0); ATT_DMA(1, 1);
    f32x16 o[4];
#pragma unroll
    for (int d = 0; d < 4; ++d)
#pragma unroll
        for (int r = 0; r < 16; ++r) o[d][r] = 0.f;
    float l_reg = 0.f;
    f32x16 negm;
#pragma unroll
    for (int r = 0; r < 16; ++r) negm[r] = -mshift;
    const lds_cptr shm3 = (lds_cptr)shm;
    const lds_cptr kp0 = shm3 + LDS_K + m * 8192 + hi * 1024 + r32 * 16;
    const lds_cptr vp0 = shm3 + LDS_V + ((lane >> 4) & 1) * 32 + (lane & 3) * 8 + (4 * hi + ((lane & 15) >> 2)) * 64;
    int slot = 0;
    for (int t = 0; t < NT; ++t) {
        if (t + 1 < NT) { ATT_WAIT_BAR(4); } else { ATT_WAIT_BAR(0); }
        if (t + 2 < NT) { const int s2 = (slot == 0) ? 2 : slot - 1; ATT_DMA(t + 2, s2); }
        if (t <= cw) {
            const lds_cptr kp = kp0 + slot * KSLOT; const lds_cptr vp = vp0 + slot * VSLOT;
            bf16x8 kf[8];
#pragma unroll
            for (int j = 0; j < 4; ++j) { kf[2 * j] = *(const __attribute__((address_space(3))) bf16x8*)(kp + j * 2048); kf[2 * j + 1] = *(const __attribute__((address_space(3))) bf16x8*)(kp + j * 2048 + 512); }
            f32x16 p0 = __builtin_amdgcn_mfma_f32_32x32x16_bf16(kf[0], qr[0], negm, 0, 0, 0);
            f32x16 p1 = __builtin_amdgcn_mfma_f32_32x32x16_bf16(kf[1], qr[0], negm, 0, 0, 0);
#pragma unroll
            for (int d0 = 1; d0 < 4; ++d0) { p0 = __builtin_amdgcn_mfma_f32_32x32x16_bf16(kf[2 * d0], qr[d0], p0, 0, 0, 0); p1 = __builtin_amdgcn_mfma_f32_32x32x16_bf16(kf[2 * d0 + 1], qr[d0], p1, 0, 0, 0); }
            float sacc = 0.f;
#pragma unroll
            for (int r = 0; r < 16; ++r) { p0[r] = __builtin_amdgcn_exp2f(p0[r]); p1[r] = __builtin_amdgcn_exp2f(p1[r]); sacc += p0[r] + p1[r]; }
            l_reg += sacc;
            u32x4 pw[4];
#pragma unroll
            for (int q = 0; q < 4; ++q) { pw[0][q] = cvt_pk_bf16(p0[2 * q], p0[2 * q + 1]); pw[1][q] = cvt_pk_bf16(p0[8 + 2 * q], p0[8 + 2 * q + 1]);
                                          pw[2][q] = cvt_pk_bf16(p1[2 * q], p1[2 * q + 1]); pw[3][q] = cvt_pk_bf16(p1[8 + 2 * q], p1[8 + 2 * q + 1]); }
#pragma unroll
            for (int d = 0; d < 4; ++d) {
#pragma unroll
                for (int ks = 0; ks < 4; ++ks) {
                    const s16x4 lo = vtr(vp + d * 4096 + ks * 1024), hh = vtr(vp + d * 4096 + ks * 1024 + 512);
                    const bf16x8 vf = (bf16x8){lo[0], lo[1], lo[2], lo[3], hh[0], hh[1], hh[2], hh[3]};
                    o[d] = __builtin_amdgcn_mfma_f32_32x32x16_bf16(__builtin_bit_cast(bf16x8, pw[ks]), vf, o[d], 0, 0, 0);
                }
            }
        }
        slot = (slot == 2) ? 0 : slot + 1;
    }
    { auto rr = __builtin_amdgcn_permlane32_swap(__float_as_uint(l_reg), __float_as_uint(l_reg), false, false); l_reg = __uint_as_float(rr[0]) + __uint_as_float(rr[1]); }
    LAS float* wsf = (LAS float*)(shm + LDS_WS) + wid * 64;
    if (hi == 0) wsf[r32] = l_reg;
    ATT_WAIT_BAR(0);
    float rli[16];
    const float scl = m ? lam : 1.0f;
#pragma unroll
    for (int r = 0; r < 16; ++r) rli[r] = scl * __builtin_amdgcn_rcpf(wsf[crow(r, hi)]);
    LAS float* stg = (LAS float*)shm + qg * (32 * STG_ROW);
    if (m == 1) {
#pragma unroll
        for (int r = 0; r < 16; ++r)
#pragma unroll
            for (int d = 0; d < 4; ++d) stg[crow(r, hi) * STG_ROW + d * 32 + r32] = o[d][r] * rli[r];
    }
    ATT_WAIT_BAR(0);
    if (m == 0) {
#pragma unroll
        for (int r = 0; r < 16; ++r)
#pragma unroll
            for (int d = 0; d < 4; ++d) { LAS float* p = stg + crow(r, hi) * STG_ROW + d * 32 + r32; *p = o[d][r] * rli[r] - *p; }
    }
    ATT_WAIT_BAR(0);
    {
        const int row = 16 * m + (lane >> 2), qt = lane & 3;
        const LAS float* p = stg + row * STG_ROW + qt * 32;
        f32x4 v[8]; float ss = 0.f;
#pragma unroll
        for (int i = 0; i < 8; ++i) { v[i] = *(const LAS f32x4*)(p + 4 * i); ss += (v[i][0] * v[i][0] + v[i][1] * v[i][1]) + (v[i][2] * v[i][2] + v[i][3] * v[i][3]); }
        ss += __shfl_xor(ss, 1); ss += __shfl_xor(ss, 2);
        const float rn = rsqrtf(ss * (1.f / 128.f) + EPS) * oml;
        bf16_t* dst = MIX + (rowbase + q0 + qg * 32 + row) * D + DS + h * 128 + qt * 32;
#pragma unroll
        for (int i = 0; i < 4; ++i) {
            const f32x4 g0 = *(const f32x4*)(subg + qt * 32 + 8 * i), g1 = *(const f32x4*)(subg + qt * 32 + 8 * i + 4);
            const f32x4 a = v[2 * i] * g0 * rn, c = v[2 * i + 1] * g1 * rn;
            u32x4 w; w.x = cvt_pk_bf16(a[0], a[1]); w.y = cvt_pk_bf16(a[2], a[3]); w.z = cvt_pk_bf16(c[0], c[1]); w.w = cvt_pk_bf16(c[2], c[3]);
            *(u32x4*)(dst + 8 * i) = w;
        }
    }
    ATT_WAIT_BAR(0);
#undef ATT_DMA
}
}
__device__ __forceinline__ void attn_phase(Frame& F, int l) {
    const bf16_t* Q = (const bf16_t*)(F.ws + WS_Q); const bf16_t* K = (const bf16_t*)(F.ws + WS_K); const bf16_t* V = (const bf16_t*)(F.ws + WS_V);
    bf16_t* MIX = (bf16_t*)(F.ws + WS_MIX);
    const float* sc = (const float*)(F.ws + WS_SCAL) + l * 4;
    const float lam = sc[0], mshift = sc[1], oml = sc[2];
    const float* subg = arg_in(19) + l * DV;
    const int G = F.G;
    for (int v = F.bx; v < 256; v += G) {
        const int bh = v >> 4, s = v & 15;
#pragma unroll 1
        for (int i = 0; i < 4; ++i) { const int qb = (i == 0) ? s : (i == 1) ? 31 - s : (i == 2) ? 32 + s : 63 - s;
            att::attn_unit(bh, qb, Q, K, V, MIX, subg, lam, mshift, oml, F.lds + LDS_RING, F.tid); }
    }
}

__device__ __forceinline__ void router_phase(Frame& F, int l) {
    const float* h1 = F.out; const float* g = arg_in(21) + (size_t)l * D; const float* wr = arg_in(22) + (size_t)l * D * NE; const float* br = arg_in(23) + l * NE;
    bf16_t* XN = (bf16_t*)(F.ws + WS_XN); int* TOPI = (int*)(F.ws + WS_TOPI); float* TOPG = (float*)(F.ws + WS_TOPG); int* WGCNT = (int*)(F.ws + WS_WGCNT);
    const int lane = F.lane, tid = F.tid;
    LAS unsigned char* wl = F.lds + LDS_RING;
    LAS int* cnt = (LAS int*)(F.ctl + 256);
    __syncthreads();
    for (int i = tid; i < D * 8; i += NTHREADS) { const int k = i >> 3, c = i & 7; const f32x4 w = *(const f32x4*)(wr + (size_t)k * NE + 4 * c);
        *(LAS f32x4*)(wl + (k ^ ((k >> 5) & 1)) * 128 + (((c + (k >> 2)) & 7) * 16)) = w; }
    if (tid < 32) cnt[tid] = 0;
    __syncthreads();
    const float bias = br[lane >> 1];
    for (int wgu = F.bx; wgu < 256; wgu += F.G) {
        if (wgu != F.bx) { __syncthreads(); if (tid < 32) cnt[tid] = 0; __syncthreads(); }
        for (int ri = 0; ri < 16; ++ri) {
            const int row = wgu * 128 + F.wave * 16 + ri;
            const f32x4* xr = (const f32x4*)(h1 + (size_t)row * D) + lane; f32x4 v[4]; float s = 0.f;
#pragma unroll
            for (int j = 0; j < 4; ++j) { v[j] = xr[64 * j]; s += (v[j][0] * v[j][0] + v[j][1] * v[j][1]) + (v[j][2] * v[j][2] + v[j][3] * v[j][3]); }
            const float r = rsqrtf(wave_sum(s) * (1.f / D) + EPS);
            float acc[32];
#pragma unroll
            for (int e = 0; e < 32; ++e) acc[e] = 0.f;
#pragma unroll
            for (int j = 0; j < 4; ++j) {
                const f32x4 gg = *(const f32x4*)(g + 4 * lane + 256 * j); const f32x4 xn = v[j] * gg * r;
                u32x2 w; w.x = cvt_pk_bf16(xn[0], xn[1]); w.y = cvt_pk_bf16(xn[2], xn[3]); *(u32x2*)(XN + (size_t)row * D + 4 * lane + 256 * j) = w;
#pragma unroll
                for (int i = 0; i < 4; ++i) {
                    const int k = 4 * lane + 256 * j + i; const LAS unsigned char* rowp = wl + (k ^ ((k >> 5) & 1)) * 128;
#pragma unroll
                    for (int c = 0; c < 8; ++c) { const f32x4 w4 = *(const LAS f32x4*)(rowp + (((c + (k >> 2)) & 7) * 16));
                        acc[4 * c] += xn[i] * w4[0]; acc[4 * c + 1] += xn[i] * w4[1]; acc[4 * c + 2] += xn[i] * w4[2]; acc[4 * c + 3] += xn[i] * w4[3]; }
                }
            }
            float v16[16], v8[8], v4[4], v2[2], v1;
#pragma unroll
            for (int i = 0; i < 16; ++i) { const bool up = lane & 32; const float keep = up ? acc[16 + i] : acc[i], send = up ? acc[i] : acc[16 + i]; v16[i] = keep + __shfl_xor(send, 32); }
#pragma unroll
            for (int i = 0; i < 8; ++i) { const bool up = lane & 16; const float keep = up ? v16[8 + i] : v16[i], send = up ? v16[i] : v16[8 + i]; v8[i] = keep + __shfl_xor(send, 16); }
#pragma unroll
            for (int i = 0; i < 4; ++i) { const bool up = lane & 8; const float keep = up ? v8[4 + i] : v8[i], send = up ? v8[i] : v8[4 + i]; v4[i] = keep + __shfl_xor(send, 8); }
#pragma unroll
            for (int i = 0; i < 2; ++i) { const bool up = lane & 4; const float keep = up ? v4[2 + i] : v4[i], send = up ? v4[i] : v4[2 + i]; v2[i] = keep + __shfl_xor(send, 4); }
            { const bool up = lane & 2; const float keep = up ? v2[1] : v2[0], send = up ? v2[0] : v2[1]; v1 = keep + __shfl_xor(send, 2); }
            v1 += __shfl_xor(v1, 1);
            float mylogit = v1 + bias; const int mye = lane >> 1;
            float val[4]; int sel[4];
#pragma unroll
            for (int k = 0; k < 4; ++k) {
                float bv = mylogit; int be = mye;
#pragma unroll
                for (int o = 2; o < 64; o <<= 1) { const float ov = __shfl_xor(bv, o); const int oe = __shfl_xor(be, o); if (ov > bv || (ov == bv && oe < be)) { bv = ov; be = oe; } }
                val[k] = bv; sel[k] = be; if (mye == be) mylogit = -INFINITY;
            }
            float ex[4], sum = 0.f;
#pragma unroll
            for (int k = 0; k < 4; ++k) { ex[k] = __expf(val[k] - val[0]); sum += ex[k]; }
            if (lane < 4) {
                const int e = lane == 0 ? sel[0] : lane == 1 ? sel[1] : lane == 2 ? sel[2] : sel[3];
                const float gte = (lane == 0 ? ex[0] : lane == 1 ? ex[1] : lane == 2 ? ex[2] : ex[3]) / sum;
                const int pos = __hip_atomic_fetch_add(cnt + e, 1, __ATOMIC_RELAXED, __HIP_MEMORY_SCOPE_WORKGROUP);
                TOPI[row * 4 + lane] = e | (pos << 8); TOPG[row * 4 + lane] = gte;
            }
        }
        __syncthreads();
        if (tid < 32) WGCNT[wgu * 32 + tid] = cnt[tid];
    }
    __syncthreads();
}
__device__ __forceinline__ void routing_phase(Frame& F) {
    const int* TOPI = (const int*)(F.ws + WS_TOPI); const float* TOPG = (const float*)(F.ws + WS_TOPG); const int* WGCNT = (const int*)(F.ws + WS_WGCNT);
    int* TOKROW = (int*)(F.ws + WS_TOKROW); int* ROWTOK = (int*)(F.ws + WS_ROWTOK); float* ROWGATE = (float*)(F.ws + WS_ROWGATE); int* TILEEXP = (int*)(F.ws + WS_TILEEXP);
    const int tid = F.tid;
    LAS int* tot = (LAS int*)(F.lds + LDS_RING);
    LAS int* pst = tot + 32;
    LAS int* mypre = pst + 40;
    LAS int* part = mypre + 32;
    for (int wgu = F.bx; wgu < 256; wgu += F.G) {
        __syncthreads();
        {
            const int e = tid & 31, wq = tid >> 5; int a = 0, mine = 0;
#pragma unroll
            for (int j = 0; j < 16; ++j) { const int w = wq * 16 + j; const int c = WGCNT[w * 32 + e]; a += c; if (w < wgu) mine += c; }
            part[wq * 32 + e] = a; part[512 + wq * 32 + e] = mine;
        }
        __syncthreads();
        if (tid < 32) { int a = 0, mine = 0;
#pragma unroll
            for (int q = 0; q < 16; ++q) { a += part[q * 32 + tid]; mine += part[512 + q * 32 + tid]; }
            tot[tid] = a; mypre[tid] = mine; }
        __syncthreads();
        if (tid == 0) { int a = 0; for (int e = 0; e < 32; ++e) { pst[e] = a; a += (tot[e] + 255) & ~255; } pst[32] = a; }
        __syncthreads();
        {
            const int t = wgu * 128 + (tid >> 2), k = tid & 3;
            const int w = TOPI[t * 4 + k]; const int e = w & 255, pos = w >> 8;
            const int dest = pst[e] + mypre[e] + pos;
            ROWTOK[dest] = t; ROWGATE[dest] = TOPG[t * 4 + k]; TOKROW[t * 4 + k] = dest;
        }
        if (wgu < 32) {
            const int e = wgu; const int beg = pst[e] + tot[e], end = pst[e + 1];
            for (int r = beg + tid; r < end; r += NTHREADS) { ROWTOK[r] = 0; ROWGATE[r] = 0.f; }
        }
        if (wgu == 0) {
            const int ntiles = pst[32] >> 8;
            for (int pm = tid; pm < ntiles; pm += NTHREADS) { int e = 0; for (int q = 1; q < 32; ++q) if ((pm << 8) >= pst[q]) e = q; TILEEXP[pm] = e; }
            if (tid == 0) TILEEXP[1023] = ntiles;
        }
    }
    __syncthreads();
}
struct CRow { f32x4 h[4]; u32x4 y[4][2]; };
__device__ __forceinline__ void crow_load(CRow& r, const float* out, const bf16_t* YB, const int* TOKROW, int m, int lane) {
    const float* hr = out + (size_t)m * D + 8 * lane;
    r.h[0] = *(const f32x4*)(hr); r.h[1] = *(const f32x4*)(hr + 4); r.h[2] = *(const f32x4*)(hr + 512); r.h[3] = *(const f32x4*)(hr + 516);
    const int4 tr = *(const int4*)(TOKROW + m * 4);
    const int rows[4] = {tr.x, tr.y, tr.z, tr.w};
#pragma unroll
    for (int k = 0; k < 4; ++k) { const bf16_t* yr = YB + (size_t)rows[k] * D + 8 * lane; r.y[k][0] = *(const u32x4*)(yr); r.y[k][1] = *(const u32x4*)(yr + 512); }
}
__device__ __forceinline__ void crow_finish(CRow& r, float* out, bf16_t* XN, const float* gnext, int m, int lane) {
#pragma unroll
    for (int k = 0; k < 4; ++k)
#pragma unroll
        for (int hf = 0; hf < 2; ++hf) { const u32x4 w = r.y[k][hf];
            r.h[2 * hf][0] += bf_lo(w.x); r.h[2 * hf][1] += bf_hi(w.x); r.h[2 * hf][2] += bf_lo(w.y); r.h[2 * hf][3] += bf_hi(w.y);
            r.h[2 * hf + 1][0] += bf_lo(w.z); r.h[2 * hf + 1][1] += bf_hi(w.z); r.h[2 * hf + 1][2] += bf_lo(w.w); r.h[2 * hf + 1][3] += bf_hi(w.w); }
    float* orow = out + (size_t)m * D + 8 * lane;
    *(f32x4*)(orow) = r.h[0]; *(f32x4*)(orow + 4) = r.h[1]; *(f32x4*)(orow + 512) = r.h[2]; *(f32x4*)(orow + 516) = r.h[3];
    if (gnext) {
        float s = 0.f;
#pragma unroll
        for (int j = 0; j < 4; ++j) s += (r.h[j][0] * r.h[j][0] + r.h[j][1] * r.h[j][1]) + (r.h[j][2] * r.h[j][2] + r.h[j][3] * r.h[j][3]);
        const float rr = rsqrtf(wave_sum(s) * (1.f / D) + EPS);
        const float* gp = gnext + 8 * lane;
        const f32x4 a0 = r.h[0] * *(const f32x4*)(gp) * rr, a1 = r.h[1] * *(const f32x4*)(gp + 4) * rr, a2 = r.h[2] * *(const f32x4*)(gp + 512) * rr, a3 = r.h[3] * *(const f32x4*)(gp + 516) * rr;
        u32x4 w; w.x = cvt_pk_bf16(a0[0], a0[1]); w.y = cvt_pk_bf16(a0[2], a0[3]); w.z = cvt_pk_bf16(a1[0], a1[1]); w.w = cvt_pk_bf16(a1[2], a1[3]);
        *(u32x4*)(XN + (size_t)m * D + 8 * lane) = w;
        w.x = cvt_pk_bf16(a2[0], a2[1]); w.y = cvt_pk_bf16(a2[2], a2[3]); w.z = cvt_pk_bf16(a3[0], a3[1]); w.w = cvt_pk_bf16(a3[2], a3[3]);
        *(u32x4*)(XN + (size_t)m * D + 512 + 8 * lane) = w;
    }
}
__device__ __forceinline__ void combine_phase(Frame& F, const float* gnext, float* dst) {
    const bf16_t* YB = (const bf16_t*)(F.ws + WS_YB); const int* TOKROW = (const int*)(F.ws + WS_TOKROW); bf16_t* XN = (bf16_t*)(F.ws + WS_XN);
    const int lane = F.lane, NGW = F.G * NWAVES;
    CRow ra, rb;
    int m = F.bx * NWAVES + F.wave;
    if (m < T) crow_load(ra, F.out, YB, TOKROW, m, lane);
    while (m < T) {
        const int mb = m + NGW;
        if (mb < T) crow_load(rb, F.out, YB, TOKROW, mb, lane);
        crow_finish(ra, dst, XN, gnext, m, lane);
        if (mb >= T) break;
        const int mc = mb + NGW;
        if (mc < T) crow_load(ra, F.out, YB, TOKROW, mc, lane);
        crow_finish(rb, dst, XN, gnext, mb, lane);
        m = mc;
    }
}

constexpr int NPH_LAYER = 10, NPH = 1 + DEPTH * NPH_LAYER;
__global__ void __launch_bounds__(NTHREADS, 2) mk_fwd(Args args) {
    extern __shared__ __attribute__((aligned(16))) unsigned char lds_raw[];
    Frame F;
    F.lds = (LAS unsigned char*)lds_raw; F.ctl = F.lds + LDS_CTL; F.ws = args.ws; F.ws0 = args.ws; F.out0 = args.out; F.ap = &args; F.z = 0;
    F.tid = threadIdx.x; F.lane = F.tid & 63; F.wave = __builtin_amdgcn_readfirstlane(F.tid >> 6); F.G = gridDim.x; F.bx = blockIdx.x;
    F.out = args.out;
    for (int u = F.tid; u < 1024; u += NTHREADS) ((LAS unsigned*)F.ctl)[u] = 0u;
    __syncthreads();
    XcdBarrier bar = xcd_barrier_post((unsigned*)(F.ws + WS_CTL) + CW_BAR, (volatile LAS unsigned*)F.ctl);
    const int lo = args.ph_lo, hi = args.ph_hi;
#ifndef PHMASK
#define PHMASK 0x1fff
#endif
#define RUN(k) (lo <= (k) && (k) < hi)
#define EN(b) ((PHMASK >> (b)) & 1)
#ifndef DUPMASK
#define DUPMASK 0
#endif
#define NREP(b) (((DUPMASK >> (b)) & 1) ? 2 : 1)
#define SEAM(k) do { if (RUN((k) + 1)) xcd_barrier(bar); } while (0)
    if (EN(10) && RUN(0)) { for (int rep = 0; rep < NREP(10); ++rep) { phase_begin(F); p0_prologue(F); if (rep + 1 < NREP(10)) xcd_barrier(bar); } SEAM(0); }
    for (int l = 0; l < DEPTH; ++l) {
        const int pb = 1 + l * NPH_LAYER;
        if (EN(0) && RUN(pb + 0)) { for (int rep = 0; rep < NREP(0); ++rep) { phase_begin(F); unsigned char* ws = F.ws; (void)ws;
            PInProj P; P.so.init(T, DIN, F.G, F.bx); P.A = (const char*)(ws + WS_XN); P.B = (const char*)(ws + WS_WIN + l * WIN_STRIDE);
            P.UQKV = (bf16_t*)(ws + WS_U); P.GQK = (const float*)(ws + WS_SCAL) + 64 + l * 128; P.COS = (const float*)(ws + WS_COS); P.SIN = (const float*)(ws + WS_SIN);
            pg8::gemm_phase(F.lds + LDS_RING, F.ctl, P, F.tid);  if (rep + 1 < NREP(0)) xcd_barrier(bar); } SEAM(pb + 0);
        }
        if (EN(1) && RUN(pb + 1)) { for (int rep = 0; rep < NREP(1); ++rep) { phase_begin(F); unsigned char* ws = F.ws; (void)ws; s5a_phase(F, l);  if (rep + 1 < NREP(1)) xcd_barrier(bar); } SEAM(pb + 1); }
        if (EN(2) && RUN(pb + 2)) { for (int rep = 0; rep < NREP(2); ++rep) { phase_begin(F); unsigned char* ws = F.ws; (void)ws; if (EN(11)) for (int r2 = 0; r2 < NREP(11); ++r2) { phase_begin(F); s5c_phase(F, l); } if (EN(12)) for (int r2 = 0; r2 < NREP(12); ++r2) { phase_begin(F); attn_phase(F, l); }  if (rep + 1 < NREP(2)) xcd_barrier(bar); } SEAM(pb + 2); }
        if (EN(3) && RUN(pb + 3)) { for (int rep = 0; rep < NREP(3); ++rep) { phase_begin(F); unsigned char* ws = F.ws; (void)ws;
            PGlu P; P.so.init(T, DS, F.G, F.bx); P.A = (const char*)(ws + WS_YG); P.B = (const char*)(ws + WS_WGLU + l * WGLU_STRIDE);
            P.YG = (const bf16_t*)(ws + WS_YG); P.MIX = (bf16_t*)(ws + WS_MIX); P.RSP = (float*)(ws + WS_RSP);
            pg8::gemm_phase(F.lds + LDS_RING, F.ctl, P, F.tid);  if (rep + 1 < NREP(3)) xcd_barrier(bar); } SEAM(pb + 3);
        }
        if (EN(4) && RUN(pb + 4)) { for (int rep = 0; rep < NREP(4); ++rep) { phase_begin(F); unsigned char* ws = F.ws; (void)ws;
            POut P; P.so.init(T, D, F.G, F.bx); P.A = (const char*)(ws + WS_MIX); P.B = (const char*)(ws + WS_WOUT + l * WOUT_STRIDE);
            P.RSP = (const float*)(ws + WS_RSP); P.base = (l == 0) ? arg_in(0) : F.out; P.out = F.out;
            pg8::gemm_phase(F.lds + LDS_RING, F.ctl, P, F.tid);  if (rep + 1 < NREP(4)) xcd_barrier(bar); } SEAM(pb + 4);
        }
        if (EN(5) && RUN(pb + 5)) { for (int rep = 0; rep < NREP(5); ++rep) { phase_begin(F); unsigned char* ws = F.ws; (void)ws; router_phase(F, l);  if (rep + 1 < NREP(5)) xcd_barrier(bar); } SEAM(pb + 5); }
        if (EN(6) && RUN(pb + 6)) { for (int rep = 0; rep < NREP(6); ++rep) { phase_begin(F); unsigned char* ws = F.ws; (void)ws; routing_phase(F);  if (rep + 1 < NREP(6)) xcd_barrier(bar); } SEAM(pb + 6); }
        if (EN(7) && RUN(pb + 7)) { for (int rep = 0; rep < NREP(7); ++rep) { phase_begin(F); unsigned char* ws = F.ws; (void)ws;
            PUp P; P.mo.G = F.G; P.mo.c = F.bx; P.mo.ntiles = ((const int*)(ws + WS_TILEEXP))[1023];
            P.A = (const char*)(ws + WS_XN); P.B = (const char*)(ws + WS_WUP + l * WUP_STRIDE); P.ROWTOK = (const int*)(ws + WS_ROWTOK); P.TILEEXP = (const int*)(ws + WS_TILEEXP);
            P.bup = arg_in(25) + (size_t)l * NE * 2048; P.ACT = (bf16_t*)(ws + WS_ACT);
            pg8::gemm_phase(F.lds + LDS_RING, F.ctl, P, F.tid);  if (rep + 1 < NREP(7)) xcd_barrier(bar); } SEAM(pb + 7);
        }
        if (EN(8) && RUN(pb + 8)) { for (int rep = 0; rep < NREP(8); ++rep) { phase_begin(F); unsigned char* ws = F.ws; (void)ws;
            PDown P; P.mo.G = F.G; P.mo.c = F.bx; P.mo.ntiles = ((const int*)(ws + WS_TILEEXP))[1023];
            P.A = (const char*)(ws + WS_ACT); P.B = (const char*)(ws + WS_WDN + l * WDN_STRIDE); P.TILEEXP = (const int*)(ws + WS_TILEEXP);
            P.bdn = arg_in(27) + (size_t)l * NE * 1024; P.ROWGATE = (const float*)(ws + WS_ROWGATE); P.YB = (bf16_t*)(ws + WS_YB);
            pg8::gemm_phase(F.lds + LDS_RING, F.ctl, P, F.tid);  if (rep + 1 < NREP(8)) xcd_barrier(bar); } SEAM(pb + 8);
        }
        if (EN(9) && RUN(pb + 9)) { for (int rep = 0; rep < NREP(9); ++rep) { phase_begin(F); unsigned char* ws = F.ws; (void)ws; combine_phase(F, (l + 1 < DEPTH) ? arg_in(1) + (size_t)(l + 1) * D : nullptr, (rep + 1 < NREP(9)) ? (float*)(ws + WS_ACT) : F.out);  if (rep + 1 < NREP(9)) xcd_barrier(bar); } SEAM(pb + 9); }
    }
#undef RUN
#undef SEAM
}

extern "C" void kernel_launch(void* const* d_in, const int* in_sizes, int n_in, void* d_out, int out_size, void* d_ws, size_t ws_size, hipStream_t stream) {
    static int grid = 0;
    if (grid == 0) {
        if (n_in != 28 || out_size != T * D || ws_size < WS_END) { fprintf(stderr, "kernel_launch: unexpected shapes (n_in %d out %d ws %zu)\n", n_in, out_size, ws_size); grid = -1; return; }
        int dev = 0, cus = 0;
        if (hipGetDevice(&dev) != hipSuccess || hipDeviceGetAttribute(&cus, hipDeviceAttributeMultiprocessorCount, dev) != hipSuccess) { grid = -1; return; }
        if (hipFuncSetAttribute((const void*)mk_fwd, hipFuncAttributeMaxDynamicSharedMemorySize, LDS_BYTES) != hipSuccess) { fprintf(stderr, "kernel_launch: hipFuncSetAttribute failed\n"); grid = -1; return; }
        int per_cu = 0;
        if (hipOccupancyMaxActiveBlocksPerMultiprocessor(&per_cu, (const void*)mk_fwd, NTHREADS, LDS_BYTES) != hipSuccess || per_cu < 1) { fprintf(stderr, "kernel_launch: occupancy query says %d\n", per_cu); }
        (void)hipGetLastError();
        grid = cus;
    }
    if (grid < 0) return;
    if (hipMemsetAsync((char*)d_ws + WS_CTL, 0, CTL_ZERO_BYTES, stream) != hipSuccess) return;
    Args a{};
    for (int i = 0; i < 28; ++i) a.in[i] = (const float*)d_in[i];
    a.out = (float*)d_out; a.ws = (unsigned char*)d_ws; a.ph_lo = 0; a.ph_hi = NPH;
    hipLaunchKernelGGL(mk_fwd, dim3(grid), dim3(NTHREADS), LDS_BYTES, stream, a);
}
```

```cpp
#define MOE_XA 2
#include <hip/hip_runtime.h>
#include <cstdio>
#include <cstdint>
#include <math.h>

#define LAS __attribute__((address_space(3)))
#define GAS __attribute__((address_space(1)))
typedef unsigned short bf16_t;
typedef short bf16x8 __attribute__((ext_vector_type(8)));
typedef short s16x4 __attribute__((ext_vector_type(4)));
typedef float f32x4 __attribute__((ext_vector_type(4)));
typedef float f32x2 __attribute__((ext_vector_type(2)));
typedef float f32x16 __attribute__((ext_vector_type(16)));
typedef unsigned u32x4 __attribute__((ext_vector_type(4)));
typedef unsigned u32x2 __attribute__((ext_vector_type(2)));

constexpr int D = 1024, BATCH = 4, SEQ = 8192, DEPTH = 2, T = BATCH * SEQ;
constexpr int DS = 512, NG = 32, HS = 16, NP = 64, DA = 512, NH = 4, DV = 128, DIN = 2048;
constexpr int NE = 32, DFF = 1024, NASSIGN = T * 4;
constexpr int MPAD_MAX = NASSIGN + NE * 256, NTILE_MAX = MPAD_MAX / 256;
constexpr int NCHUNK = T / 64, CPB = SEQ / 64;
constexpr float EPS = 1e-6f;
constexpr float C2 = 0.125f * 1.4426950408889634f;
constexpr int NWAVES = 8, NTHREADS = 512;

constexpr size_t MiB = 1u << 20;
constexpr size_t WS_CTL = 0, CTL_ZERO_BYTES = 1 * MiB;
constexpr size_t WS_COS = 1 * MiB, WS_SIN = 2 * MiB;
constexpr size_t WS_SCAL = 3 * MiB;
constexpr size_t WS_KT = 4 * MiB, KT_STRIDE = 2 * MiB;
constexpr size_t WS_LAML = 8 * MiB, LAML_STRIDE = 32768;
constexpr size_t WS_GT = 16 * MiB, GT_STRIDE = 8 * MiB;
constexpr size_t WS_HT = 32 * MiB, HT_STRIDE = 8 * MiB;
constexpr size_t WS_WIN = 48 * MiB, WIN_STRIDE = 4 * MiB;
constexpr size_t WS_WGLU = 56 * MiB, WGLU_STRIDE = MiB / 2;
constexpr size_t WS_WOUT = 58 * MiB, WOUT_STRIDE = 2 * MiB;
constexpr size_t WS_WUP = 64 * MiB, WUP_STRIDE = 128 * MiB;
constexpr size_t WS_WDN = 320 * MiB, WDN_STRIDE = 64 * MiB;
constexpr size_t WS_XN = 448 * MiB;
constexpr size_t WS_U = 512 * MiB, WS_Q = 544 * MiB, WS_K = 576 * MiB, WS_V = 608 * MiB;
constexpr size_t WS_YG = 640 * MiB;
constexpr size_t WS_MIX = 672 * MiB;
constexpr size_t WS_S = 736 * MiB;
constexpr size_t WS_RSP = 744 * MiB;
constexpr size_t WS_TOPI = 746 * MiB, WS_TOPG = 747 * MiB, WS_TOKROW = 748 * MiB, WS_WGCNT = 749 * MiB;
constexpr size_t WS_ROWTOK = 750 * MiB, WS_ROWGATE = 751 * MiB, WS_TILEEXP = 752 * MiB;
constexpr size_t WS_ACT = 768 * MiB, WS_YB = 1040 * MiB, WS_END = 1312 * MiB;
constexpr int CW_BAR = 4096;

constexpr int LDS_CTL = 0;
constexpr int LDS_RING = 4096;
constexpr int LDS_BYTES = 147456;

__device__ __forceinline__ unsigned f2bf(float f) { unsigned u = __builtin_bit_cast(unsigned, f); return (u + 0x7fffu + ((u >> 16) & 1u)) >> 16; }
__device__ __forceinline__ unsigned pk2(float lo, float hi) { return f2bf(lo) | (f2bf(hi) << 16); }
__device__ __forceinline__ unsigned cvt_pk_bf16(float lo, float hi) { unsigned r; asm volatile("v_cvt_pk_bf16_f32 %0, %1, %2" : "=v"(r) : "v"(lo), "v"(hi)); return r; }
__device__ __forceinline__ float bf_lo(unsigned w) { return __builtin_bit_cast(float, w << 16); }
__device__ __forceinline__ float bf_hi(unsigned w) { return __builtin_bit_cast(float, w & 0xffff0000u); }
__device__ __forceinline__ float wave_sum(float v) {
#pragma unroll
    for (int o = 1; o < 64; o <<= 1) v += __shfl_xor(v, o);
    return v;
}
__device__ __forceinline__ float gelu_tanh(float x) {
    const float z = 0.7978845608028654f * (x + 0.044715f * x * x * x);
    return x / (1.f + __expf(-2.f * z));
}
__device__ __forceinline__ float sigmoidf(float v) { return 1.f / (1.f + __expf(-v)); }

#define XB_TMO      128
#define XB_XCNT(j)  (256  + 64 * (j))
#define XB_XSUB(j)  (1280 + 64 * (j))
#define XB_XGEN(j)  (2304 + 64 * (j))
#define XB_TOP      3328
#define XB_TOPGEN   3392
#define XCD_BAR_WORDS 3456
#define XB_SPIN_CAP (1u << 18)
__device__ __forceinline__ unsigned xb_ld(unsigned* p)              { return __hip_atomic_load(p, __ATOMIC_RELAXED, __HIP_MEMORY_SCOPE_AGENT); }
__device__ __forceinline__ unsigned xb_add(unsigned* p, unsigned v) { return __hip_atomic_fetch_add(p, v, __ATOMIC_RELAXED, __HIP_MEMORY_SCOPE_AGENT); }
__device__ __forceinline__ unsigned xb_xcc_id() { return (unsigned)__builtin_amdgcn_s_getreg((3 << 11) | 20) & 0xFu; }
#define XB_SPIN(cond, bar) do { unsigned _sp = 0; while (cond) { __builtin_amdgcn_s_sleep(1); \
    if ((++_sp & 255u) == 0u) { if (xb_ld(&(bar)[XB_TMO])) break; if (_sp > XB_SPIN_CAP) { atomicAdd(&(bar)[XB_TMO], 1u); break; } } } } while (0)
struct XcdBarrier { unsigned* bar; unsigned x; volatile LAS unsigned* st; };
__device__ __forceinline__ XcdBarrier xcd_barrier_post(unsigned* bar, volatile LAS unsigned* st) {
    XcdBarrier b; b.bar = bar; b.x = xb_xcc_id(); b.st = st;
    if (threadIdx.x == 0) (void)xb_add(&bar[XB_XCNT(b.x)], 1u);
    return b;
}
__device__ __forceinline__ void xcd_barrier_complete(unsigned* bar, unsigned x, unsigned& nloc, unsigned& nx) {
    const unsigned G = gridDim.x * gridDim.y * gridDim.z;
    unsigned sum, cnt, mine, sp = 0u;
    for (;;) {
        sum = 0u; cnt = 0u; mine = 0u;
#pragma unroll
        for (unsigned j = 0; j < 16; ++j) { const unsigned c = xb_ld(&bar[XB_XCNT(j)]); sum += c; cnt += (c > 0u) ? 1u : 0u; mine = (j == x) ? c : mine; }
        if (sum == G) break;
        __builtin_amdgcn_s_sleep(1);
        if ((++sp & 255u) == 0u) { if (xb_ld(&bar[XB_TMO])) break; if (sp > XB_SPIN_CAP) { atomicAdd(&bar[XB_TMO], 1u); break; } }
    }
    nloc = mine > 0u ? mine : 1u; nx = cnt > 0u ? cnt : 1u;
}
__device__ __forceinline__ void xcd_barrier(const XcdBarrier& b) {
    asm volatile("s_waitcnt vmcnt(0)" ::: "memory");
    __syncthreads();
    if (threadIdx.x == 0) {
        unsigned* bar = b.bar;
        __builtin_amdgcn_s_waitcnt(0);
        unsigned nloc = b.st[0], nx = b.st[1];
        if (nloc == 0u) { xcd_barrier_complete(bar, b.x, nloc, nx); b.st[0] = nloc; b.st[1] = nx; }
        const unsigned old = xb_add(&bar[XB_XSUB(b.x)], 1u);
        const unsigned gen = old / nloc;
        if (old + 1u == (gen + 1u) * nloc) {
            __builtin_amdgcn_fence(__ATOMIC_RELEASE, "agent");
            asm volatile("s_waitcnt vmcnt(0)" ::: "memory");
            const unsigned og = xb_add(&bar[XB_TOP], 1u);
            const unsigned tg = og / nx;
            if (og + 1u == (tg + 1u) * nx) xb_add(&bar[XB_TOPGEN], 1u);
            else XB_SPIN(xb_ld(&bar[XB_TOPGEN]) == tg, bar);
            __builtin_amdgcn_fence(__ATOMIC_ACQUIRE, "agent");
            xb_add(&bar[XB_XGEN(b.x)], 1u);
            asm volatile("s_waitcnt vmcnt(0)" ::: "memory");
        } else {
            XB_SPIN(xb_ld(&bar[XB_XGEN(b.x)]) == gen, bar);
            __builtin_amdgcn_fence(__ATOMIC_ACQUIRE, "agent");
            asm volatile("s_waitcnt vmcnt(0)" ::: "memory");
        }
    }
    __syncthreads();
}

namespace pg8 {
constexpr int BM = 256, BK = 64, HALF = 128, HTB = HALF * BK * 2, STAGE_BYTES = 8 * HTB;
__host__ __device__ __forceinline__ int lds_byte(int r, int c) { const int st = (r >> 4) * 2 + (c >> 5), rr = r & 15, cc = c & 31, ob = rr * 64 + cc * 2; return st * 1024 + (ob ^ (((ob >> 9) & 1) << 5)); }
__host__ __device__ __forceinline__ void stage_rc(int b, int& R, int& C) { const int st = b / 1024, sb = b % 1024, swz = sb ^ (((sb >> 9) & 1) << 5); R = (st >> 1) * 16 + swz / 64; C = (st & 1) * 32 + (swz % 64) / 2; }
__host__ __device__ __forceinline__ int perm32(int rho) { const int n = rho >> 4, i = rho & 15; return 8 * (i >> 2) + 4 * n + (i & 3); }

struct Unit { int pm, pn; };
template <class P>
__device__ __forceinline__ void gemm_phase(LAS unsigned char* lds, LAS unsigned char* ldsctl, P& S, const int tid) {
    const int wid = __builtin_amdgcn_readfirstlane(tid >> 6), lane = tid & 63, wr = wid >> 2, wc = wid & 3, fr = lane & 15, fq = lane >> 4;
    constexpr int K = P::K, nt = K / BK;
    int R0, C0, R1, C1; stage_rc(tid * 16, R0, C0); stage_rc(tid * 16 + 8192, R1, C1);
    unsigned voffB[2];
    {
        const int Rb0 = P::BROW64 ? (64 * (R0 >> 5) + perm32(R0 & 31)) : ((R0 & ~31) + perm32(R0 & 31));
        const int Rb1 = P::BROW64 ? (64 * (R1 >> 5) + perm32(R1 & 31)) : ((R1 & ~31) + perm32(R1 & 31));
        voffB[0] = (unsigned)(Rb0 * K + C0) * 2u; voffB[1] = (unsigned)(Rb1 * K + C1) * 2u;
    }
    const unsigned ldsw = (unsigned)wid * 1024u;
    const int aoff = lds_byte(wr * 64 + fr, fq * 8), boff = lds_byte(wc * 32 + fr, fq * 8);
#define PG8_SA(b, h) (((b) * 2 + (h)) * HTB)
#define PG8_SB(b, h) ((4 + (b) * 2 + (h)) * HTB)
#define PG8_STAGE_A(bufoff, vo, h, kofs) do { _Pragma("unroll") for (int _i = 0; _i < 2; ++_i) \
        __builtin_amdgcn_global_load_lds((const unsigned*)(Abase + (vo)[P::GATHER ? (h) : 0][_i] + ((kofs) + (P::GATHER ? 0u : (unsigned)(h) * HSTEPA))), (LAS unsigned*)(lds + (bufoff) + ldsw + _i * 8192), 16, 0, 0); } while (0)
#define PG8_STAGE_B(bufoff, gbase) do { _Pragma("unroll") for (int _i = 0; _i < 2; ++_i) \
        __builtin_amdgcn_global_load_lds((const unsigned*)((const char*)(gbase) + voffB[_i]), (LAS unsigned*)(lds + (bufoff) + ldsw + _i * 8192), 16, 0, 0); } while (0)
#define PG8_LDA(dst, b, h) do { _Pragma("unroll") for (int m = 0; m < 4; ++m) _Pragma("unroll") for (int k = 0; k < 2; ++k) dst[m][k] = *(const LAS bf16x8*)(lds + PG8_SA(b, h) + aoff + m * 2048 + k * 1024); } while (0)
#define PG8_LDB(dst, b, h) do { _Pragma("unroll") for (int n = 0; n < 2; ++n) _Pragma("unroll") for (int k = 0; k < 2; ++k) dst[n][k] = *(const LAS bf16x8*)(lds + PG8_SB(b, h) + boff + n * 2048 + k * 1024); } while (0)
#define PG8_MMA(ai, bj, At, Bt) do { __builtin_amdgcn_s_setprio(1); _Pragma("unroll") for (int m = 0; m < 4; ++m) _Pragma("unroll") for (int n = 0; n < 2; ++n) _Pragma("unroll") for (int k = 0; k < 2; ++k) \
        acc[ai][bj][m][n] = __builtin_amdgcn_mfma_f32_16x16x32_bf16(Bt[n][k], At[m][k], acc[ai][bj][m][n], 0, 0, 0); __builtin_amdgcn_s_setprio(0); } while (0)
#define PG8_WAIT_V(n) asm volatile("s_waitcnt vmcnt(" #n ")" ::: "memory")
#define PG8_WAIT_L(n) asm volatile("s_waitcnt lgkmcnt(" #n ")" ::: "memory")
#define PG8_BAR __builtin_amdgcn_s_barrier()
#define PG8_SCHED __builtin_amdgcn_sched_barrier(0)
    Unit cur, nxt; int ui = 0;
    if (!S.next(0, cur)) return;
    f32x4 acc[2][2][4][2];
#pragma unroll
    for (int a = 0; a < 2; ++a)
#pragma unroll
        for (int b = 0; b < 2; ++b)
#pragma unroll
            for (int m = 0; m < 4; ++m)
#pragma unroll
                for (int n = 0; n < 2; ++n) acc[a][b][m][n] = (f32x4){0.f, 0.f, 0.f, 0.f};
    bf16x8 At[4][2], B0[2][2], B1[2][2];
    const char* const Abase = S.a_base();
    unsigned voffA[2][2], voffAn[2][2];
    const char *cB0, *cB1;
    S.unit_begin(cur, ldsctl, tid, 0);
    S.a_offs(cur, R0, C0, R1, C1, voffA, true);
    S.b_ptrs(cur, cB0, cB1);
    constexpr unsigned kstep = BK * 2, HSTEPA = (unsigned)HALF * K * 2u;
    PG8_STAGE_B(PG8_SB(0, 0), cB0); PG8_STAGE_B(PG8_SB(0, 1), cB1); PG8_STAGE_A(PG8_SA(0, 0), voffA, 0, 0u); PG8_STAGE_A(PG8_SA(0, 1), voffA, 1, 0u);
    if (wr == 1) PG8_BAR;
    PG8_WAIT_V(2); PG8_BAR;
    PG8_STAGE_B(PG8_SB(1, 0), cB0 + kstep); PG8_STAGE_A(PG8_SA(1, 0), voffA, 0, kstep); PG8_STAGE_B(PG8_SB(1, 1), cB1 + kstep);
    PG8_WAIT_V(6); PG8_BAR;
    for (;;) {
        const bool has_next = S.next(ui + 1, nxt);
        const char *nB0 = cB0, *nB1 = cB1;
#pragma unroll
        for (int h = 0; h < 2; ++h)
#pragma unroll
            for (int i = 0; i < 2; ++i) voffAn[h][i] = voffA[h][i];
        if (has_next) { S.unit_begin(nxt, ldsctl, tid, (ui + 1) & 1); S.a_offs(nxt, R0, C0, R1, C1, voffAn, false); S.b_ptrs(nxt, nB0, nB1); }
        for (int t = 0; t < nt; t += 2) {
            const bool last = (t == nt - 2);
            S.midk(acc, cur, t, wr, fr, ldsctl, ui & 1);
            if (last) S.a_fix(voffAn);
            unsigned a2o[2][2];
#pragma unroll
            for (int h = 0; h < 2; ++h)
#pragma unroll
                for (int i = 0; i < 2; ++i) a2o[h][i] = last ? voffAn[h][i] : voffA[h][i] + (unsigned)(t + 2) * kstep;
            const char* b2h0 = last ? nB0 : cB0 + (size_t)(t + 2) * kstep; const char* b2h1 = last ? nB1 : cB1 + (size_t)(t + 2) * kstep;
            const unsigned a1k = (unsigned)(t + 1) * kstep;
            PG8_LDB(B0, 0, 0); PG8_LDB(B1, 0, 1); PG8_SCHED; PG8_LDA(At, 0, 0); PG8_STAGE_A(PG8_SA(1, 1), voffA, 1, a1k);
            PG8_WAIT_V(8); PG8_WAIT_L(0); PG8_BAR; PG8_MMA(0, 0, At, B0); PG8_MMA(0, 1, At, B1); PG8_BAR; PG8_SCHED;
            PG8_LDA(At, 0, 1); PG8_STAGE_B(PG8_SB(0, 0), b2h0); PG8_STAGE_B(PG8_SB(0, 1), b2h1); PG8_STAGE_A(PG8_SA(0, 0), a2o, 0, 0u);
            PG8_WAIT_V(8); PG8_WAIT_L(0); PG8_BAR; PG8_MMA(1, 0, At, B0); PG8_MMA(1, 1, At, B1); PG8_BAR; PG8_SCHED;
            PG8_LDB(B0, 1, 0); PG8_LDB(B1, 1, 1); PG8_SCHED; PG8_LDA(At, 1, 0); PG8_STAGE_A(PG8_SA(0, 1), a2o, 1, 0u);
            PG8_WAIT_V(8); PG8_WAIT_L(0); PG8_BAR; PG8_MMA(0, 0, At, B0); PG8_MMA(0, 1, At, B1); PG8_BAR; PG8_SCHED;
            PG8_LDA(At, 1, 1); PG8_STAGE_B(PG8_SB(1, 0), b2h0 + kstep); PG8_STAGE_B(PG8_SB(1, 1), b2h1 + kstep); PG8_STAGE_A(PG8_SA(1, 0), a2o, 0, kstep);
            PG8_WAIT_V(8); PG8_WAIT_L(0); PG8_BAR; PG8_MMA(1, 0, At, B0); PG8_MMA(1, 1, At, B1); PG8_BAR; PG8_SCHED;
        }
        if (wr == 0) PG8_BAR;
        S.epi(acc, cur, wr, wc, fr, fq);
        if (!has_next) break;
#pragma unroll
        for (int a = 0; a < 2; ++a)
#pragma unroll
            for (int b = 0; b < 2; ++b)
#pragma unroll
                for (int m = 0; m < 4; ++m)
#pragma unroll
                    for (int n = 0; n < 2; ++n) acc[a][b][m][n] = (f32x4){0.f, 0.f, 0.f, 0.f};
        cur = nxt; cB0 = nB0; cB1 = nB1; ++ui;
#pragma unroll
        for (int h = 0; h < 2; ++h)
#pragma unroll
            for (int i = 0; i < 2; ++i) voffA[h][i] = voffAn[h][i];
        if (wr == 1) PG8_BAR;
    }
    PG8_WAIT_V(0);
    PG8_BAR;
#undef PG8_SA
#undef PG8_SB
#undef PG8_STAGE_A
#undef PG8_STAGE_B
#undef PG8_LDA
#undef PG8_LDB
#undef PG8_MMA
#undef PG8_WAIT_V
#undef PG8_WAIT_L
#undef PG8_BAR
#undef PG8_SCHED
}
struct StaticOrder {
    int nM, nN, nwg, G, c;
    __device__ void init(int M, int N, int G_, int c_) { nM = M / BM; nN = N / BM; nwg = nM * nN; G = G_; c = c_; }
    __device__ bool next(int i, Unit& u) const {
        const long L = (long)i * G + c; if (L >= nwg) return false;
        int wgid = (int)L; { const int q = nwg / 8, r = nwg % 8, xcd = wgid % 8, off = wgid / 8; wgid = (xcd < r ? xcd * (q + 1) : r * (q + 1) + (xcd - r) * q) + off; }
        const int nig = 8 * nN, gid = wgid / nig, fm = gid * 8, gsz = (nM - fm) < 8 ? (nM - fm) : 8;
        u.pm = fm + ((wgid % nig) % gsz); u.pn = (wgid % nig) / gsz; return true;
    }
};
}

struct Frame {
    LAS unsigned char* lds; LAS unsigned char* ctl;
    unsigned char* ws;
    int tid, lane, wave, G, bx;
    float* out; const struct Args* ap; unsigned char* ws0; float* out0; size_t z;
};

struct Args { const float* in[28]; float* out; unsigned char* ws; int ph_lo, ph_hi; };
#define arg_in(i) (F.ap->in[i] + F.z)
__device__ __forceinline__ void phase_begin(Frame& F) {
    int t = F.tid; asm volatile("" : "+v"(t)); F.tid = t; F.lane = t & 63; F.wave = __builtin_amdgcn_readfirstlane(t >> 6);
    size_t z = 0; asm volatile("" : "+s"(z)); F.z = z; F.ws = F.ws0 + z; F.out = F.out0 + z;
    int bx = F.bx; asm volatile("" : "+s"(bx)); F.bx = bx;
}
struct PBase {
    static constexpr bool GATHER = false;
    __device__ __forceinline__ void unit_begin(const pg8::Unit&, LAS unsigned char*, int, int) {}
    __device__ __forceinline__ void midk(f32x4 (&)[2][2][4][2], const pg8::Unit&, int, int, int, LAS unsigned char*, int) {}
    __device__ __forceinline__ void a_fix(unsigned (&)[2][2]) {}
};
struct PInProj : PBase {
    static constexpr int K = 1024, BROW64 = 1;
    pg8::StaticOrder so; const char* A; const char* B; bf16_t* UQKV; const float *GQK, *COS, *SIN;
    __device__ __forceinline__ bool next(int i, pg8::Unit& u) const { return so.next(i, u); }
    __device__ __forceinline__ const char* a_base() const { return A; }
    __device__ __forceinline__ void a_offs(const pg8::Unit& u, int R0, int C0, int R1, int C1, unsigned (&vo)[2][2], bool) const {
#pragma unroll
        for (int h = 0; h < 2; ++h) { vo[h][0] = (unsigned)((u.pm * 256 + 128 * h + R0) * K + C0) * 2u; vo[h][1] = (unsigned)((u.pm * 256 + 128 * h + R1) * K + C1) * 2u; }
    }
    __device__ __forceinline__ void b_ptrs(const pg8::Unit& u, const char*& b0, const char*& b1) const { b0 = B + (size_t)u.pn * 256 * K * 2; b1 = b0 + (size_t)32 * K * 2; }
    __device__ __forceinline__ void epi(f32x4 (&acc)[2][2][4][2], const pg8::Unit& u, int wr, int wc, int fr, int fq) const {
        const int kind = u.pn >> 1;
        const int colg = (u.pn & 1) * 256 + 64 * wc;
        bf16_t* dst = UQKV + (size_t)kind * (size_t)(16u << 20);
        const int row0 = u.pm * 256 + wr * 64 + fr;
        if (kind == 0 || kind == 3) {
#pragma unroll
            for (int ai = 0; ai < 2; ++ai)
#pragma unroll
                for (int m = 0; m < 4; ++m) { bf16_t* rowp = dst + (size_t)(row0 + ai * 128 + m * 16) * 512 + colg + 8 * fq;
#pragma unroll
                    for (int bj = 0; bj < 2; ++bj) { const f32x4 v0 = acc[ai][bj][m][0], v1 = acc[ai][bj][m][1];
                        u32x4 w; w.x = cvt_pk_bf16(v0[0], v0[1]); w.y = cvt_pk_bf16(v0[2], v0[3]); w.z = cvt_pk_bf16(v1[0], v1[1]); w.w = cvt_pk_bf16(v1[2], v1[3]);
                        *(u32x4*)(rowp + 32 * bj) = w; } }
        } else {
            const float* g = GQK + (kind - 1) * 64; const float sc = kind == 1 ? C2 : 1.0f;
            f32x4 g0[2], g1[2];
#pragma unroll
            for (int n = 0; n < 2; ++n) { g0[n] = *(const f32x4*)(g + 8 * fq + 4 * n); g1[n] = *(const f32x4*)(g + 32 + 8 * fq + 4 * n); }
#pragma unroll
            for (int ai = 0; ai < 2; ++ai)
#pragma unroll
                for (int m = 0; m < 4; ++m) {
                    const int row = row0 + ai * 128 + m * 16; const int pos = row & (SEQ - 1);
                    float ss = 0.f;
#pragma unroll
                    for (int bj = 0; bj < 2; ++bj)
#pragma unroll
                        for (int n = 0; n < 2; ++n) { const f32x4 x = acc[ai][bj][m][n]; ss += (x[0] * x[0] + x[1] * x[1]) + (x[2] * x[2] + x[3] * x[3]); }
                    ss += __shfl_xor(ss, 16); ss += __shfl_xor(ss, 32);
                    const float r = rsqrtf(ss * (1.f / 64.f) + EPS) * sc;
                    f32x4 o1[2], o2[2];
#pragma unroll
                    for (int n = 0; n < 2; ++n) {
                        const f32x4 c = *(const f32x4*)(COS + (size_t)pos * 32 + 8 * fq + 4 * n), s = *(const f32x4*)(SIN + (size_t)pos * 32 + 8 * fq + 4 * n);
                        const f32x4 x1 = acc[ai][0][m][n] * g0[n] * r, x2 = acc[ai][1][m][n] * g1[n] * r;
                        o1[n] = x1 * c - x2 * s; o2[n] = x2 * c + x1 * s;
                    }
                    bf16_t* rowp = dst + (size_t)row * 512 + colg + 8 * fq;
                    u32x4 w; w.x = cvt_pk_bf16(o1[0][0], o1[0][1]); w.y = cvt_pk_bf16(o1[0][2], o1[0][3]); w.z = cvt_pk_bf16(o1[1][0], o1[1][1]); w.w = cvt_pk_bf16(o1[1][2], o1[1][3]);
                    *(u32x4*)(rowp) = w;
                    w.x = cvt_pk_bf16(o2[0][0], o2[0][1]); w.y = cvt_pk_bf16(o2[0][2], o2[0][3]); w.z = cvt_pk_bf16(o2[1][0], o2[1][1]); w.w = cvt_pk_bf16(o2[1][2], o2[1][3]);
                    *(u32x4*)(rowp + 32) = w;
                    asm volatile("" ::: "memory");
                }
        }
    }
};
struct PGlu : PBase {
    static constexpr int K = 512, BROW64 = 0;
    pg8::StaticOrder so; const char* A; const char* B; const bf16_t* YG; bf16_t* MIX; float* RSP;
    __device__ __forceinline__ bool next(int i, pg8::Unit& u) const { return so.next(i, u); }
    __device__ __forceinline__ const char* a_base() const { return A; }
    __device__ __forceinline__ void a_offs(const pg8::Unit& u, int R0, int C0, int R1, int C1, unsigned (&vo)[2][2], bool) const {
#pragma unroll
        for (int h = 0; h < 2; ++h) { vo[h][0] = (unsigned)((u.pm * 256 + 128 * h + R0) * K + C0) * 2u; vo[h][1] = (unsigned)((u.pm * 256 + 128 * h + R1) * K + C1) * 2u; }
    }
    __device__ __forceinline__ void b_ptrs(const pg8::Unit& u, const char*& b0, const char*& b1) const { b0 = B + (size_t)u.pn * 256 * K * 2; b1 = b0 + (size_t)128 * K * 2; }
    __device__ __forceinline__ void epi(f32x4 (&acc)[2][2][4][2], const pg8::Unit& u, int wr, int wc, int fr, int fq) const {
        const int row0 = u.pm * 256 + wr * 64 + fr, col0 = u.pn * 256 + wc * 32 + 8 * fq;
#pragma unroll
        for (int ai = 0; ai < 2; ++ai)
#pragma unroll
            for (int m = 0; m < 4; ++m) {
                const int row = row0 + ai * 128 + m * 16; float ss = 0.f;
#pragma unroll
                for (int bj = 0; bj < 2; ++bj) {
                    const u32x4 yw = *(const u32x4*)(YG + (size_t)row * 512 + col0 + 128 * bj);
                    const f32x4 a0 = acc[ai][bj][m][0], a1 = acc[ai][bj][m][1];
                    float z[8];
                    z[0] = bf_lo(yw.x) * sigmoidf(a0[0]); z[1] = bf_hi(yw.x) * sigmoidf(a0[1]); z[2] = bf_lo(yw.y) * sigmoidf(a0[2]); z[3] = bf_hi(yw.y) * sigmoidf(a0[3]);
                    z[4] = bf_lo(yw.z) * sigmoidf(a1[0]); z[5] = bf_hi(yw.z) * sigmoidf(a1[1]); z[6] = bf_lo(yw.w) * sigmoidf(a1[2]); z[7] = bf_hi(yw.w) * sigmoidf(a1[3]);
#pragma unroll
                    for (int i = 0; i < 8; ++i) ss += z[i] * z[i];
                    u32x4 w; w.x = cvt_pk_bf16(z[0], z[1]); w.y = cvt_pk_bf16(z[2], z[3]); w.z = cvt_pk_bf16(z[4], z[5]); w.w = cvt_pk_bf16(z[6], z[7]);
                    *(u32x4*)(MIX + (size_t)row * 1024 + col0 + 128 * bj) = w;
                }
                ss += __shfl_xor(ss, 16); ss += __shfl_xor(ss, 32);
                if (fq == 0) RSP[(size_t)row * 8 + u.pn * 4 + wc] = ss;
            }
    }
};
struct POut : PBase {
    static constexpr int K = 1024, BROW64 = 0;
    pg8::StaticOrder so; const char* A; const char* B; const float* RSP; const float* base; float* out;
    __device__ __forceinline__ bool next(int i, pg8::Unit& u) const { return so.next(i, u); }
    __device__ __forceinline__ const char* a_base() const { return A; }
    __device__ __forceinline__ void a_offs(const pg8::Unit& u, int R0, int C0, int R1, int C1, unsigned (&vo)[2][2], bool) const {
#pragma unroll
        for (int h = 0; h < 2; ++h) { vo[h][0] = (unsigned)((u.pm * 256 + 128 * h + R0) * K + C0) * 2u; vo[h][1] = (unsigned)((u.pm * 256 + 128 * h + R1) * K + C1) * 2u; }
    }
    __device__ __forceinline__ void b_ptrs(const pg8::Unit& u, const char*& b0, const char*& b1) const { b0 = B + (size_t)u.pn * 256 * K * 2; b1 = b0 + (size_t)128 * K * 2; }
    __device__ __forceinline__ void unit_begin(const pg8::Unit& u, LAS unsigned char* ldsctl, int tid, int slot) const {
        if (tid < 256) {
            const f32x4 p0 = *(const f32x4*)(RSP + (size_t)(u.pm * 256 + tid) * 8), p1 = *(const f32x4*)(RSP + (size_t)(u.pm * 256 + tid) * 8 + 4);
            const float ss = ((p0[0] + p0[1]) + (p0[2] + p0[3])) + ((p1[0] + p1[1]) + (p1[2] + p1[3]));
            ((LAS float*)(ldsctl + 1024 + slot * 1024))[tid] = rsqrtf(ss * (1.f / 512.f) + EPS);
        }
    }
    __device__ __forceinline__ void midk(f32x4 (&acc)[2][2][4][2], const pg8::Unit& u, int t, int wr, int fr, LAS unsigned char* ldsctl, int slot) const {
        if (t == 8) {
            const LAS float* rs = (const LAS float*)(ldsctl + 1024 + slot * 1024);
#pragma unroll
            for (int ai = 0; ai < 2; ++ai)
#pragma unroll
                for (int m = 0; m < 4; ++m) { const float r = rs[ai * 128 + wr * 64 + m * 16 + fr];
#pragma unroll
                    for (int bj = 0; bj < 2; ++bj)
#pragma unroll
                        for (int n = 0; n < 2; ++n) acc[ai][bj][m][n] *= r; }
        }
    }
    __device__ __forceinline__ void epi(f32x4 (&acc)[2][2][4][2], const pg8::Unit& u, int wr, int wc, int fr, int fq) const {
        const int row0 = u.pm * 256 + wr * 64 + fr, col0 = u.pn * 256 + wc * 32 + 8 * fq;
#pragma unroll
        for (int ai = 0; ai < 2; ++ai)
#pragma unroll
            for (int m = 0; m < 4; ++m) { const size_t off = (size_t)(row0 + ai * 128 + m * 16) * 1024 + col0;
#pragma unroll
                for (int bj = 0; bj < 2; ++bj)
#pragma unroll
                    for (int n = 0; n < 2; ++n) { const f32x4 bs = *(const f32x4*)(base + off + bj * 128 + 4 * n); *(f32x4*)(out + off + bj * 128 + 4 * n) = bs + acc[ai][bj][m][n]; }
                if (m & 1) asm volatile("" ::: "memory"); }
    }
};
template <int NN> struct MoeOrder {
    int j, wpx, s0, s1, s2, s3, n0, n1, n2, n3;
    __device__ __forceinline__ void init(int G, int c, const int* PST) {
#ifndef MOE_XA
#define MOE_XA 1
#endif
#ifndef MOE_CHUNKED
#define MOE_CHUNKED 0
#endif
        if (MOE_XA == 1 && (G & 7) == 0) { wpx = G >> 3; const int x = MOE_CHUNKED ? c / wpx : (c & 7); j = MOE_CHUNKED ? c % wpx : (c >> 3);
            s0 = PST[x] >> 8; n0 = (PST[x + 1] - PST[x]) >> 8; s1 = PST[x + 8] >> 8; n1 = (PST[x + 9] - PST[x + 8]) >> 8;
            s2 = PST[x + 16] >> 8; n2 = (PST[x + 17] - PST[x + 16]) >> 8; s3 = PST[x + 24] >> 8; n3 = (PST[x + 25] - PST[x + 24]) >> 8; }
        else { j = c; wpx = G; s0 = 0; n0 = PST[32] >> 8; s1 = s2 = s3 = 0; n1 = n2 = n3 = 0; }
        if (MOE_XA == 2 && (G & 7) == 0) { wpx = G >> 3; j = c >> 3; s1 = c & 7; n0 = PST[32] >> 8; }
    }
    __device__ __forceinline__ bool next(int i, pg8::Unit& u) const {
        const int q = i * wpx + j; int pml = q / NN; u.pn = q % NN;
        if (MOE_XA == 2) { u.pm = s1 + 8 * pml; return u.pm < n0; }
        if (pml < n0) { u.pm = s0 + pml; return true; } pml -= n0;
        if (pml < n1) { u.pm = s1 + pml; return true; } pml -= n1;
        if (pml < n2) { u.pm = s2 + pml; return true; } pml -= n2;
        if (pml < n3) { u.pm = s3 + pml; return true; }
        return false;
    }
};
struct PUp : PBase {
    static constexpr int K = 1024, BROW64 = 0; static constexpr bool GATHER = true;
    MoeOrder<8> mo; const char* A; const char* B; const int* ROWTOK; const int* TILEEXP; const float* bup; bf16_t* ACT;
    int idx[2][2]; int c0, c1;
    __device__ __forceinline__ bool next(int i, pg8::Unit& u) const { return mo.next(i, u); }
    __device__ __forceinline__ const char* a_base() const { return A; }
    __device__ __forceinline__ void a_offs(const pg8::Unit& u, int R0, int C0, int R1, int C1, unsigned (&vo)[2][2], bool first) {
        c0 = C0; c1 = C1;
        const int* rp = ROWTOK + u.pm * 256;
#pragma unroll
        for (int h = 0; h < 2; ++h) {
            asm volatile("global_load_dword %0, %1, off" : "=v"(idx[h][0]) : "v"(rp + 128 * h + R0) : "memory");
            asm volatile("global_load_dword %0, %1, off" : "=v"(idx[h][1]) : "v"(rp + 128 * h + R1) : "memory");
        }
        asm volatile("s_waitcnt vmcnt(0)" : "+v"(idx[0][0]), "+v"(idx[0][1]), "+v"(idx[1][0]), "+v"(idx[1][1]) :: "memory");
#pragma unroll
        for (int h = 0; h < 2; ++h) { vo[h][0] = (unsigned)(idx[h][0] * K + c0) * 2u; vo[h][1] = (unsigned)(idx[h][1] * K + c1) * 2u; }
    }
    __device__ __forceinline__ void b_ptrs(const pg8::Unit& u, const char*& b0, const char*& b1) const {
        const int e = TILEEXP[u.pm]; b0 = B + ((size_t)e * 2048 + (size_t)u.pn * 128) * K * 2; b1 = b0 + (size_t)1024 * K * 2; }
    __device__ __forceinline__ void epi(f32x4 (&acc)[2][2][4][2], const pg8::Unit& u, int wr, int wc, int fr, int fq) const {
        const int e = TILEEXP[u.pm];
        const int row0 = u.pm * 256 + wr * 64 + fr, col0 = u.pn * 128 + wc * 32 + 8 * fq;
        const float* bg = bup + (size_t)e * 2048 + col0; const float* bl = bg + 1024;
        f32x4 bgv[2], blv[2];
#pragma unroll
        for (int n = 0; n < 2; ++n) { bgv[n] = *(const f32x4*)(bg + 4 * n); blv[n] = *(const f32x4*)(bl + 4 * n); }
#pragma unroll
        for (int ai = 0; ai < 2; ++ai)
#pragma unroll
            for (int m = 0; m < 4; ++m) {
                float a[8];
#pragma unroll
                for (int n = 0; n < 2; ++n)
#pragma unroll
                    for (int j = 0; j < 4; ++j) {
                        float glu = acc[ai][0][m][n][j] + bgv[n][j], lin = acc[ai][1][m][n][j] + blv[n][j];
                        glu = fminf(glu, 7.0f); lin = fminf(fmaxf(lin, -7.0f), 7.0f);
                        a[4 * n + j] = glu * sigmoidf(1.702f * glu) * (lin + 1.0f);
                    }
                u32x4 w; w.x = cvt_pk_bf16(a[0], a[1]); w.y = cvt_pk_bf16(a[2], a[3]); w.z = cvt_pk_bf16(a[4], a[5]); w.w = cvt_pk_bf16(a[6], a[7]);
                *(u32x4*)(ACT + (size_t)(row0 + ai * 128 + m * 16) * 1024 + col0) = w;
            }
    }
};
struct PDown : PBase {
    static constexpr int K = 1024, BROW64 = 0;
    MoeOrder<4> mo; const char* A; const char* B; const int* TILEEXP; const float* bdn; const float* ROWGATE; bf16_t* YB;
    __device__ __forceinline__ bool next(int i, pg8::Unit& u) const { return mo.next(i, u); }
    __device__ __forceinline__ const char* a_base() const { return A; }
    __device__ __forceinline__ void a_offs(const pg8::Unit& u, int R0, int C0, int R1, int C1, unsigned (&vo)[2][2], bool) const {
#pragma unroll
        for (int h = 0; h < 2; ++h) { vo[h][0] = (unsigned)((u.pm * 256 + 128 * h + R0) * K + C0) * 2u; vo[h][1] = (unsigned)((u.pm * 256 + 128 * h + R1) * K + C1) * 2u; }
    }
    __device__ __forceinline__ void b_ptrs(const pg8::Unit& u, const char*& b0, const char*& b1) const {
        const int e = TILEEXP[u.pm]; b0 = B + ((size_t)e * 1024 + (size_t)u.pn * 256) * K * 2; b1 = b0 + (size_t)128 * K * 2; }
    __device__ __forceinline__ void epi(f32x4 (&acc)[2][2][4][2], const pg8::Unit& u, int wr, int wc, int fr, int fq) const {
        const int e = TILEEXP[u.pm];
        const int row0 = u.pm * 256 + wr * 64 + fr, col0 = u.pn * 256 + wc * 32 + 8 * fq;
        f32x4 bv[2][2];
#pragma unroll
        for (int bj = 0; bj < 2; ++bj)
#pragma unroll
            for (int n = 0; n < 2; ++n) bv[bj][n] = *(const f32x4*)(bdn + (size_t)e * 1024 + col0 + 128 * bj + 4 * n);
#pragma unroll
        for (int ai = 0; ai < 2; ++ai)
#pragma unroll
            for (int m = 0; m < 4; ++m) { const int row = row0 + ai * 128 + m * 16; const float gt = ROWGATE[row];
#pragma unroll
                for (int bj = 0; bj < 2; ++bj) { const f32x4 v0 = (acc[ai][bj][m][0] + bv[bj][0]) * gt, v1 = (acc[ai][bj][m][1] + bv[bj][1]) * gt;
                    u32x4 w; w.x = cvt_pk_bf16(v0[0], v0[1]); w.y = cvt_pk_bf16(v0[2], v0[3]); w.z = cvt_pk_bf16(v1[0], v1[1]); w.w = cvt_pk_bf16(v1[2], v1[3]);
                    *(u32x4*)(YB + (size_t)row * 1024 + col0 + 128 * bj) = w; } }
    }
};

struct TItem { const float* src; bf16_t* dst; const float* ksc; int N, K; };
__device__ __forceinline__ void titem_load(const TItem& it, f32x4 (&v)[16], int lane) {
    const float* p = it.src + (size_t)(lane >> 4) * it.N + 4 * (lane & 15);
#pragma unroll
    for (int i = 0; i < 16; ++i) v[i] = *(const f32x4*)(p + (size_t)(4 * i) * it.N);
}
__device__ __forceinline__ void titem_store(const TItem& it, f32x4 (&v)[16], LAS float* scr, int lane) {
    if (it.ksc) {
#pragma unroll
        for (int i = 0; i < 16; ++i) v[i] *= it.ksc[4 * i + (lane >> 4)];
    }
#pragma unroll
    for (int i = 0; i < 16; ++i) { LAS float* d = scr + (4 * i + (lane >> 4)) * 65 + 4 * (lane & 15); d[0] = v[i][0]; d[1] = v[i][1]; d[2] = v[i][2]; d[3] = v[i][3]; }
    asm volatile("s_waitcnt lgkmcnt(0)" ::: "memory");
    const int c = lane & 7;
#pragma unroll
    for (int j = 0; j < 8; ++j) { const int n = (lane >> 3) + 8 * j; const LAS float* s = scr + (8 * c) * 65 + n;
        u32x4 o; o.x = pk2(s[0 * 65], s[1 * 65]); o.y = pk2(s[2 * 65], s[3 * 65]); o.z = pk2(s[4 * 65], s[5 * 65]); o.w = pk2(s[6 * 65], s[7 * 65]);
        *(u32x4*)(it.dst + (size_t)n * it.K + 8 * c) = o; }
    asm volatile("s_waitcnt lgkmcnt(0)" ::: "memory");
}
__device__ __forceinline__ void rms_row_to_bf16(const f32x4 (&v)[4], const float* g, bf16_t* orow, int lane) {
    float s = 0.f;
#pragma unroll
    for (int j = 0; j < 4; ++j) s += (v[j][0] * v[j][0] + v[j][1] * v[j][1]) + (v[j][2] * v[j][2] + v[j][3] * v[j][3]);
    const float r = rsqrtf(wave_sum(s) * (1.f / D) + EPS);
#pragma unroll
    for (int j = 0; j < 4; ++j) { const f32x4 gg = *(const f32x4*)(g + 4 * lane + 256 * j); const f32x4 o = v[j] * gg * r;
        u32x2 w; w.x = cvt_pk_bf16(o[0], o[1]); w.y = cvt_pk_bf16(o[2], o[3]); *(u32x2*)(orow + 4 * lane + 256 * j) = w; }
}
struct Cplx { float re, im; };
__device__ __forceinline__ Cplx cmul(Cplx a, Cplx b) { return Cplx{a.re * b.re - a.im * b.im, a.re * b.im + a.im * b.re}; }
__device__ __forceinline__ Cplx lam_pow(float lr, float li, float step, int n) {
    const float mag = expf((float)n * lr * step); const double ang = (double)n * (double)li * (double)step;
    return Cplx{mag * (float)cos(ang), mag * (float)sin(ang)};
}
__device__ __forceinline__ Cplx bbar_factor(float lr, float li, float step) {
    const Cplx lb = lam_pow(lr, li, step, 1); const float nr = lb.re - 1.f, ni = lb.im, den = lr * lr + li * li;
    return Cplx{(nr * lr + ni * li) / den, (ni * lr - nr * li) / den};
}
__device__ __forceinline__ void p0_prologue(Frame& F) {
    const int gw = F.bx * NWAVES + F.wave, NGW = F.G * NWAVES, lane = F.lane;
    const int gt = F.bx * NTHREADS + F.tid, NGT = F.G * NTHREADS;
    unsigned char* ws = F.ws;
    {
        LAS float* scr = (LAS float*)(F.lds + LDS_RING) + F.wave * (64 * 65);
        constexpr int I_UP = 32 * 16 * 32, I_DN = 32 * 16 * 16, I_IN = 16 * 32, I_OUT = 16 * 16, I_GLU = 8 * 8;
        constexpr int PER_L = I_UP + I_DN + I_IN + I_OUT + I_GLU, TOTAL = DEPTH * PER_L;
        auto decode = [&](int it) -> TItem {
            TItem ti; const int l = it / PER_L; int r = it % PER_L; const float* W; bf16_t* WT; int K, N; ti.ksc = nullptr;
            if (r < I_UP) { const int e = r / 512; r %= 512; K = 1024; N = 2048; W = arg_in(24) + ((size_t)l * NE + e) * 1024 * 2048; WT = (bf16_t*)(ws + WS_WUP + l * WUP_STRIDE) + (size_t)e * 2048 * 1024; }
            else if ((r -= I_UP) < I_DN) { const int e = r / 256; r %= 256; K = 1024; N = 1024; W = arg_in(26) + ((size_t)l * NE + e) * 1024 * 1024; WT = (bf16_t*)(ws + WS_WDN + l * WDN_STRIDE) + (size_t)e * 1024 * 1024; }
            else if ((r -= I_DN) < I_IN) { K = 1024; N = 2048; W = arg_in(2) + (size_t)l * 1024 * 2048; WT = (bf16_t*)(ws + WS_WIN + l * WIN_STRIDE); }
            else if ((r -= I_IN) < I_OUT) { K = 1024; N = 1024; W = arg_in(20) + (size_t)l * 1024 * 1024; WT = (bf16_t*)(ws + WS_WOUT + l * WOUT_STRIDE); if ((r / 16) * 64 < DS) ti.ksc = arg_in(12) + l * DS + (r / 16) * 64; }
            else { r -= I_OUT; K = 512; N = 512; W = arg_in(11) + (size_t)l * 512 * 512; WT = (bf16_t*)(ws + WS_WGLU + l * WGLU_STRIDE); }
            const int nblk = N / 64, k0 = 64 * (r / nblk), n0 = 64 * (r % nblk);
            ti.src = W + (size_t)k0 * N + n0; ti.dst = WT + (size_t)n0 * K + k0; ti.N = N; ti.K = K; return ti;
        };
        f32x4 va[16], vb[16]; TItem ia, ib;
        int it = gw;
        if (it < TOTAL) { ia = decode(it); titem_load(ia, va, lane); }
        while (it < TOTAL) {
            const int itb = it + NGW;
            if (itb < TOTAL) { ib = decode(itb); titem_load(ib, vb, lane); }
            titem_store(ia, va, scr, lane);
            if (itb >= TOTAL) break;
            const int itc = itb + NGW;
            if (itc < TOTAL) { ia = decode(itc); titem_load(ia, va, lane); }
            titem_store(ib, vb, scr, lane);
            it = itc;
        }
    }
    for (int i = gt; i < SEQ * 32; i += NGT) {
        const int s = i >> 5, j = i & 31;
        const float inv = 1.0f / powf(10000.0f, (float)(2 * j) / 64.0f);
        const float ang = (float)s * inv;
        ((float*)(ws + WS_COS))[i] = (float)cos((double)ang); ((float*)(ws + WS_SIN))[i] = (float)sin((double)ang);
    }
    if (F.bx == 0 && F.wave < DEPTH) {
        const int l = F.wave;
        float a = arg_in(15)[l * 64 + lane] * arg_in(16)[l * 64 + lane], b = arg_in(17)[l * 64 + lane] * arg_in(18)[l * 64 + lane];
        a = wave_sum(a); b = wave_sum(b);
        float mq = fabsf(arg_in(13)[l * 64 + lane]), mk = fabsf(arg_in(14)[l * 64 + lane]);
#pragma unroll
        for (int o = 1; o < 64; o <<= 1) { mq = fmaxf(mq, __shfl_xor(mq, o)); mk = fmaxf(mk, __shfl_xor(mk, o)); }
        const float lambda_init = 0.8f - 0.6f * expf(-0.3f * (float)l);
        { float* gqk = (float*)(ws + WS_SCAL) + 64 + l * 128; gqk[lane] = arg_in(13)[l * 64 + lane]; gqk[64 + lane] = arg_in(14)[l * 64 + lane]; }
        if (lane == 0) { float* sc = (float*)(ws + WS_SCAL) + l * 4; sc[0] = expf(a) - expf(b) + lambda_init; sc[1] = C2 * 64.f * mq * mk * 1.02f + 0.5f; sc[2] = 1.0f - lambda_init; }
    }
    for (int l = 0; l < DEPTH; ++l) {
        const float* lam_re = arg_in(3) + l * NG * NP; const float* lam_im = arg_in(4) + l * NG * NP; const float* log_step = arg_in(5) + l * NG;
        const float* b_re = arg_in(6) + (size_t)l * NG * NP * HS; const float* b_im = arg_in(7) + (size_t)l * NG * NP * HS;
        const float* c_re = arg_in(8) + (size_t)l * NG * HS * NP; const float* c_im = arg_in(9) + (size_t)l * NG * HS * NP;
        bf16_t* KT = (bf16_t*)(ws + WS_KT + l * KT_STRIDE); bf16_t* GT = (bf16_t*)(ws + WS_GT + l * GT_STRIDE); bf16_t* HT = (bf16_t*)(ws + WS_HT + l * HT_STRIDE);
        float* LAML = (float*)(ws + WS_LAML + l * LAML_STRIDE);
        for (int i = gt; i < NG * 65 * HS * 4; i += NGT) {
            const int pq = i & 3, h = (i >> 2) % HS, slot = (i / (4 * HS)) % 65, g = i / (4 * HS * 65);
            float accv[16];
#pragma unroll
            for (int q = 0; q < 16; ++q) accv[q] = 0.f;
            if (slot > 0) {
                const float step = expf(log_step[g]);
                for (int pp = 0; pp < 16; ++pp) {
                    const int p = pq * 16 + pp;
                    const float lr = lam_re[g * NP + p], li = lam_im[g * NP + p];
                    const Cplx pw = lam_pow(lr, li, step, slot - 1), f = bbar_factor(lr, li, step);
                    const Cplx w = cmul(cmul(Cplx{c_re[(size_t)(g * HS + h) * NP + p], c_im[(size_t)(g * HS + h) * NP + p]}, pw), f);
#pragma unroll
                    for (int q = 0; q < 16; ++q) { const float br = b_re[(size_t)(g * NP + p) * HS + q], bi = b_im[(size_t)(g * NP + p) * HS + q]; accv[q] += w.re * br - w.im * bi; }
                }
            }
#pragma unroll
            for (int q = 0; q < 16; ++q) { accv[q] += __shfl_xor(accv[q], 1); accv[q] += __shfl_xor(accv[q], 2); }
            if (pq == 0) {
                u32x4 o0, o1; o0.x = pk2(accv[0], accv[1]); o0.y = pk2(accv[2], accv[3]); o0.z = pk2(accv[4], accv[5]); o0.w = pk2(accv[6], accv[7]);
                o1.x = pk2(accv[8], accv[9]); o1.y = pk2(accv[10], accv[11]); o1.z = pk2(accv[12], accv[13]); o1.w = pk2(accv[14], accv[15]);
                u32x4* dst = (u32x4*)(KT + ((size_t)(g * 65 + slot) * HS + h) * 16); dst[0] = o0; dst[1] = o1;
            }
        }
        for (int i = gt; i < NG * NP * 64; i += NGT) {
            const int s = i % 64, p = (i / 64) % NP, g = i / (64 * NP);
            const float step = expf(log_step[g]); const float lr = lam_re[g * NP + p], li = lam_im[g * NP + p];
            const Cplx w = cmul(lam_pow(lr, li, step, 63 - s), bbar_factor(lr, li, step));
            float vr[16], vi[16];
#pragma unroll
            for (int q = 0; q < 16; ++q) { const float br = b_re[(size_t)(g * NP + p) * HS + q], bi = b_im[(size_t)(g * NP + p) * HS + q]; vr[q] = w.re * br - w.im * bi; vi[q] = w.re * bi + w.im * br; }
            u32x4* dr = (u32x4*)(GT + ((size_t)(g * 128 + 2 * p) * 1024 + s * 16)); u32x4* di = (u32x4*)(GT + ((size_t)(g * 128 + 2 * p + 1) * 1024 + s * 16));
            u32x4 o; o.x = pk2(vr[0], vr[1]); o.y = pk2(vr[2], vr[3]); o.z = pk2(vr[4], vr[5]); o.w = pk2(vr[6], vr[7]); dr[0] = o;
            o.x = pk2(vr[8], vr[9]); o.y = pk2(vr[10], vr[11]); o.z = pk2(vr[12], vr[13]); o.w = pk2(vr[14], vr[15]); dr[1] = o;
            o.x = pk2(vi[0], vi[1]); o.y = pk2(vi[2], vi[3]); o.z = pk2(vi[4], vi[5]); o.w = pk2(vi[6], vi[7]); di[0] = o;
            o.x = pk2(vi[8], vi[9]); o.y = pk2(vi[10], vi[11]); o.z = pk2(vi[12], vi[13]); o.w = pk2(vi[14], vi[15]); di[1] = o;
        }
        for (int i = gt; i < NG * 64 * HS * 4; i += NGT) {
            const int pq = i & 3, h = (i >> 2) % HS, t = (i / (4 * HS)) % 64, g = i / (4 * HS * 64);
            const float step = expf(log_step[g]);
            bf16_t* dst = HT + ((size_t)(g * 1024 + t * 16 + h) * 128 + pq * 32);
            for (int pp = 0; pp < 16; pp += 4) {
                float v[8];
#pragma unroll
                for (int q = 0; q < 4; ++q) { const int p = pq * 16 + pp + q;
                    const Cplx w = cmul(Cplx{c_re[(size_t)(g * HS + h) * NP + p], c_im[(size_t)(g * HS + h) * NP + p]}, lam_pow(lam_re[g * NP + p], lam_im[g * NP + p], step, t + 1));
                    v[2 * q] = w.re; v[2 * q + 1] = -w.im; }
                u32x4 o; o.x = pk2(v[0], v[1]); o.y = pk2(v[2], v[3]); o.z = pk2(v[4], v[5]); o.w = pk2(v[6], v[7]);
                *(u32x4*)(dst + 2 * pp) = o;
            }
        }
        for (int i = gt; i < NG * NP; i += NGT) { const int g = i / NP; const Cplx w = lam_pow(lam_re[i], lam_im[i], expf(log_step[g]), 64); LAML[2 * i] = w.re; LAML[2 * i + 1] = w.im; }
    }
    for (int m = gw; m < T; m += NGW) {
        const f32x4* xr = (const f32x4*)(arg_in(0) + (size_t)m * D) + lane; f32x4 v[4];
#pragma unroll
        for (int j = 0; j < 4; ++j) v[j] = xr[64 * j];
        rms_row_to_bf16(v, arg_in(1), (bf16_t*)(ws + WS_XN) + (size_t)m * D, lane);
    }
}

__device__ __forceinline__ void s5a_phase(Frame& F, int l) {
    const bf16_t* GT = (const bf16_t*)(F.ws + WS_GT + l * GT_STRIDE); const bf16_t* U = (const bf16_t*)(F.ws + WS_U); float* S = (float*)(F.ws + WS_S);
    const int lane = F.lane, n = lane & 15, kq = lane >> 4;
    for (int uu = F.bx * NWAVES + F.wave; uu < NG * 32 * 2; uu += F.G * NWAVES) {
        const int g = uu >> 6, ntile = (uu >> 1) & 31, mh = uu & 1;
        const int chunk = ntile * 16 + n;
        const bf16_t* up = U + ((size_t)chunk * 64 + (kq >> 1)) * DS + g * 16 + 8 * (kq & 1);
        const bf16_t* gp = GT + ((size_t)(g * 128 + mh * 64 + n) * 1024 + 8 * kq);
        f32x4 acc[4];
#pragma unroll
        for (int mt = 0; mt < 4; ++mt) acc[mt] = (f32x4){0.f, 0.f, 0.f, 0.f};
#pragma unroll 4
        for (int ks = 0; ks < 32; ++ks) {
            const bf16x8 b = *(const bf16x8*)(up + (size_t)(2 * ks) * DS);
#pragma unroll
            for (int mt = 0; mt < 4; ++mt) { const bf16x8 a = *(const bf16x8*)(gp + (size_t)(mt * 16) * 1024 + 32 * ks); acc[mt] = __builtin_amdgcn_mfma_f32_16x16x32_bf16(a, b, acc[mt], 0, 0, 0); }
        }
#pragma unroll
        for (int mt = 0; mt < 4; ++mt) *(f32x4*)(S + ((size_t)chunk * NG + g) * 128 + mh * 64 + mt * 16 + 4 * kq) = acc[mt];
    }
}
__device__ __forceinline__ void s5c_phase(Frame& F, int l) {
    const bf16_t* KT = (const bf16_t*)(F.ws + WS_KT + l * KT_STRIDE); const bf16_t* HT = (const bf16_t*)(F.ws + WS_HT + l * HT_STRIDE);
    const float* LAML = (const float*)(F.ws + WS_LAML + l * LAML_STRIDE); const float* S = (const float*)(F.ws + WS_S);
    const bf16_t* U = (const bf16_t*)(F.ws + WS_U); bf16_t* YG = (bf16_t*)(F.ws + WS_YG); const float* dsk = arg_in(10) + l * DS;
    const int lane = F.lane, n = lane & 15, kq = lane >> 4, wave = F.wave;
    LAS unsigned char* ktl = F.lds + LDS_RING;
    LAS unsigned char* xs = F.lds + LDS_RING + 33792 + wave * 4096;
    LAS f32x2* EB = (LAS f32x2*)(F.lds + LDS_RING + 33792 + 8 * 4096);
    LAS f32x2* EH = EB + 512;
    for (int wu = F.bx; wu < NG * 8; wu += F.G) {
        const int g = wu >> 3, scq = wu & 7, b = scq >> 1, cbase = (scq & 1) * 64, scl = wave >> 1, par = wave & 1;
        __syncthreads();
        for (int i = F.tid; i < 65 * 32; i += NTHREADS) *(LAS u32x4*)(ktl + i * 16) = *(const u32x4*)(KT + (size_t)g * 65 * 256 + i * 8);
        const Cplx L = Cplx{LAML[(g * NP + lane) * 2], LAML[(g * NP + lane) * 2 + 1]};
        const float* sp = S + ((size_t)(b * CPB) * NG + g) * 128 + 2 * lane;
        {
            f32x2 sv[8];
#pragma unroll
            for (int j = 0; j < 8; ++j) sv[j] = *(const f32x2*)(sp + (size_t)(cbase + 8 * wave + j) * NG * 128);
            Cplx E{0.f, 0.f};
#pragma unroll
            for (int j = 0; j < 8; ++j) { const Cplx nx = cmul(L, E); E.re = nx.re + sv[j][0]; E.im = nx.im + sv[j][1]; }
            EB[wave * 64 + lane] = (f32x2){E.re, E.im};
            if (cbase) {
#pragma unroll
                for (int j = 0; j < 8; ++j) sv[j] = *(const f32x2*)(sp + (size_t)(8 * wave + j) * NG * 128);
                Cplx H{0.f, 0.f};
#pragma unroll
                for (int j = 0; j < 8; ++j) { const Cplx nx = cmul(L, H); H.re = nx.re + sv[j][0]; H.im = nx.im + sv[j][1]; }
                EH[wave * 64 + lane] = (f32x2){H.re, H.im};
            }
        }
        __syncthreads();
        const int c0 = cbase + 16 * scl;
        {
            const Cplx L2 = cmul(L, L), L4 = cmul(L2, L2), L8 = cmul(L4, L4);
            Cplx X{0.f, 0.f};
            if (cbase) {
#pragma unroll
                for (int w = 0; w < 8; ++w) { const f32x2 e = EH[w * 64 + lane]; const Cplx nx = cmul(L8, X); X.re = nx.re + e[0]; X.im = nx.im + e[1]; }
            }
            for (int w = 0; w < 2 * scl; ++w) { const f32x2 e = EB[w * 64 + lane]; const Cplx nx = cmul(L8, X); X.re = nx.re + e[0]; X.im = nx.im + e[1]; }
            f32x2 sv[16];
#pragma unroll
            for (int j = 0; j < 16; ++j) sv[j] = *(const f32x2*)(sp + (size_t)(c0 + j) * NG * 128);
#pragma unroll
            for (int j = 0; j < 16; ++j) {
                *(LAS unsigned*)(xs + j * 256 + 4 * lane) = pk2(X.re, X.im);
                const Cplx nx = cmul(L, X); X.re = nx.re + sv[j][0]; X.im = nx.im + sv[j][1];
            }
        }
        const int chunk = b * CPB + c0 + n;
        bf16x8 ub[32];
        {
            const bf16_t* up = U + ((size_t)chunk * 64 + (kq >> 1)) * DS + g * 16 + 8 * (kq & 1);
#pragma unroll
            for (int kp = 0; kp < 32; ++kp) ub[kp] = *(const bf16x8*)(up + (size_t)(2 * kp) * DS);
        }
        const LAS unsigned char* xbp = xs + n * 256 + 16 * kq;
        const f32x4 dv = *(const f32x4*)(dsk + g * 16 + 4 * kq);
        const bf16_t* hp = HT + ((size_t)(g * 1024 + n) * 128 + 8 * kq);
        const bf16_t* uq = U + (size_t)chunk * 64 * DS + g * 16 + 4 * kq;
        const LAS unsigned char* kbase = ktl + (n * 16 + 8 * (kq & 1)) * 2;
        bf16x8 ha[4]; u32x2 uw;
#pragma unroll
        for (int ks = 0; ks < 4; ++ks) ha[ks] = *(const bf16x8*)(hp + (size_t)(par * 16) * 128 + 32 * ks);
        uw = *(const u32x2*)(uq + (size_t)par * DS);
        for (int ti = 0; ti < 32; ++ti) {
            const int t = 2 * ti + par, tn = (ti < 31) ? t + 2 : t;
            bf16x8 hn[4]; u32x2 un;
#pragma unroll
            for (int ks = 0; ks < 4; ++ks) hn[ks] = *(const bf16x8*)(hp + (size_t)(tn * 16) * 128 + 32 * ks);
            un = *(const u32x2*)(uq + (size_t)tn * DS);
            f32x4 acc = (f32x4){0.f, 0.f, 0.f, 0.f};
            const int slot0 = t + 1 - (kq >> 1);
#pragma unroll
            for (int kp = 0; kp < 32; ++kp) {
                if (kp <= ti) { const bf16x8 a = *(const LAS bf16x8*)(kbase + (slot0 - 2 * kp) * 512); acc = __builtin_amdgcn_mfma_f32_16x16x32_bf16(a, ub[kp], acc, 0, 0, 0); }
            }
#pragma unroll
            for (int ks = 0; ks < 4; ++ks) acc = __builtin_amdgcn_mfma_f32_16x16x32_bf16(ha[ks], *(const LAS bf16x8*)(xbp + 64 * ks), acc, 0, 0, 0);
            const float y0 = acc[0] + dv[0] * bf_lo(uw.x), y1 = acc[1] + dv[1] * bf_hi(uw.x), y2 = acc[2] + dv[2] * bf_lo(uw.y), y3 = acc[3] + dv[3] * bf_hi(uw.y);
            u32x2 w; w.x = cvt_pk_bf16(gelu_tanh(y0), gelu_tanh(y1)); w.y = cvt_pk_bf16(gelu_tanh(y2), gelu_tanh(y3));
            *(u32x2*)(YG + ((size_t)chunk * 64 + t) * DS + g * 16 + 4 * kq) = w;
#pragma unroll
            for (int ks = 0; ks < 4; ++ks) ha[ks] = hn[ks];
            uw = un;
        }
    }
    __syncthreads();
}

namespace att {
constexpr int KSLOT = 16384, VSLOT = 16384, LDS_K = 0, LDS_V = 3 * KSLOT, LDS_WS = 6 * 16384, LDS_END = LDS_WS + 8 * 256;
constexpr int STG_ROW = 136;
__device__ __forceinline__ int crow(int r, int hi) { return (r & 3) + 8 * (r >> 2) + 4 * hi; }
__device__ __forceinline__ void glds16(const void* gsrc, unsigned lds_dst) { unsigned keep;
    asm volatile("s_mov_b32 %0, m0\n\ts_mov_b32 m0, %2\n\ts_nop 0\n\tglobal_load_lds_dwordx4 %1, off\n\ts_mov_b32 m0, %0" : "=&s"(keep) : "v"(gsrc), "s"(lds_dst) : "memory"); }
typedef __attribute__((address_space(3))) const char* lds_cptr;
typedef short v4i16_t __attribute__((ext_vector_type(4)));
__device__ __forceinline__ s16x4 vtr(lds_cptr p) { return __builtin_bit_cast(s16x4, __builtin_amdgcn_ds_read_tr16_b64_v4i16((__attribute__((address_space(3))) v4i16_t*)p)); }
#define ATT_WAIT_BAR(N) asm volatile("s_waitcnt vmcnt(" #N ") lgkmcnt(0)\n\ts_barrier" ::: "memory")

template <int MODE> __device__ __forceinline__ void attn_unit(int bh, int qb, const bf16_t* Q, const bf16_t* K, const bf16_t* V, bf16_t* MIX, const float* subg, float lam, float mshift, float oml,
                                          LAS unsigned char* shm, int tid) {
    const int lane = tid & 63, r32 = lane & 31, hi = lane >> 5; const int wid = __builtin_amdgcn_readfirstlane(tid >> 6);
    const int b = bh >> 2, h = bh & 3, m = wid & 1, qg = wid >> 1;
    const size_t rowbase = (size_t)b * SEQ; const int q0 = qb * 128;
    const int NT = 2 * qb + 2, cw = 2 * qb + (qg >> 1);
    const unsigned lds0 = (unsigned)(uintptr_t)shm;
    const bf16_t* k0src = K + (rowbase + lane) * DA + h * 128 + wid * 8;
    const bf16_t* k1src = k0src + 64;
    const bf16_t* v0src = V + (rowbase + 16 * (wid & 3) + (lane >> 2)) * DA + h * 128 + (wid >> 2) * 32 + (lane & 3) * 8;
    const bf16_t* v1src = v0src + 64;
    const unsigned kdst = lds0 + LDS_K + wid * 1024, vdst = lds0 + LDS_V + wid * 1024;
#define ATT_DMA(t, slot) do { const size_t _o = (size_t)(t) * 64 * DA; \
        glds16(k0src + _o, (unsigned)__builtin_amdgcn_readfirstlane(kdst + (slot) * KSLOT)); glds16(k1src + _o, (unsigned)__builtin_amdgcn_readfirstlane(kdst + (slot) * KSLOT + 8192)); \
        glds16(v0src + _o, (unsigned)__builtin_amdgcn_readfirstlane(vdst + (slot) * VSLOT)); glds16(v1src + _o, (unsigned)__builtin_amdgcn_readfirstlane(vdst + (slot) * VSLOT + 8192)); } while (0)
    bf16x8 qr[4];
    { const bf16_t* Qw = Q + (rowbase + q0 + qg * 32 + r32) * DA + h * 128 + m * 64 + hi * 8;
#pragma unroll
      for (int d0 = 0; d0 < 4; ++d0) qr[d0] = *(const bf16x8*)(Qw + d0 * 16); }
#ifndef ATT_GRP
#define ATT_GRP (wid & 1)
#endif
    const int grp = ATT_GRP;
#define ATT_DMA_K(t, slot) do { if (MODE & 1) break; const size_t _o = (size_t)(t) * 64 * DA; \
        glds16(k0src + _o, (unsigned)__builtin_amdgcn_readfirstlane(kdst + (slot) * KSLOT)); glds16(k1src + _o, (unsigned)__builtin_amdgcn_readfirstlane(kdst + (slot) * KSLOT + 8192)); } while (0)
#define ATT_DMA_V(t, slot) do { if (MODE & 1) break; const size_t _o = (size_t)(t) * 64 * DA; \
        glds16(v0src + _o, (unsigned)__builtin_amdgcn_readfirstlane(vdst + (slot) * VSLOT)); glds16(v1src + _o, (unsigned)__builtin_amdgcn_readfirstlane(vdst + (slot) * VSLOT + 8192)); } while (0)
    ATT_DMA_K(0, 0); ATT_DMA_V(0, 0); ATT_DMA_K(1, 1); ATT_DMA_V(1, 1);
    f32x16 o[4];
#pragma unroll
    for (int d = 0; d < 4; ++d)
#pragma unroll
        for (int r = 0; r < 16; ++r) o[d][r] = 0.f;
    float l_reg = 0.f;
    const f32x16 zero16 = {0.f, 0.f, 0.f, 0.f, 0.f, 0.f, 0.f, 0.f, 0.f, 0.f, 0.f, 0.f, 0.f, 0.f, 0.f, 0.f};
    (void)mshift;
    const lds_cptr shm3 = (lds_cptr)shm;
    const lds_cptr kp0 = shm3 + LDS_K + m * 8192 + hi * 1024 + r32 * 16;
    const lds_cptr vp0 = shm3 + LDS_V + ((lane >> 4) & 1) * 32 + (lane & 3) * 8 + (4 * hi + ((lane & 15) >> 2)) * 64;
    u32x4 pw[4];
#pragma unroll
    for (int q = 0; q < 4; ++q) pw[q] = (u32x4){0u, 0u, 0u, 0u};
#define ATT_SB() __builtin_amdgcn_sched_barrier(0)
#define ATT_QKEXP(sl) do { if (MODE & 2) break; const lds_cptr kp = kp0 + (sl) * KSLOT; bf16x8 kf[8]; \
        ATT_SB(); \
        _Pragma("unroll") for (int j = 0; j < 4; ++j) { kf[2 * j] = *(const __attribute__((address_space(3))) bf16x8*)(kp + j * 2048); kf[2 * j + 1] = *(const __attribute__((address_space(3))) bf16x8*)(kp + j * 2048 + 512); } \
        ATT_SB(); \
        f32x16 p0 = __builtin_amdgcn_mfma_f32_32x32x16_bf16(kf[0], qr[0], zero16, 0, 0, 0); \
        f32x16 p1 = __builtin_amdgcn_mfma_f32_32x32x16_bf16(kf[1], qr[0], zero16, 0, 0, 0); \
        _Pragma("unroll") for (int d0 = 1; d0 < 4; ++d0) { p0 = __builtin_amdgcn_mfma_f32_32x32x16_bf16(kf[2 * d0], qr[d0], p0, 0, 0, 0); p1 = __builtin_amdgcn_mfma_f32_32x32x16_bf16(kf[2 * d0 + 1], qr[d0], p1, 0, 0, 0); } \
        ATT_SB(); \
        float sacc = 0.f; \
        _Pragma("unroll") for (int r = 0; r < 16; ++r) { p0[r] = __builtin_amdgcn_exp2f(p0[r]); p1[r] = __builtin_amdgcn_exp2f(p1[r]); sacc += p0[r] + p1[r]; } \
        l_reg += sacc; \
        _Pragma("unroll") for (int q = 0; q < 4; ++q) { pw[0][q] = cvt_pk_bf16(p0[2 * q], p0[2 * q + 1]); pw[1][q] = cvt_pk_bf16(p0[8 + 2 * q], p0[8 + 2 * q + 1]); \
                                                        pw[2][q] = cvt_pk_bf16(p1[2 * q], p1[2 * q + 1]); pw[3][q] = cvt_pk_bf16(p1[8 + 2 * q], p1[8 + 2 * q + 1]); } } while (0)
#define ATT_VRD(buf, d) do { _Pragma("unroll") for (int ks = 0; ks < 4; ++ks) { buf[0][ks] = vtr(vp + (d) * 4096 + ks * 1024); buf[1][ks] = vtr(vp + (d) * 4096 + ks * 1024 + 512); } } while (0)
#define ATT_VMM(buf, d) do { _Pragma("unroll") for (int ks = 0; ks < 4; ++ks) { \
        const bf16x8 vf = (bf16x8){buf[0][ks][0], buf[0][ks][1], buf[0][ks][2], buf[0][ks][3], buf[1][ks][0], buf[1][ks][1], buf[1][ks][2], buf[1][ks][3]}; \
        o[d] = __builtin_amdgcn_mfma_f32_32x32x16_bf16(__builtin_bit_cast(bf16x8, pw[ks]), vf, o[d], 0, 0, 0); } } while (0)
#define ATT_PV(sl) do { if (MODE & 4) break; const lds_cptr vp = vp0 + (sl) * VSLOT; s16x4 va[2][4], vb[2][4]; \
        ATT_SB(); ATT_VRD(va, 0); ATT_SB(); ATT_VRD(vb, 1); ATT_SB(); ATT_VMM(va, 0); ATT_SB(); ATT_VRD(va, 2); ATT_SB(); ATT_VMM(vb, 1); ATT_SB(); \
        ATT_VRD(vb, 3); ATT_SB(); ATT_VMM(va, 2); ATT_SB(); ATT_VMM(vb, 3); ATT_SB(); } while (0)
#ifndef ATT_TWO_GROUP
#define ATT_TWO_GROUP 0
#endif
    int sk = 0, skm1 = 2;
    if (ATT_TWO_GROUP) {
        for (int k = 0; k <= NT; ++k) {
            if (k + 1 < NT) { ATT_WAIT_BAR(4); } else { ATT_WAIT_BAR(0); }
            if (k + 2 < NT) ATT_DMA_K(k + 2, skm1);
            if (grp == 0) { if (k <= cw) ATT_QKEXP(sk); }
            else          { if (k >= 1 && k - 1 <= cw) ATT_PV(skm1); }
            if (k == NT) break;
            if (k + 2 < NT) { ATT_WAIT_BAR(4); } else { ATT_WAIT_BAR(0); }
            if (k + 2 < NT) ATT_DMA_V(k + 2, skm1);
            if (grp == 0) { if (k <= cw) ATT_PV(sk); }
            else          { if (k <= cw) ATT_QKEXP(sk); }
            skm1 = sk; sk = (sk == 2) ? 0 : sk + 1;
        }
    } else {
        for (int k = 0; k < NT; ++k) {
            if (k + 1 < NT) { ATT_WAIT_BAR(4); } else { ATT_WAIT_BAR(0); }
            if (k + 2 < NT) { ATT_DMA_K(k + 2, skm1); ATT_DMA_V(k + 2, skm1); }
            if (k <= cw) { ATT_QKEXP(sk); ATT_PV(sk); }
            skm1 = sk; sk = (sk == 2) ? 0 : sk + 1;
        }
    }
#undef ATT_QKEXP
#undef ATT_PV
#undef ATT_VRD
#undef ATT_VMM
#undef ATT_SB
#undef ATT_DMA_K
#undef ATT_DMA_V
    { auto rr = __builtin_amdgcn_permlane32_swap(__float_as_uint(l_reg), __float_as_uint(l_reg), false, false); l_reg = __uint_as_float(rr[0]) + __uint_as_float(rr[1]); }
    LAS float* wsf = (LAS float*)(shm + LDS_WS) + wid * 64;
    if (hi == 0) wsf[r32] = l_reg;
    ATT_WAIT_BAR(0);
    float rli[16];
    const float scl = m ? lam : 1.0f;
#pragma unroll
    for (int r = 0; r < 16; ++r) rli[r] = scl * __builtin_amdgcn_rcpf(wsf[crow(r, hi)]);
    LAS float* stg = (LAS float*)shm + qg * (32 * STG_ROW);
    if (m == 1) {
#pragma unroll
        for (int r = 0; r < 16; ++r)
#pragma unroll
            for (int d = 0; d < 4; ++d) stg[crow(r, hi) * STG_ROW + d * 32 + r32] = o[d][r] * rli[r];
    }
    ATT_WAIT_BAR(0);
    if (m == 0) {
#pragma unroll
        for (int r = 0; r < 16; ++r)
#pragma unroll
            for (int d = 0; d < 4; ++d) { LAS float* p = stg + crow(r, hi) * STG_ROW + d * 32 + r32; *p = o[d][r] * rli[r] - *p; }
    }
    ATT_WAIT_BAR(0);
    {
        const int row = 16 * m + (lane >> 2), qt = lane & 3;
        const LAS float* p = stg + row * STG_ROW + qt * 32;
        f32x4 v[8]; float ss = 0.f;
#pragma unroll
        for (int i = 0; i < 8; ++i) { v[i] = *(const LAS f32x4*)(p + 4 * i); ss += (v[i][0] * v[i][0] + v[i][1] * v[i][1]) + (v[i][2] * v[i][2] + v[i][3] * v[i][3]); }
        ss += __shfl_xor(ss, 1); ss += __shfl_xor(ss, 2);
        const float rn = rsqrtf(ss * (1.f / 128.f) + EPS) * oml;
        bf16_t* dst = MIX + (rowbase + q0 + qg * 32 + row) * D + DS + h * 128 + qt * 32;
#pragma unroll
        for (int i = 0; i < 4; ++i) {
            const f32x4 g0 = *(const f32x4*)(subg + qt * 32 + 8 * i), g1 = *(const f32x4*)(subg + qt * 32 + 8 * i + 4);
            const f32x4 a = v[2 * i] * g0 * rn, c = v[2 * i + 1] * g1 * rn;
            u32x4 w; w.x = cvt_pk_bf16(a[0], a[1]); w.y = cvt_pk_bf16(a[2], a[3]); w.z = cvt_pk_bf16(c[0], c[1]); w.w = cvt_pk_bf16(c[2], c[3]);
            *(u32x4*)(dst + 8 * i) = w;
        }
    }
    ATT_WAIT_BAR(0);
#undef ATT_DMA
}
}
template <int MODE> __device__ __forceinline__ void attn_phase(Frame& F, int l) {
    const bf16_t* Q = (const bf16_t*)(F.ws + WS_Q); const bf16_t* K = (const bf16_t*)(F.ws + WS_K); const bf16_t* V = (const bf16_t*)(F.ws + WS_V);
    bf16_t* MIX = (bf16_t*)(F.ws + WS_MIX);
    const float* sc = (const float*)(F.ws + WS_SCAL) + l * 4;
    const float lam = sc[0], mshift = sc[1], oml = sc[2];
    const float* subg = arg_in(19) + l * DV;
    const int G = F.G;
#ifndef ATT_XA
#define ATT_XA 1
#endif
    const bool xa = ATT_XA && (G & 7) == 0;
    const int x = F.bx & 7, j = F.bx >> 3, wpx = xa ? (G >> 3) : 1;
    const int npair = xa ? (32 - j + wpx - 1) / wpx : 0;
    const int nit = xa ? 4 * npair : (1024 - F.bx + G - 1) / G;
#pragma unroll 1
    for (int it = 0; it < nit; ++it) {
        int bh, qb;
        if (xa) { const int r = it / (2 * npair), rem = it % (2 * npair), sidx = j + (rem >> 1) * wpx; bh = 2 * x + r; qb = (rem & 1) ? sidx : 63 - sidx; }
        else { const int v = F.bx + it * G; bh = v >> 6; qb = v & 63; }
        att::attn_unit<MODE>(bh, qb, Q, K, V, MIX, subg, lam, mshift, oml, F.lds + LDS_RING, F.tid);
    }
}

__device__ __forceinline__ void router_phase(Frame& F, int l) {
    const float* h1 = F.out; const float* g = arg_in(21) + (size_t)l * D; const float* wr = arg_in(22) + (size_t)l * D * NE; const float* br = arg_in(23) + l * NE;
    bf16_t* XN = (bf16_t*)(F.ws + WS_XN); int* TOPI = (int*)(F.ws + WS_TOPI); float* TOPG = (float*)(F.ws + WS_TOPG); int* WGCNT = (int*)(F.ws + WS_WGCNT);
    const int lane = F.lane, tid = F.tid;
    LAS unsigned char* wl = F.lds + LDS_RING;
    LAS int* cnt = (LAS int*)(F.ctl + 256);
    __syncthreads();
    for (int i = tid; i < D * 8; i += NTHREADS) { const int k = i >> 3, c = i & 7; const f32x4 w = *(const f32x4*)(wr + (size_t)k * NE + 4 * c);
        *(LAS f32x4*)(wl + (k ^ ((k >> 5) & 1)) * 128 + (((c + (k >> 2)) & 7) * 16)) = w; }
    if (tid < 32) cnt[tid] = 0;
    __syncthreads();
    const float bias = br[lane >> 1];
    for (int wgu = F.bx; wgu < 256; wgu += F.G) {
        if (wgu != F.bx) { __syncthreads(); if (tid < 32) cnt[tid] = 0; __syncthreads(); }
        for (int ri = 0; ri < 16; ++ri) {
            const int row = wgu * 128 + F.wave * 16 + ri;
            const f32x4* xr = (const f32x4*)(h1 + (size_t)row * D) + lane; f32x4 v[4]; float s = 0.f;
#pragma unroll
            for (int j = 0; j < 4; ++j) { v[j] = xr[64 * j]; s += (v[j][0] * v[j][0] + v[j][1] * v[j][1]) + (v[j][2] * v[j][2] + v[j][3] * v[j][3]); }
            const float r = rsqrtf(wave_sum(s) * (1.f / D) + EPS);
            float acc[32];
#pragma unroll
            for (int e = 0; e < 32; ++e) acc[e] = 0.f;
#pragma unroll
            for (int j = 0; j < 4; ++j) {
                const f32x4 gg = *(const f32x4*)(g + 4 * lane + 256 * j); const f32x4 xn = v[j] * gg * r;
                u32x2 w; w.x = cvt_pk_bf16(xn[0], xn[1]); w.y = cvt_pk_bf16(xn[2], xn[3]); *(u32x2*)(XN + (size_t)row * D + 4 * lane + 256 * j) = w;
#pragma unroll
                for (int i = 0; i < 4; ++i) {
                    const int k = 4 * lane + 256 * j + i; const LAS unsigned char* rowp = wl + (k ^ ((k >> 5) & 1)) * 128;
#pragma unroll
                    for (int c = 0; c < 8; ++c) { const f32x4 w4 = *(const LAS f32x4*)(rowp + (((c + (k >> 2)) & 7) * 16));
                        acc[4 * c] += xn[i] * w4[0]; acc[4 * c + 1] += xn[i] * w4[1]; acc[4 * c + 2] += xn[i] * w4[2]; acc[4 * c + 3] += xn[i] * w4[3]; }
                }
            }
            float v16[16], v8[8], v4[4], v2[2], v1;
#pragma unroll
            for (int i = 0; i < 16; ++i) { const bool up = lane & 32; const float keep = up ? acc[16 + i] : acc[i], send = up ? acc[i] : acc[16 + i]; v16[i] = keep + __shfl_xor(send, 32); }
#pragma unroll
            for (int i = 0; i < 8; ++i) { const bool up = lane & 16; const float keep = up ? v16[8 + i] : v16[i], send = up ? v16[i] : v16[8 + i]; v8[i] = keep + __shfl_xor(send, 16); }
#pragma unroll
            for (int i = 0; i < 4; ++i) { const bool up = lane & 8; const float keep = up ? v8[4 + i] : v8[i], send = up ? v8[i] : v8[4 + i]; v4[i] = keep + __shfl_xor(send, 8); }
#pragma unroll
            for (int i = 0; i < 2; ++i) { const bool up = lane & 4; const float keep = up ? v4[2 + i] : v4[i], send = up ? v4[i] : v4[2 + i]; v2[i] = keep + __shfl_xor(send, 4); }
            { const bool up = lane & 2; const float keep = up ? v2[1] : v2[0], send = up ? v2[0] : v2[1]; v1 = keep + __shfl_xor(send, 2); }
            v1 += __shfl_xor(v1, 1);
            float mylogit = v1 + bias; const int mye = lane >> 1;
            float val[4]; int sel[4];
#pragma unroll
            for (int k = 0; k < 4; ++k) {
                float bv = mylogit; int be = mye;
#pragma unroll
                for (int o = 2; o < 64; o <<= 1) { const float ov = __shfl_xor(bv, o); const int oe = __shfl_xor(be, o); if (ov > bv || (ov == bv && oe < be)) { bv = ov; be = oe; } }
                val[k] = bv; sel[k] = be; if (mye == be) mylogit = -INFINITY;
            }
            float ex[4], sum = 0.f;
#pragma unroll
            for (int k = 0; k < 4; ++k) { ex[k] = __expf(val[k] - val[0]); sum += ex[k]; }
            if (lane < 4) {
                const int e = lane == 0 ? sel[0] : lane == 1 ? sel[1] : lane == 2 ? sel[2] : sel[3];
                const float gte = (lane == 0 ? ex[0] : lane == 1 ? ex[1] : lane == 2 ? ex[2] : ex[3]) / sum;
                const int pos = __hip_atomic_fetch_add(cnt + e, 1, __ATOMIC_RELAXED, __HIP_MEMORY_SCOPE_WORKGROUP);
                TOPI[row * 4 + lane] = e | (pos << 8); TOPG[row * 4 + lane] = gte;
            }
        }
        __syncthreads();
        if (tid < 32) WGCNT[wgu * 32 + tid] = cnt[tid];
    }
    __syncthreads();
}
__device__ __forceinline__ void routing_phase(Frame& F) {
    const int* TOPI = (const int*)(F.ws + WS_TOPI); const float* TOPG = (const float*)(F.ws + WS_TOPG); const int* WGCNT = (const int*)(F.ws + WS_WGCNT);
    int* TOKROW = (int*)(F.ws + WS_TOKROW); int* ROWTOK = (int*)(F.ws + WS_ROWTOK); float* ROWGATE = (float*)(F.ws + WS_ROWGATE); int* TILEEXP = (int*)(F.ws + WS_TILEEXP);
    const int tid = F.tid;
    LAS int* tot = (LAS int*)(F.lds + LDS_RING);
    LAS int* pst = tot + 32;
    LAS int* mypre = pst + 40;
    LAS int* part = mypre + 32;
    for (int wgu = F.bx; wgu < 256; wgu += F.G) {
        __syncthreads();
        {
            const int e = tid & 31, wq = tid >> 5; int a = 0, mine = 0;
#pragma unroll
            for (int j = 0; j < 16; ++j) { const int w = wq * 16 + j; const int c = WGCNT[w * 32 + e]; a += c; if (w < wgu) mine += c; }
            part[wq * 32 + e] = a; part[512 + wq * 32 + e] = mine;
        }
        __syncthreads();
        if (tid < 32) { int a = 0, mine = 0;
#pragma unroll
            for (int q = 0; q < 16; ++q) { a += part[q * 32 + tid]; mine += part[512 + q * 32 + tid]; }
            tot[tid] = a; mypre[tid] = mine; }
        __syncthreads();
        if (tid == 0) { int a = 0; for (int e = 0; e < 32; ++e) { pst[e] = a; a += (tot[e] + 255) & ~255; } pst[32] = a; }
        __syncthreads();
        {
            const int t = wgu * 128 + (tid >> 2), k = tid & 3;
            const int w = TOPI[t * 4 + k]; const int e = w & 255, pos = w >> 8;
            const int dest = pst[e] + mypre[e] + pos;
            ROWTOK[dest] = t; ROWGATE[dest] = TOPG[t * 4 + k]; TOKROW[t * 4 + k] = dest;
        }
        if (wgu < 32) {
            const int e = wgu; const int beg = pst[e] + tot[e], end = pst[e + 1];
            for (int r = beg + tid; r < end; r += NTHREADS) { ROWTOK[r] = 0; ROWGATE[r] = 0.f; }
        }
        if (wgu == 0) {
            const int ntiles = pst[32] >> 8;
            for (int pm = tid; pm < ntiles; pm += NTHREADS) { int e = 0; for (int q = 1; q < 32; ++q) if ((pm << 8) >= pst[q]) e = q; TILEEXP[pm] = e; }
            if (tid == 0) TILEEXP[1023] = ntiles;
            if (tid < 33) TILEEXP[768 + tid] = pst[tid];
        }
    }
    __syncthreads();
}
struct CRow { f32x4 h[4]; u32x4 y[4][2]; };
__device__ __forceinline__ void crow_load(CRow& r, const float* out, const bf16_t* YB, const int* TOKROW, int m, int lane) {
    const float* hr = out + (size_t)m * D + 8 * lane;
    r.h[0] = *(const f32x4*)(hr); r.h[1] = *(const f32x4*)(hr + 4); r.h[2] = *(const f32x4*)(hr + 512); r.h[3] = *(const f32x4*)(hr + 516);
    const int4 tr = *(const int4*)(TOKROW + m * 4);
    const int rows[4] = {tr.x, tr.y, tr.z, tr.w};
#pragma unroll
    for (int k = 0; k < 4; ++k) { const bf16_t* yr = YB + (size_t)rows[k] * D + 8 * lane; r.y[k][0] = *(const u32x4*)(yr); r.y[k][1] = *(const u32x4*)(yr + 512); }
}
__device__ __forceinline__ void crow_finish(CRow& r, float* out, bf16_t* XN, const float* gnext, int m, int lane) {
#pragma unroll
    for (int k = 0; k < 4; ++k)
#pragma unroll
        for (int hf = 0; hf < 2; ++hf) { const u32x4 w = r.y[k][hf];
            r.h[2 * hf][0] += bf_lo(w.x); r.h[2 * hf][1] += bf_hi(w.x); r.h[2 * hf][2] += bf_lo(w.y); r.h[2 * hf][3] += bf_hi(w.y);
            r.h[2 * hf + 1][0] += bf_lo(w.z); r.h[2 * hf + 1][1] += bf_hi(w.z); r.h[2 * hf + 1][2] += bf_lo(w.w); r.h[2 * hf + 1][3] += bf_hi(w.w); }
    float* orow = out + (size_t)m * D + 8 * lane;
    *(f32x4*)(orow) = r.h[0]; *(f32x4*)(orow + 4) = r.h[1]; *(f32x4*)(orow + 512) = r.h[2]; *(f32x4*)(orow + 516) = r.h[3];
    if (gnext) {
        float s = 0.f;
#pragma unroll
        for (int j = 0; j < 4; ++j) s += (r.h[j][0] * r.h[j][0] + r.h[j][1] * r.h[j][1]) + (r.h[j][2] * r.h[j][2] + r.h[j][3] * r.h[j][3]);
        const float rr = rsqrtf(wave_sum(s) * (1.f / D) + EPS);
        const float* gp = gnext + 8 * lane;
        const f32x4 a0 = r.h[0] * *(const f32x4*)(gp) * rr, a1 = r.h[1] * *(const f32x4*)(gp + 4) * rr, a2 = r.h[2] * *(const f32x4*)(gp + 512) * rr, a3 = r.h[3] * *(const f32x4*)(gp + 516) * rr;
        u32x4 w; w.x = cvt_pk_bf16(a0[0], a0[1]); w.y = cvt_pk_bf16(a0[2], a0[3]); w.z = cvt_pk_bf16(a1[0], a1[1]); w.w = cvt_pk_bf16(a1[2], a1[3]);
        *(u32x4*)(XN + (size_t)m * D + 8 * lane) = w;
        w.x = cvt_pk_bf16(a2[0], a2[1]); w.y = cvt_pk_bf16(a2[2], a2[3]); w.z = cvt_pk_bf16(a3[0], a3[1]); w.w = cvt_pk_bf16(a3[2], a3[3]);
        *(u32x4*)(XN + (size_t)m * D + 512 + 8 * lane) = w;
    }
}
__device__ __forceinline__ void combine_phase(Frame& F, const float* gnext, float* dst) {
    const bf16_t* YB = (const bf16_t*)(F.ws + WS_YB); const int* TOKROW = (const int*)(F.ws + WS_TOKROW); bf16_t* XN = (bf16_t*)(F.ws + WS_XN);
    const int lane = F.lane, NGW = F.G * NWAVES;
    CRow ra, rb;
    int m = F.bx * NWAVES + F.wave;
    if (m < T) crow_load(ra, F.out, YB, TOKROW, m, lane);
    while (m < T) {
        const int mb = m + NGW;
        if (mb < T) crow_load(rb, F.out, YB, TOKROW, mb, lane);
        crow_finish(ra, dst, XN, gnext, m, lane);
        if (mb >= T) break;
        const int mc = mb + NGW;
        if (mc < T) crow_load(ra, F.out, YB, TOKROW, mc, lane);
        crow_finish(rb, dst, XN, gnext, mb, lane);
        m = mc;
    }
}

constexpr int NPH_LAYER = 10, NPH = 1 + DEPTH * NPH_LAYER;
__global__ void __launch_bounds__(NTHREADS, 2) mk_fwd(Args args) {
    extern __shared__ __attribute__((aligned(16))) unsigned char lds_raw[];
    Frame F;
    F.lds = (LAS unsigned char*)lds_raw; F.ctl = F.lds + LDS_CTL; F.ws = args.ws; F.ws0 = args.ws; F.out0 = args.out; F.ap = &args; F.z = 0;
    F.tid = threadIdx.x; F.lane = F.tid & 63; F.wave = __builtin_amdgcn_readfirstlane(F.tid >> 6); F.G = gridDim.x; F.bx = blockIdx.x;
    F.out = args.out;
    for (int u = F.tid; u < 1024; u += NTHREADS) ((LAS unsigned*)F.ctl)[u] = 0u;
    __syncthreads();
    XcdBarrier bar = xcd_barrier_post((unsigned*)(F.ws + WS_CTL) + CW_BAR, (volatile LAS unsigned*)F.ctl);
    const int lo = args.ph_lo, hi = args.ph_hi;
#ifndef PHMASK
#define PHMASK 0x1fff
#endif
#define RUN(k) (lo <= (k) && (k) < hi)
#define EN(b) ((PHMASK >> (b)) & 1)
#ifndef DUPMASK
#define DUPMASK 0
#endif
#ifndef ATT_PROBE_MODE
#define ATT_PROBE_MODE 0
#endif
#define NREP(b) (((DUPMASK >> (b)) & 1) ? 2 : 1)
#define SEAM(k) do { if (RUN((k) + 1)) xcd_barrier(bar); } while (0)
    if (EN(10) && RUN(0)) { for (int rep = 0; rep < NREP(10); ++rep) { phase_begin(F); p0_prologue(F); if (rep + 1 < NREP(10)) xcd_barrier(bar); } SEAM(0); }
    for (int l = 0; l < DEPTH; ++l) {
        const int pb = 1 + l * NPH_LAYER;
        if (EN(0) && RUN(pb + 0)) { for (int rep = 0; rep < NREP(0); ++rep) { phase_begin(F); unsigned char* ws = F.ws; (void)ws;
            PInProj P; P.so.init(T, DIN, F.G, F.bx); P.A = (const char*)(ws + WS_XN); P.B = (const char*)(ws + WS_WIN + l * WIN_STRIDE);
            P.UQKV = (bf16_t*)(ws + WS_U); P.GQK = (const float*)(ws + WS_SCAL) + 64 + l * 128; P.COS = (const float*)(ws + WS_COS); P.SIN = (const float*)(ws + WS_SIN);
            pg8::gemm_phase(F.lds + LDS_RING, F.ctl, P, F.tid);  if (rep + 1 < NREP(0)) xcd_barrier(bar); } SEAM(pb + 0);
        }
        if (EN(1) && RUN(pb + 1)) { for (int rep = 0; rep < NREP(1); ++rep) { phase_begin(F); unsigned char* ws = F.ws; (void)ws; s5a_phase(F, l);  if (rep + 1 < NREP(1)) xcd_barrier(bar); } SEAM(pb + 1); }
        if (EN(2) && RUN(pb + 2)) { for (int rep = 0; rep < NREP(2); ++rep) { phase_begin(F); unsigned char* ws = F.ws; (void)ws; if (EN(11)) for (int r2 = 0; r2 < NREP(11); ++r2) { phase_begin(F); s5c_phase(F, l); } if (EN(12)) { if (NREP(12) == 2) { phase_begin(F); attn_phase<ATT_PROBE_MODE>(F, l); } phase_begin(F); attn_phase<0>(F, l); }  if (rep + 1 < NREP(2)) xcd_barrier(bar); } SEAM(pb + 2); }
        if (EN(3) && RUN(pb + 3)) { for (int rep = 0; rep < NREP(3); ++rep) { phase_begin(F); unsigned char* ws = F.ws; (void)ws;
            PGlu P; P.so.init(T, DS, F.G, F.bx); P.A = (const char*)(ws + WS_YG); P.B = (const char*)(ws + WS_WGLU + l * WGLU_STRIDE);
            P.YG = (const bf16_t*)(ws + WS_YG); P.MIX = (bf16_t*)(ws + WS_MIX); P.RSP = (float*)(ws + WS_RSP);
            pg8::gemm_phase(F.lds + LDS_RING, F.ctl, P, F.tid);  if (rep + 1 < NREP(3)) xcd_barrier(bar); } SEAM(pb + 3);
        }
        if (EN(4) && RUN(pb + 4)) { for (int rep = 0; rep < NREP(4); ++rep) { phase_begin(F); unsigned char* ws = F.ws; (void)ws;
            POut P; P.so.init(T, D, F.G, F.bx); P.A = (const char*)(ws + WS_MIX); P.B = (const char*)(ws + WS_WOUT + l * WOUT_STRIDE);
            P.RSP = (const float*)(ws + WS_RSP); P.base = (l == 0) ? arg_in(0) : F.out; P.out = (rep + 1 < NREP(4)) ? (float*)(ws + WS_ACT) : F.out;
            pg8::gemm_phase(F.lds + LDS_RING, F.ctl, P, F.tid);  if (rep + 1 < NREP(4)) xcd_barrier(bar); } SEAM(pb + 4);
        }
        if (EN(5) && RUN(pb + 5)) { for (int rep = 0; rep < NREP(5); ++rep) { phase_begin(F); unsigned char* ws = F.ws; (void)ws; router_phase(F, l);  if (rep + 1 < NREP(5)) xcd_barrier(bar); } SEAM(pb + 5); }
        if (EN(6) && RUN(pb + 6)) { for (int rep = 0; rep < NREP(6); ++rep) { phase_begin(F); unsigned char* ws = F.ws; (void)ws; routing_phase(F);  if (rep + 1 < NREP(6)) xcd_barrier(bar); } SEAM(pb + 6); }
        if (EN(7) && RUN(pb + 7)) { for (int rep = 0; rep < NREP(7); ++rep) { phase_begin(F); unsigned char* ws = F.ws; (void)ws;
            PUp P; P.mo.init(F.G, F.bx, (const int*)(ws + WS_TILEEXP) + 768);
            P.A = (const char*)(ws + WS_XN); P.B = (const char*)(ws + WS_WUP + l * WUP_STRIDE); P.ROWTOK = (const int*)(ws + WS_ROWTOK); P.TILEEXP = (const int*)(ws + WS_TILEEXP);
            P.bup = arg_in(25) + (size_t)l * NE * 2048; P.ACT = (bf16_t*)(ws + WS_ACT);
            pg8::gemm_phase(F.lds + LDS_RING, F.ctl, P, F.tid);  if (rep + 1 < NREP(7)) xcd_barrier(bar); } SEAM(pb + 7);
        }
        if (EN(8) && RUN(pb + 8)) { for (int rep = 0; rep < NREP(8); ++rep) { phase_begin(F); unsigned char* ws = F.ws; (void)ws;
            PDown P; P.mo.init(F.G, F.bx, (const int*)(ws + WS_TILEEXP) + 768);
            P.A = (const char*)(ws + WS_ACT); P.B = (const char*)(ws + WS_WDN + l * WDN_STRIDE); P.TILEEXP = (const int*)(ws + WS_TILEEXP);
            P.bdn = arg_in(27) + (size_t)l * NE * 1024; P.ROWGATE = (const float*)(ws + WS_ROWGATE); P.YB = (bf16_t*)(ws + WS_YB);
            pg8::gemm_phase(F.lds + LDS_RING, F.ctl, P, F.tid);  if (rep + 1 < NREP(8)) xcd_barrier(bar); } SEAM(pb + 8);
        }
        if (EN(9) && RUN(pb + 9)) { for (int rep = 0; rep < NREP(9); ++rep) { phase_begin(F); unsigned char* ws = F.ws; (void)ws; combine_phase(F, (l + 1 < DEPTH) ? arg_in(1) + (size_t)(l + 1) * D : nullptr, (rep + 1 < NREP(9)) ? (float*)(ws + WS_ACT) : F.out);  if (rep + 1 < NREP(9)) xcd_barrier(bar); } SEAM(pb + 9); }
    }
#undef RUN
#undef SEAM
}

extern "C" void kernel_launch(void* const* d_in, const int* in_sizes, int n_in, void* d_out, int out_size, void* d_ws, size_t ws_size, hipStream_t stream) {
    static int grid = 0;
    if (grid == 0) {
        if (n_in != 28 || out_size != T * D || ws_size < WS_END) { fprintf(stderr, "kernel_launch: unexpected shapes (n_in %d out %d ws %zu)\n", n_in, out_size, ws_size); grid = -1; return; }
        int dev = 0, cus = 0;
        if (hipGetDevice(&dev) != hipSuccess || hipDeviceGetAttribute(&cus, hipDeviceAttributeMultiprocessorCount, dev) != hipSuccess) { grid = -1; return; }
        if (hipFuncSetAttribute((const void*)mk_fwd, hipFuncAttributeMaxDynamicSharedMemorySize, LDS_BYTES) != hipSuccess) { fprintf(stderr, "kernel_launch: hipFuncSetAttribute failed\n"); grid = -1; return; }
        int per_cu = 0;
        if (hipOccupancyMaxActiveBlocksPerMultiprocessor(&per_cu, (const void*)mk_fwd, NTHREADS, LDS_BYTES) != hipSuccess || per_cu < 1) { fprintf(stderr, "kernel_launch: occupancy query says %d\n", per_cu); }
        (void)hipGetLastError();
        grid = cus;
    }
    if (grid < 0) return;
    if (hipMemsetAsync((char*)d_ws + WS_CTL, 0, CTL_ZERO_BYTES, stream) != hipSuccess) return;
    Args a{};
    for (int i = 0; i < 28; ++i) a.in[i] = (const float*)d_in[i];
    a.out = (float*)d_out; a.ws = (unsigned char*)d_ws; a.ph_lo = 0; a.ph_hi = NPH;
    hipLaunchKernelGGL(mk_fwd, dim3(grid), dim3(NTHREADS), LDS_BYTES, stream, a);
}
```

```cpp
#include <hip/hip_runtime.h>
#include <cstdio>
#include <cstdint>
#include <math.h>

#ifndef UP_FP8
#define UP_FP8 1
#endif
#ifndef DN_FP8
#define DN_FP8 1
#endif
#define LAS __attribute__((address_space(3)))
#define GAS __attribute__((address_space(1)))
typedef unsigned short bf16_t;
typedef short bf16x8 __attribute__((ext_vector_type(8)));
typedef short s16x4 __attribute__((ext_vector_type(4)));
typedef float f32x4 __attribute__((ext_vector_type(4)));
typedef float f32x2 __attribute__((ext_vector_type(2)));
typedef float f32x16 __attribute__((ext_vector_type(16)));
typedef unsigned u32x4 __attribute__((ext_vector_type(4)));
typedef unsigned u32x2 __attribute__((ext_vector_type(2)));
typedef int v8i32 __attribute__((ext_vector_type(8)));

constexpr int D = 1024, BATCH = 4, SEQ = 8192, DEPTH = 2, T = BATCH * SEQ;
constexpr int DS = 512, NG = 32, HS = 16, NP = 64, DA = 512, NH = 4, DV = 128, DIN = 2048;
constexpr int NE = 32, DFF = 1024, NASSIGN = T * 4;
constexpr int MPAD_MAX = NASSIGN + NE * 256, NTILE_MAX = MPAD_MAX / 256;
constexpr int NCHUNK = T / 64, CPB = SEQ / 64;
constexpr float EPS = 1e-6f;
constexpr float C2 = 0.125f * 1.4426950408889634f;
constexpr int NWAVES = 8, NTHREADS = 512;

constexpr size_t MiB = 1u << 20;
constexpr size_t WS_CTL = 0, CTL_ZERO_BYTES = 1 * MiB;
constexpr size_t WS_COS = 1 * MiB, WS_SIN = 2 * MiB;
constexpr size_t WS_SCAL = 3 * MiB;
constexpr size_t WS_KT = 4 * MiB, KT_STRIDE = 2 * MiB;
constexpr size_t WS_LAML = 8 * MiB, LAML_STRIDE = 32768;
constexpr size_t WS_WRT = 9 * MiB, WRT_STRIDE = 131072;
constexpr size_t WS_RS = 10 * MiB;
constexpr size_t WS_GT = 16 * MiB, GT_STRIDE = 8 * MiB;
constexpr size_t WS_HT = 32 * MiB, HT_STRIDE = 8 * MiB;
constexpr size_t WS_WIN = 48 * MiB, WIN_STRIDE = 4 * MiB;
constexpr size_t WS_WGLU = 56 * MiB, WGLU_STRIDE = MiB / 2;
constexpr size_t WS_WOUT = 58 * MiB, WOUT_STRIDE = 2 * MiB;
constexpr size_t WS_WUP = 64 * MiB, WUP_STRIDE = 128 * MiB;
constexpr size_t WS_WDN = 320 * MiB, WDN_STRIDE = 64 * MiB;
constexpr size_t WS_XN = 448 * MiB;
constexpr size_t WS_U = 512 * MiB, WS_Q = 544 * MiB, WS_K = 576 * MiB, WS_V = 608 * MiB;
constexpr size_t WS_YG = 640 * MiB;
constexpr size_t WS_MIX = 672 * MiB;
constexpr size_t WS_S = 736 * MiB;
constexpr size_t WS_RSP = 744 * MiB;
constexpr size_t WS_TOPI = 746 * MiB, WS_TOPG = 747 * MiB, WS_TOKROW = 748 * MiB, WS_WGCNT = 749 * MiB;
constexpr size_t WS_ROWTOK = 750 * MiB, WS_ROWGATE = 751 * MiB, WS_TILEEXP = 752 * MiB, WS_ROWSCALE = 753 * MiB;
constexpr size_t WS_ACT = 768 * MiB, WS_YB = 1040 * MiB, WS_END = 1312 * MiB;
constexpr int CW_BAR = 4096;

constexpr int LDS_CTL = 0;
constexpr int LDS_RING = 4096;
constexpr int LDS_BYTES = 163840;

__device__ __forceinline__ unsigned f2bf(float f) { unsigned u = __builtin_bit_cast(unsigned, f); return (u + 0x7fffu + ((u >> 16) & 1u)) >> 16; }
__device__ __forceinline__ unsigned pk2(float lo, float hi) { return f2bf(lo) | (f2bf(hi) << 16); }
__device__ __forceinline__ unsigned cvt_pk_bf16(float lo, float hi) { unsigned r; asm volatile("v_cvt_pk_bf16_f32 %0, %1, %2" : "=v"(r) : "v"(lo), "v"(hi)); return r; }
__device__ __forceinline__ unsigned pk4_fp8(float a, float b, float c, float d) { int w = 0; w = __builtin_amdgcn_cvt_pk_fp8_f32(a, b, w, false); w = __builtin_amdgcn_cvt_pk_fp8_f32(c, d, w, true); return (unsigned)w; }
__device__ __forceinline__ float bf_lo(unsigned w) { return __builtin_bit_cast(float, w << 16); }
__device__ __forceinline__ float bf_hi(unsigned w) { return __builtin_bit_cast(float, w & 0xffff0000u); }
__device__ __forceinline__ float wave_sum(float v) {
#pragma unroll
    for (int o = 1; o < 64; o <<= 1) v += __shfl_xor(v, o);
    return v;
}
__device__ __forceinline__ float gelu_tanh(float x) {
    const float z = 0.7978845608028654f * (x + 0.044715f * x * x * x);
    return x / (1.f + __expf(-2.f * z));
}
__device__ __forceinline__ float sigmoidf(float v) { return 1.f / (1.f + __expf(-v)); }

#define XB_TMO      128
#define XB_XCNT(j)  (256  + 64 * (j))
#define XB_XSUB(j)  (1280 + 64 * (j))
#define XB_XGEN(j)  (2304 + 64 * (j))
#define XB_TOP      3328
#define XB_TOPGEN   3392
#define XCD_BAR_WORDS 3456
#define XB_SPIN_CAP (1u << 18)
__device__ __forceinline__ unsigned xb_ld(unsigned* p)              { return __hip_atomic_load(p, __ATOMIC_RELAXED, __HIP_MEMORY_SCOPE_AGENT); }
__device__ __forceinline__ unsigned xb_add(unsigned* p, unsigned v) { return __hip_atomic_fetch_add(p, v, __ATOMIC_RELAXED, __HIP_MEMORY_SCOPE_AGENT); }
__device__ __forceinline__ unsigned xb_xcc_id() { return (unsigned)__builtin_amdgcn_s_getreg((3 << 11) | 20) & 0xFu; }
#define XB_SPIN(cond, bar) do { unsigned _sp = 0; while (cond) { __builtin_amdgcn_s_sleep(1); \
    if ((++_sp & 255u) == 0u) { if (xb_ld(&(bar)[XB_TMO])) break; if (_sp > XB_SPIN_CAP) { atomicAdd(&(bar)[XB_TMO], 1u); break; } } } } while (0)
struct XcdBarrier { unsigned* bar; unsigned x; volatile LAS unsigned* st; };
__device__ __forceinline__ XcdBarrier xcd_barrier_post(unsigned* bar, volatile LAS unsigned* st) {
    XcdBarrier b; b.bar = bar; b.x = xb_xcc_id(); b.st = st;
    if (threadIdx.x == 0) (void)xb_add(&bar[XB_XCNT(b.x)], 1u);
    return b;
}
__device__ __forceinline__ void xcd_barrier_complete(unsigned* bar, unsigned x, unsigned& nloc, unsigned& nx) {
    const unsigned G = gridDim.x * gridDim.y * gridDim.z;
    unsigned sum, cnt, mine, sp = 0u;
    for (;;) {
        sum = 0u; cnt = 0u; mine = 0u;
#pragma unroll
        for (unsigned j = 0; j < 16; ++j) { const unsigned c = xb_ld(&bar[XB_XCNT(j)]); sum += c; cnt += (c > 0u) ? 1u : 0u; mine = (j == x) ? c : mine; }
        if (sum == G) break;
        __builtin_amdgcn_s_sleep(1);
        if ((++sp & 255u) == 0u) { if (xb_ld(&bar[XB_TMO])) break; if (sp > XB_SPIN_CAP) { atomicAdd(&bar[XB_TMO], 1u); break; } }
    }
    nloc = mine > 0u ? mine : 1u; nx = cnt > 0u ? cnt : 1u;
}
__device__ __forceinline__ void xcd_barrier(const XcdBarrier& b) {
    asm volatile("s_waitcnt vmcnt(0)" ::: "memory");
    __syncthreads();
    if (threadIdx.x == 0) {
        unsigned* bar = b.bar;
        __builtin_amdgcn_s_waitcnt(0);
        unsigned nloc = b.st[0], nx = b.st[1];
        if (nloc == 0u) { xcd_barrier_complete(bar, b.x, nloc, nx); b.st[0] = nloc; b.st[1] = nx; }
        const unsigned old = xb_add(&bar[XB_XSUB(b.x)], 1u);
        const unsigned gen = old / nloc;
        if (old + 1u == (gen + 1u) * nloc) {
            __builtin_amdgcn_fence(__ATOMIC_RELEASE, "agent");
            asm volatile("s_waitcnt vmcnt(0)" ::: "memory");
            const unsigned og = xb_add(&bar[XB_TOP], 1u);
            const unsigned tg = og / nx;
            if (og + 1u == (tg + 1u) * nx) xb_add(&bar[XB_TOPGEN], 1u);
            else XB_SPIN(xb_ld(&bar[XB_TOPGEN]) == tg, bar);
            __builtin_amdgcn_fence(__ATOMIC_ACQUIRE, "agent");
            xb_add(&bar[XB_XGEN(b.x)], 1u);
            asm volatile("s_waitcnt vmcnt(0)" ::: "memory");
        } else {
            XB_SPIN(xb_ld(&bar[XB_XGEN(b.x)]) == gen, bar);
            __builtin_amdgcn_fence(__ATOMIC_ACQUIRE, "agent");
            asm volatile("s_waitcnt vmcnt(0)" ::: "memory");
        }
    }
    __syncthreads();
}

namespace pg8 {
constexpr int BM = 256, BK = 64, HALF = 128, HTB = HALF * BK * 2, STAGE_BYTES = 8 * HTB;
__host__ __device__ __forceinline__ int lds_byte(int r, int c) { const int st = (r >> 4) * 2 + (c >> 5), rr = r & 15, cc = c & 31, ob = rr * 64 + cc * 2; return st * 1024 + (ob ^ (((ob >> 9) & 1) << 5)); }
__host__ __device__ __forceinline__ void stage_rc(int b, int& R, int& C) { const int st = b / 1024, sb = b % 1024, swz = sb ^ (((sb >> 9) & 1) << 5); R = (st >> 1) * 16 + swz / 64; C = (st & 1) * 32 + (swz % 64) / 2; }
__host__ __device__ __forceinline__ int perm32(int rho) { const int n = rho >> 4, i = rho & 15; return 8 * (i >> 2) + 4 * n + (i & 3); }

struct Unit { int pm, pn; };
template <class P>
__device__ __forceinline__ void gemm_phase(LAS unsigned char* lds, LAS unsigned char* ldsctl, P& S, const int tid) {
    const int wid = __builtin_amdgcn_readfirstlane(tid >> 6), lane = tid & 63, wr = wid >> 2, wc = wid & 3, fr = lane & 15, fq = lane >> 4;
    constexpr bool F8 = P::FP8;
    constexpr int K = P::K, ES = F8 ? 1 : 2, nt = K * ES / 128;
    int R0, C0, R1, C1; stage_rc(tid * 16, R0, C0); stage_rc(tid * 16 + 8192, R1, C1);
    unsigned voffB[2];
    {
        const int Rb0 = P::BROW64 ? (64 * (R0 >> 5) + perm32(R0 & 31)) : ((R0 & ~31) + perm32(R0 & 31));
        const int Rb1 = P::BROW64 ? (64 * (R1 >> 5) + perm32(R1 & 31)) : ((R1 & ~31) + perm32(R1 & 31));
        voffB[0] = (unsigned)(Rb0 * K * ES + 2 * C0); voffB[1] = (unsigned)(Rb1 * K * ES + 2 * C1);
    }
    const unsigned ldsw = (unsigned)wid * 1024u;
    const int scl8 = P::SCALE_AB;
    const int aoff = F8 ? lds_byte(wr * 64 + fr, fq * 16) : lds_byte(wr * 64 + fr, fq * 8), boff = F8 ? lds_byte(wc * 32 + fr, fq * 16) : lds_byte(wc * 32 + fr, fq * 8);
#define PG8_SA(b, h) (((b) * 2 + (h)) * HTB)
#define PG8_SB(b, h) ((4 + (b) * 2 + (h)) * HTB)
    const unsigned ldsbase = (unsigned)__builtin_amdgcn_readfirstlane((int)(unsigned)(uintptr_t)lds + (int)ldsw);
#define PG8_GLDS(sbase, voff, ldsdst) do { unsigned _keep; asm volatile("s_mov_b32 %0, m0\n\ts_mov_b32 m0, %3\n\ts_nop 0\n\tglobal_load_lds_dwordx4 %2, %1\n\ts_mov_b32 m0, %0" \
        : "=&s"(_keep) : "s"(sbase), "v"(voff), "s"(ldsdst) : "memory"); } while (0)
#define PG8_STAGE_A(bufoff, vo, h, kofs) do { _Pragma("unroll") for (int _i = 0; _i < 2; ++_i) \
        PG8_GLDS(Abase, (vo)[P::GATHER ? (h) : 0][_i] + ((kofs) + (P::GATHER ? 0u : (unsigned)(h) * HSTEPA)), ldsbase + (unsigned)((bufoff) + _i * 8192)); } while (0)
#define PG8_STAGE_B(bufoff, gbase) do { _Pragma("unroll") for (int _i = 0; _i < 2; ++_i) \
        PG8_GLDS((const char*)(gbase), voffB[_i], ldsbase + (unsigned)((bufoff) + _i * 8192)); } while (0)
#define PG8_LDA(dst, b, h) do { if constexpr (F8) { _Pragma("unroll") for (int m = 0; m < 4; ++m) { const u32x4 _l = *(const LAS u32x4*)(lds + PG8_SA(b, h) + aoff + m * 2048), _h = *(const LAS u32x4*)(lds + PG8_SA(b, h) + aoff + m * 2048 + 16); dst##8[m] = __builtin_bit_cast(v8i32, __builtin_shufflevector(_l, _h, 0, 1, 2, 3, 4, 5, 6, 7)); } } \
        else { _Pragma("unroll") for (int m = 0; m < 4; ++m) _Pragma("unroll") for (int k = 0; k < 2; ++k) dst[m][k] = *(const LAS bf16x8*)(lds + PG8_SA(b, h) + aoff + m * 2048 + k * 1024); } } while (0)
#define PG8_LDB(dst, b, h) do { if constexpr (F8) { _Pragma("unroll") for (int n = 0; n < 2; ++n) { const u32x4 _l = *(const LAS u32x4*)(lds + PG8_SB(b, h) + boff + n * 2048), _h = *(const LAS u32x4*)(lds + PG8_SB(b, h) + boff + n * 2048 + 16); dst##8[n] = __builtin_bit_cast(v8i32, __builtin_shufflevector(_l, _h, 0, 1, 2, 3, 4, 5, 6, 7)); } } \
        else { _Pragma("unroll") for (int n = 0; n < 2; ++n) _Pragma("unroll") for (int k = 0; k < 2; ++k) dst[n][k] = *(const LAS bf16x8*)(lds + PG8_SB(b, h) + boff + n * 2048 + k * 1024); } } while (0)
#define PG8_MMA(ai, bj, At, Bt) do { __builtin_amdgcn_s_setprio(1); \
        if constexpr (F8) { _Pragma("unroll") for (int m = 0; m < 4; ++m) _Pragma("unroll") for (int n = 0; n < 2; ++n) \
            asm volatile("v_mfma_scale_f32_16x16x128_f8f6f4 %0, %1, %2, %0, %3, %3 op_sel:[0,1,0] op_sel_hi:[0,0,0]" : "+v"(acc[ai][bj][m][n]) : "v"(Bt##8[n]), "v"(At##8[m]), "v"(scl8)); } \
        else { _Pragma("unroll") for (int m = 0; m < 4; ++m) _Pragma("unroll") for (int n = 0; n < 2; ++n) _Pragma("unroll") for (int k = 0; k < 2; ++k) \
            acc[ai][bj][m][n] = __builtin_amdgcn_mfma_f32_16x16x32_bf16(Bt[n][k], At[m][k], acc[ai][bj][m][n], 0, 0, 0); } \
        __builtin_amdgcn_s_setprio(0); } while (0)
#define PG8_WAIT_V(n) asm volatile("s_waitcnt vmcnt(" #n ")" ::: "memory")
#define PG8_WAIT_L(n) asm volatile("s_waitcnt lgkmcnt(" #n ")" ::: "memory")
#define PG8_BAR __builtin_amdgcn_s_barrier()
#define PG8_SCHED __builtin_amdgcn_sched_barrier(0)
    Unit cur, nxt; int ui = 0;
    if (!S.next(0, cur)) return;
    f32x4 acc[2][2][4][2];
#pragma unroll
    for (int a = 0; a < 2; ++a)
#pragma unroll
        for (int b = 0; b < 2; ++b)
#pragma unroll
            for (int m = 0; m < 4; ++m)
#pragma unroll
                for (int n = 0; n < 2; ++n) acc[a][b][m][n] = (f32x4){0.f, 0.f, 0.f, 0.f};
    bf16x8 At[4][2], B0[2][2], B1[2][2]; v8i32 At8[4], B08[2], B18[2];
    const char* const Abase = S.a_base();
    unsigned voffA[2][2], voffAn[2][2];
    const char *cB0, *cB1;
    S.unit_begin(cur, ldsctl, tid, 0);
    S.a_offs(cur, R0, C0, R1, C1, voffA, true);
    asm volatile("" ::: "memory");
    S.b_ptrs(cur, cB0, cB1);
    constexpr unsigned kstep = 128, HSTEPA = (unsigned)HALF * K * ES;
    PG8_STAGE_B(PG8_SB(0, 0), cB0); PG8_STAGE_B(PG8_SB(0, 1), cB1); PG8_STAGE_A(PG8_SA(0, 0), voffA, 0, 0u); PG8_STAGE_A(PG8_SA(0, 1), voffA, 1, 0u);
    if (wr == 1) PG8_BAR;
    PG8_WAIT_V(2); PG8_BAR;
    PG8_STAGE_B(PG8_SB(1, 0), cB0 + kstep); PG8_STAGE_A(PG8_SA(1, 0), voffA, 0, kstep); PG8_STAGE_B(PG8_SB(1, 1), cB1 + kstep);
    PG8_WAIT_V(6); PG8_BAR;
    for (;;) {
        const bool has_next = S.next(ui + 1, nxt);
        const char *nB0 = cB0, *nB1 = cB1;
        if constexpr (P::GATHER) {
#pragma unroll
            for (int h = 0; h < 2; ++h)
#pragma unroll
                for (int i = 0; i < 2; ++i) voffAn[h][i] = voffA[h][i];
        }
        if (has_next) { S.unit_begin(nxt, ldsctl, tid, (ui + 1) & 1); S.b_ptrs(nxt, nB0, nB1);
            if constexpr (P::GATHER) { int t2 = tid; asm volatile("" : "+v"(t2)); int r0, c0, r1, c1; stage_rc(t2 * 16, r0, c0); stage_rc(t2 * 16 + 8192, r1, c1); S.a_offs(nxt, r0, c0, r1, c1, voffAn, false); } }
#pragma unroll 1
        for (int t = 0; t < nt; t += 2) {
            const bool last = (t == nt - 2);
            S.midk(acc, cur, t, wr, fr, ldsctl, ui & 1);
            unsigned a2o[2][2];
            if constexpr (!P::GATHER) { if (last) { int t2 = tid; asm volatile("" : "+v"(t2)); int r0, c0, r1, c1; stage_rc(t2 * 16, r0, c0); stage_rc(t2 * 16 + 8192, r1, c1);
                                                   S.a_offs(has_next ? nxt : cur, r0, c0, r1, c1, voffAn, false); } }
#pragma unroll
            for (int h = 0; h < 2; ++h)
#pragma unroll
                for (int i = 0; i < 2; ++i) a2o[h][i] = last ? voffAn[h][i] : voffA[h][i] + (unsigned)(t + 2) * kstep;
            const char* b2h0 = last ? nB0 : cB0 + (size_t)(t + 2) * kstep; const char* b2h1 = last ? nB1 : cB1 + (size_t)(t + 2) * kstep;
            const unsigned a1k = (unsigned)(t + 1) * kstep;
            PG8_LDB(B0, 0, 0); PG8_LDB(B1, 0, 1); PG8_SCHED; PG8_LDA(At, 0, 0); PG8_STAGE_A(PG8_SA(1, 1), voffA, 1, a1k);
            PG8_WAIT_V(8); PG8_WAIT_L(0); PG8_BAR; PG8_MMA(0, 0, At, B0); PG8_MMA(0, 1, At, B1); PG8_BAR; PG8_SCHED;
            PG8_LDA(At, 0, 1); PG8_STAGE_B(PG8_SB(0, 0), b2h0); PG8_STAGE_B(PG8_SB(0, 1), b2h1); PG8_STAGE_A(PG8_SA(0, 0), a2o, 0, 0u);
            PG8_WAIT_V(8); PG8_WAIT_L(0); PG8_BAR; PG8_MMA(1, 0, At, B0); PG8_MMA(1, 1, At, B1); PG8_BAR; PG8_SCHED;
            PG8_LDB(B0, 1, 0); PG8_LDB(B1, 1, 1); PG8_SCHED; PG8_LDA(At, 1, 0); PG8_STAGE_A(PG8_SA(0, 1), a2o, 1, 0u);
            PG8_WAIT_V(8); PG8_WAIT_L(0); PG8_BAR; PG8_MMA(0, 0, At, B0); PG8_MMA(0, 1, At, B1); PG8_BAR; PG8_SCHED;
            PG8_LDA(At, 1, 1); PG8_STAGE_B(PG8_SB(1, 0), b2h0 + kstep); PG8_STAGE_B(PG8_SB(1, 1), b2h1 + kstep); PG8_STAGE_A(PG8_SA(1, 0), a2o, 0, kstep);
            PG8_WAIT_V(8); PG8_WAIT_L(0); PG8_BAR; PG8_MMA(1, 0, At, B0); PG8_MMA(1, 1, At, B1); PG8_BAR; PG8_SCHED;
        }
        if (wr == 0) PG8_BAR;
        if constexpr (F8) asm volatile("s_nop 15\n\ts_nop 15" ::: "memory");
        { int l2 = tid; asm volatile("" : "+v"(l2)); S.epi(acc, cur, wr, wc, l2 & 15, (l2 >> 4) & 3); }
        if (!has_next) break;
#pragma unroll
        for (int a = 0; a < 2; ++a)
#pragma unroll
            for (int b = 0; b < 2; ++b)
#pragma unroll
                for (int m = 0; m < 4; ++m)
#pragma unroll
                    for (int n = 0; n < 2; ++n) acc[a][b][m][n] = (f32x4){0.f, 0.f, 0.f, 0.f};
        cur = nxt; cB0 = nB0; cB1 = nB1; ++ui;
#pragma unroll
        for (int h = 0; h < 2; ++h)
#pragma unroll
            for (int i = 0; i < 2; ++i) voffA[h][i] = voffAn[h][i];
        if (wr == 1) PG8_BAR;
    }
    PG8_WAIT_V(0);
    PG8_BAR;
#undef PG8_SA
#undef PG8_SB
#undef PG8_STAGE_A
#undef PG8_GLDS
#undef PG8_STAGE_B
#undef PG8_LDA
#undef PG8_LDB
#undef PG8_MMA
#undef PG8_WAIT_V
#undef PG8_WAIT_L
#undef PG8_BAR
#undef PG8_SCHED
}
struct StaticOrder {
    int nM, nN, nwg, G, c;
    __device__ void init(int M, int N, int G_, int c_) { nM = M / BM; nN = N / BM; nwg = nM * nN; G = G_; c = c_; }
    __device__ bool next(int i, Unit& u) const {
        const long L = (long)i * G + c; if (L >= nwg) return false;
        int wgid = (int)L; { const int q = nwg / 8, r = nwg % 8, xcd = wgid % 8, off = wgid / 8; wgid = (xcd < r ? xcd * (q + 1) : r * (q + 1) + (xcd - r) * q) + off; }
        const int nig = 8 * nN, gid = wgid / nig, fm = gid * 8, gsz = (nM - fm) < 8 ? (nM - fm) : 8;
        u.pm = fm + ((wgid % nig) % gsz); u.pn = (wgid % nig) / gsz; return true;
    }
};
}

struct Frame {
    LAS unsigned char* lds; LAS unsigned char* ctl;
    unsigned char* ws;
    int tid, lane, wave, G, bx;
    float* out; const struct Args* ap; unsigned char* ws0; float* out0; size_t z;
};

struct Args { const float* in[28]; float* out; unsigned char* ws; int ph_lo, ph_hi; };
#define arg_in(i) (F.ap->in[i] + F.z)
__device__ __forceinline__ void phase_begin(Frame& F) {
    int t = F.tid; asm volatile("" : "+v"(t)); F.tid = t; F.lane = t & 63; F.wave = __builtin_amdgcn_readfirstlane(t >> 6);
    size_t z = 0; asm volatile("" : "+s"(z)); F.z = z; F.ws = F.ws0 + z; F.out = F.out0 + z;
    int bx = F.bx; asm volatile("" : "+s"(bx)); F.bx = bx;
}
struct PBase {
    static constexpr bool GATHER = false, FP8 = false; static constexpr int SCALE_AB = 0x7f7f7f7f;
    __device__ __forceinline__ void unit_begin(const pg8::Unit&, LAS unsigned char*, int, int) {}
    __device__ __forceinline__ void midk(f32x4 (&)[2][2][4][2], const pg8::Unit&, int, int, int, LAS unsigned char*, int) {}
    __device__ __forceinline__ void a_fix(unsigned (&)[2][2]) {}
};
struct PInProj : PBase {
    static constexpr int K = 1024, BROW64 = 1;
    pg8::StaticOrder so; const char* A; const char* B; bf16_t* UQKV; const float *GQK, *COS, *SIN;
    __device__ __forceinline__ bool next(int i, pg8::Unit& u) const { return so.next(i, u); }
    __device__ __forceinline__ const char* a_base() const { return A; }
    __device__ __forceinline__ void a_offs(const pg8::Unit& u, int R0, int C0, int R1, int C1, unsigned (&vo)[2][2], bool) const {
#pragma unroll
        for (int h = 0; h < 2; ++h) { vo[h][0] = (unsigned)((u.pm * 256 + 128 * h + R0) * K + C0) * 2u; vo[h][1] = (unsigned)((u.pm * 256 + 128 * h + R1) * K + C1) * 2u; }
    }
    __device__ __forceinline__ void b_ptrs(const pg8::Unit& u, const char*& b0, const char*& b1) const { b0 = B + (size_t)u.pn * 256 * K * 2; b1 = b0 + (size_t)32 * K * 2; }
    __device__ __forceinline__ void epi(f32x4 (&acc)[2][2][4][2], const pg8::Unit& u, int wr, int wc, int fr, int fq) const {
        const int kind = u.pn >> 1;
        const int colg = (u.pn & 1) * 256 + 64 * wc;
        bf16_t* dst = UQKV + (size_t)kind * (size_t)(16u << 20);
        const int row0 = u.pm * 256 + wr * 64 + fr;
        if (kind == 0 || kind == 3) {
#pragma unroll
            for (int ai = 0; ai < 2; ++ai)
#pragma unroll
                for (int m = 0; m < 4; ++m) { bf16_t* rowp = dst + (size_t)(row0 + ai * 128 + m * 16) * 512 + colg + 8 * fq;
#pragma unroll
                    for (int bj = 0; bj < 2; ++bj) { const f32x4 v0 = acc[ai][bj][m][0], v1 = acc[ai][bj][m][1];
                        u32x4 w; w.x = cvt_pk_bf16(v0[0], v0[1]); w.y = cvt_pk_bf16(v0[2], v0[3]); w.z = cvt_pk_bf16(v1[0], v1[1]); w.w = cvt_pk_bf16(v1[2], v1[3]);
                        *(u32x4*)(rowp + 32 * bj) = w; } }
        } else {
            const float* g = GQK + (kind - 1) * 64; const float sc = kind == 1 ? C2 : 1.0f;
            f32x4 g0[2], g1[2];
#pragma unroll
            for (int n = 0; n < 2; ++n) { g0[n] = *(const f32x4*)(g + 8 * fq + 4 * n); g1[n] = *(const f32x4*)(g + 32 + 8 * fq + 4 * n); }
#pragma unroll
            for (int ai = 0; ai < 2; ++ai)
#pragma unroll
                for (int m = 0; m < 4; ++m) {
                    const int row = row0 + ai * 128 + m * 16; const int pos = row & (SEQ - 1);
                    float ss = 0.f;
#pragma unroll
                    for (int bj = 0; bj < 2; ++bj)
#pragma unroll
                        for (int n = 0; n < 2; ++n) { const f32x4 x = acc[ai][bj][m][n]; ss += (x[0] * x[0] + x[1] * x[1]) + (x[2] * x[2] + x[3] * x[3]); }
                    ss += __shfl_xor(ss, 16); ss += __shfl_xor(ss, 32);
                    const float r = rsqrtf(ss * (1.f / 64.f) + EPS) * sc;
                    f32x4 o1[2], o2[2];
#pragma unroll
                    for (int n = 0; n < 2; ++n) {
                        const f32x4 c = *(const f32x4*)(COS + (size_t)pos * 32 + 8 * fq + 4 * n), s = *(const f32x4*)(SIN + (size_t)pos * 32 + 8 * fq + 4 * n);
                        const f32x4 x1 = acc[ai][0][m][n] * g0[n] * r, x2 = acc[ai][1][m][n] * g1[n] * r;
                        o1[n] = x1 * c - x2 * s; o2[n] = x2 * c + x1 * s;
                    }
                    bf16_t* rowp = dst + (size_t)row * 512 + colg + 8 * fq;
                    u32x4 w; w.x = cvt_pk_bf16(o1[0][0], o1[0][1]); w.y = cvt_pk_bf16(o1[0][2], o1[0][3]); w.z = cvt_pk_bf16(o1[1][0], o1[1][1]); w.w = cvt_pk_bf16(o1[1][2], o1[1][3]);
                    *(u32x4*)(rowp) = w;
                    w.x = cvt_pk_bf16(o2[0][0], o2[0][1]); w.y = cvt_pk_bf16(o2[0][2], o2[0][3]); w.z = cvt_pk_bf16(o2[1][0], o2[1][1]); w.w = cvt_pk_bf16(o2[1][2], o2[1][3]);
                    *(u32x4*)(rowp + 32) = w;
                    asm volatile("" ::: "memory");
                }
        }
    }
};
struct PGlu : PBase {
    static constexpr int K = 512, BROW64 = 0;
    pg8::StaticOrder so; const char* A; const char* B; const bf16_t* YG; bf16_t* MIX; float* RSP;
    __device__ __forceinline__ bool next(int i, pg8::Unit& u) const { return so.next(i, u); }
    __device__ __forceinline__ const char* a_base() const { return A; }
    __device__ __forceinline__ void a_offs(const pg8::Unit& u, int R0, int C0, int R1, int C1, unsigned (&vo)[2][2], bool) const {
#pragma unroll
        for (int h = 0; h < 2; ++h) { vo[h][0] = (unsigned)((u.pm * 256 + 128 * h + R0) * K + C0) * 2u; vo[h][1] = (unsigned)((u.pm * 256 + 128 * h + R1) * K + C1) * 2u; }
    }
    __device__ __forceinline__ void b_ptrs(const pg8::Unit& u, const char*& b0, const char*& b1) const { b0 = B + (size_t)u.pn * 256 * K * 2; b1 = b0 + (size_t)128 * K * 2; }
    __device__ __forceinline__ void epi(f32x4 (&acc)[2][2][4][2], const pg8::Unit& u, int wr, int wc, int fr, int fq) const {
        const int row0 = u.pm * 256 + wr * 64 + fr, col0 = u.pn * 256 + wc * 32 + 8 * fq;
#pragma unroll
        for (int ai = 0; ai < 2; ++ai)
#pragma unroll
            for (int m = 0; m < 4; ++m) {
                const int row = row0 + ai * 128 + m * 16; float ss = 0.f;
#pragma unroll
                for (int bj = 0; bj < 2; ++bj) {
                    const u32x4 yw = *(const u32x4*)(YG + (size_t)row * 512 + col0 + 128 * bj);
                    const f32x4 a0 = acc[ai][bj][m][0], a1 = acc[ai][bj][m][1];
                    float z[8];
                    z[0] = bf_lo(yw.x) * sigmoidf(a0[0]); z[1] = bf_hi(yw.x) * sigmoidf(a0[1]); z[2] = bf_lo(yw.y) * sigmoidf(a0[2]); z[3] = bf_hi(yw.y) * sigmoidf(a0[3]);
                    z[4] = bf_lo(yw.z) * sigmoidf(a1[0]); z[5] = bf_hi(yw.z) * sigmoidf(a1[1]); z[6] = bf_lo(yw.w) * sigmoidf(a1[2]); z[7] = bf_hi(yw.w) * sigmoidf(a1[3]);
#pragma unroll
                    for (int i = 0; i < 8; ++i) ss += z[i] * z[i];
                    u32x4 w; w.x = cvt_pk_bf16(z[0], z[1]); w.y = cvt_pk_bf16(z[2], z[3]); w.z = cvt_pk_bf16(z[4], z[5]); w.w = cvt_pk_bf16(z[6], z[7]);
                    *(u32x4*)(MIX + (size_t)row * 1024 + col0 + 128 * bj) = w;
                }
                ss += __shfl_xor(ss, 16); ss += __shfl_xor(ss, 32);
                if (fq == 0) RSP[(size_t)row * 8 + u.pn * 4 + wc] = ss;
            }
    }
};
struct POut : PBase {
    static constexpr int K = 1024, BROW64 = 0;
    pg8::StaticOrder so; const char* A; const char* B; const float* RSP; const float* base; float* out;
    __device__ __forceinline__ bool next(int i, pg8::Unit& u) const { return so.next(i, u); }
    __device__ __forceinline__ const char* a_base() const { return A; }
    __device__ __forceinline__ void a_offs(const pg8::Unit& u, int R0, int C0, int R1, int C1, unsigned (&vo)[2][2], bool) const {
#pragma unroll
        for (int h = 0; h < 2; ++h) { vo[h][0] = (unsigned)((u.pm * 256 + 128 * h + R0) * K + C0) * 2u; vo[h][1] = (unsigned)((u.pm * 256 + 128 * h + R1) * K + C1) * 2u; }
    }
    __device__ __forceinline__ void b_ptrs(const pg8::Unit& u, const char*& b0, const char*& b1) const { b0 = B + (size_t)u.pn * 256 * K * 2; b1 = b0 + (size_t)128 * K * 2; }
    __device__ __forceinline__ void unit_begin(const pg8::Unit& u, LAS unsigned char* ldsctl, int tid, int slot) const {
        if (tid < 256) {
            const f32x4 p0 = *(const f32x4*)(RSP + (size_t)(u.pm * 256 + tid) * 8), p1 = *(const f32x4*)(RSP + (size_t)(u.pm * 256 + tid) * 8 + 4);
            const float ss = ((p0[0] + p0[1]) + (p0[2] + p0[3])) + ((p1[0] + p1[1]) + (p1[2] + p1[3]));
            ((LAS float*)(ldsctl + 1024 + slot * 1024))[tid] = rsqrtf(ss * (1.f / 512.f) + EPS);
        }
    }
    __device__ __forceinline__ void midk(f32x4 (&acc)[2][2][4][2], const pg8::Unit& u, int t, int wr, int fr, LAS unsigned char* ldsctl, int slot) const {
        if (t == 8) {
            const LAS float* rs = (const LAS float*)(ldsctl + 1024 + slot * 1024);
#pragma unroll
            for (int ai = 0; ai < 2; ++ai)
#pragma unroll
                for (int m = 0; m < 4; ++m) { const float r = rs[ai * 128 + wr * 64 + m * 16 + fr];
#pragma unroll
                    for (int bj = 0; bj < 2; ++bj)
#pragma unroll
                        for (int n = 0; n < 2; ++n) acc[ai][bj][m][n] *= r; }
        }
    }
    __device__ __forceinline__ void epi(f32x4 (&acc)[2][2][4][2], const pg8::Unit& u, int wr, int wc, int fr, int fq) const {
        const int row0 = u.pm * 256 + wr * 64 + fr, col0 = u.pn * 256 + wc * 32 + 8 * fq;
#pragma unroll
        for (int ai = 0; ai < 2; ++ai)
#pragma unroll
            for (int m = 0; m < 4; ++m) { const size_t off = (size_t)(row0 + ai * 128 + m * 16) * 1024 + col0;
#pragma unroll
                for (int bj = 0; bj < 2; ++bj)
#pragma unroll
                    for (int n = 0; n < 2; ++n) { const f32x4 bs = *(const f32x4*)(base + off + bj * 128 + 4 * n); *(f32x4*)(out + off + bj * 128 + 4 * n) = bs + acc[ai][bj][m][n]; }
                if (m & 1) asm volatile("" ::: "memory"); }
    }
};
template <int NN> struct MoeOrder {
    int j, wpx, s0, s1, s2, s3, n0, n1, n2, n3;
    __device__ __forceinline__ void init(int G, int c, const int* PST) {
#ifndef MOE_XA
#define MOE_XA 2
#endif
#ifndef MOE_CHUNKED
#define MOE_CHUNKED 0
#endif
        if (MOE_XA == 1 && (G & 7) == 0) { wpx = G >> 3; const int x = MOE_CHUNKED ? c / wpx : (c & 7); j = MOE_CHUNKED ? c % wpx : (c >> 3);
            s0 = PST[x] >> 8; n0 = (PST[x + 1] - PST[x]) >> 8; s1 = PST[x + 8] >> 8; n1 = (PST[x + 9] - PST[x + 8]) >> 8;
            s2 = PST[x + 16] >> 8; n2 = (PST[x + 17] - PST[x + 16]) >> 8; s3 = PST[x + 24] >> 8; n3 = (PST[x + 25] - PST[x + 24]) >> 8; }
        else { j = c; wpx = G; s0 = 0; n0 = PST[32] >> 8; s1 = s2 = s3 = 0; n1 = n2 = n3 = 0; }
        if (MOE_XA == 2 && (G & 7) == 0) { wpx = G >> 3; j = c >> 3; s1 = c & 7; n0 = PST[32] >> 8; }
    }
    __device__ __forceinline__ bool next(int i, pg8::Unit& u) const {
        const int q = i * wpx + j; int pml = q / NN; u.pn = q % NN;
        if (MOE_XA == 2) { u.pm = s1 + 8 * pml; return u.pm < n0; }
        if (pml < n0) { u.pm = s0 + pml; return true; } pml -= n0;
        if (pml < n1) { u.pm = s1 + pml; return true; } pml -= n1;
        if (pml < n2) { u.pm = s2 + pml; return true; } pml -= n2;
        if (pml < n3) { u.pm = s3 + pml; return true; }
        return false;
    }
};
struct PUp : PBase {
    static constexpr int K = 1024, BROW64 = 0; static constexpr bool GATHER = true, FP8 = UP_FP8; static constexpr int ES = UP_FP8 ? 1 : 2;
    static constexpr int SCALE_AB = 0x7c79;
    MoeOrder<8> mo; const char* A; const char* B; const int* ROWTOK; const int* TILEEXP; const float* bup; const float* ROWSCALE; bf16_t* ACT;
    int idx[2][2]; int c0, c1;
    __device__ __forceinline__ bool next(int i, pg8::Unit& u) const { return mo.next(i, u); }
    __device__ __forceinline__ const char* a_base() const { return A; }
    __device__ __forceinline__ void a_offs(const pg8::Unit& u, int R0, int C0, int R1, int C1, unsigned (&vo)[2][2], bool first) {
        c0 = C0; c1 = C1;
        const int* rp = ROWTOK + u.pm * 256;
#pragma unroll
        for (int h = 0; h < 2; ++h) {
            asm volatile("global_load_dword %0, %1, off" : "=v"(idx[h][0]) : "v"(rp + 128 * h + R0) : "memory");
            asm volatile("global_load_dword %0, %1, off" : "=v"(idx[h][1]) : "v"(rp + 128 * h + R1) : "memory");
        }
        asm volatile("s_waitcnt vmcnt(0)" : "+v"(idx[0][0]), "+v"(idx[0][1]), "+v"(idx[1][0]), "+v"(idx[1][1]) :: "memory");
#pragma unroll
        for (int h = 0; h < 2; ++h) { vo[h][0] = (unsigned)(idx[h][0] * K * ES + 2 * c0); vo[h][1] = (unsigned)(idx[h][1] * K * ES + 2 * c1); }
    }
    __device__ __forceinline__ void b_ptrs(const pg8::Unit& u, const char*& b0, const char*& b1) const {
        const int e = TILEEXP[u.pm]; b0 = B + ((size_t)e * 2048 + (size_t)u.pn * 128) * K * ES; b1 = b0 + (size_t)1024 * K * ES; }
    __device__ __forceinline__ void epi(f32x4 (&acc)[2][2][4][2], const pg8::Unit& u, int wr, int wc, int fr, int fq) const {
        const int e = TILEEXP[u.pm];
        const int row0 = u.pm * 256 + wr * 64 + fr, col0 = u.pn * 128 + wc * 32 + 8 * fq;
        const float* bg = bup + (size_t)e * 2048 + col0; const float* bl = bg + 1024;
        f32x4 bgv[2], blv[2];
#pragma unroll
        for (int n = 0; n < 2; ++n) { bgv[n] = *(const f32x4*)(bg + 4 * n); blv[n] = *(const f32x4*)(bl + 4 * n); }
#pragma unroll
        for (int ai = 0; ai < 2; ++ai)
#pragma unroll
            for (int m = 0; m < 4; ++m) {
                float a[8]; const float rs = ROWSCALE[row0 + ai * 128 + m * 16];
#pragma unroll
                for (int n = 0; n < 2; ++n)
#pragma unroll
                    for (int j = 0; j < 4; ++j) {
                        float glu = acc[ai][0][m][n][j] * rs + bgv[n][j], lin = acc[ai][1][m][n][j] * rs + blv[n][j];
                        glu = fminf(glu, 7.0f); lin = fminf(fmaxf(lin, -7.0f), 7.0f);
                        a[4 * n + j] = glu * sigmoidf(1.702f * glu) * (lin + 1.0f);
                    }
                if (DN_FP8) { u32x2 w; w.x = pk4_fp8(a[0] * 4.f, a[1] * 4.f, a[2] * 4.f, a[3] * 4.f); w.y = pk4_fp8(a[4] * 4.f, a[5] * 4.f, a[6] * 4.f, a[7] * 4.f);
                    *(u32x2*)((unsigned char*)ACT + (size_t)(row0 + ai * 128 + m * 16) * 1024 + col0) = w; }
                else { u32x4 w; w.x = cvt_pk_bf16(a[0], a[1]); w.y = cvt_pk_bf16(a[2], a[3]); w.z = cvt_pk_bf16(a[4], a[5]); w.w = cvt_pk_bf16(a[6], a[7]);
                    *(u32x4*)(ACT + (size_t)(row0 + ai * 128 + m * 16) * 1024 + col0) = w; }
            }
    }
};
struct PDown : PBase {
    static constexpr int K = 1024, BROW64 = 0; static constexpr bool FP8 = DN_FP8; static constexpr int ES = DN_FP8 ? 1 : 2;
    static constexpr int SCALE_AB = 0x7d79;
    MoeOrder<4> mo; const char* A; const char* B; const int* TILEEXP; const float* bdn; const float* ROWGATE; bf16_t* YB;
    __device__ __forceinline__ bool next(int i, pg8::Unit& u) const { return mo.next(i, u); }
    __device__ __forceinline__ const char* a_base() const { return A; }
    __device__ __forceinline__ void a_offs(const pg8::Unit& u, int R0, int C0, int R1, int C1, unsigned (&vo)[2][2], bool) const {
#pragma unroll
        for (int h = 0; h < 2; ++h) { vo[h][0] = (unsigned)((u.pm * 256 + 128 * h + R0) * K * ES + 2 * C0); vo[h][1] = (unsigned)((u.pm * 256 + 128 * h + R1) * K * ES + 2 * C1); }
    }
    __device__ __forceinline__ void b_ptrs(const pg8::Unit& u, const char*& b0, const char*& b1) const {
        const int e = TILEEXP[u.pm]; b0 = B + ((size_t)e * 1024 + (size_t)u.pn * 256) * K * ES; b1 = b0 + (size_t)128 * K * ES; }
    __device__ __forceinline__ void epi(f32x4 (&acc)[2][2][4][2], const pg8::Unit& u, int wr, int wc, int fr, int fq) const {
        const int e = TILEEXP[u.pm];
        const int row0 = u.pm * 256 + wr * 64 + fr, col0 = u.pn * 256 + wc * 32 + 8 * fq;
        const float* bp = bdn + (size_t)e * 1024 + col0;
#pragma unroll
        for (int bj = 0; bj < 2; ++bj) {
            const f32x4 bv0 = *(const f32x4*)(bp + 128 * bj), bv1 = *(const f32x4*)(bp + 128 * bj + 4);
#pragma unroll
            for (int ai = 0; ai < 2; ++ai)
#pragma unroll
                for (int m = 0; m < 4; ++m) { const int row = row0 + ai * 128 + m * 16; const float gt = ROWGATE[row];
                    const f32x4 v0 = (acc[ai][bj][m][0] + bv0) * gt, v1 = (acc[ai][bj][m][1] + bv1) * gt;
                    u32x4 w; w.x = cvt_pk_bf16(v0[0], v0[1]); w.y = cvt_pk_bf16(v0[2], v0[3]); w.z = cvt_pk_bf16(v1[0], v1[1]); w.w = cvt_pk_bf16(v1[2], v1[3]);
                    *(u32x4*)(YB + (size_t)row * 1024 + col0 + 128 * bj) = w; }
            asm volatile("" ::: "memory");
        }
    }
};

struct TItem { const float* src; bf16_t* dst; const float* ksc; int N, K; unsigned char* dst8; };
__device__ __forceinline__ void titem_load(const TItem& it, f32x4 (&v)[16], int lane) {
    const float* p = it.src + (size_t)(lane >> 4) * it.N + 4 * (lane & 15);
#pragma unroll
    for (int i = 0; i < 16; ++i) v[i] = *(const f32x4*)(p + (size_t)(4 * i) * it.N);
}
__device__ __forceinline__ void titem_store(const TItem& it, f32x4 (&v)[16], LAS float* scr, int lane) {
    if (it.ksc) {
#pragma unroll
        for (int i = 0; i < 16; ++i) v[i] *= it.ksc[4 * i + (lane >> 4)];
    }
#pragma unroll
    for (int i = 0; i < 16; ++i) { LAS float* d = scr + (4 * i + (lane >> 4)) * 65 + 4 * (lane & 15); d[0] = v[i][0]; d[1] = v[i][1]; d[2] = v[i][2]; d[3] = v[i][3]; }
    asm volatile("s_waitcnt lgkmcnt(0)" ::: "memory");
    if (it.dst8) {
        const int c = lane & 3;
#pragma unroll
        for (int j = 0; j < 4; ++j) { const int n = (lane >> 2) + 16 * j; const LAS float* s = scr + (16 * c) * 65 + n;
            u32x4 o;
            o.x = pk4_fp8(s[0 * 65] * 64.f, s[1 * 65] * 64.f, s[2 * 65] * 64.f, s[3 * 65] * 64.f); o.y = pk4_fp8(s[4 * 65] * 64.f, s[5 * 65] * 64.f, s[6 * 65] * 64.f, s[7 * 65] * 64.f);
            o.z = pk4_fp8(s[8 * 65] * 64.f, s[9 * 65] * 64.f, s[10 * 65] * 64.f, s[11 * 65] * 64.f); o.w = pk4_fp8(s[12 * 65] * 64.f, s[13 * 65] * 64.f, s[14 * 65] * 64.f, s[15 * 65] * 64.f);
            *(u32x4*)(it.dst8 + (size_t)n * it.K + 16 * c) = o; }
    } else {
        const int c = lane & 7;
#pragma unroll
        for (int j = 0; j < 8; ++j) { const int n = (lane >> 3) + 8 * j; const LAS float* s = scr + (8 * c) * 65 + n;
            u32x4 o; o.x = pk2(s[0 * 65], s[1 * 65]); o.y = pk2(s[2 * 65], s[3 * 65]); o.z = pk2(s[4 * 65], s[5 * 65]); o.w = pk2(s[6 * 65], s[7 * 65]);
            *(u32x4*)(it.dst + (size_t)n * it.K + 8 * c) = o; }
    }
    asm volatile("s_waitcnt lgkmcnt(0)" ::: "memory");
}
__device__ __forceinline__ void rms_row_to_bf16(const f32x4 (&v)[4], const float* g, bf16_t* orow, int lane) {
    float s = 0.f;
#pragma unroll
    for (int j = 0; j < 4; ++j) s += (v[j][0] * v[j][0] + v[j][1] * v[j][1]) + (v[j][2] * v[j][2] + v[j][3] * v[j][3]);
    const float r = rsqrtf(wave_sum(s) * (1.f / D) + EPS);
#pragma unroll
    for (int j = 0; j < 4; ++j) { const f32x4 gg = *(const f32x4*)(g + 4 * lane + 256 * j); const f32x4 o = v[j] * gg * r;
        u32x2 w; w.x = cvt_pk_bf16(o[0], o[1]); w.y = cvt_pk_bf16(o[2], o[3]); *(u32x2*)(orow + 4 * lane + 256 * j) = w; }
}
struct Cplx { float re, im; };
__device__ __forceinline__ Cplx cmul(Cplx a, Cplx b) { return Cplx{a.re * b.re - a.im * b.im, a.re * b.im + a.im * b.re}; }
__device__ __forceinline__ Cplx lam_pow(float lr, float li, float step, int n) {
    const float mag = expf((float)n * lr * step); const double ang = (double)n * (double)li * (double)step;
    return Cplx{mag * (float)cos(ang), mag * (float)sin(ang)};
}
__device__ __forceinline__ Cplx bbar_factor(float lr, float li, float step) {
    const Cplx lb = lam_pow(lr, li, step, 1); const float nr = lb.re - 1.f, ni = lb.im, den = lr * lr + li * li;
    return Cplx{(nr * lr + ni * li) / den, (ni * lr - nr * li) / den};
}
template <int PMODE> __device__ __forceinline__ void p0_prologue(Frame& F) {
    const int gw = F.bx * NWAVES + F.wave, NGW = F.G * NWAVES, lane = F.lane;
    const int gt = F.bx * NTHREADS + F.tid, NGT = F.G * NTHREADS;
    unsigned char* ws = F.ws;
    if (!(PMODE & 1)) {
        LAS float* scr = (LAS float*)(F.lds + LDS_RING) + F.wave * (64 * 65);
        constexpr int I_UP = 32 * 16 * 32, I_DN = 32 * 16 * 16, I_IN = 16 * 32, I_OUT = 16 * 16, I_GLU = 8 * 8;
        constexpr int PER_L = I_UP + I_DN + I_IN + I_OUT + I_GLU, TOTAL = DEPTH * PER_L;
        auto decode = [&](int it) -> TItem {
            TItem ti; const int l = it / PER_L; int r = it % PER_L; const float* W; bf16_t* WT; int K, N; ti.ksc = nullptr; bool f8 = false;
            if (r < I_UP) { const int e = r / 512; r %= 512; K = 1024; N = 2048; W = arg_in(24) + ((size_t)l * NE + e) * 1024 * 2048; WT = (bf16_t*)(ws + WS_WUP + l * WUP_STRIDE) + (size_t)e * 2048 * 1024 / (UP_FP8 ? 2 : 1); f8 = UP_FP8; }
            else if ((r -= I_UP) < I_DN) { const int e = r / 256; r %= 256; K = 1024; N = 1024; W = arg_in(26) + ((size_t)l * NE + e) * 1024 * 1024; WT = (bf16_t*)(ws + WS_WDN + l * WDN_STRIDE) + (size_t)e * 1024 * 1024 / (DN_FP8 ? 2 : 1); f8 = DN_FP8; }
            else if ((r -= I_DN) < I_IN) { K = 1024; N = 2048; W = arg_in(2) + (size_t)l * 1024 * 2048; WT = (bf16_t*)(ws + WS_WIN + l * WIN_STRIDE); }
            else if ((r -= I_IN) < I_OUT) { K = 1024; N = 1024; W = arg_in(20) + (size_t)l * 1024 * 1024; WT = (bf16_t*)(ws + WS_WOUT + l * WOUT_STRIDE); if ((r / 16) * 64 < DS) ti.ksc = arg_in(12) + l * DS + (r / 16) * 64; }
            else { r -= I_OUT; K = 512; N = 512; W = arg_in(11) + (size_t)l * 512 * 512; WT = (bf16_t*)(ws + WS_WGLU + l * WGLU_STRIDE); }
            const int nblk = N / 64, k0 = 64 * (r / nblk), n0 = 64 * (r % nblk);
            ti.src = W + (size_t)k0 * N + n0; ti.dst = WT + (size_t)n0 * K + k0; ti.N = N; ti.K = K; ti.dst8 = f8 ? (unsigned char*)WT + (size_t)n0 * K + k0 : nullptr; return ti;
        };
        f32x4 va[16], vb[16]; TItem ia, ib;
        int it = gw;
        if (it < TOTAL) { ia = decode(it); titem_load(ia, va, lane); }
        while (it < TOTAL) {
            const int itb = it + NGW;
            if (itb < TOTAL) { ib = decode(itb); titem_load(ib, vb, lane); }
            titem_store(ia, va, scr, lane);
            if (itb >= TOTAL) break;
            const int itc = itb + NGW;
            if (itc < TOTAL) { ia = decode(itc); titem_load(ia, va, lane); }
            titem_store(ib, vb, scr, lane);
            it = itc;
        }
    }
    for (int i = gt; i < SEQ * 32; i += NGT) {
        const int s = i >> 5, j = i & 31;
        const float inv = 1.0f / powf(10000.0f, (float)(2 * j) / 64.0f);
        const float ang = (float)s * inv;
        ((float*)(ws + WS_COS))[i] = (float)cos((double)ang); ((float*)(ws + WS_SIN))[i] = (float)sin((double)ang);
    }
    if (F.bx == 0 && F.wave < DEPTH) {
        const int l = F.wave;
        float a = arg_in(15)[l * 64 + lane] * arg_in(16)[l * 64 + lane], b = arg_in(17)[l * 64 + lane] * arg_in(18)[l * 64 + lane];
        a = wave_sum(a); b = wave_sum(b);
        float mq = fabsf(arg_in(13)[l * 64 + lane]), mk = fabsf(arg_in(14)[l * 64 + lane]);
#pragma unroll
        for (int o = 1; o < 64; o <<= 1) { mq = fmaxf(mq, __shfl_xor(mq, o)); mk = fmaxf(mk, __shfl_xor(mk, o)); }
        const float lambda_init = 0.8f - 0.6f * expf(-0.3f * (float)l);
        { float* gqk = (float*)(ws + WS_SCAL) + 64 + l * 128; gqk[lane] = arg_in(13)[l * 64 + lane]; gqk[64 + lane] = arg_in(14)[l * 64 + lane]; }
        if (lane == 0) { float* sc = (float*)(ws + WS_SCAL) + l * 4; sc[0] = expf(a) - expf(b) + lambda_init; sc[1] = C2 * 64.f * mq * mk * 1.02f + 0.5f; sc[2] = 1.0f - lambda_init; }
    }
    for (int i = gt; i < DEPTH * NE * D; i += NGT) {
        const int l = i / (NE * D), e = (i / D) % NE, k = i % D;
        const float w = arg_in(22)[(size_t)l * D * NE + (size_t)k * NE + e];
        const unsigned hi = f2bf(w); const float lo = w - __builtin_bit_cast(float, hi << 16);
        bf16_t* t = (bf16_t*)(ws + WS_WRT + l * WRT_STRIDE);
        t[e * D + k] = (bf16_t)hi; t[NE * D + e * D + k] = (bf16_t)f2bf(lo);
    }
    if (!(PMODE & 2)) for (int l = 0; l < DEPTH; ++l) {
        const float* lam_re = arg_in(3) + l * NG * NP; const float* lam_im = arg_in(4) + l * NG * NP; const float* log_step = arg_in(5) + l * NG;
        const float* b_re = arg_in(6) + (size_t)l * NG * NP * HS; const float* b_im = arg_in(7) + (size_t)l * NG * NP * HS;
        const float* c_re = arg_in(8) + (size_t)l * NG * HS * NP; const float* c_im = arg_in(9) + (size_t)l * NG * HS * NP;
        bf16_t* KT = (bf16_t*)(ws + WS_KT + l * KT_STRIDE); bf16_t* GT = (bf16_t*)(ws + WS_GT + l * GT_STRIDE); bf16_t* HT = (bf16_t*)(ws + WS_HT + l * HT_STRIDE);
        float* LAML = (float*)(ws + WS_LAML + l * LAML_STRIDE);
        for (int i = gt; i < NG * 65 * HS * 4; i += NGT) {
            const int pq = i & 3, h = (i >> 2) % HS, slot = (i / (4 * HS)) % 65, g = i / (4 * HS * 65);
            float accv[16];
#pragma unroll
            for (int q = 0; q < 16; ++q) accv[q] = 0.f;
            if (slot > 0) {
                const float step = expf(log_step[g]);
                for (int pp = 0; pp < 16; ++pp) {
                    const int p = pq * 16 + pp;
                    const float lr = lam_re[g * NP + p], li = lam_im[g * NP + p];
                    const Cplx pw = lam_pow(lr, li, step, slot - 1), f = bbar_factor(lr, li, step);
                    const Cplx w = cmul(cmul(Cplx{c_re[(size_t)(g * HS + h) * NP + p], c_im[(size_t)(g * HS + h) * NP + p]}, pw), f);
#pragma unroll
                    for (int q = 0; q < 16; ++q) { const float br = b_re[(size_t)(g * NP + p) * HS + q], bi = b_im[(size_t)(g * NP + p) * HS + q]; accv[q] += w.re * br - w.im * bi; }
                }
            }
#pragma unroll
            for (int q = 0; q < 16; ++q) { accv[q] += __shfl_xor(accv[q], 1); accv[q] += __shfl_xor(accv[q], 2); }
            if (pq == 0) {
                u32x4 o0, o1; o0.x = pk2(accv[0], accv[1]); o0.y = pk2(accv[2], accv[3]); o0.z = pk2(accv[4], accv[5]); o0.w = pk2(accv[6], accv[7]);
                o1.x = pk2(accv[8], accv[9]); o1.y = pk2(accv[10], accv[11]); o1.z = pk2(accv[12], accv[13]); o1.w = pk2(accv[14], accv[15]);
                u32x4* dst = (u32x4*)(KT + ((size_t)(g * 65 + slot) * HS + h) * 16); dst[0] = o0; dst[1] = o1;
            }
        }
        for (int i = gt; i < NG * NP * 64; i += NGT) {
            const int s = i % 64, p = (i / 64) % NP, g = i / (64 * NP);
            const float step = expf(log_step[g]); const float lr = lam_re[g * NP + p], li = lam_im[g * NP + p];
            const Cplx w = cmul(lam_pow(lr, li, step, 63 - s), bbar_factor(lr, li, step));
            float vr[16], vi[16];
#pragma unroll
            for (int q = 0; q < 16; ++q) { const float br = b_re[(size_t)(g * NP + p) * HS + q], bi = b_im[(size_t)(g * NP + p) * HS + q]; vr[q] = w.re * br - w.im * bi; vi[q] = w.re * bi + w.im * br; }
            u32x4* dr = (u32x4*)(GT + ((size_t)(g * 128 + 2 * p) * 1024 + s * 16)); u32x4* di = (u32x4*)(GT + ((size_t)(g * 128 + 2 * p + 1) * 1024 + s * 16));
            u32x4 o; o.x = pk2(vr[0], vr[1]); o.y = pk2(vr[2], vr[3]); o.z = pk2(vr[4], vr[5]); o.w = pk2(vr[6], vr[7]); dr[0] = o;
            o.x = pk2(vr[8], vr[9]); o.y = pk2(vr[10], vr[11]); o.z = pk2(vr[12], vr[13]); o.w = pk2(vr[14], vr[15]); dr[1] = o;
            o.x = pk2(vi[0], vi[1]); o.y = pk2(vi[2], vi[3]); o.z = pk2(vi[4], vi[5]); o.w = pk2(vi[6], vi[7]); di[0] = o;
            o.x = pk2(vi[8], vi[9]); o.y = pk2(vi[10], vi[11]); o.z = pk2(vi[12], vi[13]); o.w = pk2(vi[14], vi[15]); di[1] = o;
        }
        for (int i = gt; i < NG * 64 * HS * 4; i += NGT) {
            const int pq = i & 3, h = (i >> 2) % HS, t = (i / (4 * HS)) % 64, g = i / (4 * HS * 64);
            const float step = expf(log_step[g]);
            bf16_t* dst = HT + ((size_t)(g * 1024 + t * 16 + h) * 128 + pq * 32);
            for (int pp = 0; pp < 16; pp += 4) {
                float v[8];
#pragma unroll
                for (int q = 0; q < 4; ++q) { const int p = pq * 16 + pp + q;
                    const Cplx w = cmul(Cplx{c_re[(size_t)(g * HS + h) * NP + p], c_im[(size_t)(g * HS + h) * NP + p]}, lam_pow(lam_re[g * NP + p], lam_im[g * NP + p], step, t + 1));
                    v[2 * q] = w.re; v[2 * q + 1] = -w.im; }
                u32x4 o; o.x = pk2(v[0], v[1]); o.y = pk2(v[2], v[3]); o.z = pk2(v[4], v[5]); o.w = pk2(v[6], v[7]);
                *(u32x4*)(dst + 2 * pp) = o;
            }
        }
        for (int i = gt; i < NG * NP; i += NGT) { const int g = i / NP; const Cplx w = lam_pow(lam_re[i], lam_im[i], expf(log_step[g]), 64); LAML[2 * i] = w.re; LAML[2 * i + 1] = w.im; }
    }
    for (int m = gw; m < T; m += NGW) {
        const f32x4* xr = (const f32x4*)(arg_in(0) + (size_t)m * D) + lane; f32x4 v[4];
#pragma unroll
        for (int j = 0; j < 4; ++j) v[j] = xr[64 * j];
        rms_row_to_bf16(v, arg_in(1), (bf16_t*)(ws + WS_XN) + (size_t)m * D, lane);
    }
}

__device__ __forceinline__ void s5a_phase(Frame& F, int l) {
    const bf16_t* GT = (const bf16_t*)(F.ws + WS_GT + l * GT_STRIDE); const bf16_t* U = (const bf16_t*)(F.ws + WS_U); float* S = (float*)(F.ws + WS_S);
    const int lane = F.lane, n = lane & 15, kq = lane >> 4;
    for (int uu = F.bx * NWAVES + F.wave; uu < NG * 32 * 2; uu += F.G * NWAVES) {
        const int g = uu >> 6, ntile = (uu >> 1) & 31, mh = uu & 1;
        const int chunk = ntile * 16 + n;
        const bf16_t* up = U + ((size_t)chunk * 64 + (kq >> 1)) * DS + g * 16 + 8 * (kq & 1);
        const bf16_t* gp = GT + ((size_t)(g * 128 + mh * 64 + n) * 1024 + 8 * kq);
        f32x4 acc[4];
#pragma unroll
        for (int mt = 0; mt < 4; ++mt) acc[mt] = (f32x4){0.f, 0.f, 0.f, 0.f};
#pragma unroll 4
        for (int ks = 0; ks < 32; ++ks) {
            const bf16x8 b = *(const bf16x8*)(up + (size_t)(2 * ks) * DS);
#pragma unroll
            for (int mt = 0; mt < 4; ++mt) { const bf16x8 a = *(const bf16x8*)(gp + (size_t)(mt * 16) * 1024 + 32 * ks); acc[mt] = __builtin_amdgcn_mfma_f32_16x16x32_bf16(a, b, acc[mt], 0, 0, 0); }
        }
#pragma unroll
        for (int mt = 0; mt < 4; ++mt) *(f32x4*)(S + ((size_t)chunk * NG + g) * 128 + mh * 64 + mt * 16 + 4 * kq) = acc[mt];
    }
}
__device__ __forceinline__ void s5c_phase(Frame& F, int l) {
    const bf16_t* KT = (const bf16_t*)(F.ws + WS_KT + l * KT_STRIDE); const bf16_t* HT = (const bf16_t*)(F.ws + WS_HT + l * HT_STRIDE);
    const float* LAML = (const float*)(F.ws + WS_LAML + l * LAML_STRIDE); const float* S = (const float*)(F.ws + WS_S);
    const bf16_t* U = (const bf16_t*)(F.ws + WS_U); bf16_t* YG = (bf16_t*)(F.ws + WS_YG); const float* dsk = arg_in(10) + l * DS;
    const int lane = F.lane, n = lane & 15, kq = lane >> 4, wave = F.wave;
    LAS unsigned char* ktl = F.lds + LDS_RING;
    LAS unsigned char* xs = F.lds + LDS_RING + 33792 + wave * 4096;
    LAS f32x2* EB = (LAS f32x2*)(F.lds + LDS_RING + 33792 + 8 * 4096);
    LAS f32x2* EH = EB + 512;
    for (int wu = F.bx; wu < NG * 8; wu += F.G) {
        const int g = wu >> 3, scq = wu & 7, b = scq >> 1, cbase = (scq & 1) * 64, scl = wave >> 1, par = wave & 1;
        __syncthreads();
        for (int i = F.tid; i < 65 * 32; i += NTHREADS) *(LAS u32x4*)(ktl + i * 16) = *(const u32x4*)(KT + (size_t)g * 65 * 256 + i * 8);
        const Cplx L = Cplx{LAML[(g * NP + lane) * 2], LAML[(g * NP + lane) * 2 + 1]};
        const float* sp = S + ((size_t)(b * CPB) * NG + g) * 128 + 2 * lane;
        {
            f32x2 sv[8];
#pragma unroll
            for (int j = 0; j < 8; ++j) sv[j] = *(const f32x2*)(sp + (size_t)(cbase + 8 * wave + j) * NG * 128);
            Cplx E{0.f, 0.f};
#pragma unroll
            for (int j = 0; j < 8; ++j) { const Cplx nx = cmul(L, E); E.re = nx.re + sv[j][0]; E.im = nx.im + sv[j][1]; }
            EB[wave * 64 + lane] = (f32x2){E.re, E.im};
            if (cbase) {
#pragma unroll
                for (int j = 0; j < 8; ++j) sv[j] = *(const f32x2*)(sp + (size_t)(8 * wave + j) * NG * 128);
                Cplx H{0.f, 0.f};
#pragma unroll
                for (int j = 0; j < 8; ++j) { const Cplx nx = cmul(L, H); H.re = nx.re + sv[j][0]; H.im = nx.im + sv[j][1]; }
                EH[wave * 64 + lane] = (f32x2){H.re, H.im};
            }
        }
        __syncthreads();
        const int c0 = cbase + 16 * scl;
        {
            const Cplx L2 = cmul(L, L), L4 = cmul(L2, L2), L8 = cmul(L4, L4);
            Cplx X{0.f, 0.f};
            if (cbase) {
#pragma unroll
                for (int w = 0; w < 8; ++w) { const f32x2 e = EH[w * 64 + lane]; const Cplx nx = cmul(L8, X); X.re = nx.re + e[0]; X.im = nx.im + e[1]; }
            }
            for (int w = 0; w < 2 * scl; ++w) { const f32x2 e = EB[w * 64 + lane]; const Cplx nx = cmul(L8, X); X.re = nx.re + e[0]; X.im = nx.im + e[1]; }
            f32x2 sv[16];
#pragma unroll
            for (int j = 0; j < 16; ++j) sv[j] = *(const f32x2*)(sp + (size_t)(c0 + j) * NG * 128);
#pragma unroll
            for (int j = 0; j < 16; ++j) {
                *(LAS unsigned*)(xs + j * 256 + 4 * lane) = pk2(X.re, X.im);
                const Cplx nx = cmul(L, X); X.re = nx.re + sv[j][0]; X.im = nx.im + sv[j][1];
            }
        }
        const int chunk = b * CPB + c0 + n;
        bf16x8 ub[32];
        {
            const bf16_t* up = U + ((size_t)chunk * 64 + (kq >> 1)) * DS + g * 16 + 8 * (kq & 1);
#pragma unroll
            for (int kp = 0; kp < 32; ++kp) ub[kp] = *(const bf16x8*)(up + (size_t)(2 * kp) * DS);
        }
        const LAS unsigned char* xbp = xs + n * 256 + 16 * kq;
        const f32x4 dv = *(const f32x4*)(dsk + g * 16 + 4 * kq);
        const bf16_t* hp = HT + ((size_t)(g * 1024 + n) * 128 + 8 * kq);
        const bf16_t* uq = U + (size_t)chunk * 64 * DS + g * 16 + 4 * kq;
        const LAS unsigned char* kbase = ktl + (n * 16 + 8 * (kq & 1)) * 2;
        bf16x8 ha[4]; u32x2 uw;
#pragma unroll
        for (int ks = 0; ks < 4; ++ks) ha[ks] = *(const bf16x8*)(hp + (size_t)(par * 16) * 128 + 32 * ks);
        uw = *(const u32x2*)(uq + (size_t)par * DS);
        for (int ti = 0; ti < 32; ++ti) {
            const int t = 2 * ti + par, tn = (ti < 31) ? t + 2 : t;
            bf16x8 hn[4]; u32x2 un;
#pragma unroll
            for (int ks = 0; ks < 4; ++ks) hn[ks] = *(const bf16x8*)(hp + (size_t)(tn * 16) * 128 + 32 * ks);
            un = *(const u32x2*)(uq + (size_t)tn * DS);
            f32x4 acc = (f32x4){0.f, 0.f, 0.f, 0.f};
            const int slot0 = t + 1 - (kq >> 1);
#pragma unroll
            for (int kp = 0; kp < 32; ++kp) {
                if (kp <= ti) { const bf16x8 a = *(const LAS bf16x8*)(kbase + (slot0 - 2 * kp) * 512); acc = __builtin_amdgcn_mfma_f32_16x16x32_bf16(a, ub[kp], acc, 0, 0, 0); }
            }
#pragma unroll
            for (int ks = 0; ks < 4; ++ks) acc = __builtin_amdgcn_mfma_f32_16x16x32_bf16(ha[ks], *(const LAS bf16x8*)(xbp + 64 * ks), acc, 0, 0, 0);
            const float y0 = acc[0] + dv[0] * bf_lo(uw.x), y1 = acc[1] + dv[1] * bf_hi(uw.x), y2 = acc[2] + dv[2] * bf_lo(uw.y), y3 = acc[3] + dv[3] * bf_hi(uw.y);
            u32x2 w; w.x = cvt_pk_bf16(gelu_tanh(y0), gelu_tanh(y1)); w.y = cvt_pk_bf16(gelu_tanh(y2), gelu_tanh(y3));
            *(u32x2*)(YG + ((size_t)chunk * 64 + t) * DS + g * 16 + 4 * kq) = w;
#pragma unroll
            for (int ks = 0; ks < 4; ++ks) ha[ks] = hn[ks];
            uw = un;
        }
    }
    __syncthreads();
}

namespace att {
constexpr int KSLOT = 16384, VSLOT = 16384, LDS_K = 0, LDS_V = 3 * KSLOT, LDS_WS = 6 * 16384, LDS_END = LDS_WS + 8 * 256;
constexpr int STG_ROW = 136;
__device__ __forceinline__ int crow(int r, int hi) { return (r & 3) + 8 * (r >> 2) + 4 * hi; }
__device__ __forceinline__ void glds16(const void* gsrc, unsigned lds_dst) { unsigned keep;
    asm volatile("s_mov_b32 %0, m0\n\ts_mov_b32 m0, %2\n\ts_nop 0\n\tglobal_load_lds_dwordx4 %1, off\n\ts_mov_b32 m0, %0" : "=&s"(keep) : "v"(gsrc), "s"(lds_dst) : "memory"); }
typedef __attribute__((address_space(3))) const char* lds_cptr;
typedef short v4i16_t __attribute__((ext_vector_type(4)));
__device__ __forceinline__ s16x4 vtr(lds_cptr p) { return __builtin_bit_cast(s16x4, __builtin_amdgcn_ds_read_tr16_b64_v4i16((__attribute__((address_space(3))) v4i16_t*)p)); }
#define ATT_WAIT_BAR(N) asm volatile("s_waitcnt vmcnt(" #N ") lgkmcnt(0)\n\ts_barrier" ::: "memory")

template <int MODE> __device__ __forceinline__ void attn_unit(int bh, int qb, const bf16_t* Q, const bf16_t* K, const bf16_t* V, bf16_t* MIX, const float* subg, float lam, float mshift, float oml,
                                          LAS unsigned char* shm, int tid) {
    const int lane = tid & 63, r32 = lane & 31, hi = lane >> 5; const int wid = __builtin_amdgcn_readfirstlane(tid >> 6);
    const int b = bh >> 2, h = bh & 3, m = wid & 1, qg = wid >> 1;
    const size_t rowbase = (size_t)b * SEQ; const int q0 = qb * 128;
    const int NT = 2 * qb + 2, cw = 2 * qb + (qg >> 1);
    const unsigned lds0 = (unsigned)(uintptr_t)shm;
    const bf16_t* k0src = K + (rowbase + lane) * DA + h * 128 + wid * 8;
    const bf16_t* k1src = k0src + 64;
    const bf16_t* v0src = V + (rowbase + 16 * (wid & 3) + (lane >> 2)) * DA + h * 128 + (wid >> 2) * 32 + (lane & 3) * 8;
    const bf16_t* v1src = v0src + 64;
    const unsigned kdst = lds0 + LDS_K + wid * 1024, vdst = lds0 + LDS_V + wid * 1024;
#define ATT_DMA(t, slot) do { const size_t _o = (size_t)(t) * 64 * DA; \
        glds16(k0src + _o, (unsigned)__builtin_amdgcn_readfirstlane(kdst + (slot) * KSLOT)); glds16(k1src + _o, (unsigned)__builtin_amdgcn_readfirstlane(kdst + (slot) * KSLOT + 8192)); \
        glds16(v0src + _o, (unsigned)__builtin_amdgcn_readfirstlane(vdst + (slot) * VSLOT)); glds16(v1src + _o, (unsigned)__builtin_amdgcn_readfirstlane(vdst + (slot) * VSLOT + 8192)); } while (0)
    bf16x8 qr[4];
    { const bf16_t* Qw = Q + (rowbase + q0 + qg * 32 + r32) * DA + h * 128 + m * 64 + hi * 8;
#pragma unroll
      for (int d0 = 0; d0 < 4; ++d0) qr[d0] = *(const bf16x8*)(Qw + d0 * 16); }
#ifndef ATT_GRP
#define ATT_GRP (wid & 1)
#endif
    const int grp = ATT_GRP;
#define ATT_DMA_K(t, slot) do { if (MODE & 1) break; const size_t _o = (size_t)(t) * 64 * DA; \
        glds16(k0src + _o, (unsigned)__builtin_amdgcn_readfirstlane(kdst + (slot) * KSLOT)); glds16(k1src + _o, (unsigned)__builtin_amdgcn_readfirstlane(kdst + (slot) * KSLOT + 8192)); } while (0)
#define ATT_DMA_V(t, slot) do { if (MODE & 1) break; const size_t _o = (size_t)(t) * 64 * DA; \
        glds16(v0src + _o, (unsigned)__builtin_amdgcn_readfirstlane(vdst + (slot) * VSLOT)); glds16(v1src + _o, (unsigned)__builtin_amdgcn_readfirstlane(vdst + (slot) * VSLOT + 8192)); } while (0)
    ATT_DMA_K(0, 0); ATT_DMA_V(0, 0); ATT_DMA_K(1, 1); ATT_DMA_V(1, 1);
    f32x16 o[4];
#pragma unroll
    for (int d = 0; d < 4; ++d)
#pragma unroll
        for (int r = 0; r < 16; ++r) o[d][r] = 0.f;
    float l_reg = 0.f;
    const f32x16 zero16 = {0.f, 0.f, 0.f, 0.f, 0.f, 0.f, 0.f, 0.f, 0.f, 0.f, 0.f, 0.f, 0.f, 0.f, 0.f, 0.f};
    (void)mshift;
    const lds_cptr shm3 = (lds_cptr)shm;
    const lds_cptr kp0 = shm3 + LDS_K + m * 8192 + hi * 1024 + r32 * 16;
    const lds_cptr vp0 = shm3 + LDS_V + ((lane >> 4) & 1) * 32 + (lane & 3) * 8 + (4 * hi + ((lane & 15) >> 2)) * 64;
    u32x4 pw[4];
#pragma unroll
    for (int q = 0; q < 4; ++q) pw[q] = (u32x4){0u, 0u, 0u, 0u};
#define ATT_SB() __builtin_amdgcn_sched_barrier(0)
#define ATT_QKEXP(sl) do { if (MODE & 2) break; const lds_cptr kp = kp0 + (sl) * KSLOT; bf16x8 kf[8]; \
        ATT_SB(); \
        _Pragma("unroll") for (int j = 0; j < 4; ++j) { kf[2 * j] = *(const __attribute__((address_space(3))) bf16x8*)(kp + j * 2048); kf[2 * j + 1] = *(const __attribute__((address_space(3))) bf16x8*)(kp + j * 2048 + 512); } \
        ATT_SB(); \
        f32x16 p0 = __builtin_amdgcn_mfma_f32_32x32x16_bf16(kf[0], qr[0], zero16, 0, 0, 0); \
        f32x16 p1 = __builtin_amdgcn_mfma_f32_32x32x16_bf16(kf[1], qr[0], zero16, 0, 0, 0); \
        _Pragma("unroll") for (int d0 = 1; d0 < 4; ++d0) { p0 = __builtin_amdgcn_mfma_f32_32x32x16_bf16(kf[2 * d0], qr[d0], p0, 0, 0, 0); p1 = __builtin_amdgcn_mfma_f32_32x32x16_bf16(kf[2 * d0 + 1], qr[d0], p1, 0, 0, 0); } \
        ATT_SB(); \
        float sacc = 0.f; \
        _Pragma("unroll") for (int r = 0; r < 16; ++r) { p0[r] = __builtin_amdgcn_exp2f(p0[r]); p1[r] = __builtin_amdgcn_exp2f(p1[r]); sacc += p0[r] + p1[r]; } \
        l_reg += sacc; \
        _Pragma("unroll") for (int q = 0; q < 4; ++q) { pw[0][q] = cvt_pk_bf16(p0[2 * q], p0[2 * q + 1]); pw[1][q] = cvt_pk_bf16(p0[8 + 2 * q], p0[8 + 2 * q + 1]); \
                                                        pw[2][q] = cvt_pk_bf16(p1[2 * q], p1[2 * q + 1]); pw[3][q] = cvt_pk_bf16(p1[8 + 2 * q], p1[8 + 2 * q + 1]); } } while (0)
#define ATT_VRD(buf, d) do { _Pragma("unroll") for (int ks = 0; ks < 4; ++ks) { buf[0][ks] = vtr(vp + (d) * 4096 + ks * 1024); buf[1][ks] = vtr(vp + (d) * 4096 + ks * 1024 + 512); } } while (0)
#define ATT_VMM(buf, d) do { _Pragma("unroll") for (int ks = 0; ks < 4; ++ks) { \
        const bf16x8 vf = (bf16x8){buf[0][ks][0], buf[0][ks][1], buf[0][ks][2], buf[0][ks][3], buf[1][ks][0], buf[1][ks][1], buf[1][ks][2], buf[1][ks][3]}; \
        o[d] = __builtin_amdgcn_mfma_f32_32x32x16_bf16(__builtin_bit_cast(bf16x8, pw[ks]), vf, o[d], 0, 0, 0); } } while (0)
#define ATT_PV(sl) do { if (MODE & 4) break; const lds_cptr vp = vp0 + (sl) * VSLOT; s16x4 va[2][4], vb[2][4]; \
        ATT_SB(); ATT_VRD(va, 0); ATT_SB(); ATT_VRD(vb, 1); ATT_SB(); ATT_VMM(va, 0); ATT_SB(); ATT_VRD(va, 2); ATT_SB(); ATT_VMM(vb, 1); ATT_SB(); \
        ATT_VRD(vb, 3); ATT_SB(); ATT_VMM(va, 2); ATT_SB(); ATT_VMM(vb, 3); ATT_SB(); } while (0)
#ifndef ATT_TWO_GROUP
#define ATT_TWO_GROUP 0
#endif
    int sk = 0, skm1 = 2;
    if (ATT_TWO_GROUP) {
        for (int k = 0; k <= NT; ++k) {
            if (k + 1 < NT) { ATT_WAIT_BAR(4); } else { ATT_WAIT_BAR(0); }
            if (k + 2 < NT) ATT_DMA_K(k + 2, skm1);
            if (grp == 0) { if (k <= cw) ATT_QKEXP(sk); }
            else          { if (k >= 1 && k - 1 <= cw) ATT_PV(skm1); }
            if (k == NT) break;
            if (k + 2 < NT) { ATT_WAIT_BAR(4); } else { ATT_WAIT_BAR(0); }
            if (k + 2 < NT) ATT_DMA_V(k + 2, skm1);
            if (grp == 0) { if (k <= cw) ATT_PV(sk); }
            else          { if (k <= cw) ATT_QKEXP(sk); }
            skm1 = sk; sk = (sk == 2) ? 0 : sk + 1;
        }
    } else {
        for (int k = 0; k < NT; ++k) {
            if (k + 1 < NT) { ATT_WAIT_BAR(4); } else { ATT_WAIT_BAR(0); }
            if (k + 2 < NT) { ATT_DMA_K(k + 2, skm1); ATT_DMA_V(k + 2, skm1); }
            if (k <= cw) { ATT_QKEXP(sk); ATT_PV(sk); }
            skm1 = sk; sk = (sk == 2) ? 0 : sk + 1;
        }
    }
#undef ATT_QKEXP
#undef ATT_PV
#undef ATT_VRD
#undef ATT_VMM
#undef ATT_SB
#undef ATT_DMA_K
#undef ATT_DMA_V
    { auto rr = __builtin_amdgcn_permlane32_swap(__float_as_uint(l_reg), __float_as_uint(l_reg), false, false); l_reg = __uint_as_float(rr[0]) + __uint_as_float(rr[1]); }
    LAS float* wsf = (LAS float*)(shm + LDS_WS) + wid * 64;
    if (hi == 0) wsf[r32] = l_reg;
    ATT_WAIT_BAR(0);
    float rli[16];
    const float scl = m ? lam : 1.0f;
#pragma unroll
    for (int r = 0; r < 16; ++r) rli[r] = scl * __builtin_amdgcn_rcpf(wsf[crow(r, hi)]);
    LAS float* stg = (LAS float*)shm + qg * (32 * STG_ROW);
    if (m == 1) {
#pragma unroll
        for (int r = 0; r < 16; ++r)
#pragma unroll
            for (int d = 0; d < 4; ++d) stg[crow(r, hi) * STG_ROW + d * 32 + r32] = o[d][r] * rli[r];
    }
    ATT_WAIT_BAR(0);
    if (m == 0) {
#pragma unroll
        for (int r = 0; r < 16; ++r)
#pragma unroll
            for (int d = 0; d < 4; ++d) { LAS float* p = stg + crow(r, hi) * STG_ROW + d * 32 + r32; *p = o[d][r] * rli[r] - *p; }
    }
    ATT_WAIT_BAR(0);
    {
        const int row = 16 * m + (lane >> 2), qt = lane & 3;
        const LAS float* p = stg + row * STG_ROW + qt * 32;
        f32x4 v[8]; float ss = 0.f;
#pragma unroll
        for (int i = 0; i < 8; ++i) { v[i] = *(const LAS f32x4*)(p + 4 * i); ss += (v[i][0] * v[i][0] + v[i][1] * v[i][1]) + (v[i][2] * v[i][2] + v[i][3] * v[i][3]); }
        ss += __shfl_xor(ss, 1); ss += __shfl_xor(ss, 2);
        const float rn = rsqrtf(ss * (1.f / 128.f) + EPS) * oml;
        bf16_t* dst = MIX + (rowbase + q0 + qg * 32 + row) * D + DS + h * 128 + qt * 32;
#pragma unroll
        for (int i = 0; i < 4; ++i) {
            const f32x4 g0 = *(const f32x4*)(subg + qt * 32 + 8 * i), g1 = *(const f32x4*)(subg + qt * 32 + 8 * i + 4);
            const f32x4 a = v[2 * i] * g0 * rn, c = v[2 * i + 1] * g1 * rn;
            u32x4 w; w.x = cvt_pk_bf16(a[0], a[1]); w.y = cvt_pk_bf16(a[2], a[3]); w.z = cvt_pk_bf16(c[0], c[1]); w.w = cvt_pk_bf16(c[2], c[3]);
            *(u32x4*)(dst + 8 * i) = w;
        }
    }
    ATT_WAIT_BAR(0);
#undef ATT_DMA
}
}
template <int MODE> __device__ __forceinline__ void attn_phase(Frame& F, int l) {
    const bf16_t* Q = (const bf16_t*)(F.ws + WS_Q); const bf16_t* K = (const bf16_t*)(F.ws + WS_K); const bf16_t* V = (const bf16_t*)(F.ws + WS_V);
    bf16_t* MIX = (bf16_t*)(F.ws + WS_MIX);
    const float* sc = (const float*)(F.ws + WS_SCAL) + l * 4;
    const float lam = sc[0], mshift = sc[1], oml = sc[2];
    const float* subg = arg_in(19) + l * DV;
    const int G = F.G;
#ifndef ATT_XA
#define ATT_XA 1
#endif
    const bool xa = ATT_XA && (G & 7) == 0;
    const int x = F.bx & 7, j = F.bx >> 3, wpx = xa ? (G >> 3) : 1;
    const int npair = xa ? (32 - j + wpx - 1) / wpx : 0;
    const int nit = xa ? 4 * npair : (1024 - F.bx + G - 1) / G;
#pragma unroll 1
    for (int it = 0; it < nit; ++it) {
        int bh, qb;
        if (xa) { const int r = it / (2 * npair), rem = it % (2 * npair), sidx = j + (rem >> 1) * wpx; bh = 2 * x + r; qb = (rem & 1) ? sidx : 63 - sidx; }
        else { const int v = F.bx + it * G; bh = v >> 6; qb = v & 63; }
        att::attn_unit<MODE>(bh, qb, Q, K, V, MIX, subg, lam, mshift, oml, F.lds + LDS_RING, F.tid);
    }
}

__device__ __forceinline__ void router_phase(Frame& F, int l) {
    const float* h1 = F.out; const float* g = arg_in(21) + (size_t)l * D; const float* br = arg_in(23) + l * NE;
    const bf16_t* WRT = (const bf16_t*)(F.ws + WS_WRT + l * WRT_STRIDE);
    bf16_t* XN = (bf16_t*)(F.ws + WS_XN); int* TOPI = (int*)(F.ws + WS_TOPI); float* TOPG = (float*)(F.ws + WS_TOPG); int* WGCNT = (int*)(F.ws + WS_WGCNT); float* RS = (float*)(F.ws + WS_RS);
    const int lane = F.lane, tid = F.tid, wave = F.wave, n = lane & 15, kq = lane >> 4;
    constexpr int PITCH = 2080;
    LAS unsigned char* wl = F.lds + LDS_RING;
    LAS float* lg = (LAS float*)(F.lds + LDS_RING + 2 * 32 * PITCH) + wave * (16 * 33 + 16);
    LAS int* cnt = (LAS int*)(F.ctl + 256);
    __syncthreads();
    for (int i = tid; i < 2 * NE * 128; i += NTHREADS) { const int row = i >> 7, c = i & 127; *(LAS u32x4*)(wl + row * PITCH + c * 16) = *(const u32x4*)(WRT + (size_t)row * D + c * 8); }
    if (tid < 32) cnt[tid] = 0;
    __syncthreads();
    for (int wgu = F.bx; wgu < T / 128; wgu += F.G) {
        if (wgu != F.bx) { __syncthreads(); if (tid < 32) cnt[tid] = 0; __syncthreads(); }
        const int row = wgu * 128 + wave * 16 + n;
        const float* hp = h1 + (size_t)row * D + 8 * kq; const float* gp = g + 8 * kq;
        bf16_t* xp = XN + (size_t)row * D + 8 * kq; unsigned char* xp8 = (unsigned char*)XN + (size_t)row * D + 8 * kq;
        const LAS unsigned char* bh = wl + n * PITCH + 16 * kq;
        f32x4 acc0 = (f32x4){0.f, 0.f, 0.f, 0.f}, acc1 = acc0; float ss = 0.f;
#pragma unroll 4
        for (int ks = 0; ks < 32; ++ks) {
            const f32x4 h0 = *(const f32x4*)(hp + 32 * ks), h4 = *(const f32x4*)(hp + 32 * ks + 4);
            const f32x4 g0 = *(const f32x4*)(gp + 32 * ks), g4 = *(const f32x4*)(gp + 32 * ks + 4);
            const f32x4 x0 = h0 * g0, x4 = h4 * g4;
            ss += (x0[0] * x0[0] + x0[1] * x0[1]) + (x0[2] * x0[2] + x0[3] * x0[3]) + (x4[0] * x4[0] + x4[1] * x4[1]) + (x4[2] * x4[2] + x4[3] * x4[3]);
            u32x4 hi; hi.x = cvt_pk_bf16(x0[0], x0[1]); hi.y = cvt_pk_bf16(x0[2], x0[3]); hi.z = cvt_pk_bf16(x4[0], x4[1]); hi.w = cvt_pk_bf16(x4[2], x4[3]);
            if (UP_FP8) { u32x2 w8; w8.x = pk4_fp8(x0[0] * 8.f, x0[1] * 8.f, x0[2] * 8.f, x0[3] * 8.f); w8.y = pk4_fp8(x4[0] * 8.f, x4[1] * 8.f, x4[2] * 8.f, x4[3] * 8.f); *(u32x2*)(xp8 + 32 * ks) = w8; }
            else *(u32x4*)(xp + 32 * ks) = hi;
            u32x4 lo;
            lo.x = cvt_pk_bf16(x0[0] - bf_lo(hi.x), x0[1] - bf_hi(hi.x)); lo.y = cvt_pk_bf16(x0[2] - bf_lo(hi.y), x0[3] - bf_hi(hi.y));
            lo.z = cvt_pk_bf16(x4[0] - bf_lo(hi.z), x4[1] - bf_hi(hi.z)); lo.w = cvt_pk_bf16(x4[2] - bf_lo(hi.w), x4[3] - bf_hi(hi.w));
            const bf16x8 ah = __builtin_bit_cast(bf16x8, hi), al = __builtin_bit_cast(bf16x8, lo);
            const bf16x8 b0h = *(const LAS bf16x8*)(bh + 64 * ks), b1h = *(const LAS bf16x8*)(bh + 16 * PITCH + 64 * ks);
            const bf16x8 b0l = *(const LAS bf16x8*)(bh + 32 * PITCH + 64 * ks), b1l = *(const LAS bf16x8*)(bh + 48 * PITCH + 64 * ks);
            acc0 = __builtin_amdgcn_mfma_f32_16x16x32_bf16(ah, b0h, acc0, 0, 0, 0); acc1 = __builtin_amdgcn_mfma_f32_16x16x32_bf16(ah, b1h, acc1, 0, 0, 0);
            acc0 = __builtin_amdgcn_mfma_f32_16x16x32_bf16(al, b0h, acc0, 0, 0, 0); acc1 = __builtin_amdgcn_mfma_f32_16x16x32_bf16(al, b1h, acc1, 0, 0, 0);
            acc0 = __builtin_amdgcn_mfma_f32_16x16x32_bf16(ah, b0l, acc0, 0, 0, 0); acc1 = __builtin_amdgcn_mfma_f32_16x16x32_bf16(ah, b1l, acc1, 0, 0, 0);
        }
        ss += __shfl_xor(ss, 16); ss += __shfl_xor(ss, 32);
        const float r = rsqrtf(ss * (1.f / D) + EPS);
        if (kq == 0) { lg[16 * 33 + n] = r; RS[row] = r; }
        asm volatile("s_waitcnt lgkmcnt(0)" ::: "memory");
        const float b0 = br[n], b1 = br[16 + n];
#pragma unroll
        for (int q = 0; q < 4; ++q) { const float rt = lg[16 * 33 + 4 * kq + q]; lg[(4 * kq + q) * 33 + n] = acc0[q] * rt + b0; lg[(4 * kq + q) * 33 + 16 + n] = acc1[q] * rt + b1; }
        asm volatile("s_waitcnt lgkmcnt(0)" ::: "memory");
        if (lane < 16) {
            const int tok = wgu * 128 + wave * 16 + lane;
            float v[32];
#pragma unroll
            for (int e = 0; e < 32; ++e) v[e] = lg[lane * 33 + e];
            unsigned mask = 0u; float val[4]; int sel[4];
#pragma unroll
            for (int k = 0; k < 4; ++k) { float best = -INFINITY; int bi = 0;
#pragma unroll
                for (int e = 0; e < 32; ++e) { const bool ok = !((mask >> e) & 1u) && (v[e] > best); best = ok ? v[e] : best; bi = ok ? e : bi; }
                mask |= 1u << bi; val[k] = best; sel[k] = bi; }
            float ex[4], sum = 0.f;
#pragma unroll
            for (int k = 0; k < 4; ++k) { ex[k] = __expf(val[k] - val[0]); sum += ex[k]; }
            const float inv = 1.f / sum;
#pragma unroll
            for (int k = 0; k < 4; ++k) { const int pos = __hip_atomic_fetch_add(cnt + sel[k], 1, __ATOMIC_RELAXED, __HIP_MEMORY_SCOPE_WORKGROUP);
                TOPI[tok * 4 + k] = sel[k] | (pos << 8); TOPG[tok * 4 + k] = ex[k] * inv; }
        }
        __syncthreads();
        if (tid < 32) WGCNT[wgu * 32 + tid] = cnt[tid];
    }
    __syncthreads();
}
__device__ __forceinline__ void routing_phase(Frame& F) {
    const int* TOPI = (const int*)(F.ws + WS_TOPI); const float* TOPG = (const float*)(F.ws + WS_TOPG); const int* WGCNT = (const int*)(F.ws + WS_WGCNT);
    int* TOKROW = (int*)(F.ws + WS_TOKROW); int* ROWTOK = (int*)(F.ws + WS_ROWTOK); float* ROWGATE = (float*)(F.ws + WS_ROWGATE); int* TILEEXP = (int*)(F.ws + WS_TILEEXP);
    float* ROWSCALE = (float*)(F.ws + WS_ROWSCALE); const float* RS = (const float*)(F.ws + WS_RS);
    const int tid = F.tid;
    LAS int* tot = (LAS int*)(F.lds + LDS_RING);
    LAS int* pst = tot + 32;
    LAS int* mypre = pst + 40;
    LAS int* part = mypre + 32;
    for (int wgu = F.bx; wgu < 256; wgu += F.G) {
        __syncthreads();
        {
            const int e = tid & 31, wq = tid >> 5; int a = 0, mine = 0;
#pragma unroll
            for (int j = 0; j < 16; ++j) { const int w = wq * 16 + j; const int c = WGCNT[w * 32 + e]; a += c; if (w < wgu) mine += c; }
            part[wq * 32 + e] = a; part[512 + wq * 32 + e] = mine;
        }
        __syncthreads();
        if (tid < 32) { int a = 0, mine = 0;
#pragma unroll
            for (int q = 0; q < 16; ++q) { a += part[q * 32 + tid]; mine += part[512 + q * 32 + tid]; }
            tot[tid] = a; mypre[tid] = mine; }
        __syncthreads();
        if (tid == 0) { int a = 0; for (int e = 0; e < 32; ++e) { pst[e] = a; a += (tot[e] + 255) & ~255; } pst[32] = a; }
        __syncthreads();
        {
            const int t = wgu * 128 + (tid >> 2), k = tid & 3;
            const int w = TOPI[t * 4 + k]; const int e = w & 255, pos = w >> 8;
            const int dest = pst[e] + mypre[e] + pos;
            ROWTOK[dest] = t; ROWGATE[dest] = TOPG[t * 4 + k]; ROWSCALE[dest] = RS[t]; TOKROW[t * 4 + k] = dest;
        }
        if (wgu < 32) {
            const int e = wgu; const int beg = pst[e] + tot[e], end = pst[e + 1];
            for (int r = beg + tid; r < end; r += NTHREADS) { ROWTOK[r] = 0; ROWGATE[r] = 0.f; ROWSCALE[r] = 0.f; }
        }
        if (wgu == 0) {
            const int ntiles = pst[32] >> 8;
            for (int pm = tid; pm < ntiles; pm += NTHREADS) { int e = 0; for (int q = 1; q < 32; ++q) if ((pm << 8) >= pst[q]) e = q; TILEEXP[pm] = e; }
            if (tid == 0) TILEEXP[1023] = ntiles;
            if (tid < 33) TILEEXP[768 + tid] = pst[tid];
        }
    }
    __syncthreads();
}
struct CRow { f32x4 h[4]; u32x4 y[4][2]; };
__device__ __forceinline__ void crow_load(CRow& r, const float* out, const bf16_t* YB, const int* TOKROW, int m, int lane) {
    const float* hr = out + (size_t)m * D + 8 * lane;
    r.h[0] = *(const f32x4*)(hr); r.h[1] = *(const f32x4*)(hr + 4); r.h[2] = *(const f32x4*)(hr + 512); r.h[3] = *(const f32x4*)(hr + 516);
    const int4 tr = *(const int4*)(TOKROW + m * 4);
    const int rows[4] = {tr.x, tr.y, tr.z, tr.w};
#pragma unroll
    for (int k = 0; k < 4; ++k) { const bf16_t* yr = YB + (size_t)rows[k] * D + 8 * lane; r.y[k][0] = *(const u32x4*)(yr); r.y[k][1] = *(const u32x4*)(yr + 512); }
}
__device__ __forceinline__ void crow_finish(CRow& r, float* out, bf16_t* XN, const float* gnext, int m, int lane) {
#pragma unroll
    for (int k = 0; k < 4; ++k)
#pragma unroll
        for (int hf = 0; hf < 2; ++hf) { const u32x4 w = r.y[k][hf];
            r.h[2 * hf][0] += bf_lo(w.x); r.h[2 * hf][1] += bf_hi(w.x); r.h[2 * hf][2] += bf_lo(w.y); r.h[2 * hf][3] += bf_hi(w.y);
            r.h[2 * hf + 1][0] += bf_lo(w.z); r.h[2 * hf + 1][1] += bf_hi(w.z); r.h[2 * hf + 1][2] += bf_lo(w.w); r.h[2 * hf + 1][3] += bf_hi(w.w); }
    float* orow = out + (size_t)m * D + 8 * lane;
    *(f32x4*)(orow) = r.h[0]; *(f32x4*)(orow + 4) = r.h[1]; *(f32x4*)(orow + 512) = r.h[2]; *(f32x4*)(orow + 516) = r.h[3];
    if (gnext) {
        float s = 0.f;
#pragma unroll
        for (int j = 0; j < 4; ++j) s += (r.h[j][0] * r.h[j][0] + r.h[j][1] * r.h[j][1]) + (r.h[j][2] * r.h[j][2] + r.h[j][3] * r.h[j][3]);
        const float rr = rsqrtf(wave_sum(s) * (1.f / D) + EPS);
        const float* gp = gnext + 8 * lane;
        const f32x4 a0 = r.h[0] * *(const f32x4*)(gp) * rr, a1 = r.h[1] * *(const f32x4*)(gp + 4) * rr, a2 = r.h[2] * *(const f32x4*)(gp + 512) * rr, a3 = r.h[3] * *(const f32x4*)(gp + 516) * rr;
        u32x4 w; w.x = cvt_pk_bf16(a0[0], a0[1]); w.y = cvt_pk_bf16(a0[2], a0[3]); w.z = cvt_pk_bf16(a1[0], a1[1]); w.w = cvt_pk_bf16(a1[2], a1[3]);
        *(u32x4*)(XN + (size_t)m * D + 8 * lane) = w;
        w.x = cvt_pk_bf16(a2[0], a2[1]); w.y = cvt_pk_bf16(a2[2], a2[3]); w.z = cvt_pk_bf16(a3[0], a3[1]); w.w = cvt_pk_bf16(a3[2], a3[3]);
        *(u32x4*)(XN + (size_t)m * D + 512 + 8 * lane) = w;
    }
}
__device__ __forceinline__ void combine_phase(Frame& F, const float* gnext, float* dst) {
    const bf16_t* YB = (const bf16_t*)(F.ws + WS_YB); const int* TOKROW = (const int*)(F.ws + WS_TOKROW); bf16_t* XN = (bf16_t*)(F.ws + WS_XN);
    const int lane = F.lane, NGW = F.G * NWAVES;
    CRow ra, rb;
    int m = F.bx * NWAVES + F.wave;
    if (m < T) crow_load(ra, F.out, YB, TOKROW, m, lane);
    while (m < T) {
        const int mb = m + NGW;
        if (mb < T) crow_load(rb, F.out, YB, TOKROW, mb, lane);
        crow_finish(ra, dst, XN, gnext, m, lane);
        if (mb >= T) break;
        const int mc = mb + NGW;
        if (mc < T) crow_load(ra, F.out, YB, TOKROW, mc, lane);
        crow_finish(rb, dst, XN, gnext, mb, lane);
        m = mc;
    }
}

constexpr int NPH_LAYER = 10, NPH = 1 + DEPTH * NPH_LAYER;
__global__ void __launch_bounds__(NTHREADS, 2) mk_fwd(Args args) {
    extern __shared__ __attribute__((aligned(16))) unsigned char lds_raw[];
    Frame F;
    F.lds = (LAS unsigned char*)lds_raw; F.ctl = F.lds + LDS_CTL; F.ws = args.ws; F.ws0 = args.ws; F.out0 = args.out; F.ap = &args; F.z = 0;
    F.tid = threadIdx.x; F.lane = F.tid & 63; F.wave = __builtin_amdgcn_readfirstlane(F.tid >> 6); F.G = gridDim.x; F.bx = blockIdx.x;
    F.out = args.out;
    for (int u = F.tid; u < 1024; u += NTHREADS) ((LAS unsigned*)F.ctl)[u] = 0u;
    __syncthreads();
    XcdBarrier bar = xcd_barrier_post((unsigned*)(F.ws + WS_CTL) + CW_BAR, (volatile LAS unsigned*)F.ctl);
    const int lo = args.ph_lo, hi = args.ph_hi;
#ifndef PHMASK
#define PHMASK 0x1fff
#endif
#define RUN(k) (lo <= (k) && (k) < hi)
#define EN(b) ((PHMASK >> (b)) & 1)
#ifndef DUPMASK
#define DUPMASK 0
#endif
#ifndef ATT_PROBE_MODE
#define ATT_PROBE_MODE 0
#endif
#ifndef PRO_PROBE_MODE
#define PRO_PROBE_MODE 0
#endif
#define NREP(b) (((DUPMASK >> (b)) & 1) ? 2 : 1)
#define SEAM(k) do { if (RUN((k) + 1)) xcd_barrier(bar); } while (0)
    if (EN(10) && RUN(0)) { { if (NREP(10) == 2) { phase_begin(F); p0_prologue<PRO_PROBE_MODE>(F); xcd_barrier(bar); } phase_begin(F); p0_prologue<0>(F); } SEAM(0); }
    for (int l = 0; l < DEPTH; ++l) {
        const int pb = 1 + l * NPH_LAYER;
        if (EN(0) && RUN(pb + 0)) { for (int rep = 0; rep < NREP(0); ++rep) { phase_begin(F); unsigned char* ws = F.ws; (void)ws;
            PInProj P; P.so.init(T, DIN, F.G, F.bx); P.A = (const char*)(ws + WS_XN); P.B = (const char*)(ws + WS_WIN + l * WIN_STRIDE);
            P.UQKV = (bf16_t*)(ws + WS_U); P.GQK = (const float*)(ws + WS_SCAL) + 64 + l * 128; P.COS = (const float*)(ws + WS_COS); P.SIN = (const float*)(ws + WS_SIN);
            pg8::gemm_phase(F.lds + LDS_RING, F.ctl, P, F.tid);  if (rep + 1 < NREP(0)) xcd_barrier(bar); } SEAM(pb + 0);
        }
        if (EN(1) && RUN(pb + 1)) { for (int rep = 0; rep < NREP(1); ++rep) { phase_begin(F); unsigned char* ws = F.ws; (void)ws; s5a_phase(F, l);  if (rep + 1 < NREP(1)) xcd_barrier(bar); } SEAM(pb + 1); }
        if (EN(2) && RUN(pb + 2)) { for (int rep = 0; rep < NREP(2); ++rep) { phase_begin(F); unsigned char* ws = F.ws; (void)ws; if (EN(11)) for (int r2 = 0; r2 < NREP(11); ++r2) { phase_begin(F); s5c_phase(F, l); } if (EN(12)) { if (NREP(12) == 2) { phase_begin(F); attn_phase<ATT_PROBE_MODE>(F, l); } phase_begin(F); attn_phase<0>(F, l); }  if (rep + 1 < NREP(2)) xcd_barrier(bar); } SEAM(pb + 2); }
        if (EN(3) && RUN(pb + 3)) { for (int rep = 0; rep < NREP(3); ++rep) { phase_begin(F); unsigned char* ws = F.ws; (void)ws;
            PGlu P; P.so.init(T, DS, F.G, F.bx); P.A = (const char*)(ws + WS_YG); P.B = (const char*)(ws + WS_WGLU + l * WGLU_STRIDE);
            P.YG = (const bf16_t*)(ws + WS_YG); P.MIX = (bf16_t*)(ws + WS_MIX); P.RSP = (float*)(ws + WS_RSP);
            pg8::gemm_phase(F.lds + LDS_RING, F.ctl, P, F.tid);  if (rep + 1 < NREP(3)) xcd_barrier(bar); } SEAM(pb + 3);
        }
        if (EN(4) && RUN(pb + 4)) { for (int rep = 0; rep < NREP(4); ++rep) { phase_begin(F); unsigned char* ws = F.ws; (void)ws;
            POut P; P.so.init(T, D, F.G, F.bx); P.A = (const char*)(ws + WS_MIX); P.B = (const char*)(ws + WS_WOUT + l * WOUT_STRIDE);
            P.RSP = (const float*)(ws + WS_RSP); P.base = (l == 0) ? arg_in(0) : F.out; P.out = (rep + 1 < NREP(4)) ? (float*)(ws + WS_ACT) : F.out;
            pg8::gemm_phase(F.lds + LDS_RING, F.ctl, P, F.tid);  if (rep + 1 < NREP(4)) xcd_barrier(bar); } SEAM(pb + 4);
        }
        if (EN(5) && RUN(pb + 5)) { for (int rep = 0; rep < NREP(5); ++rep) { phase_begin(F); unsigned char* ws = F.ws; (void)ws; router_phase(F, l);  if (rep + 1 < NREP(5)) xcd_barrier(bar); } SEAM(pb + 5); }
        if (EN(6) && RUN(pb + 6)) { for (int rep = 0; rep < NREP(6); ++rep) { phase_begin(F); unsigned char* ws = F.ws; (void)ws; routing_phase(F);  if (rep + 1 < NREP(6)) xcd_barrier(bar); } SEAM(pb + 6); }
        if (EN(7) && RUN(pb + 7)) { for (int rep = 0; rep < NREP(7); ++rep) { phase_begin(F); unsigned char* ws = F.ws; (void)ws;
            PUp P; P.mo.init(F.G, F.bx, (const int*)(ws + WS_TILEEXP) + 768);
            P.A = (const char*)(ws + WS_XN); P.B = (const char*)(ws + WS_WUP + l * WUP_STRIDE); P.ROWTOK = (const int*)(ws + WS_ROWTOK); P.TILEEXP = (const int*)(ws + WS_TILEEXP);
            P.bup = arg_in(25) + (size_t)l * NE * 2048; P.ROWSCALE = (const float*)(ws + WS_ROWSCALE); P.ACT = (bf16_t*)(ws + WS_ACT);
            pg8::gemm_phase(F.lds + LDS_RING, F.ctl, P, F.tid);  if (rep + 1 < NREP(7)) xcd_barrier(bar); } SEAM(pb + 7);
        }
        if (EN(8) && RUN(pb + 8)) { for (int rep = 0; rep < NREP(8); ++rep) { phase_begin(F); unsigned char* ws = F.ws; (void)ws;
            PDown P; P.mo.init(F.G, F.bx, (const int*)(ws + WS_TILEEXP) + 768);
            P.A = (const char*)(ws + WS_ACT); P.B = (const char*)(ws + WS_WDN + l * WDN_STRIDE); P.TILEEXP = (const int*)(ws + WS_TILEEXP);
            P.bdn = arg_in(27) + (size_t)l * NE * 1024; P.ROWGATE = (const float*)(ws + WS_ROWGATE); P.YB = (bf16_t*)(ws + WS_YB);
            pg8::gemm_phase(F.lds + LDS_RING, F.ctl, P, F.tid);  if (rep + 1 < NREP(8)) xcd_barrier(bar); } SEAM(pb + 8);
        }
        if (EN(9) && RUN(pb + 9)) { for (int rep = 0; rep < NREP(9); ++rep) { phase_begin(F); unsigned char* ws = F.ws; (void)ws; combine_phase(F, (l + 1 < DEPTH) ? arg_in(1) + (size_t)(l + 1) * D : nullptr, (rep + 1 < NREP(9)) ? (float*)(ws + WS_ACT) : F.out);  if (rep + 1 < NREP(9)) xcd_barrier(bar); } SEAM(pb + 9); }
    }
#undef RUN
#undef SEAM
}

extern "C" void kernel_launch(void* const* d_in, const int* in_sizes, int n_in, void* d_out, int out_size, void* d_ws, size_t ws_size, hipStream_t stream) {
    static int grid = 0;
    if (grid == 0) {
        if (n_in != 28 || out_size != T * D || ws_size < WS_END) { fprintf(stderr, "kernel_launch: unexpected shapes (n_in %d out %d ws %zu)\n", n_in, out_size, ws_size); grid = -1; return; }
        int dev = 0, cus = 0;
        if (hipGetDevice(&dev) != hipSuccess || hipDeviceGetAttribute(&cus, hipDeviceAttributeMultiprocessorCount, dev) != hipSuccess) { grid = -1; return; }
        if (hipFuncSetAttribute((const void*)mk_fwd, hipFuncAttributeMaxDynamicSharedMemorySize, LDS_BYTES) != hipSuccess) { fprintf(stderr, "kernel_launch: hipFuncSetAttribute failed\n"); grid = -1; return; }
        int per_cu = 0;
        if (hipOccupancyMaxActiveBlocksPerMultiprocessor(&per_cu, (const void*)mk_fwd, NTHREADS, LDS_BYTES) != hipSuccess || per_cu < 1) { fprintf(stderr, "kernel_launch: occupancy query says %d\n", per_cu); }
        (void)hipGetLastError();
        grid = cus;
    }
    if (grid < 0) return;
    if (hipMemsetAsync((char*)d_ws + WS_CTL, 0, CTL_ZERO_BYTES, stream) != hipSuccess) return;
    Args a{};
    for (int i = 0; i < 28; ++i) a.in[i] = (const float*)d_in[i];
    a.out = (float*)d_out; a.ws = (unsigned char*)d_ws; a.ph_lo = 0; a.ph_hi = NPH;
    hipLaunchKernelGGL(mk_fwd, dim3(grid), dim3(NTHREADS), LDS_BYTES, stream, a);
}
```

```cpp
#include <hip/hip_runtime.h>
#include <cstdio>
#include <cstdint>
#include <math.h>

#ifndef UP_FP8
#define UP_FP8 1
#endif
#ifndef DN_FP8
#define DN_FP8 1
#endif
#define LAS __attribute__((address_space(3)))
#define GAS __attribute__((address_space(1)))
typedef unsigned short bf16_t;
typedef short bf16x8 __attribute__((ext_vector_type(8)));
typedef short s16x4 __attribute__((ext_vector_type(4)));
typedef float f32x4 __attribute__((ext_vector_type(4)));
typedef float f32x2 __attribute__((ext_vector_type(2)));
typedef float f32x16 __attribute__((ext_vector_type(16)));
typedef unsigned u32x4 __attribute__((ext_vector_type(4)));
typedef unsigned u32x2 __attribute__((ext_vector_type(2)));
typedef int v8i32 __attribute__((ext_vector_type(8)));

constexpr int D = 1024, BATCH = 4, SEQ = 8192, DEPTH = 2, T = BATCH * SEQ;
constexpr int DS = 512, NG = 32, HS = 16, NP = 64, DA = 512, NH = 4, DV = 128, DIN = 2048;
constexpr int NE = 32, DFF = 1024, NASSIGN = T * 4;
constexpr int MPAD_MAX = NASSIGN + NE * 256, NTILE_MAX = MPAD_MAX / 256;
constexpr int NCHUNK = T / 64, CPB = SEQ / 64;
constexpr float EPS = 1e-6f;
constexpr float C2 = 0.125f * 1.4426950408889634f;
constexpr int NWAVES = 8, NTHREADS = 512;

constexpr size_t MiB = 1u << 20;
constexpr size_t WS_CTL = 0, CTL_ZERO_BYTES = 1 * MiB;
constexpr size_t WS_COS = 1 * MiB, WS_SIN = 2 * MiB;
constexpr size_t WS_SCAL = 3 * MiB;
constexpr size_t WS_KT = 4 * MiB, KT_STRIDE = 2 * MiB;
constexpr size_t WS_LAML = 8 * MiB, LAML_STRIDE = 32768;
constexpr size_t WS_WRT = 9 * MiB, WRT_STRIDE = 131072;
constexpr size_t WS_RS = 10 * MiB;
constexpr size_t WS_GT = 16 * MiB, GT_STRIDE = 8 * MiB;
constexpr size_t WS_HT = 32 * MiB, HT_STRIDE = 8 * MiB;
constexpr size_t WS_WIN = 48 * MiB, WIN_STRIDE = 4 * MiB;
constexpr size_t WS_WGLU = 56 * MiB, WGLU_STRIDE = MiB / 2;
constexpr size_t WS_WOUT = 58 * MiB, WOUT_STRIDE = 2 * MiB;
constexpr size_t WS_WUP = 64 * MiB, WUP_STRIDE = 128 * MiB;
constexpr size_t WS_WDN = 320 * MiB, WDN_STRIDE = 64 * MiB;
constexpr size_t WS_XN = 448 * MiB;
constexpr size_t WS_U = 512 * MiB, WS_Q = 544 * MiB, WS_K = 576 * MiB, WS_V = 608 * MiB;
constexpr size_t WS_YG = 640 * MiB;
constexpr size_t WS_MIX = 672 * MiB;
constexpr size_t WS_S = 736 * MiB;
constexpr size_t WS_RSP = 744 * MiB;
constexpr size_t WS_TOPI = 746 * MiB, WS_TOPG = 747 * MiB, WS_TOKROW = 748 * MiB, WS_WGCNT = 749 * MiB;
constexpr size_t WS_ROWTOK = 750 * MiB, WS_ROWGATE = 751 * MiB, WS_TILEEXP = 752 * MiB, WS_ROWSCALE = 753 * MiB;
constexpr size_t WS_ACT = 768 * MiB, WS_YB = 1040 * MiB, WS_H1 = 1180 * MiB, WS_H2 = 1244 * MiB, WS_END = 1312 * MiB;
constexpr int CW_BAR = 4096;

constexpr int LDS_CTL = 0;
constexpr int LDS_RING = 4096;
constexpr int LDS_BYTES = 163840;

__device__ __forceinline__ unsigned f2bf(float f) { unsigned u = __builtin_bit_cast(unsigned, f); return (u + 0x7fffu + ((u >> 16) & 1u)) >> 16; }
__device__ __forceinline__ unsigned pk2(float lo, float hi) { return f2bf(lo) | (f2bf(hi) << 16); }
__device__ __forceinline__ unsigned cvt_pk_bf16(float lo, float hi) { unsigned r; asm volatile("v_cvt_pk_bf16_f32 %0, %1, %2" : "=v"(r) : "v"(lo), "v"(hi)); return r; }
__device__ __forceinline__ unsigned pk4_fp8(float a, float b, float c, float d) { int w = 0; w = __builtin_amdgcn_cvt_pk_fp8_f32(a, b, w, false); w = __builtin_amdgcn_cvt_pk_fp8_f32(c, d, w, true); return (unsigned)w; }
__device__ __forceinline__ void fp8x4_add(unsigned w, float sc, f32x4& a) { const f32x2 lo = __builtin_amdgcn_cvt_pk_f32_fp8((int)w, false), hi = __builtin_amdgcn_cvt_pk_f32_fp8((int)w, true); a[0] += lo[0] * sc; a[1] += lo[1] * sc; a[2] += hi[0] * sc; a[3] += hi[1] * sc; }
__device__ __forceinline__ float bf_lo(unsigned w) { return __builtin_bit_cast(float, w << 16); }
__device__ __forceinline__ float bf_hi(unsigned w) { return __builtin_bit_cast(float, w & 0xffff0000u); }
__device__ __forceinline__ float wave_sum(float v) {
#pragma unroll
    for (int o = 1; o < 64; o <<= 1) v += __shfl_xor(v, o);
    return v;
}
__device__ __forceinline__ float gelu_tanh(float x) {
    const float z = 0.7978845608028654f * (x + 0.044715f * x * x * x);
    return x / (1.f + __expf(-2.f * z));
}
__device__ __forceinline__ float sigmoidf(float v) { return 1.f / (1.f + __expf(-v)); }

#define XB_TMO      128
#define XB_XCNT(j)  (256  + 64 * (j))
#define XB_XSUB(j)  (1280 + 64 * (j))
#define XB_XGEN(j)  (2304 + 64 * (j))
#define XB_TOP      3328
#define XB_TOPGEN   3392
#define XCD_BAR_WORDS 3456
#define XB_SPIN_CAP (1u << 18)
__device__ __forceinline__ unsigned xb_ld(unsigned* p)              { return __hip_atomic_load(p, __ATOMIC_RELAXED, __HIP_MEMORY_SCOPE_AGENT); }
__device__ __forceinline__ unsigned xb_add(unsigned* p, unsigned v) { return __hip_atomic_fetch_add(p, v, __ATOMIC_RELAXED, __HIP_MEMORY_SCOPE_AGENT); }
__device__ __forceinline__ unsigned xb_xcc_id() { return (unsigned)__builtin_amdgcn_s_getreg((3 << 11) | 20) & 0xFu; }
#define XB_SPIN(cond, bar) do { unsigned _sp = 0; while (cond) { __builtin_amdgcn_s_sleep(1); \
    if ((++_sp & 255u) == 0u) { if (xb_ld(&(bar)[XB_TMO])) break; if (_sp > XB_SPIN_CAP) { atomicAdd(&(bar)[XB_TMO], 1u); break; } } } } while (0)
struct XcdBarrier { unsigned* bar; unsigned x; volatile LAS unsigned* st; };
__device__ __forceinline__ XcdBarrier xcd_barrier_post(unsigned* bar, volatile LAS unsigned* st) {
    XcdBarrier b; b.bar = bar; b.x = xb_xcc_id(); b.st = st;
    if (threadIdx.x == 0) (void)xb_add(&bar[XB_XCNT(b.x)], 1u);
    return b;
}
__device__ __forceinline__ void xcd_barrier_complete(unsigned* bar, unsigned x, unsigned& nloc, unsigned& nx) {
    const unsigned G = gridDim.x * gridDim.y * gridDim.z;
    unsigned sum, cnt, mine, sp = 0u;
    for (;;) {
        sum = 0u; cnt = 0u; mine = 0u;
#pragma unroll
        for (unsigned j = 0; j < 16; ++j) { const unsigned c = xb_ld(&bar[XB_XCNT(j)]); sum += c; cnt += (c > 0u) ? 1u : 0u; mine = (j == x) ? c : mine; }
        if (sum == G) break;
        __builtin_amdgcn_s_sleep(1);
        if ((++sp & 255u) == 0u) { if (xb_ld(&bar[XB_TMO])) break; if (sp > XB_SPIN_CAP) { atomicAdd(&bar[XB_TMO], 1u); break; } }
    }
    nloc = mine > 0u ? mine : 1u; nx = cnt > 0u ? cnt : 1u;
}
__device__ __forceinline__ void xcd_barrier(const XcdBarrier& b) {
    asm volatile("s_waitcnt vmcnt(0)" ::: "memory");
    __syncthreads();
    if (threadIdx.x == 0) {
        unsigned* bar = b.bar;
        __builtin_amdgcn_s_waitcnt(0);
        unsigned nloc = b.st[0], nx = b.st[1];
        if (nloc == 0u) { xcd_barrier_complete(bar, b.x, nloc, nx); b.st[0] = nloc; b.st[1] = nx; }
        const unsigned old = xb_add(&bar[XB_XSUB(b.x)], 1u);
        const unsigned gen = old / nloc;
        if (old + 1u == (gen + 1u) * nloc) {
            __builtin_amdgcn_fence(__ATOMIC_RELEASE, "agent");
            asm volatile("s_waitcnt vmcnt(0)" ::: "memory");
            const unsigned og = xb_add(&bar[XB_TOP], 1u);
            const unsigned tg = og / nx;
            if (og + 1u == (tg + 1u) * nx) xb_add(&bar[XB_TOPGEN], 1u);
            else XB_SPIN(xb_ld(&bar[XB_TOPGEN]) == tg, bar);
            __builtin_amdgcn_fence(__ATOMIC_ACQUIRE, "agent");
            xb_add(&bar[XB_XGEN(b.x)], 1u);
            asm volatile("s_waitcnt vmcnt(0)" ::: "memory");
        } else {
            XB_SPIN(xb_ld(&bar[XB_XGEN(b.x)]) == gen, bar);
            __builtin_amdgcn_fence(__ATOMIC_ACQUIRE, "agent");
            asm volatile("s_waitcnt vmcnt(0)" ::: "memory");
        }
    }
    __syncthreads();
}

namespace pg8 {
constexpr int BM = 256, BK = 64, HALF = 128, HTB = HALF * BK * 2, STAGE_BYTES = 8 * HTB;
__host__ __device__ __forceinline__ int lds_byte(int r, int c) { const int st = (r >> 4) * 2 + (c >> 5), rr = r & 15, cc = c & 31, ob = rr * 64 + cc * 2; return st * 1024 + (ob ^ (((ob >> 9) & 1) << 5)); }
__host__ __device__ __forceinline__ void stage_rc(int b, int& R, int& C) { const int st = b / 1024, sb = b % 1024, swz = sb ^ (((sb >> 9) & 1) << 5); R = (st >> 1) * 16 + swz / 64; C = (st & 1) * 32 + (swz % 64) / 2; }
__host__ __device__ __forceinline__ int perm32(int rho) { const int n = rho >> 4, i = rho & 15; return 8 * (i >> 2) + 4 * n + (i & 3); }

struct Unit { int pm, pn; };
template <class P>
__device__ __forceinline__ void gemm_phase(LAS unsigned char* lds, LAS unsigned char* ldsctl, P& S, const int tid) {
    const int wid = __builtin_amdgcn_readfirstlane(tid >> 6), lane = tid & 63, wr = wid >> 2, wc = wid & 3, fr = lane & 15, fq = lane >> 4;
    constexpr bool F8 = P::FP8;
    constexpr int K = P::K, ES = F8 ? 1 : 2, nt = K * ES / 128;
    int R0, C0, R1, C1; stage_rc(tid * 16, R0, C0); stage_rc(tid * 16 + 8192, R1, C1);
    unsigned voffB[2];
    {
        const int Rb0 = P::BROW64 ? (64 * (R0 >> 5) + perm32(R0 & 31)) : ((R0 & ~31) + perm32(R0 & 31));
        const int Rb1 = P::BROW64 ? (64 * (R1 >> 5) + perm32(R1 & 31)) : ((R1 & ~31) + perm32(R1 & 31));
        voffB[0] = (unsigned)(Rb0 * K * ES + 2 * C0); voffB[1] = (unsigned)(Rb1 * K * ES + 2 * C1);
    }
    const unsigned ldsw = (unsigned)wid * 1024u;
    const int scl8 = P::SCALE_AB;
    const int aoff = F8 ? lds_byte(wr * 64 + fr, fq * 16) : lds_byte(wr * 64 + fr, fq * 8), boff = F8 ? lds_byte(wc * 32 + fr, fq * 16) : lds_byte(wc * 32 + fr, fq * 8);
#define PG8_SA(b, h) (((b) * 2 + (h)) * HTB)
#define PG8_SB(b, h) ((4 + (b) * 2 + (h)) * HTB)
    const unsigned ldsbase = (unsigned)__builtin_amdgcn_readfirstlane((int)(unsigned)(uintptr_t)lds + (int)ldsw);
#define PG8_GLDS(sbase, voff, ldsdst) do { unsigned _keep; asm volatile("s_mov_b32 %0, m0\n\ts_mov_b32 m0, %3\n\ts_nop 0\n\tglobal_load_lds_dwordx4 %2, %1\n\ts_mov_b32 m0, %0" \
        : "=&s"(_keep) : "s"(sbase), "v"(voff), "s"(ldsdst) : "memory"); } while (0)
#define PG8_STAGE_A(bufoff, vo, h, kofs) do { _Pragma("unroll") for (int _i = 0; _i < 2; ++_i) \
        PG8_GLDS(Abase, (vo)[P::GATHER ? (h) : 0][_i] + ((kofs) + (P::GATHER ? 0u : (unsigned)(h) * HSTEPA)), ldsbase + (unsigned)((bufoff) + _i * 8192)); } while (0)
#define PG8_STAGE_B(bufoff, gbase) do { _Pragma("unroll") for (int _i = 0; _i < 2; ++_i) \
        PG8_GLDS((const char*)(gbase), voffB[_i], ldsbase + (unsigned)((bufoff) + _i * 8192)); } while (0)
#define PG8_LDA(dst, b, h) do { if constexpr (F8) { _Pragma("unroll") for (int m = 0; m < 4; ++m) { const u32x4 _l = *(const LAS u32x4*)(lds + PG8_SA(b, h) + aoff + m * 2048), _h = *(const LAS u32x4*)(lds + PG8_SA(b, h) + aoff + m * 2048 + 16); dst##8[m] = __builtin_bit_cast(v8i32, __builtin_shufflevector(_l, _h, 0, 1, 2, 3, 4, 5, 6, 7)); } } \
        else { _Pragma("unroll") for (int m = 0; m < 4; ++m) _Pragma("unroll") for (int k = 0; k < 2; ++k) dst[m][k] = *(const LAS bf16x8*)(lds + PG8_SA(b, h) + aoff + m * 2048 + k * 1024); } } while (0)
#define PG8_LDB(dst, b, h) do { if constexpr (F8) { _Pragma("unroll") for (int n = 0; n < 2; ++n) { const u32x4 _l = *(const LAS u32x4*)(lds + PG8_SB(b, h) + boff + n * 2048), _h = *(const LAS u32x4*)(lds + PG8_SB(b, h) + boff + n * 2048 + 16); dst##8[n] = __builtin_bit_cast(v8i32, __builtin_shufflevector(_l, _h, 0, 1, 2, 3, 4, 5, 6, 7)); } } \
        else { _Pragma("unroll") for (int n = 0; n < 2; ++n) _Pragma("unroll") for (int k = 0; k < 2; ++k) dst[n][k] = *(const LAS bf16x8*)(lds + PG8_SB(b, h) + boff + n * 2048 + k * 1024); } } while (0)
#define PG8_MMA(ai, bj, At, Bt) do { __builtin_amdgcn_s_setprio(1); \
        if constexpr (F8) { _Pragma("unroll") for (int m = 0; m < 4; ++m) _Pragma("unroll") for (int n = 0; n < 2; ++n) \
            asm volatile("v_mfma_scale_f32_16x16x128_f8f6f4 %0, %1, %2, %0, %3, %3 op_sel:[0,1,0] op_sel_hi:[0,0,0]" : "+v"(acc[ai][bj][m][n]) : "v"(Bt##8[n]), "v"(At##8[m]), "v"(scl8)); } \
        else { _Pragma("unroll") for (int m = 0; m < 4; ++m) _Pragma("unroll") for (int n = 0; n < 2; ++n) _Pragma("unroll") for (int k = 0; k < 2; ++k) \
            acc[ai][bj][m][n] = __builtin_amdgcn_mfma_f32_16x16x32_bf16(Bt[n][k], At[m][k], acc[ai][bj][m][n], 0, 0, 0); } \
        __builtin_amdgcn_s_setprio(0); } while (0)
#define PG8_WAIT_V(n) asm volatile("s_waitcnt vmcnt(" #n ")" ::: "memory")
#define PG8_WAIT_L(n) asm volatile("s_waitcnt lgkmcnt(" #n ")" ::: "memory")
#define PG8_BAR __builtin_amdgcn_s_barrier()
#define PG8_SCHED __builtin_amdgcn_sched_barrier(0)
    Unit cur, nxt; int ui = 0;
    if (!S.next(0, cur)) return;
    f32x4 acc[2][2][4][2];
#pragma unroll
    for (int a = 0; a < 2; ++a)
#pragma unroll
        for (int b = 0; b < 2; ++b)
#pragma unroll
            for (int m = 0; m < 4; ++m)
#pragma unroll
                for (int n = 0; n < 2; ++n) acc[a][b][m][n] = (f32x4){0.f, 0.f, 0.f, 0.f};
    bf16x8 At[4][2], B0[2][2], B1[2][2]; v8i32 At8[4], B08[2], B18[2];
    const char* const Abase = S.a_base();
    unsigned voffA[2][2], voffAn[2][2];
    const char *cB0, *cB1;
    S.unit_begin(cur, ldsctl, tid, 0);
    S.a_offs(cur, R0, C0, R1, C1, voffA, true);
    asm volatile("" ::: "memory");
    S.b_ptrs(cur, cB0, cB1);
    constexpr unsigned kstep = 128, HSTEPA = (unsigned)HALF * K * ES;
    PG8_STAGE_B(PG8_SB(0, 0), cB0); PG8_STAGE_B(PG8_SB(0, 1), cB1); PG8_STAGE_A(PG8_SA(0, 0), voffA, 0, 0u); PG8_STAGE_A(PG8_SA(0, 1), voffA, 1, 0u);
    if (wr == 1) PG8_BAR;
    PG8_WAIT_V(2); PG8_BAR;
    PG8_STAGE_B(PG8_SB(1, 0), cB0 + kstep); PG8_STAGE_A(PG8_SA(1, 0), voffA, 0, kstep); PG8_STAGE_B(PG8_SB(1, 1), cB1 + kstep);
    PG8_WAIT_V(6); PG8_BAR;
    for (;;) {
        const bool has_next = S.next(ui + 1, nxt);
        const char *nB0 = cB0, *nB1 = cB1;
        if constexpr (P::GATHER) {
#pragma unroll
            for (int h = 0; h < 2; ++h)
#pragma unroll
                for (int i = 0; i < 2; ++i) voffAn[h][i] = voffA[h][i];
        }
        if (has_next) { S.unit_begin(nxt, ldsctl, tid, (ui + 1) & 1); S.b_ptrs(nxt, nB0, nB1);
            if constexpr (P::GATHER) { int t2 = tid; asm volatile("" : "+v"(t2)); int r0, c0, r1, c1; stage_rc(t2 * 16, r0, c0); stage_rc(t2 * 16 + 8192, r1, c1); S.a_offs(nxt, r0, c0, r1, c1, voffAn, false); } }
#pragma unroll 1
        for (int t = 0; t < nt; t += 2) {
            const bool last = (t == nt - 2);
            S.midk(acc, cur, t, wr, fr, ldsctl, ui & 1);
            unsigned a2o[2][2];
            if constexpr (!P::GATHER) { if (last) { int t2 = tid; asm volatile("" : "+v"(t2)); int r0, c0, r1, c1; stage_rc(t2 * 16, r0, c0); stage_rc(t2 * 16 + 8192, r1, c1);
                                                   S.a_offs(has_next ? nxt : cur, r0, c0, r1, c1, voffAn, false); } }
#pragma unroll
            for (int h = 0; h < 2; ++h)
#pragma unroll
                for (int i = 0; i < 2; ++i) a2o[h][i] = last ? voffAn[h][i] : voffA[h][i] + (unsigned)(t + 2) * kstep;
            const char* b2h0 = last ? nB0 : cB0 + (size_t)(t + 2) * kstep; const char* b2h1 = last ? nB1 : cB1 + (size_t)(t + 2) * kstep;
            const unsigned a1k = (unsigned)(t + 1) * kstep;
            PG8_LDB(B0, 0, 0); PG8_LDB(B1, 0, 1); PG8_SCHED; PG8_LDA(At, 0, 0); PG8_STAGE_A(PG8_SA(1, 1), voffA, 1, a1k);
            PG8_WAIT_V(8); PG8_WAIT_L(0); PG8_BAR; PG8_MMA(0, 0, At, B0); PG8_MMA(0, 1, At, B1); PG8_BAR; PG8_SCHED;
            PG8_LDA(At, 0, 1); PG8_STAGE_B(PG8_SB(0, 0), b2h0); PG8_STAGE_B(PG8_SB(0, 1), b2h1); PG8_STAGE_A(PG8_SA(0, 0), a2o, 0, 0u);
            PG8_WAIT_V(8); PG8_WAIT_L(0); PG8_BAR; PG8_MMA(1, 0, At, B0); PG8_MMA(1, 1, At, B1); PG8_BAR; PG8_SCHED;
            PG8_LDB(B0, 1, 0); PG8_LDB(B1, 1, 1); PG8_SCHED; PG8_LDA(At, 1, 0); PG8_STAGE_A(PG8_SA(0, 1), a2o, 1, 0u);
            PG8_WAIT_V(8); PG8_WAIT_L(0); PG8_BAR; PG8_MMA(0, 0, At, B0); PG8_MMA(0, 1, At, B1); PG8_BAR; PG8_SCHED;
            PG8_LDA(At, 1, 1); PG8_STAGE_B(PG8_SB(1, 0), b2h0 + kstep); PG8_STAGE_B(PG8_SB(1, 1), b2h1 + kstep); PG8_STAGE_A(PG8_SA(1, 0), a2o, 0, kstep);
            PG8_WAIT_V(8); PG8_WAIT_L(0); PG8_BAR; PG8_MMA(1, 0, At, B0); PG8_MMA(1, 1, At, B1); PG8_BAR; PG8_SCHED;
        }
        if (wr == 0) PG8_BAR;
        if constexpr (F8) asm volatile("s_nop 15\n\ts_nop 15" ::: "memory");
        { int l2 = tid; asm volatile("" : "+v"(l2)); S.epi(acc, cur, wr, wc, l2 & 15, (l2 >> 4) & 3); }
        if (!has_next) break;
#pragma unroll
        for (int a = 0; a < 2; ++a)
#pragma unroll
            for (int b = 0; b < 2; ++b)
#pragma unroll
                for (int m = 0; m < 4; ++m)
#pragma unroll
                    for (int n = 0; n < 2; ++n) acc[a][b][m][n] = (f32x4){0.f, 0.f, 0.f, 0.f};
        cur = nxt; cB0 = nB0; cB1 = nB1; ++ui;
#pragma unroll
        for (int h = 0; h < 2; ++h)
#pragma unroll
            for (int i = 0; i < 2; ++i) voffA[h][i] = voffAn[h][i];
        if (wr == 1) PG8_BAR;
    }
    PG8_WAIT_V(0);
    PG8_BAR;
#undef PG8_SA
#undef PG8_SB
#undef PG8_STAGE_A
#undef PG8_GLDS
#undef PG8_STAGE_B
#undef PG8_LDA
#undef PG8_LDB
#undef PG8_MMA
#undef PG8_WAIT_V
#undef PG8_WAIT_L
#undef PG8_BAR
#undef PG8_SCHED
}
struct StaticOrder {
    int nM, nN, nwg, G, c;
    __device__ void init(int M, int N, int G_, int c_) { nM = M / BM; nN = N / BM; nwg = nM * nN; G = G_; c = c_; }
    __device__ bool next(int i, Unit& u) const {
        const long L = (long)i * G + c; if (L >= nwg) return false;
        int wgid = (int)L; { const int q = nwg / 8, r = nwg % 8, xcd = wgid % 8, off = wgid / 8; wgid = (xcd < r ? xcd * (q + 1) : r * (q + 1) + (xcd - r) * q) + off; }
        const int nig = 8 * nN, gid = wgid / nig, fm = gid * 8, gsz = (nM - fm) < 8 ? (nM - fm) : 8;
        u.pm = fm + ((wgid % nig) % gsz); u.pn = (wgid % nig) / gsz; return true;
    }
};
}

struct Frame {
    LAS unsigned char* lds; LAS unsigned char* ctl;
    unsigned char* ws;
    int tid, lane, wave, G, bx;
    float* out; const struct Args* ap; unsigned char* ws0; float* out0; size_t z;
};

struct Args { const float* in[28]; float* out; unsigned char* ws; int ph_lo, ph_hi; };
#define arg_in(i) (F.ap->in[i] + F.z)
__device__ __forceinline__ void phase_begin(Frame& F) {
    int t = F.tid; asm volatile("" : "+v"(t)); F.tid = t; F.lane = t & 63; F.wave = __builtin_amdgcn_readfirstlane(t >> 6);
    size_t z = 0; asm volatile("" : "+s"(z)); F.z = z; F.ws = F.ws0 + z; F.out = F.out0 + z;
    int bx = F.bx; asm volatile("" : "+s"(bx)); F.bx = bx;
}
struct PBase {
    static constexpr bool GATHER = false, FP8 = false; static constexpr int SCALE_AB = 0x7f7f7f7f;
    __device__ __forceinline__ void unit_begin(const pg8::Unit&, LAS unsigned char*, int, int) {}
    __device__ __forceinline__ void midk(f32x4 (&)[2][2][4][2], const pg8::Unit&, int, int, int, LAS unsigned char*, int) {}
    __device__ __forceinline__ void a_fix(unsigned (&)[2][2]) {}
};
struct PInProj : PBase {
    static constexpr int K = 1024, BROW64 = 1;
    pg8::StaticOrder so; const char* A; const char* B; bf16_t* UQKV; const float *GQK, *COS, *SIN;
    __device__ __forceinline__ bool next(int i, pg8::Unit& u) const { return so.next(i, u); }
    __device__ __forceinline__ const char* a_base() const { return A; }
    __device__ __forceinline__ void a_offs(const pg8::Unit& u, int R0, int C0, int R1, int C1, unsigned (&vo)[2][2], bool) const {
#pragma unroll
        for (int h = 0; h < 2; ++h) { vo[h][0] = (unsigned)((u.pm * 256 + 128 * h + R0) * K + C0) * 2u; vo[h][1] = (unsigned)((u.pm * 256 + 128 * h + R1) * K + C1) * 2u; }
    }
    __device__ __forceinline__ void b_ptrs(const pg8::Unit& u, const char*& b0, const char*& b1) const { b0 = B + (size_t)u.pn * 256 * K * 2; b1 = b0 + (size_t)32 * K * 2; }
    __device__ __forceinline__ void epi(f32x4 (&acc)[2][2][4][2], const pg8::Unit& u, int wr, int wc, int fr, int fq) const {
        const int kind = u.pn >> 1;
        const int colg = (u.pn & 1) * 256 + 64 * wc;
        bf16_t* dst = UQKV + (size_t)kind * (size_t)(16u << 20);
        const int row0 = u.pm * 256 + wr * 64 + fr;
        if (kind == 0 || kind == 3) {
#pragma unroll
            for (int ai = 0; ai < 2; ++ai)
#pragma unroll
                for (int m = 0; m < 4; ++m) { bf16_t* rowp = dst + (size_t)(row0 + ai * 128 + m * 16) * 512 + colg + 8 * fq;
#pragma unroll
                    for (int bj = 0; bj < 2; ++bj) { const f32x4 v0 = acc[ai][bj][m][0], v1 = acc[ai][bj][m][1];
                        u32x4 w; w.x = cvt_pk_bf16(v0[0], v0[1]); w.y = cvt_pk_bf16(v0[2], v0[3]); w.z = cvt_pk_bf16(v1[0], v1[1]); w.w = cvt_pk_bf16(v1[2], v1[3]);
                        *(u32x4*)(rowp + 32 * bj) = w; } }
        } else {
            const float* g = GQK + (kind - 1) * 64; const float sc = kind == 1 ? C2 : 1.0f;
            f32x4 g0[2], g1[2];
#pragma unroll
            for (int n = 0; n < 2; ++n) { g0[n] = *(const f32x4*)(g + 8 * fq + 4 * n); g1[n] = *(const f32x4*)(g + 32 + 8 * fq + 4 * n); }
#pragma unroll
            for (int ai = 0; ai < 2; ++ai)
#pragma unroll
                for (int m = 0; m < 4; ++m) {
                    const int row = row0 + ai * 128 + m * 16; const int pos = row & (SEQ - 1);
                    float ss = 0.f;
#pragma unroll
                    for (int bj = 0; bj < 2; ++bj)
#pragma unroll
                        for (int n = 0; n < 2; ++n) { const f32x4 x = acc[ai][bj][m][n]; ss += (x[0] * x[0] + x[1] * x[1]) + (x[2] * x[2] + x[3] * x[3]); }
                    ss += __shfl_xor(ss, 16); ss += __shfl_xor(ss, 32);
                    const float r = rsqrtf(ss * (1.f / 64.f) + EPS) * sc;
                    f32x4 o1[2], o2[2];
#pragma unroll
                    for (int n = 0; n < 2; ++n) {
                        const f32x4 c = *(const f32x4*)(COS + (size_t)pos * 32 + 8 * fq + 4 * n), s = *(const f32x4*)(SIN + (size_t)pos * 32 + 8 * fq + 4 * n);
                        const f32x4 x1 = acc[ai][0][m][n] * g0[n] * r, x2 = acc[ai][1][m][n] * g1[n] * r;
                        o1[n] = x1 * c - x2 * s; o2[n] = x2 * c + x1 * s;
                    }
                    bf16_t* rowp = dst + (size_t)row * 512 + colg + 8 * fq;
                    u32x4 w; w.x = cvt_pk_bf16(o1[0][0], o1[0][1]); w.y = cvt_pk_bf16(o1[0][2], o1[0][3]); w.z = cvt_pk_bf16(o1[1][0], o1[1][1]); w.w = cvt_pk_bf16(o1[1][2], o1[1][3]);
                    *(u32x4*)(rowp) = w;
                    w.x = cvt_pk_bf16(o2[0][0], o2[0][1]); w.y = cvt_pk_bf16(o2[0][2], o2[0][3]); w.z = cvt_pk_bf16(o2[1][0], o2[1][1]); w.w = cvt_pk_bf16(o2[1][2], o2[1][3]);
                    *(u32x4*)(rowp + 32) = w;
                    asm volatile("" ::: "memory");
                }
        }
    }
};
struct PGlu : PBase {
    static constexpr int K = 512, BROW64 = 0;
    pg8::StaticOrder so; const char* A; const char* B; const bf16_t* YG; bf16_t* MIX; float* RSP;
    __device__ __forceinline__ bool next(int i, pg8::Unit& u) const { return so.next(i, u); }
    __device__ __forceinline__ const char* a_base() const { return A; }
    __device__ __forceinline__ void a_offs(const pg8::Unit& u, int R0, int C0, int R1, int C1, unsigned (&vo)[2][2], bool) const {
#pragma unroll
        for (int h = 0; h < 2; ++h) { vo[h][0] = (unsigned)((u.pm * 256 + 128 * h + R0) * K + C0) * 2u; vo[h][1] = (unsigned)((u.pm * 256 + 128 * h + R1) * K + C1) * 2u; }
    }
    __device__ __forceinline__ void b_ptrs(const pg8::Unit& u, const char*& b0, const char*& b1) const { b0 = B + (size_t)u.pn * 256 * K * 2; b1 = b0 + (size_t)128 * K * 2; }
    __device__ __forceinline__ void epi(f32x4 (&acc)[2][2][4][2], const pg8::Unit& u, int wr, int wc, int fr, int fq) const {
        const int row0 = u.pm * 256 + wr * 64 + fr, col0 = u.pn * 256 + wc * 32 + 8 * fq;
#pragma unroll
        for (int ai = 0; ai < 2; ++ai)
#pragma unroll
            for (int m = 0; m < 4; ++m) {
                const int row = row0 + ai * 128 + m * 16; float ss = 0.f;
#pragma unroll
                for (int bj = 0; bj < 2; ++bj) {
                    const u32x4 yw = *(const u32x4*)(YG + (size_t)row * 512 + col0 + 128 * bj);
                    const f32x4 a0 = acc[ai][bj][m][0], a1 = acc[ai][bj][m][1];
                    float z[8];
                    z[0] = bf_lo(yw.x) * sigmoidf(a0[0]); z[1] = bf_hi(yw.x) * sigmoidf(a0[1]); z[2] = bf_lo(yw.y) * sigmoidf(a0[2]); z[3] = bf_hi(yw.y) * sigmoidf(a0[3]);
                    z[4] = bf_lo(yw.z) * sigmoidf(a1[0]); z[5] = bf_hi(yw.z) * sigmoidf(a1[1]); z[6] = bf_lo(yw.w) * sigmoidf(a1[2]); z[7] = bf_hi(yw.w) * sigmoidf(a1[3]);
#pragma unroll
                    for (int i = 0; i < 8; ++i) ss += z[i] * z[i];
                    u32x4 w; w.x = cvt_pk_bf16(z[0], z[1]); w.y = cvt_pk_bf16(z[2], z[3]); w.z = cvt_pk_bf16(z[4], z[5]); w.w = cvt_pk_bf16(z[6], z[7]);
                    *(u32x4*)(MIX + (size_t)row * 1024 + col0 + 128 * bj) = w;
                }
                ss += __shfl_xor(ss, 16); ss += __shfl_xor(ss, 32);
                if (fq == 0) RSP[(size_t)row * 8 + u.pn * 4 + wc] = ss;
            }
    }
};
struct POut : PBase {
    static constexpr int K = 1024, BROW64 = 0;
    pg8::StaticOrder so; const char* A; const char* B; const float* RSP; const float* base32; const bf16_t* base16; bf16_t* H1;
    __device__ __forceinline__ bool next(int i, pg8::Unit& u) const { return so.next(i, u); }
    __device__ __forceinline__ const char* a_base() const { return A; }
    __device__ __forceinline__ void a_offs(const pg8::Unit& u, int R0, int C0, int R1, int C1, unsigned (&vo)[2][2], bool) const {
#pragma unroll
        for (int h = 0; h < 2; ++h) { vo[h][0] = (unsigned)((u.pm * 256 + 128 * h + R0) * K + C0) * 2u; vo[h][1] = (unsigned)((u.pm * 256 + 128 * h + R1) * K + C1) * 2u; }
    }
    __device__ __forceinline__ void b_ptrs(const pg8::Unit& u, const char*& b0, const char*& b1) const { b0 = B + (size_t)u.pn * 256 * K * 2; b1 = b0 + (size_t)128 * K * 2; }
    __device__ __forceinline__ void unit_begin(const pg8::Unit& u, LAS unsigned char* ldsctl, int tid, int slot) const {
        if (tid < 256) {
            const f32x4 p0 = *(const f32x4*)(RSP + (size_t)(u.pm * 256 + tid) * 8), p1 = *(const f32x4*)(RSP + (size_t)(u.pm * 256 + tid) * 8 + 4);
            const float ss = ((p0[0] + p0[1]) + (p0[2] + p0[3])) + ((p1[0] + p1[1]) + (p1[2] + p1[3]));
            ((LAS float*)(ldsctl + 1024 + slot * 1024))[tid] = rsqrtf(ss * (1.f / 512.f) + EPS);
        }
    }
    __device__ __forceinline__ void midk(f32x4 (&acc)[2][2][4][2], const pg8::Unit& u, int t, int wr, int fr, LAS unsigned char* ldsctl, int slot) const {
        if (t == 8) {
            const LAS float* rs = (const LAS float*)(ldsctl + 1024 + slot * 1024);
#pragma unroll
            for (int ai = 0; ai < 2; ++ai)
#pragma unroll
                for (int m = 0; m < 4; ++m) { const float r = rs[ai * 128 + wr * 64 + m * 16 + fr];
#pragma unroll
                    for (int bj = 0; bj < 2; ++bj)
#pragma unroll
                        for (int n = 0; n < 2; ++n) acc[ai][bj][m][n] *= r; }
        }
    }
    __device__ __forceinline__ void epi(f32x4 (&acc)[2][2][4][2], const pg8::Unit& u, int wr, int wc, int fr, int fq) const {
        const int row0 = u.pm * 256 + wr * 64 + fr, col0 = u.pn * 256 + wc * 32 + 8 * fq;
#pragma unroll
        for (int ai = 0; ai < 2; ++ai)
#pragma unroll
            for (int m = 0; m < 4; ++m) { const size_t off = (size_t)(row0 + ai * 128 + m * 16) * 1024 + col0;
#pragma unroll
                for (int bj = 0; bj < 2; ++bj) {
                    f32x4 v0 = acc[ai][bj][m][0], v1 = acc[ai][bj][m][1];
                    if (base32) { v0 += *(const f32x4*)(base32 + off + bj * 128); v1 += *(const f32x4*)(base32 + off + bj * 128 + 4); }
                    else { const u32x4 b = *(const u32x4*)(base16 + off + bj * 128); v0[0] += bf_lo(b.x); v0[1] += bf_hi(b.x); v0[2] += bf_lo(b.y); v0[3] += bf_hi(b.y); v1[0] += bf_lo(b.z); v1[1] += bf_hi(b.z); v1[2] += bf_lo(b.w); v1[3] += bf_hi(b.w); }
                    u32x4 w; w.x = cvt_pk_bf16(v0[0], v0[1]); w.y = cvt_pk_bf16(v0[2], v0[3]); w.z = cvt_pk_bf16(v1[0], v1[1]); w.w = cvt_pk_bf16(v1[2], v1[3]);
                    *(u32x4*)(H1 + off + bj * 128) = w; }
                if (m & 1) asm volatile("" ::: "memory"); }
    }
};
template <int NN> struct MoeOrder {
    int j, wpx, s0, s1, s2, s3, n0, n1, n2, n3;
    __device__ __forceinline__ void init(int G, int c, const int* PST) {
#ifndef MOE_XA
#define MOE_XA 2
#endif
#ifndef MOE_CHUNKED
#define MOE_CHUNKED 0
#endif
        if (MOE_XA == 1 && (G & 7) == 0) { wpx = G >> 3; const int x = MOE_CHUNKED ? c / wpx : (c & 7); j = MOE_CHUNKED ? c % wpx : (c >> 3);
            s0 = PST[x] >> 8; n0 = (PST[x + 1] - PST[x]) >> 8; s1 = PST[x + 8] >> 8; n1 = (PST[x + 9] - PST[x + 8]) >> 8;
            s2 = PST[x + 16] >> 8; n2 = (PST[x + 17] - PST[x + 16]) >> 8; s3 = PST[x + 24] >> 8; n3 = (PST[x + 25] - PST[x + 24]) >> 8; }
        else { j = c; wpx = G; s0 = 0; n0 = PST[32] >> 8; s1 = s2 = s3 = 0; n1 = n2 = n3 = 0; }
        if (MOE_XA == 2 && (G & 7) == 0) { wpx = G >> 3; j = c >> 3; s1 = c & 7; n0 = PST[32] >> 8; }
    }
    __device__ __forceinline__ bool next(int i, pg8::Unit& u) const {
        const int q = i * wpx + j; int pml = q / NN; u.pn = q % NN;
        if (MOE_XA == 2) { u.pm = s1 + 8 * pml; return u.pm < n0; }
        if (pml < n0) { u.pm = s0 + pml; return true; } pml -= n0;
        if (pml < n1) { u.pm = s1 + pml; return true; } pml -= n1;
        if (pml < n2) { u.pm = s2 + pml; return true; } pml -= n2;
        if (pml < n3) { u.pm = s3 + pml; return true; }
        return false;
    }
};
struct PUp : PBase {
    static constexpr int K = 1024, BROW64 = 0; static constexpr bool GATHER = true, FP8 = UP_FP8; static constexpr int ES = UP_FP8 ? 1 : 2;
    static constexpr int SCALE_AB = 0x7c79;
    MoeOrder<8> mo; const char* A; const char* B; const int* ROWTOK; const int* TILEEXP; const float* bup; const float* ROWSCALE; bf16_t* ACT;
    int idx[2][2]; int c0, c1;
    __device__ __forceinline__ bool next(int i, pg8::Unit& u) const { return mo.next(i, u); }
    __device__ __forceinline__ const char* a_base() const { return A; }
    __device__ __forceinline__ void a_offs(const pg8::Unit& u, int R0, int C0, int R1, int C1, unsigned (&vo)[2][2], bool first) {
        c0 = C0; c1 = C1;
        const int* rp = ROWTOK + u.pm * 256;
#pragma unroll
        for (int h = 0; h < 2; ++h) {
            asm volatile("global_load_dword %0, %1, off" : "=v"(idx[h][0]) : "v"(rp + 128 * h + R0) : "memory");
            asm volatile("global_load_dword %0, %1, off" : "=v"(idx[h][1]) : "v"(rp + 128 * h + R1) : "memory");
        }
        asm volatile("s_waitcnt vmcnt(0)" : "+v"(idx[0][0]), "+v"(idx[0][1]), "+v"(idx[1][0]), "+v"(idx[1][1]) :: "memory");
#pragma unroll
        for (int h = 0; h < 2; ++h) { vo[h][0] = (unsigned)(idx[h][0] * K * ES + 2 * c0); vo[h][1] = (unsigned)(idx[h][1] * K * ES + 2 * c1); }
    }
    __device__ __forceinline__ void b_ptrs(const pg8::Unit& u, const char*& b0, const char*& b1) const {
        const int e = TILEEXP[u.pm]; b0 = B + ((size_t)e * 2048 + (size_t)u.pn * 128) * K * ES; b1 = b0 + (size_t)1024 * K * ES; }
    __device__ __forceinline__ void epi(f32x4 (&acc)[2][2][4][2], const pg8::Unit& u, int wr, int wc, int fr, int fq) const {
        const int e = TILEEXP[u.pm];
        const int row0 = u.pm * 256 + wr * 64 + fr, col0 = u.pn * 128 + wc * 32 + 8 * fq;
        const float* bg = bup + (size_t)e * 2048 + col0; const float* bl = bg + 1024;
        f32x4 bgv[2], blv[2];
#pragma unroll
        for (int n = 0; n < 2; ++n) { bgv[n] = *(const f32x4*)(bg + 4 * n); blv[n] = *(const f32x4*)(bl + 4 * n); }
#pragma unroll
        for (int ai = 0; ai < 2; ++ai)
#pragma unroll
            for (int m = 0; m < 4; ++m) {
                float a[8]; const float rs = ROWSCALE[row0 + ai * 128 + m * 16];
#pragma unroll
                for (int n = 0; n < 2; ++n)
#pragma unroll
                    for (int j = 0; j < 4; ++j) {
                        float glu = acc[ai][0][m][n][j] * rs + bgv[n][j], lin = acc[ai][1][m][n][j] * rs + blv[n][j];
                        glu = fminf(glu, 7.0f); lin = fminf(fmaxf(lin, -7.0f), 7.0f);
                        a[4 * n + j] = glu * sigmoidf(1.702f * glu) * (lin + 1.0f);
                    }
                if (DN_FP8) { u32x2 w; w.x = pk4_fp8(a[0] * 4.f, a[1] * 4.f, a[2] * 4.f, a[3] * 4.f); w.y = pk4_fp8(a[4] * 4.f, a[5] * 4.f, a[6] * 4.f, a[7] * 4.f);
                    *(u32x2*)((unsigned char*)ACT + (size_t)(row0 + ai * 128 + m * 16) * 1024 + col0) = w; }
                else { u32x4 w; w.x = cvt_pk_bf16(a[0], a[1]); w.y = cvt_pk_bf16(a[2], a[3]); w.z = cvt_pk_bf16(a[4], a[5]); w.w = cvt_pk_bf16(a[6], a[7]);
                    *(u32x4*)(ACT + (size_t)(row0 + ai * 128 + m * 16) * 1024 + col0) = w; }
            }
    }
};
struct PDown : PBase {
    static constexpr int K = 1024, BROW64 = 0; static constexpr bool FP8 = DN_FP8; static constexpr int ES = DN_FP8 ? 1 : 2;
    static constexpr int SCALE_AB = 0x7d79;
    MoeOrder<4> mo; const char* A; const char* B; const int* TILEEXP; const float* bdn; const float* ROWGATE; bf16_t* YB;
    __device__ __forceinline__ bool next(int i, pg8::Unit& u) const { return mo.next(i, u); }
    __device__ __forceinline__ const char* a_base() const { return A; }
    __device__ __forceinline__ void a_offs(const pg8::Unit& u, int R0, int C0, int R1, int C1, unsigned (&vo)[2][2], bool) const {
#pragma unroll
        for (int h = 0; h < 2; ++h) { vo[h][0] = (unsigned)((u.pm * 256 + 128 * h + R0) * K * ES + 2 * C0); vo[h][1] = (unsigned)((u.pm * 256 + 128 * h + R1) * K * ES + 2 * C1); }
    }
    __device__ __forceinline__ void b_ptrs(const pg8::Unit& u, const char*& b0, const char*& b1) const {
        const int e = TILEEXP[u.pm]; b0 = B + ((size_t)e * 1024 + (size_t)u.pn * 256) * K * ES; b1 = b0 + (size_t)128 * K * ES; }
    __device__ __forceinline__ void epi(f32x4 (&acc)[2][2][4][2], const pg8::Unit& u, int wr, int wc, int fr, int fq) const {
        const int e = TILEEXP[u.pm];
        const int row0 = u.pm * 256 + wr * 64 + fr, col0 = u.pn * 256 + wc * 32 + 8 * fq;
        const float* bp = bdn + (size_t)e * 1024 + col0;
#pragma unroll
        for (int bj = 0; bj < 2; ++bj) {
            const f32x4 bv0 = *(const f32x4*)(bp + 128 * bj), bv1 = *(const f32x4*)(bp + 128 * bj + 4);
#pragma unroll
            for (int ai = 0; ai < 2; ++ai)
#pragma unroll
                for (int m = 0; m < 4; ++m) { const int row = row0 + ai * 128 + m * 16; const float gt = ROWGATE[row];
                    const f32x4 v0 = (acc[ai][bj][m][0] + bv0) * (gt * 16.f), v1 = (acc[ai][bj][m][1] + bv1) * (gt * 16.f);
                    u32x2 w; w.x = pk4_fp8(v0[0], v0[1], v0[2], v0[3]); w.y = pk4_fp8(v1[0], v1[1], v1[2], v1[3]);
                    *(u32x2*)((unsigned char*)YB + (size_t)row * 1024 + col0 + 128 * bj) = w; }
            asm volatile("" ::: "memory");
        }
    }
};

struct TItem { const float* src; bf16_t* dst; const float* ksc; int N, K; unsigned char* dst8; };
__device__ __forceinline__ void titem_load(const TItem& it, f32x4 (&v)[16], int lane) {
    const float* p = it.src + (size_t)(lane >> 4) * it.N + 4 * (lane & 15);
#pragma unroll
    for (int i = 0; i < 16; ++i) v[i] = *(const f32x4*)(p + (size_t)(4 * i) * it.N);
}
__device__ __forceinline__ void titem_store(const TItem& it, f32x4 (&v)[16], LAS float* scr, int lane) {
    if (it.ksc) {
#pragma unroll
        for (int i = 0; i < 16; ++i) v[i] *= it.ksc[4 * i + (lane >> 4)];
    }
#pragma unroll
    for (int i = 0; i < 16; ++i) { LAS float* d = scr + (4 * i + (lane >> 4)) * 65 + 4 * (lane & 15); d[0] = v[i][0]; d[1] = v[i][1]; d[2] = v[i][2]; d[3] = v[i][3]; }
    asm volatile("s_waitcnt lgkmcnt(0)" ::: "memory");
    if (it.dst8) {
        const int c = lane & 3;
#pragma unroll
        for (int j = 0; j < 4; ++j) { const int n = (lane >> 2) + 16 * j; const LAS float* s = scr + (16 * c) * 65 + n;
            u32x4 o;
            o.x = pk4_fp8(s[0 * 65] * 64.f, s[1 * 65] * 64.f, s[2 * 65] * 64.f, s[3 * 65] * 64.f); o.y = pk4_fp8(s[4 * 65] * 64.f, s[5 * 65] * 64.f, s[6 * 65] * 64.f, s[7 * 65] * 64.f);
            o.z = pk4_fp8(s[8 * 65] * 64.f, s[9 * 65] * 64.f, s[10 * 65] * 64.f, s[11 * 65] * 64.f); o.w = pk4_fp8(s[12 * 65] * 64.f, s[13 * 65] * 64.f, s[14 * 65] * 64.f, s[15 * 65] * 64.f);
            *(u32x4*)(it.dst8 + (size_t)n * it.K + 16 * c) = o; }
    } else {
        const int c = lane & 7;
#pragma unroll
        for (int j = 0; j < 8; ++j) { const int n = (lane >> 3) + 8 * j; const LAS float* s = scr + (8 * c) * 65 + n;
            u32x4 o; o.x = pk2(s[0 * 65], s[1 * 65]); o.y = pk2(s[2 * 65], s[3 * 65]); o.z = pk2(s[4 * 65], s[5 * 65]); o.w = pk2(s[6 * 65], s[7 * 65]);
            *(u32x4*)(it.dst + (size_t)n * it.K + 8 * c) = o; }
    }
    asm volatile("s_waitcnt lgkmcnt(0)" ::: "memory");
}
__device__ __forceinline__ void rms_row_to_bf16(const f32x4 (&v)[4], const float* g, bf16_t* orow, int lane) {
    float s = 0.f;
#pragma unroll
    for (int j = 0; j < 4; ++j) s += (v[j][0] * v[j][0] + v[j][1] * v[j][1]) + (v[j][2] * v[j][2] + v[j][3] * v[j][3]);
    const float r = rsqrtf(wave_sum(s) * (1.f / D) + EPS);
#pragma unroll
    for (int j = 0; j < 4; ++j) { const f32x4 gg = *(const f32x4*)(g + 4 * lane + 256 * j); const f32x4 o = v[j] * gg * r;
        u32x2 w; w.x = cvt_pk_bf16(o[0], o[1]); w.y = cvt_pk_bf16(o[2], o[3]); *(u32x2*)(orow + 4 * lane + 256 * j) = w; }
}
struct Cplx { float re, im; };
__device__ __forceinline__ Cplx cmul(Cplx a, Cplx b) { return Cplx{a.re * b.re - a.im * b.im, a.re * b.im + a.im * b.re}; }
__device__ __forceinline__ Cplx lam_pow(float lr, float li, float step, int n) {
    const float mag = expf((float)n * lr * step); const double ang = (double)n * (double)li * (double)step;
    return Cplx{mag * (float)cos(ang), mag * (float)sin(ang)};
}
__device__ __forceinline__ Cplx bbar_factor(float lr, float li, float step) {
    const Cplx lb = lam_pow(lr, li, step, 1); const float nr = lb.re - 1.f, ni = lb.im, den = lr * lr + li * li;
    return Cplx{(nr * lr + ni * li) / den, (ni * lr - nr * li) / den};
}
template <int PMODE> __device__ __forceinline__ void p0_prologue(Frame& F) {
    const int gw = F.bx * NWAVES + F.wave, NGW = F.G * NWAVES, lane = F.lane;
    const int gt = F.bx * NTHREADS + F.tid, NGT = F.G * NTHREADS;
    unsigned char* ws = F.ws;
    if (!(PMODE & 1)) {
        LAS float* scr = (LAS float*)(F.lds + LDS_RING) + F.wave * (64 * 65);
        constexpr int I_UP = 32 * 16 * 32, I_DN = 32 * 16 * 16, I_IN = 16 * 32, I_OUT = 16 * 16, I_GLU = 8 * 8;
        constexpr int PER_L = I_UP + I_DN + I_IN + I_OUT + I_GLU, TOTAL = DEPTH * PER_L;
        auto decode = [&](int it) -> TItem {
            TItem ti; const int l = it / PER_L; int r = it % PER_L; const float* W; bf16_t* WT; int K, N; ti.ksc = nullptr; bool f8 = false;
            if (r < I_UP) { const int e = r / 512; r %= 512; K = 1024; N = 2048; W = arg_in(24) + ((size_t)l * NE + e) * 1024 * 2048; WT = (bf16_t*)(ws + WS_WUP + l * WUP_STRIDE) + (size_t)e * 2048 * 1024 / (UP_FP8 ? 2 : 1); f8 = UP_FP8; }
            else if ((r -= I_UP) < I_DN) { const int e = r / 256; r %= 256; K = 1024; N = 1024; W = arg_in(26) + ((size_t)l * NE + e) * 1024 * 1024; WT = (bf16_t*)(ws + WS_WDN + l * WDN_STRIDE) + (size_t)e * 1024 * 1024 / (DN_FP8 ? 2 : 1); f8 = DN_FP8; }
            else if ((r -= I_DN) < I_IN) { K = 1024; N = 2048; W = arg_in(2) + (size_t)l * 1024 * 2048; WT = (bf16_t*)(ws + WS_WIN + l * WIN_STRIDE); }
            else if ((r -= I_IN) < I_OUT) { K = 1024; N = 1024; W = arg_in(20) + (size_t)l * 1024 * 1024; WT = (bf16_t*)(ws + WS_WOUT + l * WOUT_STRIDE); if ((r / 16) * 64 < DS) ti.ksc = arg_in(12) + l * DS + (r / 16) * 64; }
            else { r -= I_OUT; K = 512; N = 512; W = arg_in(11) + (size_t)l * 512 * 512; WT = (bf16_t*)(ws + WS_WGLU + l * WGLU_STRIDE); }
            const int nblk = N / 64, k0 = 64 * (r / nblk), n0 = 64 * (r % nblk);
            ti.src = W + (size_t)k0 * N + n0; ti.dst = WT + (size_t)n0 * K + k0; ti.N = N; ti.K = K; ti.dst8 = f8 ? (unsigned char*)WT + (size_t)n0 * K + k0 : nullptr; return ti;
        };
        f32x4 va[16], vb[16]; TItem ia, ib;
        int it = gw;
        if (it < TOTAL) { ia = decode(it); titem_load(ia, va, lane); }
        while (it < TOTAL) {
            const int itb = it + NGW;
            if (itb < TOTAL) { ib = decode(itb); titem_load(ib, vb, lane); }
            titem_store(ia, va, scr, lane);
            if (itb >= TOTAL) break;
            const int itc = itb + NGW;
            if (itc < TOTAL) { ia = decode(itc); titem_load(ia, va, lane); }
            titem_store(ib, vb, scr, lane);
            it = itc;
        }
    }
    for (int i = gt; i < SEQ * 32; i += NGT) {
        const int s = i >> 5, j = i & 31;
        const float inv = 1.0f / powf(10000.0f, (float)(2 * j) / 64.0f);
        const float ang = (float)s * inv;
        ((float*)(ws + WS_COS))[i] = (float)cos((double)ang); ((float*)(ws + WS_SIN))[i] = (float)sin((double)ang);
    }
    if (F.bx == 0 && F.wave < DEPTH) {
        const int l = F.wave;
        float a = arg_in(15)[l * 64 + lane] * arg_in(16)[l * 64 + lane], b = arg_in(17)[l * 64 + lane] * arg_in(18)[l * 64 + lane];
        a = wave_sum(a); b = wave_sum(b);
        float mq = fabsf(arg_in(13)[l * 64 + lane]), mk = fabsf(arg_in(14)[l * 64 + lane]);
#pragma unroll
        for (int o = 1; o < 64; o <<= 1) { mq = fmaxf(mq, __shfl_xor(mq, o)); mk = fmaxf(mk, __shfl_xor(mk, o)); }
        const float lambda_init = 0.8f - 0.6f * expf(-0.3f * (float)l);
        { float* gqk = (float*)(ws + WS_SCAL) + 64 + l * 128; gqk[lane] = arg_in(13)[l * 64 + lane]; gqk[64 + lane] = arg_in(14)[l * 64 + lane]; }
        if (lane == 0) { float* sc = (float*)(ws + WS_SCAL) + l * 4; sc[0] = expf(a) - expf(b) + lambda_init; sc[1] = C2 * 64.f * mq * mk * 1.02f + 0.5f; sc[2] = 1.0f - lambda_init; }
    }
    for (int i = gt; i < DEPTH * NE * D; i += NGT) {
        const int l = i / (NE * D), e = (i / D) % NE, k = i % D;
        const float w = arg_in(22)[(size_t)l * D * NE + (size_t)k * NE + e];
        const unsigned hi = f2bf(w); const float lo = w - __builtin_bit_cast(float, hi << 16);
        bf16_t* t = (bf16_t*)(ws + WS_WRT + l * WRT_STRIDE);
        t[e * D + k] = (bf16_t)hi; t[NE * D + e * D + k] = (bf16_t)f2bf(lo);
    }
#define TBL_PTRS(l) const float* lam_re = arg_in(3) + (l) * NG * NP; const float* lam_im = arg_in(4) + (l) * NG * NP; const float* log_step = arg_in(5) + (l) * NG; \
        const float* b_re = arg_in(6) + (size_t)(l) * NG * NP * HS; const float* b_im = arg_in(7) + (size_t)(l) * NG * NP * HS; \
        const float* c_re = arg_in(8) + (size_t)(l) * NG * HS * NP; const float* c_im = arg_in(9) + (size_t)(l) * NG * HS * NP; \
        bf16_t* KT = (bf16_t*)(ws + WS_KT + (l) * KT_STRIDE); bf16_t* HT = (bf16_t*)(ws + WS_HT + (l) * HT_STRIDE); (void)KT; (void)HT; (void)b_re; (void)b_im
    if (!(PMODE & 2)) {
        {
            LAS float* pwl = (LAS float*)(F.lds + LDS_RING);
            for (int cb = F.bx; cb < DEPTH * NG * 17; cb += F.G) {
                const int l = cb / (NG * 17), rb = cb % (NG * 17);
                if (rb >= NG * 9) continue;
                const int blk = rb;
                TBL_PTRS(l);
                const int g = blk / 9, s0 = (blk % 9) * 8;
                const float step = expf(log_step[g]);
                __syncthreads();
                { const int p = F.tid & 63, sl = F.tid >> 6, slot = s0 + sl; Cplx w{0.f, 0.f};
                  if (slot >= 1 && slot <= 64) { const float lr = lam_re[g * NP + p], li = lam_im[g * NP + p]; w = cmul(lam_pow(lr, li, step, slot - 1), bbar_factor(lr, li, step)); }
                  pwl[(sl * 64 + p) * 2] = w.re; pwl[(sl * 64 + p) * 2 + 1] = w.im; }
                __syncthreads();
                const int pq = F.tid & 3, h = (F.tid >> 2) & 15, sl = F.tid >> 6, slot = s0 + sl;
                float accv[16];
#pragma unroll
                for (int q = 0; q < 16; ++q) accv[q] = 0.f;
                for (int pp = 0; pp < 16; ++pp) {
                    const int p = pq * 16 + pp;
                    const Cplx w = cmul(Cplx{c_re[(size_t)(g * HS + h) * NP + p], c_im[(size_t)(g * HS + h) * NP + p]}, Cplx{pwl[(sl * 64 + p) * 2], pwl[(sl * 64 + p) * 2 + 1]});
#pragma unroll
                    for (int q = 0; q < 16; ++q) { const float br = b_re[(size_t)(g * NP + p) * HS + q], bi = b_im[(size_t)(g * NP + p) * HS + q]; accv[q] += w.re * br - w.im * bi; }
                }
#pragma unroll
                for (int q = 0; q < 16; ++q) { accv[q] += __shfl_xor(accv[q], 1); accv[q] += __shfl_xor(accv[q], 2); }
                if (pq == 0 && slot <= 64) {
                    u32x4 o0, o1; o0.x = pk2(accv[0], accv[1]); o0.y = pk2(accv[2], accv[3]); o0.z = pk2(accv[4], accv[5]); o0.w = pk2(accv[6], accv[7]);
                    o1.x = pk2(accv[8], accv[9]); o1.y = pk2(accv[10], accv[11]); o1.z = pk2(accv[12], accv[13]); o1.w = pk2(accv[14], accv[15]);
                    u32x4* dst = (u32x4*)(KT + ((size_t)(g * 65 + slot) * HS + h) * 16); dst[0] = o0; dst[1] = o1;
                }
            }
            for (int cb = F.bx; cb < DEPTH * NG * 17; cb += F.G) {
                const int l = cb / (NG * 17), rb = cb % (NG * 17);
                if (rb < NG * 9) continue;
                const int blk = rb - NG * 9;
                TBL_PTRS(l);
                const int g = blk >> 3, t0 = (blk & 7) * 8;
                const float step = expf(log_step[g]);
                __syncthreads();
                { const int p = F.tid & 63, tl = F.tid >> 6; const Cplx w = lam_pow(lam_re[g * NP + p], lam_im[g * NP + p], step, t0 + tl + 1); pwl[(tl * 64 + p) * 2] = w.re; pwl[(tl * 64 + p) * 2 + 1] = w.im; }
                __syncthreads();
                const int pq = F.tid & 3, h = (F.tid >> 2) & 15, tl = F.tid >> 6, t = t0 + tl;
                bf16_t* dst = HT + ((size_t)(g * 1024 + t * 16 + h) * 128 + pq * 32);
                for (int pp = 0; pp < 16; pp += 4) {
                    float v[8];
#pragma unroll
                    for (int q = 0; q < 4; ++q) { const int p = pq * 16 + pp + q;
                        const Cplx w = cmul(Cplx{c_re[(size_t)(g * HS + h) * NP + p], c_im[(size_t)(g * HS + h) * NP + p]}, Cplx{pwl[(tl * 64 + p) * 2], pwl[(tl * 64 + p) * 2 + 1]});
                        v[2 * q] = w.re; v[2 * q + 1] = -w.im; }
                    u32x4 o; o.x = pk2(v[0], v[1]); o.y = pk2(v[2], v[3]); o.z = pk2(v[4], v[5]); o.w = pk2(v[6], v[7]);
                    *(u32x4*)(dst + 2 * pp) = o;
                }
            }
            __syncthreads();
        }
    }
#undef TBL_PTRS
    if (!(PMODE & 2)) for (int l = 0; l < DEPTH; ++l) {
        const float* lam_re = arg_in(3) + l * NG * NP; const float* lam_im = arg_in(4) + l * NG * NP; const float* log_step = arg_in(5) + l * NG;
        const float* b_re = arg_in(6) + (size_t)l * NG * NP * HS; const float* b_im = arg_in(7) + (size_t)l * NG * NP * HS;
        const float* c_re = arg_in(8) + (size_t)l * NG * HS * NP; const float* c_im = arg_in(9) + (size_t)l * NG * HS * NP;
        bf16_t* KT = (bf16_t*)(ws + WS_KT + l * KT_STRIDE); bf16_t* GT = (bf16_t*)(ws + WS_GT + l * GT_STRIDE); bf16_t* HT = (bf16_t*)(ws + WS_HT + l * HT_STRIDE);
        float* LAML = (float*)(ws + WS_LAML + l * LAML_STRIDE);
        for (int i = gt; i < NG * NP * 64; i += NGT) {
            const int s = i % 64, p = (i / 64) % NP, g = i / (64 * NP);
            const float step = expf(log_step[g]); const float lr = lam_re[g * NP + p], li = lam_im[g * NP + p];
            const Cplx w = cmul(lam_pow(lr, li, step, 63 - s), bbar_factor(lr, li, step));
            float vr[16], vi[16];
#pragma unroll
            for (int q = 0; q < 16; ++q) { const float br = b_re[(size_t)(g * NP + p) * HS + q], bi = b_im[(size_t)(g * NP + p) * HS + q]; vr[q] = w.re * br - w.im * bi; vi[q] = w.re * bi + w.im * br; }
            u32x4* dr = (u32x4*)(GT + ((size_t)(g * 128 + 2 * p) * 1024 + s * 16)); u32x4* di = (u32x4*)(GT + ((size_t)(g * 128 + 2 * p + 1) * 1024 + s * 16));
            u32x4 o; o.x = pk2(vr[0], vr[1]); o.y = pk2(vr[2], vr[3]); o.z = pk2(vr[4], vr[5]); o.w = pk2(vr[6], vr[7]); dr[0] = o;
            o.x = pk2(vr[8], vr[9]); o.y = pk2(vr[10], vr[11]); o.z = pk2(vr[12], vr[13]); o.w = pk2(vr[14], vr[15]); dr[1] = o;
            o.x = pk2(vi[0], vi[1]); o.y = pk2(vi[2], vi[3]); o.z = pk2(vi[4], vi[5]); o.w = pk2(vi[6], vi[7]); di[0] = o;
            o.x = pk2(vi[8], vi[9]); o.y = pk2(vi[10], vi[11]); o.z = pk2(vi[12], vi[13]); o.w = pk2(vi[14], vi[15]); di[1] = o;
        }
        for (int i = gt; i < NG * NP; i += NGT) { const int g = i / NP; const Cplx w = lam_pow(lam_re[i], lam_im[i], expf(log_step[g]), 64); LAML[2 * i] = w.re; LAML[2 * i + 1] = w.im; }
    }
    {
        const float* xin = arg_in(0); const float* g0 = arg_in(1); bf16_t* XN = (bf16_t*)(ws + WS_XN);
        f32x4 va[4], vb[4];
        int m = gw;
        if (m < T) {
#pragma unroll
            for (int j = 0; j < 4; ++j) va[j] = ((const f32x4*)(xin + (size_t)m * D) + lane)[64 * j]; }
        while (m < T) {
            const int mb = m + NGW;
            if (mb < T) {
#pragma unroll
                for (int j = 0; j < 4; ++j) vb[j] = ((const f32x4*)(xin + (size_t)mb * D) + lane)[64 * j]; }
            rms_row_to_bf16(va, g0, XN + (size_t)m * D, lane);
            if (mb >= T) break;
            const int mc = mb + NGW;
            if (mc < T) {
#pragma unroll
                for (int j = 0; j < 4; ++j) va[j] = ((const f32x4*)(xin + (size_t)mc * D) + lane)[64 * j]; }
            rms_row_to_bf16(vb, g0, XN + (size_t)mb * D, lane);
            m = mc;
        }
    }
}

__device__ __forceinline__ void s5a_phase(Frame& F, int l) {
    const bf16_t* GT = (const bf16_t*)(F.ws + WS_GT + l * GT_STRIDE); const bf16_t* U = (const bf16_t*)(F.ws + WS_U); float* S = (float*)(F.ws + WS_S);
    const int lane = F.lane, n = lane & 15, kq = lane >> 4;
    for (int uu = F.bx * NWAVES + F.wave; uu < NG * 32 * 2; uu += F.G * NWAVES) {
        const int g = uu >> 6, ntile = (uu >> 1) & 31, mh = uu & 1;
        const int chunk = ntile * 16 + n;
        const bf16_t* up = U + ((size_t)chunk * 64 + (kq >> 1)) * DS + g * 16 + 8 * (kq & 1);
        const bf16_t* gp = GT + ((size_t)(g * 128 + mh * 64 + n) * 1024 + 8 * kq);
        f32x4 acc[4];
#pragma unroll
        for (int mt = 0; mt < 4; ++mt) acc[mt] = (f32x4){0.f, 0.f, 0.f, 0.f};
#pragma unroll 4
        for (int ks = 0; ks < 32; ++ks) {
            const bf16x8 b = *(const bf16x8*)(up + (size_t)(2 * ks) * DS);
#pragma unroll
            for (int mt = 0; mt < 4; ++mt) { const bf16x8 a = *(const bf16x8*)(gp + (size_t)(mt * 16) * 1024 + 32 * ks); acc[mt] = __builtin_amdgcn_mfma_f32_16x16x32_bf16(a, b, acc[mt], 0, 0, 0); }
        }
#pragma unroll
        for (int mt = 0; mt < 4; ++mt) *(f32x4*)(S + ((size_t)chunk * NG + g) * 128 + mh * 64 + mt * 16 + 4 * kq) = acc[mt];
    }
}
__device__ __forceinline__ void s5c_phase(Frame& F, int l) {
    const bf16_t* KT = (const bf16_t*)(F.ws + WS_KT + l * KT_STRIDE); const bf16_t* HT = (const bf16_t*)(F.ws + WS_HT + l * HT_STRIDE);
    const float* LAML = (const float*)(F.ws + WS_LAML + l * LAML_STRIDE); const float* S = (const float*)(F.ws + WS_S);
    const bf16_t* U = (const bf16_t*)(F.ws + WS_U); bf16_t* YG = (bf16_t*)(F.ws + WS_YG); const float* dsk = arg_in(10) + l * DS;
    const int lane = F.lane, n = lane & 15, kq = lane >> 4, wave = F.wave;
    LAS unsigned char* ktl = F.lds + LDS_RING;
    LAS unsigned char* xs = F.lds + LDS_RING + 33792 + wave * 4096;
    LAS f32x2* EB = (LAS f32x2*)(F.lds + LDS_RING + 33792 + 8 * 4096);
    LAS f32x2* EH = EB + 512;
    for (int wu = F.bx; wu < NG * 8; wu += F.G) {
        const int g = wu >> 3, scq = wu & 7, b = scq >> 1, cbase = (scq & 1) * 64, scl = wave >> 1, par = wave & 1;
        __syncthreads();
        for (int i = F.tid; i < 65 * 32; i += NTHREADS) *(LAS u32x4*)(ktl + i * 16) = *(const u32x4*)(KT + (size_t)g * 65 * 256 + i * 8);
        const Cplx L = Cplx{LAML[(g * NP + lane) * 2], LAML[(g * NP + lane) * 2 + 1]};
        const float* sp = S + ((size_t)(b * CPB) * NG + g) * 128 + 2 * lane;
        {
            f32x2 sv[8];
#pragma unroll
            for (int j = 0; j < 8; ++j) sv[j] = *(const f32x2*)(sp + (size_t)(cbase + 8 * wave + j) * NG * 128);
            Cplx E{0.f, 0.f};
#pragma unroll
            for (int j = 0; j < 8; ++j) { const Cplx nx = cmul(L, E); E.re = nx.re + sv[j][0]; E.im = nx.im + sv[j][1]; }
            EB[wave * 64 + lane] = (f32x2){E.re, E.im};
            if (cbase) {
#pragma unroll
                for (int j = 0; j < 8; ++j) sv[j] = *(const f32x2*)(sp + (size_t)(8 * wave + j) * NG * 128);
                Cplx H{0.f, 0.f};
#pragma unroll
                for (int j = 0; j < 8; ++j) { const Cplx nx = cmul(L, H); H.re = nx.re + sv[j][0]; H.im = nx.im + sv[j][1]; }
                EH[wave * 64 + lane] = (f32x2){H.re, H.im};
            }
        }
        __syncthreads();
        const int c0 = cbase + 16 * scl;
        {
            const Cplx L2 = cmul(L, L), L4 = cmul(L2, L2), L8 = cmul(L4, L4);
            Cplx X{0.f, 0.f};
            if (cbase) {
#pragma unroll
                for (int w = 0; w < 8; ++w) { const f32x2 e = EH[w * 64 + lane]; const Cplx nx = cmul(L8, X); X.re = nx.re + e[0]; X.im = nx.im + e[1]; }
            }
            for (int w = 0; w < 2 * scl; ++w) { const f32x2 e = EB[w * 64 + lane]; const Cplx nx = cmul(L8, X); X.re = nx.re + e[0]; X.im = nx.im + e[1]; }
            f32x2 sv[16];
#pragma unroll
            for (int j = 0; j < 16; ++j) sv[j] = *(const f32x2*)(sp + (size_t)(c0 + j) * NG * 128);
#pragma unroll
            for (int j = 0; j < 16; ++j) {
                *(LAS unsigned*)(xs + j * 256 + 4 * lane) = pk2(X.re, X.im);
                const Cplx nx = cmul(L, X); X.re = nx.re + sv[j][0]; X.im = nx.im + sv[j][1];
            }
        }
        const int chunk = b * CPB + c0 + n;
        bf16x8 ub[32];
        {
            const bf16_t* up = U + ((size_t)chunk * 64 + (kq >> 1)) * DS + g * 16 + 8 * (kq & 1);
#pragma unroll
            for (int kp = 0; kp < 32; ++kp) ub[kp] = *(const bf16x8*)(up + (size_t)(2 * kp) * DS);
        }
        const LAS unsigned char* xbp = xs + n * 256 + 16 * kq;
        const f32x4 dv = *(const f32x4*)(dsk + g * 16 + 4 * kq);
        const bf16_t* hp = HT + ((size_t)(g * 1024 + n) * 128 + 8 * kq);
        const bf16_t* uq = U + (size_t)chunk * 64 * DS + g * 16 + 4 * kq;
        const LAS unsigned char* kbase = ktl + (n * 16 + 8 * (kq & 1)) * 2;
        bf16x8 ha[4]; u32x2 uw;
#pragma unroll
        for (int ks = 0; ks < 4; ++ks) ha[ks] = *(const bf16x8*)(hp + (size_t)(par * 16) * 128 + 32 * ks);
        uw = *(const u32x2*)(uq + (size_t)par * DS);
        for (int ti = 0; ti < 32; ++ti) {
            const int t = 2 * ti + par, tn = (ti < 31) ? t + 2 : t;
            bf16x8 hn[4]; u32x2 un;
#pragma unroll
            for (int ks = 0; ks < 4; ++ks) hn[ks] = *(const bf16x8*)(hp + (size_t)(tn * 16) * 128 + 32 * ks);
            un = *(const u32x2*)(uq + (size_t)tn * DS);
            f32x4 acc = (f32x4){0.f, 0.f, 0.f, 0.f};
            const int slot0 = t + 1 - (kq >> 1);
#pragma unroll
            for (int kp = 0; kp < 32; ++kp) {
                if (kp <= ti) { const bf16x8 a = *(const LAS bf16x8*)(kbase + (slot0 - 2 * kp) * 512); acc = __builtin_amdgcn_mfma_f32_16x16x32_bf16(a, ub[kp], acc, 0, 0, 0); }
            }
#pragma unroll
            for (int ks = 0; ks < 4; ++ks) acc = __builtin_amdgcn_mfma_f32_16x16x32_bf16(ha[ks], *(const LAS bf16x8*)(xbp + 64 * ks), acc, 0, 0, 0);
            const float y0 = acc[0] + dv[0] * bf_lo(uw.x), y1 = acc[1] + dv[1] * bf_hi(uw.x), y2 = acc[2] + dv[2] * bf_lo(uw.y), y3 = acc[3] + dv[3] * bf_hi(uw.y);
            u32x2 w; w.x = cvt_pk_bf16(gelu_tanh(y0), gelu_tanh(y1)); w.y = cvt_pk_bf16(gelu_tanh(y2), gelu_tanh(y3));
            *(u32x2*)(YG + ((size_t)chunk * 64 + t) * DS + g * 16 + 4 * kq) = w;
#pragma unroll
            for (int ks = 0; ks < 4; ++ks) ha[ks] = hn[ks];
            uw = un;
        }
    }
    __syncthreads();
}

namespace att {
constexpr int KSLOT = 16384, VSLOT = 16384, LDS_K = 0, LDS_V = 3 * KSLOT, LDS_WS = 6 * 16384, LDS_END = LDS_WS + 8 * 256;
constexpr int STG_ROW = 136;
__device__ __forceinline__ int crow(int r, int hi) { return (r & 3) + 8 * (r >> 2) + 4 * hi; }
__device__ __forceinline__ void glds16(const void* gsrc, unsigned lds_dst) { unsigned keep;
    asm volatile("s_mov_b32 %0, m0\n\ts_mov_b32 m0, %2\n\ts_nop 0\n\tglobal_load_lds_dwordx4 %1, off\n\ts_mov_b32 m0, %0" : "=&s"(keep) : "v"(gsrc), "s"(lds_dst) : "memory"); }
typedef __attribute__((address_space(3))) const char* lds_cptr;
typedef short v4i16_t __attribute__((ext_vector_type(4)));
__device__ __forceinline__ s16x4 vtr(lds_cptr p) { return __builtin_bit_cast(s16x4, __builtin_amdgcn_ds_read_tr16_b64_v4i16((__attribute__((address_space(3))) v4i16_t*)p)); }
#define ATT_WAIT_BAR(N) asm volatile("s_waitcnt vmcnt(" #N ") lgkmcnt(0)\n\ts_barrier" ::: "memory")

template <int MODE> __device__ __forceinline__ void attn_unit(int bh, int qb, const bf16_t* Q, const bf16_t* K, const bf16_t* V, bf16_t* MIX, const float* subg, float lam, float mshift, float oml,
                                          LAS unsigned char* shm, int tid) {
    const int lane = tid & 63, r32 = lane & 31, hi = lane >> 5; const int wid = __builtin_amdgcn_readfirstlane(tid >> 6);
    const int b = bh >> 2, h = bh & 3, m = wid & 1, qg = wid >> 1;
    const size_t rowbase = (size_t)b * SEQ; const int q0 = qb * 128;
    const int NT = 2 * qb + 2, cw = 2 * qb + (qg >> 1);
    const unsigned lds0 = (unsigned)(uintptr_t)shm;
    const bf16_t* k0src = K + (rowbase + lane) * DA + h * 128 + wid * 8;
    const bf16_t* k1src = k0src + 64;
    const bf16_t* v0src = V + (rowbase + 16 * (wid & 3) + (lane >> 2)) * DA + h * 128 + (wid >> 2) * 32 + (lane & 3) * 8;
    const bf16_t* v1src = v0src + 64;
    const unsigned kdst = lds0 + LDS_K + wid * 1024, vdst = lds0 + LDS_V + wid * 1024;
#define ATT_DMA(t, slot) do { const size_t _o = (size_t)(t) * 64 * DA; \
        glds16(k0src + _o, (unsigned)__builtin_amdgcn_readfirstlane(kdst + (slot) * KSLOT)); glds16(k1src + _o, (unsigned)__builtin_amdgcn_readfirstlane(kdst + (slot) * KSLOT + 8192)); \
        glds16(v0src + _o, (unsigned)__builtin_amdgcn_readfirstlane(vdst + (slot) * VSLOT)); glds16(v1src + _o, (unsigned)__builtin_amdgcn_readfirstlane(vdst + (slot) * VSLOT + 8192)); } while (0)
    bf16x8 qr[4];
    { const bf16_t* Qw = Q + (rowbase + q0 + qg * 32 + r32) * DA + h * 128 + m * 64 + hi * 8;
#pragma unroll
      for (int d0 = 0; d0 < 4; ++d0) qr[d0] = *(const bf16x8*)(Qw + d0 * 16); }
#ifndef ATT_GRP
#define ATT_GRP (wid & 1)
#endif
    const int grp = ATT_GRP;
#define ATT_DMA_K(t, slot) do { if (MODE & 1) break; const size_t _o = (size_t)(t) * 64 * DA; \
        glds16(k0src + _o, (unsigned)__builtin_amdgcn_readfirstlane(kdst + (slot) * KSLOT)); glds16(k1src + _o, (unsigned)__builtin_amdgcn_readfirstlane(kdst + (slot) * KSLOT + 8192)); } while (0)
#define ATT_DMA_V(t, slot) do { if (MODE & 1) break; const size_t _o = (size_t)(t) * 64 * DA; \
        glds16(v0src + _o, (unsigned)__builtin_amdgcn_readfirstlane(vdst + (slot) * VSLOT)); glds16(v1src + _o, (unsigned)__builtin_amdgcn_readfirstlane(vdst + (slot) * VSLOT + 8192)); } while (0)
    ATT_DMA_K(0, 0); ATT_DMA_V(0, 0); ATT_DMA_K(1, 1); ATT_DMA_V(1, 1);
    f32x16 o[4];
#pragma unroll
    for (int d = 0; d < 4; ++d)
#pragma unroll
        for (int r = 0; r < 16; ++r) o[d][r] = 0.f;
    float l_reg = 0.f;
    const f32x16 zero16 = {0.f, 0.f, 0.f, 0.f, 0.f, 0.f, 0.f, 0.f, 0.f, 0.f, 0.f, 0.f, 0.f, 0.f, 0.f, 0.f};
    (void)mshift;
    const lds_cptr shm3 = (lds_cptr)shm;
    const lds_cptr kp0 = shm3 + LDS_K + m * 8192 + hi * 1024 + r32 * 16;
    const lds_cptr vp0 = shm3 + LDS_V + ((lane >> 4) & 1) * 32 + (lane & 3) * 8 + (4 * hi + ((lane & 15) >> 2)) * 64;
    u32x4 pw[4];
#pragma unroll
    for (int q = 0; q < 4; ++q) pw[q] = (u32x4){0u, 0u, 0u, 0u};
#define ATT_SB() __builtin_amdgcn_sched_barrier(0)
#define ATT_QKEXP(sl) do { if (MODE & 2) break; const lds_cptr kp = kp0 + (sl) * KSLOT; bf16x8 kf[8]; \
        ATT_SB(); \
        _Pragma("unroll") for (int j = 0; j < 4; ++j) { kf[2 * j] = *(const __attribute__((address_space(3))) bf16x8*)(kp + j * 2048); kf[2 * j + 1] = *(const __attribute__((address_space(3))) bf16x8*)(kp + j * 2048 + 512); } \
        ATT_SB(); \
        f32x16 p0 = __builtin_amdgcn_mfma_f32_32x32x16_bf16(kf[0], qr[0], zero16, 0, 0, 0); \
        f32x16 p1 = __builtin_amdgcn_mfma_f32_32x32x16_bf16(kf[1], qr[0], zero16, 0, 0, 0); \
        _Pragma("unroll") for (int d0 = 1; d0 < 4; ++d0) { p0 = __builtin_amdgcn_mfma_f32_32x32x16_bf16(kf[2 * d0], qr[d0], p0, 0, 0, 0); p1 = __builtin_amdgcn_mfma_f32_32x32x16_bf16(kf[2 * d0 + 1], qr[d0], p1, 0, 0, 0); } \
        ATT_SB(); \
        float sacc = 0.f; \
        _Pragma("unroll") for (int r = 0; r < 16; ++r) { p0[r] = __builtin_amdgcn_exp2f(p0[r]); p1[r] = __builtin_amdgcn_exp2f(p1[r]); sacc += p0[r] + p1[r]; } \
        l_reg += sacc; \
        _Pragma("unroll") for (int q = 0; q < 4; ++q) { pw[0][q] = cvt_pk_bf16(p0[2 * q], p0[2 * q + 1]); pw[1][q] = cvt_pk_bf16(p0[8 + 2 * q], p0[8 + 2 * q + 1]); \
                                                        pw[2][q] = cvt_pk_bf16(p1[2 * q], p1[2 * q + 1]); pw[3][q] = cvt_pk_bf16(p1[8 + 2 * q], p1[8 + 2 * q + 1]); } } while (0)
#define ATT_VRD(buf, d) do { _Pragma("unroll") for (int ks = 0; ks < 4; ++ks) { buf[0][ks] = vtr(vp + (d) * 4096 + ks * 1024); buf[1][ks] = vtr(vp + (d) * 4096 + ks * 1024 + 512); } } while (0)
#define ATT_VMM(buf, d) do { _Pragma("unroll") for (int ks = 0; ks < 4; ++ks) { \
        const bf16x8 vf = (bf16x8){buf[0][ks][0], buf[0][ks][1], buf[0][ks][2], buf[0][ks][3], buf[1][ks][0], buf[1][ks][1], buf[1][ks][2], buf[1][ks][3]}; \
        o[d] = __builtin_amdgcn_mfma_f32_32x32x16_bf16(__builtin_bit_cast(bf16x8, pw[ks]), vf, o[d], 0, 0, 0); } } while (0)
#define ATT_PV(sl) do { if (MODE & 4) break; const lds_cptr vp = vp0 + (sl) * VSLOT; s16x4 va[2][4], vb[2][4]; \
        ATT_SB(); ATT_VRD(va, 0); ATT_SB(); ATT_VRD(vb, 1); ATT_SB(); ATT_VMM(va, 0); ATT_SB(); ATT_VRD(va, 2); ATT_SB(); ATT_VMM(vb, 1); ATT_SB(); \
        ATT_VRD(vb, 3); ATT_SB(); ATT_VMM(va, 2); ATT_SB(); ATT_VMM(vb, 3); ATT_SB(); } while (0)
#ifndef ATT_TWO_GROUP
#define ATT_TWO_GROUP 0
#endif
    int sk = 0, skm1 = 2;
    if (ATT_TWO_GROUP) {
        for (int k = 0; k <= NT; ++k) {
            if (k + 1 < NT) { ATT_WAIT_BAR(4); } else { ATT_WAIT_BAR(0); }
            if (k + 2 < NT) ATT_DMA_K(k + 2, skm1);
            if (grp == 0) { if (k <= cw) ATT_QKEXP(sk); }
            else          { if (k >= 1 && k - 1 <= cw) ATT_PV(skm1); }
            if (k == NT) break;
            if (k + 2 < NT) { ATT_WAIT_BAR(4); } else { ATT_WAIT_BAR(0); }
            if (k + 2 < NT) ATT_DMA_V(k + 2, skm1);
            if (grp == 0) { if (k <= cw) ATT_PV(sk); }
            else          { if (k <= cw) ATT_QKEXP(sk); }
            skm1 = sk; sk = (sk == 2) ? 0 : sk + 1;
        }
    } else {
        for (int k = 0; k < NT; ++k) {
            if (k + 1 < NT) { ATT_WAIT_BAR(4); } else { ATT_WAIT_BAR(0); }
            if (k + 2 < NT) { ATT_DMA_K(k + 2, skm1); ATT_DMA_V(k + 2, skm1); }
            if (k <= cw) { ATT_QKEXP(sk); ATT_PV(sk); }
            skm1 = sk; sk = (sk == 2) ? 0 : sk + 1;
        }
    }
#undef ATT_QKEXP
#undef ATT_PV
#undef ATT_VRD
#undef ATT_VMM
#undef ATT_SB
#undef ATT_DMA_K
#undef ATT_DMA_V
    { auto rr = __builtin_amdgcn_permlane32_swap(__float_as_uint(l_reg), __float_as_uint(l_reg), false, false); l_reg = __uint_as_float(rr[0]) + __uint_as_float(rr[1]); }
    LAS float* wsf = (LAS float*)(shm + LDS_WS) + wid * 64;
    if (hi == 0) wsf[r32] = l_reg;
    ATT_WAIT_BAR(0);
    float rli[16];
    const float scl = m ? lam : 1.0f;
#pragma unroll
    for (int r = 0; r < 16; ++r) rli[r] = scl * __builtin_amdgcn_rcpf(wsf[crow(r, hi)]);
    LAS float* stg = (LAS float*)shm + qg * (32 * STG_ROW);
    if (m == 1) {
#pragma unroll
        for (int r = 0; r < 16; ++r)
#pragma unroll
            for (int d = 0; d < 4; ++d) stg[crow(r, hi) * STG_ROW + d * 32 + r32] = o[d][r] * rli[r];
    }
    ATT_WAIT_BAR(0);
    if (m == 0) {
#pragma unroll
        for (int r = 0; r < 16; ++r)
#pragma unroll
            for (int d = 0; d < 4; ++d) { LAS float* p = stg + crow(r, hi) * STG_ROW + d * 32 + r32; *p = o[d][r] * rli[r] - *p; }
    }
    ATT_WAIT_BAR(0);
    {
        const int row = 16 * m + (lane >> 2), qt = lane & 3;
        const LAS float* p = stg + row * STG_ROW + qt * 32;
        f32x4 v[8]; float ss = 0.f;
#pragma unroll
        for (int i = 0; i < 8; ++i) { v[i] = *(const LAS f32x4*)(p + 4 * i); ss += (v[i][0] * v[i][0] + v[i][1] * v[i][1]) + (v[i][2] * v[i][2] + v[i][3] * v[i][3]); }
        ss += __shfl_xor(ss, 1); ss += __shfl_xor(ss, 2);
        const float rn = rsqrtf(ss * (1.f / 128.f) + EPS) * oml;
        bf16_t* dst = MIX + (rowbase + q0 + qg * 32 + row) * D + DS + h * 128 + qt * 32;
#pragma unroll
        for (int i = 0; i < 4; ++i) {
            const f32x4 g0 = *(const f32x4*)(subg + qt * 32 + 8 * i), g1 = *(const f32x4*)(subg + qt * 32 + 8 * i + 4);
            const f32x4 a = v[2 * i] * g0 * rn, c = v[2 * i + 1] * g1 * rn;
            u32x4 w; w.x = cvt_pk_bf16(a[0], a[1]); w.y = cvt_pk_bf16(a[2], a[3]); w.z = cvt_pk_bf16(c[0], c[1]); w.w = cvt_pk_bf16(c[2], c[3]);
            *(u32x4*)(dst + 8 * i) = w;
        }
    }
    ATT_WAIT_BAR(0);
#undef ATT_DMA
}
}
template <int MODE> __device__ __forceinline__ void attn_phase(Frame& F, int l) {
    const bf16_t* Q = (const bf16_t*)(F.ws + WS_Q); const bf16_t* K = (const bf16_t*)(F.ws + WS_K); const bf16_t* V = (const bf16_t*)(F.ws + WS_V);
    bf16_t* MIX = (bf16_t*)(F.ws + WS_MIX);
    const float* sc = (const float*)(F.ws + WS_SCAL) + l * 4;
    const float lam = sc[0], mshift = sc[1], oml = sc[2];
    const float* subg = arg_in(19) + l * DV;
    const int G = F.G;
#ifndef ATT_XA
#define ATT_XA 1
#endif
    const bool xa = ATT_XA && (G & 7) == 0;
    const int x = F.bx & 7, j = F.bx >> 3, wpx = xa ? (G >> 3) : 1;
    const int npair = xa ? (32 - j + wpx - 1) / wpx : 0;
    const int nit = xa ? 4 * npair : (1024 - F.bx + G - 1) / G;
#pragma unroll 1
    for (int it = 0; it < nit; ++it) {
        int bh, qb;
        if (xa) { const int r = it / (2 * npair), rem = it % (2 * npair), sidx = j + (rem >> 1) * wpx; bh = 2 * x + r; qb = (rem & 1) ? sidx : 63 - sidx; }
        else { const int v = F.bx + it * G; bh = v >> 6; qb = v & 63; }
        att::attn_unit<MODE>(bh, qb, Q, K, V, MIX, subg, lam, mshift, oml, F.lds + LDS_RING, F.tid);
    }
}

__device__ __forceinline__ void router_phase(Frame& F, int l) {
    const bf16_t* h1 = (const bf16_t*)(F.ws + WS_H1); const float* g = arg_in(21) + (size_t)l * D; const float* br = arg_in(23) + l * NE;
    const bf16_t* WRT = (const bf16_t*)(F.ws + WS_WRT + l * WRT_STRIDE);
    bf16_t* XN = (bf16_t*)(F.ws + WS_XN); int* TOPI = (int*)(F.ws + WS_TOPI); float* TOPG = (float*)(F.ws + WS_TOPG); int* WGCNT = (int*)(F.ws + WS_WGCNT); float* RS = (float*)(F.ws + WS_RS);
    const int lane = F.lane, tid = F.tid, wave = F.wave, n = lane & 15, kq = lane >> 4;
    constexpr int PITCH = 2080;
    LAS unsigned char* wl = F.lds + LDS_RING;
    LAS float* lg = (LAS float*)(F.lds + LDS_RING + 2 * 32 * PITCH) + wave * (16 * 33 + 16);
    LAS int* cnt = (LAS int*)(F.ctl + 256);
    __syncthreads();
    for (int i = tid; i < 2 * NE * 128; i += NTHREADS) { const int row = i >> 7, c = i & 127; *(LAS u32x4*)(wl + row * PITCH + c * 16) = *(const u32x4*)(WRT + (size_t)row * D + c * 8); }
    if (tid < 32) cnt[tid] = 0;
    __syncthreads();
    for (int wgu = F.bx; wgu < T / 128; wgu += F.G) {
        if (wgu != F.bx) { __syncthreads(); if (tid < 32) cnt[tid] = 0; __syncthreads(); }
        const int row = wgu * 128 + wave * 16 + n;
        const bf16_t* hp = h1 + (size_t)row * D + 8 * kq; const float* gp = g + 8 * kq;
        bf16_t* xp = XN + (size_t)row * D + 8 * kq; unsigned char* xp8 = (unsigned char*)XN + (size_t)row * D + 8 * kq;
        const LAS unsigned char* bh = wl + n * PITCH + 16 * kq;
        f32x4 acc0 = (f32x4){0.f, 0.f, 0.f, 0.f}, acc1 = acc0; float ss = 0.f;
#pragma unroll 4
        for (int ks = 0; ks < 32; ++ks) {
            const u32x4 hw = *(const u32x4*)(hp + 32 * ks); const f32x4 h0 = (f32x4){bf_lo(hw.x), bf_hi(hw.x), bf_lo(hw.y), bf_hi(hw.y)}, h4 = (f32x4){bf_lo(hw.z), bf_hi(hw.z), bf_lo(hw.w), bf_hi(hw.w)};
            const f32x4 g0 = *(const f32x4*)(gp + 32 * ks), g4 = *(const f32x4*)(gp + 32 * ks + 4);
            const f32x4 x0 = h0 * g0, x4 = h4 * g4;
            ss += (x0[0] * x0[0] + x0[1] * x0[1]) + (x0[2] * x0[2] + x0[3] * x0[3]) + (x4[0] * x4[0] + x4[1] * x4[1]) + (x4[2] * x4[2] + x4[3] * x4[3]);
            u32x4 hi; hi.x = cvt_pk_bf16(x0[0], x0[1]); hi.y = cvt_pk_bf16(x0[2], x0[3]); hi.z = cvt_pk_bf16(x4[0], x4[1]); hi.w = cvt_pk_bf16(x4[2], x4[3]);
            if (UP_FP8) { u32x2 w8; w8.x = pk4_fp8(x0[0] * 8.f, x0[1] * 8.f, x0[2] * 8.f, x0[3] * 8.f); w8.y = pk4_fp8(x4[0] * 8.f, x4[1] * 8.f, x4[2] * 8.f, x4[3] * 8.f); *(u32x2*)(xp8 + 32 * ks) = w8; }
            else *(u32x4*)(xp + 32 * ks) = hi;
            u32x4 lo;
            lo.x = cvt_pk_bf16(x0[0] - bf_lo(hi.x), x0[1] - bf_hi(hi.x)); lo.y = cvt_pk_bf16(x0[2] - bf_lo(hi.y), x0[3] - bf_hi(hi.y));
            lo.z = cvt_pk_bf16(x4[0] - bf_lo(hi.z), x4[1] - bf_hi(hi.z)); lo.w = cvt_pk_bf16(x4[2] - bf_lo(hi.w), x4[3] - bf_hi(hi.w));
            const bf16x8 ah = __builtin_bit_cast(bf16x8, hi), al = __builtin_bit_cast(bf16x8, lo);
            const bf16x8 b0h = *(const LAS bf16x8*)(bh + 64 * ks), b1h = *(const LAS bf16x8*)(bh + 16 * PITCH + 64 * ks);
            const bf16x8 b0l = *(const LAS bf16x8*)(bh + 32 * PITCH + 64 * ks), b1l = *(const LAS bf16x8*)(bh + 48 * PITCH + 64 * ks);
            acc0 = __builtin_amdgcn_mfma_f32_16x16x32_bf16(ah, b0h, acc0, 0, 0, 0); acc1 = __builtin_amdgcn_mfma_f32_16x16x32_bf16(ah, b1h, acc1, 0, 0, 0);
            acc0 = __builtin_amdgcn_mfma_f32_16x16x32_bf16(al, b0h, acc0, 0, 0, 0); acc1 = __builtin_amdgcn_mfma_f32_16x16x32_bf16(al, b1h, acc1, 0, 0, 0);
            acc0 = __builtin_amdgcn_mfma_f32_16x16x32_bf16(ah, b0l, acc0, 0, 0, 0); acc1 = __builtin_amdgcn_mfma_f32_16x16x32_bf16(ah, b1l, acc1, 0, 0, 0);
        }
        ss += __shfl_xor(ss, 16); ss += __shfl_xor(ss, 32);
        const float r = rsqrtf(ss * (1.f / D) + EPS);
        if (kq == 0) { lg[16 * 33 + n] = r; RS[row] = r; }
        asm volatile("s_waitcnt lgkmcnt(0)" ::: "memory");
        const float b0 = br[n], b1 = br[16 + n];
#pragma unroll
        for (int q = 0; q < 4; ++q) { const float rt = lg[16 * 33 + 4 * kq + q]; lg[(4 * kq + q) * 33 + n] = acc0[q] * rt + b0; lg[(4 * kq + q) * 33 + 16 + n] = acc1[q] * rt + b1; }
        asm volatile("s_waitcnt lgkmcnt(0)" ::: "memory");
        if (lane < 16) {
            const int tok = wgu * 128 + wave * 16 + lane;
            float v[32];
#pragma unroll
            for (int e = 0; e < 32; ++e) v[e] = lg[lane * 33 + e];
            unsigned mask = 0u; float val[4]; int sel[4];
#pragma unroll
            for (int k = 0; k < 4; ++k) { float best = -INFINITY; int bi = 0;
#pragma unroll
                for (int e = 0; e < 32; ++e) { const bool ok = !((mask >> e) & 1u) && (v[e] > best); best = ok ? v[e] : best; bi = ok ? e : bi; }
                mask |= 1u << bi; val[k] = best; sel[k] = bi; }
            float ex[4], sum = 0.f;
#pragma unroll
            for (int k = 0; k < 4; ++k) { ex[k] = __expf(val[k] - val[0]); sum += ex[k]; }
            const float inv = 1.f / sum;
#pragma unroll
            for (int k = 0; k < 4; ++k) { const int pos = __hip_atomic_fetch_add(cnt + sel[k], 1, __ATOMIC_RELAXED, __HIP_MEMORY_SCOPE_WORKGROUP);
                TOPI[tok * 4 + k] = sel[k] | (pos << 8); TOPG[tok * 4 + k] = ex[k] * inv; }
        }
        __syncthreads();
        if (tid < 32) WGCNT[wgu * 32 + tid] = cnt[tid];
    }
    __syncthreads();
}
__device__ __forceinline__ void routing_phase(Frame& F) {
    const int* TOPI = (const int*)(F.ws + WS_TOPI); const float* TOPG = (const float*)(F.ws + WS_TOPG); const int* WGCNT = (const int*)(F.ws + WS_WGCNT);
    int* TOKROW = (int*)(F.ws + WS_TOKROW); int* ROWTOK = (int*)(F.ws + WS_ROWTOK); float* ROWGATE = (float*)(F.ws + WS_ROWGATE); int* TILEEXP = (int*)(F.ws + WS_TILEEXP);
    float* ROWSCALE = (float*)(F.ws + WS_ROWSCALE); const float* RS = (const float*)(F.ws + WS_RS);
    const int tid = F.tid;
    LAS int* tot = (LAS int*)(F.lds + LDS_RING);
    LAS int* pst = tot + 32;
    LAS int* mypre = pst + 40;
    LAS int* part = mypre + 32;
    for (int wgu = F.bx; wgu < 256; wgu += F.G) {
        __syncthreads();
        {
            const int e = tid & 31, wq = tid >> 5; int a = 0, mine = 0;
#pragma unroll
            for (int j = 0; j < 16; ++j) { const int w = wq * 16 + j; const int c = WGCNT[w * 32 + e]; a += c; if (w < wgu) mine += c; }
            part[wq * 32 + e] = a; part[512 + wq * 32 + e] = mine;
        }
        __syncthreads();
        if (tid < 32) { int a = 0, mine = 0;
#pragma unroll
            for (int q = 0; q < 16; ++q) { a += part[q * 32 + tid]; mine += part[512 + q * 32 + tid]; }
            tot[tid] = a; mypre[tid] = mine; }
        __syncthreads();
        if (tid == 0) { int a = 0; for (int e = 0; e < 32; ++e) { pst[e] = a; a += (tot[e] + 255) & ~255; } pst[32] = a; }
        __syncthreads();
        {
            const int t = wgu * 128 + (tid >> 2), k = tid & 3;
            const int w = TOPI[t * 4 + k]; const int e = w & 255, pos = w >> 8;
            const int dest = pst[e] + mypre[e] + pos;
            ROWTOK[dest] = t; ROWGATE[dest] = TOPG[t * 4 + k]; ROWSCALE[dest] = RS[t]; TOKROW[t * 4 + k] = dest;
        }
        if (wgu < 32) {
            const int e = wgu; const int beg = pst[e] + tot[e], end = pst[e + 1];
            for (int r = beg + tid; r < end; r += NTHREADS) { ROWTOK[r] = 0; ROWGATE[r] = 0.f; ROWSCALE[r] = 0.f; }
        }
        if (wgu == 0) {
            const int ntiles = pst[32] >> 8;
            for (int pm = tid; pm < ntiles; pm += NTHREADS) { int e = 0; for (int q = 1; q < 32; ++q) if ((pm << 8) >= pst[q]) e = q; TILEEXP[pm] = e; }
            if (tid == 0) TILEEXP[1023] = ntiles;
            if (tid < 33) TILEEXP[768 + tid] = pst[tid];
        }
    }
    __syncthreads();
}
struct CRow { u32x4 h[2]; u32x2 y[4][2]; };
__device__ __forceinline__ void crow_load(CRow& r, const bf16_t* H1, const unsigned char* YB, const int* TOKROW, int m, int lane) {
    const bf16_t* hr = H1 + (size_t)m * D + 8 * lane;
    r.h[0] = *(const u32x4*)(hr); r.h[1] = *(const u32x4*)(hr + 512);
    const int4 tr = *(const int4*)(TOKROW + m * 4);
    const int rows[4] = {tr.x, tr.y, tr.z, tr.w};
#pragma unroll
    for (int k = 0; k < 4; ++k) { const unsigned char* yr = YB + (size_t)rows[k] * D + 8 * lane; r.y[k][0] = *(const u32x2*)(yr); r.y[k][1] = *(const u32x2*)(yr + 512); }
}
__device__ __forceinline__ void crow_finish(CRow& r, float* out32, bf16_t* H2, bf16_t* XN, const float* gnext, int m, int lane) {
    f32x4 v[4];
#pragma unroll
    for (int hf = 0; hf < 2; ++hf) { const u32x4 w = r.h[hf]; v[2 * hf] = (f32x4){bf_lo(w.x), bf_hi(w.x), bf_lo(w.y), bf_hi(w.y)}; v[2 * hf + 1] = (f32x4){bf_lo(w.z), bf_hi(w.z), bf_lo(w.w), bf_hi(w.w)}; }
#pragma unroll
    for (int k = 0; k < 4; ++k)
#pragma unroll
        for (int hf = 0; hf < 2; ++hf) { fp8x4_add(r.y[k][hf].x, 1.f / 16.f, v[2 * hf]); fp8x4_add(r.y[k][hf].y, 1.f / 16.f, v[2 * hf + 1]); }
    if (out32) { float* orow = out32 + (size_t)m * D + 8 * lane; *(f32x4*)(orow) = v[0]; *(f32x4*)(orow + 4) = v[1]; *(f32x4*)(orow + 512) = v[2]; *(f32x4*)(orow + 516) = v[3]; }
    else {
        u32x4 w; w.x = cvt_pk_bf16(v[0][0], v[0][1]); w.y = cvt_pk_bf16(v[0][2], v[0][3]); w.z = cvt_pk_bf16(v[1][0], v[1][1]); w.w = cvt_pk_bf16(v[1][2], v[1][3]);
        *(u32x4*)(H2 + (size_t)m * D + 8 * lane) = w;
        w.x = cvt_pk_bf16(v[2][0], v[2][1]); w.y = cvt_pk_bf16(v[2][2], v[2][3]); w.z = cvt_pk_bf16(v[3][0], v[3][1]); w.w = cvt_pk_bf16(v[3][2], v[3][3]);
        *(u32x4*)(H2 + (size_t)m * D + 512 + 8 * lane) = w;
    }
    if (gnext) {
        float s = 0.f;
#pragma unroll
        for (int j = 0; j < 4; ++j) s += (v[j][0] * v[j][0] + v[j][1] * v[j][1]) + (v[j][2] * v[j][2] + v[j][3] * v[j][3]);
        const float rr = rsqrtf(wave_sum(s) * (1.f / D) + EPS);
        const float* gp = gnext + 8 * lane;
        const f32x4 a0 = v[0] * *(const f32x4*)(gp) * rr, a1 = v[1] * *(const f32x4*)(gp + 4) * rr, a2 = v[2] * *(const f32x4*)(gp + 512) * rr, a3 = v[3] * *(const f32x4*)(gp + 516) * rr;
        u32x4 w; w.x = cvt_pk_bf16(a0[0], a0[1]); w.y = cvt_pk_bf16(a0[2], a0[3]); w.z = cvt_pk_bf16(a1[0], a1[1]); w.w = cvt_pk_bf16(a1[2], a1[3]);
        *(u32x4*)(XN + (size_t)m * D + 8 * lane) = w;
        w.x = cvt_pk_bf16(a2[0], a2[1]); w.y = cvt_pk_bf16(a2[2], a2[3]); w.z = cvt_pk_bf16(a3[0], a3[1]); w.w = cvt_pk_bf16(a3[2], a3[3]);
        *(u32x4*)(XN + (size_t)m * D + 512 + 8 * lane) = w;
    }
}
__device__ __forceinline__ void combine_phase(Frame& F, const float* gnext, float* out32) {
    const unsigned char* YB = (const unsigned char*)(F.ws + WS_YB); const int* TOKROW = (const int*)(F.ws + WS_TOKROW); bf16_t* XN = (bf16_t*)(F.ws + WS_XN);
    const bf16_t* H1 = (const bf16_t*)(F.ws + WS_H1); bf16_t* H2 = (bf16_t*)(F.ws + WS_H2);
    const int lane = F.lane, NGW = F.G * NWAVES;
    CRow ra, rb;
    int m = F.bx * NWAVES + F.wave;
    if (m < T) crow_load(ra, H1, YB, TOKROW, m, lane);
    while (m < T) {
        const int mb = m + NGW;
        if (mb < T) crow_load(rb, H1, YB, TOKROW, mb, lane);
        crow_finish(ra, out32, H2, XN, gnext, m, lane);
        if (mb >= T) break;
        const int mc = mb + NGW;
        if (mc < T) crow_load(ra, H1, YB, TOKROW, mc, lane);
        crow_finish(rb, out32, H2, XN, gnext, mb, lane);
        m = mc;
    }
}

constexpr int NPH_LAYER = 10, NPH = 1 + DEPTH * NPH_LAYER;
__global__ void __launch_bounds__(NTHREADS, 2) mk_fwd(Args args) {
    extern __shared__ __attribute__((aligned(16))) unsigned char lds_raw[];
    Frame F;
    F.lds = (LAS unsigned char*)lds_raw; F.ctl = F.lds + LDS_CTL; F.ws = args.ws; F.ws0 = args.ws; F.out0 = args.out; F.ap = &args; F.z = 0;
    F.tid = threadIdx.x; F.lane = F.tid & 63; F.wave = __builtin_amdgcn_readfirstlane(F.tid >> 6); F.G = gridDim.x; F.bx = blockIdx.x;
    F.out = args.out;
    for (int u = F.tid; u < 1024; u += NTHREADS) ((LAS unsigned*)F.ctl)[u] = 0u;
    __syncthreads();
    XcdBarrier bar = xcd_barrier_post((unsigned*)(F.ws + WS_CTL) + CW_BAR, (volatile LAS unsigned*)F.ctl);
    const int lo = args.ph_lo, hi = args.ph_hi;
#ifndef PHMASK
#define PHMASK 0x1fff
#endif
#define RUN(k) (lo <= (k) && (k) < hi)
#define EN(b) ((PHMASK >> (b)) & 1)
#ifndef DUPMASK
#define DUPMASK 0
#endif
#ifndef ATT_PROBE_MODE
#define ATT_PROBE_MODE 0
#endif
#ifndef PRO_PROBE_MODE
#define PRO_PROBE_MODE 0
#endif
#define NREP(b) (((DUPMASK >> (b)) & 1) ? 2 : 1)
#define SEAM(k) do { if (RUN((k) + 1)) xcd_barrier(bar); } while (0)
    if (EN(10) && RUN(0)) { { if (NREP(10) == 2) { phase_begin(F); p0_prologue<PRO_PROBE_MODE>(F); xcd_barrier(bar); } phase_begin(F); p0_prologue<0>(F); } SEAM(0); }
    for (int l = 0; l < DEPTH; ++l) {
        const int pb = 1 + l * NPH_LAYER;
        if (EN(0) && RUN(pb + 0)) { for (int rep = 0; rep < NREP(0); ++rep) { phase_begin(F); unsigned char* ws = F.ws; (void)ws;
            PInProj P; P.so.init(T, DIN, F.G, F.bx); P.A = (const char*)(ws + WS_XN); P.B = (const char*)(ws + WS_WIN + l * WIN_STRIDE);
            P.UQKV = (bf16_t*)(ws + WS_U); P.GQK = (const float*)(ws + WS_SCAL) + 64 + l * 128; P.COS = (const float*)(ws + WS_COS); P.SIN = (const float*)(ws + WS_SIN);
            pg8::gemm_phase(F.lds + LDS_RING, F.ctl, P, F.tid);  if (rep + 1 < NREP(0)) xcd_barrier(bar); } SEAM(pb + 0);
        }
        if (EN(1) && RUN(pb + 1)) { for (int rep = 0; rep < NREP(1); ++rep) { phase_begin(F); unsigned char* ws = F.ws; (void)ws; s5a_phase(F, l);  if (rep + 1 < NREP(1)) xcd_barrier(bar); } SEAM(pb + 1); }
        if (EN(2) && RUN(pb + 2)) { for (int rep = 0; rep < NREP(2); ++rep) { phase_begin(F); unsigned char* ws = F.ws; (void)ws; if (EN(11)) for (int r2 = 0; r2 < NREP(11); ++r2) { phase_begin(F); s5c_phase(F, l); } if (EN(12)) { if (NREP(12) == 2) { phase_begin(F); attn_phase<ATT_PROBE_MODE>(F, l); } phase_begin(F); attn_phase<0>(F, l); }  if (rep + 1 < NREP(2)) xcd_barrier(bar); } SEAM(pb + 2); }
        if (EN(3) && RUN(pb + 3)) { for (int rep = 0; rep < NREP(3); ++rep) { phase_begin(F); unsigned char* ws = F.ws; (void)ws;
            PGlu P; P.so.init(T, DS, F.G, F.bx); P.A = (const char*)(ws + WS_YG); P.B = (const char*)(ws + WS_WGLU + l * WGLU_STRIDE);
            P.YG = (const bf16_t*)(ws + WS_YG); P.MIX = (bf16_t*)(ws + WS_MIX); P.RSP = (float*)(ws + WS_RSP);
            pg8::gemm_phase(F.lds + LDS_RING, F.ctl, P, F.tid);  if (rep + 1 < NREP(3)) xcd_barrier(bar); } SEAM(pb + 3);
        }
        if (EN(4) && RUN(pb + 4)) { for (int rep = 0; rep < NREP(4); ++rep) { phase_begin(F); unsigned char* ws = F.ws; (void)ws;
            POut P; P.so.init(T, D, F.G, F.bx); P.A = (const char*)(ws + WS_MIX); P.B = (const char*)(ws + WS_WOUT + l * WOUT_STRIDE);
            P.RSP = (const float*)(ws + WS_RSP); P.base32 = (l == 0) ? arg_in(0) : nullptr; P.base16 = (const bf16_t*)(ws + WS_H2); P.H1 = (bf16_t*)(ws + WS_H1);
            pg8::gemm_phase(F.lds + LDS_RING, F.ctl, P, F.tid);  if (rep + 1 < NREP(4)) xcd_barrier(bar); } SEAM(pb + 4);
        }
        if (EN(5) && RUN(pb + 5)) { for (int rep = 0; rep < NREP(5); ++rep) { phase_begin(F); unsigned char* ws = F.ws; (void)ws; router_phase(F, l);  if (rep + 1 < NREP(5)) xcd_barrier(bar); } SEAM(pb + 5); }
        if (EN(6) && RUN(pb + 6)) { for (int rep = 0; rep < NREP(6); ++rep) { phase_begin(F); unsigned char* ws = F.ws; (void)ws; routing_phase(F);  if (rep + 1 < NREP(6)) xcd_barrier(bar); } SEAM(pb + 6); }
        if (EN(7) && RUN(pb + 7)) { for (int rep = 0; rep < NREP(7); ++rep) { phase_begin(F); unsigned char* ws = F.ws; (void)ws;
            PUp P; P.mo.init(F.G, F.bx, (const int*)(ws + WS_TILEEXP) + 768);
            P.A = (const char*)(ws + WS_XN); P.B = (const char*)(ws + WS_WUP + l * WUP_STRIDE); P.ROWTOK = (const int*)(ws + WS_ROWTOK); P.TILEEXP = (const int*)(ws + WS_TILEEXP);
            P.bup = arg_in(25) + (size_t)l * NE * 2048; P.ROWSCALE = (const float*)(ws + WS_ROWSCALE); P.ACT = (bf16_t*)(ws + WS_ACT);
            pg8::gemm_phase(F.lds + LDS_RING, F.ctl, P, F.tid);  if (rep + 1 < NREP(7)) xcd_barrier(bar); } SEAM(pb + 7);
        }
        if (EN(8) && RUN(pb + 8)) { for (int rep = 0; rep < NREP(8); ++rep) { phase_begin(F); unsigned char* ws = F.ws; (void)ws;
            PDown P; P.mo.init(F.G, F.bx, (const int*)(ws + WS_TILEEXP) + 768);
            P.A = (const char*)(ws + WS_ACT); P.B = (const char*)(ws + WS_WDN + l * WDN_STRIDE); P.TILEEXP = (const int*)(ws + WS_TILEEXP);
            P.bdn = arg_in(27) + (size_t)l * NE * 1024; P.ROWGATE = (const float*)(ws + WS_ROWGATE); P.YB = (bf16_t*)(ws + WS_YB);
            pg8::gemm_phase(F.lds + LDS_RING, F.ctl, P, F.tid);  if (rep + 1 < NREP(8)) xcd_barrier(bar); } SEAM(pb + 8);
        }
        if (EN(9) && RUN(pb + 9)) { for (int rep = 0; rep < NREP(9); ++rep) { phase_begin(F); unsigned char* ws = F.ws; (void)ws; combine_phase(F, (l + 1 < DEPTH) ? arg_in(1) + (size_t)(l + 1) * D : nullptr, (l + 1 < DEPTH) ? nullptr : F.out);  if (rep + 1 < NREP(9)) xcd_barrier(bar); } SEAM(pb + 9); }
    }
#undef RUN
#undef SEAM
}

extern "C" void kernel_launch(void* const* d_in, const int* in_sizes, int n_in, void* d_out, int out_size, void* d_ws, size_t ws_size, hipStream_t stream) {
    static int grid = 0;
    if (grid == 0) {
        if (n_in != 28 || out_size != T * D || ws_size < WS_END) { fprintf(stderr, "kernel_launch: unexpected shapes (n_in %d out %d ws %zu)\n", n_in, out_size, ws_size); grid = -1; return; }
        int dev = 0, cus = 0;
        if (hipGetDevice(&dev) != hipSuccess || hipDeviceGetAttribute(&cus, hipDeviceAttributeMultiprocessorCount, dev) != hipSuccess) { grid = -1; return; }
        if (hipFuncSetAttribute((const void*)mk_fwd, hipFuncAttributeMaxDynamicSharedMemorySize, LDS_BYTES) != hipSuccess) { fprintf(stderr, "kernel_launch: hipFuncSetAttribute failed\n"); grid = -1; return; }
        int per_cu = 0;
        if (hipOccupancyMaxActiveBlocksPerMultiprocessor(&per_cu, (const void*)mk_fwd, NTHREADS, LDS_BYTES) != hipSuccess || per_cu < 1) { fprintf(stderr, "kernel_launch: occupancy query says %d\n", per_cu); }
        (void)hipGetLastError();
        grid = cus;
    }
    if (grid < 0) return;
    if (hipMemsetAsync((char*)d_ws + WS_CTL, 0, CTL_ZERO_BYTES, stream) != hipSuccess) return;
    Args a{};
    for (int i = 0; i < 28; ++i) a.in[i] = (const float*)d_in[i];
    a.out = (float*)d_out; a.ws = (unsigned char*)d_ws; a.ph_lo = 0; a.ph_hi = NPH;
    hipLaunchKernelGGL(mk_fwd, dim3(grid), dim3(NTHREADS), LDS_BYTES, stream, a);
}
```

```cpp
#include <hip/hip_runtime.h>
#include <cstdio>
#include <cstdint>
#include <math.h>

#ifndef UP_FP8
#define UP_FP8 1
#endif
#ifndef DN_FP8
#define DN_FP8 1
#endif
#define LAS __attribute__((address_space(3)))
#define GAS __attribute__((address_space(1)))
typedef unsigned short bf16_t;
typedef short bf16x8 __attribute__((ext_vector_type(8)));
typedef short s16x4 __attribute__((ext_vector_type(4)));
typedef float f32x4 __attribute__((ext_vector_type(4)));
typedef float f32x2 __attribute__((ext_vector_type(2)));
typedef float f32x16 __attribute__((ext_vector_type(16)));
typedef unsigned u32x4 __attribute__((ext_vector_type(4)));
typedef unsigned u32x2 __attribute__((ext_vector_type(2)));
typedef int v8i32 __attribute__((ext_vector_type(8)));

constexpr int D = 1024, BATCH = 4, SEQ = 8192, DEPTH = 2, T = BATCH * SEQ;
constexpr int DS = 512, NG = 32, HS = 16, NP = 64, DA = 512, NH = 4, DV = 128, DIN = 2048;
constexpr int NE = 32, DFF = 1024, NASSIGN = T * 4;
constexpr int MPAD_MAX = NASSIGN + NE * 256, NTILE_MAX = MPAD_MAX / 256;
constexpr int NCHUNK = T / 64, CPB = SEQ / 64;
constexpr float EPS = 1e-6f;
constexpr float C2 = 0.125f * 1.4426950408889634f;
constexpr int NWAVES = 8, NTHREADS = 512;

constexpr size_t MiB = 1u << 20;
constexpr size_t WS_CTL = 0, CTL_ZERO_BYTES = 1 * MiB;
constexpr size_t WS_COS = 1 * MiB, WS_SIN = 2 * MiB;
constexpr size_t WS_SCAL = 3 * MiB;
constexpr size_t WS_KT = 4 * MiB, KT_STRIDE = 2 * MiB;
constexpr size_t WS_LAML = 8 * MiB, LAML_STRIDE = 32768;
constexpr size_t WS_WRT = 9 * MiB, WRT_STRIDE = 131072;
constexpr size_t WS_RS = 10 * MiB;
constexpr size_t WS_GT = 16 * MiB, GT_STRIDE = 8 * MiB;
constexpr size_t WS_HT = 32 * MiB, HT_STRIDE = 8 * MiB;
constexpr size_t WS_WIN = 48 * MiB, WIN_STRIDE = 4 * MiB;
constexpr size_t WS_WGLU = 56 * MiB, WGLU_STRIDE = MiB / 2;
constexpr size_t WS_WOUT = 58 * MiB, WOUT_STRIDE = 2 * MiB;
constexpr size_t WS_WUP = 64 * MiB, WUP_STRIDE = 128 * MiB;
constexpr size_t WS_WDN = 320 * MiB, WDN_STRIDE = 64 * MiB;
constexpr size_t WS_XN = 448 * MiB;
constexpr size_t WS_U = 512 * MiB, WS_Q = 544 * MiB, WS_K = 576 * MiB, WS_V = 608 * MiB;
constexpr size_t WS_YG = 640 * MiB;
constexpr size_t WS_MIX = 672 * MiB;
constexpr size_t WS_S = 736 * MiB;
constexpr size_t WS_RSP = 744 * MiB;
constexpr size_t WS_TOPI = 746 * MiB, WS_TOPG = 747 * MiB, WS_TOKROW = 748 * MiB, WS_WGCNT = 749 * MiB;
constexpr size_t WS_ROWTOK = 750 * MiB, WS_ROWGATE = 751 * MiB, WS_TILEEXP = 752 * MiB, WS_ROWSCALE = 753 * MiB;
constexpr size_t WS_ACT = 768 * MiB, WS_YB = 1040 * MiB, WS_H1 = 1180 * MiB, WS_H2 = 1244 * MiB, WS_END = 1312 * MiB;
constexpr int CW_BAR = 4096;

constexpr int LDS_CTL = 0;
constexpr int LDS_RING = 4096;
constexpr int LDS_BYTES = 163840;

__device__ __forceinline__ unsigned f2bf(float f) { unsigned u = __builtin_bit_cast(unsigned, f); return (u + 0x7fffu + ((u >> 16) & 1u)) >> 16; }
__device__ __forceinline__ unsigned pk2(float lo, float hi) { return f2bf(lo) | (f2bf(hi) << 16); }
__device__ __forceinline__ unsigned cvt_pk_bf16(float lo, float hi) { unsigned r; asm volatile("v_cvt_pk_bf16_f32 %0, %1, %2" : "=v"(r) : "v"(lo), "v"(hi)); return r; }
__device__ __forceinline__ unsigned pk4_fp8(float a, float b, float c, float d) { int w = 0; w = __builtin_amdgcn_cvt_pk_fp8_f32(a, b, w, false); w = __builtin_amdgcn_cvt_pk_fp8_f32(c, d, w, true); return (unsigned)w; }
__device__ __forceinline__ void fp8x4_add(unsigned w, float sc, f32x4& a) { const f32x2 lo = __builtin_amdgcn_cvt_pk_f32_fp8((int)w, false), hi = __builtin_amdgcn_cvt_pk_f32_fp8((int)w, true); a[0] += lo[0] * sc; a[1] += lo[1] * sc; a[2] += hi[0] * sc; a[3] += hi[1] * sc; }
__device__ __forceinline__ float bf_lo(unsigned w) { return __builtin_bit_cast(float, w << 16); }
__device__ __forceinline__ float bf_hi(unsigned w) { return __builtin_bit_cast(float, w & 0xffff0000u); }
__device__ __forceinline__ float wave_sum(float v) {
#pragma unroll
    for (int o = 1; o < 64; o <<= 1) v += __shfl_xor(v, o);
    return v;
}
__device__ __forceinline__ float gelu_tanh(float x) {
    const float z = 0.7978845608028654f * (x + 0.044715f * x * x * x);
    return x / (1.f + __expf(-2.f * z));
}
__device__ __forceinline__ float sigmoidf(float v) { return 1.f / (1.f + __expf(-v)); }

#define XB_TMO      128
#define XB_XCNT(j)  (256  + 64 * (j))
#define XB_XSUB(j)  (1280 + 64 * (j))
#define XB_XGEN(j)  (2304 + 64 * (j))
#define XB_TOP      3328
#define XB_TOPGEN   3392
#define XCD_BAR_WORDS 3456
#define XB_SPIN_CAP (1u << 18)
__device__ __forceinline__ unsigned xb_ld(unsigned* p)              { return __hip_atomic_load(p, __ATOMIC_RELAXED, __HIP_MEMORY_SCOPE_AGENT); }
__device__ __forceinline__ unsigned xb_add(unsigned* p, unsigned v) { return __hip_atomic_fetch_add(p, v, __ATOMIC_RELAXED, __HIP_MEMORY_SCOPE_AGENT); }
__device__ __forceinline__ unsigned xb_xcc_id() { return (unsigned)__builtin_amdgcn_s_getreg((3 << 11) | 20) & 0xFu; }
#define XB_SPIN(cond, bar) do { unsigned _sp = 0; while (cond) { __builtin_amdgcn_s_sleep(1); \
    if ((++_sp & 255u) == 0u) { if (xb_ld(&(bar)[XB_TMO])) break; if (_sp > XB_SPIN_CAP) { atomicAdd(&(bar)[XB_TMO], 1u); break; } } } } while (0)
struct XcdBarrier { unsigned* bar; unsigned x; volatile LAS unsigned* st; };
__device__ __forceinline__ XcdBarrier xcd_barrier_post(unsigned* bar, volatile LAS unsigned* st) {
    XcdBarrier b; b.bar = bar; b.x = xb_xcc_id(); b.st = st;
    if (threadIdx.x == 0) (void)xb_add(&bar[XB_XCNT(b.x)], 1u);
    return b;
}
__device__ __forceinline__ void xcd_barrier_complete(unsigned* bar, unsigned x, unsigned& nloc, unsigned& nx) {
    const unsigned G = gridDim.x * gridDim.y * gridDim.z;
    unsigned sum, cnt, mine, sp = 0u;
    for (;;) {
        sum = 0u; cnt = 0u; mine = 0u;
#pragma unroll
        for (unsigned j = 0; j < 16; ++j) { const unsigned c = xb_ld(&bar[XB_XCNT(j)]); sum += c; cnt += (c > 0u) ? 1u : 0u; mine = (j == x) ? c : mine; }
        if (sum == G) break;
        __builtin_amdgcn_s_sleep(1);
        if ((++sp & 255u) == 0u) { if (xb_ld(&bar[XB_TMO])) break; if (sp > XB_SPIN_CAP) { atomicAdd(&bar[XB_TMO], 1u); break; } }
    }
    nloc = mine > 0u ? mine : 1u; nx = cnt > 0u ? cnt : 1u;
}
__device__ __forceinline__ void xcd_barrier(const XcdBarrier& b) {
    asm volatile("s_waitcnt vmcnt(0)" ::: "memory");
    __syncthreads();
    if (threadIdx.x == 0) {
        unsigned* bar = b.bar;
        __builtin_amdgcn_s_waitcnt(0);
        unsigned nloc = b.st[0], nx = b.st[1];
        if (nloc == 0u) { xcd_barrier_complete(bar, b.x, nloc, nx); b.st[0] = nloc; b.st[1] = nx; }
        const unsigned old = xb_add(&bar[XB_XSUB(b.x)], 1u);
        const unsigned gen = old / nloc;
        if (old + 1u == (gen + 1u) * nloc) {
            __builtin_amdgcn_fence(__ATOMIC_RELEASE, "agent");
            asm volatile("s_waitcnt vmcnt(0)" ::: "memory");
            const unsigned og = xb_add(&bar[XB_TOP], 1u);
            const unsigned tg = og / nx;
            if (og + 1u == (tg + 1u) * nx) xb_add(&bar[XB_TOPGEN], 1u);
            else XB_SPIN(xb_ld(&bar[XB_TOPGEN]) == tg, bar);
            __builtin_amdgcn_fence(__ATOMIC_ACQUIRE, "agent");
            xb_add(&bar[XB_XGEN(b.x)], 1u);
            asm volatile("s_waitcnt vmcnt(0)" ::: "memory");
        } else {
            XB_SPIN(xb_ld(&bar[XB_XGEN(b.x)]) == gen, bar);
            __builtin_amdgcn_fence(__ATOMIC_ACQUIRE, "agent");
            asm volatile("s_waitcnt vmcnt(0)" ::: "memory");
        }
    }
    __syncthreads();
}

namespace pg8 {
constexpr int BM = 256, BK = 64, HALF = 128, HTB = HALF * BK * 2, STAGE_BYTES = 8 * HTB;
__host__ __device__ __forceinline__ int lds_byte(int r, int c) { const int st = (r >> 4) * 2 + (c >> 5), rr = r & 15, cc = c & 31, ob = rr * 64 + cc * 2; return st * 1024 + (ob ^ (((ob >> 9) & 1) << 5)); }
__host__ __device__ __forceinline__ void stage_rc(int b, int& R, int& C) { const int st = b / 1024, sb = b % 1024, swz = sb ^ (((sb >> 9) & 1) << 5); R = (st >> 1) * 16 + swz / 64; C = (st & 1) * 32 + (swz % 64) / 2; }
__host__ __device__ __forceinline__ int perm32(int rho) { const int n = rho >> 4, i = rho & 15; return 8 * (i >> 2) + 4 * n + (i & 3); }

struct Unit { int pm, pn; };
template <class P>
__device__ __forceinline__ void gemm_phase(LAS unsigned char* lds, LAS unsigned char* ldsctl, P& S, const int tid) {
    const int wid = __builtin_amdgcn_readfirstlane(tid >> 6), lane = tid & 63, wr = wid >> 2, wc = wid & 3, fr = lane & 15, fq = lane >> 4;
    constexpr bool F8 = P::FP8;
    constexpr int K = P::K, ES = F8 ? 1 : 2, nt = K * ES / 128;
    int R0, C0, R1, C1; stage_rc(tid * 16, R0, C0); stage_rc(tid * 16 + 8192, R1, C1);
    unsigned voffB[2];
    {
        const int Rb0 = P::BROW64 ? (64 * (R0 >> 5) + perm32(R0 & 31)) : ((R0 & ~31) + perm32(R0 & 31));
        const int Rb1 = P::BROW64 ? (64 * (R1 >> 5) + perm32(R1 & 31)) : ((R1 & ~31) + perm32(R1 & 31));
        voffB[0] = (unsigned)(Rb0 * K * ES + 2 * C0); voffB[1] = (unsigned)(Rb1 * K * ES + 2 * C1);
    }
    const unsigned ldsw = (unsigned)wid * 1024u;
    const int scl8 = P::SCALE_AB;
    const int aoff = F8 ? lds_byte(wr * 64 + fr, fq * 16) : lds_byte(wr * 64 + fr, fq * 8), boff = F8 ? lds_byte(wc * 32 + fr, fq * 16) : lds_byte(wc * 32 + fr, fq * 8);
#define PG8_SA(b, h) (((b) * 2 + (h)) * HTB)
#define PG8_SB(b, h) ((4 + (b) * 2 + (h)) * HTB)
    const unsigned ldsbase = (unsigned)__builtin_amdgcn_readfirstlane((int)(unsigned)(uintptr_t)lds + (int)ldsw);
#define PG8_GLDS(sbase, voff, ldsdst) do { unsigned _keep; asm volatile("s_mov_b32 %0, m0\n\ts_mov_b32 m0, %3\n\ts_nop 0\n\tglobal_load_lds_dwordx4 %2, %1\n\ts_mov_b32 m0, %0" \
        : "=&s"(_keep) : "s"(sbase), "v"(voff), "s"(ldsdst) : "memory"); } while (0)
#define PG8_STAGE_A(bufoff, vo, h, kofs) do { _Pragma("unroll") for (int _i = 0; _i < 2; ++_i) \
        PG8_GLDS(Abase, (vo)[P::GATHER ? (h) : 0][_i] + ((kofs) + (P::GATHER ? 0u : (unsigned)(h) * HSTEPA)), ldsbase + (unsigned)((bufoff) + _i * 8192)); } while (0)
#define PG8_STAGE_B(bufoff, gbase) do { _Pragma("unroll") for (int _i = 0; _i < 2; ++_i) \
        PG8_GLDS((const char*)(gbase), voffB[_i], ldsbase + (unsigned)((bufoff) + _i * 8192)); } while (0)
#define PG8_LDA(dst, b, h) do { if constexpr (F8) { _Pragma("unroll") for (int m = 0; m < 4; ++m) { const u32x4 _l = *(const LAS u32x4*)(lds + PG8_SA(b, h) + aoff + m * 2048), _h = *(const LAS u32x4*)(lds + PG8_SA(b, h) + aoff + m * 2048 + 16); dst##8[m] = __builtin_bit_cast(v8i32, __builtin_shufflevector(_l, _h, 0, 1, 2, 3, 4, 5, 6, 7)); } } \
        else { _Pragma("unroll") for (int m = 0; m < 4; ++m) _Pragma("unroll") for (int k = 0; k < 2; ++k) dst[m][k] = *(const LAS bf16x8*)(lds + PG8_SA(b, h) + aoff + m * 2048 + k * 1024); } } while (0)
#define PG8_LDB(dst, b, h) do { if constexpr (F8) { _Pragma("unroll") for (int n = 0; n < 2; ++n) { const u32x4 _l = *(const LAS u32x4*)(lds + PG8_SB(b, h) + boff + n * 2048), _h = *(const LAS u32x4*)(lds + PG8_SB(b, h) + boff + n * 2048 + 16); dst##8[n] = __builtin_bit_cast(v8i32, __builtin_shufflevector(_l, _h, 0, 1, 2, 3, 4, 5, 6, 7)); } } \
        else { _Pragma("unroll") for (int n = 0; n < 2; ++n) _Pragma("unroll") for (int k = 0; k < 2; ++k) dst[n][k] = *(const LAS bf16x8*)(lds + PG8_SB(b, h) + boff + n * 2048 + k * 1024); } } while (0)
#define PG8_MMA(ai, bj, At, Bt) do { __builtin_amdgcn_s_setprio(1); \
        if constexpr (F8) { _Pragma("unroll") for (int m = 0; m < 4; ++m) _Pragma("unroll") for (int n = 0; n < 2; ++n) \
            asm volatile("v_mfma_scale_f32_16x16x128_f8f6f4 %0, %1, %2, %0, %3, %3 op_sel:[0,1,0] op_sel_hi:[0,0,0]" : "+v"(acc[ai][bj][m][n]) : "v"(Bt##8[n]), "v"(At##8[m]), "v"(scl8)); } \
        else { _Pragma("unroll") for (int m = 0; m < 4; ++m) _Pragma("unroll") for (int n = 0; n < 2; ++n) _Pragma("unroll") for (int k = 0; k < 2; ++k) \
            acc[ai][bj][m][n] = __builtin_amdgcn_mfma_f32_16x16x32_bf16(Bt[n][k], At[m][k], acc[ai][bj][m][n], 0, 0, 0); } \
        __builtin_amdgcn_s_setprio(0); } while (0)
#define PG8_WAIT_V(n) asm volatile("s_waitcnt vmcnt(" #n ")" ::: "memory")
#define PG8_WAIT_L(n) asm volatile("s_waitcnt lgkmcnt(" #n ")" ::: "memory")
#define PG8_BAR __builtin_amdgcn_s_barrier()
#define PG8_SCHED __builtin_amdgcn_sched_barrier(0)
    Unit cur, nxt; int ui = 0;
    if (!S.next(0, cur)) return;
    f32x4 acc[2][2][4][2];
#pragma unroll
    for (int a = 0; a < 2; ++a)
#pragma unroll
        for (int b = 0; b < 2; ++b)
#pragma unroll
            for (int m = 0; m < 4; ++m)
#pragma unroll
                for (int n = 0; n < 2; ++n) acc[a][b][m][n] = (f32x4){0.f, 0.f, 0.f, 0.f};
    bf16x8 At[4][2], B0[2][2], B1[2][2]; v8i32 At8[4], B08[2], B18[2];
    const char* const Abase = S.a_base();
    unsigned voffA[2][2], voffAn[2][2];
    const char *cB0, *cB1;
    S.unit_begin(cur, ldsctl, tid, 0);
    S.a_offs(cur, R0, C0, R1, C1, voffA, true);
    asm volatile("" ::: "memory");
    S.b_ptrs(cur, cB0, cB1);
    constexpr unsigned kstep = 128, HSTEPA = (unsigned)HALF * K * ES;
    PG8_STAGE_B(PG8_SB(0, 0), cB0); PG8_STAGE_B(PG8_SB(0, 1), cB1); PG8_STAGE_A(PG8_SA(0, 0), voffA, 0, 0u); PG8_STAGE_A(PG8_SA(0, 1), voffA, 1, 0u);
    if (wr == 1) PG8_BAR;
    PG8_WAIT_V(2); PG8_BAR;
    PG8_STAGE_B(PG8_SB(1, 0), cB0 + kstep); PG8_STAGE_A(PG8_SA(1, 0), voffA, 0, kstep); PG8_STAGE_B(PG8_SB(1, 1), cB1 + kstep);
    PG8_WAIT_V(6); PG8_BAR;
    for (;;) {
        const bool has_next = S.next(ui + 1, nxt);
        const char *nB0 = cB0, *nB1 = cB1;
        if constexpr (P::GATHER) {
#pragma unroll
            for (int h = 0; h < 2; ++h)
#pragma unroll
                for (int i = 0; i < 2; ++i) voffAn[h][i] = voffA[h][i];
        }
        if (has_next) { S.unit_begin(nxt, ldsctl, tid, (ui + 1) & 1); S.b_ptrs(nxt, nB0, nB1);
            if constexpr (P::GATHER) { int t2 = tid; asm volatile("" : "+v"(t2)); int r0, c0, r1, c1; stage_rc(t2 * 16, r0, c0); stage_rc(t2 * 16 + 8192, r1, c1); S.a_offs(nxt, r0, c0, r1, c1, voffAn, false); } }
#pragma unroll 1
        for (int t = 0; t < nt; t += 2) {
            const bool last = (t == nt - 2);
            S.midk(acc, cur, t, wr, fr, ldsctl, ui & 1);
            unsigned a2o[2][2];
            if constexpr (!P::GATHER) { if (last) { int t2 = tid; asm volatile("" : "+v"(t2)); int r0, c0, r1, c1; stage_rc(t2 * 16, r0, c0); stage_rc(t2 * 16 + 8192, r1, c1);
                                                   S.a_offs(has_next ? nxt : cur, r0, c0, r1, c1, voffAn, false); } }
#pragma unroll
            for (int h = 0; h < 2; ++h)
#pragma unroll
                for (int i = 0; i < 2; ++i) a2o[h][i] = last ? voffAn[h][i] : voffA[h][i] + (unsigned)(t + 2) * kstep;
            const char* b2h0 = last ? nB0 : cB0 + (size_t)(t + 2) * kstep; const char* b2h1 = last ? nB1 : cB1 + (size_t)(t + 2) * kstep;
            const unsigned a1k = (unsigned)(t + 1) * kstep;
            PG8_LDB(B0, 0, 0); PG8_LDB(B1, 0, 1); PG8_SCHED; PG8_LDA(At, 0, 0); PG8_STAGE_A(PG8_SA(1, 1), voffA, 1, a1k);
            PG8_WAIT_V(8); PG8_WAIT_L(0); PG8_BAR; PG8_MMA(0, 0, At, B0); PG8_MMA(0, 1, At, B1); PG8_BAR; PG8_SCHED;
            PG8_LDA(At, 0, 1); PG8_STAGE_B(PG8_SB(0, 0), b2h0); PG8_STAGE_B(PG8_SB(0, 1), b2h1); PG8_STAGE_A(PG8_SA(0, 0), a2o, 0, 0u);
            PG8_WAIT_V(8); PG8_WAIT_L(0); PG8_BAR; PG8_MMA(1, 0, At, B0); PG8_MMA(1, 1, At, B1); PG8_BAR; PG8_SCHED;
            PG8_LDB(B0, 1, 0); PG8_LDB(B1, 1, 1); PG8_SCHED; PG8_LDA(At, 1, 0); PG8_STAGE_A(PG8_SA(0, 1), a2o, 1, 0u);
            PG8_WAIT_V(8); PG8_WAIT_L(0); PG8_BAR; PG8_MMA(0, 0, At, B0); PG8_MMA(0, 1, At, B1); PG8_BAR; PG8_SCHED;
            PG8_LDA(At, 1, 1); PG8_STAGE_B(PG8_SB(1, 0), b2h0 + kstep); PG8_STAGE_B(PG8_SB(1, 1), b2h1 + kstep); PG8_STAGE_A(PG8_SA(1, 0), a2o, 0, kstep);
            PG8_WAIT_V(8); PG8_WAIT_L(0); PG8_BAR; PG8_MMA(1, 0, At, B0); PG8_MMA(1, 1, At, B1); PG8_BAR; PG8_SCHED;
        }
        if (wr == 0) PG8_BAR;
        if constexpr (F8) asm volatile("s_nop 15\n\ts_nop 15" ::: "memory");
        { int l2 = tid; asm volatile("" : "+v"(l2)); S.epi(acc, cur, wr, wc, l2 & 15, (l2 >> 4) & 3); }
        if (!has_next) break;
#pragma unroll
        for (int a = 0; a < 2; ++a)
#pragma unroll
            for (int b = 0; b < 2; ++b)
#pragma unroll
                for (int m = 0; m < 4; ++m)
#pragma unroll
                    for (int n = 0; n < 2; ++n) acc[a][b][m][n] = (f32x4){0.f, 0.f, 0.f, 0.f};
        cur = nxt; cB0 = nB0; cB1 = nB1; ++ui;
#pragma unroll
        for (int h = 0; h < 2; ++h)
#pragma unroll
            for (int i = 0; i < 2; ++i) voffA[h][i] = voffAn[h][i];
        if (wr == 1) PG8_BAR;
    }
    PG8_WAIT_V(0);
    PG8_BAR;
#undef PG8_SA
#undef PG8_SB
#undef PG8_STAGE_A
#undef PG8_GLDS
#undef PG8_STAGE_B
#undef PG8_LDA
#undef PG8_LDB
#undef PG8_MMA
#undef PG8_WAIT_V
#undef PG8_WAIT_L
#undef PG8_BAR
#undef PG8_SCHED
}
struct StaticOrder {
    int nM, nN, nwg, G, c;
    __device__ void init(int M, int N, int G_, int c_) { nM = M / BM; nN = N / BM; nwg = nM * nN; G = G_; c = c_; }
    __device__ bool next(int i, Unit& u) const {
        const long L = (long)i * G + c; if (L >= nwg) return false;
        int wgid = (int)L; { const int q = nwg / 8, r = nwg % 8, xcd = wgid % 8, off = wgid / 8; wgid = (xcd < r ? xcd * (q + 1) : r * (q + 1) + (xcd - r) * q) + off; }
        const int nig = 8 * nN, gid = wgid / nig, fm = gid * 8, gsz = (nM - fm) < 8 ? (nM - fm) : 8;
        u.pm = fm + ((wgid % nig) % gsz); u.pn = (wgid % nig) / gsz; return true;
    }
};
}

struct Frame {
    LAS unsigned char* lds; LAS unsigned char* ctl;
    unsigned char* ws;
    int tid, lane, wave, G, bx;
    float* out; const struct Args* ap; unsigned char* ws0; float* out0; size_t z;
};

struct Args { const float* in[28]; float* out; unsigned char* ws; int ph_lo, ph_hi; };
#define arg_in(i) (F.ap->in[i] + F.z)
__device__ __forceinline__ void phase_begin(Frame& F) {
    int t = F.tid; asm volatile("" : "+v"(t)); F.tid = t; F.lane = t & 63; F.wave = __builtin_amdgcn_readfirstlane(t >> 6);
    size_t z = 0; asm volatile("" : "+s"(z)); F.z = z; F.ws = F.ws0 + z; F.out = F.out0 + z;
    int bx = F.bx; asm volatile("" : "+s"(bx)); F.bx = bx;
}
struct PBase {
    static constexpr bool GATHER = false, FP8 = false; static constexpr int SCALE_AB = 0x7f7f7f7f;
    __device__ __forceinline__ void unit_begin(const pg8::Unit&, LAS unsigned char*, int, int) {}
    __device__ __forceinline__ void midk(f32x4 (&)[2][2][4][2], const pg8::Unit&, int, int, int, LAS unsigned char*, int) {}
    __device__ __forceinline__ void a_fix(unsigned (&)[2][2]) {}
};
struct PInProj : PBase {
    static constexpr int K = 1024, BROW64 = 1;
    pg8::StaticOrder so; const char* A; const char* B; bf16_t* UQKV; const float *GQK, *COS, *SIN;
    __device__ __forceinline__ bool next(int i, pg8::Unit& u) const { return so.next(i, u); }
    __device__ __forceinline__ const char* a_base() const { return A; }
    __device__ __forceinline__ void a_offs(const pg8::Unit& u, int R0, int C0, int R1, int C1, unsigned (&vo)[2][2], bool) const {
#pragma unroll
        for (int h = 0; h < 2; ++h) { vo[h][0] = (unsigned)((u.pm * 256 + 128 * h + R0) * K + C0) * 2u; vo[h][1] = (unsigned)((u.pm * 256 + 128 * h + R1) * K + C1) * 2u; }
    }
    __device__ __forceinline__ void b_ptrs(const pg8::Unit& u, const char*& b0, const char*& b1) const { b0 = B + (size_t)u.pn * 256 * K * 2; b1 = b0 + (size_t)32 * K * 2; }
    __device__ __forceinline__ void epi(f32x4 (&acc)[2][2][4][2], const pg8::Unit& u, int wr, int wc, int fr, int fq) const {
        const int kind = u.pn >> 1;
        const int colg = (u.pn & 1) * 256 + 64 * wc;
        bf16_t* dst = UQKV + (size_t)kind * (size_t)(16u << 20);
        const int row0 = u.pm * 256 + wr * 64 + fr;
        if (kind == 0 || kind == 3) {
#pragma unroll
            for (int ai = 0; ai < 2; ++ai)
#pragma unroll
                for (int m = 0; m < 4; ++m) { bf16_t* rowp = dst + (size_t)(row0 + ai * 128 + m * 16) * 512 + colg + 8 * fq;
#pragma unroll
                    for (int bj = 0; bj < 2; ++bj) { const f32x4 v0 = acc[ai][bj][m][0], v1 = acc[ai][bj][m][1];
                        u32x4 w; w.x = cvt_pk_bf16(v0[0], v0[1]); w.y = cvt_pk_bf16(v0[2], v0[3]); w.z = cvt_pk_bf16(v1[0], v1[1]); w.w = cvt_pk_bf16(v1[2], v1[3]);
                        *(u32x4*)(rowp + 32 * bj) = w; } }
        } else {
            const float* g = GQK + (kind - 1) * 64; const float sc = kind == 1 ? C2 * 32.0f : 16.0f;
            f32x4 g0[2], g1[2];
#pragma unroll
            for (int n = 0; n < 2; ++n) { g0[n] = *(const f32x4*)(g + 8 * fq + 4 * n); g1[n] = *(const f32x4*)(g + 32 + 8 * fq + 4 * n); }
#pragma unroll
            for (int ai = 0; ai < 2; ++ai)
#pragma unroll
                for (int m = 0; m < 4; ++m) {
                    const int row = row0 + ai * 128 + m * 16; const int pos = row & (SEQ - 1);
                    float ss = 0.f;
#pragma unroll
                    for (int bj = 0; bj < 2; ++bj)
#pragma unroll
                        for (int n = 0; n < 2; ++n) { const f32x4 x = acc[ai][bj][m][n]; ss += (x[0] * x[0] + x[1] * x[1]) + (x[2] * x[2] + x[3] * x[3]); }
                    ss += __shfl_xor(ss, 16); ss += __shfl_xor(ss, 32);
                    const float r = rsqrtf(ss * (1.f / 64.f) + EPS) * sc;
                    f32x4 o1[2], o2[2];
#pragma unroll
                    for (int n = 0; n < 2; ++n) {
                        const f32x4 c = *(const f32x4*)(COS + (size_t)pos * 32 + 8 * fq + 4 * n), s = *(const f32x4*)(SIN + (size_t)pos * 32 + 8 * fq + 4 * n);
                        const f32x4 x1 = acc[ai][0][m][n] * g0[n] * r, x2 = acc[ai][1][m][n] * g1[n] * r;
                        o1[n] = x1 * c - x2 * s; o2[n] = x2 * c + x1 * s;
                    }
                    unsigned char* rowp = (unsigned char*)dst + (size_t)row * 512 + colg + 8 * fq;
                    u32x2 w; w.x = pk4_fp8(o1[0][0], o1[0][1], o1[0][2], o1[0][3]); w.y = pk4_fp8(o1[1][0], o1[1][1], o1[1][2], o1[1][3]);
                    *(u32x2*)(rowp) = w;
                    w.x = pk4_fp8(o2[0][0], o2[0][1], o2[0][2], o2[0][3]); w.y = pk4_fp8(o2[1][0], o2[1][1], o2[1][2], o2[1][3]);
                    *(u32x2*)(rowp + 32) = w;
                    asm volatile("" ::: "memory");
                }
        }
    }
};
struct PGlu : PBase {
    static constexpr int K = 512, BROW64 = 0;
    pg8::StaticOrder so; const char* A; const char* B; const bf16_t* YG; bf16_t* MIX; float* RSP;
    __device__ __forceinline__ bool next(int i, pg8::Unit& u) const { return so.next(i, u); }
    __device__ __forceinline__ const char* a_base() const { return A; }
    __device__ __forceinline__ void a_offs(const pg8::Unit& u, int R0, int C0, int R1, int C1, unsigned (&vo)[2][2], bool) const {
#pragma unroll
        for (int h = 0; h < 2; ++h) { vo[h][0] = (unsigned)((u.pm * 256 + 128 * h + R0) * K + C0) * 2u; vo[h][1] = (unsigned)((u.pm * 256 + 128 * h + R1) * K + C1) * 2u; }
    }
    __device__ __forceinline__ void b_ptrs(const pg8::Unit& u, const char*& b0, const char*& b1) const { b0 = B + (size_t)u.pn * 256 * K * 2; b1 = b0 + (size_t)128 * K * 2; }
    __device__ __forceinline__ void epi(f32x4 (&acc)[2][2][4][2], const pg8::Unit& u, int wr, int wc, int fr, int fq) const {
        const int row0 = u.pm * 256 + wr * 64 + fr, col0 = u.pn * 256 + wc * 32 + 8 * fq;
#pragma unroll
        for (int ai = 0; ai < 2; ++ai)
#pragma unroll
            for (int m = 0; m < 4; ++m) {
                const int row = row0 + ai * 128 + m * 16; float ss = 0.f;
#pragma unroll
                for (int bj = 0; bj < 2; ++bj) {
                    const u32x4 yw = *(const u32x4*)(YG + (size_t)row * 512 + col0 + 128 * bj);
                    const f32x4 a0 = acc[ai][bj][m][0], a1 = acc[ai][bj][m][1];
                    float z[8];
                    z[0] = bf_lo(yw.x) * sigmoidf(a0[0]); z[1] = bf_hi(yw.x) * sigmoidf(a0[1]); z[2] = bf_lo(yw.y) * sigmoidf(a0[2]); z[3] = bf_hi(yw.y) * sigmoidf(a0[3]);
                    z[4] = bf_lo(yw.z) * sigmoidf(a1[0]); z[5] = bf_hi(yw.z) * sigmoidf(a1[1]); z[6] = bf_lo(yw.w) * sigmoidf(a1[2]); z[7] = bf_hi(yw.w) * sigmoidf(a1[3]);
#pragma unroll
                    for (int i = 0; i < 8; ++i) ss += z[i] * z[i];
                    u32x4 w; w.x = cvt_pk_bf16(z[0], z[1]); w.y = cvt_pk_bf16(z[2], z[3]); w.z = cvt_pk_bf16(z[4], z[5]); w.w = cvt_pk_bf16(z[6], z[7]);
                    *(u32x4*)(MIX + (size_t)row * 1024 + col0 + 128 * bj) = w;
                }
                ss += __shfl_xor(ss, 16); ss += __shfl_xor(ss, 32);
                if (fq == 0) RSP[(size_t)row * 8 + u.pn * 4 + wc] = ss;
            }
    }
};
struct POut : PBase {
    static constexpr int K = 1024, BROW64 = 0;
    pg8::StaticOrder so; const char* A; const char* B; const float* RSP; const float* base32; const bf16_t* base16; bf16_t* H1;
    __device__ __forceinline__ bool next(int i, pg8::Unit& u) const { return so.next(i, u); }
    __device__ __forceinline__ const char* a_base() const { return A; }
    __device__ __forceinline__ void a_offs(const pg8::Unit& u, int R0, int C0, int R1, int C1, unsigned (&vo)[2][2], bool) const {
#pragma unroll
        for (int h = 0; h < 2; ++h) { vo[h][0] = (unsigned)((u.pm * 256 + 128 * h + R0) * K + C0) * 2u; vo[h][1] = (unsigned)((u.pm * 256 + 128 * h + R1) * K + C1) * 2u; }
    }
    __device__ __forceinline__ void b_ptrs(const pg8::Unit& u, const char*& b0, const char*& b1) const { b0 = B + (size_t)u.pn * 256 * K * 2; b1 = b0 + (size_t)128 * K * 2; }
    __device__ __forceinline__ void unit_begin(const pg8::Unit& u, LAS unsigned char* ldsctl, int tid, int slot) const {
        if (tid < 256) {
            const f32x4 p0 = *(const f32x4*)(RSP + (size_t)(u.pm * 256 + tid) * 8), p1 = *(const f32x4*)(RSP + (size_t)(u.pm * 256 + tid) * 8 + 4);
            const float ss = ((p0[0] + p0[1]) + (p0[2] + p0[3])) + ((p1[0] + p1[1]) + (p1[2] + p1[3]));
            ((LAS float*)(ldsctl + 1024 + slot * 1024))[tid] = rsqrtf(ss * (1.f / 512.f) + EPS);
        }
    }
    __device__ __forceinline__ void midk(f32x4 (&acc)[2][2][4][2], const pg8::Unit& u, int t, int wr, int fr, LAS unsigned char* ldsctl, int slot) const {
        if (t == 8) {
            const LAS float* rs = (const LAS float*)(ldsctl + 1024 + slot * 1024);
#pragma unroll
            for (int ai = 0; ai < 2; ++ai)
#pragma unroll
                for (int m = 0; m < 4; ++m) { const float r = rs[ai * 128 + wr * 64 + m * 16 + fr];
#pragma unroll
                    for (int bj = 0; bj < 2; ++bj)
#pragma unroll
                        for (int n = 0; n < 2; ++n) acc[ai][bj][m][n] *= r; }
        }
    }
    __device__ __forceinline__ void epi(f32x4 (&acc)[2][2][4][2], const pg8::Unit& u, int wr, int wc, int fr, int fq) const {
        const int row0 = u.pm * 256 + wr * 64 + fr, col0 = u.pn * 256 + wc * 32 + 8 * fq;
#pragma unroll
        for (int ai = 0; ai < 2; ++ai)
#pragma unroll
            for (int m = 0; m < 4; ++m) { const size_t off = (size_t)(row0 + ai * 128 + m * 16) * 1024 + col0;
#pragma unroll
                for (int bj = 0; bj < 2; ++bj) {
                    f32x4 v0 = acc[ai][bj][m][0], v1 = acc[ai][bj][m][1];
                    if (base32) { v0 += *(const f32x4*)(base32 + off + bj * 128); v1 += *(const f32x4*)(base32 + off + bj * 128 + 4); }
                    else { const u32x4 b = *(const u32x4*)(base16 + off + bj * 128); v0[0] += bf_lo(b.x); v0[1] += bf_hi(b.x); v0[2] += bf_lo(b.y); v0[3] += bf_hi(b.y); v1[0] += bf_lo(b.z); v1[1] += bf_hi(b.z); v1[2] += bf_lo(b.w); v1[3] += bf_hi(b.w); }
                    u32x4 w; w.x = cvt_pk_bf16(v0[0], v0[1]); w.y = cvt_pk_bf16(v0[2], v0[3]); w.z = cvt_pk_bf16(v1[0], v1[1]); w.w = cvt_pk_bf16(v1[2], v1[3]);
                    *(u32x4*)(H1 + off + bj * 128) = w; }
                if (m & 1) asm volatile("" ::: "memory"); }
    }
};
template <int NN> struct MoeOrder {
    int j, wpx, s0, s1, s2, s3, n0, n1, n2, n3;
    __device__ __forceinline__ void init(int G, int c, const int* PST) {
#ifndef MOE_XA
#define MOE_XA 2
#endif
#ifndef MOE_CHUNKED
#define MOE_CHUNKED 0
#endif
        if (MOE_XA == 1 && (G & 7) == 0) { wpx = G >> 3; const int x = MOE_CHUNKED ? c / wpx : (c & 7); j = MOE_CHUNKED ? c % wpx : (c >> 3);
            s0 = PST[x] >> 8; n0 = (PST[x + 1] - PST[x]) >> 8; s1 = PST[x + 8] >> 8; n1 = (PST[x + 9] - PST[x + 8]) >> 8;
            s2 = PST[x + 16] >> 8; n2 = (PST[x + 17] - PST[x + 16]) >> 8; s3 = PST[x + 24] >> 8; n3 = (PST[x + 25] - PST[x + 24]) >> 8; }
        else { j = c; wpx = G; s0 = 0; n0 = PST[32] >> 8; s1 = s2 = s3 = 0; n1 = n2 = n3 = 0; }
        if (MOE_XA == 2 && (G & 7) == 0) { wpx = G >> 3; j = c >> 3; s1 = c & 7; n0 = PST[32] >> 8; }
    }
    __device__ __forceinline__ bool next(int i, pg8::Unit& u) const {
        const int q = i * wpx + j; int pml = q / NN; u.pn = q % NN;
        if (MOE_XA == 2) { u.pm = s1 + 8 * pml; return u.pm < n0; }
        if (pml < n0) { u.pm = s0 + pml; return true; } pml -= n0;
        if (pml < n1) { u.pm = s1 + pml; return true; } pml -= n1;
        if (pml < n2) { u.pm = s2 + pml; return true; } pml -= n2;
        if (pml < n3) { u.pm = s3 + pml; return true; }
        return false;
    }
};
struct PUp : PBase {
    static constexpr int K = 1024, BROW64 = 0; static constexpr bool GATHER = true, FP8 = UP_FP8; static constexpr int ES = UP_FP8 ? 1 : 2;
    static constexpr int SCALE_AB = 0x7c79;
    MoeOrder<8> mo; const char* A; const char* B; const int* ROWTOK; const int* TILEEXP; const float* bup; const float* ROWSCALE; bf16_t* ACT;
    int idx[2][2]; int c0, c1;
    __device__ __forceinline__ bool next(int i, pg8::Unit& u) const { return mo.next(i, u); }
    __device__ __forceinline__ const char* a_base() const { return A; }
    __device__ __forceinline__ void a_offs(const pg8::Unit& u, int R0, int C0, int R1, int C1, unsigned (&vo)[2][2], bool first) {
        c0 = C0; c1 = C1;
        const int* rp = ROWTOK + u.pm * 256;
#pragma unroll
        for (int h = 0; h < 2; ++h) {
            asm volatile("global_load_dword %0, %1, off" : "=v"(idx[h][0]) : "v"(rp + 128 * h + R0) : "memory");
            asm volatile("global_load_dword %0, %1, off" : "=v"(idx[h][1]) : "v"(rp + 128 * h + R1) : "memory");
        }
        asm volatile("s_waitcnt vmcnt(0)" : "+v"(idx[0][0]), "+v"(idx[0][1]), "+v"(idx[1][0]), "+v"(idx[1][1]) :: "memory");
#pragma unroll
        for (int h = 0; h < 2; ++h) { vo[h][0] = (unsigned)(idx[h][0] * K * ES + 2 * c0); vo[h][1] = (unsigned)(idx[h][1] * K * ES + 2 * c1); }
    }
    __device__ __forceinline__ void b_ptrs(const pg8::Unit& u, const char*& b0, const char*& b1) const {
        const int e = TILEEXP[u.pm]; b0 = B + ((size_t)e * 2048 + (size_t)u.pn * 128) * K * ES; b1 = b0 + (size_t)1024 * K * ES; }
    __device__ __forceinline__ void epi(f32x4 (&acc)[2][2][4][2], const pg8::Unit& u, int wr, int wc, int fr, int fq) const {
        const int e = TILEEXP[u.pm];
        const int row0 = u.pm * 256 + wr * 64 + fr, col0 = u.pn * 128 + wc * 32 + 8 * fq;
        const float* bg = bup + (size_t)e * 2048 + col0; const float* bl = bg + 1024;
        f32x4 bgv[2], blv[2];
#pragma unroll
        for (int n = 0; n < 2; ++n) { bgv[n] = *(const f32x4*)(bg + 4 * n); blv[n] = *(const f32x4*)(bl + 4 * n); }
#pragma unroll
        for (int ai = 0; ai < 2; ++ai)
#pragma unroll
            for (int m = 0; m < 4; ++m) {
                float a[8]; const float rs = ROWSCALE[row0 + ai * 128 + m * 16];
#pragma unroll
                for (int n = 0; n < 2; ++n)
#pragma unroll
                    for (int j = 0; j < 4; ++j) {
                        float glu = acc[ai][0][m][n][j] * rs + bgv[n][j], lin = acc[ai][1][m][n][j] * rs + blv[n][j];
                        glu = fminf(glu, 7.0f); lin = fminf(fmaxf(lin, -7.0f), 7.0f);
                        a[4 * n + j] = glu * sigmoidf(1.702f * glu) * (lin + 1.0f);
                    }
                if (DN_FP8) { u32x2 w; w.x = pk4_fp8(a[0] * 4.f, a[1] * 4.f, a[2] * 4.f, a[3] * 4.f); w.y = pk4_fp8(a[4] * 4.f, a[5] * 4.f, a[6] * 4.f, a[7] * 4.f);
                    *(u32x2*)((unsigned char*)ACT + (size_t)(row0 + ai * 128 + m * 16) * 1024 + col0) = w; }
                else { u32x4 w; w.x = cvt_pk_bf16(a[0], a[1]); w.y = cvt_pk_bf16(a[2], a[3]); w.z = cvt_pk_bf16(a[4], a[5]); w.w = cvt_pk_bf16(a[6], a[7]);
                    *(u32x4*)(ACT + (size_t)(row0 + ai * 128 + m * 16) * 1024 + col0) = w; }
            }
    }
};
struct PDown : PBase {
    static constexpr int K = 1024, BROW64 = 0; static constexpr bool FP8 = DN_FP8; static constexpr int ES = DN_FP8 ? 1 : 2;
    static constexpr int SCALE_AB = 0x7d79;
    MoeOrder<4> mo; const char* A; const char* B; const int* TILEEXP; const float* bdn; const float* ROWGATE; bf16_t* YB;
    __device__ __forceinline__ bool next(int i, pg8::Unit& u) const { return mo.next(i, u); }
    __device__ __forceinline__ const char* a_base() const { return A; }
    __device__ __forceinline__ void a_offs(const pg8::Unit& u, int R0, int C0, int R1, int C1, unsigned (&vo)[2][2], bool) const {
#pragma unroll
        for (int h = 0; h < 2; ++h) { vo[h][0] = (unsigned)((u.pm * 256 + 128 * h + R0) * K * ES + 2 * C0); vo[h][1] = (unsigned)((u.pm * 256 + 128 * h + R1) * K * ES + 2 * C1); }
    }
    __device__ __forceinline__ void b_ptrs(const pg8::Unit& u, const char*& b0, const char*& b1) const {
        const int e = TILEEXP[u.pm]; b0 = B + ((size_t)e * 1024 + (size_t)u.pn * 256) * K * ES; b1 = b0 + (size_t)128 * K * ES; }
    __device__ __forceinline__ void epi(f32x4 (&acc)[2][2][4][2], const pg8::Unit& u, int wr, int wc, int fr, int fq) const {
        const int e = TILEEXP[u.pm];
        const int row0 = u.pm * 256 + wr * 64 + fr, col0 = u.pn * 256 + wc * 32 + 8 * fq;
        const float* bp = bdn + (size_t)e * 1024 + col0;
#pragma unroll
        for (int bj = 0; bj < 2; ++bj) {
            const f32x4 bv0 = *(const f32x4*)(bp + 128 * bj), bv1 = *(const f32x4*)(bp + 128 * bj + 4);
#pragma unroll
            for (int ai = 0; ai < 2; ++ai)
#pragma unroll
                for (int m = 0; m < 4; ++m) { const int row = row0 + ai * 128 + m * 16; const float gt = ROWGATE[row];
                    const f32x4 v0 = (acc[ai][bj][m][0] + bv0) * (gt * 16.f), v1 = (acc[ai][bj][m][1] + bv1) * (gt * 16.f);
                    u32x2 w; w.x = pk4_fp8(v0[0], v0[1], v0[2], v0[3]); w.y = pk4_fp8(v1[0], v1[1], v1[2], v1[3]);
                    *(u32x2*)((unsigned char*)YB + (size_t)row * 1024 + col0 + 128 * bj) = w; }
            asm volatile("" ::: "memory");
        }
    }
};

struct TItem { const float* src; bf16_t* dst; const float* ksc; int N, K; unsigned char* dst8; };
__device__ __forceinline__ void titem_load(const TItem& it, f32x4 (&v)[16], int lane) {
    const float* p = it.src + (size_t)(lane >> 4) * it.N + 4 * (lane & 15);
#pragma unroll
    for (int i = 0; i < 16; ++i) v[i] = *(const f32x4*)(p + (size_t)(4 * i) * it.N);
}
__device__ __forceinline__ void titem_store(const TItem& it, f32x4 (&v)[16], LAS float* scr, int lane) {
    if (it.ksc) {
#pragma unroll
        for (int i = 0; i < 16; ++i) v[i] *= it.ksc[4 * i + (lane >> 4)];
    }
#pragma unroll
    for (int i = 0; i < 16; ++i) { LAS float* d = scr + (4 * i + (lane >> 4)) * 65 + 4 * (lane & 15); d[0] = v[i][0]; d[1] = v[i][1]; d[2] = v[i][2]; d[3] = v[i][3]; }
    asm volatile("s_waitcnt lgkmcnt(0)" ::: "memory");
    if (it.dst8) {
        const int c = lane & 3;
#pragma unroll
        for (int j = 0; j < 4; ++j) { const int n = (lane >> 2) + 16 * j; const LAS float* s = scr + (16 * c) * 65 + n;
            u32x4 o;
            o.x = pk4_fp8(s[0 * 65] * 64.f, s[1 * 65] * 64.f, s[2 * 65] * 64.f, s[3 * 65] * 64.f); o.y = pk4_fp8(s[4 * 65] * 64.f, s[5 * 65] * 64.f, s[6 * 65] * 64.f, s[7 * 65] * 64.f);
            o.z = pk4_fp8(s[8 * 65] * 64.f, s[9 * 65] * 64.f, s[10 * 65] * 64.f, s[11 * 65] * 64.f); o.w = pk4_fp8(s[12 * 65] * 64.f, s[13 * 65] * 64.f, s[14 * 65] * 64.f, s[15 * 65] * 64.f);
            *(u32x4*)(it.dst8 + (size_t)n * it.K + 16 * c) = o; }
    } else {
        const int c = lane & 7;
#pragma unroll
        for (int j = 0; j < 8; ++j) { const int n = (lane >> 3) + 8 * j; const LAS float* s = scr + (8 * c) * 65 + n;
            u32x4 o; o.x = pk2(s[0 * 65], s[1 * 65]); o.y = pk2(s[2 * 65], s[3 * 65]); o.z = pk2(s[4 * 65], s[5 * 65]); o.w = pk2(s[6 * 65], s[7 * 65]);
            *(u32x4*)(it.dst + (size_t)n * it.K + 8 * c) = o; }
    }
    asm volatile("s_waitcnt lgkmcnt(0)" ::: "memory");
}
__device__ __forceinline__ void rms_row_to_bf16(const f32x4 (&v)[4], const float* g, bf16_t* orow, int lane) {
    float s = 0.f;
#pragma unroll
    for (int j = 0; j < 4; ++j) s += (v[j][0] * v[j][0] + v[j][1] * v[j][1]) + (v[j][2] * v[j][2] + v[j][3] * v[j][3]);
    const float r = rsqrtf(wave_sum(s) * (1.f / D) + EPS);
#pragma unroll
    for (int j = 0; j < 4; ++j) { const f32x4 gg = *(const f32x4*)(g + 4 * lane + 256 * j); const f32x4 o = v[j] * gg * r;
        u32x2 w; w.x = cvt_pk_bf16(o[0], o[1]); w.y = cvt_pk_bf16(o[2], o[3]); *(u32x2*)(orow + 4 * lane + 256 * j) = w; }
}
struct Cplx { float re, im; };
__device__ __forceinline__ Cplx cmul(Cplx a, Cplx b) { return Cplx{a.re * b.re - a.im * b.im, a.re * b.im + a.im * b.re}; }
__device__ __forceinline__ Cplx lam_pow(float lr, float li, float step, int n) {
    const float mag = expf((float)n * lr * step); const double ang = (double)n * (double)li * (double)step;
    return Cplx{mag * (float)cos(ang), mag * (float)sin(ang)};
}
__device__ __forceinline__ Cplx bbar_factor(float lr, float li, float step) {
    const Cplx lb = lam_pow(lr, li, step, 1); const float nr = lb.re - 1.f, ni = lb.im, den = lr * lr + li * li;
    return Cplx{(nr * lr + ni * li) / den, (ni * lr - nr * li) / den};
}
template <int PMODE> __device__ __forceinline__ void p0_prologue(Frame& F) {
    const int gw = F.bx * NWAVES + F.wave, NGW = F.G * NWAVES, lane = F.lane;
    const int gt = F.bx * NTHREADS + F.tid, NGT = F.G * NTHREADS;
    unsigned char* ws = F.ws;
    if (!(PMODE & 1)) {
        LAS float* scr = (LAS float*)(F.lds + LDS_RING) + F.wave * (64 * 65);
        constexpr int I_UP = 32 * 16 * 32, I_DN = 32 * 16 * 16, I_IN = 16 * 32, I_OUT = 16 * 16, I_GLU = 8 * 8;
        constexpr int PER_L = I_UP + I_DN + I_IN + I_OUT + I_GLU, TOTAL = DEPTH * PER_L;
        auto decode = [&](int it) -> TItem {
            TItem ti; const int l = it / PER_L; int r = it % PER_L; const float* W; bf16_t* WT; int K, N; ti.ksc = nullptr; bool f8 = false;
            if (r < I_UP) { const int e = r / 512; r %= 512; K = 1024; N = 2048; W = arg_in(24) + ((size_t)l * NE + e) * 1024 * 2048; WT = (bf16_t*)(ws + WS_WUP + l * WUP_STRIDE) + (size_t)e * 2048 * 1024 / (UP_FP8 ? 2 : 1); f8 = UP_FP8; }
            else if ((r -= I_UP) < I_DN) { const int e = r / 256; r %= 256; K = 1024; N = 1024; W = arg_in(26) + ((size_t)l * NE + e) * 1024 * 1024; WT = (bf16_t*)(ws + WS_WDN + l * WDN_STRIDE) + (size_t)e * 1024 * 1024 / (DN_FP8 ? 2 : 1); f8 = DN_FP8; }
            else if ((r -= I_DN) < I_IN) { K = 1024; N = 2048; W = arg_in(2) + (size_t)l * 1024 * 2048; WT = (bf16_t*)(ws + WS_WIN + l * WIN_STRIDE); }
            else if ((r -= I_IN) < I_OUT) { K = 1024; N = 1024; W = arg_in(20) + (size_t)l * 1024 * 1024; WT = (bf16_t*)(ws + WS_WOUT + l * WOUT_STRIDE); if ((r / 16) * 64 < DS) ti.ksc = arg_in(12) + l * DS + (r / 16) * 64; }
            else { r -= I_OUT; K = 512; N = 512; W = arg_in(11) + (size_t)l * 512 * 512; WT = (bf16_t*)(ws + WS_WGLU + l * WGLU_STRIDE); }
            const int nblk = N / 64, k0 = 64 * (r / nblk), n0 = 64 * (r % nblk);
            ti.src = W + (size_t)k0 * N + n0; ti.dst = WT + (size_t)n0 * K + k0; ti.N = N; ti.K = K; ti.dst8 = f8 ? (unsigned char*)WT + (size_t)n0 * K + k0 : nullptr; return ti;
        };
        f32x4 va[16], vb[16]; TItem ia, ib;
        int it = gw;
        if (it < TOTAL) { ia = decode(it); titem_load(ia, va, lane); }
        while (it < TOTAL) {
            const int itb = it + NGW;
            if (itb < TOTAL) { ib = decode(itb); titem_load(ib, vb, lane); }
            titem_store(ia, va, scr, lane);
            if (itb >= TOTAL) break;
            const int itc = itb + NGW;
            if (itc < TOTAL) { ia = decode(itc); titem_load(ia, va, lane); }
            titem_store(ib, vb, scr, lane);
            it = itc;
        }
    }
    for (int i = gt; i < SEQ * 32; i += NGT) {
        const int s = i >> 5, j = i & 31;
        const float inv = 1.0f / powf(10000.0f, (float)(2 * j) / 64.0f);
        const float ang = (float)s * inv;
        ((float*)(ws + WS_COS))[i] = (float)cos((double)ang); ((float*)(ws + WS_SIN))[i] = (float)sin((double)ang);
    }
    if (F.bx == 0 && F.wave < DEPTH) {
        const int l = F.wave;
        float a = arg_in(15)[l * 64 + lane] * arg_in(16)[l * 64 + lane], b = arg_in(17)[l * 64 + lane] * arg_in(18)[l * 64 + lane];
        a = wave_sum(a); b = wave_sum(b);
        float mq = fabsf(arg_in(13)[l * 64 + lane]), mk = fabsf(arg_in(14)[l * 64 + lane]);
#pragma unroll
        for (int o = 1; o < 64; o <<= 1) { mq = fmaxf(mq, __shfl_xor(mq, o)); mk = fmaxf(mk, __shfl_xor(mk, o)); }
        const float lambda_init = 0.8f - 0.6f * expf(-0.3f * (float)l);
        { float* gqk = (float*)(ws + WS_SCAL) + 64 + l * 128; gqk[lane] = arg_in(13)[l * 64 + lane]; gqk[64 + lane] = arg_in(14)[l * 64 + lane]; }
        if (lane == 0) { float* sc = (float*)(ws + WS_SCAL) + l * 4; sc[0] = expf(a) - expf(b) + lambda_init; sc[1] = C2 * 64.f * mq * mk * 1.02f + 0.5f; sc[2] = 1.0f - lambda_init; }
    }
    for (int i = gt; i < DEPTH * NE * D; i += NGT) {
        const int l = i / (NE * D), e = (i / D) % NE, k = i % D;
        const float w = arg_in(22)[(size_t)l * D * NE + (size_t)k * NE + e];
        const unsigned hi = f2bf(w); const float lo = w - __builtin_bit_cast(float, hi << 16);
        bf16_t* t = (bf16_t*)(ws + WS_WRT + l * WRT_STRIDE);
        t[e * D + k] = (bf16_t)hi; t[NE * D + e * D + k] = (bf16_t)f2bf(lo);
    }
#define TBL_PTRS(l) const float* lam_re = arg_in(3) + (l) * NG * NP; const float* lam_im = arg_in(4) + (l) * NG * NP; const float* log_step = arg_in(5) + (l) * NG; \
        const float* b_re = arg_in(6) + (size_t)(l) * NG * NP * HS; const float* b_im = arg_in(7) + (size_t)(l) * NG * NP * HS; \
        const float* c_re = arg_in(8) + (size_t)(l) * NG * HS * NP; const float* c_im = arg_in(9) + (size_t)(l) * NG * HS * NP; \
        bf16_t* KT = (bf16_t*)(ws + WS_KT + (l) * KT_STRIDE); bf16_t* HT = (bf16_t*)(ws + WS_HT + (l) * HT_STRIDE); (void)KT; (void)HT; (void)b_re; (void)b_im
    if (!(PMODE & 2)) {
        {
            LAS float* pwl = (LAS float*)(F.lds + LDS_RING);
            for (int cb = F.bx; cb < DEPTH * NG * 17; cb += F.G) {
                const int l = cb / (NG * 17), rb = cb % (NG * 17);
                if (rb >= NG * 9) continue;
                const int blk = rb;
                TBL_PTRS(l);
                const int g = blk / 9, s0 = (blk % 9) * 8;
                const float step = expf(log_step[g]);
                __syncthreads();
                { const int p = F.tid & 63, sl = F.tid >> 6, slot = s0 + sl; Cplx w{0.f, 0.f};
                  if (slot >= 1 && slot <= 64) { const float lr = lam_re[g * NP + p], li = lam_im[g * NP + p]; w = cmul(lam_pow(lr, li, step, slot - 1), bbar_factor(lr, li, step)); }
                  pwl[(sl * 64 + p) * 2] = w.re; pwl[(sl * 64 + p) * 2 + 1] = w.im; }
                __syncthreads();
                const int pq = F.tid & 3, h = (F.tid >> 2) & 15, sl = F.tid >> 6, slot = s0 + sl;
                float accv[16];
#pragma unroll
                for (int q = 0; q < 16; ++q) accv[q] = 0.f;
                for (int pp = 0; pp < 16; ++pp) {
                    const int p = pq * 16 + pp;
                    const Cplx w = cmul(Cplx{c_re[(size_t)(g * HS + h) * NP + p], c_im[(size_t)(g * HS + h) * NP + p]}, Cplx{pwl[(sl * 64 + p) * 2], pwl[(sl * 64 + p) * 2 + 1]});
#pragma unroll
                    for (int q = 0; q < 16; ++q) { const float br = b_re[(size_t)(g * NP + p) * HS + q], bi = b_im[(size_t)(g * NP + p) * HS + q]; accv[q] += w.re * br - w.im * bi; }
                }
#pragma unroll
                for (int q = 0; q < 16; ++q) { accv[q] += __shfl_xor(accv[q], 1); accv[q] += __shfl_xor(accv[q], 2); }
                if (pq == 0 && slot <= 64) {
                    u32x4 o0, o1; o0.x = pk2(accv[0], accv[1]); o0.y = pk2(accv[2], accv[3]); o0.z = pk2(accv[4], accv[5]); o0.w = pk2(accv[6], accv[7]);
                    o1.x = pk2(accv[8], accv[9]); o1.y = pk2(accv[10], accv[11]); o1.z = pk2(accv[12], accv[13]); o1.w = pk2(accv[14], accv[15]);
                    u32x4* dst = (u32x4*)(KT + ((size_t)(g * 65 + slot) * HS + h) * 16); dst[0] = o0; dst[1] = o1;
                }
            }
            for (int cb = F.bx; cb < DEPTH * NG * 17; cb += F.G) {
                const int l = cb / (NG * 17), rb = cb % (NG * 17);
                if (rb < NG * 9) continue;
                const int blk = rb - NG * 9;
                TBL_PTRS(l);
                const int g = blk >> 3, t0 = (blk & 7) * 8;
                const float step = expf(log_step[g]);
                __syncthreads();
                { const int p = F.tid & 63, tl = F.tid >> 6; const Cplx w = lam_pow(lam_re[g * NP + p], lam_im[g * NP + p], step, t0 + tl + 1); pwl[(tl * 64 + p) * 2] = w.re; pwl[(tl * 64 + p) * 2 + 1] = w.im; }
                __syncthreads();
                const int pq = F.tid & 3, h = (F.tid >> 2) & 15, tl = F.tid >> 6, t = t0 + tl;
                bf16_t* dst = HT + ((size_t)(g * 1024 + t * 16 + h) * 128 + pq * 32);
                for (int pp = 0; pp < 16; pp += 4) {
                    float v[8];
#pragma unroll
                    for (int q = 0; q < 4; ++q) { const int p = pq * 16 + pp + q;
                        const Cplx w = cmul(Cplx{c_re[(size_t)(g * HS + h) * NP + p], c_im[(size_t)(g * HS + h) * NP + p]}, Cplx{pwl[(tl * 64 + p) * 2], pwl[(tl * 64 + p) * 2 + 1]});
                        v[2 * q] = w.re; v[2 * q + 1] = -w.im; }
                    u32x4 o; o.x = pk2(v[0], v[1]); o.y = pk2(v[2], v[3]); o.z = pk2(v[4], v[5]); o.w = pk2(v[6], v[7]);
                    *(u32x4*)(dst + 2 * pp) = o;
                }
            }
            __syncthreads();
        }
    }
#undef TBL_PTRS
    if (!(PMODE & 2)) for (int l = 0; l < DEPTH; ++l) {
        const float* lam_re = arg_in(3) + l * NG * NP; const float* lam_im = arg_in(4) + l * NG * NP; const float* log_step = arg_in(5) + l * NG;
        const float* b_re = arg_in(6) + (size_t)l * NG * NP * HS; const float* b_im = arg_in(7) + (size_t)l * NG * NP * HS;
        const float* c_re = arg_in(8) + (size_t)l * NG * HS * NP; const float* c_im = arg_in(9) + (size_t)l * NG * HS * NP;
        bf16_t* KT = (bf16_t*)(ws + WS_KT + l * KT_STRIDE); bf16_t* GT = (bf16_t*)(ws + WS_GT + l * GT_STRIDE); bf16_t* HT = (bf16_t*)(ws + WS_HT + l * HT_STRIDE);
        float* LAML = (float*)(ws + WS_LAML + l * LAML_STRIDE);
        for (int i = gt; i < NG * NP * 64; i += NGT) {
            const int s = i % 64, p = (i / 64) % NP, g = i / (64 * NP);
            const float step = expf(log_step[g]); const float lr = lam_re[g * NP + p], li = lam_im[g * NP + p];
            const Cplx w = cmul(lam_pow(lr, li, step, 63 - s), bbar_factor(lr, li, step));
            float vr[16], vi[16];
#pragma unroll
            for (int q = 0; q < 16; ++q) { const float br = b_re[(size_t)(g * NP + p) * HS + q], bi = b_im[(size_t)(g * NP + p) * HS + q]; vr[q] = w.re * br - w.im * bi; vi[q] = w.re * bi + w.im * br; }
            u32x4* dr = (u32x4*)(GT + ((size_t)(g * 128 + 2 * p) * 1024 + s * 16)); u32x4* di = (u32x4*)(GT + ((size_t)(g * 128 + 2 * p + 1) * 1024 + s * 16));
            u32x4 o; o.x = pk2(vr[0], vr[1]); o.y = pk2(vr[2], vr[3]); o.z = pk2(vr[4], vr[5]); o.w = pk2(vr[6], vr[7]); dr[0] = o;
            o.x = pk2(vr[8], vr[9]); o.y = pk2(vr[10], vr[11]); o.z = pk2(vr[12], vr[13]); o.w = pk2(vr[14], vr[15]); dr[1] = o;
            o.x = pk2(vi[0], vi[1]); o.y = pk2(vi[2], vi[3]); o.z = pk2(vi[4], vi[5]); o.w = pk2(vi[6], vi[7]); di[0] = o;
            o.x = pk2(vi[8], vi[9]); o.y = pk2(vi[10], vi[11]); o.z = pk2(vi[12], vi[13]); o.w = pk2(vi[14], vi[15]); di[1] = o;
        }
        for (int i = gt; i < NG * NP; i += NGT) { const int g = i / NP; const Cplx w = lam_pow(lam_re[i], lam_im[i], expf(log_step[g]), 64); LAML[2 * i] = w.re; LAML[2 * i + 1] = w.im; }
    }
    {
        const float* xin = arg_in(0); const float* g0 = arg_in(1); bf16_t* XN = (bf16_t*)(ws + WS_XN);
        f32x4 va[4], vb[4];
        int m = gw;
        if (m < T) {
#pragma unroll
            for (int j = 0; j < 4; ++j) va[j] = ((const f32x4*)(xin + (size_t)m * D) + lane)[64 * j]; }
        while (m < T) {
            const int mb = m + NGW;
            if (mb < T) {
#pragma unroll
                for (int j = 0; j < 4; ++j) vb[j] = ((const f32x4*)(xin + (size_t)mb * D) + lane)[64 * j]; }
            rms_row_to_bf16(va, g0, XN + (size_t)m * D, lane);
            if (mb >= T) break;
            const int mc = mb + NGW;
            if (mc < T) {
#pragma unroll
                for (int j = 0; j < 4; ++j) va[j] = ((const f32x4*)(xin + (size_t)mc * D) + lane)[64 * j]; }
            rms_row_to_bf16(vb, g0, XN + (size_t)mb * D, lane);
            m = mc;
        }
    }
}

__device__ __forceinline__ void s5a_phase(Frame& F, int l) {
    const bf16_t* GT = (const bf16_t*)(F.ws + WS_GT + l * GT_STRIDE); const bf16_t* U = (const bf16_t*)(F.ws + WS_U); float* S = (float*)(F.ws + WS_S);
    const int lane = F.lane, n = lane & 15, kq = lane >> 4;
    for (int uu = F.bx * NWAVES + F.wave; uu < NG * 32 * 2; uu += F.G * NWAVES) {
        const int g = uu >> 6, ntile = (uu >> 1) & 31, mh = uu & 1;
        const int chunk = ntile * 16 + n;
        const bf16_t* up = U + ((size_t)chunk * 64 + (kq >> 1)) * DS + g * 16 + 8 * (kq & 1);
        const bf16_t* gp = GT + ((size_t)(g * 128 + mh * 64 + n) * 1024 + 8 * kq);
        f32x4 acc[4];
#pragma unroll
        for (int mt = 0; mt < 4; ++mt) acc[mt] = (f32x4){0.f, 0.f, 0.f, 0.f};
#pragma unroll 4
        for (int ks = 0; ks < 32; ++ks) {
            const bf16x8 b = *(const bf16x8*)(up + (size_t)(2 * ks) * DS);
#pragma unroll
            for (int mt = 0; mt < 4; ++mt) { const bf16x8 a = *(const bf16x8*)(gp + (size_t)(mt * 16) * 1024 + 32 * ks); acc[mt] = __builtin_amdgcn_mfma_f32_16x16x32_bf16(a, b, acc[mt], 0, 0, 0); }
        }
#pragma unroll
        for (int mt = 0; mt < 4; ++mt) *(f32x4*)(S + ((size_t)chunk * NG + g) * 128 + mh * 64 + mt * 16 + 4 * kq) = acc[mt];
    }
}
__device__ __forceinline__ void s5c_phase(Frame& F, int l) {
    const bf16_t* KT = (const bf16_t*)(F.ws + WS_KT + l * KT_STRIDE); const bf16_t* HT = (const bf16_t*)(F.ws + WS_HT + l * HT_STRIDE);
    const float* LAML = (const float*)(F.ws + WS_LAML + l * LAML_STRIDE); const float* S = (const float*)(F.ws + WS_S);
    const bf16_t* U = (const bf16_t*)(F.ws + WS_U); bf16_t* YG = (bf16_t*)(F.ws + WS_YG); const float* dsk = arg_in(10) + l * DS;
    const int lane = F.lane, n = lane & 15, kq = lane >> 4, wave = F.wave;
    LAS unsigned char* ktl = F.lds + LDS_RING;
    LAS unsigned char* xs = F.lds + LDS_RING + 33792 + wave * 4096;
    LAS f32x2* EB = (LAS f32x2*)(F.lds + LDS_RING + 33792 + 8 * 4096);
    LAS f32x2* EH = EB + 512;
    for (int wu = F.bx; wu < NG * 8; wu += F.G) {
        const int g = wu >> 3, scq = wu & 7, b = scq >> 1, cbase = (scq & 1) * 64, scl = wave >> 1, par = wave & 1;
        __syncthreads();
        for (int i = F.tid; i < 65 * 32; i += NTHREADS) *(LAS u32x4*)(ktl + i * 16) = *(const u32x4*)(KT + (size_t)g * 65 * 256 + i * 8);
        const Cplx L = Cplx{LAML[(g * NP + lane) * 2], LAML[(g * NP + lane) * 2 + 1]};
        const float* sp = S + ((size_t)(b * CPB) * NG + g) * 128 + 2 * lane;
        {
            f32x2 sv[8];
#pragma unroll
            for (int j = 0; j < 8; ++j) sv[j] = *(const f32x2*)(sp + (size_t)(cbase + 8 * wave + j) * NG * 128);
            Cplx E{0.f, 0.f};
#pragma unroll
            for (int j = 0; j < 8; ++j) { const Cplx nx = cmul(L, E); E.re = nx.re + sv[j][0]; E.im = nx.im + sv[j][1]; }
            EB[wave * 64 + lane] = (f32x2){E.re, E.im};
            if (cbase) {
#pragma unroll
                for (int j = 0; j < 8; ++j) sv[j] = *(const f32x2*)(sp + (size_t)(8 * wave + j) * NG * 128);
                Cplx H{0.f, 0.f};
#pragma unroll
                for (int j = 0; j < 8; ++j) { const Cplx nx = cmul(L, H); H.re = nx.re + sv[j][0]; H.im = nx.im + sv[j][1]; }
                EH[wave * 64 + lane] = (f32x2){H.re, H.im};
            }
        }
        __syncthreads();
        const int c0 = cbase + 16 * scl;
        {
            const Cplx L2 = cmul(L, L), L4 = cmul(L2, L2), L8 = cmul(L4, L4);
            Cplx X{0.f, 0.f};
            if (cbase) {
#pragma unroll
                for (int w = 0; w < 8; ++w) { const f32x2 e = EH[w * 64 + lane]; const Cplx nx = cmul(L8, X); X.re = nx.re + e[0]; X.im = nx.im + e[1]; }
            }
            for (int w = 0; w < 2 * scl; ++w) { const f32x2 e = EB[w * 64 + lane]; const Cplx nx = cmul(L8, X); X.re = nx.re + e[0]; X.im = nx.im + e[1]; }
            f32x2 sv[16];
#pragma unroll
            for (int j = 0; j < 16; ++j) sv[j] = *(const f32x2*)(sp + (size_t)(c0 + j) * NG * 128);
#pragma unroll
            for (int j = 0; j < 16; ++j) {
                *(LAS unsigned*)(xs + j * 256 + 4 * lane) = pk2(X.re, X.im);
                const Cplx nx = cmul(L, X); X.re = nx.re + sv[j][0]; X.im = nx.im + sv[j][1];
            }
        }
        const int chunk = b * CPB + c0 + n;
        bf16x8 ub[32];
        {
            const bf16_t* up = U + ((size_t)chunk * 64 + (kq >> 1)) * DS + g * 16 + 8 * (kq & 1);
#pragma unroll
            for (int kp = 0; kp < 32; ++kp) ub[kp] = *(const bf16x8*)(up + (size_t)(2 * kp) * DS);
        }
        const LAS unsigned char* xbp = xs + n * 256 + 16 * kq;
        const f32x4 dv = *(const f32x4*)(dsk + g * 16 + 4 * kq);
        const bf16_t* hp = HT + ((size_t)(g * 1024 + n) * 128 + 8 * kq);
        const bf16_t* uq = U + (size_t)chunk * 64 * DS + g * 16 + 4 * kq;
        const LAS unsigned char* kbase = ktl + (n * 16 + 8 * (kq & 1)) * 2;
        bf16x8 ha[4]; u32x2 uw;
#pragma unroll
        for (int ks = 0; ks < 4; ++ks) ha[ks] = *(const bf16x8*)(hp + (size_t)(par * 16) * 128 + 32 * ks);
        uw = *(const u32x2*)(uq + (size_t)par * DS);
        for (int ti = 0; ti < 32; ++ti) {
            const int t = 2 * ti + par, tn = (ti < 31) ? t + 2 : t;
            bf16x8 hn[4]; u32x2 un;
#pragma unroll
            for (int ks = 0; ks < 4; ++ks) hn[ks] = *(const bf16x8*)(hp + (size_t)(tn * 16) * 128 + 32 * ks);
            un = *(const u32x2*)(uq + (size_t)tn * DS);
            f32x4 acc = (f32x4){0.f, 0.f, 0.f, 0.f};
            const int slot0 = t + 1 - (kq >> 1);
#pragma unroll
            for (int kp = 0; kp < 32; ++kp) {
                if (kp <= ti) { const bf16x8 a = *(const LAS bf16x8*)(kbase + (slot0 - 2 * kp) * 512); acc = __builtin_amdgcn_mfma_f32_16x16x32_bf16(a, ub[kp], acc, 0, 0, 0); }
            }
#pragma unroll
            for (int ks = 0; ks < 4; ++ks) acc = __builtin_amdgcn_mfma_f32_16x16x32_bf16(ha[ks], *(const LAS bf16x8*)(xbp + 64 * ks), acc, 0, 0, 0);
            const float y0 = acc[0] + dv[0] * bf_lo(uw.x), y1 = acc[1] + dv[1] * bf_hi(uw.x), y2 = acc[2] + dv[2] * bf_lo(uw.y), y3 = acc[3] + dv[3] * bf_hi(uw.y);
            u32x2 w; w.x = cvt_pk_bf16(gelu_tanh(y0), gelu_tanh(y1)); w.y = cvt_pk_bf16(gelu_tanh(y2), gelu_tanh(y3));
            *(u32x2*)(YG + ((size_t)chunk * 64 + t) * DS + g * 16 + 4 * kq) = w;
#pragma unroll
            for (int ks = 0; ks < 4; ++ks) ha[ks] = hn[ks];
            uw = un;
        }
    }
    __syncthreads();
}

namespace att {
constexpr int KSLOT = 16384, VSLOT = 16384, LDS_K = 0, LDS_V = 3 * KSLOT, LDS_WS = 6 * 16384, LDS_END = LDS_WS + 8 * 256;
constexpr int STG_ROW = 136;
__device__ __forceinline__ int crow(int r, int hi) { return (r & 3) + 8 * (r >> 2) + 4 * hi; }
__device__ __forceinline__ void glds16(const void* gsrc, unsigned lds_dst) { unsigned keep;
    asm volatile("s_mov_b32 %0, m0\n\ts_mov_b32 m0, %2\n\ts_nop 0\n\tglobal_load_lds_dwordx4 %1, off\n\ts_mov_b32 m0, %0" : "=&s"(keep) : "v"(gsrc), "s"(lds_dst) : "memory"); }
typedef __attribute__((address_space(3))) const char* lds_cptr;
typedef short v4i16_t __attribute__((ext_vector_type(4)));
__device__ __forceinline__ s16x4 vtr(lds_cptr p) { return __builtin_bit_cast(s16x4, __builtin_amdgcn_ds_read_tr16_b64_v4i16((__attribute__((address_space(3))) v4i16_t*)p)); }
#define ATT_WAIT_BAR(N) asm volatile("s_waitcnt vmcnt(" #N ") lgkmcnt(0)\n\ts_barrier" ::: "memory")

template <int MODE> __device__ __forceinline__ void attn_unit(int bh, int qb, const bf16_t* Q, const bf16_t* K, const bf16_t* V, bf16_t* MIX, const float* subg, float lam, float mshift, float oml,
                                          LAS unsigned char* shm, int tid) {
    const int lane = tid & 63, r32 = lane & 31, hi = lane >> 5; const int wid = __builtin_amdgcn_readfirstlane(tid >> 6);
    const int b = bh >> 2, h = bh & 3, m = wid & 1, qg = wid >> 1;
    const size_t rowbase = (size_t)b * SEQ; const int q0 = qb * 128;
    const int NT = 2 * qb + 2, cw = 2 * qb + (qg >> 1);
    const unsigned lds0 = (unsigned)(uintptr_t)shm;
    const unsigned char* k0src = (const unsigned char*)K + (rowbase + lane) * DA + h * 128 + (wid >> 2) * 64 + ((wid >> 1) & 1) * 32 + (wid & 1) * 16;
    const bf16_t* v0src = V + (rowbase + 16 * (wid & 3) + (lane >> 2)) * DA + h * 128 + (wid >> 2) * 32 + (lane & 3) * 8;
    const bf16_t* v1src = v0src + 64;
    const unsigned kdst = lds0 + LDS_K + (wid >> 2) * 4096 + (wid & 3) * 1024, vdst = lds0 + LDS_V + wid * 1024;
#define ATT_DMA(t, slot) do { const size_t _o = (size_t)(t) * 64 * DA; \
        glds16(k0src + _o, (unsigned)__builtin_amdgcn_readfirstlane(kdst + (slot) * KSLOT)); glds16(k1src + _o, (unsigned)__builtin_amdgcn_readfirstlane(kdst + (slot) * KSLOT + 8192)); \
        glds16(v0src + _o, (unsigned)__builtin_amdgcn_readfirstlane(vdst + (slot) * VSLOT)); glds16(v1src + _o, (unsigned)__builtin_amdgcn_readfirstlane(vdst + (slot) * VSLOT + 8192)); } while (0)
    v8i32 qf;
    { const unsigned char* Qw = (const unsigned char*)Q + (rowbase + q0 + qg * 32 + r32) * DA + h * 128 + m * 64 + hi * 32;
      const u32x4 ql = *(const u32x4*)(Qw), qh = *(const u32x4*)(Qw + 16); qf = __builtin_bit_cast(v8i32, __builtin_shufflevector(ql, qh, 0, 1, 2, 3, 4, 5, 6, 7)); }
#ifndef ATT_GRP
#define ATT_GRP (wid & 1)
#endif
    const int grp = ATT_GRP;
#define ATT_DMA_K(t, slot) do { if (MODE & 1) break; const size_t _o = (size_t)(t) * 64 * DA; \
        glds16(k0src + _o, (unsigned)__builtin_amdgcn_readfirstlane(kdst + (slot) * KSLOT)); } while (0)
#define ATT_DMA_V(t, slot) do { if (MODE & 1) break; const size_t _o = (size_t)(t) * 64 * DA; \
        glds16(v0src + _o, (unsigned)__builtin_amdgcn_readfirstlane(vdst + (slot) * VSLOT)); glds16(v1src + _o, (unsigned)__builtin_amdgcn_readfirstlane(vdst + (slot) * VSLOT + 8192)); } while (0)
    ATT_DMA_K(0, 0); ATT_DMA_V(0, 0); ATT_DMA_K(1, 1); ATT_DMA_V(1, 1);
    f32x16 o[4];
#pragma unroll
    for (int d = 0; d < 4; ++d)
#pragma unroll
        for (int r = 0; r < 16; ++r) o[d][r] = 0.f;
    float l_reg = 0.f;
    const f32x16 zero16 = {0.f, 0.f, 0.f, 0.f, 0.f, 0.f, 0.f, 0.f, 0.f, 0.f, 0.f, 0.f, 0.f, 0.f, 0.f, 0.f};
    (void)mshift;
    const lds_cptr shm3 = (lds_cptr)shm;
    const lds_cptr kp0 = shm3 + LDS_K + m * 4096 + hi * 2048 + r32 * 16;
    const lds_cptr vp0 = shm3 + LDS_V + ((lane >> 4) & 1) * 32 + (lane & 3) * 8 + (4 * hi + ((lane & 15) >> 2)) * 64;
    u32x4 pw[4];
#pragma unroll
    for (int q = 0; q < 4; ++q) pw[q] = (u32x4){0u, 0u, 0u, 0u};
#define ATT_SB() __builtin_amdgcn_sched_barrier(0)
#define ATT_QKEXP(sl) do { if (MODE & 2) break; const lds_cptr kp = kp0 + (sl) * KSLOT; \
        ATT_SB(); \
        const u32x4 k0l = *(const __attribute__((address_space(3))) u32x4*)(kp), k0h = *(const __attribute__((address_space(3))) u32x4*)(kp + 1024); \
        const u32x4 k1l = *(const __attribute__((address_space(3))) u32x4*)(kp + 512), k1h = *(const __attribute__((address_space(3))) u32x4*)(kp + 1024 + 512); \
        ATT_SB(); \
        const v8i32 kf0 = __builtin_bit_cast(v8i32, __builtin_shufflevector(k0l, k0h, 0, 1, 2, 3, 4, 5, 6, 7)), kf1 = __builtin_bit_cast(v8i32, __builtin_shufflevector(k1l, k1h, 0, 1, 2, 3, 4, 5, 6, 7)); \
        f32x16 p0 = __builtin_amdgcn_mfma_scale_f32_32x32x64_f8f6f4(kf0, qf, zero16, 0, 0, 0, 0x7a7b, 1, 0x7a7b); \
        f32x16 p1 = __builtin_amdgcn_mfma_scale_f32_32x32x64_f8f6f4(kf1, qf, zero16, 0, 0, 0, 0x7a7b, 1, 0x7a7b); \
        ATT_SB(); \
        float sacc = 0.f; \
        _Pragma("unroll") for (int r = 0; r < 16; ++r) { p0[r] = __builtin_amdgcn_exp2f(p0[r]); p1[r] = __builtin_amdgcn_exp2f(p1[r]); sacc += p0[r] + p1[r]; } \
        l_reg += sacc; \
        _Pragma("unroll") for (int q = 0; q < 4; ++q) { pw[0][q] = cvt_pk_bf16(p0[2 * q], p0[2 * q + 1]); pw[1][q] = cvt_pk_bf16(p0[8 + 2 * q], p0[8 + 2 * q + 1]); \
                                                        pw[2][q] = cvt_pk_bf16(p1[2 * q], p1[2 * q + 1]); pw[3][q] = cvt_pk_bf16(p1[8 + 2 * q], p1[8 + 2 * q + 1]); } } while (0)
#define ATT_VRD(buf, d) do { _Pragma("unroll") for (int ks = 0; ks < 4; ++ks) { buf[0][ks] = vtr(vp + (d) * 4096 + ks * 1024); buf[1][ks] = vtr(vp + (d) * 4096 + ks * 1024 + 512); } } while (0)
#define ATT_VMM(buf, d) do { _Pragma("unroll") for (int ks = 0; ks < 4; ++ks) { \
        const bf16x8 vf = (bf16x8){buf[0][ks][0], buf[0][ks][1], buf[0][ks][2], buf[0][ks][3], buf[1][ks][0], buf[1][ks][1], buf[1][ks][2], buf[1][ks][3]}; \
        o[d] = __builtin_amdgcn_mfma_f32_32x32x16_bf16(__builtin_bit_cast(bf16x8, pw[ks]), vf, o[d], 0, 0, 0); } } while (0)
#define ATT_PV(sl) do { if (MODE & 4) break; const lds_cptr vp = vp0 + (sl) * VSLOT; s16x4 va[2][4], vb[2][4]; \
        ATT_SB(); ATT_VRD(va, 0); ATT_SB(); ATT_VRD(vb, 1); ATT_SB(); ATT_VMM(va, 0); ATT_SB(); ATT_VRD(va, 2); ATT_SB(); ATT_VMM(vb, 1); ATT_SB(); \
        ATT_VRD(vb, 3); ATT_SB(); ATT_VMM(va, 2); ATT_SB(); ATT_VMM(vb, 3); ATT_SB(); } while (0)
#ifndef ATT_TWO_GROUP
#define ATT_TWO_GROUP 0
#endif
    int sk = 0, skm1 = 2;
    if (ATT_TWO_GROUP) {
        for (int k = 0; k <= NT; ++k) {
            if (k + 1 < NT) { ATT_WAIT_BAR(3); } else { ATT_WAIT_BAR(0); }
            if (k + 2 < NT) ATT_DMA_K(k + 2, skm1);
            if (grp == 0) { if (k <= cw) ATT_QKEXP(sk); }
            else          { if (k >= 1 && k - 1 <= cw) ATT_PV(skm1); }
            if (k == NT) break;
            if (k + 2 < NT) { ATT_WAIT_BAR(3); } else { ATT_WAIT_BAR(0); }
            if (k + 2 < NT) ATT_DMA_V(k + 2, skm1);
            if (grp == 0) { if (k <= cw) ATT_PV(sk); }
            else          { if (k <= cw) ATT_QKEXP(sk); }
            skm1 = sk; sk = (sk == 2) ? 0 : sk + 1;
        }
    } else {
        for (int k = 0; k < NT; ++k) {
            if (k + 1 < NT) { ATT_WAIT_BAR(3); } else { ATT_WAIT_BAR(0); }
            if (k + 2 < NT) { ATT_DMA_K(k + 2, skm1); ATT_DMA_V(k + 2, skm1); }
            if (k <= cw) { ATT_QKEXP(sk); ATT_PV(sk); }
            skm1 = sk; sk = (sk == 2) ? 0 : sk + 1;
        }
    }
#undef ATT_QKEXP
#undef ATT_PV
#undef ATT_VRD
#undef ATT_VMM
#undef ATT_SB
#undef ATT_DMA_K
#undef ATT_DMA_V
    { auto rr = __builtin_amdgcn_permlane32_swap(__float_as_uint(l_reg), __float_as_uint(l_reg), false, false); l_reg = __uint_as_float(rr[0]) + __uint_as_float(rr[1]); }
    LAS float* wsf = (LAS float*)(shm + LDS_WS) + wid * 64;
    if (hi == 0) wsf[r32] = l_reg;
    ATT_WAIT_BAR(0);
    float rli[16];
    const float scl = m ? lam : 1.0f;
#pragma unroll
    for (int r = 0; r < 16; ++r) rli[r] = scl * __builtin_amdgcn_rcpf(wsf[crow(r, hi)]);
    LAS float* stg = (LAS float*)shm + qg * (32 * STG_ROW);
    if (m == 1) {
#pragma unroll
        for (int r = 0; r < 16; ++r)
#pragma unroll
            for (int d = 0; d < 4; ++d) stg[crow(r, hi) * STG_ROW + d * 32 + r32] = o[d][r] * rli[r];
    }
    ATT_WAIT_BAR(0);
    if (m == 0) {
#pragma unroll
        for (int r = 0; r < 16; ++r)
#pragma unroll
            for (int d = 0; d < 4; ++d) { LAS float* p = stg + crow(r, hi) * STG_ROW + d * 32 + r32; *p = o[d][r] * rli[r] - *p; }
    }
    ATT_WAIT_BAR(0);
    {
        const int row = 16 * m + (lane >> 2), qt = lane & 3;
        const LAS float* p = stg + row * STG_ROW + qt * 32;
        f32x4 v[8]; float ss = 0.f;
#pragma unroll
        for (int i = 0; i < 8; ++i) { v[i] = *(const LAS f32x4*)(p + 4 * i); ss += (v[i][0] * v[i][0] + v[i][1] * v[i][1]) + (v[i][2] * v[i][2] + v[i][3] * v[i][3]); }
        ss += __shfl_xor(ss, 1); ss += __shfl_xor(ss, 2);
        const float rn = rsqrtf(ss * (1.f / 128.f) + EPS) * oml;
        bf16_t* dst = MIX + (rowbase + q0 + qg * 32 + row) * D + DS + h * 128 + qt * 32;
#pragma unroll
        for (int i = 0; i < 4; ++i) {
            const f32x4 g0 = *(const f32x4*)(subg + qt * 32 + 8 * i), g1 = *(const f32x4*)(subg + qt * 32 + 8 * i + 4);
            const f32x4 a = v[2 * i] * g0 * rn, c = v[2 * i + 1] * g1 * rn;
            u32x4 w; w.x = cvt_pk_bf16(a[0], a[1]); w.y = cvt_pk_bf16(a[2], a[3]); w.z = cvt_pk_bf16(c[0], c[1]); w.w = cvt_pk_bf16(c[2], c[3]);
            *(u32x4*)(dst + 8 * i) = w;
        }
    }
    ATT_WAIT_BAR(0);
#undef ATT_DMA
}
}
template <int MODE> __device__ __forceinline__ void attn_phase(Frame& F, int l) {
    const bf16_t* Q = (const bf16_t*)(F.ws + WS_Q); const bf16_t* K = (const bf16_t*)(F.ws + WS_K); const bf16_t* V = (const bf16_t*)(F.ws + WS_V);
    bf16_t* MIX = (bf16_t*)(F.ws + WS_MIX);
    const float* sc = (const float*)(F.ws + WS_SCAL) + l * 4;
    const float lam = sc[0], mshift = sc[1], oml = sc[2];
    const float* subg = arg_in(19) + l * DV;
    const int G = F.G;
#ifndef ATT_XA
#define ATT_XA 1
#endif
    const bool xa = ATT_XA && (G & 7) == 0;
    const int x = F.bx & 7, j = F.bx >> 3, wpx = xa ? (G >> 3) : 1;
    const int npair = xa ? (32 - j + wpx - 1) / wpx : 0;
    const int nit = xa ? 4 * npair : (1024 - F.bx + G - 1) / G;
#pragma unroll 1
    for (int it = 0; it < nit; ++it) {
        int bh, qb;
        if (xa) { const int r = it / (2 * npair), rem = it % (2 * npair), sidx = j + (rem >> 1) * wpx; bh = 2 * x + r; qb = (rem & 1) ? sidx : 63 - sidx; }
        else { const int v = F.bx + it * G; bh = v >> 6; qb = v & 63; }
        att::attn_unit<MODE>(bh, qb, Q, K, V, MIX, subg, lam, mshift, oml, F.lds + LDS_RING, F.tid);
    }
}

__device__ __forceinline__ void router_phase(Frame& F, int l) {
    const bf16_t* h1 = (const bf16_t*)(F.ws + WS_H1); const float* g = arg_in(21) + (size_t)l * D; const float* br = arg_in(23) + l * NE;
    const bf16_t* WRT = (const bf16_t*)(F.ws + WS_WRT + l * WRT_STRIDE);
    bf16_t* XN = (bf16_t*)(F.ws + WS_XN); int* TOPI = (int*)(F.ws + WS_TOPI); float* TOPG = (float*)(F.ws + WS_TOPG); int* WGCNT = (int*)(F.ws + WS_WGCNT); float* RS = (float*)(F.ws + WS_RS);
    const int lane = F.lane, tid = F.tid, wave = F.wave, n = lane & 15, kq = lane >> 4;
    constexpr int PITCH = 2080;
    LAS unsigned char* wl = F.lds + LDS_RING;
    LAS float* lg = (LAS float*)(F.lds + LDS_RING + 2 * 32 * PITCH) + wave * (16 * 33 + 16);
    LAS int* cnt = (LAS int*)(F.ctl + 256);
    __syncthreads();
    for (int i = tid; i < 2 * NE * 128; i += NTHREADS) { const int row = i >> 7, c = i & 127; *(LAS u32x4*)(wl + row * PITCH + c * 16) = *(const u32x4*)(WRT + (size_t)row * D + c * 8); }
    if (tid < 32) cnt[tid] = 0;
    __syncthreads();
    for (int wgu = F.bx; wgu < T / 128; wgu += F.G) {
        if (wgu != F.bx) { __syncthreads(); if (tid < 32) cnt[tid] = 0; __syncthreads(); }
        const int row = wgu * 128 + wave * 16 + n;
        const bf16_t* hp = h1 + (size_t)row * D + 8 * kq; const float* gp = g + 8 * kq;
        bf16_t* xp = XN + (size_t)row * D + 8 * kq; unsigned char* xp8 = (unsigned char*)XN + (size_t)row * D + 8 * kq;
        const LAS unsigned char* bh = wl + n * PITCH + 16 * kq;
        f32x4 acc0 = (f32x4){0.f, 0.f, 0.f, 0.f}, acc1 = acc0; float ss = 0.f;
#pragma unroll 4
        for (int ks = 0; ks < 32; ++ks) {
            const u32x4 hw = *(const u32x4*)(hp + 32 * ks); const f32x4 h0 = (f32x4){bf_lo(hw.x), bf_hi(hw.x), bf_lo(hw.y), bf_hi(hw.y)}, h4 = (f32x4){bf_lo(hw.z), bf_hi(hw.z), bf_lo(hw.w), bf_hi(hw.w)};
            const f32x4 g0 = *(const f32x4*)(gp + 32 * ks), g4 = *(const f32x4*)(gp + 32 * ks + 4);
            const f32x4 x0 = h0 * g0, x4 = h4 * g4;
            ss += (x0[0] * x0[0] + x0[1] * x0[1]) + (x0[2] * x0[2] + x0[3] * x0[3]) + (x4[0] * x4[0] + x4[1] * x4[1]) + (x4[2] * x4[2] + x4[3] * x4[3]);
            u32x4 hi; hi.x = cvt_pk_bf16(x0[0], x0[1]); hi.y = cvt_pk_bf16(x0[2], x0[3]); hi.z = cvt_pk_bf16(x4[0], x4[1]); hi.w = cvt_pk_bf16(x4[2], x4[3]);
            if (UP_FP8) { u32x2 w8; w8.x = pk4_fp8(x0[0] * 8.f, x0[1] * 8.f, x0[2] * 8.f, x0[3] * 8.f); w8.y = pk4_fp8(x4[0] * 8.f, x4[1] * 8.f, x4[2] * 8.f, x4[3] * 8.f); *(u32x2*)(xp8 + 32 * ks) = w8; }
            else *(u32x4*)(xp + 32 * ks) = hi;
            u32x4 lo;
            lo.x = cvt_pk_bf16(x0[0] - bf_lo(hi.x), x0[1] - bf_hi(hi.x)); lo.y = cvt_pk_bf16(x0[2] - bf_lo(hi.y), x0[3] - bf_hi(hi.y));
            lo.z = cvt_pk_bf16(x4[0] - bf_lo(hi.z), x4[1] - bf_hi(hi.z)); lo.w = cvt_pk_bf16(x4[2] - bf_lo(hi.w), x4[3] - bf_hi(hi.w));
            const bf16x8 ah = __builtin_bit_cast(bf16x8, hi), al = __builtin_bit_cast(bf16x8, lo);
            const bf16x8 b0h = *(const LAS bf16x8*)(bh + 64 * ks), b1h = *(const LAS bf16x8*)(bh + 16 * PITCH + 64 * ks);
            const bf16x8 b0l = *(const LAS bf16x8*)(bh + 32 * PITCH + 64 * ks), b1l = *(const LAS bf16x8*)(bh + 48 * PITCH + 64 * ks);
            acc0 = __builtin_amdgcn_mfma_f32_16x16x32_bf16(ah, b0h, acc0, 0, 0, 0); acc1 = __builtin_amdgcn_mfma_f32_16x16x32_bf16(ah, b1h, acc1, 0, 0, 0);
            acc0 = __builtin_amdgcn_mfma_f32_16x16x32_bf16(al, b0h, acc0, 0, 0, 0); acc1 = __builtin_amdgcn_mfma_f32_16x16x32_bf16(al, b1h, acc1, 0, 0, 0);
            acc0 = __builtin_amdgcn_mfma_f32_16x16x32_bf16(ah, b0l, acc0, 0, 0, 0); acc1 = __builtin_amdgcn_mfma_f32_16x16x32_bf16(ah, b1l, acc1, 0, 0, 0);
        }
        ss += __shfl_xor(ss, 16); ss += __shfl_xor(ss, 32);
        const float r = rsqrtf(ss * (1.f / D) + EPS);
        if (kq == 0) { lg[16 * 33 + n] = r; RS[row] = r; }
        asm volatile("s_waitcnt lgkmcnt(0)" ::: "memory");
        const float b0 = br[n], b1 = br[16 + n];
#pragma unroll
        for (int q = 0; q < 4; ++q) { const float rt = lg[16 * 33 + 4 * kq + q]; lg[(4 * kq + q) * 33 + n] = acc0[q] * rt + b0; lg[(4 * kq + q) * 33 + 16 + n] = acc1[q] * rt + b1; }
        asm volatile("s_waitcnt lgkmcnt(0)" ::: "memory");
        if (lane < 16) {
            const int tok = wgu * 128 + wave * 16 + lane;
            float v[32];
#pragma unroll
            for (int e = 0; e < 32; ++e) v[e] = lg[lane * 33 + e];
            unsigned mask = 0u; float val[4]; int sel[4];
#pragma unroll
            for (int k = 0; k < 4; ++k) { float best = -INFINITY; int bi = 0;
#pragma unroll
                for (int e = 0; e < 32; ++e) { const bool ok = !((mask >> e) & 1u) && (v[e] > best); best = ok ? v[e] : best; bi = ok ? e : bi; }
                mask |= 1u << bi; val[k] = best; sel[k] = bi; }
            float ex[4], sum = 0.f;
#pragma unroll
            for (int k = 0; k < 4; ++k) { ex[k] = __expf(val[k] - val[0]); sum += ex[k]; }
            const float inv = 1.f / sum;
#pragma unroll
            for (int k = 0; k < 4; ++k) { const int pos = __hip_atomic_fetch_add(cnt + sel[k], 1, __ATOMIC_RELAXED, __HIP_MEMORY_SCOPE_WORKGROUP);
                TOPI[tok * 4 + k] = sel[k] | (pos << 8); TOPG[tok * 4 + k] = ex[k] * inv; }
        }
        __syncthreads();
        if (tid < 32) WGCNT[wgu * 32 + tid] = cnt[tid];
    }
    __syncthreads();
}
__device__ __forceinline__ void routing_phase(Frame& F) {
    const int* TOPI = (const int*)(F.ws + WS_TOPI); const float* TOPG = (const float*)(F.ws + WS_TOPG); const int* WGCNT = (const int*)(F.ws + WS_WGCNT);
    int* TOKROW = (int*)(F.ws + WS_TOKROW); int* ROWTOK = (int*)(F.ws + WS_ROWTOK); float* ROWGATE = (float*)(F.ws + WS_ROWGATE); int* TILEEXP = (int*)(F.ws + WS_TILEEXP);
    float* ROWSCALE = (float*)(F.ws + WS_ROWSCALE); const float* RS = (const float*)(F.ws + WS_RS);
    const int tid = F.tid;
    LAS int* tot = (LAS int*)(F.lds + LDS_RING);
    LAS int* pst = tot + 32;
    LAS int* mypre = pst + 40;
    LAS int* part = mypre + 32;
    for (int wgu = F.bx; wgu < 256; wgu += F.G) {
        __syncthreads();
        {
            const int e = tid & 31, wq = tid >> 5; int a = 0, mine = 0;
#pragma unroll
            for (int j = 0; j < 16; ++j) { const int w = wq * 16 + j; const int c = WGCNT[w * 32 + e]; a += c; if (w < wgu) mine += c; }
            part[wq * 32 + e] = a; part[512 + wq * 32 + e] = mine;
        }
        __syncthreads();
        if (tid < 32) { int a = 0, mine = 0;
#pragma unroll
            for (int q = 0; q < 16; ++q) { a += part[q * 32 + tid]; mine += part[512 + q * 32 + tid]; }
            tot[tid] = a; mypre[tid] = mine; }
        __syncthreads();
        if (tid == 0) { int a = 0; for (int e = 0; e < 32; ++e) { pst[e] = a; a += (tot[e] + 255) & ~255; } pst[32] = a; }
        __syncthreads();
        {
            const int t = wgu * 128 + (tid >> 2), k = tid & 3;
            const int w = TOPI[t * 4 + k]; const int e = w & 255, pos = w >> 8;
            const int dest = pst[e] + mypre[e] + pos;
            ROWTOK[dest] = t; ROWGATE[dest] = TOPG[t * 4 + k]; ROWSCALE[dest] = RS[t]; TOKROW[t * 4 + k] = dest;
        }
        if (wgu < 32) {
            const int e = wgu; const int beg = pst[e] + tot[e], end = pst[e + 1];
            for (int r = beg + tid; r < end; r += NTHREADS) { ROWTOK[r] = 0; ROWGATE[r] = 0.f; ROWSCALE[r] = 0.f; }
        }
        if (wgu == 0) {
            const int ntiles = pst[32] >> 8;
            for (int pm = tid; pm < ntiles; pm += NTHREADS) { int e = 0; for (int q = 1; q < 32; ++q) if ((pm << 8) >= pst[q]) e = q; TILEEXP[pm] = e; }
            if (tid == 0) TILEEXP[1023] = ntiles;
            if (tid < 33) TILEEXP[768 + tid] = pst[tid];
        }
    }
    __syncthreads();
}
struct CRow { u32x4 h[2]; u32x2 y[4][2]; };
__device__ __forceinline__ void crow_load(CRow& r, const bf16_t* H1, const unsigned char* YB, const int* TOKROW, int m, int lane) {
    const bf16_t* hr = H1 + (size_t)m * D + 8 * lane;
    r.h[0] = *(const u32x4*)(hr); r.h[1] = *(const u32x4*)(hr + 512);
    const int4 tr = *(const int4*)(TOKROW + m * 4);
    const int rows[4] = {tr.x, tr.y, tr.z, tr.w};
#pragma unroll
    for (int k = 0; k < 4; ++k) { const unsigned char* yr = YB + (size_t)rows[k] * D + 8 * lane; r.y[k][0] = *(const u32x2*)(yr); r.y[k][1] = *(const u32x2*)(yr + 512); }
}
__device__ __forceinline__ void crow_finish(CRow& r, float* out32, bf16_t* H2, bf16_t* XN, const float* gnext, int m, int lane) {
    f32x4 v[4];
#pragma unroll
    for (int hf = 0; hf < 2; ++hf) { const u32x4 w = r.h[hf]; v[2 * hf] = (f32x4){bf_lo(w.x), bf_hi(w.x), bf_lo(w.y), bf_hi(w.y)}; v[2 * hf + 1] = (f32x4){bf_lo(w.z), bf_hi(w.z), bf_lo(w.w), bf_hi(w.w)}; }
#pragma unroll
    for (int k = 0; k < 4; ++k)
#pragma unroll
        for (int hf = 0; hf < 2; ++hf) { fp8x4_add(r.y[k][hf].x, 1.f / 16.f, v[2 * hf]); fp8x4_add(r.y[k][hf].y, 1.f / 16.f, v[2 * hf + 1]); }
    if (out32) { float* orow = out32 + (size_t)m * D + 8 * lane; *(f32x4*)(orow) = v[0]; *(f32x4*)(orow + 4) = v[1]; *(f32x4*)(orow + 512) = v[2]; *(f32x4*)(orow + 516) = v[3]; }
    else {
        u32x4 w; w.x = cvt_pk_bf16(v[0][0], v[0][1]); w.y = cvt_pk_bf16(v[0][2], v[0][3]); w.z = cvt_pk_bf16(v[1][0], v[1][1]); w.w = cvt_pk_bf16(v[1][2], v[1][3]);
        *(u32x4*)(H2 + (size_t)m * D + 8 * lane) = w;
        w.x = cvt_pk_bf16(v[2][0], v[2][1]); w.y = cvt_pk_bf16(v[2][2], v[2][3]); w.z = cvt_pk_bf16(v[3][0], v[3][1]); w.w = cvt_pk_bf16(v[3][2], v[3][3]);
        *(u32x4*)(H2 + (size_t)m * D + 512 + 8 * lane) = w;
    }
    if (gnext) {
        float s = 0.f;
#pragma unroll
        for (int j = 0; j < 4; ++j) s += (v[j][0] * v[j][0] + v[j][1] * v[j][1]) + (v[j][2] * v[j][2] + v[j][3] * v[j][3]);
        const float rr = rsqrtf(wave_sum(s) * (1.f / D) + EPS);
        const float* gp = gnext + 8 * lane;
        const f32x4 a0 = v[0] * *(const f32x4*)(gp) * rr, a1 = v[1] * *(const f32x4*)(gp + 4) * rr, a2 = v[2] * *(const f32x4*)(gp + 512) * rr, a3 = v[3] * *(const f32x4*)(gp + 516) * rr;
        u32x4 w; w.x = cvt_pk_bf16(a0[0], a0[1]); w.y = cvt_pk_bf16(a0[2], a0[3]); w.z = cvt_pk_bf16(a1[0], a1[1]); w.w = cvt_pk_bf16(a1[2], a1[3]);
        *(u32x4*)(XN + (size_t)m * D + 8 * lane) = w;
        w.x = cvt_pk_bf16(a2[0], a2[1]); w.y = cvt_pk_bf16(a2[2], a2[3]); w.z = cvt_pk_bf16(a3[0], a3[1]); w.w = cvt_pk_bf16(a3[2], a3[3]);
        *(u32x4*)(XN + (size_t)m * D + 512 + 8 * lane) = w;
    }
}
__device__ __forceinline__ void combine_phase(Frame& F, const float* gnext, float* out32) {
    const unsigned char* YB = (const unsigned char*)(F.ws + WS_YB); const int* TOKROW = (const int*)(F.ws + WS_TOKROW); bf16_t* XN = (bf16_t*)(F.ws + WS_XN);
    const bf16_t* H1 = (const bf16_t*)(F.ws + WS_H1); bf16_t* H2 = (bf16_t*)(F.ws + WS_H2);
    const int lane = F.lane, NGW = F.G * NWAVES;
    CRow ra, rb;
    int m = F.bx * NWAVES + F.wave;
    if (m < T) crow_load(ra, H1, YB, TOKROW, m, lane);
    while (m < T) {
        const int mb = m + NGW;
        if (mb < T) crow_load(rb, H1, YB, TOKROW, mb, lane);
        crow_finish(ra, out32, H2, XN, gnext, m, lane);
        if (mb >= T) break;
        const int mc = mb + NGW;
        if (mc < T) crow_load(ra, H1, YB, TOKROW, mc, lane);
        crow_finish(rb, out32, H2, XN, gnext, mb, lane);
        m = mc;
    }
}

constexpr int NPH_LAYER = 10, NPH = 1 + DEPTH * NPH_LAYER;
__global__ void __launch_bounds__(NTHREADS, 2) mk_fwd(Args args) {
    extern __shared__ __attribute__((aligned(16))) unsigned char lds_raw[];
    Frame F;
    F.lds = (LAS unsigned char*)lds_raw; F.ctl = F.lds + LDS_CTL; F.ws = args.ws; F.ws0 = args.ws; F.out0 = args.out; F.ap = &args; F.z = 0;
    F.tid = threadIdx.x; F.lane = F.tid & 63; F.wave = __builtin_amdgcn_readfirstlane(F.tid >> 6); F.G = gridDim.x; F.bx = blockIdx.x;
    F.out = args.out;
    for (int u = F.tid; u < 1024; u += NTHREADS) ((LAS unsigned*)F.ctl)[u] = 0u;
    __syncthreads();
    XcdBarrier bar = xcd_barrier_post((unsigned*)(F.ws + WS_CTL) + CW_BAR, (volatile LAS unsigned*)F.ctl);
    const int lo = args.ph_lo, hi = args.ph_hi;
#ifndef PHMASK
#define PHMASK 0x1fff
#endif
#define RUN(k) (lo <= (k) && (k) < hi)
#define EN(b) ((PHMASK >> (b)) & 1)
#ifndef DUPMASK
#define DUPMASK 0
#endif
#ifndef ATT_PROBE_MODE
#define ATT_PROBE_MODE 0
#endif
#ifndef PRO_PROBE_MODE
#define PRO_PROBE_MODE 0
#endif
#define NREP(b) (((DUPMASK >> (b)) & 1) ? 2 : 1)
#define SEAM(k) do { if (RUN((k) + 1)) xcd_barrier(bar); } while (0)
    if (EN(10) && RUN(0)) { { if (NREP(10) == 2) { phase_begin(F); p0_prologue<PRO_PROBE_MODE>(F); xcd_barrier(bar); } phase_begin(F); p0_prologue<0>(F); } SEAM(0); }
    for (int l = 0; l < DEPTH; ++l) {
        const int pb = 1 + l * NPH_LAYER;
        if (EN(0) && RUN(pb + 0)) { for (int rep = 0; rep < NREP(0); ++rep) { phase_begin(F); unsigned char* ws = F.ws; (void)ws;
            PInProj P; P.so.init(T, DIN, F.G, F.bx); P.A = (const char*)(ws + WS_XN); P.B = (const char*)(ws + WS_WIN + l * WIN_STRIDE);
            P.UQKV = (bf16_t*)(ws + WS_U); P.GQK = (const float*)(ws + WS_SCAL) + 64 + l * 128; P.COS = (const float*)(ws + WS_COS); P.SIN = (const float*)(ws + WS_SIN);
            pg8::gemm_phase(F.lds + LDS_RING, F.ctl, P, F.tid);  if (rep + 1 < NREP(0)) xcd_barrier(bar); } SEAM(pb + 0);
        }
        if (EN(1) && RUN(pb + 1)) { for (int rep = 0; rep < NREP(1); ++rep) { phase_begin(F); unsigned char* ws = F.ws; (void)ws; s5a_phase(F, l);  if (rep + 1 < NREP(1)) xcd_barrier(bar); } SEAM(pb + 1); }
        if (EN(2) && RUN(pb + 2)) { for (int rep = 0; rep < NREP(2); ++rep) { phase_begin(F); unsigned char* ws = F.ws; (void)ws; if (EN(11)) for (int r2 = 0; r2 < NREP(11); ++r2) { phase_begin(F); s5c_phase(F, l); } if (EN(12)) { if (NREP(12) == 2) { phase_begin(F); attn_phase<ATT_PROBE_MODE>(F, l); } phase_begin(F); attn_phase<0>(F, l); }  if (rep + 1 < NREP(2)) xcd_barrier(bar); } SEAM(pb + 2); }
        if (EN(3) && RUN(pb + 3)) { for (int rep = 0; rep < NREP(3); ++rep) { phase_begin(F); unsigned char* ws = F.ws; (void)ws;
            PGlu P; P.so.init(T, DS, F.G, F.bx); P.A = (const char*)(ws + WS_YG); P.B = (const char*)(ws + WS_WGLU + l * WGLU_STRIDE);
            P.YG = (const bf16_t*)(ws + WS_YG); P.MIX = (bf16_t*)(ws + WS_MIX); P.RSP = (float*)(ws + WS_RSP);
            pg8::gemm_phase(F.lds + LDS_RING, F.ctl, P, F.tid);  if (rep + 1 < NREP(3)) xcd_barrier(bar); } SEAM(pb + 3);
        }
        if (EN(4) && RUN(pb + 4)) { for (int rep = 0; rep < NREP(4); ++rep) { phase_begin(F); unsigned char* ws = F.ws; (void)ws;
            POut P; P.so.init(T, D, F.G, F.bx); P.A = (const char*)(ws + WS_MIX); P.B = (const char*)(ws + WS_WOUT + l * WOUT_STRIDE);
            P.RSP = (const float*)(ws + WS_RSP); P.base32 = (l == 0) ? arg_in(0) : nullptr; P.base16 = (const bf16_t*)(ws + WS_H2); P.H1 = (bf16_t*)(ws + WS_H1);
            pg8::gemm_phase(F.lds + LDS_RING, F.ctl, P, F.tid);  if (rep + 1 < NREP(4)) xcd_barrier(bar); } SEAM(pb + 4);
        }
        if (EN(5) && RUN(pb + 5)) { for (int rep = 0; rep < NREP(5); ++rep) { phase_begin(F); unsigned char* ws = F.ws; (void)ws; router_phase(F, l);  if (rep + 1 < NREP(5)) xcd_barrier(bar); } SEAM(pb + 5); }
        if (EN(6) && RUN(pb + 6)) { for (int rep = 0; rep < NREP(6); ++rep) { phase_begin(F); unsigned char* ws = F.ws; (void)ws; routing_phase(F);  if (rep + 1 < NREP(6)) xcd_barrier(bar); } SEAM(pb + 6); }
        if (EN(7) && RUN(pb + 7)) { for (int rep = 0; rep < NREP(7); ++rep) { phase_begin(F); unsigned char* ws = F.ws; (void)ws;
            PUp P; P.mo.init(F.G, F.bx, (const int*)(ws + WS_TILEEXP) + 768);
            P.A = (const char*)(ws + WS_XN); P.B = (const char*)(ws + WS_WUP + l * WUP_STRIDE); P.ROWTOK = (const int*)(ws + WS_ROWTOK); P.TILEEXP = (const int*)(ws + WS_TILEEXP);
            P.bup = arg_in(25) + (size_t)l * NE * 2048; P.ROWSCALE = (const float*)(ws + WS_ROWSCALE); P.ACT = (bf16_t*)(ws + WS_ACT);
            pg8::gemm_phase(F.lds + LDS_RING, F.ctl, P, F.tid);  if (rep + 1 < NREP(7)) xcd_barrier(bar); } SEAM(pb + 7);
        }
        if (EN(8) && RUN(pb + 8)) { for (int rep = 0; rep < NREP(8); ++rep) { phase_begin(F); unsigned char* ws = F.ws; (void)ws;
            PDown P; P.mo.init(F.G, F.bx, (const int*)(ws + WS_TILEEXP) + 768);
            P.A = (const char*)(ws + WS_ACT); P.B = (const char*)(ws + WS_WDN + l * WDN_STRIDE); P.TILEEXP = (const int*)(ws + WS_TILEEXP);
            P.bdn = arg_in(27) + (size_t)l * NE * 1024; P.ROWGATE = (const float*)(ws + WS_ROWGATE); P.YB = (bf16_t*)(ws + WS_YB);
            pg8::gemm_phase(F.lds + LDS_RING, F.ctl, P, F.tid);  if (rep + 1 < NREP(8)) xcd_barrier(bar); } SEAM(pb + 8);
        }
        if (EN(9) && RUN(pb + 9)) { for (int rep = 0; rep < NREP(9); ++rep) { phase_begin(F); unsigned char* ws = F.ws; (void)ws; combine_phase(F, (l + 1 < DEPTH) ? arg_in(1) + (size_t)(l + 1) * D : nullptr, (l + 1 < DEPTH) ? nullptr : F.out);  if (rep + 1 < NREP(9)) xcd_barrier(bar); } SEAM(pb + 9); }
    }
#undef RUN
#undef SEAM
}

extern "C" void kernel_launch(void* const* d_in, const int* in_sizes, int n_in, void* d_out, int out_size, void* d_ws, size_t ws_size, hipStream_t stream) {
    static int grid = 0;
    if (grid == 0) {
        if (n_in != 28 || out_size != T * D || ws_size < WS_END) { fprintf(stderr, "kernel_launch: unexpected shapes (n_in %d out %d ws %zu)\n", n_in, out_size, ws_size); grid = -1; return; }
        int dev = 0, cus = 0;
        if (hipGetDevice(&dev) != hipSuccess || hipDeviceGetAttribute(&cus, hipDeviceAttributeMultiprocessorCount, dev) != hipSuccess) { grid = -1; return; }
        if (hipFuncSetAttribute((const void*)mk_fwd, hipFuncAttributeMaxDynamicSharedMemorySize, LDS_BYTES) != hipSuccess) { fprintf(stderr, "kernel_launch: hipFuncSetAttribute failed\n"); grid = -1; return; }
        int per_cu = 0;
        if (hipOccupancyMaxActiveBlocksPerMultiprocessor(&per_cu, (const void*)mk_fwd, NTHREADS, LDS_BYTES) != hipSuccess || per_cu < 1) { fprintf(stderr, "kernel_launch: occupancy query says %d\n", per_cu); }
        (void)hipGetLastError();
        grid = cus;
    }
    if (grid < 0) return;
    if (hipMemsetAsync((char*)d_ws + WS_CTL, 0, CTL_ZERO_BYTES, stream) != hipSuccess) return;
    Args a{};
    for (int i = 0; i < 28; ++i) a.in[i] = (const float*)d_in[i];
    a.out = (float*)d_out; a.ws = (unsigned char*)d_ws; a.ph_lo = 0; a.ph_hi = NPH;
    hipLaunchKernelGGL(mk_fwd, dim3(grid), dim3(NTHREADS), LDS_BYTES, stream, a);
}
```

```cpp
#include <hip/hip_runtime.h>
#include <cstdio>
#include <cstdint>
#include <math.h>

#ifndef UP_FP8
#define UP_FP8 1
#endif
#ifndef DN_FP8
#define DN_FP8 1
#endif
#define LAS __attribute__((address_space(3)))
#define GAS __attribute__((address_space(1)))
typedef unsigned short bf16_t;
typedef short bf16x8 __attribute__((ext_vector_type(8)));
typedef short s16x4 __attribute__((ext_vector_type(4)));
typedef float f32x4 __attribute__((ext_vector_type(4)));
typedef float f32x2 __attribute__((ext_vector_type(2)));
typedef float f32x16 __attribute__((ext_vector_type(16)));
typedef unsigned u32x4 __attribute__((ext_vector_type(4)));
typedef unsigned u32x2 __attribute__((ext_vector_type(2)));
typedef int v8i32 __attribute__((ext_vector_type(8)));

constexpr int D = 1024, BATCH = 4, SEQ = 8192, DEPTH = 2, T = BATCH * SEQ;
constexpr int DS = 512, NG = 32, HS = 16, NP = 64, DA = 512, NH = 4, DV = 128, DIN = 2048;
constexpr int NE = 32, DFF = 1024, NASSIGN = T * 4;
constexpr int MPAD_MAX = NASSIGN + NE * 256, NTILE_MAX = MPAD_MAX / 256;
constexpr int NCHUNK = T / 64, CPB = SEQ / 64;
constexpr float EPS = 1e-6f;
constexpr float C2 = 0.125f * 1.4426950408889634f;
constexpr int NWAVES = 8, NTHREADS = 512;

constexpr size_t MiB = 1u << 20;
constexpr size_t WS_CTL = 0, CTL_ZERO_BYTES = 1 * MiB;
constexpr size_t WS_COS = 1 * MiB, WS_SIN = 2 * MiB;
constexpr size_t WS_SCAL = 3 * MiB;
constexpr size_t WS_KT = 4 * MiB, KT_STRIDE = 2 * MiB;
constexpr size_t WS_LAML = 8 * MiB, LAML_STRIDE = 32768;
constexpr size_t WS_WRT = 9 * MiB, WRT_STRIDE = 131072;
constexpr size_t WS_RS = 10 * MiB;
constexpr size_t WS_GT = 16 * MiB, GT_STRIDE = 8 * MiB;
constexpr size_t WS_HT = 32 * MiB, HT_STRIDE = 8 * MiB;
constexpr size_t WS_WIN = 48 * MiB, WIN_STRIDE = 4 * MiB;
constexpr size_t WS_WGLU = 56 * MiB, WGLU_STRIDE = MiB / 2;
constexpr size_t WS_WOUT = 58 * MiB, WOUT_STRIDE = 2 * MiB;
constexpr size_t WS_WUP = 64 * MiB, WUP_STRIDE = 128 * MiB;
constexpr size_t WS_WDN = 320 * MiB, WDN_STRIDE = 64 * MiB;
constexpr size_t WS_XN = 448 * MiB;
constexpr size_t WS_U = 512 * MiB, WS_Q = 544 * MiB, WS_K = 576 * MiB, WS_V = 608 * MiB;
constexpr size_t WS_YG = 640 * MiB;
constexpr size_t WS_MIX = 672 * MiB;
constexpr size_t WS_S = 736 * MiB;
constexpr size_t WS_RSP = 744 * MiB;
constexpr size_t WS_TOPI = 746 * MiB, WS_TOPG = 747 * MiB, WS_TOKROW = 748 * MiB, WS_WGCNT = 749 * MiB;
constexpr size_t WS_ROWTOK = 750 * MiB, WS_ROWGATE = 751 * MiB, WS_TILEEXP = 752 * MiB, WS_ROWSCALE = 753 * MiB;
constexpr size_t WS_ACT = 768 * MiB, WS_YB = 1040 * MiB, WS_H1 = 1180 * MiB, WS_H2 = 1244 * MiB, WS_END = 1312 * MiB;
constexpr int CW_BAR = 4096;

constexpr int LDS_CTL = 0;
constexpr int LDS_RING = 4096;
constexpr int LDS_BYTES = 163840;

__device__ __forceinline__ unsigned f2bf(float f) { unsigned u = __builtin_bit_cast(unsigned, f); return (u + 0x7fffu + ((u >> 16) & 1u)) >> 16; }
__device__ __forceinline__ unsigned pk2(float lo, float hi) { return f2bf(lo) | (f2bf(hi) << 16); }
__device__ __forceinline__ unsigned cvt_pk_bf16(float lo, float hi) { unsigned r; asm volatile("v_cvt_pk_bf16_f32 %0, %1, %2" : "=v"(r) : "v"(lo), "v"(hi)); return r; }
__device__ __forceinline__ unsigned pk4_fp8(float a, float b, float c, float d) { int w = 0; w = __builtin_amdgcn_cvt_pk_fp8_f32(a, b, w, false); w = __builtin_amdgcn_cvt_pk_fp8_f32(c, d, w, true); return (unsigned)w; }
__device__ __forceinline__ void fp8x4_add(unsigned w, float sc, f32x4& a) { const f32x2 lo = __builtin_amdgcn_cvt_pk_f32_fp8((int)w, false), hi = __builtin_amdgcn_cvt_pk_f32_fp8((int)w, true); a[0] += lo[0] * sc; a[1] += lo[1] * sc; a[2] += hi[0] * sc; a[3] += hi[1] * sc; }
__device__ __forceinline__ float bf_lo(unsigned w) { return __builtin_bit_cast(float, w << 16); }
__device__ __forceinline__ float bf_hi(unsigned w) { return __builtin_bit_cast(float, w & 0xffff0000u); }
__device__ __forceinline__ float wave_sum(float v) {
#pragma unroll
    for (int o = 1; o < 64; o <<= 1) v += __shfl_xor(v, o);
    return v;
}
__device__ __forceinline__ float gelu_tanh(float x) {
    const float z = 0.7978845608028654f * (x + 0.044715f * x * x * x);
    return x / (1.f + __expf(-2.f * z));
}
__device__ __forceinline__ float sigmoidf(float v) { return 1.f / (1.f + __expf(-v)); }

#define XB_TMO      128
#define XB_XCNT(j)  (256  + 64 * (j))
#define XB_XSUB(j)  (1280 + 64 * (j))
#define XB_XGEN(j)  (2304 + 64 * (j))
#define XB_TOP      3328
#define XB_TOPGEN   3392
#define XCD_BAR_WORDS 3456
#define XB_SPIN_CAP (1u << 18)
__device__ __forceinline__ unsigned xb_ld(unsigned* p)              { return __hip_atomic_load(p, __ATOMIC_RELAXED, __HIP_MEMORY_SCOPE_AGENT); }
__device__ __forceinline__ unsigned xb_add(unsigned* p, unsigned v) { return __hip_atomic_fetch_add(p, v, __ATOMIC_RELAXED, __HIP_MEMORY_SCOPE_AGENT); }
__device__ __forceinline__ unsigned xb_xcc_id() { return (unsigned)__builtin_amdgcn_s_getreg((3 << 11) | 20) & 0xFu; }
#define XB_SPIN(cond, bar) do { unsigned _sp = 0; while (cond) { __builtin_amdgcn_s_sleep(1); \
    if ((++_sp & 255u) == 0u) { if (xb_ld(&(bar)[XB_TMO])) break; if (_sp > XB_SPIN_CAP) { atomicAdd(&(bar)[XB_TMO], 1u); break; } } } } while (0)
struct XcdBarrier { unsigned* bar; unsigned x; volatile LAS unsigned* st; };
__device__ __forceinline__ XcdBarrier xcd_barrier_post(unsigned* bar, volatile LAS unsigned* st) {
    XcdBarrier b; b.bar = bar; b.x = xb_xcc_id(); b.st = st;
    if (threadIdx.x == 0) (void)xb_add(&bar[XB_XCNT(b.x)], 1u);
    return b;
}
__device__ __forceinline__ void xcd_barrier_complete(unsigned* bar, unsigned x, unsigned& nloc, unsigned& nx) {
    const unsigned G = gridDim.x * gridDim.y * gridDim.z;
    unsigned sum, cnt, mine, sp = 0u;
    for (;;) {
        sum = 0u; cnt = 0u; mine = 0u;
#pragma unroll
        for (unsigned j = 0; j < 16; ++j) { const unsigned c = xb_ld(&bar[XB_XCNT(j)]); sum += c; cnt += (c > 0u) ? 1u : 0u; mine = (j == x) ? c : mine; }
        if (sum == G) break;
        __builtin_amdgcn_s_sleep(1);
        if ((++sp & 255u) == 0u) { if (xb_ld(&bar[XB_TMO])) break; if (sp > XB_SPIN_CAP) { atomicAdd(&bar[XB_TMO], 1u); break; } }
    }
    nloc = mine > 0u ? mine : 1u; nx = cnt > 0u ? cnt : 1u;
}
__device__ __forceinline__ void xcd_barrier(const XcdBarrier& b) {
    asm volatile("s_waitcnt vmcnt(0)" ::: "memory");
    __syncthreads();
    if (threadIdx.x == 0) {
        unsigned* bar = b.bar;
        __builtin_amdgcn_s_waitcnt(0);
        unsigned nloc = b.st[0], nx = b.st[1];
        if (nloc == 0u) { xcd_barrier_complete(bar, b.x, nloc, nx); b.st[0] = nloc; b.st[1] = nx; }
        const unsigned old = xb_add(&bar[XB_XSUB(b.x)], 1u);
        const unsigned gen = old / nloc;
        if (old + 1u == (gen + 1u) * nloc) {
            __builtin_amdgcn_fence(__ATOMIC_RELEASE, "agent");
            asm volatile("s_waitcnt vmcnt(0)" ::: "memory");
            const unsigned og = xb_add(&bar[XB_TOP], 1u);
            const unsigned tg = og / nx;
            if (og + 1u == (tg + 1u) * nx) xb_add(&bar[XB_TOPGEN], 1u);
            else XB_SPIN(xb_ld(&bar[XB_TOPGEN]) == tg, bar);
            __builtin_amdgcn_fence(__ATOMIC_ACQUIRE, "agent");
            xb_add(&bar[XB_XGEN(b.x)], 1u);
            asm volatile("s_waitcnt vmcnt(0)" ::: "memory");
        } else {
            XB_SPIN(xb_ld(&bar[XB_XGEN(b.x)]) == gen, bar);
            __builtin_amdgcn_fence(__ATOMIC_ACQUIRE, "agent");
            asm volatile("s_waitcnt vmcnt(0)" ::: "memory");
        }
    }
    __syncthreads();
}

namespace pg8 {
constexpr int BM = 256, BK = 64, HALF = 128, HTB = HALF * BK * 2, STAGE_BYTES = 8 * HTB;
__host__ __device__ __forceinline__ int lds_byte(int r, int c) { const int st = (r >> 4) * 2 + (c >> 5), rr = r & 15, cc = c & 31, ob = rr * 64 + cc * 2; return st * 1024 + (ob ^ (((ob >> 9) & 1) << 5)); }
__host__ __device__ __forceinline__ void stage_rc(int b, int& R, int& C) { const int st = b / 1024, sb = b % 1024, swz = sb ^ (((sb >> 9) & 1) << 5); R = (st >> 1) * 16 + swz / 64; C = (st & 1) * 32 + (swz % 64) / 2; }
__host__ __device__ __forceinline__ int perm32(int rho) { const int n = rho >> 4, i = rho & 15; return 8 * (i >> 2) + 4 * n + (i & 3); }

struct Unit { int pm, pn; };
template <class P>
__device__ __forceinline__ void gemm_phase(LAS unsigned char* lds, LAS unsigned char* ldsctl, P& S, const int tid) {
    const int wid = __builtin_amdgcn_readfirstlane(tid >> 6), lane = tid & 63, wr = wid >> 2, wc = wid & 3, fr = lane & 15, fq = lane >> 4;
    constexpr bool F8 = P::FP8;
    constexpr int K = P::K, ES = F8 ? 1 : 2, nt = K * ES / 128;
    int R0, C0, R1, C1; stage_rc(tid * 16, R0, C0); stage_rc(tid * 16 + 8192, R1, C1);
    unsigned voffB[2];
    {
        const int Rb0 = P::BROW64 ? (64 * (R0 >> 5) + perm32(R0 & 31)) : ((R0 & ~31) + perm32(R0 & 31));
        const int Rb1 = P::BROW64 ? (64 * (R1 >> 5) + perm32(R1 & 31)) : ((R1 & ~31) + perm32(R1 & 31));
        voffB[0] = (unsigned)(Rb0 * K * ES + 2 * C0); voffB[1] = (unsigned)(Rb1 * K * ES + 2 * C1);
    }
    const unsigned ldsw = (unsigned)wid * 1024u;
    const int scl8 = P::SCALE_AB;
    const int aoff = lds_byte(wr * 64 + fr, fq * 8), boff = lds_byte(wc * 32 + fr, fq * 8);
#define PG8_SA(b, h) (((b) * 2 + (h)) * HTB)
#define PG8_SB(b, h) ((4 + (b) * 2 + (h)) * HTB)
    const unsigned ldsbase = (unsigned)__builtin_amdgcn_readfirstlane((int)(unsigned)(uintptr_t)lds + (int)ldsw);
#define PG8_GLDS(sbase, voff, ldsdst) do { if (P::NODMA) break; unsigned _keep; asm volatile("s_mov_b32 %0, m0\n\ts_mov_b32 m0, %3\n\ts_nop 0\n\tglobal_load_lds_dwordx4 %2, %1\n\ts_mov_b32 m0, %0" \
        : "=&s"(_keep) : "s"(sbase), "v"(voff), "s"(ldsdst) : "memory"); } while (0)
#define PG8_STAGE_A(bufoff, vo, h, kofs) do { _Pragma("unroll") for (int _i = 0; _i < 2; ++_i) \
        PG8_GLDS(Abase, (vo)[P::GATHER ? (h) : 0][_i] + ((kofs) + (P::GATHER ? 0u : (unsigned)(h) * HSTEPA)), ldsbase + (unsigned)((bufoff) + _i * 8192)); } while (0)
#define PG8_STAGE_B(bufoff, gbase) do { _Pragma("unroll") for (int _i = 0; _i < 2; ++_i) \
        PG8_GLDS((const char*)(gbase), voffB[_i], ldsbase + (unsigned)((bufoff) + _i * 8192)); } while (0)
#define PG8_LDA(dst, b, h) do { if constexpr (F8) { _Pragma("unroll") for (int m = 0; m < 4; ++m) { const u32x4 _l = *(const LAS u32x4*)(lds + PG8_SA(b, h) + aoff + m * 2048), _h = *(const LAS u32x4*)(lds + PG8_SA(b, h) + aoff + m * 2048 + 1024); dst##8[m] = __builtin_bit_cast(v8i32, __builtin_shufflevector(_l, _h, 0, 1, 2, 3, 4, 5, 6, 7)); } } \
        else { _Pragma("unroll") for (int m = 0; m < 4; ++m) _Pragma("unroll") for (int k = 0; k < 2; ++k) dst[m][k] = *(const LAS bf16x8*)(lds + PG8_SA(b, h) + aoff + m * 2048 + k * 1024); } } while (0)
#define PG8_LDB(dst, b, h) do { if constexpr (F8) { _Pragma("unroll") for (int n = 0; n < 2; ++n) { const u32x4 _l = *(const LAS u32x4*)(lds + PG8_SB(b, h) + boff + n * 2048), _h = *(const LAS u32x4*)(lds + PG8_SB(b, h) + boff + n * 2048 + 1024); dst##8[n] = __builtin_bit_cast(v8i32, __builtin_shufflevector(_l, _h, 0, 1, 2, 3, 4, 5, 6, 7)); } } \
        else { _Pragma("unroll") for (int n = 0; n < 2; ++n) _Pragma("unroll") for (int k = 0; k < 2; ++k) dst[n][k] = *(const LAS bf16x8*)(lds + PG8_SB(b, h) + boff + n * 2048 + k * 1024); } } while (0)
#define PG8_MMA(ai, bj, At, Bt) do { __builtin_amdgcn_s_setprio(1); \
        if constexpr (F8) { _Pragma("unroll") for (int m = 0; m < 4; ++m) _Pragma("unroll") for (int n = 0; n < 2; ++n) \
            asm volatile("v_mfma_scale_f32_16x16x128_f8f6f4 %0, %1, %2, %0, %3, %3 op_sel:[0,1,0] op_sel_hi:[0,0,0]" : "+v"(acc[ai][bj][m][n]) : "v"(Bt##8[n]), "v"(At##8[m]), "v"(scl8)); } \
        else { _Pragma("unroll") for (int m = 0; m < 4; ++m) _Pragma("unroll") for (int n = 0; n < 2; ++n) _Pragma("unroll") for (int k = 0; k < 2; ++k) \
            acc[ai][bj][m][n] = __builtin_amdgcn_mfma_f32_16x16x32_bf16(Bt[n][k], At[m][k], acc[ai][bj][m][n], 0, 0, 0); } \
        __builtin_amdgcn_s_setprio(0); } while (0)
#define PG8_WAIT_V(n) asm volatile("s_waitcnt vmcnt(" #n ")" ::: "memory")
#define PG8_WAIT_L(n) asm volatile("s_waitcnt lgkmcnt(" #n ")" ::: "memory")
#define PG8_BAR __builtin_amdgcn_s_barrier()
#define PG8_SCHED __builtin_amdgcn_sched_barrier(0)
    Unit cur, nxt; int ui = 0;
    if (!S.next(0, cur)) return;
    f32x4 acc[2][2][4][2];
#pragma unroll
    for (int a = 0; a < 2; ++a)
#pragma unroll
        for (int b = 0; b < 2; ++b)
#pragma unroll
            for (int m = 0; m < 4; ++m)
#pragma unroll
                for (int n = 0; n < 2; ++n) acc[a][b][m][n] = (f32x4){0.f, 0.f, 0.f, 0.f};
    bf16x8 At[4][2], B0[2][2], B1[2][2]; v8i32 At8[4], B08[2], B18[2];
    const char* const Abase = S.a_base();
    unsigned voffA[2][2], voffAn[2][2];
    const char *cB0, *cB1;
    S.unit_begin(cur, ldsctl, tid, 0);
    S.a_offs(cur, R0, C0, R1, C1, voffA, true);
    asm volatile("" ::: "memory");
    S.b_ptrs(cur, cB0, cB1);
    constexpr unsigned kstep = 128, HSTEPA = (unsigned)HALF * K * ES;
    PG8_STAGE_B(PG8_SB(0, 0), cB0); PG8_STAGE_B(PG8_SB(0, 1), cB1); PG8_STAGE_A(PG8_SA(0, 0), voffA, 0, 0u); PG8_STAGE_A(PG8_SA(0, 1), voffA, 1, 0u);
    if (wr == 1) PG8_BAR;
    PG8_WAIT_V(2); PG8_BAR;
    PG8_STAGE_B(PG8_SB(1, 0), cB0 + kstep); PG8_STAGE_A(PG8_SA(1, 0), voffA, 0, kstep); PG8_STAGE_B(PG8_SB(1, 1), cB1 + kstep);
    PG8_WAIT_V(6); PG8_BAR;
    for (;;) {
        const bool has_next = S.next(ui + 1, nxt);
        const char *nB0 = cB0, *nB1 = cB1;
        if constexpr (P::GATHER) {
#pragma unroll
            for (int h = 0; h < 2; ++h)
#pragma unroll
                for (int i = 0; i < 2; ++i) voffAn[h][i] = voffA[h][i];
        }
        if (has_next) { S.unit_begin(nxt, ldsctl, tid, (ui + 1) & 1); S.b_ptrs(nxt, nB0, nB1);
            if constexpr (P::GATHER) { int t2 = tid; asm volatile("" : "+v"(t2)); int r0, c0, r1, c1; stage_rc(t2 * 16, r0, c0); stage_rc(t2 * 16 + 8192, r1, c1); S.a_offs(nxt, r0, c0, r1, c1, voffAn, false); } }
#pragma unroll 1
        for (int t = 0; t < nt; t += 2) {
            const bool last = (t == nt - 2);
            S.midk(acc, cur, t, wr, fr, ldsctl, ui & 1);
            unsigned a2o[2][2];
            if constexpr (!P::GATHER) { if (last) { int t2 = tid; asm volatile("" : "+v"(t2)); int r0, c0, r1, c1; stage_rc(t2 * 16, r0, c0); stage_rc(t2 * 16 + 8192, r1, c1);
                                                   S.a_offs(has_next ? nxt : cur, r0, c0, r1, c1, voffAn, false); } }
#pragma unroll
            for (int h = 0; h < 2; ++h)
#pragma unroll
                for (int i = 0; i < 2; ++i) a2o[h][i] = last ? voffAn[h][i] : voffA[h][i] + (unsigned)(t + 2) * kstep;
            const char* b2h0 = last ? nB0 : cB0 + (size_t)(t + 2) * kstep; const char* b2h1 = last ? nB1 : cB1 + (size_t)(t + 2) * kstep;
            const unsigned a1k = (unsigned)(t + 1) * kstep;
            PG8_LDB(B0, 0, 0); PG8_LDB(B1, 0, 1); PG8_SCHED; PG8_LDA(At, 0, 0); PG8_STAGE_A(PG8_SA(1, 1), voffA, 1, a1k);
            PG8_WAIT_V(8); PG8_WAIT_L(0); PG8_BAR; PG8_MMA(0, 0, At, B0); PG8_MMA(0, 1, At, B1); PG8_BAR; PG8_SCHED;
            PG8_LDA(At, 0, 1); PG8_STAGE_B(PG8_SB(0, 0), b2h0); PG8_STAGE_B(PG8_SB(0, 1), b2h1); PG8_STAGE_A(PG8_SA(0, 0), a2o, 0, 0u);
            PG8_WAIT_V(8); PG8_WAIT_L(0); PG8_BAR; PG8_MMA(1, 0, At, B0); PG8_MMA(1, 1, At, B1); PG8_BAR; PG8_SCHED;
            PG8_LDB(B0, 1, 0); PG8_LDB(B1, 1, 1); PG8_SCHED; PG8_LDA(At, 1, 0); PG8_STAGE_A(PG8_SA(0, 1), a2o, 1, 0u);
            PG8_WAIT_V(8); PG8_WAIT_L(0); PG8_BAR; PG8_MMA(0, 0, At, B0); PG8_MMA(0, 1, At, B1); PG8_BAR; PG8_SCHED;
            PG8_LDA(At, 1, 1); PG8_STAGE_B(PG8_SB(1, 0), b2h0 + kstep); PG8_STAGE_B(PG8_SB(1, 1), b2h1 + kstep); PG8_STAGE_A(PG8_SA(1, 0), a2o, 0, kstep);
            PG8_WAIT_V(8); PG8_WAIT_L(0); PG8_BAR; PG8_MMA(1, 0, At, B0); PG8_MMA(1, 1, At, B1); PG8_BAR; PG8_SCHED;
        }
        if (wr == 0) PG8_BAR;
        if constexpr (F8) asm volatile("s_nop 15\n\ts_nop 15" ::: "memory");
        { int l2 = tid; asm volatile("" : "+v"(l2)); S.epi(acc, cur, wr, wc, l2 & 15, (l2 >> 4) & 3); }
        if (!has_next) break;
#pragma unroll
        for (int a = 0; a < 2; ++a)
#pragma unroll
            for (int b = 0; b < 2; ++b)
#pragma unroll
                for (int m = 0; m < 4; ++m)
#pragma unroll
                    for (int n = 0; n < 2; ++n) acc[a][b][m][n] = (f32x4){0.f, 0.f, 0.f, 0.f};
        cur = nxt; cB0 = nB0; cB1 = nB1; ++ui;
#pragma unroll
        for (int h = 0; h < 2; ++h)
#pragma unroll
            for (int i = 0; i < 2; ++i) voffA[h][i] = voffAn[h][i];
        if (wr == 1) PG8_BAR;
    }
    PG8_WAIT_V(0);
    PG8_BAR;
#undef PG8_SA
#undef PG8_SB
#undef PG8_STAGE_A
#undef PG8_GLDS
#undef PG8_STAGE_B
#undef PG8_LDA
#undef PG8_LDB
#undef PG8_MMA
#undef PG8_WAIT_V
#undef PG8_WAIT_L
#undef PG8_BAR
#undef PG8_SCHED
}
struct StaticOrder {
    int nM, nN, nwg, G, c;
    __device__ void init(int M, int N, int G_, int c_) { nM = M / BM; nN = N / BM; nwg = nM * nN; G = G_; c = c_; }
    __device__ bool next(int i, Unit& u) const {
        const long L = (long)i * G + c; if (L >= nwg) return false;
        int wgid = (int)L; { const int q = nwg / 8, r = nwg % 8, xcd = wgid % 8, off = wgid / 8; wgid = (xcd < r ? xcd * (q + 1) : r * (q + 1) + (xcd - r) * q) + off; }
        const int nig = 8 * nN, gid = wgid / nig, fm = gid * 8, gsz = (nM - fm) < 8 ? (nM - fm) : 8;
        u.pm = fm + ((wgid % nig) % gsz); u.pn = (wgid % nig) / gsz; return true;
    }
};
}

struct Frame {
    LAS unsigned char* lds; LAS unsigned char* ctl;
    unsigned char* ws;
    int tid, lane, wave, G, bx;
    float* out; const struct Args* ap; unsigned char* ws0; float* out0; size_t z;
};

struct Args { const float* in[28]; float* out; unsigned char* ws; int ph_lo, ph_hi; };
#define arg_in(i) (F.ap->in[i] + F.z)
__device__ __forceinline__ void phase_begin(Frame& F) {
    int t = F.tid; asm volatile("" : "+v"(t)); F.tid = t; F.lane = t & 63; F.wave = __builtin_amdgcn_readfirstlane(t >> 6);
    size_t z = 0; asm volatile("" : "+s"(z)); F.z = z; F.ws = F.ws0 + z; F.out = F.out0 + z;
    int bx = F.bx; asm volatile("" : "+s"(bx)); F.bx = bx;
}
__device__ __forceinline__ void phase_restart(Frame& F) {
    int wv = F.wave; asm volatile("" : "+s"(wv)); F.wave = wv;
    int ln = (int)__builtin_amdgcn_mbcnt_hi(~0u, __builtin_amdgcn_mbcnt_lo(~0u, 0u)); asm volatile("" : "+v"(ln)); F.lane = ln; F.tid = wv * 64 + ln;
    size_t z = 0; asm volatile("" : "+s"(z)); F.z = z; F.ws = F.ws0 + z; F.out = F.out0 + z;
}
struct PBase {
    static constexpr bool GATHER = false, FP8 = false, NODMA = false; static constexpr int SCALE_AB = 0x7f7f7f7f;
    __device__ __forceinline__ void unit_begin(const pg8::Unit&, LAS unsigned char*, int, int) {}
    __device__ __forceinline__ void midk(f32x4 (&)[2][2][4][2], const pg8::Unit&, int, int, int, LAS unsigned char*, int) {}
    __device__ __forceinline__ void a_fix(unsigned (&)[2][2]) {}
};
struct PInProj : PBase {
    static constexpr int K = 1024, BROW64 = 1;
    pg8::StaticOrder so; const char* A; const char* B; bf16_t* UQKV; const float *GQK, *COS, *SIN;
    __device__ __forceinline__ bool next(int i, pg8::Unit& u) const { return so.next(i, u); }
    __device__ __forceinline__ const char* a_base() const { return A; }
    __device__ __forceinline__ void a_offs(const pg8::Unit& u, int R0, int C0, int R1, int C1, unsigned (&vo)[2][2], bool) const {
#pragma unroll
        for (int h = 0; h < 2; ++h) { vo[h][0] = (unsigned)((u.pm * 256 + 128 * h + R0) * K + C0) * 2u; vo[h][1] = (unsigned)((u.pm * 256 + 128 * h + R1) * K + C1) * 2u; }
    }
    __device__ __forceinline__ void b_ptrs(const pg8::Unit& u, const char*& b0, const char*& b1) const { b0 = B + (size_t)u.pn * 256 * K * 2; b1 = b0 + (size_t)32 * K * 2; }
    __device__ __forceinline__ void epi(f32x4 (&acc)[2][2][4][2], const pg8::Unit& u, int wr, int wc, int fr, int fq) const {
        const int kind = u.pn >> 1;
        const int colg = (u.pn & 1) * 256 + 64 * wc;
        bf16_t* dst = UQKV + (size_t)kind * (size_t)(16u << 20);
        const int row0 = u.pm * 256 + wr * 64 + fr;
        if (kind == 0 || kind == 3) {
#pragma unroll
            for (int ai = 0; ai < 2; ++ai)
#pragma unroll
                for (int m = 0; m < 4; ++m) { bf16_t* rowp = dst + (size_t)(row0 + ai * 128 + m * 16) * 512 + colg + 8 * fq;
#pragma unroll
                    for (int bj = 0; bj < 2; ++bj) { const f32x4 v0 = acc[ai][bj][m][0], v1 = acc[ai][bj][m][1];
                        u32x4 w; w.x = cvt_pk_bf16(v0[0], v0[1]); w.y = cvt_pk_bf16(v0[2], v0[3]); w.z = cvt_pk_bf16(v1[0], v1[1]); w.w = cvt_pk_bf16(v1[2], v1[3]);
                        *(u32x4*)(rowp + 32 * bj) = w; } }
        } else {
            const float* g = GQK + (kind - 1) * 64; const float sc = kind == 1 ? C2 * 32.0f : 16.0f;
            f32x4 g0[2], g1[2];
#pragma unroll
            for (int n = 0; n < 2; ++n) { g0[n] = *(const f32x4*)(g + 8 * fq + 4 * n); g1[n] = *(const f32x4*)(g + 32 + 8 * fq + 4 * n); }
#pragma unroll
            for (int ai = 0; ai < 2; ++ai)
#pragma unroll
                for (int m = 0; m < 4; ++m) {
                    const int row = row0 + ai * 128 + m * 16; const int pos = row & (SEQ - 1);
                    float ss = 0.f;
#pragma unroll
                    for (int bj = 0; bj < 2; ++bj)
#pragma unroll
                        for (int n = 0; n < 2; ++n) { const f32x4 x = acc[ai][bj][m][n]; ss += (x[0] * x[0] + x[1] * x[1]) + (x[2] * x[2] + x[3] * x[3]); }
                    ss += __shfl_xor(ss, 16); ss += __shfl_xor(ss, 32);
                    const float r = rsqrtf(ss * (1.f / 64.f) + EPS) * sc;
                    f32x4 o1[2], o2[2];
#pragma unroll
                    for (int n = 0; n < 2; ++n) {
                        const f32x4 c = *(const f32x4*)(COS + (size_t)pos * 32 + 8 * fq + 4 * n), s = *(const f32x4*)(SIN + (size_t)pos * 32 + 8 * fq + 4 * n);
                        const f32x4 x1 = acc[ai][0][m][n] * g0[n] * r, x2 = acc[ai][1][m][n] * g1[n] * r;
                        o1[n] = x1 * c - x2 * s; o2[n] = x2 * c + x1 * s;
                    }
                    unsigned char* rowp = (unsigned char*)dst + (size_t)row * 512 + colg + 8 * fq;
                    u32x2 w; w.x = pk4_fp8(o1[0][0], o1[0][1], o1[0][2], o1[0][3]); w.y = pk4_fp8(o1[1][0], o1[1][1], o1[1][2], o1[1][3]);
                    *(u32x2*)(rowp) = w;
                    w.x = pk4_fp8(o2[0][0], o2[0][1], o2[0][2], o2[0][3]); w.y = pk4_fp8(o2[1][0], o2[1][1], o2[1][2], o2[1][3]);
                    *(u32x2*)(rowp + 32) = w;
                    asm volatile("" ::: "memory");
                }
        }
    }
};
struct PGlu : PBase {
    static constexpr int K = 512, BROW64 = 0;
    pg8::StaticOrder so; const char* A; const char* B; const bf16_t* YG; bf16_t* MIX; float* RSP;
    __device__ __forceinline__ bool next(int i, pg8::Unit& u) const { return so.next(i, u); }
    __device__ __forceinline__ const char* a_base() const { return A; }
    __device__ __forceinline__ void a_offs(const pg8::Unit& u, int R0, int C0, int R1, int C1, unsigned (&vo)[2][2], bool) const {
#pragma unroll
        for (int h = 0; h < 2; ++h) { vo[h][0] = (unsigned)((u.pm * 256 + 128 * h + R0) * K + C0) * 2u; vo[h][1] = (unsigned)((u.pm * 256 + 128 * h + R1) * K + C1) * 2u; }
    }
    __device__ __forceinline__ void b_ptrs(const pg8::Unit& u, const char*& b0, const char*& b1) const { b0 = B + (size_t)u.pn * 256 * K * 2; b1 = b0 + (size_t)128 * K * 2; }
    __device__ __forceinline__ void epi(f32x4 (&acc)[2][2][4][2], const pg8::Unit& u, int wr, int wc, int fr, int fq) const {
        const int row0 = u.pm * 256 + wr * 64 + fr, col0 = u.pn * 256 + wc * 32 + 8 * fq;
#pragma unroll
        for (int ai = 0; ai < 2; ++ai)
#pragma unroll
            for (int m = 0; m < 4; ++m) {
                const int row = row0 + ai * 128 + m * 16; float ss = 0.f;
#pragma unroll
                for (int bj = 0; bj < 2; ++bj) {
                    const u32x4 yw = *(const u32x4*)(YG + (size_t)row * 512 + col0 + 128 * bj);
                    const f32x4 a0 = acc[ai][bj][m][0], a1 = acc[ai][bj][m][1];
                    float z[8];
                    z[0] = bf_lo(yw.x) * sigmoidf(a0[0]); z[1] = bf_hi(yw.x) * sigmoidf(a0[1]); z[2] = bf_lo(yw.y) * sigmoidf(a0[2]); z[3] = bf_hi(yw.y) * sigmoidf(a0[3]);
                    z[4] = bf_lo(yw.z) * sigmoidf(a1[0]); z[5] = bf_hi(yw.z) * sigmoidf(a1[1]); z[6] = bf_lo(yw.w) * sigmoidf(a1[2]); z[7] = bf_hi(yw.w) * sigmoidf(a1[3]);
#pragma unroll
                    for (int i = 0; i < 8; ++i) ss += z[i] * z[i];
                    u32x4 w; w.x = cvt_pk_bf16(z[0], z[1]); w.y = cvt_pk_bf16(z[2], z[3]); w.z = cvt_pk_bf16(z[4], z[5]); w.w = cvt_pk_bf16(z[6], z[7]);
                    *(u32x4*)(MIX + (size_t)row * 1024 + col0 + 128 * bj) = w;
                }
                ss += __shfl_xor(ss, 16); ss += __shfl_xor(ss, 32);
                if (fq == 0) RSP[(size_t)row * 8 + u.pn * 4 + wc] = ss;
            }
    }
};
struct POut : PBase {
    static constexpr int K = 1024, BROW64 = 0;
    pg8::StaticOrder so; const char* A; const char* B; const float* RSP; const float* base32; const bf16_t* base16; bf16_t* H1;
    __device__ __forceinline__ bool next(int i, pg8::Unit& u) const { return so.next(i, u); }
    __device__ __forceinline__ const char* a_base() const { return A; }
    __device__ __forceinline__ void a_offs(const pg8::Unit& u, int R0, int C0, int R1, int C1, unsigned (&vo)[2][2], bool) const {
#pragma unroll
        for (int h = 0; h < 2; ++h) { vo[h][0] = (unsigned)((u.pm * 256 + 128 * h + R0) * K + C0) * 2u; vo[h][1] = (unsigned)((u.pm * 256 + 128 * h + R1) * K + C1) * 2u; }
    }
    __device__ __forceinline__ void b_ptrs(const pg8::Unit& u, const char*& b0, const char*& b1) const { b0 = B + (size_t)u.pn * 256 * K * 2; b1 = b0 + (size_t)128 * K * 2; }
    __device__ __forceinline__ void unit_begin(const pg8::Unit& u, LAS unsigned char* ldsctl, int tid, int slot) const {
        if (tid < 256) {
            const f32x4 p0 = *(const f32x4*)(RSP + (size_t)(u.pm * 256 + tid) * 8), p1 = *(const f32x4*)(RSP + (size_t)(u.pm * 256 + tid) * 8 + 4);
            const float ss = ((p0[0] + p0[1]) + (p0[2] + p0[3])) + ((p1[0] + p1[1]) + (p1[2] + p1[3]));
            ((LAS float*)(ldsctl + 1024 + slot * 1024))[tid] = rsqrtf(ss * (1.f / 512.f) + EPS);
        }
    }
    __device__ __forceinline__ void midk(f32x4 (&acc)[2][2][4][2], const pg8::Unit& u, int t, int wr, int fr, LAS unsigned char* ldsctl, int slot) const {
        if (t == 8) {
            const LAS float* rs = (const LAS float*)(ldsctl + 1024 + slot * 1024);
#pragma unroll
            for (int ai = 0; ai < 2; ++ai)
#pragma unroll
                for (int m = 0; m < 4; ++m) { const float r = rs[ai * 128 + wr * 64 + m * 16 + fr];
#pragma unroll
                    for (int bj = 0; bj < 2; ++bj)
#pragma unroll
                        for (int n = 0; n < 2; ++n) acc[ai][bj][m][n] *= r; }
        }
    }
    __device__ __forceinline__ void epi(f32x4 (&acc)[2][2][4][2], const pg8::Unit& u, int wr, int wc, int fr, int fq) const {
        const int row0 = u.pm * 256 + wr * 64 + fr, col0 = u.pn * 256 + wc * 32 + 8 * fq;
#pragma unroll
        for (int ai = 0; ai < 2; ++ai)
#pragma unroll
            for (int m = 0; m < 4; ++m) { const size_t off = (size_t)(row0 + ai * 128 + m * 16) * 1024 + col0;
#pragma unroll
                for (int bj = 0; bj < 2; ++bj) {
                    f32x4 v0 = acc[ai][bj][m][0], v1 = acc[ai][bj][m][1];
                    if (base32) { v0 += *(const f32x4*)(base32 + off + bj * 128); v1 += *(const f32x4*)(base32 + off + bj * 128 + 4); }
                    else { const u32x4 b = *(const u32x4*)(base16 + off + bj * 128); v0[0] += bf_lo(b.x); v0[1] += bf_hi(b.x); v0[2] += bf_lo(b.y); v0[3] += bf_hi(b.y); v1[0] += bf_lo(b.z); v1[1] += bf_hi(b.z); v1[2] += bf_lo(b.w); v1[3] += bf_hi(b.w); }
                    u32x4 w; w.x = cvt_pk_bf16(v0[0], v0[1]); w.y = cvt_pk_bf16(v0[2], v0[3]); w.z = cvt_pk_bf16(v1[0], v1[1]); w.w = cvt_pk_bf16(v1[2], v1[3]);
                    *(u32x4*)(H1 + off + bj * 128) = w; }
                if (m & 1) asm volatile("" ::: "memory"); }
    }
};
template <int NN> struct MoeOrder {
    int j, wpx, s0, s1, s2, s3, n0, n1, n2, n3;
    __device__ __forceinline__ void init(int G, int c, const int* PST) {
#ifndef MOE_XA
#define MOE_XA 2
#endif
#ifndef MOE_CHUNKED
#define MOE_CHUNKED 0
#endif
        if (MOE_XA == 1 && (G & 7) == 0) { wpx = G >> 3; const int x = MOE_CHUNKED ? c / wpx : (c & 7); j = MOE_CHUNKED ? c % wpx : (c >> 3);
            s0 = PST[x] >> 8; n0 = (PST[x + 1] - PST[x]) >> 8; s1 = PST[x + 8] >> 8; n1 = (PST[x + 9] - PST[x + 8]) >> 8;
            s2 = PST[x + 16] >> 8; n2 = (PST[x + 17] - PST[x + 16]) >> 8; s3 = PST[x + 24] >> 8; n3 = (PST[x + 25] - PST[x + 24]) >> 8; }
        else { j = c; wpx = G; s0 = 0; n0 = PST[32] >> 8; s1 = s2 = s3 = 0; n1 = n2 = n3 = 0; }
        if (MOE_XA == 2 && (G & 7) == 0) { wpx = G >> 3; j = c >> 3; s1 = c & 7; n0 = PST[32] >> 8; }
    }
    __device__ __forceinline__ bool next(int i, pg8::Unit& u) const {
        const int q = i * wpx + j; int pml = q / NN; u.pn = q % NN;
        if (MOE_XA == 2) { u.pm = s1 + 8 * pml; return u.pm < n0; }
        if (pml < n0) { u.pm = s0 + pml; return true; } pml -= n0;
        if (pml < n1) { u.pm = s1 + pml; return true; } pml -= n1;
        if (pml < n2) { u.pm = s2 + pml; return true; } pml -= n2;
        if (pml < n3) { u.pm = s3 + pml; return true; }
        return false;
    }
};
struct PUp : PBase {
    static constexpr int K = 1024, BROW64 = 0; static constexpr bool GATHER = true, FP8 = UP_FP8; static constexpr int ES = UP_FP8 ? 1 : 2;
    static constexpr int SCALE_AB = 0x7c79;
    MoeOrder<8> mo; const char* A; const char* B; const int* ROWTOK; const int* TILEEXP; const float* bup; const float* ROWSCALE; bf16_t* ACT;
    int idx[2][2]; int c0, c1;
    __device__ __forceinline__ bool next(int i, pg8::Unit& u) const { return mo.next(i, u); }
    __device__ __forceinline__ const char* a_base() const { return A; }
    __device__ __forceinline__ void a_offs(const pg8::Unit& u, int R0, int C0, int R1, int C1, unsigned (&vo)[2][2], bool first) {
        c0 = C0; c1 = C1;
        const int* rp = ROWTOK + u.pm * 256;
#pragma unroll
        for (int h = 0; h < 2; ++h) {
            asm volatile("global_load_dword %0, %1, off" : "=v"(idx[h][0]) : "v"(rp + 128 * h + R0) : "memory");
            asm volatile("global_load_dword %0, %1, off" : "=v"(idx[h][1]) : "v"(rp + 128 * h + R1) : "memory");
        }
        asm volatile("s_waitcnt vmcnt(0)" : "+v"(idx[0][0]), "+v"(idx[0][1]), "+v"(idx[1][0]), "+v"(idx[1][1]) :: "memory");
#pragma unroll
        for (int h = 0; h < 2; ++h) { vo[h][0] = (unsigned)(idx[h][0] * K * ES + 2 * c0); vo[h][1] = (unsigned)(idx[h][1] * K * ES + 2 * c1); }
    }
    __device__ __forceinline__ void b_ptrs(const pg8::Unit& u, const char*& b0, const char*& b1) const {
        const int e = TILEEXP[u.pm]; b0 = B + ((size_t)e * 2048 + (size_t)u.pn * 128) * K * ES; b1 = b0 + (size_t)1024 * K * ES; }
    __device__ __forceinline__ void epi(f32x4 (&acc)[2][2][4][2], const pg8::Unit& u, int wr, int wc, int fr, int fq) const {
        const int e = TILEEXP[u.pm];
        const int row0 = u.pm * 256 + wr * 64 + fr, col0 = u.pn * 128 + wc * 32 + 8 * fq;
        const float* bg = bup + (size_t)e * 2048 + col0; const float* bl = bg + 1024;
        f32x4 bgv[2], blv[2];
#pragma unroll
        for (int n = 0; n < 2; ++n) { bgv[n] = *(const f32x4*)(bg + 4 * n); blv[n] = *(const f32x4*)(bl + 4 * n); }
#pragma unroll
        for (int ai = 0; ai < 2; ++ai)
#pragma unroll
            for (int m = 0; m < 4; ++m) {
                float a[8]; const float rs = ROWSCALE[row0 + ai * 128 + m * 16];
#pragma unroll
                for (int n = 0; n < 2; ++n)
#pragma unroll
                    for (int j = 0; j < 4; ++j) {
                        float glu = acc[ai][0][m][n][j] * rs + bgv[n][j], lin = acc[ai][1][m][n][j] * rs + blv[n][j];
                        glu = fminf(glu, 7.0f); lin = fminf(fmaxf(lin, -7.0f), 7.0f);
                        a[4 * n + j] = glu * sigmoidf(1.702f * glu) * (lin + 1.0f);
                    }
                if (DN_FP8) { u32x2 w; w.x = pk4_fp8(a[0] * 4.f, a[1] * 4.f, a[2] * 4.f, a[3] * 4.f); w.y = pk4_fp8(a[4] * 4.f, a[5] * 4.f, a[6] * 4.f, a[7] * 4.f);
                    *(u32x2*)((unsigned char*)ACT + (size_t)(row0 + ai * 128 + m * 16) * 1024 + col0) = w; }
                else { u32x4 w; w.x = cvt_pk_bf16(a[0], a[1]); w.y = cvt_pk_bf16(a[2], a[3]); w.z = cvt_pk_bf16(a[4], a[5]); w.w = cvt_pk_bf16(a[6], a[7]);
                    *(u32x4*)(ACT + (size_t)(row0 + ai * 128 + m * 16) * 1024 + col0) = w; }
            }
    }
};
struct PUpNoDma : PUp { static constexpr bool NODMA = true; };
struct PDown : PBase {
    static constexpr int K = 1024, BROW64 = 0; static constexpr bool FP8 = DN_FP8; static constexpr int ES = DN_FP8 ? 1 : 2;
    static constexpr int SCALE_AB = 0x7d79;
    MoeOrder<4> mo; const char* A; const char* B; const int* TILEEXP; const float* bdn; const float* ROWGATE; bf16_t* YB;
    __device__ __forceinline__ bool next(int i, pg8::Unit& u) const { return mo.next(i, u); }
    __device__ __forceinline__ const char* a_base() const { return A; }
    __device__ __forceinline__ void a_offs(const pg8::Unit& u, int R0, int C0, int R1, int C1, unsigned (&vo)[2][2], bool) const {
#pragma unroll
        for (int h = 0; h < 2; ++h) { vo[h][0] = (unsigned)((u.pm * 256 + 128 * h + R0) * K * ES + 2 * C0); vo[h][1] = (unsigned)((u.pm * 256 + 128 * h + R1) * K * ES + 2 * C1); }
    }
    __device__ __forceinline__ void b_ptrs(const pg8::Unit& u, const char*& b0, const char*& b1) const {
        const int e = TILEEXP[u.pm]; b0 = B + ((size_t)e * 1024 + (size_t)u.pn * 256) * K * ES; b1 = b0 + (size_t)128 * K * ES; }
    __device__ __forceinline__ void epi(f32x4 (&acc)[2][2][4][2], const pg8::Unit& u, int wr, int wc, int fr, int fq) const {
        const int e = TILEEXP[u.pm];
        const int row0 = u.pm * 256 + wr * 64 + fr, col0 = u.pn * 256 + wc * 32 + 8 * fq;
        const float* bp = bdn + (size_t)e * 1024 + col0;
#pragma unroll
        for (int bj = 0; bj < 2; ++bj) {
            const f32x4 bv0 = *(const f32x4*)(bp + 128 * bj), bv1 = *(const f32x4*)(bp + 128 * bj + 4);
#pragma unroll
            for (int ai = 0; ai < 2; ++ai)
#pragma unroll
                for (int m = 0; m < 4; ++m) { const int row = row0 + ai * 128 + m * 16; const float gt = ROWGATE[row];
                    const f32x4 v0 = (acc[ai][bj][m][0] + bv0) * (gt * 16.f), v1 = (acc[ai][bj][m][1] + bv1) * (gt * 16.f);
                    u32x2 w; w.x = pk4_fp8(v0[0], v0[1], v0[2], v0[3]); w.y = pk4_fp8(v1[0], v1[1], v1[2], v1[3]);
                    *(u32x2*)((unsigned char*)YB + (size_t)row * 1024 + col0 + 128 * bj) = w; }
            asm volatile("" ::: "memory");
        }
    }
};

struct TItem { const float* src; bf16_t* dst; const float* ksc; int N, K; unsigned char* dst8; };
__device__ __forceinline__ void titem_load(const TItem& it, f32x4 (&v)[16], int lane) {
    const float* p = it.src + (size_t)(lane >> 4) * it.N + 4 * (lane & 15);
#pragma unroll
    for (int i = 0; i < 16; ++i) v[i] = *(const f32x4*)(p + (size_t)(4 * i) * it.N);
}
__device__ __forceinline__ void titem_store(const TItem& it, f32x4 (&v)[16], LAS float* scr, int lane) {
    if (it.ksc) {
#pragma unroll
        for (int i = 0; i < 16; ++i) v[i] *= it.ksc[4 * i + (lane >> 4)];
    }
#pragma unroll
    for (int i = 0; i < 16; ++i) { LAS float* d = scr + (4 * i + (lane >> 4)) * 65 + 4 * (lane & 15); d[0] = v[i][0]; d[1] = v[i][1]; d[2] = v[i][2]; d[3] = v[i][3]; }
    asm volatile("s_waitcnt lgkmcnt(0)" ::: "memory");
    if (it.dst8) {
        const int c = lane & 3;
#pragma unroll
        for (int j = 0; j < 4; ++j) { const int n = (lane >> 2) + 16 * j; const LAS float* s = scr + (16 * c) * 65 + n;
            u32x4 o;
            o.x = pk4_fp8(s[0 * 65] * 64.f, s[1 * 65] * 64.f, s[2 * 65] * 64.f, s[3 * 65] * 64.f); o.y = pk4_fp8(s[4 * 65] * 64.f, s[5 * 65] * 64.f, s[6 * 65] * 64.f, s[7 * 65] * 64.f);
            o.z = pk4_fp8(s[8 * 65] * 64.f, s[9 * 65] * 64.f, s[10 * 65] * 64.f, s[11 * 65] * 64.f); o.w = pk4_fp8(s[12 * 65] * 64.f, s[13 * 65] * 64.f, s[14 * 65] * 64.f, s[15 * 65] * 64.f);
            *(u32x4*)(it.dst8 + (size_t)n * it.K + 16 * c) = o; }
    } else {
        const int c = lane & 7;
#pragma unroll
        for (int j = 0; j < 8; ++j) { const int n = (lane >> 3) + 8 * j; const LAS float* s = scr + (8 * c) * 65 + n;
            u32x4 o; o.x = pk2(s[0 * 65], s[1 * 65]); o.y = pk2(s[2 * 65], s[3 * 65]); o.z = pk2(s[4 * 65], s[5 * 65]); o.w = pk2(s[6 * 65], s[7 * 65]);
            *(u32x4*)(it.dst + (size_t)n * it.K + 8 * c) = o; }
    }
    asm volatile("s_waitcnt lgkmcnt(0)" ::: "memory");
}
__device__ __forceinline__ void rms_row_to_bf16(const f32x4 (&v)[4], const float* g, bf16_t* orow, int lane) {
    float s = 0.f;
#pragma unroll
    for (int j = 0; j < 4; ++j) s += (v[j][0] * v[j][0] + v[j][1] * v[j][1]) + (v[j][2] * v[j][2] + v[j][3] * v[j][3]);
    const float r = rsqrtf(wave_sum(s) * (1.f / D) + EPS);
#pragma unroll
    for (int j = 0; j < 4; ++j) { const f32x4 gg = *(const f32x4*)(g + 4 * lane + 256 * j); const f32x4 o = v[j] * gg * r;
        u32x2 w; w.x = cvt_pk_bf16(o[0], o[1]); w.y = cvt_pk_bf16(o[2], o[3]); *(u32x2*)(orow + 4 * lane + 256 * j) = w; }
}
struct Cplx { float re, im; };
__device__ __forceinline__ Cplx cmul(Cplx a, Cplx b) { return Cplx{a.re * b.re - a.im * b.im, a.re * b.im + a.im * b.re}; }
__device__ __forceinline__ Cplx lam_pow(float lr, float li, float step, int n) {
    const float mag = expf((float)n * lr * step); const double ang = (double)n * (double)li * (double)step;
    return Cplx{mag * (float)cos(ang), mag * (float)sin(ang)};
}
__device__ __forceinline__ Cplx lam_pow_fast(float lr, float li, float step, int n) {
    const float mag = __expf((float)n * lr * step); const double rev = (double)n * (double)li * (double)step * 0.15915494309189535; const float fr = (float)(rev - floor(rev));
    return Cplx{mag * __builtin_amdgcn_cosf(fr), mag * __builtin_amdgcn_sinf(fr)};
}
__device__ __forceinline__ Cplx bbar_factor(float lr, float li, float step) {
    const Cplx lb = lam_pow(lr, li, step, 1); const float nr = lb.re - 1.f, ni = lb.im, den = lr * lr + li * li;
    return Cplx{(nr * lr + ni * li) / den, (ni * lr - nr * li) / den};
}
template <int PMODE> __device__ __forceinline__ void p0_prologue(Frame& F) {
    const int gw = F.bx * NWAVES + F.wave, NGW = F.G * NWAVES, lane = F.lane;
    const int gt = F.bx * NTHREADS + F.tid, NGT = F.G * NTHREADS;
    unsigned char* ws = F.ws;
    if (!(PMODE & 1)) {
        LAS float* scr = (LAS float*)(F.lds + LDS_RING) + F.wave * (64 * 65);
        constexpr int I_UP = UP_FP8 ? 0 : 32 * 16 * 32, I_DN = DN_FP8 ? 0 : 32 * 16 * 16, I_IN = 16 * 32, I_OUT = 16 * 16, I_GLU = 8 * 8;
        constexpr int PER_L = I_UP + I_DN + I_IN + I_OUT + I_GLU, TOTAL = DEPTH * PER_L;
        auto decode = [&](int it) -> TItem {
            TItem ti; const int l = it / PER_L; int r = it % PER_L; const float* W; bf16_t* WT; int K, N; ti.ksc = nullptr; bool f8 = false;
            if (r < I_UP) { const int e = r / 512; r %= 512; K = 1024; N = 2048; W = arg_in(24) + ((size_t)l * NE + e) * 1024 * 2048; WT = (bf16_t*)(ws + WS_WUP + l * WUP_STRIDE) + (size_t)e * 2048 * 1024 / (UP_FP8 ? 2 : 1); f8 = UP_FP8; }
            else if ((r -= I_UP) < I_DN) { const int e = r / 256; r %= 256; K = 1024; N = 1024; W = arg_in(26) + ((size_t)l * NE + e) * 1024 * 1024; WT = (bf16_t*)(ws + WS_WDN + l * WDN_STRIDE) + (size_t)e * 1024 * 1024 / (DN_FP8 ? 2 : 1); f8 = DN_FP8; }
            else if ((r -= I_DN) < I_IN) { K = 1024; N = 2048; W = arg_in(2) + (size_t)l * 1024 * 2048; WT = (bf16_t*)(ws + WS_WIN + l * WIN_STRIDE); }
            else if ((r -= I_IN) < I_OUT) { K = 1024; N = 1024; W = arg_in(20) + (size_t)l * 1024 * 1024; WT = (bf16_t*)(ws + WS_WOUT + l * WOUT_STRIDE); if ((r / 16) * 64 < DS) ti.ksc = arg_in(12) + l * DS + (r / 16) * 64; }
            else { r -= I_OUT; K = 512; N = 512; W = arg_in(11) + (size_t)l * 512 * 512; WT = (bf16_t*)(ws + WS_WGLU + l * WGLU_STRIDE); }
            const int nblk = N / 64, k0 = 64 * (r / nblk), n0 = 64 * (r % nblk);
            ti.src = W + (size_t)k0 * N + n0; ti.dst = WT + (size_t)n0 * K + k0; ti.N = N; ti.K = K; ti.dst8 = f8 ? (unsigned char*)WT + (size_t)n0 * K + k0 : nullptr; return ti;
        };
        f32x4 va[16]; TItem ia;
        for (int it = gw; it < TOTAL; it += NGW) { ia = decode(it); titem_load(ia, va, lane); titem_store(ia, va, scr, lane); }
    }
    if (!(PMODE & 1) && (UP_FP8 || DN_FP8)) {
        LAS float* tile = (LAS float*)(F.lds + LDS_RING);
        constexpr int C_UP = UP_FP8 ? 32 * 8 * 8 : 0, C_DN = DN_FP8 ? 32 * 8 * 4 : 0, C_PER_L = C_UP + C_DN, C_TOTAL = DEPTH * C_PER_L;
        auto cdecode = [&](int it, const float*& src, unsigned char*& dst, int& N) {
            const int l = it / C_PER_L; int r = it % C_PER_L; const float* W; unsigned char* WT;
            if (r < C_UP) { const int e = r >> 6; r &= 63; N = 2048; W = arg_in(24) + ((size_t)l * NE + e) * 1024 * 2048; WT = ws + WS_WUP + l * WUP_STRIDE + (size_t)e * 2048 * 1024; }
            else { r -= C_UP; const int e = r >> 5; r &= 31; N = 1024; W = arg_in(26) + ((size_t)l * NE + e) * 1024 * 1024; WT = ws + WS_WDN + l * WDN_STRIDE + (size_t)e * 1024 * 1024; }
            const int nblk = N >> 8, k0 = 128 * (r / nblk), n0 = 256 * (r % nblk);
            src = W + (size_t)k0 * N + n0; dst = WT + (size_t)n0 * 1024 + k0;
        };
        auto cload = [&](const float* src, int N, f32x4 (&v)[16]) {
            const float* p = src + (size_t)F.wave * N + 4 * lane;
#pragma unroll
            for (int i = 0; i < 16; ++i) v[i] = *(const f32x4*)(p + (size_t)(8 * i) * N);
        };
        auto cstore = [&](unsigned char* dst, f32x4 (&v)[16]) {
            __syncthreads();
#pragma unroll
            for (int i = 0; i < 16; ++i) *(LAS f32x4*)(tile + (8 * i + F.wave) * 260 + 4 * lane) = v[i];
            __syncthreads();
            const int n = F.tid & 255, cc = F.tid >> 8;
#pragma unroll
            for (int j = 0; j < 4; ++j) { const int c = 2 * j + cc; const LAS float* sp = tile + (16 * c) * 260 + n;
                u32x4 o;
                o.x = pk4_fp8(sp[0 * 260] * 64.f, sp[1 * 260] * 64.f, sp[2 * 260] * 64.f, sp[3 * 260] * 64.f); o.y = pk4_fp8(sp[4 * 260] * 64.f, sp[5 * 260] * 64.f, sp[6 * 260] * 64.f, sp[7 * 260] * 64.f);
                o.z = pk4_fp8(sp[8 * 260] * 64.f, sp[9 * 260] * 64.f, sp[10 * 260] * 64.f, sp[11 * 260] * 64.f); o.w = pk4_fp8(sp[12 * 260] * 64.f, sp[13 * 260] * 64.f, sp[14 * 260] * 64.f, sp[15 * 260] * 64.f);
                *(u32x4*)(dst + (size_t)n * 1024 + 16 * c) = o; }
        };
        f32x4 va[16], vb[16]; const float* sa; const float* sb; unsigned char* da; unsigned char* db; int na, nb;
        int it = F.bx;
        if (it < C_TOTAL) { cdecode(it, sa, da, na); cload(sa, na, va); }
        while (it < C_TOTAL) {
            const int itb = it + F.G;
            if (itb < C_TOTAL) { cdecode(itb, sb, db, nb); cload(sb, nb, vb); }
            cstore(da, va);
            if (itb >= C_TOTAL) break;
            const int itc = itb + F.G;
            if (itc < C_TOTAL) { cdecode(itc, sa, da, na); cload(sa, na, va); }
            cstore(db, vb);
            it = itc;
        }
        __syncthreads();
    }
    phase_begin(F); ws = F.ws;
    for (int i = F.bx * NTHREADS + F.tid; i < SEQ * 32; i += NGT) {
        const int s = i >> 5, j = i & 31;
        const float inv = 1.0f / powf(10000.0f, (float)(2 * j) / 64.0f);
        const float ang = (float)s * inv;
        ((float*)(ws + WS_COS))[i] = (float)cos((double)ang); ((float*)(ws + WS_SIN))[i] = (float)sin((double)ang);
    }
    if (F.bx == 0 && F.wave < DEPTH) {
        const int l = F.wave;
        float a = arg_in(15)[l * 64 + lane] * arg_in(16)[l * 64 + lane], b = arg_in(17)[l * 64 + lane] * arg_in(18)[l * 64 + lane];
        a = wave_sum(a); b = wave_sum(b);
        float mq = fabsf(arg_in(13)[l * 64 + lane]), mk = fabsf(arg_in(14)[l * 64 + lane]);
#pragma unroll
        for (int o = 1; o < 64; o <<= 1) { mq = fmaxf(mq, __shfl_xor(mq, o)); mk = fmaxf(mk, __shfl_xor(mk, o)); }
        const float lambda_init = 0.8f - 0.6f * expf(-0.3f * (float)l);
        { float* gqk = (float*)(ws + WS_SCAL) + 64 + l * 128; gqk[lane] = arg_in(13)[l * 64 + lane]; gqk[64 + lane] = arg_in(14)[l * 64 + lane]; }
        if (lane == 0) { float* sc = (float*)(ws + WS_SCAL) + l * 4; sc[0] = expf(a) - expf(b) + lambda_init; sc[1] = C2 * 64.f * mq * mk * 1.02f + 0.5f; sc[2] = 1.0f - lambda_init; }
    }
    for (int i = gt; i < DEPTH * NE * D; i += NGT) {
        const int l = i / (NE * D), e = (i / D) % NE, k = i % D;
        const float w = arg_in(22)[(size_t)l * D * NE + (size_t)k * NE + e];
        const unsigned hi = f2bf(w); const float lo = w - __builtin_bit_cast(float, hi << 16);
        bf16_t* t = (bf16_t*)(ws + WS_WRT + l * WRT_STRIDE);
        t[e * D + k] = (bf16_t)hi; t[NE * D + e * D + k] = (bf16_t)f2bf(lo);
    }
    phase_begin(F); ws = F.ws;
#define TBL_PTRS(l) const float* lam_re = arg_in(3) + (l) * NG * NP; const float* lam_im = arg_in(4) + (l) * NG * NP; const float* log_step = arg_in(5) + (l) * NG; \
        const float* b_re = arg_in(6) + (size_t)(l) * NG * NP * HS; const float* b_im = arg_in(7) + (size_t)(l) * NG * NP * HS; \
        const float* c_re = arg_in(8) + (size_t)(l) * NG * HS * NP; const float* c_im = arg_in(9) + (size_t)(l) * NG * HS * NP; \
        bf16_t* KT = (bf16_t*)(ws + WS_KT + (l) * KT_STRIDE); bf16_t* HT = (bf16_t*)(ws + WS_HT + (l) * HT_STRIDE); (void)KT; (void)HT; (void)b_re; (void)b_im
    if (!(PMODE & 2)) {
        {
            LAS float* pwl = (LAS float*)(F.lds + LDS_RING);
            for (int cb = F.bx; cb < DEPTH * NG * 17; cb += F.G) {
                const int l = cb / (NG * 17), rb = cb % (NG * 17);
                if (rb >= NG * 9) continue;
                const int blk = rb;
                TBL_PTRS(l);
                const int g = blk / 9, s0 = (blk % 9) * 8;
                const float step = expf(log_step[g]);
                LAS float* cgl = pwl + 1024;
                LAS float* ffl = cgl + 2048;
                LAS float* bgl = ffl + 128;
                __syncthreads();
                { const int p = F.tid & 63, sl = F.tid >> 6, slot = s0 + sl; Cplx w{0.f, 0.f};
                  if (slot >= 1 && slot <= 64) w = lam_pow_fast(lam_re[g * NP + p], lam_im[g * NP + p], step, slot - 1);
                  pwl[(sl * 64 + p) * 2] = w.re; pwl[(sl * 64 + p) * 2 + 1] = w.im; }
                for (int idx = F.tid; idx < 1024; idx += NTHREADS) { cgl[2 * idx] = c_re[(size_t)g * HS * NP + idx]; cgl[2 * idx + 1] = c_im[(size_t)g * HS * NP + idx]; }
                if (F.tid < 64) { const Cplx f = bbar_factor(lam_re[g * NP + F.tid], lam_im[g * NP + F.tid], step); ffl[2 * F.tid] = f.re; ffl[2 * F.tid + 1] = f.im; }
                __syncthreads();
                for (int idx = F.tid; idx < 1024; idx += NTHREADS) { const int p = idx >> 4; const Cplx w = cmul(Cplx{ffl[2 * p], ffl[2 * p + 1]}, Cplx{b_re[(size_t)g * NP * HS + idx], b_im[(size_t)g * NP * HS + idx]}); bgl[2 * idx] = w.re; bgl[2 * idx + 1] = w.im; }
                __syncthreads();
                const int pq = F.tid & 3, h = (F.tid >> 2) & 15, sl = F.tid >> 6, slot = s0 + sl;
                float accv[16];
#pragma unroll
                for (int q = 0; q < 16; ++q) accv[q] = 0.f;
                for (int pp = 0; pp < 16; ++pp) {
                    const int p = pq * 16 + pp;
                    const Cplx w = cmul(Cplx{cgl[(h * 64 + p) * 2], cgl[(h * 64 + p) * 2 + 1]}, Cplx{pwl[(sl * 64 + p) * 2], pwl[(sl * 64 + p) * 2 + 1]});
                    const LAS f32x4* bp = (const LAS f32x4*)(bgl + p * 32);
#pragma unroll
                    for (int q2 = 0; q2 < 8; ++q2) { const f32x4 bb = bp[q2]; accv[2 * q2] += w.re * bb[0] - w.im * bb[1]; accv[2 * q2 + 1] += w.re * bb[2] - w.im * bb[3]; }
                }
#pragma unroll
                for (int q = 0; q < 16; ++q) { accv[q] += __shfl_xor(accv[q], 1); accv[q] += __shfl_xor(accv[q], 2); }
                if (pq == 0 && slot <= 64) {
                    u32x4 o0, o1; o0.x = pk2(accv[0], accv[1]); o0.y = pk2(accv[2], accv[3]); o0.z = pk2(accv[4], accv[5]); o0.w = pk2(accv[6], accv[7]);
                    o1.x = pk2(accv[8], accv[9]); o1.y = pk2(accv[10], accv[11]); o1.z = pk2(accv[12], accv[13]); o1.w = pk2(accv[14], accv[15]);
                    u32x4* dst = (u32x4*)(KT + ((size_t)(g * 65 + slot) * HS + h) * 16); dst[0] = o0; dst[1] = o1;
                }
            }
            for (int cb = F.bx; cb < DEPTH * NG * 17; cb += F.G) {
                const int l = cb / (NG * 17), rb = cb % (NG * 17);
                if (rb < NG * 9) continue;
                const int blk = rb - NG * 9;
                TBL_PTRS(l);
                const int g = blk >> 3, t0 = (blk & 7) * 8;
                const float step = expf(log_step[g]);
                __syncthreads();
                LAS float* cgl = pwl + 1024;
                { const int p = F.tid & 63, tl = F.tid >> 6; const Cplx w = lam_pow_fast(lam_re[g * NP + p], lam_im[g * NP + p], step, t0 + tl + 1); pwl[(tl * 64 + p) * 2] = w.re; pwl[(tl * 64 + p) * 2 + 1] = w.im; }
                for (int idx = F.tid; idx < 1024; idx += NTHREADS) { cgl[2 * idx] = c_re[(size_t)g * HS * NP + idx]; cgl[2 * idx + 1] = c_im[(size_t)g * HS * NP + idx]; }
                __syncthreads();
                const int pq = F.tid & 3, h = (F.tid >> 2) & 15, tl = F.tid >> 6, t = t0 + tl;
                bf16_t* dst = HT + ((size_t)(g * 1024 + t * 16 + h) * 128 + pq * 32);
                for (int pp = 0; pp < 16; pp += 4) {
                    float v[8];
#pragma unroll
                    for (int q = 0; q < 4; ++q) { const int p = pq * 16 + pp + q;
                        const Cplx w = cmul(Cplx{cgl[(h * 64 + p) * 2], cgl[(h * 64 + p) * 2 + 1]}, Cplx{pwl[(tl * 64 + p) * 2], pwl[(tl * 64 + p) * 2 + 1]});
                        v[2 * q] = w.re; v[2 * q + 1] = -w.im; }
                    u32x4 o; o.x = pk2(v[0], v[1]); o.y = pk2(v[2], v[3]); o.z = pk2(v[4], v[5]); o.w = pk2(v[6], v[7]);
                    *(u32x4*)(dst + 2 * pp) = o;
                }
            }
            __syncthreads();
        }
    }
#undef TBL_PTRS
    if (!(PMODE & 2)) for (int l = 0; l < DEPTH; ++l) {
        const float* lam_re = arg_in(3) + l * NG * NP; const float* lam_im = arg_in(4) + l * NG * NP; const float* log_step = arg_in(5) + l * NG;
        const float* b_re = arg_in(6) + (size_t)l * NG * NP * HS; const float* b_im = arg_in(7) + (size_t)l * NG * NP * HS;
        const float* c_re = arg_in(8) + (size_t)l * NG * HS * NP; const float* c_im = arg_in(9) + (size_t)l * NG * HS * NP;
        bf16_t* KT = (bf16_t*)(ws + WS_KT + l * KT_STRIDE); bf16_t* GT = (bf16_t*)(ws + WS_GT + l * GT_STRIDE); bf16_t* HT = (bf16_t*)(ws + WS_HT + l * HT_STRIDE);
        float* LAML = (float*)(ws + WS_LAML + l * LAML_STRIDE);
        for (int i = gt; i < NG * NP * 64; i += NGT) {
            const int s = i % 64, p = (i / 64) % NP, g = i / (64 * NP);
            const float step = expf(log_step[g]); const float lr = lam_re[g * NP + p], li = lam_im[g * NP + p];
            const Cplx w = cmul(lam_pow_fast(lr, li, step, 63 - s), bbar_factor(lr, li, step));
            float vr[16], vi[16];
#pragma unroll
            for (int q = 0; q < 16; ++q) { const float br = b_re[(size_t)(g * NP + p) * HS + q], bi = b_im[(size_t)(g * NP + p) * HS + q]; vr[q] = w.re * br - w.im * bi; vi[q] = w.re * bi + w.im * br; }
            u32x4* dr = (u32x4*)(GT + ((size_t)(g * 128 + 2 * p) * 1024 + s * 16)); u32x4* di = (u32x4*)(GT + ((size_t)(g * 128 + 2 * p + 1) * 1024 + s * 16));
            u32x4 o; o.x = pk2(vr[0], vr[1]); o.y = pk2(vr[2], vr[3]); o.z = pk2(vr[4], vr[5]); o.w = pk2(vr[6], vr[7]); dr[0] = o;
            o.x = pk2(vr[8], vr[9]); o.y = pk2(vr[10], vr[11]); o.z = pk2(vr[12], vr[13]); o.w = pk2(vr[14], vr[15]); dr[1] = o;
            o.x = pk2(vi[0], vi[1]); o.y = pk2(vi[2], vi[3]); o.z = pk2(vi[4], vi[5]); o.w = pk2(vi[6], vi[7]); di[0] = o;
            o.x = pk2(vi[8], vi[9]); o.y = pk2(vi[10], vi[11]); o.z = pk2(vi[12], vi[13]); o.w = pk2(vi[14], vi[15]); di[1] = o;
        }
        for (int i = gt; i < NG * NP; i += NGT) { const int g = i / NP; const Cplx w = lam_pow(lam_re[i], lam_im[i], expf(log_step[g]), 64); LAML[2 * i] = w.re; LAML[2 * i + 1] = w.im; }
    }
    {
        const float* xin = arg_in(0); const float* g0 = arg_in(1); bf16_t* XN = (bf16_t*)(ws + WS_XN);
        f32x4 va[4], vb[4];
        int m = gw;
        if (m < T) {
#pragma unroll
            for (int j = 0; j < 4; ++j) va[j] = ((const f32x4*)(xin + (size_t)m * D) + lane)[64 * j]; }
        while (m < T) {
            const int mb = m + NGW;
            if (mb < T) {
#pragma unroll
                for (int j = 0; j < 4; ++j) vb[j] = ((const f32x4*)(xin + (size_t)mb * D) + lane)[64 * j]; }
            rms_row_to_bf16(va, g0, XN + (size_t)m * D, lane);
            if (mb >= T) break;
            const int mc = mb + NGW;
            if (mc < T) {
#pragma unroll
                for (int j = 0; j < 4; ++j) va[j] = ((const f32x4*)(xin + (size_t)mc * D) + lane)[64 * j]; }
            rms_row_to_bf16(vb, g0, XN + (size_t)mb * D, lane);
            m = mc;
        }
    }
}

__device__ __forceinline__ void s5a_phase(Frame& F, int l) {
    const bf16_t* GT = (const bf16_t*)(F.ws + WS_GT + l * GT_STRIDE); const bf16_t* U = (const bf16_t*)(F.ws + WS_U); float* S = (float*)(F.ws + WS_S);
    const int lane = F.lane, n = lane & 15, kq = lane >> 4;
    for (int uu = F.bx * NWAVES + F.wave; uu < NG * 32 * 2; uu += F.G * NWAVES) {
        const int g = uu >> 6, ntile = (uu >> 1) & 31, mh = uu & 1;
        const int chunk = ntile * 16 + n;
        const bf16_t* up = U + ((size_t)chunk * 64 + (kq >> 1)) * DS + g * 16 + 8 * (kq & 1);
        const bf16_t* gp = GT + ((size_t)(g * 128 + mh * 64 + n) * 1024 + 8 * kq);
        f32x4 acc[4];
#pragma unroll
        for (int mt = 0; mt < 4; ++mt) acc[mt] = (f32x4){0.f, 0.f, 0.f, 0.f};
#pragma unroll 4
        for (int ks = 0; ks < 32; ++ks) {
            const bf16x8 b = *(const bf16x8*)(up + (size_t)(2 * ks) * DS);
#pragma unroll
            for (int mt = 0; mt < 4; ++mt) { const bf16x8 a = *(const bf16x8*)(gp + (size_t)(mt * 16) * 1024 + 32 * ks); acc[mt] = __builtin_amdgcn_mfma_f32_16x16x32_bf16(a, b, acc[mt], 0, 0, 0); }
        }
#pragma unroll
        for (int mt = 0; mt < 4; ++mt) *(f32x4*)(S + ((size_t)chunk * NG + g) * 128 + mh * 64 + mt * 16 + 4 * kq) = acc[mt];
    }
}
__device__ __forceinline__ void s5c_phase(Frame& F, int l) {
    const bf16_t* KT = (const bf16_t*)(F.ws + WS_KT + l * KT_STRIDE); const bf16_t* HT = (const bf16_t*)(F.ws + WS_HT + l * HT_STRIDE);
    const float* LAML = (const float*)(F.ws + WS_LAML + l * LAML_STRIDE); const float* S = (const float*)(F.ws + WS_S);
    const bf16_t* U = (const bf16_t*)(F.ws + WS_U); bf16_t* YG = (bf16_t*)(F.ws + WS_YG); const float* dsk = arg_in(10) + l * DS;
    const int lane = F.lane, n = lane & 15, kq = lane >> 4, wave = F.wave;
    LAS unsigned char* ktl = F.lds + LDS_RING;
    LAS unsigned char* xs = F.lds + LDS_RING + 33792 + wave * 4096;
    LAS f32x2* EB = (LAS f32x2*)(F.lds + LDS_RING + 33792 + 8 * 4096);
    LAS f32x2* EH = EB + 512;
    for (int wu = F.bx; wu < NG * 8; wu += F.G) {
        const int g = wu >> 3, scq = wu & 7, b = scq >> 1, cbase = (scq & 1) * 64, scl = wave >> 1, par = wave & 1;
        __syncthreads();
        for (int i = F.tid; i < 65 * 32; i += NTHREADS) *(LAS u32x4*)(ktl + i * 16) = *(const u32x4*)(KT + (size_t)g * 65 * 256 + i * 8);
        const Cplx L = Cplx{LAML[(g * NP + lane) * 2], LAML[(g * NP + lane) * 2 + 1]};
        const float* sp = S + ((size_t)(b * CPB) * NG + g) * 128 + 2 * lane;
        {
            f32x2 sv[8];
#pragma unroll
            for (int j = 0; j < 8; ++j) sv[j] = *(const f32x2*)(sp + (size_t)(cbase + 8 * wave + j) * NG * 128);
            Cplx E{0.f, 0.f};
#pragma unroll
            for (int j = 0; j < 8; ++j) { const Cplx nx = cmul(L, E); E.re = nx.re + sv[j][0]; E.im = nx.im + sv[j][1]; }
            EB[wave * 64 + lane] = (f32x2){E.re, E.im};
            if (cbase) {
#pragma unroll
                for (int j = 0; j < 8; ++j) sv[j] = *(const f32x2*)(sp + (size_t)(8 * wave + j) * NG * 128);
                Cplx H{0.f, 0.f};
#pragma unroll
                for (int j = 0; j < 8; ++j) { const Cplx nx = cmul(L, H); H.re = nx.re + sv[j][0]; H.im = nx.im + sv[j][1]; }
                EH[wave * 64 + lane] = (f32x2){H.re, H.im};
            }
        }
        __syncthreads();
        const int c0 = cbase + 16 * scl;
        {
            const Cplx L2 = cmul(L, L), L4 = cmul(L2, L2), L8 = cmul(L4, L4);
            Cplx X{0.f, 0.f};
            if (cbase) {
#pragma unroll
                for (int w = 0; w < 8; ++w) { const f32x2 e = EH[w * 64 + lane]; const Cplx nx = cmul(L8, X); X.re = nx.re + e[0]; X.im = nx.im + e[1]; }
            }
            for (int w = 0; w < 2 * scl; ++w) { const f32x2 e = EB[w * 64 + lane]; const Cplx nx = cmul(L8, X); X.re = nx.re + e[0]; X.im = nx.im + e[1]; }
            f32x2 sv[16];
#pragma unroll
            for (int j = 0; j < 16; ++j) sv[j] = *(const f32x2*)(sp + (size_t)(c0 + j) * NG * 128);
#pragma unroll
            for (int j = 0; j < 16; ++j) {
                *(LAS unsigned*)(xs + j * 256 + 4 * lane) = pk2(X.re, X.im);
                const Cplx nx = cmul(L, X); X.re = nx.re + sv[j][0]; X.im = nx.im + sv[j][1];
            }
        }
        const int chunk = b * CPB + c0 + n;
        bf16x8 ub[32];
        {
            const bf16_t* up = U + ((size_t)chunk * 64 + (kq >> 1)) * DS + g * 16 + 8 * (kq & 1);
#pragma unroll
            for (int kp = 0; kp < 32; ++kp) ub[kp] = *(const bf16x8*)(up + (size_t)(2 * kp) * DS);
        }
        const LAS unsigned char* xbp = xs + n * 256 + 16 * kq;
        const f32x4 dv = *(const f32x4*)(dsk + g * 16 + 4 * kq);
        const bf16_t* hp = HT + ((size_t)(g * 1024 + n) * 128 + 8 * kq);
        const bf16_t* uq = U + (size_t)chunk * 64 * DS + g * 16 + 4 * kq;
        const LAS unsigned char* kbase = ktl + (n * 16 + 8 * (kq & 1)) * 2;
        bf16x8 ha[4]; u32x2 uw;
#pragma unroll
        for (int ks = 0; ks < 4; ++ks) ha[ks] = *(const bf16x8*)(hp + (size_t)(par * 16) * 128 + 32 * ks);
        uw = *(const u32x2*)(uq + (size_t)par * DS);
        for (int ti = 0; ti < 32; ++ti) {
            const int t = 2 * ti + par, tn = (ti < 31) ? t + 2 : t;
            bf16x8 hn[4]; u32x2 un;
#pragma unroll
            for (int ks = 0; ks < 4; ++ks) hn[ks] = *(const bf16x8*)(hp + (size_t)(tn * 16) * 128 + 32 * ks);
            un = *(const u32x2*)(uq + (size_t)tn * DS);
            f32x4 acc = (f32x4){0.f, 0.f, 0.f, 0.f};
            const int slot0 = t + 1 - (kq >> 1);
#pragma unroll
            for (int kp = 0; kp < 32; ++kp) {
                if (kp <= ti) { const bf16x8 a = *(const LAS bf16x8*)(kbase + (slot0 - 2 * kp) * 512); acc = __builtin_amdgcn_mfma_f32_16x16x32_bf16(a, ub[kp], acc, 0, 0, 0); }
            }
#pragma unroll
            for (int ks = 0; ks < 4; ++ks) acc = __builtin_amdgcn_mfma_f32_16x16x32_bf16(ha[ks], *(const LAS bf16x8*)(xbp + 64 * ks), acc, 0, 0, 0);
            const float y0 = acc[0] + dv[0] * bf_lo(uw.x), y1 = acc[1] + dv[1] * bf_hi(uw.x), y2 = acc[2] + dv[2] * bf_lo(uw.y), y3 = acc[3] + dv[3] * bf_hi(uw.y);
            u32x2 w; w.x = cvt_pk_bf16(gelu_tanh(y0), gelu_tanh(y1)); w.y = cvt_pk_bf16(gelu_tanh(y2), gelu_tanh(y3));
            *(u32x2*)(YG + ((size_t)chunk * 64 + t) * DS + g * 16 + 4 * kq) = w;
#pragma unroll
            for (int ks = 0; ks < 4; ++ks) ha[ks] = hn[ks];
            uw = un;
        }
    }
    __syncthreads();
}

namespace att {
constexpr int KSLOT = 16384, VSLOT = 16384, LDS_K = 0, LDS_V = 3 * KSLOT, LDS_WS = 6 * 16384, LDS_END = LDS_WS + 8 * 256;
constexpr int STG_ROW = 136;
__device__ __forceinline__ int crow(int r, int hi) { return (r & 3) + 8 * (r >> 2) + 4 * hi; }
__device__ __forceinline__ void glds16(const void* gsrc, unsigned lds_dst) { unsigned keep;
    asm volatile("s_mov_b32 %0, m0\n\ts_mov_b32 m0, %2\n\ts_nop 0\n\tglobal_load_lds_dwordx4 %1, off\n\ts_mov_b32 m0, %0" : "=&s"(keep) : "v"(gsrc), "s"(lds_dst) : "memory"); }
typedef __attribute__((address_space(3))) const char* lds_cptr;
typedef short v4i16_t __attribute__((ext_vector_type(4)));
__device__ __forceinline__ s16x4 vtr(lds_cptr p) { return __builtin_bit_cast(s16x4, __builtin_amdgcn_ds_read_tr16_b64_v4i16((__attribute__((address_space(3))) v4i16_t*)p)); }
#define ATT_WAIT_BAR(N) asm volatile("s_waitcnt vmcnt(" #N ") lgkmcnt(0)\n\ts_barrier" ::: "memory")

template <int MODE> __device__ __forceinline__ void attn_unit(int bh, int qb, const bf16_t* Q, const bf16_t* K, const bf16_t* V, bf16_t* MIX, const float* subg, float lam, float mshift, float oml,
                                          LAS unsigned char* shm, int tid) {
    const int lane = tid & 63, r32 = lane & 31, hi = lane >> 5; const int wid = __builtin_amdgcn_readfirstlane(tid >> 6);
    const int b = bh >> 2, h = bh & 3, m = wid & 1, qg = wid >> 1;
    const size_t rowbase = (size_t)b * SEQ; const int q0 = qb * 128;
    const int NT = 2 * qb + 2, cw = 2 * qb + (qg >> 1);
    const unsigned lds0 = (unsigned)(uintptr_t)shm;
    const unsigned char* k0src = (const unsigned char*)K + (rowbase + lane) * DA + h * 128 + (wid >> 2) * 64 + ((wid >> 1) & 1) * 32 + (wid & 1) * 16;
    const bf16_t* v0src = V + (rowbase + 16 * (wid & 3) + (lane >> 2)) * DA + h * 128 + (wid >> 2) * 32 + (lane & 3) * 8;
    const bf16_t* v1src = v0src + 64;
    const unsigned kdst = lds0 + LDS_K + (wid >> 2) * 4096 + (wid & 3) * 1024, vdst = lds0 + LDS_V + wid * 1024;
#define ATT_DMA(t, slot) do { const size_t _o = (size_t)(t) * 64 * DA; \
        glds16(k0src + _o, (unsigned)__builtin_amdgcn_readfirstlane(kdst + (slot) * KSLOT)); glds16(k1src + _o, (unsigned)__builtin_amdgcn_readfirstlane(kdst + (slot) * KSLOT + 8192)); \
        glds16(v0src + _o, (unsigned)__builtin_amdgcn_readfirstlane(vdst + (slot) * VSLOT)); glds16(v1src + _o, (unsigned)__builtin_amdgcn_readfirstlane(vdst + (slot) * VSLOT + 8192)); } while (0)
    v8i32 qf;
    { const unsigned char* Qw = (const unsigned char*)Q + (rowbase + q0 + qg * 32 + r32) * DA + h * 128 + m * 64 + hi * 32;
      const u32x4 ql = *(const u32x4*)(Qw), qh = *(const u32x4*)(Qw + 16); qf = __builtin_bit_cast(v8i32, __builtin_shufflevector(ql, qh, 0, 1, 2, 3, 4, 5, 6, 7)); }
#ifndef ATT_GRP
#define ATT_GRP (wid & 1)
#endif
    const int grp = ATT_GRP;
#define ATT_DMA_K(t, slot) do { if (MODE & 1) break; const size_t _o = (size_t)(t) * 64 * DA; \
        glds16(k0src + _o, (unsigned)__builtin_amdgcn_readfirstlane(kdst + (slot) * KSLOT)); } while (0)
#define ATT_DMA_V(t, slot) do { if (MODE & 1) break; const size_t _o = (size_t)(t) * 64 * DA; \
        glds16(v0src + _o, (unsigned)__builtin_amdgcn_readfirstlane(vdst + (slot) * VSLOT)); glds16(v1src + _o, (unsigned)__builtin_amdgcn_readfirstlane(vdst + (slot) * VSLOT + 8192)); } while (0)
    ATT_DMA_K(0, 0); ATT_DMA_V(0, 0); ATT_DMA_K(1, 1); ATT_DMA_V(1, 1);
    f32x16 o[4];
#pragma unroll
    for (int d = 0; d < 4; ++d)
#pragma unroll
        for (int r = 0; r < 16; ++r) o[d][r] = 0.f;
    float l_reg = 0.f;
    const f32x16 zero16 = {0.f, 0.f, 0.f, 0.f, 0.f, 0.f, 0.f, 0.f, 0.f, 0.f, 0.f, 0.f, 0.f, 0.f, 0.f, 0.f};
    (void)mshift;
    const lds_cptr shm3 = (lds_cptr)shm;
    const lds_cptr kp0 = shm3 + LDS_K + m * 4096 + hi * 2048 + r32 * 16;
    const lds_cptr vp0 = shm3 + LDS_V + ((lane >> 4) & 1) * 32 + (lane & 3) * 8 + (4 * hi + ((lane & 15) >> 2)) * 64;
    u32x4 pw[4];
#pragma unroll
    for (int q = 0; q < 4; ++q) pw[q] = (u32x4){0u, 0u, 0u, 0u};
#define ATT_SB() __builtin_amdgcn_sched_barrier(0)
#define ATT_QKEXP(sl) do { if (MODE & 2) break; const lds_cptr kp = kp0 + (sl) * KSLOT; \
        ATT_SB(); \
        const u32x4 k0l = *(const __attribute__((address_space(3))) u32x4*)(kp), k0h = *(const __attribute__((address_space(3))) u32x4*)(kp + 1024); \
        const u32x4 k1l = *(const __attribute__((address_space(3))) u32x4*)(kp + 512), k1h = *(const __attribute__((address_space(3))) u32x4*)(kp + 1024 + 512); \
        ATT_SB(); \
        const v8i32 kf0 = __builtin_bit_cast(v8i32, __builtin_shufflevector(k0l, k0h, 0, 1, 2, 3, 4, 5, 6, 7)), kf1 = __builtin_bit_cast(v8i32, __builtin_shufflevector(k1l, k1h, 0, 1, 2, 3, 4, 5, 6, 7)); \
        f32x16 p0 = __builtin_amdgcn_mfma_scale_f32_32x32x64_f8f6f4(kf0, qf, zero16, 0, 0, 0, 0x7a7b, 1, 0x7a7b); \
        f32x16 p1 = __builtin_amdgcn_mfma_scale_f32_32x32x64_f8f6f4(kf1, qf, zero16, 0, 0, 0, 0x7a7b, 1, 0x7a7b); \
        ATT_SB(); \
        float sacc = 0.f; \
        _Pragma("unroll") for (int r = 0; r < 16; ++r) { p0[r] = __builtin_amdgcn_exp2f(p0[r]); p1[r] = __builtin_amdgcn_exp2f(p1[r]); sacc += p0[r] + p1[r]; } \
        l_reg += sacc; \
        _Pragma("unroll") for (int q = 0; q < 4; ++q) { pw[0][q] = cvt_pk_bf16(p0[2 * q], p0[2 * q + 1]); pw[1][q] = cvt_pk_bf16(p0[8 + 2 * q], p0[8 + 2 * q + 1]); \
                                                        pw[2][q] = cvt_pk_bf16(p1[2 * q], p1[2 * q + 1]); pw[3][q] = cvt_pk_bf16(p1[8 + 2 * q], p1[8 + 2 * q + 1]); } } while (0)
#define ATT_VRD(buf, d) do { _Pragma("unroll") for (int ks = 0; ks < 4; ++ks) { buf[0][ks] = vtr(vp + (d) * 4096 + ks * 1024); buf[1][ks] = vtr(vp + (d) * 4096 + ks * 1024 + 512); } } while (0)
#define ATT_VMM(buf, d) do { _Pragma("unroll") for (int ks = 0; ks < 4; ++ks) { \
        const bf16x8 vf = (bf16x8){buf[0][ks][0], buf[0][ks][1], buf[0][ks][2], buf[0][ks][3], buf[1][ks][0], buf[1][ks][1], buf[1][ks][2], buf[1][ks][3]}; \
        o[d] = __builtin_amdgcn_mfma_f32_32x32x16_bf16(__builtin_bit_cast(bf16x8, pw[ks]), vf, o[d], 0, 0, 0); } } while (0)
#define ATT_PV(sl) do { if (MODE & 4) break; const lds_cptr vp = vp0 + (sl) * VSLOT; s16x4 va[2][4], vb[2][4]; \
        ATT_SB(); ATT_VRD(va, 0); ATT_SB(); ATT_VRD(vb, 1); ATT_SB(); ATT_VMM(va, 0); ATT_SB(); ATT_VRD(va, 2); ATT_SB(); ATT_VMM(vb, 1); ATT_SB(); \
        ATT_VRD(vb, 3); ATT_SB(); ATT_VMM(va, 2); ATT_SB(); ATT_VMM(vb, 3); ATT_SB(); } while (0)
#ifndef ATT_TWO_GROUP
#define ATT_TWO_GROUP 0
#endif
    int sk = 0, skm1 = 2;
    if (ATT_TWO_GROUP) {
        for (int k = 0; k <= NT; ++k) {
            if (k + 1 < NT) { ATT_WAIT_BAR(3); } else { ATT_WAIT_BAR(0); }
            if (k + 2 < NT) ATT_DMA_K(k + 2, skm1);
            if (grp == 0) { if (k <= cw) ATT_QKEXP(sk); }
            else          { if (k >= 1 && k - 1 <= cw) ATT_PV(skm1); }
            if (k == NT) break;
            if (k + 2 < NT) { ATT_WAIT_BAR(3); } else { ATT_WAIT_BAR(0); }
            if (k + 2 < NT) ATT_DMA_V(k + 2, skm1);
            if (grp == 0) { if (k <= cw) ATT_PV(sk); }
            else          { if (k <= cw) ATT_QKEXP(sk); }
            skm1 = sk; sk = (sk == 2) ? 0 : sk + 1;
        }
    } else {
        for (int k = 0; k < NT; ++k) {
            if (k + 1 < NT) { ATT_WAIT_BAR(3); } else { ATT_WAIT_BAR(0); }
            if (k + 2 < NT) { ATT_DMA_K(k + 2, skm1); ATT_DMA_V(k + 2, skm1); }
            if (k <= cw) { ATT_QKEXP(sk); ATT_PV(sk); }
            skm1 = sk; sk = (sk == 2) ? 0 : sk + 1;
        }
    }
#undef ATT_QKEXP
#undef ATT_PV
#undef ATT_VRD
#undef ATT_VMM
#undef ATT_SB
#undef ATT_DMA_K
#undef ATT_DMA_V
    { auto rr = __builtin_amdgcn_permlane32_swap(__float_as_uint(l_reg), __float_as_uint(l_reg), false, false); l_reg = __uint_as_float(rr[0]) + __uint_as_float(rr[1]); }
    LAS float* wsf = (LAS float*)(shm + LDS_WS) + wid * 64;
    if (hi == 0) wsf[r32] = l_reg;
    ATT_WAIT_BAR(0);
    float rli[16];
    const float scl = m ? lam : 1.0f;
#pragma unroll
    for (int r = 0; r < 16; ++r) rli[r] = scl * __builtin_amdgcn_rcpf(wsf[crow(r, hi)]);
    LAS float* stg = (LAS float*)shm + qg * (32 * STG_ROW);
    if (m == 1) {
#pragma unroll
        for (int r = 0; r < 16; ++r)
#pragma unroll
            for (int d = 0; d < 4; ++d) stg[crow(r, hi) * STG_ROW + d * 32 + r32] = o[d][r] * rli[r];
    }
    ATT_WAIT_BAR(0);
    if (m == 0) {
#pragma unroll
        for (int r = 0; r < 16; ++r)
#pragma unroll
            for (int d = 0; d < 4; ++d) { LAS float* p = stg + crow(r, hi) * STG_ROW + d * 32 + r32; *p = o[d][r] * rli[r] - *p; }
    }
    ATT_WAIT_BAR(0);
    {
        const int row = 16 * m + (lane >> 2), qt = lane & 3;
        const LAS float* p = stg + row * STG_ROW + qt * 32;
        f32x4 v[8]; float ss = 0.f;
#pragma unroll
        for (int i = 0; i < 8; ++i) { v[i] = *(const LAS f32x4*)(p + 4 * i); ss += (v[i][0] * v[i][0] + v[i][1] * v[i][1]) + (v[i][2] * v[i][2] + v[i][3] * v[i][3]); }
        ss += __shfl_xor(ss, 1); ss += __shfl_xor(ss, 2);
        const float rn = rsqrtf(ss * (1.f / 128.f) + EPS) * oml;
        bf16_t* dst = MIX + (rowbase + q0 + qg * 32 + row) * D + DS + h * 128 + qt * 32;
#pragma unroll
        for (int i = 0; i < 4; ++i) {
            const f32x4 g0 = *(const f32x4*)(subg + qt * 32 + 8 * i), g1 = *(const f32x4*)(subg + qt * 32 + 8 * i + 4);
            const f32x4 a = v[2 * i] * g0 * rn, c = v[2 * i + 1] * g1 * rn;
            u32x4 w; w.x = cvt_pk_bf16(a[0], a[1]); w.y = cvt_pk_bf16(a[2], a[3]); w.z = cvt_pk_bf16(c[0], c[1]); w.w = cvt_pk_bf16(c[2], c[3]);
            *(u32x4*)(dst + 8 * i) = w;
        }
    }
    ATT_WAIT_BAR(0);
#undef ATT_DMA
}
}
template <int MODE> __device__ __forceinline__ void attn_phase(Frame& F, int l) {
    const bf16_t* Q = (const bf16_t*)(F.ws + WS_Q); const bf16_t* K = (const bf16_t*)(F.ws + WS_K); const bf16_t* V = (const bf16_t*)(F.ws + WS_V);
    bf16_t* MIX = (bf16_t*)(F.ws + WS_MIX);
    const float* sc = (const float*)(F.ws + WS_SCAL) + l * 4;
    const float lam = sc[0], mshift = sc[1], oml = sc[2];
    const float* subg = arg_in(19) + l * DV;
    const int G = F.G;
#ifndef ATT_XA
#define ATT_XA 1
#endif
    const bool xa = ATT_XA && (G & 7) == 0;
    const int x = F.bx & 7, j = F.bx >> 3, wpx = xa ? (G >> 3) : 1;
    const int npair = xa ? (32 - j + wpx - 1) / wpx : 0;
    const int nit = xa ? 4 * npair : (1024 - F.bx + G - 1) / G;
#pragma unroll 1
    for (int it = 0; it < nit; ++it) {
        int bh, qb;
        if (xa) { const int r = it / (2 * npair), rem = it % (2 * npair), sidx = j + (rem >> 1) * wpx; bh = 2 * x + r; qb = (rem & 1) ? sidx : 63 - sidx; }
        else { const int v = F.bx + it * G; bh = v >> 6; qb = v & 63; }
        att::attn_unit<MODE>(bh, qb, Q, K, V, MIX, subg, lam, mshift, oml, F.lds + LDS_RING, F.tid);
    }
}

__device__ __forceinline__ void router_phase(Frame& F, int l) {
    const bf16_t* h1 = (const bf16_t*)(F.ws + WS_H1); const float* g = arg_in(21) + (size_t)l * D; const float* br = arg_in(23) + l * NE;
    const bf16_t* WRT = (const bf16_t*)(F.ws + WS_WRT + l * WRT_STRIDE);
    bf16_t* XN = (bf16_t*)(F.ws + WS_XN); int* TOPI = (int*)(F.ws + WS_TOPI); float* TOPG = (float*)(F.ws + WS_TOPG); int* WGCNT = (int*)(F.ws + WS_WGCNT); float* RS = (float*)(F.ws + WS_RS);
    const int lane = F.lane, tid = F.tid, wave = F.wave, n = lane & 15, kq = lane >> 4;
    constexpr int PITCH = 2080;
    LAS unsigned char* wl = F.lds + LDS_RING;
    LAS float* lg = (LAS float*)(F.lds + LDS_RING + 2 * 32 * PITCH) + wave * (16 * 33 + 16);
    LAS int* cnt = (LAS int*)(F.ctl + 256);
    __syncthreads();
    for (int i = tid; i < 2 * NE * 128; i += NTHREADS) { const int row = i >> 7, c = i & 127; *(LAS u32x4*)(wl + row * PITCH + c * 16) = *(const u32x4*)(WRT + (size_t)row * D + c * 8); }
    if (tid < 32) cnt[tid] = 0;
    __syncthreads();
    for (int wgu = F.bx; wgu < T / 128; wgu += F.G) {
        if (wgu != F.bx) { __syncthreads(); if (tid < 32) cnt[tid] = 0; __syncthreads(); }
        const int row = wgu * 128 + wave * 16 + n;
        const bf16_t* hp = h1 + (size_t)row * D + 8 * kq; const float* gp = g + 8 * kq;
        bf16_t* xp = XN + (size_t)row * D + 8 * kq; unsigned char* xp8 = (unsigned char*)XN + (size_t)row * D + 8 * kq;
        const LAS unsigned char* bh = wl + n * PITCH + 16 * kq;
        f32x4 acc0 = (f32x4){0.f, 0.f, 0.f, 0.f}, acc1 = acc0; float ss = 0.f;
#pragma unroll 4
        for (int ks = 0; ks < 32; ++ks) {
            const u32x4 hw = *(const u32x4*)(hp + 32 * ks); const f32x4 h0 = (f32x4){bf_lo(hw.x), bf_hi(hw.x), bf_lo(hw.y), bf_hi(hw.y)}, h4 = (f32x4){bf_lo(hw.z), bf_hi(hw.z), bf_lo(hw.w), bf_hi(hw.w)};
            const f32x4 g0 = *(const f32x4*)(gp + 32 * ks), g4 = *(const f32x4*)(gp + 32 * ks + 4);
            const f32x4 x0 = h0 * g0, x4 = h4 * g4;
            ss += (x0[0] * x0[0] + x0[1] * x0[1]) + (x0[2] * x0[2] + x0[3] * x0[3]) + (x4[0] * x4[0] + x4[1] * x4[1]) + (x4[2] * x4[2] + x4[3] * x4[3]);
            u32x4 hi; hi.x = cvt_pk_bf16(x0[0], x0[1]); hi.y = cvt_pk_bf16(x0[2], x0[3]); hi.z = cvt_pk_bf16(x4[0], x4[1]); hi.w = cvt_pk_bf16(x4[2], x4[3]);
            if (UP_FP8) { u32x2 w8; w8.x = pk4_fp8(x0[0] * 8.f, x0[1] * 8.f, x0[2] * 8.f, x0[3] * 8.f); w8.y = pk4_fp8(x4[0] * 8.f, x4[1] * 8.f, x4[2] * 8.f, x4[3] * 8.f); *(u32x2*)(xp8 + 32 * ks) = w8; }
            else *(u32x4*)(xp + 32 * ks) = hi;
            u32x4 lo;
            lo.x = cvt_pk_bf16(x0[0] - bf_lo(hi.x), x0[1] - bf_hi(hi.x)); lo.y = cvt_pk_bf16(x0[2] - bf_lo(hi.y), x0[3] - bf_hi(hi.y));
            lo.z = cvt_pk_bf16(x4[0] - bf_lo(hi.z), x4[1] - bf_hi(hi.z)); lo.w = cvt_pk_bf16(x4[2] - bf_lo(hi.w), x4[3] - bf_hi(hi.w));
            const bf16x8 ah = __builtin_bit_cast(bf16x8, hi), al = __builtin_bit_cast(bf16x8, lo);
            const bf16x8 b0h = *(const LAS bf16x8*)(bh + 64 * ks), b1h = *(const LAS bf16x8*)(bh + 16 * PITCH + 64 * ks);
            const bf16x8 b0l = *(const LAS bf16x8*)(bh + 32 * PITCH + 64 * ks), b1l = *(const LAS bf16x8*)(bh + 48 * PITCH + 64 * ks);
            acc0 = __builtin_amdgcn_mfma_f32_16x16x32_bf16(ah, b0h, acc0, 0, 0, 0); acc1 = __builtin_amdgcn_mfma_f32_16x16x32_bf16(ah, b1h, acc1, 0, 0, 0);
            acc0 = __builtin_amdgcn_mfma_f32_16x16x32_bf16(al, b0h, acc0, 0, 0, 0); acc1 = __builtin_amdgcn_mfma_f32_16x16x32_bf16(al, b1h, acc1, 0, 0, 0);
            acc0 = __builtin_amdgcn_mfma_f32_16x16x32_bf16(ah, b0l, acc0, 0, 0, 0); acc1 = __builtin_amdgcn_mfma_f32_16x16x32_bf16(ah, b1l, acc1, 0, 0, 0);
        }
        ss += __shfl_xor(ss, 16); ss += __shfl_xor(ss, 32);
        const float r = rsqrtf(ss * (1.f / D) + EPS);
        if (kq == 0) { lg[16 * 33 + n] = r; RS[row] = r; }
        asm volatile("s_waitcnt lgkmcnt(0)" ::: "memory");
        const float b0 = br[n], b1 = br[16 + n];
#pragma unroll
        for (int q = 0; q < 4; ++q) { const float rt = lg[16 * 33 + 4 * kq + q]; lg[(4 * kq + q) * 33 + n] = acc0[q] * rt + b0; lg[(4 * kq + q) * 33 + 16 + n] = acc1[q] * rt + b1; }
        asm volatile("s_waitcnt lgkmcnt(0)" ::: "memory");
        if (lane < 16) {
            const int tok = wgu * 128 + wave * 16 + lane;
            float v[32];
#pragma unroll
            for (int e = 0; e < 32; ++e) v[e] = lg[lane * 33 + e];
            unsigned mask = 0u; float val[4]; int sel[4];
#pragma unroll
            for (int k = 0; k < 4; ++k) { float best = -INFINITY; int bi = 0;
#pragma unroll
                for (int e = 0; e < 32; ++e) { const bool ok = !((mask >> e) & 1u) && (v[e] > best); best = ok ? v[e] : best; bi = ok ? e : bi; }
                mask |= 1u << bi; val[k] = best; sel[k] = bi; }
            float ex[4], sum = 0.f;
#pragma unroll
            for (int k = 0; k < 4; ++k) { ex[k] = __expf(val[k] - val[0]); sum += ex[k]; }
            const float inv = 1.f / sum;
#pragma unroll
            for (int k = 0; k < 4; ++k) { const int pos = __hip_atomic_fetch_add(cnt + sel[k], 1, __ATOMIC_RELAXED, __HIP_MEMORY_SCOPE_WORKGROUP);
                TOPI[tok * 4 + k] = sel[k] | (pos << 8); TOPG[tok * 4 + k] = ex[k] * inv; }
        }
        __syncthreads();
        if (tid < 32) WGCNT[wgu * 32 + tid] = cnt[tid];
    }
    __syncthreads();
}
__device__ __forceinline__ void routing_phase(Frame& F) {
    const int* TOPI = (const int*)(F.ws + WS_TOPI); const float* TOPG = (const float*)(F.ws + WS_TOPG); const int* WGCNT = (const int*)(F.ws + WS_WGCNT);
    int* TOKROW = (int*)(F.ws + WS_TOKROW); int* ROWTOK = (int*)(F.ws + WS_ROWTOK); float* ROWGATE = (float*)(F.ws + WS_ROWGATE); int* TILEEXP = (int*)(F.ws + WS_TILEEXP);
    float* ROWSCALE = (float*)(F.ws + WS_ROWSCALE); const float* RS = (const float*)(F.ws + WS_RS);
    const int tid = F.tid;
    LAS int* tot = (LAS int*)(F.lds + LDS_RING);
    LAS int* pst = tot + 32;
    LAS int* mypre = pst + 40;
    LAS int* part = mypre + 32;
    for (int wgu = F.bx; wgu < 256; wgu += F.G) {
        __syncthreads();
        {
            const int e = tid & 31, wq = tid >> 5; int a = 0, mine = 0;
#pragma unroll
            for (int j = 0; j < 16; ++j) { const int w = wq * 16 + j; const int c = WGCNT[w * 32 + e]; a += c; if (w < wgu) mine += c; }
            part[wq * 32 + e] = a; part[512 + wq * 32 + e] = mine;
        }
        __syncthreads();
        if (tid < 32) { int a = 0, mine = 0;
#pragma unroll
            for (int q = 0; q < 16; ++q) { a += part[q * 32 + tid]; mine += part[512 + q * 32 + tid]; }
            tot[tid] = a; mypre[tid] = mine; }
        __syncthreads();
        if (tid == 0) { int a = 0; for (int e = 0; e < 32; ++e) { pst[e] = a; a += (tot[e] + 255) & ~255; } pst[32] = a; }
        __syncthreads();
        {
            const int t = wgu * 128 + (tid >> 2), k = tid & 3;
            const int w = TOPI[t * 4 + k]; const int e = w & 255, pos = w >> 8;
            const int dest = pst[e] + mypre[e] + pos;
            ROWTOK[dest] = t; ROWGATE[dest] = TOPG[t * 4 + k]; ROWSCALE[dest] = RS[t]; TOKROW[t * 4 + k] = dest;
        }
        if (wgu < 32) {
            const int e = wgu; const int beg = pst[e] + tot[e], end = pst[e + 1];
            for (int r = beg + tid; r < end; r += NTHREADS) { ROWTOK[r] = 0; ROWGATE[r] = 0.f; ROWSCALE[r] = 0.f; }
        }
        if (wgu == 0) {
            const int ntiles = pst[32] >> 8;
            for (int pm = tid; pm < ntiles; pm += NTHREADS) { int e = 0; for (int q = 1; q < 32; ++q) if ((pm << 8) >= pst[q]) e = q; TILEEXP[pm] = e; }
            if (tid == 0) TILEEXP[1023] = ntiles;
            if (tid < 33) TILEEXP[768 + tid] = pst[tid];
        }
    }
    __syncthreads();
}
struct CRow { u32x4 h[2]; u32x2 y[4][2]; };
__device__ __forceinline__ void crow_load(CRow& r, const bf16_t* H1, const unsigned char* YB, const int* TOKROW, int m, int lane) {
    const bf16_t* hr = H1 + (size_t)m * D + 8 * lane;
    r.h[0] = *(const u32x4*)(hr); r.h[1] = *(const u32x4*)(hr + 512);
    const int4 tr = *(const int4*)(TOKROW + m * 4);
    const int rows[4] = {tr.x, tr.y, tr.z, tr.w};
#pragma unroll
    for (int k = 0; k < 4; ++k) { const unsigned char* yr = YB + (size_t)rows[k] * D + 8 * lane; r.y[k][0] = *(const u32x2*)(yr); r.y[k][1] = *(const u32x2*)(yr + 512); }
}
__device__ __forceinline__ void crow_finish(CRow& r, float* out32, bf16_t* H2, bf16_t* XN, const float* gnext, int m, int lane) {
    f32x4 v[4];
#pragma unroll
    for (int hf = 0; hf < 2; ++hf) { const u32x4 w = r.h[hf]; v[2 * hf] = (f32x4){bf_lo(w.x), bf_hi(w.x), bf_lo(w.y), bf_hi(w.y)}; v[2 * hf + 1] = (f32x4){bf_lo(w.z), bf_hi(w.z), bf_lo(w.w), bf_hi(w.w)}; }
#pragma unroll
    for (int k = 0; k < 4; ++k)
#pragma unroll
        for (int hf = 0; hf < 2; ++hf) { fp8x4_add(r.y[k][hf].x, 1.f / 16.f, v[2 * hf]); fp8x4_add(r.y[k][hf].y, 1.f / 16.f, v[2 * hf + 1]); }
    if (out32) { float* orow = out32 + (size_t)m * D + 8 * lane; *(f32x4*)(orow) = v[0]; *(f32x4*)(orow + 4) = v[1]; *(f32x4*)(orow + 512) = v[2]; *(f32x4*)(orow + 516) = v[3]; }
    else {
        u32x4 w; w.x = cvt_pk_bf16(v[0][0], v[0][1]); w.y = cvt_pk_bf16(v[0][2], v[0][3]); w.z = cvt_pk_bf16(v[1][0], v[1][1]); w.w = cvt_pk_bf16(v[1][2], v[1][3]);
        *(u32x4*)(H2 + (size_t)m * D + 8 * lane) = w;
        w.x = cvt_pk_bf16(v[2][0], v[2][1]); w.y = cvt_pk_bf16(v[2][2], v[2][3]); w.z = cvt_pk_bf16(v[3][0], v[3][1]); w.w = cvt_pk_bf16(v[3][2], v[3][3]);
        *(u32x4*)(H2 + (size_t)m * D + 512 + 8 * lane) = w;
    }
    if (gnext) {
        float s = 0.f;
#pragma unroll
        for (int j = 0; j < 4; ++j) s += (v[j][0] * v[j][0] + v[j][1] * v[j][1]) + (v[j][2] * v[j][2] + v[j][3] * v[j][3]);
        const float rr = rsqrtf(wave_sum(s) * (1.f / D) + EPS);
        const float* gp = gnext + 8 * lane;
        const f32x4 a0 = v[0] * *(const f32x4*)(gp) * rr, a1 = v[1] * *(const f32x4*)(gp + 4) * rr, a2 = v[2] * *(const f32x4*)(gp + 512) * rr, a3 = v[3] * *(const f32x4*)(gp + 516) * rr;
        u32x4 w; w.x = cvt_pk_bf16(a0[0], a0[1]); w.y = cvt_pk_bf16(a0[2], a0[3]); w.z = cvt_pk_bf16(a1[0], a1[1]); w.w = cvt_pk_bf16(a1[2], a1[3]);
        *(u32x4*)(XN + (size_t)m * D + 8 * lane) = w;
        w.x = cvt_pk_bf16(a2[0], a2[1]); w.y = cvt_pk_bf16(a2[2], a2[3]); w.z = cvt_pk_bf16(a3[0], a3[1]); w.w = cvt_pk_bf16(a3[2], a3[3]);
        *(u32x4*)(XN + (size_t)m * D + 512 + 8 * lane) = w;
    }
}
__device__ __forceinline__ void combine_phase(Frame& F, const float* gnext, float* out32) {
    const unsigned char* YB = (const unsigned char*)(F.ws + WS_YB); const int* TOKROW = (const int*)(F.ws + WS_TOKROW); bf16_t* XN = (bf16_t*)(F.ws + WS_XN);
    const bf16_t* H1 = (const bf16_t*)(F.ws + WS_H1); bf16_t* H2 = (bf16_t*)(F.ws + WS_H2);
    const int lane = F.lane, NGW = F.G * NWAVES;
    CRow ra, rb;
    int m = F.bx * NWAVES + F.wave;
    if (m < T) crow_load(ra, H1, YB, TOKROW, m, lane);
    while (m < T) {
        const int mb = m + NGW;
        if (mb < T) crow_load(rb, H1, YB, TOKROW, mb, lane);
        crow_finish(ra, out32, H2, XN, gnext, m, lane);
        if (mb >= T) break;
        const int mc = mb + NGW;
        if (mc < T) crow_load(ra, H1, YB, TOKROW, mc, lane);
        crow_finish(rb, out32, H2, XN, gnext, mb, lane);
        m = mc;
    }
}

constexpr int NPH_LAYER = 10, NPH = 1 + DEPTH * NPH_LAYER;
__global__ void __launch_bounds__(NTHREADS, 2) mk_fwd(Args args) {
    extern __shared__ __attribute__((aligned(16))) unsigned char lds_raw[];
    Frame F;
    F.lds = (LAS unsigned char*)lds_raw; F.ctl = F.lds + LDS_CTL; F.ws = args.ws; F.ws0 = args.ws; F.out0 = args.out; F.ap = &args; F.z = 0;
    F.tid = threadIdx.x; F.lane = F.tid & 63; F.wave = __builtin_amdgcn_readfirstlane(F.tid >> 6); F.G = gridDim.x; F.bx = blockIdx.x;
    F.out = args.out;
    for (int u = F.tid; u < 1024; u += NTHREADS) ((LAS unsigned*)F.ctl)[u] = 0u;
    __syncthreads();
    XcdBarrier bar = xcd_barrier_post((unsigned*)(F.ws + WS_CTL) + CW_BAR, (volatile LAS unsigned*)F.ctl);
    const int lo = args.ph_lo, hi = args.ph_hi;
#ifndef PHMASK
#define PHMASK 0x1fff
#endif
#define RUN(k) (lo <= (k) && (k) < hi)
#define EN(b) ((PHMASK >> (b)) & 1)
#ifndef DUPMASK
#define DUPMASK 0
#endif
#ifndef ATT_PROBE_MODE
#define ATT_PROBE_MODE 0
#endif
#ifndef GEMM_PROBE
#define GEMM_PROBE 0
#endif
#ifndef PRO_PROBE_MODE
#define PRO_PROBE_MODE 0
#endif
#define NREP(b) (((DUPMASK >> (b)) & 1) ? 2 : 1)
#define SEAM(k) do { if (RUN((k) + 1)) xcd_barrier(bar); } while (0)
    if (EN(10) && RUN(0)) { { if (NREP(10) == 2) { phase_begin(F); p0_prologue<PRO_PROBE_MODE>(F); xcd_barrier(bar); } phase_begin(F); p0_prologue<0>(F); } SEAM(0); }
    for (int l = 0; l < DEPTH; ++l) {
        const int pb = 1 + l * NPH_LAYER;
        if (EN(0) && RUN(pb + 0)) { for (int rep = 0; rep < NREP(0); ++rep) { phase_begin(F); unsigned char* ws = F.ws; (void)ws;
            PInProj P; P.so.init(T, DIN, F.G, F.bx); P.A = (const char*)(ws + WS_XN); P.B = (const char*)(ws + WS_WIN + l * WIN_STRIDE);
            P.UQKV = (bf16_t*)(ws + WS_U); P.GQK = (const float*)(ws + WS_SCAL) + 64 + l * 128; P.COS = (const float*)(ws + WS_COS); P.SIN = (const float*)(ws + WS_SIN);
            pg8::gemm_phase(F.lds + LDS_RING, F.ctl, P, F.tid);  if (rep + 1 < NREP(0)) xcd_barrier(bar); } SEAM(pb + 0);
        }
        if (EN(1) && RUN(pb + 1)) { for (int rep = 0; rep < NREP(1); ++rep) { phase_begin(F); unsigned char* ws = F.ws; (void)ws; s5a_phase(F, l);  if (rep + 1 < NREP(1)) xcd_barrier(bar); } SEAM(pb + 1); }
        if (EN(2) && RUN(pb + 2)) { for (int rep = 0; rep < NREP(2); ++rep) { phase_begin(F); unsigned char* ws = F.ws; (void)ws; if (EN(11)) for (int r2 = 0; r2 < NREP(11); ++r2) { phase_begin(F); s5c_phase(F, l); } if (EN(12)) { if (NREP(12) == 2) { phase_begin(F); attn_phase<ATT_PROBE_MODE>(F, l); } phase_begin(F); attn_phase<0>(F, l); }  if (rep + 1 < NREP(2)) xcd_barrier(bar); } SEAM(pb + 2); }
        if (EN(3) && RUN(pb + 3)) { for (int rep = 0; rep < NREP(3); ++rep) { phase_begin(F); unsigned char* ws = F.ws; (void)ws;
            PGlu P; P.so.init(T, DS, F.G, F.bx); P.A = (const char*)(ws + WS_YG); P.B = (const char*)(ws + WS_WGLU + l * WGLU_STRIDE);
            P.YG = (const bf16_t*)(ws + WS_YG); P.MIX = (bf16_t*)(ws + WS_MIX); P.RSP = (float*)(ws + WS_RSP);
            pg8::gemm_phase(F.lds + LDS_RING, F.ctl, P, F.tid);  if (rep + 1 < NREP(3)) xcd_barrier(bar); } SEAM(pb + 3);
        }
        if (EN(4) && RUN(pb + 4)) { for (int rep = 0; rep < NREP(4); ++rep) { phase_begin(F); unsigned char* ws = F.ws; (void)ws;
            POut P; P.so.init(T, D, F.G, F.bx); P.A = (const char*)(ws + WS_MIX); P.B = (const char*)(ws + WS_WOUT + l * WOUT_STRIDE);
            P.RSP = (const float*)(ws + WS_RSP); P.base32 = (l == 0) ? arg_in(0) : nullptr; P.base16 = (const bf16_t*)(ws + WS_H2); P.H1 = (bf16_t*)(ws + WS_H1);
            pg8::gemm_phase(F.lds + LDS_RING, F.ctl, P, F.tid);  if (rep + 1 < NREP(4)) xcd_barrier(bar); } SEAM(pb + 4);
        }
        if (EN(5) && RUN(pb + 5)) { for (int rep = 0; rep < NREP(5); ++rep) { phase_begin(F); unsigned char* ws = F.ws; (void)ws; router_phase(F, l);  if (rep + 1 < NREP(5)) xcd_barrier(bar); } SEAM(pb + 5); }
        if (EN(6) && RUN(pb + 6)) { for (int rep = 0; rep < NREP(6); ++rep) { phase_begin(F); unsigned char* ws = F.ws; (void)ws; routing_phase(F);  if (rep + 1 < NREP(6)) xcd_barrier(bar); } SEAM(pb + 6); }
        if (EN(7) && RUN(pb + 7)) { for (int rep = 0; rep < NREP(7); ++rep) { phase_begin(F); unsigned char* ws = F.ws; (void)ws;
            PUp P; P.mo.init(F.G, F.bx, (const int*)(ws + WS_TILEEXP) + 768);
            P.A = (const char*)(ws + WS_XN); P.B = (const char*)(ws + WS_WUP + l * WUP_STRIDE); P.ROWTOK = (const int*)(ws + WS_ROWTOK); P.TILEEXP = (const int*)(ws + WS_TILEEXP);
            P.bup = arg_in(25) + (size_t)l * NE * 2048; P.ROWSCALE = (const float*)(ws + WS_ROWSCALE); P.ACT = (bf16_t*)(ws + WS_ACT);
            if (GEMM_PROBE && rep + 1 < NREP(7)) { PUpNoDma Q; (PUp&)Q = P; pg8::gemm_phase(F.lds + LDS_RING, F.ctl, Q, F.tid); } else pg8::gemm_phase(F.lds + LDS_RING, F.ctl, P, F.tid);  if (rep + 1 < NREP(7)) xcd_barrier(bar); } SEAM(pb + 7);
        }
        if (EN(8) && RUN(pb + 8)) { for (int rep = 0; rep < NREP(8); ++rep) { phase_begin(F); unsigned char* ws = F.ws; (void)ws;
            PDown P; P.mo.init(F.G, F.bx, (const int*)(ws + WS_TILEEXP) + 768);
            P.A = (const char*)(ws + WS_ACT); P.B = (const char*)(ws + WS_WDN + l * WDN_STRIDE); P.TILEEXP = (const int*)(ws + WS_TILEEXP);
            P.bdn = arg_in(27) + (size_t)l * NE * 1024; P.ROWGATE = (const float*)(ws + WS_ROWGATE); P.YB = (bf16_t*)(ws + WS_YB);
            pg8::gemm_phase(F.lds + LDS_RING, F.ctl, P, F.tid);  if (rep + 1 < NREP(8)) xcd_barrier(bar); } SEAM(pb + 8);
        }
        if (EN(9) && RUN(pb + 9)) { for (int rep = 0; rep < NREP(9); ++rep) { phase_begin(F); unsigned char* ws = F.ws; (void)ws; combine_phase(F, (l + 1 < DEPTH) ? arg_in(1) + (size_t)(l + 1) * D : nullptr, (l + 1 < DEPTH) ? nullptr : F.out);  if (rep + 1 < NREP(9)) xcd_barrier(bar); } SEAM(pb + 9); }
    }
#undef RUN
#undef SEAM
}

extern "C" void kernel_launch(void* const* d_in, const int* in_sizes, int n_in, void* d_out, int out_size, void* d_ws, size_t ws_size, hipStream_t stream) {
    static int grid = 0;
    if (grid == 0) {
        if (n_in != 28 || out_size != T * D || ws_size < WS_END) { fprintf(stderr, "kernel_launch: unexpected shapes (n_in %d out %d ws %zu)\n", n_in, out_size, ws_size); grid = -1; return; }
        int dev = 0, cus = 0;
        if (hipGetDevice(&dev) != hipSuccess || hipDeviceGetAttribute(&cus, hipDeviceAttributeMultiprocessorCount, dev) != hipSuccess) { grid = -1; return; }
        if (hipFuncSetAttribute((const void*)mk_fwd, hipFuncAttributeMaxDynamicSharedMemorySize, LDS_BYTES) != hipSuccess) { fprintf(stderr, "kernel_launch: hipFuncSetAttribute failed\n"); grid = -1; return; }
        int per_cu = 0;
        if (hipOccupancyMaxActiveBlocksPerMultiprocessor(&per_cu, (const void*)mk_fwd, NTHREADS, LDS_BYTES) != hipSuccess || per_cu < 1) { fprintf(stderr, "kernel_launch: occupancy query says %d\n", per_cu); }
        (void)hipGetLastError();
        grid = cus;
    }
    if (grid < 0) return;
    if (hipMemsetAsync((char*)d_ws + WS_CTL, 0, CTL_ZERO_BYTES, stream) != hipSuccess) return;
    Args a{};
    for (int i = 0; i < 28; ++i) a.in[i] = (const float*)d_in[i];
    a.out = (float*)d_out; a.ws = (unsigned char*)d_ws; a.ph_lo = 0; a.ph_hi = NPH;
    hipLaunchKernelGGL(mk_fwd, dim3(grid), dim3(NTHREADS), LDS_BYTES, stream, a);
}
```

```cpp
#include <hip/hip_runtime.h>
#include <cstdio>
#include <cstdint>
#include <math.h>

#ifndef UP_FP8
#define UP_FP8 1
#endif
#ifndef DN_FP8
#define DN_FP8 1
#endif
#define LAS __attribute__((address_space(3)))
#define GAS __attribute__((address_space(1)))
typedef unsigned short bf16_t;
typedef short bf16x8 __attribute__((ext_vector_type(8)));
typedef short s16x4 __attribute__((ext_vector_type(4)));
typedef float f32x4 __attribute__((ext_vector_type(4)));
typedef float f32x2 __attribute__((ext_vector_type(2)));
typedef float f32x16 __attribute__((ext_vector_type(16)));
typedef unsigned u32x4 __attribute__((ext_vector_type(4)));
typedef unsigned u32x2 __attribute__((ext_vector_type(2)));
typedef int v8i32 __attribute__((ext_vector_type(8)));

constexpr int D = 1024, BATCH = 4, SEQ = 8192, DEPTH = 2, T = BATCH * SEQ;
constexpr int DS = 512, NG = 32, HS = 16, NP = 64, DA = 512, NH = 4, DV = 128, DIN = 2048;
constexpr int NE = 32, DFF = 1024, NASSIGN = T * 4;
constexpr int MPAD_MAX = NASSIGN + NE * 256, NTILE_MAX = MPAD_MAX / 256;
constexpr int NCHUNK = T / 64, CPB = SEQ / 64;
constexpr float EPS = 1e-6f;
constexpr float C2 = 0.125f * 1.4426950408889634f;
constexpr int NWAVES = 8, NTHREADS = 512;

constexpr size_t MiB = 1u << 20;
constexpr size_t WS_CTL = 0, CTL_ZERO_BYTES = 1 * MiB;
constexpr size_t WS_COS = 1 * MiB, WS_SIN = 2 * MiB;
constexpr size_t WS_SCAL = 3 * MiB;
constexpr size_t WS_KT = 4 * MiB, KT_STRIDE = 2 * MiB;
constexpr size_t WS_LAML = 8 * MiB, LAML_STRIDE = 32768;
constexpr size_t WS_WRT = 9 * MiB, WRT_STRIDE = 131072;
constexpr size_t WS_RS = 10 * MiB;
constexpr size_t WS_GT = 16 * MiB, GT_STRIDE = 8 * MiB;
constexpr size_t WS_HT = 32 * MiB, HT_STRIDE = 8 * MiB;
constexpr size_t WS_WIN = 48 * MiB, WIN_STRIDE = 4 * MiB;
constexpr size_t WS_WGLU = 56 * MiB, WGLU_STRIDE = MiB / 2;
constexpr size_t WS_WOUT = 58 * MiB, WOUT_STRIDE = 2 * MiB;
constexpr size_t WS_WUP = 64 * MiB, WUP_STRIDE = 128 * MiB;
constexpr size_t WS_WDN = 320 * MiB, WDN_STRIDE = 64 * MiB;
constexpr size_t WS_XN = 448 * MiB;
constexpr size_t WS_U = 512 * MiB, WS_Q = 544 * MiB, WS_K = 576 * MiB, WS_V = 608 * MiB;
constexpr size_t WS_YG = 640 * MiB;
constexpr size_t WS_MIX = 672 * MiB;
constexpr size_t WS_S = 736 * MiB;
constexpr size_t WS_RSP = 744 * MiB;
constexpr size_t WS_TOPI = 746 * MiB, WS_TOPG = 747 * MiB, WS_TOKROW = 748 * MiB, WS_WGCNT = 749 * MiB;
constexpr size_t WS_ROWTOK = 750 * MiB, WS_ROWGATE = 751 * MiB, WS_TILEEXP = 752 * MiB, WS_ROWSCALE = 753 * MiB;
constexpr size_t WS_ACT = 768 * MiB, WS_YB = 1040 * MiB, WS_H1 = 1180 * MiB, WS_H2 = 1244 * MiB, WS_END = 1312 * MiB;
constexpr int CW_BAR = 4096;

constexpr int LDS_CTL = 0;
constexpr int LDS_RING = 4096;
constexpr int LDS_BYTES = 163840;

__device__ __forceinline__ unsigned f2bf(float f) { unsigned u = __builtin_bit_cast(unsigned, f); return (u + 0x7fffu + ((u >> 16) & 1u)) >> 16; }
__device__ __forceinline__ unsigned pk2(float lo, float hi) { return f2bf(lo) | (f2bf(hi) << 16); }
__device__ __forceinline__ unsigned cvt_pk_bf16(float lo, float hi) { unsigned r; asm volatile("v_cvt_pk_bf16_f32 %0, %1, %2" : "=v"(r) : "v"(lo), "v"(hi)); return r; }
__device__ __forceinline__ unsigned pk4_fp8(float a, float b, float c, float d) { int w = 0; w = __builtin_amdgcn_cvt_pk_fp8_f32(a, b, w, false); w = __builtin_amdgcn_cvt_pk_fp8_f32(c, d, w, true); return (unsigned)w; }
__device__ __forceinline__ void fp8x4_add(unsigned w, float sc, f32x4& a) { const f32x2 lo = __builtin_amdgcn_cvt_pk_f32_fp8((int)w, false), hi = __builtin_amdgcn_cvt_pk_f32_fp8((int)w, true); a[0] += lo[0] * sc; a[1] += lo[1] * sc; a[2] += hi[0] * sc; a[3] += hi[1] * sc; }
__device__ __forceinline__ float bf_lo(unsigned w) { return __builtin_bit_cast(float, w << 16); }
__device__ __forceinline__ float bf_hi(unsigned w) { return __builtin_bit_cast(float, w & 0xffff0000u); }
__device__ __forceinline__ float wave_sum(float v) {
#pragma unroll
    for (int o = 1; o < 64; o <<= 1) v += __shfl_xor(v, o);
    return v;
}
__device__ __forceinline__ float gelu_tanh(float x) {
    const float z = 0.7978845608028654f * (x + 0.044715f * x * x * x);
    return x / (1.f + __expf(-2.f * z));
}
__device__ __forceinline__ float sigmoidf(float v) { return 1.f / (1.f + __expf(-v)); }

#define XB_TMO      128
#define XB_XCNT(j)  (256  + 64 * (j))
#define XB_XSUB(j)  (1280 + 64 * (j))
#define XB_XGEN(j)  (2304 + 64 * (j))
#define XB_TOP      3328
#define XB_TOPGEN   3392
#define XCD_BAR_WORDS 3456
#define XB_SPIN_CAP (1u << 18)
__device__ __forceinline__ unsigned xb_ld(unsigned* p)              { return __hip_atomic_load(p, __ATOMIC_RELAXED, __HIP_MEMORY_SCOPE_AGENT); }
__device__ __forceinline__ unsigned xb_add(unsigned* p, unsigned v) { return __hip_atomic_fetch_add(p, v, __ATOMIC_RELAXED, __HIP_MEMORY_SCOPE_AGENT); }
__device__ __forceinline__ unsigned xb_xcc_id() { return (unsigned)__builtin_amdgcn_s_getreg((3 << 11) | 20) & 0xFu; }
#define XB_SPIN(cond, bar) do { unsigned _sp = 0; while (cond) { __builtin_amdgcn_s_sleep(1); \
    if ((++_sp & 255u) == 0u) { if (xb_ld(&(bar)[XB_TMO])) break; if (_sp > XB_SPIN_CAP) { atomicAdd(&(bar)[XB_TMO], 1u); break; } } } } while (0)
struct XcdBarrier { unsigned* bar; unsigned x; volatile LAS unsigned* st; };
__device__ __forceinline__ XcdBarrier xcd_barrier_post(unsigned* bar, volatile LAS unsigned* st) {
    XcdBarrier b; b.bar = bar; b.x = xb_xcc_id(); b.st = st;
    if (threadIdx.x == 0) (void)xb_add(&bar[XB_XCNT(b.x)], 1u);
    return b;
}
__device__ __forceinline__ void xcd_barrier_complete(unsigned* bar, unsigned x, unsigned& nloc, unsigned& nx) {
    const unsigned G = gridDim.x * gridDim.y * gridDim.z;
    unsigned sum, cnt, mine, sp = 0u;
    for (;;) {
        sum = 0u; cnt = 0u; mine = 0u;
#pragma unroll
        for (unsigned j = 0; j < 16; ++j) { const unsigned c = xb_ld(&bar[XB_XCNT(j)]); sum += c; cnt += (c > 0u) ? 1u : 0u; mine = (j == x) ? c : mine; }
        if (sum == G) break;
        __builtin_amdgcn_s_sleep(1);
        if ((++sp & 255u) == 0u) { if (xb_ld(&bar[XB_TMO])) break; if (sp > XB_SPIN_CAP) { atomicAdd(&bar[XB_TMO], 1u); break; } }
    }
    nloc = mine > 0u ? mine : 1u; nx = cnt > 0u ? cnt : 1u;
}
__device__ __forceinline__ void xcd_barrier(const XcdBarrier& b) {
    asm volatile("s_waitcnt vmcnt(0)" ::: "memory");
    __syncthreads();
    if (threadIdx.x == 0) {
        unsigned* bar = b.bar;
        __builtin_amdgcn_s_waitcnt(0);
        unsigned nloc = b.st[0], nx = b.st[1];
        if (nloc == 0u) { xcd_barrier_complete(bar, b.x, nloc, nx); b.st[0] = nloc; b.st[1] = nx; }
        const unsigned old = xb_add(&bar[XB_XSUB(b.x)], 1u);
        const unsigned gen = old / nloc;
        if (old + 1u == (gen + 1u) * nloc) {
            __builtin_amdgcn_fence(__ATOMIC_RELEASE, "agent");
            asm volatile("s_waitcnt vmcnt(0)" ::: "memory");
            const unsigned og = xb_add(&bar[XB_TOP], 1u);
            const unsigned tg = og / nx;
            if (og + 1u == (tg + 1u) * nx) xb_add(&bar[XB_TOPGEN], 1u);
            else XB_SPIN(xb_ld(&bar[XB_TOPGEN]) == tg, bar);
            __builtin_amdgcn_fence(__ATOMIC_ACQUIRE, "agent");
            xb_add(&bar[XB_XGEN(b.x)], 1u);
            asm volatile("s_waitcnt vmcnt(0)" ::: "memory");
        } else {
            XB_SPIN(xb_ld(&bar[XB_XGEN(b.x)]) == gen, bar);
            __builtin_amdgcn_fence(__ATOMIC_ACQUIRE, "agent");
            asm volatile("s_waitcnt vmcnt(0)" ::: "memory");
        }
    }
    __syncthreads();
}

namespace pg8 {
constexpr int BM = 256, BK = 64, HALF = 128, HTB = HALF * BK * 2, STAGE_BYTES = 8 * HTB;
__host__ __device__ __forceinline__ int lds_byte(int r, int c) { const int st = (r >> 4) * 2 + (c >> 5), rr = r & 15, cc = c & 31, ob = rr * 64 + cc * 2; return st * 1024 + (ob ^ (((ob >> 9) & 1) << 5)); }
__host__ __device__ __forceinline__ void stage_rc(int b, int& R, int& C) { const int st = b / 1024, sb = b % 1024, swz = sb ^ (((sb >> 9) & 1) << 5); R = (st >> 1) * 16 + swz / 64; C = (st & 1) * 32 + (swz % 64) / 2; }
__host__ __device__ __forceinline__ int perm32(int rho) { const int n = rho >> 4, i = rho & 15; return 8 * (i >> 2) + 4 * n + (i & 3); }

struct Unit { int pm, pn; };
template <class P>
__device__ __forceinline__ void gemm_phase(LAS unsigned char* lds, LAS unsigned char* ldsctl, P& S, const int tid) {
    const int wid = __builtin_amdgcn_readfirstlane(tid >> 6), lane = tid & 63, wr = wid >> 2, wc = wid & 3, fr = lane & 15, fq = lane >> 4;
    constexpr bool F8 = P::FP8;
    constexpr int K = P::K, ES = F8 ? 1 : 2, nt = K * ES / 128;
    int R0, C0, R1, C1; stage_rc(tid * 16, R0, C0); stage_rc(tid * 16 + 8192, R1, C1);
    unsigned voffB[2];
    {
        const int Rb0 = P::BROW64 ? (64 * (R0 >> 5) + perm32(R0 & 31)) : ((R0 & ~31) + perm32(R0 & 31));
        const int Rb1 = P::BROW64 ? (64 * (R1 >> 5) + perm32(R1 & 31)) : ((R1 & ~31) + perm32(R1 & 31));
        voffB[0] = (unsigned)(Rb0 * K * ES + 2 * C0); voffB[1] = (unsigned)(Rb1 * K * ES + 2 * C1);
    }
    const unsigned ldsw = (unsigned)wid * 1024u;
    const int scl8 = P::SCALE_AB;
    const int aoff = lds_byte(wr * 64 + fr, fq * 8), boff = lds_byte(wc * 32 + fr, fq * 8);
#define PG8_SA(b, h) (((b) * 2 + (h)) * HTB)
#define PG8_SB(b, h) ((4 + (b) * 2 + (h)) * HTB)
    const unsigned ldsbase = (unsigned)__builtin_amdgcn_readfirstlane((int)(unsigned)(uintptr_t)lds + (int)ldsw);
#define PG8_GLDS(sbase, voff, ldsdst) do { if (P::NODMA) break; unsigned _keep; asm volatile("s_mov_b32 %0, m0\n\ts_mov_b32 m0, %3\n\ts_nop 0\n\tglobal_load_lds_dwordx4 %2, %1\n\ts_mov_b32 m0, %0" \
        : "=&s"(_keep) : "s"(sbase), "v"(voff), "s"(ldsdst) : "memory"); } while (0)
#define PG8_STAGE_A(bufoff, vo, h, kofs) do { _Pragma("unroll") for (int _i = 0; _i < 2; ++_i) \
        PG8_GLDS(Abase, (vo)[P::GATHER ? (h) : 0][_i] + ((kofs) + (P::GATHER ? 0u : (unsigned)(h) * HSTEPA)), ldsbase + (unsigned)((bufoff) + _i * 8192)); } while (0)
#define PG8_STAGE_B(bufoff, gbase) do { _Pragma("unroll") for (int _i = 0; _i < 2; ++_i) \
        PG8_GLDS((const char*)(gbase), voffB[_i], ldsbase + (unsigned)((bufoff) + _i * 8192)); } while (0)
#define PG8_LDA(dst, b, h) do { if constexpr (F8) { _Pragma("unroll") for (int m = 0; m < 4; ++m) { const u32x4 _l = *(const LAS u32x4*)(lds + PG8_SA(b, h) + aoff + m * 2048), _h = *(const LAS u32x4*)(lds + PG8_SA(b, h) + aoff + m * 2048 + 1024); dst##8[m] = __builtin_bit_cast(v8i32, __builtin_shufflevector(_l, _h, 0, 1, 2, 3, 4, 5, 6, 7)); } } \
        else { _Pragma("unroll") for (int m = 0; m < 4; ++m) _Pragma("unroll") for (int k = 0; k < 2; ++k) dst[m][k] = *(const LAS bf16x8*)(lds + PG8_SA(b, h) + aoff + m * 2048 + k * 1024); } } while (0)
#define PG8_LDB(dst, b, h) do { if constexpr (F8) { _Pragma("unroll") for (int n = 0; n < 2; ++n) { const u32x4 _l = *(const LAS u32x4*)(lds + PG8_SB(b, h) + boff + n * 2048), _h = *(const LAS u32x4*)(lds + PG8_SB(b, h) + boff + n * 2048 + 1024); dst##8[n] = __builtin_bit_cast(v8i32, __builtin_shufflevector(_l, _h, 0, 1, 2, 3, 4, 5, 6, 7)); } } \
        else { _Pragma("unroll") for (int n = 0; n < 2; ++n) _Pragma("unroll") for (int k = 0; k < 2; ++k) dst[n][k] = *(const LAS bf16x8*)(lds + PG8_SB(b, h) + boff + n * 2048 + k * 1024); } } while (0)
#define PG8_MMA(ai, bj, At, Bt) do { __builtin_amdgcn_s_setprio(1); \
        if constexpr (F8) { _Pragma("unroll") for (int m = 0; m < 4; ++m) _Pragma("unroll") for (int n = 0; n < 2; ++n) \
            asm volatile("v_mfma_scale_f32_16x16x128_f8f6f4 %0, %1, %2, %0, %3, %3 op_sel:[0,1,0] op_sel_hi:[0,0,0]" : "+v"(acc[ai][bj][m][n]) : "v"(Bt##8[n]), "v"(At##8[m]), "v"(scl8)); } \
        else { _Pragma("unroll") for (int m = 0; m < 4; ++m) _Pragma("unroll") for (int n = 0; n < 2; ++n) _Pragma("unroll") for (int k = 0; k < 2; ++k) \
            acc[ai][bj][m][n] = __builtin_amdgcn_mfma_f32_16x16x32_bf16(Bt[n][k], At[m][k], acc[ai][bj][m][n], 0, 0, 0); } \
        __builtin_amdgcn_s_setprio(0); } while (0)
#define PG8_WAIT_V(n) asm volatile("s_waitcnt vmcnt(" #n ")" ::: "memory")
#define PG8_WAIT_L(n) asm volatile("s_waitcnt lgkmcnt(" #n ")" ::: "memory")
#define PG8_BAR __builtin_amdgcn_s_barrier()
#define PG8_SCHED __builtin_amdgcn_sched_barrier(0)
    Unit cur, nxt; int ui = 0;
    if (!S.next(0, cur)) return;
    f32x4 acc[2][2][4][2];
#pragma unroll
    for (int a = 0; a < 2; ++a)
#pragma unroll
        for (int b = 0; b < 2; ++b)
#pragma unroll
            for (int m = 0; m < 4; ++m)
#pragma unroll
                for (int n = 0; n < 2; ++n) acc[a][b][m][n] = (f32x4){0.f, 0.f, 0.f, 0.f};
    bf16x8 At[4][2], B0[2][2], B1[2][2]; v8i32 At8[4], B08[2], B18[2];
    const char* const Abase = S.a_base();
    unsigned voffA[2][2], voffAn[2][2];
    const char *cB0, *cB1;
    S.unit_begin(cur, ldsctl, tid, 0);
    S.a_offs(cur, R0, C0, R1, C1, voffA, true);
    asm volatile("" ::: "memory");
    S.b_ptrs(cur, cB0, cB1);
    constexpr unsigned kstep = 128, HSTEPA = (unsigned)HALF * K * ES;
    PG8_STAGE_B(PG8_SB(0, 0), cB0); PG8_STAGE_B(PG8_SB(0, 1), cB1); PG8_STAGE_A(PG8_SA(0, 0), voffA, 0, 0u); PG8_STAGE_A(PG8_SA(0, 1), voffA, 1, 0u);
    if (wr == 1) PG8_BAR;
    PG8_WAIT_V(2); PG8_BAR;
    PG8_STAGE_B(PG8_SB(1, 0), cB0 + kstep); PG8_STAGE_A(PG8_SA(1, 0), voffA, 0, kstep); PG8_STAGE_B(PG8_SB(1, 1), cB1 + kstep);
    PG8_WAIT_V(6); PG8_BAR;
    for (;;) {
        const bool has_next = S.next(ui + 1, nxt);
        const char *nB0 = cB0, *nB1 = cB1;
        if constexpr (P::GATHER) {
#pragma unroll
            for (int h = 0; h < 2; ++h)
#pragma unroll
                for (int i = 0; i < 2; ++i) voffAn[h][i] = voffA[h][i];
        }
        if (has_next) { S.unit_begin(nxt, ldsctl, tid, (ui + 1) & 1); S.b_ptrs(nxt, nB0, nB1);
            if constexpr (P::GATHER) { int t2 = tid; asm volatile("" : "+v"(t2)); int r0, c0, r1, c1; stage_rc(t2 * 16, r0, c0); stage_rc(t2 * 16 + 8192, r1, c1); S.a_offs(nxt, r0, c0, r1, c1, voffAn, false); } }
#pragma unroll 1
        for (int t = 0; t < nt; t += 2) {
            const bool last = (t == nt - 2);
            S.midk(acc, cur, t, wr, fr, ldsctl, ui & 1);
            unsigned a2o[2][2];
            if constexpr (!P::GATHER) { if (last) { int t2 = tid; asm volatile("" : "+v"(t2)); int r0, c0, r1, c1; stage_rc(t2 * 16, r0, c0); stage_rc(t2 * 16 + 8192, r1, c1);
                                                   S.a_offs(has_next ? nxt : cur, r0, c0, r1, c1, voffAn, false); } }
#pragma unroll
            for (int h = 0; h < 2; ++h)
#pragma unroll
                for (int i = 0; i < 2; ++i) a2o[h][i] = last ? voffAn[h][i] : voffA[h][i] + (unsigned)(t + 2) * kstep;
            const char* b2h0 = last ? nB0 : cB0 + (size_t)(t + 2) * kstep; const char* b2h1 = last ? nB1 : cB1 + (size_t)(t + 2) * kstep;
            const unsigned a1k = (unsigned)(t + 1) * kstep;
            PG8_LDB(B0, 0, 0); PG8_LDB(B1, 0, 1); PG8_SCHED; PG8_LDA(At, 0, 0); PG8_STAGE_A(PG8_SA(1, 1), voffA, 1, a1k);
            PG8_WAIT_V(8); PG8_WAIT_L(0); PG8_BAR; PG8_MMA(0, 0, At, B0); PG8_MMA(0, 1, At, B1); PG8_BAR; PG8_SCHED;
            PG8_LDA(At, 0, 1); PG8_STAGE_B(PG8_SB(0, 0), b2h0); PG8_STAGE_B(PG8_SB(0, 1), b2h1); PG8_STAGE_A(PG8_SA(0, 0), a2o, 0, 0u);
            PG8_WAIT_V(8); PG8_WAIT_L(0); PG8_BAR; PG8_MMA(1, 0, At, B0); PG8_MMA(1, 1, At, B1); PG8_BAR; PG8_SCHED;
            PG8_LDB(B0, 1, 0); PG8_LDB(B1, 1, 1); PG8_SCHED; PG8_LDA(At, 1, 0); PG8_STAGE_A(PG8_SA(0, 1), a2o, 1, 0u);
            PG8_WAIT_V(8); PG8_WAIT_L(0); PG8_BAR; PG8_MMA(0, 0, At, B0); PG8_MMA(0, 1, At, B1); PG8_BAR; PG8_SCHED;
            PG8_LDA(At, 1, 1); PG8_STAGE_B(PG8_SB(1, 0), b2h0 + kstep); PG8_STAGE_B(PG8_SB(1, 1), b2h1 + kstep); PG8_STAGE_A(PG8_SA(1, 0), a2o, 0, kstep);
            PG8_WAIT_V(8); PG8_WAIT_L(0); PG8_BAR; PG8_MMA(1, 0, At, B0); PG8_MMA(1, 1, At, B1); PG8_BAR; PG8_SCHED;
        }
        if (wr == 0) PG8_BAR;
        if constexpr (F8) asm volatile("s_nop 15\n\ts_nop 15" ::: "memory");
        { int l2 = tid; asm volatile("" : "+v"(l2)); S.epi(acc, cur, wr, wc, l2 & 15, (l2 >> 4) & 3); }
        if (!has_next) break;
#pragma unroll
        for (int a = 0; a < 2; ++a)
#pragma unroll
            for (int b = 0; b < 2; ++b)
#pragma unroll
                for (int m = 0; m < 4; ++m)
#pragma unroll
                    for (int n = 0; n < 2; ++n) acc[a][b][m][n] = (f32x4){0.f, 0.f, 0.f, 0.f};
        cur = nxt; cB0 = nB0; cB1 = nB1; ++ui;
#pragma unroll
        for (int h = 0; h < 2; ++h)
#pragma unroll
            for (int i = 0; i < 2; ++i) voffA[h][i] = voffAn[h][i];
        if (wr == 1) PG8_BAR;
    }
    PG8_WAIT_V(0);
    PG8_BAR;
#undef PG8_SA
#undef PG8_SB
#undef PG8_STAGE_A
#undef PG8_GLDS
#undef PG8_STAGE_B
#undef PG8_LDA
#undef PG8_LDB
#undef PG8_MMA
#undef PG8_WAIT_V
#undef PG8_WAIT_L
#undef PG8_BAR
#undef PG8_SCHED
}
struct StaticOrder {
    int nM, nN, nwg, G, c;
    __device__ void init(int M, int N, int G_, int c_) { nM = M / BM; nN = N / BM; nwg = nM * nN; G = G_; c = c_; }
    __device__ bool next(int i, Unit& u) const {
        const long L = (long)i * G + c; if (L >= nwg) return false;
        int wgid = (int)L; { const int q = nwg / 8, r = nwg % 8, xcd = wgid % 8, off = wgid / 8; wgid = (xcd < r ? xcd * (q + 1) : r * (q + 1) + (xcd - r) * q) + off; }
        const int nig = 8 * nN, gid = wgid / nig, fm = gid * 8, gsz = (nM - fm) < 8 ? (nM - fm) : 8;
        u.pm = fm + ((wgid % nig) % gsz); u.pn = (wgid % nig) / gsz; return true;
    }
};
}

struct Frame {
    LAS unsigned char* lds; LAS unsigned char* ctl;
    unsigned char* ws;
    int tid, lane, wave, G, bx;
    float* out; const struct Args* ap; unsigned char* ws0; float* out0; size_t z;
};

struct Args { const float* in[28]; float* out; unsigned char* ws; int ph_lo, ph_hi; };
#define arg_in(i) (F.ap->in[i] + F.z)
__device__ __forceinline__ void phase_begin(Frame& F) {
    int t = F.tid; asm volatile("" : "+v"(t)); F.tid = t; F.lane = t & 63; F.wave = __builtin_amdgcn_readfirstlane(t >> 6);
    size_t z = 0; asm volatile("" : "+s"(z)); F.z = z; F.ws = F.ws0 + z; F.out = F.out0 + z;
    int bx = F.bx; asm volatile("" : "+s"(bx)); F.bx = bx;
}
__device__ __forceinline__ void phase_restart(Frame& F) {
    int wv = F.wave; asm volatile("" : "+s"(wv)); F.wave = wv;
    int ln = (int)__builtin_amdgcn_mbcnt_hi(~0u, __builtin_amdgcn_mbcnt_lo(~0u, 0u)); asm volatile("" : "+v"(ln)); F.lane = ln; F.tid = wv * 64 + ln;
    size_t z = 0; asm volatile("" : "+s"(z)); F.z = z; F.ws = F.ws0 + z; F.out = F.out0 + z;
}
struct PBase {
    static constexpr bool GATHER = false, FP8 = false, NODMA = false; static constexpr int SCALE_AB = 0x7f7f7f7f;
    __device__ __forceinline__ void unit_begin(const pg8::Unit&, LAS unsigned char*, int, int) {}
    __device__ __forceinline__ void midk(f32x4 (&)[2][2][4][2], const pg8::Unit&, int, int, int, LAS unsigned char*, int) {}
    __device__ __forceinline__ void a_fix(unsigned (&)[2][2]) {}
};
struct PInProj : PBase {
    static constexpr int K = 1024, BROW64 = 1;
    pg8::StaticOrder so; const char* A; const char* B; bf16_t* UQKV; const float *GQK, *COS, *SIN;
    __device__ __forceinline__ bool next(int i, pg8::Unit& u) const { return so.next(i, u); }
    __device__ __forceinline__ const char* a_base() const { return A; }
    __device__ __forceinline__ void a_offs(const pg8::Unit& u, int R0, int C0, int R1, int C1, unsigned (&vo)[2][2], bool) const {
#pragma unroll
        for (int h = 0; h < 2; ++h) { vo[h][0] = (unsigned)((u.pm * 256 + 128 * h + R0) * K + C0) * 2u; vo[h][1] = (unsigned)((u.pm * 256 + 128 * h + R1) * K + C1) * 2u; }
    }
    __device__ __forceinline__ void b_ptrs(const pg8::Unit& u, const char*& b0, const char*& b1) const { b0 = B + (size_t)u.pn * 256 * K * 2; b1 = b0 + (size_t)32 * K * 2; }
    __device__ __forceinline__ void epi(f32x4 (&acc)[2][2][4][2], const pg8::Unit& u, int wr, int wc, int fr, int fq) const {
        const int kind = u.pn >> 1;
        const int colg = (u.pn & 1) * 256 + 64 * wc;
        bf16_t* dst = UQKV + (size_t)kind * (size_t)(16u << 20);
        const int row0 = u.pm * 256 + wr * 64 + fr;
        if (kind == 0 || kind == 3) {
#pragma unroll
            for (int ai = 0; ai < 2; ++ai)
#pragma unroll
                for (int m = 0; m < 4; ++m) { bf16_t* rowp = dst + (size_t)(row0 + ai * 128 + m * 16) * 512 + colg + 8 * fq;
#pragma unroll
                    for (int bj = 0; bj < 2; ++bj) { const f32x4 v0 = acc[ai][bj][m][0], v1 = acc[ai][bj][m][1];
                        u32x4 w; w.x = cvt_pk_bf16(v0[0], v0[1]); w.y = cvt_pk_bf16(v0[2], v0[3]); w.z = cvt_pk_bf16(v1[0], v1[1]); w.w = cvt_pk_bf16(v1[2], v1[3]);
                        *(u32x4*)(rowp + 32 * bj) = w; } }
        } else {
            const float* g = GQK + (kind - 1) * 64; const float sc = kind == 1 ? C2 * 32.0f : 16.0f;
            f32x4 g0[2], g1[2];
#pragma unroll
            for (int n = 0; n < 2; ++n) { g0[n] = *(const f32x4*)(g + 8 * fq + 4 * n); g1[n] = *(const f32x4*)(g + 32 + 8 * fq + 4 * n); }
#pragma unroll
            for (int ai = 0; ai < 2; ++ai)
#pragma unroll
                for (int m = 0; m < 4; ++m) {
                    const int row = row0 + ai * 128 + m * 16; const int pos = row & (SEQ - 1);
                    float ss = 0.f;
#pragma unroll
                    for (int bj = 0; bj < 2; ++bj)
#pragma unroll
                        for (int n = 0; n < 2; ++n) { const f32x4 x = acc[ai][bj][m][n]; ss += (x[0] * x[0] + x[1] * x[1]) + (x[2] * x[2] + x[3] * x[3]); }
                    ss += __shfl_xor(ss, 16); ss += __shfl_xor(ss, 32);
                    const float r = rsqrtf(ss * (1.f / 64.f) + EPS) * sc;
                    f32x4 o1[2], o2[2];
#pragma unroll
                    for (int n = 0; n < 2; ++n) {
                        const f32x4 c = *(const f32x4*)(COS + (size_t)pos * 32 + 8 * fq + 4 * n), s = *(const f32x4*)(SIN + (size_t)pos * 32 + 8 * fq + 4 * n);
                        const f32x4 x1 = acc[ai][0][m][n] * g0[n] * r, x2 = acc[ai][1][m][n] * g1[n] * r;
                        o1[n] = x1 * c - x2 * s; o2[n] = x2 * c + x1 * s;
                    }
                    unsigned char* rowp = (unsigned char*)dst + (size_t)row * 512 + colg + 8 * fq;
                    u32x2 w; w.x = pk4_fp8(o1[0][0], o1[0][1], o1[0][2], o1[0][3]); w.y = pk4_fp8(o1[1][0], o1[1][1], o1[1][2], o1[1][3]);
                    *(u32x2*)(rowp) = w;
                    w.x = pk4_fp8(o2[0][0], o2[0][1], o2[0][2], o2[0][3]); w.y = pk4_fp8(o2[1][0], o2[1][1], o2[1][2], o2[1][3]);
                    *(u32x2*)(rowp + 32) = w;
                    asm volatile("" ::: "memory");
                }
        }
    }
};
struct PGlu : PBase {
    static constexpr int K = 512, BROW64 = 0;
    pg8::StaticOrder so; const char* A; const char* B; const bf16_t* YG; bf16_t* MIX; float* RSP;
    __device__ __forceinline__ bool next(int i, pg8::Unit& u) const { return so.next(i, u); }
    __device__ __forceinline__ const char* a_base() const { return A; }
    __device__ __forceinline__ void a_offs(const pg8::Unit& u, int R0, int C0, int R1, int C1, unsigned (&vo)[2][2], bool) const {
#pragma unroll
        for (int h = 0; h < 2; ++h) { vo[h][0] = (unsigned)((u.pm * 256 + 128 * h + R0) * K + C0) * 2u; vo[h][1] = (unsigned)((u.pm * 256 + 128 * h + R1) * K + C1) * 2u; }
    }
    __device__ __forceinline__ void b_ptrs(const pg8::Unit& u, const char*& b0, const char*& b1) const { b0 = B + (size_t)u.pn * 256 * K * 2; b1 = b0 + (size_t)128 * K * 2; }
    __device__ __forceinline__ void epi(f32x4 (&acc)[2][2][4][2], const pg8::Unit& u, int wr, int wc, int fr, int fq) const {
        const int row0 = u.pm * 256 + wr * 64 + fr, col0 = u.pn * 256 + wc * 32 + 8 * fq;
#pragma unroll
        for (int ai = 0; ai < 2; ++ai)
#pragma unroll
            for (int m = 0; m < 4; ++m) {
                const int row = row0 + ai * 128 + m * 16; float ss = 0.f;
#pragma unroll
                for (int bj = 0; bj < 2; ++bj) {
                    const u32x4 yw = *(const u32x4*)(YG + (size_t)row * 512 + col0 + 128 * bj);
                    const f32x4 a0 = acc[ai][bj][m][0], a1 = acc[ai][bj][m][1];
                    float z[8];
                    z[0] = bf_lo(yw.x) * sigmoidf(a0[0]); z[1] = bf_hi(yw.x) * sigmoidf(a0[1]); z[2] = bf_lo(yw.y) * sigmoidf(a0[2]); z[3] = bf_hi(yw.y) * sigmoidf(a0[3]);
                    z[4] = bf_lo(yw.z) * sigmoidf(a1[0]); z[5] = bf_hi(yw.z) * sigmoidf(a1[1]); z[6] = bf_lo(yw.w) * sigmoidf(a1[2]); z[7] = bf_hi(yw.w) * sigmoidf(a1[3]);
#pragma unroll
                    for (int i = 0; i < 8; ++i) ss += z[i] * z[i];
                    u32x4 w; w.x = cvt_pk_bf16(z[0], z[1]); w.y = cvt_pk_bf16(z[2], z[3]); w.z = cvt_pk_bf16(z[4], z[5]); w.w = cvt_pk_bf16(z[6], z[7]);
                    *(u32x4*)(MIX + (size_t)row * 1024 + col0 + 128 * bj) = w;
                }
                ss += __shfl_xor(ss, 16); ss += __shfl_xor(ss, 32);
                if (fq == 0) RSP[(size_t)row * 8 + u.pn * 4 + wc] = ss;
            }
    }
};
struct POut : PBase {
    static constexpr int K = 1024, BROW64 = 0;
    pg8::StaticOrder so; const char* A; const char* B; const float* RSP; const float* base32; const bf16_t* base16; bf16_t* H1;
    __device__ __forceinline__ bool next(int i, pg8::Unit& u) const { return so.next(i, u); }
    __device__ __forceinline__ const char* a_base() const { return A; }
    __device__ __forceinline__ void a_offs(const pg8::Unit& u, int R0, int C0, int R1, int C1, unsigned (&vo)[2][2], bool) const {
#pragma unroll
        for (int h = 0; h < 2; ++h) { vo[h][0] = (unsigned)((u.pm * 256 + 128 * h + R0) * K + C0) * 2u; vo[h][1] = (unsigned)((u.pm * 256 + 128 * h + R1) * K + C1) * 2u; }
    }
    __device__ __forceinline__ void b_ptrs(const pg8::Unit& u, const char*& b0, const char*& b1) const { b0 = B + (size_t)u.pn * 256 * K * 2; b1 = b0 + (size_t)128 * K * 2; }
    __device__ __forceinline__ void unit_begin(const pg8::Unit& u, LAS unsigned char* ldsctl, int tid, int slot) const {
        if (tid < 256) {
            const f32x4 p0 = *(const f32x4*)(RSP + (size_t)(u.pm * 256 + tid) * 8), p1 = *(const f32x4*)(RSP + (size_t)(u.pm * 256 + tid) * 8 + 4);
            const float ss = ((p0[0] + p0[1]) + (p0[2] + p0[3])) + ((p1[0] + p1[1]) + (p1[2] + p1[3]));
            ((LAS float*)(ldsctl + 1024 + slot * 1024))[tid] = rsqrtf(ss * (1.f / 512.f) + EPS);
        }
    }
    __device__ __forceinline__ void midk(f32x4 (&acc)[2][2][4][2], const pg8::Unit& u, int t, int wr, int fr, LAS unsigned char* ldsctl, int slot) const {
        if (t == 8) {
            const LAS float* rs = (const LAS float*)(ldsctl + 1024 + slot * 1024);
#pragma unroll
            for (int ai = 0; ai < 2; ++ai)
#pragma unroll
                for (int m = 0; m < 4; ++m) { const float r = rs[ai * 128 + wr * 64 + m * 16 + fr];
#pragma unroll
                    for (int bj = 0; bj < 2; ++bj)
#pragma unroll
                        for (int n = 0; n < 2; ++n) acc[ai][bj][m][n] *= r; }
        }
    }
    __device__ __forceinline__ void epi(f32x4 (&acc)[2][2][4][2], const pg8::Unit& u, int wr, int wc, int fr, int fq) const {
        const int row0 = u.pm * 256 + wr * 64 + fr, col0 = u.pn * 256 + wc * 32 + 8 * fq;
#pragma unroll
        for (int ai = 0; ai < 2; ++ai)
#pragma unroll
            for (int m = 0; m < 4; ++m) { const size_t off = (size_t)(row0 + ai * 128 + m * 16) * 1024 + col0;
#pragma unroll
                for (int bj = 0; bj < 2; ++bj) {
                    f32x4 v0 = acc[ai][bj][m][0], v1 = acc[ai][bj][m][1];
                    if (base32) { v0 += *(const f32x4*)(base32 + off + bj * 128); v1 += *(const f32x4*)(base32 + off + bj * 128 + 4); }
                    else { const u32x4 b = *(const u32x4*)(base16 + off + bj * 128); v0[0] += bf_lo(b.x); v0[1] += bf_hi(b.x); v0[2] += bf_lo(b.y); v0[3] += bf_hi(b.y); v1[0] += bf_lo(b.z); v1[1] += bf_hi(b.z); v1[2] += bf_lo(b.w); v1[3] += bf_hi(b.w); }
                    u32x4 w; w.x = cvt_pk_bf16(v0[0], v0[1]); w.y = cvt_pk_bf16(v0[2], v0[3]); w.z = cvt_pk_bf16(v1[0], v1[1]); w.w = cvt_pk_bf16(v1[2], v1[3]);
                    *(u32x4*)(H1 + off + bj * 128) = w; }
                if (m & 1) asm volatile("" ::: "memory"); }
    }
};
template <int NN> struct MoeOrder {
    int j, wpx, s0, s1, s2, s3, n0, n1, n2, n3;
    __device__ __forceinline__ void init(int G, int c, const int* PST) {
#ifndef MOE_XA
#define MOE_XA 2
#endif
#ifndef MOE_CHUNKED
#define MOE_CHUNKED 0
#endif
        if (MOE_XA == 1 && (G & 7) == 0) { wpx = G >> 3; const int x = MOE_CHUNKED ? c / wpx : (c & 7); j = MOE_CHUNKED ? c % wpx : (c >> 3);
            s0 = PST[x] >> 8; n0 = (PST[x + 1] - PST[x]) >> 8; s1 = PST[x + 8] >> 8; n1 = (PST[x + 9] - PST[x + 8]) >> 8;
            s2 = PST[x + 16] >> 8; n2 = (PST[x + 17] - PST[x + 16]) >> 8; s3 = PST[x + 24] >> 8; n3 = (PST[x + 25] - PST[x + 24]) >> 8; }
        else { j = c; wpx = G; s0 = 0; n0 = PST[32] >> 8; s1 = s2 = s3 = 0; n1 = n2 = n3 = 0; }
        if (MOE_XA == 2 && (G & 7) == 0) { wpx = G >> 3; j = c >> 3; s1 = c & 7; n0 = PST[32] >> 8; }
    }
    __device__ __forceinline__ bool next(int i, pg8::Unit& u) const {
        const int q = i * wpx + j; int pml = q / NN; u.pn = q % NN;
        if (MOE_XA == 2) { u.pm = s1 + 8 * pml; return u.pm < n0; }
        if (pml < n0) { u.pm = s0 + pml; return true; } pml -= n0;
        if (pml < n1) { u.pm = s1 + pml; return true; } pml -= n1;
        if (pml < n2) { u.pm = s2 + pml; return true; } pml -= n2;
        if (pml < n3) { u.pm = s3 + pml; return true; }
        return false;
    }
};
struct PUp : PBase {
    static constexpr int K = 1024, BROW64 = 0; static constexpr bool GATHER = true, FP8 = UP_FP8; static constexpr int ES = UP_FP8 ? 1 : 2;
    static constexpr int SCALE_AB = 0x7c79;
    MoeOrder<8> mo; const char* A; const char* B; const int* ROWTOK; const int* TILEEXP; const float* bup; const float* ROWSCALE; bf16_t* ACT;
    int idx[2][2]; int c0, c1;
    __device__ __forceinline__ bool next(int i, pg8::Unit& u) const { return mo.next(i, u); }
    __device__ __forceinline__ const char* a_base() const { return A; }
    __device__ __forceinline__ void a_offs(const pg8::Unit& u, int R0, int C0, int R1, int C1, unsigned (&vo)[2][2], bool first) {
        c0 = C0; c1 = C1;
        const int* rp = ROWTOK + u.pm * 256;
#pragma unroll
        for (int h = 0; h < 2; ++h) {
            asm volatile("global_load_dword %0, %1, off" : "=v"(idx[h][0]) : "v"(rp + 128 * h + R0) : "memory");
            asm volatile("global_load_dword %0, %1, off" : "=v"(idx[h][1]) : "v"(rp + 128 * h + R1) : "memory");
        }
        asm volatile("s_waitcnt vmcnt(0)" : "+v"(idx[0][0]), "+v"(idx[0][1]), "+v"(idx[1][0]), "+v"(idx[1][1]) :: "memory");
#pragma unroll
        for (int h = 0; h < 2; ++h) { vo[h][0] = (unsigned)(idx[h][0] * K * ES + 2 * c0); vo[h][1] = (unsigned)(idx[h][1] * K * ES + 2 * c1); }
    }
    __device__ __forceinline__ void b_ptrs(const pg8::Unit& u, const char*& b0, const char*& b1) const {
        const int e = TILEEXP[u.pm]; b0 = B + ((size_t)e * 2048 + (size_t)u.pn * 128) * K * ES; b1 = b0 + (size_t)1024 * K * ES; }
    __device__ __forceinline__ void epi(f32x4 (&acc)[2][2][4][2], const pg8::Unit& u, int wr, int wc, int fr, int fq) const {
        const int e = TILEEXP[u.pm];
        const int row0 = u.pm * 256 + wr * 64 + fr, col0 = u.pn * 128 + wc * 32 + 8 * fq;
        const float* bg = bup + (size_t)e * 2048 + col0; const float* bl = bg + 1024;
        f32x4 bgv[2], blv[2];
#pragma unroll
        for (int n = 0; n < 2; ++n) { bgv[n] = *(const f32x4*)(bg + 4 * n); blv[n] = *(const f32x4*)(bl + 4 * n); }
#pragma unroll
        for (int ai = 0; ai < 2; ++ai)
#pragma unroll
            for (int m = 0; m < 4; ++m) {
                float a[8]; const float rs = ROWSCALE[row0 + ai * 128 + m * 16];
#pragma unroll
                for (int n = 0; n < 2; ++n)
#pragma unroll
                    for (int j = 0; j < 4; ++j) {
                        float glu = acc[ai][0][m][n][j] * rs + bgv[n][j], lin = acc[ai][1][m][n][j] * rs + blv[n][j];
                        glu = fminf(glu, 7.0f); lin = fminf(fmaxf(lin, -7.0f), 7.0f);
                        a[4 * n + j] = glu * sigmoidf(1.702f * glu) * (lin + 1.0f);
                    }
                if (DN_FP8) { u32x2 w; w.x = pk4_fp8(a[0] * 4.f, a[1] * 4.f, a[2] * 4.f, a[3] * 4.f); w.y = pk4_fp8(a[4] * 4.f, a[5] * 4.f, a[6] * 4.f, a[7] * 4.f);
                    *(u32x2*)((unsigned char*)ACT + (size_t)(row0 + ai * 128 + m * 16) * 1024 + col0) = w; }
                else { u32x4 w; w.x = cvt_pk_bf16(a[0], a[1]); w.y = cvt_pk_bf16(a[2], a[3]); w.z = cvt_pk_bf16(a[4], a[5]); w.w = cvt_pk_bf16(a[6], a[7]);
                    *(u32x4*)(ACT + (size_t)(row0 + ai * 128 + m * 16) * 1024 + col0) = w; }
            }
    }
};
struct PUpNoDma : PUp { static constexpr bool NODMA = true; };
struct PDown : PBase {
    static constexpr int K = 1024, BROW64 = 0; static constexpr bool FP8 = DN_FP8; static constexpr int ES = DN_FP8 ? 1 : 2;
    static constexpr int SCALE_AB = 0x7d79;
    MoeOrder<4> mo; const char* A; const char* B; const int* TILEEXP; const float* bdn; const float* ROWGATE; bf16_t* YB;
    __device__ __forceinline__ bool next(int i, pg8::Unit& u) const { return mo.next(i, u); }
    __device__ __forceinline__ const char* a_base() const { return A; }
    __device__ __forceinline__ void a_offs(const pg8::Unit& u, int R0, int C0, int R1, int C1, unsigned (&vo)[2][2], bool) const {
#pragma unroll
        for (int h = 0; h < 2; ++h) { vo[h][0] = (unsigned)((u.pm * 256 + 128 * h + R0) * K * ES + 2 * C0); vo[h][1] = (unsigned)((u.pm * 256 + 128 * h + R1) * K * ES + 2 * C1); }
    }
    __device__ __forceinline__ void b_ptrs(const pg8::Unit& u, const char*& b0, const char*& b1) const {
        const int e = TILEEXP[u.pm]; b0 = B + ((size_t)e * 1024 + (size_t)u.pn * 256) * K * ES; b1 = b0 + (size_t)128 * K * ES; }
    __device__ __forceinline__ void epi(f32x4 (&acc)[2][2][4][2], const pg8::Unit& u, int wr, int wc, int fr, int fq) const {
        const int e = TILEEXP[u.pm];
        const int row0 = u.pm * 256 + wr * 64 + fr, col0 = u.pn * 256 + wc * 32 + 8 * fq;
        const float* bp = bdn + (size_t)e * 1024 + col0;
#pragma unroll
        for (int bj = 0; bj < 2; ++bj) {
            const f32x4 bv0 = *(const f32x4*)(bp + 128 * bj), bv1 = *(const f32x4*)(bp + 128 * bj + 4);
#pragma unroll
            for (int ai = 0; ai < 2; ++ai)
#pragma unroll
                for (int m = 0; m < 4; ++m) { const int row = row0 + ai * 128 + m * 16; const float gt = ROWGATE[row];
                    const f32x4 v0 = (acc[ai][bj][m][0] + bv0) * (gt * 16.f), v1 = (acc[ai][bj][m][1] + bv1) * (gt * 16.f);
                    u32x2 w; w.x = pk4_fp8(v0[0], v0[1], v0[2], v0[3]); w.y = pk4_fp8(v1[0], v1[1], v1[2], v1[3]);
                    *(u32x2*)((unsigned char*)YB + (size_t)row * 1024 + col0 + 128 * bj) = w; }
            asm volatile("" ::: "memory");
        }
    }
};

struct TItem { const float* src; bf16_t* dst; const float* ksc; int N, K; unsigned char* dst8; };
__device__ __forceinline__ void titem_load(const TItem& it, f32x4 (&v)[16], int lane) {
    const float* p = it.src + (size_t)(lane >> 4) * it.N + 4 * (lane & 15);
#pragma unroll
    for (int i = 0; i < 16; ++i) v[i] = *(const f32x4*)(p + (size_t)(4 * i) * it.N);
}
__device__ __forceinline__ void titem_store(const TItem& it, f32x4 (&v)[16], LAS float* scr, int lane) {
    if (it.ksc) {
#pragma unroll
        for (int i = 0; i < 16; ++i) v[i] *= it.ksc[4 * i + (lane >> 4)];
    }
#pragma unroll
    for (int i = 0; i < 16; ++i) { LAS float* d = scr + (4 * i + (lane >> 4)) * 65 + 4 * (lane & 15); d[0] = v[i][0]; d[1] = v[i][1]; d[2] = v[i][2]; d[3] = v[i][3]; }
    asm volatile("s_waitcnt lgkmcnt(0)" ::: "memory");
    if (it.dst8) {
        const int c = lane & 3;
#pragma unroll
        for (int j = 0; j < 4; ++j) { const int n = (lane >> 2) + 16 * j; const LAS float* s = scr + (16 * c) * 65 + n;
            u32x4 o;
            o.x = pk4_fp8(s[0 * 65] * 64.f, s[1 * 65] * 64.f, s[2 * 65] * 64.f, s[3 * 65] * 64.f); o.y = pk4_fp8(s[4 * 65] * 64.f, s[5 * 65] * 64.f, s[6 * 65] * 64.f, s[7 * 65] * 64.f);
            o.z = pk4_fp8(s[8 * 65] * 64.f, s[9 * 65] * 64.f, s[10 * 65] * 64.f, s[11 * 65] * 64.f); o.w = pk4_fp8(s[12 * 65] * 64.f, s[13 * 65] * 64.f, s[14 * 65] * 64.f, s[15 * 65] * 64.f);
            *(u32x4*)(it.dst8 + (size_t)n * it.K + 16 * c) = o; }
    } else {
        const int c = lane & 7;
#pragma unroll
        for (int j = 0; j < 8; ++j) { const int n = (lane >> 3) + 8 * j; const LAS float* s = scr + (8 * c) * 65 + n;
            u32x4 o; o.x = pk2(s[0 * 65], s[1 * 65]); o.y = pk2(s[2 * 65], s[3 * 65]); o.z = pk2(s[4 * 65], s[5 * 65]); o.w = pk2(s[6 * 65], s[7 * 65]);
            *(u32x4*)(it.dst + (size_t)n * it.K + 8 * c) = o; }
    }
    asm volatile("s_waitcnt lgkmcnt(0)" ::: "memory");
}
__device__ __forceinline__ void rms_row_to_bf16(const f32x4 (&v)[4], const float* g, bf16_t* orow, int lane) {
    float s = 0.f;
#pragma unroll
    for (int j = 0; j < 4; ++j) s += (v[j][0] * v[j][0] + v[j][1] * v[j][1]) + (v[j][2] * v[j][2] + v[j][3] * v[j][3]);
    const float r = rsqrtf(wave_sum(s) * (1.f / D) + EPS);
#pragma unroll
    for (int j = 0; j < 4; ++j) { const f32x4 gg = *(const f32x4*)(g + 4 * lane + 256 * j); const f32x4 o = v[j] * gg * r;
        u32x2 w; w.x = cvt_pk_bf16(o[0], o[1]); w.y = cvt_pk_bf16(o[2], o[3]); *(u32x2*)(orow + 4 * lane + 256 * j) = w; }
}
struct Cplx { float re, im; };
__device__ __forceinline__ Cplx cmul(Cplx a, Cplx b) { return Cplx{a.re * b.re - a.im * b.im, a.re * b.im + a.im * b.re}; }
__device__ __forceinline__ Cplx lam_pow(float lr, float li, float step, int n) {
    const float mag = expf((float)n * lr * step); const double ang = (double)n * (double)li * (double)step;
    return Cplx{mag * (float)cos(ang), mag * (float)sin(ang)};
}
__device__ __forceinline__ Cplx lam_pow_fast(float lr, float li, float step, int n) {
    const float mag = __expf((float)n * lr * step); const double rev = (double)n * (double)li * (double)step * 0.15915494309189535; const float fr = (float)(rev - floor(rev));
    return Cplx{mag * __builtin_amdgcn_cosf(fr), mag * __builtin_amdgcn_sinf(fr)};
}
__device__ __forceinline__ Cplx bbar_factor(float lr, float li, float step) {
    const Cplx lb = lam_pow(lr, li, step, 1); const float nr = lb.re - 1.f, ni = lb.im, den = lr * lr + li * li;
    return Cplx{(nr * lr + ni * li) / den, (ni * lr - nr * li) / den};
}
template <int PMODE> __device__ __forceinline__ void p0_prologue(Frame& F) {
    const int gw = F.bx * NWAVES + F.wave, NGW = F.G * NWAVES, lane = F.lane;
    const int gt = F.bx * NTHREADS + F.tid, NGT = F.G * NTHREADS;
    unsigned char* ws = F.ws;
    if (!(PMODE & 1)) {
        LAS float* scr = (LAS float*)(F.lds + LDS_RING) + F.wave * (64 * 65);
        constexpr int I_UP = UP_FP8 ? 0 : 32 * 16 * 32, I_DN = DN_FP8 ? 0 : 32 * 16 * 16, I_IN = 16 * 32, I_OUT = 16 * 16, I_GLU = 8 * 8;
        constexpr int PER_L = I_UP + I_DN + I_IN + I_OUT + I_GLU, TOTAL = DEPTH * PER_L;
        auto decode = [&](int it) -> TItem {
            TItem ti; const int l = it / PER_L; int r = it % PER_L; const float* W; bf16_t* WT; int K, N; ti.ksc = nullptr; bool f8 = false;
            if (r < I_UP) { const int e = r / 512; r %= 512; K = 1024; N = 2048; W = arg_in(24) + ((size_t)l * NE + e) * 1024 * 2048; WT = (bf16_t*)(ws + WS_WUP + l * WUP_STRIDE) + (size_t)e * 2048 * 1024 / (UP_FP8 ? 2 : 1); f8 = UP_FP8; }
            else if ((r -= I_UP) < I_DN) { const int e = r / 256; r %= 256; K = 1024; N = 1024; W = arg_in(26) + ((size_t)l * NE + e) * 1024 * 1024; WT = (bf16_t*)(ws + WS_WDN + l * WDN_STRIDE) + (size_t)e * 1024 * 1024 / (DN_FP8 ? 2 : 1); f8 = DN_FP8; }
            else if ((r -= I_DN) < I_IN) { K = 1024; N = 2048; W = arg_in(2) + (size_t)l * 1024 * 2048; WT = (bf16_t*)(ws + WS_WIN + l * WIN_STRIDE); }
            else if ((r -= I_IN) < I_OUT) { K = 1024; N = 1024; W = arg_in(20) + (size_t)l * 1024 * 1024; WT = (bf16_t*)(ws + WS_WOUT + l * WOUT_STRIDE); if ((r / 16) * 64 < DS) ti.ksc = arg_in(12) + l * DS + (r / 16) * 64; }
            else { r -= I_OUT; K = 512; N = 512; W = arg_in(11) + (size_t)l * 512 * 512; WT = (bf16_t*)(ws + WS_WGLU + l * WGLU_STRIDE); }
            const int nblk = N / 64, k0 = 64 * (r / nblk), n0 = 64 * (r % nblk);
            ti.src = W + (size_t)k0 * N + n0; ti.dst = WT + (size_t)n0 * K + k0; ti.N = N; ti.K = K; ti.dst8 = f8 ? (unsigned char*)WT + (size_t)n0 * K + k0 : nullptr; return ti;
        };
        f32x4 va[16]; TItem ia;
        for (int it = gw; it < TOTAL; it += NGW) { ia = decode(it); titem_load(ia, va, lane); titem_store(ia, va, scr, lane); }
    }
    if (!(PMODE & 1) && (UP_FP8 || DN_FP8)) {
        LAS float* tile = (LAS float*)(F.lds + LDS_RING);
        constexpr int C_UP = UP_FP8 ? 32 * 8 * 8 : 0, C_DN = DN_FP8 ? 32 * 8 * 4 : 0, C_PER_L = C_UP + C_DN, C_TOTAL = DEPTH * C_PER_L;
        auto cdecode = [&](int it, const float*& src, unsigned char*& dst, int& N) {
            const int l = it / C_PER_L; int r = it % C_PER_L; const float* W; unsigned char* WT;
            if (r < C_UP) { const int e = r >> 6; r &= 63; N = 2048; W = arg_in(24) + ((size_t)l * NE + e) * 1024 * 2048; WT = ws + WS_WUP + l * WUP_STRIDE + (size_t)e * 2048 * 1024; }
            else { r -= C_UP; const int e = r >> 5; r &= 31; N = 1024; W = arg_in(26) + ((size_t)l * NE + e) * 1024 * 1024; WT = ws + WS_WDN + l * WDN_STRIDE + (size_t)e * 1024 * 1024; }
            const int nblk = N >> 8, k0 = 128 * (r / nblk), n0 = 256 * (r % nblk);
            src = W + (size_t)k0 * N + n0; dst = WT + (size_t)n0 * 1024 + k0;
        };
        auto cload = [&](const float* src, int N, f32x4 (&v)[16]) {
            const float* p = src + (size_t)F.wave * N + 4 * lane;
#pragma unroll
            for (int i = 0; i < 16; ++i) v[i] = *(const f32x4*)(p + (size_t)(8 * i) * N);
        };
        auto cstore = [&](unsigned char* dst, f32x4 (&v)[16]) {
            __syncthreads();
#pragma unroll
            for (int i = 0; i < 16; ++i) *(LAS f32x4*)(tile + (8 * i + F.wave) * 260 + 4 * lane) = v[i];
            __syncthreads();
            const int n = F.tid & 255, cc = F.tid >> 8;
#pragma unroll
            for (int j = 0; j < 4; ++j) { const int c = 2 * j + cc; const LAS float* sp = tile + (16 * c) * 260 + n;
                u32x4 o;
                o.x = pk4_fp8(sp[0 * 260] * 64.f, sp[1 * 260] * 64.f, sp[2 * 260] * 64.f, sp[3 * 260] * 64.f); o.y = pk4_fp8(sp[4 * 260] * 64.f, sp[5 * 260] * 64.f, sp[6 * 260] * 64.f, sp[7 * 260] * 64.f);
                o.z = pk4_fp8(sp[8 * 260] * 64.f, sp[9 * 260] * 64.f, sp[10 * 260] * 64.f, sp[11 * 260] * 64.f); o.w = pk4_fp8(sp[12 * 260] * 64.f, sp[13 * 260] * 64.f, sp[14 * 260] * 64.f, sp[15 * 260] * 64.f);
                *(u32x4*)(dst + (size_t)n * 1024 + 16 * c) = o; }
        };
        f32x4 va[16], vb[16]; const float* sa; const float* sb; unsigned char* da; unsigned char* db; int na, nb;
        int it = F.bx;
        if (it < C_TOTAL) { cdecode(it, sa, da, na); cload(sa, na, va); }
        while (it < C_TOTAL) {
            const int itb = it + F.G;
            if (itb < C_TOTAL) { cdecode(itb, sb, db, nb); cload(sb, nb, vb); }
            cstore(da, va);
            if (itb >= C_TOTAL) break;
            const int itc = itb + F.G;
            if (itc < C_TOTAL) { cdecode(itc, sa, da, na); cload(sa, na, va); }
            cstore(db, vb);
            it = itc;
        }
        __syncthreads();
    }
    phase_begin(F); ws = F.ws;
    for (int i = F.bx * NTHREADS + F.tid; i < SEQ * 32; i += NGT) {
        const int s = i >> 5, j = i & 31;
        const float inv = 1.0f / powf(10000.0f, (float)(2 * j) / 64.0f);
        const float ang = (float)s * inv;
        ((float*)(ws + WS_COS))[i] = (float)cos((double)ang); ((float*)(ws + WS_SIN))[i] = (float)sin((double)ang);
    }
    if (F.bx == 0 && F.wave < DEPTH) {
        const int l = F.wave;
        float a = arg_in(15)[l * 64 + lane] * arg_in(16)[l * 64 + lane], b = arg_in(17)[l * 64 + lane] * arg_in(18)[l * 64 + lane];
        a = wave_sum(a); b = wave_sum(b);
        float mq = fabsf(arg_in(13)[l * 64 + lane]), mk = fabsf(arg_in(14)[l * 64 + lane]);
#pragma unroll
        for (int o = 1; o < 64; o <<= 1) { mq = fmaxf(mq, __shfl_xor(mq, o)); mk = fmaxf(mk, __shfl_xor(mk, o)); }
        const float lambda_init = 0.8f - 0.6f * expf(-0.3f * (float)l);
        { float* gqk = (float*)(ws + WS_SCAL) + 64 + l * 128; gqk[lane] = arg_in(13)[l * 64 + lane]; gqk[64 + lane] = arg_in(14)[l * 64 + lane]; }
        if (lane == 0) { float* sc = (float*)(ws + WS_SCAL) + l * 4; sc[0] = expf(a) - expf(b) + lambda_init; sc[1] = C2 * 64.f * mq * mk * 1.02f + 0.5f; sc[2] = 1.0f - lambda_init; }
    }
    for (int i = gt; i < DEPTH * NE * D; i += NGT) {
        const int l = i / (NE * D), e = (i / D) % NE, k = i % D;
        const float w = arg_in(22)[(size_t)l * D * NE + (size_t)k * NE + e];
        const unsigned hi = f2bf(w); const float lo = w - __builtin_bit_cast(float, hi << 16);
        bf16_t* t = (bf16_t*)(ws + WS_WRT + l * WRT_STRIDE);
        t[e * D + k] = (bf16_t)hi; t[NE * D + e * D + k] = (bf16_t)f2bf(lo);
    }
    phase_begin(F); ws = F.ws;
#define TBL_PTRS(l) const float* lam_re = arg_in(3) + (l) * NG * NP; const float* lam_im = arg_in(4) + (l) * NG * NP; const float* log_step = arg_in(5) + (l) * NG; \
        const float* b_re = arg_in(6) + (size_t)(l) * NG * NP * HS; const float* b_im = arg_in(7) + (size_t)(l) * NG * NP * HS; \
        const float* c_re = arg_in(8) + (size_t)(l) * NG * HS * NP; const float* c_im = arg_in(9) + (size_t)(l) * NG * HS * NP; \
        bf16_t* KT = (bf16_t*)(ws + WS_KT + (l) * KT_STRIDE); bf16_t* HT = (bf16_t*)(ws + WS_HT + (l) * HT_STRIDE); (void)KT; (void)HT; (void)b_re; (void)b_im
    if (!(PMODE & 2)) {
        {
            LAS float* pwl = (LAS float*)(F.lds + LDS_RING);
            for (int cb = F.bx; cb < DEPTH * NG * 17; cb += F.G) {
                const int l = cb / (NG * 17), rb = cb % (NG * 17);
                if (rb >= NG * 9) continue;
                const int blk = rb;
                TBL_PTRS(l);
                const int g = blk / 9, s0 = (blk % 9) * 8;
                const float step = expf(log_step[g]);
                LAS float* cgl = pwl + 1024;
                LAS float* ffl = cgl + 2048;
                LAS float* bgl = ffl + 128;
                __syncthreads();
                { const int p = F.tid & 63, sl = F.tid >> 6, slot = s0 + sl; Cplx w{0.f, 0.f};
                  if (slot >= 1 && slot <= 64) w = lam_pow_fast(lam_re[g * NP + p], lam_im[g * NP + p], step, slot - 1);
                  pwl[(sl * 64 + p) * 2] = w.re; pwl[(sl * 64 + p) * 2 + 1] = w.im; }
                for (int idx = F.tid; idx < 1024; idx += NTHREADS) { cgl[2 * idx] = c_re[(size_t)g * HS * NP + idx]; cgl[2 * idx + 1] = c_im[(size_t)g * HS * NP + idx]; }
                if (F.tid < 64) { const Cplx f = bbar_factor(lam_re[g * NP + F.tid], lam_im[g * NP + F.tid], step); ffl[2 * F.tid] = f.re; ffl[2 * F.tid + 1] = f.im; }
                __syncthreads();
                for (int idx = F.tid; idx < 1024; idx += NTHREADS) { const int p = idx >> 4; const Cplx w = cmul(Cplx{ffl[2 * p], ffl[2 * p + 1]}, Cplx{b_re[(size_t)g * NP * HS + idx], b_im[(size_t)g * NP * HS + idx]}); bgl[2 * idx] = w.re; bgl[2 * idx + 1] = w.im; }
                __syncthreads();
                const int pq = F.tid & 3, h = (F.tid >> 2) & 15, sl = F.tid >> 6, slot = s0 + sl;
                float accv[16];
#pragma unroll
                for (int q = 0; q < 16; ++q) accv[q] = 0.f;
                for (int pp = 0; pp < 16; ++pp) {
                    const int p = pq * 16 + pp;
                    const Cplx w = cmul(Cplx{cgl[(h * 64 + p) * 2], cgl[(h * 64 + p) * 2 + 1]}, Cplx{pwl[(sl * 64 + p) * 2], pwl[(sl * 64 + p) * 2 + 1]});
                    const LAS f32x4* bp = (const LAS f32x4*)(bgl + p * 32);
#pragma unroll
                    for (int q2 = 0; q2 < 8; ++q2) { const f32x4 bb = bp[q2]; accv[2 * q2] += w.re * bb[0] - w.im * bb[1]; accv[2 * q2 + 1] += w.re * bb[2] - w.im * bb[3]; }
                }
#pragma unroll
                for (int q = 0; q < 16; ++q) { accv[q] += __shfl_xor(accv[q], 1); accv[q] += __shfl_xor(accv[q], 2); }
                if (pq == 0 && slot <= 64) {
                    u32x4 o0, o1; o0.x = pk2(accv[0], accv[1]); o0.y = pk2(accv[2], accv[3]); o0.z = pk2(accv[4], accv[5]); o0.w = pk2(accv[6], accv[7]);
                    o1.x = pk2(accv[8], accv[9]); o1.y = pk2(accv[10], accv[11]); o1.z = pk2(accv[12], accv[13]); o1.w = pk2(accv[14], accv[15]);
                    u32x4* dst = (u32x4*)(KT + ((size_t)(g * 65 + slot) * HS + h) * 16); dst[0] = o0; dst[1] = o1;
                }
            }
            for (int cb = F.bx; cb < DEPTH * NG * 17; cb += F.G) {
                const int l = cb / (NG * 17), rb = cb % (NG * 17);
                if (rb < NG * 9) continue;
                const int blk = rb - NG * 9;
                TBL_PTRS(l);
                const int g = blk >> 3, t0 = (blk & 7) * 8;
                const float step = expf(log_step[g]);
                __syncthreads();
                LAS float* cgl = pwl + 1024;
                { const int p = F.tid & 63, tl = F.tid >> 6; const Cplx w = lam_pow_fast(lam_re[g * NP + p], lam_im[g * NP + p], step, t0 + tl + 1); pwl[(tl * 64 + p) * 2] = w.re; pwl[(tl * 64 + p) * 2 + 1] = w.im; }
                for (int idx = F.tid; idx < 1024; idx += NTHREADS) { cgl[2 * idx] = c_re[(size_t)g * HS * NP + idx]; cgl[2 * idx + 1] = c_im[(size_t)g * HS * NP + idx]; }
                __syncthreads();
                const int pq = F.tid & 3, h = (F.tid >> 2) & 15, tl = F.tid >> 6, t = t0 + tl;
                bf16_t* dst = HT + ((size_t)(g * 1024 + t * 16 + h) * 128 + pq * 32);
                for (int pp = 0; pp < 16; pp += 4) {
                    float v[8];
#pragma unroll
                    for (int q = 0; q < 4; ++q) { const int p = pq * 16 + pp + q;
                        const Cplx w = cmul(Cplx{cgl[(h * 64 + p) * 2], cgl[(h * 64 + p) * 2 + 1]}, Cplx{pwl[(tl * 64 + p) * 2], pwl[(tl * 64 + p) * 2 + 1]});
                        v[2 * q] = w.re; v[2 * q + 1] = -w.im; }
                    u32x4 o; o.x = pk2(v[0], v[1]); o.y = pk2(v[2], v[3]); o.z = pk2(v[4], v[5]); o.w = pk2(v[6], v[7]);
                    *(u32x4*)(dst + 2 * pp) = o;
                }
            }
            __syncthreads();
        }
    }
#undef TBL_PTRS
    if (!(PMODE & 2)) for (int l = 0; l < DEPTH; ++l) {
        const float* lam_re = arg_in(3) + l * NG * NP; const float* lam_im = arg_in(4) + l * NG * NP; const float* log_step = arg_in(5) + l * NG;
        const float* b_re = arg_in(6) + (size_t)l * NG * NP * HS; const float* b_im = arg_in(7) + (size_t)l * NG * NP * HS;
        const float* c_re = arg_in(8) + (size_t)l * NG * HS * NP; const float* c_im = arg_in(9) + (size_t)l * NG * HS * NP;
        bf16_t* KT = (bf16_t*)(ws + WS_KT + l * KT_STRIDE); bf16_t* GT = (bf16_t*)(ws + WS_GT + l * GT_STRIDE); bf16_t* HT = (bf16_t*)(ws + WS_HT + l * HT_STRIDE);
        float* LAML = (float*)(ws + WS_LAML + l * LAML_STRIDE);
        for (int i = gt; i < NG * NP * 64; i += NGT) {
            const int s = i % 64, p = (i / 64) % NP, g = i / (64 * NP);
            const float step = expf(log_step[g]); const float lr = lam_re[g * NP + p], li = lam_im[g * NP + p];
            const Cplx w = cmul(lam_pow_fast(lr, li, step, 63 - s), bbar_factor(lr, li, step));
            float vr[16], vi[16];
#pragma unroll
            for (int q = 0; q < 16; ++q) { const float br = b_re[(size_t)(g * NP + p) * HS + q], bi = b_im[(size_t)(g * NP + p) * HS + q]; vr[q] = w.re * br - w.im * bi; vi[q] = w.re * bi + w.im * br; }
            u32x4* dr = (u32x4*)(GT + ((size_t)(g * 128 + 2 * p) * 1024 + s * 16)); u32x4* di = (u32x4*)(GT + ((size_t)(g * 128 + 2 * p + 1) * 1024 + s * 16));
            u32x4 o; o.x = pk2(vr[0], vr[1]); o.y = pk2(vr[2], vr[3]); o.z = pk2(vr[4], vr[5]); o.w = pk2(vr[6], vr[7]); dr[0] = o;
            o.x = pk2(vr[8], vr[9]); o.y = pk2(vr[10], vr[11]); o.z = pk2(vr[12], vr[13]); o.w = pk2(vr[14], vr[15]); dr[1] = o;
            o.x = pk2(vi[0], vi[1]); o.y = pk2(vi[2], vi[3]); o.z = pk2(vi[4], vi[5]); o.w = pk2(vi[6], vi[7]); di[0] = o;
            o.x = pk2(vi[8], vi[9]); o.y = pk2(vi[10], vi[11]); o.z = pk2(vi[12], vi[13]); o.w = pk2(vi[14], vi[15]); di[1] = o;
        }
        for (int i = gt; i < NG * NP; i += NGT) { const int g = i / NP; const Cplx w = lam_pow(lam_re[i], lam_im[i], expf(log_step[g]), 64); LAML[2 * i] = w.re; LAML[2 * i + 1] = w.im; }
    }
    {
        const float* xin = arg_in(0); const float* g0 = arg_in(1); bf16_t* XN = (bf16_t*)(ws + WS_XN);
        f32x4 va[4], vb[4];
        int m = gw;
        if (m < T) {
#pragma unroll
            for (int j = 0; j < 4; ++j) va[j] = ((const f32x4*)(xin + (size_t)m * D) + lane)[64 * j]; }
        while (m < T) {
            const int mb = m + NGW;
            if (mb < T) {
#pragma unroll
                for (int j = 0; j < 4; ++j) vb[j] = ((const f32x4*)(xin + (size_t)mb * D) + lane)[64 * j]; }
            rms_row_to_bf16(va, g0, XN + (size_t)m * D, lane);
            if (mb >= T) break;
            const int mc = mb + NGW;
            if (mc < T) {
#pragma unroll
                for (int j = 0; j < 4; ++j) va[j] = ((const f32x4*)(xin + (size_t)mc * D) + lane)[64 * j]; }
            rms_row_to_bf16(vb, g0, XN + (size_t)mb * D, lane);
            m = mc;
        }
    }
}

__device__ __forceinline__ void s5a_phase(Frame& F, int l) {
    const bf16_t* GT = (const bf16_t*)(F.ws + WS_GT + l * GT_STRIDE); const bf16_t* U = (const bf16_t*)(F.ws + WS_U); float* S = (float*)(F.ws + WS_S);
    const int lane = F.lane, n = lane & 15, kq = lane >> 4;
    for (int uu = F.bx * NWAVES + F.wave; uu < NG * 32 * 2; uu += F.G * NWAVES) {
        const int g = uu >> 6, ntile = (uu >> 1) & 31, mh = uu & 1;
        const int chunk = ntile * 16 + n;
        const bf16_t* up = U + ((size_t)chunk * 64 + (kq >> 1)) * DS + g * 16 + 8 * (kq & 1);
        const bf16_t* gp = GT + ((size_t)(g * 128 + mh * 64 + n) * 1024 + 8 * kq);
        f32x4 acc[4];
#pragma unroll
        for (int mt = 0; mt < 4; ++mt) acc[mt] = (f32x4){0.f, 0.f, 0.f, 0.f};
#pragma unroll 4
        for (int ks = 0; ks < 32; ++ks) {
            const bf16x8 b = *(const bf16x8*)(up + (size_t)(2 * ks) * DS);
#pragma unroll
            for (int mt = 0; mt < 4; ++mt) { const bf16x8 a = *(const bf16x8*)(gp + (size_t)(mt * 16) * 1024 + 32 * ks); acc[mt] = __builtin_amdgcn_mfma_f32_16x16x32_bf16(a, b, acc[mt], 0, 0, 0); }
        }
#pragma unroll
        for (int mt = 0; mt < 4; ++mt) *(f32x4*)(S + ((size_t)chunk * NG + g) * 128 + mh * 64 + mt * 16 + 4 * kq) = acc[mt];
    }
}
__device__ __forceinline__ void s5c_phase(Frame& F, int l) {
    const bf16_t* KT = (const bf16_t*)(F.ws + WS_KT + l * KT_STRIDE); const bf16_t* HT = (const bf16_t*)(F.ws + WS_HT + l * HT_STRIDE);
    const float* LAML = (const float*)(F.ws + WS_LAML + l * LAML_STRIDE); const float* S = (const float*)(F.ws + WS_S);
    const bf16_t* U = (const bf16_t*)(F.ws + WS_U); bf16_t* YG = (bf16_t*)(F.ws + WS_YG); const float* dsk = arg_in(10) + l * DS;
    const int lane = F.lane, n = lane & 15, kq = lane >> 4, wave = F.wave;
    LAS unsigned char* ktl = F.lds + LDS_RING;
    LAS unsigned char* xs = F.lds + LDS_RING + 33792 + wave * 4096;
    LAS f32x2* EB = (LAS f32x2*)(F.lds + LDS_RING + 33792 + 8 * 4096);
    LAS f32x2* EH = EB + 512;
    for (int wu = F.bx; wu < NG * 8; wu += F.G) {
        const int g = wu >> 3, scq = wu & 7, b = scq >> 1, cbase = (scq & 1) * 64, scl = wave >> 1, par = wave & 1;
        __syncthreads();
        for (int i = F.tid; i < 65 * 32; i += NTHREADS) *(LAS u32x4*)(ktl + i * 16) = *(const u32x4*)(KT + (size_t)g * 65 * 256 + i * 8);
        const Cplx L = Cplx{LAML[(g * NP + lane) * 2], LAML[(g * NP + lane) * 2 + 1]};
        const float* sp = S + ((size_t)(b * CPB) * NG + g) * 128 + 2 * lane;
        {
            f32x2 sv[8];
#pragma unroll
            for (int j = 0; j < 8; ++j) sv[j] = *(const f32x2*)(sp + (size_t)(cbase + 8 * wave + j) * NG * 128);
            Cplx E{0.f, 0.f};
#pragma unroll
            for (int j = 0; j < 8; ++j) { const Cplx nx = cmul(L, E); E.re = nx.re + sv[j][0]; E.im = nx.im + sv[j][1]; }
            EB[wave * 64 + lane] = (f32x2){E.re, E.im};
            if (cbase) {
#pragma unroll
                for (int j = 0; j < 8; ++j) sv[j] = *(const f32x2*)(sp + (size_t)(8 * wave + j) * NG * 128);
                Cplx H{0.f, 0.f};
#pragma unroll
                for (int j = 0; j < 8; ++j) { const Cplx nx = cmul(L, H); H.re = nx.re + sv[j][0]; H.im = nx.im + sv[j][1]; }
                EH[wave * 64 + lane] = (f32x2){H.re, H.im};
            }
        }
        __syncthreads();
        const int c0 = cbase + 16 * scl;
        {
            const Cplx L2 = cmul(L, L), L4 = cmul(L2, L2), L8 = cmul(L4, L4);
            Cplx X{0.f, 0.f};
            if (cbase) {
#pragma unroll
                for (int w = 0; w < 8; ++w) { const f32x2 e = EH[w * 64 + lane]; const Cplx nx = cmul(L8, X); X.re = nx.re + e[0]; X.im = nx.im + e[1]; }
            }
            for (int w = 0; w < 2 * scl; ++w) { const f32x2 e = EB[w * 64 + lane]; const Cplx nx = cmul(L8, X); X.re = nx.re + e[0]; X.im = nx.im + e[1]; }
            f32x2 sv[16];
#pragma unroll
            for (int j = 0; j < 16; ++j) sv[j] = *(const f32x2*)(sp + (size_t)(c0 + j) * NG * 128);
#pragma unroll
            for (int j = 0; j < 16; ++j) {
                *(LAS unsigned*)(xs + j * 256 + 4 * lane) = pk2(X.re, X.im);
                const Cplx nx = cmul(L, X); X.re = nx.re + sv[j][0]; X.im = nx.im + sv[j][1];
            }
        }
        const int chunk = b * CPB + c0 + n;
        bf16x8 ub[32];
        {
            const bf16_t* up = U + ((size_t)chunk * 64 + (kq >> 1)) * DS + g * 16 + 8 * (kq & 1);
#pragma unroll
            for (int kp = 0; kp < 32; ++kp) ub[kp] = *(const bf16x8*)(up + (size_t)(2 * kp) * DS);
        }
        const LAS unsigned char* xbp = xs + n * 256 + 16 * kq;
        const f32x4 dv = *(const f32x4*)(dsk + g * 16 + 4 * kq);
        const bf16_t* hp = HT + ((size_t)(g * 1024 + n) * 128 + 8 * kq);
        const bf16_t* uq = U + (size_t)chunk * 64 * DS + g * 16 + 4 * kq;
        const LAS unsigned char* kbase = ktl + (n * 16 + 8 * (kq & 1)) * 2;
        bf16x8 ha[4]; u32x2 uw;
#pragma unroll
        for (int ks = 0; ks < 4; ++ks) ha[ks] = *(const bf16x8*)(hp + (size_t)(par * 16) * 128 + 32 * ks);
        uw = *(const u32x2*)(uq + (size_t)par * DS);
        for (int ti = 0; ti < 32; ++ti) {
            const int t = 2 * ti + par, tn = (ti < 31) ? t + 2 : t;
            bf16x8 hn[4]; u32x2 un;
#pragma unroll
            for (int ks = 0; ks < 4; ++ks) hn[ks] = *(const bf16x8*)(hp + (size_t)(tn * 16) * 128 + 32 * ks);
            un = *(const u32x2*)(uq + (size_t)tn * DS);
            f32x4 acc = (f32x4){0.f, 0.f, 0.f, 0.f};
            const int slot0 = t + 1 - (kq >> 1);
#pragma unroll
            for (int kp = 0; kp < 32; ++kp) {
                if (kp <= ti) { const bf16x8 a = *(const LAS bf16x8*)(kbase + (slot0 - 2 * kp) * 512); acc = __builtin_amdgcn_mfma_f32_16x16x32_bf16(a, ub[kp], acc, 0, 0, 0); }
            }
#pragma unroll
            for (int ks = 0; ks < 4; ++ks) acc = __builtin_amdgcn_mfma_f32_16x16x32_bf16(ha[ks], *(const LAS bf16x8*)(xbp + 64 * ks), acc, 0, 0, 0);
            const float y0 = acc[0] + dv[0] * bf_lo(uw.x), y1 = acc[1] + dv[1] * bf_hi(uw.x), y2 = acc[2] + dv[2] * bf_lo(uw.y), y3 = acc[3] + dv[3] * bf_hi(uw.y);
            u32x2 w; w.x = cvt_pk_bf16(gelu_tanh(y0), gelu_tanh(y1)); w.y = cvt_pk_bf16(gelu_tanh(y2), gelu_tanh(y3));
            *(u32x2*)(YG + ((size_t)chunk * 64 + t) * DS + g * 16 + 4 * kq) = w;
#pragma unroll
            for (int ks = 0; ks < 4; ++ks) ha[ks] = hn[ks];
            uw = un;
        }
    }
    __syncthreads();
}

namespace att {
constexpr int KSLOT = 16384, VSLOT = 16384, LDS_K = 0, LDS_V = 3 * KSLOT, LDS_WS = 6 * 16384, LDS_END = LDS_WS + 8 * 256;
constexpr int STG_ROW = 136;
__device__ __forceinline__ int crow(int r, int hi) { return (r & 3) + 8 * (r >> 2) + 4 * hi; }
__device__ __forceinline__ void glds16(const void* gsrc, unsigned lds_dst) { unsigned keep;
    asm volatile("s_mov_b32 %0, m0\n\ts_mov_b32 m0, %2\n\ts_nop 0\n\tglobal_load_lds_dwordx4 %1, off\n\ts_mov_b32 m0, %0" : "=&s"(keep) : "v"(gsrc), "s"(lds_dst) : "memory"); }
typedef __attribute__((address_space(3))) const char* lds_cptr;
typedef short v4i16_t __attribute__((ext_vector_type(4)));
__device__ __forceinline__ s16x4 vtr(lds_cptr p) { return __builtin_bit_cast(s16x4, __builtin_amdgcn_ds_read_tr16_b64_v4i16((__attribute__((address_space(3))) v4i16_t*)p)); }
#define ATT_WAIT_BAR(N) asm volatile("s_waitcnt vmcnt(" #N ") lgkmcnt(0)\n\ts_barrier" ::: "memory")

template <int MODE> __device__ __forceinline__ void attn_unit(int bh, int qb, const bf16_t* Q, const bf16_t* K, const bf16_t* V, bf16_t* MIX, const float* subg, float lam, float mshift, float oml,
                                          LAS unsigned char* shm, int tid) {
    const int lane = tid & 63, r32 = lane & 31, hi = lane >> 5; const int wid = __builtin_amdgcn_readfirstlane(tid >> 6);
    const int b = bh >> 2, h = bh & 3, m = wid & 1, qg = wid >> 1;
    const size_t rowbase = (size_t)b * SEQ; const int q0 = qb * 128;
    const int NT = 2 * qb + 2, cw = 2 * qb + (qg >> 1);
    const unsigned lds0 = (unsigned)(uintptr_t)shm;
    const unsigned char* k0src = (const unsigned char*)K + (rowbase + lane) * DA + h * 128 + (wid >> 2) * 64 + ((wid >> 1) & 1) * 32 + (wid & 1) * 16;
    const bf16_t* v0src = V + (rowbase + 16 * (wid & 3) + (lane >> 2)) * DA + h * 128 + (wid >> 2) * 32 + (lane & 3) * 8;
    const bf16_t* v1src = v0src + 64;
    const unsigned kdst = lds0 + LDS_K + (wid >> 2) * 4096 + (wid & 3) * 1024, vdst = lds0 + LDS_V + wid * 1024;
#define ATT_DMA(t, slot) do { const size_t _o = (size_t)(t) * 64 * DA; \
        glds16(k0src + _o, (unsigned)__builtin_amdgcn_readfirstlane(kdst + (slot) * KSLOT)); glds16(k1src + _o, (unsigned)__builtin_amdgcn_readfirstlane(kdst + (slot) * KSLOT + 8192)); \
        glds16(v0src + _o, (unsigned)__builtin_amdgcn_readfirstlane(vdst + (slot) * VSLOT)); glds16(v1src + _o, (unsigned)__builtin_amdgcn_readfirstlane(vdst + (slot) * VSLOT + 8192)); } while (0)
    v8i32 qf;
    { const unsigned char* Qw = (const unsigned char*)Q + (rowbase + q0 + qg * 32 + r32) * DA + h * 128 + m * 64 + hi * 32;
      const u32x4 ql = *(const u32x4*)(Qw), qh = *(const u32x4*)(Qw + 16); qf = __builtin_bit_cast(v8i32, __builtin_shufflevector(ql, qh, 0, 1, 2, 3, 4, 5, 6, 7)); }
#ifndef ATT_GRP
#define ATT_GRP (wid & 1)
#endif
    const int grp = ATT_GRP;
#define ATT_DMA_K(t, slot) do { if (MODE & 1) break; const size_t _o = (size_t)(t) * 64 * DA; \
        glds16(k0src + _o, (unsigned)__builtin_amdgcn_readfirstlane(kdst + (slot) * KSLOT)); } while (0)
#define ATT_DMA_V(t, slot) do { if (MODE & 1) break; const size_t _o = (size_t)(t) * 64 * DA; \
        glds16(v0src + _o, (unsigned)__builtin_amdgcn_readfirstlane(vdst + (slot) * VSLOT)); glds16(v1src + _o, (unsigned)__builtin_amdgcn_readfirstlane(vdst + (slot) * VSLOT + 8192)); } while (0)
    ATT_DMA_K(0, 0); ATT_DMA_V(0, 0); ATT_DMA_K(1, 1); ATT_DMA_V(1, 1);
    f32x16 o[4];
#pragma unroll
    for (int d = 0; d < 4; ++d)
#pragma unroll
        for (int r = 0; r < 16; ++r) o[d][r] = 0.f;
    float l_reg = 0.f;
    const f32x16 zero16 = {0.f, 0.f, 0.f, 0.f, 0.f, 0.f, 0.f, 0.f, 0.f, 0.f, 0.f, 0.f, 0.f, 0.f, 0.f, 0.f};
    (void)mshift;
    const lds_cptr shm3 = (lds_cptr)shm;
    const lds_cptr kp0 = shm3 + LDS_K + m * 4096 + hi * 2048 + r32 * 16;
    const lds_cptr vp0 = shm3 + LDS_V + ((lane >> 4) & 1) * 32 + (lane & 3) * 8 + (4 * hi + ((lane & 15) >> 2)) * 64;
    u32x4 pw[4];
#pragma unroll
    for (int q = 0; q < 4; ++q) pw[q] = (u32x4){0u, 0u, 0u, 0u};
#define ATT_SB() __builtin_amdgcn_sched_barrier(0)
#define ATT_QKEXP(sl) do { if (MODE & 2) break; const lds_cptr kp = kp0 + (sl) * KSLOT; \
        ATT_SB(); \
        const u32x4 k0l = *(const __attribute__((address_space(3))) u32x4*)(kp), k0h = *(const __attribute__((address_space(3))) u32x4*)(kp + 1024); \
        const u32x4 k1l = *(const __attribute__((address_space(3))) u32x4*)(kp + 512), k1h = *(const __attribute__((address_space(3))) u32x4*)(kp + 1024 + 512); \
        ATT_SB(); \
        const v8i32 kf0 = __builtin_bit_cast(v8i32, __builtin_shufflevector(k0l, k0h, 0, 1, 2, 3, 4, 5, 6, 7)), kf1 = __builtin_bit_cast(v8i32, __builtin_shufflevector(k1l, k1h, 0, 1, 2, 3, 4, 5, 6, 7)); \
        f32x16 p0 = __builtin_amdgcn_mfma_scale_f32_32x32x64_f8f6f4(kf0, qf, zero16, 0, 0, 0, 0x7a7b, 1, 0x7a7b); \
        f32x16 p1 = __builtin_amdgcn_mfma_scale_f32_32x32x64_f8f6f4(kf1, qf, zero16, 0, 0, 0, 0x7a7b, 1, 0x7a7b); \
        ATT_SB(); \
        float sacc = 0.f; \
        _Pragma("unroll") for (int r = 0; r < 16; ++r) { p0[r] = __builtin_amdgcn_exp2f(p0[r]); p1[r] = __builtin_amdgcn_exp2f(p1[r]); sacc += p0[r] + p1[r]; } \
        l_reg += sacc; \
        _Pragma("unroll") for (int q = 0; q < 4; ++q) { pw[0][q] = cvt_pk_bf16(p0[2 * q], p0[2 * q + 1]); pw[1][q] = cvt_pk_bf16(p0[8 + 2 * q], p0[8 + 2 * q + 1]); \
                                                        pw[2][q] = cvt_pk_bf16(p1[2 * q], p1[2 * q + 1]); pw[3][q] = cvt_pk_bf16(p1[8 + 2 * q], p1[8 + 2 * q + 1]); } } while (0)
#define ATT_VRD(buf, d) do { _Pragma("unroll") for (int ks = 0; ks < 4; ++ks) { buf[0][ks] = vtr(vp + (d) * 4096 + ks * 1024); buf[1][ks] = vtr(vp + (d) * 4096 + ks * 1024 + 512); } } while (0)
#define ATT_VMM(buf, d) do { _Pragma("unroll") for (int ks = 0; ks < 4; ++ks) { \
        const bf16x8 vf = (bf16x8){buf[0][ks][0], buf[0][ks][1], buf[0][ks][2], buf[0][ks][3], buf[1][ks][0], buf[1][ks][1], buf[1][ks][2], buf[1][ks][3]}; \
        o[d] = __builtin_amdgcn_mfma_f32_32x32x16_bf16(__builtin_bit_cast(bf16x8, pw[ks]), vf, o[d], 0, 0, 0); } } while (0)
#define ATT_PV(sl) do { if (MODE & 4) break; const lds_cptr vp = vp0 + (sl) * VSLOT; s16x4 va[2][4], vb[2][4]; \
        ATT_SB(); ATT_VRD(va, 0); ATT_SB(); ATT_VRD(vb, 1); ATT_SB(); ATT_VMM(va, 0); ATT_SB(); ATT_VRD(va, 2); ATT_SB(); ATT_VMM(vb, 1); ATT_SB(); \
        ATT_VRD(vb, 3); ATT_SB(); ATT_VMM(va, 2); ATT_SB(); ATT_VMM(vb, 3); ATT_SB(); } while (0)
#ifndef ATT_TWO_GROUP
#define ATT_TWO_GROUP 0
#endif
    int sk = 0, skm1 = 2;
    if (ATT_TWO_GROUP) {
        for (int k = 0; k <= NT; ++k) {
            if (k + 1 < NT) { ATT_WAIT_BAR(3); } else { ATT_WAIT_BAR(0); }
            if (k + 2 < NT) ATT_DMA_K(k + 2, skm1);
            if (grp == 0) { if (k <= cw) ATT_QKEXP(sk); }
            else          { if (k >= 1 && k - 1 <= cw) ATT_PV(skm1); }
            if (k == NT) break;
            if (k + 2 < NT) { ATT_WAIT_BAR(3); } else { ATT_WAIT_BAR(0); }
            if (k + 2 < NT) ATT_DMA_V(k + 2, skm1);
            if (grp == 0) { if (k <= cw) ATT_PV(sk); }
            else          { if (k <= cw) ATT_QKEXP(sk); }
            skm1 = sk; sk = (sk == 2) ? 0 : sk + 1;
        }
    } else {
        for (int k = 0; k < NT; ++k) {
            if (k + 1 < NT) { ATT_WAIT_BAR(3); } else { ATT_WAIT_BAR(0); }
            if (k + 2 < NT) { ATT_DMA_K(k + 2, skm1); ATT_DMA_V(k + 2, skm1); }
            if (k <= cw) { ATT_QKEXP(sk); ATT_PV(sk); }
            skm1 = sk; sk = (sk == 2) ? 0 : sk + 1;
        }
    }
#undef ATT_QKEXP
#undef ATT_PV
#undef ATT_VRD
#undef ATT_VMM
#undef ATT_SB
#undef ATT_DMA_K
#undef ATT_DMA_V
    { auto rr = __builtin_amdgcn_permlane32_swap(__float_as_uint(l_reg), __float_as_uint(l_reg), false, false); l_reg = __uint_as_float(rr[0]) + __uint_as_float(rr[1]); }
    LAS float* wsf = (LAS float*)(shm + LDS_WS) + wid * 64;
    if (hi == 0) wsf[r32] = l_reg;
    ATT_WAIT_BAR(0);
    float rli[16];
    const float scl = m ? lam : 1.0f;
#pragma unroll
    for (int r = 0; r < 16; ++r) rli[r] = scl * __builtin_amdgcn_rcpf(wsf[crow(r, hi)]);
    LAS float* stg = (LAS float*)shm + qg * (32 * STG_ROW);
    if (m == 1) {
#pragma unroll
        for (int r = 0; r < 16; ++r)
#pragma unroll
            for (int d = 0; d < 4; ++d) stg[crow(r, hi) * STG_ROW + d * 32 + r32] = o[d][r] * rli[r];
    }
    ATT_WAIT_BAR(0);
    if (m == 0) {
#pragma unroll
        for (int r = 0; r < 16; ++r)
#pragma unroll
            for (int d = 0; d < 4; ++d) { LAS float* p = stg + crow(r, hi) * STG_ROW + d * 32 + r32; *p = o[d][r] * rli[r] - *p; }
    }
    ATT_WAIT_BAR(0);
    {
        const int row = 16 * m + (lane >> 2), qt = lane & 3;
        const LAS float* p = stg + row * STG_ROW + qt * 32;
        f32x4 v[8]; float ss = 0.f;
#pragma unroll
        for (int i = 0; i < 8; ++i) { v[i] = *(const LAS f32x4*)(p + 4 * i); ss += (v[i][0] * v[i][0] + v[i][1] * v[i][1]) + (v[i][2] * v[i][2] + v[i][3] * v[i][3]); }
        ss += __shfl_xor(ss, 1); ss += __shfl_xor(ss, 2);
        const float rn = rsqrtf(ss * (1.f / 128.f) + EPS) * oml;
        bf16_t* dst = MIX + (rowbase + q0 + qg * 32 + row) * D + DS + h * 128 + qt * 32;
#pragma unroll
        for (int i = 0; i < 4; ++i) {
            const f32x4 g0 = *(const f32x4*)(subg + qt * 32 + 8 * i), g1 = *(const f32x4*)(subg + qt * 32 + 8 * i + 4);
            const f32x4 a = v[2 * i] * g0 * rn, c = v[2 * i + 1] * g1 * rn;
            u32x4 w; w.x = cvt_pk_bf16(a[0], a[1]); w.y = cvt_pk_bf16(a[2], a[3]); w.z = cvt_pk_bf16(c[0], c[1]); w.w = cvt_pk_bf16(c[2], c[3]);
            *(u32x4*)(dst + 8 * i) = w;
        }
    }
    ATT_WAIT_BAR(0);
#undef ATT_DMA
}
}
template <int MODE> __device__ __forceinline__ void attn_phase(Frame& F, int l) {
    const bf16_t* Q = (const bf16_t*)(F.ws + WS_Q); const bf16_t* K = (const bf16_t*)(F.ws + WS_K); const bf16_t* V = (const bf16_t*)(F.ws + WS_V);
    bf16_t* MIX = (bf16_t*)(F.ws + WS_MIX);
    const float* sc = (const float*)(F.ws + WS_SCAL) + l * 4;
    const float lam = sc[0], mshift = sc[1], oml = sc[2];
    const float* subg = arg_in(19) + l * DV;
    const int G = F.G;
#ifndef ATT_XA
#define ATT_XA 1
#endif
    const bool xa = ATT_XA && (G & 7) == 0;
    const int x = F.bx & 7, j = F.bx >> 3, wpx = xa ? (G >> 3) : 1;
    const int npair = xa ? (32 - j + wpx - 1) / wpx : 0;
    const int nit = xa ? 4 * npair : (1024 - F.bx + G - 1) / G;
#pragma unroll 1
    for (int it = 0; it < nit; ++it) {
        int bh, qb;
        if (xa) { const int r = it / (2 * npair), rem = it % (2 * npair), sidx = j + (rem >> 1) * wpx; bh = 2 * x + r; qb = (rem & 1) ? sidx : 63 - sidx; }
        else { const int v = F.bx + it * G; bh = v >> 6; qb = v & 63; }
        att::attn_unit<MODE>(bh, qb, Q, K, V, MIX, subg, lam, mshift, oml, F.lds + LDS_RING, F.tid);
    }
}

__device__ __forceinline__ void router_phase(Frame& F, int l) {
    const bf16_t* h1 = (const bf16_t*)(F.ws + WS_H1); const float* g = arg_in(21) + (size_t)l * D; const float* br = arg_in(23) + l * NE;
    const bf16_t* WRT = (const bf16_t*)(F.ws + WS_WRT + l * WRT_STRIDE);
    bf16_t* XN = (bf16_t*)(F.ws + WS_XN); int* TOPI = (int*)(F.ws + WS_TOPI); float* TOPG = (float*)(F.ws + WS_TOPG); int* WGCNT = (int*)(F.ws + WS_WGCNT); float* RS = (float*)(F.ws + WS_RS);
    const int lane = F.lane, tid = F.tid, wave = F.wave, n = lane & 15, kq = lane >> 4;
    constexpr int PITCH = 2080;
    LAS unsigned char* wl = F.lds + LDS_RING;
    LAS float* lg = (LAS float*)(F.lds + LDS_RING + 2 * 32 * PITCH) + wave * (16 * 33 + 16);
    LAS int* cnt = (LAS int*)(F.ctl + 256);
    __syncthreads();
    for (int i = tid; i < 2 * NE * 128; i += NTHREADS) { const int row = i >> 7, c = i & 127; *(LAS u32x4*)(wl + row * PITCH + c * 16) = *(const u32x4*)(WRT + (size_t)row * D + c * 8); }
    if (tid < 32) cnt[tid] = 0;
    __syncthreads();
    for (int wgu = F.bx; wgu < T / 128; wgu += F.G) {
        if (wgu != F.bx) { __syncthreads(); if (tid < 32) cnt[tid] = 0; __syncthreads(); }
        const int row = wgu * 128 + wave * 16 + n;
        const bf16_t* hp = h1 + (size_t)row * D + 8 * kq; const float* gp = g + 8 * kq;
        bf16_t* xp = XN + (size_t)row * D + 8 * kq; unsigned char* xp8 = (unsigned char*)XN + (size_t)row * D + 8 * kq;
        const LAS unsigned char* bh = wl + n * PITCH + 16 * kq;
        f32x4 acc0 = (f32x4){0.f, 0.f, 0.f, 0.f}, acc1 = acc0; float ss = 0.f;
#pragma unroll 4
        for (int ks = 0; ks < 32; ++ks) {
            const u32x4 hw = *(const u32x4*)(hp + 32 * ks); const f32x4 h0 = (f32x4){bf_lo(hw.x), bf_hi(hw.x), bf_lo(hw.y), bf_hi(hw.y)}, h4 = (f32x4){bf_lo(hw.z), bf_hi(hw.z), bf_lo(hw.w), bf_hi(hw.w)};
            const f32x4 g0 = *(const f32x4*)(gp + 32 * ks), g4 = *(const f32x4*)(gp + 32 * ks + 4);
            const f32x4 x0 = h0 * g0, x4 = h4 * g4;
            ss += (x0[0] * x0[0] + x0[1] * x0[1]) + (x0[2] * x0[2] + x0[3] * x0[3]) + (x4[0] * x4[0] + x4[1] * x4[1]) + (x4[2] * x4[2] + x4[3] * x4[3]);
            u32x4 hi; hi.x = cvt_pk_bf16(x0[0], x0[1]); hi.y = cvt_pk_bf16(x0[2], x0[3]); hi.z = cvt_pk_bf16(x4[0], x4[1]); hi.w = cvt_pk_bf16(x4[2], x4[3]);
            if (UP_FP8) { u32x2 w8; w8.x = pk4_fp8(x0[0] * 8.f, x0[1] * 8.f, x0[2] * 8.f, x0[3] * 8.f); w8.y = pk4_fp8(x4[0] * 8.f, x4[1] * 8.f, x4[2] * 8.f, x4[3] * 8.f); *(u32x2*)(xp8 + 32 * ks) = w8; }
            else *(u32x4*)(xp + 32 * ks) = hi;
            u32x4 lo;
            lo.x = cvt_pk_bf16(x0[0] - bf_lo(hi.x), x0[1] - bf_hi(hi.x)); lo.y = cvt_pk_bf16(x0[2] - bf_lo(hi.y), x0[3] - bf_hi(hi.y));
            lo.z = cvt_pk_bf16(x4[0] - bf_lo(hi.z), x4[1] - bf_hi(hi.z)); lo.w = cvt_pk_bf16(x4[2] - bf_lo(hi.w), x4[3] - bf_hi(hi.w));
            const bf16x8 ah = __builtin_bit_cast(bf16x8, hi), al = __builtin_bit_cast(bf16x8, lo);
            const bf16x8 b0h = *(const LAS bf16x8*)(bh + 64 * ks), b1h = *(const LAS bf16x8*)(bh + 16 * PITCH + 64 * ks);
            const bf16x8 b0l = *(const LAS bf16x8*)(bh + 32 * PITCH + 64 * ks), b1l = *(const LAS bf16x8*)(bh + 48 * PITCH + 64 * ks);
            acc0 = __builtin_amdgcn_mfma_f32_16x16x32_bf16(ah, b0h, acc0, 0, 0, 0); acc1 = __builtin_amdgcn_mfma_f32_16x16x32_bf16(ah, b1h, acc1, 0, 0, 0);
            acc0 = __builtin_amdgcn_mfma_f32_16x16x32_bf16(al, b0h, acc0, 0, 0, 0); acc1 = __builtin_amdgcn_mfma_f32_16x16x32_bf16(al, b1h, acc1, 0, 0, 0);
            acc0 = __builtin_amdgcn_mfma_f32_16x16x32_bf16(ah, b0l, acc0, 0, 0, 0); acc1 = __builtin_amdgcn_mfma_f32_16x16x32_bf16(ah, b1l, acc1, 0, 0, 0);
        }
        ss += __shfl_xor(ss, 16); ss += __shfl_xor(ss, 32);
        const float r = rsqrtf(ss * (1.f / D) + EPS);
        if (kq == 0) { lg[16 * 33 + n] = r; RS[row] = r; }
        asm volatile("s_waitcnt lgkmcnt(0)" ::: "memory");
        const float b0 = br[n], b1 = br[16 + n];
#pragma unroll
        for (int q = 0; q < 4; ++q) { const float rt = lg[16 * 33 + 4 * kq + q]; lg[(4 * kq + q) * 33 + n] = acc0[q] * rt + b0; lg[(4 * kq + q) * 33 + 16 + n] = acc1[q] * rt + b1; }
        asm volatile("s_waitcnt lgkmcnt(0)" ::: "memory");
        if (lane < 16) {
            const int tok = wgu * 128 + wave * 16 + lane;
            float v[32];
#pragma unroll
            for (int e = 0; e < 32; ++e) v[e] = lg[lane * 33 + e];
            unsigned mask = 0u; float val[4]; int sel[4];
#pragma unroll
            for (int k = 0; k < 4; ++k) { float best = -INFINITY; int bi = 0;
#pragma unroll
                for (int e = 0; e < 32; ++e) { const bool ok = !((mask >> e) & 1u) && (v[e] > best); best = ok ? v[e] : best; bi = ok ? e : bi; }
                mask |= 1u << bi; val[k] = best; sel[k] = bi; }
            float ex[4], sum = 0.f;
#pragma unroll
            for (int k = 0; k < 4; ++k) { ex[k] = __expf(val[k] - val[0]); sum += ex[k]; }
            const float inv = 1.f / sum;
#pragma unroll
            for (int k = 0; k < 4; ++k) { const int pos = __hip_atomic_fetch_add(cnt + sel[k], 1, __ATOMIC_RELAXED, __HIP_MEMORY_SCOPE_WORKGROUP);
                TOPI[tok * 4 + k] = sel[k] | (pos << 8); TOPG[tok * 4 + k] = ex[k] * inv; }
        }
        __syncthreads();
        if (tid < 32) WGCNT[wgu * 32 + tid] = cnt[tid];
    }
    __syncthreads();
}
__device__ __forceinline__ void routing_phase(Frame& F) {
    const int* TOPI = (const int*)(F.ws + WS_TOPI); const float* TOPG = (const float*)(F.ws + WS_TOPG); const int* WGCNT = (const int*)(F.ws + WS_WGCNT);
    int* TOKROW = (int*)(F.ws + WS_TOKROW); int* ROWTOK = (int*)(F.ws + WS_ROWTOK); float* ROWGATE = (float*)(F.ws + WS_ROWGATE); int* TILEEXP = (int*)(F.ws + WS_TILEEXP);
    float* ROWSCALE = (float*)(F.ws + WS_ROWSCALE); const float* RS = (const float*)(F.ws + WS_RS);
    const int tid = F.tid;
    LAS int* tot = (LAS int*)(F.lds + LDS_RING);
    LAS int* pst = tot + 32;
    LAS int* mypre = pst + 40;
    LAS int* part = mypre + 32;
    for (int wgu = F.bx; wgu < 256; wgu += F.G) {
        __syncthreads();
        {
            const int e = tid & 31, wq = tid >> 5; int a = 0, mine = 0;
#pragma unroll
            for (int j = 0; j < 16; ++j) { const int w = wq * 16 + j; const int c = WGCNT[w * 32 + e]; a += c; if (w < wgu) mine += c; }
            part[wq * 32 + e] = a; part[512 + wq * 32 + e] = mine;
        }
        __syncthreads();
        if (tid < 32) { int a = 0, mine = 0;
#pragma unroll
            for (int q = 0; q < 16; ++q) { a += part[q * 32 + tid]; mine += part[512 + q * 32 + tid]; }
            tot[tid] = a; mypre[tid] = mine; }
        __syncthreads();
        if (tid == 0) { int a = 0; for (int e = 0; e < 32; ++e) { pst[e] = a; a += (tot[e] + 255) & ~255; } pst[32] = a; }
        __syncthreads();
        {
            const int t = wgu * 128 + (tid >> 2), k = tid & 3;
            const int w = TOPI[t * 4 + k]; const int e = w & 255, pos = w >> 8;
            const int dest = pst[e] + mypre[e] + pos;
            ROWTOK[dest] = t; ROWGATE[dest] = TOPG[t * 4 + k]; ROWSCALE[dest] = RS[t]; TOKROW[t * 4 + k] = dest;
        }
        if (wgu < 32) {
            const int e = wgu; const int beg = pst[e] + tot[e], end = pst[e + 1];
            for (int r = beg + tid; r < end; r += NTHREADS) { ROWTOK[r] = 0; ROWGATE[r] = 0.f; ROWSCALE[r] = 0.f; }
        }
        if (wgu == 0) {
            const int ntiles = pst[32] >> 8;
            for (int pm = tid; pm < ntiles; pm += NTHREADS) { int e = 0; for (int q = 1; q < 32; ++q) if ((pm << 8) >= pst[q]) e = q; TILEEXP[pm] = e; }
            if (tid == 0) TILEEXP[1023] = ntiles;
            if (tid < 33) TILEEXP[768 + tid] = pst[tid];
        }
    }
    __syncthreads();
}
struct CRow { u32x4 h[2]; u32x2 y[4][2]; };
__device__ __forceinline__ void crow_load(CRow& r, const bf16_t* H1, const unsigned char* YB, const int* TOKROW, int m, int lane) {
    const bf16_t* hr = H1 + (size_t)m * D + 8 * lane;
    r.h[0] = *(const u32x4*)(hr); r.h[1] = *(const u32x4*)(hr + 512);
    const int4 tr = *(const int4*)(TOKROW + m * 4);
    const int rows[4] = {tr.x, tr.y, tr.z, tr.w};
#pragma unroll
    for (int k = 0; k < 4; ++k) { const unsigned char* yr = YB + (size_t)rows[k] * D + 8 * lane; r.y[k][0] = *(const u32x2*)(yr); r.y[k][1] = *(const u32x2*)(yr + 512); }
}
__device__ __forceinline__ void crow_finish(CRow& r, float* out32, bf16_t* H2, bf16_t* XN, const float* gnext, int m, int lane) {
    f32x4 v[4];
#pragma unroll
    for (int hf = 0; hf < 2; ++hf) { const u32x4 w = r.h[hf]; v[2 * hf] = (f32x4){bf_lo(w.x), bf_hi(w.x), bf_lo(w.y), bf_hi(w.y)}; v[2 * hf + 1] = (f32x4){bf_lo(w.z), bf_hi(w.z), bf_lo(w.w), bf_hi(w.w)}; }
#pragma unroll
    for (int k = 0; k < 4; ++k)
#pragma unroll
        for (int hf = 0; hf < 2; ++hf) { fp8x4_add(r.y[k][hf].x, 1.f / 16.f, v[2 * hf]); fp8x4_add(r.y[k][hf].y, 1.f / 16.f, v[2 * hf + 1]); }
    if (out32) { float* orow = out32 + (size_t)m * D + 8 * lane; *(f32x4*)(orow) = v[0]; *(f32x4*)(orow + 4) = v[1]; *(f32x4*)(orow + 512) = v[2]; *(f32x4*)(orow + 516) = v[3]; }
    else {
        u32x4 w; w.x = cvt_pk_bf16(v[0][0], v[0][1]); w.y = cvt_pk_bf16(v[0][2], v[0][3]); w.z = cvt_pk_bf16(v[1][0], v[1][1]); w.w = cvt_pk_bf16(v[1][2], v[1][3]);
        *(u32x4*)(H2 + (size_t)m * D + 8 * lane) = w;
        w.x = cvt_pk_bf16(v[2][0], v[2][1]); w.y = cvt_pk_bf16(v[2][2], v[2][3]); w.z = cvt_pk_bf16(v[3][0], v[3][1]); w.w = cvt_pk_bf16(v[3][2], v[3][3]);
        *(u32x4*)(H2 + (size_t)m * D + 512 + 8 * lane) = w;
    }
    if (gnext) {
        float s = 0.f;
#pragma unroll
        for (int j = 0; j < 4; ++j) s += (v[j][0] * v[j][0] + v[j][1] * v[j][1]) + (v[j][2] * v[j][2] + v[j][3] * v[j][3]);
        const float rr = rsqrtf(wave_sum(s) * (1.f / D) + EPS);
        const float* gp = gnext + 8 * lane;
        const f32x4 a0 = v[0] * *(const f32x4*)(gp) * rr, a1 = v[1] * *(const f32x4*)(gp + 4) * rr, a2 = v[2] * *(const f32x4*)(gp + 512) * rr, a3 = v[3] * *(const f32x4*)(gp + 516) * rr;
        u32x4 w; w.x = cvt_pk_bf16(a0[0], a0[1]); w.y = cvt_pk_bf16(a0[2], a0[3]); w.z = cvt_pk_bf16(a1[0], a1[1]); w.w = cvt_pk_bf16(a1[2], a1[3]);
        *(u32x4*)(XN + (size_t)m * D + 8 * lane) = w;
        w.x = cvt_pk_bf16(a2[0], a2[1]); w.y = cvt_pk_bf16(a2[2], a2[3]); w.z = cvt_pk_bf16(a3[0], a3[1]); w.w = cvt_pk_bf16(a3[2], a3[3]);
        *(u32x4*)(XN + (size_t)m * D + 512 + 8 * lane) = w;
    }
}
__device__ __forceinline__ void combine_phase(Frame& F, const float* gnext, float* out32) {
    const unsigned char* YB = (const unsigned char*)(F.ws + WS_YB); const int* TOKROW = (const int*)(F.ws + WS_TOKROW); bf16_t* XN = (bf16_t*)(F.ws + WS_XN);
    const bf16_t* H1 = (const bf16_t*)(F.ws + WS_H1); bf16_t* H2 = (bf16_t*)(F.ws + WS_H2);
    const int lane = F.lane, NGW = F.G * NWAVES;
    CRow ra, rb;
    int m = F.bx * NWAVES + F.wave;
    if (m < T) crow_load(ra, H1, YB, TOKROW, m, lane);
    while (m < T) {
        const int mb = m + NGW;
        if (mb < T) crow_load(rb, H1, YB, TOKROW, mb, lane);
        crow_finish(ra, out32, H2, XN, gnext, m, lane);
        if (mb >= T) break;
        const int mc = mb + NGW;
        if (mc < T) crow_load(ra, H1, YB, TOKROW, mc, lane);
        crow_finish(rb, out32, H2, XN, gnext, mb, lane);
        m = mc;
    }
}

constexpr int NPH_LAYER = 10, NPH = 1 + DEPTH * NPH_LAYER;
__global__ void __launch_bounds__(NTHREADS, 2) mk_fwd(Args args) {
    extern __shared__ __attribute__((aligned(16))) unsigned char lds_raw[];
    Frame F;
    F.lds = (LAS unsigned char*)lds_raw; F.ctl = F.lds + LDS_CTL; F.ws = args.ws; F.ws0 = args.ws; F.out0 = args.out; F.ap = &args; F.z = 0;
    F.tid = threadIdx.x; F.lane = F.tid & 63; F.wave = __builtin_amdgcn_readfirstlane(F.tid >> 6); F.G = gridDim.x; F.bx = blockIdx.x;
    F.out = args.out;
    for (int u = F.tid; u < 1024; u += NTHREADS) ((LAS unsigned*)F.ctl)[u] = 0u;
    __syncthreads();
    XcdBarrier bar = xcd_barrier_post((unsigned*)(F.ws + WS_CTL) + CW_BAR, (volatile LAS unsigned*)F.ctl);
    const int lo = args.ph_lo, hi = args.ph_hi;
#ifndef PHMASK
#define PHMASK 0x1fff
#endif
#define RUN(k) (lo <= (k) && (k) < hi)
#define EN(b) ((PHMASK >> (b)) & 1)
#ifndef DUPMASK
#define DUPMASK 0
#endif
#ifndef ATT_PROBE_MODE
#define ATT_PROBE_MODE 0
#endif
#ifndef GEMM_PROBE
#define GEMM_PROBE 0
#endif
#ifndef PRO_PROBE_MODE
#define PRO_PROBE_MODE 0
#endif
#define NREP(b) (((DUPMASK >> (b)) & 1) ? 2 : 1)
#define SEAM(k) do { if (RUN((k) + 1)) xcd_barrier(bar); } while (0)
    if (EN(10) && RUN(0)) { { if (NREP(10) == 2) { phase_begin(F); p0_prologue<PRO_PROBE_MODE>(F); xcd_barrier(bar); } phase_begin(F); p0_prologue<0>(F); } SEAM(0); }
    for (int l = 0; l < DEPTH; ++l) {
        const int pb = 1 + l * NPH_LAYER;
#ifdef EXTRA_BARRIERS
        for (int eb = 0; eb < EXTRA_BARRIERS; ++eb) xcd_barrier(bar);
#endif
        if (EN(0) && RUN(pb + 0)) { for (int rep = 0; rep < NREP(0); ++rep) { phase_begin(F); unsigned char* ws = F.ws; (void)ws;
            PInProj P; P.so.init(T, DIN, F.G, F.bx); P.A = (const char*)(ws + WS_XN); P.B = (const char*)(ws + WS_WIN + l * WIN_STRIDE);
            P.UQKV = (bf16_t*)(ws + WS_U); P.GQK = (const float*)(ws + WS_SCAL) + 64 + l * 128; P.COS = (const float*)(ws + WS_COS); P.SIN = (const float*)(ws + WS_SIN);
            pg8::gemm_phase(F.lds + LDS_RING, F.ctl, P, F.tid);  if (rep + 1 < NREP(0)) xcd_barrier(bar); } SEAM(pb + 0);
        }
        if (EN(1) && RUN(pb + 1)) { for (int rep = 0; rep < NREP(1); ++rep) { phase_begin(F); unsigned char* ws = F.ws; (void)ws; s5a_phase(F, l);  if (rep + 1 < NREP(1)) xcd_barrier(bar); } SEAM(pb + 1); }
        if (EN(2) && RUN(pb + 2)) { for (int rep = 0; rep < NREP(2); ++rep) { phase_begin(F); unsigned char* ws = F.ws; (void)ws; if (EN(11)) for (int r2 = 0; r2 < NREP(11); ++r2) { phase_begin(F); s5c_phase(F, l); } if (EN(12)) { if (NREP(12) == 2) { phase_begin(F); attn_phase<ATT_PROBE_MODE>(F, l); } phase_begin(F); attn_phase<0>(F, l); }  if (rep + 1 < NREP(2)) xcd_barrier(bar); } SEAM(pb + 2); }
        if (EN(3) && RUN(pb + 3)) { for (int rep = 0; rep < NREP(3); ++rep) { phase_begin(F); unsigned char* ws = F.ws; (void)ws;
            PGlu P; P.so.init(T, DS, F.G, F.bx); P.A = (const char*)(ws + WS_YG); P.B = (const char*)(ws + WS_WGLU + l * WGLU_STRIDE);
            P.YG = (const bf16_t*)(ws + WS_YG); P.MIX = (bf16_t*)(ws + WS_MIX); P.RSP = (float*)(ws + WS_RSP);
            pg8::gemm_phase(F.lds + LDS_RING, F.ctl, P, F.tid);  if (rep + 1 < NREP(3)) xcd_barrier(bar); } SEAM(pb + 3);
        }
        if (EN(4) && RUN(pb + 4)) { for (int rep = 0; rep < NREP(4); ++rep) { phase_begin(F); unsigned char* ws = F.ws; (void)ws;
            POut P; P.so.init(T, D, F.G, F.bx); P.A = (const char*)(ws + WS_MIX); P.B = (const char*)(ws + WS_WOUT + l * WOUT_STRIDE);
            P.RSP = (const float*)(ws + WS_RSP); P.base32 = (l == 0) ? arg_in(0) : nullptr; P.base16 = (const bf16_t*)(ws + WS_H2); P.H1 = (bf16_t*)(ws + WS_H1);
            pg8::gemm_phase(F.lds + LDS_RING, F.ctl, P, F.tid);  if (rep + 1 < NREP(4)) xcd_barrier(bar); } SEAM(pb + 4);
        }
        if (EN(5) && RUN(pb + 5)) { for (int rep = 0; rep < NREP(5); ++rep) { phase_begin(F); unsigned char* ws = F.ws; (void)ws; router_phase(F, l);  if (rep + 1 < NREP(5)) xcd_barrier(bar); } SEAM(pb + 5); }
        if (EN(6) && RUN(pb + 6)) { for (int rep = 0; rep < NREP(6); ++rep) { phase_begin(F); unsigned char* ws = F.ws; (void)ws; routing_phase(F);  if (rep + 1 < NREP(6)) xcd_barrier(bar); } SEAM(pb + 6); }
        if (EN(7) && RUN(pb + 7)) { for (int rep = 0; rep < NREP(7); ++rep) { phase_begin(F); unsigned char* ws = F.ws; (void)ws;
            PUp P; P.mo.init(F.G, F.bx, (const int*)(ws + WS_TILEEXP) + 768);
            P.A = (const char*)(ws + WS_XN); P.B = (const char*)(ws + WS_WUP + l * WUP_STRIDE); P.ROWTOK = (const int*)(ws + WS_ROWTOK); P.TILEEXP = (const int*)(ws + WS_TILEEXP);
            P.bup = arg_in(25) + (size_t)l * NE * 2048; P.ROWSCALE = (const float*)(ws + WS_ROWSCALE); P.ACT = (bf16_t*)(ws + WS_ACT);
            if (GEMM_PROBE && rep + 1 < NREP(7)) { PUpNoDma Q; (PUp&)Q = P; pg8::gemm_phase(F.lds + LDS_RING, F.ctl, Q, F.tid); } else pg8::gemm_phase(F.lds + LDS_RING, F.ctl, P, F.tid);  if (rep + 1 < NREP(7)) xcd_barrier(bar); } SEAM(pb + 7);
        }
        if (EN(8) && RUN(pb + 8)) { for (int rep = 0; rep < NREP(8); ++rep) { phase_begin(F); unsigned char* ws = F.ws; (void)ws;
            PDown P; P.mo.init(F.G, F.bx, (const int*)(ws + WS_TILEEXP) + 768);
            P.A = (const char*)(ws + WS_ACT); P.B = (const char*)(ws + WS_WDN + l * WDN_STRIDE); P.TILEEXP = (const int*)(ws + WS_TILEEXP);
            P.bdn = arg_in(27) + (size_t)l * NE * 1024; P.ROWGATE = (const float*)(ws + WS_ROWGATE); P.YB = (bf16_t*)(ws + WS_YB);
            pg8::gemm_phase(F.lds + LDS_RING, F.ctl, P, F.tid);  if (rep + 1 < NREP(8)) xcd_barrier(bar); } SEAM(pb + 8);
        }
        if (EN(9) && RUN(pb + 9)) { for (int rep = 0; rep < NREP(9); ++rep) { phase_begin(F); unsigned char* ws = F.ws; (void)ws; combine_phase(F, (l + 1 < DEPTH) ? arg_in(1) + (size_t)(l + 1) * D : nullptr, (l + 1 < DEPTH) ? nullptr : F.out);  if (rep + 1 < NREP(9)) xcd_barrier(bar); } SEAM(pb + 9); }
    }
#undef RUN
#undef SEAM
}

extern "C" void kernel_launch(void* const* d_in, const int* in_sizes, int n_in, void* d_out, int out_size, void* d_ws, size_t ws_size, hipStream_t stream) {
    static int grid = 0;
    if (grid == 0) {
        if (n_in != 28 || out_size != T * D || ws_size < WS_END) { fprintf(stderr, "kernel_launch: unexpected shapes (n_in %d out %d ws %zu)\n", n_in, out_size, ws_size); grid = -1; return; }
        int dev = 0, cus = 0;
        if (hipGetDevice(&dev) != hipSuccess || hipDeviceGetAttribute(&cus, hipDeviceAttributeMultiprocessorCount, dev) != hipSuccess) { grid = -1; return; }
        if (hipFuncSetAttribute((const void*)mk_fwd, hipFuncAttributeMaxDynamicSharedMemorySize, LDS_BYTES) != hipSuccess) { fprintf(stderr, "kernel_launch: hipFuncSetAttribute failed\n"); grid = -1; return; }
        int per_cu = 0;
        if (hipOccupancyMaxActiveBlocksPerMultiprocessor(&per_cu, (const void*)mk_fwd, NTHREADS, LDS_BYTES) != hipSuccess || per_cu < 1) { fprintf(stderr, "kernel_launch: occupancy query says %d\n", per_cu); }
        (void)hipGetLastError();
        grid = cus;
    }
    if (grid < 0) return;
    if (hipMemsetAsync((char*)d_ws + WS_CTL, 0, CTL_ZERO_BYTES, stream) != hipSuccess) return;
    Args a{};
    for (int i = 0; i < 28; ++i) a.in[i] = (const float*)d_in[i];
    a.out = (float*)d_out; a.ws = (unsigned char*)d_ws; a.ph_lo = 0; a.ph_hi = NPH;
    hipLaunchKernelGGL(mk_fwd, dim3(grid), dim3(NTHREADS), LDS_BYTES, stream, a);
}
```

```cpp
#include <hip/hip_runtime.h>
#include <cstdio>
#include <cstdint>
#include <math.h>

#ifndef GEMM_PROBE
#define GEMM_PROBE 0
#endif
#ifndef GEMM_PROBE_KIND
#define GEMM_PROBE_KIND 1
#endif
#ifndef UP_FP8
#define UP_FP8 1
#endif
#ifndef DN_FP8
#define DN_FP8 1
#endif
#define LAS __attribute__((address_space(3)))
#define GAS __attribute__((address_space(1)))
typedef unsigned short bf16_t;
typedef short bf16x8 __attribute__((ext_vector_type(8)));
typedef short s16x4 __attribute__((ext_vector_type(4)));
typedef float f32x4 __attribute__((ext_vector_type(4)));
typedef float f32x2 __attribute__((ext_vector_type(2)));
typedef float f32x16 __attribute__((ext_vector_type(16)));
typedef unsigned u32x4 __attribute__((ext_vector_type(4)));
typedef unsigned u32x2 __attribute__((ext_vector_type(2)));
typedef int v8i32 __attribute__((ext_vector_type(8)));

constexpr int D = 1024, BATCH = 4, SEQ = 8192, DEPTH = 2, T = BATCH * SEQ;
constexpr int DS = 512, NG = 32, HS = 16, NP = 64, DA = 512, NH = 4, DV = 128, DIN = 2048;
constexpr int NE = 32, DFF = 1024, NASSIGN = T * 4;
constexpr int MPAD_MAX = NASSIGN + NE * 256, NTILE_MAX = MPAD_MAX / 256;
constexpr int NCHUNK = T / 64, CPB = SEQ / 64;
constexpr float EPS = 1e-6f;
constexpr float C2 = 0.125f * 1.4426950408889634f;
constexpr int NWAVES = 8, NTHREADS = 512;

constexpr size_t MiB = 1u << 20;
constexpr size_t WS_CTL = 0, CTL_ZERO_BYTES = 1 * MiB;
constexpr size_t WS_COS = 1 * MiB, WS_SIN = 2 * MiB;
constexpr size_t WS_SCAL = 3 * MiB;
constexpr size_t WS_KT = 4 * MiB, KT_STRIDE = 2 * MiB;
constexpr size_t WS_LAML = 8 * MiB, LAML_STRIDE = 32768;
constexpr size_t WS_WRT = 9 * MiB, WRT_STRIDE = 131072;
constexpr size_t WS_RS = 10 * MiB;
constexpr size_t WS_GT = 16 * MiB, GT_STRIDE = 8 * MiB;
constexpr size_t WS_HT = 32 * MiB, HT_STRIDE = 8 * MiB;
constexpr size_t WS_WIN = 48 * MiB, WIN_STRIDE = 4 * MiB;
constexpr size_t WS_WGLU = 56 * MiB, WGLU_STRIDE = MiB / 2;
constexpr size_t WS_WOUT = 58 * MiB, WOUT_STRIDE = 2 * MiB;
constexpr size_t WS_WUP = 64 * MiB, WUP_STRIDE = 128 * MiB;
constexpr size_t WS_WDN = 320 * MiB, WDN_STRIDE = 64 * MiB;
constexpr size_t WS_XN = 448 * MiB;
constexpr size_t WS_U = 512 * MiB, WS_Q = 544 * MiB, WS_K = 576 * MiB, WS_V = 608 * MiB;
constexpr size_t WS_YG = 640 * MiB;
constexpr size_t WS_MIX = 672 * MiB;
constexpr size_t WS_S = 736 * MiB;
constexpr size_t WS_RSP = 744 * MiB;
constexpr size_t WS_TOPI = 746 * MiB, WS_TOPG = 747 * MiB, WS_TOKROW = 748 * MiB, WS_WGCNT = 749 * MiB;
constexpr size_t WS_ROWTOK = 750 * MiB, WS_ROWGATE = 751 * MiB, WS_TILEEXP = 752 * MiB, WS_ROWSCALE = 753 * MiB;
constexpr size_t WS_ACT = 768 * MiB, WS_YB = 1040 * MiB, WS_H1 = 1180 * MiB, WS_H2 = 1244 * MiB, WS_END = 1312 * MiB;
constexpr int CW_BAR = 4096;

constexpr int LDS_CTL = 0;
constexpr int LDS_RING = 4096;
constexpr int LDS_BYTES = 163840;

__device__ __forceinline__ unsigned f2bf(float f) { unsigned u = __builtin_bit_cast(unsigned, f); return (u + 0x7fffu + ((u >> 16) & 1u)) >> 16; }
__device__ __forceinline__ unsigned pk2(float lo, float hi) { return f2bf(lo) | (f2bf(hi) << 16); }
__device__ __forceinline__ unsigned cvt_pk_bf16(float lo, float hi) { unsigned r; asm volatile("v_cvt_pk_bf16_f32 %0, %1, %2" : "=v"(r) : "v"(lo), "v"(hi)); return r; }
__device__ __forceinline__ unsigned pk4_fp8(float a, float b, float c, float d) { int w = 0; w = __builtin_amdgcn_cvt_pk_fp8_f32(a, b, w, false); w = __builtin_amdgcn_cvt_pk_fp8_f32(c, d, w, true); return (unsigned)w; }
__device__ __forceinline__ void fp8x4_add(unsigned w, float sc, f32x4& a) { const f32x2 lo = __builtin_amdgcn_cvt_pk_f32_fp8((int)w, false), hi = __builtin_amdgcn_cvt_pk_f32_fp8((int)w, true); a[0] += lo[0] * sc; a[1] += lo[1] * sc; a[2] += hi[0] * sc; a[3] += hi[1] * sc; }
__device__ __forceinline__ float bf_lo(unsigned w) { return __builtin_bit_cast(float, w << 16); }
__device__ __forceinline__ float bf_hi(unsigned w) { return __builtin_bit_cast(float, w & 0xffff0000u); }
__device__ __forceinline__ float wave_sum(float v) {
#pragma unroll
    for (int o = 1; o < 64; o <<= 1) v += __shfl_xor(v, o);
    return v;
}
__device__ __forceinline__ float gelu_tanh(float x) {
    const float z = 0.7978845608028654f * (x + 0.044715f * x * x * x);
    return x * __builtin_amdgcn_rcpf(1.f + __builtin_amdgcn_exp2f(-2.885390082f * z));
}
__device__ __forceinline__ float sigmoidf(float v) { return __builtin_amdgcn_rcpf(1.f + __builtin_amdgcn_exp2f(-1.4426950409f * v)); }

#define XB_TMO      128
#define XB_XCNT(j)  (256  + 64 * (j))
#define XB_XSUB(j)  (1280 + 64 * (j))
#define XB_XGEN(j)  (2304 + 64 * (j))
#define XB_TOP      3328
#define XB_TOPGEN   3392
#define XCD_BAR_WORDS 3456
#define XB_SPIN_CAP (1u << 18)
__device__ __forceinline__ unsigned xb_ld(unsigned* p)              { return __hip_atomic_load(p, __ATOMIC_RELAXED, __HIP_MEMORY_SCOPE_AGENT); }
__device__ __forceinline__ unsigned xb_add(unsigned* p, unsigned v) { return __hip_atomic_fetch_add(p, v, __ATOMIC_RELAXED, __HIP_MEMORY_SCOPE_AGENT); }
__device__ __forceinline__ unsigned xb_xcc_id() { return (unsigned)__builtin_amdgcn_s_getreg((3 << 11) | 20) & 0xFu; }
#define XB_SPIN(cond, bar) do { unsigned _sp = 0; while (cond) { __builtin_amdgcn_s_sleep(1); \
    if ((++_sp & 255u) == 0u) { if (xb_ld(&(bar)[XB_TMO])) break; if (_sp > XB_SPIN_CAP) { atomicAdd(&(bar)[XB_TMO], 1u); break; } } } } while (0)
struct XcdBarrier { unsigned* bar; unsigned x; volatile LAS unsigned* st; };
__device__ __forceinline__ XcdBarrier xcd_barrier_post(unsigned* bar, volatile LAS unsigned* st) {
    XcdBarrier b; b.bar = bar; b.x = xb_xcc_id(); b.st = st;
    if (threadIdx.x == 0) (void)xb_add(&bar[XB_XCNT(b.x)], 1u);
    return b;
}
__device__ __forceinline__ void xcd_barrier_complete(unsigned* bar, unsigned x, unsigned& nloc, unsigned& nx) {
    const unsigned G = gridDim.x * gridDim.y * gridDim.z;
    unsigned sum, cnt, mine, sp = 0u;
    for (;;) {
        sum = 0u; cnt = 0u; mine = 0u;
#pragma unroll
        for (unsigned j = 0; j < 16; ++j) { const unsigned c = xb_ld(&bar[XB_XCNT(j)]); sum += c; cnt += (c > 0u) ? 1u : 0u; mine = (j == x) ? c : mine; }
        if (sum == G) break;
        __builtin_amdgcn_s_sleep(1);
        if ((++sp & 255u) == 0u) { if (xb_ld(&bar[XB_TMO])) break; if (sp > XB_SPIN_CAP) { atomicAdd(&bar[XB_TMO], 1u); break; } }
    }
    nloc = mine > 0u ? mine : 1u; nx = cnt > 0u ? cnt : 1u;
}
__device__ __forceinline__ void xcd_barrier(const XcdBarrier& b) {
    asm volatile("s_waitcnt vmcnt(0)" ::: "memory");
    __syncthreads();
    if (threadIdx.x == 0) {
        unsigned* bar = b.bar;
        __builtin_amdgcn_s_waitcnt(0);
        unsigned nloc = b.st[0], nx = b.st[1];
        if (nloc == 0u) { xcd_barrier_complete(bar, b.x, nloc, nx); b.st[0] = nloc; b.st[1] = nx; }
        const unsigned old = xb_add(&bar[XB_XSUB(b.x)], 1u);
        const unsigned gen = old / nloc;
        if (old + 1u == (gen + 1u) * nloc) {
            __builtin_amdgcn_fence(__ATOMIC_RELEASE, "agent");
            asm volatile("s_waitcnt vmcnt(0)" ::: "memory");
            const unsigned og = xb_add(&bar[XB_TOP], 1u);
            const unsigned tg = og / nx;
            if (og + 1u == (tg + 1u) * nx) xb_add(&bar[XB_TOPGEN], 1u);
            else XB_SPIN(xb_ld(&bar[XB_TOPGEN]) == tg, bar);
            __builtin_amdgcn_fence(__ATOMIC_ACQUIRE, "agent");
            xb_add(&bar[XB_XGEN(b.x)], 1u);
            asm volatile("s_waitcnt vmcnt(0)" ::: "memory");
        } else {
            XB_SPIN(xb_ld(&bar[XB_XGEN(b.x)]) == gen, bar);
            __builtin_amdgcn_fence(__ATOMIC_ACQUIRE, "agent");
            asm volatile("s_waitcnt vmcnt(0)" ::: "memory");
        }
    }
    __syncthreads();
}

namespace pg8 {
constexpr int BM = 256, BK = 64, HALF = 128, HTB = HALF * BK * 2, STAGE_BYTES = 8 * HTB;
__host__ __device__ __forceinline__ int lds_byte(int r, int c) { const int st = (r >> 4) * 2 + (c >> 5), rr = r & 15, cc = c & 31, ob = rr * 64 + cc * 2; return st * 1024 + (ob ^ (((ob >> 9) & 1) << 5)); }
__host__ __device__ __forceinline__ void stage_rc(int b, int& R, int& C) { const int st = b / 1024, sb = b % 1024, swz = sb ^ (((sb >> 9) & 1) << 5); R = (st >> 1) * 16 + swz / 64; C = (st & 1) * 32 + (swz % 64) / 2; }
__host__ __device__ __forceinline__ int perm32(int rho) { const int n = rho >> 4, i = rho & 15; return 8 * (i >> 2) + 4 * n + (i & 3); }

struct Unit { int pm, pn; };
template <class P>
__device__ __forceinline__ void gemm_phase(LAS unsigned char* lds, LAS unsigned char* ldsctl, P& S, const int tid) {
    const int wid = __builtin_amdgcn_readfirstlane(tid >> 6), lane = tid & 63, wr = wid >> 2, wc = wid & 3, fr = lane & 15, fq = lane >> 4;
    constexpr bool F8 = P::FP8;
    constexpr int K = P::K, ES = F8 ? 1 : 2, nt = K * ES / 128;
    int R0, C0, R1, C1; stage_rc(tid * 16, R0, C0); stage_rc(tid * 16 + 8192, R1, C1);
    unsigned voffB[2];
    {
        const int Rb0 = P::BROW64 ? (64 * (R0 >> 5) + perm32(R0 & 31)) : ((R0 & ~31) + perm32(R0 & 31));
        const int Rb1 = P::BROW64 ? (64 * (R1 >> 5) + perm32(R1 & 31)) : ((R1 & ~31) + perm32(R1 & 31));
        voffB[0] = (unsigned)(Rb0 * K * ES + 2 * C0); voffB[1] = (unsigned)(Rb1 * K * ES + 2 * C1);
    }
    const unsigned ldsw = (unsigned)wid * 1024u;
    const int scl8 = P::SCALE_AB;
    const int aoff = lds_byte(wr * 64 + fr, fq * 8), boff = lds_byte(wc * 32 + fr, fq * 8);
#define PG8_SA(b, h) (((b) * 2 + (h)) * HTB)
#define PG8_SB(b, h) ((4 + (b) * 2 + (h)) * HTB)
    const unsigned ldsbase = (unsigned)__builtin_amdgcn_readfirstlane((int)(unsigned)(uintptr_t)lds + (int)ldsw);
#define PG8_GLDS(sbase, voff, ldsdst) do { if (P::NODMA) break; unsigned _keep; asm volatile("s_mov_b32 %0, m0\n\ts_mov_b32 m0, %3\n\ts_nop 0\n\tglobal_load_lds_dwordx4 %2, %1\n\ts_mov_b32 m0, %0" \
        : "=&s"(_keep) : "s"(sbase), "v"(voff), "s"(ldsdst) : "memory"); } while (0)
#define PG8_STAGE_A(bufoff, vo, h, kofs) do { _Pragma("unroll") for (int _i = 0; _i < 2; ++_i) \
        PG8_GLDS(Abase, (vo)[P::GATHER ? (h) : 0][_i] + ((kofs) + (P::GATHER ? 0u : (unsigned)(h) * HSTEPA)), ldsbase + (unsigned)((bufoff) + _i * 8192)); } while (0)
#define PG8_STAGE_B(bufoff, gbase) do { _Pragma("unroll") for (int _i = 0; _i < 2; ++_i) \
        PG8_GLDS((const char*)(gbase), voffB[_i], ldsbase + (unsigned)((bufoff) + _i * 8192)); } while (0)
#define PG8_LDA(dst, b, h) do { if constexpr (F8) { _Pragma("unroll") for (int m = 0; m < 4; ++m) { const u32x4 _l = *(const LAS u32x4*)(lds + PG8_SA(b, h) + aoff + m * 2048), _h = *(const LAS u32x4*)(lds + PG8_SA(b, h) + aoff + m * 2048 + 1024); dst##8[m] = __builtin_bit_cast(v8i32, __builtin_shufflevector(_l, _h, 0, 1, 2, 3, 4, 5, 6, 7)); } } \
        else { _Pragma("unroll") for (int m = 0; m < 4; ++m) _Pragma("unroll") for (int k = 0; k < 2; ++k) dst[m][k] = *(const LAS bf16x8*)(lds + PG8_SA(b, h) + aoff + m * 2048 + k * 1024); } } while (0)
#define PG8_LDB(dst, b, h) do { if constexpr (F8) { _Pragma("unroll") for (int n = 0; n < 2; ++n) { const u32x4 _l = *(const LAS u32x4*)(lds + PG8_SB(b, h) + boff + n * 2048), _h = *(const LAS u32x4*)(lds + PG8_SB(b, h) + boff + n * 2048 + 1024); dst##8[n] = __builtin_bit_cast(v8i32, __builtin_shufflevector(_l, _h, 0, 1, 2, 3, 4, 5, 6, 7)); } } \
        else { _Pragma("unroll") for (int n = 0; n < 2; ++n) _Pragma("unroll") for (int k = 0; k < 2; ++k) dst[n][k] = *(const LAS bf16x8*)(lds + PG8_SB(b, h) + boff + n * 2048 + k * 1024); } } while (0)
#define PG8_MMA(ai, bj, At, Bt) do { __builtin_amdgcn_s_setprio(1); \
        if constexpr (F8) { _Pragma("unroll") for (int m = 0; m < 4; ++m) _Pragma("unroll") for (int n = 0; n < 2; ++n) \
            asm volatile("v_mfma_scale_f32_16x16x128_f8f6f4 %0, %1, %2, %0, %3, %3 op_sel:[0,1,0] op_sel_hi:[0,0,0]" : "+v"(acc[ai][bj][m][n]) : "v"(Bt##8[n]), "v"(At##8[m]), "v"(scl8)); } \
        else { _Pragma("unroll") for (int m = 0; m < 4; ++m) _Pragma("unroll") for (int n = 0; n < 2; ++n) _Pragma("unroll") for (int k = 0; k < 2; ++k) \
            acc[ai][bj][m][n] = __builtin_amdgcn_mfma_f32_16x16x32_bf16(Bt[n][k], At[m][k], acc[ai][bj][m][n], 0, 0, 0); } \
        __builtin_amdgcn_s_setprio(0); } while (0)
#define PG8_WAIT_V(n) asm volatile("s_waitcnt vmcnt(" #n ")" ::: "memory")
#define PG8_WAIT_L(n) asm volatile("s_waitcnt lgkmcnt(" #n ")" ::: "memory")
#define PG8_BAR __builtin_amdgcn_s_barrier()
#define PG8_SCHED __builtin_amdgcn_sched_barrier(0)
    Unit cur, nxt; int ui = 0;
    if (!S.next(0, cur)) return;
    f32x4 acc[2][2][4][2];
#pragma unroll
    for (int a = 0; a < 2; ++a)
#pragma unroll
        for (int b = 0; b < 2; ++b)
#pragma unroll
            for (int m = 0; m < 4; ++m)
#pragma unroll
                for (int n = 0; n < 2; ++n) acc[a][b][m][n] = (f32x4){0.f, 0.f, 0.f, 0.f};
    bf16x8 At[4][2], B0[2][2], B1[2][2]; v8i32 At8[4], B08[2], B18[2];
    const char* const Abase = S.a_base();
    unsigned voffA[2][2], voffAn[2][2];
    const char *cB0, *cB1;
    S.unit_begin(cur, ldsctl, tid, 0);
    S.a_offs(cur, R0, C0, R1, C1, voffA, true);
    asm volatile("" ::: "memory");
    S.b_ptrs(cur, cB0, cB1);
    constexpr unsigned kstep = 128, HSTEPA = (unsigned)HALF * K * ES;
    PG8_STAGE_B(PG8_SB(0, 0), cB0); PG8_STAGE_B(PG8_SB(0, 1), cB1); PG8_STAGE_A(PG8_SA(0, 0), voffA, 0, 0u); PG8_STAGE_A(PG8_SA(0, 1), voffA, 1, 0u);
    if (wr == 1) PG8_BAR;
    PG8_WAIT_V(2); PG8_BAR;
    PG8_STAGE_B(PG8_SB(1, 0), cB0 + kstep); PG8_STAGE_A(PG8_SA(1, 0), voffA, 0, kstep); PG8_STAGE_B(PG8_SB(1, 1), cB1 + kstep);
    PG8_WAIT_V(6); PG8_BAR;
    for (;;) {
        const bool has_next = S.next(ui + 1, nxt);
        const char *nB0 = cB0, *nB1 = cB1;
        if constexpr (P::GATHER) {
#pragma unroll
            for (int h = 0; h < 2; ++h)
#pragma unroll
                for (int i = 0; i < 2; ++i) voffAn[h][i] = voffA[h][i];
        }
        if (has_next) { S.unit_begin(nxt, ldsctl, tid, (ui + 1) & 1); S.b_ptrs(nxt, nB0, nB1);
            if constexpr (P::GATHER) { int t2 = tid; asm volatile("" : "+v"(t2)); int r0, c0, r1, c1; stage_rc(t2 * 16, r0, c0); stage_rc(t2 * 16 + 8192, r1, c1); S.a_offs(nxt, r0, c0, r1, c1, voffAn, false); } }
#pragma unroll 1
        for (int t = 0; t < nt; t += 2) {
            const bool last = (t == nt - 2);
            S.midk(acc, cur, t, wr, fr, ldsctl, ui & 1);
            unsigned a2o[2][2];
            if constexpr (!P::GATHER) { if (last) { int t2 = tid; asm volatile("" : "+v"(t2)); int r0, c0, r1, c1; stage_rc(t2 * 16, r0, c0); stage_rc(t2 * 16 + 8192, r1, c1);
                                                   S.a_offs(has_next ? nxt : cur, r0, c0, r1, c1, voffAn, false); } }
#pragma unroll
            for (int h = 0; h < 2; ++h)
#pragma unroll
                for (int i = 0; i < 2; ++i) a2o[h][i] = last ? voffAn[h][i] : voffA[h][i] + (unsigned)(t + 2) * kstep;
            const char* b2h0 = last ? nB0 : cB0 + (size_t)(t + 2) * kstep; const char* b2h1 = last ? nB1 : cB1 + (size_t)(t + 2) * kstep;
            const unsigned a1k = (unsigned)(t + 1) * kstep;
            PG8_LDB(B0, 0, 0); PG8_LDB(B1, 0, 1); PG8_SCHED; PG8_LDA(At, 0, 0); PG8_STAGE_A(PG8_SA(1, 1), voffA, 1, a1k);
            PG8_WAIT_V(8); PG8_WAIT_L(0); PG8_BAR; PG8_MMA(0, 0, At, B0); PG8_MMA(0, 1, At, B1); PG8_BAR; PG8_SCHED;
            PG8_LDA(At, 0, 1); PG8_STAGE_B(PG8_SB(0, 0), b2h0); PG8_STAGE_B(PG8_SB(0, 1), b2h1); PG8_STAGE_A(PG8_SA(0, 0), a2o, 0, 0u);
            PG8_WAIT_V(8); PG8_WAIT_L(0); PG8_BAR; PG8_MMA(1, 0, At, B0); PG8_MMA(1, 1, At, B1); PG8_BAR; PG8_SCHED;
            PG8_LDB(B0, 1, 0); PG8_LDB(B1, 1, 1); PG8_SCHED; PG8_LDA(At, 1, 0); PG8_STAGE_A(PG8_SA(0, 1), a2o, 1, 0u);
            PG8_WAIT_V(8); PG8_WAIT_L(0); PG8_BAR; PG8_MMA(0, 0, At, B0); PG8_MMA(0, 1, At, B1); PG8_BAR; PG8_SCHED;
            PG8_LDA(At, 1, 1); PG8_STAGE_B(PG8_SB(1, 0), b2h0 + kstep); PG8_STAGE_B(PG8_SB(1, 1), b2h1 + kstep); PG8_STAGE_A(PG8_SA(1, 0), a2o, 0, kstep);
            PG8_WAIT_V(8); PG8_WAIT_L(0); PG8_BAR; PG8_MMA(1, 0, At, B0); PG8_MMA(1, 1, At, B1); PG8_BAR; PG8_SCHED;
        }
        if (wr == 0) PG8_BAR;
        if constexpr (F8) asm volatile("s_nop 15\n\ts_nop 15" ::: "memory");
        { int l2 = tid; asm volatile("" : "+v"(l2)); if (!P::NOEPI) S.epi(acc, cur, wr, wc, l2 & 15, (l2 >> 4) & 3); }
        if (!has_next) break;
#pragma unroll
        for (int a = 0; a < 2; ++a)
#pragma unroll
            for (int b = 0; b < 2; ++b)
#pragma unroll
                for (int m = 0; m < 4; ++m)
#pragma unroll
                    for (int n = 0; n < 2; ++n) acc[a][b][m][n] = (f32x4){0.f, 0.f, 0.f, 0.f};
        cur = nxt; cB0 = nB0; cB1 = nB1; ++ui;
#pragma unroll
        for (int h = 0; h < 2; ++h)
#pragma unroll
            for (int i = 0; i < 2; ++i) voffA[h][i] = voffAn[h][i];
        if (wr == 1) PG8_BAR;
    }
    PG8_WAIT_V(0);
    PG8_BAR;
#undef PG8_SA
#undef PG8_SB
#undef PG8_STAGE_A
#undef PG8_GLDS
#undef PG8_STAGE_B
#undef PG8_LDA
#undef PG8_LDB
#undef PG8_MMA
#undef PG8_WAIT_V
#undef PG8_WAIT_L
#undef PG8_BAR
#undef PG8_SCHED
}
struct StaticOrder {
    int nM, nN, nwg, G, c;
    __device__ void init(int M, int N, int G_, int c_) { nM = M / BM; nN = N / BM; nwg = nM * nN; G = G_; c = c_; }
    __device__ bool next(int i, Unit& u) const {
        const long L = (long)i * G + c; if (L >= nwg) return false;
        int wgid = (int)L; { const int q = nwg / 8, r = nwg % 8, xcd = wgid % 8, off = wgid / 8; wgid = (xcd < r ? xcd * (q + 1) : r * (q + 1) + (xcd - r) * q) + off; }
        const int nig = 8 * nN, gid = wgid / nig, fm = gid * 8, gsz = (nM - fm) < 8 ? (nM - fm) : 8;
        u.pm = fm + ((wgid % nig) % gsz); u.pn = (wgid % nig) / gsz; return true;
    }
};
}

struct Frame {
    LAS unsigned char* lds; LAS unsigned char* ctl;
    unsigned char* ws;
    int tid, lane, wave, G, bx;
    float* out; const struct Args* ap; unsigned char* ws0; float* out0; size_t z;
};

struct Args { const float* in[28]; float* out; unsigned char* ws; int ph_lo, ph_hi; };
#define arg_in(i) (F.ap->in[i] + F.z)
__device__ __forceinline__ void phase_begin(Frame& F) {
    int t = F.tid; asm volatile("" : "+v"(t)); F.tid = t; F.lane = t & 63; F.wave = __builtin_amdgcn_readfirstlane(t >> 6);
    size_t z = 0; asm volatile("" : "+s"(z)); F.z = z; F.ws = F.ws0 + z; F.out = F.out0 + z;
    int bx = F.bx; asm volatile("" : "+s"(bx)); F.bx = bx;
}
__device__ __forceinline__ void phase_restart(Frame& F) {
    int wv = F.wave; asm volatile("" : "+s"(wv)); F.wave = wv;
    int ln = (int)__builtin_amdgcn_mbcnt_hi(~0u, __builtin_amdgcn_mbcnt_lo(~0u, 0u)); asm volatile("" : "+v"(ln)); F.lane = ln; F.tid = wv * 64 + ln;
    size_t z = 0; asm volatile("" : "+s"(z)); F.z = z; F.ws = F.ws0 + z; F.out = F.out0 + z;
}
struct PBase {
    static constexpr bool GATHER = false, FP8 = false, NODMA = false, NOEPI = false; static constexpr int SCALE_AB = 0x7f7f7f7f;
    __device__ __forceinline__ void unit_begin(const pg8::Unit&, LAS unsigned char*, int, int) {}
    __device__ __forceinline__ void midk(f32x4 (&)[2][2][4][2], const pg8::Unit&, int, int, int, LAS unsigned char*, int) {}
    __device__ __forceinline__ void a_fix(unsigned (&)[2][2]) {}
};
struct PInProj : PBase {
    static constexpr int K = 1024, BROW64 = 1;
    pg8::StaticOrder so; const char* A; const char* B; bf16_t* UQKV; const float *GQK, *COS, *SIN;
    __device__ __forceinline__ bool next(int i, pg8::Unit& u) const { return so.next(i, u); }
    __device__ __forceinline__ const char* a_base() const { return A; }
    __device__ __forceinline__ void a_offs(const pg8::Unit& u, int R0, int C0, int R1, int C1, unsigned (&vo)[2][2], bool) const {
#pragma unroll
        for (int h = 0; h < 2; ++h) { vo[h][0] = (unsigned)((u.pm * 256 + 128 * h + R0) * K + C0) * 2u; vo[h][1] = (unsigned)((u.pm * 256 + 128 * h + R1) * K + C1) * 2u; }
    }
    __device__ __forceinline__ void b_ptrs(const pg8::Unit& u, const char*& b0, const char*& b1) const { b0 = B + (size_t)u.pn * 256 * K * 2; b1 = b0 + (size_t)32 * K * 2; }
    __device__ __forceinline__ void epi(f32x4 (&acc)[2][2][4][2], const pg8::Unit& u, int wr, int wc, int fr, int fq) const {
        const int kind = u.pn >> 1;
        const int colg = (u.pn & 1) * 256 + 64 * wc;
        bf16_t* dst = UQKV + (size_t)kind * (size_t)(16u << 20);
        const int row0 = u.pm * 256 + wr * 64 + fr;
        if (kind == 0 || kind == 3) {
#pragma unroll
            for (int ai = 0; ai < 2; ++ai)
#pragma unroll
                for (int m = 0; m < 4; ++m) { bf16_t* rowp = dst + (size_t)(row0 + ai * 128 + m * 16) * 512 + colg + 8 * fq;
#pragma unroll
                    for (int bj = 0; bj < 2; ++bj) { const f32x4 v0 = acc[ai][bj][m][0], v1 = acc[ai][bj][m][1];
                        u32x4 w; w.x = cvt_pk_bf16(v0[0], v0[1]); w.y = cvt_pk_bf16(v0[2], v0[3]); w.z = cvt_pk_bf16(v1[0], v1[1]); w.w = cvt_pk_bf16(v1[2], v1[3]);
                        *(u32x4*)(rowp + 32 * bj) = w; } }
        } else {
            const float* g = GQK + (kind - 1) * 64; const float sc = kind == 1 ? C2 * 32.0f : 16.0f;
            f32x4 g0[2], g1[2];
#pragma unroll
            for (int n = 0; n < 2; ++n) { g0[n] = *(const f32x4*)(g + 8 * fq + 4 * n); g1[n] = *(const f32x4*)(g + 32 + 8 * fq + 4 * n); }
#pragma unroll
            for (int ai = 0; ai < 2; ++ai)
#pragma unroll
                for (int m = 0; m < 4; ++m) {
                    const int row = row0 + ai * 128 + m * 16; const int pos = row & (SEQ - 1);
                    float ss = 0.f;
#pragma unroll
                    for (int bj = 0; bj < 2; ++bj)
#pragma unroll
                        for (int n = 0; n < 2; ++n) { const f32x4 x = acc[ai][bj][m][n]; ss += (x[0] * x[0] + x[1] * x[1]) + (x[2] * x[2] + x[3] * x[3]); }
                    ss += __shfl_xor(ss, 16); ss += __shfl_xor(ss, 32);
                    const float r = rsqrtf(ss * (1.f / 64.f) + EPS) * sc;
                    f32x4 o1[2], o2[2];
#pragma unroll
                    for (int n = 0; n < 2; ++n) {
                        const f32x4 c = *(const f32x4*)(COS + (size_t)pos * 32 + 8 * fq + 4 * n), s = *(const f32x4*)(SIN + (size_t)pos * 32 + 8 * fq + 4 * n);
                        const f32x4 x1 = acc[ai][0][m][n] * g0[n] * r, x2 = acc[ai][1][m][n] * g1[n] * r;
                        o1[n] = x1 * c - x2 * s; o2[n] = x2 * c + x1 * s;
                    }
                    unsigned char* rowp = (unsigned char*)dst + (size_t)row * 512 + colg + 8 * fq;
                    u32x2 w; w.x = pk4_fp8(o1[0][0], o1[0][1], o1[0][2], o1[0][3]); w.y = pk4_fp8(o1[1][0], o1[1][1], o1[1][2], o1[1][3]);
                    *(u32x2*)(rowp) = w;
                    w.x = pk4_fp8(o2[0][0], o2[0][1], o2[0][2], o2[0][3]); w.y = pk4_fp8(o2[1][0], o2[1][1], o2[1][2], o2[1][3]);
                    *(u32x2*)(rowp + 32) = w;
                    asm volatile("" ::: "memory");
                }
        }
    }
};
struct PGlu : PBase {
    static constexpr int K = 512, BROW64 = 0;
    pg8::StaticOrder so; const char* A; const char* B; const bf16_t* YG; bf16_t* MIX; float* RSP;
    __device__ __forceinline__ bool next(int i, pg8::Unit& u) const { return so.next(i, u); }
    __device__ __forceinline__ const char* a_base() const { return A; }
    __device__ __forceinline__ void a_offs(const pg8::Unit& u, int R0, int C0, int R1, int C1, unsigned (&vo)[2][2], bool) const {
#pragma unroll
        for (int h = 0; h < 2; ++h) { vo[h][0] = (unsigned)((u.pm * 256 + 128 * h + R0) * K + C0) * 2u; vo[h][1] = (unsigned)((u.pm * 256 + 128 * h + R1) * K + C1) * 2u; }
    }
    __device__ __forceinline__ void b_ptrs(const pg8::Unit& u, const char*& b0, const char*& b1) const { b0 = B + (size_t)u.pn * 256 * K * 2; b1 = b0 + (size_t)128 * K * 2; }
    __device__ __forceinline__ void epi(f32x4 (&acc)[2][2][4][2], const pg8::Unit& u, int wr, int wc, int fr, int fq) const {
        const int row0 = u.pm * 256 + wr * 64 + fr, col0 = u.pn * 256 + wc * 32 + 8 * fq;
#pragma unroll
        for (int ai = 0; ai < 2; ++ai)
#pragma unroll
            for (int m = 0; m < 4; ++m) {
                const int row = row0 + ai * 128 + m * 16; float ss = 0.f;
#pragma unroll
                for (int bj = 0; bj < 2; ++bj) {
                    const u32x4 yw = *(const u32x4*)(YG + (size_t)row * 512 + col0 + 128 * bj);
                    const f32x4 a0 = acc[ai][bj][m][0], a1 = acc[ai][bj][m][1];
                    float z[8];
                    z[0] = bf_lo(yw.x) * sigmoidf(a0[0]); z[1] = bf_hi(yw.x) * sigmoidf(a0[1]); z[2] = bf_lo(yw.y) * sigmoidf(a0[2]); z[3] = bf_hi(yw.y) * sigmoidf(a0[3]);
                    z[4] = bf_lo(yw.z) * sigmoidf(a1[0]); z[5] = bf_hi(yw.z) * sigmoidf(a1[1]); z[6] = bf_lo(yw.w) * sigmoidf(a1[2]); z[7] = bf_hi(yw.w) * sigmoidf(a1[3]);
#pragma unroll
                    for (int i = 0; i < 8; ++i) ss += z[i] * z[i];
                    u32x4 w; w.x = cvt_pk_bf16(z[0], z[1]); w.y = cvt_pk_bf16(z[2], z[3]); w.z = cvt_pk_bf16(z[4], z[5]); w.w = cvt_pk_bf16(z[6], z[7]);
                    *(u32x4*)(MIX + (size_t)row * 1024 + col0 + 128 * bj) = w;
                }
                ss += __shfl_xor(ss, 16); ss += __shfl_xor(ss, 32);
                if (fq == 0) RSP[(size_t)row * 8 + u.pn * 4 + wc] = ss;
            }
    }
};
struct POut : PBase {
    static constexpr int K = 1024, BROW64 = 0;
    pg8::StaticOrder so; const char* A; const char* B; const float* RSP; const float* base32; const bf16_t* base16; bf16_t* H1;
    __device__ __forceinline__ bool next(int i, pg8::Unit& u) const { return so.next(i, u); }
    __device__ __forceinline__ const char* a_base() const { return A; }
    __device__ __forceinline__ void a_offs(const pg8::Unit& u, int R0, int C0, int R1, int C1, unsigned (&vo)[2][2], bool) const {
#pragma unroll
        for (int h = 0; h < 2; ++h) { vo[h][0] = (unsigned)((u.pm * 256 + 128 * h + R0) * K + C0) * 2u; vo[h][1] = (unsigned)((u.pm * 256 + 128 * h + R1) * K + C1) * 2u; }
    }
    __device__ __forceinline__ void b_ptrs(const pg8::Unit& u, const char*& b0, const char*& b1) const { b0 = B + (size_t)u.pn * 256 * K * 2; b1 = b0 + (size_t)128 * K * 2; }
    __device__ __forceinline__ void unit_begin(const pg8::Unit& u, LAS unsigned char* ldsctl, int tid, int slot) const {
        if (tid < 256) {
            const f32x4 p0 = *(const f32x4*)(RSP + (size_t)(u.pm * 256 + tid) * 8), p1 = *(const f32x4*)(RSP + (size_t)(u.pm * 256 + tid) * 8 + 4);
            const float ss = ((p0[0] + p0[1]) + (p0[2] + p0[3])) + ((p1[0] + p1[1]) + (p1[2] + p1[3]));
            ((LAS float*)(ldsctl + 1024 + slot * 1024))[tid] = rsqrtf(ss * (1.f / 512.f) + EPS);
        }
    }
    __device__ __forceinline__ void midk(f32x4 (&acc)[2][2][4][2], const pg8::Unit& u, int t, int wr, int fr, LAS unsigned char* ldsctl, int slot) const {
        if (t == 8) {
            const LAS float* rs = (const LAS float*)(ldsctl + 1024 + slot * 1024);
#pragma unroll
            for (int ai = 0; ai < 2; ++ai)
#pragma unroll
                for (int m = 0; m < 4; ++m) { const float r = rs[ai * 128 + wr * 64 + m * 16 + fr];
#pragma unroll
                    for (int bj = 0; bj < 2; ++bj)
#pragma unroll
                        for (int n = 0; n < 2; ++n) acc[ai][bj][m][n] *= r; }
        }
    }
    __device__ __forceinline__ void epi(f32x4 (&acc)[2][2][4][2], const pg8::Unit& u, int wr, int wc, int fr, int fq) const {
        const int row0 = u.pm * 256 + wr * 64 + fr, col0 = u.pn * 256 + wc * 32 + 8 * fq;
#pragma unroll
        for (int ai = 0; ai < 2; ++ai)
#pragma unroll
            for (int m = 0; m < 4; ++m) { const size_t off = (size_t)(row0 + ai * 128 + m * 16) * 1024 + col0;
#pragma unroll
                for (int bj = 0; bj < 2; ++bj) {
                    f32x4 v0 = acc[ai][bj][m][0], v1 = acc[ai][bj][m][1];
                    if (base32) { v0 += *(const f32x4*)(base32 + off + bj * 128); v1 += *(const f32x4*)(base32 + off + bj * 128 + 4); }
                    else { const u32x4 b = *(const u32x4*)(base16 + off + bj * 128); v0[0] += bf_lo(b.x); v0[1] += bf_hi(b.x); v0[2] += bf_lo(b.y); v0[3] += bf_hi(b.y); v1[0] += bf_lo(b.z); v1[1] += bf_hi(b.z); v1[2] += bf_lo(b.w); v1[3] += bf_hi(b.w); }
                    u32x4 w; w.x = cvt_pk_bf16(v0[0], v0[1]); w.y = cvt_pk_bf16(v0[2], v0[3]); w.z = cvt_pk_bf16(v1[0], v1[1]); w.w = cvt_pk_bf16(v1[2], v1[3]);
                    *(u32x4*)(H1 + off + bj * 128) = w; }
                if (m & 1) asm volatile("" ::: "memory"); }
    }
};
template <int NN> struct MoeOrder {
    int j, wpx, s0, s1, s2, s3, n0, n1, n2, n3;
    __device__ __forceinline__ void init(int G, int c, const int* PST) {
#ifndef MOE_XA
#define MOE_XA 2
#endif
#ifndef MOE_CHUNKED
#define MOE_CHUNKED 0
#endif
        if (MOE_XA == 1 && (G & 7) == 0) { wpx = G >> 3; const int x = MOE_CHUNKED ? c / wpx : (c & 7); j = MOE_CHUNKED ? c % wpx : (c >> 3);
            s0 = PST[x] >> 8; n0 = (PST[x + 1] - PST[x]) >> 8; s1 = PST[x + 8] >> 8; n1 = (PST[x + 9] - PST[x + 8]) >> 8;
            s2 = PST[x + 16] >> 8; n2 = (PST[x + 17] - PST[x + 16]) >> 8; s3 = PST[x + 24] >> 8; n3 = (PST[x + 25] - PST[x + 24]) >> 8; }
        else { j = c; wpx = G; s0 = 0; n0 = PST[32] >> 8; s1 = s2 = s3 = 0; n1 = n2 = n3 = 0; }
        if (MOE_XA == 2 && (G & 7) == 0) { wpx = G >> 3; j = c >> 3; s1 = c & 7; n0 = PST[32] >> 8; }
    }
    __device__ __forceinline__ bool next(int i, pg8::Unit& u) const {
        const int q = i * wpx + j; int pml = q / NN; u.pn = q % NN;
        if (MOE_XA == 2) { u.pm = s1 + 8 * pml; return u.pm < n0; }
        if (pml < n0) { u.pm = s0 + pml; return true; } pml -= n0;
        if (pml < n1) { u.pm = s1 + pml; return true; } pml -= n1;
        if (pml < n2) { u.pm = s2 + pml; return true; } pml -= n2;
        if (pml < n3) { u.pm = s3 + pml; return true; }
        return false;
    }
};
struct PUp : PBase {
    static constexpr int K = 1024, BROW64 = 0; static constexpr bool GATHER = true, FP8 = UP_FP8; static constexpr int ES = UP_FP8 ? 1 : 2;
    static constexpr int SCALE_AB = 0x7c79;
    MoeOrder<8> mo; const char* A; const char* B; const int* ROWTOK; const int* TILEEXP; const float* bup; const float* ROWSCALE; bf16_t* ACT;
    int idx[2][2]; int c0, c1;
    __device__ __forceinline__ bool next(int i, pg8::Unit& u) const { return mo.next(i, u); }
    __device__ __forceinline__ const char* a_base() const { return A; }
    __device__ __forceinline__ void a_offs(const pg8::Unit& u, int R0, int C0, int R1, int C1, unsigned (&vo)[2][2], bool first) {
        c0 = C0; c1 = C1;
        const int* rp = ROWTOK + u.pm * 256;
#pragma unroll
        for (int h = 0; h < 2; ++h) {
            asm volatile("global_load_dword %0, %1, off" : "=v"(idx[h][0]) : "v"(rp + 128 * h + R0) : "memory");
            asm volatile("global_load_dword %0, %1, off" : "=v"(idx[h][1]) : "v"(rp + 128 * h + R1) : "memory");
        }
        asm volatile("s_waitcnt vmcnt(0)" : "+v"(idx[0][0]), "+v"(idx[0][1]), "+v"(idx[1][0]), "+v"(idx[1][1]) :: "memory");
#pragma unroll
        for (int h = 0; h < 2; ++h) { vo[h][0] = (unsigned)(idx[h][0] * K * ES + 2 * c0); vo[h][1] = (unsigned)(idx[h][1] * K * ES + 2 * c1); }
    }
    __device__ __forceinline__ void b_ptrs(const pg8::Unit& u, const char*& b0, const char*& b1) const {
        const int e = TILEEXP[u.pm]; b0 = B + ((size_t)e * 2048 + (size_t)u.pn * 128) * K * ES; b1 = b0 + (size_t)1024 * K * ES; }
    __device__ __forceinline__ void epi(f32x4 (&acc)[2][2][4][2], const pg8::Unit& u, int wr, int wc, int fr, int fq) const {
        const int e = TILEEXP[u.pm];
        const int row0 = u.pm * 256 + wr * 64 + fr, col0 = u.pn * 128 + wc * 32 + 8 * fq;
        const float* bg = bup + (size_t)e * 2048 + col0; const float* bl = bg + 1024;
        f32x4 bgv[2], blv[2];
#pragma unroll
        for (int n = 0; n < 2; ++n) { bgv[n] = *(const f32x4*)(bg + 4 * n); blv[n] = *(const f32x4*)(bl + 4 * n); }
#pragma unroll
        for (int ai = 0; ai < 2; ++ai)
#pragma unroll
            for (int m = 0; m < 4; ++m) {
                float a[8]; const float rs = ROWSCALE[row0 + ai * 128 + m * 16];
#pragma unroll
                for (int n = 0; n < 2; ++n)
#pragma unroll
                    for (int j = 0; j < 4; ++j) {
                        float glu = acc[ai][0][m][n][j] * rs + bgv[n][j], lin = acc[ai][1][m][n][j] * rs + blv[n][j];
                        glu = fminf(glu, 7.0f); lin = fminf(fmaxf(lin, -7.0f), 7.0f);
                        a[4 * n + j] = glu * __builtin_amdgcn_rcpf(1.f + __builtin_amdgcn_exp2f(-2.4554669595f * glu)) * (lin + 1.0f);
                    }
                if (DN_FP8) { u32x2 w; w.x = pk4_fp8(a[0] * 4.f, a[1] * 4.f, a[2] * 4.f, a[3] * 4.f); w.y = pk4_fp8(a[4] * 4.f, a[5] * 4.f, a[6] * 4.f, a[7] * 4.f);
                    *(u32x2*)((unsigned char*)ACT + (size_t)(row0 + ai * 128 + m * 16) * 1024 + col0) = w; }
                else { u32x4 w; w.x = cvt_pk_bf16(a[0], a[1]); w.y = cvt_pk_bf16(a[2], a[3]); w.z = cvt_pk_bf16(a[4], a[5]); w.w = cvt_pk_bf16(a[6], a[7]);
                    *(u32x4*)(ACT + (size_t)(row0 + ai * 128 + m * 16) * 1024 + col0) = w; }
            }
    }
};
struct PUpNoDma : PUp { static constexpr bool NODMA = (GEMM_PROBE_KIND & 1) != 0, NOEPI = (GEMM_PROBE_KIND & 2) != 0; };
struct PDown : PBase {
    static constexpr int K = 1024, BROW64 = 0; static constexpr bool FP8 = DN_FP8; static constexpr int ES = DN_FP8 ? 1 : 2;
    static constexpr int SCALE_AB = 0x7d79;
    MoeOrder<4> mo; const char* A; const char* B; const int* TILEEXP; const float* bdn; const float* ROWGATE; bf16_t* YB;
    __device__ __forceinline__ bool next(int i, pg8::Unit& u) const { return mo.next(i, u); }
    __device__ __forceinline__ const char* a_base() const { return A; }
    __device__ __forceinline__ void a_offs(const pg8::Unit& u, int R0, int C0, int R1, int C1, unsigned (&vo)[2][2], bool) const {
#pragma unroll
        for (int h = 0; h < 2; ++h) { vo[h][0] = (unsigned)((u.pm * 256 + 128 * h + R0) * K * ES + 2 * C0); vo[h][1] = (unsigned)((u.pm * 256 + 128 * h + R1) * K * ES + 2 * C1); }
    }
    __device__ __forceinline__ void b_ptrs(const pg8::Unit& u, const char*& b0, const char*& b1) const {
        const int e = TILEEXP[u.pm]; b0 = B + ((size_t)e * 1024 + (size_t)u.pn * 256) * K * ES; b1 = b0 + (size_t)128 * K * ES; }
    __device__ __forceinline__ void epi(f32x4 (&acc)[2][2][4][2], const pg8::Unit& u, int wr, int wc, int fr, int fq) const {
        const int e = TILEEXP[u.pm];
        const int row0 = u.pm * 256 + wr * 64 + fr, col0 = u.pn * 256 + wc * 32 + 8 * fq;
        const float* bp = bdn + (size_t)e * 1024 + col0;
#pragma unroll
        for (int bj = 0; bj < 2; ++bj) {
            const f32x4 bv0 = *(const f32x4*)(bp + 128 * bj), bv1 = *(const f32x4*)(bp + 128 * bj + 4);
#pragma unroll
            for (int ai = 0; ai < 2; ++ai)
#pragma unroll
                for (int m = 0; m < 4; ++m) { const int row = row0 + ai * 128 + m * 16; const float gt = ROWGATE[row];
                    const f32x4 v0 = (acc[ai][bj][m][0] + bv0) * (gt * 16.f), v1 = (acc[ai][bj][m][1] + bv1) * (gt * 16.f);
                    u32x2 w; w.x = pk4_fp8(v0[0], v0[1], v0[2], v0[3]); w.y = pk4_fp8(v1[0], v1[1], v1[2], v1[3]);
                    *(u32x2*)((unsigned char*)YB + (size_t)row * 1024 + col0 + 128 * bj) = w; }
            asm volatile("" ::: "memory");
        }
    }
};

struct TItem { const float* src; bf16_t* dst; const float* ksc; int N, K; unsigned char* dst8; };
__device__ __forceinline__ void titem_load(const TItem& it, f32x4 (&v)[16], int lane) {
    const float* p = it.src + (size_t)(lane >> 4) * it.N + 4 * (lane & 15);
#pragma unroll
    for (int i = 0; i < 16; ++i) v[i] = *(const f32x4*)(p + (size_t)(4 * i) * it.N);
}
__device__ __forceinline__ void titem_store(const TItem& it, f32x4 (&v)[16], LAS float* scr, int lane) {
    if (it.ksc) {
#pragma unroll
        for (int i = 0; i < 16; ++i) v[i] *= it.ksc[4 * i + (lane >> 4)];
    }
#pragma unroll
    for (int i = 0; i < 16; ++i) { LAS float* d = scr + (4 * i + (lane >> 4)) * 65 + 4 * (lane & 15); d[0] = v[i][0]; d[1] = v[i][1]; d[2] = v[i][2]; d[3] = v[i][3]; }
    asm volatile("s_waitcnt lgkmcnt(0)" ::: "memory");
    if (it.dst8) {
        const int c = lane & 3;
#pragma unroll
        for (int j = 0; j < 4; ++j) { const int n = (lane >> 2) + 16 * j; const LAS float* s = scr + (16 * c) * 65 + n;
            u32x4 o;
            o.x = pk4_fp8(s[0 * 65] * 64.f, s[1 * 65] * 64.f, s[2 * 65] * 64.f, s[3 * 65] * 64.f); o.y = pk4_fp8(s[4 * 65] * 64.f, s[5 * 65] * 64.f, s[6 * 65] * 64.f, s[7 * 65] * 64.f);
            o.z = pk4_fp8(s[8 * 65] * 64.f, s[9 * 65] * 64.f, s[10 * 65] * 64.f, s[11 * 65] * 64.f); o.w = pk4_fp8(s[12 * 65] * 64.f, s[13 * 65] * 64.f, s[14 * 65] * 64.f, s[15 * 65] * 64.f);
            *(u32x4*)(it.dst8 + (size_t)n * it.K + 16 * c) = o; }
    } else {
        const int c = lane & 7;
#pragma unroll
        for (int j = 0; j < 8; ++j) { const int n = (lane >> 3) + 8 * j; const LAS float* s = scr + (8 * c) * 65 + n;
            u32x4 o; o.x = pk2(s[0 * 65], s[1 * 65]); o.y = pk2(s[2 * 65], s[3 * 65]); o.z = pk2(s[4 * 65], s[5 * 65]); o.w = pk2(s[6 * 65], s[7 * 65]);
            *(u32x4*)(it.dst + (size_t)n * it.K + 8 * c) = o; }
    }
    asm volatile("s_waitcnt lgkmcnt(0)" ::: "memory");
}
__device__ __forceinline__ void rms_row_to_bf16(const f32x4 (&v)[4], const float* g, bf16_t* orow, int lane) {
    float s = 0.f;
#pragma unroll
    for (int j = 0; j < 4; ++j) s += (v[j][0] * v[j][0] + v[j][1] * v[j][1]) + (v[j][2] * v[j][2] + v[j][3] * v[j][3]);
    const float r = rsqrtf(wave_sum(s) * (1.f / D) + EPS);
#pragma unroll
    for (int j = 0; j < 4; ++j) { const f32x4 gg = *(const f32x4*)(g + 4 * lane + 256 * j); const f32x4 o = v[j] * gg * r;
        u32x2 w; w.x = cvt_pk_bf16(o[0], o[1]); w.y = cvt_pk_bf16(o[2], o[3]); *(u32x2*)(orow + 4 * lane + 256 * j) = w; }
}
struct Cplx { float re, im; };
__device__ __forceinline__ Cplx cmul(Cplx a, Cplx b) { return Cplx{a.re * b.re - a.im * b.im, a.re * b.im + a.im * b.re}; }
__device__ __forceinline__ Cplx lam_pow(float lr, float li, float step, int n) {
    const float mag = expf((float)n * lr * step); const double ang = (double)n * (double)li * (double)step;
    return Cplx{mag * (float)cos(ang), mag * (float)sin(ang)};
}
__device__ __forceinline__ Cplx lam_pow_fast(float lr, float li, float step, int n) {
    const float mag = __expf((float)n * lr * step); const double rev = (double)n * (double)li * (double)step * 0.15915494309189535; const float fr = (float)(rev - floor(rev));
    return Cplx{mag * __builtin_amdgcn_cosf(fr), mag * __builtin_amdgcn_sinf(fr)};
}
__device__ __forceinline__ Cplx bbar_factor(float lr, float li, float step) {
    const Cplx lb = lam_pow(lr, li, step, 1); const float nr = lb.re - 1.f, ni = lb.im, den = lr * lr + li * li;
    return Cplx{(nr * lr + ni * li) / den, (ni * lr - nr * li) / den};
}
template <int PMODE> __device__ __forceinline__ void p0_prologue(Frame& F) {
    const int gw = F.bx * NWAVES + F.wave, NGW = F.G * NWAVES, lane = F.lane;
    const int gt = F.bx * NTHREADS + F.tid, NGT = F.G * NTHREADS;
    unsigned char* ws = F.ws;
    if (!(PMODE & 1)) {
        LAS float* scr = (LAS float*)(F.lds + LDS_RING) + F.wave * (64 * 65);
        constexpr int I_UP = UP_FP8 ? 0 : 32 * 16 * 32, I_DN = DN_FP8 ? 0 : 32 * 16 * 16, I_IN = 16 * 32, I_OUT = 16 * 16, I_GLU = 8 * 8;
        constexpr int PER_L = I_UP + I_DN + I_IN + I_OUT + I_GLU, TOTAL = DEPTH * PER_L;
        auto decode = [&](int it) -> TItem {
            TItem ti; const int l = it / PER_L; int r = it % PER_L; const float* W; bf16_t* WT; int K, N; ti.ksc = nullptr; bool f8 = false;
            if (r < I_UP) { const int e = r / 512; r %= 512; K = 1024; N = 2048; W = arg_in(24) + ((size_t)l * NE + e) * 1024 * 2048; WT = (bf16_t*)(ws + WS_WUP + l * WUP_STRIDE) + (size_t)e * 2048 * 1024 / (UP_FP8 ? 2 : 1); f8 = UP_FP8; }
            else if ((r -= I_UP) < I_DN) { const int e = r / 256; r %= 256; K = 1024; N = 1024; W = arg_in(26) + ((size_t)l * NE + e) * 1024 * 1024; WT = (bf16_t*)(ws + WS_WDN + l * WDN_STRIDE) + (size_t)e * 1024 * 1024 / (DN_FP8 ? 2 : 1); f8 = DN_FP8; }
            else if ((r -= I_DN) < I_IN) { K = 1024; N = 2048; W = arg_in(2) + (size_t)l * 1024 * 2048; WT = (bf16_t*)(ws + WS_WIN + l * WIN_STRIDE); }
            else if ((r -= I_IN) < I_OUT) { K = 1024; N = 1024; W = arg_in(20) + (size_t)l * 1024 * 1024; WT = (bf16_t*)(ws + WS_WOUT + l * WOUT_STRIDE); if ((r / 16) * 64 < DS) ti.ksc = arg_in(12) + l * DS + (r / 16) * 64; }
            else { r -= I_OUT; K = 512; N = 512; W = arg_in(11) + (size_t)l * 512 * 512; WT = (bf16_t*)(ws + WS_WGLU + l * WGLU_STRIDE); }
            const int nblk = N / 64, k0 = 64 * (r / nblk), n0 = 64 * (r % nblk);
            ti.src = W + (size_t)k0 * N + n0; ti.dst = WT + (size_t)n0 * K + k0; ti.N = N; ti.K = K; ti.dst8 = f8 ? (unsigned char*)WT + (size_t)n0 * K + k0 : nullptr; return ti;
        };
        f32x4 va[16]; TItem ia;
        for (int it = gw; it < TOTAL; it += NGW) { ia = decode(it); titem_load(ia, va, lane); titem_store(ia, va, scr, lane); }
    }
    if (!(PMODE & 1) && (UP_FP8 || DN_FP8)) {
        LAS float* tile = (LAS float*)(F.lds + LDS_RING);
        constexpr int C_UP = UP_FP8 ? 32 * 8 * 8 : 0, C_DN = DN_FP8 ? 32 * 8 * 4 : 0, C_PER_L = C_UP + C_DN, C_TOTAL = DEPTH * C_PER_L;
        auto cdecode = [&](int it, const float*& src, unsigned char*& dst, int& N) {
            const int l = it / C_PER_L; int r = it % C_PER_L; const float* W; unsigned char* WT;
            if (r < C_UP) { const int e = r >> 6; r &= 63; N = 2048; W = arg_in(24) + ((size_t)l * NE + e) * 1024 * 2048; WT = ws + WS_WUP + l * WUP_STRIDE + (size_t)e * 2048 * 1024; }
            else { r -= C_UP; const int e = r >> 5; r &= 31; N = 1024; W = arg_in(26) + ((size_t)l * NE + e) * 1024 * 1024; WT = ws + WS_WDN + l * WDN_STRIDE + (size_t)e * 1024 * 1024; }
            const int nblk = N >> 8, k0 = 128 * (r / nblk), n0 = 256 * (r % nblk);
            src = W + (size_t)k0 * N + n0; dst = WT + (size_t)n0 * 1024 + k0;
        };
        auto cload = [&](const float* src, int N, f32x4 (&v)[16]) {
            const float* p = src + (size_t)F.wave * N + 4 * lane;
#pragma unroll
            for (int i = 0; i < 16; ++i) v[i] = *(const f32x4*)(p + (size_t)(8 * i) * N);
        };
        auto cstore = [&](unsigned char* dst, f32x4 (&v)[16]) {
            __syncthreads();
#pragma unroll
            for (int i = 0; i < 16; ++i) *(LAS f32x4*)(tile + (8 * i + F.wave) * 260 + 4 * lane) = v[i];
            __syncthreads();
            const int n = F.tid & 255, cc = F.tid >> 8;
#pragma unroll
            for (int j = 0; j < 4; ++j) { const int c = 2 * j + cc; const LAS float* sp = tile + (16 * c) * 260 + n;
                u32x4 o;
                o.x = pk4_fp8(sp[0 * 260] * 64.f, sp[1 * 260] * 64.f, sp[2 * 260] * 64.f, sp[3 * 260] * 64.f); o.y = pk4_fp8(sp[4 * 260] * 64.f, sp[5 * 260] * 64.f, sp[6 * 260] * 64.f, sp[7 * 260] * 64.f);
                o.z = pk4_fp8(sp[8 * 260] * 64.f, sp[9 * 260] * 64.f, sp[10 * 260] * 64.f, sp[11 * 260] * 64.f); o.w = pk4_fp8(sp[12 * 260] * 64.f, sp[13 * 260] * 64.f, sp[14 * 260] * 64.f, sp[15 * 260] * 64.f);
                *(u32x4*)(dst + (size_t)n * 1024 + 16 * c) = o; }
        };
        f32x4 va[16], vb[16]; const float* sa; const float* sb; unsigned char* da; unsigned char* db; int na, nb;
        int it = F.bx;
        if (it < C_TOTAL) { cdecode(it, sa, da, na); cload(sa, na, va); }
        while (it < C_TOTAL) {
            const int itb = it + F.G;
            if (itb < C_TOTAL) { cdecode(itb, sb, db, nb); cload(sb, nb, vb); }
            cstore(da, va);
            if (itb >= C_TOTAL) break;
            const int itc = itb + F.G;
            if (itc < C_TOTAL) { cdecode(itc, sa, da, na); cload(sa, na, va); }
            cstore(db, vb);
            it = itc;
        }
        __syncthreads();
    }
    phase_begin(F); ws = F.ws;
    for (int i = F.bx * NTHREADS + F.tid; i < SEQ * 32; i += NGT) {
        const int s = i >> 5, j = i & 31;
        const float inv = 1.0f / powf(10000.0f, (float)(2 * j) / 64.0f);
        const float ang = (float)s * inv;
        ((float*)(ws + WS_COS))[i] = (float)cos((double)ang); ((float*)(ws + WS_SIN))[i] = (float)sin((double)ang);
    }
    if (F.bx == 0 && F.wave < DEPTH) {
        const int l = F.wave;
        float a = arg_in(15)[l * 64 + lane] * arg_in(16)[l * 64 + lane], b = arg_in(17)[l * 64 + lane] * arg_in(18)[l * 64 + lane];
        a = wave_sum(a); b = wave_sum(b);
        float mq = fabsf(arg_in(13)[l * 64 + lane]), mk = fabsf(arg_in(14)[l * 64 + lane]);
#pragma unroll
        for (int o = 1; o < 64; o <<= 1) { mq = fmaxf(mq, __shfl_xor(mq, o)); mk = fmaxf(mk, __shfl_xor(mk, o)); }
        const float lambda_init = 0.8f - 0.6f * expf(-0.3f * (float)l);
        { float* gqk = (float*)(ws + WS_SCAL) + 64 + l * 128; gqk[lane] = arg_in(13)[l * 64 + lane]; gqk[64 + lane] = arg_in(14)[l * 64 + lane]; }
        if (lane == 0) { float* sc = (float*)(ws + WS_SCAL) + l * 4; sc[0] = expf(a) - expf(b) + lambda_init; sc[1] = C2 * 64.f * mq * mk * 1.02f + 0.5f; sc[2] = 1.0f - lambda_init; }
    }
    for (int i = gt; i < DEPTH * NE * D; i += NGT) {
        const int l = i / (NE * D), e = (i / D) % NE, k = i % D;
        const float w = arg_in(22)[(size_t)l * D * NE + (size_t)k * NE + e];
        const unsigned hi = f2bf(w); const float lo = w - __builtin_bit_cast(float, hi << 16);
        bf16_t* t = (bf16_t*)(ws + WS_WRT + l * WRT_STRIDE);
        t[e * D + k] = (bf16_t)hi; t[NE * D + e * D + k] = (bf16_t)f2bf(lo);
    }
    phase_begin(F); ws = F.ws;
#define TBL_PTRS(l) const float* lam_re = arg_in(3) + (l) * NG * NP; const float* lam_im = arg_in(4) + (l) * NG * NP; const float* log_step = arg_in(5) + (l) * NG; \
        const float* b_re = arg_in(6) + (size_t)(l) * NG * NP * HS; const float* b_im = arg_in(7) + (size_t)(l) * NG * NP * HS; \
        const float* c_re = arg_in(8) + (size_t)(l) * NG * HS * NP; const float* c_im = arg_in(9) + (size_t)(l) * NG * HS * NP; \
        bf16_t* KT = (bf16_t*)(ws + WS_KT + (l) * KT_STRIDE); bf16_t* HT = (bf16_t*)(ws + WS_HT + (l) * HT_STRIDE); (void)KT; (void)HT; (void)b_re; (void)b_im
    if (!(PMODE & 2)) {
        {
            LAS float* pwl = (LAS float*)(F.lds + LDS_RING);
            for (int cb = F.bx; cb < DEPTH * NG * 17; cb += F.G) {
                const int l = cb / (NG * 17), rb = cb % (NG * 17);
                if (rb >= NG * 9) continue;
                const int blk = rb;
                TBL_PTRS(l);
                const int g = blk / 9, s0 = (blk % 9) * 8;
                const float step = expf(log_step[g]);
                LAS float* cgl = pwl + 1024;
                LAS float* ffl = cgl + 2048;
                LAS float* bgl = ffl + 128;
                __syncthreads();
                { const int p = F.tid & 63, sl = F.tid >> 6, slot = s0 + sl; Cplx w{0.f, 0.f};
                  if (slot >= 1 && slot <= 64) w = lam_pow_fast(lam_re[g * NP + p], lam_im[g * NP + p], step, slot - 1);
                  pwl[(sl * 64 + p) * 2] = w.re; pwl[(sl * 64 + p) * 2 + 1] = w.im; }
                for (int idx = F.tid; idx < 1024; idx += NTHREADS) { cgl[2 * idx] = c_re[(size_t)g * HS * NP + idx]; cgl[2 * idx + 1] = c_im[(size_t)g * HS * NP + idx]; }
                if (F.tid < 64) { const Cplx f = bbar_factor(lam_re[g * NP + F.tid], lam_im[g * NP + F.tid], step); ffl[2 * F.tid] = f.re; ffl[2 * F.tid + 1] = f.im; }
                __syncthreads();
                for (int idx = F.tid; idx < 1024; idx += NTHREADS) { const int p = idx >> 4; const Cplx w = cmul(Cplx{ffl[2 * p], ffl[2 * p + 1]}, Cplx{b_re[(size_t)g * NP * HS + idx], b_im[(size_t)g * NP * HS + idx]}); bgl[2 * idx] = w.re; bgl[2 * idx + 1] = w.im; }
                __syncthreads();
                const int pq = F.tid & 3, h = (F.tid >> 2) & 15, sl = F.tid >> 6, slot = s0 + sl;
                float accv[16];
#pragma unroll
                for (int q = 0; q < 16; ++q) accv[q] = 0.f;
                for (int pp = 0; pp < 16; ++pp) {
                    const int p = pq * 16 + pp;
                    const Cplx w = cmul(Cplx{cgl[(h * 64 + p) * 2], cgl[(h * 64 + p) * 2 + 1]}, Cplx{pwl[(sl * 64 + p) * 2], pwl[(sl * 64 + p) * 2 + 1]});
                    const LAS f32x4* bp = (const LAS f32x4*)(bgl + p * 32);
#pragma unroll
                    for (int q2 = 0; q2 < 8; ++q2) { const f32x4 bb = bp[q2]; accv[2 * q2] += w.re * bb[0] - w.im * bb[1]; accv[2 * q2 + 1] += w.re * bb[2] - w.im * bb[3]; }
                }
#pragma unroll
                for (int q = 0; q < 16; ++q) { accv[q] += __shfl_xor(accv[q], 1); accv[q] += __shfl_xor(accv[q], 2); }
                if (pq == 0 && slot <= 64) {
                    u32x4 o0, o1; o0.x = pk2(accv[0], accv[1]); o0.y = pk2(accv[2], accv[3]); o0.z = pk2(accv[4], accv[5]); o0.w = pk2(accv[6], accv[7]);
                    o1.x = pk2(accv[8], accv[9]); o1.y = pk2(accv[10], accv[11]); o1.z = pk2(accv[12], accv[13]); o1.w = pk2(accv[14], accv[15]);
                    u32x4* dst = (u32x4*)(KT + ((size_t)(g * 65 + slot) * HS + h) * 16); dst[0] = o0; dst[1] = o1;
                }
            }
            for (int cb = F.bx; cb < DEPTH * NG * 17; cb += F.G) {
                const int l = cb / (NG * 17), rb = cb % (NG * 17);
                if (rb < NG * 9) continue;
                const int blk = rb - NG * 9;
                TBL_PTRS(l);
                const int g = blk >> 3, t0 = (blk & 7) * 8;
                const float step = expf(log_step[g]);
                __syncthreads();
                LAS float* cgl = pwl + 1024;
                { const int p = F.tid & 63, tl = F.tid >> 6; const Cplx w = lam_pow_fast(lam_re[g * NP + p], lam_im[g * NP + p], step, t0 + tl + 1); pwl[(tl * 64 + p) * 2] = w.re; pwl[(tl * 64 + p) * 2 + 1] = w.im; }
                for (int idx = F.tid; idx < 1024; idx += NTHREADS) { cgl[2 * idx] = c_re[(size_t)g * HS * NP + idx]; cgl[2 * idx + 1] = c_im[(size_t)g * HS * NP + idx]; }
                __syncthreads();
                const int pq = F.tid & 3, h = (F.tid >> 2) & 15, tl = F.tid >> 6, t = t0 + tl;
                bf16_t* dst = HT + ((size_t)(g * 1024 + t * 16 + h) * 128 + pq * 32);
                for (int pp = 0; pp < 16; pp += 4) {
                    float v[8];
#pragma unroll
                    for (int q = 0; q < 4; ++q) { const int p = pq * 16 + pp + q;
                        const Cplx w = cmul(Cplx{cgl[(h * 64 + p) * 2], cgl[(h * 64 + p) * 2 + 1]}, Cplx{pwl[(tl * 64 + p) * 2], pwl[(tl * 64 + p) * 2 + 1]});
                        v[2 * q] = w.re; v[2 * q + 1] = -w.im; }
                    u32x4 o; o.x = pk2(v[0], v[1]); o.y = pk2(v[2], v[3]); o.z = pk2(v[4], v[5]); o.w = pk2(v[6], v[7]);
                    *(u32x4*)(dst + 2 * pp) = o;
                }
            }
            __syncthreads();
        }
    }
#undef TBL_PTRS
    if (!(PMODE & 2)) for (int l = 0; l < DEPTH; ++l) {
        const float* lam_re = arg_in(3) + l * NG * NP; const float* lam_im = arg_in(4) + l * NG * NP; const float* log_step = arg_in(5) + l * NG;
        const float* b_re = arg_in(6) + (size_t)l * NG * NP * HS; const float* b_im = arg_in(7) + (size_t)l * NG * NP * HS;
        const float* c_re = arg_in(8) + (size_t)l * NG * HS * NP; const float* c_im = arg_in(9) + (size_t)l * NG * HS * NP;
        bf16_t* KT = (bf16_t*)(ws + WS_KT + l * KT_STRIDE); bf16_t* GT = (bf16_t*)(ws + WS_GT + l * GT_STRIDE); bf16_t* HT = (bf16_t*)(ws + WS_HT + l * HT_STRIDE);
        float* LAML = (float*)(ws + WS_LAML + l * LAML_STRIDE);
        for (int i = gt; i < NG * NP * 64; i += NGT) {
            const int s = i % 64, p = (i / 64) % NP, g = i / (64 * NP);
            const float step = expf(log_step[g]); const float lr = lam_re[g * NP + p], li = lam_im[g * NP + p];
            const Cplx w = cmul(lam_pow_fast(lr, li, step, 63 - s), bbar_factor(lr, li, step));
            float vr[16], vi[16];
#pragma unroll
            for (int q = 0; q < 16; ++q) { const float br = b_re[(size_t)(g * NP + p) * HS + q], bi = b_im[(size_t)(g * NP + p) * HS + q]; vr[q] = w.re * br - w.im * bi; vi[q] = w.re * bi + w.im * br; }
            u32x4* dr = (u32x4*)(GT + ((size_t)(g * 128 + 2 * p) * 1024 + s * 16)); u32x4* di = (u32x4*)(GT + ((size_t)(g * 128 + 2 * p + 1) * 1024 + s * 16));
            u32x4 o; o.x = pk2(vr[0], vr[1]); o.y = pk2(vr[2], vr[3]); o.z = pk2(vr[4], vr[5]); o.w = pk2(vr[6], vr[7]); dr[0] = o;
            o.x = pk2(vr[8], vr[9]); o.y = pk2(vr[10], vr[11]); o.z = pk2(vr[12], vr[13]); o.w = pk2(vr[14], vr[15]); dr[1] = o;
            o.x = pk2(vi[0], vi[1]); o.y = pk2(vi[2], vi[3]); o.z = pk2(vi[4], vi[5]); o.w = pk2(vi[6], vi[7]); di[0] = o;
            o.x = pk2(vi[8], vi[9]); o.y = pk2(vi[10], vi[11]); o.z = pk2(vi[12], vi[13]); o.w = pk2(vi[14], vi[15]); di[1] = o;
        }
        for (int i = gt; i < NG * NP; i += NGT) { const int g = i / NP; const Cplx w = lam_pow(lam_re[i], lam_im[i], expf(log_step[g]), 64); LAML[2 * i] = w.re; LAML[2 * i + 1] = w.im; }
    }
    {
        const float* xin = arg_in(0); const float* g0 = arg_in(1); bf16_t* XN = (bf16_t*)(ws + WS_XN);
        f32x4 va[4], vb[4];
        int m = gw;
        if (m < T) {
#pragma unroll
            for (int j = 0; j < 4; ++j) va[j] = ((const f32x4*)(xin + (size_t)m * D) + lane)[64 * j]; }
        while (m < T) {
            const int mb = m + NGW;
            if (mb < T) {
#pragma unroll
                for (int j = 0; j < 4; ++j) vb[j] = ((const f32x4*)(xin + (size_t)mb * D) + lane)[64 * j]; }
            rms_row_to_bf16(va, g0, XN + (size_t)m * D, lane);
            if (mb >= T) break;
            const int mc = mb + NGW;
            if (mc < T) {
#pragma unroll
                for (int j = 0; j < 4; ++j) va[j] = ((const f32x4*)(xin + (size_t)mc * D) + lane)[64 * j]; }
            rms_row_to_bf16(vb, g0, XN + (size_t)mb * D, lane);
            m = mc;
        }
    }
}

__device__ __forceinline__ void s5a_phase(Frame& F, int l) {
    const bf16_t* GT = (const bf16_t*)(F.ws + WS_GT + l * GT_STRIDE); const bf16_t* U = (const bf16_t*)(F.ws + WS_U); float* S = (float*)(F.ws + WS_S);
    const int lane = F.lane, n = lane & 15, kq = lane >> 4;
    for (int uu = F.bx * NWAVES + F.wave; uu < NG * 32 * 2; uu += F.G * NWAVES) {
        const int g = uu >> 6, ntile = (uu >> 1) & 31, mh = uu & 1;
        const int chunk = ntile * 16 + n;
        const bf16_t* up = U + ((size_t)chunk * 64 + (kq >> 1)) * DS + g * 16 + 8 * (kq & 1);
        const bf16_t* gp = GT + ((size_t)(g * 128 + mh * 64 + n) * 1024 + 8 * kq);
        f32x4 acc[4];
#pragma unroll
        for (int mt = 0; mt < 4; ++mt) acc[mt] = (f32x4){0.f, 0.f, 0.f, 0.f};
#pragma unroll 4
        for (int ks = 0; ks < 32; ++ks) {
            const bf16x8 b = *(const bf16x8*)(up + (size_t)(2 * ks) * DS);
#pragma unroll
            for (int mt = 0; mt < 4; ++mt) { const bf16x8 a = *(const bf16x8*)(gp + (size_t)(mt * 16) * 1024 + 32 * ks); acc[mt] = __builtin_amdgcn_mfma_f32_16x16x32_bf16(a, b, acc[mt], 0, 0, 0); }
        }
#pragma unroll
        for (int mt = 0; mt < 4; ++mt) *(f32x4*)(S + ((size_t)chunk * NG + g) * 128 + mh * 64 + mt * 16 + 4 * kq) = acc[mt];
    }
}
__device__ __forceinline__ void s5c_phase(Frame& F, int l) {
    const bf16_t* KT = (const bf16_t*)(F.ws + WS_KT + l * KT_STRIDE); const bf16_t* HT = (const bf16_t*)(F.ws + WS_HT + l * HT_STRIDE);
    const float* LAML = (const float*)(F.ws + WS_LAML + l * LAML_STRIDE); const float* S = (const float*)(F.ws + WS_S);
    const bf16_t* U = (const bf16_t*)(F.ws + WS_U); bf16_t* YG = (bf16_t*)(F.ws + WS_YG); const float* dsk = arg_in(10) + l * DS;
    const int lane = F.lane, n = lane & 15, kq = lane >> 4, wave = F.wave;
    LAS unsigned char* ktl = F.lds + LDS_RING;
    LAS unsigned char* xs = F.lds + LDS_RING + 33792 + wave * 4096;
    LAS f32x2* EB = (LAS f32x2*)(F.lds + LDS_RING + 33792 + 8 * 4096);
    LAS f32x2* EH = EB + 512;
    for (int wu = F.bx; wu < NG * 8; wu += F.G) {
        const int g = wu >> 3, scq = wu & 7, b = scq >> 1, cbase = (scq & 1) * 64, scl = wave >> 1, par = wave & 1;
        __syncthreads();
        for (int i = F.tid; i < 65 * 32; i += NTHREADS) *(LAS u32x4*)(ktl + i * 16) = *(const u32x4*)(KT + (size_t)g * 65 * 256 + i * 8);
        const Cplx L = Cplx{LAML[(g * NP + lane) * 2], LAML[(g * NP + lane) * 2 + 1]};
        const float* sp = S + ((size_t)(b * CPB) * NG + g) * 128 + 2 * lane;
        {
            f32x2 sv[8];
#pragma unroll
            for (int j = 0; j < 8; ++j) sv[j] = *(const f32x2*)(sp + (size_t)(cbase + 8 * wave + j) * NG * 128);
            Cplx E{0.f, 0.f};
#pragma unroll
            for (int j = 0; j < 8; ++j) { const Cplx nx = cmul(L, E); E.re = nx.re + sv[j][0]; E.im = nx.im + sv[j][1]; }
            EB[wave * 64 + lane] = (f32x2){E.re, E.im};
            if (cbase) {
#pragma unroll
                for (int j = 0; j < 8; ++j) sv[j] = *(const f32x2*)(sp + (size_t)(8 * wave + j) * NG * 128);
                Cplx H{0.f, 0.f};
#pragma unroll
                for (int j = 0; j < 8; ++j) { const Cplx nx = cmul(L, H); H.re = nx.re + sv[j][0]; H.im = nx.im + sv[j][1]; }
                EH[wave * 64 + lane] = (f32x2){H.re, H.im};
            }
        }
        __syncthreads();
        const int c0 = cbase + 16 * scl;
        {
            const Cplx L2 = cmul(L, L), L4 = cmul(L2, L2), L8 = cmul(L4, L4);
            Cplx X{0.f, 0.f};
            if (cbase) {
#pragma unroll
                for (int w = 0; w < 8; ++w) { const f32x2 e = EH[w * 64 + lane]; const Cplx nx = cmul(L8, X); X.re = nx.re + e[0]; X.im = nx.im + e[1]; }
            }
            for (int w = 0; w < 2 * scl; ++w) { const f32x2 e = EB[w * 64 + lane]; const Cplx nx = cmul(L8, X); X.re = nx.re + e[0]; X.im = nx.im + e[1]; }
            f32x2 sv[16];
#pragma unroll
            for (int j = 0; j < 16; ++j) sv[j] = *(const f32x2*)(sp + (size_t)(c0 + j) * NG * 128);
#pragma unroll
            for (int j = 0; j < 16; ++j) {
                *(LAS unsigned*)(xs + j * 256 + 4 * lane) = pk2(X.re, X.im);
                const Cplx nx = cmul(L, X); X.re = nx.re + sv[j][0]; X.im = nx.im + sv[j][1];
            }
        }
        const int chunk = b * CPB + c0 + n;
        bf16x8 ub[32];
        {
            const bf16_t* up = U + ((size_t)chunk * 64 + (kq >> 1)) * DS + g * 16 + 8 * (kq & 1);
#pragma unroll
            for (int kp = 0; kp < 32; ++kp) ub[kp] = *(const bf16x8*)(up + (size_t)(2 * kp) * DS);
        }
        const LAS unsigned char* xbp = xs + n * 256 + 16 * kq;
        const f32x4 dv = *(const f32x4*)(dsk + g * 16 + 4 * kq);
        const bf16_t* hp = HT + ((size_t)(g * 1024 + n) * 128 + 8 * kq);
        const bf16_t* uq = U + (size_t)chunk * 64 * DS + g * 16 + 4 * kq;
        const LAS unsigned char* kbase = ktl + (n * 16 + 8 * (kq & 1)) * 2;
        u32x2 uw = *(const u32x2*)(uq + (size_t)par * DS);
        for (int ti = 0; ti < 32; ++ti) {
            const int t = 2 * ti + par, tn = (ti < 31) ? t + 2 : t;
            bf16x8 ha[4];
#pragma unroll
            for (int ks = 0; ks < 4; ++ks) ha[ks] = *(const bf16x8*)(hp + (size_t)(t * 16) * 128 + 32 * ks);
            const u32x2 un = *(const u32x2*)(uq + (size_t)tn * DS);
            f32x4 acc = (f32x4){0.f, 0.f, 0.f, 0.f};
            const int slot0 = t + 1 - (kq >> 1);
#pragma unroll
            for (int kp = 0; kp < 32; ++kp) {
                if (kp <= ti) { const bf16x8 a = *(const LAS bf16x8*)(kbase + (slot0 - 2 * kp) * 512); acc = __builtin_amdgcn_mfma_f32_16x16x32_bf16(a, ub[kp], acc, 0, 0, 0); }
            }
#pragma unroll
            for (int ks = 0; ks < 4; ++ks) acc = __builtin_amdgcn_mfma_f32_16x16x32_bf16(ha[ks], *(const LAS bf16x8*)(xbp + 64 * ks), acc, 0, 0, 0);
            const float y0 = acc[0] + dv[0] * bf_lo(uw.x), y1 = acc[1] + dv[1] * bf_hi(uw.x), y2 = acc[2] + dv[2] * bf_lo(uw.y), y3 = acc[3] + dv[3] * bf_hi(uw.y);
            u32x2 w; w.x = cvt_pk_bf16(gelu_tanh(y0), gelu_tanh(y1)); w.y = cvt_pk_bf16(gelu_tanh(y2), gelu_tanh(y3));
            *(u32x2*)(YG + ((size_t)chunk * 64 + t) * DS + g * 16 + 4 * kq) = w;
            uw = un;
        }
    }
    __syncthreads();
}

namespace att {
constexpr int KSLOT = 16384, VSLOT = 16384, LDS_K = 0, LDS_V = 3 * KSLOT, LDS_WS = 6 * 16384, LDS_END = LDS_WS + 8 * 256;
constexpr int STG_ROW = 136;
__device__ __forceinline__ int crow(int r, int hi) { return (r & 3) + 8 * (r >> 2) + 4 * hi; }
__device__ __forceinline__ void glds16(const void* gsrc, unsigned lds_dst) { unsigned keep;
    asm volatile("s_mov_b32 %0, m0\n\ts_mov_b32 m0, %2\n\ts_nop 0\n\tglobal_load_lds_dwordx4 %1, off\n\ts_mov_b32 m0, %0" : "=&s"(keep) : "v"(gsrc), "s"(lds_dst) : "memory"); }
typedef __attribute__((address_space(3))) const char* lds_cptr;
typedef short v4i16_t __attribute__((ext_vector_type(4)));
__device__ __forceinline__ s16x4 vtr(lds_cptr p) { return __builtin_bit_cast(s16x4, __builtin_amdgcn_ds_read_tr16_b64_v4i16((__attribute__((address_space(3))) v4i16_t*)p)); }
#define ATT_WAIT_BAR(N) asm volatile("s_waitcnt vmcnt(" #N ") lgkmcnt(0)\n\ts_barrier" ::: "memory")

template <int MODE> __device__ __forceinline__ void attn_unit(int bh, int qb, const bf16_t* Q, const bf16_t* K, const bf16_t* V, bf16_t* MIX, const float* subg, float lam, float mshift, float oml,
                                          LAS unsigned char* shm, int tid) {
    const int lane = tid & 63, r32 = lane & 31, hi = lane >> 5; const int wid = __builtin_amdgcn_readfirstlane(tid >> 6);
    const int b = bh >> 2, h = bh & 3, m = wid & 1, qg = wid >> 1;
    const size_t rowbase = (size_t)b * SEQ; const int q0 = qb * 128;
    const int NT = 2 * qb + 2, cw = 2 * qb + (qg >> 1);
    const unsigned lds0 = (unsigned)(uintptr_t)shm;
    const unsigned char* k0src = (const unsigned char*)K + (rowbase + lane) * DA + h * 128 + (wid >> 2) * 64 + ((wid >> 1) & 1) * 32 + (wid & 1) * 16;
    const bf16_t* v0src = V + (rowbase + 16 * (wid & 3) + (lane >> 2)) * DA + h * 128 + (wid >> 2) * 32 + (lane & 3) * 8;
    const bf16_t* v1src = v0src + 64;
    const unsigned kdst = lds0 + LDS_K + (wid >> 2) * 4096 + (wid & 3) * 1024, vdst = lds0 + LDS_V + wid * 1024;
#define ATT_DMA(t, slot) do { const size_t _o = (size_t)(t) * 64 * DA; \
        glds16(k0src + _o, (unsigned)__builtin_amdgcn_readfirstlane(kdst + (slot) * KSLOT)); glds16(k1src + _o, (unsigned)__builtin_amdgcn_readfirstlane(kdst + (slot) * KSLOT + 8192)); \
        glds16(v0src + _o, (unsigned)__builtin_amdgcn_readfirstlane(vdst + (slot) * VSLOT)); glds16(v1src + _o, (unsigned)__builtin_amdgcn_readfirstlane(vdst + (slot) * VSLOT + 8192)); } while (0)
    v8i32 qf;
    { const unsigned char* Qw = (const unsigned char*)Q + (rowbase + q0 + qg * 32 + r32) * DA + h * 128 + m * 64 + hi * 32;
      const u32x4 ql = *(const u32x4*)(Qw), qh = *(const u32x4*)(Qw + 16); qf = __builtin_bit_cast(v8i32, __builtin_shufflevector(ql, qh, 0, 1, 2, 3, 4, 5, 6, 7)); }
#ifndef ATT_GRP
#define ATT_GRP (wid & 1)
#endif
    const int grp = ATT_GRP;
#define ATT_DMA_K(t, slot) do { if (MODE & 1) break; const size_t _o = (size_t)(t) * 64 * DA; \
        glds16(k0src + _o, (unsigned)__builtin_amdgcn_readfirstlane(kdst + (slot) * KSLOT)); } while (0)
#define ATT_DMA_V(t, slot) do { if (MODE & 1) break; const size_t _o = (size_t)(t) * 64 * DA; \
        glds16(v0src + _o, (unsigned)__builtin_amdgcn_readfirstlane(vdst + (slot) * VSLOT)); glds16(v1src + _o, (unsigned)__builtin_amdgcn_readfirstlane(vdst + (slot) * VSLOT + 8192)); } while (0)
    ATT_DMA_K(0, 0); ATT_DMA_V(0, 0); ATT_DMA_K(1, 1); ATT_DMA_V(1, 1);
    f32x16 o[4];
#pragma unroll
    for (int d = 0; d < 4; ++d)
#pragma unroll
        for (int r = 0; r < 16; ++r) o[d][r] = 0.f;
    float l_reg = 0.f;
    const f32x16 zero16 = {0.f, 0.f, 0.f, 0.f, 0.f, 0.f, 0.f, 0.f, 0.f, 0.f, 0.f, 0.f, 0.f, 0.f, 0.f, 0.f};
    (void)mshift;
    const lds_cptr shm3 = (lds_cptr)shm;
    const lds_cptr kp0 = shm3 + LDS_K + m * 4096 + hi * 2048 + r32 * 16;
    const lds_cptr vp0 = shm3 + LDS_V + ((lane >> 4) & 1) * 32 + (lane & 3) * 8 + (4 * hi + ((lane & 15) >> 2)) * 64;
    u32x4 pw[4];
#pragma unroll
    for (int q = 0; q < 4; ++q) pw[q] = (u32x4){0u, 0u, 0u, 0u};
#define ATT_SB() __builtin_amdgcn_sched_barrier(0)
#define ATT_QKEXP(sl) do { if (MODE & 2) break; const lds_cptr kp = kp0 + (sl) * KSLOT; \
        ATT_SB(); \
        const u32x4 k0l = *(const __attribute__((address_space(3))) u32x4*)(kp), k0h = *(const __attribute__((address_space(3))) u32x4*)(kp + 1024); \
        const u32x4 k1l = *(const __attribute__((address_space(3))) u32x4*)(kp + 512), k1h = *(const __attribute__((address_space(3))) u32x4*)(kp + 1024 + 512); \
        ATT_SB(); \
        const v8i32 kf0 = __builtin_bit_cast(v8i32, __builtin_shufflevector(k0l, k0h, 0, 1, 2, 3, 4, 5, 6, 7)), kf1 = __builtin_bit_cast(v8i32, __builtin_shufflevector(k1l, k1h, 0, 1, 2, 3, 4, 5, 6, 7)); \
        f32x16 p0 = __builtin_amdgcn_mfma_scale_f32_32x32x64_f8f6f4(kf0, qf, zero16, 0, 0, 0, 0x7a7b, 1, 0x7a7b); \
        f32x16 p1 = __builtin_amdgcn_mfma_scale_f32_32x32x64_f8f6f4(kf1, qf, zero16, 0, 0, 0, 0x7a7b, 1, 0x7a7b); \
        ATT_SB(); \
        float sacc = 0.f; \
        _Pragma("unroll") for (int r = 0; r < 16; ++r) { p0[r] = __builtin_amdgcn_exp2f(p0[r]); p1[r] = __builtin_amdgcn_exp2f(p1[r]); sacc += p0[r] + p1[r]; } \
        l_reg += sacc; \
        _Pragma("unroll") for (int q = 0; q < 4; ++q) { pw[0][q] = cvt_pk_bf16(p0[2 * q], p0[2 * q + 1]); pw[1][q] = cvt_pk_bf16(p0[8 + 2 * q], p0[8 + 2 * q + 1]); \
                                                        pw[2][q] = cvt_pk_bf16(p1[2 * q], p1[2 * q + 1]); pw[3][q] = cvt_pk_bf16(p1[8 + 2 * q], p1[8 + 2 * q + 1]); } } while (0)
#define ATT_VRD(buf, d) do { _Pragma("unroll") for (int ks = 0; ks < 4; ++ks) { buf[0][ks] = vtr(vp + (d) * 4096 + ks * 1024); buf[1][ks] = vtr(vp + (d) * 4096 + ks * 1024 + 512); } } while (0)
#define ATT_VMM(buf, d) do { _Pragma("unroll") for (int ks = 0; ks < 4; ++ks) { \
        const bf16x8 vf = (bf16x8){buf[0][ks][0], buf[0][ks][1], buf[0][ks][2], buf[0][ks][3], buf[1][ks][0], buf[1][ks][1], buf[1][ks][2], buf[1][ks][3]}; \
        o[d] = __builtin_amdgcn_mfma_f32_32x32x16_bf16(__builtin_bit_cast(bf16x8, pw[ks]), vf, o[d], 0, 0, 0); } } while (0)
#define ATT_PV(sl) do { if (MODE & 4) break; const lds_cptr vp = vp0 + (sl) * VSLOT; s16x4 va[2][4], vb[2][4]; \
        ATT_SB(); ATT_VRD(va, 0); ATT_SB(); ATT_VRD(vb, 1); ATT_SB(); ATT_VMM(va, 0); ATT_SB(); ATT_VRD(va, 2); ATT_SB(); ATT_VMM(vb, 1); ATT_SB(); \
        ATT_VRD(vb, 3); ATT_SB(); ATT_VMM(va, 2); ATT_SB(); ATT_VMM(vb, 3); ATT_SB(); } while (0)
#ifndef ATT_TWO_GROUP
#define ATT_TWO_GROUP 0
#endif
    int sk = 0, skm1 = 2;
    if (ATT_TWO_GROUP) {
        for (int k = 0; k <= NT; ++k) {
            if (k + 1 < NT) { ATT_WAIT_BAR(3); } else { ATT_WAIT_BAR(0); }
            if (k + 2 < NT) ATT_DMA_K(k + 2, skm1);
            if (grp == 0) { if (k <= cw) ATT_QKEXP(sk); }
            else          { if (k >= 1 && k - 1 <= cw) ATT_PV(skm1); }
            if (k == NT) break;
            if (k + 2 < NT) { ATT_WAIT_BAR(3); } else { ATT_WAIT_BAR(0); }
            if (k + 2 < NT) ATT_DMA_V(k + 2, skm1);
            if (grp == 0) { if (k <= cw) ATT_PV(sk); }
            else          { if (k <= cw) ATT_QKEXP(sk); }
            skm1 = sk; sk = (sk == 2) ? 0 : sk + 1;
        }
    } else {
        for (int k = 0; k < NT; ++k) {
            if (k + 1 < NT) { ATT_WAIT_BAR(3); } else { ATT_WAIT_BAR(0); }
            if (k + 2 < NT) { ATT_DMA_K(k + 2, skm1); ATT_DMA_V(k + 2, skm1); }
            if (k <= cw) { ATT_QKEXP(sk); ATT_PV(sk); }
            skm1 = sk; sk = (sk == 2) ? 0 : sk + 1;
        }
    }
#undef ATT_QKEXP
#undef ATT_PV
#undef ATT_VRD
#undef ATT_VMM
#undef ATT_SB
#undef ATT_DMA_K
#undef ATT_DMA_V
    { auto rr = __builtin_amdgcn_permlane32_swap(__float_as_uint(l_reg), __float_as_uint(l_reg), false, false); l_reg = __uint_as_float(rr[0]) + __uint_as_float(rr[1]); }
    LAS float* wsf = (LAS float*)(shm + LDS_WS) + wid * 64;
    if (hi == 0) wsf[r32] = l_reg;
    ATT_WAIT_BAR(0);
    float rli[16];
    const float scl = m ? lam : 1.0f;
#pragma unroll
    for (int r = 0; r < 16; ++r) rli[r] = scl * __builtin_amdgcn_rcpf(wsf[crow(r, hi)]);
    LAS float* stg = (LAS float*)shm + qg * (32 * STG_ROW);
    if (m == 1) {
#pragma unroll
        for (int r = 0; r < 16; ++r)
#pragma unroll
            for (int d = 0; d < 4; ++d) stg[crow(r, hi) * STG_ROW + d * 32 + r32] = o[d][r] * rli[r];
    }
    ATT_WAIT_BAR(0);
    if (m == 0) {
#pragma unroll
        for (int r = 0; r < 16; ++r)
#pragma unroll
            for (int d = 0; d < 4; ++d) { LAS float* p = stg + crow(r, hi) * STG_ROW + d * 32 + r32; *p = o[d][r] * rli[r] - *p; }
    }
    ATT_WAIT_BAR(0);
    {
        const int row = 16 * m + (lane >> 2), qt = lane & 3;
        const LAS float* p = stg + row * STG_ROW + qt * 32;
        f32x4 v[8]; float ss = 0.f;
#pragma unroll
        for (int i = 0; i < 8; ++i) { v[i] = *(const LAS f32x4*)(p + 4 * i); ss += (v[i][0] * v[i][0] + v[i][1] * v[i][1]) + (v[i][2] * v[i][2] + v[i][3] * v[i][3]); }
        ss += __shfl_xor(ss, 1); ss += __shfl_xor(ss, 2);
        const float rn = rsqrtf(ss * (1.f / 128.f) + EPS) * oml;
        bf16_t* dst = MIX + (rowbase + q0 + qg * 32 + row) * D + DS + h * 128 + qt * 32;
#pragma unroll
        for (int i = 0; i < 4; ++i) {
            const f32x4 g0 = *(const f32x4*)(subg + qt * 32 + 8 * i), g1 = *(const f32x4*)(subg + qt * 32 + 8 * i + 4);
            const f32x4 a = v[2 * i] * g0 * rn, c = v[2 * i + 1] * g1 * rn;
            u32x4 w; w.x = cvt_pk_bf16(a[0], a[1]); w.y = cvt_pk_bf16(a[2], a[3]); w.z = cvt_pk_bf16(c[0], c[1]); w.w = cvt_pk_bf16(c[2], c[3]);
            *(u32x4*)(dst + 8 * i) = w;
        }
    }
    ATT_WAIT_BAR(0);
#undef ATT_DMA
}
}
template <int MODE> __device__ __forceinline__ void attn_phase(Frame& F, int l) {
    const bf16_t* Q = (const bf16_t*)(F.ws + WS_Q); const bf16_t* K = (const bf16_t*)(F.ws + WS_K); const bf16_t* V = (const bf16_t*)(F.ws + WS_V);
    bf16_t* MIX = (bf16_t*)(F.ws + WS_MIX);
    const float* sc = (const float*)(F.ws + WS_SCAL) + l * 4;
    const float lam = sc[0], mshift = sc[1], oml = sc[2];
    const float* subg = arg_in(19) + l * DV;
    const int G = F.G;
#ifndef ATT_XA
#define ATT_XA 1
#endif
    const bool xa = ATT_XA && (G & 7) == 0;
    const int x = F.bx & 7, j = F.bx >> 3, wpx = xa ? (G >> 3) : 1;
    const int npair = xa ? (32 - j + wpx - 1) / wpx : 0;
    const int nit = xa ? 4 * npair : (1024 - F.bx + G - 1) / G;
#pragma unroll 1
    for (int it = 0; it < nit; ++it) {
        int bh, qb;
        if (xa) { const int r = it / (2 * npair), rem = it % (2 * npair), sidx = j + (rem >> 1) * wpx; bh = 2 * x + r; qb = (rem & 1) ? sidx : 63 - sidx; }
        else { const int v = F.bx + it * G; bh = v >> 6; qb = v & 63; }
        att::attn_unit<MODE>(bh, qb, Q, K, V, MIX, subg, lam, mshift, oml, F.lds + LDS_RING, F.tid);
    }
}

__device__ __forceinline__ void router_phase(Frame& F, int l) {
    const bf16_t* h1 = (const bf16_t*)(F.ws + WS_H1); const float* g = arg_in(21) + (size_t)l * D; const float* br = arg_in(23) + l * NE;
    const bf16_t* WRT = (const bf16_t*)(F.ws + WS_WRT + l * WRT_STRIDE);
    bf16_t* XN = (bf16_t*)(F.ws + WS_XN); int* TOPI = (int*)(F.ws + WS_TOPI); float* TOPG = (float*)(F.ws + WS_TOPG); int* WGCNT = (int*)(F.ws + WS_WGCNT); float* RS = (float*)(F.ws + WS_RS);
    const int lane = F.lane, tid = F.tid, wave = F.wave, n = lane & 15, kq = lane >> 4;
    constexpr int PITCH = 2080;
    LAS unsigned char* wl = F.lds + LDS_RING;
    LAS float* lg = (LAS float*)(F.lds + LDS_RING + 2 * 32 * PITCH) + wave * (16 * 33 + 16);
    LAS int* cnt = (LAS int*)(F.ctl + 256);
    __syncthreads();
    for (int i = tid; i < 2 * NE * 128; i += NTHREADS) { const int row = i >> 7, c = i & 127; *(LAS u32x4*)(wl + row * PITCH + c * 16) = *(const u32x4*)(WRT + (size_t)row * D + c * 8); }
    if (tid < 32) cnt[tid] = 0;
    __syncthreads();
    for (int wgu = F.bx; wgu < T / 128; wgu += F.G) {
        if (wgu != F.bx) { __syncthreads(); if (tid < 32) cnt[tid] = 0; __syncthreads(); }
        const int row = wgu * 128 + wave * 16 + n;
        const bf16_t* hp = h1 + (size_t)row * D + 8 * kq; const float* gp = g + 8 * kq;
        bf16_t* xp = XN + (size_t)row * D + 8 * kq; unsigned char* xp8 = (unsigned char*)XN + (size_t)row * D + 8 * kq;
        const LAS unsigned char* bh = wl + n * PITCH + 16 * kq;
        f32x4 acc0 = (f32x4){0.f, 0.f, 0.f, 0.f}, acc1 = acc0; float ss = 0.f;
#pragma unroll 4
        for (int ks = 0; ks < 32; ++ks) {
            const u32x4 hw = *(const u32x4*)(hp + 32 * ks); const f32x4 h0 = (f32x4){bf_lo(hw.x), bf_hi(hw.x), bf_lo(hw.y), bf_hi(hw.y)}, h4 = (f32x4){bf_lo(hw.z), bf_hi(hw.z), bf_lo(hw.w), bf_hi(hw.w)};
            const f32x4 g0 = *(const f32x4*)(gp + 32 * ks), g4 = *(const f32x4*)(gp + 32 * ks + 4);
            const f32x4 x0 = h0 * g0, x4 = h4 * g4;
            ss += (x0[0] * x0[0] + x0[1] * x0[1]) + (x0[2] * x0[2] + x0[3] * x0[3]) + (x4[0] * x4[0] + x4[1] * x4[1]) + (x4[2] * x4[2] + x4[3] * x4[3]);
            u32x4 hi; hi.x = cvt_pk_bf16(x0[0], x0[1]); hi.y = cvt_pk_bf16(x0[2], x0[3]); hi.z = cvt_pk_bf16(x4[0], x4[1]); hi.w = cvt_pk_bf16(x4[2], x4[3]);
            if (UP_FP8) { u32x2 w8; w8.x = pk4_fp8(x0[0] * 8.f, x0[1] * 8.f, x0[2] * 8.f, x0[3] * 8.f); w8.y = pk4_fp8(x4[0] * 8.f, x4[1] * 8.f, x4[2] * 8.f, x4[3] * 8.f); *(u32x2*)(xp8 + 32 * ks) = w8; }
            else *(u32x4*)(xp + 32 * ks) = hi;
            u32x4 lo;
            lo.x = cvt_pk_bf16(x0[0] - bf_lo(hi.x), x0[1] - bf_hi(hi.x)); lo.y = cvt_pk_bf16(x0[2] - bf_lo(hi.y), x0[3] - bf_hi(hi.y));
            lo.z = cvt_pk_bf16(x4[0] - bf_lo(hi.z), x4[1] - bf_hi(hi.z)); lo.w = cvt_pk_bf16(x4[2] - bf_lo(hi.w), x4[3] - bf_hi(hi.w));
            const bf16x8 ah = __builtin_bit_cast(bf16x8, hi), al = __builtin_bit_cast(bf16x8, lo);
            const bf16x8 b0h = *(const LAS bf16x8*)(bh + 64 * ks), b1h = *(const LAS bf16x8*)(bh + 16 * PITCH + 64 * ks);
            const bf16x8 b0l = *(const LAS bf16x8*)(bh + 32 * PITCH + 64 * ks), b1l = *(const LAS bf16x8*)(bh + 48 * PITCH + 64 * ks);
            acc0 = __builtin_amdgcn_mfma_f32_16x16x32_bf16(ah, b0h, acc0, 0, 0, 0); acc1 = __builtin_amdgcn_mfma_f32_16x16x32_bf16(ah, b1h, acc1, 0, 0, 0);
            acc0 = __builtin_amdgcn_mfma_f32_16x16x32_bf16(al, b0h, acc0, 0, 0, 0); acc1 = __builtin_amdgcn_mfma_f32_16x16x32_bf16(al, b1h, acc1, 0, 0, 0);
            acc0 = __builtin_amdgcn_mfma_f32_16x16x32_bf16(ah, b0l, acc0, 0, 0, 0); acc1 = __builtin_amdgcn_mfma_f32_16x16x32_bf16(ah, b1l, acc1, 0, 0, 0);
        }
        ss += __shfl_xor(ss, 16); ss += __shfl_xor(ss, 32);
        const float r = rsqrtf(ss * (1.f / D) + EPS);
        if (kq == 0) { lg[16 * 33 + n] = r; RS[row] = r; }
        asm volatile("s_waitcnt lgkmcnt(0)" ::: "memory");
        const float b0 = br[n], b1 = br[16 + n];
#pragma unroll
        for (int q = 0; q < 4; ++q) { const float rt = lg[16 * 33 + 4 * kq + q]; lg[(4 * kq + q) * 33 + n] = acc0[q] * rt + b0; lg[(4 * kq + q) * 33 + 16 + n] = acc1[q] * rt + b1; }
        asm volatile("s_waitcnt lgkmcnt(0)" ::: "memory");
        if (lane < 16) {
            const int tok = wgu * 128 + wave * 16 + lane;
            float v[32];
#pragma unroll
            for (int e = 0; e < 32; ++e) v[e] = lg[lane * 33 + e];
            unsigned mask = 0u; float val[4]; int sel[4];
#pragma unroll
            for (int k = 0; k < 4; ++k) { float best = -INFINITY; int bi = 0;
#pragma unroll
                for (int e = 0; e < 32; ++e) { const bool ok = !((mask >> e) & 1u) && (v[e] > best); best = ok ? v[e] : best; bi = ok ? e : bi; }
                mask |= 1u << bi; val[k] = best; sel[k] = bi; }
            float ex[4], sum = 0.f;
#pragma unroll
            for (int k = 0; k < 4; ++k) { ex[k] = __expf(val[k] - val[0]); sum += ex[k]; }
            const float inv = 1.f / sum;
#pragma unroll
            for (int k = 0; k < 4; ++k) { const int pos = __hip_atomic_fetch_add(cnt + sel[k], 1, __ATOMIC_RELAXED, __HIP_MEMORY_SCOPE_WORKGROUP);
                TOPI[tok * 4 + k] = sel[k] | (pos << 8); TOPG[tok * 4 + k] = ex[k] * inv; }
        }
        __syncthreads();
        if (tid < 32) WGCNT[wgu * 32 + tid] = cnt[tid];
    }
    __syncthreads();
}
__device__ __forceinline__ void routing_phase(Frame& F) {
    const int* TOPI = (const int*)(F.ws + WS_TOPI); const float* TOPG = (const float*)(F.ws + WS_TOPG); const int* WGCNT = (const int*)(F.ws + WS_WGCNT);
    int* TOKROW = (int*)(F.ws + WS_TOKROW); int* ROWTOK = (int*)(F.ws + WS_ROWTOK); float* ROWGATE = (float*)(F.ws + WS_ROWGATE); int* TILEEXP = (int*)(F.ws + WS_TILEEXP);
    float* ROWSCALE = (float*)(F.ws + WS_ROWSCALE); const float* RS = (const float*)(F.ws + WS_RS);
    const int tid = F.tid;
    LAS int* tot = (LAS int*)(F.lds + LDS_RING);
    LAS int* pst = tot + 32;
    LAS int* mypre = pst + 40;
    LAS int* part = mypre + 32;
    for (int wgu = F.bx; wgu < 256; wgu += F.G) {
        __syncthreads();
        {
            const int e = tid & 31, wq = tid >> 5; int a = 0, mine = 0;
#pragma unroll
            for (int j = 0; j < 16; ++j) { const int w = wq * 16 + j; const int c = WGCNT[w * 32 + e]; a += c; if (w < wgu) mine += c; }
            part[wq * 32 + e] = a; part[512 + wq * 32 + e] = mine;
        }
        __syncthreads();
        if (tid < 32) { int a = 0, mine = 0;
#pragma unroll
            for (int q = 0; q < 16; ++q) { a += part[q * 32 + tid]; mine += part[512 + q * 32 + tid]; }
            tot[tid] = a; mypre[tid] = mine; }
        __syncthreads();
        if (tid == 0) { int a = 0; for (int e = 0; e < 32; ++e) { pst[e] = a; a += (tot[e] + 255) & ~255; } pst[32] = a; }
        __syncthreads();
        {
            const int t = wgu * 128 + (tid >> 2), k = tid & 3;
            const int w = TOPI[t * 4 + k]; const int e = w & 255, pos = w >> 8;
            const int dest = pst[e] + mypre[e] + pos;
            ROWTOK[dest] = t; ROWGATE[dest] = TOPG[t * 4 + k]; ROWSCALE[dest] = RS[t]; TOKROW[t * 4 + k] = dest;
        }
        if (wgu < 32) {
            const int e = wgu; const int beg = pst[e] + tot[e], end = pst[e + 1];
            for (int r = beg + tid; r < end; r += NTHREADS) { ROWTOK[r] = 0; ROWGATE[r] = 0.f; ROWSCALE[r] = 0.f; }
        }
        if (wgu == 0) {
            const int ntiles = pst[32] >> 8;
            for (int pm = tid; pm < ntiles; pm += NTHREADS) { int e = 0; for (int q = 1; q < 32; ++q) if ((pm << 8) >= pst[q]) e = q; TILEEXP[pm] = e; }
            if (tid == 0) TILEEXP[1023] = ntiles;
            if (tid < 33) TILEEXP[768 + tid] = pst[tid];
        }
    }
    __syncthreads();
}
struct CRow { u32x4 h[2]; u32x2 y[4][2]; };
__device__ __forceinline__ void crow_load(CRow& r, const bf16_t* H1, const unsigned char* YB, const int* TOKROW, int m, int lane) {
    const bf16_t* hr = H1 + (size_t)m * D + 8 * lane;
    r.h[0] = *(const u32x4*)(hr); r.h[1] = *(const u32x4*)(hr + 512);
    const int4 tr = *(const int4*)(TOKROW + m * 4);
    const int rows[4] = {tr.x, tr.y, tr.z, tr.w};
#pragma unroll
    for (int k = 0; k < 4; ++k) { const unsigned char* yr = YB + (size_t)rows[k] * D + 8 * lane; r.y[k][0] = *(const u32x2*)(yr); r.y[k][1] = *(const u32x2*)(yr + 512); }
}
__device__ __forceinline__ void crow_finish(CRow& r, float* out32, bf16_t* H2, bf16_t* XN, const float* gnext, int m, int lane) {
    f32x4 v[4];
#pragma unroll
    for (int hf = 0; hf < 2; ++hf) { const u32x4 w = r.h[hf]; v[2 * hf] = (f32x4){bf_lo(w.x), bf_hi(w.x), bf_lo(w.y), bf_hi(w.y)}; v[2 * hf + 1] = (f32x4){bf_lo(w.z), bf_hi(w.z), bf_lo(w.w), bf_hi(w.w)}; }
#pragma unroll
    for (int k = 0; k < 4; ++k)
#pragma unroll
        for (int hf = 0; hf < 2; ++hf) { fp8x4_add(r.y[k][hf].x, 1.f / 16.f, v[2 * hf]); fp8x4_add(r.y[k][hf].y, 1.f / 16.f, v[2 * hf + 1]); }
    if (out32) { float* orow = out32 + (size_t)m * D + 8 * lane; *(f32x4*)(orow) = v[0]; *(f32x4*)(orow + 4) = v[1]; *(f32x4*)(orow + 512) = v[2]; *(f32x4*)(orow + 516) = v[3]; }
    else {
        u32x4 w; w.x = cvt_pk_bf16(v[0][0], v[0][1]); w.y = cvt_pk_bf16(v[0][2], v[0][3]); w.z = cvt_pk_bf16(v[1][0], v[1][1]); w.w = cvt_pk_bf16(v[1][2], v[1][3]);
        *(u32x4*)(H2 + (size_t)m * D + 8 * lane) = w;
        w.x = cvt_pk_bf16(v[2][0], v[2][1]); w.y = cvt_pk_bf16(v[2][2], v[2][3]); w.z = cvt_pk_bf16(v[3][0], v[3][1]); w.w = cvt_pk_bf16(v[3][2], v[3][3]);
        *(u32x4*)(H2 + (size_t)m * D + 512 + 8 * lane) = w;
    }
    if (gnext) {
        float s = 0.f;
#pragma unroll
        for (int j = 0; j < 4; ++j) s += (v[j][0] * v[j][0] + v[j][1] * v[j][1]) + (v[j][2] * v[j][2] + v[j][3] * v[j][3]);
        const float rr = rsqrtf(wave_sum(s) * (1.f / D) + EPS);
        const float* gp = gnext + 8 * lane;
        const f32x4 a0 = v[0] * *(const f32x4*)(gp) * rr, a1 = v[1] * *(const f32x4*)(gp + 4) * rr, a2 = v[2] * *(const f32x4*)(gp + 512) * rr, a3 = v[3] * *(const f32x4*)(gp + 516) * rr;
        u32x4 w; w.x = cvt_pk_bf16(a0[0], a0[1]); w.y = cvt_pk_bf16(a0[2], a0[3]); w.z = cvt_pk_bf16(a1[0], a1[1]); w.w = cvt_pk_bf16(a1[2], a1[3]);
        *(u32x4*)(XN + (size_t)m * D + 8 * lane) = w;
        w.x = cvt_pk_bf16(a2[0], a2[1]); w.y = cvt_pk_bf16(a2[2], a2[3]); w.z = cvt_pk_bf16(a3[0], a3[1]); w.w = cvt_pk_bf16(a3[2], a3[3]);
        *(u32x4*)(XN + (size_t)m * D + 512 + 8 * lane) = w;
    }
}
__device__ __forceinline__ void combine_phase(Frame& F, const float* gnext, float* out32) {
    const unsigned char* YB = (const unsigned char*)(F.ws + WS_YB); const int* TOKROW = (const int*)(F.ws + WS_TOKROW); bf16_t* XN = (bf16_t*)(F.ws + WS_XN);
    const bf16_t* H1 = (const bf16_t*)(F.ws + WS_H1); bf16_t* H2 = (bf16_t*)(F.ws + WS_H2);
    const int lane = F.lane, NGW = F.G * NWAVES;
    CRow ra, rb;
    int m = F.bx * NWAVES + F.wave;
    if (m < T) crow_load(ra, H1, YB, TOKROW, m, lane);
    while (m < T) {
        const int mb = m + NGW;
        if (mb < T) crow_load(rb, H1, YB, TOKROW, mb, lane);
        crow_finish(ra, out32, H2, XN, gnext, m, lane);
        if (mb >= T) break;
        const int mc = mb + NGW;
        if (mc < T) crow_load(ra, H1, YB, TOKROW, mc, lane);
        crow_finish(rb, out32, H2, XN, gnext, mb, lane);
        m = mc;
    }
}

constexpr int NPH_LAYER = 10, NPH = 1 + DEPTH * NPH_LAYER;
__global__ void __launch_bounds__(NTHREADS, 2) mk_fwd(Args args) {
    extern __shared__ __attribute__((aligned(16))) unsigned char lds_raw[];
    Frame F;
    F.lds = (LAS unsigned char*)lds_raw; F.ctl = F.lds + LDS_CTL; F.ws = args.ws; F.ws0 = args.ws; F.out0 = args.out; F.ap = &args; F.z = 0;
    F.tid = threadIdx.x; F.lane = F.tid & 63; F.wave = __builtin_amdgcn_readfirstlane(F.tid >> 6); F.G = gridDim.x; F.bx = blockIdx.x;
    F.out = args.out;
    for (int u = F.tid; u < 1024; u += NTHREADS) ((LAS unsigned*)F.ctl)[u] = 0u;
    __syncthreads();
    XcdBarrier bar = xcd_barrier_post((unsigned*)(F.ws + WS_CTL) + CW_BAR, (volatile LAS unsigned*)F.ctl);
    const int lo = args.ph_lo, hi = args.ph_hi;
#ifndef PHMASK
#define PHMASK 0x1fff
#endif
#define RUN(k) (lo <= (k) && (k) < hi)
#define EN(b) ((PHMASK >> (b)) & 1)
#ifndef DUPMASK
#define DUPMASK 0
#endif
#ifndef ATT_PROBE_MODE
#define ATT_PROBE_MODE 0
#endif
#ifndef PRO_PROBE_MODE
#define PRO_PROBE_MODE 0
#endif
#define NREP(b) (((DUPMASK >> (b)) & 1) ? 2 : 1)
#define SEAM(k) do { if (RUN((k) + 1)) xcd_barrier(bar); } while (0)
    if (EN(10) && RUN(0)) { { if (NREP(10) == 2) { phase_begin(F); p0_prologue<PRO_PROBE_MODE>(F); xcd_barrier(bar); } phase_begin(F); p0_prologue<0>(F); } SEAM(0); }
    for (int l = 0; l < DEPTH; ++l) {
        const int pb = 1 + l * NPH_LAYER;
#ifdef EXTRA_BARRIERS
        for (int eb = 0; eb < EXTRA_BARRIERS; ++eb) xcd_barrier(bar);
#endif
        if (EN(0) && RUN(pb + 0)) { for (int rep = 0; rep < NREP(0); ++rep) { phase_begin(F); unsigned char* ws = F.ws; (void)ws;
            PInProj P; P.so.init(T, DIN, F.G, F.bx); P.A = (const char*)(ws + WS_XN); P.B = (const char*)(ws + WS_WIN + l * WIN_STRIDE);
            P.UQKV = (bf16_t*)(ws + WS_U); P.GQK = (const float*)(ws + WS_SCAL) + 64 + l * 128; P.COS = (const float*)(ws + WS_COS); P.SIN = (const float*)(ws + WS_SIN);
            pg8::gemm_phase(F.lds + LDS_RING, F.ctl, P, F.tid);  if (rep + 1 < NREP(0)) xcd_barrier(bar); } SEAM(pb + 0);
        }
        if (EN(1) && RUN(pb + 1)) { for (int rep = 0; rep < NREP(1); ++rep) { phase_begin(F); unsigned char* ws = F.ws; (void)ws; s5a_phase(F, l);  if (rep + 1 < NREP(1)) xcd_barrier(bar); } SEAM(pb + 1); }
        if (EN(2) && RUN(pb + 2)) { for (int rep = 0; rep < NREP(2); ++rep) { phase_begin(F); unsigned char* ws = F.ws; (void)ws; if (EN(11)) for (int r2 = 0; r2 < NREP(11); ++r2) { phase_begin(F); s5c_phase(F, l); } if (EN(12)) { if (NREP(12) == 2) { phase_begin(F); attn_phase<ATT_PROBE_MODE>(F, l); } phase_begin(F); attn_phase<0>(F, l); }  if (rep + 1 < NREP(2)) xcd_barrier(bar); } SEAM(pb + 2); }
        if (EN(3) && RUN(pb + 3)) { for (int rep = 0; rep < NREP(3); ++rep) { phase_begin(F); unsigned char* ws = F.ws; (void)ws;
            PGlu P; P.so.init(T, DS, F.G, F.bx); P.A = (const char*)(ws + WS_YG); P.B = (const char*)(ws + WS_WGLU + l * WGLU_STRIDE);
            P.YG = (const bf16_t*)(ws + WS_YG); P.MIX = (bf16_t*)(ws + WS_MIX); P.RSP = (float*)(ws + WS_RSP);
            pg8::gemm_phase(F.lds + LDS_RING, F.ctl, P, F.tid);  if (rep + 1 < NREP(3)) xcd_barrier(bar); } SEAM(pb + 3);
        }
        if (EN(4) && RUN(pb + 4)) { for (int rep = 0; rep < NREP(4); ++rep) { phase_begin(F); unsigned char* ws = F.ws; (void)ws;
            POut P; P.so.init(T, D, F.G, F.bx); P.A = (const char*)(ws + WS_MIX); P.B = (const char*)(ws + WS_WOUT + l * WOUT_STRIDE);
            P.RSP = (const float*)(ws + WS_RSP); P.base32 = (l == 0) ? arg_in(0) : nullptr; P.base16 = (const bf16_t*)(ws + WS_H2); P.H1 = (bf16_t*)(ws + WS_H1);
            pg8::gemm_phase(F.lds + LDS_RING, F.ctl, P, F.tid);  if (rep + 1 < NREP(4)) xcd_barrier(bar); } SEAM(pb + 4);
        }
        if (EN(5) && RUN(pb + 5)) { for (int rep = 0; rep < NREP(5); ++rep) { phase_begin(F); unsigned char* ws = F.ws; (void)ws; router_phase(F, l);  if (rep + 1 < NREP(5)) xcd_barrier(bar); } SEAM(pb + 5); }
        if (EN(6) && RUN(pb + 6)) { for (int rep = 0; rep < NREP(6); ++rep) { phase_begin(F); unsigned char* ws = F.ws; (void)ws; routing_phase(F);  if (rep + 1 < NREP(6)) xcd_barrier(bar); } SEAM(pb + 6); }
        if (EN(7) && RUN(pb + 7)) { for (int rep = 0; rep < NREP(7); ++rep) { phase_begin(F); unsigned char* ws = F.ws; (void)ws;
            PUp P; P.mo.init(F.G, F.bx, (const int*)(ws + WS_TILEEXP) + 768);
            P.A = (const char*)(ws + WS_XN); P.B = (const char*)(ws + WS_WUP + l * WUP_STRIDE); P.ROWTOK = (const int*)(ws + WS_ROWTOK); P.TILEEXP = (const int*)(ws + WS_TILEEXP);
            P.bup = arg_in(25) + (size_t)l * NE * 2048; P.ROWSCALE = (const float*)(ws + WS_ROWSCALE); P.ACT = (bf16_t*)(ws + WS_ACT);
            if (GEMM_PROBE && rep + 1 < NREP(7)) { PUpNoDma Q; (PUp&)Q = P; pg8::gemm_phase(F.lds + LDS_RING, F.ctl, Q, F.tid); } else pg8::gemm_phase(F.lds + LDS_RING, F.ctl, P, F.tid);  if (rep + 1 < NREP(7)) xcd_barrier(bar); } SEAM(pb + 7);
        }
        if (EN(8) && RUN(pb + 8)) { for (int rep = 0; rep < NREP(8); ++rep) { phase_begin(F); unsigned char* ws = F.ws; (void)ws;
            PDown P; P.mo.init(F.G, F.bx, (const int*)(ws + WS_TILEEXP) + 768);
            P.A = (const char*)(ws + WS_ACT); P.B = (const char*)(ws + WS_WDN + l * WDN_STRIDE); P.TILEEXP = (const int*)(ws + WS_TILEEXP);
            P.bdn = arg_in(27) + (size_t)l * NE * 1024; P.ROWGATE = (const float*)(ws + WS_ROWGATE); P.YB = (bf16_t*)(ws + WS_YB);
            pg8::gemm_phase(F.lds + LDS_RING, F.ctl, P, F.tid);  if (rep + 1 < NREP(8)) xcd_barrier(bar); } SEAM(pb + 8);
        }
        if (EN(9) && RUN(pb + 9)) { for (int rep = 0; rep < NREP(9); ++rep) { phase_begin(F); unsigned char* ws = F.ws; (void)ws; combine_phase(F, (l + 1 < DEPTH) ? arg_in(1) + (size_t)(l + 1) * D : nullptr, (l + 1 < DEPTH) ? nullptr : F.out);  if (rep + 1 < NREP(9)) xcd_barrier(bar); } SEAM(pb + 9); }
    }
#undef RUN
#undef SEAM
}

extern "C" void kernel_launch(void* const* d_in, const int* in_sizes, int n_in, void* d_out, int out_size, void* d_ws, size_t ws_size, hipStream_t stream) {
    static int grid = 0;
    if (grid == 0) {
        if (n_in != 28 || out_size != T * D || ws_size < WS_END) { fprintf(stderr, "kernel_launch: unexpected shapes (n_in %d out %d ws %zu)\n", n_in, out_size, ws_size); grid = -1; return; }
        int dev = 0, cus = 0;
        if (hipGetDevice(&dev) != hipSuccess || hipDeviceGetAttribute(&cus, hipDeviceAttributeMultiprocessorCount, dev) != hipSuccess) { grid = -1; return; }
        if (hipFuncSetAttribute((const void*)mk_fwd, hipFuncAttributeMaxDynamicSharedMemorySize, LDS_BYTES) != hipSuccess) { fprintf(stderr, "kernel_launch: hipFuncSetAttribute failed\n"); grid = -1; return; }
        int per_cu = 0;
        if (hipOccupancyMaxActiveBlocksPerMultiprocessor(&per_cu, (const void*)mk_fwd, NTHREADS, LDS_BYTES) != hipSuccess || per_cu < 1) { fprintf(stderr, "kernel_launch: occupancy query says %d\n", per_cu); }
        (void)hipGetLastError();
        grid = cus;
    }
    if (grid < 0) return;
    if (hipMemsetAsync((char*)d_ws + WS_CTL, 0, CTL_ZERO_BYTES, stream) != hipSuccess) return;
    Args a{};
    for (int i = 0; i < 28; ++i) a.in[i] = (const float*)d_in[i];
    a.out = (float*)d_out; a.ws = (unsigned char*)d_ws; a.ph_lo = 0; a.ph_hi = NPH;
    hipLaunchKernelGGL(mk_fwd, dim3(grid), dim3(NTHREADS), LDS_BYTES, stream, a);
}
```

```cpp
#include <hip/hip_runtime.h>
#include <cstdio>
#include <cstdint>
#include <math.h>

#ifndef GEMM_PROBE
#define GEMM_PROBE 0
#endif
#ifndef GEMM_PROBE_KIND
#define GEMM_PROBE_KIND 1
#endif
#ifndef UP_FP8
#define UP_FP8 1
#endif
#ifndef DN_FP8
#define DN_FP8 1
#endif
#define LAS __attribute__((address_space(3)))
#define GAS __attribute__((address_space(1)))
typedef unsigned short bf16_t;
typedef short bf16x8 __attribute__((ext_vector_type(8)));
typedef short s16x4 __attribute__((ext_vector_type(4)));
typedef float f32x4 __attribute__((ext_vector_type(4)));
typedef float f32x2 __attribute__((ext_vector_type(2)));
typedef float f32x16 __attribute__((ext_vector_type(16)));
typedef unsigned u32x4 __attribute__((ext_vector_type(4)));
typedef unsigned u32x2 __attribute__((ext_vector_type(2)));
typedef int v8i32 __attribute__((ext_vector_type(8)));

constexpr int D = 1024, BATCH = 4, SEQ = 8192, DEPTH = 2, T = BATCH * SEQ;
constexpr int DS = 512, NG = 32, HS = 16, NP = 64, DA = 512, NH = 4, DV = 128, DIN = 2048;
constexpr int NE = 32, DFF = 1024, NASSIGN = T * 4;
constexpr int MPAD_MAX = NASSIGN + NE * 256, NTILE_MAX = MPAD_MAX / 256;
constexpr int NCHUNK = T / 64, CPB = SEQ / 64;
constexpr float EPS = 1e-6f;
constexpr float C2 = 0.125f * 1.4426950408889634f;
constexpr int NWAVES = 8, NTHREADS = 512;

constexpr size_t MiB = 1u << 20;
constexpr size_t WS_CTL = 0, CTL_ZERO_BYTES = 1 * MiB;
constexpr size_t WS_COS = 1 * MiB, WS_SIN = 2 * MiB;
constexpr size_t WS_SCAL = 3 * MiB;
constexpr size_t WS_KT = 4 * MiB, KT_STRIDE = 2 * MiB;
constexpr size_t WS_LAML = 8 * MiB, LAML_STRIDE = 32768;
constexpr size_t WS_WRT = 9 * MiB, WRT_STRIDE = 131072;
constexpr size_t WS_RS = 10 * MiB;
constexpr size_t WS_GT = 16 * MiB, GT_STRIDE = 8 * MiB;
constexpr size_t WS_HT = 32 * MiB, HT_STRIDE = 8 * MiB;
constexpr size_t WS_WIN = 48 * MiB, WIN_STRIDE = 4 * MiB;
constexpr size_t WS_WGLU = 56 * MiB, WGLU_STRIDE = MiB / 2;
constexpr size_t WS_WOUT = 58 * MiB, WOUT_STRIDE = 2 * MiB;
constexpr size_t WS_WUP = 64 * MiB, WUP_STRIDE = 128 * MiB;
constexpr size_t WS_WDN = 320 * MiB, WDN_STRIDE = 64 * MiB;
constexpr size_t WS_XN = 448 * MiB;
constexpr size_t WS_U = 512 * MiB, WS_Q = 544 * MiB, WS_K = 576 * MiB, WS_V = 608 * MiB;
constexpr size_t WS_YG = 640 * MiB;
constexpr size_t WS_MIX = 672 * MiB;
constexpr size_t WS_S = 736 * MiB;
constexpr size_t WS_RSP = 744 * MiB;
constexpr size_t WS_TOPI = 746 * MiB, WS_TOPG = 747 * MiB, WS_TOKROW = 748 * MiB, WS_WGCNT = 749 * MiB;
constexpr size_t WS_ROWTOK = 750 * MiB, WS_ROWGATE = 751 * MiB, WS_TILEEXP = 752 * MiB, WS_ROWSCALE = 753 * MiB;
constexpr size_t WS_ACT = 768 * MiB, WS_YB = 1040 * MiB, WS_H1 = 1180 * MiB, WS_H2 = 1244 * MiB, WS_END = 1312 * MiB;
constexpr int CW_BAR = 4096;

constexpr int LDS_CTL = 0;
constexpr int LDS_RING = 4096;
constexpr int LDS_BYTES = 163840;

__device__ __forceinline__ unsigned f2bf(float f) { unsigned u = __builtin_bit_cast(unsigned, f); return (u + 0x7fffu + ((u >> 16) & 1u)) >> 16; }
__device__ __forceinline__ unsigned pk2(float lo, float hi) { return f2bf(lo) | (f2bf(hi) << 16); }
__device__ __forceinline__ unsigned cvt_pk_bf16(float lo, float hi) { unsigned r; asm volatile("v_cvt_pk_bf16_f32 %0, %1, %2" : "=v"(r) : "v"(lo), "v"(hi)); return r; }
__device__ __forceinline__ unsigned pk4_fp8(float a, float b, float c, float d) { int w = 0; w = __builtin_amdgcn_cvt_pk_fp8_f32(a, b, w, false); w = __builtin_amdgcn_cvt_pk_fp8_f32(c, d, w, true); return (unsigned)w; }
__device__ __forceinline__ void fp8x4_add(unsigned w, float sc, f32x4& a) { const f32x2 lo = __builtin_amdgcn_cvt_pk_f32_fp8((int)w, false), hi = __builtin_amdgcn_cvt_pk_f32_fp8((int)w, true); a[0] += lo[0] * sc; a[1] += lo[1] * sc; a[2] += hi[0] * sc; a[3] += hi[1] * sc; }
__device__ __forceinline__ float bf_lo(unsigned w) { return __builtin_bit_cast(float, w << 16); }
__device__ __forceinline__ float bf_hi(unsigned w) { return __builtin_bit_cast(float, w & 0xffff0000u); }
__device__ __forceinline__ float wave_sum(float v) {
#pragma unroll
    for (int o = 1; o < 64; o <<= 1) v += __shfl_xor(v, o);
    return v;
}
__device__ __forceinline__ float gelu_tanh(float x) {
    const float z = 0.7978845608028654f * (x + 0.044715f * x * x * x);
    return x * __builtin_amdgcn_rcpf(1.f + __builtin_amdgcn_exp2f(-2.885390082f * z));
}
__device__ __forceinline__ float sigmoidf(float v) { return __builtin_amdgcn_rcpf(1.f + __builtin_amdgcn_exp2f(-1.4426950409f * v)); }

#define XB_TMO      128
#define XB_XCNT(j)  (256  + 64 * (j))
#define XB_XSUB(j)  (1280 + 64 * (j))
#define XB_XGEN(j)  (2304 + 64 * (j))
#define XB_TOP      3328
#define XB_TOPGEN   3392
#define XCD_BAR_WORDS 3456
#define XB_SPIN_CAP (1u << 18)
__device__ __forceinline__ unsigned xb_ld(unsigned* p)              { return __hip_atomic_load(p, __ATOMIC_RELAXED, __HIP_MEMORY_SCOPE_AGENT); }
__device__ __forceinline__ unsigned xb_add(unsigned* p, unsigned v) { return __hip_atomic_fetch_add(p, v, __ATOMIC_RELAXED, __HIP_MEMORY_SCOPE_AGENT); }
__device__ __forceinline__ unsigned xb_xcc_id() { return (unsigned)__builtin_amdgcn_s_getreg((3 << 11) | 20) & 0xFu; }
#define XB_SPIN(cond, bar) do { unsigned _sp = 0; while (cond) { __builtin_amdgcn_s_sleep(1); \
    if ((++_sp & 255u) == 0u) { if (xb_ld(&(bar)[XB_TMO])) break; if (_sp > XB_SPIN_CAP) { atomicAdd(&(bar)[XB_TMO], 1u); break; } } } } while (0)
struct XcdBarrier { unsigned* bar; unsigned x; volatile LAS unsigned* st; };
__device__ __forceinline__ XcdBarrier xcd_barrier_post(unsigned* bar, volatile LAS unsigned* st) {
    XcdBarrier b; b.bar = bar; b.x = xb_xcc_id(); b.st = st;
    if (threadIdx.x == 0) (void)xb_add(&bar[XB_XCNT(b.x)], 1u);
    return b;
}
__device__ __forceinline__ void xcd_barrier_complete(unsigned* bar, unsigned x, unsigned& nloc, unsigned& nx) {
    const unsigned G = gridDim.x * gridDim.y * gridDim.z;
    unsigned sum, cnt, mine, sp = 0u;
    for (;;) {
        sum = 0u; cnt = 0u; mine = 0u;
#pragma unroll
        for (unsigned j = 0; j < 16; ++j) { const unsigned c = xb_ld(&bar[XB_XCNT(j)]); sum += c; cnt += (c > 0u) ? 1u : 0u; mine = (j == x) ? c : mine; }
        if (sum == G) break;
        __builtin_amdgcn_s_sleep(1);
        if ((++sp & 255u) == 0u) { if (xb_ld(&bar[XB_TMO])) break; if (sp > XB_SPIN_CAP) { atomicAdd(&bar[XB_TMO], 1u); break; } }
    }
    nloc = mine > 0u ? mine : 1u; nx = cnt > 0u ? cnt : 1u;
}
__device__ __forceinline__ void xcd_barrier(const XcdBarrier& b) {
    asm volatile("s_waitcnt vmcnt(0)" ::: "memory");
    __syncthreads();
    if (threadIdx.x == 0) {
        unsigned* bar = b.bar;
        __builtin_amdgcn_s_waitcnt(0);
        unsigned nloc = b.st[0], nx = b.st[1];
        if (nloc == 0u) { xcd_barrier_complete(bar, b.x, nloc, nx); b.st[0] = nloc; b.st[1] = nx; }
        const unsigned old = xb_add(&bar[XB_XSUB(b.x)], 1u);
        const unsigned gen = old / nloc;
        if (old + 1u == (gen + 1u) * nloc) {
            __builtin_amdgcn_fence(__ATOMIC_RELEASE, "agent");
            asm volatile("s_waitcnt vmcnt(0)" ::: "memory");
            const unsigned og = xb_add(&bar[XB_TOP], 1u);
            const unsigned tg = og / nx;
            if (og + 1u == (tg + 1u) * nx) xb_add(&bar[XB_TOPGEN], 1u);
            else XB_SPIN(xb_ld(&bar[XB_TOPGEN]) == tg, bar);
            __builtin_amdgcn_fence(__ATOMIC_ACQUIRE, "agent");
            xb_add(&bar[XB_XGEN(b.x)], 1u);
            asm volatile("s_waitcnt vmcnt(0)" ::: "memory");
        } else {
            XB_SPIN(xb_ld(&bar[XB_XGEN(b.x)]) == gen, bar);
            __builtin_amdgcn_fence(__ATOMIC_ACQUIRE, "agent");
            asm volatile("s_waitcnt vmcnt(0)" ::: "memory");
        }
    }
    __syncthreads();
}

namespace pg8 {
constexpr int BM = 256, BK = 64, HALF = 128, HTB = HALF * BK * 2, STAGE_BYTES = 8 * HTB;
__host__ __device__ __forceinline__ int lds_byte(int r, int c) { const int st = (r >> 4) * 2 + (c >> 5), rr = r & 15, cc = c & 31, ob = rr * 64 + cc * 2; return st * 1024 + (ob ^ (((ob >> 9) & 1) << 5)); }
__host__ __device__ __forceinline__ void stage_rc(int b, int& R, int& C) { const int st = b / 1024, sb = b % 1024, swz = sb ^ (((sb >> 9) & 1) << 5); R = (st >> 1) * 16 + swz / 64; C = (st & 1) * 32 + (swz % 64) / 2; }
__host__ __device__ __forceinline__ int perm32(int rho) { const int n = rho >> 4, i = rho & 15; return 8 * (i >> 2) + 4 * n + (i & 3); }
__host__ __device__ __forceinline__ int perm16x(int rho) { const int n = rho >> 4, i = rho & 15; return 16 * (i >> 2) + 4 * n + (i & 3); }

struct Unit { int pm, pn; };
template <class P>
__device__ __forceinline__ void gemm_phase(LAS unsigned char* lds, LAS unsigned char* ldsctl, P& S, const int tid) {
    const int wid = __builtin_amdgcn_readfirstlane(tid >> 6), lane = tid & 63, wr = wid >> 2, wc = wid & 3, fr = lane & 15, fq = lane >> 4;
    constexpr bool F8 = P::FP8;
    constexpr int K = P::K, ES = F8 ? 1 : 2, nt = K * ES / 128;
    int R0, C0, R1, C1; stage_rc(tid * 16, R0, C0); stage_rc(tid * 16 + 8192, R1, C1);
    unsigned voffB[2];
    {
        const int Rb0 = P::BROW64 == 2 ? (64 * (R0 >> 5) + perm16x(R0 & 31)) : P::BROW64 ? (64 * (R0 >> 5) + perm32(R0 & 31)) : ((R0 & ~31) + perm32(R0 & 31));
        const int Rb1 = P::BROW64 == 2 ? (64 * (R1 >> 5) + perm16x(R1 & 31)) : P::BROW64 ? (64 * (R1 >> 5) + perm32(R1 & 31)) : ((R1 & ~31) + perm32(R1 & 31));
        voffB[0] = (unsigned)(Rb0 * K * ES + 2 * C0); voffB[1] = (unsigned)(Rb1 * K * ES + 2 * C1);
    }
    const unsigned ldsw = (unsigned)wid * 1024u;
    const int scl8 = P::SCALE_AB;
    const int aoff = lds_byte(wr * 64 + fr, fq * 8), boff = lds_byte(wc * 32 + fr, fq * 8);
#define PG8_SA(b, h) (((b) * 2 + (h)) * HTB)
#define PG8_SB(b, h) ((4 + (b) * 2 + (h)) * HTB)
    const unsigned ldsbase = (unsigned)__builtin_amdgcn_readfirstlane((int)(unsigned)(uintptr_t)lds + (int)ldsw);
#define PG8_GLDS(sbase, voff, ldsdst) do { if (P::NODMA) break; unsigned _keep; asm volatile("s_mov_b32 %0, m0\n\ts_mov_b32 m0, %3\n\ts_nop 0\n\tglobal_load_lds_dwordx4 %2, %1\n\ts_mov_b32 m0, %0" \
        : "=&s"(_keep) : "s"(sbase), "v"(voff), "s"(ldsdst) : "memory"); } while (0)
#define PG8_STAGE_A(bufoff, vo, h, kofs) do { _Pragma("unroll") for (int _i = 0; _i < 2; ++_i) \
        PG8_GLDS(Abase, (vo)[P::GATHER ? (h) : 0][_i] + ((kofs) + (P::GATHER ? 0u : (unsigned)(h) * HSTEPA)), ldsbase + (unsigned)((bufoff) + _i * 8192)); } while (0)
#define PG8_STAGE_B(bufoff, gbase) do { _Pragma("unroll") for (int _i = 0; _i < 2; ++_i) \
        PG8_GLDS((const char*)(gbase), voffB[_i], ldsbase + (unsigned)((bufoff) + _i * 8192)); } while (0)
#define PG8_LDA(dst, b, h) do { if constexpr (F8) { _Pragma("unroll") for (int m = 0; m < 4; ++m) { const u32x4 _l = *(const LAS u32x4*)(lds + PG8_SA(b, h) + aoff + m * 2048), _h = *(const LAS u32x4*)(lds + PG8_SA(b, h) + aoff + m * 2048 + 1024); dst##8[m] = __builtin_bit_cast(v8i32, __builtin_shufflevector(_l, _h, 0, 1, 2, 3, 4, 5, 6, 7)); } } \
        else { _Pragma("unroll") for (int m = 0; m < 4; ++m) _Pragma("unroll") for (int k = 0; k < 2; ++k) dst[m][k] = *(const LAS bf16x8*)(lds + PG8_SA(b, h) + aoff + m * 2048 + k * 1024); } } while (0)
#define PG8_LDB(dst, b, h) do { if constexpr (F8) { _Pragma("unroll") for (int n = 0; n < 2; ++n) { const u32x4 _l = *(const LAS u32x4*)(lds + PG8_SB(b, h) + boff + n * 2048), _h = *(const LAS u32x4*)(lds + PG8_SB(b, h) + boff + n * 2048 + 1024); dst##8[n] = __builtin_bit_cast(v8i32, __builtin_shufflevector(_l, _h, 0, 1, 2, 3, 4, 5, 6, 7)); } } \
        else { _Pragma("unroll") for (int n = 0; n < 2; ++n) _Pragma("unroll") for (int k = 0; k < 2; ++k) dst[n][k] = *(const LAS bf16x8*)(lds + PG8_SB(b, h) + boff + n * 2048 + k * 1024); } } while (0)
#define PG8_MMA(ai, bj, At, Bt) do { __builtin_amdgcn_s_setprio(1); \
        if constexpr (F8) { _Pragma("unroll") for (int m = 0; m < 4; ++m) _Pragma("unroll") for (int n = 0; n < 2; ++n) \
            asm volatile("v_mfma_scale_f32_16x16x128_f8f6f4 %0, %1, %2, %0, %3, %3 op_sel:[0,1,0] op_sel_hi:[0,0,0]" : "+v"(acc[ai][bj][m][n]) : "v"(Bt##8[n]), "v"(At##8[m]), "v"(scl8)); } \
        else { _Pragma("unroll") for (int m = 0; m < 4; ++m) _Pragma("unroll") for (int n = 0; n < 2; ++n) _Pragma("unroll") for (int k = 0; k < 2; ++k) \
            acc[ai][bj][m][n] = __builtin_amdgcn_mfma_f32_16x16x32_bf16(Bt[n][k], At[m][k], acc[ai][bj][m][n], 0, 0, 0); } \
        __builtin_amdgcn_s_setprio(0); } while (0)
#define PG8_WAIT_V(n) asm volatile("s_waitcnt vmcnt(" #n ")" ::: "memory")
#define PG8_WAIT_L(n) asm volatile("s_waitcnt lgkmcnt(" #n ")" ::: "memory")
#define PG8_BAR __builtin_amdgcn_s_barrier()
#define PG8_SCHED __builtin_amdgcn_sched_barrier(0)
    Unit cur, nxt; int ui = 0;
    if (!S.next(0, cur)) return;
    f32x4 acc[2][2][4][2];
#pragma unroll
    for (int a = 0; a < 2; ++a)
#pragma unroll
        for (int b = 0; b < 2; ++b)
#pragma unroll
            for (int m = 0; m < 4; ++m)
#pragma unroll
                for (int n = 0; n < 2; ++n) acc[a][b][m][n] = (f32x4){0.f, 0.f, 0.f, 0.f};
    bf16x8 At[4][2], B0[2][2], B1[2][2]; v8i32 At8[4], B08[2], B18[2];
    const char* const Abase = S.a_base();
    unsigned voffA[2][2], voffAn[2][2];
    const char *cB0, *cB1;
    S.unit_begin(cur, ldsctl, tid, 0);
    S.a_offs(cur, R0, C0, R1, C1, voffA, true);
    asm volatile("" ::: "memory");
    S.b_ptrs(cur, cB0, cB1);
    constexpr unsigned kstep = 128, HSTEPA = (unsigned)HALF * K * ES;
    PG8_STAGE_B(PG8_SB(0, 0), cB0); PG8_STAGE_B(PG8_SB(0, 1), cB1); PG8_STAGE_A(PG8_SA(0, 0), voffA, 0, 0u); PG8_STAGE_A(PG8_SA(0, 1), voffA, 1, 0u);
    if (wr == 1) PG8_BAR;
    PG8_WAIT_V(2); PG8_BAR;
    PG8_STAGE_B(PG8_SB(1, 0), cB0 + kstep); PG8_STAGE_A(PG8_SA(1, 0), voffA, 0, kstep); PG8_STAGE_B(PG8_SB(1, 1), cB1 + kstep);
    PG8_WAIT_V(6); PG8_BAR;
    for (;;) {
        const bool has_next = S.next(ui + 1, nxt);
        const char *nB0 = cB0, *nB1 = cB1;
        if constexpr (P::GATHER) {
#pragma unroll
            for (int h = 0; h < 2; ++h)
#pragma unroll
                for (int i = 0; i < 2; ++i) voffAn[h][i] = voffA[h][i];
        }
        if (has_next) { S.unit_begin(nxt, ldsctl, tid, (ui + 1) & 1); S.b_ptrs(nxt, nB0, nB1);
            if constexpr (P::GATHER) { int t2 = tid; asm volatile("" : "+v"(t2)); int r0, c0, r1, c1; stage_rc(t2 * 16, r0, c0); stage_rc(t2 * 16 + 8192, r1, c1); S.a_offs(nxt, r0, c0, r1, c1, voffAn, false); } }
        { int l3 = tid; asm volatile("" : "+v"(l3)); S.epi_prefetch(cur, wr, wc, l3 & 15, (l3 >> 4) & 3); }
#pragma unroll 1
        for (int t = 0; t < nt; t += 2) {
            const bool last = (t == nt - 2);
            S.midk(acc, cur, t, wr, fr, ldsctl, ui & 1);
            unsigned a2o[2][2];
            if constexpr (!P::GATHER) { if (last) { int t2 = tid; asm volatile("" : "+v"(t2)); int r0, c0, r1, c1; stage_rc(t2 * 16, r0, c0); stage_rc(t2 * 16 + 8192, r1, c1);
                                                   S.a_offs(has_next ? nxt : cur, r0, c0, r1, c1, voffAn, false); } }
#pragma unroll
            for (int h = 0; h < 2; ++h)
#pragma unroll
                for (int i = 0; i < 2; ++i) a2o[h][i] = last ? voffAn[h][i] : voffA[h][i] + (unsigned)(t + 2) * kstep;
            const char* b2h0 = last ? nB0 : cB0 + (size_t)(t + 2) * kstep; const char* b2h1 = last ? nB1 : cB1 + (size_t)(t + 2) * kstep;
            const unsigned a1k = (unsigned)(t + 1) * kstep;
            PG8_LDB(B0, 0, 0); PG8_LDB(B1, 0, 1); PG8_SCHED; PG8_LDA(At, 0, 0); PG8_STAGE_A(PG8_SA(1, 1), voffA, 1, a1k);
            PG8_WAIT_V(8); PG8_WAIT_L(0); PG8_BAR; PG8_MMA(0, 0, At, B0); PG8_MMA(0, 1, At, B1); PG8_BAR; PG8_SCHED;
            PG8_LDA(At, 0, 1); PG8_STAGE_B(PG8_SB(0, 0), b2h0); PG8_STAGE_B(PG8_SB(0, 1), b2h1); PG8_STAGE_A(PG8_SA(0, 0), a2o, 0, 0u);
            PG8_WAIT_V(8); PG8_WAIT_L(0); PG8_BAR; PG8_MMA(1, 0, At, B0); PG8_MMA(1, 1, At, B1); PG8_BAR; PG8_SCHED;
            PG8_LDB(B0, 1, 0); PG8_LDB(B1, 1, 1); PG8_SCHED; PG8_LDA(At, 1, 0); PG8_STAGE_A(PG8_SA(0, 1), a2o, 1, 0u);
            PG8_WAIT_V(8); PG8_WAIT_L(0); PG8_BAR; PG8_MMA(0, 0, At, B0); PG8_MMA(0, 1, At, B1); PG8_BAR; PG8_SCHED;
            PG8_LDA(At, 1, 1); PG8_STAGE_B(PG8_SB(1, 0), b2h0 + kstep); PG8_STAGE_B(PG8_SB(1, 1), b2h1 + kstep); PG8_STAGE_A(PG8_SA(1, 0), a2o, 0, kstep);
            PG8_WAIT_V(8); PG8_WAIT_L(0); PG8_BAR; PG8_MMA(1, 0, At, B0); PG8_MMA(1, 1, At, B1); PG8_BAR; PG8_SCHED;
        }
        if (wr == 0) PG8_BAR;
        if constexpr (F8) asm volatile("s_nop 15\n\ts_nop 15" ::: "memory");
        { int l2 = tid; asm volatile("" : "+v"(l2)); if (!P::NOEPI) S.epi(acc, cur, wr, wc, l2 & 15, (l2 >> 4) & 3); }
        if (!has_next) break;
#pragma unroll
        for (int a = 0; a < 2; ++a)
#pragma unroll
            for (int b = 0; b < 2; ++b)
#pragma unroll
                for (int m = 0; m < 4; ++m)
#pragma unroll
                    for (int n = 0; n < 2; ++n) acc[a][b][m][n] = (f32x4){0.f, 0.f, 0.f, 0.f};
        cur = nxt; cB0 = nB0; cB1 = nB1; ++ui;
#pragma unroll
        for (int h = 0; h < 2; ++h)
#pragma unroll
            for (int i = 0; i < 2; ++i) voffA[h][i] = voffAn[h][i];
        if (wr == 1) PG8_BAR;
    }
    PG8_WAIT_V(0);
    PG8_BAR;
#undef PG8_SA
#undef PG8_SB
#undef PG8_STAGE_A
#undef PG8_GLDS
#undef PG8_STAGE_B
#undef PG8_LDA
#undef PG8_LDB
#undef PG8_MMA
#undef PG8_WAIT_V
#undef PG8_WAIT_L
#undef PG8_BAR
#undef PG8_SCHED
}
struct StaticOrder {
    int nM, nN, nwg, G, c;
    __device__ void init(int M, int N, int G_, int c_) { nM = M / BM; nN = N / BM; nwg = nM * nN; G = G_; c = c_; }
    __device__ bool next(int i, Unit& u) const {
        const long L = (long)i * G + c; if (L >= nwg) return false;
        int wgid = (int)L; { const int q = nwg / 8, r = nwg % 8, xcd = wgid % 8, off = wgid / 8; wgid = (xcd < r ? xcd * (q + 1) : r * (q + 1) + (xcd - r) * q) + off; }
        const int nig = 8 * nN, gid = wgid / nig, fm = gid * 8, gsz = (nM - fm) < 8 ? (nM - fm) : 8;
        u.pm = fm + ((wgid % nig) % gsz); u.pn = (wgid % nig) / gsz; return true;
    }
};
}

struct Frame {
    LAS unsigned char* lds; LAS unsigned char* ctl;
    unsigned char* ws;
    int tid, lane, wave, G, bx;
    float* out; const struct Args* ap; unsigned char* ws0; float* out0; size_t z;
};

struct Args { const float* in[28]; float* out; unsigned char* ws; int ph_lo, ph_hi; };
#define arg_in(i) (F.ap->in[i] + F.z)
__device__ __forceinline__ void phase_begin(Frame& F) {
    int t = F.tid; asm volatile("" : "+v"(t)); F.tid = t; F.lane = t & 63; F.wave = __builtin_amdgcn_readfirstlane(t >> 6);
    size_t z = 0; asm volatile("" : "+s"(z)); F.z = z; F.ws = F.ws0 + z; F.out = F.out0 + z;
    int bx = F.bx; asm volatile("" : "+s"(bx)); F.bx = bx;
}
__device__ __forceinline__ void phase_restart(Frame& F) {
    int wv = F.wave; asm volatile("" : "+s"(wv)); F.wave = wv;
    int ln = (int)__builtin_amdgcn_mbcnt_hi(~0u, __builtin_amdgcn_mbcnt_lo(~0u, 0u)); asm volatile("" : "+v"(ln)); F.lane = ln; F.tid = wv * 64 + ln;
    size_t z = 0; asm volatile("" : "+s"(z)); F.z = z; F.ws = F.ws0 + z; F.out = F.out0 + z;
}
struct PBase {
    static constexpr bool GATHER = false, FP8 = false, NODMA = false, NOEPI = false; static constexpr int SCALE_AB = 0x7f7f7f7f;
    __device__ __forceinline__ void unit_begin(const pg8::Unit&, LAS unsigned char*, int, int) {}
    __device__ __forceinline__ void midk(f32x4 (&)[2][2][4][2], const pg8::Unit&, int, int, int, LAS unsigned char*, int) {}
    __device__ __forceinline__ void a_fix(unsigned (&)[2][2]) {}
    __device__ __forceinline__ void epi_prefetch(const pg8::Unit&, int, int, int, int) {}
};
struct PInProj : PBase {
    static constexpr int K = 1024, BROW64 = 1;
    pg8::StaticOrder so; const char* A; const char* B; bf16_t* UQKV; const float *GQK, *COS, *SIN;
    __device__ __forceinline__ bool next(int i, pg8::Unit& u) const { return so.next(i, u); }
    __device__ __forceinline__ const char* a_base() const { return A; }
    __device__ __forceinline__ void a_offs(const pg8::Unit& u, int R0, int C0, int R1, int C1, unsigned (&vo)[2][2], bool) const {
#pragma unroll
        for (int h = 0; h < 2; ++h) { vo[h][0] = (unsigned)((u.pm * 256 + 128 * h + R0) * K + C0) * 2u; vo[h][1] = (unsigned)((u.pm * 256 + 128 * h + R1) * K + C1) * 2u; }
    }
    __device__ __forceinline__ void b_ptrs(const pg8::Unit& u, const char*& b0, const char*& b1) const { b0 = B + (size_t)u.pn * 256 * K * 2; b1 = b0 + (size_t)32 * K * 2; }
    __device__ __forceinline__ void epi(f32x4 (&acc)[2][2][4][2], const pg8::Unit& u, int wr, int wc, int fr, int fq) const {
        const int kind = u.pn >> 1;
        const int colg = (u.pn & 1) * 256 + 64 * wc;
        bf16_t* dst = UQKV + (size_t)kind * (size_t)(16u << 20);
        const int row0 = u.pm * 256 + wr * 64 + fr;
        if (kind == 0 || kind == 3) {
#pragma unroll
            for (int ai = 0; ai < 2; ++ai)
#pragma unroll
                for (int m = 0; m < 4; ++m) { bf16_t* rowp = dst + (size_t)(row0 + ai * 128 + m * 16) * 512 + colg + 8 * fq;
#pragma unroll
                    for (int bj = 0; bj < 2; ++bj) { const f32x4 v0 = acc[ai][bj][m][0], v1 = acc[ai][bj][m][1];
                        u32x4 w; w.x = cvt_pk_bf16(v0[0], v0[1]); w.y = cvt_pk_bf16(v0[2], v0[3]); w.z = cvt_pk_bf16(v1[0], v1[1]); w.w = cvt_pk_bf16(v1[2], v1[3]);
                        *(u32x4*)(rowp + 32 * bj) = w; } }
        } else {
            const float* g = GQK + (kind - 1) * 64; const float sc = kind == 1 ? C2 * 32.0f : 16.0f;
            f32x4 g0[2], g1[2];
#pragma unroll
            for (int n = 0; n < 2; ++n) { g0[n] = *(const f32x4*)(g + 8 * fq + 4 * n); g1[n] = *(const f32x4*)(g + 32 + 8 * fq + 4 * n); }
#pragma unroll
            for (int ai = 0; ai < 2; ++ai)
#pragma unroll
                for (int m = 0; m < 4; ++m) {
                    const int row = row0 + ai * 128 + m * 16; const int pos = row & (SEQ - 1);
                    float ss = 0.f;
#pragma unroll
                    for (int bj = 0; bj < 2; ++bj)
#pragma unroll
                        for (int n = 0; n < 2; ++n) { const f32x4 x = acc[ai][bj][m][n]; ss += (x[0] * x[0] + x[1] * x[1]) + (x[2] * x[2] + x[3] * x[3]); }
                    ss += __shfl_xor(ss, 16); ss += __shfl_xor(ss, 32);
                    const float r = rsqrtf(ss * (1.f / 64.f) + EPS) * sc;
                    f32x4 o1[2], o2[2];
#pragma unroll
                    for (int n = 0; n < 2; ++n) {
                        const f32x4 c = *(const f32x4*)(COS + (size_t)pos * 32 + 8 * fq + 4 * n), s = *(const f32x4*)(SIN + (size_t)pos * 32 + 8 * fq + 4 * n);
                        const f32x4 x1 = acc[ai][0][m][n] * g0[n] * r, x2 = acc[ai][1][m][n] * g1[n] * r;
                        o1[n] = x1 * c - x2 * s; o2[n] = x2 * c + x1 * s;
                    }
                    unsigned char* rowp = (unsigned char*)dst + (size_t)row * 512 + colg + 8 * fq;
                    u32x2 w; w.x = pk4_fp8(o1[0][0], o1[0][1], o1[0][2], o1[0][3]); w.y = pk4_fp8(o1[1][0], o1[1][1], o1[1][2], o1[1][3]);
                    *(u32x2*)(rowp) = w;
                    w.x = pk4_fp8(o2[0][0], o2[0][1], o2[0][2], o2[0][3]); w.y = pk4_fp8(o2[1][0], o2[1][1], o2[1][2], o2[1][3]);
                    *(u32x2*)(rowp + 32) = w;
                    asm volatile("" ::: "memory");
                }
        }
    }
};
struct PGlu : PBase {
    static constexpr int K = 512, BROW64 = 0;
    pg8::StaticOrder so; const char* A; const char* B; const bf16_t* YG; bf16_t* MIX; float* RSP;
    __device__ __forceinline__ bool next(int i, pg8::Unit& u) const { return so.next(i, u); }
    __device__ __forceinline__ const char* a_base() const { return A; }
    __device__ __forceinline__ void a_offs(const pg8::Unit& u, int R0, int C0, int R1, int C1, unsigned (&vo)[2][2], bool) const {
#pragma unroll
        for (int h = 0; h < 2; ++h) { vo[h][0] = (unsigned)((u.pm * 256 + 128 * h + R0) * K + C0) * 2u; vo[h][1] = (unsigned)((u.pm * 256 + 128 * h + R1) * K + C1) * 2u; }
    }
    __device__ __forceinline__ void b_ptrs(const pg8::Unit& u, const char*& b0, const char*& b1) const { b0 = B + (size_t)u.pn * 256 * K * 2; b1 = b0 + (size_t)128 * K * 2; }
    __device__ __forceinline__ void epi(f32x4 (&acc)[2][2][4][2], const pg8::Unit& u, int wr, int wc, int fr, int fq) const {
        const int row0 = u.pm * 256 + wr * 64 + fr, col0 = u.pn * 256 + wc * 32 + 8 * fq;
#pragma unroll
        for (int ai = 0; ai < 2; ++ai)
#pragma unroll
            for (int m = 0; m < 4; ++m) {
                const int row = row0 + ai * 128 + m * 16; float ss = 0.f;
#pragma unroll
                for (int bj = 0; bj < 2; ++bj) {
                    const u32x4 yw = *(const u32x4*)(YG + (size_t)row * 512 + col0 + 128 * bj);
                    const f32x4 a0 = acc[ai][bj][m][0], a1 = acc[ai][bj][m][1];
                    float z[8];
                    z[0] = bf_lo(yw.x) * sigmoidf(a0[0]); z[1] = bf_hi(yw.x) * sigmoidf(a0[1]); z[2] = bf_lo(yw.y) * sigmoidf(a0[2]); z[3] = bf_hi(yw.y) * sigmoidf(a0[3]);
                    z[4] = bf_lo(yw.z) * sigmoidf(a1[0]); z[5] = bf_hi(yw.z) * sigmoidf(a1[1]); z[6] = bf_lo(yw.w) * sigmoidf(a1[2]); z[7] = bf_hi(yw.w) * sigmoidf(a1[3]);
#pragma unroll
                    for (int i = 0; i < 8; ++i) ss += z[i] * z[i];
                    u32x4 w; w.x = cvt_pk_bf16(z[0], z[1]); w.y = cvt_pk_bf16(z[2], z[3]); w.z = cvt_pk_bf16(z[4], z[5]); w.w = cvt_pk_bf16(z[6], z[7]);
                    *(u32x4*)(MIX + (size_t)row * 1024 + col0 + 128 * bj) = w;
                }
                ss += __shfl_xor(ss, 16); ss += __shfl_xor(ss, 32);
                if (fq == 0) RSP[(size_t)row * 8 + u.pn * 4 + wc] = ss;
            }
    }
};
struct POut : PBase {
    static constexpr int K = 1024, BROW64 = 0;
    pg8::StaticOrder so; const char* A; const char* B; const float* RSP; const float* base32; const bf16_t* base16; bf16_t* H1;
    __device__ __forceinline__ bool next(int i, pg8::Unit& u) const { return so.next(i, u); }
    __device__ __forceinline__ const char* a_base() const { return A; }
    __device__ __forceinline__ void a_offs(const pg8::Unit& u, int R0, int C0, int R1, int C1, unsigned (&vo)[2][2], bool) const {
#pragma unroll
        for (int h = 0; h < 2; ++h) { vo[h][0] = (unsigned)((u.pm * 256 + 128 * h + R0) * K + C0) * 2u; vo[h][1] = (unsigned)((u.pm * 256 + 128 * h + R1) * K + C1) * 2u; }
    }
    __device__ __forceinline__ void b_ptrs(const pg8::Unit& u, const char*& b0, const char*& b1) const { b0 = B + (size_t)u.pn * 256 * K * 2; b1 = b0 + (size_t)128 * K * 2; }
    __device__ __forceinline__ void unit_begin(const pg8::Unit& u, LAS unsigned char* ldsctl, int tid, int slot) const {
        if (tid < 256) {
            const f32x4 p0 = *(const f32x4*)(RSP + (size_t)(u.pm * 256 + tid) * 8), p1 = *(const f32x4*)(RSP + (size_t)(u.pm * 256 + tid) * 8 + 4);
            const float ss = ((p0[0] + p0[1]) + (p0[2] + p0[3])) + ((p1[0] + p1[1]) + (p1[2] + p1[3]));
            ((LAS float*)(ldsctl + 1024 + slot * 1024))[tid] = rsqrtf(ss * (1.f / 512.f) + EPS);
        }
    }
    __device__ __forceinline__ void midk(f32x4 (&acc)[2][2][4][2], const pg8::Unit& u, int t, int wr, int fr, LAS unsigned char* ldsctl, int slot) const {
        if (t == 8) {
            const LAS float* rs = (const LAS float*)(ldsctl + 1024 + slot * 1024);
#pragma unroll
            for (int ai = 0; ai < 2; ++ai)
#pragma unroll
                for (int m = 0; m < 4; ++m) { const float r = rs[ai * 128 + wr * 64 + m * 16 + fr];
#pragma unroll
                    for (int bj = 0; bj < 2; ++bj)
#pragma unroll
                        for (int n = 0; n < 2; ++n) acc[ai][bj][m][n] *= r; }
        }
    }
    __device__ __forceinline__ void epi(f32x4 (&acc)[2][2][4][2], const pg8::Unit& u, int wr, int wc, int fr, int fq) const {
        const int row0 = u.pm * 256 + wr * 64 + fr, col0 = u.pn * 256 + wc * 32 + 8 * fq;
#pragma unroll
        for (int ai = 0; ai < 2; ++ai)
#pragma unroll
            for (int m = 0; m < 4; ++m) { const size_t off = (size_t)(row0 + ai * 128 + m * 16) * 1024 + col0;
#pragma unroll
                for (int bj = 0; bj < 2; ++bj) {
                    f32x4 v0 = acc[ai][bj][m][0], v1 = acc[ai][bj][m][1];
                    if (base32) { v0 += *(const f32x4*)(base32 + off + bj * 128); v1 += *(const f32x4*)(base32 + off + bj * 128 + 4); }
                    else { const u32x4 b = *(const u32x4*)(base16 + off + bj * 128); v0[0] += bf_lo(b.x); v0[1] += bf_hi(b.x); v0[2] += bf_lo(b.y); v0[3] += bf_hi(b.y); v1[0] += bf_lo(b.z); v1[1] += bf_hi(b.z); v1[2] += bf_lo(b.w); v1[3] += bf_hi(b.w); }
                    u32x4 w; w.x = cvt_pk_bf16(v0[0], v0[1]); w.y = cvt_pk_bf16(v0[2], v0[3]); w.z = cvt_pk_bf16(v1[0], v1[1]); w.w = cvt_pk_bf16(v1[2], v1[3]);
                    *(u32x4*)(H1 + off + bj * 128) = w; }
                if (m & 1) asm volatile("" ::: "memory"); }
    }
};
template <int NN> struct MoeOrder {
    int j, wpx, s0, s1, s2, s3, n0, n1, n2, n3;
    __device__ __forceinline__ void init(int G, int c, const int* PST) {
#ifndef MOE_XA
#define MOE_XA 2
#endif
#ifndef MOE_CHUNKED
#define MOE_CHUNKED 0
#endif
        if (MOE_XA == 1 && (G & 7) == 0) { wpx = G >> 3; const int x = MOE_CHUNKED ? c / wpx : (c & 7); j = MOE_CHUNKED ? c % wpx : (c >> 3);
            s0 = PST[x] >> 8; n0 = (PST[x + 1] - PST[x]) >> 8; s1 = PST[x + 8] >> 8; n1 = (PST[x + 9] - PST[x + 8]) >> 8;
            s2 = PST[x + 16] >> 8; n2 = (PST[x + 17] - PST[x + 16]) >> 8; s3 = PST[x + 24] >> 8; n3 = (PST[x + 25] - PST[x + 24]) >> 8; }
        else { j = c; wpx = G; s0 = 0; n0 = PST[32] >> 8; s1 = s2 = s3 = 0; n1 = n2 = n3 = 0; }
        if (MOE_XA == 2 && (G & 7) == 0) { wpx = G >> 3; j = c >> 3; s1 = c & 7; n0 = PST[32] >> 8; }
    }
    __device__ __forceinline__ bool next(int i, pg8::Unit& u) const {
        const int q = i * wpx + j; int pml = q / NN; u.pn = q % NN;
        if (MOE_XA == 2) { u.pm = s1 + 8 * pml; return u.pm < n0; }
        if (pml < n0) { u.pm = s0 + pml; return true; } pml -= n0;
        if (pml < n1) { u.pm = s1 + pml; return true; } pml -= n1;
        if (pml < n2) { u.pm = s2 + pml; return true; } pml -= n2;
        if (pml < n3) { u.pm = s3 + pml; return true; }
        return false;
    }
};
struct PUp : PBase {
    static constexpr int K = 1024, BROW64 = 0; static constexpr bool GATHER = true, FP8 = UP_FP8; static constexpr int ES = UP_FP8 ? 1 : 2;
    static constexpr int SCALE_AB = 0x7c79;
    MoeOrder<8> mo; const char* A; const char* B; const int* ROWTOK; const int* TILEEXP; const float* bup; const float* ROWSCALE; bf16_t* ACT;
    int idx[2][2]; int c0, c1;
    __device__ __forceinline__ bool next(int i, pg8::Unit& u) const { return mo.next(i, u); }
    __device__ __forceinline__ const char* a_base() const { return A; }
    __device__ __forceinline__ void a_offs(const pg8::Unit& u, int R0, int C0, int R1, int C1, unsigned (&vo)[2][2], bool first) {
        c0 = C0; c1 = C1;
        const int* rp = ROWTOK + u.pm * 256;
#pragma unroll
        for (int h = 0; h < 2; ++h) {
            asm volatile("global_load_dword %0, %1, off" : "=v"(idx[h][0]) : "v"(rp + 128 * h + R0) : "memory");
            asm volatile("global_load_dword %0, %1, off" : "=v"(idx[h][1]) : "v"(rp + 128 * h + R1) : "memory");
        }
        asm volatile("s_waitcnt vmcnt(0)" : "+v"(idx[0][0]), "+v"(idx[0][1]), "+v"(idx[1][0]), "+v"(idx[1][1]) :: "memory");
#pragma unroll
        for (int h = 0; h < 2; ++h) { vo[h][0] = (unsigned)(idx[h][0] * K * ES + 2 * c0); vo[h][1] = (unsigned)(idx[h][1] * K * ES + 2 * c1); }
    }
    __device__ __forceinline__ void b_ptrs(const pg8::Unit& u, const char*& b0, const char*& b1) const {
        const int e = TILEEXP[u.pm]; b0 = B + ((size_t)e * 2048 + (size_t)u.pn * 128) * K * ES; b1 = b0 + (size_t)1024 * K * ES; }
    float ps[8]; f32x4 pbg[2], pbl[2];
    __device__ __forceinline__ void epi_prefetch(const pg8::Unit& u, int wr, int wc, int fr, int fq) {
        const int e = TILEEXP[u.pm];
        const int row0 = u.pm * 256 + wr * 64 + fr, col0 = u.pn * 128 + wc * 32 + 8 * fq;
        const float* bg = bup + (size_t)e * 2048 + col0; const float* bl = bg + 1024;
#pragma unroll
        for (int ai = 0; ai < 2; ++ai)
#pragma unroll
            for (int m = 0; m < 4; ++m) asm volatile("global_load_dword %0, %1, off" : "=v"(ps[ai * 4 + m]) : "v"(ROWSCALE + row0 + ai * 128 + m * 16) : "memory");
#pragma unroll
        for (int n = 0; n < 2; ++n) { asm volatile("global_load_dwordx4 %0, %1, off" : "=v"(pbg[n]) : "v"(bg + 4 * n) : "memory"); asm volatile("global_load_dwordx4 %0, %1, off" : "=v"(pbl[n]) : "v"(bl + 4 * n) : "memory"); }
    }
    __device__ __forceinline__ void epi(f32x4 (&acc)[2][2][4][2], const pg8::Unit& u, int wr, int wc, int fr, int fq) {
        const int row0 = u.pm * 256 + wr * 64 + fr, col0 = u.pn * 128 + wc * 32 + 8 * fq;
        asm volatile("" : "+v"(ps[0]), "+v"(ps[1]), "+v"(ps[2]), "+v"(ps[3]), "+v"(ps[4]), "+v"(ps[5]), "+v"(ps[6]), "+v"(ps[7]), "+v"(pbg[0]), "+v"(pbg[1]), "+v"(pbl[0]), "+v"(pbl[1]));
        f32x4 bg4[2], bl1[2];
#pragma unroll
        for (int n = 0; n < 2; ++n) { bg4[n] = pbg[n] * 4.0f; bl1[n] = pbl[n] + 1.0f; }
        constexpr float CS = -2.4554669595f * 0.25f;
#pragma unroll
        for (int ai = 0; ai < 2; ++ai) {
            u32x2 w8[4];
#pragma unroll
            for (int m = 0; m < 4; ++m) {
                const float rs = ps[ai * 4 + m], rs4 = rs * 4.0f;
                f32x4 av[2];
#pragma unroll
                for (int n = 0; n < 2; ++n) {
                    f32x4 G = acc[ai][0][m][n] * rs4 + bg4[n], L = acc[ai][1][m][n] * rs + bl1[n], E;
#pragma unroll
                    for (int j = 0; j < 4; ++j) { G[j] = fminf(G[j], 28.0f); L[j] = __builtin_amdgcn_fmed3f(L[j], -6.0f, 8.0f); }
                    const f32x4 X = G * CS;
#pragma unroll
                    for (int j = 0; j < 4; ++j) E[j] = __builtin_amdgcn_exp2f(X[j]);
                    E = E + 1.0f;
#pragma unroll
                    for (int j = 0; j < 4; ++j) E[j] = __builtin_amdgcn_rcpf(E[j]);
                    av[n] = G * E * L;
                }
                w8[m].x = pk4_fp8(av[0][0], av[0][1], av[0][2], av[0][3]); w8[m].y = pk4_fp8(av[1][0], av[1][1], av[1][2], av[1][3]);
            }
            const bool odd = fq & 1;
#pragma unroll
            for (int mp = 0; mp < 2; ++mp) {
                const u32x2 snd = odd ? w8[2 * mp] : w8[2 * mp + 1], own = odd ? w8[2 * mp + 1] : w8[2 * mp];
                u32x2 rcv; rcv.x = (unsigned)__shfl_xor((int)snd.x, 16); rcv.y = (unsigned)__shfl_xor((int)snd.y, 16);
                const u32x4 w = odd ? (u32x4){rcv.x, rcv.y, own.x, own.y} : (u32x4){own.x, own.y, rcv.x, rcv.y};
                const int row = row0 + ai * 128 + (2 * mp + (odd ? 1 : 0)) * 16;
                *(u32x4*)((unsigned char*)ACT + (size_t)row * 1024 + u.pn * 128 + wc * 32 + 16 * (fq >> 1)) = w;
            }
        }
    }
};
struct PUpNoDma : PUp { static constexpr bool NODMA = (GEMM_PROBE_KIND & 1) != 0, NOEPI = (GEMM_PROBE_KIND & 2) != 0; };
struct PDown : PBase {
    static constexpr int K = 1024, BROW64 = 2; static constexpr bool FP8 = DN_FP8; static constexpr int ES = DN_FP8 ? 1 : 2;
    static constexpr int SCALE_AB = 0x7d79;
    MoeOrder<4> mo; const char* A; const char* B; const int* TILEEXP; const float* bdn; const float* ROWGATE; bf16_t* YB;
    __device__ __forceinline__ bool next(int i, pg8::Unit& u) const { return mo.next(i, u); }
    __device__ __forceinline__ const char* a_base() const { return A; }
    __device__ __forceinline__ void a_offs(const pg8::Unit& u, int R0, int C0, int R1, int C1, unsigned (&vo)[2][2], bool) const {
#pragma unroll
        for (int h = 0; h < 2; ++h) { vo[h][0] = (unsigned)((u.pm * 256 + 128 * h + R0) * K * ES + 2 * C0); vo[h][1] = (unsigned)((u.pm * 256 + 128 * h + R1) * K * ES + 2 * C1); }
    }
    __device__ __forceinline__ void b_ptrs(const pg8::Unit& u, const char*& b0, const char*& b1) const {
        const int e = TILEEXP[u.pm]; b0 = B + ((size_t)e * 1024 + (size_t)u.pn * 256) * K * ES; b1 = b0 + (size_t)8 * K * ES; }
    float pg[8]; f32x4 pb[2][2];
    __device__ __forceinline__ void epi_prefetch(const pg8::Unit& u, int wr, int wc, int fr, int fq) {
        const int e = TILEEXP[u.pm];
        const int row0 = u.pm * 256 + wr * 64 + fr, col0 = u.pn * 256 + wc * 64 + 16 * fq;
        const float* bp = bdn + (size_t)e * 1024 + col0;
#pragma unroll
        for (int ai = 0; ai < 2; ++ai)
#pragma unroll
            for (int m = 0; m < 4; ++m) asm volatile("global_load_dword %0, %1, off" : "=v"(pg[ai * 4 + m]) : "v"(ROWGATE + row0 + ai * 128 + m * 16) : "memory");
#pragma unroll
        for (int bj = 0; bj < 2; ++bj)
#pragma unroll
            for (int n = 0; n < 2; ++n) asm volatile("global_load_dwordx4 %0, %1, off" : "=v"(pb[bj][n]) : "v"(bp + 8 * bj + 4 * n) : "memory");
    }
    __device__ __forceinline__ void epi(f32x4 (&acc)[2][2][4][2], const pg8::Unit& u, int wr, int wc, int fr, int fq) {
        const int row0 = u.pm * 256 + wr * 64 + fr, col0 = u.pn * 256 + wc * 64 + 16 * fq;
        asm volatile("" : "+v"(pg[0]), "+v"(pg[1]), "+v"(pg[2]), "+v"(pg[3]), "+v"(pg[4]), "+v"(pg[5]), "+v"(pg[6]), "+v"(pg[7]), "+v"(pb[0][0]), "+v"(pb[0][1]), "+v"(pb[1][0]), "+v"(pb[1][1]));
#pragma unroll
        for (int ai = 0; ai < 2; ++ai)
#pragma unroll
            for (int m = 0; m < 4; ++m) { const int row = row0 + ai * 128 + m * 16; const float gt = pg[ai * 4 + m] * 16.f;
                const f32x4 v00 = (acc[ai][0][m][0] + pb[0][0]) * gt, v01 = (acc[ai][0][m][1] + pb[0][1]) * gt, v10 = (acc[ai][1][m][0] + pb[1][0]) * gt, v11 = (acc[ai][1][m][1] + pb[1][1]) * gt;
                u32x4 w; w.x = pk4_fp8(v00[0], v00[1], v00[2], v00[3]); w.y = pk4_fp8(v01[0], v01[1], v01[2], v01[3]); w.z = pk4_fp8(v10[0], v10[1], v10[2], v10[3]); w.w = pk4_fp8(v11[0], v11[1], v11[2], v11[3]);
                *(u32x4*)((unsigned char*)YB + (size_t)row * 1024 + col0) = w; }
    }
};

struct TItem { const float* src; bf16_t* dst; const float* ksc; int N, K; unsigned char* dst8; };
__device__ __forceinline__ void titem_load(const TItem& it, f32x4 (&v)[16], int lane) {
    const float* p = it.src + (size_t)(lane >> 4) * it.N + 4 * (lane & 15);
#pragma unroll
    for (int i = 0; i < 16; ++i) v[i] = *(const f32x4*)(p + (size_t)(4 * i) * it.N);
}
__device__ __forceinline__ void titem_store(const TItem& it, f32x4 (&v)[16], LAS float* scr, int lane) {
    if (it.ksc) {
#pragma unroll
        for (int i = 0; i < 16; ++i) v[i] *= it.ksc[4 * i + (lane >> 4)];
    }
#pragma unroll
    for (int i = 0; i < 16; ++i) { LAS float* d = scr + (4 * i + (lane >> 4)) * 65 + 4 * (lane & 15); d[0] = v[i][0]; d[1] = v[i][1]; d[2] = v[i][2]; d[3] = v[i][3]; }
    asm volatile("s_waitcnt lgkmcnt(0)" ::: "memory");
    if (it.dst8) {
        const int c = lane & 3;
#pragma unroll
        for (int j = 0; j < 4; ++j) { const int n = (lane >> 2) + 16 * j; const LAS float* s = scr + (16 * c) * 65 + n;
            u32x4 o;
            o.x = pk4_fp8(s[0 * 65] * 64.f, s[1 * 65] * 64.f, s[2 * 65] * 64.f, s[3 * 65] * 64.f); o.y = pk4_fp8(s[4 * 65] * 64.f, s[5 * 65] * 64.f, s[6 * 65] * 64.f, s[7 * 65] * 64.f);
            o.z = pk4_fp8(s[8 * 65] * 64.f, s[9 * 65] * 64.f, s[10 * 65] * 64.f, s[11 * 65] * 64.f); o.w = pk4_fp8(s[12 * 65] * 64.f, s[13 * 65] * 64.f, s[14 * 65] * 64.f, s[15 * 65] * 64.f);
            *(u32x4*)(it.dst8 + (size_t)n * it.K + 16 * c) = o; }
    } else {
        const int c = lane & 7;
#pragma unroll
        for (int j = 0; j < 8; ++j) { const int n = (lane >> 3) + 8 * j; const LAS float* s = scr + (8 * c) * 65 + n;
            u32x4 o; o.x = pk2(s[0 * 65], s[1 * 65]); o.y = pk2(s[2 * 65], s[3 * 65]); o.z = pk2(s[4 * 65], s[5 * 65]); o.w = pk2(s[6 * 65], s[7 * 65]);
            *(u32x4*)(it.dst + (size_t)n * it.K + 8 * c) = o; }
    }
    asm volatile("s_waitcnt lgkmcnt(0)" ::: "memory");
}
__device__ __forceinline__ void rms_row_to_bf16(const f32x4 (&v)[4], const float* g, bf16_t* orow, int lane) {
    float s = 0.f;
#pragma unroll
    for (int j = 0; j < 4; ++j) s += (v[j][0] * v[j][0] + v[j][1] * v[j][1]) + (v[j][2] * v[j][2] + v[j][3] * v[j][3]);
    const float r = rsqrtf(wave_sum(s) * (1.f / D) + EPS);
#pragma unroll
    for (int j = 0; j < 4; ++j) { const f32x4 gg = *(const f32x4*)(g + 4 * lane + 256 * j); const f32x4 o = v[j] * gg * r;
        u32x2 w; w.x = cvt_pk_bf16(o[0], o[1]); w.y = cvt_pk_bf16(o[2], o[3]); *(u32x2*)(orow + 4 * lane + 256 * j) = w; }
}
struct Cplx { float re, im; };
__device__ __forceinline__ Cplx cmul(Cplx a, Cplx b) { return Cplx{a.re * b.re - a.im * b.im, a.re * b.im + a.im * b.re}; }
__device__ __forceinline__ Cplx lam_pow(float lr, float li, float step, int n) {
    const float mag = expf((float)n * lr * step); const double ang = (double)n * (double)li * (double)step;
    return Cplx{mag * (float)cos(ang), mag * (float)sin(ang)};
}
__device__ __forceinline__ Cplx lam_pow_fast(float lr, float li, float step, int n) {
    const float mag = __expf((float)n * lr * step); const double rev = (double)n * (double)li * (double)step * 0.15915494309189535; const float fr = (float)(rev - floor(rev));
    return Cplx{mag * __builtin_amdgcn_cosf(fr), mag * __builtin_amdgcn_sinf(fr)};
}
__device__ __forceinline__ Cplx bbar_factor(float lr, float li, float step) {
    const Cplx lb = lam_pow(lr, li, step, 1); const float nr = lb.re - 1.f, ni = lb.im, den = lr * lr + li * li;
    return Cplx{(nr * lr + ni * li) / den, (ni * lr - nr * li) / den};
}
template <int PMODE> __device__ __forceinline__ void p0_prologue(Frame& F) {
    const int gw = F.bx * NWAVES + F.wave, NGW = F.G * NWAVES, lane = F.lane;
    const int gt = F.bx * NTHREADS + F.tid, NGT = F.G * NTHREADS;
    unsigned char* ws = F.ws;
    if (!(PMODE & 1)) {
        LAS float* scr = (LAS float*)(F.lds + LDS_RING) + F.wave * (64 * 65);
        constexpr int I_UP = UP_FP8 ? 0 : 32 * 16 * 32, I_DN = DN_FP8 ? 0 : 32 * 16 * 16, I_IN = 16 * 32, I_OUT = 16 * 16, I_GLU = 8 * 8;
        constexpr int PER_L = I_UP + I_DN + I_IN + I_OUT + I_GLU, TOTAL = DEPTH * PER_L;
        auto decode = [&](int it) -> TItem {
            TItem ti; const int l = it / PER_L; int r = it % PER_L; const float* W; bf16_t* WT; int K, N; ti.ksc = nullptr; bool f8 = false;
            if (r < I_UP) { const int e = r / 512; r %= 512; K = 1024; N = 2048; W = arg_in(24) + ((size_t)l * NE + e) * 1024 * 2048; WT = (bf16_t*)(ws + WS_WUP + l * WUP_STRIDE) + (size_t)e * 2048 * 1024 / (UP_FP8 ? 2 : 1); f8 = UP_FP8; }
            else if ((r -= I_UP) < I_DN) { const int e = r / 256; r %= 256; K = 1024; N = 1024; W = arg_in(26) + ((size_t)l * NE + e) * 1024 * 1024; WT = (bf16_t*)(ws + WS_WDN + l * WDN_STRIDE) + (size_t)e * 1024 * 1024 / (DN_FP8 ? 2 : 1); f8 = DN_FP8; }
            else if ((r -= I_DN) < I_IN) { K = 1024; N = 2048; W = arg_in(2) + (size_t)l * 1024 * 2048; WT = (bf16_t*)(ws + WS_WIN + l * WIN_STRIDE); }
            else if ((r -= I_IN) < I_OUT) { K = 1024; N = 1024; W = arg_in(20) + (size_t)l * 1024 * 1024; WT = (bf16_t*)(ws + WS_WOUT + l * WOUT_STRIDE); if ((r / 16) * 64 < DS) ti.ksc = arg_in(12) + l * DS + (r / 16) * 64; }
            else { r -= I_OUT; K = 512; N = 512; W = arg_in(11) + (size_t)l * 512 * 512; WT = (bf16_t*)(ws + WS_WGLU + l * WGLU_STRIDE); }
            const int nblk = N / 64, k0 = 64 * (r / nblk), n0 = 64 * (r % nblk);
            ti.src = W + (size_t)k0 * N + n0; ti.dst = WT + (size_t)n0 * K + k0; ti.N = N; ti.K = K; ti.dst8 = f8 ? (unsigned char*)WT + (size_t)n0 * K + k0 : nullptr; return ti;
        };
        f32x4 va[16]; TItem ia;
        for (int it = gw; it < TOTAL; it += NGW) { ia = decode(it); titem_load(ia, va, lane); titem_store(ia, va, scr, lane); }
    }
    if (!(PMODE & 1) && (UP_FP8 || DN_FP8)) {
        LAS float* tile = (LAS float*)(F.lds + LDS_RING);
        constexpr int C_UP = UP_FP8 ? 32 * 8 * 8 : 0, C_DN = DN_FP8 ? 32 * 8 * 4 : 0, C_PER_L = C_UP + C_DN, C_TOTAL = DEPTH * C_PER_L;
        auto cdecode = [&](int it, const float*& src, unsigned char*& dst, int& N) {
            const int l = it / C_PER_L; int r = it % C_PER_L; const float* W; unsigned char* WT;
            if (r < C_UP) { const int e = r >> 6; r &= 63; N = 2048; W = arg_in(24) + ((size_t)l * NE + e) * 1024 * 2048; WT = ws + WS_WUP + l * WUP_STRIDE + (size_t)e * 2048 * 1024; }
            else { r -= C_UP; const int e = r >> 5; r &= 31; N = 1024; W = arg_in(26) + ((size_t)l * NE + e) * 1024 * 1024; WT = ws + WS_WDN + l * WDN_STRIDE + (size_t)e * 1024 * 1024; }
            const int nblk = N >> 8, k0 = 128 * (r / nblk), n0 = 256 * (r % nblk);
            src = W + (size_t)k0 * N + n0; dst = WT + (size_t)n0 * 1024 + k0;
        };
        auto cload = [&](const float* src, int N, f32x4 (&v)[16]) {
            const float* p = src + (size_t)F.wave * N + 4 * lane;
#pragma unroll
            for (int i = 0; i < 16; ++i) v[i] = *(const f32x4*)(p + (size_t)(8 * i) * N);
        };
        auto cstore = [&](unsigned char* dst, f32x4 (&v)[16]) {
            __syncthreads();
#pragma unroll
            for (int i = 0; i < 16; ++i) *(LAS f32x4*)(tile + (8 * i + F.wave) * 260 + 4 * lane) = v[i];
            __syncthreads();
            const int n = F.tid & 255, cc = F.tid >> 8;
#pragma unroll
            for (int j = 0; j < 4; ++j) { const int c = 2 * j + cc; const LAS float* sp = tile + (16 * c) * 260 + n;
                u32x4 o;
                o.x = pk4_fp8(sp[0 * 260] * 64.f, sp[1 * 260] * 64.f, sp[2 * 260] * 64.f, sp[3 * 260] * 64.f); o.y = pk4_fp8(sp[4 * 260] * 64.f, sp[5 * 260] * 64.f, sp[6 * 260] * 64.f, sp[7 * 260] * 64.f);
                o.z = pk4_fp8(sp[8 * 260] * 64.f, sp[9 * 260] * 64.f, sp[10 * 260] * 64.f, sp[11 * 260] * 64.f); o.w = pk4_fp8(sp[12 * 260] * 64.f, sp[13 * 260] * 64.f, sp[14 * 260] * 64.f, sp[15 * 260] * 64.f);
                *(u32x4*)(dst + (size_t)n * 1024 + 16 * c) = o; }
        };
        f32x4 va[16], vb[16]; const float* sa; const float* sb; unsigned char* da; unsigned char* db; int na, nb;
        int it = F.bx;
        if (it < C_TOTAL) { cdecode(it, sa, da, na); cload(sa, na, va); }
        while (it < C_TOTAL) {
            const int itb = it + F.G;
            if (itb < C_TOTAL) { cdecode(itb, sb, db, nb); cload(sb, nb, vb); }
            cstore(da, va);
            if (itb >= C_TOTAL) break;
            const int itc = itb + F.G;
            if (itc < C_TOTAL) { cdecode(itc, sa, da, na); cload(sa, na, va); }
            cstore(db, vb);
            it = itc;
        }
        __syncthreads();
    }
    phase_begin(F); ws = F.ws;
    for (int i = F.bx * NTHREADS + F.tid; i < SEQ * 32; i += NGT) {
        const int s = i >> 5, j = i & 31;
        const float inv = 1.0f / powf(10000.0f, (float)(2 * j) / 64.0f);
        const float ang = (float)s * inv;
        ((float*)(ws + WS_COS))[i] = (float)cos((double)ang); ((float*)(ws + WS_SIN))[i] = (float)sin((double)ang);
    }
    if (F.bx == 0 && F.wave < DEPTH) {
        const int l = F.wave;
        float a = arg_in(15)[l * 64 + lane] * arg_in(16)[l * 64 + lane], b = arg_in(17)[l * 64 + lane] * arg_in(18)[l * 64 + lane];
        a = wave_sum(a); b = wave_sum(b);
        float mq = fabsf(arg_in(13)[l * 64 + lane]), mk = fabsf(arg_in(14)[l * 64 + lane]);
#pragma unroll
        for (int o = 1; o < 64; o <<= 1) { mq = fmaxf(mq, __shfl_xor(mq, o)); mk = fmaxf(mk, __shfl_xor(mk, o)); }
        const float lambda_init = 0.8f - 0.6f * expf(-0.3f * (float)l);
        { float* gqk = (float*)(ws + WS_SCAL) + 64 + l * 128; gqk[lane] = arg_in(13)[l * 64 + lane]; gqk[64 + lane] = arg_in(14)[l * 64 + lane]; }
        if (lane == 0) { float* sc = (float*)(ws + WS_SCAL) + l * 4; sc[0] = expf(a) - expf(b) + lambda_init; sc[1] = C2 * 64.f * mq * mk * 1.02f + 0.5f; sc[2] = 1.0f - lambda_init; }
    }
    for (int i = gt; i < DEPTH * NE * D; i += NGT) {
        const int l = i / (NE * D), e = (i / D) % NE, k = i % D;
        const float w = arg_in(22)[(size_t)l * D * NE + (size_t)k * NE + e];
        const unsigned hi = f2bf(w); const float lo = w - __builtin_bit_cast(float, hi << 16);
        bf16_t* t = (bf16_t*)(ws + WS_WRT + l * WRT_STRIDE);
        t[e * D + k] = (bf16_t)hi; t[NE * D + e * D + k] = (bf16_t)f2bf(lo);
    }
    phase_begin(F); ws = F.ws;
#define TBL_PTRS(l) const float* lam_re = arg_in(3) + (l) * NG * NP; const float* lam_im = arg_in(4) + (l) * NG * NP; const float* log_step = arg_in(5) + (l) * NG; \
        const float* b_re = arg_in(6) + (size_t)(l) * NG * NP * HS; const float* b_im = arg_in(7) + (size_t)(l) * NG * NP * HS; \
        const float* c_re = arg_in(8) + (size_t)(l) * NG * HS * NP; const float* c_im = arg_in(9) + (size_t)(l) * NG * HS * NP; \
        bf16_t* KT = (bf16_t*)(ws + WS_KT + (l) * KT_STRIDE); bf16_t* HT = (bf16_t*)(ws + WS_HT + (l) * HT_STRIDE); (void)KT; (void)HT; (void)b_re; (void)b_im
    if (!(PMODE & 2)) {
        {
            LAS float* pwl = (LAS float*)(F.lds + LDS_RING);
            for (int cb = F.bx; cb < DEPTH * NG * 17; cb += F.G) {
                const int l = cb / (NG * 17), rb = cb % (NG * 17);
                if (rb >= NG * 9) continue;
                const int blk = rb;
                TBL_PTRS(l);
                const int g = blk / 9, s0 = (blk % 9) * 8;
                const float step = expf(log_step[g]);
                LAS float* cgl = pwl + 1024;
                LAS float* ffl = cgl + 2048;
                LAS float* bgl = ffl + 128;
                __syncthreads();
                { const int p = F.tid & 63, sl = F.tid >> 6, slot = s0 + sl; Cplx w{0.f, 0.f};
                  if (slot >= 1 && slot <= 64) w = lam_pow_fast(lam_re[g * NP + p], lam_im[g * NP + p], step, slot - 1);
                  pwl[(sl * 64 + p) * 2] = w.re; pwl[(sl * 64 + p) * 2 + 1] = w.im; }
                for (int idx = F.tid; idx < 1024; idx += NTHREADS) { cgl[2 * idx] = c_re[(size_t)g * HS * NP + idx]; cgl[2 * idx + 1] = c_im[(size_t)g * HS * NP + idx]; }
                if (F.tid < 64) { const Cplx f = bbar_factor(lam_re[g * NP + F.tid], lam_im[g * NP + F.tid], step); ffl[2 * F.tid] = f.re; ffl[2 * F.tid + 1] = f.im; }
                __syncthreads();
                for (int idx = F.tid; idx < 1024; idx += NTHREADS) { const int p = idx >> 4; const Cplx w = cmul(Cplx{ffl[2 * p], ffl[2 * p + 1]}, Cplx{b_re[(size_t)g * NP * HS + idx], b_im[(size_t)g * NP * HS + idx]}); bgl[2 * idx] = w.re; bgl[2 * idx + 1] = w.im; }
                __syncthreads();
                const int pq = F.tid & 3, h = (F.tid >> 2) & 15, sl = F.tid >> 6, slot = s0 + sl;
                float accv[16];
#pragma unroll
                for (int q = 0; q < 16; ++q) accv[q] = 0.f;
                for (int pp = 0; pp < 16; ++pp) {
                    const int p = pq * 16 + pp;
                    const Cplx w = cmul(Cplx{cgl[(h * 64 + p) * 2], cgl[(h * 64 + p) * 2 + 1]}, Cplx{pwl[(sl * 64 + p) * 2], pwl[(sl * 64 + p) * 2 + 1]});
                    const LAS f32x4* bp = (const LAS f32x4*)(bgl + p * 32);
#pragma unroll
                    for (int q2 = 0; q2 < 8; ++q2) { const f32x4 bb = bp[q2]; accv[2 * q2] += w.re * bb[0] - w.im * bb[1]; accv[2 * q2 + 1] += w.re * bb[2] - w.im * bb[3]; }
                }
#pragma unroll
                for (int q = 0; q < 16; ++q) { accv[q] += __shfl_xor(accv[q], 1); accv[q] += __shfl_xor(accv[q], 2); }
                if (pq == 0 && slot <= 64) {
                    u32x4 o0, o1; o0.x = pk2(accv[0], accv[1]); o0.y = pk2(accv[2], accv[3]); o0.z = pk2(accv[4], accv[5]); o0.w = pk2(accv[6], accv[7]);
                    o1.x = pk2(accv[8], accv[9]); o1.y = pk2(accv[10], accv[11]); o1.z = pk2(accv[12], accv[13]); o1.w = pk2(accv[14], accv[15]);
                    u32x4* dst = (u32x4*)(KT + ((size_t)(g * 65 + slot) * HS + h) * 16); dst[0] = o0; dst[1] = o1;
                }
            }
            for (int cb = F.bx; cb < DEPTH * NG * 17; cb += F.G) {
                const int l = cb / (NG * 17), rb = cb % (NG * 17);
                if (rb < NG * 9) continue;
                const int blk = rb - NG * 9;
                TBL_PTRS(l);
                const int g = blk >> 3, t0 = (blk & 7) * 8;
                const float step = expf(log_step[g]);
                __syncthreads();
                LAS float* cgl = pwl + 1024;
                { const int p = F.tid & 63, tl = F.tid >> 6; const Cplx w = lam_pow_fast(lam_re[g * NP + p], lam_im[g * NP + p], step, t0 + tl + 1); pwl[(tl * 64 + p) * 2] = w.re; pwl[(tl * 64 + p) * 2 + 1] = w.im; }
                for (int idx = F.tid; idx < 1024; idx += NTHREADS) { cgl[2 * idx] = c_re[(size_t)g * HS * NP + idx]; cgl[2 * idx + 1] = c_im[(size_t)g * HS * NP + idx]; }
                __syncthreads();
                const int pq = F.tid & 3, h = (F.tid >> 2) & 15, tl = F.tid >> 6, t = t0 + tl;
                bf16_t* dst = HT + ((size_t)(g * 1024 + t * 16 + h) * 128 + pq * 32);
                for (int pp = 0; pp < 16; pp += 4) {
                    float v[8];
#pragma unroll
                    for (int q = 0; q < 4; ++q) { const int p = pq * 16 + pp + q;
                        const Cplx w = cmul(Cplx{cgl[(h * 64 + p) * 2], cgl[(h * 64 + p) * 2 + 1]}, Cplx{pwl[(tl * 64 + p) * 2], pwl[(tl * 64 + p) * 2 + 1]});
                        v[2 * q] = w.re; v[2 * q + 1] = -w.im; }
                    u32x4 o; o.x = pk2(v[0], v[1]); o.y = pk2(v[2], v[3]); o.z = pk2(v[4], v[5]); o.w = pk2(v[6], v[7]);
                    *(u32x4*)(dst + 2 * pp) = o;
                }
            }
            __syncthreads();
        }
    }
#undef TBL_PTRS
    if (!(PMODE & 2)) for (int l = 0; l < DEPTH; ++l) {
        const float* lam_re = arg_in(3) + l * NG * NP; const float* lam_im = arg_in(4) + l * NG * NP; const float* log_step = arg_in(5) + l * NG;
        const float* b_re = arg_in(6) + (size_t)l * NG * NP * HS; const float* b_im = arg_in(7) + (size_t)l * NG * NP * HS;
        const float* c_re = arg_in(8) + (size_t)l * NG * HS * NP; const float* c_im = arg_in(9) + (size_t)l * NG * HS * NP;
        bf16_t* KT = (bf16_t*)(ws + WS_KT + l * KT_STRIDE); bf16_t* GT = (bf16_t*)(ws + WS_GT + l * GT_STRIDE); bf16_t* HT = (bf16_t*)(ws + WS_HT + l * HT_STRIDE);
        float* LAML = (float*)(ws + WS_LAML + l * LAML_STRIDE);
        for (int i = gt; i < NG * NP * 64; i += NGT) {
            const int s = i % 64, p = (i / 64) % NP, g = i / (64 * NP);
            const float step = expf(log_step[g]); const float lr = lam_re[g * NP + p], li = lam_im[g * NP + p];
            const Cplx w = cmul(lam_pow_fast(lr, li, step, 63 - s), bbar_factor(lr, li, step));
            float vr[16], vi[16];
#pragma unroll
            for (int q = 0; q < 16; ++q) { const float br = b_re[(size_t)(g * NP + p) * HS + q], bi = b_im[(size_t)(g * NP + p) * HS + q]; vr[q] = w.re * br - w.im * bi; vi[q] = w.re * bi + w.im * br; }
            u32x4* dr = (u32x4*)(GT + ((size_t)(g * 128 + 2 * p) * 1024 + s * 16)); u32x4* di = (u32x4*)(GT + ((size_t)(g * 128 + 2 * p + 1) * 1024 + s * 16));
            u32x4 o; o.x = pk2(vr[0], vr[1]); o.y = pk2(vr[2], vr[3]); o.z = pk2(vr[4], vr[5]); o.w = pk2(vr[6], vr[7]); dr[0] = o;
            o.x = pk2(vr[8], vr[9]); o.y = pk2(vr[10], vr[11]); o.z = pk2(vr[12], vr[13]); o.w = pk2(vr[14], vr[15]); dr[1] = o;
            o.x = pk2(vi[0], vi[1]); o.y = pk2(vi[2], vi[3]); o.z = pk2(vi[4], vi[5]); o.w = pk2(vi[6], vi[7]); di[0] = o;
            o.x = pk2(vi[8], vi[9]); o.y = pk2(vi[10], vi[11]); o.z = pk2(vi[12], vi[13]); o.w = pk2(vi[14], vi[15]); di[1] = o;
        }
        for (int i = gt; i < NG * NP; i += NGT) { const int g = i / NP; const Cplx w = lam_pow(lam_re[i], lam_im[i], expf(log_step[g]), 64); LAML[2 * i] = w.re; LAML[2 * i + 1] = w.im; }
    }
    {
        const float* xin = arg_in(0); const float* g0 = arg_in(1); bf16_t* XN = (bf16_t*)(ws + WS_XN);
        f32x4 va[4], vb[4];
        int m = gw;
        if (m < T) {
#pragma unroll
            for (int j = 0; j < 4; ++j) va[j] = ((const f32x4*)(xin + (size_t)m * D) + lane)[64 * j]; }
        while (m < T) {
            const int mb = m + NGW;
            if (mb < T) {
#pragma unroll
                for (int j = 0; j < 4; ++j) vb[j] = ((const f32x4*)(xin + (size_t)mb * D) + lane)[64 * j]; }
            rms_row_to_bf16(va, g0, XN + (size_t)m * D, lane);
            if (mb >= T) break;
            const int mc = mb + NGW;
            if (mc < T) {
#pragma unroll
                for (int j = 0; j < 4; ++j) va[j] = ((const f32x4*)(xin + (size_t)mc * D) + lane)[64 * j]; }
            rms_row_to_bf16(vb, g0, XN + (size_t)mb * D, lane);
            m = mc;
        }
    }
}

__device__ __forceinline__ void s5a_phase(Frame& F, int l) {
    const bf16_t* GT = (const bf16_t*)(F.ws + WS_GT + l * GT_STRIDE); const bf16_t* U = (const bf16_t*)(F.ws + WS_U); float* S = (float*)(F.ws + WS_S);
    const int lane = F.lane, n = lane & 15, kq = lane >> 4;
    for (int uu = F.bx * NWAVES + F.wave; uu < NG * 32 * 2; uu += F.G * NWAVES) {
        const int g = uu >> 6, ntile = (uu >> 1) & 31, mh = uu & 1;
        const int chunk = ntile * 16 + n;
        const bf16_t* up = U + ((size_t)chunk * 64 + (kq >> 1)) * DS + g * 16 + 8 * (kq & 1);
        const bf16_t* gp = GT + ((size_t)(g * 128 + mh * 64 + n) * 1024 + 8 * kq);
        f32x4 acc[4];
#pragma unroll
        for (int mt = 0; mt < 4; ++mt) acc[mt] = (f32x4){0.f, 0.f, 0.f, 0.f};
#pragma unroll 4
        for (int ks = 0; ks < 32; ++ks) {
            const bf16x8 b = *(const bf16x8*)(up + (size_t)(2 * ks) * DS);
#pragma unroll
            for (int mt = 0; mt < 4; ++mt) { const bf16x8 a = *(const bf16x8*)(gp + (size_t)(mt * 16) * 1024 + 32 * ks); acc[mt] = __builtin_amdgcn_mfma_f32_16x16x32_bf16(a, b, acc[mt], 0, 0, 0); }
        }
#pragma unroll
        for (int mt = 0; mt < 4; ++mt) *(f32x4*)(S + ((size_t)chunk * NG + g) * 128 + mh * 64 + mt * 16 + 4 * kq) = acc[mt];
    }
}
__device__ __forceinline__ void s5c_phase(Frame& F, int l) {
    const bf16_t* KT = (const bf16_t*)(F.ws + WS_KT + l * KT_STRIDE); const bf16_t* HT = (const bf16_t*)(F.ws + WS_HT + l * HT_STRIDE);
    const float* LAML = (const float*)(F.ws + WS_LAML + l * LAML_STRIDE); const float* S = (const float*)(F.ws + WS_S);
    const bf16_t* U = (const bf16_t*)(F.ws + WS_U); bf16_t* YG = (bf16_t*)(F.ws + WS_YG); const float* dsk = arg_in(10) + l * DS;
    const int lane = F.lane, n = lane & 15, kq = lane >> 4, wave = F.wave;
    LAS unsigned char* ktl = F.lds + LDS_RING;
    LAS unsigned char* xs = F.lds + LDS_RING + 33792 + wave * 4096;
    LAS f32x2* EB = (LAS f32x2*)(F.lds + LDS_RING + 33792 + 8 * 4096);
    LAS f32x2* EH = EB + 512;
    for (int wu = F.bx; wu < NG * 8; wu += F.G) {
        const int g = wu >> 3, scq = wu & 7, b = scq >> 1, cbase = (scq & 1) * 64, scl = wave >> 1, par = wave & 1;
        __syncthreads();
        for (int i = F.tid; i < 65 * 32; i += NTHREADS) *(LAS u32x4*)(ktl + i * 16) = *(const u32x4*)(KT + (size_t)g * 65 * 256 + i * 8);
        const Cplx L = Cplx{LAML[(g * NP + lane) * 2], LAML[(g * NP + lane) * 2 + 1]};
        const float* sp = S + ((size_t)(b * CPB) * NG + g) * 128 + 2 * lane;
        {
            f32x2 sv[8];
#pragma unroll
            for (int j = 0; j < 8; ++j) sv[j] = *(const f32x2*)(sp + (size_t)(cbase + 8 * wave + j) * NG * 128);
            Cplx E{0.f, 0.f};
#pragma unroll
            for (int j = 0; j < 8; ++j) { const Cplx nx = cmul(L, E); E.re = nx.re + sv[j][0]; E.im = nx.im + sv[j][1]; }
            EB[wave * 64 + lane] = (f32x2){E.re, E.im};
            if (cbase) {
#pragma unroll
                for (int j = 0; j < 8; ++j) sv[j] = *(const f32x2*)(sp + (size_t)(8 * wave + j) * NG * 128);
                Cplx H{0.f, 0.f};
#pragma unroll
                for (int j = 0; j < 8; ++j) { const Cplx nx = cmul(L, H); H.re = nx.re + sv[j][0]; H.im = nx.im + sv[j][1]; }
                EH[wave * 64 + lane] = (f32x2){H.re, H.im};
            }
        }
        __syncthreads();
        const int c0 = cbase + 16 * scl;
        {
            const Cplx L2 = cmul(L, L), L4 = cmul(L2, L2), L8 = cmul(L4, L4);
            Cplx X{0.f, 0.f};
            if (cbase) {
#pragma unroll
                for (int w = 0; w < 8; ++w) { const f32x2 e = EH[w * 64 + lane]; const Cplx nx = cmul(L8, X); X.re = nx.re + e[0]; X.im = nx.im + e[1]; }
            }
            for (int w = 0; w < 2 * scl; ++w) { const f32x2 e = EB[w * 64 + lane]; const Cplx nx = cmul(L8, X); X.re = nx.re + e[0]; X.im = nx.im + e[1]; }
            f32x2 sv[16];
#pragma unroll
            for (int j = 0; j < 16; ++j) sv[j] = *(const f32x2*)(sp + (size_t)(c0 + j) * NG * 128);
#pragma unroll
            for (int j = 0; j < 16; ++j) {
                *(LAS unsigned*)(xs + j * 256 + 4 * lane) = pk2(X.re, X.im);
                const Cplx nx = cmul(L, X); X.re = nx.re + sv[j][0]; X.im = nx.im + sv[j][1];
            }
        }
        const int chunk = b * CPB + c0 + n;
        bf16x8 ub[32];
        {
            const bf16_t* up = U + ((size_t)chunk * 64 + (kq >> 1)) * DS + g * 16 + 8 * (kq & 1);
#pragma unroll
            for (int kp = 0; kp < 32; ++kp) ub[kp] = *(const bf16x8*)(up + (size_t)(2 * kp) * DS);
        }
        const LAS unsigned char* xbp = xs + n * 256 + 16 * kq;
        const f32x4 dv = *(const f32x4*)(dsk + g * 16 + 4 * kq);
        const bf16_t* hp = HT + ((size_t)(g * 1024 + n) * 128 + 8 * kq);
        const bf16_t* uq = U + (size_t)chunk * 64 * DS + g * 16 + 4 * kq;
        const LAS unsigned char* kbase = ktl + (n * 16 + 8 * (kq & 1)) * 2;
        u32x2 uw = *(const u32x2*)(uq + (size_t)par * DS);
        for (int ti = 0; ti < 32; ++ti) {
            const int t = 2 * ti + par, tn = (ti < 31) ? t + 2 : t;
            bf16x8 ha[4];
#pragma unroll
            for (int ks = 0; ks < 4; ++ks) ha[ks] = *(const bf16x8*)(hp + (size_t)(t * 16) * 128 + 32 * ks);
            const u32x2 un = *(const u32x2*)(uq + (size_t)tn * DS);
            f32x4 acc = (f32x4){0.f, 0.f, 0.f, 0.f};
            const int slot0 = t + 1 - (kq >> 1);
#pragma unroll
            for (int kp = 0; kp < 32; ++kp) {
                if (kp <= ti) { const bf16x8 a = *(const LAS bf16x8*)(kbase + (slot0 - 2 * kp) * 512); acc = __builtin_amdgcn_mfma_f32_16x16x32_bf16(a, ub[kp], acc, 0, 0, 0); }
            }
#pragma unroll
            for (int ks = 0; ks < 4; ++ks) acc = __builtin_amdgcn_mfma_f32_16x16x32_bf16(ha[ks], *(const LAS bf16x8*)(xbp + 64 * ks), acc, 0, 0, 0);
            const float y0 = acc[0] + dv[0] * bf_lo(uw.x), y1 = acc[1] + dv[1] * bf_hi(uw.x), y2 = acc[2] + dv[2] * bf_lo(uw.y), y3 = acc[3] + dv[3] * bf_hi(uw.y);
            u32x2 w; w.x = cvt_pk_bf16(gelu_tanh(y0), gelu_tanh(y1)); w.y = cvt_pk_bf16(gelu_tanh(y2), gelu_tanh(y3));
            *(u32x2*)(YG + ((size_t)chunk * 64 + t) * DS + g * 16 + 4 * kq) = w;
            uw = un;
        }
    }
    __syncthreads();
}

namespace att {
constexpr int KSLOT = 16384, VSLOT = 16384, LDS_K = 0, LDS_V = 3 * KSLOT, LDS_WS = 6 * 16384, LDS_END = LDS_WS + 8 * 256;
constexpr int STG_ROW = 136;
__device__ __forceinline__ int crow(int r, int hi) { return (r & 3) + 8 * (r >> 2) + 4 * hi; }
__device__ __forceinline__ void glds16(const void* gsrc, unsigned lds_dst) { unsigned keep;
    asm volatile("s_mov_b32 %0, m0\n\ts_mov_b32 m0, %2\n\ts_nop 0\n\tglobal_load_lds_dwordx4 %1, off\n\ts_mov_b32 m0, %0" : "=&s"(keep) : "v"(gsrc), "s"(lds_dst) : "memory"); }
typedef __attribute__((address_space(3))) const char* lds_cptr;
typedef short v4i16_t __attribute__((ext_vector_type(4)));
__device__ __forceinline__ s16x4 vtr(lds_cptr p) { return __builtin_bit_cast(s16x4, __builtin_amdgcn_ds_read_tr16_b64_v4i16((__attribute__((address_space(3))) v4i16_t*)p)); }
#define ATT_WAIT_BAR(N) asm volatile("s_waitcnt vmcnt(" #N ") lgkmcnt(0)\n\ts_barrier" ::: "memory")

template <int MODE> __device__ __forceinline__ void attn_unit(int bh, int qb, const bf16_t* Q, const bf16_t* K, const bf16_t* V, bf16_t* MIX, const float* subg, float lam, float mshift, float oml,
                                          LAS unsigned char* shm, int tid) {
    const int lane = tid & 63, r32 = lane & 31, hi = lane >> 5; const int wid = __builtin_amdgcn_readfirstlane(tid >> 6);
    const int b = bh >> 2, h = bh & 3, m = wid & 1, qg = wid >> 1;
    const size_t rowbase = (size_t)b * SEQ; const int q0 = qb * 128;
    const int NT = 2 * qb + 2, cw = 2 * qb + (qg >> 1);
    const unsigned lds0 = (unsigned)(uintptr_t)shm;
    const unsigned char* k0src = (const unsigned char*)K + (rowbase + lane) * DA + h * 128 + (wid >> 2) * 64 + ((wid >> 1) & 1) * 32 + (wid & 1) * 16;
    const bf16_t* v0src = V + (rowbase + 16 * (wid & 3) + (lane >> 2)) * DA + h * 128 + (wid >> 2) * 32 + (lane & 3) * 8;
    const bf16_t* v1src = v0src + 64;
    const unsigned kdst = lds0 + LDS_K + (wid >> 2) * 4096 + (wid & 3) * 1024, vdst = lds0 + LDS_V + wid * 1024;
#define ATT_DMA(t, slot) do { const size_t _o = (size_t)(t) * 64 * DA; \
        glds16(k0src + _o, (unsigned)__builtin_amdgcn_readfirstlane(kdst + (slot) * KSLOT)); glds16(k1src + _o, (unsigned)__builtin_amdgcn_readfirstlane(kdst + (slot) * KSLOT + 8192)); \
        glds16(v0src + _o, (unsigned)__builtin_amdgcn_readfirstlane(vdst + (slot) * VSLOT)); glds16(v1src + _o, (unsigned)__builtin_amdgcn_readfirstlane(vdst + (slot) * VSLOT + 8192)); } while (0)
    v8i32 qf;
    { const unsigned char* Qw = (const unsigned char*)Q + (rowbase + q0 + qg * 32 + r32) * DA + h * 128 + m * 64 + hi * 32;
      const u32x4 ql = *(const u32x4*)(Qw), qh = *(const u32x4*)(Qw + 16); qf = __builtin_bit_cast(v8i32, __builtin_shufflevector(ql, qh, 0, 1, 2, 3, 4, 5, 6, 7)); }
#ifndef ATT_GRP
#define ATT_GRP (wid & 1)
#endif
    const int grp = ATT_GRP;
#define ATT_DMA_K(t, slot) do { if (MODE & 1) break; const size_t _o = (size_t)(t) * 64 * DA; \
        glds16(k0src + _o, (unsigned)__builtin_amdgcn_readfirstlane(kdst + (slot) * KSLOT)); } while (0)
#define ATT_DMA_V(t, slot) do { if (MODE & 1) break; const size_t _o = (size_t)(t) * 64 * DA; \
        glds16(v0src + _o, (unsigned)__builtin_amdgcn_readfirstlane(vdst + (slot) * VSLOT)); glds16(v1src + _o, (unsigned)__builtin_amdgcn_readfirstlane(vdst + (slot) * VSLOT + 8192)); } while (0)
    ATT_DMA_K(0, 0); ATT_DMA_V(0, 0); ATT_DMA_K(1, 1); ATT_DMA_V(1, 1);
    f32x16 o[4];
#pragma unroll
    for (int d = 0; d < 4; ++d)
#pragma unroll
        for (int r = 0; r < 16; ++r) o[d][r] = 0.f;
    float l_reg = 0.f;
    const f32x16 zero16 = {0.f, 0.f, 0.f, 0.f, 0.f, 0.f, 0.f, 0.f, 0.f, 0.f, 0.f, 0.f, 0.f, 0.f, 0.f, 0.f};
    (void)mshift;
    const lds_cptr shm3 = (lds_cptr)shm;
    const lds_cptr kp0 = shm3 + LDS_K + m * 4096 + hi * 2048 + r32 * 16;
    const lds_cptr vp0 = shm3 + LDS_V + ((lane >> 4) & 1) * 32 + (lane & 3) * 8 + (4 * hi + ((lane & 15) >> 2)) * 64;
    u32x4 pw[4];
#pragma unroll
    for (int q = 0; q < 4; ++q) pw[q] = (u32x4){0u, 0u, 0u, 0u};
#define ATT_SB() __builtin_amdgcn_sched_barrier(0)
#define ATT_QKEXP(sl) do { if (MODE & 2) break; const lds_cptr kp = kp0 + (sl) * KSLOT; \
        ATT_SB(); \
        const u32x4 k0l = *(const __attribute__((address_space(3))) u32x4*)(kp), k0h = *(const __attribute__((address_space(3))) u32x4*)(kp + 1024); \
        const u32x4 k1l = *(const __attribute__((address_space(3))) u32x4*)(kp + 512), k1h = *(const __attribute__((address_space(3))) u32x4*)(kp + 1024 + 512); \
        ATT_SB(); \
        const v8i32 kf0 = __builtin_bit_cast(v8i32, __builtin_shufflevector(k0l, k0h, 0, 1, 2, 3, 4, 5, 6, 7)), kf1 = __builtin_bit_cast(v8i32, __builtin_shufflevector(k1l, k1h, 0, 1, 2, 3, 4, 5, 6, 7)); \
        f32x16 p0 = __builtin_amdgcn_mfma_scale_f32_32x32x64_f8f6f4(kf0, qf, zero16, 0, 0, 0, 0x7a7b, 1, 0x7a7b); \
        f32x16 p1 = __builtin_amdgcn_mfma_scale_f32_32x32x64_f8f6f4(kf1, qf, zero16, 0, 0, 0, 0x7a7b, 1, 0x7a7b); \
        ATT_SB(); \
        float sacc = 0.f; \
        _Pragma("unroll") for (int r = 0; r < 16; ++r) { p0[r] = __builtin_amdgcn_exp2f(p0[r]); p1[r] = __builtin_amdgcn_exp2f(p1[r]); sacc += p0[r] + p1[r]; } \
        l_reg += sacc; \
        _Pragma("unroll") for (int q = 0; q < 4; ++q) { pw[0][q] = cvt_pk_bf16(p0[2 * q], p0[2 * q + 1]); pw[1][q] = cvt_pk_bf16(p0[8 + 2 * q], p0[8 + 2 * q + 1]); \
                                                        pw[2][q] = cvt_pk_bf16(p1[2 * q], p1[2 * q + 1]); pw[3][q] = cvt_pk_bf16(p1[8 + 2 * q], p1[8 + 2 * q + 1]); } } while (0)
#define ATT_VRD(buf, d) do { _Pragma("unroll") for (int ks = 0; ks < 4; ++ks) { buf[0][ks] = vtr(vp + (d) * 4096 + ks * 1024); buf[1][ks] = vtr(vp + (d) * 4096 + ks * 1024 + 512); } } while (0)
#define ATT_VMM(buf, d) do { _Pragma("unroll") for (int ks = 0; ks < 4; ++ks) { \
        const bf16x8 vf = (bf16x8){buf[0][ks][0], buf[0][ks][1], buf[0][ks][2], buf[0][ks][3], buf[1][ks][0], buf[1][ks][1], buf[1][ks][2], buf[1][ks][3]}; \
        o[d] = __builtin_amdgcn_mfma_f32_32x32x16_bf16(__builtin_bit_cast(bf16x8, pw[ks]), vf, o[d], 0, 0, 0); } } while (0)
#define ATT_PV(sl) do { if (MODE & 4) break; const lds_cptr vp = vp0 + (sl) * VSLOT; s16x4 va[2][4], vb[2][4]; \
        ATT_SB(); ATT_VRD(va, 0); ATT_SB(); ATT_VRD(vb, 1); ATT_SB(); ATT_VMM(va, 0); ATT_SB(); ATT_VRD(va, 2); ATT_SB(); ATT_VMM(vb, 1); ATT_SB(); \
        ATT_VRD(vb, 3); ATT_SB(); ATT_VMM(va, 2); ATT_SB(); ATT_VMM(vb, 3); ATT_SB(); } while (0)
#ifndef ATT_TWO_GROUP
#define ATT_TWO_GROUP 0
#endif
    int sk = 0, skm1 = 2;
    if (ATT_TWO_GROUP) {
        for (int k = 0; k <= NT; ++k) {
            if (k + 1 < NT) { ATT_WAIT_BAR(3); } else { ATT_WAIT_BAR(0); }
            if (k + 2 < NT) ATT_DMA_K(k + 2, skm1);
            if (grp == 0) { if (k <= cw) ATT_QKEXP(sk); }
            else          { if (k >= 1 && k - 1 <= cw) ATT_PV(skm1); }
            if (k == NT) break;
            if (k + 2 < NT) { ATT_WAIT_BAR(3); } else { ATT_WAIT_BAR(0); }
            if (k + 2 < NT) ATT_DMA_V(k + 2, skm1);
            if (grp == 0) { if (k <= cw) ATT_PV(sk); }
            else          { if (k <= cw) ATT_QKEXP(sk); }
            skm1 = sk; sk = (sk == 2) ? 0 : sk + 1;
        }
    } else {
        for (int k = 0; k < NT; ++k) {
            if (k + 1 < NT) { ATT_WAIT_BAR(3); } else { ATT_WAIT_BAR(0); }
            if (k + 2 < NT) { ATT_DMA_K(k + 2, skm1); ATT_DMA_V(k + 2, skm1); }
            if (k <= cw) { ATT_QKEXP(sk); ATT_PV(sk); }
            skm1 = sk; sk = (sk == 2) ? 0 : sk + 1;
        }
    }
#undef ATT_QKEXP
#undef ATT_PV
#undef ATT_VRD
#undef ATT_VMM
#undef ATT_SB
#undef ATT_DMA_K
#undef ATT_DMA_V
    { auto rr = __builtin_amdgcn_permlane32_swap(__float_as_uint(l_reg), __float_as_uint(l_reg), false, false); l_reg = __uint_as_float(rr[0]) + __uint_as_float(rr[1]); }
    LAS float* wsf = (LAS float*)(shm + LDS_WS) + wid * 64;
    if (hi == 0) wsf[r32] = l_reg;
    ATT_WAIT_BAR(0);
    float rli[16];
    const float scl = m ? lam : 1.0f;
#pragma unroll
    for (int r = 0; r < 16; ++r) rli[r] = scl * __builtin_amdgcn_rcpf(wsf[crow(r, hi)]);
    LAS float* stg = (LAS float*)shm + qg * (32 * STG_ROW);
    if (m == 1) {
#pragma unroll
        for (int r = 0; r < 16; ++r)
#pragma unroll
            for (int d = 0; d < 4; ++d) stg[crow(r, hi) * STG_ROW + d * 32 + r32] = o[d][r] * rli[r];
    }
    ATT_WAIT_BAR(0);
    if (m == 0) {
#pragma unroll
        for (int r = 0; r < 16; ++r)
#pragma unroll
            for (int d = 0; d < 4; ++d) { LAS float* p = stg + crow(r, hi) * STG_ROW + d * 32 + r32; *p = o[d][r] * rli[r] - *p; }
    }
    ATT_WAIT_BAR(0);
    {
        const int row = 16 * m + (lane >> 2), qt = lane & 3;
        const LAS float* p = stg + row * STG_ROW + qt * 32;
        f32x4 v[8]; float ss = 0.f;
#pragma unroll
        for (int i = 0; i < 8; ++i) { v[i] = *(const LAS f32x4*)(p + 4 * i); ss += (v[i][0] * v[i][0] + v[i][1] * v[i][1]) + (v[i][2] * v[i][2] + v[i][3] * v[i][3]); }
        ss += __shfl_xor(ss, 1); ss += __shfl_xor(ss, 2);
        const float rn = rsqrtf(ss * (1.f / 128.f) + EPS) * oml;
        bf16_t* dst = MIX + (rowbase + q0 + qg * 32 + row) * D + DS + h * 128 + qt * 32;
#pragma unroll
        for (int i = 0; i < 4; ++i) {
            const f32x4 g0 = *(const f32x4*)(subg + qt * 32 + 8 * i), g1 = *(const f32x4*)(subg + qt * 32 + 8 * i + 4);
            const f32x4 a = v[2 * i] * g0 * rn, c = v[2 * i + 1] * g1 * rn;
            u32x4 w; w.x = cvt_pk_bf16(a[0], a[1]); w.y = cvt_pk_bf16(a[2], a[3]); w.z = cvt_pk_bf16(c[0], c[1]); w.w = cvt_pk_bf16(c[2], c[3]);
            *(u32x4*)(dst + 8 * i) = w;
        }
    }
    ATT_WAIT_BAR(0);
#undef ATT_DMA
}
}
template <int MODE> __device__ __forceinline__ void attn_phase(Frame& F, int l) {
    const bf16_t* Q = (const bf16_t*)(F.ws + WS_Q); const bf16_t* K = (const bf16_t*)(F.ws + WS_K); const bf16_t* V = (const bf16_t*)(F.ws + WS_V);
    bf16_t* MIX = (bf16_t*)(F.ws + WS_MIX);
    const float* sc = (const float*)(F.ws + WS_SCAL) + l * 4;
    const float lam = sc[0], mshift = sc[1], oml = sc[2];
    const float* subg = arg_in(19) + l * DV;
    const int G = F.G;
#ifndef ATT_XA
#define ATT_XA 1
#endif
    const bool xa = ATT_XA && (G & 7) == 0;
    const int x = F.bx & 7, j = F.bx >> 3, wpx = xa ? (G >> 3) : 1;
    const int npair = xa ? (32 - j + wpx - 1) / wpx : 0;
    const int nit = xa ? 4 * npair : (1024 - F.bx + G - 1) / G;
#pragma unroll 1
    for (int it = 0; it < nit; ++it) {
        int bh, qb;
        if (xa) { const int r = it / (2 * npair), rem = it % (2 * npair), sidx = j + (rem >> 1) * wpx; bh = 2 * x + r; qb = (rem & 1) ? sidx : 63 - sidx; }
        else { const int v = F.bx + it * G; bh = v >> 6; qb = v & 63; }
        att::attn_unit<MODE>(bh, qb, Q, K, V, MIX, subg, lam, mshift, oml, F.lds + LDS_RING, F.tid);
    }
}

__device__ __forceinline__ void router_phase(Frame& F, int l) {
    const bf16_t* h1 = (const bf16_t*)(F.ws + WS_H1); const float* g = arg_in(21) + (size_t)l * D; const float* br = arg_in(23) + l * NE;
    const bf16_t* WRT = (const bf16_t*)(F.ws + WS_WRT + l * WRT_STRIDE);
    bf16_t* XN = (bf16_t*)(F.ws + WS_XN); int* TOPI = (int*)(F.ws + WS_TOPI); float* TOPG = (float*)(F.ws + WS_TOPG); int* WGCNT = (int*)(F.ws + WS_WGCNT); float* RS = (float*)(F.ws + WS_RS);
    const int lane = F.lane, tid = F.tid, wave = F.wave, n = lane & 15, kq = lane >> 4;
    constexpr int PITCH = 2080;
    LAS unsigned char* wl = F.lds + LDS_RING;
    LAS float* lg = (LAS float*)(F.lds + LDS_RING + 2 * 32 * PITCH) + wave * (16 * 33 + 16);
    LAS int* cnt = (LAS int*)(F.ctl + 256);
    __syncthreads();
    for (int i = tid; i < 2 * NE * 128; i += NTHREADS) { const int row = i >> 7, c = i & 127; *(LAS u32x4*)(wl + row * PITCH + c * 16) = *(const u32x4*)(WRT + (size_t)row * D + c * 8); }
    if (tid < 32) cnt[tid] = 0;
    __syncthreads();
    for (int wgu = F.bx; wgu < T / 128; wgu += F.G) {
        if (wgu != F.bx) { __syncthreads(); if (tid < 32) cnt[tid] = 0; __syncthreads(); }
        const int row = wgu * 128 + wave * 16 + n;
        const bf16_t* hp = h1 + (size_t)row * D + 8 * kq; const float* gp = g + 8 * kq;
        bf16_t* xp = XN + (size_t)row * D + 8 * kq; unsigned char* xp8 = (unsigned char*)XN + (size_t)row * D + 8 * kq;
        const LAS unsigned char* bh = wl + n * PITCH + 16 * kq;
        f32x4 acc0 = (f32x4){0.f, 0.f, 0.f, 0.f}, acc1 = acc0; float ss = 0.f;
#pragma unroll 4
        for (int ks = 0; ks < 32; ++ks) {
            const u32x4 hw = *(const u32x4*)(hp + 32 * ks); const f32x4 h0 = (f32x4){bf_lo(hw.x), bf_hi(hw.x), bf_lo(hw.y), bf_hi(hw.y)}, h4 = (f32x4){bf_lo(hw.z), bf_hi(hw.z), bf_lo(hw.w), bf_hi(hw.w)};
            const f32x4 g0 = *(const f32x4*)(gp + 32 * ks), g4 = *(const f32x4*)(gp + 32 * ks + 4);
            const f32x4 x0 = h0 * g0, x4 = h4 * g4;
            ss += (x0[0] * x0[0] + x0[1] * x0[1]) + (x0[2] * x0[2] + x0[3] * x0[3]) + (x4[0] * x4[0] + x4[1] * x4[1]) + (x4[2] * x4[2] + x4[3] * x4[3]);
            u32x4 hi; hi.x = cvt_pk_bf16(x0[0], x0[1]); hi.y = cvt_pk_bf16(x0[2], x0[3]); hi.z = cvt_pk_bf16(x4[0], x4[1]); hi.w = cvt_pk_bf16(x4[2], x4[3]);
            if (UP_FP8) { u32x2 w8; w8.x = pk4_fp8(x0[0] * 8.f, x0[1] * 8.f, x0[2] * 8.f, x0[3] * 8.f); w8.y = pk4_fp8(x4[0] * 8.f, x4[1] * 8.f, x4[2] * 8.f, x4[3] * 8.f); *(u32x2*)(xp8 + 32 * ks) = w8; }
            else *(u32x4*)(xp + 32 * ks) = hi;
            u32x4 lo;
            lo.x = cvt_pk_bf16(x0[0] - bf_lo(hi.x), x0[1] - bf_hi(hi.x)); lo.y = cvt_pk_bf16(x0[2] - bf_lo(hi.y), x0[3] - bf_hi(hi.y));
            lo.z = cvt_pk_bf16(x4[0] - bf_lo(hi.z), x4[1] - bf_hi(hi.z)); lo.w = cvt_pk_bf16(x4[2] - bf_lo(hi.w), x4[3] - bf_hi(hi.w));
            const bf16x8 ah = __builtin_bit_cast(bf16x8, hi), al = __builtin_bit_cast(bf16x8, lo);
            const bf16x8 b0h = *(const LAS bf16x8*)(bh + 64 * ks), b1h = *(const LAS bf16x8*)(bh + 16 * PITCH + 64 * ks);
            const bf16x8 b0l = *(const LAS bf16x8*)(bh + 32 * PITCH + 64 * ks), b1l = *(const LAS bf16x8*)(bh + 48 * PITCH + 64 * ks);
            acc0 = __builtin_amdgcn_mfma_f32_16x16x32_bf16(ah, b0h, acc0, 0, 0, 0); acc1 = __builtin_amdgcn_mfma_f32_16x16x32_bf16(ah, b1h, acc1, 0, 0, 0);
            acc0 = __builtin_amdgcn_mfma_f32_16x16x32_bf16(al, b0h, acc0, 0, 0, 0); acc1 = __builtin_amdgcn_mfma_f32_16x16x32_bf16(al, b1h, acc1, 0, 0, 0);
            acc0 = __builtin_amdgcn_mfma_f32_16x16x32_bf16(ah, b0l, acc0, 0, 0, 0); acc1 = __builtin_amdgcn_mfma_f32_16x16x32_bf16(ah, b1l, acc1, 0, 0, 0);
        }
        ss += __shfl_xor(ss, 16); ss += __shfl_xor(ss, 32);
        const float r = rsqrtf(ss * (1.f / D) + EPS);
        if (kq == 0) { lg[16 * 33 + n] = r; RS[row] = r; }
        asm volatile("s_waitcnt lgkmcnt(0)" ::: "memory");
        const float b0 = br[n], b1 = br[16 + n];
#pragma unroll
        for (int q = 0; q < 4; ++q) { const float rt = lg[16 * 33 + 4 * kq + q]; lg[(4 * kq + q) * 33 + n] = acc0[q] * rt + b0; lg[(4 * kq + q) * 33 + 16 + n] = acc1[q] * rt + b1; }
        asm volatile("s_waitcnt lgkmcnt(0)" ::: "memory");
        if (lane < 16) {
            const int tok = wgu * 128 + wave * 16 + lane;
            float v[32];
#pragma unroll
            for (int e = 0; e < 32; ++e) v[e] = lg[lane * 33 + e];
            unsigned mask = 0u; float val[4]; int sel[4];
#pragma unroll
            for (int k = 0; k < 4; ++k) { float best = -INFINITY; int bi = 0;
#pragma unroll
                for (int e = 0; e < 32; ++e) { const bool ok = !((mask >> e) & 1u) && (v[e] > best); best = ok ? v[e] : best; bi = ok ? e : bi; }
                mask |= 1u << bi; val[k] = best; sel[k] = bi; }
            float ex[4], sum = 0.f;
#pragma unroll
            for (int k = 0; k < 4; ++k) { ex[k] = __expf(val[k] - val[0]); sum += ex[k]; }
            const float inv = 1.f / sum;
#pragma unroll
            for (int k = 0; k < 4; ++k) { const int pos = __hip_atomic_fetch_add(cnt + sel[k], 1, __ATOMIC_RELAXED, __HIP_MEMORY_SCOPE_WORKGROUP);
                TOPI[tok * 4 + k] = sel[k] | (pos << 8); TOPG[tok * 4 + k] = ex[k] * inv; }
        }
        __syncthreads();
        if (tid < 32) WGCNT[wgu * 32 + tid] = cnt[tid];
    }
    __syncthreads();
}
__device__ __forceinline__ void routing_phase(Frame& F) {
    const int* TOPI = (const int*)(F.ws + WS_TOPI); const float* TOPG = (const float*)(F.ws + WS_TOPG); const int* WGCNT = (const int*)(F.ws + WS_WGCNT);
    int* TOKROW = (int*)(F.ws + WS_TOKROW); int* ROWTOK = (int*)(F.ws + WS_ROWTOK); float* ROWGATE = (float*)(F.ws + WS_ROWGATE); int* TILEEXP = (int*)(F.ws + WS_TILEEXP);
    float* ROWSCALE = (float*)(F.ws + WS_ROWSCALE); const float* RS = (const float*)(F.ws + WS_RS);
    const int tid = F.tid;
    LAS int* tot = (LAS int*)(F.lds + LDS_RING);
    LAS int* pst = tot + 32;
    LAS int* mypre = pst + 40;
    LAS int* part = mypre + 32;
    for (int wgu = F.bx; wgu < 256; wgu += F.G) {
        __syncthreads();
        {
            const int e = tid & 31, wq = tid >> 5; int a = 0, mine = 0;
#pragma unroll
            for (int j = 0; j < 16; ++j) { const int w = wq * 16 + j; const int c = WGCNT[w * 32 + e]; a += c; if (w < wgu) mine += c; }
            part[wq * 32 + e] = a; part[512 + wq * 32 + e] = mine;
        }
        __syncthreads();
        if (tid < 32) { int a = 0, mine = 0;
#pragma unroll
            for (int q = 0; q < 16; ++q) { a += part[q * 32 + tid]; mine += part[512 + q * 32 + tid]; }
            tot[tid] = a; mypre[tid] = mine; }
        __syncthreads();
        if (tid == 0) { int a = 0; for (int e = 0; e < 32; ++e) { pst[e] = a; a += (tot[e] + 255) & ~255; } pst[32] = a; }
        __syncthreads();
        {
            const int t = wgu * 128 + (tid >> 2), k = tid & 3;
            const int w = TOPI[t * 4 + k]; const int e = w & 255, pos = w >> 8;
            const int dest = pst[e] + mypre[e] + pos;
            ROWTOK[dest] = t; ROWGATE[dest] = TOPG[t * 4 + k]; ROWSCALE[dest] = RS[t]; TOKROW[t * 4 + k] = dest;
        }
        if (wgu < 32) {
            const int e = wgu; const int beg = pst[e] + tot[e], end = pst[e + 1];
            for (int r = beg + tid; r < end; r += NTHREADS) { ROWTOK[r] = 0; ROWGATE[r] = 0.f; ROWSCALE[r] = 0.f; }
        }
        if (wgu == 0) {
            const int ntiles = pst[32] >> 8;
            for (int pm = tid; pm < ntiles; pm += NTHREADS) { int e = 0; for (int q = 1; q < 32; ++q) if ((pm << 8) >= pst[q]) e = q; TILEEXP[pm] = e; }
            if (tid == 0) TILEEXP[1023] = ntiles;
            if (tid < 33) TILEEXP[768 + tid] = pst[tid];
        }
    }
    __syncthreads();
}
struct CRow { u32x4 h[2]; u32x2 y[4][2]; };
__device__ __forceinline__ void crow_load(CRow& r, const bf16_t* H1, const unsigned char* YB, const int* TOKROW, int m, int lane) {
    const bf16_t* hr = H1 + (size_t)m * D + 8 * lane;
    r.h[0] = *(const u32x4*)(hr); r.h[1] = *(const u32x4*)(hr + 512);
    const int4 tr = *(const int4*)(TOKROW + m * 4);
    const int rows[4] = {tr.x, tr.y, tr.z, tr.w};
#pragma unroll
    for (int k = 0; k < 4; ++k) { const unsigned char* yr = YB + (size_t)rows[k] * D + 8 * lane; r.y[k][0] = *(const u32x2*)(yr); r.y[k][1] = *(const u32x2*)(yr + 512); }
}
__device__ __forceinline__ void crow_finish(CRow& r, float* out32, bf16_t* H2, bf16_t* XN, const float* gnext, int m, int lane) {
    f32x4 v[4];
#pragma unroll
    for (int hf = 0; hf < 2; ++hf) { const u32x4 w = r.h[hf]; v[2 * hf] = (f32x4){bf_lo(w.x), bf_hi(w.x), bf_lo(w.y), bf_hi(w.y)}; v[2 * hf + 1] = (f32x4){bf_lo(w.z), bf_hi(w.z), bf_lo(w.w), bf_hi(w.w)}; }
#pragma unroll
    for (int k = 0; k < 4; ++k)
#pragma unroll
        for (int hf = 0; hf < 2; ++hf) { fp8x4_add(r.y[k][hf].x, 1.f / 16.f, v[2 * hf]); fp8x4_add(r.y[k][hf].y, 1.f / 16.f, v[2 * hf + 1]); }
    if (out32) { float* orow = out32 + (size_t)m * D + 8 * lane; *(f32x4*)(orow) = v[0]; *(f32x4*)(orow + 4) = v[1]; *(f32x4*)(orow + 512) = v[2]; *(f32x4*)(orow + 516) = v[3]; }
    else {
        u32x4 w; w.x = cvt_pk_bf16(v[0][0], v[0][1]); w.y = cvt_pk_bf16(v[0][2], v[0][3]); w.z = cvt_pk_bf16(v[1][0], v[1][1]); w.w = cvt_pk_bf16(v[1][2], v[1][3]);
        *(u32x4*)(H2 + (size_t)m * D + 8 * lane) = w;
        w.x = cvt_pk_bf16(v[2][0], v[2][1]); w.y = cvt_pk_bf16(v[2][2], v[2][3]); w.z = cvt_pk_bf16(v[3][0], v[3][1]); w.w = cvt_pk_bf16(v[3][2], v[3][3]);
        *(u32x4*)(H2 + (size_t)m * D + 512 + 8 * lane) = w;
    }
    if (gnext) {
        float s = 0.f;
#pragma unroll
        for (int j = 0; j < 4; ++j) s += (v[j][0] * v[j][0] + v[j][1] * v[j][1]) + (v[j][2] * v[j][2] + v[j][3] * v[j][3]);
        const float rr = rsqrtf(wave_sum(s) * (1.f / D) + EPS);
        const float* gp = gnext + 8 * lane;
        const f32x4 a0 = v[0] * *(const f32x4*)(gp) * rr, a1 = v[1] * *(const f32x4*)(gp + 4) * rr, a2 = v[2] * *(const f32x4*)(gp + 512) * rr, a3 = v[3] * *(const f32x4*)(gp + 516) * rr;
        u32x4 w; w.x = cvt_pk_bf16(a0[0], a0[1]); w.y = cvt_pk_bf16(a0[2], a0[3]); w.z = cvt_pk_bf16(a1[0], a1[1]); w.w = cvt_pk_bf16(a1[2], a1[3]);
        *(u32x4*)(XN + (size_t)m * D + 8 * lane) = w;
        w.x = cvt_pk_bf16(a2[0], a2[1]); w.y = cvt_pk_bf16(a2[2], a2[3]); w.z = cvt_pk_bf16(a3[0], a3[1]); w.w = cvt_pk_bf16(a3[2], a3[3]);
        *(u32x4*)(XN + (size_t)m * D + 512 + 8 * lane) = w;
    }
}
__device__ __forceinline__ void combine_phase(Frame& F, const float* gnext, float* out32) {
    const unsigned char* YB = (const unsigned char*)(F.ws + WS_YB); const int* TOKROW = (const int*)(F.ws + WS_TOKROW); bf16_t* XN = (bf16_t*)(F.ws + WS_XN);
    const bf16_t* H1 = (const bf16_t*)(F.ws + WS_H1); bf16_t* H2 = (bf16_t*)(F.ws + WS_H2);
    const int lane = F.lane, NGW = F.G * NWAVES;
    CRow ra, rb;
    int m = F.bx * NWAVES + F.wave;
    if (m < T) crow_load(ra, H1, YB, TOKROW, m, lane);
    while (m < T) {
        const int mb = m + NGW;
        if (mb < T) crow_load(rb, H1, YB, TOKROW, mb, lane);
        crow_finish(ra, out32, H2, XN, gnext, m, lane);
        if (mb >= T) break;
        const int mc = mb + NGW;
        if (mc < T) crow_load(ra, H1, YB, TOKROW, mc, lane);
        crow_finish(rb, out32, H2, XN, gnext, mb, lane);
        m = mc;
    }
}

constexpr int NPH_LAYER = 10, NPH = 1 + DEPTH * NPH_LAYER;
__global__ void __launch_bounds__(NTHREADS, 2) mk_fwd(Args args) {
    extern __shared__ __attribute__((aligned(16))) unsigned char lds_raw[];
    Frame F;
    F.lds = (LAS unsigned char*)lds_raw; F.ctl = F.lds + LDS_CTL; F.ws = args.ws; F.ws0 = args.ws; F.out0 = args.out; F.ap = &args; F.z = 0;
    F.tid = threadIdx.x; F.lane = F.tid & 63; F.wave = __builtin_amdgcn_readfirstlane(F.tid >> 6); F.G = gridDim.x; F.bx = blockIdx.x;
    F.out = args.out;
    for (int u = F.tid; u < 1024; u += NTHREADS) ((LAS unsigned*)F.ctl)[u] = 0u;
    __syncthreads();
    XcdBarrier bar = xcd_barrier_post((unsigned*)(F.ws + WS_CTL) + CW_BAR, (volatile LAS unsigned*)F.ctl);
    const int lo = args.ph_lo, hi = args.ph_hi;
#ifndef PHMASK
#define PHMASK 0x1fff
#endif
#define RUN(k) (lo <= (k) && (k) < hi)
#define EN(b) ((PHMASK >> (b)) & 1)
#ifndef DUPMASK
#define DUPMASK 0
#endif
#ifndef ATT_PROBE_MODE
#define ATT_PROBE_MODE 0
#endif
#ifndef PRO_PROBE_MODE
#define PRO_PROBE_MODE 0
#endif
#define NREP(b) (((DUPMASK >> (b)) & 1) ? 2 : 1)
#define SEAM(k) do { if (RUN((k) + 1)) xcd_barrier(bar); } while (0)
    if (EN(10) && RUN(0)) { { if (NREP(10) == 2) { phase_begin(F); p0_prologue<PRO_PROBE_MODE>(F); xcd_barrier(bar); } phase_begin(F); p0_prologue<0>(F); } SEAM(0); }
    for (int l = 0; l < DEPTH; ++l) {
        const int pb = 1 + l * NPH_LAYER;
#ifdef EXTRA_BARRIERS
        for (int eb = 0; eb < EXTRA_BARRIERS; ++eb) xcd_barrier(bar);
#endif
        if (EN(0) && RUN(pb + 0)) { for (int rep = 0; rep < NREP(0); ++rep) { phase_begin(F); unsigned char* ws = F.ws; (void)ws;
            PInProj P; P.so.init(T, DIN, F.G, F.bx); P.A = (const char*)(ws + WS_XN); P.B = (const char*)(ws + WS_WIN + l * WIN_STRIDE);
            P.UQKV = (bf16_t*)(ws + WS_U); P.GQK = (const float*)(ws + WS_SCAL) + 64 + l * 128; P.COS = (const float*)(ws + WS_COS); P.SIN = (const float*)(ws + WS_SIN);
            pg8::gemm_phase(F.lds + LDS_RING, F.ctl, P, F.tid);  if (rep + 1 < NREP(0)) xcd_barrier(bar); } SEAM(pb + 0);
        }
        if (EN(1) && RUN(pb + 1)) { for (int rep = 0; rep < NREP(1); ++rep) { phase_begin(F); unsigned char* ws = F.ws; (void)ws; s5a_phase(F, l);  if (rep + 1 < NREP(1)) xcd_barrier(bar); } SEAM(pb + 1); }
        if (EN(2) && RUN(pb + 2)) { for (int rep = 0; rep < NREP(2); ++rep) { phase_begin(F); unsigned char* ws = F.ws; (void)ws; if (EN(11)) for (int r2 = 0; r2 < NREP(11); ++r2) { phase_begin(F); s5c_phase(F, l); } if (EN(12)) { if (NREP(12) == 2) { phase_begin(F); attn_phase<ATT_PROBE_MODE>(F, l); } phase_begin(F); attn_phase<0>(F, l); }  if (rep + 1 < NREP(2)) xcd_barrier(bar); } SEAM(pb + 2); }
        if (EN(3) && RUN(pb + 3)) { for (int rep = 0; rep < NREP(3); ++rep) { phase_begin(F); unsigned char* ws = F.ws; (void)ws;
            PGlu P; P.so.init(T, DS, F.G, F.bx); P.A = (const char*)(ws + WS_YG); P.B = (const char*)(ws + WS_WGLU + l * WGLU_STRIDE);
            P.YG = (const bf16_t*)(ws + WS_YG); P.MIX = (bf16_t*)(ws + WS_MIX); P.RSP = (float*)(ws + WS_RSP);
            pg8::gemm_phase(F.lds + LDS_RING, F.ctl, P, F.tid);  if (rep + 1 < NREP(3)) xcd_barrier(bar); } SEAM(pb + 3);
        }
        if (EN(4) && RUN(pb + 4)) { for (int rep = 0; rep < NREP(4); ++rep) { phase_begin(F); unsigned char* ws = F.ws; (void)ws;
            POut P; P.so.init(T, D, F.G, F.bx); P.A = (const char*)(ws + WS_MIX); P.B = (const char*)(ws + WS_WOUT + l * WOUT_STRIDE);
            P.RSP = (const float*)(ws + WS_RSP); P.base32 = (l == 0) ? arg_in(0) : nullptr; P.base16 = (const bf16_t*)(ws + WS_H2); P.H1 = (bf16_t*)(ws + WS_H1);
            pg8::gemm_phase(F.lds + LDS_RING, F.ctl, P, F.tid);  if (rep + 1 < NREP(4)) xcd_barrier(bar); } SEAM(pb + 4);
        }
        if (EN(5) && RUN(pb + 5)) { for (int rep = 0; rep < NREP(5); ++rep) { phase_begin(F); unsigned char* ws = F.ws; (void)ws; router_phase(F, l);  if (rep + 1 < NREP(5)) xcd_barrier(bar); } SEAM(pb + 5); }
        if (EN(6) && RUN(pb + 6)) { for (int rep = 0; rep < NREP(6); ++rep) { phase_begin(F); unsigned char* ws = F.ws; (void)ws; routing_phase(F);  if (rep + 1 < NREP(6)) xcd_barrier(bar); } SEAM(pb + 6); }
        if (EN(7) && RUN(pb + 7)) { for (int rep = 0; rep < NREP(7); ++rep) { phase_begin(F); unsigned char* ws = F.ws; (void)ws;
            PUp P; P.mo.init(F.G, F.bx, (const int*)(ws + WS_TILEEXP) + 768);
            P.A = (const char*)(ws + WS_XN); P.B = (const char*)(ws + WS_WUP + l * WUP_STRIDE); P.ROWTOK = (const int*)(ws + WS_ROWTOK); P.TILEEXP = (const int*)(ws + WS_TILEEXP);
            P.bup = arg_in(25) + (size_t)l * NE * 2048; P.ROWSCALE = (const float*)(ws + WS_ROWSCALE); P.ACT = (bf16_t*)(ws + WS_ACT);
            if (GEMM_PROBE && rep + 1 < NREP(7)) { PUpNoDma Q; (PUp&)Q = P; pg8::gemm_phase(F.lds + LDS_RING, F.ctl, Q, F.tid); } else pg8::gemm_phase(F.lds + LDS_RING, F.ctl, P, F.tid);  if (rep + 1 < NREP(7)) xcd_barrier(bar); } SEAM(pb + 7);
        }
        if (EN(8) && RUN(pb + 8)) { for (int rep = 0; rep < NREP(8); ++rep) { phase_begin(F); unsigned char* ws = F.ws; (void)ws;
            PDown P; P.mo.init(F.G, F.bx, (const int*)(ws + WS_TILEEXP) + 768);
            P.A = (const char*)(ws + WS_ACT); P.B = (const char*)(ws + WS_WDN + l * WDN_STRIDE); P.TILEEXP = (const int*)(ws + WS_TILEEXP);
            P.bdn = arg_in(27) + (size_t)l * NE * 1024; P.ROWGATE = (const float*)(ws + WS_ROWGATE); P.YB = (bf16_t*)(ws + WS_YB);
            pg8::gemm_phase(F.lds + LDS_RING, F.ctl, P, F.tid);  if (rep + 1 < NREP(8)) xcd_barrier(bar); } SEAM(pb + 8);
        }
        if (EN(9) && RUN(pb + 9)) { for (int rep = 0; rep < NREP(9); ++rep) { phase_begin(F); unsigned char* ws = F.ws; (void)ws; combine_phase(F, (l + 1 < DEPTH) ? arg_in(1) + (size_t)(l + 1) * D : nullptr, (l + 1 < DEPTH) ? nullptr : F.out);  if (rep + 1 < NREP(9)) xcd_barrier(bar); } SEAM(pb + 9); }
    }
#undef RUN
#undef SEAM
}

extern "C" void kernel_launch(void* const* d_in, const int* in_sizes, int n_in, void* d_out, int out_size, void* d_ws, size_t ws_size, hipStream_t stream) {
    static int grid = 0;
    if (grid == 0) {
        if (n_in != 28 || out_size != T * D || ws_size < WS_END) { fprintf(stderr, "kernel_launch: unexpected shapes (n_in %d out %d ws %zu)\n", n_in, out_size, ws_size); grid = -1; return; }
        int dev = 0, cus = 0;
        if (hipGetDevice(&dev) != hipSuccess || hipDeviceGetAttribute(&cus, hipDeviceAttributeMultiprocessorCount, dev) != hipSuccess) { grid = -1; return; }
        if (hipFuncSetAttribute((const void*)mk_fwd, hipFuncAttributeMaxDynamicSharedMemorySize, LDS_BYTES) != hipSuccess) { fprintf(stderr, "kernel_launch: hipFuncSetAttribute failed\n"); grid = -1; return; }
        int per_cu = 0;
        if (hipOccupancyMaxActiveBlocksPerMultiprocessor(&per_cu, (const void*)mk_fwd, NTHREADS, LDS_BYTES) != hipSuccess || per_cu < 1) { fprintf(stderr, "kernel_launch: occupancy query says %d\n", per_cu); }
        (void)hipGetLastError();
        grid = cus;
    }
    if (grid < 0) return;
    if (hipMemsetAsync((char*)d_ws + WS_CTL, 0, CTL_ZERO_BYTES, stream) != hipSuccess) return;
    Args a{};
    for (int i = 0; i < 28; ++i) a.in[i] = (const float*)d_in[i];
    a.out = (float*)d_out; a.ws = (unsigned char*)d_ws; a.ph_lo = 0; a.ph_hi = NPH;
    hipLaunchKernelGGL(mk_fwd, dim3(grid), dim3(NTHREADS), LDS_BYTES, stream, a);
}
```

```cpp
#include <hip/hip_runtime.h>
#include <cstdio>
#include <cstdint>
#include <math.h>

#ifndef GEMM_PROBE
#define GEMM_PROBE 0
#endif
#ifndef GEMM_PROBE_KIND
#define GEMM_PROBE_KIND 1
#endif
#ifndef UP_FP8
#define UP_FP8 1
#endif
#ifndef DN_FP8
#define DN_FP8 1
#endif
#define LAS __attribute__((address_space(3)))
#define GAS __attribute__((address_space(1)))
typedef unsigned short bf16_t;
typedef short bf16x8 __attribute__((ext_vector_type(8)));
typedef short s16x4 __attribute__((ext_vector_type(4)));
typedef float f32x4 __attribute__((ext_vector_type(4)));
typedef float f32x2 __attribute__((ext_vector_type(2)));
typedef float f32x16 __attribute__((ext_vector_type(16)));
typedef unsigned u32x4 __attribute__((ext_vector_type(4)));
typedef unsigned u32x2 __attribute__((ext_vector_type(2)));
typedef int v8i32 __attribute__((ext_vector_type(8)));

constexpr int D = 1024, BATCH = 4, SEQ = 8192, DEPTH = 2, T = BATCH * SEQ;
constexpr int DS = 512, NG = 32, HS = 16, NP = 64, DA = 512, NH = 4, DV = 128, DIN = 2048;
constexpr int NE = 32, DFF = 1024, NASSIGN = T * 4;
constexpr int MPAD_MAX = NASSIGN + NE * 256, NTILE_MAX = MPAD_MAX / 256;
constexpr int NCHUNK = T / 64, CPB = SEQ / 64;
constexpr float EPS = 1e-6f;
constexpr float C2 = 0.125f * 1.4426950408889634f;
constexpr int NWAVES = 8, NTHREADS = 512;

constexpr size_t MiB = 1u << 20;
constexpr size_t WS_CTL = 0, CTL_ZERO_BYTES = 1 * MiB;
constexpr size_t WS_COS = 1 * MiB, WS_SIN = 2 * MiB;
constexpr size_t WS_SCAL = 3 * MiB;
constexpr size_t WS_KT = 4 * MiB, KT_STRIDE = 2 * MiB;
constexpr size_t WS_LAML = 8 * MiB, LAML_STRIDE = 32768;
constexpr size_t WS_WRT = 9 * MiB, WRT_STRIDE = 131072;
constexpr size_t WS_RS = 10 * MiB;
constexpr size_t WS_GT = 16 * MiB, GT_STRIDE = 8 * MiB;
constexpr size_t WS_HT = 32 * MiB, HT_STRIDE = 8 * MiB;
constexpr size_t WS_WIN = 48 * MiB, WIN_STRIDE = 4 * MiB;
constexpr size_t WS_WGLU = 56 * MiB, WGLU_STRIDE = MiB / 2;
constexpr size_t WS_WOUT = 58 * MiB, WOUT_STRIDE = 2 * MiB;
constexpr size_t WS_WUP = 64 * MiB, WUP_STRIDE = 128 * MiB;
constexpr size_t WS_WDN = 320 * MiB, WDN_STRIDE = 64 * MiB;
constexpr size_t WS_XN = 448 * MiB;
constexpr size_t WS_U = 512 * MiB, WS_Q = 544 * MiB, WS_K = 576 * MiB, WS_V = 608 * MiB;
constexpr size_t WS_YG = 640 * MiB;
constexpr size_t WS_MIX = 672 * MiB;
constexpr size_t WS_S = 736 * MiB;
constexpr size_t WS_RSP = 744 * MiB;
constexpr size_t WS_TOPI = 746 * MiB, WS_TOPG = 747 * MiB, WS_TOKROW = 748 * MiB, WS_WGCNT = 749 * MiB;
constexpr size_t WS_ROWTOK = 750 * MiB, WS_ROWGATE = 751 * MiB, WS_TILEEXP = 752 * MiB, WS_ROWSCALE = 753 * MiB;
constexpr size_t WS_ACT = 768 * MiB, WS_YB = 1040 * MiB, WS_H1 = 1180 * MiB, WS_H2 = 1244 * MiB, WS_END = 1312 * MiB;
constexpr int CW_BAR = 4096;

constexpr int LDS_CTL = 0;
constexpr int LDS_RING = 4096;
constexpr int LDS_BYTES = 163840;

__device__ __forceinline__ unsigned f2bf(float f) { unsigned u = __builtin_bit_cast(unsigned, f); return (u + 0x7fffu + ((u >> 16) & 1u)) >> 16; }
__device__ __forceinline__ unsigned pk2(float lo, float hi) { return f2bf(lo) | (f2bf(hi) << 16); }
__device__ __forceinline__ unsigned cvt_pk_bf16(float lo, float hi) { unsigned r; asm volatile("v_cvt_pk_bf16_f32 %0, %1, %2" : "=v"(r) : "v"(lo), "v"(hi)); return r; }
__device__ __forceinline__ unsigned pk4_fp8(float a, float b, float c, float d) { int w = 0; w = __builtin_amdgcn_cvt_pk_fp8_f32(a, b, w, false); w = __builtin_amdgcn_cvt_pk_fp8_f32(c, d, w, true); return (unsigned)w; }
__device__ __forceinline__ void fp8x4_add(unsigned w, float sc, f32x4& a) { const f32x2 lo = __builtin_amdgcn_cvt_pk_f32_fp8((int)w, false), hi = __builtin_amdgcn_cvt_pk_f32_fp8((int)w, true); a[0] += lo[0] * sc; a[1] += lo[1] * sc; a[2] += hi[0] * sc; a[3] += hi[1] * sc; }
__device__ __forceinline__ float bf_lo(unsigned w) { return __builtin_bit_cast(float, w << 16); }
__device__ __forceinline__ float bf_hi(unsigned w) { return __builtin_bit_cast(float, w & 0xffff0000u); }
__device__ __forceinline__ float wave_sum(float v) {
#pragma unroll
    for (int o = 1; o < 64; o <<= 1) v += __shfl_xor(v, o);
    return v;
}
__device__ __forceinline__ float gelu_tanh(float x) {
    const float z = 0.7978845608028654f * (x + 0.044715f * x * x * x);
    return x * __builtin_amdgcn_rcpf(1.f + __builtin_amdgcn_exp2f(-2.885390082f * z));
}
__device__ __forceinline__ float sigmoidf(float v) { return __builtin_amdgcn_rcpf(1.f + __builtin_amdgcn_exp2f(-1.4426950409f * v)); }

#define XB_TMO      128
#define XB_XCNT(j)  (256  + 64 * (j))
#define XB_XSUB(j)  (1280 + 64 * (j))
#define XB_XGEN(j)  (2304 + 64 * (j))
#define XB_TOP      3328
#define XB_TOPGEN   3392
#define XCD_BAR_WORDS 3456
#define XB_SPIN_CAP (1u << 18)
__device__ __forceinline__ unsigned xb_ld(unsigned* p)              { return __hip_atomic_load(p, __ATOMIC_RELAXED, __HIP_MEMORY_SCOPE_AGENT); }
__device__ __forceinline__ unsigned xb_add(unsigned* p, unsigned v) { return __hip_atomic_fetch_add(p, v, __ATOMIC_RELAXED, __HIP_MEMORY_SCOPE_AGENT); }
__device__ __forceinline__ unsigned xb_xcc_id() { return (unsigned)__builtin_amdgcn_s_getreg((3 << 11) | 20) & 0xFu; }
#define XB_SPIN(cond, bar) do { unsigned _sp = 0; while (cond) { __builtin_amdgcn_s_sleep(1); \
    if ((++_sp & 255u) == 0u) { if (xb_ld(&(bar)[XB_TMO])) break; if (_sp > XB_SPIN_CAP) { atomicAdd(&(bar)[XB_TMO], 1u); break; } } } } while (0)
struct XcdBarrier { unsigned* bar; unsigned x; volatile LAS unsigned* st; };
__device__ __forceinline__ XcdBarrier xcd_barrier_post(unsigned* bar, volatile LAS unsigned* st) {
    XcdBarrier b; b.bar = bar; b.x = xb_xcc_id(); b.st = st;
    if (threadIdx.x == 0) (void)xb_add(&bar[XB_XCNT(b.x)], 1u);
    return b;
}
__device__ __forceinline__ void xcd_barrier_complete(unsigned* bar, unsigned x, unsigned& nloc, unsigned& nx) {
    const unsigned G = gridDim.x * gridDim.y * gridDim.z;
    unsigned sum, cnt, mine, sp = 0u;
    for (;;) {
        sum = 0u; cnt = 0u; mine = 0u;
#pragma unroll
        for (unsigned j = 0; j < 16; ++j) { const unsigned c = xb_ld(&bar[XB_XCNT(j)]); sum += c; cnt += (c > 0u) ? 1u : 0u; mine = (j == x) ? c : mine; }
        if (sum == G) break;
        __builtin_amdgcn_s_sleep(1);
        if ((++sp & 255u) == 0u) { if (xb_ld(&bar[XB_TMO])) break; if (sp > XB_SPIN_CAP) { atomicAdd(&bar[XB_TMO], 1u); break; } }
    }
    nloc = mine > 0u ? mine : 1u; nx = cnt > 0u ? cnt : 1u;
}
__device__ __forceinline__ void xcd_barrier(const XcdBarrier& b) {
    asm volatile("s_waitcnt vmcnt(0)" ::: "memory");
    __syncthreads();
    if (threadIdx.x == 0) {
        unsigned* bar = b.bar;
        __builtin_amdgcn_s_waitcnt(0);
        unsigned nloc = b.st[0], nx = b.st[1];
        if (nloc == 0u) { xcd_barrier_complete(bar, b.x, nloc, nx); b.st[0] = nloc; b.st[1] = nx; }
        const unsigned old = xb_add(&bar[XB_XSUB(b.x)], 1u);
        const unsigned gen = old / nloc;
        if (old + 1u == (gen + 1u) * nloc) {
            __builtin_amdgcn_fence(__ATOMIC_RELEASE, "agent");
            asm volatile("s_waitcnt vmcnt(0)" ::: "memory");
            const unsigned og = xb_add(&bar[XB_TOP], 1u);
            const unsigned tg = og / nx;
            if (og + 1u == (tg + 1u) * nx) xb_add(&bar[XB_TOPGEN], 1u);
            else XB_SPIN(xb_ld(&bar[XB_TOPGEN]) == tg, bar);
            __builtin_amdgcn_fence(__ATOMIC_ACQUIRE, "agent");
            xb_add(&bar[XB_XGEN(b.x)], 1u);
            asm volatile("s_waitcnt vmcnt(0)" ::: "memory");
        } else {
            XB_SPIN(xb_ld(&bar[XB_XGEN(b.x)]) == gen, bar);
            __builtin_amdgcn_fence(__ATOMIC_ACQUIRE, "agent");
            asm volatile("s_waitcnt vmcnt(0)" ::: "memory");
        }
    }
    __syncthreads();
}

namespace pg8 {
constexpr int BM = 256, BK = 64, HALF = 128, HTB = HALF * BK * 2, STAGE_BYTES = 8 * HTB;
__host__ __device__ __forceinline__ int lds_byte(int r, int c) { const int st = (r >> 4) * 2 + (c >> 5), rr = r & 15, cc = c & 31, ob = rr * 64 + cc * 2; return st * 1024 + (ob ^ (((ob >> 9) & 1) << 5)); }
__host__ __device__ __forceinline__ void stage_rc(int b, int& R, int& C) { const int st = b / 1024, sb = b % 1024, swz = sb ^ (((sb >> 9) & 1) << 5); R = (st >> 1) * 16 + swz / 64; C = (st & 1) * 32 + (swz % 64) / 2; }
__host__ __device__ __forceinline__ int perm32(int rho) { const int n = rho >> 4, i = rho & 15; return 8 * (i >> 2) + 4 * n + (i & 3); }
__host__ __device__ __forceinline__ int perm16x(int rho) { const int n = rho >> 4, i = rho & 15; return 16 * (i >> 2) + 4 * n + (i & 3); }

struct Unit { int pm, pn; };
template <class P>
__device__ __forceinline__ void gemm_phase(LAS unsigned char* lds, LAS unsigned char* ldsctl, P& S, const int tid) {
    const int wid = __builtin_amdgcn_readfirstlane(tid >> 6), lane = tid & 63, wr = wid >> 2, wc = wid & 3, fr = lane & 15, fq = lane >> 4;
    constexpr bool F8 = P::FP8;
    constexpr int K = P::K, ES = F8 ? 1 : 2, nt = K * ES / 128;
    int R0, C0, R1, C1; stage_rc(tid * 16, R0, C0); stage_rc(tid * 16 + 8192, R1, C1);
    unsigned voffB[2];
    {
        const int Rb0 = P::BROW64 == 2 ? (64 * (R0 >> 5) + perm16x(R0 & 31)) : P::BROW64 ? (64 * (R0 >> 5) + perm32(R0 & 31)) : ((R0 & ~31) + perm32(R0 & 31));
        const int Rb1 = P::BROW64 == 2 ? (64 * (R1 >> 5) + perm16x(R1 & 31)) : P::BROW64 ? (64 * (R1 >> 5) + perm32(R1 & 31)) : ((R1 & ~31) + perm32(R1 & 31));
        voffB[0] = (unsigned)(Rb0 * K * ES + 2 * C0); voffB[1] = (unsigned)(Rb1 * K * ES + 2 * C1);
    }
    const unsigned ldsw = (unsigned)wid * 1024u;
    const int scl8 = P::SCALE_AB;
    const int aoff = lds_byte(wr * 64 + fr, fq * 8), boff = lds_byte(wc * 32 + fr, fq * 8);
#define PG8_SA(b, h) (((b) * 2 + (h)) * HTB)
#define PG8_SB(b, h) ((4 + (b) * 2 + (h)) * HTB)
    const unsigned ldsbase = (unsigned)__builtin_amdgcn_readfirstlane((int)(unsigned)(uintptr_t)lds + (int)ldsw);
#define PG8_GLDS(sbase, voff, ldsdst) do { if (P::NODMA) break; unsigned _keep; asm volatile("s_mov_b32 %0, m0\n\ts_mov_b32 m0, %3\n\ts_nop 0\n\tglobal_load_lds_dwordx4 %2, %1\n\ts_mov_b32 m0, %0" \
        : "=&s"(_keep) : "s"(sbase), "v"(voff), "s"(ldsdst) : "memory"); } while (0)
#define PG8_STAGE_A(bufoff, vo, h, kofs) do { _Pragma("unroll") for (int _i = 0; _i < 2; ++_i) \
        PG8_GLDS(Abase, (vo)[P::GATHER ? (h) : 0][_i] + ((kofs) + (P::GATHER ? 0u : (unsigned)(h) * HSTEPA)), ldsbase + (unsigned)((bufoff) + _i * 8192)); } while (0)
#define PG8_STAGE_B(bufoff, gbase) do { _Pragma("unroll") for (int _i = 0; _i < 2; ++_i) \
        PG8_GLDS((const char*)(gbase), voffB[_i], ldsbase + (unsigned)((bufoff) + _i * 8192)); } while (0)
#define PG8_LDA(dst, b, h) do { if constexpr (F8) { _Pragma("unroll") for (int m = 0; m < 4; ++m) { const u32x4 _l = *(const LAS u32x4*)(lds + PG8_SA(b, h) + aoff + m * 2048), _h = *(const LAS u32x4*)(lds + PG8_SA(b, h) + aoff + m * 2048 + 1024); dst##8[m] = __builtin_bit_cast(v8i32, __builtin_shufflevector(_l, _h, 0, 1, 2, 3, 4, 5, 6, 7)); } } \
        else { _Pragma("unroll") for (int m = 0; m < 4; ++m) _Pragma("unroll") for (int k = 0; k < 2; ++k) dst[m][k] = *(const LAS bf16x8*)(lds + PG8_SA(b, h) + aoff + m * 2048 + k * 1024); } } while (0)
#define PG8_LDB(dst, b, h) do { if constexpr (F8) { _Pragma("unroll") for (int n = 0; n < 2; ++n) { const u32x4 _l = *(const LAS u32x4*)(lds + PG8_SB(b, h) + boff + n * 2048), _h = *(const LAS u32x4*)(lds + PG8_SB(b, h) + boff + n * 2048 + 1024); dst##8[n] = __builtin_bit_cast(v8i32, __builtin_shufflevector(_l, _h, 0, 1, 2, 3, 4, 5, 6, 7)); } } \
        else { _Pragma("unroll") for (int n = 0; n < 2; ++n) _Pragma("unroll") for (int k = 0; k < 2; ++k) dst[n][k] = *(const LAS bf16x8*)(lds + PG8_SB(b, h) + boff + n * 2048 + k * 1024); } } while (0)
#define PG8_MMA(ai, bj, At, Bt) do { __builtin_amdgcn_s_setprio(1); \
        if constexpr (F8) { _Pragma("unroll") for (int m = 0; m < 4; ++m) _Pragma("unroll") for (int n = 0; n < 2; ++n) \
            asm volatile("v_mfma_scale_f32_16x16x128_f8f6f4 %0, %1, %2, %0, %3, %3 op_sel:[0,1,0] op_sel_hi:[0,0,0]" : "+v"(acc[ai][bj][m][n]) : "v"(Bt##8[n]), "v"(At##8[m]), "v"(scl8)); } \
        else { _Pragma("unroll") for (int m = 0; m < 4; ++m) _Pragma("unroll") for (int n = 0; n < 2; ++n) _Pragma("unroll") for (int k = 0; k < 2; ++k) \
            acc[ai][bj][m][n] = __builtin_amdgcn_mfma_f32_16x16x32_bf16(Bt[n][k], At[m][k], acc[ai][bj][m][n], 0, 0, 0); } \
        __builtin_amdgcn_s_setprio(0); } while (0)
#define PG8_WAIT_V(n) asm volatile("s_waitcnt vmcnt(" #n ")" ::: "memory")
#define PG8_WAIT_L(n) asm volatile("s_waitcnt lgkmcnt(" #n ")" ::: "memory")
#define PG8_BAR __builtin_amdgcn_s_barrier()
#define PG8_SCHED __builtin_amdgcn_sched_barrier(0)
    Unit cur, nxt; int ui = 0;
    if (!S.next(0, cur)) return;
    f32x4 acc[2][2][4][2];
#pragma unroll
    for (int a = 0; a < 2; ++a)
#pragma unroll
        for (int b = 0; b < 2; ++b)
#pragma unroll
            for (int m = 0; m < 4; ++m)
#pragma unroll
                for (int n = 0; n < 2; ++n) acc[a][b][m][n] = (f32x4){0.f, 0.f, 0.f, 0.f};
    bf16x8 At[4][2], B0[2][2], B1[2][2]; v8i32 At8[4], B08[2], B18[2];
    const char* const Abase = S.a_base();
    unsigned voffA[2][2], voffAn[2][2];
    const char *cB0, *cB1;
    S.unit_begin(cur, ldsctl, tid, 0);
    S.a_offs(cur, R0, C0, R1, C1, voffA, true);
    asm volatile("" ::: "memory");
    S.b_ptrs(cur, cB0, cB1);
    constexpr unsigned kstep = 128, HSTEPA = (unsigned)HALF * K * ES;
    PG8_STAGE_B(PG8_SB(0, 0), cB0); PG8_STAGE_B(PG8_SB(0, 1), cB1); PG8_STAGE_A(PG8_SA(0, 0), voffA, 0, 0u); PG8_STAGE_A(PG8_SA(0, 1), voffA, 1, 0u);
    if (wr == 1) PG8_BAR;
    PG8_WAIT_V(2); PG8_BAR;
    PG8_STAGE_B(PG8_SB(1, 0), cB0 + kstep); PG8_STAGE_A(PG8_SA(1, 0), voffA, 0, kstep); PG8_STAGE_B(PG8_SB(1, 1), cB1 + kstep);
    PG8_WAIT_V(6); PG8_BAR;
    for (;;) {
        const bool has_next = S.next(ui + 1, nxt);
        const char *nB0 = cB0, *nB1 = cB1;
        if constexpr (P::GATHER) {
#pragma unroll
            for (int h = 0; h < 2; ++h)
#pragma unroll
                for (int i = 0; i < 2; ++i) voffAn[h][i] = voffA[h][i];
        }
        if (has_next) { S.unit_begin(nxt, ldsctl, tid, (ui + 1) & 1); S.b_ptrs(nxt, nB0, nB1);
            if constexpr (P::GATHER) { int t2 = tid; asm volatile("" : "+v"(t2)); int r0, c0, r1, c1; stage_rc(t2 * 16, r0, c0); stage_rc(t2 * 16 + 8192, r1, c1); S.a_offs(nxt, r0, c0, r1, c1, voffAn, false); } }
        { int l3 = tid; asm volatile("" : "+v"(l3)); S.epi_prefetch(cur, wr, wc, l3 & 15, (l3 >> 4) & 3); }
#pragma unroll 1
        for (int t = 0; t < nt; t += 2) {
            const bool last = (t == nt - 2);
            S.midk(acc, cur, t, wr, fr, ldsctl, ui & 1);
            unsigned a2o[2][2];
            if constexpr (!P::GATHER) { if (last) { int t2 = tid; asm volatile("" : "+v"(t2)); int r0, c0, r1, c1; stage_rc(t2 * 16, r0, c0); stage_rc(t2 * 16 + 8192, r1, c1);
                                                   S.a_offs(has_next ? nxt : cur, r0, c0, r1, c1, voffAn, false); } }
#pragma unroll
            for (int h = 0; h < 2; ++h)
#pragma unroll
                for (int i = 0; i < 2; ++i) a2o[h][i] = last ? voffAn[h][i] : voffA[h][i] + (unsigned)(t + 2) * kstep;
            const char* b2h0 = last ? nB0 : cB0 + (size_t)(t + 2) * kstep; const char* b2h1 = last ? nB1 : cB1 + (size_t)(t + 2) * kstep;
            const unsigned a1k = (unsigned)(t + 1) * kstep;
            PG8_LDB(B0, 0, 0); PG8_LDB(B1, 0, 1); PG8_SCHED; PG8_LDA(At, 0, 0); PG8_STAGE_A(PG8_SA(1, 1), voffA, 1, a1k);
            PG8_WAIT_V(8); PG8_WAIT_L(0); PG8_BAR; PG8_MMA(0, 0, At, B0); PG8_MMA(0, 1, At, B1); PG8_BAR; PG8_SCHED;
            PG8_LDA(At, 0, 1); PG8_STAGE_B(PG8_SB(0, 0), b2h0); PG8_STAGE_B(PG8_SB(0, 1), b2h1); PG8_STAGE_A(PG8_SA(0, 0), a2o, 0, 0u);
            PG8_WAIT_V(8); PG8_WAIT_L(0); PG8_BAR; PG8_MMA(1, 0, At, B0); PG8_MMA(1, 1, At, B1); PG8_BAR; PG8_SCHED;
            PG8_LDB(B0, 1, 0); PG8_LDB(B1, 1, 1); PG8_SCHED; PG8_LDA(At, 1, 0); PG8_STAGE_A(PG8_SA(0, 1), a2o, 1, 0u);
            PG8_WAIT_V(8); PG8_WAIT_L(0); PG8_BAR; PG8_MMA(0, 0, At, B0); PG8_MMA(0, 1, At, B1); PG8_BAR; PG8_SCHED;
            PG8_LDA(At, 1, 1); PG8_STAGE_B(PG8_SB(1, 0), b2h0 + kstep); PG8_STAGE_B(PG8_SB(1, 1), b2h1 + kstep); PG8_STAGE_A(PG8_SA(1, 0), a2o, 0, kstep);
            PG8_WAIT_V(8); PG8_WAIT_L(0); PG8_BAR; PG8_MMA(1, 0, At, B0); PG8_MMA(1, 1, At, B1); PG8_BAR; PG8_SCHED;
        }
        if (wr == 0) PG8_BAR;
        if constexpr (F8) asm volatile("s_nop 15\n\ts_nop 15" ::: "memory");
        { int l2 = tid; asm volatile("" : "+v"(l2)); if (!P::NOEPI) S.epi(acc, cur, wr, wc, l2 & 15, (l2 >> 4) & 3); }
        if (!has_next) break;
#pragma unroll
        for (int a = 0; a < 2; ++a)
#pragma unroll
            for (int b = 0; b < 2; ++b)
#pragma unroll
                for (int m = 0; m < 4; ++m)
#pragma unroll
                    for (int n = 0; n < 2; ++n) acc[a][b][m][n] = (f32x4){0.f, 0.f, 0.f, 0.f};
        cur = nxt; cB0 = nB0; cB1 = nB1; ++ui;
#pragma unroll
        for (int h = 0; h < 2; ++h)
#pragma unroll
            for (int i = 0; i < 2; ++i) voffA[h][i] = voffAn[h][i];
        if (wr == 1) PG8_BAR;
    }
    PG8_WAIT_V(0);
    PG8_BAR;
#undef PG8_SA
#undef PG8_SB
#undef PG8_STAGE_A
#undef PG8_GLDS
#undef PG8_STAGE_B
#undef PG8_LDA
#undef PG8_LDB
#undef PG8_MMA
#undef PG8_WAIT_V
#undef PG8_WAIT_L
#undef PG8_BAR
#undef PG8_SCHED
}
struct StaticOrder {
    int nM, nN, nwg, G, c;
    __device__ void init(int M, int N, int G_, int c_) { nM = M / BM; nN = N / BM; nwg = nM * nN; G = G_; c = c_; }
    __device__ bool next(int i, Unit& u) const {
        const long L = (long)i * G + c; if (L >= nwg) return false;
        int wgid = (int)L; { const int q = nwg / 8, r = nwg % 8, xcd = wgid % 8, off = wgid / 8; wgid = (xcd < r ? xcd * (q + 1) : r * (q + 1) + (xcd - r) * q) + off; }
        const int nig = 8 * nN, gid = wgid / nig, fm = gid * 8, gsz = (nM - fm) < 8 ? (nM - fm) : 8;
        u.pm = fm + ((wgid % nig) % gsz); u.pn = (wgid % nig) / gsz; return true;
    }
};
}

struct Frame {
    LAS unsigned char* lds; LAS unsigned char* ctl;
    unsigned char* ws;
    int tid, lane, wave, G, bx;
    float* out; const struct Args* ap; unsigned char* ws0; float* out0; size_t z;
};

struct Args { const float* in[28]; float* out; unsigned char* ws; int ph_lo, ph_hi; };
#define arg_in(i) (F.ap->in[i] + F.z)
__device__ __forceinline__ void phase_begin(Frame& F) {
    int t = F.tid; asm volatile("" : "+v"(t)); F.tid = t; F.lane = t & 63; F.wave = __builtin_amdgcn_readfirstlane(t >> 6);
    size_t z = 0; asm volatile("" : "+s"(z)); F.z = z; F.ws = F.ws0 + z; F.out = F.out0 + z;
    int bx = F.bx; asm volatile("" : "+s"(bx)); F.bx = bx;
}
__device__ __forceinline__ void phase_restart(Frame& F) {
    int wv = F.wave; asm volatile("" : "+s"(wv)); F.wave = wv;
    int ln = (int)__builtin_amdgcn_mbcnt_hi(~0u, __builtin_amdgcn_mbcnt_lo(~0u, 0u)); asm volatile("" : "+v"(ln)); F.lane = ln; F.tid = wv * 64 + ln;
    size_t z = 0; asm volatile("" : "+s"(z)); F.z = z; F.ws = F.ws0 + z; F.out = F.out0 + z;
}
struct PBase {
    static constexpr bool GATHER = false, FP8 = false, NODMA = false, NOEPI = false; static constexpr int SCALE_AB = 0x7f7f7f7f;
    __device__ __forceinline__ void unit_begin(const pg8::Unit&, LAS unsigned char*, int, int) {}
    __device__ __forceinline__ void midk(f32x4 (&)[2][2][4][2], const pg8::Unit&, int, int, int, LAS unsigned char*, int) {}
    __device__ __forceinline__ void a_fix(unsigned (&)[2][2]) {}
    __device__ __forceinline__ void epi_prefetch(const pg8::Unit&, int, int, int, int) {}
};
struct PInProj : PBase {
    static constexpr int K = 1024, BROW64 = 1;
    pg8::StaticOrder so; const char* A; const char* B; bf16_t* UQKV; const float *GQK, *COS, *SIN;
    __device__ __forceinline__ bool next(int i, pg8::Unit& u) const { return so.next(i, u); }
    __device__ __forceinline__ const char* a_base() const { return A; }
    __device__ __forceinline__ void a_offs(const pg8::Unit& u, int R0, int C0, int R1, int C1, unsigned (&vo)[2][2], bool) const {
#pragma unroll
        for (int h = 0; h < 2; ++h) { vo[h][0] = (unsigned)((u.pm * 256 + 128 * h + R0) * K + C0) * 2u; vo[h][1] = (unsigned)((u.pm * 256 + 128 * h + R1) * K + C1) * 2u; }
    }
    __device__ __forceinline__ void b_ptrs(const pg8::Unit& u, const char*& b0, const char*& b1) const { b0 = B + (size_t)u.pn * 256 * K * 2; b1 = b0 + (size_t)32 * K * 2; }
    __device__ __forceinline__ void epi(f32x4 (&acc)[2][2][4][2], const pg8::Unit& u, int wr, int wc, int fr, int fq) const {
        const int kind = u.pn >> 1;
        const int colg = (u.pn & 1) * 256 + 64 * wc;
        bf16_t* dst = UQKV + (size_t)kind * (size_t)(16u << 20);
        const int row0 = u.pm * 256 + wr * 64 + fr;
        if (kind == 0 || kind == 3) {
#pragma unroll
            for (int ai = 0; ai < 2; ++ai)
#pragma unroll
                for (int m = 0; m < 4; ++m) { bf16_t* rowp = dst + (size_t)(row0 + ai * 128 + m * 16) * 512 + colg + 8 * fq;
#pragma unroll
                    for (int bj = 0; bj < 2; ++bj) { const f32x4 v0 = acc[ai][bj][m][0], v1 = acc[ai][bj][m][1];
                        u32x4 w; w.x = cvt_pk_bf16(v0[0], v0[1]); w.y = cvt_pk_bf16(v0[2], v0[3]); w.z = cvt_pk_bf16(v1[0], v1[1]); w.w = cvt_pk_bf16(v1[2], v1[3]);
                        *(u32x4*)(rowp + 32 * bj) = w; } }
        } else {
            const float* g = GQK + (kind - 1) * 64; const float sc = kind == 1 ? C2 * 32.0f : 16.0f;
            f32x4 g0[2], g1[2];
#pragma unroll
            for (int n = 0; n < 2; ++n) { g0[n] = *(const f32x4*)(g + 8 * fq + 4 * n); g1[n] = *(const f32x4*)(g + 32 + 8 * fq + 4 * n); }
#pragma unroll
            for (int ai = 0; ai < 2; ++ai)
#pragma unroll
                for (int m = 0; m < 4; ++m) {
                    const int row = row0 + ai * 128 + m * 16; const int pos = row & (SEQ - 1);
                    float ss = 0.f;
#pragma unroll
                    for (int bj = 0; bj < 2; ++bj)
#pragma unroll
                        for (int n = 0; n < 2; ++n) { const f32x4 x = acc[ai][bj][m][n]; ss += (x[0] * x[0] + x[1] * x[1]) + (x[2] * x[2] + x[3] * x[3]); }
                    ss += __shfl_xor(ss, 16); ss += __shfl_xor(ss, 32);
                    const float r = rsqrtf(ss * (1.f / 64.f) + EPS) * sc;
                    f32x4 o1[2], o2[2];
#pragma unroll
                    for (int n = 0; n < 2; ++n) {
                        const f32x4 c = *(const f32x4*)(COS + (size_t)pos * 32 + 8 * fq + 4 * n), s = *(const f32x4*)(SIN + (size_t)pos * 32 + 8 * fq + 4 * n);
                        const f32x4 x1 = acc[ai][0][m][n] * g0[n] * r, x2 = acc[ai][1][m][n] * g1[n] * r;
                        o1[n] = x1 * c - x2 * s; o2[n] = x2 * c + x1 * s;
                    }
                    unsigned char* rowp = (unsigned char*)dst + (size_t)row * 512 + colg + 8 * fq;
                    u32x2 w; w.x = pk4_fp8(o1[0][0], o1[0][1], o1[0][2], o1[0][3]); w.y = pk4_fp8(o1[1][0], o1[1][1], o1[1][2], o1[1][3]);
                    *(u32x2*)(rowp) = w;
                    w.x = pk4_fp8(o2[0][0], o2[0][1], o2[0][2], o2[0][3]); w.y = pk4_fp8(o2[1][0], o2[1][1], o2[1][2], o2[1][3]);
                    *(u32x2*)(rowp + 32) = w;
                    asm volatile("" ::: "memory");
                }
        }
    }
};
struct PGlu : PBase {
    static constexpr int K = 512, BROW64 = 0;
    pg8::StaticOrder so; const char* A; const char* B; const bf16_t* YG; bf16_t* MIX; float* RSP;
    __device__ __forceinline__ bool next(int i, pg8::Unit& u) const { return so.next(i, u); }
    __device__ __forceinline__ const char* a_base() const { return A; }
    __device__ __forceinline__ void a_offs(const pg8::Unit& u, int R0, int C0, int R1, int C1, unsigned (&vo)[2][2], bool) const {
#pragma unroll
        for (int h = 0; h < 2; ++h) { vo[h][0] = (unsigned)((u.pm * 256 + 128 * h + R0) * K + C0) * 2u; vo[h][1] = (unsigned)((u.pm * 256 + 128 * h + R1) * K + C1) * 2u; }
    }
    __device__ __forceinline__ void b_ptrs(const pg8::Unit& u, const char*& b0, const char*& b1) const { b0 = B + (size_t)u.pn * 256 * K * 2; b1 = b0 + (size_t)128 * K * 2; }
    __device__ __forceinline__ void epi(f32x4 (&acc)[2][2][4][2], const pg8::Unit& u, int wr, int wc, int fr, int fq) const {
        const int row0 = u.pm * 256 + wr * 64 + fr, col0 = u.pn * 256 + wc * 32 + 8 * fq;
#pragma unroll
        for (int ai = 0; ai < 2; ++ai)
#pragma unroll
            for (int m = 0; m < 4; ++m) {
                const int row = row0 + ai * 128 + m * 16; float ss = 0.f;
#pragma unroll
                for (int bj = 0; bj < 2; ++bj) {
                    const u32x4 yw = *(const u32x4*)(YG + (size_t)row * 512 + col0 + 128 * bj);
                    const f32x4 a0 = acc[ai][bj][m][0], a1 = acc[ai][bj][m][1];
                    float z[8];
                    z[0] = bf_lo(yw.x) * sigmoidf(a0[0]); z[1] = bf_hi(yw.x) * sigmoidf(a0[1]); z[2] = bf_lo(yw.y) * sigmoidf(a0[2]); z[3] = bf_hi(yw.y) * sigmoidf(a0[3]);
                    z[4] = bf_lo(yw.z) * sigmoidf(a1[0]); z[5] = bf_hi(yw.z) * sigmoidf(a1[1]); z[6] = bf_lo(yw.w) * sigmoidf(a1[2]); z[7] = bf_hi(yw.w) * sigmoidf(a1[3]);
#pragma unroll
                    for (int i = 0; i < 8; ++i) ss += z[i] * z[i];
                    u32x4 w; w.x = cvt_pk_bf16(z[0], z[1]); w.y = cvt_pk_bf16(z[2], z[3]); w.z = cvt_pk_bf16(z[4], z[5]); w.w = cvt_pk_bf16(z[6], z[7]);
                    *(u32x4*)(MIX + (size_t)row * 1024 + col0 + 128 * bj) = w;
                }
                ss += __shfl_xor(ss, 16); ss += __shfl_xor(ss, 32);
                if (fq == 0) RSP[(size_t)row * 8 + u.pn * 4 + wc] = ss;
            }
    }
};
struct POut : PBase {
    static constexpr int K = 1024, BROW64 = 0;
    pg8::StaticOrder so; const char* A; const char* B; const float* RSP; const float* base32; const bf16_t* base16; bf16_t* H1;
    __device__ __forceinline__ bool next(int i, pg8::Unit& u) const { return so.next(i, u); }
    __device__ __forceinline__ const char* a_base() const { return A; }
    __device__ __forceinline__ void a_offs(const pg8::Unit& u, int R0, int C0, int R1, int C1, unsigned (&vo)[2][2], bool) const {
#pragma unroll
        for (int h = 0; h < 2; ++h) { vo[h][0] = (unsigned)((u.pm * 256 + 128 * h + R0) * K + C0) * 2u; vo[h][1] = (unsigned)((u.pm * 256 + 128 * h + R1) * K + C1) * 2u; }
    }
    __device__ __forceinline__ void b_ptrs(const pg8::Unit& u, const char*& b0, const char*& b1) const { b0 = B + (size_t)u.pn * 256 * K * 2; b1 = b0 + (size_t)128 * K * 2; }
    __device__ __forceinline__ void unit_begin(const pg8::Unit& u, LAS unsigned char* ldsctl, int tid, int slot) const {
        if (tid < 256) {
            const f32x4 p0 = *(const f32x4*)(RSP + (size_t)(u.pm * 256 + tid) * 8), p1 = *(const f32x4*)(RSP + (size_t)(u.pm * 256 + tid) * 8 + 4);
            const float ss = ((p0[0] + p0[1]) + (p0[2] + p0[3])) + ((p1[0] + p1[1]) + (p1[2] + p1[3]));
            ((LAS float*)(ldsctl + 1024 + slot * 1024))[tid] = rsqrtf(ss * (1.f / 512.f) + EPS);
        }
    }
    __device__ __forceinline__ void midk(f32x4 (&acc)[2][2][4][2], const pg8::Unit& u, int t, int wr, int fr, LAS unsigned char* ldsctl, int slot) const {
        if (t == 8) {
            const LAS float* rs = (const LAS float*)(ldsctl + 1024 + slot * 1024);
#pragma unroll
            for (int ai = 0; ai < 2; ++ai)
#pragma unroll
                for (int m = 0; m < 4; ++m) { const float r = rs[ai * 128 + wr * 64 + m * 16 + fr];
#pragma unroll
                    for (int bj = 0; bj < 2; ++bj)
#pragma unroll
                        for (int n = 0; n < 2; ++n) acc[ai][bj][m][n] *= r; }
        }
    }
    __device__ __forceinline__ void epi(f32x4 (&acc)[2][2][4][2], const pg8::Unit& u, int wr, int wc, int fr, int fq) const {
        const int row0 = u.pm * 256 + wr * 64 + fr, col0 = u.pn * 256 + wc * 32 + 8 * fq;
#pragma unroll
        for (int ai = 0; ai < 2; ++ai)
#pragma unroll
            for (int m = 0; m < 4; ++m) { const size_t off = (size_t)(row0 + ai * 128 + m * 16) * 1024 + col0;
#pragma unroll
                for (int bj = 0; bj < 2; ++bj) {
                    f32x4 v0 = acc[ai][bj][m][0], v1 = acc[ai][bj][m][1];
                    if (base32) { v0 += *(const f32x4*)(base32 + off + bj * 128); v1 += *(const f32x4*)(base32 + off + bj * 128 + 4); }
                    else { const u32x4 b = *(const u32x4*)(base16 + off + bj * 128); v0[0] += bf_lo(b.x); v0[1] += bf_hi(b.x); v0[2] += bf_lo(b.y); v0[3] += bf_hi(b.y); v1[0] += bf_lo(b.z); v1[1] += bf_hi(b.z); v1[2] += bf_lo(b.w); v1[3] += bf_hi(b.w); }
                    u32x4 w; w.x = cvt_pk_bf16(v0[0], v0[1]); w.y = cvt_pk_bf16(v0[2], v0[3]); w.z = cvt_pk_bf16(v1[0], v1[1]); w.w = cvt_pk_bf16(v1[2], v1[3]);
                    *(u32x4*)(H1 + off + bj * 128) = w; }
                if (m & 1) asm volatile("" ::: "memory"); }
    }
};
template <int NN> struct MoeOrder {
    int j, wpx, s0, s1, s2, s3, n0, n1, n2, n3;
    __device__ __forceinline__ void init(int G, int c, const int* PST) {
#ifndef MOE_XA
#define MOE_XA 2
#endif
#ifndef MOE_CHUNKED
#define MOE_CHUNKED 0
#endif
        if (MOE_XA == 1 && (G & 7) == 0) { wpx = G >> 3; const int x = MOE_CHUNKED ? c / wpx : (c & 7); j = MOE_CHUNKED ? c % wpx : (c >> 3);
            s0 = PST[x] >> 8; n0 = (PST[x + 1] - PST[x]) >> 8; s1 = PST[x + 8] >> 8; n1 = (PST[x + 9] - PST[x + 8]) >> 8;
            s2 = PST[x + 16] >> 8; n2 = (PST[x + 17] - PST[x + 16]) >> 8; s3 = PST[x + 24] >> 8; n3 = (PST[x + 25] - PST[x + 24]) >> 8; }
        else { j = c; wpx = G; s0 = 0; n0 = PST[32] >> 8; s1 = s2 = s3 = 0; n1 = n2 = n3 = 0; }
        if (MOE_XA == 2 && (G & 7) == 0) { wpx = G >> 3; j = c >> 3; s1 = c & 7; n0 = PST[32] >> 8; }
    }
    __device__ __forceinline__ bool next(int i, pg8::Unit& u) const {
        const int q = i * wpx + j; int pml = q / NN; u.pn = q % NN;
        if (MOE_XA == 2) { u.pm = s1 + 8 * pml; return u.pm < n0; }
        if (pml < n0) { u.pm = s0 + pml; return true; } pml -= n0;
        if (pml < n1) { u.pm = s1 + pml; return true; } pml -= n1;
        if (pml < n2) { u.pm = s2 + pml; return true; } pml -= n2;
        if (pml < n3) { u.pm = s3 + pml; return true; }
        return false;
    }
};
struct PUp : PBase {
    static constexpr int K = 1024, BROW64 = 0; static constexpr bool GATHER = true, FP8 = UP_FP8; static constexpr int ES = UP_FP8 ? 1 : 2;
    static constexpr int SCALE_AB = 0x7c79;
    MoeOrder<8> mo; const char* A; const char* B; const int* ROWTOK; const int* TILEEXP; const float* bup; const float* ROWSCALE; bf16_t* ACT;
    int idx[2][2]; int c0, c1;
    __device__ __forceinline__ bool next(int i, pg8::Unit& u) const { return mo.next(i, u); }
    __device__ __forceinline__ const char* a_base() const { return A; }
    __device__ __forceinline__ void a_offs(const pg8::Unit& u, int R0, int C0, int R1, int C1, unsigned (&vo)[2][2], bool first) {
        c0 = C0; c1 = C1;
        const int* rp = ROWTOK + u.pm * 256;
#pragma unroll
        for (int h = 0; h < 2; ++h) {
            asm volatile("global_load_dword %0, %1, off" : "=v"(idx[h][0]) : "v"(rp + 128 * h + R0) : "memory");
            asm volatile("global_load_dword %0, %1, off" : "=v"(idx[h][1]) : "v"(rp + 128 * h + R1) : "memory");
        }
        asm volatile("s_waitcnt vmcnt(0)" : "+v"(idx[0][0]), "+v"(idx[0][1]), "+v"(idx[1][0]), "+v"(idx[1][1]) :: "memory");
#pragma unroll
        for (int h = 0; h < 2; ++h) { vo[h][0] = (unsigned)(idx[h][0] * K * ES + 2 * c0); vo[h][1] = (unsigned)(idx[h][1] * K * ES + 2 * c1); }
    }
    __device__ __forceinline__ void b_ptrs(const pg8::Unit& u, const char*& b0, const char*& b1) const {
        const int e = TILEEXP[u.pm]; b0 = B + ((size_t)e * 2048 + (size_t)u.pn * 128) * K * ES; b1 = b0 + (size_t)1024 * K * ES; }
    float ps[8]; f32x4 pbg[2], pbl[2];
    __device__ __forceinline__ void epi_prefetch(const pg8::Unit& u, int wr, int wc, int fr, int fq) {
        const int e = TILEEXP[u.pm];
        const int row0 = u.pm * 256 + wr * 64 + fr, col0 = u.pn * 128 + wc * 32 + 8 * fq;
        const float* bg = bup + (size_t)e * 2048 + col0; const float* bl = bg + 1024;
#pragma unroll
        for (int ai = 0; ai < 2; ++ai)
#pragma unroll
            for (int m = 0; m < 4; ++m) asm volatile("global_load_dword %0, %1, off" : "=v"(ps[ai * 4 + m]) : "v"(ROWSCALE + row0 + ai * 128 + m * 16) : "memory");
#pragma unroll
        for (int n = 0; n < 2; ++n) { asm volatile("global_load_dwordx4 %0, %1, off" : "=v"(pbg[n]) : "v"(bg + 4 * n) : "memory"); asm volatile("global_load_dwordx4 %0, %1, off" : "=v"(pbl[n]) : "v"(bl + 4 * n) : "memory"); }
    }
    __device__ __forceinline__ void epi(f32x4 (&acc)[2][2][4][2], const pg8::Unit& u, int wr, int wc, int fr, int fq) {
        const int row0 = u.pm * 256 + wr * 64 + fr, col0 = u.pn * 128 + wc * 32 + 8 * fq;
        asm volatile("" : "+v"(ps[0]), "+v"(ps[1]), "+v"(ps[2]), "+v"(ps[3]), "+v"(ps[4]), "+v"(ps[5]), "+v"(ps[6]), "+v"(ps[7]), "+v"(pbg[0]), "+v"(pbg[1]), "+v"(pbl[0]), "+v"(pbl[1]));
        f32x4 bg4[2], bl1[2];
#pragma unroll
        for (int n = 0; n < 2; ++n) { bg4[n] = pbg[n] * 4.0f; bl1[n] = pbl[n] + 1.0f; }
        constexpr float CS = -2.4554669595f * 0.25f;
#pragma unroll
        for (int ai = 0; ai < 2; ++ai) {
            u32x2 w8[4];
#pragma unroll
            for (int m = 0; m < 4; ++m) {
                const float rs = ps[ai * 4 + m], rs4 = rs * 4.0f;
                f32x4 av[2];
#pragma unroll
                for (int n = 0; n < 2; ++n) {
                    f32x4 G = acc[ai][0][m][n] * rs4 + bg4[n], L = acc[ai][1][m][n] * rs + bl1[n], E;
#pragma unroll
                    for (int j = 0; j < 4; ++j) { G[j] = fminf(G[j], 28.0f); L[j] = __builtin_amdgcn_fmed3f(L[j], -6.0f, 8.0f); }
                    const f32x4 X = G * CS;
#pragma unroll
                    for (int j = 0; j < 4; ++j) E[j] = __builtin_amdgcn_exp2f(X[j]);
                    E = E + 1.0f;
#pragma unroll
                    for (int j = 0; j < 4; ++j) E[j] = __builtin_amdgcn_rcpf(E[j]);
                    av[n] = G * E * L;
                }
                w8[m].x = pk4_fp8(av[0][0], av[0][1], av[0][2], av[0][3]); w8[m].y = pk4_fp8(av[1][0], av[1][1], av[1][2], av[1][3]);
            }
            const bool odd = fq & 1;
#pragma unroll
            for (int mp = 0; mp < 2; ++mp) {
                const u32x2 snd = odd ? w8[2 * mp] : w8[2 * mp + 1], own = odd ? w8[2 * mp + 1] : w8[2 * mp];
                u32x2 rcv; rcv.x = (unsigned)__shfl_xor((int)snd.x, 16); rcv.y = (unsigned)__shfl_xor((int)snd.y, 16);
                const u32x4 w = odd ? (u32x4){rcv.x, rcv.y, own.x, own.y} : (u32x4){own.x, own.y, rcv.x, rcv.y};
                const int row = row0 + ai * 128 + (2 * mp + (odd ? 1 : 0)) * 16;
                *(u32x4*)((unsigned char*)ACT + (size_t)row * 1024 + u.pn * 128 + wc * 32 + 16 * (fq >> 1)) = w;
            }
        }
    }
};
struct PUpNoDma : PUp { static constexpr bool NODMA = (GEMM_PROBE_KIND & 1) != 0, NOEPI = (GEMM_PROBE_KIND & 2) != 0; };
struct PDown : PBase {
    static constexpr int K = 1024, BROW64 = 2; static constexpr bool FP8 = DN_FP8; static constexpr int ES = DN_FP8 ? 1 : 2;
    static constexpr int SCALE_AB = 0x7d79;
    MoeOrder<4> mo; const char* A; const char* B; const int* TILEEXP; const float* bdn; const float* ROWGATE; bf16_t* YB;
    __device__ __forceinline__ bool next(int i, pg8::Unit& u) const { return mo.next(i, u); }
    __device__ __forceinline__ const char* a_base() const { return A; }
    __device__ __forceinline__ void a_offs(const pg8::Unit& u, int R0, int C0, int R1, int C1, unsigned (&vo)[2][2], bool) const {
#pragma unroll
        for (int h = 0; h < 2; ++h) { vo[h][0] = (unsigned)((u.pm * 256 + 128 * h + R0) * K * ES + 2 * C0); vo[h][1] = (unsigned)((u.pm * 256 + 128 * h + R1) * K * ES + 2 * C1); }
    }
    __device__ __forceinline__ void b_ptrs(const pg8::Unit& u, const char*& b0, const char*& b1) const {
        const int e = TILEEXP[u.pm]; b0 = B + ((size_t)e * 1024 + (size_t)u.pn * 256) * K * ES; b1 = b0 + (size_t)8 * K * ES; }
    float pg[8]; f32x4 pb[2][2];
    __device__ __forceinline__ void epi_prefetch(const pg8::Unit& u, int wr, int wc, int fr, int fq) {
        const int e = TILEEXP[u.pm];
        const int row0 = u.pm * 256 + wr * 64 + fr, col0 = u.pn * 256 + wc * 64 + 16 * fq;
        const float* bp = bdn + (size_t)e * 1024 + col0;
#pragma unroll
        for (int ai = 0; ai < 2; ++ai)
#pragma unroll
            for (int m = 0; m < 4; ++m) asm volatile("global_load_dword %0, %1, off" : "=v"(pg[ai * 4 + m]) : "v"(ROWGATE + row0 + ai * 128 + m * 16) : "memory");
#pragma unroll
        for (int bj = 0; bj < 2; ++bj)
#pragma unroll
            for (int n = 0; n < 2; ++n) asm volatile("global_load_dwordx4 %0, %1, off" : "=v"(pb[bj][n]) : "v"(bp + 8 * bj + 4 * n) : "memory");
    }
    __device__ __forceinline__ void epi(f32x4 (&acc)[2][2][4][2], const pg8::Unit& u, int wr, int wc, int fr, int fq) {
        const int row0 = u.pm * 256 + wr * 64 + fr, col0 = u.pn * 256 + wc * 64 + 16 * fq;
        asm volatile("" : "+v"(pg[0]), "+v"(pg[1]), "+v"(pg[2]), "+v"(pg[3]), "+v"(pg[4]), "+v"(pg[5]), "+v"(pg[6]), "+v"(pg[7]), "+v"(pb[0][0]), "+v"(pb[0][1]), "+v"(pb[1][0]), "+v"(pb[1][1]));
#pragma unroll
        for (int ai = 0; ai < 2; ++ai)
#pragma unroll
            for (int m = 0; m < 4; ++m) { const int row = row0 + ai * 128 + m * 16; const float gt = pg[ai * 4 + m] * 16.f;
                const f32x4 v00 = (acc[ai][0][m][0] + pb[0][0]) * gt, v01 = (acc[ai][0][m][1] + pb[0][1]) * gt, v10 = (acc[ai][1][m][0] + pb[1][0]) * gt, v11 = (acc[ai][1][m][1] + pb[1][1]) * gt;
                u32x4 w; w.x = pk4_fp8(v00[0], v00[1], v00[2], v00[3]); w.y = pk4_fp8(v01[0], v01[1], v01[2], v01[3]); w.z = pk4_fp8(v10[0], v10[1], v10[2], v10[3]); w.w = pk4_fp8(v11[0], v11[1], v11[2], v11[3]);
                *(u32x4*)((unsigned char*)YB + (size_t)row * 1024 + col0) = w; }
    }
};

struct TItem { const float* src; bf16_t* dst; const float* ksc; int N, K; unsigned char* dst8; };
__device__ __forceinline__ void titem_load(const TItem& it, f32x4 (&v)[16], int lane) {
    const float* p = it.src + (size_t)(lane >> 4) * it.N + 4 * (lane & 15);
#pragma unroll
    for (int i = 0; i < 16; ++i) v[i] = *(const f32x4*)(p + (size_t)(4 * i) * it.N);
}
__device__ __forceinline__ void titem_store(const TItem& it, f32x4 (&v)[16], LAS float* scr, int lane) {
    if (it.ksc) {
#pragma unroll
        for (int i = 0; i < 16; ++i) v[i] *= it.ksc[4 * i + (lane >> 4)];
    }
#pragma unroll
    for (int i = 0; i < 16; ++i) { LAS float* d = scr + (4 * i + (lane >> 4)) * 65 + 4 * (lane & 15); d[0] = v[i][0]; d[1] = v[i][1]; d[2] = v[i][2]; d[3] = v[i][3]; }
    asm volatile("s_waitcnt lgkmcnt(0)" ::: "memory");
    if (it.dst8) {
        const int c = lane & 3;
#pragma unroll
        for (int j = 0; j < 4; ++j) { const int n = (lane >> 2) + 16 * j; const LAS float* s = scr + (16 * c) * 65 + n;
            u32x4 o;
            o.x = pk4_fp8(s[0 * 65] * 64.f, s[1 * 65] * 64.f, s[2 * 65] * 64.f, s[3 * 65] * 64.f); o.y = pk4_fp8(s[4 * 65] * 64.f, s[5 * 65] * 64.f, s[6 * 65] * 64.f, s[7 * 65] * 64.f);
            o.z = pk4_fp8(s[8 * 65] * 64.f, s[9 * 65] * 64.f, s[10 * 65] * 64.f, s[11 * 65] * 64.f); o.w = pk4_fp8(s[12 * 65] * 64.f, s[13 * 65] * 64.f, s[14 * 65] * 64.f, s[15 * 65] * 64.f);
            *(u32x4*)(it.dst8 + (size_t)n * it.K + 16 * c) = o; }
    } else {
        const int c = lane & 7;
#pragma unroll
        for (int j = 0; j < 8; ++j) { const int n = (lane >> 3) + 8 * j; const LAS float* s = scr + (8 * c) * 65 + n;
            u32x4 o; o.x = pk2(s[0 * 65], s[1 * 65]); o.y = pk2(s[2 * 65], s[3 * 65]); o.z = pk2(s[4 * 65], s[5 * 65]); o.w = pk2(s[6 * 65], s[7 * 65]);
            *(u32x4*)(it.dst + (size_t)n * it.K + 8 * c) = o; }
    }
    asm volatile("s_waitcnt lgkmcnt(0)" ::: "memory");
}
__device__ __forceinline__ void rms_row_to_bf16(const f32x4 (&v)[4], const float* g, bf16_t* orow, int lane) {
    float s = 0.f;
#pragma unroll
    for (int j = 0; j < 4; ++j) s += (v[j][0] * v[j][0] + v[j][1] * v[j][1]) + (v[j][2] * v[j][2] + v[j][3] * v[j][3]);
    const float r = rsqrtf(wave_sum(s) * (1.f / D) + EPS);
#pragma unroll
    for (int j = 0; j < 4; ++j) { const f32x4 gg = *(const f32x4*)(g + 4 * lane + 256 * j); const f32x4 o = v[j] * gg * r;
        u32x2 w; w.x = cvt_pk_bf16(o[0], o[1]); w.y = cvt_pk_bf16(o[2], o[3]); *(u32x2*)(orow + 4 * lane + 256 * j) = w; }
}
struct Cplx { float re, im; };
__device__ __forceinline__ Cplx cmul(Cplx a, Cplx b) { return Cplx{a.re * b.re - a.im * b.im, a.re * b.im + a.im * b.re}; }
__device__ __forceinline__ Cplx lam_pow(float lr, float li, float step, int n) {
    const float mag = expf((float)n * lr * step); const double ang = (double)n * (double)li * (double)step;
    return Cplx{mag * (float)cos(ang), mag * (float)sin(ang)};
}
__device__ __forceinline__ Cplx lam_pow_fast(float lr, float li, float step, int n) {
    const float mag = __expf((float)n * lr * step); const double rev = (double)n * (double)li * (double)step * 0.15915494309189535; const float fr = (float)(rev - floor(rev));
    return Cplx{mag * __builtin_amdgcn_cosf(fr), mag * __builtin_amdgcn_sinf(fr)};
}
__device__ __forceinline__ Cplx bbar_factor(float lr, float li, float step) {
    const Cplx lb = lam_pow(lr, li, step, 1); const float nr = lb.re - 1.f, ni = lb.im, den = lr * lr + li * li;
    return Cplx{(nr * lr + ni * li) / den, (ni * lr - nr * li) / den};
}
template <int PMODE> __device__ __forceinline__ void p0_prologue(Frame& F) {
    const int gw = F.bx * NWAVES + F.wave, NGW = F.G * NWAVES, lane = F.lane;
    const int gt = F.bx * NTHREADS + F.tid, NGT = F.G * NTHREADS;
    unsigned char* ws = F.ws;
    if (!(PMODE & 1)) {
        LAS float* scr = (LAS float*)(F.lds + LDS_RING) + F.wave * (64 * 65);
        constexpr int I_UP = UP_FP8 ? 0 : 32 * 16 * 32, I_DN = DN_FP8 ? 0 : 32 * 16 * 16, I_IN = 16 * 32, I_OUT = 16 * 16, I_GLU = 8 * 8;
        constexpr int PER_L = I_UP + I_DN + I_IN + I_OUT + I_GLU, TOTAL = DEPTH * PER_L;
        auto decode = [&](int it) -> TItem {
            TItem ti; const int l = it / PER_L; int r = it % PER_L; const float* W; bf16_t* WT; int K, N; ti.ksc = nullptr; bool f8 = false;
            if (r < I_UP) { const int e = r / 512; r %= 512; K = 1024; N = 2048; W = arg_in(24) + ((size_t)l * NE + e) * 1024 * 2048; WT = (bf16_t*)(ws + WS_WUP + l * WUP_STRIDE) + (size_t)e * 2048 * 1024 / (UP_FP8 ? 2 : 1); f8 = UP_FP8; }
            else if ((r -= I_UP) < I_DN) { const int e = r / 256; r %= 256; K = 1024; N = 1024; W = arg_in(26) + ((size_t)l * NE + e) * 1024 * 1024; WT = (bf16_t*)(ws + WS_WDN + l * WDN_STRIDE) + (size_t)e * 1024 * 1024 / (DN_FP8 ? 2 : 1); f8 = DN_FP8; }
            else if ((r -= I_DN) < I_IN) { K = 1024; N = 2048; W = arg_in(2) + (size_t)l * 1024 * 2048; WT = (bf16_t*)(ws + WS_WIN + l * WIN_STRIDE); }
            else if ((r -= I_IN) < I_OUT) { K = 1024; N = 1024; W = arg_in(20) + (size_t)l * 1024 * 1024; WT = (bf16_t*)(ws + WS_WOUT + l * WOUT_STRIDE); if ((r / 16) * 64 < DS) ti.ksc = arg_in(12) + l * DS + (r / 16) * 64; }
            else { r -= I_OUT; K = 512; N = 512; W = arg_in(11) + (size_t)l * 512 * 512; WT = (bf16_t*)(ws + WS_WGLU + l * WGLU_STRIDE); }
            const int nblk = N / 64, k0 = 64 * (r / nblk), n0 = 64 * (r % nblk);
            ti.src = W + (size_t)k0 * N + n0; ti.dst = WT + (size_t)n0 * K + k0; ti.N = N; ti.K = K; ti.dst8 = f8 ? (unsigned char*)WT + (size_t)n0 * K + k0 : nullptr; return ti;
        };
        f32x4 va[16]; TItem ia;
        for (int it = gw; it < TOTAL; it += NGW) { ia = decode(it); titem_load(ia, va, lane); titem_store(ia, va, scr, lane); }
    }
    if (!(PMODE & 1) && (UP_FP8 || DN_FP8)) {
        LAS float* tile = (LAS float*)(F.lds + LDS_RING);
        constexpr int C_UP = UP_FP8 ? 32 * 8 * 8 : 0, C_DN = DN_FP8 ? 32 * 8 * 4 : 0, C_PER_L = C_UP + C_DN, C_TOTAL = DEPTH * C_PER_L;
        auto cdecode = [&](int it, const float*& src, unsigned char*& dst, int& N) {
            const int l = it / C_PER_L; int r = it % C_PER_L; const float* W; unsigned char* WT;
            if (r < C_UP) { const int e = r >> 6; r &= 63; N = 2048; W = arg_in(24) + ((size_t)l * NE + e) * 1024 * 2048; WT = ws + WS_WUP + l * WUP_STRIDE + (size_t)e * 2048 * 1024; }
            else { r -= C_UP; const int e = r >> 5; r &= 31; N = 1024; W = arg_in(26) + ((size_t)l * NE + e) * 1024 * 1024; WT = ws + WS_WDN + l * WDN_STRIDE + (size_t)e * 1024 * 1024; }
            const int nblk = N >> 8, k0 = 128 * (r / nblk), n0 = 256 * (r % nblk);
            src = W + (size_t)k0 * N + n0; dst = WT + (size_t)n0 * 1024 + k0;
        };
        auto cload = [&](const float* src, int N, f32x4 (&v)[16]) {
            const float* p = src + (size_t)F.wave * N + 4 * lane;
#pragma unroll
            for (int i = 0; i < 16; ++i) v[i] = *(const f32x4*)(p + (size_t)(8 * i) * N);
        };
        auto cstore = [&](unsigned char* dst, f32x4 (&v)[16]) {
            __syncthreads();
#pragma unroll
            for (int i = 0; i < 16; ++i) *(LAS f32x4*)(tile + (8 * i + F.wave) * 260 + 4 * lane) = v[i];
            __syncthreads();
            const int n = F.tid & 255, cc = F.tid >> 8;
#pragma unroll
            for (int j = 0; j < 4; ++j) { const int c = 2 * j + cc; const LAS float* sp = tile + (16 * c) * 260 + n;
                u32x4 o;
                o.x = pk4_fp8(sp[0 * 260] * 64.f, sp[1 * 260] * 64.f, sp[2 * 260] * 64.f, sp[3 * 260] * 64.f); o.y = pk4_fp8(sp[4 * 260] * 64.f, sp[5 * 260] * 64.f, sp[6 * 260] * 64.f, sp[7 * 260] * 64.f);
                o.z = pk4_fp8(sp[8 * 260] * 64.f, sp[9 * 260] * 64.f, sp[10 * 260] * 64.f, sp[11 * 260] * 64.f); o.w = pk4_fp8(sp[12 * 260] * 64.f, sp[13 * 260] * 64.f, sp[14 * 260] * 64.f, sp[15 * 260] * 64.f);
                *(u32x4*)(dst + (size_t)n * 1024 + 16 * c) = o; }
        };
        f32x4 va[16], vb[16]; const float* sa; const float* sb; unsigned char* da; unsigned char* db; int na, nb;
        int it = F.bx;
        if (it < C_TOTAL) { cdecode(it, sa, da, na); cload(sa, na, va); }
        while (it < C_TOTAL) {
            const int itb = it + F.G;
            if (itb < C_TOTAL) { cdecode(itb, sb, db, nb); cload(sb, nb, vb); }
            cstore(da, va);
            if (itb >= C_TOTAL) break;
            const int itc = itb + F.G;
            if (itc < C_TOTAL) { cdecode(itc, sa, da, na); cload(sa, na, va); }
            cstore(db, vb);
            it = itc;
        }
        __syncthreads();
    }
    phase_begin(F); ws = F.ws;
    for (int i = F.bx * NTHREADS + F.tid; i < SEQ * 32; i += NGT) {
        const int s = i >> 5, j = i & 31;
        const float inv = 1.0f / powf(10000.0f, (float)(2 * j) / 64.0f);
        const float ang = (float)s * inv;
        ((float*)(ws + WS_COS))[i] = (float)cos((double)ang); ((float*)(ws + WS_SIN))[i] = (float)sin((double)ang);
    }
    if (F.bx == 0 && F.wave < DEPTH) {
        const int l = F.wave;
        float a = arg_in(15)[l * 64 + lane] * arg_in(16)[l * 64 + lane], b = arg_in(17)[l * 64 + lane] * arg_in(18)[l * 64 + lane];
        a = wave_sum(a); b = wave_sum(b);
        float mq = fabsf(arg_in(13)[l * 64 + lane]), mk = fabsf(arg_in(14)[l * 64 + lane]);
#pragma unroll
        for (int o = 1; o < 64; o <<= 1) { mq = fmaxf(mq, __shfl_xor(mq, o)); mk = fmaxf(mk, __shfl_xor(mk, o)); }
        const float lambda_init = 0.8f - 0.6f * expf(-0.3f * (float)l);
        { float* gqk = (float*)(ws + WS_SCAL) + 64 + l * 128; gqk[lane] = arg_in(13)[l * 64 + lane]; gqk[64 + lane] = arg_in(14)[l * 64 + lane]; }
        if (lane == 0) { float* sc = (float*)(ws + WS_SCAL) + l * 4; sc[0] = expf(a) - expf(b) + lambda_init; sc[1] = C2 * 64.f * mq * mk * 1.02f + 0.5f; sc[2] = 1.0f - lambda_init; }
    }
    for (int i = gt; i < DEPTH * NE * D; i += NGT) {
        const int l = i / (NE * D), e = (i / D) % NE, k = i % D;
        const float w = arg_in(22)[(size_t)l * D * NE + (size_t)k * NE + e];
        const unsigned hi = f2bf(w); const float lo = w - __builtin_bit_cast(float, hi << 16);
        bf16_t* t = (bf16_t*)(ws + WS_WRT + l * WRT_STRIDE);
        t[e * D + k] = (bf16_t)hi; t[NE * D + e * D + k] = (bf16_t)f2bf(lo);
    }
    phase_begin(F); ws = F.ws;
#define TBL_PTRS(l) const float* lam_re = arg_in(3) + (l) * NG * NP; const float* lam_im = arg_in(4) + (l) * NG * NP; const float* log_step = arg_in(5) + (l) * NG; \
        const float* b_re = arg_in(6) + (size_t)(l) * NG * NP * HS; const float* b_im = arg_in(7) + (size_t)(l) * NG * NP * HS; \
        const float* c_re = arg_in(8) + (size_t)(l) * NG * HS * NP; const float* c_im = arg_in(9) + (size_t)(l) * NG * HS * NP; \
        bf16_t* KT = (bf16_t*)(ws + WS_KT + (l) * KT_STRIDE); bf16_t* HT = (bf16_t*)(ws + WS_HT + (l) * HT_STRIDE); (void)KT; (void)HT; (void)b_re; (void)b_im
    if (!(PMODE & 2)) {
        {
            LAS float* pwl = (LAS float*)(F.lds + LDS_RING);
            for (int cb = F.bx; cb < DEPTH * NG * 17; cb += F.G) {
                const int l = cb / (NG * 17), rb = cb % (NG * 17);
                if (rb >= NG * 9) continue;
                const int blk = rb;
                TBL_PTRS(l);
                const int g = blk / 9, s0 = (blk % 9) * 8;
                const float step = expf(log_step[g]);
                LAS float* cgl = pwl + 1024;
                LAS float* ffl = cgl + 2048;
                LAS float* bgl = ffl + 128;
                __syncthreads();
                { const int p = F.tid & 63, sl = F.tid >> 6, slot = s0 + sl; Cplx w{0.f, 0.f};
                  if (slot >= 1 && slot <= 64) w = lam_pow_fast(lam_re[g * NP + p], lam_im[g * NP + p], step, slot - 1);
                  pwl[(sl * 64 + p) * 2] = w.re; pwl[(sl * 64 + p) * 2 + 1] = w.im; }
                for (int idx = F.tid; idx < 1024; idx += NTHREADS) { cgl[2 * idx] = c_re[(size_t)g * HS * NP + idx]; cgl[2 * idx + 1] = c_im[(size_t)g * HS * NP + idx]; }
                if (F.tid < 64) { const Cplx f = bbar_factor(lam_re[g * NP + F.tid], lam_im[g * NP + F.tid], step); ffl[2 * F.tid] = f.re; ffl[2 * F.tid + 1] = f.im; }
                __syncthreads();
                for (int idx = F.tid; idx < 1024; idx += NTHREADS) { const int p = idx >> 4; const Cplx w = cmul(Cplx{ffl[2 * p], ffl[2 * p + 1]}, Cplx{b_re[(size_t)g * NP * HS + idx], b_im[(size_t)g * NP * HS + idx]}); bgl[2 * idx] = w.re; bgl[2 * idx + 1] = w.im; }
                __syncthreads();
                const int pq = F.tid & 3, h = (F.tid >> 2) & 15, sl = F.tid >> 6, slot = s0 + sl;
                float accv[16];
#pragma unroll
                for (int q = 0; q < 16; ++q) accv[q] = 0.f;
                for (int pp = 0; pp < 16; ++pp) {
                    const int p = pq * 16 + pp;
                    const Cplx w = cmul(Cplx{cgl[(h * 64 + p) * 2], cgl[(h * 64 + p) * 2 + 1]}, Cplx{pwl[(sl * 64 + p) * 2], pwl[(sl * 64 + p) * 2 + 1]});
                    const LAS f32x4* bp = (const LAS f32x4*)(bgl + p * 32);
#pragma unroll
                    for (int q2 = 0; q2 < 8; ++q2) { const f32x4 bb = bp[q2]; accv[2 * q2] += w.re * bb[0] - w.im * bb[1]; accv[2 * q2 + 1] += w.re * bb[2] - w.im * bb[3]; }
                }
#pragma unroll
                for (int q = 0; q < 16; ++q) { accv[q] += __shfl_xor(accv[q], 1); accv[q] += __shfl_xor(accv[q], 2); }
                if (pq == 0 && slot <= 64) {
                    u32x4 o0, o1; o0.x = pk2(accv[0], accv[1]); o0.y = pk2(accv[2], accv[3]); o0.z = pk2(accv[4], accv[5]); o0.w = pk2(accv[6], accv[7]);
                    o1.x = pk2(accv[8], accv[9]); o1.y = pk2(accv[10], accv[11]); o1.z = pk2(accv[12], accv[13]); o1.w = pk2(accv[14], accv[15]);
                    u32x4* dst = (u32x4*)(KT + ((size_t)(g * 65 + slot) * HS + h) * 16); dst[0] = o0; dst[1] = o1;
                }
            }
            for (int cb = F.bx; cb < DEPTH * NG * 17; cb += F.G) {
                const int l = cb / (NG * 17), rb = cb % (NG * 17);
                if (rb < NG * 9) continue;
                const int blk = rb - NG * 9;
                TBL_PTRS(l);
                const int g = blk >> 3, t0 = (blk & 7) * 8;
                const float step = expf(log_step[g]);
                __syncthreads();
                LAS float* cgl = pwl + 1024;
                { const int p = F.tid & 63, tl = F.tid >> 6; const Cplx w = lam_pow_fast(lam_re[g * NP + p], lam_im[g * NP + p], step, t0 + tl + 1); pwl[(tl * 64 + p) * 2] = w.re; pwl[(tl * 64 + p) * 2 + 1] = w.im; }
                for (int idx = F.tid; idx < 1024; idx += NTHREADS) { cgl[2 * idx] = c_re[(size_t)g * HS * NP + idx]; cgl[2 * idx + 1] = c_im[(size_t)g * HS * NP + idx]; }
                __syncthreads();
                const int pq = F.tid & 3, h = (F.tid >> 2) & 15, tl = F.tid >> 6, t = t0 + tl;
                bf16_t* dst = HT + ((size_t)(g * 1024 + t * 16 + h) * 128 + pq * 32);
                for (int pp = 0; pp < 16; pp += 4) {
                    float v[8];
#pragma unroll
                    for (int q = 0; q < 4; ++q) { const int p = pq * 16 + pp + q;
                        const Cplx w = cmul(Cplx{cgl[(h * 64 + p) * 2], cgl[(h * 64 + p) * 2 + 1]}, Cplx{pwl[(tl * 64 + p) * 2], pwl[(tl * 64 + p) * 2 + 1]});
                        v[2 * q] = w.re; v[2 * q + 1] = -w.im; }
                    u32x4 o; o.x = pk2(v[0], v[1]); o.y = pk2(v[2], v[3]); o.z = pk2(v[4], v[5]); o.w = pk2(v[6], v[7]);
                    *(u32x4*)(dst + 2 * pp) = o;
                }
            }
            __syncthreads();
        }
    }
#undef TBL_PTRS
    if (!(PMODE & 2)) for (int l = 0; l < DEPTH; ++l) {
        const float* lam_re = arg_in(3) + l * NG * NP; const float* lam_im = arg_in(4) + l * NG * NP; const float* log_step = arg_in(5) + l * NG;
        const float* b_re = arg_in(6) + (size_t)l * NG * NP * HS; const float* b_im = arg_in(7) + (size_t)l * NG * NP * HS;
        const float* c_re = arg_in(8) + (size_t)l * NG * HS * NP; const float* c_im = arg_in(9) + (size_t)l * NG * HS * NP;
        bf16_t* KT = (bf16_t*)(ws + WS_KT + l * KT_STRIDE); bf16_t* GT = (bf16_t*)(ws + WS_GT + l * GT_STRIDE); bf16_t* HT = (bf16_t*)(ws + WS_HT + l * HT_STRIDE);
        float* LAML = (float*)(ws + WS_LAML + l * LAML_STRIDE);
        for (int i = gt; i < NG * NP * 64; i += NGT) {
            const int s = i % 64, p = (i / 64) % NP, g = i / (64 * NP);
            const float step = expf(log_step[g]); const float lr = lam_re[g * NP + p], li = lam_im[g * NP + p];
            const Cplx w = cmul(lam_pow_fast(lr, li, step, 63 - s), bbar_factor(lr, li, step));
            float vr[16], vi[16];
#pragma unroll
            for (int q = 0; q < 16; ++q) { const float br = b_re[(size_t)(g * NP + p) * HS + q], bi = b_im[(size_t)(g * NP + p) * HS + q]; vr[q] = w.re * br - w.im * bi; vi[q] = w.re * bi + w.im * br; }
            u32x4* dr = (u32x4*)(GT + ((size_t)(g * 128 + 2 * p) * 1024 + s * 16)); u32x4* di = (u32x4*)(GT + ((size_t)(g * 128 + 2 * p + 1) * 1024 + s * 16));
            u32x4 o; o.x = pk2(vr[0], vr[1]); o.y = pk2(vr[2], vr[3]); o.z = pk2(vr[4], vr[5]); o.w = pk2(vr[6], vr[7]); dr[0] = o;
            o.x = pk2(vr[8], vr[9]); o.y = pk2(vr[10], vr[11]); o.z = pk2(vr[12], vr[13]); o.w = pk2(vr[14], vr[15]); dr[1] = o;
            o.x = pk2(vi[0], vi[1]); o.y = pk2(vi[2], vi[3]); o.z = pk2(vi[4], vi[5]); o.w = pk2(vi[6], vi[7]); di[0] = o;
            o.x = pk2(vi[8], vi[9]); o.y = pk2(vi[10], vi[11]); o.z = pk2(vi[12], vi[13]); o.w = pk2(vi[14], vi[15]); di[1] = o;
        }
        for (int i = gt; i < NG * NP; i += NGT) { const int g = i / NP; const Cplx w = lam_pow(lam_re[i], lam_im[i], expf(log_step[g]), 64); LAML[2 * i] = w.re; LAML[2 * i + 1] = w.im; }
    }
    {
        const float* xin = arg_in(0); const float* g0 = arg_in(1); bf16_t* XN = (bf16_t*)(ws + WS_XN);
        f32x4 va[4], vb[4];
        int m = gw;
        if (m < T) {
#pragma unroll
            for (int j = 0; j < 4; ++j) va[j] = ((const f32x4*)(xin + (size_t)m * D) + lane)[64 * j]; }
        while (m < T) {
            const int mb = m + NGW;
            if (mb < T) {
#pragma unroll
                for (int j = 0; j < 4; ++j) vb[j] = ((const f32x4*)(xin + (size_t)mb * D) + lane)[64 * j]; }
            rms_row_to_bf16(va, g0, XN + (size_t)m * D, lane);
            if (mb >= T) break;
            const int mc = mb + NGW;
            if (mc < T) {
#pragma unroll
                for (int j = 0; j < 4; ++j) va[j] = ((const f32x4*)(xin + (size_t)mc * D) + lane)[64 * j]; }
            rms_row_to_bf16(vb, g0, XN + (size_t)mb * D, lane);
            m = mc;
        }
    }
}

__device__ __forceinline__ void s5a_phase(Frame& F, int l) {
    const bf16_t* GT = (const bf16_t*)(F.ws + WS_GT + l * GT_STRIDE); const bf16_t* U = (const bf16_t*)(F.ws + WS_U); float* S = (float*)(F.ws + WS_S);
    const int lane = F.lane, n = lane & 15, kq = lane >> 4;
    for (int uu = F.bx * NWAVES + F.wave; uu < NG * 32 * 2; uu += F.G * NWAVES) {
        const int g = uu >> 6, ntile = (uu >> 1) & 31, mh = uu & 1;
        const int chunk = ntile * 16 + n;
        const bf16_t* up = U + ((size_t)chunk * 64 + (kq >> 1)) * DS + g * 16 + 8 * (kq & 1);
        const bf16_t* gp = GT + ((size_t)(g * 128 + mh * 64 + n) * 1024 + 8 * kq);
        f32x4 acc[4];
#pragma unroll
        for (int mt = 0; mt < 4; ++mt) acc[mt] = (f32x4){0.f, 0.f, 0.f, 0.f};
#pragma unroll 4
        for (int ks = 0; ks < 32; ++ks) {
            const bf16x8 b = *(const bf16x8*)(up + (size_t)(2 * ks) * DS);
#pragma unroll
            for (int mt = 0; mt < 4; ++mt) { const bf16x8 a = *(const bf16x8*)(gp + (size_t)(mt * 16) * 1024 + 32 * ks); acc[mt] = __builtin_amdgcn_mfma_f32_16x16x32_bf16(a, b, acc[mt], 0, 0, 0); }
        }
#pragma unroll
        for (int mt = 0; mt < 4; ++mt) *(f32x4*)(S + ((size_t)chunk * NG + g) * 128 + mh * 64 + mt * 16 + 4 * kq) = acc[mt];
    }
}
__device__ __forceinline__ void s5c_phase(Frame& F, int l) {
    const bf16_t* KT = (const bf16_t*)(F.ws + WS_KT + l * KT_STRIDE); const bf16_t* HT = (const bf16_t*)(F.ws + WS_HT + l * HT_STRIDE);
    const float* LAML = (const float*)(F.ws + WS_LAML + l * LAML_STRIDE); const float* S = (const float*)(F.ws + WS_S);
    const bf16_t* U = (const bf16_t*)(F.ws + WS_U); bf16_t* YG = (bf16_t*)(F.ws + WS_YG); const float* dsk = arg_in(10) + l * DS;
    const int lane = F.lane, n = lane & 15, kq = lane >> 4, wave = F.wave;
    LAS unsigned char* ktl = F.lds + LDS_RING;
    LAS unsigned char* xs = F.lds + LDS_RING + 33792 + wave * 4096;
    LAS f32x2* EB = (LAS f32x2*)(F.lds + LDS_RING + 33792 + 8 * 4096);
    LAS f32x2* EH = EB + 512;
    for (int wu = F.bx; wu < NG * 8; wu += F.G) {
        const int g = wu >> 3, scq = wu & 7, b = scq >> 1, cbase = (scq & 1) * 64, scl = wave >> 1, par = wave & 1;
        __syncthreads();
        for (int i = F.tid; i < 65 * 32; i += NTHREADS) *(LAS u32x4*)(ktl + i * 16) = *(const u32x4*)(KT + (size_t)g * 65 * 256 + i * 8);
        const Cplx L = Cplx{LAML[(g * NP + lane) * 2], LAML[(g * NP + lane) * 2 + 1]};
        const float* sp = S + ((size_t)(b * CPB) * NG + g) * 128 + 2 * lane;
        {
            f32x2 sv[8];
#pragma unroll
            for (int j = 0; j < 8; ++j) sv[j] = *(const f32x2*)(sp + (size_t)(cbase + 8 * wave + j) * NG * 128);
            Cplx E{0.f, 0.f};
#pragma unroll
            for (int j = 0; j < 8; ++j) { const Cplx nx = cmul(L, E); E.re = nx.re + sv[j][0]; E.im = nx.im + sv[j][1]; }
            EB[wave * 64 + lane] = (f32x2){E.re, E.im};
            if (cbase) {
#pragma unroll
                for (int j = 0; j < 8; ++j) sv[j] = *(const f32x2*)(sp + (size_t)(8 * wave + j) * NG * 128);
                Cplx H{0.f, 0.f};
#pragma unroll
                for (int j = 0; j < 8; ++j) { const Cplx nx = cmul(L, H); H.re = nx.re + sv[j][0]; H.im = nx.im + sv[j][1]; }
                EH[wave * 64 + lane] = (f32x2){H.re, H.im};
            }
        }
        __syncthreads();
        const int c0 = cbase + 16 * scl;
        {
            const Cplx L2 = cmul(L, L), L4 = cmul(L2, L2), L8 = cmul(L4, L4);
            Cplx X{0.f, 0.f};
            if (cbase) {
#pragma unroll
                for (int w = 0; w < 8; ++w) { const f32x2 e = EH[w * 64 + lane]; const Cplx nx = cmul(L8, X); X.re = nx.re + e[0]; X.im = nx.im + e[1]; }
            }
            for (int w = 0; w < 2 * scl; ++w) { const f32x2 e = EB[w * 64 + lane]; const Cplx nx = cmul(L8, X); X.re = nx.re + e[0]; X.im = nx.im + e[1]; }
            f32x2 sv[16];
#pragma unroll
            for (int j = 0; j < 16; ++j) sv[j] = *(const f32x2*)(sp + (size_t)(c0 + j) * NG * 128);
#pragma unroll
            for (int j = 0; j < 16; ++j) {
                *(LAS unsigned*)(xs + j * 256 + 4 * lane) = pk2(X.re, X.im);
                const Cplx nx = cmul(L, X); X.re = nx.re + sv[j][0]; X.im = nx.im + sv[j][1];
            }
        }
        const int chunk = b * CPB + c0 + n;
        bf16x8 ub[32];
        {
            const bf16_t* up = U + ((size_t)chunk * 64 + (kq >> 1)) * DS + g * 16 + 8 * (kq & 1);
#pragma unroll
            for (int kp = 0; kp < 32; ++kp) ub[kp] = *(const bf16x8*)(up + (size_t)(2 * kp) * DS);
        }
        const LAS unsigned char* xbp = xs + n * 256 + 16 * kq;
        const f32x4 dv = *(const f32x4*)(dsk + g * 16 + 4 * kq);
        const bf16_t* hp = HT + ((size_t)(g * 1024 + n) * 128 + 8 * kq);
        const bf16_t* uq = U + (size_t)chunk * 64 * DS + g * 16 + 4 * kq;
        const LAS unsigned char* kbase = ktl + (n * 16 + 8 * (kq & 1)) * 2;
        u32x2 uw = *(const u32x2*)(uq + (size_t)par * DS);
        for (int ti = 0; ti < 32; ++ti) {
            const int t = 2 * ti + par, tn = (ti < 31) ? t + 2 : t;
            bf16x8 ha[4];
#pragma unroll
            for (int ks = 0; ks < 4; ++ks) ha[ks] = *(const bf16x8*)(hp + (size_t)(t * 16) * 128 + 32 * ks);
            const u32x2 un = *(const u32x2*)(uq + (size_t)tn * DS);
            f32x4 acc = (f32x4){0.f, 0.f, 0.f, 0.f};
            const int slot0 = t + 1 - (kq >> 1);
#pragma unroll
            for (int kp = 0; kp < 32; ++kp) {
                if (kp <= ti) { const bf16x8 a = *(const LAS bf16x8*)(kbase + (slot0 - 2 * kp) * 512); acc = __builtin_amdgcn_mfma_f32_16x16x32_bf16(a, ub[kp], acc, 0, 0, 0); }
            }
#pragma unroll
            for (int ks = 0; ks < 4; ++ks) acc = __builtin_amdgcn_mfma_f32_16x16x32_bf16(ha[ks], *(const LAS bf16x8*)(xbp + 64 * ks), acc, 0, 0, 0);
            const float y0 = acc[0] + dv[0] * bf_lo(uw.x), y1 = acc[1] + dv[1] * bf_hi(uw.x), y2 = acc[2] + dv[2] * bf_lo(uw.y), y3 = acc[3] + dv[3] * bf_hi(uw.y);
            u32x2 w; w.x = cvt_pk_bf16(gelu_tanh(y0), gelu_tanh(y1)); w.y = cvt_pk_bf16(gelu_tanh(y2), gelu_tanh(y3));
            *(u32x2*)(YG + ((size_t)chunk * 64 + t) * DS + g * 16 + 4 * kq) = w;
            uw = un;
        }
    }
    __syncthreads();
}

namespace att {
constexpr int KSLOT = 8192, VSLOT = 16384, NSLOT = 4, LDS_K = 0, LDS_V = NSLOT * KSLOT, LDS_WS = NSLOT * (KSLOT + VSLOT), LDS_END = LDS_WS + 8 * 256;
constexpr int STG_ROW = 136;
__device__ __forceinline__ int crow(int r, int hi) { return (r & 3) + 8 * (r >> 2) + 4 * hi; }
__device__ __forceinline__ void glds16(const void* gsrc, unsigned lds_dst) { unsigned keep;
    asm volatile("s_mov_b32 %0, m0\n\ts_mov_b32 m0, %2\n\ts_nop 0\n\tglobal_load_lds_dwordx4 %1, off\n\ts_mov_b32 m0, %0" : "=&s"(keep) : "v"(gsrc), "s"(lds_dst) : "memory"); }
typedef __attribute__((address_space(3))) const char* lds_cptr;
typedef short v4i16_t __attribute__((ext_vector_type(4)));
__device__ __forceinline__ s16x4 vtr(lds_cptr p) { return __builtin_bit_cast(s16x4, __builtin_amdgcn_ds_read_tr16_b64_v4i16((__attribute__((address_space(3))) v4i16_t*)p)); }
#define ATT_WAIT_BAR(N) asm volatile("s_waitcnt vmcnt(" #N ") lgkmcnt(0)\n\ts_barrier" ::: "memory")

template <int MODE> __device__ __forceinline__ void attn_unit(int bh, int qb, const bf16_t* Q, const bf16_t* K, const bf16_t* V, bf16_t* MIX, const float* subg, float lam, float mshift, float oml,
                                          LAS unsigned char* shm, int tid) {
    const int lane = tid & 63, r32 = lane & 31, hi = lane >> 5; const int wid = __builtin_amdgcn_readfirstlane(tid >> 6);
    const int b = bh >> 2, h = bh & 3, m = wid & 1, qg = wid >> 1;
    const size_t rowbase = (size_t)b * SEQ; const int q0 = qb * 128;
    const int NT = 2 * qb + 2, cw = 2 * qb + (qg >> 1);
    const unsigned lds0 = (unsigned)(uintptr_t)shm;
    const unsigned char* k0src = (const unsigned char*)K + (rowbase + lane) * DA + h * 128 + (wid >> 2) * 64 + ((wid >> 1) & 1) * 32 + (wid & 1) * 16;
    const bf16_t* v0src = V + (rowbase + 16 * (wid & 3) + (lane >> 2)) * DA + h * 128 + (wid >> 2) * 32 + (lane & 3) * 8;
    const bf16_t* v1src = v0src + 64;
    const unsigned kdst = lds0 + LDS_K + (wid >> 2) * 4096 + (wid & 3) * 1024, vdst = lds0 + LDS_V + wid * 1024;
#define ATT_DMA(t, slot) do { const size_t _o = (size_t)(t) * 64 * DA; \
        glds16(k0src + _o, (unsigned)__builtin_amdgcn_readfirstlane(kdst + (slot) * KSLOT)); glds16(k1src + _o, (unsigned)__builtin_amdgcn_readfirstlane(kdst + (slot) * KSLOT + 8192)); \
        glds16(v0src + _o, (unsigned)__builtin_amdgcn_readfirstlane(vdst + (slot) * VSLOT)); glds16(v1src + _o, (unsigned)__builtin_amdgcn_readfirstlane(vdst + (slot) * VSLOT + 8192)); } while (0)
    v8i32 qf;
    { const unsigned char* Qw = (const unsigned char*)Q + (rowbase + q0 + qg * 32 + r32) * DA + h * 128 + m * 64 + hi * 32;
      const u32x4 ql = *(const u32x4*)(Qw), qh = *(const u32x4*)(Qw + 16); qf = __builtin_bit_cast(v8i32, __builtin_shufflevector(ql, qh, 0, 1, 2, 3, 4, 5, 6, 7)); }
#ifndef ATT_GRP
#define ATT_GRP (wid & 1)
#endif
    const int grp = ATT_GRP;
#define ATT_DMA_K(t, slot) do { if (MODE & 1) break; const size_t _o = (size_t)(t) * 64 * DA; \
        glds16(k0src + _o, (unsigned)__builtin_amdgcn_readfirstlane(kdst + (slot) * KSLOT)); } while (0)
#define ATT_DMA_V(t, slot) do { if (MODE & 1) break; const size_t _o = (size_t)(t) * 64 * DA; \
        glds16(v0src + _o, (unsigned)__builtin_amdgcn_readfirstlane(vdst + (slot) * VSLOT)); glds16(v1src + _o, (unsigned)__builtin_amdgcn_readfirstlane(vdst + (slot) * VSLOT + 8192)); } while (0)
    ATT_DMA_K(0, 0); ATT_DMA_V(0, 0); ATT_DMA_K(1, 1); ATT_DMA_V(1, 1); if (NT > 2) { ATT_DMA_K(2, 2); ATT_DMA_V(2, 2); }
    f32x16 o[4];
#pragma unroll
    for (int d = 0; d < 4; ++d)
#pragma unroll
        for (int r = 0; r < 16; ++r) o[d][r] = 0.f;
    float l_reg = 0.f;
    const f32x16 zero16 = {0.f, 0.f, 0.f, 0.f, 0.f, 0.f, 0.f, 0.f, 0.f, 0.f, 0.f, 0.f, 0.f, 0.f, 0.f, 0.f};
    (void)mshift;
    const lds_cptr shm3 = (lds_cptr)shm;
    const lds_cptr kp0 = shm3 + LDS_K + m * 4096 + hi * 2048 + r32 * 16;
    const lds_cptr vp0 = shm3 + LDS_V + ((lane >> 4) & 1) * 32 + (lane & 3) * 8 + (4 * hi + ((lane & 15) >> 2)) * 64;
    u32x4 pw[4];
#pragma unroll
    for (int q = 0; q < 4; ++q) pw[q] = (u32x4){0u, 0u, 0u, 0u};
#define ATT_SB() __builtin_amdgcn_sched_barrier(0)
#define ATT_QKEXP(sl) do { if (MODE & 2) break; const lds_cptr kp = kp0 + (sl) * KSLOT; \
        ATT_SB(); \
        const u32x4 k0l = *(const __attribute__((address_space(3))) u32x4*)(kp), k0h = *(const __attribute__((address_space(3))) u32x4*)(kp + 1024); \
        const u32x4 k1l = *(const __attribute__((address_space(3))) u32x4*)(kp + 512), k1h = *(const __attribute__((address_space(3))) u32x4*)(kp + 1024 + 512); \
        ATT_SB(); \
        const v8i32 kf0 = __builtin_bit_cast(v8i32, __builtin_shufflevector(k0l, k0h, 0, 1, 2, 3, 4, 5, 6, 7)), kf1 = __builtin_bit_cast(v8i32, __builtin_shufflevector(k1l, k1h, 0, 1, 2, 3, 4, 5, 6, 7)); \
        f32x16 p0 = __builtin_amdgcn_mfma_scale_f32_32x32x64_f8f6f4(kf0, qf, zero16, 0, 0, 0, 0x7a7b, 1, 0x7a7b); \
        f32x16 p1 = __builtin_amdgcn_mfma_scale_f32_32x32x64_f8f6f4(kf1, qf, zero16, 0, 0, 0, 0x7a7b, 1, 0x7a7b); \
        ATT_SB(); \
        float sacc = 0.f; \
        _Pragma("unroll") for (int r = 0; r < 16; ++r) { p0[r] = __builtin_amdgcn_exp2f(p0[r]); p1[r] = __builtin_amdgcn_exp2f(p1[r]); sacc += p0[r] + p1[r]; } \
        l_reg += sacc; \
        _Pragma("unroll") for (int q = 0; q < 4; ++q) { pw[0][q] = cvt_pk_bf16(p0[2 * q], p0[2 * q + 1]); pw[1][q] = cvt_pk_bf16(p0[8 + 2 * q], p0[8 + 2 * q + 1]); \
                                                        pw[2][q] = cvt_pk_bf16(p1[2 * q], p1[2 * q + 1]); pw[3][q] = cvt_pk_bf16(p1[8 + 2 * q], p1[8 + 2 * q + 1]); } } while (0)
#define ATT_VRD(buf, d) do { _Pragma("unroll") for (int ks = 0; ks < 4; ++ks) { buf[0][ks] = vtr(vp + (d) * 4096 + ks * 1024); buf[1][ks] = vtr(vp + (d) * 4096 + ks * 1024 + 512); } } while (0)
#define ATT_VMM(buf, d) do { _Pragma("unroll") for (int ks = 0; ks < 4; ++ks) { \
        const bf16x8 vf = (bf16x8){buf[0][ks][0], buf[0][ks][1], buf[0][ks][2], buf[0][ks][3], buf[1][ks][0], buf[1][ks][1], buf[1][ks][2], buf[1][ks][3]}; \
        o[d] = __builtin_amdgcn_mfma_f32_32x32x16_bf16(__builtin_bit_cast(bf16x8, pw[ks]), vf, o[d], 0, 0, 0); } } while (0)
#define ATT_PV(sl) do { if (MODE & 4) break; const lds_cptr vp = vp0 + (sl) * VSLOT; s16x4 va[2][4], vb[2][4]; \
        ATT_SB(); ATT_VRD(va, 0); ATT_SB(); ATT_VRD(vb, 1); ATT_SB(); ATT_VMM(va, 0); ATT_SB(); ATT_VRD(va, 2); ATT_SB(); ATT_VMM(vb, 1); ATT_SB(); \
        ATT_VRD(vb, 3); ATT_SB(); ATT_VMM(va, 2); ATT_SB(); ATT_VMM(vb, 3); ATT_SB(); } while (0)
    u32x4 pwn[4];
#define ATT_PIN(x) asm volatile("" : "+v"(x))
#define ATT_MM(d, ks, cur, nxt) do { \
        if ((d) < 3) { nxt[0][ks] = vtr(vp + ((d) + 1) * 4096 + (ks) * 1024); nxt[1][ks] = vtr(vp + ((d) + 1) * 4096 + (ks) * 1024 + 512); } \
        { const bf16x8 vf = (bf16x8){cur[0][ks][0], cur[0][ks][1], cur[0][ks][2], cur[0][ks][3], cur[1][ks][0], cur[1][ks][1], cur[1][ks][2], cur[1][ks][3]}; \
          o[d] = __builtin_amdgcn_mfma_f32_32x32x16_bf16(__builtin_bit_cast(bf16x8, pw[ks]), vf, o[d], 0, 0, 0); } \
        asm volatile("" : "+v"(cur[0][ks]), "+v"(cur[1][ks]));     \
        } while (0)
#define ATT_EX(PX, e0, PWN, q) do { PX[e0] = __builtin_amdgcn_exp2f(PX[e0]); PX[(e0) + 1] = __builtin_amdgcn_exp2f(PX[(e0) + 1]); sacc += PX[e0]; sacc += PX[(e0) + 1]; ATT_PIN(sacc); \
        PWN[q] = cvt_pk_bf16(PX[e0], PX[(e0) + 1]); ATT_PIN(PWN); } while (0)
#define ATT_FUSED(slk, slk1) do { const lds_cptr kp = kp0 + (slk1) * KSLOT; const lds_cptr vp = vp0 + (slk) * VSLOT; s16x4 va[2][4], vb[2][4]; \
        ATT_SB(); \
        const u32x4 k0l = *(const __attribute__((address_space(3))) u32x4*)(kp), k0h = *(const __attribute__((address_space(3))) u32x4*)(kp + 1024); \
        const u32x4 k1l = *(const __attribute__((address_space(3))) u32x4*)(kp + 512), k1h = *(const __attribute__((address_space(3))) u32x4*)(kp + 1024 + 512); \
        ATT_VRD(va, 0); \
        ATT_SB(); \
        const v8i32 kf0 = __builtin_bit_cast(v8i32, __builtin_shufflevector(k0l, k0h, 0, 1, 2, 3, 4, 5, 6, 7)), kf1 = __builtin_bit_cast(v8i32, __builtin_shufflevector(k1l, k1h, 0, 1, 2, 3, 4, 5, 6, 7)); \
        f32x16 p0 = __builtin_amdgcn_mfma_scale_f32_32x32x64_f8f6f4(kf0, qf, zero16, 0, 0, 0, 0x7a7b, 1, 0x7a7b); \
        f32x16 p1 = __builtin_amdgcn_mfma_scale_f32_32x32x64_f8f6f4(kf1, qf, zero16, 0, 0, 0, 0x7a7b, 1, 0x7a7b); \
        ATT_SB(); \
        float sacc = 0.f; \
          \
        ATT_MM(0, 0, va, vb); ATT_SB(); ATT_MM(0, 1, va, vb); ATT_SB(); \
        ATT_MM(0, 2, va, vb); ATT_EX(p0, 0, pwn[0], 0); ATT_SB();  ATT_MM(0, 3, va, vb); ATT_EX(p0, 2, pwn[0], 1); ATT_SB(); \
        ATT_MM(1, 0, vb, va); ATT_EX(p0, 4, pwn[0], 2); ATT_SB();  ATT_MM(1, 1, vb, va); ATT_EX(p0, 6, pwn[0], 3); ATT_SB(); \
        ATT_MM(1, 2, vb, va); ATT_EX(p0, 8, pwn[1], 0); ATT_SB();  ATT_MM(1, 3, vb, va); ATT_EX(p0, 10, pwn[1], 1); ATT_SB(); \
        ATT_MM(2, 0, va, vb); ATT_EX(p0, 12, pwn[1], 2); ATT_SB(); ATT_MM(2, 1, va, vb); ATT_EX(p0, 14, pwn[1], 3); ATT_SB(); \
        ATT_MM(2, 2, va, vb); ATT_EX(p1, 0, pwn[2], 0); ATT_SB();  ATT_MM(2, 3, va, vb); ATT_EX(p1, 2, pwn[2], 1); ATT_SB(); \
        ATT_MM(3, 0, vb, va); ATT_EX(p1, 4, pwn[2], 2); ATT_SB();  ATT_MM(3, 1, vb, va); ATT_EX(p1, 6, pwn[2], 3); ATT_SB(); \
        ATT_MM(3, 2, vb, va); ATT_EX(p1, 8, pwn[3], 0); ATT_EX(p1, 10, pwn[3], 1); ATT_SB(); \
        ATT_MM(3, 3, vb, va); ATT_EX(p1, 12, pwn[3], 2); ATT_EX(p1, 14, pwn[3], 3); ATT_SB(); \
        l_reg += sacc; \
        _Pragma("unroll") for (int q = 0; q < 4; ++q) pw[q] = pwn[q]; } while (0)
    {
        if (NT > 2) { ATT_WAIT_BAR(6); } else { ATT_WAIT_BAR(3); }
        ATT_QKEXP(0);
        int sk = 0;
        for (int k = 0; k + 1 < NT; ++k) {
            if (k + 2 < NT) { ATT_WAIT_BAR(3); } else { ATT_WAIT_BAR(0); }
            const int sk1 = (sk + 1) & 3;
            if (k + 3 < NT) { ATT_DMA_K(k + 3, (sk + 3) & 3); ATT_DMA_V(k + 3, (sk + 3) & 3); }
            ATT_SB();
            if (k + 1 <= cw) { ATT_FUSED(sk, sk1); } else { ATT_PV(sk); }
            ATT_SB();
            sk = sk1;
        }
        if (NT - 1 <= cw) ATT_PV(sk);
    }
#undef ATT_FUSED
#undef ATT_MM
#undef ATT_EX
#undef ATT_PIN
#undef ATT_QKEXP
#undef ATT_PV
#undef ATT_VRD
#undef ATT_VMM
#undef ATT_SB
#undef ATT_DMA_K
#undef ATT_DMA_V
    { auto rr = __builtin_amdgcn_permlane32_swap(__float_as_uint(l_reg), __float_as_uint(l_reg), false, false); l_reg = __uint_as_float(rr[0]) + __uint_as_float(rr[1]); }
    LAS float* wsf = (LAS float*)(shm + LDS_WS) + wid * 64;
    if (hi == 0) wsf[r32] = l_reg;
    ATT_WAIT_BAR(0);
    float rli[16];
    const float scl = m ? lam : 1.0f;
#pragma unroll
    for (int r = 0; r < 16; ++r) rli[r] = scl * __builtin_amdgcn_rcpf(wsf[crow(r, hi)]);
    LAS float* stg = (LAS float*)shm + qg * (32 * STG_ROW);
    if (m == 1) {
#pragma unroll
        for (int r = 0; r < 16; ++r)
#pragma unroll
            for (int d = 0; d < 4; ++d) stg[crow(r, hi) * STG_ROW + d * 32 + r32] = o[d][r] * rli[r];
    }
    ATT_WAIT_BAR(0);
    if (m == 0) {
#pragma unroll
        for (int r = 0; r < 16; ++r)
#pragma unroll
            for (int d = 0; d < 4; ++d) { LAS float* p = stg + crow(r, hi) * STG_ROW + d * 32 + r32; *p = o[d][r] * rli[r] - *p; }
    }
    ATT_WAIT_BAR(0);
    {
        const int row = 16 * m + (lane >> 2), qt = lane & 3;
        const LAS float* p = stg + row * STG_ROW + qt * 32;
        f32x4 v[8]; float ss = 0.f;
#pragma unroll
        for (int i = 0; i < 8; ++i) { v[i] = *(const LAS f32x4*)(p + 4 * i); ss += (v[i][0] * v[i][0] + v[i][1] * v[i][1]) + (v[i][2] * v[i][2] + v[i][3] * v[i][3]); }
        ss += __shfl_xor(ss, 1); ss += __shfl_xor(ss, 2);
        const float rn = rsqrtf(ss * (1.f / 128.f) + EPS) * oml;
        bf16_t* dst = MIX + (rowbase + q0 + qg * 32 + row) * D + DS + h * 128 + qt * 32;
#pragma unroll
        for (int i = 0; i < 4; ++i) {
            const f32x4 g0 = *(const f32x4*)(subg + qt * 32 + 8 * i), g1 = *(const f32x4*)(subg + qt * 32 + 8 * i + 4);
            const f32x4 a = v[2 * i] * g0 * rn, c = v[2 * i + 1] * g1 * rn;
            u32x4 w; w.x = cvt_pk_bf16(a[0], a[1]); w.y = cvt_pk_bf16(a[2], a[3]); w.z = cvt_pk_bf16(c[0], c[1]); w.w = cvt_pk_bf16(c[2], c[3]);
            *(u32x4*)(dst + 8 * i) = w;
        }
    }
    ATT_WAIT_BAR(0);
#undef ATT_DMA
}
}
template <int MODE> __device__ __forceinline__ void attn_phase(Frame& F, int l) {
    const bf16_t* Q = (const bf16_t*)(F.ws + WS_Q); const bf16_t* K = (const bf16_t*)(F.ws + WS_K); const bf16_t* V = (const bf16_t*)(F.ws + WS_V);
    bf16_t* MIX = (bf16_t*)(F.ws + WS_MIX);
    const float* sc = (const float*)(F.ws + WS_SCAL) + l * 4;
    const float lam = sc[0], mshift = sc[1], oml = sc[2];
    const float* subg = arg_in(19) + l * DV;
    const int G = F.G;
#ifndef ATT_XA
#define ATT_XA 1
#endif
    const bool xa = ATT_XA && (G & 7) == 0;
    const int x = F.bx & 7, j = F.bx >> 3, wpx = xa ? (G >> 3) : 1;
    const int npair = xa ? (32 - j + wpx - 1) / wpx : 0;
    const int nit = xa ? 4 * npair : (1024 - F.bx + G - 1) / G;
#pragma unroll 1
    for (int it = 0; it < nit; ++it) {
        int bh, qb;
        if (xa) { const int r = it / (2 * npair), rem = it % (2 * npair), sidx = j + (rem >> 1) * wpx; bh = 2 * x + r; qb = (rem & 1) ? sidx : 63 - sidx; }
        else { const int v = F.bx + it * G; bh = v >> 6; qb = v & 63; }
        att::attn_unit<MODE>(bh, qb, Q, K, V, MIX, subg, lam, mshift, oml, F.lds + LDS_RING, F.tid);
    }
}

__device__ __forceinline__ void router_phase(Frame& F, int l) {
    const bf16_t* h1 = (const bf16_t*)(F.ws + WS_H1); const float* g = arg_in(21) + (size_t)l * D; const float* br = arg_in(23) + l * NE;
    const bf16_t* WRT = (const bf16_t*)(F.ws + WS_WRT + l * WRT_STRIDE);
    bf16_t* XN = (bf16_t*)(F.ws + WS_XN); int* TOPI = (int*)(F.ws + WS_TOPI); float* TOPG = (float*)(F.ws + WS_TOPG); int* WGCNT = (int*)(F.ws + WS_WGCNT); float* RS = (float*)(F.ws + WS_RS);
    const int lane = F.lane, tid = F.tid, wave = F.wave, n = lane & 15, kq = lane >> 4;
    constexpr int PITCH = 2080;
    LAS unsigned char* wl = F.lds + LDS_RING;
    LAS float* lg = (LAS float*)(F.lds + LDS_RING + 2 * 32 * PITCH) + wave * (16 * 33 + 16);
    LAS int* cnt = (LAS int*)(F.ctl + 256);
    __syncthreads();
    for (int i = tid; i < 2 * NE * 128; i += NTHREADS) { const int row = i >> 7, c = i & 127; *(LAS u32x4*)(wl + row * PITCH + c * 16) = *(const u32x4*)(WRT + (size_t)row * D + c * 8); }
    if (tid < 32) cnt[tid] = 0;
    __syncthreads();
    for (int wgu = F.bx; wgu < T / 128; wgu += F.G) {
        if (wgu != F.bx) { __syncthreads(); if (tid < 32) cnt[tid] = 0; __syncthreads(); }
        const int row = wgu * 128 + wave * 16 + n;
        const bf16_t* hp = h1 + (size_t)row * D + 8 * kq; const float* gp = g + 8 * kq;
        bf16_t* xp = XN + (size_t)row * D + 8 * kq; unsigned char* xp8 = (unsigned char*)XN + (size_t)row * D + 8 * kq;
        const LAS unsigned char* bh = wl + n * PITCH + 16 * kq;
        f32x4 acc0 = (f32x4){0.f, 0.f, 0.f, 0.f}, acc1 = acc0; float ss = 0.f;
#pragma unroll 4
        for (int ks = 0; ks < 32; ++ks) {
            const u32x4 hw = *(const u32x4*)(hp + 32 * ks); const f32x4 h0 = (f32x4){bf_lo(hw.x), bf_hi(hw.x), bf_lo(hw.y), bf_hi(hw.y)}, h4 = (f32x4){bf_lo(hw.z), bf_hi(hw.z), bf_lo(hw.w), bf_hi(hw.w)};
            const f32x4 g0 = *(const f32x4*)(gp + 32 * ks), g4 = *(const f32x4*)(gp + 32 * ks + 4);
            const f32x4 x0 = h0 * g0, x4 = h4 * g4;
            ss += (x0[0] * x0[0] + x0[1] * x0[1]) + (x0[2] * x0[2] + x0[3] * x0[3]) + (x4[0] * x4[0] + x4[1] * x4[1]) + (x4[2] * x4[2] + x4[3] * x4[3]);
            u32x4 hi; hi.x = cvt_pk_bf16(x0[0], x0[1]); hi.y = cvt_pk_bf16(x0[2], x0[3]); hi.z = cvt_pk_bf16(x4[0], x4[1]); hi.w = cvt_pk_bf16(x4[2], x4[3]);
            if (UP_FP8) { u32x2 w8; w8.x = pk4_fp8(x0[0] * 8.f, x0[1] * 8.f, x0[2] * 8.f, x0[3] * 8.f); w8.y = pk4_fp8(x4[0] * 8.f, x4[1] * 8.f, x4[2] * 8.f, x4[3] * 8.f); *(u32x2*)(xp8 + 32 * ks) = w8; }
            else *(u32x4*)(xp + 32 * ks) = hi;
            u32x4 lo;
            lo.x = cvt_pk_bf16(x0[0] - bf_lo(hi.x), x0[1] - bf_hi(hi.x)); lo.y = cvt_pk_bf16(x0[2] - bf_lo(hi.y), x0[3] - bf_hi(hi.y));
            lo.z = cvt_pk_bf16(x4[0] - bf_lo(hi.z), x4[1] - bf_hi(hi.z)); lo.w = cvt_pk_bf16(x4[2] - bf_lo(hi.w), x4[3] - bf_hi(hi.w));
            const bf16x8 ah = __builtin_bit_cast(bf16x8, hi), al = __builtin_bit_cast(bf16x8, lo);
            const bf16x8 b0h = *(const LAS bf16x8*)(bh + 64 * ks), b1h = *(const LAS bf16x8*)(bh + 16 * PITCH + 64 * ks);
            const bf16x8 b0l = *(const LAS bf16x8*)(bh + 32 * PITCH + 64 * ks), b1l = *(const LAS bf16x8*)(bh + 48 * PITCH + 64 * ks);
            acc0 = __builtin_amdgcn_mfma_f32_16x16x32_bf16(ah, b0h, acc0, 0, 0, 0); acc1 = __builtin_amdgcn_mfma_f32_16x16x32_bf16(ah, b1h, acc1, 0, 0, 0);
            acc0 = __builtin_amdgcn_mfma_f32_16x16x32_bf16(al, b0h, acc0, 0, 0, 0); acc1 = __builtin_amdgcn_mfma_f32_16x16x32_bf16(al, b1h, acc1, 0, 0, 0);
            acc0 = __builtin_amdgcn_mfma_f32_16x16x32_bf16(ah, b0l, acc0, 0, 0, 0); acc1 = __builtin_amdgcn_mfma_f32_16x16x32_bf16(ah, b1l, acc1, 0, 0, 0);
        }
        ss += __shfl_xor(ss, 16); ss += __shfl_xor(ss, 32);
        const float r = rsqrtf(ss * (1.f / D) + EPS);
        if (kq == 0) { lg[16 * 33 + n] = r; RS[row] = r; }
        asm volatile("s_waitcnt lgkmcnt(0)" ::: "memory");
        const float b0 = br[n], b1 = br[16 + n];
#pragma unroll
        for (int q = 0; q < 4; ++q) { const float rt = lg[16 * 33 + 4 * kq + q]; lg[(4 * kq + q) * 33 + n] = acc0[q] * rt + b0; lg[(4 * kq + q) * 33 + 16 + n] = acc1[q] * rt + b1; }
        asm volatile("s_waitcnt lgkmcnt(0)" ::: "memory");
        if (lane < 16) {
            const int tok = wgu * 128 + wave * 16 + lane;
            float v[32];
#pragma unroll
            for (int e = 0; e < 32; ++e) v[e] = lg[lane * 33 + e];
            unsigned mask = 0u; float val[4]; int sel[4];
#pragma unroll
            for (int k = 0; k < 4; ++k) { float best = -INFINITY; int bi = 0;
#pragma unroll
                for (int e = 0; e < 32; ++e) { const bool ok = !((mask >> e) & 1u) && (v[e] > best); best = ok ? v[e] : best; bi = ok ? e : bi; }
                mask |= 1u << bi; val[k] = best; sel[k] = bi; }
            float ex[4], sum = 0.f;
#pragma unroll
            for (int k = 0; k < 4; ++k) { ex[k] = __expf(val[k] - val[0]); sum += ex[k]; }
            const float inv = 1.f / sum;
#pragma unroll
            for (int k = 0; k < 4; ++k) { const int pos = __hip_atomic_fetch_add(cnt + sel[k], 1, __ATOMIC_RELAXED, __HIP_MEMORY_SCOPE_WORKGROUP);
                TOPI[tok * 4 + k] = sel[k] | (pos << 8); TOPG[tok * 4 + k] = ex[k] * inv; }
        }
        __syncthreads();
        if (tid < 32) WGCNT[wgu * 32 + tid] = cnt[tid];
    }
    __syncthreads();
}
__device__ __forceinline__ void routing_phase(Frame& F) {
    const int* TOPI = (const int*)(F.ws + WS_TOPI); const float* TOPG = (const float*)(F.ws + WS_TOPG); const int* WGCNT = (const int*)(F.ws + WS_WGCNT);
    int* TOKROW = (int*)(F.ws + WS_TOKROW); int* ROWTOK = (int*)(F.ws + WS_ROWTOK); float* ROWGATE = (float*)(F.ws + WS_ROWGATE); int* TILEEXP = (int*)(F.ws + WS_TILEEXP);
    float* ROWSCALE = (float*)(F.ws + WS_ROWSCALE); const float* RS = (const float*)(F.ws + WS_RS);
    const int tid = F.tid;
    LAS int* tot = (LAS int*)(F.lds + LDS_RING);
    LAS int* pst = tot + 32;
    LAS int* mypre = pst + 40;
    LAS int* part = mypre + 32;
    for (int wgu = F.bx; wgu < 256; wgu += F.G) {
        __syncthreads();
        {
            const int e = tid & 31, wq = tid >> 5; int a = 0, mine = 0;
#pragma unroll
            for (int j = 0; j < 16; ++j) { const int w = wq * 16 + j; const int c = WGCNT[w * 32 + e]; a += c; if (w < wgu) mine += c; }
            part[wq * 32 + e] = a; part[512 + wq * 32 + e] = mine;
        }
        __syncthreads();
        if (tid < 32) { int a = 0, mine = 0;
#pragma unroll
            for (int q = 0; q < 16; ++q) { a += part[q * 32 + tid]; mine += part[512 + q * 32 + tid]; }
            tot[tid] = a; mypre[tid] = mine; }
        __syncthreads();
        if (tid == 0) { int a = 0; for (int e = 0; e < 32; ++e) { pst[e] = a; a += (tot[e] + 255) & ~255; } pst[32] = a; }
        __syncthreads();
        {
            const int t = wgu * 128 + (tid >> 2), k = tid & 3;
            const int w = TOPI[t * 4 + k]; const int e = w & 255, pos = w >> 8;
            const int dest = pst[e] + mypre[e] + pos;
            ROWTOK[dest] = t; ROWGATE[dest] = TOPG[t * 4 + k]; ROWSCALE[dest] = RS[t]; TOKROW[t * 4 + k] = dest;
        }
        if (wgu < 32) {
            const int e = wgu; const int beg = pst[e] + tot[e], end = pst[e + 1];
            for (int r = beg + tid; r < end; r += NTHREADS) { ROWTOK[r] = 0; ROWGATE[r] = 0.f; ROWSCALE[r] = 0.f; }
        }
        if (wgu == 0) {
            const int ntiles = pst[32] >> 8;
            for (int pm = tid; pm < ntiles; pm += NTHREADS) { int e = 0; for (int q = 1; q < 32; ++q) if ((pm << 8) >= pst[q]) e = q; TILEEXP[pm] = e; }
            if (tid == 0) TILEEXP[1023] = ntiles;
            if (tid < 33) TILEEXP[768 + tid] = pst[tid];
        }
    }
    __syncthreads();
}
struct CRow { u32x4 h[2]; u32x2 y[4][2]; };
__device__ __forceinline__ void crow_load(CRow& r, const bf16_t* H1, const unsigned char* YB, const int* TOKROW, int m, int lane) {
    const bf16_t* hr = H1 + (size_t)m * D + 8 * lane;
    r.h[0] = *(const u32x4*)(hr); r.h[1] = *(const u32x4*)(hr + 512);
    const int4 tr = *(const int4*)(TOKROW + m * 4);
    const int rows[4] = {tr.x, tr.y, tr.z, tr.w};
#pragma unroll
    for (int k = 0; k < 4; ++k) { const unsigned char* yr = YB + (size_t)rows[k] * D + 8 * lane; r.y[k][0] = *(const u32x2*)(yr); r.y[k][1] = *(const u32x2*)(yr + 512); }
}
__device__ __forceinline__ void crow_finish(CRow& r, float* out32, bf16_t* H2, bf16_t* XN, const float* gnext, int m, int lane) {
    f32x4 v[4];
#pragma unroll
    for (int hf = 0; hf < 2; ++hf) { const u32x4 w = r.h[hf]; v[2 * hf] = (f32x4){bf_lo(w.x), bf_hi(w.x), bf_lo(w.y), bf_hi(w.y)}; v[2 * hf + 1] = (f32x4){bf_lo(w.z), bf_hi(w.z), bf_lo(w.w), bf_hi(w.w)}; }
#pragma unroll
    for (int k = 0; k < 4; ++k)
#pragma unroll
        for (int hf = 0; hf < 2; ++hf) { fp8x4_add(r.y[k][hf].x, 1.f / 16.f, v[2 * hf]); fp8x4_add(r.y[k][hf].y, 1.f / 16.f, v[2 * hf + 1]); }
    if (out32) { float* orow = out32 + (size_t)m * D + 8 * lane; *(f32x4*)(orow) = v[0]; *(f32x4*)(orow + 4) = v[1]; *(f32x4*)(orow + 512) = v[2]; *(f32x4*)(orow + 516) = v[3]; }
    else {
        u32x4 w; w.x = cvt_pk_bf16(v[0][0], v[0][1]); w.y = cvt_pk_bf16(v[0][2], v[0][3]); w.z = cvt_pk_bf16(v[1][0], v[1][1]); w.w = cvt_pk_bf16(v[1][2], v[1][3]);
        *(u32x4*)(H2 + (size_t)m * D + 8 * lane) = w;
        w.x = cvt_pk_bf16(v[2][0], v[2][1]); w.y = cvt_pk_bf16(v[2][2], v[2][3]); w.z = cvt_pk_bf16(v[3][0], v[3][1]); w.w = cvt_pk_bf16(v[3][2], v[3][3]);
        *(u32x4*)(H2 + (size_t)m * D + 512 + 8 * lane) = w;
    }
    if (gnext) {
        float s = 0.f;
#pragma unroll
        for (int j = 0; j < 4; ++j) s += (v[j][0] * v[j][0] + v[j][1] * v[j][1]) + (v[j][2] * v[j][2] + v[j][3] * v[j][3]);
        const float rr = rsqrtf(wave_sum(s) * (1.f / D) + EPS);
        const float* gp = gnext + 8 * lane;
        const f32x4 a0 = v[0] * *(const f32x4*)(gp) * rr, a1 = v[1] * *(const f32x4*)(gp + 4) * rr, a2 = v[2] * *(const f32x4*)(gp + 512) * rr, a3 = v[3] * *(const f32x4*)(gp + 516) * rr;
        u32x4 w; w.x = cvt_pk_bf16(a0[0], a0[1]); w.y = cvt_pk_bf16(a0[2], a0[3]); w.z = cvt_pk_bf16(a1[0], a1[1]); w.w = cvt_pk_bf16(a1[2], a1[3]);
        *(u32x4*)(XN + (size_t)m * D + 8 * lane) = w;
        w.x = cvt_pk_bf16(a2[0], a2[1]); w.y = cvt_pk_bf16(a2[2], a2[3]); w.z = cvt_pk_bf16(a3[0], a3[1]); w.w = cvt_pk_bf16(a3[2], a3[3]);
        *(u32x4*)(XN + (size_t)m * D + 512 + 8 * lane) = w;
    }
}
__device__ __forceinline__ void combine_phase(Frame& F, const float* gnext, float* out32) {
    const unsigned char* YB = (const unsigned char*)(F.ws + WS_YB); const int* TOKROW = (const int*)(F.ws + WS_TOKROW); bf16_t* XN = (bf16_t*)(F.ws + WS_XN);
    const bf16_t* H1 = (const bf16_t*)(F.ws + WS_H1); bf16_t* H2 = (bf16_t*)(F.ws + WS_H2);
    const int lane = F.lane, NGW = F.G * NWAVES;
    CRow ra, rb;
    int m = F.bx * NWAVES + F.wave;
    if (m < T) crow_load(ra, H1, YB, TOKROW, m, lane);
    while (m < T) {
        const int mb = m + NGW;
        if (mb < T) crow_load(rb, H1, YB, TOKROW, mb, lane);
        crow_finish(ra, out32, H2, XN, gnext, m, lane);
        if (mb >= T) break;
        const int mc = mb + NGW;
        if (mc < T) crow_load(ra, H1, YB, TOKROW, mc, lane);
        crow_finish(rb, out32, H2, XN, gnext, mb, lane);
        m = mc;
    }
}

constexpr int NPH_LAYER = 10, NPH = 1 + DEPTH * NPH_LAYER;
__global__ void __launch_bounds__(NTHREADS, 2) mk_fwd(Args args) {
    extern __shared__ __attribute__((aligned(16))) unsigned char lds_raw[];
    Frame F;
    F.lds = (LAS unsigned char*)lds_raw; F.ctl = F.lds + LDS_CTL; F.ws = args.ws; F.ws0 = args.ws; F.out0 = args.out; F.ap = &args; F.z = 0;
    F.tid = threadIdx.x; F.lane = F.tid & 63; F.wave = __builtin_amdgcn_readfirstlane(F.tid >> 6); F.G = gridDim.x; F.bx = blockIdx.x;
    F.out = args.out;
    for (int u = F.tid; u < 1024; u += NTHREADS) ((LAS unsigned*)F.ctl)[u] = 0u;
    __syncthreads();
    XcdBarrier bar = xcd_barrier_post((unsigned*)(F.ws + WS_CTL) + CW_BAR, (volatile LAS unsigned*)F.ctl);
    const int lo = args.ph_lo, hi = args.ph_hi;
#ifndef PHMASK
#define PHMASK 0x1fff
#endif
#define RUN(k) (lo <= (k) && (k) < hi)
#define EN(b) ((PHMASK >> (b)) & 1)
#ifndef DUPMASK
#define DUPMASK 0
#endif
#ifndef ATT_PROBE_MODE
#define ATT_PROBE_MODE 0
#endif
#ifndef PRO_PROBE_MODE
#define PRO_PROBE_MODE 0
#endif
#define NREP(b) (((DUPMASK >> (b)) & 1) ? 2 : 1)
#define SEAM(k) do { if (RUN((k) + 1)) xcd_barrier(bar); } while (0)
    if (EN(10) && RUN(0)) { { if (NREP(10) == 2) { phase_begin(F); p0_prologue<PRO_PROBE_MODE>(F); xcd_barrier(bar); } phase_begin(F); p0_prologue<0>(F); } SEAM(0); }
    for (int l = 0; l < DEPTH; ++l) {
        const int pb = 1 + l * NPH_LAYER;
#ifdef EXTRA_BARRIERS
        for (int eb = 0; eb < EXTRA_BARRIERS; ++eb) xcd_barrier(bar);
#endif
        if (EN(0) && RUN(pb + 0)) { for (int rep = 0; rep < NREP(0); ++rep) { phase_begin(F); unsigned char* ws = F.ws; (void)ws;
            PInProj P; P.so.init(T, DIN, F.G, F.bx); P.A = (const char*)(ws + WS_XN); P.B = (const char*)(ws + WS_WIN + l * WIN_STRIDE);
            P.UQKV = (bf16_t*)(ws + WS_U); P.GQK = (const float*)(ws + WS_SCAL) + 64 + l * 128; P.COS = (const float*)(ws + WS_COS); P.SIN = (const float*)(ws + WS_SIN);
            pg8::gemm_phase(F.lds + LDS_RING, F.ctl, P, F.tid);  if (rep + 1 < NREP(0)) xcd_barrier(bar); } SEAM(pb + 0);
        }
        if (EN(1) && RUN(pb + 1)) { for (int rep = 0; rep < NREP(1); ++rep) { phase_begin(F); unsigned char* ws = F.ws; (void)ws; s5a_phase(F, l);  if (rep + 1 < NREP(1)) xcd_barrier(bar); } SEAM(pb + 1); }
        if (EN(2) && RUN(pb + 2)) { for (int rep = 0; rep < NREP(2); ++rep) { phase_begin(F); unsigned char* ws = F.ws; (void)ws; if (EN(11)) for (int r2 = 0; r2 < NREP(11); ++r2) { phase_begin(F); s5c_phase(F, l); } if (EN(12)) { if (NREP(12) == 2) { phase_begin(F); attn_phase<ATT_PROBE_MODE>(F, l); } phase_begin(F); attn_phase<0>(F, l); }  if (rep + 1 < NREP(2)) xcd_barrier(bar); } SEAM(pb + 2); }
        if (EN(3) && RUN(pb + 3)) { for (int rep = 0; rep < NREP(3); ++rep) { phase_begin(F); unsigned char* ws = F.ws; (void)ws;
            PGlu P; P.so.init(T, DS, F.G, F.bx); P.A = (const char*)(ws + WS_YG); P.B = (const char*)(ws + WS_WGLU + l * WGLU_STRIDE);
            P.YG = (const bf16_t*)(ws + WS_YG); P.MIX = (bf16_t*)(ws + WS_MIX); P.RSP = (float*)(ws + WS_RSP);
            pg8::gemm_phase(F.lds + LDS_RING, F.ctl, P, F.tid);  if (rep + 1 < NREP(3)) xcd_barrier(bar); } SEAM(pb + 3);
        }
        if (EN(4) && RUN(pb + 4)) { for (int rep = 0; rep < NREP(4); ++rep) { phase_begin(F); unsigned char* ws = F.ws; (void)ws;
            POut P; P.so.init(T, D, F.G, F.bx); P.A = (const char*)(ws + WS_MIX); P.B = (const char*)(ws + WS_WOUT + l * WOUT_STRIDE);
            P.RSP = (const float*)(ws + WS_RSP); P.base32 = (l == 0) ? arg_in(0) : nullptr; P.base16 = (const bf16_t*)(ws + WS_H2); P.H1 = (bf16_t*)(ws + WS_H1);
            pg8::gemm_phase(F.lds + LDS_RING, F.ctl, P, F.tid);  if (rep + 1 < NREP(4)) xcd_barrier(bar); } SEAM(pb + 4);
        }
        if (EN(5) && RUN(pb + 5)) { for (int rep = 0; rep < NREP(5); ++rep) { phase_begin(F); unsigned char* ws = F.ws; (void)ws; router_phase(F, l);  if (rep + 1 < NREP(5)) xcd_barrier(bar); } SEAM(pb + 5); }
        if (EN(6) && RUN(pb + 6)) { for (int rep = 0; rep < NREP(6); ++rep) { phase_begin(F); unsigned char* ws = F.ws; (void)ws; routing_phase(F);  if (rep + 1 < NREP(6)) xcd_barrier(bar); } SEAM(pb + 6); }
        if (EN(7) && RUN(pb + 7)) { for (int rep = 0; rep < NREP(7); ++rep) { phase_begin(F); unsigned char* ws = F.ws; (void)ws;
            PUp P; P.mo.init(F.G, F.bx, (const int*)(ws + WS_TILEEXP) + 768);
            P.A = (const char*)(ws + WS_XN); P.B = (const char*)(ws + WS_WUP + l * WUP_STRIDE); P.ROWTOK = (const int*)(ws + WS_ROWTOK); P.TILEEXP = (const int*)(ws + WS_TILEEXP);
            P.bup = arg_in(25) + (size_t)l * NE * 2048; P.ROWSCALE = (const float*)(ws + WS_ROWSCALE); P.ACT = (bf16_t*)(ws + WS_ACT);
            if (GEMM_PROBE && rep + 1 < NREP(7)) { PUpNoDma Q; (PUp&)Q = P; pg8::gemm_phase(F.lds + LDS_RING, F.ctl, Q, F.tid); } else pg8::gemm_phase(F.lds + LDS_RING, F.ctl, P, F.tid);  if (rep + 1 < NREP(7)) xcd_barrier(bar); } SEAM(pb + 7);
        }
        if (EN(8) && RUN(pb + 8)) { for (int rep = 0; rep < NREP(8); ++rep) { phase_begin(F); unsigned char* ws = F.ws; (void)ws;
            PDown P; P.mo.init(F.G, F.bx, (const int*)(ws + WS_TILEEXP) + 768);
            P.A = (const char*)(ws + WS_ACT); P.B = (const char*)(ws + WS_WDN + l * WDN_STRIDE); P.TILEEXP = (const int*)(ws + WS_TILEEXP);
            P.bdn = arg_in(27) + (size_t)l * NE * 1024; P.ROWGATE = (const float*)(ws + WS_ROWGATE); P.YB = (bf16_t*)(ws + WS_YB);
            pg8::gemm_phase(F.lds + LDS_RING, F.ctl, P, F.tid);  if (rep + 1 < NREP(8)) xcd_barrier(bar); } SEAM(pb + 8);
        }
        if (EN(9) && RUN(pb + 9)) { for (int rep = 0; rep < NREP(9); ++rep) { phase_begin(F); unsigned char* ws = F.ws; (void)ws; combine_phase(F, (l + 1 < DEPTH) ? arg_in(1) + (size_t)(l + 1) * D : nullptr, (l + 1 < DEPTH) ? nullptr : F.out);  if (rep + 1 < NREP(9)) xcd_barrier(bar); } SEAM(pb + 9); }
    }
#undef RUN
#undef SEAM
}

extern "C" void kernel_launch(void* const* d_in, const int* in_sizes, int n_in, void* d_out, int out_size, void* d_ws, size_t ws_size, hipStream_t stream) {
    static int grid = 0;
    if (grid == 0) {
        if (n_in != 28 || out_size != T * D || ws_size < WS_END) { fprintf(stderr, "kernel_launch: unexpected shapes (n_in %d out %d ws %zu)\n", n_in, out_size, ws_size); grid = -1; return; }
        int dev = 0, cus = 0;
        if (hipGetDevice(&dev) != hipSuccess || hipDeviceGetAttribute(&cus, hipDeviceAttributeMultiprocessorCount, dev) != hipSuccess) { grid = -1; return; }
        if (hipFuncSetAttribute((const void*)mk_fwd, hipFuncAttributeMaxDynamicSharedMemorySize, LDS_BYTES) != hipSuccess) { fprintf(stderr, "kernel_launch: hipFuncSetAttribute failed\n"); grid = -1; return; }
        int per_cu = 0;
        if (hipOccupancyMaxActiveBlocksPerMultiprocessor(&per_cu, (const void*)mk_fwd, NTHREADS, LDS_BYTES) != hipSuccess || per_cu < 1) { fprintf(stderr, "kernel_launch: occupancy query says %d\n", per_cu); }
        (void)hipGetLastError();
        grid = cus;
    }
    if (grid < 0) return;
    if (hipMemsetAsync((char*)d_ws + WS_CTL, 0, CTL_ZERO_BYTES, stream) != hipSuccess) return;
    Args a{};
    for (int i = 0; i < 28; ++i) a.in[i] = (const float*)d_in[i];
    a.out = (float*)d_out; a.ws = (unsigned char*)d_ws; a.ph_lo = 0; a.ph_hi = NPH;
    hipLaunchKernelGGL(mk_fwd, dim3(grid), dim3(NTHREADS), LDS_BYTES, stream, a);
}
```

```cpp
#include <hip/hip_runtime.h>
#include <cstdio>
#include <cstdint>
#include <math.h>

#ifndef GEMM_PROBE
#define GEMM_PROBE 0
#endif
#ifndef GEMM_PROBE_KIND
#define GEMM_PROBE_KIND 1
#endif
#ifndef IN_FP8
#define IN_FP8 0
#endif
#ifndef MOE_BNT
#define MOE_BNT 0
#endif
#ifndef UP_FP8
#define UP_FP8 1
#endif
#ifndef DN_FP8
#define DN_FP8 1
#endif
#define LAS __attribute__((address_space(3)))
#define GAS __attribute__((address_space(1)))
typedef unsigned short bf16_t;
typedef short bf16x8 __attribute__((ext_vector_type(8)));
typedef short s16x4 __attribute__((ext_vector_type(4)));
typedef float f32x4 __attribute__((ext_vector_type(4)));
typedef float f32x2 __attribute__((ext_vector_type(2)));
typedef float f32x16 __attribute__((ext_vector_type(16)));
typedef unsigned u32x4 __attribute__((ext_vector_type(4)));
typedef unsigned u32x2 __attribute__((ext_vector_type(2)));
typedef int v8i32 __attribute__((ext_vector_type(8)));

constexpr int D = 1024, BATCH = 4, SEQ = 8192, DEPTH = 2, T = BATCH * SEQ;
constexpr int DS = 512, NG = 32, HS = 16, NP = 64, DA = 512, NH = 4, DV = 128, DIN = 2048;
constexpr int NE = 32, DFF = 1024, NASSIGN = T * 4;
constexpr int MPAD_MAX = NASSIGN + NE * 256, NTILE_MAX = MPAD_MAX / 256;
constexpr int NCHUNK = T / 64, CPB = SEQ / 64;
constexpr float EPS = 1e-6f;
constexpr float C2 = 0.125f * 1.4426950408889634f;
constexpr int NWAVES = 8, NTHREADS = 512;

constexpr size_t MiB = 1u << 20;
constexpr size_t WS_CTL = 0, CTL_ZERO_BYTES = 1 * MiB;
constexpr size_t WS_COS = 1 * MiB, WS_SIN = 2 * MiB;
constexpr size_t WS_SCAL = 3 * MiB;
constexpr size_t WS_KT = 4 * MiB, KT_STRIDE = 2 * MiB;
constexpr size_t WS_LAML = 8 * MiB, LAML_STRIDE = 32768;
constexpr size_t WS_WRT = 9 * MiB, WRT_STRIDE = 131072;
constexpr size_t WS_RS = 10 * MiB;
constexpr size_t WS_GT = 16 * MiB, GT_STRIDE = 8 * MiB;
constexpr size_t WS_HT = 32 * MiB, HT_STRIDE = 8 * MiB;
constexpr size_t WS_WIN = 48 * MiB, WIN_STRIDE = 4 * MiB;
constexpr size_t WS_WGLU = 56 * MiB, WGLU_STRIDE = MiB / 2;
constexpr size_t WS_WOUT = 58 * MiB, WOUT_STRIDE = 2 * MiB;
constexpr size_t WS_WUP = 64 * MiB, WUP_STRIDE = 128 * MiB;
constexpr size_t WS_WDN = 320 * MiB, WDN_STRIDE = 64 * MiB;
constexpr size_t WS_XN = 448 * MiB;
constexpr size_t WS_U = 512 * MiB, WS_Q = 544 * MiB, WS_K = 576 * MiB, WS_V = 608 * MiB;
constexpr size_t WS_YG = 640 * MiB;
constexpr size_t WS_MIX = 672 * MiB;
constexpr size_t WS_S = 736 * MiB;
constexpr size_t WS_RSP = 744 * MiB;
constexpr size_t WS_TOPI = 746 * MiB, WS_TOPG = 747 * MiB, WS_TOKROW = 748 * MiB, WS_WGCNT = 749 * MiB;
constexpr size_t WS_ROWTOK = 750 * MiB, WS_ROWGATE = 751 * MiB, WS_TILEEXP = 752 * MiB, WS_ROWSCALE = 753 * MiB;
constexpr size_t WS_ACT = 768 * MiB, WS_YB = 1040 * MiB, WS_H1 = 1180 * MiB, WS_H2 = 1244 * MiB, WS_END = 1312 * MiB;
constexpr int CW_BAR = 4096;

constexpr int LDS_CTL = 0;
constexpr int LDS_RING = 4096;
constexpr int LDS_BYTES = 163840;

__device__ __forceinline__ unsigned f2bf(float f) { unsigned u = __builtin_bit_cast(unsigned, f); return (u + 0x7fffu + ((u >> 16) & 1u)) >> 16; }
__device__ __forceinline__ unsigned pk2(float lo, float hi) { return f2bf(lo) | (f2bf(hi) << 16); }
__device__ __forceinline__ unsigned cvt_pk_bf16(float lo, float hi) { unsigned r; asm volatile("v_cvt_pk_bf16_f32 %0, %1, %2" : "=v"(r) : "v"(lo), "v"(hi)); return r; }
__device__ __forceinline__ unsigned pk4_fp8(float a, float b, float c, float d) { int w = 0; w = __builtin_amdgcn_cvt_pk_fp8_f32(a, b, w, false); w = __builtin_amdgcn_cvt_pk_fp8_f32(c, d, w, true); return (unsigned)w; }
__device__ __forceinline__ void fp8x4_add(unsigned w, float sc, f32x4& a) { const f32x2 lo = __builtin_amdgcn_cvt_pk_f32_fp8((int)w, false), hi = __builtin_amdgcn_cvt_pk_f32_fp8((int)w, true); a[0] += lo[0] * sc; a[1] += lo[1] * sc; a[2] += hi[0] * sc; a[3] += hi[1] * sc; }
__device__ __forceinline__ float bf_lo(unsigned w) { return __builtin_bit_cast(float, w << 16); }
__device__ __forceinline__ float bf_hi(unsigned w) { return __builtin_bit_cast(float, w & 0xffff0000u); }
__device__ __forceinline__ float wave_sum(float v) {
#pragma unroll
    for (int o = 1; o < 64; o <<= 1) v += __shfl_xor(v, o);
    return v;
}
__device__ __forceinline__ float gelu_tanh(float x) {
    const float z = 0.7978845608028654f * (x + 0.044715f * x * x * x);
    return x * __builtin_amdgcn_rcpf(1.f + __builtin_amdgcn_exp2f(-2.885390082f * z));
}
__device__ __forceinline__ float sigmoidf(float v) { return __builtin_amdgcn_rcpf(1.f + __builtin_amdgcn_exp2f(-1.4426950409f * v)); }

#define XB_TMO      128
#define XB_XCNT(j)  (256  + 64 * (j))
#define XB_XSUB(j)  (1280 + 64 * (j))
#define XB_XGEN(j)  (2304 + 64 * (j))
#define XB_TOP      3328
#define XB_TOPGEN   3392
#define XCD_BAR_WORDS 3456
#define XB_SPIN_CAP (1u << 18)
__device__ __forceinline__ unsigned xb_ld(unsigned* p)              { return __hip_atomic_load(p, __ATOMIC_RELAXED, __HIP_MEMORY_SCOPE_AGENT); }
__device__ __forceinline__ unsigned xb_add(unsigned* p, unsigned v) { return __hip_atomic_fetch_add(p, v, __ATOMIC_RELAXED, __HIP_MEMORY_SCOPE_AGENT); }
__device__ __forceinline__ unsigned xb_xcc_id() { return (unsigned)__builtin_amdgcn_s_getreg((3 << 11) | 20) & 0xFu; }
#define XB_SPIN(cond, bar) do { unsigned _sp = 0; while (cond) { __builtin_amdgcn_s_sleep(1); \
    if ((++_sp & 255u) == 0u) { if (xb_ld(&(bar)[XB_TMO])) break; if (_sp > XB_SPIN_CAP) { atomicAdd(&(bar)[XB_TMO], 1u); break; } } } } while (0)
struct XcdBarrier { unsigned* bar; unsigned x; volatile LAS unsigned* st; };
__device__ __forceinline__ XcdBarrier xcd_barrier_post(unsigned* bar, volatile LAS unsigned* st) {
    XcdBarrier b; b.bar = bar; b.x = xb_xcc_id(); b.st = st;
    if (threadIdx.x == 0) (void)xb_add(&bar[XB_XCNT(b.x)], 1u);
    return b;
}
__device__ __forceinline__ void xcd_barrier_complete(unsigned* bar, unsigned x, unsigned& nloc, unsigned& nx) {
    const unsigned G = gridDim.x * gridDim.y * gridDim.z;
    unsigned sum, cnt, mine, sp = 0u;
    for (;;) {
        sum = 0u; cnt = 0u; mine = 0u;
#pragma unroll
        for (unsigned j = 0; j < 16; ++j) { const unsigned c = xb_ld(&bar[XB_XCNT(j)]); sum += c; cnt += (c > 0u) ? 1u : 0u; mine = (j == x) ? c : mine; }
        if (sum == G) break;
        __builtin_amdgcn_s_sleep(1);
        if ((++sp & 255u) == 0u) { if (xb_ld(&bar[XB_TMO])) break; if (sp > XB_SPIN_CAP) { atomicAdd(&bar[XB_TMO], 1u); break; } }
    }
    nloc = mine > 0u ? mine : 1u; nx = cnt > 0u ? cnt : 1u;
}
__device__ __forceinline__ void xcd_barrier(const XcdBarrier& b) {
    asm volatile("s_waitcnt vmcnt(0)" ::: "memory");
    __syncthreads();
    if (threadIdx.x == 0) {
        unsigned* bar = b.bar;
        __builtin_amdgcn_s_waitcnt(0);
        unsigned nloc = b.st[0], nx = b.st[1];
        if (nloc == 0u) { xcd_barrier_complete(bar, b.x, nloc, nx); b.st[0] = nloc; b.st[1] = nx; }
        const unsigned old = xb_add(&bar[XB_XSUB(b.x)], 1u);
        const unsigned gen = old / nloc;
        if (old + 1u == (gen + 1u) * nloc) {
            __builtin_amdgcn_fence(__ATOMIC_RELEASE, "agent");
            asm volatile("s_waitcnt vmcnt(0)" ::: "memory");
            const unsigned og = xb_add(&bar[XB_TOP], 1u);
            const unsigned tg = og / nx;
            if (og + 1u == (tg + 1u) * nx) xb_add(&bar[XB_TOPGEN], 1u);
            else XB_SPIN(xb_ld(&bar[XB_TOPGEN]) == tg, bar);
            __builtin_amdgcn_fence(__ATOMIC_ACQUIRE, "agent");
            xb_add(&bar[XB_XGEN(b.x)], 1u);
            asm volatile("s_waitcnt vmcnt(0)" ::: "memory");
        } else {
            XB_SPIN(xb_ld(&bar[XB_XGEN(b.x)]) == gen, bar);
            __builtin_amdgcn_fence(__ATOMIC_ACQUIRE, "agent");
            asm volatile("s_waitcnt vmcnt(0)" ::: "memory");
        }
    }
    __syncthreads();
}

namespace pg8 {
constexpr int BM = 256, BK = 64, HALF = 128, HTB = HALF * BK * 2, STAGE_BYTES = 8 * HTB;
__host__ __device__ __forceinline__ int lds_byte(int r, int c) { const int st = (r >> 4) * 2 + (c >> 5), rr = r & 15, cc = c & 31, ob = rr * 64 + cc * 2; return st * 1024 + (ob ^ (((ob >> 9) & 1) << 5)); }
__host__ __device__ __forceinline__ void stage_rc(int b, int& R, int& C) { const int st = b / 1024, sb = b % 1024, swz = sb ^ (((sb >> 9) & 1) << 5); R = (st >> 1) * 16 + swz / 64; C = (st & 1) * 32 + (swz % 64) / 2; }
__host__ __device__ __forceinline__ int perm32(int rho) { const int n = rho >> 4, i = rho & 15; return 8 * (i >> 2) + 4 * n + (i & 3); }
__host__ __device__ __forceinline__ int perm16x(int rho) { const int n = rho >> 4, i = rho & 15; return 16 * (i >> 2) + 4 * n + (i & 3); }

struct Unit { int pm, pn; };
template <class P>
__device__ __forceinline__ void gemm_phase(LAS unsigned char* lds, LAS unsigned char* ldsctl, P& S, const int tid) {
    const int wid = __builtin_amdgcn_readfirstlane(tid >> 6), lane = tid & 63, wr = wid >> 2, wc = wid & 3, fr = lane & 15, fq = lane >> 4;
    constexpr bool F8 = P::FP8;
    constexpr int K = P::K, ES = F8 ? 1 : 2, nt = K * ES / 128;
    int R0, C0, R1, C1; stage_rc(tid * 16, R0, C0); stage_rc(tid * 16 + 8192, R1, C1);
    unsigned voffB[2];
    {
        const int Rb0 = P::BROW64 == 2 ? (64 * (R0 >> 5) + perm16x(R0 & 31)) : P::BROW64 ? (64 * (R0 >> 5) + perm32(R0 & 31)) : ((R0 & ~31) + perm32(R0 & 31));
        const int Rb1 = P::BROW64 == 2 ? (64 * (R1 >> 5) + perm16x(R1 & 31)) : P::BROW64 ? (64 * (R1 >> 5) + perm32(R1 & 31)) : ((R1 & ~31) + perm32(R1 & 31));
        voffB[0] = (unsigned)(Rb0 * K * ES + 2 * C0); voffB[1] = (unsigned)(Rb1 * K * ES + 2 * C1);
    }
    const unsigned ldsw = (unsigned)wid * 1024u;
    const int scl8 = P::SCALE_AB;
    const int aoff = lds_byte(wr * 64 + fr, fq * 8), boff = lds_byte(wc * 32 + fr, fq * 8);
#define PG8_SA(b, h) (((b) * 2 + (h)) * HTB)
#define PG8_SB(b, h) ((4 + (b) * 2 + (h)) * HTB)
    const unsigned ldsbase = (unsigned)__builtin_amdgcn_readfirstlane((int)(unsigned)(uintptr_t)lds + (int)ldsw);
#define PG8_GLDS(sbase, voff, ldsdst) do { if (P::NODMA) break; unsigned _keep; asm volatile("s_mov_b32 %0, m0\n\ts_mov_b32 m0, %3\n\ts_nop 0\n\tglobal_load_lds_dwordx4 %2, %1\n\ts_mov_b32 m0, %0" \
        : "=&s"(_keep) : "s"(sbase), "v"(voff), "s"(ldsdst) : "memory"); } while (0)
#define PG8_STAGE_A(bufoff, vo, h, kofs) do { _Pragma("unroll") for (int _i = 0; _i < 2; ++_i) \
        PG8_GLDS(Abase, (vo)[P::GATHER ? (h) : 0][_i] + ((kofs) + (P::GATHER ? 0u : (unsigned)(h) * HSTEPA)), ldsbase + (unsigned)((bufoff) + _i * 8192)); } while (0)
#define PG8_GLDS_NT(sbase, voff, ldsdst) do { if (P::NODMA) break; unsigned _keep; asm volatile("s_mov_b32 %0, m0\n\ts_mov_b32 m0, %3\n\ts_nop 0\n\tglobal_load_lds_dwordx4 %2, %1 nt\n\ts_mov_b32 m0, %0" \
        : "=&s"(_keep) : "s"(sbase), "v"(voff), "s"(ldsdst) : "memory"); } while (0)
#define PG8_STAGE_B(bufoff, gbase) do { _Pragma("unroll") for (int _i = 0; _i < 2; ++_i) { \
        if (P::BNT) PG8_GLDS_NT((const char*)(gbase), voffB[_i], ldsbase + (unsigned)((bufoff) + _i * 8192)); else PG8_GLDS((const char*)(gbase), voffB[_i], ldsbase + (unsigned)((bufoff) + _i * 8192)); } } while (0)
#define PG8_LDA(dst, b, h) do { if constexpr (F8) { _Pragma("unroll") for (int m = 0; m < 4; ++m) { const u32x4 _l = *(const LAS u32x4*)(lds + PG8_SA(b, h) + aoff + m * 2048), _h = *(const LAS u32x4*)(lds + PG8_SA(b, h) + aoff + m * 2048 + 1024); dst##8[m] = __builtin_bit_cast(v8i32, __builtin_shufflevector(_l, _h, 0, 1, 2, 3, 4, 5, 6, 7)); } } \
        else { _Pragma("unroll") for (int m = 0; m < 4; ++m) _Pragma("unroll") for (int k = 0; k < 2; ++k) dst[m][k] = *(const LAS bf16x8*)(lds + PG8_SA(b, h) + aoff + m * 2048 + k * 1024); } } while (0)
#define PG8_LDB(dst, b, h) do { if constexpr (F8) { _Pragma("unroll") for (int n = 0; n < 2; ++n) { const u32x4 _l = *(const LAS u32x4*)(lds + PG8_SB(b, h) + boff + n * 2048), _h = *(const LAS u32x4*)(lds + PG8_SB(b, h) + boff + n * 2048 + 1024); dst##8[n] = __builtin_bit_cast(v8i32, __builtin_shufflevector(_l, _h, 0, 1, 2, 3, 4, 5, 6, 7)); } } \
        else { _Pragma("unroll") for (int n = 0; n < 2; ++n) _Pragma("unroll") for (int k = 0; k < 2; ++k) dst[n][k] = *(const LAS bf16x8*)(lds + PG8_SB(b, h) + boff + n * 2048 + k * 1024); } } while (0)
#define PG8_MMA(ai, bj, At, Bt) do { __builtin_amdgcn_s_setprio(1); \
        if constexpr (F8) { _Pragma("unroll") for (int m = 0; m < 4; ++m) _Pragma("unroll") for (int n = 0; n < 2; ++n) \
            asm volatile("v_mfma_scale_f32_16x16x128_f8f6f4 %0, %1, %2, %0, %3, %3 op_sel:[0,1,0] op_sel_hi:[0,0,0]" : "+v"(acc[ai][bj][m][n]) : "v"(Bt##8[n]), "v"(At##8[m]), "v"(scl8)); } \
        else { _Pragma("unroll") for (int m = 0; m < 4; ++m) _Pragma("unroll") for (int n = 0; n < 2; ++n) _Pragma("unroll") for (int k = 0; k < 2; ++k) \
            acc[ai][bj][m][n] = __builtin_amdgcn_mfma_f32_16x16x32_bf16(Bt[n][k], At[m][k], acc[ai][bj][m][n], 0, 0, 0); } \
        __builtin_amdgcn_s_setprio(0); } while (0)
#define PG8_WAIT_V(n) asm volatile("s_waitcnt vmcnt(" #n ")" ::: "memory")
#define PG8_WAIT_L(n) asm volatile("s_waitcnt lgkmcnt(" #n ")" ::: "memory")
#define PG8_BAR __builtin_amdgcn_s_barrier()
#define PG8_SCHED __builtin_amdgcn_sched_barrier(0)
    Unit cur, nxt; int ui = 0;
    if (!S.next(0, cur)) return;
    f32x4 acc[2][2][4][2];
#pragma unroll
    for (int a = 0; a < 2; ++a)
#pragma unroll
        for (int b = 0; b < 2; ++b)
#pragma unroll
            for (int m = 0; m < 4; ++m)
#pragma unroll
                for (int n = 0; n < 2; ++n) acc[a][b][m][n] = (f32x4){0.f, 0.f, 0.f, 0.f};
    bf16x8 At[4][2], B0[2][2], B1[2][2]; v8i32 At8[4], B08[2], B18[2];
    const char* const Abase = S.a_base();
    unsigned voffA[2][2], voffAn[2][2];
    const char *cB0, *cB1;
    S.unit_begin(cur, ldsctl, tid, 0);
    S.a_offs(cur, R0, C0, R1, C1, voffA, true);
    asm volatile("" ::: "memory");
    S.b_ptrs(cur, cB0, cB1);
    constexpr unsigned kstep = 128, HSTEPA = (unsigned)HALF * K * ES;
    PG8_STAGE_B(PG8_SB(0, 0), cB0); PG8_STAGE_B(PG8_SB(0, 1), cB1); PG8_STAGE_A(PG8_SA(0, 0), voffA, 0, 0u); PG8_STAGE_A(PG8_SA(0, 1), voffA, 1, 0u);
    if (wr == 1) PG8_BAR;
    PG8_WAIT_V(2); PG8_BAR;
    PG8_STAGE_B(PG8_SB(1, 0), cB0 + kstep); PG8_STAGE_A(PG8_SA(1, 0), voffA, 0, kstep); PG8_STAGE_B(PG8_SB(1, 1), cB1 + kstep);
    PG8_WAIT_V(6); PG8_BAR;
    for (;;) {
        const bool has_next = S.next(ui + 1, nxt);
        const char *nB0 = cB0, *nB1 = cB1;
        if constexpr (P::GATHER) {
#pragma unroll
            for (int h = 0; h < 2; ++h)
#pragma unroll
                for (int i = 0; i < 2; ++i) voffAn[h][i] = voffA[h][i];
        }
        if (has_next) { S.unit_begin(nxt, ldsctl, tid, (ui + 1) & 1); S.b_ptrs(nxt, nB0, nB1);
            if constexpr (P::GATHER) { int t2 = tid; asm volatile("" : "+v"(t2)); int r0, c0, r1, c1; stage_rc(t2 * 16, r0, c0); stage_rc(t2 * 16 + 8192, r1, c1); S.a_offs(nxt, r0, c0, r1, c1, voffAn, false); } }
        if (!P::NOEPI) { int l3 = tid; asm volatile("" : "+v"(l3)); S.epi_prefetch(cur, wr, wc, l3 & 15, (l3 >> 4) & 3); }
#pragma unroll 1
        for (int t = 0; t < nt; t += 2) {
            const bool last = (t == nt - 2);
            S.midk(acc, cur, t, wr, fr, ldsctl, ui & 1);
            unsigned a2o[2][2];
            if constexpr (!P::GATHER) { if (last) { int t2 = tid; asm volatile("" : "+v"(t2)); int r0, c0, r1, c1; stage_rc(t2 * 16, r0, c0); stage_rc(t2 * 16 + 8192, r1, c1);
                                                   S.a_offs(has_next ? nxt : cur, r0, c0, r1, c1, voffAn, false); } }
#pragma unroll
            for (int h = 0; h < 2; ++h)
#pragma unroll
                for (int i = 0; i < 2; ++i) a2o[h][i] = last ? voffAn[h][i] : voffA[h][i] + (unsigned)(t + 2) * kstep;
            const char* b2h0 = last ? nB0 : cB0 + (size_t)(t + 2) * kstep; const char* b2h1 = last ? nB1 : cB1 + (size_t)(t + 2) * kstep;
            const unsigned a1k = (unsigned)(t + 1) * kstep;
            PG8_LDB(B0, 0, 0); PG8_LDB(B1, 0, 1); PG8_SCHED; PG8_LDA(At, 0, 0); PG8_STAGE_A(PG8_SA(1, 1), voffA, 1, a1k);
            PG8_WAIT_V(8); PG8_WAIT_L(0); PG8_BAR; PG8_MMA(0, 0, At, B0); PG8_MMA(0, 1, At, B1); PG8_BAR; PG8_SCHED;
            PG8_LDA(At, 0, 1); PG8_STAGE_B(PG8_SB(0, 0), b2h0); PG8_STAGE_B(PG8_SB(0, 1), b2h1); PG8_STAGE_A(PG8_SA(0, 0), a2o, 0, 0u);
            PG8_WAIT_V(8); PG8_WAIT_L(0); PG8_BAR; PG8_MMA(1, 0, At, B0); PG8_MMA(1, 1, At, B1); PG8_BAR; PG8_SCHED;
            PG8_LDB(B0, 1, 0); PG8_LDB(B1, 1, 1); PG8_SCHED; PG8_LDA(At, 1, 0); PG8_STAGE_A(PG8_SA(0, 1), a2o, 1, 0u);
            PG8_WAIT_V(8); PG8_WAIT_L(0); PG8_BAR; PG8_MMA(0, 0, At, B0); PG8_MMA(0, 1, At, B1); PG8_BAR; PG8_SCHED;
            PG8_LDA(At, 1, 1); PG8_STAGE_B(PG8_SB(1, 0), b2h0 + kstep); PG8_STAGE_B(PG8_SB(1, 1), b2h1 + kstep); PG8_STAGE_A(PG8_SA(1, 0), a2o, 0, kstep);
            PG8_WAIT_V(8); PG8_WAIT_L(0); PG8_BAR; PG8_MMA(1, 0, At, B0); PG8_MMA(1, 1, At, B1); PG8_BAR; PG8_SCHED;
        }
        if (wr == 0) PG8_BAR;
        if constexpr (F8) asm volatile("s_nop 15\n\ts_nop 15" ::: "memory");
        { int l2 = tid; asm volatile("" : "+v"(l2)); if (!P::NOEPI) S.epi(acc, cur, wr, wc, l2 & 15, (l2 >> 4) & 3); }
        if (!has_next) break;
#pragma unroll
        for (int a = 0; a < 2; ++a)
#pragma unroll
            for (int b = 0; b < 2; ++b)
#pragma unroll
                for (int m = 0; m < 4; ++m)
#pragma unroll
                    for (int n = 0; n < 2; ++n) acc[a][b][m][n] = (f32x4){0.f, 0.f, 0.f, 0.f};
        cur = nxt; cB0 = nB0; cB1 = nB1; ++ui;
#pragma unroll
        for (int h = 0; h < 2; ++h)
#pragma unroll
            for (int i = 0; i < 2; ++i) voffA[h][i] = voffAn[h][i];
        if (wr == 1) PG8_BAR;
    }
    PG8_WAIT_V(0);
    PG8_BAR;
#undef PG8_SA
#undef PG8_SB
#undef PG8_STAGE_A
#undef PG8_GLDS
#undef PG8_GLDS_NT
#undef PG8_STAGE_B
#undef PG8_LDA
#undef PG8_LDB
#undef PG8_MMA
#undef PG8_WAIT_V
#undef PG8_WAIT_L
#undef PG8_BAR
#undef PG8_SCHED
}
struct StaticOrder {
    int nM, nN, nwg, G, c;
    __device__ void init(int M, int N, int G_, int c_) { nM = M / BM; nN = N / BM; nwg = nM * nN; G = G_; c = c_; }
    __device__ bool next(int i, Unit& u) const {
        const long L = (long)i * G + c; if (L >= nwg) return false;
        int wgid = (int)L; { const int q = nwg / 8, r = nwg % 8, xcd = wgid % 8, off = wgid / 8; wgid = (xcd < r ? xcd * (q + 1) : r * (q + 1) + (xcd - r) * q) + off; }
        const int nig = 8 * nN, gid = wgid / nig, fm = gid * 8, gsz = (nM - fm) < 8 ? (nM - fm) : 8;
        u.pm = fm + ((wgid % nig) % gsz); u.pn = (wgid % nig) / gsz; return true;
    }
};
}

struct Frame {
    LAS unsigned char* lds; LAS unsigned char* ctl;
    unsigned char* ws;
    int tid, lane, wave, G, bx;
    float* out; const struct Args* ap; unsigned char* ws0; float* out0; size_t z;
};

struct Args { const float* in[28]; float* out; unsigned char* ws; int ph_lo, ph_hi; };
#define arg_in(i) (F.ap->in[i] + F.z)
__device__ __forceinline__ void phase_begin(Frame& F) {
    int t = F.tid; asm volatile("" : "+v"(t)); F.tid = t; F.lane = t & 63; F.wave = __builtin_amdgcn_readfirstlane(t >> 6);
    size_t z = 0; asm volatile("" : "+s"(z)); F.z = z; F.ws = F.ws0 + z; F.out = F.out0 + z;
    int bx = F.bx; asm volatile("" : "+s"(bx)); F.bx = bx;
}
__device__ __forceinline__ void phase_restart(Frame& F) {
    int wv = F.wave; asm volatile("" : "+s"(wv)); F.wave = wv;
    int ln = (int)__builtin_amdgcn_mbcnt_hi(~0u, __builtin_amdgcn_mbcnt_lo(~0u, 0u)); asm volatile("" : "+v"(ln)); F.lane = ln; F.tid = wv * 64 + ln;
    size_t z = 0; asm volatile("" : "+s"(z)); F.z = z; F.ws = F.ws0 + z; F.out = F.out0 + z;
}
struct PBase {
    static constexpr bool GATHER = false, FP8 = false, NODMA = false, NOEPI = false, BNT = false; static constexpr int SCALE_AB = 0x7f7f7f7f;
    __device__ __forceinline__ void unit_begin(const pg8::Unit&, LAS unsigned char*, int, int) {}
    __device__ __forceinline__ void midk(f32x4 (&)[2][2][4][2], const pg8::Unit&, int, int, int, LAS unsigned char*, int) {}
    __device__ __forceinline__ void a_fix(unsigned (&)[2][2]) {}
    __device__ __forceinline__ void epi_prefetch(const pg8::Unit&, int, int, int, int) {}
};
struct PInProj : PBase {
    static constexpr int K = 1024, BROW64 = 1; static constexpr bool FP8 = IN_FP8; static constexpr int ES = IN_FP8 ? 1 : 2;
    static constexpr int SCALE_AB = 0x7b79;
    pg8::StaticOrder so; const char* A; const char* B; bf16_t* UQKV; const float *GQK, *COS, *SIN;
    __device__ __forceinline__ bool next(int i, pg8::Unit& u) const { return so.next(i, u); }
    __device__ __forceinline__ const char* a_base() const { return A; }
    __device__ __forceinline__ void a_offs(const pg8::Unit& u, int R0, int C0, int R1, int C1, unsigned (&vo)[2][2], bool) const {
#pragma unroll
        for (int h = 0; h < 2; ++h) { vo[h][0] = (unsigned)((u.pm * 256 + 128 * h + R0) * K * ES + 2 * C0); vo[h][1] = (unsigned)((u.pm * 256 + 128 * h + R1) * K * ES + 2 * C1); }
    }
    __device__ __forceinline__ void b_ptrs(const pg8::Unit& u, const char*& b0, const char*& b1) const { b0 = B + (size_t)u.pn * 256 * K * ES; b1 = b0 + (size_t)32 * K * ES; }
    __device__ __forceinline__ void epi(f32x4 (&acc)[2][2][4][2], const pg8::Unit& u, int wr, int wc, int fr, int fq) const {
        const int kind = u.pn >> 1;
        const int colg = (u.pn & 1) * 256 + 64 * wc;
        bf16_t* dst = UQKV + (size_t)kind * (size_t)(16u << 20);
        const int row0 = u.pm * 256 + wr * 64 + fr;
        if (kind == 0 || kind == 3) {
#pragma unroll
            for (int ai = 0; ai < 2; ++ai)
#pragma unroll
                for (int m = 0; m < 4; ++m) { bf16_t* rowp = dst + (size_t)(row0 + ai * 128 + m * 16) * 512 + colg + 8 * fq;
#pragma unroll
                    for (int bj = 0; bj < 2; ++bj) { const f32x4 v0 = acc[ai][bj][m][0], v1 = acc[ai][bj][m][1];
                        u32x4 w; w.x = cvt_pk_bf16(v0[0], v0[1]); w.y = cvt_pk_bf16(v0[2], v0[3]); w.z = cvt_pk_bf16(v1[0], v1[1]); w.w = cvt_pk_bf16(v1[2], v1[3]);
                        *(u32x4*)(rowp + 32 * bj) = w; } }
        } else {
            const float* g = GQK + (kind - 1) * 64; const float sc = kind == 1 ? C2 * 32.0f : 16.0f;
            f32x4 g0[2], g1[2];
#pragma unroll
            for (int n = 0; n < 2; ++n) { g0[n] = *(const f32x4*)(g + 8 * fq + 4 * n); g1[n] = *(const f32x4*)(g + 32 + 8 * fq + 4 * n); }
#pragma unroll
            for (int ai = 0; ai < 2; ++ai)
#pragma unroll
                for (int m = 0; m < 4; ++m) {
                    const int row = row0 + ai * 128 + m * 16; const int pos = row & (SEQ - 1);
                    float ss = 0.f;
#pragma unroll
                    for (int bj = 0; bj < 2; ++bj)
#pragma unroll
                        for (int n = 0; n < 2; ++n) { const f32x4 x = acc[ai][bj][m][n]; ss += (x[0] * x[0] + x[1] * x[1]) + (x[2] * x[2] + x[3] * x[3]); }
                    ss += __shfl_xor(ss, 16); ss += __shfl_xor(ss, 32);
                    const float r = rsqrtf(ss * (1.f / 64.f) + EPS) * sc;
                    f32x4 o1[2], o2[2];
#pragma unroll
                    for (int n = 0; n < 2; ++n) {
                        const f32x4 c = *(const f32x4*)(COS + (size_t)pos * 32 + 8 * fq + 4 * n), s = *(const f32x4*)(SIN + (size_t)pos * 32 + 8 * fq + 4 * n);
                        const f32x4 x1 = acc[ai][0][m][n] * g0[n] * r, x2 = acc[ai][1][m][n] * g1[n] * r;
                        o1[n] = x1 * c - x2 * s; o2[n] = x2 * c + x1 * s;
                    }
                    unsigned char* rowp = (unsigned char*)dst + (size_t)row * 512 + colg + 8 * fq;
                    u32x2 w; w.x = pk4_fp8(o1[0][0], o1[0][1], o1[0][2], o1[0][3]); w.y = pk4_fp8(o1[1][0], o1[1][1], o1[1][2], o1[1][3]);
                    *(u32x2*)(rowp) = w;
                    w.x = pk4_fp8(o2[0][0], o2[0][1], o2[0][2], o2[0][3]); w.y = pk4_fp8(o2[1][0], o2[1][1], o2[1][2], o2[1][3]);
                    *(u32x2*)(rowp + 32) = w;
                    asm volatile("" ::: "memory");
                }
        }
    }
};
struct PGlu : PBase {
    static constexpr int K = 512, BROW64 = 0;
    pg8::StaticOrder so; const char* A; const char* B; const bf16_t* YG; bf16_t* MIX; float* RSP;
    __device__ __forceinline__ bool next(int i, pg8::Unit& u) const { return so.next(i, u); }
    __device__ __forceinline__ const char* a_base() const { return A; }
    __device__ __forceinline__ void a_offs(const pg8::Unit& u, int R0, int C0, int R1, int C1, unsigned (&vo)[2][2], bool) const {
#pragma unroll
        for (int h = 0; h < 2; ++h) { vo[h][0] = (unsigned)((u.pm * 256 + 128 * h + R0) * K + C0) * 2u; vo[h][1] = (unsigned)((u.pm * 256 + 128 * h + R1) * K + C1) * 2u; }
    }
    __device__ __forceinline__ void b_ptrs(const pg8::Unit& u, const char*& b0, const char*& b1) const { b0 = B + (size_t)u.pn * 256 * K * 2; b1 = b0 + (size_t)128 * K * 2; }
    __device__ __forceinline__ void epi(f32x4 (&acc)[2][2][4][2], const pg8::Unit& u, int wr, int wc, int fr, int fq) const {
        const int row0 = u.pm * 256 + wr * 64 + fr, col0 = u.pn * 256 + wc * 32 + 8 * fq;
#pragma unroll
        for (int ai = 0; ai < 2; ++ai)
#pragma unroll
            for (int m = 0; m < 4; ++m) {
                const int row = row0 + ai * 128 + m * 16; float ss = 0.f;
#pragma unroll
                for (int bj = 0; bj < 2; ++bj) {
                    const u32x4 yw = *(const u32x4*)(YG + (size_t)row * 512 + col0 + 128 * bj);
                    const f32x4 a0 = acc[ai][bj][m][0], a1 = acc[ai][bj][m][1];
                    float z[8];
                    z[0] = bf_lo(yw.x) * sigmoidf(a0[0]); z[1] = bf_hi(yw.x) * sigmoidf(a0[1]); z[2] = bf_lo(yw.y) * sigmoidf(a0[2]); z[3] = bf_hi(yw.y) * sigmoidf(a0[3]);
                    z[4] = bf_lo(yw.z) * sigmoidf(a1[0]); z[5] = bf_hi(yw.z) * sigmoidf(a1[1]); z[6] = bf_lo(yw.w) * sigmoidf(a1[2]); z[7] = bf_hi(yw.w) * sigmoidf(a1[3]);
#pragma unroll
                    for (int i = 0; i < 8; ++i) ss += z[i] * z[i];
                    u32x4 w; w.x = cvt_pk_bf16(z[0], z[1]); w.y = cvt_pk_bf16(z[2], z[3]); w.z = cvt_pk_bf16(z[4], z[5]); w.w = cvt_pk_bf16(z[6], z[7]);
                    *(u32x4*)(MIX + (size_t)row * 1024 + col0 + 128 * bj) = w;
                }
                ss += __shfl_xor(ss, 16); ss += __shfl_xor(ss, 32);
                if (fq == 0) RSP[(size_t)row * 8 + u.pn * 4 + wc] = ss;
            }
    }
};
struct POut : PBase {
    static constexpr int K = 1024, BROW64 = 0;
    pg8::StaticOrder so; const char* A; const char* B; const float* RSP; const float* base32; const bf16_t* base16; bf16_t* H1;
    __device__ __forceinline__ bool next(int i, pg8::Unit& u) const { return so.next(i, u); }
    __device__ __forceinline__ const char* a_base() const { return A; }
    __device__ __forceinline__ void a_offs(const pg8::Unit& u, int R0, int C0, int R1, int C1, unsigned (&vo)[2][2], bool) const {
#pragma unroll
        for (int h = 0; h < 2; ++h) { vo[h][0] = (unsigned)((u.pm * 256 + 128 * h + R0) * K + C0) * 2u; vo[h][1] = (unsigned)((u.pm * 256 + 128 * h + R1) * K + C1) * 2u; }
    }
    __device__ __forceinline__ void b_ptrs(const pg8::Unit& u, const char*& b0, const char*& b1) const { b0 = B + (size_t)u.pn * 256 * K * 2; b1 = b0 + (size_t)128 * K * 2; }
    __device__ __forceinline__ void unit_begin(const pg8::Unit& u, LAS unsigned char* ldsctl, int tid, int slot) const {
        if (tid < 256) {
            const f32x4 p0 = *(const f32x4*)(RSP + (size_t)(u.pm * 256 + tid) * 8), p1 = *(const f32x4*)(RSP + (size_t)(u.pm * 256 + tid) * 8 + 4);
            const float ss = ((p0[0] + p0[1]) + (p0[2] + p0[3])) + ((p1[0] + p1[1]) + (p1[2] + p1[3]));
            ((LAS float*)(ldsctl + 1024 + slot * 1024))[tid] = rsqrtf(ss * (1.f / 512.f) + EPS);
        }
    }
    __device__ __forceinline__ void midk(f32x4 (&acc)[2][2][4][2], const pg8::Unit& u, int t, int wr, int fr, LAS unsigned char* ldsctl, int slot) const {
        if (t == 8) {
            const LAS float* rs = (const LAS float*)(ldsctl + 1024 + slot * 1024);
#pragma unroll
            for (int ai = 0; ai < 2; ++ai)
#pragma unroll
                for (int m = 0; m < 4; ++m) { const float r = rs[ai * 128 + wr * 64 + m * 16 + fr];
#pragma unroll
                    for (int bj = 0; bj < 2; ++bj)
#pragma unroll
                        for (int n = 0; n < 2; ++n) acc[ai][bj][m][n] *= r; }
        }
    }
    __device__ __forceinline__ void epi(f32x4 (&acc)[2][2][4][2], const pg8::Unit& u, int wr, int wc, int fr, int fq) const {
        const int row0 = u.pm * 256 + wr * 64 + fr, col0 = u.pn * 256 + wc * 32 + 8 * fq;
#pragma unroll
        for (int ai = 0; ai < 2; ++ai)
#pragma unroll
            for (int m = 0; m < 4; ++m) { const size_t off = (size_t)(row0 + ai * 128 + m * 16) * 1024 + col0;
#pragma unroll
                for (int bj = 0; bj < 2; ++bj) {
                    f32x4 v0 = acc[ai][bj][m][0], v1 = acc[ai][bj][m][1];
                    if (base32) { v0 += *(const f32x4*)(base32 + off + bj * 128); v1 += *(const f32x4*)(base32 + off + bj * 128 + 4); }
                    else { const u32x4 b = *(const u32x4*)(base16 + off + bj * 128); v0[0] += bf_lo(b.x); v0[1] += bf_hi(b.x); v0[2] += bf_lo(b.y); v0[3] += bf_hi(b.y); v1[0] += bf_lo(b.z); v1[1] += bf_hi(b.z); v1[2] += bf_lo(b.w); v1[3] += bf_hi(b.w); }
                    u32x4 w; w.x = cvt_pk_bf16(v0[0], v0[1]); w.y = cvt_pk_bf16(v0[2], v0[3]); w.z = cvt_pk_bf16(v1[0], v1[1]); w.w = cvt_pk_bf16(v1[2], v1[3]);
                    *(u32x4*)(H1 + off + bj * 128) = w; }
                if (m & 1) asm volatile("" ::: "memory"); }
    }
};
template <int NN> struct MoeOrder {
    int j, wpx, s0, s1, s2, s3, n0, n1, n2, n3;
    __device__ __forceinline__ void init(int G, int c, const int* PST) {
#ifndef MOE_XA
#define MOE_XA 2
#endif
#ifndef MOE_CHUNKED
#define MOE_CHUNKED 0
#endif
        if (MOE_XA == 1 && (G & 7) == 0) { wpx = G >> 3; const int x = MOE_CHUNKED ? c / wpx : (c & 7); j = MOE_CHUNKED ? c % wpx : (c >> 3);
            s0 = PST[x] >> 8; n0 = (PST[x + 1] - PST[x]) >> 8; s1 = PST[x + 8] >> 8; n1 = (PST[x + 9] - PST[x + 8]) >> 8;
            s2 = PST[x + 16] >> 8; n2 = (PST[x + 17] - PST[x + 16]) >> 8; s3 = PST[x + 24] >> 8; n3 = (PST[x + 25] - PST[x + 24]) >> 8; }
        else { j = c; wpx = G; s0 = 0; n0 = PST[32] >> 8; s1 = s2 = s3 = 0; n1 = n2 = n3 = 0; }
        if (MOE_XA == 2 && (G & 7) == 0) { wpx = G >> 3; j = c >> 3; s1 = c & 7; n0 = PST[32] >> 8; }
    }
    __device__ __forceinline__ bool next(int i, pg8::Unit& u) const {
        const int q = i * wpx + j; int pml = q / NN; u.pn = q % NN;
        if (MOE_XA == 2) { u.pm = s1 + 8 * pml; return u.pm < n0; }
        if (pml < n0) { u.pm = s0 + pml; return true; } pml -= n0;
        if (pml < n1) { u.pm = s1 + pml; return true; } pml -= n1;
        if (pml < n2) { u.pm = s2 + pml; return true; } pml -= n2;
        if (pml < n3) { u.pm = s3 + pml; return true; }
        return false;
    }
};
struct PUp : PBase {
    static constexpr int K = 1024, BROW64 = 0; static constexpr bool GATHER = true, FP8 = UP_FP8, BNT = MOE_BNT; static constexpr int ES = UP_FP8 ? 1 : 2;
    static constexpr int SCALE_AB = 0x7c79;
    MoeOrder<8> mo; const char* A; const char* B; const int* ROWTOK; const int* TILEEXP; const float* bup; const float* ROWSCALE; bf16_t* ACT;
    int idx[2][2]; int c0, c1;
    __device__ __forceinline__ bool next(int i, pg8::Unit& u) const { return mo.next(i, u); }
    __device__ __forceinline__ const char* a_base() const { return A; }
    __device__ __forceinline__ void a_offs(const pg8::Unit& u, int R0, int C0, int R1, int C1, unsigned (&vo)[2][2], bool first) {
        c0 = C0; c1 = C1;
        const int* rp = ROWTOK + u.pm * 256;
#pragma unroll
        for (int h = 0; h < 2; ++h) {
            asm volatile("global_load_dword %0, %1, off" : "=v"(idx[h][0]) : "v"(rp + 128 * h + R0) : "memory");
            asm volatile("global_load_dword %0, %1, off" : "=v"(idx[h][1]) : "v"(rp + 128 * h + R1) : "memory");
        }
        asm volatile("s_waitcnt vmcnt(0)" : "+v"(idx[0][0]), "+v"(idx[0][1]), "+v"(idx[1][0]), "+v"(idx[1][1]) :: "memory");
#pragma unroll
        for (int h = 0; h < 2; ++h) { vo[h][0] = (unsigned)(idx[h][0] * K * ES + 2 * c0); vo[h][1] = (unsigned)(idx[h][1] * K * ES + 2 * c1); }
    }
    __device__ __forceinline__ void b_ptrs(const pg8::Unit& u, const char*& b0, const char*& b1) const {
        const int e = TILEEXP[u.pm]; b0 = B + ((size_t)e * 2048 + (size_t)u.pn * 128) * K * ES; b1 = b0 + (size_t)1024 * K * ES; }
    float ps[8]; f32x4 pbg[2], pbl[2];
    __device__ __forceinline__ void epi_prefetch(const pg8::Unit& u, int wr, int wc, int fr, int fq) {
        const int e = TILEEXP[u.pm];
        const int row0 = u.pm * 256 + wr * 64 + fr, col0 = u.pn * 128 + wc * 32 + 8 * fq;
        const float* bg = bup + (size_t)e * 2048 + col0; const float* bl = bg + 1024;
#pragma unroll
        for (int ai = 0; ai < 2; ++ai)
#pragma unroll
            for (int m = 0; m < 4; ++m) asm volatile("global_load_dword %0, %1, off" : "=v"(ps[ai * 4 + m]) : "v"(ROWSCALE + row0 + ai * 128 + m * 16) : "memory");
#pragma unroll
        for (int n = 0; n < 2; ++n) { asm volatile("global_load_dwordx4 %0, %1, off" : "=v"(pbg[n]) : "v"(bg + 4 * n) : "memory"); asm volatile("global_load_dwordx4 %0, %1, off" : "=v"(pbl[n]) : "v"(bl + 4 * n) : "memory"); }
    }
    __device__ __forceinline__ void epi(f32x4 (&acc)[2][2][4][2], const pg8::Unit& u, int wr, int wc, int fr, int fq) {
        const int row0 = u.pm * 256 + wr * 64 + fr, col0 = u.pn * 128 + wc * 32 + 8 * fq;
        asm volatile("" : "+v"(ps[0]), "+v"(ps[1]), "+v"(ps[2]), "+v"(ps[3]), "+v"(ps[4]), "+v"(ps[5]), "+v"(ps[6]), "+v"(ps[7]), "+v"(pbg[0]), "+v"(pbg[1]), "+v"(pbl[0]), "+v"(pbl[1]));
        f32x4 bg4[2], bl1[2];
#pragma unroll
        for (int n = 0; n < 2; ++n) { bg4[n] = pbg[n] * 4.0f; bl1[n] = pbl[n] + 1.0f; }
        constexpr float CS = -2.4554669595f * 0.25f;
#pragma unroll
        for (int ai = 0; ai < 2; ++ai) {
            u32x2 w8[4];
#pragma unroll
            for (int m = 0; m < 4; ++m) {
                const float rs = ps[ai * 4 + m], rs4 = rs * 4.0f;
                f32x4 av[2];
#pragma unroll
                for (int n = 0; n < 2; ++n) {
                    f32x4 G = acc[ai][0][m][n] * rs4 + bg4[n], L = acc[ai][1][m][n] * rs + bl1[n], E;
#pragma unroll
                    for (int j = 0; j < 4; ++j) { G[j] = fminf(G[j], 28.0f); L[j] = __builtin_amdgcn_fmed3f(L[j], -6.0f, 8.0f); }
                    const f32x4 X = G * CS;
#pragma unroll
                    for (int j = 0; j < 4; ++j) E[j] = __builtin_amdgcn_exp2f(X[j]);
                    E = E + 1.0f;
#pragma unroll
                    for (int j = 0; j < 4; ++j) E[j] = __builtin_amdgcn_rcpf(E[j]);
                    av[n] = G * E * L;
                }
                w8[m].x = pk4_fp8(av[0][0], av[0][1], av[0][2], av[0][3]); w8[m].y = pk4_fp8(av[1][0], av[1][1], av[1][2], av[1][3]);
            }
            const bool odd = fq & 1;
#pragma unroll
            for (int mp = 0; mp < 2; ++mp) {
                const u32x2 snd = odd ? w8[2 * mp] : w8[2 * mp + 1], own = odd ? w8[2 * mp + 1] : w8[2 * mp];
                u32x2 rcv; rcv.x = (unsigned)__shfl_xor((int)snd.x, 16); rcv.y = (unsigned)__shfl_xor((int)snd.y, 16);
                const u32x4 w = odd ? (u32x4){rcv.x, rcv.y, own.x, own.y} : (u32x4){own.x, own.y, rcv.x, rcv.y};
                const int row = row0 + ai * 128 + (2 * mp + (odd ? 1 : 0)) * 16;
                *(u32x4*)((unsigned char*)ACT + (size_t)row * 1024 + u.pn * 128 + wc * 32 + 16 * (fq >> 1)) = w;
            }
        }
    }
};
struct PUpNoDma : PUp { static constexpr bool NODMA = (GEMM_PROBE_KIND & 1) != 0, NOEPI = (GEMM_PROBE_KIND & 2) != 0; };
struct PDown : PBase {
    static constexpr int K = 1024, BROW64 = 2; static constexpr bool FP8 = DN_FP8, BNT = MOE_BNT; static constexpr int ES = DN_FP8 ? 1 : 2;
    static constexpr int SCALE_AB = 0x7d79;
    MoeOrder<4> mo; const char* A; const char* B; const int* TILEEXP; const float* bdn; const float* ROWGATE; bf16_t* YB;
    __device__ __forceinline__ bool next(int i, pg8::Unit& u) const { return mo.next(i, u); }
    __device__ __forceinline__ const char* a_base() const { return A; }
    __device__ __forceinline__ void a_offs(const pg8::Unit& u, int R0, int C0, int R1, int C1, unsigned (&vo)[2][2], bool) const {
#pragma unroll
        for (int h = 0; h < 2; ++h) { vo[h][0] = (unsigned)((u.pm * 256 + 128 * h + R0) * K * ES + 2 * C0); vo[h][1] = (unsigned)((u.pm * 256 + 128 * h + R1) * K * ES + 2 * C1); }
    }
    __device__ __forceinline__ void b_ptrs(const pg8::Unit& u, const char*& b0, const char*& b1) const {
        const int e = TILEEXP[u.pm]; b0 = B + ((size_t)e * 1024 + (size_t)u.pn * 256) * K * ES; b1 = b0 + (size_t)8 * K * ES; }
    float pg[8]; f32x4 pb[2][2];
    __device__ __forceinline__ void epi_prefetch(const pg8::Unit& u, int wr, int wc, int fr, int fq) {
        const int e = TILEEXP[u.pm];
        const int row0 = u.pm * 256 + wr * 64 + fr, col0 = u.pn * 256 + wc * 64 + 16 * fq;
        const float* bp = bdn + (size_t)e * 1024 + col0;
#pragma unroll
        for (int ai = 0; ai < 2; ++ai)
#pragma unroll
            for (int m = 0; m < 4; ++m) asm volatile("global_load_dword %0, %1, off" : "=v"(pg[ai * 4 + m]) : "v"(ROWGATE + row0 + ai * 128 + m * 16) : "memory");
#pragma unroll
        for (int bj = 0; bj < 2; ++bj)
#pragma unroll
            for (int n = 0; n < 2; ++n) asm volatile("global_load_dwordx4 %0, %1, off" : "=v"(pb[bj][n]) : "v"(bp + 8 * bj + 4 * n) : "memory");
    }
    __device__ __forceinline__ void epi(f32x4 (&acc)[2][2][4][2], const pg8::Unit& u, int wr, int wc, int fr, int fq) {
        const int row0 = u.pm * 256 + wr * 64 + fr, col0 = u.pn * 256 + wc * 64 + 16 * fq;
        asm volatile("" : "+v"(pg[0]), "+v"(pg[1]), "+v"(pg[2]), "+v"(pg[3]), "+v"(pg[4]), "+v"(pg[5]), "+v"(pg[6]), "+v"(pg[7]), "+v"(pb[0][0]), "+v"(pb[0][1]), "+v"(pb[1][0]), "+v"(pb[1][1]));
#pragma unroll
        for (int ai = 0; ai < 2; ++ai)
#pragma unroll
            for (int m = 0; m < 4; ++m) { const int row = row0 + ai * 128 + m * 16; const float gt = pg[ai * 4 + m] * 16.f;
                const f32x4 v00 = (acc[ai][0][m][0] + pb[0][0]) * gt, v01 = (acc[ai][0][m][1] + pb[0][1]) * gt, v10 = (acc[ai][1][m][0] + pb[1][0]) * gt, v11 = (acc[ai][1][m][1] + pb[1][1]) * gt;
                u32x4 w; w.x = pk4_fp8(v00[0], v00[1], v00[2], v00[3]); w.y = pk4_fp8(v01[0], v01[1], v01[2], v01[3]); w.z = pk4_fp8(v10[0], v10[1], v10[2], v10[3]); w.w = pk4_fp8(v11[0], v11[1], v11[2], v11[3]);
                *(u32x4*)((unsigned char*)YB + (size_t)row * 1024 + col0) = w; }
    }
};

struct TItem { const float* src; bf16_t* dst; const float* ksc; int N, K; unsigned char* dst8; };
__device__ __forceinline__ void titem_load(const TItem& it, f32x4 (&v)[16], int lane) {
    const float* p = it.src + (size_t)(lane >> 4) * it.N + 4 * (lane & 15);
#pragma unroll
    for (int i = 0; i < 16; ++i) v[i] = *(const f32x4*)(p + (size_t)(4 * i) * it.N);
}
__device__ __forceinline__ void titem_store(const TItem& it, f32x4 (&v)[16], LAS float* scr, int lane) {
    if (it.ksc) {
#pragma unroll
        for (int i = 0; i < 16; ++i) v[i] *= it.ksc[4 * i + (lane >> 4)];
    }
#pragma unroll
    for (int i = 0; i < 16; ++i) { LAS float* d = scr + (4 * i + (lane >> 4)) * 65 + 4 * (lane & 15); d[0] = v[i][0]; d[1] = v[i][1]; d[2] = v[i][2]; d[3] = v[i][3]; }
    asm volatile("s_waitcnt lgkmcnt(0)" ::: "memory");
    if (it.dst8) {
        const int c = lane & 3;
#pragma unroll
        for (int j = 0; j < 4; ++j) { const int n = (lane >> 2) + 16 * j; const LAS float* s = scr + (16 * c) * 65 + n;
            u32x4 o;
            o.x = pk4_fp8(s[0 * 65] * 64.f, s[1 * 65] * 64.f, s[2 * 65] * 64.f, s[3 * 65] * 64.f); o.y = pk4_fp8(s[4 * 65] * 64.f, s[5 * 65] * 64.f, s[6 * 65] * 64.f, s[7 * 65] * 64.f);
            o.z = pk4_fp8(s[8 * 65] * 64.f, s[9 * 65] * 64.f, s[10 * 65] * 64.f, s[11 * 65] * 64.f); o.w = pk4_fp8(s[12 * 65] * 64.f, s[13 * 65] * 64.f, s[14 * 65] * 64.f, s[15 * 65] * 64.f);
            *(u32x4*)(it.dst8 + (size_t)n * it.K + 16 * c) = o; }
    } else {
        const int c = lane & 7;
#pragma unroll
        for (int j = 0; j < 8; ++j) { const int n = (lane >> 3) + 8 * j; const LAS float* s = scr + (8 * c) * 65 + n;
            u32x4 o; o.x = pk2(s[0 * 65], s[1 * 65]); o.y = pk2(s[2 * 65], s[3 * 65]); o.z = pk2(s[4 * 65], s[5 * 65]); o.w = pk2(s[6 * 65], s[7 * 65]);
            *(u32x4*)(it.dst + (size_t)n * it.K + 8 * c) = o; }
    }
    asm volatile("s_waitcnt lgkmcnt(0)" ::: "memory");
}
__device__ __forceinline__ void rms_row_to_bf16(const f32x4 (&v)[4], const float* g, bf16_t* orow, int lane) {
    float s = 0.f;
#pragma unroll
    for (int j = 0; j < 4; ++j) s += (v[j][0] * v[j][0] + v[j][1] * v[j][1]) + (v[j][2] * v[j][2] + v[j][3] * v[j][3]);
    const float r = rsqrtf(wave_sum(s) * (1.f / D) + EPS) * (IN_FP8 ? 16.f : 1.f);
#pragma unroll
    for (int j = 0; j < 4; ++j) { const f32x4 gg = *(const f32x4*)(g + 4 * lane + 256 * j); const f32x4 o = v[j] * gg * r;
        if (IN_FP8) { ((unsigned*)orow)[lane + 64 * j] = pk4_fp8(o[0], o[1], o[2], o[3]); }
        else { u32x2 w; w.x = cvt_pk_bf16(o[0], o[1]); w.y = cvt_pk_bf16(o[2], o[3]); *(u32x2*)(orow + 4 * lane + 256 * j) = w; } }
}
struct Cplx { float re, im; };
__device__ __forceinline__ Cplx cmul(Cplx a, Cplx b) { return Cplx{a.re * b.re - a.im * b.im, a.re * b.im + a.im * b.re}; }
__device__ __forceinline__ Cplx lam_pow(float lr, float li, float step, int n) {
    const float mag = expf((float)n * lr * step); const double ang = (double)n * (double)li * (double)step;
    return Cplx{mag * (float)cos(ang), mag * (float)sin(ang)};
}
__device__ __forceinline__ Cplx lam_pow_fast(float lr, float li, float step, int n) {
    const float mag = __expf((float)n * lr * step); const double rev = (double)n * (double)li * (double)step * 0.15915494309189535; const float fr = (float)(rev - floor(rev));
    return Cplx{mag * __builtin_amdgcn_cosf(fr), mag * __builtin_amdgcn_sinf(fr)};
}
__device__ __forceinline__ Cplx bbar_factor(float lr, float li, float step) {
    const Cplx lb = lam_pow(lr, li, step, 1); const float nr = lb.re - 1.f, ni = lb.im, den = lr * lr + li * li;
    return Cplx{(nr * lr + ni * li) / den, (ni * lr - nr * li) / den};
}
template <int PMODE> __device__ __forceinline__ void p0_prologue(Frame& F) {
    const int gw = F.bx * NWAVES + F.wave, NGW = F.G * NWAVES, lane = F.lane;
    const int gt = F.bx * NTHREADS + F.tid, NGT = F.G * NTHREADS;
    unsigned char* ws = F.ws;
    if (!(PMODE & 1)) {
        LAS float* scr = (LAS float*)(F.lds + LDS_RING) + F.wave * (64 * 65);
        constexpr int I_UP = UP_FP8 ? 0 : 32 * 16 * 32, I_DN = DN_FP8 ? 0 : 32 * 16 * 16, I_IN = IN_FP8 ? 0 : 16 * 32, I_OUT = 16 * 16, I_GLU = 8 * 8;
        constexpr int PER_L = I_UP + I_DN + I_IN + I_OUT + I_GLU, TOTAL = DEPTH * PER_L;
        auto decode = [&](int it) -> TItem {
            TItem ti; const int l = it / PER_L; int r = it % PER_L; const float* W; bf16_t* WT; int K, N; ti.ksc = nullptr; bool f8 = false;
            if (r < I_UP) { const int e = r / 512; r %= 512; K = 1024; N = 2048; W = arg_in(24) + ((size_t)l * NE + e) * 1024 * 2048; WT = (bf16_t*)(ws + WS_WUP + l * WUP_STRIDE) + (size_t)e * 2048 * 1024 / (UP_FP8 ? 2 : 1); f8 = UP_FP8; }
            else if ((r -= I_UP) < I_DN) { const int e = r / 256; r %= 256; K = 1024; N = 1024; W = arg_in(26) + ((size_t)l * NE + e) * 1024 * 1024; WT = (bf16_t*)(ws + WS_WDN + l * WDN_STRIDE) + (size_t)e * 1024 * 1024 / (DN_FP8 ? 2 : 1); f8 = DN_FP8; }
            else if ((r -= I_DN) < I_IN) { K = 1024; N = 2048; W = arg_in(2) + (size_t)l * 1024 * 2048; WT = (bf16_t*)(ws + WS_WIN + l * WIN_STRIDE); }
            else if ((r -= I_IN) < I_OUT) { K = 1024; N = 1024; W = arg_in(20) + (size_t)l * 1024 * 1024; WT = (bf16_t*)(ws + WS_WOUT + l * WOUT_STRIDE); if ((r / 16) * 64 < DS) ti.ksc = arg_in(12) + l * DS + (r / 16) * 64; }
            else { r -= I_OUT; K = 512; N = 512; W = arg_in(11) + (size_t)l * 512 * 512; WT = (bf16_t*)(ws + WS_WGLU + l * WGLU_STRIDE); }
            const int nblk = N / 64, k0 = 64 * (r / nblk), n0 = 64 * (r % nblk);
            ti.src = W + (size_t)k0 * N + n0; ti.dst = WT + (size_t)n0 * K + k0; ti.N = N; ti.K = K; ti.dst8 = f8 ? (unsigned char*)WT + (size_t)n0 * K + k0 : nullptr; return ti;
        };
        f32x4 va[16]; TItem ia;
        for (int it = gw; it < TOTAL; it += NGW) { ia = decode(it); titem_load(ia, va, lane); titem_store(ia, va, scr, lane); }
    }
    if (!(PMODE & 1) && (UP_FP8 || DN_FP8 || IN_FP8)) {
        LAS float* tile = (LAS float*)(F.lds + LDS_RING);
        constexpr int C_UP = UP_FP8 ? 32 * 8 * 8 : 0, C_DN = DN_FP8 ? 32 * 8 * 4 : 0, C_IN = IN_FP8 ? 8 * 8 : 0, C_PER_L = C_UP + C_DN + C_IN, C_TOTAL = DEPTH * C_PER_L;
        auto cdecode = [&](int it, const float*& src, unsigned char*& dst, int& N) {
            const int l = it / C_PER_L; int r = it % C_PER_L; const float* W; unsigned char* WT;
            if (r < C_UP) { const int e = r >> 6; r &= 63; N = 2048; W = arg_in(24) + ((size_t)l * NE + e) * 1024 * 2048; WT = ws + WS_WUP + l * WUP_STRIDE + (size_t)e * 2048 * 1024; }
            else if (r < C_UP + C_DN) { r -= C_UP; const int e = r >> 5; r &= 31; N = 1024; W = arg_in(26) + ((size_t)l * NE + e) * 1024 * 1024; WT = ws + WS_WDN + l * WDN_STRIDE + (size_t)e * 1024 * 1024; }
            else { r -= C_UP + C_DN; N = 2048; W = arg_in(2) + (size_t)l * 1024 * 2048; WT = ws + WS_WIN + l * WIN_STRIDE; }
            const int nblk = N >> 8, k0 = 128 * (r / nblk), n0 = 256 * (r % nblk);
            src = W + (size_t)k0 * N + n0; dst = WT + (size_t)n0 * 1024 + k0;
        };
        auto cload = [&](const float* src, int N, f32x4 (&v)[16]) {
            const float* p = src + (size_t)F.wave * N + 4 * lane;
#pragma unroll
            for (int i = 0; i < 16; ++i) v[i] = *(const f32x4*)(p + (size_t)(8 * i) * N);
        };
        auto cstore = [&](unsigned char* dst, f32x4 (&v)[16]) {
            __syncthreads();
#pragma unroll
            for (int i = 0; i < 16; ++i) *(LAS f32x4*)(tile + (8 * i + F.wave) * 260 + 4 * lane) = v[i];
            __syncthreads();
            const int n = F.tid & 255, cc = F.tid >> 8;
#pragma unroll
            for (int j = 0; j < 4; ++j) { const int c = 2 * j + cc; const LAS float* sp = tile + (16 * c) * 260 + n;
                u32x4 o;
                o.x = pk4_fp8(sp[0 * 260] * 64.f, sp[1 * 260] * 64.f, sp[2 * 260] * 64.f, sp[3 * 260] * 64.f); o.y = pk4_fp8(sp[4 * 260] * 64.f, sp[5 * 260] * 64.f, sp[6 * 260] * 64.f, sp[7 * 260] * 64.f);
                o.z = pk4_fp8(sp[8 * 260] * 64.f, sp[9 * 260] * 64.f, sp[10 * 260] * 64.f, sp[11 * 260] * 64.f); o.w = pk4_fp8(sp[12 * 260] * 64.f, sp[13 * 260] * 64.f, sp[14 * 260] * 64.f, sp[15 * 260] * 64.f);
                *(u32x4*)(dst + (size_t)n * 1024 + 16 * c) = o; }
        };
        f32x4 va[16], vb[16]; const float* sa; const float* sb; unsigned char* da; unsigned char* db; int na, nb;
        int it = F.bx;
        if (it < C_TOTAL) { cdecode(it, sa, da, na); cload(sa, na, va); }
        while (it < C_TOTAL) {
            const int itb = it + F.G;
            if (itb < C_TOTAL) { cdecode(itb, sb, db, nb); cload(sb, nb, vb); }
            cstore(da, va);
            if (itb >= C_TOTAL) break;
            const int itc = itb + F.G;
            if (itc < C_TOTAL) { cdecode(itc, sa, da, na); cload(sa, na, va); }
            cstore(db, vb);
            it = itc;
        }
        __syncthreads();
    }
    phase_begin(F); ws = F.ws;
    for (int i = F.bx * NTHREADS + F.tid; i < SEQ * 32; i += NGT) {
        const int s = i >> 5, j = i & 31;
        const float inv = 1.0f / powf(10000.0f, (float)(2 * j) / 64.0f);
        const float ang = (float)s * inv;
        ((float*)(ws + WS_COS))[i] = (float)cos((double)ang); ((float*)(ws + WS_SIN))[i] = (float)sin((double)ang);
    }
    if (F.bx == 0 && F.wave < DEPTH) {
        const int l = F.wave;
        float a = arg_in(15)[l * 64 + lane] * arg_in(16)[l * 64 + lane], b = arg_in(17)[l * 64 + lane] * arg_in(18)[l * 64 + lane];
        a = wave_sum(a); b = wave_sum(b);
        float mq = fabsf(arg_in(13)[l * 64 + lane]), mk = fabsf(arg_in(14)[l * 64 + lane]);
#pragma unroll
        for (int o = 1; o < 64; o <<= 1) { mq = fmaxf(mq, __shfl_xor(mq, o)); mk = fmaxf(mk, __shfl_xor(mk, o)); }
        const float lambda_init = 0.8f - 0.6f * expf(-0.3f * (float)l);
        { float* gqk = (float*)(ws + WS_SCAL) + 64 + l * 128; gqk[lane] = arg_in(13)[l * 64 + lane]; gqk[64 + lane] = arg_in(14)[l * 64 + lane]; }
        if (lane == 0) { float* sc = (float*)(ws + WS_SCAL) + l * 4; sc[0] = expf(a) - expf(b) + lambda_init; sc[1] = C2 * 64.f * mq * mk * 1.02f + 0.5f; sc[2] = 1.0f - lambda_init; }
    }
    for (int i = gt; i < DEPTH * NE * D; i += NGT) {
        const int l = i / (NE * D), e = (i / D) % NE, k = i % D;
        const float w = arg_in(22)[(size_t)l * D * NE + (size_t)k * NE + e];
        const unsigned hi = f2bf(w); const float lo = w - __builtin_bit_cast(float, hi << 16);
        bf16_t* t = (bf16_t*)(ws + WS_WRT + l * WRT_STRIDE);
        t[e * D + k] = (bf16_t)hi; t[NE * D + e * D + k] = (bf16_t)f2bf(lo);
    }
    phase_begin(F); ws = F.ws;
#define TBL_PTRS(l) const float* lam_re = arg_in(3) + (l) * NG * NP; const float* lam_im = arg_in(4) + (l) * NG * NP; const float* log_step = arg_in(5) + (l) * NG; \
        const float* b_re = arg_in(6) + (size_t)(l) * NG * NP * HS; const float* b_im = arg_in(7) + (size_t)(l) * NG * NP * HS; \
        const float* c_re = arg_in(8) + (size_t)(l) * NG * HS * NP; const float* c_im = arg_in(9) + (size_t)(l) * NG * HS * NP; \
        bf16_t* KT = (bf16_t*)(ws + WS_KT + (l) * KT_STRIDE); bf16_t* HT = (bf16_t*)(ws + WS_HT + (l) * HT_STRIDE); (void)KT; (void)HT; (void)b_re; (void)b_im
    if (!(PMODE & 2)) {
        {
            LAS float* pwl = (LAS float*)(F.lds + LDS_RING);
            for (int cb = F.bx; cb < DEPTH * NG * 17; cb += F.G) {
                const int l = cb / (NG * 17), rb = cb % (NG * 17);
                if (rb >= NG * 9) continue;
                const int blk = rb;
                TBL_PTRS(l);
                const int g = blk / 9, s0 = (blk % 9) * 8;
                const float step = expf(log_step[g]);
                LAS float* cgl = pwl + 1024;
                LAS float* ffl = cgl + 2048;
                LAS float* bgl = ffl + 128;
                __syncthreads();
                { const int p = F.tid & 63, sl = F.tid >> 6, slot = s0 + sl; Cplx w{0.f, 0.f};
                  if (slot >= 1 && slot <= 64) w = lam_pow_fast(lam_re[g * NP + p], lam_im[g * NP + p], step, slot - 1);
                  pwl[(sl * 64 + p) * 2] = w.re; pwl[(sl * 64 + p) * 2 + 1] = w.im; }
                for (int idx = F.tid; idx < 1024; idx += NTHREADS) { cgl[2 * idx] = c_re[(size_t)g * HS * NP + idx]; cgl[2 * idx + 1] = c_im[(size_t)g * HS * NP + idx]; }
                if (F.tid < 64) { const Cplx f = bbar_factor(lam_re[g * NP + F.tid], lam_im[g * NP + F.tid], step); ffl[2 * F.tid] = f.re; ffl[2 * F.tid + 1] = f.im; }
                __syncthreads();
                for (int idx = F.tid; idx < 1024; idx += NTHREADS) { const int p = idx >> 4; const Cplx w = cmul(Cplx{ffl[2 * p], ffl[2 * p + 1]}, Cplx{b_re[(size_t)g * NP * HS + idx], b_im[(size_t)g * NP * HS + idx]}); bgl[2 * idx] = w.re; bgl[2 * idx + 1] = w.im; }
                __syncthreads();
                const int pq = F.tid & 3, h = (F.tid >> 2) & 15, sl = F.tid >> 6, slot = s0 + sl;
                float accv[16];
#pragma unroll
                for (int q = 0; q < 16; ++q) accv[q] = 0.f;
                for (int pp = 0; pp < 16; ++pp) {
                    const int p = pq * 16 + pp;
                    const Cplx w = cmul(Cplx{cgl[(h * 64 + p) * 2], cgl[(h * 64 + p) * 2 + 1]}, Cplx{pwl[(sl * 64 + p) * 2], pwl[(sl * 64 + p) * 2 + 1]});
                    const LAS f32x4* bp = (const LAS f32x4*)(bgl + p * 32);
#pragma unroll
                    for (int q2 = 0; q2 < 8; ++q2) { const f32x4 bb = bp[q2]; accv[2 * q2] += w.re * bb[0] - w.im * bb[1]; accv[2 * q2 + 1] += w.re * bb[2] - w.im * bb[3]; }
                }
#pragma unroll
                for (int q = 0; q < 16; ++q) { accv[q] += __shfl_xor(accv[q], 1); accv[q] += __shfl_xor(accv[q], 2); }
                if (pq == 0 && slot <= 64) {
                    u32x4 o0, o1; o0.x = pk2(accv[0], accv[1]); o0.y = pk2(accv[2], accv[3]); o0.z = pk2(accv[4], accv[5]); o0.w = pk2(accv[6], accv[7]);
                    o1.x = pk2(accv[8], accv[9]); o1.y = pk2(accv[10], accv[11]); o1.z = pk2(accv[12], accv[13]); o1.w = pk2(accv[14], accv[15]);
                    u32x4* dst = (u32x4*)(KT + ((size_t)(g * 65 + slot) * HS + h) * 16); dst[0] = o0; dst[1] = o1;
                }
            }
            for (int cb = F.bx; cb < DEPTH * NG * 17; cb += F.G) {
                const int l = cb / (NG * 17), rb = cb % (NG * 17);
                if (rb < NG * 9) continue;
                const int blk = rb - NG * 9;
                TBL_PTRS(l);
                const int g = blk >> 3, t0 = (blk & 7) * 8;
                const float step = expf(log_step[g]);
                __syncthreads();
                LAS float* cgl = pwl + 1024;
                { const int p = F.tid & 63, tl = F.tid >> 6; const Cplx w = lam_pow_fast(lam_re[g * NP + p], lam_im[g * NP + p], step, t0 + tl + 1); pwl[(tl * 64 + p) * 2] = w.re; pwl[(tl * 64 + p) * 2 + 1] = w.im; }
                for (int idx = F.tid; idx < 1024; idx += NTHREADS) { cgl[2 * idx] = c_re[(size_t)g * HS * NP + idx]; cgl[2 * idx + 1] = c_im[(size_t)g * HS * NP + idx]; }
                __syncthreads();
                const int pq = F.tid & 3, h = (F.tid >> 2) & 15, tl = F.tid >> 6, t = t0 + tl;
                bf16_t* dst = HT + ((size_t)(g * 1024 + t * 16 + h) * 128 + pq * 32);
                for (int pp = 0; pp < 16; pp += 4) {
                    float v[8];
#pragma unroll
                    for (int q = 0; q < 4; ++q) { const int p = pq * 16 + pp + q;
                        const Cplx w = cmul(Cplx{cgl[(h * 64 + p) * 2], cgl[(h * 64 + p) * 2 + 1]}, Cplx{pwl[(tl * 64 + p) * 2], pwl[(tl * 64 + p) * 2 + 1]});
                        v[2 * q] = w.re; v[2 * q + 1] = -w.im; }
                    u32x4 o; o.x = pk2(v[0], v[1]); o.y = pk2(v[2], v[3]); o.z = pk2(v[4], v[5]); o.w = pk2(v[6], v[7]);
                    *(u32x4*)(dst + 2 * pp) = o;
                }
            }
            __syncthreads();
        }
    }
#undef TBL_PTRS
    if (!(PMODE & 2)) for (int l = 0; l < DEPTH; ++l) {
        const float* lam_re = arg_in(3) + l * NG * NP; const float* lam_im = arg_in(4) + l * NG * NP; const float* log_step = arg_in(5) + l * NG;
        const float* b_re = arg_in(6) + (size_t)l * NG * NP * HS; const float* b_im = arg_in(7) + (size_t)l * NG * NP * HS;
        const float* c_re = arg_in(8) + (size_t)l * NG * HS * NP; const float* c_im = arg_in(9) + (size_t)l * NG * HS * NP;
        bf16_t* KT = (bf16_t*)(ws + WS_KT + l * KT_STRIDE); bf16_t* GT = (bf16_t*)(ws + WS_GT + l * GT_STRIDE); bf16_t* HT = (bf16_t*)(ws + WS_HT + l * HT_STRIDE);
        float* LAML = (float*)(ws + WS_LAML + l * LAML_STRIDE);
        for (int i = gt; i < NG * NP * 64; i += NGT) {
            const int s = i % 64, p = (i / 64) % NP, g = i / (64 * NP);
            const float step = expf(log_step[g]); const float lr = lam_re[g * NP + p], li = lam_im[g * NP + p];
            const Cplx w = cmul(lam_pow_fast(lr, li, step, 63 - s), bbar_factor(lr, li, step));
            float vr[16], vi[16];
#pragma unroll
            for (int q = 0; q < 16; ++q) { const float br = b_re[(size_t)(g * NP + p) * HS + q], bi = b_im[(size_t)(g * NP + p) * HS + q]; vr[q] = w.re * br - w.im * bi; vi[q] = w.re * bi + w.im * br; }
            u32x4* dr = (u32x4*)(GT + ((size_t)(g * 128 + 2 * p) * 1024 + s * 16)); u32x4* di = (u32x4*)(GT + ((size_t)(g * 128 + 2 * p + 1) * 1024 + s * 16));
            u32x4 o; o.x = pk2(vr[0], vr[1]); o.y = pk2(vr[2], vr[3]); o.z = pk2(vr[4], vr[5]); o.w = pk2(vr[6], vr[7]); dr[0] = o;
            o.x = pk2(vr[8], vr[9]); o.y = pk2(vr[10], vr[11]); o.z = pk2(vr[12], vr[13]); o.w = pk2(vr[14], vr[15]); dr[1] = o;
            o.x = pk2(vi[0], vi[1]); o.y = pk2(vi[2], vi[3]); o.z = pk2(vi[4], vi[5]); o.w = pk2(vi[6], vi[7]); di[0] = o;
            o.x = pk2(vi[8], vi[9]); o.y = pk2(vi[10], vi[11]); o.z = pk2(vi[12], vi[13]); o.w = pk2(vi[14], vi[15]); di[1] = o;
        }
        for (int i = gt; i < NG * NP; i += NGT) { const int g = i / NP; const Cplx w = lam_pow(lam_re[i], lam_im[i], expf(log_step[g]), 64); LAML[2 * i] = w.re; LAML[2 * i + 1] = w.im; }
    }
    {
        const float* xin = arg_in(0); const float* g0 = arg_in(1); bf16_t* XN = (bf16_t*)(ws + WS_XN);
        f32x4 va[4], vb[4];
        int m = gw;
        if (m < T) {
#pragma unroll
            for (int j = 0; j < 4; ++j) va[j] = ((const f32x4*)(xin + (size_t)m * D) + lane)[64 * j]; }
        while (m < T) {
            const int mb = m + NGW;
            if (mb < T) {
#pragma unroll
                for (int j = 0; j < 4; ++j) vb[j] = ((const f32x4*)(xin + (size_t)mb * D) + lane)[64 * j]; }
            rms_row_to_bf16(va, g0, (bf16_t*)((unsigned char*)XN + (size_t)m * D * (IN_FP8 ? 1 : 2)), lane);
            if (mb >= T) break;
            const int mc = mb + NGW;
            if (mc < T) {
#pragma unroll
                for (int j = 0; j < 4; ++j) va[j] = ((const f32x4*)(xin + (size_t)mc * D) + lane)[64 * j]; }
            rms_row_to_bf16(vb, g0, (bf16_t*)((unsigned char*)XN + (size_t)mb * D * (IN_FP8 ? 1 : 2)), lane);
            m = mc;
        }
    }
}

__device__ __forceinline__ void s5a_phase(Frame& F, int l) {
    const bf16_t* GT = (const bf16_t*)(F.ws + WS_GT + l * GT_STRIDE); const bf16_t* U = (const bf16_t*)(F.ws + WS_U); float* S = (float*)(F.ws + WS_S);
    const int lane = F.lane, n = lane & 15, kq = lane >> 4;
    for (int uu = F.bx * NWAVES + F.wave; uu < NG * 32 * 2; uu += F.G * NWAVES) {
        const int g = uu >> 6, ntile = (uu >> 1) & 31, mh = uu & 1;
        const int chunk = ntile * 16 + n;
        const bf16_t* up = U + ((size_t)chunk * 64 + (kq >> 1)) * DS + g * 16 + 8 * (kq & 1);
        const bf16_t* gp = GT + ((size_t)(g * 128 + mh * 64 + n) * 1024 + 8 * kq);
        f32x4 acc[4];
#pragma unroll
        for (int mt = 0; mt < 4; ++mt) acc[mt] = (f32x4){0.f, 0.f, 0.f, 0.f};
#pragma unroll 4
        for (int ks = 0; ks < 32; ++ks) {
            const bf16x8 b = *(const bf16x8*)(up + (size_t)(2 * ks) * DS);
#pragma unroll
            for (int mt = 0; mt < 4; ++mt) { const bf16x8 a = *(const bf16x8*)(gp + (size_t)(mt * 16) * 1024 + 32 * ks); acc[mt] = __builtin_amdgcn_mfma_f32_16x16x32_bf16(a, b, acc[mt], 0, 0, 0); }
        }
#pragma unroll
        for (int mt = 0; mt < 4; ++mt) *(f32x4*)(S + ((size_t)chunk * NG + g) * 128 + mh * 64 + mt * 16 + 4 * kq) = acc[mt];
    }
}
__device__ __forceinline__ void s5c_phase(Frame& F, int l) {
    const bf16_t* KT = (const bf16_t*)(F.ws + WS_KT + l * KT_STRIDE); const bf16_t* HT = (const bf16_t*)(F.ws + WS_HT + l * HT_STRIDE);
    const float* LAML = (const float*)(F.ws + WS_LAML + l * LAML_STRIDE); const float* S = (const float*)(F.ws + WS_S);
    const bf16_t* U = (const bf16_t*)(F.ws + WS_U); bf16_t* YG = (bf16_t*)(F.ws + WS_YG); const float* dsk = arg_in(10) + l * DS;
    const int lane = F.lane, n = lane & 15, kq = lane >> 4, wave = F.wave;
    LAS unsigned char* ktl = F.lds + LDS_RING;
    LAS unsigned char* xs = F.lds + LDS_RING + 33792 + wave * 4096;
    LAS f32x2* EB = (LAS f32x2*)(F.lds + LDS_RING + 33792 + 8 * 4096);
    LAS f32x2* EH = EB + 512;
    for (int wu = F.bx; wu < NG * 8; wu += F.G) {
        const int g = wu >> 3, scq = wu & 7, b = scq >> 1, cbase = (scq & 1) * 64, scl = wave >> 1, par = wave & 1;
        __syncthreads();
        for (int i = F.tid; i < 65 * 32; i += NTHREADS) *(LAS u32x4*)(ktl + i * 16) = *(const u32x4*)(KT + (size_t)g * 65 * 256 + i * 8);
        const Cplx L = Cplx{LAML[(g * NP + lane) * 2], LAML[(g * NP + lane) * 2 + 1]};
        const float* sp = S + ((size_t)(b * CPB) * NG + g) * 128 + 2 * lane;
        {
            f32x2 sv[8];
#pragma unroll
            for (int j = 0; j < 8; ++j) sv[j] = *(const f32x2*)(sp + (size_t)(cbase + 8 * wave + j) * NG * 128);
            Cplx E{0.f, 0.f};
#pragma unroll
            for (int j = 0; j < 8; ++j) { const Cplx nx = cmul(L, E); E.re = nx.re + sv[j][0]; E.im = nx.im + sv[j][1]; }
            EB[wave * 64 + lane] = (f32x2){E.re, E.im};
            if (cbase) {
#pragma unroll
                for (int j = 0; j < 8; ++j) sv[j] = *(const f32x2*)(sp + (size_t)(8 * wave + j) * NG * 128);
                Cplx H{0.f, 0.f};
#pragma unroll
                for (int j = 0; j < 8; ++j) { const Cplx nx = cmul(L, H); H.re = nx.re + sv[j][0]; H.im = nx.im + sv[j][1]; }
                EH[wave * 64 + lane] = (f32x2){H.re, H.im};
            }
        }
        __syncthreads();
        const int c0 = cbase + 16 * scl;
        {
            const Cplx L2 = cmul(L, L), L4 = cmul(L2, L2), L8 = cmul(L4, L4);
            Cplx X{0.f, 0.f};
            if (cbase) {
#pragma unroll
                for (int w = 0; w < 8; ++w) { const f32x2 e = EH[w * 64 + lane]; const Cplx nx = cmul(L8, X); X.re = nx.re + e[0]; X.im = nx.im + e[1]; }
            }
            for (int w = 0; w < 2 * scl; ++w) { const f32x2 e = EB[w * 64 + lane]; const Cplx nx = cmul(L8, X); X.re = nx.re + e[0]; X.im = nx.im + e[1]; }
            f32x2 sv[16];
#pragma unroll
            for (int j = 0; j < 16; ++j) sv[j] = *(const f32x2*)(sp + (size_t)(c0 + j) * NG * 128);
#pragma unroll
            for (int j = 0; j < 16; ++j) {
                *(LAS unsigned*)(xs + j * 256 + 4 * lane) = pk2(X.re, X.im);
                const Cplx nx = cmul(L, X); X.re = nx.re + sv[j][0]; X.im = nx.im + sv[j][1];
            }
        }
        const int chunk = b * CPB + c0 + n;
        bf16x8 ub[32];
        {
            const bf16_t* up = U + ((size_t)chunk * 64 + (kq >> 1)) * DS + g * 16 + 8 * (kq & 1);
#pragma unroll
            for (int kp = 0; kp < 32; ++kp) ub[kp] = *(const bf16x8*)(up + (size_t)(2 * kp) * DS);
        }
        const LAS unsigned char* xbp = xs + n * 256 + 16 * kq;
        const f32x4 dv = *(const f32x4*)(dsk + g * 16 + 4 * kq);
        const bf16_t* hp = HT + ((size_t)(g * 1024 + n) * 128 + 8 * kq);
        const bf16_t* uq = U + (size_t)chunk * 64 * DS + g * 16 + 4 * kq;
        const LAS unsigned char* kbase = ktl + (n * 16 + 8 * (kq & 1)) * 2;
        u32x2 uw = *(const u32x2*)(uq + (size_t)par * DS);
        for (int ti = 0; ti < 32; ++ti) {
            const int t = 2 * ti + par, tn = (ti < 31) ? t + 2 : t;
            bf16x8 ha[4];
#pragma unroll
            for (int ks = 0; ks < 4; ++ks) ha[ks] = *(const bf16x8*)(hp + (size_t)(t * 16) * 128 + 32 * ks);
            const u32x2 un = *(const u32x2*)(uq + (size_t)tn * DS);
            f32x4 acc = (f32x4){0.f, 0.f, 0.f, 0.f};
            const int slot0 = t + 1 - (kq >> 1);
#pragma unroll
            for (int kp = 0; kp < 32; ++kp) {
                if (kp <= ti) { const bf16x8 a = *(const LAS bf16x8*)(kbase + (slot0 - 2 * kp) * 512); acc = __builtin_amdgcn_mfma_f32_16x16x32_bf16(a, ub[kp], acc, 0, 0, 0); }
            }
#pragma unroll
            for (int ks = 0; ks < 4; ++ks) acc = __builtin_amdgcn_mfma_f32_16x16x32_bf16(ha[ks], *(const LAS bf16x8*)(xbp + 64 * ks), acc, 0, 0, 0);
            const float y0 = acc[0] + dv[0] * bf_lo(uw.x), y1 = acc[1] + dv[1] * bf_hi(uw.x), y2 = acc[2] + dv[2] * bf_lo(uw.y), y3 = acc[3] + dv[3] * bf_hi(uw.y);
            u32x2 w; w.x = cvt_pk_bf16(gelu_tanh(y0), gelu_tanh(y1)); w.y = cvt_pk_bf16(gelu_tanh(y2), gelu_tanh(y3));
            *(u32x2*)(YG + ((size_t)chunk * 64 + t) * DS + g * 16 + 4 * kq) = w;
            uw = un;
        }
    }
    __syncthreads();
}

namespace att {
constexpr int KSLOT = 8192, VSLOT = 16384, NSLOT = 4, LDS_K = 0, LDS_V = NSLOT * KSLOT, LDS_WS = NSLOT * (KSLOT + VSLOT), LDS_END = LDS_WS + 8 * 256;
constexpr int STG_ROW = 136;
__device__ __forceinline__ int crow(int r, int hi) { return (r & 3) + 8 * (r >> 2) + 4 * hi; }
__device__ __forceinline__ void glds16(const void* gsrc, unsigned lds_dst) { unsigned keep;
    asm volatile("s_mov_b32 %0, m0\n\ts_mov_b32 m0, %2\n\ts_nop 0\n\tglobal_load_lds_dwordx4 %1, off\n\ts_mov_b32 m0, %0" : "=&s"(keep) : "v"(gsrc), "s"(lds_dst) : "memory"); }
typedef __attribute__((address_space(3))) const char* lds_cptr;
typedef short v4i16_t __attribute__((ext_vector_type(4)));
__device__ __forceinline__ s16x4 vtr(lds_cptr p) { return __builtin_bit_cast(s16x4, __builtin_amdgcn_ds_read_tr16_b64_v4i16((__attribute__((address_space(3))) v4i16_t*)p)); }
#define ATT_WAIT_BAR(N) asm volatile("s_waitcnt vmcnt(" #N ") lgkmcnt(0)\n\ts_barrier" ::: "memory")

template <int MODE> __device__ __forceinline__ void attn_unit(int bh, int qb, const bf16_t* Q, const bf16_t* K, const bf16_t* V, bf16_t* MIX, const float* subg, float lam, float mshift, float oml,
                                          LAS unsigned char* shm, int tid) {
    const int lane = tid & 63, r32 = lane & 31, hi = lane >> 5; const int wid = __builtin_amdgcn_readfirstlane(tid >> 6);
    const int b = bh >> 2, h = bh & 3, m = wid & 1, qg = wid >> 1;
    const size_t rowbase = (size_t)b * SEQ; const int q0 = qb * 128;
    const int NT = 2 * qb + 2, cw = 2 * qb + (qg >> 1);
    const unsigned lds0 = (unsigned)(uintptr_t)shm;
    const unsigned char* k0src = (const unsigned char*)K + (rowbase + lane) * DA + h * 128 + (wid >> 2) * 64 + ((wid >> 1) & 1) * 32 + (wid & 1) * 16;
    const bf16_t* v0src = V + (rowbase + 16 * (wid & 3) + (lane >> 2)) * DA + h * 128 + (wid >> 2) * 32 + (lane & 3) * 8;
    const bf16_t* v1src = v0src + 64;
    const unsigned kdst = lds0 + LDS_K + (wid >> 2) * 4096 + (wid & 3) * 1024, vdst = lds0 + LDS_V + wid * 1024;
#define ATT_DMA(t, slot) do { const size_t _o = (size_t)(t) * 64 * DA; \
        glds16(k0src + _o, (unsigned)__builtin_amdgcn_readfirstlane(kdst + (slot) * KSLOT)); glds16(k1src + _o, (unsigned)__builtin_amdgcn_readfirstlane(kdst + (slot) * KSLOT + 8192)); \
        glds16(v0src + _o, (unsigned)__builtin_amdgcn_readfirstlane(vdst + (slot) * VSLOT)); glds16(v1src + _o, (unsigned)__builtin_amdgcn_readfirstlane(vdst + (slot) * VSLOT + 8192)); } while (0)
    v8i32 qf;
    { const unsigned char* Qw = (const unsigned char*)Q + (rowbase + q0 + qg * 32 + r32) * DA + h * 128 + m * 64 + hi * 32;
      const u32x4 ql = *(const u32x4*)(Qw), qh = *(const u32x4*)(Qw + 16); qf = __builtin_bit_cast(v8i32, __builtin_shufflevector(ql, qh, 0, 1, 2, 3, 4, 5, 6, 7)); }
#ifndef ATT_GRP
#define ATT_GRP (wid & 1)
#endif
    const int grp = ATT_GRP;
#define ATT_DMA_K(t, slot) do { if (MODE & 1) break; const size_t _o = (size_t)(t) * 64 * DA; \
        glds16(k0src + _o, (unsigned)__builtin_amdgcn_readfirstlane(kdst + (slot) * KSLOT)); } while (0)
#define ATT_DMA_V(t, slot) do { if (MODE & 1) break; const size_t _o = (size_t)(t) * 64 * DA; \
        glds16(v0src + _o, (unsigned)__builtin_amdgcn_readfirstlane(vdst + (slot) * VSLOT)); glds16(v1src + _o, (unsigned)__builtin_amdgcn_readfirstlane(vdst + (slot) * VSLOT + 8192)); } while (0)
    ATT_DMA_K(0, 0); ATT_DMA_V(0, 0); ATT_DMA_K(1, 1); ATT_DMA_V(1, 1); if (NT > 2) { ATT_DMA_K(2, 2); ATT_DMA_V(2, 2); }
    f32x16 o[4];
#pragma unroll
    for (int d = 0; d < 4; ++d)
#pragma unroll
        for (int r = 0; r < 16; ++r) o[d][r] = 0.f;
    float l_reg = 0.f;
    const f32x16 zero16 = {0.f, 0.f, 0.f, 0.f, 0.f, 0.f, 0.f, 0.f, 0.f, 0.f, 0.f, 0.f, 0.f, 0.f, 0.f, 0.f};
    (void)mshift;
    const lds_cptr shm3 = (lds_cptr)shm;
    const lds_cptr kp0 = shm3 + LDS_K + m * 4096 + hi * 2048 + r32 * 16;
    const lds_cptr vp0 = shm3 + LDS_V + ((lane >> 4) & 1) * 32 + (lane & 3) * 8 + (4 * hi + ((lane & 15) >> 2)) * 64;
    u32x4 pw[4];
#pragma unroll
    for (int q = 0; q < 4; ++q) pw[q] = (u32x4){0u, 0u, 0u, 0u};
#define ATT_SB() __builtin_amdgcn_sched_barrier(0)
#define ATT_QKEXP(sl) do { if (MODE & 2) break; const lds_cptr kp = kp0 + (sl) * KSLOT; \
        ATT_SB(); \
        const u32x4 k0l = *(const __attribute__((address_space(3))) u32x4*)(kp), k0h = *(const __attribute__((address_space(3))) u32x4*)(kp + 1024); \
        const u32x4 k1l = *(const __attribute__((address_space(3))) u32x4*)(kp + 512), k1h = *(const __attribute__((address_space(3))) u32x4*)(kp + 1024 + 512); \
        ATT_SB(); \
        const v8i32 kf0 = __builtin_bit_cast(v8i32, __builtin_shufflevector(k0l, k0h, 0, 1, 2, 3, 4, 5, 6, 7)), kf1 = __builtin_bit_cast(v8i32, __builtin_shufflevector(k1l, k1h, 0, 1, 2, 3, 4, 5, 6, 7)); \
        f32x16 p0 = __builtin_amdgcn_mfma_scale_f32_32x32x64_f8f6f4(kf0, qf, zero16, 0, 0, 0, 0x7a7b, 1, 0x7a7b); \
        f32x16 p1 = __builtin_amdgcn_mfma_scale_f32_32x32x64_f8f6f4(kf1, qf, zero16, 0, 0, 0, 0x7a7b, 1, 0x7a7b); \
        ATT_SB(); \
        float sacc = 0.f; \
        _Pragma("unroll") for (int r = 0; r < 16; ++r) { p0[r] = __builtin_amdgcn_exp2f(p0[r]); p1[r] = __builtin_amdgcn_exp2f(p1[r]); sacc += p0[r] + p1[r]; } \
        l_reg += sacc; \
        _Pragma("unroll") for (int q = 0; q < 4; ++q) { pw[0][q] = cvt_pk_bf16(p0[2 * q], p0[2 * q + 1]); pw[1][q] = cvt_pk_bf16(p0[8 + 2 * q], p0[8 + 2 * q + 1]); \
                                                        pw[2][q] = cvt_pk_bf16(p1[2 * q], p1[2 * q + 1]); pw[3][q] = cvt_pk_bf16(p1[8 + 2 * q], p1[8 + 2 * q + 1]); } } while (0)
#define ATT_VRD(buf, d) do { _Pragma("unroll") for (int ks = 0; ks < 4; ++ks) { buf[0][ks] = vtr(vp + (d) * 4096 + ks * 1024); buf[1][ks] = vtr(vp + (d) * 4096 + ks * 1024 + 512); } } while (0)
#define ATT_VMM(buf, d, PW) do { _Pragma("unroll") for (int ks = 0; ks < 4; ++ks) { \
        const bf16x8 vf = (bf16x8){buf[0][ks][0], buf[0][ks][1], buf[0][ks][2], buf[0][ks][3], buf[1][ks][0], buf[1][ks][1], buf[1][ks][2], buf[1][ks][3]}; \
        o[d] = __builtin_amdgcn_mfma_f32_32x32x16_bf16(__builtin_bit_cast(bf16x8, PW[ks]), vf, o[d], 0, 0, 0); } } while (0)
#define ATT_PV(sl, PW) do { if (MODE & 4) break; const lds_cptr vp = vp0 + (sl) * VSLOT; s16x4 va[2][4], vb[2][4]; \
        ATT_SB(); ATT_VRD(va, 0); ATT_SB(); ATT_VRD(vb, 1); ATT_SB(); ATT_VMM(va, 0, PW); ATT_SB(); ATT_VRD(va, 2); ATT_SB(); ATT_VMM(vb, 1, PW); ATT_SB(); \
        ATT_VRD(vb, 3); ATT_SB(); ATT_VMM(va, 2, PW); ATT_SB(); ATT_VMM(vb, 3, PW); ATT_SB(); } while (0)
    u32x4 pwn[4];
#define ATT_PIN(x) asm volatile("" : "+v"(x))
#define ATT_MM(d, ks, cur, nxt, PW) do { \
        if ((d) < 3) { nxt[0][ks] = vtr(vp + ((d) + 1) * 4096 + (ks) * 1024); nxt[1][ks] = vtr(vp + ((d) + 1) * 4096 + (ks) * 1024 + 512); } \
        { const bf16x8 vf = (bf16x8){cur[0][ks][0], cur[0][ks][1], cur[0][ks][2], cur[0][ks][3], cur[1][ks][0], cur[1][ks][1], cur[1][ks][2], cur[1][ks][3]}; \
          o[d] = __builtin_amdgcn_mfma_f32_32x32x16_bf16(__builtin_bit_cast(bf16x8, PW[ks]), vf, o[d], 0, 0, 0); } \
        asm volatile("" : "+v"(o[d]));     \
        } while (0)
#define ATT_EX(PX, e0, PWN, q) do { PX[e0] = __builtin_amdgcn_exp2f(PX[e0]); PX[(e0) + 1] = __builtin_amdgcn_exp2f(PX[(e0) + 1]); sacc += PX[e0]; sacc += PX[(e0) + 1]; ATT_PIN(sacc); \
        PWN[q] = cvt_pk_bf16(PX[e0], PX[(e0) + 1]); ATT_PIN(PWN); } while (0)
#define ATT_FUSED(slk, slk1, PW, PWN) do { const lds_cptr kp = kp0 + (slk1) * KSLOT; const lds_cptr vp = vp0 + (slk) * VSLOT; s16x4 va[2][4], vb[2][4]; \
        ATT_SB(); \
        const u32x4 k0l = *(const __attribute__((address_space(3))) u32x4*)(kp), k0h = *(const __attribute__((address_space(3))) u32x4*)(kp + 1024); \
        const u32x4 k1l = *(const __attribute__((address_space(3))) u32x4*)(kp + 512), k1h = *(const __attribute__((address_space(3))) u32x4*)(kp + 1024 + 512); \
        ATT_VRD(va, 0); \
        ATT_SB(); \
        const v8i32 kf0 = __builtin_bit_cast(v8i32, __builtin_shufflevector(k0l, k0h, 0, 1, 2, 3, 4, 5, 6, 7)), kf1 = __builtin_bit_cast(v8i32, __builtin_shufflevector(k1l, k1h, 0, 1, 2, 3, 4, 5, 6, 7)); \
        f32x16 p0 = __builtin_amdgcn_mfma_scale_f32_32x32x64_f8f6f4(kf0, qf, zero16, 0, 0, 0, 0x7a7b, 1, 0x7a7b); \
        f32x16 p1 = __builtin_amdgcn_mfma_scale_f32_32x32x64_f8f6f4(kf1, qf, zero16, 0, 0, 0, 0x7a7b, 1, 0x7a7b); \
        ATT_SB(); \
        float sacc = 0.f; \
          \
        ATT_MM(0, 0, va, vb, PW); ATT_SB(); ATT_MM(0, 1, va, vb, PW); ATT_SB(); \
        ATT_MM(0, 2, va, vb, PW); ATT_EX(p0, 0, PWN[0], 0); ATT_SB();  ATT_MM(0, 3, va, vb, PW); ATT_EX(p0, 2, PWN[0], 1); ATT_SB(); \
        ATT_MM(1, 0, vb, va, PW); ATT_EX(p0, 4, PWN[0], 2); ATT_SB();  ATT_MM(1, 1, vb, va, PW); ATT_EX(p0, 6, PWN[0], 3); ATT_SB(); \
        ATT_MM(1, 2, vb, va, PW); ATT_EX(p0, 8, PWN[1], 0); ATT_SB();  ATT_MM(1, 3, vb, va, PW); ATT_EX(p0, 10, PWN[1], 1); ATT_SB(); \
        ATT_MM(2, 0, va, vb, PW); ATT_EX(p0, 12, PWN[1], 2); ATT_SB(); ATT_MM(2, 1, va, vb, PW); ATT_EX(p0, 14, PWN[1], 3); ATT_SB(); \
        ATT_MM(2, 2, va, vb, PW); ATT_EX(p1, 0, PWN[2], 0); ATT_SB();  ATT_MM(2, 3, va, vb, PW); ATT_EX(p1, 2, PWN[2], 1); ATT_SB(); \
        ATT_MM(3, 0, vb, va, PW); ATT_EX(p1, 4, PWN[2], 2); ATT_SB();  ATT_MM(3, 1, vb, va, PW); ATT_EX(p1, 6, PWN[2], 3); ATT_SB(); \
        ATT_MM(3, 2, vb, va, PW); ATT_EX(p1, 8, PWN[3], 0); ATT_EX(p1, 10, PWN[3], 1); ATT_SB(); \
        ATT_MM(3, 3, vb, va, PW); ATT_EX(p1, 12, PWN[3], 2); ATT_EX(p1, 14, PWN[3], 3); ATT_SB(); \
        l_reg += sacc; \
        } while (0)
    {
        if (NT > 2) { ATT_WAIT_BAR(6); } else { ATT_WAIT_BAR(3); }
        ATT_QKEXP(0);
        int sk = 0;
#pragma unroll 1
        for (int k = 0; k < NT - 2; k += 2) {
            ATT_WAIT_BAR(3);
            ATT_DMA_K(k + 3, (sk + 3) & 3); ATT_DMA_V(k + 3, (sk + 3) & 3);
            ATT_SB(); ATT_FUSED(sk, (sk + 1) & 3, pw, pwn); ATT_SB();
            ATT_WAIT_BAR(3);
            if (k + 4 < NT) { ATT_DMA_K(k + 4, sk); ATT_DMA_V(k + 4, sk); }
            ATT_SB(); ATT_FUSED((sk + 1) & 3, (sk + 2) & 3, pwn, pw); ATT_SB();
            sk = (sk + 2) & 3;
        }
        ATT_WAIT_BAR(0);
        if (cw == NT - 1) { ATT_SB(); ATT_FUSED(sk, (sk + 1) & 3, pw, pwn); ATT_SB(); ATT_PV((sk + 1) & 3, pwn); }
        else { ATT_SB(); ATT_PV(sk, pw); }
    }
#undef ATT_FUSED
#undef ATT_MM
#undef ATT_EX
#undef ATT_PIN
#undef ATT_QKEXP
#undef ATT_PV
#undef ATT_VRD
#undef ATT_VMM
#undef ATT_SB
#undef ATT_DMA_K
#undef ATT_DMA_V
    { auto rr = __builtin_amdgcn_permlane32_swap(__float_as_uint(l_reg), __float_as_uint(l_reg), false, false); l_reg = __uint_as_float(rr[0]) + __uint_as_float(rr[1]); }
    LAS float* wsf = (LAS float*)(shm + LDS_WS) + wid * 64;
    if (hi == 0) wsf[r32] = l_reg;
    ATT_WAIT_BAR(0);
    float rli[16];
    const float scl = m ? lam : 1.0f;
#pragma unroll
    for (int r = 0; r < 16; ++r) rli[r] = scl * __builtin_amdgcn_rcpf(wsf[crow(r, hi)]);
    LAS float* stg = (LAS float*)shm + qg * (32 * STG_ROW);
    if (m == 1) {
#pragma unroll
        for (int r = 0; r < 16; ++r)
#pragma unroll
            for (int d = 0; d < 4; ++d) stg[crow(r, hi) * STG_ROW + d * 32 + r32] = o[d][r] * rli[r];
    }
    ATT_WAIT_BAR(0);
    if (m == 0) {
#pragma unroll
        for (int r = 0; r < 16; ++r)
#pragma unroll
            for (int d = 0; d < 4; ++d) { LAS float* p = stg + crow(r, hi) * STG_ROW + d * 32 + r32; *p = o[d][r] * rli[r] - *p; }
    }
    ATT_WAIT_BAR(0);
    {
        const int row = 16 * m + (lane >> 2), qt = lane & 3;
        const LAS float* p = stg + row * STG_ROW + qt * 32;
        f32x4 v[8]; float ss = 0.f;
#pragma unroll
        for (int i = 0; i < 8; ++i) { v[i] = *(const LAS f32x4*)(p + 4 * i); ss += (v[i][0] * v[i][0] + v[i][1] * v[i][1]) + (v[i][2] * v[i][2] + v[i][3] * v[i][3]); }
        ss += __shfl_xor(ss, 1); ss += __shfl_xor(ss, 2);
        const float rn = rsqrtf(ss * (1.f / 128.f) + EPS) * oml;
        bf16_t* dst = MIX + (rowbase + q0 + qg * 32 + row) * D + DS + h * 128 + qt * 32;
#pragma unroll
        for (int i = 0; i < 4; ++i) {
            const f32x4 g0 = *(const f32x4*)(subg + qt * 32 + 8 * i), g1 = *(const f32x4*)(subg + qt * 32 + 8 * i + 4);
            const f32x4 a = v[2 * i] * g0 * rn, c = v[2 * i + 1] * g1 * rn;
            u32x4 w; w.x = cvt_pk_bf16(a[0], a[1]); w.y = cvt_pk_bf16(a[2], a[3]); w.z = cvt_pk_bf16(c[0], c[1]); w.w = cvt_pk_bf16(c[2], c[3]);
            *(u32x4*)(dst + 8 * i) = w;
        }
    }
    ATT_WAIT_BAR(0);
#undef ATT_DMA
}
}
template <int MODE> __device__ __forceinline__ void attn_phase(Frame& F, int l) {
    const bf16_t* Q = (const bf16_t*)(F.ws + WS_Q); const bf16_t* K = (const bf16_t*)(F.ws + WS_K); const bf16_t* V = (const bf16_t*)(F.ws + WS_V);
    bf16_t* MIX = (bf16_t*)(F.ws + WS_MIX);
    const float* sc = (const float*)(F.ws + WS_SCAL) + l * 4;
    const float lam = sc[0], mshift = sc[1], oml = sc[2];
    const float* subg = arg_in(19) + l * DV;
    const int G = F.G;
#ifndef ATT_XA
#define ATT_XA 1
#endif
    const bool xa = ATT_XA && (G & 7) == 0;
    const int x = F.bx & 7, j = F.bx >> 3, wpx = xa ? (G >> 3) : 1;
    const int npair = xa ? (32 - j + wpx - 1) / wpx : 0;
    const int nit = xa ? 4 * npair : (1024 - F.bx + G - 1) / G;
#pragma unroll 1
    for (int it = 0; it < nit; ++it) {
        int bh, qb;
        if (xa) { const int r = it / (2 * npair), rem = it % (2 * npair), sidx = j + (rem >> 1) * wpx; bh = 2 * x + r; qb = (rem & 1) ? sidx : 63 - sidx; }
        else { const int v = F.bx + it * G; bh = v >> 6; qb = v & 63; }
        att::attn_unit<MODE>(bh, qb, Q, K, V, MIX, subg, lam, mshift, oml, F.lds + LDS_RING, F.tid);
    }
}

__device__ __forceinline__ void router_phase(Frame& F, int l) {
    const bf16_t* h1 = (const bf16_t*)(F.ws + WS_H1); const float* g = arg_in(21) + (size_t)l * D; const float* br = arg_in(23) + l * NE;
    const bf16_t* WRT = (const bf16_t*)(F.ws + WS_WRT + l * WRT_STRIDE);
    bf16_t* XN = (bf16_t*)(F.ws + WS_XN); int* TOPI = (int*)(F.ws + WS_TOPI); float* TOPG = (float*)(F.ws + WS_TOPG); int* WGCNT = (int*)(F.ws + WS_WGCNT); float* RS = (float*)(F.ws + WS_RS);
    const int lane = F.lane, tid = F.tid, wave = F.wave, n = lane & 15, kq = lane >> 4;
    constexpr int PITCH = 2080;
    LAS unsigned char* wl = F.lds + LDS_RING;
    LAS float* lg = (LAS float*)(F.lds + LDS_RING + 2 * 32 * PITCH) + wave * (16 * 33 + 16);
    LAS int* cnt = (LAS int*)(F.ctl + 256);
    __syncthreads();
    for (int i = tid; i < 2 * NE * 128; i += NTHREADS) { const int row = i >> 7, c = i & 127; *(LAS u32x4*)(wl + row * PITCH + c * 16) = *(const u32x4*)(WRT + (size_t)row * D + c * 8); }
    if (tid < 32) cnt[tid] = 0;
    __syncthreads();
    for (int wgu = F.bx; wgu < T / 128; wgu += F.G) {
        if (wgu != F.bx) { __syncthreads(); if (tid < 32) cnt[tid] = 0; __syncthreads(); }
        const int row = wgu * 128 + wave * 16 + n;
        const bf16_t* hp = h1 + (size_t)row * D + 8 * kq; const float* gp = g + 8 * kq;
        bf16_t* xp = XN + (size_t)row * D + 8 * kq; unsigned char* xp8 = (unsigned char*)XN + (size_t)row * D + 8 * kq;
        const LAS unsigned char* bh = wl + n * PITCH + 16 * kq;
        f32x4 acc0 = (f32x4){0.f, 0.f, 0.f, 0.f}, acc1 = acc0; float ss = 0.f;
#pragma unroll 4
        for (int ks = 0; ks < 32; ++ks) {
            const u32x4 hw = *(const u32x4*)(hp + 32 * ks); const f32x4 h0 = (f32x4){bf_lo(hw.x), bf_hi(hw.x), bf_lo(hw.y), bf_hi(hw.y)}, h4 = (f32x4){bf_lo(hw.z), bf_hi(hw.z), bf_lo(hw.w), bf_hi(hw.w)};
            const f32x4 g0 = *(const f32x4*)(gp + 32 * ks), g4 = *(const f32x4*)(gp + 32 * ks + 4);
            const f32x4 x0 = h0 * g0, x4 = h4 * g4;
            ss += (x0[0] * x0[0] + x0[1] * x0[1]) + (x0[2] * x0[2] + x0[3] * x0[3]) + (x4[0] * x4[0] + x4[1] * x4[1]) + (x4[2] * x4[2] + x4[3] * x4[3]);
            u32x4 hi; hi.x = cvt_pk_bf16(x0[0], x0[1]); hi.y = cvt_pk_bf16(x0[2], x0[3]); hi.z = cvt_pk_bf16(x4[0], x4[1]); hi.w = cvt_pk_bf16(x4[2], x4[3]);
            if (UP_FP8) { u32x2 w8; w8.x = pk4_fp8(x0[0] * 8.f, x0[1] * 8.f, x0[2] * 8.f, x0[3] * 8.f); w8.y = pk4_fp8(x4[0] * 8.f, x4[1] * 8.f, x4[2] * 8.f, x4[3] * 8.f); *(u32x2*)(xp8 + 32 * ks) = w8; }
            else *(u32x4*)(xp + 32 * ks) = hi;
            u32x4 lo;
            lo.x = cvt_pk_bf16(x0[0] - bf_lo(hi.x), x0[1] - bf_hi(hi.x)); lo.y = cvt_pk_bf16(x0[2] - bf_lo(hi.y), x0[3] - bf_hi(hi.y));
            lo.z = cvt_pk_bf16(x4[0] - bf_lo(hi.z), x4[1] - bf_hi(hi.z)); lo.w = cvt_pk_bf16(x4[2] - bf_lo(hi.w), x4[3] - bf_hi(hi.w));
            const bf16x8 ah = __builtin_bit_cast(bf16x8, hi), al = __builtin_bit_cast(bf16x8, lo);
            const bf16x8 b0h = *(const LAS bf16x8*)(bh + 64 * ks), b1h = *(const LAS bf16x8*)(bh + 16 * PITCH + 64 * ks);
            const bf16x8 b0l = *(const LAS bf16x8*)(bh + 32 * PITCH + 64 * ks), b1l = *(const LAS bf16x8*)(bh + 48 * PITCH + 64 * ks);
            acc0 = __builtin_amdgcn_mfma_f32_16x16x32_bf16(ah, b0h, acc0, 0, 0, 0); acc1 = __builtin_amdgcn_mfma_f32_16x16x32_bf16(ah, b1h, acc1, 0, 0, 0);
            acc0 = __builtin_amdgcn_mfma_f32_16x16x32_bf16(al, b0h, acc0, 0, 0, 0); acc1 = __builtin_amdgcn_mfma_f32_16x16x32_bf16(al, b1h, acc1, 0, 0, 0);
            acc0 = __builtin_amdgcn_mfma_f32_16x16x32_bf16(ah, b0l, acc0, 0, 0, 0); acc1 = __builtin_amdgcn_mfma_f32_16x16x32_bf16(ah, b1l, acc1, 0, 0, 0);
        }
        ss += __shfl_xor(ss, 16); ss += __shfl_xor(ss, 32);
        const float r = rsqrtf(ss * (1.f / D) + EPS);
        if (kq == 0) { lg[16 * 33 + n] = r; RS[row] = r; }
        asm volatile("s_waitcnt lgkmcnt(0)" ::: "memory");
        const float b0 = br[n], b1 = br[16 + n];
#pragma unroll
        for (int q = 0; q < 4; ++q) { const float rt = lg[16 * 33 + 4 * kq + q]; lg[(4 * kq + q) * 33 + n] = acc0[q] * rt + b0; lg[(4 * kq + q) * 33 + 16 + n] = acc1[q] * rt + b1; }
        asm volatile("s_waitcnt lgkmcnt(0)" ::: "memory");
        if (lane < 16) {
            const int tok = wgu * 128 + wave * 16 + lane;
            float v[32];
#pragma unroll
            for (int e = 0; e < 32; ++e) v[e] = lg[lane * 33 + e];
            unsigned mask = 0u; float val[4]; int sel[4];
#pragma unroll
            for (int k = 0; k < 4; ++k) { float best = -INFINITY; int bi = 0;
#pragma unroll
                for (int e = 0; e < 32; ++e) { const bool ok = !((mask >> e) & 1u) && (v[e] > best); best = ok ? v[e] : best; bi = ok ? e : bi; }
                mask |= 1u << bi; val[k] = best; sel[k] = bi; }
            float ex[4], sum = 0.f;
#pragma unroll
            for (int k = 0; k < 4; ++k) { ex[k] = __expf(val[k] - val[0]); sum += ex[k]; }
            const float inv = 1.f / sum;
#pragma unroll
            for (int k = 0; k < 4; ++k) { const int pos = __hip_atomic_fetch_add(cnt + sel[k], 1, __ATOMIC_RELAXED, __HIP_MEMORY_SCOPE_WORKGROUP);
                TOPI[tok * 4 + k] = sel[k] | (pos << 8); TOPG[tok * 4 + k] = ex[k] * inv; }
        }
        __syncthreads();
        if (tid < 32) WGCNT[wgu * 32 + tid] = cnt[tid];
    }
    __syncthreads();
}
__device__ __forceinline__ void routing_phase(Frame& F) {
    const int* TOPI = (const int*)(F.ws + WS_TOPI); const float* TOPG = (const float*)(F.ws + WS_TOPG); const int* WGCNT = (const int*)(F.ws + WS_WGCNT);
    int* TOKROW = (int*)(F.ws + WS_TOKROW); int* ROWTOK = (int*)(F.ws + WS_ROWTOK); float* ROWGATE = (float*)(F.ws + WS_ROWGATE); int* TILEEXP = (int*)(F.ws + WS_TILEEXP);
    float* ROWSCALE = (float*)(F.ws + WS_ROWSCALE); const float* RS = (const float*)(F.ws + WS_RS);
    const int tid = F.tid;
    LAS int* tot = (LAS int*)(F.lds + LDS_RING);
    LAS int* pst = tot + 32;
    LAS int* mypre = pst + 40;
    LAS int* part = mypre + 32;
    for (int wgu = F.bx; wgu < 256; wgu += F.G) {
        __syncthreads();
        {
            const int e = tid & 31, wq = tid >> 5; int a = 0, mine = 0;
#pragma unroll
            for (int j = 0; j < 16; ++j) { const int w = wq * 16 + j; const int c = WGCNT[w * 32 + e]; a += c; if (w < wgu) mine += c; }
            part[wq * 32 + e] = a; part[512 + wq * 32 + e] = mine;
        }
        __syncthreads();
        if (tid < 32) { int a = 0, mine = 0;
#pragma unroll
            for (int q = 0; q < 16; ++q) { a += part[q * 32 + tid]; mine += part[512 + q * 32 + tid]; }
            tot[tid] = a; mypre[tid] = mine; }
        __syncthreads();
        if (tid == 0) { int a = 0; for (int e = 0; e < 32; ++e) { pst[e] = a; a += (tot[e] + 255) & ~255; } pst[32] = a; }
        __syncthreads();
        {
            const int t = wgu * 128 + (tid >> 2), k = tid & 3;
            const int w = TOPI[t * 4 + k]; const int e = w & 255, pos = w >> 8;
            const int dest = pst[e] + mypre[e] + pos;
            ROWTOK[dest] = t; ROWGATE[dest] = TOPG[t * 4 + k]; ROWSCALE[dest] = RS[t]; TOKROW[t * 4 + k] = dest;
        }
        if (wgu < 32) {
            const int e = wgu; const int beg = pst[e] + tot[e], end = pst[e + 1];
            for (int r = beg + tid; r < end; r += NTHREADS) { ROWTOK[r] = 0; ROWGATE[r] = 0.f; ROWSCALE[r] = 0.f; }
        }
        if (wgu == 0) {
            const int ntiles = pst[32] >> 8;
            for (int pm = tid; pm < ntiles; pm += NTHREADS) { int e = 0; for (int q = 1; q < 32; ++q) if ((pm << 8) >= pst[q]) e = q; TILEEXP[pm] = e; }
            if (tid == 0) TILEEXP[1023] = ntiles;
            if (tid < 33) TILEEXP[768 + tid] = pst[tid];
        }
    }
    __syncthreads();
}
struct CRow { u32x4 h[2]; u32x2 y[4][2]; };
__device__ __forceinline__ void crow_load(CRow& r, const bf16_t* H1, const unsigned char* YB, const int* TOKROW, int m, int lane) {
    const bf16_t* hr = H1 + (size_t)m * D + 8 * lane;
    r.h[0] = *(const u32x4*)(hr); r.h[1] = *(const u32x4*)(hr + 512);
    const int4 tr = *(const int4*)(TOKROW + m * 4);
    const int rows[4] = {tr.x, tr.y, tr.z, tr.w};
#pragma unroll
    for (int k = 0; k < 4; ++k) { const unsigned char* yr = YB + (size_t)rows[k] * D + 8 * lane; r.y[k][0] = *(const u32x2*)(yr); r.y[k][1] = *(const u32x2*)(yr + 512); }
}
__device__ __forceinline__ void crow_finish(CRow& r, float* out32, bf16_t* H2, bf16_t* XN, const float* gnext, int m, int lane) {
    f32x4 v[4];
#pragma unroll
    for (int hf = 0; hf < 2; ++hf) { const u32x4 w = r.h[hf]; v[2 * hf] = (f32x4){bf_lo(w.x), bf_hi(w.x), bf_lo(w.y), bf_hi(w.y)}; v[2 * hf + 1] = (f32x4){bf_lo(w.z), bf_hi(w.z), bf_lo(w.w), bf_hi(w.w)}; }
#pragma unroll
    for (int k = 0; k < 4; ++k)
#pragma unroll
        for (int hf = 0; hf < 2; ++hf) { fp8x4_add(r.y[k][hf].x, 1.f / 16.f, v[2 * hf]); fp8x4_add(r.y[k][hf].y, 1.f / 16.f, v[2 * hf + 1]); }
    if (out32) { float* orow = out32 + (size_t)m * D + 8 * lane; *(f32x4*)(orow) = v[0]; *(f32x4*)(orow + 4) = v[1]; *(f32x4*)(orow + 512) = v[2]; *(f32x4*)(orow + 516) = v[3]; }
    else {
        u32x4 w; w.x = cvt_pk_bf16(v[0][0], v[0][1]); w.y = cvt_pk_bf16(v[0][2], v[0][3]); w.z = cvt_pk_bf16(v[1][0], v[1][1]); w.w = cvt_pk_bf16(v[1][2], v[1][3]);
        *(u32x4*)(H2 + (size_t)m * D + 8 * lane) = w;
        w.x = cvt_pk_bf16(v[2][0], v[2][1]); w.y = cvt_pk_bf16(v[2][2], v[2][3]); w.z = cvt_pk_bf16(v[3][0], v[3][1]); w.w = cvt_pk_bf16(v[3][2], v[3][3]);
        *(u32x4*)(H2 + (size_t)m * D + 512 + 8 * lane) = w;
    }
    if (gnext) {
        float s = 0.f;
#pragma unroll
        for (int j = 0; j < 4; ++j) s += (v[j][0] * v[j][0] + v[j][1] * v[j][1]) + (v[j][2] * v[j][2] + v[j][3] * v[j][3]);
        const float rr = rsqrtf(wave_sum(s) * (1.f / D) + EPS);
        const float* gp = gnext + 8 * lane;
        const f32x4 a0 = v[0] * *(const f32x4*)(gp) * rr, a1 = v[1] * *(const f32x4*)(gp + 4) * rr, a2 = v[2] * *(const f32x4*)(gp + 512) * rr, a3 = v[3] * *(const f32x4*)(gp + 516) * rr;
        if (IN_FP8) { unsigned char* x8 = (unsigned char*)XN + (size_t)m * D + 8 * lane;
            u32x2 w8; w8.x = pk4_fp8(a0[0] * 16.f, a0[1] * 16.f, a0[2] * 16.f, a0[3] * 16.f); w8.y = pk4_fp8(a1[0] * 16.f, a1[1] * 16.f, a1[2] * 16.f, a1[3] * 16.f); *(u32x2*)(x8) = w8;
            w8.x = pk4_fp8(a2[0] * 16.f, a2[1] * 16.f, a2[2] * 16.f, a2[3] * 16.f); w8.y = pk4_fp8(a3[0] * 16.f, a3[1] * 16.f, a3[2] * 16.f, a3[3] * 16.f); *(u32x2*)(x8 + 512) = w8; }
        else {
        u32x4 w; w.x = cvt_pk_bf16(a0[0], a0[1]); w.y = cvt_pk_bf16(a0[2], a0[3]); w.z = cvt_pk_bf16(a1[0], a1[1]); w.w = cvt_pk_bf16(a1[2], a1[3]);
        *(u32x4*)(XN + (size_t)m * D + 8 * lane) = w;
        w.x = cvt_pk_bf16(a2[0], a2[1]); w.y = cvt_pk_bf16(a2[2], a2[3]); w.z = cvt_pk_bf16(a3[0], a3[1]); w.w = cvt_pk_bf16(a3[2], a3[3]);
        *(u32x4*)(XN + (size_t)m * D + 512 + 8 * lane) = w; }
    }
}
__device__ __forceinline__ void combine_phase(Frame& F, const float* gnext, float* out32) {
    const unsigned char* YB = (const unsigned char*)(F.ws + WS_YB); const int* TOKROW = (const int*)(F.ws + WS_TOKROW); bf16_t* XN = (bf16_t*)(F.ws + WS_XN);
    const bf16_t* H1 = (const bf16_t*)(F.ws + WS_H1); bf16_t* H2 = (bf16_t*)(F.ws + WS_H2);
    const int lane = F.lane, NGW = F.G * NWAVES;
    CRow ra, rb;
    int m = F.bx * NWAVES + F.wave;
    if (m < T) crow_load(ra, H1, YB, TOKROW, m, lane);
    while (m < T) {
        const int mb = m + NGW;
        if (mb < T) crow_load(rb, H1, YB, TOKROW, mb, lane);
        crow_finish(ra, out32, H2, XN, gnext, m, lane);
        if (mb >= T) break;
        const int mc = mb + NGW;
        if (mc < T) crow_load(ra, H1, YB, TOKROW, mc, lane);
        crow_finish(rb, out32, H2, XN, gnext, mb, lane);
        m = mc;
    }
}

constexpr int NPH_LAYER = 10, NPH = 1 + DEPTH * NPH_LAYER;
__global__ void __launch_bounds__(NTHREADS, 2) mk_fwd(Args args) {
    extern __shared__ __attribute__((aligned(16))) unsigned char lds_raw[];
    Frame F;
    F.lds = (LAS unsigned char*)lds_raw; F.ctl = F.lds + LDS_CTL; F.ws = args.ws; F.ws0 = args.ws; F.out0 = args.out; F.ap = &args; F.z = 0;
    F.tid = threadIdx.x; F.lane = F.tid & 63; F.wave = __builtin_amdgcn_readfirstlane(F.tid >> 6); F.G = gridDim.x; F.bx = blockIdx.x;
    F.out = args.out;
    for (int u = F.tid; u < 1024; u += NTHREADS) ((LAS unsigned*)F.ctl)[u] = 0u;
    __syncthreads();
    XcdBarrier bar = xcd_barrier_post((unsigned*)(F.ws + WS_CTL) + CW_BAR, (volatile LAS unsigned*)F.ctl);
    const int lo = args.ph_lo, hi = args.ph_hi;
#ifndef PHMASK
#define PHMASK 0x1fff
#endif
#define RUN(k) (lo <= (k) && (k) < hi)
#define EN(b) ((PHMASK >> (b)) & 1)
#ifndef DUPMASK
#define DUPMASK 0
#endif
#ifndef ATT_PROBE_MODE
#define ATT_PROBE_MODE 0
#endif
#ifndef PRO_PROBE_MODE
#define PRO_PROBE_MODE 0
#endif
#define NREP(b) (((DUPMASK >> (b)) & 1) ? 2 : 1)
#define SEAM(k) do { if (RUN((k) + 1)) xcd_barrier(bar); } while (0)
    if (EN(10) && RUN(0)) { { if (NREP(10) == 2) { phase_begin(F); p0_prologue<PRO_PROBE_MODE>(F); xcd_barrier(bar); } phase_begin(F); p0_prologue<0>(F); } SEAM(0); }
    for (int l = 0; l < DEPTH; ++l) {
        const int pb = 1 + l * NPH_LAYER;
#ifdef EXTRA_BARRIERS
        for (int eb = 0; eb < EXTRA_BARRIERS; ++eb) xcd_barrier(bar);
#endif
        if (EN(0) && RUN(pb + 0)) { for (int rep = 0; rep < NREP(0); ++rep) { phase_begin(F); unsigned char* ws = F.ws; (void)ws;
            PInProj P; P.so.init(T, DIN, F.G, F.bx); P.A = (const char*)(ws + WS_XN); P.B = (const char*)(ws + WS_WIN + l * WIN_STRIDE);
            P.UQKV = (bf16_t*)(ws + WS_U); P.GQK = (const float*)(ws + WS_SCAL) + 64 + l * 128; P.COS = (const float*)(ws + WS_COS); P.SIN = (const float*)(ws + WS_SIN);
            pg8::gemm_phase(F.lds + LDS_RING, F.ctl, P, F.tid);  if (rep + 1 < NREP(0)) xcd_barrier(bar); } SEAM(pb + 0);
        }
        if (EN(1) && RUN(pb + 1)) { for (int rep = 0; rep < NREP(1); ++rep) { phase_begin(F); unsigned char* ws = F.ws; (void)ws; s5a_phase(F, l);  if (rep + 1 < NREP(1)) xcd_barrier(bar); } SEAM(pb + 1); }
        if (EN(2) && RUN(pb + 2)) { for (int rep = 0; rep < NREP(2); ++rep) { phase_begin(F); unsigned char* ws = F.ws; (void)ws; if (EN(11)) for (int r2 = 0; r2 < NREP(11); ++r2) { phase_begin(F); s5c_phase(F, l); } if (EN(12)) { if (NREP(12) == 2) { phase_begin(F); attn_phase<ATT_PROBE_MODE>(F, l); } phase_begin(F); attn_phase<0>(F, l); }  if (rep + 1 < NREP(2)) xcd_barrier(bar); } SEAM(pb + 2); }
        if (EN(3) && RUN(pb + 3)) { for (int rep = 0; rep < NREP(3); ++rep) { phase_begin(F); unsigned char* ws = F.ws; (void)ws;
            PGlu P; P.so.init(T, DS, F.G, F.bx); P.A = (const char*)(ws + WS_YG); P.B = (const char*)(ws + WS_WGLU + l * WGLU_STRIDE);
            P.YG = (const bf16_t*)(ws + WS_YG); P.MIX = (bf16_t*)(ws + WS_MIX); P.RSP = (float*)(ws + WS_RSP);
            pg8::gemm_phase(F.lds + LDS_RING, F.ctl, P, F.tid);  if (rep + 1 < NREP(3)) xcd_barrier(bar); } SEAM(pb + 3);
        }
        if (EN(4) && RUN(pb + 4)) { for (int rep = 0; rep < NREP(4); ++rep) { phase_begin(F); unsigned char* ws = F.ws; (void)ws;
            POut P; P.so.init(T, D, F.G, F.bx); P.A = (const char*)(ws + WS_MIX); P.B = (const char*)(ws + WS_WOUT + l * WOUT_STRIDE);
            P.RSP = (const float*)(ws + WS_RSP); P.base32 = (l == 0) ? arg_in(0) : nullptr; P.base16 = (const bf16_t*)(ws + WS_H2); P.H1 = (bf16_t*)(ws + WS_H1);
            pg8::gemm_phase(F.lds + LDS_RING, F.ctl, P, F.tid);  if (rep + 1 < NREP(4)) xcd_barrier(bar); } SEAM(pb + 4);
        }
        if (EN(5) && RUN(pb + 5)) { for (int rep = 0; rep < NREP(5); ++rep) { phase_begin(F); unsigned char* ws = F.ws; (void)ws; router_phase(F, l);  if (rep + 1 < NREP(5)) xcd_barrier(bar); } SEAM(pb + 5); }
        if (EN(6) && RUN(pb + 6)) { for (int rep = 0; rep < NREP(6); ++rep) { phase_begin(F); unsigned char* ws = F.ws; (void)ws; routing_phase(F);  if (rep + 1 < NREP(6)) xcd_barrier(bar); } SEAM(pb + 6); }
        if (EN(7) && RUN(pb + 7)) { for (int rep = 0; rep < NREP(7); ++rep) { phase_begin(F); unsigned char* ws = F.ws; (void)ws;
            PUp P; P.mo.init(F.G, F.bx, (const int*)(ws + WS_TILEEXP) + 768);
            P.A = (const char*)(ws + WS_XN); P.B = (const char*)(ws + WS_WUP + l * WUP_STRIDE); P.ROWTOK = (const int*)(ws + WS_ROWTOK); P.TILEEXP = (const int*)(ws + WS_TILEEXP);
            P.bup = arg_in(25) + (size_t)l * NE * 2048; P.ROWSCALE = (const float*)(ws + WS_ROWSCALE); P.ACT = (bf16_t*)(ws + WS_ACT);
            if (GEMM_PROBE && rep + 1 < NREP(7)) { PUpNoDma Q; (PUp&)Q = P; pg8::gemm_phase(F.lds + LDS_RING, F.ctl, Q, F.tid); } else pg8::gemm_phase(F.lds + LDS_RING, F.ctl, P, F.tid);  if (rep + 1 < NREP(7)) xcd_barrier(bar); } SEAM(pb + 7);
        }
        if (EN(8) && RUN(pb + 8)) { for (int rep = 0; rep < NREP(8); ++rep) { phase_begin(F); unsigned char* ws = F.ws; (void)ws;
            PDown P; P.mo.init(F.G, F.bx, (const int*)(ws + WS_TILEEXP) + 768);
            P.A = (const char*)(ws + WS_ACT); P.B = (const char*)(ws + WS_WDN + l * WDN_STRIDE); P.TILEEXP = (const int*)(ws + WS_TILEEXP);
            P.bdn = arg_in(27) + (size_t)l * NE * 1024; P.ROWGATE = (const float*)(ws + WS_ROWGATE); P.YB = (bf16_t*)(ws + WS_YB);
            pg8::gemm_phase(F.lds + LDS_RING, F.ctl, P, F.tid);  if (rep + 1 < NREP(8)) xcd_barrier(bar); } SEAM(pb + 8);
        }
        if (EN(9) && RUN(pb + 9)) { for (int rep = 0; rep < NREP(9); ++rep) { phase_begin(F); unsigned char* ws = F.ws; (void)ws; combine_phase(F, (l + 1 < DEPTH) ? arg_in(1) + (size_t)(l + 1) * D : nullptr, (l + 1 < DEPTH) ? nullptr : F.out);  if (rep + 1 < NREP(9)) xcd_barrier(bar); } SEAM(pb + 9); }
    }
#undef RUN
#undef SEAM
}

extern "C" void kernel_launch(void* const* d_in, const int* in_sizes, int n_in, void* d_out, int out_size, void* d_ws, size_t ws_size, hipStream_t stream) {
    static int grid = 0;
    if (grid == 0) {
        if (n_in != 28 || out_size != T * D || ws_size < WS_END) { fprintf(stderr, "kernel_launch: unexpected shapes (n_in %d out %d ws %zu)\n", n_in, out_size, ws_size); grid = -1; return; }
        int dev = 0, cus = 0;
        if (hipGetDevice(&dev) != hipSuccess || hipDeviceGetAttribute(&cus, hipDeviceAttributeMultiprocessorCount, dev) != hipSuccess) { grid = -1; return; }
        if (hipFuncSetAttribute((const void*)mk_fwd, hipFuncAttributeMaxDynamicSharedMemorySize, LDS_BYTES) != hipSuccess) { fprintf(stderr, "kernel_launch: hipFuncSetAttribute failed\n"); grid = -1; return; }
        int per_cu = 0;
        if (hipOccupancyMaxActiveBlocksPerMultiprocessor(&per_cu, (const void*)mk_fwd, NTHREADS, LDS_BYTES) != hipSuccess || per_cu < 1) { fprintf(stderr, "kernel_launch: occupancy query says %d\n", per_cu); }
        (void)hipGetLastError();
        grid = cus;
    }
    if (grid < 0) return;
    if (hipMemsetAsync((char*)d_ws + WS_CTL, 0, CTL_ZERO_BYTES, stream) != hipSuccess) return;
    Args a{};
    for (int i = 0; i < 28; ++i) a.in[i] = (const float*)d_in[i];
    a.out = (float*)d_out; a.ws = (unsigned char*)d_ws; a.ph_lo = 0; a.ph_hi = NPH;
    hipLaunchKernelGGL(mk_fwd, dim3(grid), dim3(NTHREADS), LDS_BYTES, stream, a);
}
```

```cpp
#include <hip/hip_runtime.h>
#include <cstdio>
#include <cstdint>
#include <math.h>

#ifndef GEMM_PROBE
#define GEMM_PROBE 0
#endif
#ifndef GEMM_PROBE_KIND
#define GEMM_PROBE_KIND 1
#endif
#ifndef IN_FP8
#define IN_FP8 0
#endif
#ifndef MOE_BNT
#define MOE_BNT 0
#endif
#ifndef UP_FP8
#define UP_FP8 1
#endif
#ifndef DN_FP8
#define DN_FP8 1
#endif
#define LAS __attribute__((address_space(3)))
#define GAS __attribute__((address_space(1)))
typedef unsigned short bf16_t;
typedef short bf16x8 __attribute__((ext_vector_type(8)));
typedef short s16x4 __attribute__((ext_vector_type(4)));
typedef float f32x4 __attribute__((ext_vector_type(4)));
typedef float f32x2 __attribute__((ext_vector_type(2)));
typedef float f32x16 __attribute__((ext_vector_type(16)));
typedef unsigned u32x4 __attribute__((ext_vector_type(4)));
typedef unsigned u32x2 __attribute__((ext_vector_type(2)));
typedef int v8i32 __attribute__((ext_vector_type(8)));

constexpr int D = 1024, BATCH = 4, SEQ = 8192, DEPTH = 2, T = BATCH * SEQ;
constexpr int DS = 512, NG = 32, HS = 16, NP = 64, DA = 512, NH = 4, DV = 128, DIN = 2048;
constexpr int NE = 32, DFF = 1024, NASSIGN = T * 4;
constexpr int MPAD_MAX = NASSIGN + NE * 256, NTILE_MAX = MPAD_MAX / 256;
constexpr int NCHUNK = T / 64, CPB = SEQ / 64;
constexpr float EPS = 1e-6f;
constexpr float C2 = 0.125f * 1.4426950408889634f;
constexpr int NWAVES = 8, NTHREADS = 512;

constexpr size_t MiB = 1u << 20;
constexpr size_t WS_CTL = 0, CTL_ZERO_BYTES = 1 * MiB;
constexpr size_t WS_COS = 1 * MiB, WS_SIN = 2 * MiB;
constexpr size_t WS_SCAL = 3 * MiB;
constexpr size_t WS_KT = 4 * MiB, KT_STRIDE = 2 * MiB;
constexpr size_t WS_LAML = 8 * MiB, LAML_STRIDE = 32768;
constexpr size_t WS_WRT = 9 * MiB, WRT_STRIDE = 131072;
constexpr size_t WS_RS = 10 * MiB;
constexpr size_t WS_GT = 16 * MiB, GT_STRIDE = 8 * MiB;
constexpr size_t WS_HT = 32 * MiB, HT_STRIDE = 8 * MiB;
constexpr size_t WS_WIN = 48 * MiB, WIN_STRIDE = 4 * MiB;
constexpr size_t WS_WGLU = 56 * MiB, WGLU_STRIDE = MiB / 2;
constexpr size_t WS_WOUT = 58 * MiB, WOUT_STRIDE = 2 * MiB;
constexpr size_t WS_WUP = 64 * MiB, WUP_STRIDE = 128 * MiB;
constexpr size_t WS_WDN = 320 * MiB, WDN_STRIDE = 64 * MiB;
constexpr size_t WS_XN = 448 * MiB;
constexpr size_t WS_U = 512 * MiB, WS_Q = 544 * MiB, WS_K = 576 * MiB, WS_V = 608 * MiB;
constexpr size_t WS_YG = 640 * MiB;
constexpr size_t WS_MIX = 672 * MiB;
constexpr size_t WS_S = 736 * MiB;
constexpr size_t WS_RSP = 744 * MiB;
constexpr size_t WS_TOPI = 746 * MiB, WS_TOPG = 747 * MiB, WS_TOKROW = 748 * MiB, WS_WGCNT = 749 * MiB;
constexpr size_t WS_ROWTOK = 750 * MiB, WS_ROWGATE = 751 * MiB, WS_TILEEXP = 752 * MiB, WS_ROWSCALE = 753 * MiB;
constexpr size_t WS_ACT = 768 * MiB, WS_YB = 1040 * MiB, WS_H1 = 1180 * MiB, WS_H2 = 1244 * MiB, WS_END = 1312 * MiB;
constexpr int CW_BAR = 4096;

constexpr int LDS_CTL = 0;
constexpr int LDS_RING = 4096;
constexpr int LDS_BYTES = 163840;

__device__ __forceinline__ unsigned f2bf(float f) { unsigned u = __builtin_bit_cast(unsigned, f); return (u + 0x7fffu + ((u >> 16) & 1u)) >> 16; }
__device__ __forceinline__ unsigned pk2(float lo, float hi) { return f2bf(lo) | (f2bf(hi) << 16); }
__device__ __forceinline__ unsigned cvt_pk_bf16(float lo, float hi) { unsigned r; asm volatile("v_cvt_pk_bf16_f32 %0, %1, %2" : "=v"(r) : "v"(lo), "v"(hi)); return r; }
__device__ __forceinline__ unsigned pk4_fp8(float a, float b, float c, float d) { int w = 0; w = __builtin_amdgcn_cvt_pk_fp8_f32(a, b, w, false); w = __builtin_amdgcn_cvt_pk_fp8_f32(c, d, w, true); return (unsigned)w; }
__device__ __forceinline__ void fp8x4_add(unsigned w, float sc, f32x4& a) { const f32x2 lo = __builtin_amdgcn_cvt_pk_f32_fp8((int)w, false), hi = __builtin_amdgcn_cvt_pk_f32_fp8((int)w, true); a[0] += lo[0] * sc; a[1] += lo[1] * sc; a[2] += hi[0] * sc; a[3] += hi[1] * sc; }
__device__ __forceinline__ float bf_lo(unsigned w) { return __builtin_bit_cast(float, w << 16); }
__device__ __forceinline__ float bf_hi(unsigned w) { return __builtin_bit_cast(float, w & 0xffff0000u); }
__device__ __forceinline__ float wave_sum(float v) {
#pragma unroll
    for (int o = 1; o < 64; o <<= 1) v += __shfl_xor(v, o);
    return v;
}
__device__ __forceinline__ float gelu_tanh(float x) {
    const float z = 0.7978845608028654f * (x + 0.044715f * x * x * x);
    return x * __builtin_amdgcn_rcpf(1.f + __builtin_amdgcn_exp2f(-2.885390082f * z));
}
__device__ __forceinline__ float sigmoidf(float v) { return __builtin_amdgcn_rcpf(1.f + __builtin_amdgcn_exp2f(-1.4426950409f * v)); }

#define XB_TMO      128
#define XB_XCNT(j)  (256  + 64 * (j))
#define XB_XSUB(j)  (1280 + 64 * (j))
#define XB_XGEN(j)  (2304 + 64 * (j))
#define XB_TOP      3328
#define XB_TOPGEN   3392
#define XCD_BAR_WORDS 3456
#define XB_SPIN_CAP (1u << 18)
__device__ __forceinline__ unsigned xb_ld(unsigned* p)              { return __hip_atomic_load(p, __ATOMIC_RELAXED, __HIP_MEMORY_SCOPE_AGENT); }
__device__ __forceinline__ unsigned xb_add(unsigned* p, unsigned v) { return __hip_atomic_fetch_add(p, v, __ATOMIC_RELAXED, __HIP_MEMORY_SCOPE_AGENT); }
__device__ __forceinline__ unsigned xb_xcc_id() { return (unsigned)__builtin_amdgcn_s_getreg((3 << 11) | 20) & 0xFu; }
#define XB_SPIN(cond, bar) do { unsigned _sp = 0; while (cond) { __builtin_amdgcn_s_sleep(1); \
    if ((++_sp & 255u) == 0u) { if (xb_ld(&(bar)[XB_TMO])) break; if (_sp > XB_SPIN_CAP) { atomicAdd(&(bar)[XB_TMO], 1u); break; } } } } while (0)
struct XcdBarrier { unsigned* bar; unsigned x; volatile LAS unsigned* st; };
__device__ __forceinline__ XcdBarrier xcd_barrier_post(unsigned* bar, volatile LAS unsigned* st) {
    XcdBarrier b; b.bar = bar; b.x = xb_xcc_id(); b.st = st;
    if (threadIdx.x == 0) (void)xb_add(&bar[XB_XCNT(b.x)], 1u);
    return b;
}
__device__ __forceinline__ void xcd_barrier_complete(unsigned* bar, unsigned x, unsigned& nloc, unsigned& nx) {
    const unsigned G = gridDim.x * gridDim.y * gridDim.z;
    unsigned sum, cnt, mine, sp = 0u;
    for (;;) {
        sum = 0u; cnt = 0u; mine = 0u;
#pragma unroll
        for (unsigned j = 0; j < 16; ++j) { const unsigned c = xb_ld(&bar[XB_XCNT(j)]); sum += c; cnt += (c > 0u) ? 1u : 0u; mine = (j == x) ? c : mine; }
        if (sum == G) break;
        __builtin_amdgcn_s_sleep(1);
        if ((++sp & 255u) == 0u) { if (xb_ld(&bar[XB_TMO])) break; if (sp > XB_SPIN_CAP) { atomicAdd(&bar[XB_TMO], 1u); break; } }
    }
    nloc = mine > 0u ? mine : 1u; nx = cnt > 0u ? cnt : 1u;
}
__device__ __forceinline__ void xcd_barrier(const XcdBarrier& b) {
    asm volatile("s_waitcnt vmcnt(0)" ::: "memory");
    __syncthreads();
    if (threadIdx.x == 0) {
        unsigned* bar = b.bar;
        __builtin_amdgcn_s_waitcnt(0);
        unsigned nloc = b.st[0], nx = b.st[1];
        if (nloc == 0u) { xcd_barrier_complete(bar, b.x, nloc, nx); b.st[0] = nloc; b.st[1] = nx; }
        const unsigned old = xb_add(&bar[XB_XSUB(b.x)], 1u);
        const unsigned gen = old / nloc;
        if (old + 1u == (gen + 1u) * nloc) {
            __builtin_amdgcn_fence(__ATOMIC_RELEASE, "agent");
            asm volatile("s_waitcnt vmcnt(0)" ::: "memory");
            const unsigned og = xb_add(&bar[XB_TOP], 1u);
            const unsigned tg = og / nx;
            if (og + 1u == (tg + 1u) * nx) xb_add(&bar[XB_TOPGEN], 1u);
            else XB_SPIN(xb_ld(&bar[XB_TOPGEN]) == tg, bar);
            __builtin_amdgcn_fence(__ATOMIC_ACQUIRE, "agent");
            xb_add(&bar[XB_XGEN(b.x)], 1u);
            asm volatile("s_waitcnt vmcnt(0)" ::: "memory");
        } else {
            XB_SPIN(xb_ld(&bar[XB_XGEN(b.x)]) == gen, bar);
            __builtin_amdgcn_fence(__ATOMIC_ACQUIRE, "agent");
            asm volatile("s_waitcnt vmcnt(0)" ::: "memory");
        }
    }
    __syncthreads();
}

namespace pg8 {
constexpr int BM = 256, BK = 64, HALF = 128, HTB = HALF * BK * 2, STAGE_BYTES = 8 * HTB;
__host__ __device__ __forceinline__ int lds_byte(int r, int c) { const int st = (r >> 4) * 2 + (c >> 5), rr = r & 15, cc = c & 31, ob = rr * 64 + cc * 2; return st * 1024 + (ob ^ (((ob >> 9) & 1) << 5)); }
__host__ __device__ __forceinline__ void stage_rc(int b, int& R, int& C) { const int st = b / 1024, sb = b % 1024, swz = sb ^ (((sb >> 9) & 1) << 5); R = (st >> 1) * 16 + swz / 64; C = (st & 1) * 32 + (swz % 64) / 2; }
__host__ __device__ __forceinline__ int perm32(int rho) { const int n = rho >> 4, i = rho & 15; return 8 * (i >> 2) + 4 * n + (i & 3); }
__host__ __device__ __forceinline__ int perm16x(int rho) { const int n = rho >> 4, i = rho & 15; return 16 * (i >> 2) + 4 * n + (i & 3); }

struct Unit { int pm, pn; };
template <class P>
__device__ __forceinline__ void gemm_phase(LAS unsigned char* lds, LAS unsigned char* ldsctl, P& S, const int tid) {
    const int wid = __builtin_amdgcn_readfirstlane(tid >> 6), lane = tid & 63, wr = wid >> 2, wc = wid & 3, fr = lane & 15, fq = lane >> 4;
    constexpr bool F8 = P::FP8;
    constexpr int K = P::K, ES = F8 ? 1 : 2, nt = K * ES / 128;
    int R0, C0, R1, C1; stage_rc(tid * 16, R0, C0); stage_rc(tid * 16 + 8192, R1, C1);
    unsigned voffB[2];
    {
        const int Rb0 = P::BROW64 == 2 ? (64 * (R0 >> 5) + perm16x(R0 & 31)) : P::BROW64 ? (64 * (R0 >> 5) + perm32(R0 & 31)) : ((R0 & ~31) + perm32(R0 & 31));
        const int Rb1 = P::BROW64 == 2 ? (64 * (R1 >> 5) + perm16x(R1 & 31)) : P::BROW64 ? (64 * (R1 >> 5) + perm32(R1 & 31)) : ((R1 & ~31) + perm32(R1 & 31));
        voffB[0] = (unsigned)(Rb0 * K * ES + 2 * C0); voffB[1] = (unsigned)(Rb1 * K * ES + 2 * C1);
    }
    const unsigned ldsw = (unsigned)wid * 1024u;
    const int scl8 = P::SCALE_AB;
    const int aoff = lds_byte(wr * 64 + fr, fq * 8), boff = lds_byte(wc * 32 + fr, fq * 8);
#define PG8_SA(b, h) (((b) * 2 + (h)) * HTB)
#define PG8_SB(b, h) ((4 + (b) * 2 + (h)) * HTB)
    const unsigned ldsbase = (unsigned)__builtin_amdgcn_readfirstlane((int)(unsigned)(uintptr_t)lds + (int)ldsw);
#define PG8_GLDS(sbase, voff, ldsdst) do { if (P::NODMA) break; unsigned _keep; asm volatile("s_mov_b32 %0, m0\n\ts_mov_b32 m0, %3\n\ts_nop 0\n\tglobal_load_lds_dwordx4 %2, %1\n\ts_mov_b32 m0, %0" \
        : "=&s"(_keep) : "s"(sbase), "v"(voff), "s"(ldsdst) : "memory"); } while (0)
#define PG8_STAGE_A(bufoff, vo, h, kofs) do { _Pragma("unroll") for (int _i = 0; _i < 2; ++_i) \
        PG8_GLDS(Abase, (vo)[P::GATHER ? (h) : 0][_i] + ((kofs) + (P::GATHER ? 0u : (unsigned)(h) * HSTEPA)), ldsbase + (unsigned)((bufoff) + _i * 8192)); } while (0)
#define PG8_GLDS_NT(sbase, voff, ldsdst) do { if (P::NODMA) break; unsigned _keep; asm volatile("s_mov_b32 %0, m0\n\ts_mov_b32 m0, %3\n\ts_nop 0\n\tglobal_load_lds_dwordx4 %2, %1 nt\n\ts_mov_b32 m0, %0" \
        : "=&s"(_keep) : "s"(sbase), "v"(voff), "s"(ldsdst) : "memory"); } while (0)
#define PG8_STAGE_B(bufoff, gbase) do { _Pragma("unroll") for (int _i = 0; _i < 2; ++_i) { \
        if (P::BNT) PG8_GLDS_NT((const char*)(gbase), voffB[_i], ldsbase + (unsigned)((bufoff) + _i * 8192)); else PG8_GLDS((const char*)(gbase), voffB[_i], ldsbase + (unsigned)((bufoff) + _i * 8192)); } } while (0)
#define PG8_LDA(dst, b, h) do { if constexpr (F8) { _Pragma("unroll") for (int m = 0; m < 4; ++m) { const u32x4 _l = *(const LAS u32x4*)(lds + PG8_SA(b, h) + aoff + m * 2048), _h = *(const LAS u32x4*)(lds + PG8_SA(b, h) + aoff + m * 2048 + 1024); dst##8[m] = __builtin_bit_cast(v8i32, __builtin_shufflevector(_l, _h, 0, 1, 2, 3, 4, 5, 6, 7)); } } \
        else { _Pragma("unroll") for (int m = 0; m < 4; ++m) _Pragma("unroll") for (int k = 0; k < 2; ++k) dst[m][k] = *(const LAS bf16x8*)(lds + PG8_SA(b, h) + aoff + m * 2048 + k * 1024); } } while (0)
#define PG8_LDB(dst, b, h) do { if constexpr (F8) { _Pragma("unroll") for (int n = 0; n < 2; ++n) { const u32x4 _l = *(const LAS u32x4*)(lds + PG8_SB(b, h) + boff + n * 2048), _h = *(const LAS u32x4*)(lds + PG8_SB(b, h) + boff + n * 2048 + 1024); dst##8[n] = __builtin_bit_cast(v8i32, __builtin_shufflevector(_l, _h, 0, 1, 2, 3, 4, 5, 6, 7)); } } \
        else { _Pragma("unroll") for (int n = 0; n < 2; ++n) _Pragma("unroll") for (int k = 0; k < 2; ++k) dst[n][k] = *(const LAS bf16x8*)(lds + PG8_SB(b, h) + boff + n * 2048 + k * 1024); } } while (0)
#define PG8_MMA(ai, bj, At, Bt) do { __builtin_amdgcn_s_setprio(1); \
        if constexpr (F8) { _Pragma("unroll") for (int m = 0; m < 4; ++m) _Pragma("unroll") for (int n = 0; n < 2; ++n) \
            asm volatile("v_mfma_scale_f32_16x16x128_f8f6f4 %0, %1, %2, %0, %3, %3 op_sel:[0,1,0] op_sel_hi:[0,0,0]" : "+v"(acc[ai][bj][m][n]) : "v"(Bt##8[n]), "v"(At##8[m]), "v"(scl8)); } \
        else { _Pragma("unroll") for (int m = 0; m < 4; ++m) _Pragma("unroll") for (int n = 0; n < 2; ++n) _Pragma("unroll") for (int k = 0; k < 2; ++k) \
            acc[ai][bj][m][n] = __builtin_amdgcn_mfma_f32_16x16x32_bf16(Bt[n][k], At[m][k], acc[ai][bj][m][n], 0, 0, 0); } \
        __builtin_amdgcn_s_setprio(0); } while (0)
#define PG8_WAIT_V(n) asm volatile("s_waitcnt vmcnt(" #n ")" ::: "memory")
#define PG8_WAIT_L(n) asm volatile("s_waitcnt lgkmcnt(" #n ")" ::: "memory")
#define PG8_BAR __builtin_amdgcn_s_barrier()
#define PG8_SCHED __builtin_amdgcn_sched_barrier(0)
    Unit cur, nxt; int ui = 0;
    if (!S.next(0, cur)) return;
    f32x4 acc[2][2][4][2];
#pragma unroll
    for (int a = 0; a < 2; ++a)
#pragma unroll
        for (int b = 0; b < 2; ++b)
#pragma unroll
            for (int m = 0; m < 4; ++m)
#pragma unroll
                for (int n = 0; n < 2; ++n) acc[a][b][m][n] = (f32x4){0.f, 0.f, 0.f, 0.f};
    bf16x8 At[4][2], B0[2][2], B1[2][2]; v8i32 At8[4], B08[2], B18[2];
    const char* const Abase = S.a_base();
    unsigned voffA[2][2], voffAn[2][2];
    const char *cB0, *cB1;
    S.unit_begin(cur, ldsctl, tid, 0);
    S.e_issue(cur);
    S.a_offs(cur, R0, C0, R1, C1, voffA, true);
    asm volatile("s_waitcnt lgkmcnt(0)" ::: "memory");
    S.b_ptrs(cur, cB0, cB1); S.unit_switch();
    constexpr unsigned kstep = 128, HSTEPA = (unsigned)HALF * K * ES;
    PG8_STAGE_B(PG8_SB(0, 0), cB0); PG8_STAGE_B(PG8_SB(0, 1), cB1); PG8_STAGE_A(PG8_SA(0, 0), voffA, 0, 0u); PG8_STAGE_A(PG8_SA(0, 1), voffA, 1, 0u);
    if (wr == 1) PG8_BAR;
    PG8_WAIT_V(2); PG8_BAR;
    PG8_STAGE_B(PG8_SB(1, 0), cB0 + kstep); PG8_STAGE_A(PG8_SA(1, 0), voffA, 0, kstep); PG8_STAGE_B(PG8_SB(1, 1), cB1 + kstep);
    PG8_WAIT_V(6); PG8_BAR;
    for (;;) {
        const bool has_next = S.next(ui + 1, nxt);
        const char *nB0 = cB0, *nB1 = cB1;
        if constexpr (P::GATHER) {
#pragma unroll
            for (int h = 0; h < 2; ++h)
#pragma unroll
                for (int i = 0; i < 2; ++i) voffAn[h][i] = voffA[h][i];
        }
        if (has_next) { S.unit_begin(nxt, ldsctl, tid, (ui + 1) & 1); S.e_issue(nxt);
            if constexpr (P::GATHER) { int t2 = tid; asm volatile("" : "+v"(t2)); int r0, c0, r1, c1; stage_rc(t2 * 16, r0, c0); stage_rc(t2 * 16 + 8192, r1, c1); S.a_idx_issue(nxt, r0, r1); } }
        if (!P::NOEPI) { int l3 = tid; asm volatile("" : "+v"(l3)); S.epi_prefetch(cur, wr, wc, l3 & 15, (l3 >> 4) & 3); }
#pragma unroll 1
        for (int t = 0; t < nt; t += 2) {
            const bool last = (t == nt - 2);
            S.midk(acc, cur, t, wr, fr, ldsctl, ui & 1);
            unsigned a2o[2][2];
            if (last && has_next) S.b_ptrs(nxt, nB0, nB1);
            if constexpr (P::GATHER) { if (last && has_next) { int t2 = tid; asm volatile("" : "+v"(t2)); int r0, c0, r1, c1; stage_rc(t2 * 16, r0, c0); stage_rc(t2 * 16 + 8192, r1, c1);
                                                              S.a_idx_finish(c0, c1, voffAn); } }
            if constexpr (!P::GATHER) { if (last) { int t2 = tid; asm volatile("" : "+v"(t2)); int r0, c0, r1, c1; stage_rc(t2 * 16, r0, c0); stage_rc(t2 * 16 + 8192, r1, c1);
                                                   S.a_offs(has_next ? nxt : cur, r0, c0, r1, c1, voffAn, false); } }
#pragma unroll
            for (int h = 0; h < 2; ++h)
#pragma unroll
                for (int i = 0; i < 2; ++i) a2o[h][i] = last ? voffAn[h][i] : voffA[h][i] + (unsigned)(t + 2) * kstep;
            const char* b2h0 = last ? nB0 : cB0 + (size_t)(t + 2) * kstep; const char* b2h1 = last ? nB1 : cB1 + (size_t)(t + 2) * kstep;
            const unsigned a1k = (unsigned)(t + 1) * kstep;
            PG8_LDB(B0, 0, 0); PG8_LDB(B1, 0, 1); PG8_SCHED; PG8_LDA(At, 0, 0); PG8_STAGE_A(PG8_SA(1, 1), voffA, 1, a1k);
            PG8_WAIT_V(8); PG8_WAIT_L(0); PG8_BAR; PG8_MMA(0, 0, At, B0); PG8_MMA(0, 1, At, B1); PG8_BAR; PG8_SCHED;
            PG8_LDA(At, 0, 1); PG8_STAGE_B(PG8_SB(0, 0), b2h0); PG8_STAGE_B(PG8_SB(0, 1), b2h1); PG8_STAGE_A(PG8_SA(0, 0), a2o, 0, 0u);
            PG8_WAIT_V(8); PG8_WAIT_L(0); PG8_BAR; PG8_MMA(1, 0, At, B0); PG8_MMA(1, 1, At, B1); PG8_BAR; PG8_SCHED;
            PG8_LDB(B0, 1, 0); PG8_LDB(B1, 1, 1); PG8_SCHED; PG8_LDA(At, 1, 0); PG8_STAGE_A(PG8_SA(0, 1), a2o, 1, 0u);
            PG8_WAIT_V(8); PG8_WAIT_L(0); PG8_BAR; PG8_MMA(0, 0, At, B0); PG8_MMA(0, 1, At, B1); PG8_BAR; PG8_SCHED;
            PG8_LDA(At, 1, 1); PG8_STAGE_B(PG8_SB(1, 0), b2h0 + kstep); PG8_STAGE_B(PG8_SB(1, 1), b2h1 + kstep); PG8_STAGE_A(PG8_SA(1, 0), a2o, 0, kstep);
            PG8_WAIT_V(8); PG8_WAIT_L(0); PG8_BAR; PG8_MMA(1, 0, At, B0); PG8_MMA(1, 1, At, B1); PG8_BAR; PG8_SCHED;
        }
        if (wr == 0) PG8_BAR;
        if constexpr (F8) asm volatile("s_nop 15\n\ts_nop 15" ::: "memory");
        { int l2 = tid; asm volatile("" : "+v"(l2)); if (!P::NOEPI) S.epi(acc, cur, wr, wc, l2 & 15, (l2 >> 4) & 3); }
        if (!has_next) break;
#pragma unroll
        for (int a = 0; a < 2; ++a)
#pragma unroll
            for (int b = 0; b < 2; ++b)
#pragma unroll
                for (int m = 0; m < 4; ++m)
#pragma unroll
                    for (int n = 0; n < 2; ++n) acc[a][b][m][n] = (f32x4){0.f, 0.f, 0.f, 0.f};
        cur = nxt; cB0 = nB0; cB1 = nB1; ++ui; S.unit_switch();
#pragma unroll
        for (int h = 0; h < 2; ++h)
#pragma unroll
            for (int i = 0; i < 2; ++i) voffA[h][i] = voffAn[h][i];
        if (wr == 1) PG8_BAR;
    }
    PG8_WAIT_V(0);
    PG8_BAR;
#undef PG8_SA
#undef PG8_SB
#undef PG8_STAGE_A
#undef PG8_GLDS
#undef PG8_GLDS_NT
#undef PG8_STAGE_B
#undef PG8_LDA
#undef PG8_LDB
#undef PG8_MMA
#undef PG8_WAIT_V
#undef PG8_WAIT_L
#undef PG8_BAR
#undef PG8_SCHED
}
struct StaticOrder {
    int nM, nN, nwg, G, c;
    __device__ void init(int M, int N, int G_, int c_) { nM = M / BM; nN = N / BM; nwg = nM * nN; G = G_; c = c_; }
    __device__ bool next(int i, Unit& u) const {
        const long L = (long)i * G + c; if (L >= nwg) return false;
        int wgid = (int)L; { const int q = nwg / 8, r = nwg % 8, xcd = wgid % 8, off = wgid / 8; wgid = (xcd < r ? xcd * (q + 1) : r * (q + 1) + (xcd - r) * q) + off; }
        const int nig = 8 * nN, gid = wgid / nig, fm = gid * 8, gsz = (nM - fm) < 8 ? (nM - fm) : 8;
        u.pm = fm + ((wgid % nig) % gsz); u.pn = (wgid % nig) / gsz; return true;
    }
};
}

struct Frame {
    LAS unsigned char* lds; LAS unsigned char* ctl;
    unsigned char* ws;
    int tid, lane, wave, G, bx;
    float* out; const struct Args* ap; unsigned char* ws0; float* out0; size_t z;
};

struct Args { const float* in[28]; float* out; unsigned char* ws; int ph_lo, ph_hi; };
#define arg_in(i) (F.ap->in[i] + F.z)
__device__ __forceinline__ void phase_begin(Frame& F) {
    int t = F.tid; asm volatile("" : "+v"(t)); F.tid = t; F.lane = t & 63; F.wave = __builtin_amdgcn_readfirstlane(t >> 6);
    size_t z = 0; asm volatile("" : "+s"(z)); F.z = z; F.ws = F.ws0 + z; F.out = F.out0 + z;
    int bx = F.bx; asm volatile("" : "+s"(bx)); F.bx = bx;
}
__device__ __forceinline__ void phase_restart(Frame& F) {
    int wv = F.wave; asm volatile("" : "+s"(wv)); F.wave = wv;
    int ln = (int)__builtin_amdgcn_mbcnt_hi(~0u, __builtin_amdgcn_mbcnt_lo(~0u, 0u)); asm volatile("" : "+v"(ln)); F.lane = ln; F.tid = wv * 64 + ln;
    size_t z = 0; asm volatile("" : "+s"(z)); F.z = z; F.ws = F.ws0 + z; F.out = F.out0 + z;
}
struct PBase {
    static constexpr bool GATHER = false, FP8 = false, NODMA = false, NOEPI = false, BNT = false; static constexpr int SCALE_AB = 0x7f7f7f7f;
    __device__ __forceinline__ void unit_begin(const pg8::Unit&, LAS unsigned char*, int, int) {}
    __device__ __forceinline__ void e_issue(const pg8::Unit&) {}
    __device__ __forceinline__ void unit_switch() {}
    __device__ __forceinline__ void midk(f32x4 (&)[2][2][4][2], const pg8::Unit&, int, int, int, LAS unsigned char*, int) {}
    __device__ __forceinline__ void a_fix(unsigned (&)[2][2]) {}
    __device__ __forceinline__ void epi_prefetch(const pg8::Unit&, int, int, int, int) {}
};
struct PInProj : PBase {
    static constexpr int K = 1024, BROW64 = 1; static constexpr bool FP8 = IN_FP8; static constexpr int ES = IN_FP8 ? 1 : 2;
    static constexpr int SCALE_AB = 0x7b79;
    pg8::StaticOrder so; const char* A; const char* B; bf16_t* UQKV; const float *GQK, *COS, *SIN;
    __device__ __forceinline__ bool next(int i, pg8::Unit& u) const { return so.next(i, u); }
    __device__ __forceinline__ const char* a_base() const { return A; }
    __device__ __forceinline__ void a_offs(const pg8::Unit& u, int R0, int C0, int R1, int C1, unsigned (&vo)[2][2], bool) const {
#pragma unroll
        for (int h = 0; h < 2; ++h) { vo[h][0] = (unsigned)((u.pm * 256 + 128 * h + R0) * K * ES + 2 * C0); vo[h][1] = (unsigned)((u.pm * 256 + 128 * h + R1) * K * ES + 2 * C1); }
    }
    __device__ __forceinline__ void b_ptrs(const pg8::Unit& u, const char*& b0, const char*& b1) const { b0 = B + (size_t)u.pn * 256 * K * ES; b1 = b0 + (size_t)32 * K * ES; }
    __device__ __forceinline__ void epi(f32x4 (&acc)[2][2][4][2], const pg8::Unit& u, int wr, int wc, int fr, int fq) const {
        const int kind = u.pn >> 1;
        const int colg = (u.pn & 1) * 256 + 64 * wc;
        bf16_t* dst = UQKV + (size_t)kind * (size_t)(16u << 20);
        const int row0 = u.pm * 256 + wr * 64 + fr;
        if (kind == 0 || kind == 3) {
            const bool vimg = kind == 3;
#pragma unroll
            for (int ai = 0; ai < 2; ++ai)
#pragma unroll
                for (int m = 0; m < 4; ++m) { const int row = row0 + ai * 128 + m * 16;
                    bf16_t* rowp = vimg ? dst + (size_t)(row >> 6) * 32768 + (colg >> 7) * 8192 + ((colg >> 6) & 1) * 4096 + (row & 63) * 32 + 8 * fq : dst + (size_t)row * 512 + colg + 8 * fq;
                    const int bstep = vimg ? 2048 : 32;
#pragma unroll
                    for (int bj = 0; bj < 2; ++bj) { const f32x4 v0 = acc[ai][bj][m][0], v1 = acc[ai][bj][m][1];
                        u32x4 w; w.x = cvt_pk_bf16(v0[0], v0[1]); w.y = cvt_pk_bf16(v0[2], v0[3]); w.z = cvt_pk_bf16(v1[0], v1[1]); w.w = cvt_pk_bf16(v1[2], v1[3]);
                        *(u32x4*)(rowp + bstep * bj) = w; } }
        } else {
            const float* g = GQK + (kind - 1) * 64; const float sc = kind == 1 ? C2 * 32.0f : 16.0f;
            f32x4 g0[2], g1[2];
#pragma unroll
            for (int n = 0; n < 2; ++n) { g0[n] = *(const f32x4*)(g + 8 * fq + 4 * n); g1[n] = *(const f32x4*)(g + 32 + 8 * fq + 4 * n); }
            f32x4 tc[2][2], ts[2][2];
#define ROPE_LD(buf, it) do { const int _pos = (row0 + ((it) >> 2) * 128 + ((it) & 3) * 16) & (SEQ - 1); _Pragma("unroll") for (int n = 0; n < 2; ++n) { \
                tc[buf][n] = *(const f32x4*)(COS + (size_t)_pos * 32 + 8 * fq + 4 * n); ts[buf][n] = *(const f32x4*)(SIN + (size_t)_pos * 32 + 8 * fq + 4 * n); } } while (0)
            ROPE_LD(0, 0);
#pragma unroll
            for (int ai = 0; ai < 2; ++ai)
#pragma unroll
                for (int m = 0; m < 4; ++m) {
                    const int row = row0 + ai * 128 + m * 16; const int itx = ai * 4 + m;
                    if (itx + 1 < 8) ROPE_LD((itx + 1) & 1, itx + 1);
                    float ss = 0.f;
#pragma unroll
                    for (int bj = 0; bj < 2; ++bj)
#pragma unroll
                        for (int n = 0; n < 2; ++n) { const f32x4 x = acc[ai][bj][m][n]; ss += (x[0] * x[0] + x[1] * x[1]) + (x[2] * x[2] + x[3] * x[3]); }
                    ss += __shfl_xor(ss, 16); ss += __shfl_xor(ss, 32);
                    const float r = rsqrtf(ss * (1.f / 64.f) + EPS) * sc;
                    f32x4 o1[2], o2[2];
#pragma unroll
                    for (int n = 0; n < 2; ++n) {
                        const f32x4 c = tc[itx & 1][n], s = ts[itx & 1][n];
                        const f32x4 x1 = acc[ai][0][m][n] * g0[n] * r, x2 = acc[ai][1][m][n] * g1[n] * r;
                        o1[n] = x1 * c - x2 * s; o2[n] = x2 * c + x1 * s;
                    }
                    unsigned char* rowp = kind == 2 ? (unsigned char*)dst + (size_t)(row >> 6) * 32768 + (colg >> 6) * 4096 + (fq >> 1) * 1024 + (row & 63) * 16 + 8 * (fq & 1)
                                                    : (unsigned char*)dst + (size_t)row * 512 + colg + 8 * fq;
                    u32x2 w; w.x = pk4_fp8(o1[0][0], o1[0][1], o1[0][2], o1[0][3]); w.y = pk4_fp8(o1[1][0], o1[1][1], o1[1][2], o1[1][3]);
                    *(u32x2*)(rowp) = w;
                    w.x = pk4_fp8(o2[0][0], o2[0][1], o2[0][2], o2[0][3]); w.y = pk4_fp8(o2[1][0], o2[1][1], o2[1][2], o2[1][3]);
                    *(u32x2*)(rowp + (kind == 2 ? 2048 : 32)) = w;
                    asm volatile("" ::: "memory");
                }
#undef ROPE_LD
        }
    }
};
struct PGlu : PBase {
    static constexpr int K = 512, BROW64 = 0;
    pg8::StaticOrder so; const char* A; const char* B; const bf16_t* YG; bf16_t* MIX; float* RSP;
    __device__ __forceinline__ bool next(int i, pg8::Unit& u) const { return so.next(i, u); }
    __device__ __forceinline__ const char* a_base() const { return A; }
    __device__ __forceinline__ void a_offs(const pg8::Unit& u, int R0, int C0, int R1, int C1, unsigned (&vo)[2][2], bool) const {
#pragma unroll
        for (int h = 0; h < 2; ++h) { vo[h][0] = (unsigned)((u.pm * 256 + 128 * h + R0) * K + C0) * 2u; vo[h][1] = (unsigned)((u.pm * 256 + 128 * h + R1) * K + C1) * 2u; }
    }
    __device__ __forceinline__ void b_ptrs(const pg8::Unit& u, const char*& b0, const char*& b1) const { b0 = B + (size_t)u.pn * 256 * K * 2; b1 = b0 + (size_t)128 * K * 2; }
    __device__ __forceinline__ void epi(f32x4 (&acc)[2][2][4][2], const pg8::Unit& u, int wr, int wc, int fr, int fq) const {
        const int row0 = u.pm * 256 + wr * 64 + fr, col0 = u.pn * 256 + wc * 32 + 8 * fq;
#pragma unroll
        for (int ai = 0; ai < 2; ++ai)
#pragma unroll
            for (int m = 0; m < 4; ++m) {
                const int row = row0 + ai * 128 + m * 16; float ss = 0.f;
#pragma unroll
                for (int bj = 0; bj < 2; ++bj) {
                    const u32x4 yw = *(const u32x4*)(YG + (size_t)row * 512 + col0 + 128 * bj);
                    const f32x4 a0 = acc[ai][bj][m][0], a1 = acc[ai][bj][m][1];
                    float z[8];
                    z[0] = bf_lo(yw.x) * sigmoidf(a0[0]); z[1] = bf_hi(yw.x) * sigmoidf(a0[1]); z[2] = bf_lo(yw.y) * sigmoidf(a0[2]); z[3] = bf_hi(yw.y) * sigmoidf(a0[3]);
                    z[4] = bf_lo(yw.z) * sigmoidf(a1[0]); z[5] = bf_hi(yw.z) * sigmoidf(a1[1]); z[6] = bf_lo(yw.w) * sigmoidf(a1[2]); z[7] = bf_hi(yw.w) * sigmoidf(a1[3]);
#pragma unroll
                    for (int i = 0; i < 8; ++i) ss += z[i] * z[i];
                    u32x4 w; w.x = cvt_pk_bf16(z[0], z[1]); w.y = cvt_pk_bf16(z[2], z[3]); w.z = cvt_pk_bf16(z[4], z[5]); w.w = cvt_pk_bf16(z[6], z[7]);
                    *(u32x4*)(MIX + (size_t)row * 1024 + col0 + 128 * bj) = w;
                }
                ss += __shfl_xor(ss, 16); ss += __shfl_xor(ss, 32);
                if (fq == 0) RSP[(size_t)row * 8 + u.pn * 4 + wc] = ss;
            }
    }
};
struct POut : PBase {
    static constexpr int K = 1024, BROW64 = 0;
    pg8::StaticOrder so; const char* A; const char* B; const float* RSP; const float* base32; const bf16_t* base16; bf16_t* H1;
    __device__ __forceinline__ bool next(int i, pg8::Unit& u) const { return so.next(i, u); }
    __device__ __forceinline__ const char* a_base() const { return A; }
    __device__ __forceinline__ void a_offs(const pg8::Unit& u, int R0, int C0, int R1, int C1, unsigned (&vo)[2][2], bool) const {
#pragma unroll
        for (int h = 0; h < 2; ++h) { vo[h][0] = (unsigned)((u.pm * 256 + 128 * h + R0) * K + C0) * 2u; vo[h][1] = (unsigned)((u.pm * 256 + 128 * h + R1) * K + C1) * 2u; }
    }
    __device__ __forceinline__ void b_ptrs(const pg8::Unit& u, const char*& b0, const char*& b1) const { b0 = B + (size_t)u.pn * 256 * K * 2; b1 = b0 + (size_t)128 * K * 2; }
    __device__ __forceinline__ void unit_begin(const pg8::Unit& u, LAS unsigned char* ldsctl, int tid, int slot) const {
        if (tid < 256) {
            const f32x4 p0 = *(const f32x4*)(RSP + (size_t)(u.pm * 256 + tid) * 8), p1 = *(const f32x4*)(RSP + (size_t)(u.pm * 256 + tid) * 8 + 4);
            const float ss = ((p0[0] + p0[1]) + (p0[2] + p0[3])) + ((p1[0] + p1[1]) + (p1[2] + p1[3]));
            ((LAS float*)(ldsctl + 1024 + slot * 1024))[tid] = rsqrtf(ss * (1.f / 512.f) + EPS);
        }
    }
    __device__ __forceinline__ void midk(f32x4 (&acc)[2][2][4][2], const pg8::Unit& u, int t, int wr, int fr, LAS unsigned char* ldsctl, int slot) const {
        if (t == 8) {
            const LAS float* rs = (const LAS float*)(ldsctl + 1024 + slot * 1024);
#pragma unroll
            for (int ai = 0; ai < 2; ++ai)
#pragma unroll
                for (int m = 0; m < 4; ++m) { const float r = rs[ai * 128 + wr * 64 + m * 16 + fr];
#pragma unroll
                    for (int bj = 0; bj < 2; ++bj)
#pragma unroll
                        for (int n = 0; n < 2; ++n) acc[ai][bj][m][n] *= r; }
        }
    }
    __device__ __forceinline__ void epi(f32x4 (&acc)[2][2][4][2], const pg8::Unit& u, int wr, int wc, int fr, int fq) const {
        const int row0 = u.pm * 256 + wr * 64 + fr, col0 = u.pn * 256 + wc * 32 + 8 * fq;
#pragma unroll
        for (int ai = 0; ai < 2; ++ai)
#pragma unroll
            for (int m = 0; m < 4; ++m) { const size_t off = (size_t)(row0 + ai * 128 + m * 16) * 1024 + col0;
#pragma unroll
                for (int bj = 0; bj < 2; ++bj) {
                    f32x4 v0 = acc[ai][bj][m][0], v1 = acc[ai][bj][m][1];
                    if (base32) { v0 += *(const f32x4*)(base32 + off + bj * 128); v1 += *(const f32x4*)(base32 + off + bj * 128 + 4); }
                    else { const u32x4 b = *(const u32x4*)(base16 + off + bj * 128); v0[0] += bf_lo(b.x); v0[1] += bf_hi(b.x); v0[2] += bf_lo(b.y); v0[3] += bf_hi(b.y); v1[0] += bf_lo(b.z); v1[1] += bf_hi(b.z); v1[2] += bf_lo(b.w); v1[3] += bf_hi(b.w); }
                    u32x4 w; w.x = cvt_pk_bf16(v0[0], v0[1]); w.y = cvt_pk_bf16(v0[2], v0[3]); w.z = cvt_pk_bf16(v1[0], v1[1]); w.w = cvt_pk_bf16(v1[2], v1[3]);
                    *(u32x4*)(H1 + off + bj * 128) = w; }
                if (m & 1) asm volatile("" ::: "memory"); }
    }
};
template <int NN> struct MoeOrder {
    int j, wpx, s0, s1, s2, s3, n0, n1, n2, n3;
    __device__ __forceinline__ void init(int G, int c, const int* PST) {
#ifndef MOE_XA
#define MOE_XA 2
#endif
#ifndef MOE_CHUNKED
#define MOE_CHUNKED 0
#endif
        if (MOE_XA == 1 && (G & 7) == 0) { wpx = G >> 3; const int x = MOE_CHUNKED ? c / wpx : (c & 7); j = MOE_CHUNKED ? c % wpx : (c >> 3);
            s0 = PST[x] >> 8; n0 = (PST[x + 1] - PST[x]) >> 8; s1 = PST[x + 8] >> 8; n1 = (PST[x + 9] - PST[x + 8]) >> 8;
            s2 = PST[x + 16] >> 8; n2 = (PST[x + 17] - PST[x + 16]) >> 8; s3 = PST[x + 24] >> 8; n3 = (PST[x + 25] - PST[x + 24]) >> 8; }
        else { j = c; wpx = G; s0 = 0; n0 = PST[32] >> 8; s1 = s2 = s3 = 0; n1 = n2 = n3 = 0; }
        if (MOE_XA == 2 && (G & 7) == 0) { wpx = G >> 3; j = c >> 3; s1 = c & 7; n0 = PST[32] >> 8; }
    }
    __device__ __forceinline__ bool next(int i, pg8::Unit& u) const {
        const int q = i * wpx + j; int pml = q / NN; u.pn = q % NN;
        if (MOE_XA == 2) { u.pm = s1 + 8 * pml; return u.pm < n0; }
        if (pml < n0) { u.pm = s0 + pml; return true; } pml -= n0;
        if (pml < n1) { u.pm = s1 + pml; return true; } pml -= n1;
        if (pml < n2) { u.pm = s2 + pml; return true; } pml -= n2;
        if (pml < n3) { u.pm = s3 + pml; return true; }
        return false;
    }
};
struct PUp : PBase {
    static constexpr int K = 1024, BROW64 = 0; static constexpr bool GATHER = true, FP8 = UP_FP8, BNT = MOE_BNT; static constexpr int ES = UP_FP8 ? 1 : 2;
    static constexpr int SCALE_AB = 0x7c79;
    MoeOrder<8> mo; const char* A; const char* B; const int* ROWTOK; const int* TILEEXP; const float* bup; const float* ROWSCALE; bf16_t* ACT;
    int idx[2][2]; int c0, c1;
    __device__ __forceinline__ bool next(int i, pg8::Unit& u) const { return mo.next(i, u); }
    __device__ __forceinline__ const char* a_base() const { return A; }
    __device__ __forceinline__ void a_offs(const pg8::Unit& u, int R0, int C0, int R1, int C1, unsigned (&vo)[2][2], bool first) {
        c0 = C0; c1 = C1;
        const int* rp = ROWTOK + u.pm * 256;
#pragma unroll
        for (int h = 0; h < 2; ++h) {
            asm volatile("global_load_dword %0, %1, off" : "=v"(idx[h][0]) : "v"(rp + 128 * h + R0) : "memory");
            asm volatile("global_load_dword %0, %1, off" : "=v"(idx[h][1]) : "v"(rp + 128 * h + R1) : "memory");
        }
        asm volatile("s_waitcnt vmcnt(0)" : "+v"(idx[0][0]), "+v"(idx[0][1]), "+v"(idx[1][0]), "+v"(idx[1][1]) :: "memory");
#pragma unroll
        for (int h = 0; h < 2; ++h) { vo[h][0] = (unsigned)(idx[h][0] * K * ES + 2 * c0); vo[h][1] = (unsigned)(idx[h][1] * K * ES + 2 * c1); }
    }
    int e_cur, e_nxt;
    const LAS int* tl;
    __device__ __forceinline__ void e_issue(const pg8::Unit& u) { e_nxt = __builtin_amdgcn_readfirstlane(tl[u.pm]); }
    __device__ __forceinline__ void unit_switch() { e_cur = e_nxt; }
    __device__ __forceinline__ void b_ptrs(const pg8::Unit& u, const char*& b0, const char*& b1) {
        const int e = e_nxt; b0 = B + ((size_t)e * 2048 + (size_t)u.pn * 128) * K * ES; b1 = b0 + (size_t)1024 * K * ES; }
    __device__ __forceinline__ void a_idx_issue(const pg8::Unit& u, int R0, int R1) {
        const int* rp = ROWTOK + u.pm * 256;
#pragma unroll
        for (int h = 0; h < 2; ++h) {
            asm volatile("global_load_dword %0, %1, off" : "=v"(idx[h][0]) : "v"(rp + 128 * h + R0) : "memory");
            asm volatile("global_load_dword %0, %1, off" : "=v"(idx[h][1]) : "v"(rp + 128 * h + R1) : "memory");
        }
    }
    __device__ __forceinline__ void a_idx_finish(int C0, int C1, unsigned (&vo)[2][2]) {
        asm volatile("" : "+v"(idx[0][0]), "+v"(idx[0][1]), "+v"(idx[1][0]), "+v"(idx[1][1]) :: "memory");
#pragma unroll
        for (int h = 0; h < 2; ++h) { vo[h][0] = (unsigned)(idx[h][0] * K * ES + 2 * C0); vo[h][1] = (unsigned)(idx[h][1] * K * ES + 2 * C1); }
    }
    float ps[8]; f32x4 pbg[2], pbl[2];
    __device__ __forceinline__ void epi_prefetch(const pg8::Unit& u, int wr, int wc, int fr, int fq) {
        const int e = e_cur;
        const int row0 = u.pm * 256 + wr * 64 + fr, col0 = u.pn * 128 + wc * 32 + 8 * fq;
        const float* bg = bup + (size_t)e * 2048 + col0; const float* bl = bg + 1024;
#pragma unroll
        for (int ai = 0; ai < 2; ++ai)
#pragma unroll
            for (int m = 0; m < 4; ++m) asm volatile("global_load_dword %0, %1, off" : "=v"(ps[ai * 4 + m]) : "v"(ROWSCALE + row0 + ai * 128 + m * 16) : "memory");
#pragma unroll
        for (int n = 0; n < 2; ++n) { asm volatile("global_load_dwordx4 %0, %1, off" : "=v"(pbg[n]) : "v"(bg + 4 * n) : "memory"); asm volatile("global_load_dwordx4 %0, %1, off" : "=v"(pbl[n]) : "v"(bl + 4 * n) : "memory"); }
    }
    __device__ __forceinline__ void epi(f32x4 (&acc)[2][2][4][2], const pg8::Unit& u, int wr, int wc, int fr, int fq) {
        const int row0 = u.pm * 256 + wr * 64 + fr, col0 = u.pn * 128 + wc * 32 + 8 * fq;
        asm volatile("" : "+v"(ps[0]), "+v"(ps[1]), "+v"(ps[2]), "+v"(ps[3]), "+v"(ps[4]), "+v"(ps[5]), "+v"(ps[6]), "+v"(ps[7]), "+v"(pbg[0]), "+v"(pbg[1]), "+v"(pbl[0]), "+v"(pbl[1]));
        f32x4 bg4[2], bl1[2];
#pragma unroll
        for (int n = 0; n < 2; ++n) { bg4[n] = pbg[n] * 4.0f; bl1[n] = pbl[n] + 1.0f; }
        constexpr float CS = -2.4554669595f * 0.25f;
#pragma unroll
        for (int ai = 0; ai < 2; ++ai) {
            u32x2 w8[4];
#pragma unroll
            for (int m = 0; m < 4; ++m) {
                const float rs = ps[ai * 4 + m], rs4 = rs * 4.0f;
                f32x4 av[2];
#pragma unroll
                for (int n = 0; n < 2; ++n) {
                    f32x4 G = acc[ai][0][m][n] * rs4 + bg4[n], L = acc[ai][1][m][n] * rs + bl1[n], E;
#pragma unroll
                    for (int j = 0; j < 4; ++j) { G[j] = fminf(G[j], 28.0f); L[j] = __builtin_amdgcn_fmed3f(L[j], -6.0f, 8.0f); }
                    const f32x4 X = G * CS;
#pragma unroll
                    for (int j = 0; j < 4; ++j) E[j] = __builtin_amdgcn_exp2f(X[j]);
                    E = E + 1.0f;
#pragma unroll
                    for (int j = 0; j < 4; ++j) E[j] = __builtin_amdgcn_rcpf(E[j]);
                    av[n] = G * E * L;
                }
                w8[m].x = pk4_fp8(av[0][0], av[0][1], av[0][2], av[0][3]); w8[m].y = pk4_fp8(av[1][0], av[1][1], av[1][2], av[1][3]);
            }
            const bool odd = fq & 1;
#pragma unroll
            for (int mp = 0; mp < 2; ++mp) {
                const u32x2 snd = odd ? w8[2 * mp] : w8[2 * mp + 1], own = odd ? w8[2 * mp + 1] : w8[2 * mp];
                u32x2 rcv; rcv.x = (unsigned)__shfl_xor((int)snd.x, 16); rcv.y = (unsigned)__shfl_xor((int)snd.y, 16);
                const u32x4 w = odd ? (u32x4){rcv.x, rcv.y, own.x, own.y} : (u32x4){own.x, own.y, rcv.x, rcv.y};
                const int row = row0 + ai * 128 + (2 * mp + (odd ? 1 : 0)) * 16;
                *(u32x4*)((unsigned char*)ACT + (size_t)row * 1024 + u.pn * 128 + wc * 32 + 16 * (fq >> 1)) = w;
            }
        }
    }
};
struct PUpNoDma : PUp { static constexpr bool NODMA = (GEMM_PROBE_KIND & 1) != 0, NOEPI = (GEMM_PROBE_KIND & 2) != 0; };
struct PDown : PBase {
    static constexpr int K = 1024, BROW64 = 2; static constexpr bool FP8 = DN_FP8, BNT = MOE_BNT; static constexpr int ES = DN_FP8 ? 1 : 2;
    static constexpr int SCALE_AB = 0x7d79;
    MoeOrder<4> mo; const char* A; const char* B; const int* TILEEXP; const float* bdn; const float* ROWGATE; bf16_t* YB;
    __device__ __forceinline__ bool next(int i, pg8::Unit& u) const { return mo.next(i, u); }
    __device__ __forceinline__ const char* a_base() const { return A; }
    __device__ __forceinline__ void a_offs(const pg8::Unit& u, int R0, int C0, int R1, int C1, unsigned (&vo)[2][2], bool) const {
#pragma unroll
        for (int h = 0; h < 2; ++h) { vo[h][0] = (unsigned)((u.pm * 256 + 128 * h + R0) * K * ES + 2 * C0); vo[h][1] = (unsigned)((u.pm * 256 + 128 * h + R1) * K * ES + 2 * C1); }
    }
    int e_cur, e_nxt;
    const LAS int* tl;
    __device__ __forceinline__ void e_issue(const pg8::Unit& u) { e_nxt = __builtin_amdgcn_readfirstlane(tl[u.pm]); }
    __device__ __forceinline__ void unit_switch() { e_cur = e_nxt; }
    __device__ __forceinline__ void b_ptrs(const pg8::Unit& u, const char*& b0, const char*& b1) {
        const int e = e_nxt; b0 = B + ((size_t)e * 1024 + (size_t)u.pn * 256) * K * ES; b1 = b0 + (size_t)8 * K * ES; }
    float pg[8]; f32x4 pb[2][2];
    __device__ __forceinline__ void epi_prefetch(const pg8::Unit& u, int wr, int wc, int fr, int fq) {
        const int e = e_cur;
        const int row0 = u.pm * 256 + wr * 64 + fr, col0 = u.pn * 256 + wc * 64 + 16 * fq;
        const float* bp = bdn + (size_t)e * 1024 + col0;
#pragma unroll
        for (int ai = 0; ai < 2; ++ai)
#pragma unroll
            for (int m = 0; m < 4; ++m) asm volatile("global_load_dword %0, %1, off" : "=v"(pg[ai * 4 + m]) : "v"(ROWGATE + row0 + ai * 128 + m * 16) : "memory");
#pragma unroll
        for (int bj = 0; bj < 2; ++bj)
#pragma unroll
            for (int n = 0; n < 2; ++n) asm volatile("global_load_dwordx4 %0, %1, off" : "=v"(pb[bj][n]) : "v"(bp + 8 * bj + 4 * n) : "memory");
    }
    __device__ __forceinline__ void epi(f32x4 (&acc)[2][2][4][2], const pg8::Unit& u, int wr, int wc, int fr, int fq) {
        const int row0 = u.pm * 256 + wr * 64 + fr, col0 = u.pn * 256 + wc * 64 + 16 * fq;
        asm volatile("" : "+v"(pg[0]), "+v"(pg[1]), "+v"(pg[2]), "+v"(pg[3]), "+v"(pg[4]), "+v"(pg[5]), "+v"(pg[6]), "+v"(pg[7]), "+v"(pb[0][0]), "+v"(pb[0][1]), "+v"(pb[1][0]), "+v"(pb[1][1]));
#pragma unroll
        for (int ai = 0; ai < 2; ++ai)
#pragma unroll
            for (int m = 0; m < 4; ++m) { const int row = row0 + ai * 128 + m * 16; const float gt = pg[ai * 4 + m] * 16.f;
                const f32x4 v00 = (acc[ai][0][m][0] + pb[0][0]) * gt, v01 = (acc[ai][0][m][1] + pb[0][1]) * gt, v10 = (acc[ai][1][m][0] + pb[1][0]) * gt, v11 = (acc[ai][1][m][1] + pb[1][1]) * gt;
                u32x4 w; w.x = pk4_fp8(v00[0], v00[1], v00[2], v00[3]); w.y = pk4_fp8(v01[0], v01[1], v01[2], v01[3]); w.z = pk4_fp8(v10[0], v10[1], v10[2], v10[3]); w.w = pk4_fp8(v11[0], v11[1], v11[2], v11[3]);
                *(u32x4*)((unsigned char*)YB + (size_t)row * 1024 + col0) = w; }
    }
};

struct TItem { const float* src; bf16_t* dst; const float* ksc; int N, K; unsigned char* dst8; };
__device__ __forceinline__ void titem_load(const TItem& it, f32x4 (&v)[16], int lane) {
    const float* p = it.src + (size_t)(lane >> 4) * it.N + 4 * (lane & 15);
#pragma unroll
    for (int i = 0; i < 16; ++i) v[i] = *(const f32x4*)(p + (size_t)(4 * i) * it.N);
}
__device__ __forceinline__ void titem_store(const TItem& it, f32x4 (&v)[16], LAS float* scr, int lane) {
    if (it.ksc) {
#pragma unroll
        for (int i = 0; i < 16; ++i) v[i] *= it.ksc[4 * i + (lane >> 4)];
    }
#pragma unroll
    for (int i = 0; i < 16; ++i) { LAS float* d = scr + (4 * i + (lane >> 4)) * 65 + 4 * (lane & 15); d[0] = v[i][0]; d[1] = v[i][1]; d[2] = v[i][2]; d[3] = v[i][3]; }
    asm volatile("s_waitcnt lgkmcnt(0)" ::: "memory");
    if (it.dst8) {
        const int c = lane & 3;
#pragma unroll
        for (int j = 0; j < 4; ++j) { const int n = (lane >> 2) + 16 * j; const LAS float* s = scr + (16 * c) * 65 + n;
            u32x4 o;
            o.x = pk4_fp8(s[0 * 65] * 64.f, s[1 * 65] * 64.f, s[2 * 65] * 64.f, s[3 * 65] * 64.f); o.y = pk4_fp8(s[4 * 65] * 64.f, s[5 * 65] * 64.f, s[6 * 65] * 64.f, s[7 * 65] * 64.f);
            o.z = pk4_fp8(s[8 * 65] * 64.f, s[9 * 65] * 64.f, s[10 * 65] * 64.f, s[11 * 65] * 64.f); o.w = pk4_fp8(s[12 * 65] * 64.f, s[13 * 65] * 64.f, s[14 * 65] * 64.f, s[15 * 65] * 64.f);
            *(u32x4*)(it.dst8 + (size_t)n * it.K + 16 * c) = o; }
    } else {
        const int c = lane & 7;
#pragma unroll
        for (int j = 0; j < 8; ++j) { const int n = (lane >> 3) + 8 * j; const LAS float* s = scr + (8 * c) * 65 + n;
            u32x4 o; o.x = pk2(s[0 * 65], s[1 * 65]); o.y = pk2(s[2 * 65], s[3 * 65]); o.z = pk2(s[4 * 65], s[5 * 65]); o.w = pk2(s[6 * 65], s[7 * 65]);
            *(u32x4*)(it.dst + (size_t)n * it.K + 8 * c) = o; }
    }
    asm volatile("s_waitcnt lgkmcnt(0)" ::: "memory");
}
__device__ __forceinline__ void rms_row_to_bf16(const f32x4 (&v)[4], const float* g, bf16_t* orow, int lane) {
    float s = 0.f;
#pragma unroll
    for (int j = 0; j < 4; ++j) s += (v[j][0] * v[j][0] + v[j][1] * v[j][1]) + (v[j][2] * v[j][2] + v[j][3] * v[j][3]);
    const float r = rsqrtf(wave_sum(s) * (1.f / D) + EPS) * (IN_FP8 ? 16.f : 1.f);
#pragma unroll
    for (int j = 0; j < 4; ++j) { const f32x4 gg = *(const f32x4*)(g + 4 * lane + 256 * j); const f32x4 o = v[j] * gg * r;
        if (IN_FP8) { ((unsigned*)orow)[lane + 64 * j] = pk4_fp8(o[0], o[1], o[2], o[3]); }
        else { u32x2 w; w.x = cvt_pk_bf16(o[0], o[1]); w.y = cvt_pk_bf16(o[2], o[3]); *(u32x2*)(orow + 4 * lane + 256 * j) = w; } }
}
struct Cplx { float re, im; };
__device__ __forceinline__ Cplx cmul(Cplx a, Cplx b) { return Cplx{a.re * b.re - a.im * b.im, a.re * b.im + a.im * b.re}; }
__device__ __forceinline__ Cplx lam_pow(float lr, float li, float step, int n) {
    const float mag = expf((float)n * lr * step); const double ang = (double)n * (double)li * (double)step;
    return Cplx{mag * (float)cos(ang), mag * (float)sin(ang)};
}
__device__ __forceinline__ Cplx lam_pow_fast(float lr, float li, float step, int n) {
    const float mag = __expf((float)n * lr * step); const double rev = (double)n * (double)li * (double)step * 0.15915494309189535; const float fr = (float)(rev - floor(rev));
    return Cplx{mag * __builtin_amdgcn_cosf(fr), mag * __builtin_amdgcn_sinf(fr)};
}
__device__ __forceinline__ Cplx bbar_factor(float lr, float li, float step) {
    const Cplx lb = lam_pow(lr, li, step, 1); const float nr = lb.re - 1.f, ni = lb.im, den = lr * lr + li * li;
    return Cplx{(nr * lr + ni * li) / den, (ni * lr - nr * li) / den};
}
template <int PMODE> __device__ __forceinline__ void p0_prologue(Frame& F) {
    const int gw = F.bx * NWAVES + F.wave, NGW = F.G * NWAVES, lane = F.lane;
    const int gt = F.bx * NTHREADS + F.tid, NGT = F.G * NTHREADS;
    unsigned char* ws = F.ws;
    if (!(PMODE & 1)) {
        LAS float* scr = (LAS float*)(F.lds + LDS_RING) + F.wave * (64 * 65);
        constexpr int I_UP = UP_FP8 ? 0 : 32 * 16 * 32, I_DN = DN_FP8 ? 0 : 32 * 16 * 16, I_IN = IN_FP8 ? 0 : 16 * 32, I_OUT = 16 * 16, I_GLU = 8 * 8;
        constexpr int PER_L = I_UP + I_DN + I_IN + I_OUT + I_GLU, TOTAL = DEPTH * PER_L;
        auto decode = [&](int it) -> TItem {
            TItem ti; const int l = it / PER_L; int r = it % PER_L; const float* W; bf16_t* WT; int K, N; ti.ksc = nullptr; bool f8 = false;
            if (r < I_UP) { const int e = r / 512; r %= 512; K = 1024; N = 2048; W = arg_in(24) + ((size_t)l * NE + e) * 1024 * 2048; WT = (bf16_t*)(ws + WS_WUP + l * WUP_STRIDE) + (size_t)e * 2048 * 1024 / (UP_FP8 ? 2 : 1); f8 = UP_FP8; }
            else if ((r -= I_UP) < I_DN) { const int e = r / 256; r %= 256; K = 1024; N = 1024; W = arg_in(26) + ((size_t)l * NE + e) * 1024 * 1024; WT = (bf16_t*)(ws + WS_WDN + l * WDN_STRIDE) + (size_t)e * 1024 * 1024 / (DN_FP8 ? 2 : 1); f8 = DN_FP8; }
            else if ((r -= I_DN) < I_IN) { K = 1024; N = 2048; W = arg_in(2) + (size_t)l * 1024 * 2048; WT = (bf16_t*)(ws + WS_WIN + l * WIN_STRIDE); }
            else if ((r -= I_IN) < I_OUT) { K = 1024; N = 1024; W = arg_in(20) + (size_t)l * 1024 * 1024; WT = (bf16_t*)(ws + WS_WOUT + l * WOUT_STRIDE); if ((r / 16) * 64 < DS) ti.ksc = arg_in(12) + l * DS + (r / 16) * 64; }
            else { r -= I_OUT; K = 512; N = 512; W = arg_in(11) + (size_t)l * 512 * 512; WT = (bf16_t*)(ws + WS_WGLU + l * WGLU_STRIDE); }
            const int nblk = N / 64, k0 = 64 * (r / nblk), n0 = 64 * (r % nblk);
            ti.src = W + (size_t)k0 * N + n0; ti.dst = WT + (size_t)n0 * K + k0; ti.N = N; ti.K = K; ti.dst8 = f8 ? (unsigned char*)WT + (size_t)n0 * K + k0 : nullptr; return ti;
        };
        f32x4 va[16]; TItem ia;
        for (int it = gw; it < TOTAL; it += NGW) { ia = decode(it); titem_load(ia, va, lane); titem_store(ia, va, scr, lane); }
    }
    if (!(PMODE & 1) && (UP_FP8 || DN_FP8 || IN_FP8)) {
        LAS float* tile = (LAS float*)(F.lds + LDS_RING);
        constexpr int C_UP = UP_FP8 ? 32 * 8 * 8 : 0, C_DN = DN_FP8 ? 32 * 8 * 4 : 0, C_IN = IN_FP8 ? 8 * 8 : 0, C_PER_L = C_UP + C_DN + C_IN, C_TOTAL = DEPTH * C_PER_L;
        auto cdecode = [&](int it, const float*& src, unsigned char*& dst, int& N) {
            const int l = it / C_PER_L; int r = it % C_PER_L; const float* W; unsigned char* WT;
            if (r < C_UP) { const int e = r >> 6; r &= 63; N = 2048; W = arg_in(24) + ((size_t)l * NE + e) * 1024 * 2048; WT = ws + WS_WUP + l * WUP_STRIDE + (size_t)e * 2048 * 1024; }
            else if (r < C_UP + C_DN) { r -= C_UP; const int e = r >> 5; r &= 31; N = 1024; W = arg_in(26) + ((size_t)l * NE + e) * 1024 * 1024; WT = ws + WS_WDN + l * WDN_STRIDE + (size_t)e * 1024 * 1024; }
            else { r -= C_UP + C_DN; N = 2048; W = arg_in(2) + (size_t)l * 1024 * 2048; WT = ws + WS_WIN + l * WIN_STRIDE; }
            const int nblk = N >> 8, k0 = 128 * (r / nblk), n0 = 256 * (r % nblk);
            src = W + (size_t)k0 * N + n0; dst = WT + (size_t)n0 * 1024 + k0;
        };
        auto cload = [&](const float* src, int N, f32x4 (&v)[16]) {
            const float* p = src + (size_t)F.wave * N + 4 * lane;
#pragma unroll
            for (int i = 0; i < 16; ++i) v[i] = *(const f32x4*)(p + (size_t)(8 * i) * N);
        };
        auto cstore = [&](unsigned char* dst, f32x4 (&v)[16]) {
            __syncthreads();
#pragma unroll
            for (int i = 0; i < 16; ++i) *(LAS f32x4*)(tile + (8 * i + F.wave) * 260 + 4 * lane) = v[i];
            __syncthreads();
            const int n = F.tid & 255, cc = F.tid >> 8;
#pragma unroll
            for (int j = 0; j < 4; ++j) { const int c = 2 * j + cc; const LAS float* sp = tile + (16 * c) * 260 + n;
                u32x4 o;
                o.x = pk4_fp8(sp[0 * 260] * 64.f, sp[1 * 260] * 64.f, sp[2 * 260] * 64.f, sp[3 * 260] * 64.f); o.y = pk4_fp8(sp[4 * 260] * 64.f, sp[5 * 260] * 64.f, sp[6 * 260] * 64.f, sp[7 * 260] * 64.f);
                o.z = pk4_fp8(sp[8 * 260] * 64.f, sp[9 * 260] * 64.f, sp[10 * 260] * 64.f, sp[11 * 260] * 64.f); o.w = pk4_fp8(sp[12 * 260] * 64.f, sp[13 * 260] * 64.f, sp[14 * 260] * 64.f, sp[15 * 260] * 64.f);
                *(u32x4*)(dst + (size_t)n * 1024 + 16 * c) = o; }
        };
        f32x4 va[16], vb[16]; const float* sa; const float* sb; unsigned char* da; unsigned char* db; int na, nb;
        int it = F.bx;
        if (it < C_TOTAL) { cdecode(it, sa, da, na); cload(sa, na, va); }
        while (it < C_TOTAL) {
            const int itb = it + F.G;
            if (itb < C_TOTAL) { cdecode(itb, sb, db, nb); cload(sb, nb, vb); }
            cstore(da, va);
            if (itb >= C_TOTAL) break;
            const int itc = itb + F.G;
            if (itc < C_TOTAL) { cdecode(itc, sa, da, na); cload(sa, na, va); }
            cstore(db, vb);
            it = itc;
        }
        __syncthreads();
    }
    phase_begin(F); ws = F.ws;
    for (int i = F.bx * NTHREADS + F.tid; i < SEQ * 32; i += NGT) {
        const int s = i >> 5, j = i & 31;
        const float inv = 1.0f / powf(10000.0f, (float)(2 * j) / 64.0f);
        const float ang = (float)s * inv;
        ((float*)(ws + WS_COS))[i] = (float)cos((double)ang); ((float*)(ws + WS_SIN))[i] = (float)sin((double)ang);
    }
    if (F.bx == 0 && F.wave < DEPTH) {
        const int l = F.wave;
        float a = arg_in(15)[l * 64 + lane] * arg_in(16)[l * 64 + lane], b = arg_in(17)[l * 64 + lane] * arg_in(18)[l * 64 + lane];
        a = wave_sum(a); b = wave_sum(b);
        float mq = fabsf(arg_in(13)[l * 64 + lane]), mk = fabsf(arg_in(14)[l * 64 + lane]);
#pragma unroll
        for (int o = 1; o < 64; o <<= 1) { mq = fmaxf(mq, __shfl_xor(mq, o)); mk = fmaxf(mk, __shfl_xor(mk, o)); }
        const float lambda_init = 0.8f - 0.6f * expf(-0.3f * (float)l);
        { float* gqk = (float*)(ws + WS_SCAL) + 64 + l * 128; gqk[lane] = arg_in(13)[l * 64 + lane]; gqk[64 + lane] = arg_in(14)[l * 64 + lane]; }
        if (lane == 0) { float* sc = (float*)(ws + WS_SCAL) + l * 4; sc[0] = expf(a) - expf(b) + lambda_init; sc[1] = C2 * 64.f * mq * mk * 1.02f + 0.5f; sc[2] = 1.0f - lambda_init; }
    }
    for (int i = gt; i < DEPTH * NE * D; i += NGT) {
        const int l = i / (NE * D), e = (i / D) % NE, k = i % D;
        const float w = arg_in(22)[(size_t)l * D * NE + (size_t)k * NE + e];
        const unsigned hi = f2bf(w); const float lo = w - __builtin_bit_cast(float, hi << 16);
        bf16_t* t = (bf16_t*)(ws + WS_WRT + l * WRT_STRIDE);
        t[e * D + k] = (bf16_t)hi; t[NE * D + e * D + k] = (bf16_t)f2bf(lo);
    }
    phase_begin(F); ws = F.ws;
#define TBL_PTRS(l) const float* lam_re = arg_in(3) + (l) * NG * NP; const float* lam_im = arg_in(4) + (l) * NG * NP; const float* log_step = arg_in(5) + (l) * NG; \
        const float* b_re = arg_in(6) + (size_t)(l) * NG * NP * HS; const float* b_im = arg_in(7) + (size_t)(l) * NG * NP * HS; \
        const float* c_re = arg_in(8) + (size_t)(l) * NG * HS * NP; const float* c_im = arg_in(9) + (size_t)(l) * NG * HS * NP; \
        bf16_t* KT = (bf16_t*)(ws + WS_KT + (l) * KT_STRIDE); bf16_t* HT = (bf16_t*)(ws + WS_HT + (l) * HT_STRIDE); (void)KT; (void)HT; (void)b_re; (void)b_im
    if (!(PMODE & 2)) {
        {
            LAS float* pwl = (LAS float*)(F.lds + LDS_RING);
            for (int cb = F.bx; cb < DEPTH * NG * 17; cb += F.G) {
                const int l = cb / (NG * 17), rb = cb % (NG * 17);
                if (rb >= NG * 9) continue;
                const int blk = rb;
                TBL_PTRS(l);
                const int g = blk / 9, s0 = (blk % 9) * 8;
                const float step = expf(log_step[g]);
                LAS float* cgl = pwl + 1024;
                LAS float* ffl = cgl + 2048;
                LAS float* bgl = ffl + 128;
                __syncthreads();
                { const int p = F.tid & 63, sl = F.tid >> 6, slot = s0 + sl; Cplx w{0.f, 0.f};
                  if (slot >= 1 && slot <= 64) w = lam_pow_fast(lam_re[g * NP + p], lam_im[g * NP + p], step, slot - 1);
                  pwl[(sl * 64 + p) * 2] = w.re; pwl[(sl * 64 + p) * 2 + 1] = w.im; }
                for (int idx = F.tid; idx < 1024; idx += NTHREADS) { cgl[2 * idx] = c_re[(size_t)g * HS * NP + idx]; cgl[2 * idx + 1] = c_im[(size_t)g * HS * NP + idx]; }
                if (F.tid < 64) { const Cplx f = bbar_factor(lam_re[g * NP + F.tid], lam_im[g * NP + F.tid], step); ffl[2 * F.tid] = f.re; ffl[2 * F.tid + 1] = f.im; }
                __syncthreads();
                for (int idx = F.tid; idx < 1024; idx += NTHREADS) { const int p = idx >> 4; const Cplx w = cmul(Cplx{ffl[2 * p], ffl[2 * p + 1]}, Cplx{b_re[(size_t)g * NP * HS + idx], b_im[(size_t)g * NP * HS + idx]}); bgl[2 * idx] = w.re; bgl[2 * idx + 1] = w.im; }
                __syncthreads();
                const int pq = F.tid & 3, h = (F.tid >> 2) & 15, sl = F.tid >> 6, slot = s0 + sl;
                float accv[16];
#pragma unroll
                for (int q = 0; q < 16; ++q) accv[q] = 0.f;
                for (int pp = 0; pp < 16; ++pp) {
                    const int p = pq * 16 + pp;
                    const Cplx w = cmul(Cplx{cgl[(h * 64 + p) * 2], cgl[(h * 64 + p) * 2 + 1]}, Cplx{pwl[(sl * 64 + p) * 2], pwl[(sl * 64 + p) * 2 + 1]});
                    const LAS f32x4* bp = (const LAS f32x4*)(bgl + p * 32);
#pragma unroll
                    for (int q2 = 0; q2 < 8; ++q2) { const f32x4 bb = bp[q2]; accv[2 * q2] += w.re * bb[0] - w.im * bb[1]; accv[2 * q2 + 1] += w.re * bb[2] - w.im * bb[3]; }
                }
#pragma unroll
                for (int q = 0; q < 16; ++q) { accv[q] += __shfl_xor(accv[q], 1); accv[q] += __shfl_xor(accv[q], 2); }
                if (pq == 0 && slot <= 64) {
                    u32x4 o0, o1; o0.x = pk2(accv[0], accv[1]); o0.y = pk2(accv[2], accv[3]); o0.z = pk2(accv[4], accv[5]); o0.w = pk2(accv[6], accv[7]);
                    o1.x = pk2(accv[8], accv[9]); o1.y = pk2(accv[10], accv[11]); o1.z = pk2(accv[12], accv[13]); o1.w = pk2(accv[14], accv[15]);
                    u32x4* dst = (u32x4*)(KT + ((size_t)(g * 65 + slot) * HS + h) * 16); dst[0] = o0; dst[1] = o1;
                }
            }
            for (int cb = F.bx; cb < DEPTH * NG * 17; cb += F.G) {
                const int l = cb / (NG * 17), rb = cb % (NG * 17);
                if (rb < NG * 9) continue;
                const int blk = rb - NG * 9;
                TBL_PTRS(l);
                const int g = blk >> 3, t0 = (blk & 7) * 8;
                const float step = expf(log_step[g]);
                __syncthreads();
                LAS float* cgl = pwl + 1024;
                { const int p = F.tid & 63, tl = F.tid >> 6; const Cplx w = lam_pow_fast(lam_re[g * NP + p], lam_im[g * NP + p], step, t0 + tl + 1); pwl[(tl * 64 + p) * 2] = w.re; pwl[(tl * 64 + p) * 2 + 1] = w.im; }
                for (int idx = F.tid; idx < 1024; idx += NTHREADS) { cgl[2 * idx] = c_re[(size_t)g * HS * NP + idx]; cgl[2 * idx + 1] = c_im[(size_t)g * HS * NP + idx]; }
                __syncthreads();
                const int pq = F.tid & 3, h = (F.tid >> 2) & 15, tl = F.tid >> 6, t = t0 + tl;
                bf16_t* dst = HT + ((size_t)(g * 1024 + t * 16 + h) * 128 + pq * 32);
                for (int pp = 0; pp < 16; pp += 4) {
                    float v[8];
#pragma unroll
                    for (int q = 0; q < 4; ++q) { const int p = pq * 16 + pp + q;
                        const Cplx w = cmul(Cplx{cgl[(h * 64 + p) * 2], cgl[(h * 64 + p) * 2 + 1]}, Cplx{pwl[(tl * 64 + p) * 2], pwl[(tl * 64 + p) * 2 + 1]});
                        v[2 * q] = w.re; v[2 * q + 1] = -w.im; }
                    u32x4 o; o.x = pk2(v[0], v[1]); o.y = pk2(v[2], v[3]); o.z = pk2(v[4], v[5]); o.w = pk2(v[6], v[7]);
                    *(u32x4*)(dst + 2 * pp) = o;
                }
            }
            __syncthreads();
        }
    }
#undef TBL_PTRS
    if (!(PMODE & 2)) for (int l = 0; l < DEPTH; ++l) {
        const float* lam_re = arg_in(3) + l * NG * NP; const float* lam_im = arg_in(4) + l * NG * NP; const float* log_step = arg_in(5) + l * NG;
        const float* b_re = arg_in(6) + (size_t)l * NG * NP * HS; const float* b_im = arg_in(7) + (size_t)l * NG * NP * HS;
        const float* c_re = arg_in(8) + (size_t)l * NG * HS * NP; const float* c_im = arg_in(9) + (size_t)l * NG * HS * NP;
        bf16_t* KT = (bf16_t*)(ws + WS_KT + l * KT_STRIDE); bf16_t* GT = (bf16_t*)(ws + WS_GT + l * GT_STRIDE); bf16_t* HT = (bf16_t*)(ws + WS_HT + l * HT_STRIDE);
        float* LAML = (float*)(ws + WS_LAML + l * LAML_STRIDE);
        for (int i = gt; i < NG * NP * 64; i += NGT) {
            const int s = i % 64, p = (i / 64) % NP, g = i / (64 * NP);
            const float step = expf(log_step[g]); const float lr = lam_re[g * NP + p], li = lam_im[g * NP + p];
            const Cplx w = cmul(lam_pow_fast(lr, li, step, 63 - s), bbar_factor(lr, li, step));
            float vr[16], vi[16];
#pragma unroll
            for (int q = 0; q < 16; ++q) { const float br = b_re[(size_t)(g * NP + p) * HS + q], bi = b_im[(size_t)(g * NP + p) * HS + q]; vr[q] = w.re * br - w.im * bi; vi[q] = w.re * bi + w.im * br; }
            u32x4* dr = (u32x4*)(GT + ((size_t)(g * 128 + 2 * p) * 1024 + s * 16)); u32x4* di = (u32x4*)(GT + ((size_t)(g * 128 + 2 * p + 1) * 1024 + s * 16));
            u32x4 o; o.x = pk2(vr[0], vr[1]); o.y = pk2(vr[2], vr[3]); o.z = pk2(vr[4], vr[5]); o.w = pk2(vr[6], vr[7]); dr[0] = o;
            o.x = pk2(vr[8], vr[9]); o.y = pk2(vr[10], vr[11]); o.z = pk2(vr[12], vr[13]); o.w = pk2(vr[14], vr[15]); dr[1] = o;
            o.x = pk2(vi[0], vi[1]); o.y = pk2(vi[2], vi[3]); o.z = pk2(vi[4], vi[5]); o.w = pk2(vi[6], vi[7]); di[0] = o;
            o.x = pk2(vi[8], vi[9]); o.y = pk2(vi[10], vi[11]); o.z = pk2(vi[12], vi[13]); o.w = pk2(vi[14], vi[15]); di[1] = o;
        }
        for (int i = gt; i < NG * NP; i += NGT) { const int g = i / NP; const Cplx w = lam_pow(lam_re[i], lam_im[i], expf(log_step[g]), 64); LAML[2 * i] = w.re; LAML[2 * i + 1] = w.im; }
    }
    {
        const float* xin = arg_in(0); const float* g0 = arg_in(1); bf16_t* XN = (bf16_t*)(ws + WS_XN);
        f32x4 va[4], vb[4];
        int m = gw;
        if (m < T) {
#pragma unroll
            for (int j = 0; j < 4; ++j) va[j] = ((const f32x4*)(xin + (size_t)m * D) + lane)[64 * j]; }
        while (m < T) {
            const int mb = m + NGW;
            if (mb < T) {
#pragma unroll
                for (int j = 0; j < 4; ++j) vb[j] = ((const f32x4*)(xin + (size_t)mb * D) + lane)[64 * j]; }
            rms_row_to_bf16(va, g0, (bf16_t*)((unsigned char*)XN + (size_t)m * D * (IN_FP8 ? 1 : 2)), lane);
            if (mb >= T) break;
            const int mc = mb + NGW;
            if (mc < T) {
#pragma unroll
                for (int j = 0; j < 4; ++j) va[j] = ((const f32x4*)(xin + (size_t)mc * D) + lane)[64 * j]; }
            rms_row_to_bf16(vb, g0, (bf16_t*)((unsigned char*)XN + (size_t)mb * D * (IN_FP8 ? 1 : 2)), lane);
            m = mc;
        }
    }
}

__device__ __forceinline__ void s5a_phase(Frame& F, int l) {
    const bf16_t* GT = (const bf16_t*)(F.ws + WS_GT + l * GT_STRIDE); const bf16_t* U = (const bf16_t*)(F.ws + WS_U); float* S = (float*)(F.ws + WS_S);
    const int lane = F.lane, n = lane & 15, kq = lane >> 4;
    for (int uu = F.bx * NWAVES + F.wave; uu < NG * 32 * 2; uu += F.G * NWAVES) {
        const int g = uu >> 6, ntile = (uu >> 1) & 31, mh = uu & 1;
        const int chunk = ntile * 16 + n;
        const bf16_t* up = U + ((size_t)chunk * 64 + (kq >> 1)) * DS + g * 16 + 8 * (kq & 1);
        const bf16_t* gp = GT + ((size_t)(g * 128 + mh * 64 + n) * 1024 + 8 * kq);
        f32x4 acc[4];
#pragma unroll
        for (int mt = 0; mt < 4; ++mt) acc[mt] = (f32x4){0.f, 0.f, 0.f, 0.f};
#pragma unroll 4
        for (int ks = 0; ks < 32; ++ks) {
            const bf16x8 b = *(const bf16x8*)(up + (size_t)(2 * ks) * DS);
#pragma unroll
            for (int mt = 0; mt < 4; ++mt) { const bf16x8 a = *(const bf16x8*)(gp + (size_t)(mt * 16) * 1024 + 32 * ks); acc[mt] = __builtin_amdgcn_mfma_f32_16x16x32_bf16(a, b, acc[mt], 0, 0, 0); }
        }
#pragma unroll
        for (int mt = 0; mt < 4; ++mt) *(f32x4*)(S + ((size_t)chunk * NG + g) * 128 + mh * 64 + mt * 16 + 4 * kq) = acc[mt];
    }
}
__device__ __forceinline__ void s5c_phase(Frame& F, int l) {
    const bf16_t* KT = (const bf16_t*)(F.ws + WS_KT + l * KT_STRIDE); const bf16_t* HT = (const bf16_t*)(F.ws + WS_HT + l * HT_STRIDE);
    const float* LAML = (const float*)(F.ws + WS_LAML + l * LAML_STRIDE); const float* S = (const float*)(F.ws + WS_S);
    const bf16_t* U = (const bf16_t*)(F.ws + WS_U); bf16_t* YG = (bf16_t*)(F.ws + WS_YG); const float* dsk = arg_in(10) + l * DS;
    const int lane = F.lane, n = lane & 15, kq = lane >> 4, wave = F.wave;
    LAS unsigned char* ktl = F.lds + LDS_RING;
    LAS unsigned char* xs = F.lds + LDS_RING + 33792 + wave * 4096;
    LAS f32x2* EB = (LAS f32x2*)(F.lds + LDS_RING + 33792 + 8 * 4096);
    LAS f32x2* EH = EB + 512;
    for (int wu = F.bx; wu < NG * 8; wu += F.G) {
        const int g = wu >> 3, scq = wu & 7, b = scq >> 1, cbase = (scq & 1) * 64, scl = wave >> 1, par = wave & 1;
        __syncthreads();
        for (int i = F.tid; i < 65 * 32; i += NTHREADS) *(LAS u32x4*)(ktl + i * 16) = *(const u32x4*)(KT + (size_t)g * 65 * 256 + i * 8);
        const Cplx L = Cplx{LAML[(g * NP + lane) * 2], LAML[(g * NP + lane) * 2 + 1]};
        const float* sp = S + ((size_t)(b * CPB) * NG + g) * 128 + 2 * lane;
        {
            f32x2 sv[8];
#pragma unroll
            for (int j = 0; j < 8; ++j) sv[j] = *(const f32x2*)(sp + (size_t)(cbase + 8 * wave + j) * NG * 128);
            Cplx E{0.f, 0.f};
#pragma unroll
            for (int j = 0; j < 8; ++j) { const Cplx nx = cmul(L, E); E.re = nx.re + sv[j][0]; E.im = nx.im + sv[j][1]; }
            EB[wave * 64 + lane] = (f32x2){E.re, E.im};
            if (cbase) {
#pragma unroll
                for (int j = 0; j < 8; ++j) sv[j] = *(const f32x2*)(sp + (size_t)(8 * wave + j) * NG * 128);
                Cplx H{0.f, 0.f};
#pragma unroll
                for (int j = 0; j < 8; ++j) { const Cplx nx = cmul(L, H); H.re = nx.re + sv[j][0]; H.im = nx.im + sv[j][1]; }
                EH[wave * 64 + lane] = (f32x2){H.re, H.im};
            }
        }
        __syncthreads();
        const int c0 = cbase + 16 * scl;
        {
            const Cplx L2 = cmul(L, L), L4 = cmul(L2, L2), L8 = cmul(L4, L4);
            Cplx X{0.f, 0.f};
            if (cbase) {
#pragma unroll
                for (int w = 0; w < 8; ++w) { const f32x2 e = EH[w * 64 + lane]; const Cplx nx = cmul(L8, X); X.re = nx.re + e[0]; X.im = nx.im + e[1]; }
            }
            for (int w = 0; w < 2 * scl; ++w) { const f32x2 e = EB[w * 64 + lane]; const Cplx nx = cmul(L8, X); X.re = nx.re + e[0]; X.im = nx.im + e[1]; }
            f32x2 sv[16];
#pragma unroll
            for (int j = 0; j < 16; ++j) sv[j] = *(const f32x2*)(sp + (size_t)(c0 + j) * NG * 128);
#pragma unroll
            for (int j = 0; j < 16; ++j) {
                *(LAS unsigned*)(xs + j * 256 + 4 * lane) = pk2(X.re, X.im);
                const Cplx nx = cmul(L, X); X.re = nx.re + sv[j][0]; X.im = nx.im + sv[j][1];
            }
        }
        const int chunk = b * CPB + c0 + n;
        bf16x8 ub[32];
        {
            const bf16_t* up = U + ((size_t)chunk * 64 + (kq >> 1)) * DS + g * 16 + 8 * (kq & 1);
#pragma unroll
            for (int kp = 0; kp < 32; ++kp) ub[kp] = *(const bf16x8*)(up + (size_t)(2 * kp) * DS);
        }
        const LAS unsigned char* xbp = xs + n * 256 + 16 * kq;
        const f32x4 dv = *(const f32x4*)(dsk + g * 16 + 4 * kq);
        const bf16_t* hp = HT + ((size_t)(g * 1024 + n) * 128 + 8 * kq);
        const bf16_t* uq = U + (size_t)chunk * 64 * DS + g * 16 + 4 * kq;
        const LAS unsigned char* kbase = ktl + (n * 16 + 8 * (kq & 1)) * 2;
        u32x2 uw = *(const u32x2*)(uq + (size_t)par * DS);
        for (int ti = 0; ti < 32; ++ti) {
            const int t = 2 * ti + par, tn = (ti < 31) ? t + 2 : t;
            bf16x8 ha[4];
#pragma unroll
            for (int ks = 0; ks < 4; ++ks) ha[ks] = *(const bf16x8*)(hp + (size_t)(t * 16) * 128 + 32 * ks);
            const u32x2 un = *(const u32x2*)(uq + (size_t)tn * DS);
            f32x4 acc = (f32x4){0.f, 0.f, 0.f, 0.f};
            const int slot0 = t + 1 - (kq >> 1);
#pragma unroll
            for (int kp = 0; kp < 32; ++kp) {
                if (kp <= ti) { const bf16x8 a = *(const LAS bf16x8*)(kbase + (slot0 - 2 * kp) * 512); acc = __builtin_amdgcn_mfma_f32_16x16x32_bf16(a, ub[kp], acc, 0, 0, 0); }
            }
#pragma unroll
            for (int ks = 0; ks < 4; ++ks) acc = __builtin_amdgcn_mfma_f32_16x16x32_bf16(ha[ks], *(const LAS bf16x8*)(xbp + 64 * ks), acc, 0, 0, 0);
            const float y0 = acc[0] + dv[0] * bf_lo(uw.x), y1 = acc[1] + dv[1] * bf_hi(uw.x), y2 = acc[2] + dv[2] * bf_lo(uw.y), y3 = acc[3] + dv[3] * bf_hi(uw.y);
            u32x2 w; w.x = cvt_pk_bf16(gelu_tanh(y0), gelu_tanh(y1)); w.y = cvt_pk_bf16(gelu_tanh(y2), gelu_tanh(y3));
            *(u32x2*)(YG + ((size_t)chunk * 64 + t) * DS + g * 16 + 4 * kq) = w;
            uw = un;
        }
    }
    __syncthreads();
}

namespace att {
constexpr int KSLOT = 8192, VSLOT = 16384, NSLOT = 4, LDS_K = 0, LDS_V = NSLOT * KSLOT, LDS_WS = NSLOT * (KSLOT + VSLOT), LDS_END = LDS_WS + 8 * 256;
constexpr int STG_ROW = 136;
__device__ __forceinline__ int crow(int r, int hi) { return (r & 3) + 8 * (r >> 2) + 4 * hi; }
__device__ __forceinline__ void glds16(const void* gsrc, unsigned lds_dst) { unsigned keep;
    asm volatile("s_mov_b32 %0, m0\n\ts_mov_b32 m0, %2\n\ts_nop 0\n\tglobal_load_lds_dwordx4 %1, off\n\ts_mov_b32 m0, %0" : "=&s"(keep) : "v"(gsrc), "s"(lds_dst) : "memory"); }
typedef __attribute__((address_space(3))) const char* lds_cptr;
typedef short v4i16_t __attribute__((ext_vector_type(4)));
__device__ __forceinline__ s16x4 vtr(lds_cptr p) { return __builtin_bit_cast(s16x4, __builtin_amdgcn_ds_read_tr16_b64_v4i16((__attribute__((address_space(3))) v4i16_t*)p)); }
#define ATT_WAIT_BAR(N) asm volatile("s_waitcnt vmcnt(" #N ") lgkmcnt(0)\n\ts_barrier" ::: "memory")

template <int MODE> __device__ __forceinline__ void attn_unit(int bh, int qb, const bf16_t* Q, const bf16_t* K, const bf16_t* V, bf16_t* MIX, const float* subg, float lam, float mshift, float oml,
                                          LAS unsigned char* shm, int tid) {
    const int lane = tid & 63, r32 = lane & 31, hi = lane >> 5; const int wid = __builtin_amdgcn_readfirstlane(tid >> 6);
    const int b = bh >> 2, h = bh & 3, m = wid & 1, qg = wid >> 1;
    const size_t rowbase = (size_t)b * SEQ; const int q0 = qb * 128;
    const int NT = 2 * qb + 2, cw = 2 * qb + (qg >> 1);
    const unsigned lds0 = (unsigned)(uintptr_t)shm;
    const unsigned char* k0src = (const unsigned char*)K + rowbase * DA + h * 8192 + wid * 1024 + lane * 16;
    const bf16_t* v0src = V + rowbase * DA + h * 8192 + wid * 512 + lane * 8;
    const bf16_t* v1src = v0src + 4096;
    const unsigned kdst = lds0 + LDS_K + (wid >> 2) * 4096 + (wid & 3) * 1024, vdst = lds0 + LDS_V + wid * 1024;
#define ATT_DMA(t, slot) do { const size_t _o = (size_t)(t) * 64 * DA; \
        glds16(k0src + _o, (unsigned)__builtin_amdgcn_readfirstlane(kdst + (slot) * KSLOT)); glds16(k1src + _o, (unsigned)__builtin_amdgcn_readfirstlane(kdst + (slot) * KSLOT + 8192)); \
        glds16(v0src + _o, (unsigned)__builtin_amdgcn_readfirstlane(vdst + (slot) * VSLOT)); glds16(v1src + _o, (unsigned)__builtin_amdgcn_readfirstlane(vdst + (slot) * VSLOT + 8192)); } while (0)
    v8i32 qf;
    { const unsigned char* Qw = (const unsigned char*)Q + (rowbase + q0 + qg * 32 + r32) * DA + h * 128 + m * 64 + hi * 32;
      const u32x4 ql = *(const u32x4*)(Qw), qh = *(const u32x4*)(Qw + 16); qf = __builtin_bit_cast(v8i32, __builtin_shufflevector(ql, qh, 0, 1, 2, 3, 4, 5, 6, 7)); }
#ifndef ATT_GRP
#define ATT_GRP (wid & 1)
#endif
    const int grp = ATT_GRP;
#define ATT_DMA_K(t, slot) do { if (MODE & 1) break; const size_t _o = (size_t)(t) * 64 * DA; \
        glds16(k0src + _o, (unsigned)__builtin_amdgcn_readfirstlane(kdst + (slot) * KSLOT)); } while (0)
#define ATT_DMA_V(t, slot) do { if (MODE & 1) break; const size_t _o = (size_t)(t) * 64 * DA; \
        glds16(v0src + _o, (unsigned)__builtin_amdgcn_readfirstlane(vdst + (slot) * VSLOT)); glds16(v1src + _o, (unsigned)__builtin_amdgcn_readfirstlane(vdst + (slot) * VSLOT + 8192)); } while (0)
    ATT_DMA_K(0, 0); ATT_DMA_V(0, 0); ATT_DMA_K(1, 1); ATT_DMA_V(1, 1); if (NT > 2) { ATT_DMA_K(2, 2); ATT_DMA_V(2, 2); }
    f32x16 o[4];
#pragma unroll
    for (int d = 0; d < 4; ++d)
#pragma unroll
        for (int r = 0; r < 16; ++r) o[d][r] = 0.f;
    float l_reg = 0.f;
    const f32x16 zero16 = {0.f, 0.f, 0.f, 0.f, 0.f, 0.f, 0.f, 0.f, 0.f, 0.f, 0.f, 0.f, 0.f, 0.f, 0.f, 0.f};
    (void)mshift;
    const lds_cptr shm3 = (lds_cptr)shm;
    const lds_cptr kp0 = shm3 + LDS_K + m * 4096 + hi * 2048 + r32 * 16;
    const lds_cptr vp0 = shm3 + LDS_V + ((lane >> 4) & 1) * 32 + (lane & 3) * 8 + (4 * hi + ((lane & 15) >> 2)) * 64;
    u32x4 pw[4];
#pragma unroll
    for (int q = 0; q < 4; ++q) pw[q] = (u32x4){0u, 0u, 0u, 0u};
#define ATT_SB() __builtin_amdgcn_sched_barrier(0)
#define ATT_QKEXP(sl) do { if (MODE & 2) break; const lds_cptr kp = kp0 + (sl) * KSLOT; \
        ATT_SB(); \
        const u32x4 k0l = *(const __attribute__((address_space(3))) u32x4*)(kp), k0h = *(const __attribute__((address_space(3))) u32x4*)(kp + 1024); \
        const u32x4 k1l = *(const __attribute__((address_space(3))) u32x4*)(kp + 512), k1h = *(const __attribute__((address_space(3))) u32x4*)(kp + 1024 + 512); \
        ATT_SB(); \
        const v8i32 kf0 = __builtin_bit_cast(v8i32, __builtin_shufflevector(k0l, k0h, 0, 1, 2, 3, 4, 5, 6, 7)), kf1 = __builtin_bit_cast(v8i32, __builtin_shufflevector(k1l, k1h, 0, 1, 2, 3, 4, 5, 6, 7)); \
        f32x16 p0 = __builtin_amdgcn_mfma_scale_f32_32x32x64_f8f6f4(kf0, qf, zero16, 0, 0, 0, 0x7a7b, 1, 0x7a7b); \
        f32x16 p1 = __builtin_amdgcn_mfma_scale_f32_32x32x64_f8f6f4(kf1, qf, zero16, 0, 0, 0, 0x7a7b, 1, 0x7a7b); \
        ATT_SB(); \
        float sacc = 0.f; \
        _Pragma("unroll") for (int r = 0; r < 16; ++r) { p0[r] = __builtin_amdgcn_exp2f(p0[r]); p1[r] = __builtin_amdgcn_exp2f(p1[r]); sacc += p0[r] + p1[r]; } \
        l_reg += sacc; \
        _Pragma("unroll") for (int q = 0; q < 4; ++q) { pw[0][q] = cvt_pk_bf16(p0[2 * q], p0[2 * q + 1]); pw[1][q] = cvt_pk_bf16(p0[8 + 2 * q], p0[8 + 2 * q + 1]); \
                                                        pw[2][q] = cvt_pk_bf16(p1[2 * q], p1[2 * q + 1]); pw[3][q] = cvt_pk_bf16(p1[8 + 2 * q], p1[8 + 2 * q + 1]); } } while (0)
#define ATT_VRD(buf, d) do { _Pragma("unroll") for (int ks = 0; ks < 4; ++ks) { buf[0][ks] = vtr(vp + (d) * 4096 + ks * 1024); buf[1][ks] = vtr(vp + (d) * 4096 + ks * 1024 + 512); } } while (0)
#define ATT_VMM(buf, d, PW) do { _Pragma("unroll") for (int ks = 0; ks < 4; ++ks) { \
        const bf16x8 vf = (bf16x8){buf[0][ks][0], buf[0][ks][1], buf[0][ks][2], buf[0][ks][3], buf[1][ks][0], buf[1][ks][1], buf[1][ks][2], buf[1][ks][3]}; \
        o[d] = __builtin_amdgcn_mfma_f32_32x32x16_bf16(__builtin_bit_cast(bf16x8, PW[ks]), vf, o[d], 0, 0, 0); } } while (0)
#define ATT_PV(sl, PW) do { if (MODE & 4) break; const lds_cptr vp = vp0 + (sl) * VSLOT; s16x4 va[2][4], vb[2][4]; \
        ATT_SB(); ATT_VRD(va, 0); ATT_SB(); ATT_VRD(vb, 1); ATT_SB(); ATT_VMM(va, 0, PW); ATT_SB(); ATT_VRD(va, 2); ATT_SB(); ATT_VMM(vb, 1, PW); ATT_SB(); \
        ATT_VRD(vb, 3); ATT_SB(); ATT_VMM(va, 2, PW); ATT_SB(); ATT_VMM(vb, 3, PW); ATT_SB(); } while (0)
    u32x4 pwn[4];
#define ATT_PIN(x) asm volatile("" : "+v"(x))
#define ATT_MM(d, ks, cur, nxt, PW) do { \
        if ((d) < 3) { nxt[0][ks] = vtr(vp + ((d) + 1) * 4096 + (ks) * 1024); nxt[1][ks] = vtr(vp + ((d) + 1) * 4096 + (ks) * 1024 + 512); } \
        { const bf16x8 vf = (bf16x8){cur[0][ks][0], cur[0][ks][1], cur[0][ks][2], cur[0][ks][3], cur[1][ks][0], cur[1][ks][1], cur[1][ks][2], cur[1][ks][3]}; \
          o[d] = __builtin_amdgcn_mfma_f32_32x32x16_bf16(__builtin_bit_cast(bf16x8, PW[ks]), vf, o[d], 0, 0, 0); } \
        asm volatile("" : "+v"(o[d]));     \
        } while (0)
#define ATT_EX(PX, e0, PWN, q) do { PX[e0] = __builtin_amdgcn_exp2f(PX[e0]); PX[(e0) + 1] = __builtin_amdgcn_exp2f(PX[(e0) + 1]); sacc += PX[e0]; sacc += PX[(e0) + 1]; ATT_PIN(sacc); \
        PWN[q] = cvt_pk_bf16(PX[e0], PX[(e0) + 1]); ATT_PIN(PWN); } while (0)
#define ATT_FUSED(slk, slk1, PW, PWN) do { const lds_cptr kp = kp0 + (slk1) * KSLOT; const lds_cptr vp = vp0 + (slk) * VSLOT; s16x4 va[2][4], vb[2][4]; \
        ATT_SB(); \
        const u32x4 k0l = *(const __attribute__((address_space(3))) u32x4*)(kp), k0h = *(const __attribute__((address_space(3))) u32x4*)(kp + 1024); \
        const u32x4 k1l = *(const __attribute__((address_space(3))) u32x4*)(kp + 512), k1h = *(const __attribute__((address_space(3))) u32x4*)(kp + 1024 + 512); \
        ATT_VRD(va, 0); \
        ATT_SB(); \
        const v8i32 kf0 = __builtin_bit_cast(v8i32, __builtin_shufflevector(k0l, k0h, 0, 1, 2, 3, 4, 5, 6, 7)), kf1 = __builtin_bit_cast(v8i32, __builtin_shufflevector(k1l, k1h, 0, 1, 2, 3, 4, 5, 6, 7)); \
        f32x16 p0 = __builtin_amdgcn_mfma_scale_f32_32x32x64_f8f6f4(kf0, qf, zero16, 0, 0, 0, 0x7a7b, 1, 0x7a7b); \
        f32x16 p1 = __builtin_amdgcn_mfma_scale_f32_32x32x64_f8f6f4(kf1, qf, zero16, 0, 0, 0, 0x7a7b, 1, 0x7a7b); \
        ATT_SB(); \
        float sacc = 0.f; \
          \
        ATT_MM(0, 0, va, vb, PW); ATT_SB(); ATT_MM(0, 1, va, vb, PW); ATT_SB(); \
        ATT_MM(0, 2, va, vb, PW); ATT_EX(p0, 0, PWN[0], 0); ATT_SB();  ATT_MM(0, 3, va, vb, PW); ATT_EX(p0, 2, PWN[0], 1); ATT_SB(); \
        ATT_MM(1, 0, vb, va, PW); ATT_EX(p0, 4, PWN[0], 2); ATT_SB();  ATT_MM(1, 1, vb, va, PW); ATT_EX(p0, 6, PWN[0], 3); ATT_SB(); \
        ATT_MM(1, 2, vb, va, PW); ATT_EX(p0, 8, PWN[1], 0); ATT_SB();  ATT_MM(1, 3, vb, va, PW); ATT_EX(p0, 10, PWN[1], 1); ATT_SB(); \
        ATT_MM(2, 0, va, vb, PW); ATT_EX(p0, 12, PWN[1], 2); ATT_SB(); ATT_MM(2, 1, va, vb, PW); ATT_EX(p0, 14, PWN[1], 3); ATT_SB(); \
        ATT_MM(2, 2, va, vb, PW); ATT_EX(p1, 0, PWN[2], 0); ATT_SB();  ATT_MM(2, 3, va, vb, PW); ATT_EX(p1, 2, PWN[2], 1); ATT_SB(); \
        ATT_MM(3, 0, vb, va, PW); ATT_EX(p1, 4, PWN[2], 2); ATT_SB();  ATT_MM(3, 1, vb, va, PW); ATT_EX(p1, 6, PWN[2], 3); ATT_SB(); \
        ATT_MM(3, 2, vb, va, PW); ATT_EX(p1, 8, PWN[3], 0); ATT_EX(p1, 10, PWN[3], 1); ATT_SB(); \
        ATT_MM(3, 3, vb, va, PW); ATT_EX(p1, 12, PWN[3], 2); ATT_EX(p1, 14, PWN[3], 3); ATT_SB(); \
        l_reg += sacc; \
        } while (0)
    {
        if (NT > 2) { ATT_WAIT_BAR(6); } else { ATT_WAIT_BAR(3); }
        ATT_QKEXP(0);
        int sk = 0;
#pragma unroll 1
        for (int k = 0; k < NT - 2; k += 2) {
            ATT_WAIT_BAR(3);
            ATT_DMA_K(k + 3, (sk + 3) & 3); ATT_DMA_V(k + 3, (sk + 3) & 3);
            ATT_SB(); ATT_FUSED(sk, (sk + 1) & 3, pw, pwn); ATT_SB();
            ATT_WAIT_BAR(3);
            if (k + 4 < NT) { ATT_DMA_K(k + 4, sk); ATT_DMA_V(k + 4, sk); }
            ATT_SB(); ATT_FUSED((sk + 1) & 3, (sk + 2) & 3, pwn, pw); ATT_SB();
            sk = (sk + 2) & 3;
        }
        ATT_WAIT_BAR(0);
        if (cw == NT - 1) { ATT_SB(); ATT_FUSED(sk, (sk + 1) & 3, pw, pwn); ATT_SB(); ATT_PV((sk + 1) & 3, pwn); }
        else { ATT_SB(); ATT_PV(sk, pw); }
    }
#undef ATT_FUSED
#undef ATT_MM
#undef ATT_EX
#undef ATT_PIN
#undef ATT_QKEXP
#undef ATT_PV
#undef ATT_VRD
#undef ATT_VMM
#undef ATT_SB
#undef ATT_DMA_K
#undef ATT_DMA_V
    { auto rr = __builtin_amdgcn_permlane32_swap(__float_as_uint(l_reg), __float_as_uint(l_reg), false, false); l_reg = __uint_as_float(rr[0]) + __uint_as_float(rr[1]); }
    LAS float* wsf = (LAS float*)(shm + LDS_WS) + wid * 64;
    if (hi == 0) wsf[r32] = l_reg;
    ATT_WAIT_BAR(0);
    float rli[16];
    const float scl = m ? lam : 1.0f;
#pragma unroll
    for (int r = 0; r < 16; ++r) rli[r] = scl * __builtin_amdgcn_rcpf(wsf[crow(r, hi)]);
    LAS float* stg = (LAS float*)shm + qg * (32 * STG_ROW);
    if (m == 1) {
#pragma unroll
        for (int r = 0; r < 16; ++r)
#pragma unroll
            for (int d = 0; d < 4; ++d) stg[crow(r, hi) * STG_ROW + d * 32 + r32] = o[d][r] * rli[r];
    }
    ATT_WAIT_BAR(0);
    if (m == 0) {
#pragma unroll
        for (int r = 0; r < 16; ++r)
#pragma unroll
            for (int d = 0; d < 4; ++d) { LAS float* p = stg + crow(r, hi) * STG_ROW + d * 32 + r32; *p = o[d][r] * rli[r] - *p; }
    }
    ATT_WAIT_BAR(0);
    {
        const int row = 16 * m + (lane >> 2), qt = lane & 3;
        const LAS float* p = stg + row * STG_ROW + qt * 32;
        f32x4 v[8]; float ss = 0.f;
#pragma unroll
        for (int i = 0; i < 8; ++i) { v[i] = *(const LAS f32x4*)(p + 4 * i); ss += (v[i][0] * v[i][0] + v[i][1] * v[i][1]) + (v[i][2] * v[i][2] + v[i][3] * v[i][3]); }
        ss += __shfl_xor(ss, 1); ss += __shfl_xor(ss, 2);
        const float rn = rsqrtf(ss * (1.f / 128.f) + EPS) * oml;
        bf16_t* dst = MIX + (rowbase + q0 + qg * 32 + row) * D + DS + h * 128 + qt * 32;
#pragma unroll
        for (int i = 0; i < 4; ++i) {
            const f32x4 g0 = *(const f32x4*)(subg + qt * 32 + 8 * i), g1 = *(const f32x4*)(subg + qt * 32 + 8 * i + 4);
            const f32x4 a = v[2 * i] * g0 * rn, c = v[2 * i + 1] * g1 * rn;
            u32x4 w; w.x = cvt_pk_bf16(a[0], a[1]); w.y = cvt_pk_bf16(a[2], a[3]); w.z = cvt_pk_bf16(c[0], c[1]); w.w = cvt_pk_bf16(c[2], c[3]);
            *(u32x4*)(dst + 8 * i) = w;
        }
    }
    ATT_WAIT_BAR(0);
#undef ATT_DMA
}
}
template <int MODE> __device__ __forceinline__ void attn_phase(Frame& F, int l) {
    const bf16_t* Q = (const bf16_t*)(F.ws + WS_Q); const bf16_t* K = (const bf16_t*)(F.ws + WS_K); const bf16_t* V = (const bf16_t*)(F.ws + WS_V);
    bf16_t* MIX = (bf16_t*)(F.ws + WS_MIX);
    const float* sc = (const float*)(F.ws + WS_SCAL) + l * 4;
    const float lam = sc[0], mshift = sc[1], oml = sc[2];
    const float* subg = arg_in(19) + l * DV;
    const int G = F.G;
#ifndef ATT_XA
#define ATT_XA 1
#endif
    const bool xa = ATT_XA && (G & 7) == 0;
    const int x = F.bx & 7, j = F.bx >> 3, wpx = xa ? (G >> 3) : 1;
    const int npair = xa ? (32 - j + wpx - 1) / wpx : 0;
    const int nit = xa ? 4 * npair : (1024 - F.bx + G - 1) / G;
#pragma unroll 1
    for (int it = 0; it < nit; ++it) {
        int bh, qb;
        if (xa) { const int r = it / (2 * npair), rem = it % (2 * npair), sidx = j + (rem >> 1) * wpx; bh = 2 * x + r; qb = (rem & 1) ? sidx : 63 - sidx; }
        else { const int v = F.bx + it * G; bh = v >> 6; qb = v & 63; }
        att::attn_unit<MODE>(bh, qb, Q, K, V, MIX, subg, lam, mshift, oml, F.lds + LDS_RING, F.tid);
    }
}

__device__ __forceinline__ void router_phase(Frame& F, int l) {
    const bf16_t* h1 = (const bf16_t*)(F.ws + WS_H1); const float* g = arg_in(21) + (size_t)l * D; const float* br = arg_in(23) + l * NE;
    const bf16_t* WRT = (const bf16_t*)(F.ws + WS_WRT + l * WRT_STRIDE);
    bf16_t* XN = (bf16_t*)(F.ws + WS_XN); int* TOPI = (int*)(F.ws + WS_TOPI); float* TOPG = (float*)(F.ws + WS_TOPG); int* WGCNT = (int*)(F.ws + WS_WGCNT); float* RS = (float*)(F.ws + WS_RS);
    const int lane = F.lane, tid = F.tid, wave = F.wave, n = lane & 15, kq = lane >> 4;
    constexpr int PITCH = 2080;
    LAS unsigned char* wl = F.lds + LDS_RING;
    LAS float* lg = (LAS float*)(F.lds + LDS_RING + 2 * 32 * PITCH) + wave * (16 * 33 + 16);
    LAS int* cnt = (LAS int*)(F.ctl + 256);
    __syncthreads();
    for (int i = tid; i < 2 * NE * 128; i += NTHREADS) { const int row = i >> 7, c = i & 127; *(LAS u32x4*)(wl + row * PITCH + c * 16) = *(const u32x4*)(WRT + (size_t)row * D + c * 8); }
    if (tid < 32) cnt[tid] = 0;
    __syncthreads();
    for (int wgu = F.bx; wgu < T / 128; wgu += F.G) {
        if (wgu != F.bx) { __syncthreads(); if (tid < 32) cnt[tid] = 0; __syncthreads(); }
        const int row = wgu * 128 + wave * 16 + n;
        const bf16_t* hp = h1 + (size_t)row * D + 8 * kq; const float* gp = g + 8 * kq;
        bf16_t* xp = XN + (size_t)row * D + 8 * kq; unsigned char* xp8 = (unsigned char*)XN + (size_t)row * D + 8 * kq;
        const LAS unsigned char* bh = wl + n * PITCH + 16 * kq;
        f32x4 acc0 = (f32x4){0.f, 0.f, 0.f, 0.f}, acc1 = acc0; float ss = 0.f;
#pragma unroll 4
        for (int ks = 0; ks < 32; ++ks) {
            const u32x4 hw = *(const u32x4*)(hp + 32 * ks); const f32x4 h0 = (f32x4){bf_lo(hw.x), bf_hi(hw.x), bf_lo(hw.y), bf_hi(hw.y)}, h4 = (f32x4){bf_lo(hw.z), bf_hi(hw.z), bf_lo(hw.w), bf_hi(hw.w)};
            const f32x4 g0 = *(const f32x4*)(gp + 32 * ks), g4 = *(const f32x4*)(gp + 32 * ks + 4);
            const f32x4 x0 = h0 * g0, x4 = h4 * g4;
            ss += (x0[0] * x0[0] + x0[1] * x0[1]) + (x0[2] * x0[2] + x0[3] * x0[3]) + (x4[0] * x4[0] + x4[1] * x4[1]) + (x4[2] * x4[2] + x4[3] * x4[3]);
            u32x4 hi; hi.x = cvt_pk_bf16(x0[0], x0[1]); hi.y = cvt_pk_bf16(x0[2], x0[3]); hi.z = cvt_pk_bf16(x4[0], x4[1]); hi.w = cvt_pk_bf16(x4[2], x4[3]);
            if (UP_FP8) { u32x2 w8; w8.x = pk4_fp8(x0[0] * 8.f, x0[1] * 8.f, x0[2] * 8.f, x0[3] * 8.f); w8.y = pk4_fp8(x4[0] * 8.f, x4[1] * 8.f, x4[2] * 8.f, x4[3] * 8.f); *(u32x2*)(xp8 + 32 * ks) = w8; }
            else *(u32x4*)(xp + 32 * ks) = hi;
            u32x4 lo;
            lo.x = cvt_pk_bf16(x0[0] - bf_lo(hi.x), x0[1] - bf_hi(hi.x)); lo.y = cvt_pk_bf16(x0[2] - bf_lo(hi.y), x0[3] - bf_hi(hi.y));
            lo.z = cvt_pk_bf16(x4[0] - bf_lo(hi.z), x4[1] - bf_hi(hi.z)); lo.w = cvt_pk_bf16(x4[2] - bf_lo(hi.w), x4[3] - bf_hi(hi.w));
            const bf16x8 ah = __builtin_bit_cast(bf16x8, hi), al = __builtin_bit_cast(bf16x8, lo);
            const bf16x8 b0h = *(const LAS bf16x8*)(bh + 64 * ks), b1h = *(const LAS bf16x8*)(bh + 16 * PITCH + 64 * ks);
            const bf16x8 b0l = *(const LAS bf16x8*)(bh + 32 * PITCH + 64 * ks), b1l = *(const LAS bf16x8*)(bh + 48 * PITCH + 64 * ks);
            acc0 = __builtin_amdgcn_mfma_f32_16x16x32_bf16(ah, b0h, acc0, 0, 0, 0); acc1 = __builtin_amdgcn_mfma_f32_16x16x32_bf16(ah, b1h, acc1, 0, 0, 0);
            acc0 = __builtin_amdgcn_mfma_f32_16x16x32_bf16(al, b0h, acc0, 0, 0, 0); acc1 = __builtin_amdgcn_mfma_f32_16x16x32_bf16(al, b1h, acc1, 0, 0, 0);
            acc0 = __builtin_amdgcn_mfma_f32_16x16x32_bf16(ah, b0l, acc0, 0, 0, 0); acc1 = __builtin_amdgcn_mfma_f32_16x16x32_bf16(ah, b1l, acc1, 0, 0, 0);
        }
        ss += __shfl_xor(ss, 16); ss += __shfl_xor(ss, 32);
        const float r = rsqrtf(ss * (1.f / D) + EPS);
        if (kq == 0) { lg[16 * 33 + n] = r; RS[row] = r; }
        asm volatile("s_waitcnt lgkmcnt(0)" ::: "memory");
        const float b0 = br[n], b1 = br[16 + n];
#pragma unroll
        for (int q = 0; q < 4; ++q) { const float rt = lg[16 * 33 + 4 * kq + q]; lg[(4 * kq + q) * 33 + n] = acc0[q] * rt + b0; lg[(4 * kq + q) * 33 + 16 + n] = acc1[q] * rt + b1; }
        asm volatile("s_waitcnt lgkmcnt(0)" ::: "memory");
        if (lane < 16) {
            const int tok = wgu * 128 + wave * 16 + lane;
            float v[32];
#pragma unroll
            for (int e = 0; e < 32; ++e) v[e] = lg[lane * 33 + e];
            unsigned mask = 0u; float val[4]; int sel[4];
#pragma unroll
            for (int k = 0; k < 4; ++k) { float best = -INFINITY; int bi = 0;
#pragma unroll
                for (int e = 0; e < 32; ++e) { const bool ok = !((mask >> e) & 1u) && (v[e] > best); best = ok ? v[e] : best; bi = ok ? e : bi; }
                mask |= 1u << bi; val[k] = best; sel[k] = bi; }
            float ex[4], sum = 0.f;
#pragma unroll
            for (int k = 0; k < 4; ++k) { ex[k] = __expf(val[k] - val[0]); sum += ex[k]; }
            const float inv = 1.f / sum;
#pragma unroll
            for (int k = 0; k < 4; ++k) { const int pos = __hip_atomic_fetch_add(cnt + sel[k], 1, __ATOMIC_RELAXED, __HIP_MEMORY_SCOPE_WORKGROUP);
                TOPI[tok * 4 + k] = sel[k] | (pos << 8); TOPG[tok * 4 + k] = ex[k] * inv; }
        }
        __syncthreads();
        if (tid < 32) WGCNT[wgu * 32 + tid] = cnt[tid];
    }
    __syncthreads();
}
__device__ __forceinline__ void routing_phase(Frame& F) {
    const int* TOPI = (const int*)(F.ws + WS_TOPI); const float* TOPG = (const float*)(F.ws + WS_TOPG); const int* WGCNT = (const int*)(F.ws + WS_WGCNT);
    int* TOKROW = (int*)(F.ws + WS_TOKROW); int* ROWTOK = (int*)(F.ws + WS_ROWTOK); float* ROWGATE = (float*)(F.ws + WS_ROWGATE); int* TILEEXP = (int*)(F.ws + WS_TILEEXP);
    float* ROWSCALE = (float*)(F.ws + WS_ROWSCALE); const float* RS = (const float*)(F.ws + WS_RS);
    const int tid = F.tid;
    LAS int* tot = (LAS int*)(F.lds + LDS_RING);
    LAS int* pst = tot + 32;
    LAS int* mypre = pst + 40;
    LAS int* part = mypre + 32;
    for (int wgu = F.bx; wgu < 256; wgu += F.G) {
        __syncthreads();
        {
            const int e = tid & 31, wq = tid >> 5; int a = 0, mine = 0;
#pragma unroll
            for (int j = 0; j < 16; ++j) { const int w = wq * 16 + j; const int c = WGCNT[w * 32 + e]; a += c; if (w < wgu) mine += c; }
            part[wq * 32 + e] = a; part[512 + wq * 32 + e] = mine;
        }
        __syncthreads();
        if (tid < 32) { int a = 0, mine = 0;
#pragma unroll
            for (int q = 0; q < 16; ++q) { a += part[q * 32 + tid]; mine += part[512 + q * 32 + tid]; }
            tot[tid] = a; mypre[tid] = mine; }
        __syncthreads();
        if (tid == 0) { int a = 0; for (int e = 0; e < 32; ++e) { pst[e] = a; a += (tot[e] + 255) & ~255; } pst[32] = a; }
        __syncthreads();
        {
            const int t = wgu * 128 + (tid >> 2), k = tid & 3;
            const int w = TOPI[t * 4 + k]; const int e = w & 255, pos = w >> 8;
            const int dest = pst[e] + mypre[e] + pos;
            ROWTOK[dest] = t; ROWGATE[dest] = TOPG[t * 4 + k]; ROWSCALE[dest] = RS[t]; TOKROW[t * 4 + k] = dest;
        }
        if (wgu < 32) {
            const int e = wgu; const int beg = pst[e] + tot[e], end = pst[e + 1];
            for (int r = beg + tid; r < end; r += NTHREADS) { ROWTOK[r] = 0; ROWGATE[r] = 0.f; ROWSCALE[r] = 0.f; }
        }
        if (wgu == 0) {
            const int ntiles = pst[32] >> 8;
            for (int pm = tid; pm < ntiles; pm += NTHREADS) { int e = 0; for (int q = 1; q < 32; ++q) if ((pm << 8) >= pst[q]) e = q; TILEEXP[pm] = e; }
            if (tid == 0) TILEEXP[1023] = ntiles;
            if (tid < 33) TILEEXP[768 + tid] = pst[tid];
        }
    }
    __syncthreads();
}
struct CRow { u32x4 h[2]; u32x2 y[4][2]; };
__device__ __forceinline__ void crow_load(CRow& r, const bf16_t* H1, const unsigned char* YB, const int* TOKROW, int m, int lane) {
    const bf16_t* hr = H1 + (size_t)m * D + 8 * lane;
    r.h[0] = *(const u32x4*)(hr); r.h[1] = *(const u32x4*)(hr + 512);
    const int4 tr = *(const int4*)(TOKROW + m * 4);
    const int rows[4] = {tr.x, tr.y, tr.z, tr.w};
#pragma unroll
    for (int k = 0; k < 4; ++k) { const unsigned char* yr = YB + (size_t)rows[k] * D + 8 * lane; r.y[k][0] = *(const u32x2*)(yr); r.y[k][1] = *(const u32x2*)(yr + 512); }
}
__device__ __forceinline__ void crow_finish(CRow& r, float* out32, bf16_t* H2, bf16_t* XN, const float* gnext, int m, int lane) {
    f32x4 v[4];
#pragma unroll
    for (int hf = 0; hf < 2; ++hf) { const u32x4 w = r.h[hf]; v[2 * hf] = (f32x4){bf_lo(w.x), bf_hi(w.x), bf_lo(w.y), bf_hi(w.y)}; v[2 * hf + 1] = (f32x4){bf_lo(w.z), bf_hi(w.z), bf_lo(w.w), bf_hi(w.w)}; }
#pragma unroll
    for (int k = 0; k < 4; ++k)
#pragma unroll
        for (int hf = 0; hf < 2; ++hf) { fp8x4_add(r.y[k][hf].x, 1.f / 16.f, v[2 * hf]); fp8x4_add(r.y[k][hf].y, 1.f / 16.f, v[2 * hf + 1]); }
    if (out32) { float* orow = out32 + (size_t)m * D + 8 * lane; *(f32x4*)(orow) = v[0]; *(f32x4*)(orow + 4) = v[1]; *(f32x4*)(orow + 512) = v[2]; *(f32x4*)(orow + 516) = v[3]; }
    else {
        u32x4 w; w.x = cvt_pk_bf16(v[0][0], v[0][1]); w.y = cvt_pk_bf16(v[0][2], v[0][3]); w.z = cvt_pk_bf16(v[1][0], v[1][1]); w.w = cvt_pk_bf16(v[1][2], v[1][3]);
        *(u32x4*)(H2 + (size_t)m * D + 8 * lane) = w;
        w.x = cvt_pk_bf16(v[2][0], v[2][1]); w.y = cvt_pk_bf16(v[2][2], v[2][3]); w.z = cvt_pk_bf16(v[3][0], v[3][1]); w.w = cvt_pk_bf16(v[3][2], v[3][3]);
        *(u32x4*)(H2 + (size_t)m * D + 512 + 8 * lane) = w;
    }
    if (gnext) {
        float s = 0.f;
#pragma unroll
        for (int j = 0; j < 4; ++j) s += (v[j][0] * v[j][0] + v[j][1] * v[j][1]) + (v[j][2] * v[j][2] + v[j][3] * v[j][3]);
        const float rr = rsqrtf(wave_sum(s) * (1.f / D) + EPS);
        const float* gp = gnext + 8 * lane;
        const f32x4 a0 = v[0] * *(const f32x4*)(gp) * rr, a1 = v[1] * *(const f32x4*)(gp + 4) * rr, a2 = v[2] * *(const f32x4*)(gp + 512) * rr, a3 = v[3] * *(const f32x4*)(gp + 516) * rr;
        if (IN_FP8) { unsigned char* x8 = (unsigned char*)XN + (size_t)m * D + 8 * lane;
            u32x2 w8; w8.x = pk4_fp8(a0[0] * 16.f, a0[1] * 16.f, a0[2] * 16.f, a0[3] * 16.f); w8.y = pk4_fp8(a1[0] * 16.f, a1[1] * 16.f, a1[2] * 16.f, a1[3] * 16.f); *(u32x2*)(x8) = w8;
            w8.x = pk4_fp8(a2[0] * 16.f, a2[1] * 16.f, a2[2] * 16.f, a2[3] * 16.f); w8.y = pk4_fp8(a3[0] * 16.f, a3[1] * 16.f, a3[2] * 16.f, a3[3] * 16.f); *(u32x2*)(x8 + 512) = w8; }
        else {
        u32x4 w; w.x = cvt_pk_bf16(a0[0], a0[1]); w.y = cvt_pk_bf16(a0[2], a0[3]); w.z = cvt_pk_bf16(a1[0], a1[1]); w.w = cvt_pk_bf16(a1[2], a1[3]);
        *(u32x4*)(XN + (size_t)m * D + 8 * lane) = w;
        w.x = cvt_pk_bf16(a2[0], a2[1]); w.y = cvt_pk_bf16(a2[2], a2[3]); w.z = cvt_pk_bf16(a3[0], a3[1]); w.w = cvt_pk_bf16(a3[2], a3[3]);
        *(u32x4*)(XN + (size_t)m * D + 512 + 8 * lane) = w; }
    }
}
__device__ __forceinline__ void combine_phase(Frame& F, const float* gnext, float* out32) {
    const unsigned char* YB = (const unsigned char*)(F.ws + WS_YB); const int* TOKROW = (const int*)(F.ws + WS_TOKROW); bf16_t* XN = (bf16_t*)(F.ws + WS_XN);
    const bf16_t* H1 = (const bf16_t*)(F.ws + WS_H1); bf16_t* H2 = (bf16_t*)(F.ws + WS_H2);
    const int lane = F.lane, NGW = F.G * NWAVES;
    CRow ra, rb;
    int m = F.bx * NWAVES + F.wave;
    if (m < T) crow_load(ra, H1, YB, TOKROW, m, lane);
    while (m < T) {
        const int mb = m + NGW;
        if (mb < T) crow_load(rb, H1, YB, TOKROW, mb, lane);
        crow_finish(ra, out32, H2, XN, gnext, m, lane);
        if (mb >= T) break;
        const int mc = mb + NGW;
        if (mc < T) crow_load(ra, H1, YB, TOKROW, mc, lane);
        crow_finish(rb, out32, H2, XN, gnext, mb, lane);
        m = mc;
    }
}

constexpr int NPH_LAYER = 10, NPH = 1 + DEPTH * NPH_LAYER;
__global__ void __launch_bounds__(NTHREADS, 2) mk_fwd(Args args) {
    extern __shared__ __attribute__((aligned(16))) unsigned char lds_raw[];
    Frame F;
    F.lds = (LAS unsigned char*)lds_raw; F.ctl = F.lds + LDS_CTL; F.ws = args.ws; F.ws0 = args.ws; F.out0 = args.out; F.ap = &args; F.z = 0;
    F.tid = threadIdx.x; F.lane = F.tid & 63; F.wave = __builtin_amdgcn_readfirstlane(F.tid >> 6); F.G = gridDim.x; F.bx = blockIdx.x;
    F.out = args.out;
    for (int u = F.tid; u < 1024; u += NTHREADS) ((LAS unsigned*)F.ctl)[u] = 0u;
    __syncthreads();
    XcdBarrier bar = xcd_barrier_post((unsigned*)(F.ws + WS_CTL) + CW_BAR, (volatile LAS unsigned*)F.ctl);
    const int lo = args.ph_lo, hi = args.ph_hi;
#ifndef PHMASK
#define PHMASK 0x1fff
#endif
#define RUN(k) (lo <= (k) && (k) < hi)
#define EN(b) ((PHMASK >> (b)) & 1)
#ifndef DUPMASK
#define DUPMASK 0
#endif
#ifndef ATT_PROBE_MODE
#define ATT_PROBE_MODE 0
#endif
#ifndef PRO_PROBE_MODE
#define PRO_PROBE_MODE 0
#endif
#define NREP(b) (((DUPMASK >> (b)) & 1) ? 2 : 1)
#define SEAM(k) do { if (RUN((k) + 1)) xcd_barrier(bar); } while (0)
    if (EN(10) && RUN(0)) { { if (NREP(10) == 2) { phase_begin(F); p0_prologue<PRO_PROBE_MODE>(F); xcd_barrier(bar); } phase_begin(F); p0_prologue<0>(F); } SEAM(0); }
    for (int l = 0; l < DEPTH; ++l) {
        const int pb = 1 + l * NPH_LAYER;
#ifdef EXTRA_BARRIERS
        for (int eb = 0; eb < EXTRA_BARRIERS; ++eb) xcd_barrier(bar);
#endif
        if (EN(0) && RUN(pb + 0)) { for (int rep = 0; rep < NREP(0); ++rep) { phase_begin(F); unsigned char* ws = F.ws; (void)ws;
            PInProj P; P.so.init(T, DIN, F.G, F.bx); P.A = (const char*)(ws + WS_XN); P.B = (const char*)(ws + WS_WIN + l * WIN_STRIDE);
            P.UQKV = (bf16_t*)(ws + WS_U); P.GQK = (const float*)(ws + WS_SCAL) + 64 + l * 128; P.COS = (const float*)(ws + WS_COS); P.SIN = (const float*)(ws + WS_SIN);
            pg8::gemm_phase(F.lds + LDS_RING, F.ctl, P, F.tid);  if (rep + 1 < NREP(0)) xcd_barrier(bar); } SEAM(pb + 0);
        }
        if (EN(1) && RUN(pb + 1)) { for (int rep = 0; rep < NREP(1); ++rep) { phase_begin(F); unsigned char* ws = F.ws; (void)ws; s5a_phase(F, l);  if (rep + 1 < NREP(1)) xcd_barrier(bar); } SEAM(pb + 1); }
        if (EN(2) && RUN(pb + 2)) { for (int rep = 0; rep < NREP(2); ++rep) { phase_begin(F); unsigned char* ws = F.ws; (void)ws; if (EN(11)) for (int r2 = 0; r2 < NREP(11); ++r2) { phase_begin(F); s5c_phase(F, l); } if (EN(12)) { if (NREP(12) == 2) { phase_begin(F); attn_phase<ATT_PROBE_MODE>(F, l); } phase_begin(F); attn_phase<0>(F, l); }  if (rep + 1 < NREP(2)) xcd_barrier(bar); } SEAM(pb + 2); }
        if (EN(3) && RUN(pb + 3)) { for (int rep = 0; rep < NREP(3); ++rep) { phase_begin(F); unsigned char* ws = F.ws; (void)ws;
            PGlu P; P.so.init(T, DS, F.G, F.bx); P.A = (const char*)(ws + WS_YG); P.B = (const char*)(ws + WS_WGLU + l * WGLU_STRIDE);
            P.YG = (const bf16_t*)(ws + WS_YG); P.MIX = (bf16_t*)(ws + WS_MIX); P.RSP = (float*)(ws + WS_RSP);
            pg8::gemm_phase(F.lds + LDS_RING, F.ctl, P, F.tid);  if (rep + 1 < NREP(3)) xcd_barrier(bar); } SEAM(pb + 3);
        }
        if (EN(4) && RUN(pb + 4)) { for (int rep = 0; rep < NREP(4); ++rep) { phase_begin(F); unsigned char* ws = F.ws; (void)ws;
            POut P; P.so.init(T, D, F.G, F.bx); P.A = (const char*)(ws + WS_MIX); P.B = (const char*)(ws + WS_WOUT + l * WOUT_STRIDE);
            P.RSP = (const float*)(ws + WS_RSP); P.base32 = (l == 0) ? arg_in(0) : nullptr; P.base16 = (const bf16_t*)(ws + WS_H2); P.H1 = (bf16_t*)(ws + WS_H1);
            pg8::gemm_phase(F.lds + LDS_RING, F.ctl, P, F.tid);  if (rep + 1 < NREP(4)) xcd_barrier(bar); } SEAM(pb + 4);
        }
        if (EN(5) && RUN(pb + 5)) { for (int rep = 0; rep < NREP(5); ++rep) { phase_begin(F); unsigned char* ws = F.ws; (void)ws; router_phase(F, l);  if (rep + 1 < NREP(5)) xcd_barrier(bar); } SEAM(pb + 5); }
        if (EN(6) && RUN(pb + 6)) { for (int rep = 0; rep < NREP(6); ++rep) { phase_begin(F); unsigned char* ws = F.ws; (void)ws; routing_phase(F);  if (rep + 1 < NREP(6)) xcd_barrier(bar); } SEAM(pb + 6); }
        if (EN(7) && RUN(pb + 7)) { for (int rep = 0; rep < NREP(7); ++rep) { phase_begin(F); unsigned char* ws = F.ws; (void)ws;
            PUp P; P.mo.init(F.G, F.bx, (const int*)(ws + WS_TILEEXP) + 768);
            P.A = (const char*)(ws + WS_XN); P.B = (const char*)(ws + WS_WUP + l * WUP_STRIDE); P.ROWTOK = (const int*)(ws + WS_ROWTOK); P.TILEEXP = (const int*)(ws + WS_TILEEXP);
            P.bup = arg_in(25) + (size_t)l * NE * 2048; P.ROWSCALE = (const float*)(ws + WS_ROWSCALE); P.ACT = (bf16_t*)(ws + WS_ACT);
            { LAS int* tl = (LAS int*)(F.lds + LDS_RING + 131072); for (int i = F.tid; i < 640; i += NTHREADS) tl[i] = P.TILEEXP[i]; __syncthreads(); P.tl = tl; }
            if (GEMM_PROBE && rep + 1 < NREP(7)) { PUpNoDma Q; (PUp&)Q = P; pg8::gemm_phase(F.lds + LDS_RING, F.ctl, Q, F.tid); } else pg8::gemm_phase(F.lds + LDS_RING, F.ctl, P, F.tid);  if (rep + 1 < NREP(7)) xcd_barrier(bar); } SEAM(pb + 7);
        }
        if (EN(8) && RUN(pb + 8)) { for (int rep = 0; rep < NREP(8); ++rep) { phase_begin(F); unsigned char* ws = F.ws; (void)ws;
            PDown P; P.mo.init(F.G, F.bx, (const int*)(ws + WS_TILEEXP) + 768);
            P.A = (const char*)(ws + WS_ACT); P.B = (const char*)(ws + WS_WDN + l * WDN_STRIDE); P.TILEEXP = (const int*)(ws + WS_TILEEXP);
            P.bdn = arg_in(27) + (size_t)l * NE * 1024; P.ROWGATE = (const float*)(ws + WS_ROWGATE); P.YB = (bf16_t*)(ws + WS_YB);
            { LAS int* tl = (LAS int*)(F.lds + LDS_RING + 131072); for (int i = F.tid; i < 640; i += NTHREADS) tl[i] = P.TILEEXP[i]; __syncthreads(); P.tl = tl; }
            pg8::gemm_phase(F.lds + LDS_RING, F.ctl, P, F.tid);  if (rep + 1 < NREP(8)) xcd_barrier(bar); } SEAM(pb + 8);
        }
        if (EN(9) && RUN(pb + 9)) { for (int rep = 0; rep < NREP(9); ++rep) { phase_begin(F); unsigned char* ws = F.ws; (void)ws; combine_phase(F, (l + 1 < DEPTH) ? arg_in(1) + (size_t)(l + 1) * D : nullptr, (l + 1 < DEPTH) ? nullptr : F.out);  if (rep + 1 < NREP(9)) xcd_barrier(bar); } SEAM(pb + 9); }
    }
#undef RUN
#undef SEAM
}

extern "C" void kernel_launch(void* const* d_in, const int* in_sizes, int n_in, void* d_out, int out_size, void* d_ws, size_t ws_size, hipStream_t stream) {
    static int grid = 0;
    if (grid == 0) {
        if (n_in != 28 || out_size != T * D || ws_size < WS_END) { fprintf(stderr, "kernel_launch: unexpected shapes (n_in %d out %d ws %zu)\n", n_in, out_size, ws_size); grid = -1; return; }
        int dev = 0, cus = 0;
        if (hipGetDevice(&dev) != hipSuccess || hipDeviceGetAttribute(&cus, hipDeviceAttributeMultiprocessorCount, dev) != hipSuccess) { grid = -1; return; }
        if (hipFuncSetAttribute((const void*)mk_fwd, hipFuncAttributeMaxDynamicSharedMemorySize, LDS_BYTES) != hipSuccess) { fprintf(stderr, "kernel_launch: hipFuncSetAttribute failed\n"); grid = -1; return; }
        int per_cu = 0;
        if (hipOccupancyMaxActiveBlocksPerMultiprocessor(&per_cu, (const void*)mk_fwd, NTHREADS, LDS_BYTES) != hipSuccess || per_cu < 1) { fprintf(stderr, "kernel_launch: occupancy query says %d\n", per_cu); }
        (void)hipGetLastError();
        grid = cus;
    }
    if (grid < 0) return;
    if (hipMemsetAsync((char*)d_ws + WS_CTL, 0, CTL_ZERO_BYTES, stream) != hipSuccess) return;
    Args a{};
    for (int i = 0; i < 28; ++i) a.in[i] = (const float*)d_in[i];
    a.out = (float*)d_out; a.ws = (unsigned char*)d_ws; a.ph_lo = 0; a.ph_hi = NPH;
    hipLaunchKernelGGL(mk_fwd, dim3(grid), dim3(NTHREADS), LDS_BYTES, stream, a);
}
```

```cpp
#include <hip/hip_runtime.h>
#include <cstdio>
#include <cstdint>
#include <math.h>

#ifndef GEMM_PROBE
#define GEMM_PROBE 0
#endif
#ifndef GEMM_PROBE_KIND
#define GEMM_PROBE_KIND 1
#endif
#ifndef PRO_ODD_SHARE
#define PRO_ODD_SHARE 38
#endif
#ifndef IN_FP8
#define IN_FP8 0
#endif
#ifndef MOE_BNT
#define MOE_BNT 0
#endif
#ifndef UP_FP8
#define UP_FP8 1
#endif
#ifndef DN_FP8
#define DN_FP8 1
#endif
#define LAS __attribute__((address_space(3)))
#define GAS __attribute__((address_space(1)))
typedef unsigned short bf16_t;
typedef short bf16x8 __attribute__((ext_vector_type(8)));
typedef short s16x4 __attribute__((ext_vector_type(4)));
typedef float f32x4 __attribute__((ext_vector_type(4)));
typedef float f32x2 __attribute__((ext_vector_type(2)));
typedef float f32x16 __attribute__((ext_vector_type(16)));
typedef unsigned u32x4 __attribute__((ext_vector_type(4)));
typedef unsigned u32x2 __attribute__((ext_vector_type(2)));
typedef int v8i32 __attribute__((ext_vector_type(8)));

constexpr int D = 1024, BATCH = 4, SEQ = 8192, DEPTH = 2, T = BATCH * SEQ;
constexpr int DS = 512, NG = 32, HS = 16, NP = 64, DA = 512, NH = 4, DV = 128, DIN = 2048;
constexpr int NE = 32, DFF = 1024, NASSIGN = T * 4;
constexpr int MPAD_MAX = NASSIGN + NE * 256, NTILE_MAX = MPAD_MAX / 256;
constexpr int NCHUNK = T / 64, CPB = SEQ / 64;
constexpr float EPS = 1e-6f;
constexpr float C2 = 0.125f * 1.4426950408889634f;
constexpr int NWAVES = 8, NTHREADS = 512;

constexpr size_t MiB = 1u << 20;
constexpr size_t WS_CTL = 0, CTL_ZERO_BYTES = 1 * MiB;
constexpr size_t WS_COS = 1 * MiB, WS_SIN = 2 * MiB;
constexpr size_t WS_SCAL = 3 * MiB;
constexpr size_t WS_KT = 4 * MiB, KT_STRIDE = 2 * MiB;
constexpr size_t WS_LAML = 8 * MiB, LAML_STRIDE = 32768;
constexpr size_t WS_WRT = 9 * MiB, WRT_STRIDE = 131072;
constexpr size_t WS_RS = 10 * MiB;
constexpr size_t WS_GT = 16 * MiB, GT_STRIDE = 8 * MiB;
constexpr size_t WS_HT = 32 * MiB, HT_STRIDE = 8 * MiB;
constexpr size_t WS_WIN = 48 * MiB, WIN_STRIDE = 4 * MiB;
constexpr size_t WS_WGLU = 56 * MiB, WGLU_STRIDE = MiB / 2;
constexpr size_t WS_WOUT = 58 * MiB, WOUT_STRIDE = 2 * MiB;
constexpr size_t WS_WUP = 64 * MiB, WUP_STRIDE = 128 * MiB;
constexpr size_t WS_WDN = 320 * MiB, WDN_STRIDE = 64 * MiB;
constexpr size_t WS_XN = 448 * MiB;
constexpr size_t WS_U = 512 * MiB, WS_Q = 544 * MiB, WS_K = 576 * MiB, WS_V = 608 * MiB;
constexpr size_t WS_YG = 640 * MiB;
constexpr size_t WS_MIX = 672 * MiB;
constexpr size_t WS_S = 736 * MiB;
constexpr size_t WS_RSP = 744 * MiB;
constexpr size_t WS_TOPI = 746 * MiB, WS_TOPG = 747 * MiB, WS_TOKROW = 748 * MiB, WS_WGCNT = 749 * MiB;
constexpr size_t WS_ROWTOK = 750 * MiB, WS_ROWGATE = 751 * MiB, WS_TILEEXP = 752 * MiB, WS_ROWSCALE = 753 * MiB;
constexpr size_t WS_ACT = 768 * MiB, WS_YB = 1040 * MiB, WS_H1 = 1180 * MiB, WS_H2 = 1244 * MiB, WS_END = 1312 * MiB;
constexpr int CW_BAR = 4096;

constexpr int LDS_CTL = 0;
constexpr int LDS_RING = 4096;
constexpr int LDS_BYTES = 163840;

__device__ __forceinline__ unsigned f2bf(float f) { unsigned u = __builtin_bit_cast(unsigned, f); return (u + 0x7fffu + ((u >> 16) & 1u)) >> 16; }
__device__ __forceinline__ unsigned pk2(float lo, float hi) { return f2bf(lo) | (f2bf(hi) << 16); }
__device__ __forceinline__ unsigned cvt_pk_bf16(float lo, float hi) { unsigned r; asm volatile("v_cvt_pk_bf16_f32 %0, %1, %2" : "=v"(r) : "v"(lo), "v"(hi)); return r; }
__device__ __forceinline__ unsigned pk4_fp8(float a, float b, float c, float d) { int w = __builtin_bit_cast(int, a);
    w = __builtin_amdgcn_cvt_pk_fp8_f32(a, b, w, false); w = __builtin_amdgcn_cvt_pk_fp8_f32(c, d, w, true); return (unsigned)w; }
__device__ __forceinline__ void fp8x4_add(unsigned w, float sc, f32x4& a) { const f32x2 lo = __builtin_amdgcn_cvt_pk_f32_fp8((int)w, false), hi = __builtin_amdgcn_cvt_pk_f32_fp8((int)w, true); a[0] += lo[0] * sc; a[1] += lo[1] * sc; a[2] += hi[0] * sc; a[3] += hi[1] * sc; }
__device__ __forceinline__ float bf_lo(unsigned w) { return __builtin_bit_cast(float, w << 16); }
__device__ __forceinline__ float bf_hi(unsigned w) { return __builtin_bit_cast(float, w & 0xffff0000u); }
__device__ __forceinline__ float sum_x16_x32(float v) {
    { auto r = __builtin_amdgcn_permlane16_swap(__float_as_uint(v), __float_as_uint(v), false, false); v = __uint_as_float(r[0]) + __uint_as_float(r[1]); }
    { auto r = __builtin_amdgcn_permlane32_swap(__float_as_uint(v), __float_as_uint(v), false, false); v = __uint_as_float(r[0]) + __uint_as_float(r[1]); }
    return v;
}
__device__ __forceinline__ float wave_sum(float v) {
#pragma unroll
    for (int o = 1; o < 64; o <<= 1) v += __shfl_xor(v, o);
    return v;
}
__device__ __forceinline__ float gelu_tanh(float x) {
    const float z = 0.7978845608028654f * (x + 0.044715f * x * x * x);
    return x * __builtin_amdgcn_rcpf(1.f + __builtin_amdgcn_exp2f(-2.885390082f * z));
}
__device__ __forceinline__ float sigmoidf(float v) { return __builtin_amdgcn_rcpf(1.f + __builtin_amdgcn_exp2f(-1.4426950409f * v)); }

#define XB_TMO      128
#define XB_XCNT(j)  (256  + 64 * (j))
#define XB_XSUB(j)  (1280 + 64 * (j))
#define XB_XGEN(j)  (2304 + 64 * (j))
#define XB_TOP      3328
#define XB_TOPGEN   3392
#define XCD_BAR_WORDS 3456
#define XB_SPIN_CAP (1u << 18)
__device__ __forceinline__ unsigned xb_ld(unsigned* p)              { return __hip_atomic_load(p, __ATOMIC_RELAXED, __HIP_MEMORY_SCOPE_AGENT); }
__device__ __forceinline__ unsigned xb_add(unsigned* p, unsigned v) { return __hip_atomic_fetch_add(p, v, __ATOMIC_RELAXED, __HIP_MEMORY_SCOPE_AGENT); }
__device__ __forceinline__ unsigned xb_xcc_id() { return (unsigned)__builtin_amdgcn_s_getreg((3 << 11) | 20) & 0xFu; }
#define XB_SPIN(cond, bar) do { unsigned _sp = 0; while (cond) { __builtin_amdgcn_s_sleep(1); \
    if ((++_sp & 255u) == 0u) { if (xb_ld(&(bar)[XB_TMO])) break; if (_sp > XB_SPIN_CAP) { atomicAdd(&(bar)[XB_TMO], 1u); break; } } } } while (0)
struct XcdBarrier { unsigned* bar; unsigned x; volatile LAS unsigned* st; };
__device__ __forceinline__ XcdBarrier xcd_barrier_post(unsigned* bar, volatile LAS unsigned* st) {
    XcdBarrier b; b.bar = bar; b.x = xb_xcc_id(); b.st = st;
    if (threadIdx.x == 0) (void)xb_add(&bar[XB_XCNT(b.x)], 1u);
    return b;
}
__device__ __forceinline__ void xcd_barrier_complete(unsigned* bar, unsigned x, unsigned& nloc, unsigned& nx) {
    const unsigned G = gridDim.x * gridDim.y * gridDim.z;
    unsigned sum, cnt, mine, sp = 0u;
    for (;;) {
        sum = 0u; cnt = 0u; mine = 0u;
#pragma unroll
        for (unsigned j = 0; j < 16; ++j) { const unsigned c = xb_ld(&bar[XB_XCNT(j)]); sum += c; cnt += (c > 0u) ? 1u : 0u; mine = (j == x) ? c : mine; }
        if (sum == G) break;
        __builtin_amdgcn_s_sleep(1);
        if ((++sp & 255u) == 0u) { if (xb_ld(&bar[XB_TMO])) break; if (sp > XB_SPIN_CAP) { atomicAdd(&bar[XB_TMO], 1u); break; } }
    }
    nloc = mine > 0u ? mine : 1u; nx = cnt > 0u ? cnt : 1u;
}
__device__ __forceinline__ void xcd_barrier(const XcdBarrier& b) {
    asm volatile("s_waitcnt vmcnt(0)" ::: "memory");
    __syncthreads();
    if (threadIdx.x == 0) {
        unsigned* bar = b.bar;
        __builtin_amdgcn_s_waitcnt(0);
        unsigned nloc = b.st[0], nx = b.st[1];
        if (nloc == 0u) { xcd_barrier_complete(bar, b.x, nloc, nx); b.st[0] = nloc; b.st[1] = nx; }
        const unsigned old = xb_add(&bar[XB_XSUB(b.x)], 1u);
        const unsigned gen = old / nloc;
        if (old + 1u == (gen + 1u) * nloc) {
            __builtin_amdgcn_fence(__ATOMIC_RELEASE, "agent");
            asm volatile("s_waitcnt vmcnt(0)" ::: "memory");
            const unsigned og = xb_add(&bar[XB_TOP], 1u);
            const unsigned tg = og / nx;
            if (og + 1u == (tg + 1u) * nx) xb_add(&bar[XB_TOPGEN], 1u);
            else XB_SPIN(xb_ld(&bar[XB_TOPGEN]) == tg, bar);
            __builtin_amdgcn_fence(__ATOMIC_ACQUIRE, "agent");
            xb_add(&bar[XB_XGEN(b.x)], 1u);
            asm volatile("s_waitcnt vmcnt(0)" ::: "memory");
        } else {
            XB_SPIN(xb_ld(&bar[XB_XGEN(b.x)]) == gen, bar);
            __builtin_amdgcn_fence(__ATOMIC_ACQUIRE, "agent");
            asm volatile("s_waitcnt vmcnt(0)" ::: "memory");
        }
    }
    __syncthreads();
}

namespace pg8 {
constexpr int BM = 256, BK = 64, HALF = 128, HTB = HALF * BK * 2, STAGE_BYTES = 8 * HTB;
__host__ __device__ __forceinline__ int lds_byte(int r, int c) { const int st = (r >> 4) * 2 + (c >> 5), rr = r & 15, cc = c & 31, ob = rr * 64 + cc * 2; return st * 1024 + (ob ^ (((ob >> 9) & 1) << 5)); }
__host__ __device__ __forceinline__ void stage_rc(int b, int& R, int& C) { const int st = b / 1024, sb = b % 1024, swz = sb ^ (((sb >> 9) & 1) << 5); R = (st >> 1) * 16 + swz / 64; C = (st & 1) * 32 + (swz % 64) / 2; }
__host__ __device__ __forceinline__ int perm32(int rho) { const int n = rho >> 4, i = rho & 15; return 8 * (i >> 2) + 4 * n + (i & 3); }
__host__ __device__ __forceinline__ int perm16x(int rho) { const int n = rho >> 4, i = rho & 15; return 16 * (i >> 2) + 4 * n + (i & 3); }

struct Unit { int pm, pn; };
template <class P>
__device__ __forceinline__ void gemm_phase(LAS unsigned char* lds, LAS unsigned char* ldsctl, P& S, const int tid) {
    const int wid = __builtin_amdgcn_readfirstlane(tid >> 6), lane = tid & 63, wr = wid >> 2, wc = wid & 3, fr = lane & 15, fq = lane >> 4;
    constexpr bool F8 = P::FP8;
    constexpr int K = P::K, ES = F8 ? 1 : 2, nt = K * ES / 128;
    int R0, C0, R1, C1; stage_rc(tid * 16, R0, C0); stage_rc(tid * 16 + 8192, R1, C1);
    unsigned voffB[2];
    {
        const int Rb0 = P::BROW64 == 2 ? (64 * (R0 >> 5) + perm16x(R0 & 31)) : P::BROW64 ? (64 * (R0 >> 5) + perm32(R0 & 31)) : ((R0 & ~31) + perm32(R0 & 31));
        const int Rb1 = P::BROW64 == 2 ? (64 * (R1 >> 5) + perm16x(R1 & 31)) : P::BROW64 ? (64 * (R1 >> 5) + perm32(R1 & 31)) : ((R1 & ~31) + perm32(R1 & 31));
        voffB[0] = (unsigned)(Rb0 * K * ES + 2 * C0); voffB[1] = (unsigned)(Rb1 * K * ES + 2 * C1);
    }
    const unsigned ldsw = (unsigned)wid * 1024u;
    const int scl8 = P::SCALE_AB;
    const int aoff = lds_byte(wr * 64 + fr, fq * 8), boff = lds_byte(wc * 32 + fr, fq * 8);
#define PG8_SA(b, h) (((b) * 2 + (h)) * HTB)
#define PG8_SB(b, h) ((4 + (b) * 2 + (h)) * HTB)
    const unsigned ldsbase = (unsigned)__builtin_amdgcn_readfirstlane((int)(unsigned)(uintptr_t)lds + (int)ldsw);
#define PG8_GLDS(sbase, voff, ldsdst) do { if (P::NODMA) break; unsigned _keep; asm volatile("s_mov_b32 %0, m0\n\ts_mov_b32 m0, %3\n\ts_nop 0\n\tglobal_load_lds_dwordx4 %2, %1\n\ts_mov_b32 m0, %0" \
        : "=&s"(_keep) : "s"(sbase), "v"(voff), "s"(ldsdst) : "memory"); } while (0)
#define PG8_STAGE_A(bufoff, vo, h, kofs) do { _Pragma("unroll") for (int _i = 0; _i < 2; ++_i) \
        PG8_GLDS(Abase, (vo)[P::GATHER ? (h) : 0][_i] + ((kofs) + (P::GATHER ? 0u : (unsigned)(h) * HSTEPA)), ldsbase + (unsigned)((bufoff) + _i * 8192)); } while (0)
#define PG8_GLDS_NT(sbase, voff, ldsdst) do { if (P::NODMA) break; unsigned _keep; asm volatile("s_mov_b32 %0, m0\n\ts_mov_b32 m0, %3\n\ts_nop 0\n\tglobal_load_lds_dwordx4 %2, %1 nt\n\ts_mov_b32 m0, %0" \
        : "=&s"(_keep) : "s"(sbase), "v"(voff), "s"(ldsdst) : "memory"); } while (0)
#define PG8_STAGE_B(bufoff, gbase) do { _Pragma("unroll") for (int _i = 0; _i < 2; ++_i) { \
        if (P::BNT) PG8_GLDS_NT((const char*)(gbase), voffB[_i], ldsbase + (unsigned)((bufoff) + _i * 8192)); else PG8_GLDS((const char*)(gbase), voffB[_i], ldsbase + (unsigned)((bufoff) + _i * 8192)); } } while (0)
#define PG8_LDA(dst, b, h) do { if constexpr (F8) { _Pragma("unroll") for (int m = 0; m < 4; ++m) { const u32x4 _l = *(const LAS u32x4*)(lds + PG8_SA(b, h) + aoff + m * 2048), _h = *(const LAS u32x4*)(lds + PG8_SA(b, h) + aoff + m * 2048 + 1024); dst##8[m] = __builtin_bit_cast(v8i32, __builtin_shufflevector(_l, _h, 0, 1, 2, 3, 4, 5, 6, 7)); } } \
        else { _Pragma("unroll") for (int m = 0; m < 4; ++m) _Pragma("unroll") for (int k = 0; k < 2; ++k) dst[m][k] = *(const LAS bf16x8*)(lds + PG8_SA(b, h) + aoff + m * 2048 + k * 1024); } } while (0)
#define PG8_LDB(dst, b, h) do { if constexpr (F8) { _Pragma("unroll") for (int n = 0; n < 2; ++n) { const u32x4 _l = *(const LAS u32x4*)(lds + PG8_SB(b, h) + boff + n * 2048), _h = *(const LAS u32x4*)(lds + PG8_SB(b, h) + boff + n * 2048 + 1024); dst##8[n] = __builtin_bit_cast(v8i32, __builtin_shufflevector(_l, _h, 0, 1, 2, 3, 4, 5, 6, 7)); } } \
        else { _Pragma("unroll") for (int n = 0; n < 2; ++n) _Pragma("unroll") for (int k = 0; k < 2; ++k) dst[n][k] = *(const LAS bf16x8*)(lds + PG8_SB(b, h) + boff + n * 2048 + k * 1024); } } while (0)
#define PG8_MMA(ai, bj, At, Bt) do { __builtin_amdgcn_s_setprio(1); \
        if constexpr (F8) { _Pragma("unroll") for (int m = 0; m < 4; ++m) _Pragma("unroll") for (int n = 0; n < 2; ++n) \
            asm volatile("v_mfma_scale_f32_16x16x128_f8f6f4 %0, %1, %2, %0, %3, %3 op_sel:[0,1,0] op_sel_hi:[0,0,0]" : "+v"(acc[ai][bj][m][n]) : "v"(Bt##8[n]), "v"(At##8[m]), "v"(scl8)); } \
        else { _Pragma("unroll") for (int m = 0; m < 4; ++m) _Pragma("unroll") for (int n = 0; n < 2; ++n) _Pragma("unroll") for (int k = 0; k < 2; ++k) \
            acc[ai][bj][m][n] = __builtin_amdgcn_mfma_f32_16x16x32_bf16(Bt[n][k], At[m][k], acc[ai][bj][m][n], 0, 0, 0); } \
        __builtin_amdgcn_s_setprio(0); } while (0)
#define PG8_WAIT_V(n) asm volatile("s_waitcnt vmcnt(" #n ")" ::: "memory")
#define PG8_WAIT_L(n) asm volatile("s_waitcnt lgkmcnt(" #n ")" ::: "memory")
#define PG8_BAR __builtin_amdgcn_s_barrier()
#define PG8_SCHED __builtin_amdgcn_sched_barrier(0)
    Unit cur, nxt; int ui = 0;
    if (!S.next(0, cur)) return;
    f32x4 acc[2][2][4][2];
#pragma unroll
    for (int a = 0; a < 2; ++a)
#pragma unroll
        for (int b = 0; b < 2; ++b)
#pragma unroll
            for (int m = 0; m < 4; ++m)
#pragma unroll
                for (int n = 0; n < 2; ++n) acc[a][b][m][n] = (f32x4){0.f, 0.f, 0.f, 0.f};
    bf16x8 At[4][2], B0[2][2], B1[2][2]; v8i32 At8[4], B08[2], B18[2];
    const char* const Abase = S.a_base();
    unsigned voffA[2][2], voffAn[2][2];
    const char *cB0, *cB1;
    S.unit_begin(cur, ldsctl, tid, 0);
    S.e_issue(cur);
    S.a_offs(cur, R0, C0, R1, C1, voffA, true);
    asm volatile("s_waitcnt lgkmcnt(0)" ::: "memory");
    S.b_ptrs(cur, cB0, cB1); S.unit_switch();
    constexpr unsigned kstep = 128, HSTEPA = (unsigned)HALF * K * ES;
    PG8_STAGE_B(PG8_SB(0, 0), cB0); PG8_STAGE_B(PG8_SB(0, 1), cB1); PG8_STAGE_A(PG8_SA(0, 0), voffA, 0, 0u); PG8_STAGE_A(PG8_SA(0, 1), voffA, 1, 0u);
    if (wr == 1) PG8_BAR;
    PG8_WAIT_V(2); PG8_BAR;
    PG8_STAGE_B(PG8_SB(1, 0), cB0 + kstep); PG8_STAGE_A(PG8_SA(1, 0), voffA, 0, kstep); PG8_STAGE_B(PG8_SB(1, 1), cB1 + kstep);
    PG8_WAIT_V(6); PG8_BAR;
    if (P::EPI_AHEAD && !P::NOEPI) { int l3 = tid; asm volatile("" : "+v"(l3)); S.epi_prefetch(cur, wr, wc, l3 & 15, (l3 >> 4) & 3); }
    for (;;) {
        const bool has_next = S.next(ui + 1, nxt);
        const char *nB0 = cB0, *nB1 = cB1;
        if constexpr (P::GATHER) {
#pragma unroll
            for (int h = 0; h < 2; ++h)
#pragma unroll
                for (int i = 0; i < 2; ++i) voffAn[h][i] = voffA[h][i];
        }
        if (has_next) { S.unit_begin(nxt, ldsctl, tid, (ui + 1) & 1); S.e_issue(nxt);
            if constexpr (P::GATHER) { int t2 = tid; asm volatile("" : "+v"(t2)); int r0, c0, r1, c1; stage_rc(t2 * 16, r0, c0); stage_rc(t2 * 16 + 8192, r1, c1); S.a_idx_issue(nxt, r0, r1); } }
        if (!P::NOEPI && !P::EPI_AHEAD) { int l3 = tid; asm volatile("" : "+v"(l3)); S.epi_prefetch(cur, wr, wc, l3 & 15, (l3 >> 4) & 3); }
#pragma unroll 1
        for (int t = 0; t < nt; t += 2) {
            const bool last = (t == nt - 2);
            S.midk(acc, cur, t, wr, fr, ldsctl, ui & 1);
            unsigned a2o[2][2];
            if (last && has_next) S.b_ptrs(nxt, nB0, nB1);
            if constexpr (P::GATHER) { if (last && has_next) { int t2 = tid; asm volatile("" : "+v"(t2)); int r0, c0, r1, c1; stage_rc(t2 * 16, r0, c0); stage_rc(t2 * 16 + 8192, r1, c1);
                                                              S.a_idx_finish(c0, c1, voffAn); } }
            if constexpr (!P::GATHER) { if (last) { int t2 = tid; asm volatile("" : "+v"(t2)); int r0, c0, r1, c1; stage_rc(t2 * 16, r0, c0); stage_rc(t2 * 16 + 8192, r1, c1);
                                                   S.a_offs(has_next ? nxt : cur, r0, c0, r1, c1, voffAn, false); } }
#pragma unroll
            for (int h = 0; h < 2; ++h)
#pragma unroll
                for (int i = 0; i < 2; ++i) a2o[h][i] = last ? voffAn[h][i] : voffA[h][i] + (unsigned)(t + 2) * kstep;
            const char* b2h0 = last ? nB0 : cB0 + (size_t)(t + 2) * kstep; const char* b2h1 = last ? nB1 : cB1 + (size_t)(t + 2) * kstep;
            const unsigned a1k = (unsigned)(t + 1) * kstep;
            PG8_LDB(B0, 0, 0); PG8_LDB(B1, 0, 1); PG8_SCHED; PG8_LDA(At, 0, 0); PG8_STAGE_A(PG8_SA(1, 1), voffA, 1, a1k);
            PG8_WAIT_V(8); PG8_WAIT_L(0); PG8_BAR; PG8_MMA(0, 0, At, B0); PG8_MMA(0, 1, At, B1); PG8_BAR; PG8_SCHED;
            PG8_LDA(At, 0, 1); PG8_STAGE_B(PG8_SB(0, 0), b2h0); PG8_STAGE_B(PG8_SB(0, 1), b2h1); PG8_STAGE_A(PG8_SA(0, 0), a2o, 0, 0u);
            PG8_WAIT_V(8); PG8_WAIT_L(0); PG8_BAR; PG8_MMA(1, 0, At, B0); PG8_MMA(1, 1, At, B1); PG8_BAR; PG8_SCHED;
            PG8_LDB(B0, 1, 0); PG8_LDB(B1, 1, 1); PG8_SCHED; PG8_LDA(At, 1, 0); PG8_STAGE_A(PG8_SA(0, 1), a2o, 1, 0u);
            PG8_WAIT_V(8); PG8_WAIT_L(0); PG8_BAR; PG8_MMA(0, 0, At, B0); PG8_MMA(0, 1, At, B1); PG8_BAR; PG8_SCHED;
            PG8_LDA(At, 1, 1); PG8_STAGE_B(PG8_SB(1, 0), b2h0 + kstep); PG8_STAGE_B(PG8_SB(1, 1), b2h1 + kstep); PG8_STAGE_A(PG8_SA(1, 0), a2o, 0, kstep);
            PG8_WAIT_V(8); PG8_WAIT_L(0); PG8_BAR; PG8_MMA(1, 0, At, B0); PG8_MMA(1, 1, At, B1); PG8_BAR; PG8_SCHED;
        }
        if (wr == 0) PG8_BAR;
        if constexpr (F8) asm volatile("s_nop 15\n\ts_nop 15" ::: "memory");
        if (P::EPI_AHEAD && !P::NOEPI) { int l3 = tid; asm volatile("" : "+v"(l3)); S.epi_prefetch2(has_next ? nxt : cur, has_next, wr, wc, l3 & 15, (l3 >> 4) & 3); }
        { int l2 = tid; asm volatile("" : "+v"(l2)); if (!P::NOEPI) S.epi(acc, cur, wr, wc, l2 & 15, (l2 >> 4) & 3); }

        if (!has_next) break;
        if (P::EPI_AHEAD && !P::NOEPI) S.epi_adopt();
#pragma unroll
        for (int a = 0; a < 2; ++a)
#pragma unroll
            for (int b = 0; b < 2; ++b)
#pragma unroll
                for (int m = 0; m < 4; ++m)
#pragma unroll
                    for (int n = 0; n < 2; ++n) acc[a][b][m][n] = (f32x4){0.f, 0.f, 0.f, 0.f};
        cur = nxt; cB0 = nB0; cB1 = nB1; ++ui; S.unit_switch();
#pragma unroll
        for (int h = 0; h < 2; ++h)
#pragma unroll
            for (int i = 0; i < 2; ++i) voffA[h][i] = voffAn[h][i];
        if (wr == 1) PG8_BAR;
    }
    PG8_WAIT_V(0);
    PG8_BAR;
#undef PG8_SA
#undef PG8_SB
#undef PG8_STAGE_A
#undef PG8_GLDS
#undef PG8_GLDS_NT
#undef PG8_STAGE_B
#undef PG8_LDA
#undef PG8_LDB
#undef PG8_MMA
#undef PG8_WAIT_V
#undef PG8_WAIT_L
#undef PG8_BAR
#undef PG8_SCHED
}
struct StaticOrder {
    int nM, nN, nwg, G, c;
    __device__ void init(int M, int N, int G_, int c_) { nM = M / BM; nN = N / BM; nwg = nM * nN; G = G_; c = c_; }
    __device__ bool next(int i, Unit& u) const {
        const long L = (long)i * G + c; if (L >= nwg) return false;
        int wgid = (int)L; { const int q = nwg / 8, r = nwg % 8, xcd = wgid % 8, off = wgid / 8; wgid = (xcd < r ? xcd * (q + 1) : r * (q + 1) + (xcd - r) * q) + off; }
        const int nig = 8 * nN, gid = wgid / nig, fm = gid * 8, gsz = (nM - fm) < 8 ? (nM - fm) : 8;
        u.pm = fm + ((wgid % nig) % gsz); u.pn = (wgid % nig) / gsz; return true;
    }
};
}

struct Frame {
    LAS unsigned char* lds; LAS unsigned char* ctl;
    unsigned char* ws;
    int tid, lane, wave, G, bx;
    float* out; const struct Args* ap; unsigned char* ws0; float* out0; size_t z;
};

struct Args { const float* in[28]; float* out; unsigned char* ws; int ph_lo, ph_hi; };
#define arg_in(i) (F.ap->in[i] + F.z)
__device__ __forceinline__ void phase_begin(Frame& F) {
    int t = F.tid; asm volatile("" : "+v"(t)); F.tid = t; F.lane = t & 63; F.wave = __builtin_amdgcn_readfirstlane(t >> 6);
    size_t z = 0; asm volatile("" : "+s"(z)); F.z = z; F.ws = F.ws0 + z; F.out = F.out0 + z;
    int bx = F.bx; asm volatile("" : "+s"(bx)); F.bx = bx;
}
__device__ __forceinline__ void phase_restart(Frame& F) {
    int wv = F.wave; asm volatile("" : "+s"(wv)); F.wave = wv;
    int ln = (int)__builtin_amdgcn_mbcnt_hi(~0u, __builtin_amdgcn_mbcnt_lo(~0u, 0u)); asm volatile("" : "+v"(ln)); F.lane = ln; F.tid = wv * 64 + ln;
    size_t z = 0; asm volatile("" : "+s"(z)); F.z = z; F.ws = F.ws0 + z; F.out = F.out0 + z;
}
struct PBase {
    static constexpr bool GATHER = false, FP8 = false, NODMA = false, NOEPI = false, BNT = false; static constexpr int SCALE_AB = 0x7f7f7f7f;
    __device__ __forceinline__ void unit_begin(const pg8::Unit&, LAS unsigned char*, int, int) {}
    static constexpr bool EPI_AHEAD = false;
    __device__ __forceinline__ void epi_prefetch2(const pg8::Unit&, bool, int, int, int, int) {}
    __device__ __forceinline__ void epi_adopt() {}
    __device__ __forceinline__ void e_issue(const pg8::Unit&) {}
    __device__ __forceinline__ void unit_switch() {}
    __device__ __forceinline__ void midk(f32x4 (&)[2][2][4][2], const pg8::Unit&, int, int, int, LAS unsigned char*, int) {}
    __device__ __forceinline__ void a_fix(unsigned (&)[2][2]) {}
    __device__ __forceinline__ void epi_prefetch(const pg8::Unit&, int, int, int, int) {}
};
struct PInProj : PBase {
    static constexpr int K = 1024, BROW64 = 1; static constexpr bool FP8 = IN_FP8; static constexpr int ES = IN_FP8 ? 1 : 2;
    static constexpr int SCALE_AB = 0x7b79;
    pg8::StaticOrder so; const char* A; const char* B; bf16_t* UQKV; const float *GQK, *COS, *SIN;
    __device__ __forceinline__ bool next(int i, pg8::Unit& u) const { return so.next(i, u); }
    __device__ __forceinline__ const char* a_base() const { return A; }
    __device__ __forceinline__ void a_offs(const pg8::Unit& u, int R0, int C0, int R1, int C1, unsigned (&vo)[2][2], bool) const {
#pragma unroll
        for (int h = 0; h < 2; ++h) { vo[h][0] = (unsigned)((u.pm * 256 + 128 * h + R0) * K * ES + 2 * C0); vo[h][1] = (unsigned)((u.pm * 256 + 128 * h + R1) * K * ES + 2 * C1); }
    }
    __device__ __forceinline__ void b_ptrs(const pg8::Unit& u, const char*& b0, const char*& b1) const { b0 = B + (size_t)u.pn * 256 * K * ES; b1 = b0 + (size_t)32 * K * ES; }
    __device__ __forceinline__ void epi(f32x4 (&acc)[2][2][4][2], const pg8::Unit& u, int wr, int wc, int fr, int fq) const {
        const int kind = u.pn >> 1;
        const int colg = (u.pn & 1) * 256 + 64 * wc;
        bf16_t* dst = UQKV + (size_t)kind * (size_t)(16u << 20);
        const int row0 = u.pm * 256 + wr * 64 + fr;
        if (kind == 0 || kind == 3) {
            const bool vimg = kind == 3;
#pragma unroll
            for (int ai = 0; ai < 2; ++ai)
#pragma unroll
                for (int m = 0; m < 4; ++m) { const int row = row0 + ai * 128 + m * 16;
                    bf16_t* rowp = vimg ? dst + (size_t)(row >> 6) * 32768 + (colg >> 7) * 8192 + ((colg >> 6) & 1) * 4096 + (row & 63) * 32 + 8 * fq
                                        : dst + ((size_t)((colg >> 4) + (fq >> 1)) * T + row) * 16 + 8 * (fq & 1);
                    const int bstep = vimg ? 2048 : 2 * T * 16;
#pragma unroll
                    for (int bj = 0; bj < 2; ++bj) { const f32x4 v0 = acc[ai][bj][m][0], v1 = acc[ai][bj][m][1];
                        u32x4 w; w.x = cvt_pk_bf16(v0[0], v0[1]); w.y = cvt_pk_bf16(v0[2], v0[3]); w.z = cvt_pk_bf16(v1[0], v1[1]); w.w = cvt_pk_bf16(v1[2], v1[3]);
                        *(u32x4*)(rowp + bstep * bj) = w; } }
        } else {
            const float* g = GQK + (kind - 1) * 64; const float sc = kind == 1 ? C2 * 32.0f : 16.0f;
            f32x4 g0[2], g1[2];
#pragma unroll
            for (int n = 0; n < 2; ++n) { g0[n] = *(const f32x4*)(g + 8 * fq + 4 * n); g1[n] = *(const f32x4*)(g + 32 + 8 * fq + 4 * n); }
            f32x4 tc[2][2], ts[2][2];
#define ROPE_LD(buf, it) do { const int _pos = (row0 + ((it) >> 2) * 128 + ((it) & 3) * 16) & (SEQ - 1); _Pragma("unroll") for (int n = 0; n < 2; ++n) { \
                tc[buf][n] = *(const f32x4*)(COS + (size_t)_pos * 32 + 8 * fq + 4 * n); ts[buf][n] = *(const f32x4*)(SIN + (size_t)_pos * 32 + 8 * fq + 4 * n); } } while (0)
            ROPE_LD(0, 0);
#pragma unroll
            for (int ai = 0; ai < 2; ++ai)
#pragma unroll
                for (int m = 0; m < 4; ++m) {
                    const int row = row0 + ai * 128 + m * 16; const int itx = ai * 4 + m;
                    if (itx + 1 < 8) ROPE_LD((itx + 1) & 1, itx + 1);
                    float ss = 0.f;
#pragma unroll
                    for (int bj = 0; bj < 2; ++bj)
#pragma unroll
                        for (int n = 0; n < 2; ++n) { const f32x4 x = acc[ai][bj][m][n]; ss += (x[0] * x[0] + x[1] * x[1]) + (x[2] * x[2] + x[3] * x[3]); }
                    ss = sum_x16_x32(ss);
                    const float r = __builtin_amdgcn_rsqf(ss * (1.f / 64.f) + EPS) * sc;
                    f32x4 o1[2], o2[2];
#pragma unroll
                    for (int n = 0; n < 2; ++n) {
                        const f32x4 c = tc[itx & 1][n], s = ts[itx & 1][n];
                        const f32x4 x1 = acc[ai][0][m][n] * g0[n] * r, x2 = acc[ai][1][m][n] * g1[n] * r;
                        o1[n] = x1 * c - x2 * s; o2[n] = x2 * c + x1 * s;
                    }
                    unsigned char* rowp = kind == 2 ? (unsigned char*)dst + (size_t)(row >> 6) * 32768 + (colg >> 6) * 4096 + (fq >> 1) * 1024 + (row & 63) * 16 + 8 * (fq & 1)
                                                    : (unsigned char*)dst + (size_t)row * 512 + colg + 8 * fq;
                    u32x2 w; w.x = pk4_fp8(o1[0][0], o1[0][1], o1[0][2], o1[0][3]); w.y = pk4_fp8(o1[1][0], o1[1][1], o1[1][2], o1[1][3]);
                    *(u32x2*)(rowp) = w;
                    w.x = pk4_fp8(o2[0][0], o2[0][1], o2[0][2], o2[0][3]); w.y = pk4_fp8(o2[1][0], o2[1][1], o2[1][2], o2[1][3]);
                    *(u32x2*)(rowp + (kind == 2 ? 2048 : 32)) = w;
                    asm volatile("" ::: "memory");
                }
#undef ROPE_LD
        }
    }
};
struct PGlu : PBase {
    static constexpr int K = 512, BROW64 = 0;
    pg8::StaticOrder so; const char* A; const char* B; const bf16_t* YG; bf16_t* MIX; float* RSP;
    __device__ __forceinline__ bool next(int i, pg8::Unit& u) const { return so.next(i, u); }
    __device__ __forceinline__ const char* a_base() const { return A; }
    __device__ __forceinline__ void a_offs(const pg8::Unit& u, int R0, int C0, int R1, int C1, unsigned (&vo)[2][2], bool) const {
#pragma unroll
        for (int h = 0; h < 2; ++h) { vo[h][0] = (unsigned)((u.pm * 256 + 128 * h + R0) * K + C0) * 2u; vo[h][1] = (unsigned)((u.pm * 256 + 128 * h + R1) * K + C1) * 2u; }
    }
    __device__ __forceinline__ void b_ptrs(const pg8::Unit& u, const char*& b0, const char*& b1) const { b0 = B + (size_t)u.pn * 256 * K * 2; b1 = b0 + (size_t)128 * K * 2; }
    __device__ __forceinline__ void epi(f32x4 (&acc)[2][2][4][2], const pg8::Unit& u, int wr, int wc, int fr, int fq) const {
        const int row0 = u.pm * 256 + wr * 64 + fr, col0 = u.pn * 256 + wc * 32 + 8 * fq;
#pragma unroll
        for (int ai = 0; ai < 2; ++ai)
#pragma unroll
            for (int m = 0; m < 4; ++m) {
                const int row = row0 + ai * 128 + m * 16; float ss = 0.f;
#pragma unroll
                for (int bj = 0; bj < 2; ++bj) {
                    const u32x4 yw = *(const u32x4*)(YG + (size_t)row * 512 + col0 + 128 * bj);
                    const f32x4 a0 = acc[ai][bj][m][0], a1 = acc[ai][bj][m][1];
                    float z[8];
                    z[0] = bf_lo(yw.x) * sigmoidf(a0[0]); z[1] = bf_hi(yw.x) * sigmoidf(a0[1]); z[2] = bf_lo(yw.y) * sigmoidf(a0[2]); z[3] = bf_hi(yw.y) * sigmoidf(a0[3]);
                    z[4] = bf_lo(yw.z) * sigmoidf(a1[0]); z[5] = bf_hi(yw.z) * sigmoidf(a1[1]); z[6] = bf_lo(yw.w) * sigmoidf(a1[2]); z[7] = bf_hi(yw.w) * sigmoidf(a1[3]);
#pragma unroll
                    for (int i = 0; i < 8; ++i) ss += z[i] * z[i];
                    u32x4 w; w.x = cvt_pk_bf16(z[0], z[1]); w.y = cvt_pk_bf16(z[2], z[3]); w.z = cvt_pk_bf16(z[4], z[5]); w.w = cvt_pk_bf16(z[6], z[7]);
                    *(u32x4*)(MIX + (size_t)row * 1024 + col0 + 128 * bj) = w;
                }
                ss = sum_x16_x32(ss);
                if (fq == 0) RSP[(size_t)row * 8 + u.pn * 4 + wc] = ss;
            }
    }
};
struct POut : PBase {
    static constexpr int K = 1024, BROW64 = 0;
    pg8::StaticOrder so; const char* A; const char* B; const float* RSP; const float* base32; const bf16_t* base16; bf16_t* H1;
    __device__ __forceinline__ bool next(int i, pg8::Unit& u) const { return so.next(i, u); }
    __device__ __forceinline__ const char* a_base() const { return A; }
    __device__ __forceinline__ void a_offs(const pg8::Unit& u, int R0, int C0, int R1, int C1, unsigned (&vo)[2][2], bool) const {
#pragma unroll
        for (int h = 0; h < 2; ++h) { vo[h][0] = (unsigned)((u.pm * 256 + 128 * h + R0) * K + C0) * 2u; vo[h][1] = (unsigned)((u.pm * 256 + 128 * h + R1) * K + C1) * 2u; }
    }
    __device__ __forceinline__ void b_ptrs(const pg8::Unit& u, const char*& b0, const char*& b1) const { b0 = B + (size_t)u.pn * 256 * K * 2; b1 = b0 + (size_t)128 * K * 2; }
    __device__ __forceinline__ void unit_begin(const pg8::Unit& u, LAS unsigned char* ldsctl, int tid, int slot) const {
        if (tid < 256) {
            const f32x4 p0 = *(const f32x4*)(RSP + (size_t)(u.pm * 256 + tid) * 8), p1 = *(const f32x4*)(RSP + (size_t)(u.pm * 256 + tid) * 8 + 4);
            const float ss = ((p0[0] + p0[1]) + (p0[2] + p0[3])) + ((p1[0] + p1[1]) + (p1[2] + p1[3]));
            ((LAS float*)(ldsctl + 1024 + slot * 1024))[tid] = __builtin_amdgcn_rsqf(ss * (1.f / 512.f) + EPS);
        }
    }
    __device__ __forceinline__ void midk(f32x4 (&acc)[2][2][4][2], const pg8::Unit& u, int t, int wr, int fr, LAS unsigned char* ldsctl, int slot) const {
        if (t == 8) {
            const LAS float* rs = (const LAS float*)(ldsctl + 1024 + slot * 1024);
#pragma unroll
            for (int ai = 0; ai < 2; ++ai)
#pragma unroll
                for (int m = 0; m < 4; ++m) { const float r = rs[ai * 128 + wr * 64 + m * 16 + fr];
#pragma unroll
                    for (int bj = 0; bj < 2; ++bj)
#pragma unroll
                        for (int n = 0; n < 2; ++n) acc[ai][bj][m][n] *= r; }
        }
    }
    __device__ __forceinline__ void epi(f32x4 (&acc)[2][2][4][2], const pg8::Unit& u, int wr, int wc, int fr, int fq) const {
        const int row0 = u.pm * 256 + wr * 64 + fr, col0 = u.pn * 256 + wc * 32 + 8 * fq;
        if (base32) {
            f32x4 rb[2][2][2];
#define PO_LD(buf, it) do { const size_t _off = (size_t)(row0 + ((it) >> 2) * 128 + ((it) & 3) * 16) * 1024 + col0; _Pragma("unroll") for (int bj = 0; bj < 2; ++bj) { \
                rb[buf][bj][0] = *(const f32x4*)(base32 + _off + bj * 128); rb[buf][bj][1] = *(const f32x4*)(base32 + _off + bj * 128 + 4); } } while (0)
            PO_LD(0, 0);
#pragma unroll
            for (int it = 0; it < 8; ++it) {
                if (it + 1 < 8) PO_LD((it + 1) & 1, it + 1);
                const int ai = it >> 2, m = it & 3; const size_t off = (size_t)(row0 + ai * 128 + m * 16) * 1024 + col0;
#pragma unroll
                for (int bj = 0; bj < 2; ++bj) {
                    const f32x4 v0 = acc[ai][bj][m][0] + rb[it & 1][bj][0], v1 = acc[ai][bj][m][1] + rb[it & 1][bj][1];
                    u32x4 w; w.x = cvt_pk_bf16(v0[0], v0[1]); w.y = cvt_pk_bf16(v0[2], v0[3]); w.z = cvt_pk_bf16(v1[0], v1[1]); w.w = cvt_pk_bf16(v1[2], v1[3]);
                    *(u32x4*)(H1 + off + bj * 128) = w; }
                asm volatile("" ::: "memory");
            }
#undef PO_LD
        } else {
            u32x4 rb[2][2];
#define PO_LD(buf, it) do { const size_t _off = (size_t)(row0 + ((it) >> 2) * 128 + ((it) & 3) * 16) * 1024 + col0; _Pragma("unroll") for (int bj = 0; bj < 2; ++bj) rb[buf][bj] = *(const u32x4*)(base16 + _off + bj * 128); } while (0)
            PO_LD(0, 0);
#pragma unroll
            for (int it = 0; it < 8; ++it) {
                if (it + 1 < 8) PO_LD((it + 1) & 1, it + 1);
                const int ai = it >> 2, m = it & 3; const size_t off = (size_t)(row0 + ai * 128 + m * 16) * 1024 + col0;
#pragma unroll
                for (int bj = 0; bj < 2; ++bj) {
                    f32x4 v0 = acc[ai][bj][m][0], v1 = acc[ai][bj][m][1]; const u32x4 b = rb[it & 1][bj];
                    v0[0] += bf_lo(b.x); v0[1] += bf_hi(b.x); v0[2] += bf_lo(b.y); v0[3] += bf_hi(b.y); v1[0] += bf_lo(b.z); v1[1] += bf_hi(b.z); v1[2] += bf_lo(b.w); v1[3] += bf_hi(b.w);
                    u32x4 w; w.x = cvt_pk_bf16(v0[0], v0[1]); w.y = cvt_pk_bf16(v0[2], v0[3]); w.z = cvt_pk_bf16(v1[0], v1[1]); w.w = cvt_pk_bf16(v1[2], v1[3]);
                    *(u32x4*)(H1 + off + bj * 128) = w; }
                asm volatile("" ::: "memory");
            }
#undef PO_LD
        }
    }
};
template <int NN> struct MoeOrder {
    int j, wpx, s0, s1, s2, s3, n0, n1, n2, n3;
    __device__ __forceinline__ void init(int G, int c, const int* PST) {
#ifndef MOE_XA
#define MOE_XA 3
#endif
#ifndef MOE_CHUNKED
#define MOE_CHUNKED 0
#endif
        if (MOE_XA == 1 && (G & 7) == 0) { wpx = G >> 3; const int x = MOE_CHUNKED ? c / wpx : (c & 7); j = MOE_CHUNKED ? c % wpx : (c >> 3);
            s0 = PST[x] >> 8; n0 = (PST[x + 1] - PST[x]) >> 8; s1 = PST[x + 8] >> 8; n1 = (PST[x + 9] - PST[x + 8]) >> 8;
            s2 = PST[x + 16] >> 8; n2 = (PST[x + 17] - PST[x + 16]) >> 8; s3 = PST[x + 24] >> 8; n3 = (PST[x + 25] - PST[x + 24]) >> 8; }
        else { j = c; wpx = G; s0 = 0; n0 = PST[32] >> 8; s1 = s2 = s3 = 0; n1 = n2 = n3 = 0; }
        if (MOE_XA == 2 && (G & 7) == 0) { wpx = G >> 3; j = c >> 3; s1 = c & 7; n0 = PST[32] >> 8; }
        if (MOE_XA == 3 && (G & 7) == 0) { wpx = G >> 3; j = c >> 3; n0 = PST[32] >> 8; n1 = (n0 + 7) >> 3; s1 = (c & 7) * n1; }
    }
    __device__ __forceinline__ bool next(int i, pg8::Unit& u) const {
        const int q = i * wpx + j; int pml = q / NN; u.pn = q % NN;
        if (MOE_XA == 2) { u.pm = s1 + 8 * pml; return u.pm < n0; }
        if (MOE_XA == 3) { u.pm = s1 + pml; return pml < n1 && u.pm < n0; }
        if (pml < n0) { u.pm = s0 + pml; return true; } pml -= n0;
        if (pml < n1) { u.pm = s1 + pml; return true; } pml -= n1;
        if (pml < n2) { u.pm = s2 + pml; return true; } pml -= n2;
        if (pml < n3) { u.pm = s3 + pml; return true; }
        return false;
    }
};
struct PUp : PBase {
    static constexpr int K = 1024, BROW64 = 0; static constexpr bool GATHER = true, FP8 = UP_FP8, BNT = MOE_BNT; static constexpr int ES = UP_FP8 ? 1 : 2;
    static constexpr int SCALE_AB = 0x7c79;
    MoeOrder<8> mo; const char* A; const char* B; const int* ROWTOK; const int* TILEEXP; const float* bup; const float* ROWSCALE; bf16_t* ACT;
    int idx[2][2]; int c0, c1;
    __device__ __forceinline__ bool next(int i, pg8::Unit& u) const { return mo.next(i, u); }
    __device__ __forceinline__ const char* a_base() const { return A; }
    __device__ __forceinline__ void a_offs(const pg8::Unit& u, int R0, int C0, int R1, int C1, unsigned (&vo)[2][2], bool first) {
        c0 = C0; c1 = C1;
        const int* rp = ROWTOK + u.pm * 256;
#pragma unroll
        for (int h = 0; h < 2; ++h) {
            asm volatile("global_load_dword %0, %1, off" : "=v"(idx[h][0]) : "v"(rp + 128 * h + R0) : "memory");
            asm volatile("global_load_dword %0, %1, off" : "=v"(idx[h][1]) : "v"(rp + 128 * h + R1) : "memory");
        }
        asm volatile("s_waitcnt vmcnt(0)" : "+v"(idx[0][0]), "+v"(idx[0][1]), "+v"(idx[1][0]), "+v"(idx[1][1]) :: "memory");
#pragma unroll
        for (int h = 0; h < 2; ++h) { vo[h][0] = (unsigned)(idx[h][0] * K * ES + 2 * c0); vo[h][1] = (unsigned)(idx[h][1] * K * ES + 2 * c1); }
    }
    int e_cur, e_nxt;
    const LAS int* tl;
    __device__ __forceinline__ void e_issue(const pg8::Unit& u) { e_nxt = __builtin_amdgcn_readfirstlane(tl[u.pm]); }
    __device__ __forceinline__ void unit_switch() { e_cur = e_nxt; }
    __device__ __forceinline__ void b_ptrs(const pg8::Unit& u, const char*& b0, const char*& b1) {
        const int e = e_nxt; b0 = B + ((size_t)e * 2048 + (size_t)u.pn * 128) * K * ES; b1 = b0 + (size_t)1024 * K * ES; }
    __device__ __forceinline__ void a_idx_issue(const pg8::Unit& u, int R0, int R1) {
        const int* rp = ROWTOK + u.pm * 256;
#pragma unroll
        for (int h = 0; h < 2; ++h) {
            asm volatile("global_load_dword %0, %1, off" : "=v"(idx[h][0]) : "v"(rp + 128 * h + R0) : "memory");
            asm volatile("global_load_dword %0, %1, off" : "=v"(idx[h][1]) : "v"(rp + 128 * h + R1) : "memory");
        }
    }
    __device__ __forceinline__ void a_idx_finish(int C0, int C1, unsigned (&vo)[2][2]) {
        asm volatile("" : "+v"(idx[0][0]), "+v"(idx[0][1]), "+v"(idx[1][0]), "+v"(idx[1][1]) :: "memory");
#pragma unroll
        for (int h = 0; h < 2; ++h) { vo[h][0] = (unsigned)(idx[h][0] * K * ES + 2 * C0); vo[h][1] = (unsigned)(idx[h][1] * K * ES + 2 * C1); }
    }
    float ps[8]; f32x4 pbg[2], pbl[2];
    float ps2[8]; f32x4 pbg2[2], pbl2[2];
    static constexpr bool EPI_AHEAD = true;
    __device__ __forceinline__ void epi_prefetch2(const pg8::Unit& u, bool isnext, int wr, int wc, int fr, int fq) {
        const int e = isnext ? e_nxt : e_cur;
        const int row0 = u.pm * 256 + wr * 64 + fr, col0 = u.pn * 128 + wc * 32 + 8 * fq;
        const float* bg = bup + (size_t)e * 2048 + col0; const float* bl = bg + 1024;
#pragma unroll
        for (int ai = 0; ai < 2; ++ai)
#pragma unroll
            for (int m = 0; m < 4; ++m) asm volatile("global_load_dword %0, %1, off" : "=v"(ps2[ai * 4 + m]) : "v"(ROWSCALE + row0 + ai * 128 + m * 16) : "memory");
#pragma unroll
        for (int n = 0; n < 2; ++n) { asm volatile("global_load_dwordx4 %0, %1, off" : "=v"(pbg2[n]) : "v"(bg + 4 * n) : "memory"); asm volatile("global_load_dwordx4 %0, %1, off" : "=v"(pbl2[n]) : "v"(bl + 4 * n) : "memory"); }
    }
    __device__ __forceinline__ void epi_adopt() {
        asm volatile("s_waitcnt vmcnt(4)" : "+v"(ps2[0]), "+v"(ps2[1]), "+v"(ps2[2]), "+v"(ps2[3]), "+v"(ps2[4]), "+v"(ps2[5]), "+v"(ps2[6]), "+v"(ps2[7]), "+v"(pbg2[0]), "+v"(pbg2[1]), "+v"(pbl2[0]), "+v"(pbl2[1]) :: "memory");
#pragma unroll
        for (int i = 0; i < 8; ++i) ps[i] = ps2[i];
#pragma unroll
        for (int n = 0; n < 2; ++n) { pbg[n] = pbg2[n]; pbl[n] = pbl2[n]; }
    }
    __device__ __forceinline__ void epi_prefetch(const pg8::Unit& u, int wr, int wc, int fr, int fq) {
        const int e = e_cur;
        const int row0 = u.pm * 256 + wr * 64 + fr, col0 = u.pn * 128 + wc * 32 + 8 * fq;
        const float* bg = bup + (size_t)e * 2048 + col0; const float* bl = bg + 1024;
#pragma unroll
        for (int ai = 0; ai < 2; ++ai)
#pragma unroll
            for (int m = 0; m < 4; ++m) asm volatile("global_load_dword %0, %1, off" : "=v"(ps[ai * 4 + m]) : "v"(ROWSCALE + row0 + ai * 128 + m * 16) : "memory");
#pragma unroll
        for (int n = 0; n < 2; ++n) { asm volatile("global_load_dwordx4 %0, %1, off" : "=v"(pbg[n]) : "v"(bg + 4 * n) : "memory"); asm volatile("global_load_dwordx4 %0, %1, off" : "=v"(pbl[n]) : "v"(bl + 4 * n) : "memory"); }
    }
    __device__ __forceinline__ void epi(f32x4 (&acc)[2][2][4][2], const pg8::Unit& u, int wr, int wc, int fr, int fq) {
        const int row0 = u.pm * 256 + wr * 64 + fr, col0 = u.pn * 128 + wc * 32 + 8 * fq;
        asm volatile("" : "+v"(ps[0]), "+v"(ps[1]), "+v"(ps[2]), "+v"(ps[3]), "+v"(ps[4]), "+v"(ps[5]), "+v"(ps[6]), "+v"(ps[7]), "+v"(pbg[0]), "+v"(pbg[1]), "+v"(pbl[0]), "+v"(pbl[1]));
        constexpr float CS = -2.4554669595f * 0.25f, ICS = 1.0f / CS;
        f32x4 bgs[2], blc[2];
#pragma unroll
        for (int n = 0; n < 2; ++n) { bgs[n] = pbg[n] * (4.0f * CS); blc[n] = (pbl[n] + 1.0f) * ICS; }
#pragma unroll
        for (int ai = 0; ai < 2; ++ai) {
            u32x2 w8[4];
#pragma unroll
            for (int m = 0; m < 4; ++m) {
                const float rs = ps[ai * 4 + m], rsg = rs * (4.0f * CS), rsl = rs * ICS;
                f32x4 av[2];
#pragma unroll
                for (int n = 0; n < 2; ++n) {
                    f32x4 G = acc[ai][0][m][n] * rsg + bgs[n], L = acc[ai][1][m][n] * rsl + blc[n], E;
#pragma unroll
                    for (int j = 0; j < 4; ++j) { G[j] = fmaxf(G[j], 28.0f * CS); L[j] = __builtin_amdgcn_fmed3f(L[j], 8.0f * ICS, -6.0f * ICS); }
#pragma unroll
                    for (int j = 0; j < 4; ++j) E[j] = __builtin_amdgcn_exp2f(G[j]);
                    E = E + 1.0f;
#pragma unroll
                    for (int j = 0; j < 4; ++j) E[j] = __builtin_amdgcn_rcpf(E[j]);
                    av[n] = G * E * L;
                }
                w8[m].x = pk4_fp8(av[0][0], av[0][1], av[0][2], av[0][3]); w8[m].y = pk4_fp8(av[1][0], av[1][1], av[1][2], av[1][3]);
            }
            const bool odd = fq & 1;
#pragma unroll
            for (int mp = 0; mp < 2; ++mp) {
                const auto rx = __builtin_amdgcn_permlane16_swap(w8[2 * mp].x, w8[2 * mp + 1].x, false, false);
                const auto ry = __builtin_amdgcn_permlane16_swap(w8[2 * mp].y, w8[2 * mp + 1].y, false, false);
                const u32x4 w = (u32x4){rx[0], ry[0], rx[1], ry[1]};
                const int row = row0 + ai * 128 + (2 * mp + (odd ? 1 : 0)) * 16;
                *(u32x4*)((unsigned char*)ACT + (size_t)row * 1024 + u.pn * 128 + wc * 32 + 16 * (fq >> 1)) = w;
            }
        }
    }
};
struct PUpNoDma : PUp { static constexpr bool NODMA = (GEMM_PROBE_KIND & 1) != 0, NOEPI = (GEMM_PROBE_KIND & 2) != 0; };
struct PDown : PBase {
    static constexpr int K = 1024, BROW64 = 2; static constexpr bool FP8 = DN_FP8, BNT = MOE_BNT; static constexpr int ES = DN_FP8 ? 1 : 2;
    static constexpr int SCALE_AB = 0x7d79;
    MoeOrder<4> mo; const char* A; const char* B; const int* TILEEXP; const float* bdn; const float* ROWGATE; bf16_t* YB;
    __device__ __forceinline__ bool next(int i, pg8::Unit& u) const { return mo.next(i, u); }
    __device__ __forceinline__ const char* a_base() const { return A; }
    __device__ __forceinline__ void a_offs(const pg8::Unit& u, int R0, int C0, int R1, int C1, unsigned (&vo)[2][2], bool) const {
#pragma unroll
        for (int h = 0; h < 2; ++h) { vo[h][0] = (unsigned)((u.pm * 256 + 128 * h + R0) * K * ES + 2 * C0); vo[h][1] = (unsigned)((u.pm * 256 + 128 * h + R1) * K * ES + 2 * C1); }
    }
    int e_cur, e_nxt;
    const LAS int* tl;
    __device__ __forceinline__ void e_issue(const pg8::Unit& u) { e_nxt = __builtin_amdgcn_readfirstlane(tl[u.pm]); }
    __device__ __forceinline__ void unit_switch() { e_cur = e_nxt; }
    __device__ __forceinline__ void b_ptrs(const pg8::Unit& u, const char*& b0, const char*& b1) {
        const int e = e_nxt; b0 = B + ((size_t)e * 1024 + (size_t)u.pn * 256) * K * ES; b1 = b0 + (size_t)8 * K * ES; }
    float pg[8]; f32x4 pb[2][2];
    float pg2[8]; f32x4 pb2[2][2];
    static constexpr bool EPI_AHEAD = true;
    __device__ __forceinline__ void epi_prefetch2(const pg8::Unit& u, bool isnext, int wr, int wc, int fr, int fq) {
        const int e = isnext ? e_nxt : e_cur;
        const int row0 = u.pm * 256 + wr * 64 + fr, col0 = u.pn * 256 + wc * 64 + 16 * fq;
        const float* bp = bdn + (size_t)e * 1024 + col0;
#pragma unroll
        for (int ai = 0; ai < 2; ++ai)
#pragma unroll
            for (int m = 0; m < 4; ++m) asm volatile("global_load_dword %0, %1, off" : "=v"(pg2[ai * 4 + m]) : "v"(ROWGATE + row0 + ai * 128 + m * 16) : "memory");
#pragma unroll
        for (int bj = 0; bj < 2; ++bj)
#pragma unroll
            for (int n = 0; n < 2; ++n) asm volatile("global_load_dwordx4 %0, %1, off" : "=v"(pb2[bj][n]) : "v"(bp + 8 * bj + 4 * n) : "memory");
    }
    __device__ __forceinline__ void epi_adopt() {
        asm volatile("s_waitcnt vmcnt(8)" : "+v"(pg2[0]), "+v"(pg2[1]), "+v"(pg2[2]), "+v"(pg2[3]), "+v"(pg2[4]), "+v"(pg2[5]), "+v"(pg2[6]), "+v"(pg2[7]), "+v"(pb2[0][0]), "+v"(pb2[0][1]), "+v"(pb2[1][0]), "+v"(pb2[1][1]) :: "memory");
#pragma unroll
        for (int i = 0; i < 8; ++i) pg[i] = pg2[i];
#pragma unroll
        for (int bj = 0; bj < 2; ++bj)
#pragma unroll
            for (int n = 0; n < 2; ++n) pb[bj][n] = pb2[bj][n];
    }
    __device__ __forceinline__ void epi_prefetch(const pg8::Unit& u, int wr, int wc, int fr, int fq) {
        const int e = e_cur;
        const int row0 = u.pm * 256 + wr * 64 + fr, col0 = u.pn * 256 + wc * 64 + 16 * fq;
        const float* bp = bdn + (size_t)e * 1024 + col0;
#pragma unroll
        for (int ai = 0; ai < 2; ++ai)
#pragma unroll
            for (int m = 0; m < 4; ++m) asm volatile("global_load_dword %0, %1, off" : "=v"(pg[ai * 4 + m]) : "v"(ROWGATE + row0 + ai * 128 + m * 16) : "memory");
#pragma unroll
        for (int bj = 0; bj < 2; ++bj)
#pragma unroll
            for (int n = 0; n < 2; ++n) asm volatile("global_load_dwordx4 %0, %1, off" : "=v"(pb[bj][n]) : "v"(bp + 8 * bj + 4 * n) : "memory");
    }
    __device__ __forceinline__ void epi(f32x4 (&acc)[2][2][4][2], const pg8::Unit& u, int wr, int wc, int fr, int fq) {
        const int row0 = u.pm * 256 + wr * 64 + fr, col0 = u.pn * 256 + wc * 64 + 16 * fq;
        asm volatile("" : "+v"(pg[0]), "+v"(pg[1]), "+v"(pg[2]), "+v"(pg[3]), "+v"(pg[4]), "+v"(pg[5]), "+v"(pg[6]), "+v"(pg[7]), "+v"(pb[0][0]), "+v"(pb[0][1]), "+v"(pb[1][0]), "+v"(pb[1][1]));
#pragma unroll
        for (int ai = 0; ai < 2; ++ai)
#pragma unroll
            for (int m = 0; m < 4; ++m) { const int row = row0 + ai * 128 + m * 16; const float gt = pg[ai * 4 + m] * 16.f;
                const f32x4 v00 = (acc[ai][0][m][0] + pb[0][0]) * gt, v01 = (acc[ai][0][m][1] + pb[0][1]) * gt, v10 = (acc[ai][1][m][0] + pb[1][0]) * gt, v11 = (acc[ai][1][m][1] + pb[1][1]) * gt;
                u32x4 w; w.x = pk4_fp8(v00[0], v00[1], v00[2], v00[3]); w.y = pk4_fp8(v01[0], v01[1], v01[2], v01[3]); w.z = pk4_fp8(v10[0], v10[1], v10[2], v10[3]); w.w = pk4_fp8(v11[0], v11[1], v11[2], v11[3]);
                __builtin_nontemporal_store(w, (u32x4*)((unsigned char*)YB + (size_t)row * 1024 + col0)); }
    }
};

struct TItem { const float* src; bf16_t* dst; const float* ksc; int N, K; unsigned char* dst8; };
__device__ __forceinline__ void titem_load(const TItem& it, f32x4 (&v)[16], int lane) {
    const float* p = it.src + (size_t)(lane >> 4) * it.N + 4 * (lane & 15);
#pragma unroll
    for (int i = 0; i < 16; ++i) v[i] = *(const f32x4*)(p + (size_t)(4 * i) * it.N);
}
__device__ __forceinline__ void titem_store(const TItem& it, f32x4 (&v)[16], LAS float* scr, int lane) {
    if (it.ksc) {
#pragma unroll
        for (int i = 0; i < 16; ++i) v[i] *= it.ksc[4 * i + (lane >> 4)];
    }
#pragma unroll
    for (int i = 0; i < 16; ++i) { LAS float* d = scr + (4 * i + (lane >> 4)) * 65 + 4 * (lane & 15); d[0] = v[i][0]; d[1] = v[i][1]; d[2] = v[i][2]; d[3] = v[i][3]; }
    asm volatile("s_waitcnt lgkmcnt(0)" ::: "memory");
    if (it.dst8) {
        const int c = lane & 3;
#pragma unroll
        for (int j = 0; j < 4; ++j) { const int n = (lane >> 2) + 16 * j; const LAS float* s = scr + (16 * c) * 65 + n;
            u32x4 o;
            o.x = pk4_fp8(s[0 * 65] * 64.f, s[1 * 65] * 64.f, s[2 * 65] * 64.f, s[3 * 65] * 64.f); o.y = pk4_fp8(s[4 * 65] * 64.f, s[5 * 65] * 64.f, s[6 * 65] * 64.f, s[7 * 65] * 64.f);
            o.z = pk4_fp8(s[8 * 65] * 64.f, s[9 * 65] * 64.f, s[10 * 65] * 64.f, s[11 * 65] * 64.f); o.w = pk4_fp8(s[12 * 65] * 64.f, s[13 * 65] * 64.f, s[14 * 65] * 64.f, s[15 * 65] * 64.f);
            *(u32x4*)(it.dst8 + (size_t)n * it.K + 16 * c) = o; }
    } else {
        const int c = lane & 7;
#pragma unroll
        for (int j = 0; j < 8; ++j) { const int n = (lane >> 3) + 8 * j; const LAS float* s = scr + (8 * c) * 65 + n;
            u32x4 o; o.x = pk2(s[0 * 65], s[1 * 65]); o.y = pk2(s[2 * 65], s[3 * 65]); o.z = pk2(s[4 * 65], s[5 * 65]); o.w = pk2(s[6 * 65], s[7 * 65]);
            *(u32x4*)(it.dst + (size_t)n * it.K + 8 * c) = o; }
    }
    asm volatile("s_waitcnt lgkmcnt(0)" ::: "memory");
}
__device__ __forceinline__ void rms_row_to_bf16(const f32x4 (&v)[4], const float* g, bf16_t* orow, int lane) {
    float s = 0.f;
#pragma unroll
    for (int j = 0; j < 4; ++j) s += (v[j][0] * v[j][0] + v[j][1] * v[j][1]) + (v[j][2] * v[j][2] + v[j][3] * v[j][3]);
    const float r = __builtin_amdgcn_rsqf(wave_sum(s) * (1.f / D) + EPS) * (IN_FP8 ? 16.f : 1.f);
#pragma unroll
    for (int j = 0; j < 4; ++j) { const f32x4 gg = *(const f32x4*)(g + 4 * lane + 256 * j); const f32x4 o = v[j] * gg * r;
        if (IN_FP8) { ((unsigned*)orow)[lane + 64 * j] = pk4_fp8(o[0], o[1], o[2], o[3]); }
        else { u32x2 w; w.x = cvt_pk_bf16(o[0], o[1]); w.y = cvt_pk_bf16(o[2], o[3]); *(u32x2*)(orow + 4 * lane + 256 * j) = w; } }
}
struct Cplx { float re, im; };
__device__ __forceinline__ Cplx cmul(Cplx a, Cplx b) { return Cplx{a.re * b.re - a.im * b.im, a.re * b.im + a.im * b.re}; }
__device__ __forceinline__ Cplx lam_pow(float lr, float li, float step, int n) {
    const float mag = expf((float)n * lr * step); const double ang = (double)n * (double)li * (double)step;
    return Cplx{mag * (float)cos(ang), mag * (float)sin(ang)};
}
__device__ __forceinline__ Cplx lam_pow_fast(float lr, float li, float step, int n) {
    const float mag = __expf((float)n * lr * step); const double rev = (double)n * (double)li * (double)step * 0.15915494309189535; const float fr = (float)(rev - floor(rev));
    return Cplx{mag * __builtin_amdgcn_cosf(fr), mag * __builtin_amdgcn_sinf(fr)};
}
__device__ __forceinline__ Cplx bbar_factor(float lr, float li, float step) {
    const Cplx lb = lam_pow(lr, li, step, 1); const float nr = lb.re - 1.f, ni = lb.im, den = lr * lr + li * li;
    return Cplx{(nr * lr + ni * li) / den, (ni * lr - nr * li) / den};
}
template <int PMODE> __device__ __forceinline__ void p0_prologue(Frame& F) {
    const int gw = F.bx * NWAVES + F.wave, NGW = F.G * NWAVES, lane = F.lane;
    const int gt = F.bx * NTHREADS + F.tid, NGT = F.G * NTHREADS;
    unsigned char* ws = F.ws;
    if (!(PMODE & 1)) {
        LAS float* scr = (LAS float*)(F.lds + LDS_RING) + F.wave * (64 * 65);
        constexpr int I_UP = UP_FP8 ? 0 : 32 * 16 * 32, I_DN = DN_FP8 ? 0 : 32 * 16 * 16, I_IN = IN_FP8 ? 0 : 16 * 32, I_OUT = 16 * 16, I_GLU = 8 * 8;
        constexpr int PER_L = I_UP + I_DN + I_IN + I_OUT + I_GLU, TOTAL = DEPTH * PER_L;
        auto decode = [&](int it) -> TItem {
            TItem ti; const int l = it / PER_L; int r = it % PER_L; const float* W; bf16_t* WT; int K, N; ti.ksc = nullptr; bool f8 = false;
            if (r < I_UP) { const int e = r / 512; r %= 512; K = 1024; N = 2048; W = arg_in(24) + ((size_t)l * NE + e) * 1024 * 2048; WT = (bf16_t*)(ws + WS_WUP + l * WUP_STRIDE) + (size_t)e * 2048 * 1024 / (UP_FP8 ? 2 : 1); f8 = UP_FP8; }
            else if ((r -= I_UP) < I_DN) { const int e = r / 256; r %= 256; K = 1024; N = 1024; W = arg_in(26) + ((size_t)l * NE + e) * 1024 * 1024; WT = (bf16_t*)(ws + WS_WDN + l * WDN_STRIDE) + (size_t)e * 1024 * 1024 / (DN_FP8 ? 2 : 1); f8 = DN_FP8; }
            else if ((r -= I_DN) < I_IN) { K = 1024; N = 2048; W = arg_in(2) + (size_t)l * 1024 * 2048; WT = (bf16_t*)(ws + WS_WIN + l * WIN_STRIDE); }
            else if ((r -= I_IN) < I_OUT) { K = 1024; N = 1024; W = arg_in(20) + (size_t)l * 1024 * 1024; WT = (bf16_t*)(ws + WS_WOUT + l * WOUT_STRIDE); if ((r / 16) * 64 < DS) ti.ksc = arg_in(12) + l * DS + (r / 16) * 64; }
            else { r -= I_OUT; K = 512; N = 512; W = arg_in(11) + (size_t)l * 512 * 512; WT = (bf16_t*)(ws + WS_WGLU + l * WGLU_STRIDE); }
            const int nblk = N / 64, k0 = 64 * (r / nblk), n0 = 64 * (r % nblk);
            ti.src = W + (size_t)k0 * N + n0; ti.dst = WT + (size_t)n0 * K + k0; ti.N = N; ti.K = K; ti.dst8 = f8 ? (unsigned char*)WT + (size_t)n0 * K + k0 : nullptr; return ti;
        };
        f32x4 va[16]; TItem ia;
        for (int it = gw; it < TOTAL; it += NGW) { ia = decode(it); titem_load(ia, va, lane); titem_store(ia, va, scr, lane); }
    }
    if (!(PMODE & 1) && (UP_FP8 || DN_FP8 || IN_FP8)) {
        LAS float* tile = (LAS float*)(F.lds + LDS_RING);
        constexpr int C_UP = UP_FP8 ? 32 * 8 * 8 : 0, C_DN = DN_FP8 ? 32 * 8 * 4 : 0, C_IN = IN_FP8 ? 8 * 8 : 0, C_PER_L = C_UP + C_DN + C_IN, C_TOTAL = DEPTH * C_PER_L;
        auto cdecode = [&](int it, const float*& src, unsigned char*& dst, int& N) {
            const int l = it / C_PER_L; int r = it % C_PER_L; const float* W; unsigned char* WT;
            if (r < C_UP) { const int e = r >> 6; r &= 63; N = 2048; W = arg_in(24) + ((size_t)l * NE + e) * 1024 * 2048; WT = ws + WS_WUP + l * WUP_STRIDE + (size_t)e * 2048 * 1024; }
            else if (r < C_UP + C_DN) { r -= C_UP; const int e = r >> 5; r &= 31; N = 1024; W = arg_in(26) + ((size_t)l * NE + e) * 1024 * 1024; WT = ws + WS_WDN + l * WDN_STRIDE + (size_t)e * 1024 * 1024; }
            else { r -= C_UP + C_DN; N = 2048; W = arg_in(2) + (size_t)l * 1024 * 2048; WT = ws + WS_WIN + l * WIN_STRIDE; }
            const int nblk = N >> 8, k0 = 128 * (r / nblk), n0 = 256 * (r % nblk);
            src = W + (size_t)k0 * N + n0; dst = WT + (size_t)n0 * 1024 + k0;
        };
        auto cload = [&](const float* src, int N, f32x4 (&v)[16]) {
            const float* p = src + (size_t)F.wave * N + 4 * lane;
#pragma unroll
            for (int i = 0; i < 16; ++i) v[i] = __builtin_nontemporal_load((const f32x4*)(p + (size_t)(8 * i) * N));
        };
        auto cstore = [&](unsigned char* dst, f32x4 (&v)[16]) {
            __syncthreads();
#pragma unroll
            for (int i = 0; i < 16; ++i) *(LAS f32x4*)(tile + (8 * i + F.wave) * 260 + 4 * lane) = v[i];
            __syncthreads();
            const int n = F.tid & 255, cc = F.tid >> 8;
#pragma unroll
            for (int j = 0; j < 4; ++j) { const int c = 2 * j + cc; const LAS float* sp = tile + (16 * c) * 260 + n;
                u32x4 o;
                o.x = pk4_fp8(sp[0 * 260] * 64.f, sp[1 * 260] * 64.f, sp[2 * 260] * 64.f, sp[3 * 260] * 64.f); o.y = pk4_fp8(sp[4 * 260] * 64.f, sp[5 * 260] * 64.f, sp[6 * 260] * 64.f, sp[7 * 260] * 64.f);
                o.z = pk4_fp8(sp[8 * 260] * 64.f, sp[9 * 260] * 64.f, sp[10 * 260] * 64.f, sp[11 * 260] * 64.f); o.w = pk4_fp8(sp[12 * 260] * 64.f, sp[13 * 260] * 64.f, sp[14 * 260] * 64.f, sp[15 * 260] * 64.f);
                *(u32x4*)(dst + (size_t)n * 1024 + 16 * c) = o; }
        };
        f32x4 va[16], vb[16]; const float* sa; const float* sb; unsigned char* da; unsigned char* db; int na, nb;
        const bool split = ((F.G & 15) == 0) && (C_TOTAL % (F.G >> 1)) == 0;
        const int per_pair = split ? C_TOTAL / (F.G >> 1) : 0, odd_n = split ? (per_pair * PRO_ODD_SHARE) / 100 : 0;
        const int pairq = ((F.bx >> 4) << 3) | (F.bx & 7), npairs = F.G >> 1;
        const bool oddwg = ((F.bx >> 3) & 1) != 0;
        const int myn = split ? (oddwg ? odd_n : per_pair - odd_n) : 0, j0 = split ? (oddwg ? per_pair - odd_n : 0) : 0;
        auto item = [&](int j) -> int { return split ? ((j < myn) ? pairq + (j0 + j) * npairs : C_TOTAL) : F.bx + j * F.G; };
        int jj = 0; int it = item(0);
        if (it < C_TOTAL) { cdecode(it, sa, da, na); cload(sa, na, va); }
        while (it < C_TOTAL) {
            const int itb = item(jj + 1);
            if (itb < C_TOTAL) { cdecode(itb, sb, db, nb); cload(sb, nb, vb); }
            cstore(da, va);
            if (itb >= C_TOTAL) break;
            const int itc = item(jj + 2);
            if (itc < C_TOTAL) { cdecode(itc, sa, da, na); cload(sa, na, va); }
            cstore(db, vb);
            it = itc; jj += 2;
        }
        __syncthreads();
    }
    phase_begin(F); ws = F.ws;
    if (((F.bx >> 3) & 1) != 0 || (F.G & 15) != 0) {
    phase_begin(F); ws = F.ws; const bool tsplit = (F.G & 15) == 0; const int tbx = tsplit ? (((F.bx >> 4) << 3) | (F.bx & 7)) : F.bx, tG = tsplit ? (F.G >> 1) : F.G, tgt = tbx * NTHREADS + F.tid, tNGT = tG * NTHREADS;
    for (int i = tbx * NTHREADS + F.tid; i < SEQ * 32; i += tNGT) {
        const int s = i >> 5, j = i & 31;
        const float inv = 1.0f / powf(10000.0f, (float)(2 * j) / 64.0f);
        const float ang = (float)s * inv;
        ((float*)(ws + WS_COS))[i] = (float)cos((double)ang); ((float*)(ws + WS_SIN))[i] = (float)sin((double)ang);
    }
    if (tbx == 0 && F.wave < DEPTH) {
        const int l = F.wave;
        float a = arg_in(15)[l * 64 + lane] * arg_in(16)[l * 64 + lane], b = arg_in(17)[l * 64 + lane] * arg_in(18)[l * 64 + lane];
        a = wave_sum(a); b = wave_sum(b);
        float mq = fabsf(arg_in(13)[l * 64 + lane]), mk = fabsf(arg_in(14)[l * 64 + lane]);
#pragma unroll
        for (int o = 1; o < 64; o <<= 1) { mq = fmaxf(mq, __shfl_xor(mq, o)); mk = fmaxf(mk, __shfl_xor(mk, o)); }
        const float lambda_init = 0.8f - 0.6f * expf(-0.3f * (float)l);
        { float* gqk = (float*)(ws + WS_SCAL) + 64 + l * 128; gqk[lane] = arg_in(13)[l * 64 + lane]; gqk[64 + lane] = arg_in(14)[l * 64 + lane]; }
        if (lane == 0) { float* sc = (float*)(ws + WS_SCAL) + l * 4; sc[0] = expf(a) - expf(b) + lambda_init; sc[1] = C2 * 64.f * mq * mk * 1.02f + 0.5f; sc[2] = 1.0f - lambda_init; }
    }
    for (int i = tgt; i < DEPTH * NE * D; i += tNGT) {
        const int l = i / (NE * D), e = (i / D) % NE, k = i % D;
        const float w = arg_in(22)[(size_t)l * D * NE + (size_t)k * NE + e];
        const unsigned hi = f2bf(w); const float lo = w - __builtin_bit_cast(float, hi << 16);
        bf16_t* t = (bf16_t*)(ws + WS_WRT + l * WRT_STRIDE);
        t[e * D + k] = (bf16_t)hi; t[NE * D + e * D + k] = (bf16_t)f2bf(lo);
    }
    phase_begin(F); ws = F.ws;
#define TBL_PTRS(l) const float* lam_re = arg_in(3) + (l) * NG * NP; const float* lam_im = arg_in(4) + (l) * NG * NP; const float* log_step = arg_in(5) + (l) * NG; \
        const float* b_re = arg_in(6) + (size_t)(l) * NG * NP * HS; const float* b_im = arg_in(7) + (size_t)(l) * NG * NP * HS; \
        const float* c_re = arg_in(8) + (size_t)(l) * NG * HS * NP; const float* c_im = arg_in(9) + (size_t)(l) * NG * HS * NP; \
        bf16_t* KT = (bf16_t*)(ws + WS_KT + (l) * KT_STRIDE); bf16_t* HT = (bf16_t*)(ws + WS_HT + (l) * HT_STRIDE); (void)KT; (void)HT; (void)b_re; (void)b_im
    if (!(PMODE & 2)) {
        {
            LAS float* pwl = (LAS float*)(F.lds + LDS_RING);
            for (int cb = tbx; cb < DEPTH * NG * 17; cb += tG) {
                const int l = cb / (NG * 17), rb = cb % (NG * 17);
                if (rb >= NG * 9) continue;
                const int blk = rb;
                TBL_PTRS(l);
                const int g = blk / 9, s0 = (blk % 9) * 8;
                const float step = expf(log_step[g]);
                LAS float* cgl = pwl + 1024;
                LAS float* ffl = cgl + 2048;
                LAS float* bgl = ffl + 128;
                __syncthreads();
                { const int p = F.tid & 63, sl = F.tid >> 6, slot = s0 + sl; Cplx w{0.f, 0.f};
                  if (slot >= 1 && slot <= 64) w = lam_pow_fast(lam_re[g * NP + p], lam_im[g * NP + p], step, slot - 1);
                  pwl[(sl * 64 + p) * 2] = w.re; pwl[(sl * 64 + p) * 2 + 1] = w.im; }
                for (int idx = F.tid; idx < 1024; idx += NTHREADS) { cgl[2 * idx] = c_re[(size_t)g * HS * NP + idx]; cgl[2 * idx + 1] = c_im[(size_t)g * HS * NP + idx]; }
                if (F.tid < 64) { const Cplx f = bbar_factor(lam_re[g * NP + F.tid], lam_im[g * NP + F.tid], step); ffl[2 * F.tid] = f.re; ffl[2 * F.tid + 1] = f.im; }
                __syncthreads();
                for (int idx = F.tid; idx < 1024; idx += NTHREADS) { const int p = idx >> 4; const Cplx w = cmul(Cplx{ffl[2 * p], ffl[2 * p + 1]}, Cplx{b_re[(size_t)g * NP * HS + idx], b_im[(size_t)g * NP * HS + idx]}); bgl[2 * idx] = w.re; bgl[2 * idx + 1] = w.im; }
                __syncthreads();
                const int pq = F.tid & 3, h = (F.tid >> 2) & 15, sl = F.tid >> 6, slot = s0 + sl;
                float accv[16];
#pragma unroll
                for (int q = 0; q < 16; ++q) accv[q] = 0.f;
                for (int pp = 0; pp < 16; ++pp) {
                    const int p = pq * 16 + pp;
                    const Cplx w = cmul(Cplx{cgl[(h * 64 + p) * 2], cgl[(h * 64 + p) * 2 + 1]}, Cplx{pwl[(sl * 64 + p) * 2], pwl[(sl * 64 + p) * 2 + 1]});
                    const LAS f32x4* bp = (const LAS f32x4*)(bgl + p * 32);
#pragma unroll
                    for (int q2 = 0; q2 < 8; ++q2) { const f32x4 bb = bp[q2]; accv[2 * q2] += w.re * bb[0] - w.im * bb[1]; accv[2 * q2 + 1] += w.re * bb[2] - w.im * bb[3]; }
                }
#pragma unroll
                for (int q = 0; q < 16; ++q) { accv[q] += __shfl_xor(accv[q], 1); accv[q] += __shfl_xor(accv[q], 2); }
                if (pq == 0 && slot <= 64) {
                    u32x4 o0, o1; o0.x = pk2(accv[0], accv[1]); o0.y = pk2(accv[2], accv[3]); o0.z = pk2(accv[4], accv[5]); o0.w = pk2(accv[6], accv[7]);
                    o1.x = pk2(accv[8], accv[9]); o1.y = pk2(accv[10], accv[11]); o1.z = pk2(accv[12], accv[13]); o1.w = pk2(accv[14], accv[15]);
                    u32x4* dst = (u32x4*)(KT + ((size_t)(g * 65 + slot) * HS + h) * 16); dst[0] = o0; dst[1] = o1;
                }
            }
            for (int cb = tbx; cb < DEPTH * NG * 17; cb += tG) {
                const int l = cb / (NG * 17), rb = cb % (NG * 17);
                if (rb < NG * 9) continue;
                const int blk = rb - NG * 9;
                TBL_PTRS(l);
                const int g = blk >> 3, t0 = (blk & 7) * 8;
                const float step = expf(log_step[g]);
                __syncthreads();
                LAS float* cgl = pwl + 1024;
                { const int p = F.tid & 63, tl = F.tid >> 6; const Cplx w = lam_pow_fast(lam_re[g * NP + p], lam_im[g * NP + p], step, t0 + tl + 1); pwl[(tl * 64 + p) * 2] = w.re; pwl[(tl * 64 + p) * 2 + 1] = w.im; }
                for (int idx = F.tid; idx < 1024; idx += NTHREADS) { cgl[2 * idx] = c_re[(size_t)g * HS * NP + idx]; cgl[2 * idx + 1] = c_im[(size_t)g * HS * NP + idx]; }
                __syncthreads();
                const int pq = F.tid & 3, h = (F.tid >> 2) & 15, tl = F.tid >> 6, t = t0 + tl;
                bf16_t* dst = HT + ((size_t)(g * 1024 + t * 16 + h) * 128 + pq * 32);
                for (int pp = 0; pp < 16; pp += 4) {
                    float v[8];
#pragma unroll
                    for (int q = 0; q < 4; ++q) { const int p = pq * 16 + pp + q;
                        const Cplx w = cmul(Cplx{cgl[(h * 64 + p) * 2], cgl[(h * 64 + p) * 2 + 1]}, Cplx{pwl[(tl * 64 + p) * 2], pwl[(tl * 64 + p) * 2 + 1]});
                        v[2 * q] = w.re; v[2 * q + 1] = -w.im; }
                    u32x4 o; o.x = pk2(v[0], v[1]); o.y = pk2(v[2], v[3]); o.z = pk2(v[4], v[5]); o.w = pk2(v[6], v[7]);
                    *(u32x4*)(dst + 2 * pp) = o;
                }
            }
            __syncthreads();
        }
    }
#undef TBL_PTRS
    if (!(PMODE & 2)) for (int l = 0; l < DEPTH; ++l) {
        const float* lam_re = arg_in(3) + l * NG * NP; const float* lam_im = arg_in(4) + l * NG * NP; const float* log_step = arg_in(5) + l * NG;
        const float* b_re = arg_in(6) + (size_t)l * NG * NP * HS; const float* b_im = arg_in(7) + (size_t)l * NG * NP * HS;
        const float* c_re = arg_in(8) + (size_t)l * NG * HS * NP; const float* c_im = arg_in(9) + (size_t)l * NG * HS * NP;
        bf16_t* KT = (bf16_t*)(ws + WS_KT + l * KT_STRIDE); bf16_t* GT = (bf16_t*)(ws + WS_GT + l * GT_STRIDE); bf16_t* HT = (bf16_t*)(ws + WS_HT + l * HT_STRIDE);
        float* LAML = (float*)(ws + WS_LAML + l * LAML_STRIDE);
        for (int i = tgt; i < NG * NP * 64; i += tNGT) {
            const int s = i % 64, p = (i / 64) % NP, g = i / (64 * NP);
            const float step = expf(log_step[g]); const float lr = lam_re[g * NP + p], li = lam_im[g * NP + p];
            const Cplx w = cmul(lam_pow_fast(lr, li, step, 63 - s), bbar_factor(lr, li, step));
            float vr[16], vi[16];
#pragma unroll
            for (int q = 0; q < 16; ++q) { const float br = b_re[(size_t)(g * NP + p) * HS + q], bi = b_im[(size_t)(g * NP + p) * HS + q]; vr[q] = w.re * br - w.im * bi; vi[q] = w.re * bi + w.im * br; }
            auto gaddr = [&](int m, int half) -> u32x4* { const int kq = (s & 1) * 2 + half; return (u32x4*)(GT + ((((size_t)(g * 2 + (m >> 6)) * 4 + ((m >> 4) & 3)) * 32 + (s >> 1)) * 512 + (kq * 16 + (m & 15)) * 8)); };
            u32x4 o; o.x = pk2(vr[0], vr[1]); o.y = pk2(vr[2], vr[3]); o.z = pk2(vr[4], vr[5]); o.w = pk2(vr[6], vr[7]); *gaddr(2 * p, 0) = o;
            o.x = pk2(vr[8], vr[9]); o.y = pk2(vr[10], vr[11]); o.z = pk2(vr[12], vr[13]); o.w = pk2(vr[14], vr[15]); *gaddr(2 * p, 1) = o;
            o.x = pk2(vi[0], vi[1]); o.y = pk2(vi[2], vi[3]); o.z = pk2(vi[4], vi[5]); o.w = pk2(vi[6], vi[7]); *gaddr(2 * p + 1, 0) = o;
            o.x = pk2(vi[8], vi[9]); o.y = pk2(vi[10], vi[11]); o.z = pk2(vi[12], vi[13]); o.w = pk2(vi[14], vi[15]); *gaddr(2 * p + 1, 1) = o;
        }
        for (int i = tgt; i < NG * NP; i += tNGT) { const int g = i / NP; const Cplx w = lam_pow(lam_re[i], lam_im[i], expf(log_step[g]), 64); LAML[2 * i] = w.re; LAML[2 * i + 1] = w.im; }
    }
    }
    phase_begin(F); ws = F.ws;
    {
        const float* xin = arg_in(0); const float* g0 = arg_in(1); bf16_t* XN = (bf16_t*)(ws + WS_XN);
        f32x4 va[4], vb[4], vc[4];
        auto ldrow = [&](f32x4 (&v)[4], int row) { if (row < T) {
#pragma unroll
            for (int j = 0; j < 4; ++j) v[j] = __builtin_nontemporal_load(((const f32x4*)(xin + (size_t)row * D) + lane) + 64 * j); } };
        auto fin = [&](const f32x4 (&v)[4], int row) { rms_row_to_bf16(v, g0, (bf16_t*)((unsigned char*)XN + (size_t)row * D * (IN_FP8 ? 1 : 2)), lane); };
        int m = gw;
        ldrow(va, m); ldrow(vb, m + NGW);
        while (m < T) {
            ldrow(vc, m + 2 * NGW); fin(va, m); m += NGW; if (m >= T) break;
            ldrow(va, m + 2 * NGW); fin(vb, m); m += NGW; if (m >= T) break;
            ldrow(vb, m + 2 * NGW); fin(vc, m); m += NGW;
        }
    }
}

__device__ __forceinline__ void s5_glds16(const void* gsrc, unsigned lds_dst) { unsigned keep;
    asm volatile("s_mov_b32 %0, m0\n\ts_mov_b32 m0, %2\n\ts_nop 0\n\tglobal_load_lds_dwordx4 %1, off\n\ts_mov_b32 m0, %0" : "=&s"(keep) : "v"(gsrc), "s"(lds_dst) : "memory"); }
__device__ __forceinline__ void s5a_phase(Frame& F, int l) {
    const bf16_t* GT = (const bf16_t*)(F.ws + WS_GT + l * GT_STRIDE); const bf16_t* U = (const bf16_t*)(F.ws + WS_U); float* S = (float*)(F.ws + WS_S);
    const int lane = F.lane, n = lane & 15, kq = lane >> 4;
    for (int uu = F.bx * NWAVES + F.wave; uu < NG * 32 * 2; uu += F.G * NWAVES) {
        const int g = uu >> 6, ntile = (uu >> 1) & 31, mh = uu & 1;
        const int chunk = ntile * 16 + n;
        const bf16_t* up = U + (((size_t)g * T + (size_t)chunk * 64 + (kq >> 1)) * 16 + 8 * (kq & 1));
        const bf16_t* gp = GT + ((size_t)(g * 2 + mh) * 65536 + lane * 8);
        f32x4 acc[4];
#pragma unroll
        for (int mt = 0; mt < 4; ++mt) acc[mt] = (f32x4){0.f, 0.f, 0.f, 0.f};
        bf16x8 fb[2][4], fa[2][4][4];
#define S5A_LD(buf, kg) do { _Pragma("unroll") for (int i = 0; i < 4; ++i) { const int ks = 4 * (kg) + i; fb[buf][i] = *(const bf16x8*)(up + (size_t)(2 * ks) * 16); \
            _Pragma("unroll") for (int mt = 0; mt < 4; ++mt) fa[buf][i][mt] = *(const bf16x8*)(gp + (size_t)mt * 16384 + 512 * ks); } } while (0)
        S5A_LD(0, 0);
#pragma unroll
        for (int kg = 0; kg < 8; ++kg) {
            if (kg + 1 < 8) S5A_LD((kg + 1) & 1, kg + 1);
#pragma unroll
            for (int i = 0; i < 4; ++i)
#pragma unroll
                for (int mt = 0; mt < 4; ++mt) acc[mt] = __builtin_amdgcn_mfma_f32_16x16x32_bf16(fa[kg & 1][i][mt], fb[kg & 1][i], acc[mt], 0, 0, 0);
        }
#undef S5A_LD
#pragma unroll
        for (int mt = 0; mt < 4; ++mt) *(f32x4*)(S + ((size_t)chunk * NG + g) * 128 + mh * 64 + mt * 16 + 4 * kq) = acc[mt];
    }
}
template <int SPROBE> __device__ __forceinline__ void s5c_phase(Frame& F, int l) {
    const bf16_t* KT = (const bf16_t*)(F.ws + WS_KT + l * KT_STRIDE); const bf16_t* HT = (const bf16_t*)(F.ws + WS_HT + l * HT_STRIDE);
    const float* LAML = (const float*)(F.ws + WS_LAML + l * LAML_STRIDE); const float* S = (const float*)(F.ws + WS_S);
    const bf16_t* U = (const bf16_t*)(F.ws + WS_U); bf16_t* YG = (bf16_t*)(F.ws + WS_YG); const float* dsk = arg_in(10) + l * DS;
    const int lane = F.lane, n = lane & 15, kq = lane >> 4, wave = F.wave;
    LAS unsigned char* ktz = F.lds + LDS_RING;
    LAS unsigned char* ktl = ktz + 14 * 512;
    LAS unsigned char* xs = F.lds + LDS_RING + 40960 + wave * 4352;
    LAS f32x2* EB = (LAS f32x2*)(F.lds + LDS_RING + 40960 + 8 * 4352);
    LAS f32x2* EH = EB + 512;
    for (int wu = F.bx; wu < NG * 8; wu += F.G) {
        const int g = wu >> 3, scq = wu & 7, b = scq >> 1, cbase = (scq & 1) * 64, scl = wave >> 1, par = wave & 1;
        __syncthreads();
        const unsigned char* htg = (const unsigned char*)HT + (size_t)g * 262144;
        const unsigned hring = (unsigned)(uintptr_t)(F.lds + LDS_RING + 86016);
#define S5_HT_DMA(q) do { _Pragma("unroll") for (int i = 0; i < 4; ++i) { const int r = (i * 8 + wave) * 4 + (lane >> 4), c = lane & 15; \
            s5_glds16(htg + (size_t)(q) * 32768 + r * 256 + ((c ^ (r & 15)) * 16), (unsigned)__builtin_amdgcn_readfirstlane((int)(hring + ((q) & 1) * 32768 + (i * 8 + wave) * 1024))); } } while (0)
        S5_HT_DMA(0);
        for (int i = F.tid; i < 65 * 32; i += NTHREADS) *(LAS u32x4*)(ktl + i * 16) = *(const u32x4*)(KT + (size_t)g * 65 * 256 + i * 8);
        if (F.tid < 14 * 32) { unsigned z0 = 0u; asm volatile("" : "+v"(z0)); *(LAS u32x4*)(ktz + F.tid * 16) = (u32x4){z0, z0, z0, z0}; }
        const Cplx L = Cplx{LAML[(g * NP + lane) * 2], LAML[(g * NP + lane) * 2 + 1]};
        const float* sp = S + ((size_t)(b * CPB) * NG + g) * 128 + 2 * lane;
        {
            f32x2 sv[8];
#pragma unroll
            for (int j = 0; j < 8; ++j) sv[j] = *(const f32x2*)(sp + (size_t)(cbase + 8 * wave + j) * NG * 128);
            Cplx E{0.f, 0.f};
#pragma unroll
            for (int j = 0; j < 8; ++j) { const Cplx nx = cmul(L, E); E.re = nx.re + sv[j][0]; E.im = nx.im + sv[j][1]; }
            EB[wave * 64 + lane] = (f32x2){E.re, E.im};
            if (cbase) {
#pragma unroll
                for (int j = 0; j < 8; ++j) sv[j] = *(const f32x2*)(sp + (size_t)(8 * wave + j) * NG * 128);
                Cplx H{0.f, 0.f};
#pragma unroll
                for (int j = 0; j < 8; ++j) { const Cplx nx = cmul(L, H); H.re = nx.re + sv[j][0]; H.im = nx.im + sv[j][1]; }
                EH[wave * 64 + lane] = (f32x2){H.re, H.im};
            }
        }
        __syncthreads();
        const int c0 = cbase + 16 * scl;
        {
            const Cplx L2 = cmul(L, L), L4 = cmul(L2, L2), L8 = cmul(L4, L4);
            Cplx X{0.f, 0.f};
            if (cbase) {
#pragma unroll
                for (int w = 0; w < 8; ++w) { const f32x2 e = EH[w * 64 + lane]; const Cplx nx = cmul(L8, X); X.re = nx.re + e[0]; X.im = nx.im + e[1]; }
            }
            for (int w = 0; w < 2 * scl; ++w) { const f32x2 e = EB[w * 64 + lane]; const Cplx nx = cmul(L8, X); X.re = nx.re + e[0]; X.im = nx.im + e[1]; }
            f32x2 sv[16];
#pragma unroll
            for (int j = 0; j < 16; ++j) sv[j] = *(const f32x2*)(sp + (size_t)(c0 + j) * NG * 128);
#pragma unroll
            for (int j = 0; j < 16; ++j) {
                *(LAS unsigned*)(xs + j * 272 + 4 * lane) = pk2(X.re, X.im);
                const Cplx nx = cmul(L, X); X.re = nx.re + sv[j][0]; X.im = nx.im + sv[j][1];
            }
        }
        const int chunk = b * CPB + c0 + n;
        bf16x8 ub[32];
        {
            const bf16_t* up = U + (((size_t)g * T + (size_t)chunk * 64 + (kq >> 1)) * 16 + 8 * (kq & 1));
#pragma unroll
            for (int kp = 0; kp < 32; ++kp) ub[kp] = *(const bf16x8*)(up + (size_t)(2 * kp) * 16);
        }
        const LAS unsigned char* xbp = xs + n * 272 + 16 * kq;
        const f32x4 dv = *(const f32x4*)(dsk + g * 16 + 4 * kq);
        const LAS unsigned char* kbase = ktl + (n * 16 + 8 * (kq & 1)) * 2;
        const LAS unsigned char* hrd = F.lds + LDS_RING + 86016 + n * 256;
        const int bsrc = 4 * (n + 16 * (2 * par + (kq >> 1)));
        int nq = 8; asm volatile("" : "+s"(nq));
        if (SPROBE & 2) nq = 0;
        for (int q = 0; q < nq; ++q) {
            asm volatile("s_waitcnt vmcnt(2) lgkmcnt(0)\n\ts_barrier" ::: "memory");
            if (q + 1 < 8) S5_HT_DMA(q + 1);
            u32x4 cu[4];
            switch (q) {
#define S5_CASE(Q) case Q: cu[0] = __builtin_bit_cast(u32x4, ub[4 * Q]); cu[1] = __builtin_bit_cast(u32x4, ub[4 * Q + 1]); cu[2] = __builtin_bit_cast(u32x4, ub[4 * Q + 2]); cu[3] = __builtin_bit_cast(u32x4, ub[4 * Q + 3]); break;
                S5_CASE(0) S5_CASE(1) S5_CASE(2) S5_CASE(3) S5_CASE(4) S5_CASE(5) S5_CASE(6) default: S5_CASE(7)
#undef S5_CASE
            }
            const LAS unsigned char* hb = hrd + (q & 1) * 32768;
#pragma unroll 1
        for (int j = 0; j < 4; ++j) {
            const int ti = 4 * q + j, t = 2 * ti + par;
            u32x2 uw;
            { const u32x4 cj = j == 0 ? cu[0] : j == 1 ? cu[1] : j == 2 ? cu[2] : cu[3];
              const unsigned x = (unsigned)__builtin_amdgcn_ds_bpermute(bsrc, (int)cj.x), y = (unsigned)__builtin_amdgcn_ds_bpermute(bsrc, (int)cj.y);
              const unsigned z = (unsigned)__builtin_amdgcn_ds_bpermute(bsrc, (int)cj.z), w = (unsigned)__builtin_amdgcn_ds_bpermute(bsrc, (int)cj.w);
              uw.x = (kq & 1) ? z : x; uw.y = (kq & 1) ? w : y; }
            f32x4 acc0 = (f32x4){0.f, 0.f, 0.f, 0.f}, acc1 = acc0;
            const int slot0 = t + 1 - (kq >> 1);
            const LAS unsigned char* kp0 = kbase + slot0 * 512;
            bf16x8 fa[4], fb[4];
#define S5_AF(buf, G) do { const LAS unsigned char* gb = kp0 - (4 * (G) + 3) * 1024; _Pragma("unroll") for (int j = 0; j < 4; ++j) buf[j] = *(const LAS bf16x8*)(gb + (3 - j) * 1024); } while (0)
#define S5_MM(buf, G) do { acc0 = __builtin_amdgcn_mfma_f32_16x16x32_bf16(buf[0], ub[4 * (G)], acc0, 0, 0, 0); acc1 = __builtin_amdgcn_mfma_f32_16x16x32_bf16(buf[1], ub[4 * (G) + 1], acc1, 0, 0, 0); \
                           acc0 = __builtin_amdgcn_mfma_f32_16x16x32_bf16(buf[2], ub[4 * (G) + 2], acc0, 0, 0, 0); acc1 = __builtin_amdgcn_mfma_f32_16x16x32_bf16(buf[3], ub[4 * (G) + 3], acc1, 0, 0, 0); } while (0)
#define S5_PIN(buf) asm volatile("" : "+v"(buf[0]), "+v"(buf[1]), "+v"(buf[2]), "+v"(buf[3]))
#define S5_SB() __builtin_amdgcn_sched_barrier(0)
            do { S5_AF(fa, 0); S5_SB();
                 S5_AF(fb, 1); S5_SB(); S5_MM(fa, 0); S5_SB(); S5_PIN(fb); if (ti < 4) break;
                 S5_AF(fa, 2); S5_SB(); S5_MM(fb, 1); S5_SB(); S5_PIN(fa); if (ti < 8) break;
                 S5_AF(fb, 3); S5_SB(); S5_MM(fa, 2); S5_SB(); S5_PIN(fb); if (ti < 12) break;
                 S5_AF(fa, 4); S5_SB(); S5_MM(fb, 3); S5_SB(); S5_PIN(fa); if (ti < 16) break;
                 S5_AF(fb, 5); S5_SB(); S5_MM(fa, 4); S5_SB(); S5_PIN(fb); if (ti < 20) break;
                 S5_AF(fa, 6); S5_SB(); S5_MM(fb, 5); S5_SB(); S5_PIN(fa); if (ti < 24) break;
                 S5_AF(fb, 7); S5_SB(); S5_MM(fa, 6); S5_SB(); S5_PIN(fb); if (ti < 28) break;
                 S5_MM(fb, 7);
            } while (0);
#undef S5_AF
#undef S5_MM
#undef S5_PIN
#undef S5_SB
            {
                bf16x8 xb[4], ha[4];
#pragma unroll
                for (int ks = 0; ks < 4; ++ks) { xb[ks] = *(const LAS bf16x8*)(xbp + 64 * ks); ha[ks] = *(const LAS bf16x8*)(hb + (2 * j + par) * 4096 + (((kq + 4 * ks) ^ n) * 16)); }
                acc0 = __builtin_amdgcn_mfma_f32_16x16x32_bf16(ha[0], xb[0], acc0, 0, 0, 0); acc1 = __builtin_amdgcn_mfma_f32_16x16x32_bf16(ha[1], xb[1], acc1, 0, 0, 0);
                acc0 = __builtin_amdgcn_mfma_f32_16x16x32_bf16(ha[2], xb[2], acc0, 0, 0, 0); acc1 = __builtin_amdgcn_mfma_f32_16x16x32_bf16(ha[3], xb[3], acc1, 0, 0, 0);
            }
            const f32x4 acc = acc0 + acc1;
            const float y0 = acc[0] + dv[0] * bf_lo(uw.x), y1 = acc[1] + dv[1] * bf_hi(uw.x), y2 = acc[2] + dv[2] * bf_lo(uw.y), y3 = acc[3] + dv[3] * bf_hi(uw.y);
            u32x2 w; w.x = cvt_pk_bf16(gelu_tanh(y0), gelu_tanh(y1)); w.y = cvt_pk_bf16(gelu_tanh(y2), gelu_tanh(y3));
            *(u32x2*)(YG + ((size_t)chunk * 64 + t) * DS + g * 16 + 4 * kq) = w;
        }
        }
    }
    __syncthreads();
}

namespace att {
constexpr int KSLOT = 8192, VSLOT = 16384, NSLOT = 4, LDS_K = 0, LDS_V = NSLOT * KSLOT, LDS_WS = NSLOT * (KSLOT + VSLOT), LDS_END = LDS_WS + 8 * 256;
constexpr int STG_ROW = 136;
__device__ __forceinline__ int crow(int r, int hi) { return (r & 3) + 8 * (r >> 2) + 4 * hi; }
__device__ __forceinline__ void glds16(const void* gsrc, unsigned lds_dst) { unsigned keep;
    asm volatile("s_mov_b32 %0, m0\n\ts_mov_b32 m0, %2\n\ts_nop 0\n\tglobal_load_lds_dwordx4 %1, off\n\ts_mov_b32 m0, %0" : "=&s"(keep) : "v"(gsrc), "s"(lds_dst) : "memory"); }
typedef __attribute__((address_space(3))) const char* lds_cptr;
typedef short v4i16_t __attribute__((ext_vector_type(4)));
__device__ __forceinline__ s16x4 vtr(lds_cptr p) { return __builtin_bit_cast(s16x4, __builtin_amdgcn_ds_read_tr16_b64_v4i16((__attribute__((address_space(3))) v4i16_t*)p)); }
#define ATT_WAIT_BAR(N) asm volatile("s_waitcnt vmcnt(" #N ") lgkmcnt(0)\n\ts_barrier" ::: "memory")

template <int MODE> __device__ __forceinline__ void attn_unit(int bh, int qb, const bf16_t* Q, const bf16_t* K, const bf16_t* V, bf16_t* MIX, const float* subg, float lam, float mshift, float oml,
                                          LAS unsigned char* shm, int tid) {
    const int lane = tid & 63, r32 = lane & 31, hi = lane >> 5; const int wid = __builtin_amdgcn_readfirstlane(tid >> 6);
    const int b = bh >> 2, h = bh & 3, m = wid & 1, qg = wid >> 1;
    const size_t rowbase = (size_t)b * SEQ; const int q0 = qb * 128;
    const int NT = 2 * qb + 2, cw = 2 * qb + (qg >> 1);
    const unsigned lds0 = (unsigned)(uintptr_t)shm;
    const unsigned char* k0src = (const unsigned char*)K + rowbase * DA + h * 8192 + wid * 1024 + lane * 16;
    const bf16_t* v0src = V + rowbase * DA + h * 8192 + wid * 512 + lane * 8;
    const bf16_t* v1src = v0src + 4096;
    const unsigned kdst = lds0 + LDS_K + (wid >> 2) * 4096 + (wid & 3) * 1024, vdst = lds0 + LDS_V + wid * 1024;
#define ATT_DMA(t, slot) do { const size_t _o = (size_t)(t) * 64 * DA; \
        glds16(k0src + _o, (unsigned)__builtin_amdgcn_readfirstlane(kdst + (slot) * KSLOT)); glds16(k1src + _o, (unsigned)__builtin_amdgcn_readfirstlane(kdst + (slot) * KSLOT + 8192)); \
        glds16(v0src + _o, (unsigned)__builtin_amdgcn_readfirstlane(vdst + (slot) * VSLOT)); glds16(v1src + _o, (unsigned)__builtin_amdgcn_readfirstlane(vdst + (slot) * VSLOT + 8192)); } while (0)
    v8i32 qf;
    { const unsigned char* Qw = (const unsigned char*)Q + (rowbase + q0 + qg * 32 + r32) * DA + h * 128 + m * 64 + hi * 32;
      const u32x4 ql = *(const u32x4*)(Qw), qh = *(const u32x4*)(Qw + 16); qf = __builtin_bit_cast(v8i32, __builtin_shufflevector(ql, qh, 0, 1, 2, 3, 4, 5, 6, 7)); }
#ifndef ATT_GRP
#define ATT_GRP (wid & 1)
#endif
    const int grp = ATT_GRP;
#define ATT_DMA_K(t, slot) do { if (MODE & 1) break; const size_t _o = (size_t)(t) * 64 * DA; \
        glds16(k0src + _o, (unsigned)__builtin_amdgcn_readfirstlane(kdst + (slot) * KSLOT)); } while (0)
#define ATT_DMA_V(t, slot) do { if (MODE & 1) break; const size_t _o = (size_t)(t) * 64 * DA; \
        glds16(v0src + _o, (unsigned)__builtin_amdgcn_readfirstlane(vdst + (slot) * VSLOT)); glds16(v1src + _o, (unsigned)__builtin_amdgcn_readfirstlane(vdst + (slot) * VSLOT + 8192)); } while (0)
    ATT_DMA_K(0, 0); ATT_DMA_V(0, 0); ATT_DMA_K(1, 1); ATT_DMA_V(1, 1); if (NT > 2) { ATT_DMA_K(2, 2); ATT_DMA_V(2, 2); }
    f32x16 o[4];
#pragma unroll
    for (int d = 0; d < 4; ++d)
#pragma unroll
        for (int r = 0; r < 16; ++r) o[d][r] = 0.f;
    float l_reg = 0.f;
    const f32x16 zero16 = {0.f, 0.f, 0.f, 0.f, 0.f, 0.f, 0.f, 0.f, 0.f, 0.f, 0.f, 0.f, 0.f, 0.f, 0.f, 0.f};
    (void)mshift;
    const lds_cptr shm3 = (lds_cptr)shm;
    const lds_cptr kp0 = shm3 + LDS_K + m * 4096 + hi * 2048 + r32 * 16;
    const lds_cptr vp0 = shm3 + LDS_V + ((lane >> 4) & 1) * 32 + (lane & 3) * 8 + (4 * hi + ((lane & 15) >> 2)) * 64;
    u32x4 pw[4];
#pragma unroll
    for (int q = 0; q < 4; ++q) pw[q] = (u32x4){0u, 0u, 0u, 0u};
#define ATT_SB() __builtin_amdgcn_sched_barrier(0)
#define ATT_QKEXP(sl) do { if (MODE & 2) break; const lds_cptr kp = kp0 + (sl) * KSLOT; \
        ATT_SB(); \
        const u32x4 k0l = *(const __attribute__((address_space(3))) u32x4*)(kp), k0h = *(const __attribute__((address_space(3))) u32x4*)(kp + 1024); \
        const u32x4 k1l = *(const __attribute__((address_space(3))) u32x4*)(kp + 512), k1h = *(const __attribute__((address_space(3))) u32x4*)(kp + 1024 + 512); \
        ATT_SB(); \
        const v8i32 kf0 = __builtin_bit_cast(v8i32, __builtin_shufflevector(k0l, k0h, 0, 1, 2, 3, 4, 5, 6, 7)), kf1 = __builtin_bit_cast(v8i32, __builtin_shufflevector(k1l, k1h, 0, 1, 2, 3, 4, 5, 6, 7)); \
        f32x16 p0 = __builtin_amdgcn_mfma_scale_f32_32x32x64_f8f6f4(kf0, qf, zero16, 0, 0, 0, 0x7a7b, 1, 0x7a7b); \
        f32x16 p1 = __builtin_amdgcn_mfma_scale_f32_32x32x64_f8f6f4(kf1, qf, zero16, 0, 0, 0, 0x7a7b, 1, 0x7a7b); \
        ATT_SB(); \
        float sacc = 0.f; \
        _Pragma("unroll") for (int r = 0; r < 16; ++r) { p0[r] = __builtin_amdgcn_exp2f(p0[r]); p1[r] = __builtin_amdgcn_exp2f(p1[r]); sacc += p0[r] + p1[r]; } \
        l_reg += sacc; \
        _Pragma("unroll") for (int q = 0; q < 4; ++q) { pw[0][q] = cvt_pk_bf16(p0[2 * q], p0[2 * q + 1]); pw[1][q] = cvt_pk_bf16(p0[8 + 2 * q], p0[8 + 2 * q + 1]); \
                                                        pw[2][q] = cvt_pk_bf16(p1[2 * q], p1[2 * q + 1]); pw[3][q] = cvt_pk_bf16(p1[8 + 2 * q], p1[8 + 2 * q + 1]); } } while (0)
#define ATT_VRD(buf, d) do { _Pragma("unroll") for (int ks = 0; ks < 4; ++ks) { buf[0][ks] = vtr(vp + (d) * 4096 + ks * 1024); buf[1][ks] = vtr(vp + (d) * 4096 + ks * 1024 + 512); } } while (0)
#define ATT_VMM(buf, d, PW) do { _Pragma("unroll") for (int ks = 0; ks < 4; ++ks) { \
        const bf16x8 vf = (bf16x8){buf[0][ks][0], buf[0][ks][1], buf[0][ks][2], buf[0][ks][3], buf[1][ks][0], buf[1][ks][1], buf[1][ks][2], buf[1][ks][3]}; \
        o[d] = __builtin_amdgcn_mfma_f32_32x32x16_bf16(__builtin_bit_cast(bf16x8, PW[ks]), vf, o[d], 0, 0, 0); } } while (0)
#define ATT_PV(sl, PW) do { if (MODE & 4) break; const lds_cptr vp = vp0 + (sl) * VSLOT; s16x4 va[2][4], vb[2][4]; \
        ATT_SB(); ATT_VRD(va, 0); ATT_SB(); ATT_VRD(vb, 1); ATT_SB(); ATT_VMM(va, 0, PW); ATT_SB(); ATT_VRD(va, 2); ATT_SB(); ATT_VMM(vb, 1, PW); ATT_SB(); \
        ATT_VRD(vb, 3); ATT_SB(); ATT_VMM(va, 2, PW); ATT_SB(); ATT_VMM(vb, 3, PW); ATT_SB(); } while (0)
    u32x4 pwn[4];
#define ATT_PIN(x) asm volatile("" : "+v"(x))
#define ATT_MM(d, ks, cur, nxt, PW) do { \
        if ((d) < 3) { nxt[0][ks] = vtr(vp + ((d) + 1) * 4096 + (ks) * 1024); nxt[1][ks] = vtr(vp + ((d) + 1) * 4096 + (ks) * 1024 + 512); } \
        { const bf16x8 vf = (bf16x8){cur[0][ks][0], cur[0][ks][1], cur[0][ks][2], cur[0][ks][3], cur[1][ks][0], cur[1][ks][1], cur[1][ks][2], cur[1][ks][3]}; \
          o[d] = __builtin_amdgcn_mfma_f32_32x32x16_bf16(__builtin_bit_cast(bf16x8, PW[ks]), vf, o[d], 0, 0, 0); } \
        asm volatile("" : "+v"(o[d]));     \
        } while (0)
#define ATT_EX(PX, e0, PWN, q) do { PX[e0] = __builtin_amdgcn_exp2f(PX[e0]); PX[(e0) + 1] = __builtin_amdgcn_exp2f(PX[(e0) + 1]); sacc += PX[e0]; sacc += PX[(e0) + 1]; ATT_PIN(sacc); \
        PWN[q] = cvt_pk_bf16(PX[e0], PX[(e0) + 1]); ATT_PIN(PWN); } while (0)
#define ATT_FUSED(slk, slk1, PW, PWN) do { const lds_cptr kp = kp0 + (slk1) * KSLOT; const lds_cptr vp = vp0 + (slk) * VSLOT; s16x4 va[2][4], vb[2][4]; \
        ATT_SB(); \
        const u32x4 k0l = *(const __attribute__((address_space(3))) u32x4*)(kp), k0h = *(const __attribute__((address_space(3))) u32x4*)(kp + 1024); \
        const u32x4 k1l = *(const __attribute__((address_space(3))) u32x4*)(kp + 512), k1h = *(const __attribute__((address_space(3))) u32x4*)(kp + 1024 + 512); \
        ATT_VRD(va, 0); \
        ATT_SB(); \
        const v8i32 kf0 = __builtin_bit_cast(v8i32, __builtin_shufflevector(k0l, k0h, 0, 1, 2, 3, 4, 5, 6, 7)), kf1 = __builtin_bit_cast(v8i32, __builtin_shufflevector(k1l, k1h, 0, 1, 2, 3, 4, 5, 6, 7)); \
        f32x16 p0 = __builtin_amdgcn_mfma_scale_f32_32x32x64_f8f6f4(kf0, qf, zero16, 0, 0, 0, 0x7a7b, 1, 0x7a7b); \
        f32x16 p1 = __builtin_amdgcn_mfma_scale_f32_32x32x64_f8f6f4(kf1, qf, zero16, 0, 0, 0, 0x7a7b, 1, 0x7a7b); \
        ATT_SB(); \
        float sacc = 0.f; \
          \
        ATT_MM(0, 0, va, vb, PW); ATT_SB(); ATT_MM(0, 1, va, vb, PW); ATT_SB(); \
        ATT_MM(0, 2, va, vb, PW); ATT_EX(p0, 0, PWN[0], 0); ATT_SB();  ATT_MM(0, 3, va, vb, PW); ATT_EX(p0, 2, PWN[0], 1); ATT_SB(); \
        ATT_MM(1, 0, vb, va, PW); ATT_EX(p0, 4, PWN[0], 2); ATT_SB();  ATT_MM(1, 1, vb, va, PW); ATT_EX(p0, 6, PWN[0], 3); ATT_SB(); \
        ATT_MM(1, 2, vb, va, PW); ATT_EX(p0, 8, PWN[1], 0); ATT_SB();  ATT_MM(1, 3, vb, va, PW); ATT_EX(p0, 10, PWN[1], 1); ATT_SB(); \
        ATT_MM(2, 0, va, vb, PW); ATT_EX(p0, 12, PWN[1], 2); ATT_SB(); ATT_MM(2, 1, va, vb, PW); ATT_EX(p0, 14, PWN[1], 3); ATT_SB(); \
        ATT_MM(2, 2, va, vb, PW); ATT_EX(p1, 0, PWN[2], 0); ATT_SB();  ATT_MM(2, 3, va, vb, PW); ATT_EX(p1, 2, PWN[2], 1); ATT_SB(); \
        ATT_MM(3, 0, vb, va, PW); ATT_EX(p1, 4, PWN[2], 2); ATT_SB();  ATT_MM(3, 1, vb, va, PW); ATT_EX(p1, 6, PWN[2], 3); ATT_SB(); \
        ATT_MM(3, 2, vb, va, PW); ATT_EX(p1, 8, PWN[3], 0); ATT_EX(p1, 10, PWN[3], 1); ATT_SB(); \
        ATT_MM(3, 3, vb, va, PW); ATT_EX(p1, 12, PWN[3], 2); ATT_EX(p1, 14, PWN[3], 3); ATT_SB(); \
        l_reg += sacc; \
        } while (0)
    {
        if (wid >= 4) __builtin_amdgcn_s_setprio(1);
        if (NT > 2) { ATT_WAIT_BAR(6); } else { ATT_WAIT_BAR(3); }
        ATT_QKEXP(0);
        int sk = 0;
#pragma unroll 1
        for (int k = 0; k < NT - 2; k += 2) {
            ATT_WAIT_BAR(3);
            ATT_DMA_K(k + 3, (sk + 3) & 3); ATT_DMA_V(k + 3, (sk + 3) & 3);
            ATT_SB(); ATT_FUSED(sk, (sk + 1) & 3, pw, pwn); ATT_SB();
            ATT_WAIT_BAR(3);
            if (k + 4 < NT) { ATT_DMA_K(k + 4, sk); ATT_DMA_V(k + 4, sk); }
            ATT_SB(); ATT_FUSED((sk + 1) & 3, (sk + 2) & 3, pwn, pw); ATT_SB();
            sk = (sk + 2) & 3;
        }
        ATT_WAIT_BAR(0);
        if (cw == NT - 1) { ATT_SB(); ATT_FUSED(sk, (sk + 1) & 3, pw, pwn); ATT_SB(); ATT_PV((sk + 1) & 3, pwn); }
        else { ATT_SB(); ATT_PV(sk, pw); }
    }
#undef ATT_FUSED
#undef ATT_MM
#undef ATT_EX
#undef ATT_PIN
#undef ATT_QKEXP
#undef ATT_PV
#undef ATT_VRD
#undef ATT_VMM
#undef ATT_SB
#undef ATT_DMA_K
#undef ATT_DMA_V
    __builtin_amdgcn_s_setprio(0);
    { auto rr = __builtin_amdgcn_permlane32_swap(__float_as_uint(l_reg), __float_as_uint(l_reg), false, false); l_reg = __uint_as_float(rr[0]) + __uint_as_float(rr[1]); }
    LAS float* wsf = (LAS float*)(shm + LDS_WS) + wid * 64;
    if (hi == 0) wsf[r32] = l_reg;
    ATT_WAIT_BAR(0);
    float rli[16];
    const float scl = m ? lam : 1.0f;
#pragma unroll
    for (int r = 0; r < 16; ++r) rli[r] = scl * __builtin_amdgcn_rcpf(wsf[crow(r, hi)]);
    LAS float* stg = (LAS float*)shm + qg * (32 * STG_ROW);
    if (m == 1) {
#pragma unroll
        for (int r = 0; r < 16; ++r)
#pragma unroll
            for (int d = 0; d < 4; ++d) stg[crow(r, hi) * STG_ROW + d * 32 + r32] = o[d][r] * rli[r];
    }
    ATT_WAIT_BAR(0);
    if (m == 0) {
#pragma unroll
        for (int r = 0; r < 16; ++r)
#pragma unroll
            for (int d = 0; d < 4; ++d) { LAS float* p = stg + crow(r, hi) * STG_ROW + d * 32 + r32; *p = o[d][r] * rli[r] - *p; }
    }
    ATT_WAIT_BAR(0);
    {
        const int row = 16 * m + (lane >> 2), qt = lane & 3;
        const LAS float* p = stg + row * STG_ROW + qt * 32;
        f32x4 v[8]; float ss = 0.f;
#pragma unroll
        for (int i = 0; i < 8; ++i) { v[i] = *(const LAS f32x4*)(p + 4 * i); ss += (v[i][0] * v[i][0] + v[i][1] * v[i][1]) + (v[i][2] * v[i][2] + v[i][3] * v[i][3]); }
        ss += __shfl_xor(ss, 1); ss += __shfl_xor(ss, 2);
        const float rn = __builtin_amdgcn_rsqf(ss * (1.f / 128.f) + EPS) * oml;
        bf16_t* dst = MIX + (rowbase + q0 + qg * 32 + row) * D + DS + h * 128 + qt * 32;
#pragma unroll
        for (int i = 0; i < 4; ++i) {
            const f32x4 g0 = *(const f32x4*)(subg + qt * 32 + 8 * i), g1 = *(const f32x4*)(subg + qt * 32 + 8 * i + 4);
            const f32x4 a = v[2 * i] * g0 * rn, c = v[2 * i + 1] * g1 * rn;
            u32x4 w; w.x = cvt_pk_bf16(a[0], a[1]); w.y = cvt_pk_bf16(a[2], a[3]); w.z = cvt_pk_bf16(c[0], c[1]); w.w = cvt_pk_bf16(c[2], c[3]);
            *(u32x4*)(dst + 8 * i) = w;
        }
    }
    ATT_WAIT_BAR(0);
#undef ATT_DMA
}
}
template <int MODE> __device__ __forceinline__ void attn_phase(Frame& F, int l) {
    const bf16_t* Q = (const bf16_t*)(F.ws + WS_Q); const bf16_t* K = (const bf16_t*)(F.ws + WS_K); const bf16_t* V = (const bf16_t*)(F.ws + WS_V);
    bf16_t* MIX = (bf16_t*)(F.ws + WS_MIX);
    const float* sc = (const float*)(F.ws + WS_SCAL) + l * 4;
    const float lam = sc[0], mshift = sc[1], oml = sc[2];
    const float* subg = arg_in(19) + l * DV;
    const int G = F.G;
#ifndef ATT_XA
#define ATT_XA 1
#endif
    const bool xa = ATT_XA && (G & 7) == 0;
    const int x = F.bx & 7, j = F.bx >> 3, wpx = xa ? (G >> 3) : 1;
    const int npair = xa ? (32 - j + wpx - 1) / wpx : 0;
    const int nit = xa ? 4 * npair : (1024 - F.bx + G - 1) / G;
#pragma unroll 1
    for (int it = 0; it < nit; ++it) {
        int bh, qb;
        if (xa) { const int r = it / (2 * npair), rem = it % (2 * npair), sidx = j + (rem >> 1) * wpx; bh = 2 * x + r; qb = (rem & 1) ? sidx : 63 - sidx; }
        else { const int v = F.bx + it * G; bh = v >> 6; qb = v & 63; }
        att::attn_unit<MODE>(bh, qb, Q, K, V, MIX, subg, lam, mshift, oml, F.lds + LDS_RING, F.tid);
    }
}

__device__ __forceinline__ void router_phase(Frame& F, int l) {
    const bf16_t* h1 = (const bf16_t*)(F.ws + WS_H1); const float* g = arg_in(21) + (size_t)l * D; const float* br = arg_in(23) + l * NE;
    const bf16_t* WRT = (const bf16_t*)(F.ws + WS_WRT + l * WRT_STRIDE);
    bf16_t* XN = (bf16_t*)(F.ws + WS_XN); int* TOPI = (int*)(F.ws + WS_TOPI); float* TOPG = (float*)(F.ws + WS_TOPG); int* WGCNT = (int*)(F.ws + WS_WGCNT); float* RS = (float*)(F.ws + WS_RS);
    const int lane = F.lane, tid = F.tid, wave = F.wave, n = lane & 15, kq = lane >> 4;
    constexpr int PITCH = 2080;
    LAS unsigned char* wl = F.lds + LDS_RING;
    LAS float* lg = (LAS float*)(F.lds + LDS_RING + 2 * 32 * PITCH) + wave * (16 * 33 + 16);
    LAS int* cnt = (LAS int*)(F.ctl + 256);
    __syncthreads();
    {
        u32x4 st[16];
#pragma unroll
        for (int k = 0; k < 16; ++k) { const int i = tid + k * NTHREADS, row = i >> 7, c = i & 127; st[k] = *(const u32x4*)(WRT + (size_t)row * D + c * 8); }
#pragma unroll
        for (int k = 0; k < 16; ++k) { const int i = tid + k * NTHREADS, row = i >> 7, c = i & 127; *(LAS u32x4*)(wl + row * PITCH + c * 16) = st[k]; }
    }
    if (tid < 32) cnt[tid] = 0;
    __syncthreads();
    for (int wgu = F.bx; wgu < T / 128; wgu += F.G) {
        if (wgu != F.bx) { __syncthreads(); if (tid < 32) cnt[tid] = 0; __syncthreads(); }
        const int row = wgu * 128 + wave * 16 + n;
        const bf16_t* hp = h1 + (size_t)row * D + 8 * kq; const float* gp = g + 8 * kq;
        bf16_t* xp = XN + (size_t)row * D + 8 * kq; unsigned char* xp8 = (unsigned char*)XN + (size_t)row * D + 8 * kq;
        const LAS unsigned char* bh = wl + n * PITCH + 16 * kq;
        f32x4 acc0 = (f32x4){0.f, 0.f, 0.f, 0.f}, acc1 = acc0; float ss = 0.f;
        u32x4 lhw[2][4]; f32x4 lg0[2][4], lg4[2][4];
#define RT_LD(buf, kg) do { _Pragma("unroll") for (int i = 0; i < 4; ++i) { const int ks = 4 * (kg) + i; lhw[buf][i] = *(const u32x4*)(hp + 32 * ks); \
            lg0[buf][i] = *(const f32x4*)(gp + 32 * ks); lg4[buf][i] = *(const f32x4*)(gp + 32 * ks + 4); } } while (0)
        RT_LD(0, 0);
#pragma unroll
        for (int kg = 0; kg < 8; ++kg) {
            if (kg + 1 < 8) RT_LD((kg + 1) & 1, kg + 1);
#pragma unroll
            for (int i = 0; i < 4; ++i) {
            const int ks = 4 * kg + i;
            const u32x4 hw = lhw[kg & 1][i]; const f32x4 h0 = (f32x4){bf_lo(hw.x), bf_hi(hw.x), bf_lo(hw.y), bf_hi(hw.y)}, h4 = (f32x4){bf_lo(hw.z), bf_hi(hw.z), bf_lo(hw.w), bf_hi(hw.w)};
            const f32x4 g0 = lg0[kg & 1][i], g4 = lg4[kg & 1][i];
            const f32x4 x0 = h0 * g0, x4 = h4 * g4;
            ss += (x0[0] * x0[0] + x0[1] * x0[1]) + (x0[2] * x0[2] + x0[3] * x0[3]) + (x4[0] * x4[0] + x4[1] * x4[1]) + (x4[2] * x4[2] + x4[3] * x4[3]);
            u32x4 hi; hi.x = cvt_pk_bf16(x0[0], x0[1]); hi.y = cvt_pk_bf16(x0[2], x0[3]); hi.z = cvt_pk_bf16(x4[0], x4[1]); hi.w = cvt_pk_bf16(x4[2], x4[3]);
            if (UP_FP8) { u32x2 w8; w8.x = pk4_fp8(x0[0] * 8.f, x0[1] * 8.f, x0[2] * 8.f, x0[3] * 8.f); w8.y = pk4_fp8(x4[0] * 8.f, x4[1] * 8.f, x4[2] * 8.f, x4[3] * 8.f); *(u32x2*)(xp8 + 32 * ks) = w8; }
            else *(u32x4*)(xp + 32 * ks) = hi;
            u32x4 lo;
            lo.x = cvt_pk_bf16(x0[0] - bf_lo(hi.x), x0[1] - bf_hi(hi.x)); lo.y = cvt_pk_bf16(x0[2] - bf_lo(hi.y), x0[3] - bf_hi(hi.y));
            lo.z = cvt_pk_bf16(x4[0] - bf_lo(hi.z), x4[1] - bf_hi(hi.z)); lo.w = cvt_pk_bf16(x4[2] - bf_lo(hi.w), x4[3] - bf_hi(hi.w));
            const bf16x8 ah = __builtin_bit_cast(bf16x8, hi), al = __builtin_bit_cast(bf16x8, lo);
            const bf16x8 b0h = *(const LAS bf16x8*)(bh + 64 * ks), b1h = *(const LAS bf16x8*)(bh + 16 * PITCH + 64 * ks);
            const bf16x8 b0l = *(const LAS bf16x8*)(bh + 32 * PITCH + 64 * ks), b1l = *(const LAS bf16x8*)(bh + 48 * PITCH + 64 * ks);
            acc0 = __builtin_amdgcn_mfma_f32_16x16x32_bf16(ah, b0h, acc0, 0, 0, 0); acc1 = __builtin_amdgcn_mfma_f32_16x16x32_bf16(ah, b1h, acc1, 0, 0, 0);
            acc0 = __builtin_amdgcn_mfma_f32_16x16x32_bf16(al, b0h, acc0, 0, 0, 0); acc1 = __builtin_amdgcn_mfma_f32_16x16x32_bf16(al, b1h, acc1, 0, 0, 0);
            acc0 = __builtin_amdgcn_mfma_f32_16x16x32_bf16(ah, b0l, acc0, 0, 0, 0); acc1 = __builtin_amdgcn_mfma_f32_16x16x32_bf16(ah, b1l, acc1, 0, 0, 0);
            }
        }
#undef RT_LD
        ss = sum_x16_x32(ss);
        const float r = __builtin_amdgcn_rsqf(ss * (1.f / D) + EPS);
        if (kq == 0) { lg[16 * 33 + n] = r; RS[row] = r; }
        asm volatile("s_waitcnt lgkmcnt(0)" ::: "memory");
        const float b0 = br[n], b1 = br[16 + n];
#pragma unroll
        for (int q = 0; q < 4; ++q) { const float rt = lg[16 * 33 + 4 * kq + q]; lg[(4 * kq + q) * 33 + n] = acc0[q] * rt + b0; lg[(4 * kq + q) * 33 + 16 + n] = acc1[q] * rt + b1; }
        asm volatile("s_waitcnt lgkmcnt(0)" ::: "memory");
        if (lane < 16) {
            const int tok = wgu * 128 + wave * 16 + lane;
            float v[32];
#pragma unroll
            for (int e = 0; e < 32; ++e) v[e] = lg[lane * 33 + e];
            unsigned mask = 0u; float val[4]; int sel[4];
#pragma unroll
            for (int k = 0; k < 4; ++k) { float best = -INFINITY; int bi = 0;
#pragma unroll
                for (int e = 0; e < 32; ++e) { const bool ok = !((mask >> e) & 1u) && (v[e] > best); best = ok ? v[e] : best; bi = ok ? e : bi; }
                mask |= 1u << bi; val[k] = best; sel[k] = bi; }
            float ex[4], sum = 0.f;
#pragma unroll
            for (int k = 0; k < 4; ++k) { ex[k] = __expf(val[k] - val[0]); sum += ex[k]; }
            const float inv = __builtin_amdgcn_rcpf(sum);
#pragma unroll
            for (int k = 0; k < 4; ++k) { const int pos = __hip_atomic_fetch_add(cnt + sel[k], 1, __ATOMIC_RELAXED, __HIP_MEMORY_SCOPE_WORKGROUP);
                TOPI[tok * 4 + k] = sel[k] | (pos << 8); TOPG[tok * 4 + k] = ex[k] * inv; }
        }
        __syncthreads();
        if (tid < 32) WGCNT[wgu * 32 + tid] = cnt[tid];
    }
    __syncthreads();
}
__device__ __forceinline__ void routing_phase(Frame& F) {
    const int* TOPI = (const int*)(F.ws + WS_TOPI); const float* TOPG = (const float*)(F.ws + WS_TOPG); const int* WGCNT = (const int*)(F.ws + WS_WGCNT);
    int* TOKROW = (int*)(F.ws + WS_TOKROW); int* ROWTOK = (int*)(F.ws + WS_ROWTOK); float* ROWGATE = (float*)(F.ws + WS_ROWGATE); int* TILEEXP = (int*)(F.ws + WS_TILEEXP);
    float* ROWSCALE = (float*)(F.ws + WS_ROWSCALE); const float* RS = (const float*)(F.ws + WS_RS);
    const int tid = F.tid;
    LAS int* tot = (LAS int*)(F.lds + LDS_RING);
    LAS int* pst = tot + 32;
    LAS int* mypre = pst + 40;
    LAS int* part = mypre + 32;
    for (int wgu = F.bx; wgu < 256; wgu += F.G) {
        __syncthreads();
        {
            const int e = tid & 31, wq = tid >> 5; int a = 0, mine = 0;
#pragma unroll
            for (int j = 0; j < 16; ++j) { const int w = wq * 16 + j; const int c = WGCNT[w * 32 + e]; a += c; if (w < wgu) mine += c; }
            part[wq * 32 + e] = a; part[512 + wq * 32 + e] = mine;
        }
        __syncthreads();
        if (tid < 32) { int a = 0, mine = 0;
#pragma unroll
            for (int q = 0; q < 16; ++q) { a += part[q * 32 + tid]; mine += part[512 + q * 32 + tid]; }
            tot[tid] = a; mypre[tid] = mine; }
        __syncthreads();
        if (tid == 0) { int a = 0; for (int e = 0; e < 32; ++e) { pst[e] = a; a += (tot[e] + 255) & ~255; } pst[32] = a; }
        __syncthreads();
        {
            const int t = wgu * 128 + (tid >> 2), k = tid & 3;
            const int w = TOPI[t * 4 + k]; const int e = w & 255, pos = w >> 8;
            const int dest = pst[e] + mypre[e] + pos;
            ROWTOK[dest] = t; ROWGATE[dest] = TOPG[t * 4 + k]; ROWSCALE[dest] = RS[t]; TOKROW[t * 4 + k] = dest;
        }
        if (wgu < 32) {
            const int e = wgu; const int beg = pst[e] + tot[e], end = pst[e + 1];
            for (int r = beg + tid; r < end; r += NTHREADS) { ROWTOK[r] = 0; ROWGATE[r] = 0.f; ROWSCALE[r] = 0.f; }
        }
        if (wgu == 0) {
            const int ntiles = pst[32] >> 8;
            for (int pm = tid; pm < ntiles; pm += NTHREADS) { int e = 0; for (int q = 1; q < 32; ++q) if ((pm << 8) >= pst[q]) e = q; TILEEXP[pm] = e; }
            if (tid == 0) TILEEXP[1023] = ntiles;
            if (tid < 33) TILEEXP[768 + tid] = pst[tid];
        }
    }
    __syncthreads();
}
struct CRow { u32x4 h[2]; u32x2 y[4][2]; };
__device__ __forceinline__ void crow_load(CRow& r, const bf16_t* H1, const unsigned char* YB, const int4 tr, int m, int lane) {
    const bf16_t* hr = H1 + (size_t)m * D + 8 * lane;
    r.h[0] = *(const u32x4*)(hr); r.h[1] = *(const u32x4*)(hr + 512);
    const int rows[4] = {tr.x, tr.y, tr.z, tr.w};
#pragma unroll
    for (int k = 0; k < 4; ++k) { const unsigned char* yr = YB + (size_t)rows[k] * D + 8 * lane; r.y[k][0] = *(const u32x2*)(yr); r.y[k][1] = *(const u32x2*)(yr + 512); }
}
__device__ __forceinline__ void crow_finish(CRow& r, float* out32, bf16_t* H2, bf16_t* XN, const float* gnext, int m, int lane) {
    f32x4 v[4];
#pragma unroll
    for (int hf = 0; hf < 2; ++hf) { const u32x4 w = r.h[hf]; v[2 * hf] = (f32x4){bf_lo(w.x), bf_hi(w.x), bf_lo(w.y), bf_hi(w.y)}; v[2 * hf + 1] = (f32x4){bf_lo(w.z), bf_hi(w.z), bf_lo(w.w), bf_hi(w.w)}; }
#pragma unroll
    for (int k = 0; k < 4; ++k)
#pragma unroll
        for (int hf = 0; hf < 2; ++hf) { fp8x4_add(r.y[k][hf].x, 1.f / 16.f, v[2 * hf]); fp8x4_add(r.y[k][hf].y, 1.f / 16.f, v[2 * hf + 1]); }
    if (out32) { float* orow = out32 + (size_t)m * D + 8 * lane; *(f32x4*)(orow) = v[0]; *(f32x4*)(orow + 4) = v[1]; *(f32x4*)(orow + 512) = v[2]; *(f32x4*)(orow + 516) = v[3]; }
    else {
        u32x4 w; w.x = cvt_pk_bf16(v[0][0], v[0][1]); w.y = cvt_pk_bf16(v[0][2], v[0][3]); w.z = cvt_pk_bf16(v[1][0], v[1][1]); w.w = cvt_pk_bf16(v[1][2], v[1][3]);
        *(u32x4*)(H2 + (size_t)m * D + 8 * lane) = w;
        w.x = cvt_pk_bf16(v[2][0], v[2][1]); w.y = cvt_pk_bf16(v[2][2], v[2][3]); w.z = cvt_pk_bf16(v[3][0], v[3][1]); w.w = cvt_pk_bf16(v[3][2], v[3][3]);
        *(u32x4*)(H2 + (size_t)m * D + 512 + 8 * lane) = w;
    }
    if (gnext) {
        float s = 0.f;
#pragma unroll
        for (int j = 0; j < 4; ++j) s += (v[j][0] * v[j][0] + v[j][1] * v[j][1]) + (v[j][2] * v[j][2] + v[j][3] * v[j][3]);
        const float rr = __builtin_amdgcn_rsqf(wave_sum(s) * (1.f / D) + EPS);
        const float* gp = gnext + 8 * lane;
        const f32x4 a0 = v[0] * *(const f32x4*)(gp) * rr, a1 = v[1] * *(const f32x4*)(gp + 4) * rr, a2 = v[2] * *(const f32x4*)(gp + 512) * rr, a3 = v[3] * *(const f32x4*)(gp + 516) * rr;
        if (IN_FP8) { unsigned char* x8 = (unsigned char*)XN + (size_t)m * D + 8 * lane;
            u32x2 w8; w8.x = pk4_fp8(a0[0] * 16.f, a0[1] * 16.f, a0[2] * 16.f, a0[3] * 16.f); w8.y = pk4_fp8(a1[0] * 16.f, a1[1] * 16.f, a1[2] * 16.f, a1[3] * 16.f); *(u32x2*)(x8) = w8;
            w8.x = pk4_fp8(a2[0] * 16.f, a2[1] * 16.f, a2[2] * 16.f, a2[3] * 16.f); w8.y = pk4_fp8(a3[0] * 16.f, a3[1] * 16.f, a3[2] * 16.f, a3[3] * 16.f); *(u32x2*)(x8 + 512) = w8; }
        else {
        u32x4 w; w.x = cvt_pk_bf16(a0[0], a0[1]); w.y = cvt_pk_bf16(a0[2], a0[3]); w.z = cvt_pk_bf16(a1[0], a1[1]); w.w = cvt_pk_bf16(a1[2], a1[3]);
        *(u32x4*)(XN + (size_t)m * D + 8 * lane) = w;
        w.x = cvt_pk_bf16(a2[0], a2[1]); w.y = cvt_pk_bf16(a2[2], a2[3]); w.z = cvt_pk_bf16(a3[0], a3[1]); w.w = cvt_pk_bf16(a3[2], a3[3]);
        *(u32x4*)(XN + (size_t)m * D + 512 + 8 * lane) = w; }
    }
}
__device__ __forceinline__ void combine_phase(Frame& F, const float* gnext, float* out32) {
    const unsigned char* YB = (const unsigned char*)(F.ws + WS_YB); const int* TOKROW = (const int*)(F.ws + WS_TOKROW); bf16_t* XN = (bf16_t*)(F.ws + WS_XN);
    const bf16_t* H1 = (const bf16_t*)(F.ws + WS_H1); bf16_t* H2 = (bf16_t*)(F.ws + WS_H2);
    const int lane = F.lane, NGW = F.G * NWAVES;
    CRow ra, rb;
    int m = F.bx * NWAVES + F.wave;
    auto ldidx = [&](int row) -> int4 { return (row < T) ? *(const int4*)(TOKROW + row * 4) : make_int4(0, 0, 0, 0); };
    int4 t2 = ldidx(m + NGW);
    if (m < T) crow_load(ra, H1, YB, ldidx(m), m, lane);
    while (m < T) {
        const int mb = m + NGW;
        const int4 t3 = ldidx(mb + NGW);
        if (mb < T) crow_load(rb, H1, YB, t2, mb, lane);
        crow_finish(ra, out32, H2, XN, gnext, m, lane);
        if (mb >= T) break;
        const int mc = mb + NGW;
        const int4 t4 = ldidx(mc + NGW);
        if (mc < T) crow_load(ra, H1, YB, t3, mc, lane);
        crow_finish(rb, out32, H2, XN, gnext, mb, lane);
        m = mc; t2 = t4;
    }
}

constexpr int NPH_LAYER = 10, NPH = 1 + DEPTH * NPH_LAYER;
__global__ void __launch_bounds__(NTHREADS, 2) mk_fwd(Args args) {
    extern __shared__ __attribute__((aligned(16))) unsigned char lds_raw[];
    Frame F;
    F.lds = (LAS unsigned char*)lds_raw; F.ctl = F.lds + LDS_CTL; F.ws = args.ws; F.ws0 = args.ws; F.out0 = args.out; F.ap = &args; F.z = 0;
    F.tid = threadIdx.x; F.lane = F.tid & 63; F.wave = __builtin_amdgcn_readfirstlane(F.tid >> 6); F.G = gridDim.x; F.bx = blockIdx.x;
    F.out = args.out;
    for (int u = F.tid; u < 1024; u += NTHREADS) ((LAS unsigned*)F.ctl)[u] = 0u;
    __syncthreads();
    XcdBarrier bar = xcd_barrier_post((unsigned*)(F.ws + WS_CTL) + CW_BAR, (volatile LAS unsigned*)F.ctl);
    const int lo = args.ph_lo, hi = args.ph_hi;
#ifndef PHMASK
#define PHMASK 0x1fff
#endif
#define RUN(k) (lo <= (k) && (k) < hi)
#define EN(b) ((PHMASK >> (b)) & 1)
#ifndef DUPMASK
#define DUPMASK 0
#endif
#ifndef ATT_PROBE_MODE
#define ATT_PROBE_MODE 0
#endif
#ifndef S5C_PROBE_MODE
#define S5C_PROBE_MODE 0
#endif
#ifndef PRO_PROBE_MODE
#define PRO_PROBE_MODE 0
#endif
#define NREP(b) (((DUPMASK >> (b)) & 1) ? 2 : 1)
#define SEAM(k) do { if (RUN((k) + 1)) xcd_barrier(bar); } while (0)
    if (EN(10) && RUN(0)) { { if (NREP(10) == 2) { phase_begin(F); p0_prologue<PRO_PROBE_MODE>(F); xcd_barrier(bar); } phase_begin(F); p0_prologue<0>(F); } SEAM(0); }
    for (int l = 0; l < DEPTH; ++l) {
        const int pb = 1 + l * NPH_LAYER;
#ifdef EXTRA_BARRIERS
        for (int eb = 0; eb < EXTRA_BARRIERS; ++eb) xcd_barrier(bar);
#endif
        if (EN(0) && RUN(pb + 0)) { for (int rep = 0; rep < NREP(0); ++rep) { phase_begin(F); unsigned char* ws = F.ws; (void)ws;
            PInProj P; P.so.init(T, DIN, F.G, F.bx); P.A = (const char*)(ws + WS_XN); P.B = (const char*)(ws + WS_WIN + l * WIN_STRIDE);
            P.UQKV = (bf16_t*)(ws + WS_U); P.GQK = (const float*)(ws + WS_SCAL) + 64 + l * 128; P.COS = (const float*)(ws + WS_COS); P.SIN = (const float*)(ws + WS_SIN);
            pg8::gemm_phase(F.lds + LDS_RING, F.ctl, P, F.tid);  if (rep + 1 < NREP(0)) xcd_barrier(bar); } SEAM(pb + 0);
        }
        if (EN(1) && RUN(pb + 1)) { for (int rep = 0; rep < NREP(1); ++rep) { phase_begin(F); unsigned char* ws = F.ws; (void)ws; s5a_phase(F, l);  if (rep + 1 < NREP(1)) xcd_barrier(bar); } SEAM(pb + 1); }
        if (EN(2) && RUN(pb + 2)) { for (int rep = 0; rep < NREP(2); ++rep) { phase_begin(F); unsigned char* ws = F.ws; (void)ws; if (EN(11)) { if (NREP(11) == 2) { phase_begin(F); s5c_phase<S5C_PROBE_MODE>(F, l); } phase_begin(F); s5c_phase<0>(F, l); } if (EN(12)) { if (NREP(12) == 2) { phase_begin(F); attn_phase<ATT_PROBE_MODE>(F, l); } phase_begin(F); attn_phase<0>(F, l); }  if (rep + 1 < NREP(2)) xcd_barrier(bar); } SEAM(pb + 2); }
        if (EN(3) && RUN(pb + 3)) { for (int rep = 0; rep < NREP(3); ++rep) { phase_begin(F); unsigned char* ws = F.ws; (void)ws;
            PGlu P; P.so.init(T, DS, F.G, F.bx); P.A = (const char*)(ws + WS_YG); P.B = (const char*)(ws + WS_WGLU + l * WGLU_STRIDE);
            P.YG = (const bf16_t*)(ws + WS_YG); P.MIX = (bf16_t*)(ws + WS_MIX); P.RSP = (float*)(ws + WS_RSP);
            pg8::gemm_phase(F.lds + LDS_RING, F.ctl, P, F.tid);  if (rep + 1 < NREP(3)) xcd_barrier(bar); } SEAM(pb + 3);
        }
        if (EN(4) && RUN(pb + 4)) { for (int rep = 0; rep < NREP(4); ++rep) { phase_begin(F); unsigned char* ws = F.ws; (void)ws;
            POut P; P.so.init(T, D, F.G, F.bx); P.A = (const char*)(ws + WS_MIX); P.B = (const char*)(ws + WS_WOUT + l * WOUT_STRIDE);
            P.RSP = (const float*)(ws + WS_RSP); P.base32 = (l == 0) ? arg_in(0) : nullptr; P.base16 = (const bf16_t*)(ws + WS_H2); P.H1 = (bf16_t*)(ws + WS_H1);
            pg8::gemm_phase(F.lds + LDS_RING, F.ctl, P, F.tid);  if (rep + 1 < NREP(4)) xcd_barrier(bar); } SEAM(pb + 4);
        }
        if (EN(5) && RUN(pb + 5)) { for (int rep = 0; rep < NREP(5); ++rep) { phase_begin(F); unsigned char* ws = F.ws; (void)ws; router_phase(F, l);  if (rep + 1 < NREP(5)) xcd_barrier(bar); } SEAM(pb + 5); }
        if (EN(6) && RUN(pb + 6)) { for (int rep = 0; rep < NREP(6); ++rep) { phase_begin(F); unsigned char* ws = F.ws; (void)ws; routing_phase(F);  if (rep + 1 < NREP(6)) xcd_barrier(bar); } SEAM(pb + 6); }
        if (EN(7) && RUN(pb + 7)) { for (int rep = 0; rep < NREP(7); ++rep) { phase_begin(F); unsigned char* ws = F.ws; (void)ws;
            PUp P; P.mo.init(F.G, F.bx, (const int*)(ws + WS_TILEEXP) + 768);
            P.A = (const char*)(ws + WS_XN); P.B = (const char*)(ws + WS_WUP + l * WUP_STRIDE); P.ROWTOK = (const int*)(ws + WS_ROWTOK); P.TILEEXP = (const int*)(ws + WS_TILEEXP);
            P.bup = arg_in(25) + (size_t)l * NE * 2048; P.ROWSCALE = (const float*)(ws + WS_ROWSCALE); P.ACT = (bf16_t*)(ws + WS_ACT);
            { LAS int* tl = (LAS int*)(F.lds + LDS_RING + 131072); for (int i = F.tid; i < 640; i += NTHREADS) tl[i] = P.TILEEXP[i]; __syncthreads(); P.tl = tl; }
            if (GEMM_PROBE && rep + 1 < NREP(7)) { PUpNoDma Q; (PUp&)Q = P; pg8::gemm_phase(F.lds + LDS_RING, F.ctl, Q, F.tid); } else pg8::gemm_phase(F.lds + LDS_RING, F.ctl, P, F.tid);  if (rep + 1 < NREP(7)) xcd_barrier(bar); } SEAM(pb + 7);
        }
        if (EN(8) && RUN(pb + 8)) { for (int rep = 0; rep < NREP(8); ++rep) { phase_begin(F); unsigned char* ws = F.ws; (void)ws;
            PDown P; P.mo.init(F.G, F.bx, (const int*)(ws + WS_TILEEXP) + 768);
            P.A = (const char*)(ws + WS_ACT); P.B = (const char*)(ws + WS_WDN + l * WDN_STRIDE); P.TILEEXP = (const int*)(ws + WS_TILEEXP);
            P.bdn = arg_in(27) + (size_t)l * NE * 1024; P.ROWGATE = (const float*)(ws + WS_ROWGATE); P.YB = (bf16_t*)(ws + WS_YB);
            { LAS int* tl = (LAS int*)(F.lds + LDS_RING + 131072); for (int i = F.tid; i < 640; i += NTHREADS) tl[i] = P.TILEEXP[i]; __syncthreads(); P.tl = tl; }
            pg8::gemm_phase(F.lds + LDS_RING, F.ctl, P, F.tid);  if (rep + 1 < NREP(8)) xcd_barrier(bar); } SEAM(pb + 8);
        }
        if (EN(9) && RUN(pb + 9)) { for (int rep = 0; rep < NREP(9); ++rep) { phase_begin(F); unsigned char* ws = F.ws; (void)ws; combine_phase(F, (l + 1 < DEPTH) ? arg_in(1) + (size_t)(l + 1) * D : nullptr, (l + 1 < DEPTH) ? nullptr : F.out);  if (rep + 1 < NREP(9)) xcd_barrier(bar); } SEAM(pb + 9); }
    }
#undef RUN
#undef SEAM
}

extern "C" void kernel_launch(void* const* d_in, const int* in_sizes, int n_in, void* d_out, int out_size, void* d_ws, size_t ws_size, hipStream_t stream) {
    static int grid = 0;
    if (grid == 0) {
        if (n_in != 28 || out_size != T * D || ws_size < WS_END) { fprintf(stderr, "kernel_launch: unexpected shapes (n_in %d out %d ws %zu)\n", n_in, out_size, ws_size); grid = -1; return; }
        int dev = 0, cus = 0;
        if (hipGetDevice(&dev) != hipSuccess || hipDeviceGetAttribute(&cus, hipDeviceAttributeMultiprocessorCount, dev) != hipSuccess) { grid = -1; return; }
        if (hipFuncSetAttribute((const void*)mk_fwd, hipFuncAttributeMaxDynamicSharedMemorySize, LDS_BYTES) != hipSuccess) { fprintf(stderr, "kernel_launch: hipFuncSetAttribute failed\n"); grid = -1; return; }
        int per_cu = 0;
        if (hipOccupancyMaxActiveBlocksPerMultiprocessor(&per_cu, (const void*)mk_fwd, NTHREADS, LDS_BYTES) != hipSuccess || per_cu < 1) { fprintf(stderr, "kernel_launch: occupancy query says %d\n", per_cu); }
        (void)hipGetLastError();
        grid = cus;
    }
    if (grid < 0) return;
    if (hipMemsetAsync((char*)d_ws + WS_CTL, 0, CTL_ZERO_BYTES, stream) != hipSuccess) return;
    Args a{};
    for (int i = 0; i < 28; ++i) a.in[i] = (const float*)d_in[i];
    a.out = (float*)d_out; a.ws = (unsigned char*)d_ws; a.ph_lo = 0; a.ph_hi = NPH;
    hipLaunchKernelGGL(mk_fwd, dim3(grid), dim3(NTHREADS), LDS_BYTES, stream, a);
}
```
